# Optimizing an MI355X kernel written in HIP

```python
import math
import jax, jax.numpy as jnp
from jax import lax
import numpy as np

D_MODEL = 1024
BATCH = 16
SEQ = 2048
DEPTH = 1
DEC_BATCH = 8
DEC_SEQ = 64
PAST_LEN = 2048

CHUNK = 64
D_MIX = D_MODEL
C_CONV = D_MIX // 2
CONV_WIDTH = 31
N_HEADS = 4
HEAD_DIM = (D_MIX - C_CONV) // (2 * N_HEADS)
V_DIM = 2 * HEAD_DIM
QK_WIDTH = N_HEADS * 2 * HEAD_DIM
ATTN_WIDTH = N_HEADS * V_DIM
D_IN = 2 * C_CONV + 2 * QK_WIDTH + ATTN_WIDTH
N_BUCKETS = 32
MAX_DISTANCE = 128
Q_BLOCK = 128
N_KEYS = 128
N_EXPERTS = N_KEYS * N_KEYS
R_HEADS = 8
TOPK = 16
D_QUERY = 256
D_HALF = D_QUERY // 2
PEER_BLOCK = 128
EPS = 1e-6
NEG = -1e30

kernel_name = "hymba_conformer_diffattn_peer_stream"


def _lambda_init(layer):
    return 0.8 - 0.6 * math.exp(-0.3 * layer)


def _rmsnorm(x, g):
    xf = x.astype(jnp.float32)
    y = xf * lax.rsqrt(jnp.mean(xf * xf, axis=-1, keepdims=True) + EPS)
    return (y * g.astype(jnp.float32)).astype(x.dtype)


def _rel_bucket(rel):
    nb = N_BUCKETS // 2
    max_exact = nb // 2
    ret = jnp.where(rel > 0, nb, 0)
    n = jnp.abs(rel)
    nf = jnp.maximum(n, 1).astype(jnp.float32)
    large = max_exact + (jnp.log(nf / max_exact) / math.log(MAX_DISTANCE / max_exact)
                         * (nb - max_exact)).astype(jnp.int32)
    large = jnp.minimum(large, nb - 1)
    return ret + jnp.where(n < max_exact, n, large)


def _project(x, g_mix, w_in):
    B, S, _ = x.shape
    z = _rmsnorm(x, g_mix) @ w_in
    glu_in, q, k, v = jnp.split(z, [2 * C_CONV, 2 * C_CONV + QK_WIDTH, 2 * C_CONV + 2 * QK_WIDTH], axis=-1)
    a = glu_in[..., :C_CONV] * jax.nn.sigmoid(glu_in[..., C_CONV:])
    q = q.reshape(B, S, N_HEADS, 2, HEAD_DIM)
    k = k.reshape(B, S, N_HEADS, 2, HEAD_DIM)
    v = v.reshape(B, S, N_HEADS, V_DIM)
    return a, q, k, v


def _conv_branch(a, left, conv_w, conv_b, ln_g, ln_b):
    padded = jnp.concatenate([left, a], axis=1)
    y = lax.conv_general_dilated(padded, conv_w[:, None, :], window_strides=(1,), padding='VALID',
                                 dimension_numbers=('NWC', 'WIO', 'NWC'), feature_group_count=C_CONV)
    yf = (y + conv_b).astype(jnp.float32)
    mu = jnp.mean(yf, axis=-1, keepdims=True)
    var = jnp.mean((yf - mu) ** 2, axis=-1, keepdims=True)
    yn = (yf - mu) * lax.rsqrt(var + EPS) * ln_g.astype(jnp.float32) + ln_b.astype(jnp.float32)
    return jax.nn.silu(yn).astype(a.dtype), padded[:, -(CONV_WIDTH - 1):]


def _diff_attn(q, k, v, q_pos, k_pos, rel_bias, lam):
    logits = jnp.einsum('bqhmd,bkhmd->bhmqk', q, k).astype(jnp.float32) * (HEAD_DIM ** -0.5)
    bias = jnp.moveaxis(rel_bias[_rel_bucket(k_pos[None, :] - q_pos[:, None])].astype(jnp.float32), -1, 0)
    logits = logits + bias[None, :, None]
    mask = (k_pos[None, :] // CHUNK) <= (q_pos[:, None] // CHUNK)
    p = jax.nn.softmax(jnp.where(mask, logits, NEG), axis=-1)
    attn = p[:, :, 0] - lam * p[:, :, 1]
    return jnp.einsum('bhqk,bkhe->bqhe', attn.astype(v.dtype), v)


def _subln(o, g, lambda_init):
    of = o.astype(jnp.float32)
    y = of * lax.rsqrt(jnp.mean(of * of, axis=-1, keepdims=True) + EPS) * g.astype(jnp.float32)
    y = y * (1.0 - lambda_init)
    B, S = o.shape[:2]
    return y.reshape(B, S, ATTN_WIDTH).astype(o.dtype)


def _peer(h, w_query, sub_keys, peer_u, peer_v):
    B, S, D = h.shape
    T = B * S
    n_blk = -(-T // PEER_BLOCK)
    flat = jnp.pad(h.reshape(T, D), ((0, n_blk * PEER_BLOCK - T), (0, 0))).reshape(n_blk, PEER_BLOCK, D)

    def one_block(xb):
        q = (xb @ w_query).reshape(PEER_BLOCK, R_HEADS, 2, D_HALF)
        s = jnp.einsum('trpd,rpnd->trpn', q, sub_keys).astype(jnp.float32)
        s_top, i_top = lax.top_k(s, TOPK)
        cand = s_top[:, :, 0, :, None] + s_top[:, :, 1, None, :]
        cand_idx = i_top[:, :, 0, :, None] * N_KEYS + i_top[:, :, 1, None, :]
        best, pos = lax.top_k(cand.reshape(PEER_BLOCK, R_HEADS, TOPK * TOPK), TOPK)
        idx = jnp.take_along_axis(cand_idx.reshape(PEER_BLOCK, R_HEADS, TOPK * TOPK), pos, axis=-1)
        gate = jax.nn.softmax(best, axis=-1)
        act = jax.nn.gelu(jnp.einsum('trkd,td->trk', peer_u[idx], xb).astype(jnp.float32), approximate=False)
        coef = (gate * act).astype(xb.dtype)
        return jnp.einsum('trk,trkd->td', coef, peer_v[idx])

    out = lax.map(one_block, flat)
    return out.reshape(n_blk * PEER_BLOCK, D)[:T].reshape(B, S, D)


def setup_inputs(seed: int = 0) -> dict:
    key = jax.random.key(seed)
    ks = jax.random.split(key, 24)
    nrm = lambda k, shape, s: jax.random.normal(k, shape, jnp.float32) * s
    return {
        "x_prompt": nrm(ks[0], (BATCH, SEQ, D_MODEL), 1.0),
        "x_sample": nrm(ks[1], (DEC_BATCH, DEC_SEQ, D_MODEL), 1.0),
        "cache_k": nrm(ks[2], (DEPTH, DEC_BATCH, PAST_LEN, N_HEADS, 2, HEAD_DIM), 1.0),
        "cache_v": nrm(ks[3], (DEPTH, DEC_BATCH, PAST_LEN, N_HEADS, V_DIM), 1.0),
        "state_conv": nrm(ks[4], (DEPTH, DEC_BATCH, CONV_WIDTH - 1, C_CONV), 0.5),
        "g_mix": 1.0 + nrm(ks[5], (DEPTH, D_MODEL), 0.02),
        "w_in": nrm(ks[6], (DEPTH, D_MODEL, D_IN), D_MODEL ** -0.5),
        "conv_w": nrm(ks[7], (DEPTH, CONV_WIDTH, C_CONV), CONV_WIDTH ** -0.5),
        "conv_b": nrm(ks[8], (DEPTH, C_CONV), 0.02),
        "conv_ln_g": 1.0 + nrm(ks[9], (DEPTH, C_CONV), 0.02),
        "conv_ln_b": nrm(ks[10], (DEPTH, C_CONV), 0.02),
        "lambda_q1": nrm(ks[11], (DEPTH, HEAD_DIM), 0.1),
        "lambda_k1": nrm(ks[12], (DEPTH, HEAD_DIM), 0.1),
        "lambda_q2": nrm(ks[13], (DEPTH, HEAD_DIM), 0.1),
        "lambda_k2": nrm(ks[14], (DEPTH, HEAD_DIM), 0.1),
        "subln_g": 1.0 + nrm(ks[15], (DEPTH, V_DIM), 0.02),
        "rel_bias": nrm(ks[16], (N_BUCKETS, N_HEADS), 0.5),
        "w_out": nrm(ks[17], (DEPTH, D_MIX, D_MODEL), D_MIX ** -0.5),
        "g_ffn": 1.0 + nrm(ks[18], (DEPTH, D_MODEL), 0.02),
        "w_query": nrm(ks[19], (DEPTH, D_MODEL, R_HEADS * D_QUERY), D_MODEL ** -0.5),
        "sub_keys": nrm(ks[20], (DEPTH, R_HEADS, 2, N_KEYS, D_HALF), D_HALF ** -0.5),
        "peer_u": nrm(ks[21], (DEPTH, N_EXPERTS, D_MODEL), D_MODEL ** -0.5),
        "peer_v": nrm(ks[22], (DEPTH, N_EXPERTS, D_MODEL), 0.25),
        "g_final": 1.0 + nrm(ks[23], (D_MODEL,), 0.02),
    }


def reference(x_prompt, x_sample, cache_k, cache_v, state_conv, g_mix, w_in, conv_w, conv_b,
              conv_ln_g, conv_ln_b, lambda_q1, lambda_k1, lambda_q2, lambda_k2, subln_g, rel_bias,
              w_out, g_ffn, w_query, sub_keys, peer_u, peer_v, g_final):
    B, S, _ = x_prompt.shape
    Bd, Sd, _ = x_sample.shape
    past = cache_k.shape[2]
    pos_p = jnp.arange(S, dtype=jnp.int32)
    pos_s = past + jnp.arange(Sd, dtype=jnp.int32)
    pos_all = jnp.arange(past + Sd, dtype=jnp.int32)

    xp, xs = x_prompt, x_sample
    kp_l, vp_l, cp_l, ks_l, vs_l, cs_l = [], [], [], [], [], []
    for l in range(DEPTH):
        lam_init = _lambda_init(l)
        lam = (jnp.exp(jnp.sum(lambda_q1[l].astype(jnp.float32) * lambda_k1[l].astype(jnp.float32)))
               - jnp.exp(jnp.sum(lambda_q2[l].astype(jnp.float32) * lambda_k2[l].astype(jnp.float32)))
               + lam_init)

        a_p, q_p, k_p, v_p = _project(xp, g_mix[l], w_in[l])
        zero_left = jnp.zeros((B, CONV_WIDTH - 1, C_CONV), a_p.dtype)
        conv_p, tail_p = _conv_branch(a_p, zero_left, conv_w[l], conv_b[l], conv_ln_g[l], conv_ln_b[l])
        outs = []
        for start in range(0, S, Q_BLOCK):
            stop = start + Q_BLOCK
            outs.append(_diff_attn(q_p[:, start:stop], k_p[:, :stop], v_p[:, :stop],
                                   pos_p[start:stop], pos_p[:stop], rel_bias, lam))
        att_p = _subln(jnp.concatenate(outs, axis=1), subln_g[l], lam_init)
        xp = xp + jnp.concatenate([conv_p, att_p], axis=-1) @ w_out[l]
        xp = xp + _peer(_rmsnorm(xp, g_ffn[l]), w_query[l], sub_keys[l], peer_u[l], peer_v[l])

        a_s, q_s, k_s, v_s = _project(xs, g_mix[l], w_in[l])
        conv_s, tail_s = _conv_branch(a_s, state_conv[l], conv_w[l], conv_b[l], conv_ln_g[l], conv_ln_b[l])
        keys = jnp.concatenate([cache_k[l], k_s], axis=1)
        vals = jnp.concatenate([cache_v[l], v_s], axis=1)
        att_s = _subln(_diff_attn(q_s, keys, vals, pos_s, pos_all, rel_bias, lam), subln_g[l], lam_init)
        xs = xs + jnp.concatenate([conv_s, att_s], axis=-1) @ w_out[l]
        xs = xs + _peer(_rmsnorm(xs, g_ffn[l]), w_query[l], sub_keys[l], peer_u[l], peer_v[l])

        kp_l.append(k_p); vp_l.append(v_p); cp_l.append(tail_p)
        ks_l.append(k_s); vs_l.append(v_s); cs_l.append(tail_s)

    y_prompt = _rmsnorm(xp, g_final)
    y_sample = _rmsnorm(xs, g_final)
    return (y_prompt, y_sample, jnp.stack(kp_l), jnp.stack(vp_l), jnp.stack(cp_l),
            jnp.stack(ks_l), jnp.stack(vs_l), jnp.stack(cs_l))
```

```cpp
#include <hip/hip_runtime.h>
#include <hip/hip_cooperative_groups.h>
#include <cstdio>
#include <cstdint>
#include <cmath>
namespace cg = cooperative_groups;
namespace pg8 {
#define PG8_LAS __attribute__((address_space(3)))
typedef unsigned short bf16_t;
typedef short bf16x8 __attribute__((ext_vector_type(8)));
typedef float f32x4 __attribute__((ext_vector_type(4)));
typedef unsigned u32x4 __attribute__((ext_vector_type(4)));
constexpr int BM = 256, BK = 64, HALF = 128, HTB = HALF * BK * 2  , STAGE_BYTES = 8 * HTB, NXCD = 8, WGM = 8;

__host__ __device__ __forceinline__ int lds_byte(int r, int c) { const int st = (r >> 4) * 2 + (c >> 5), rr = r & 15, cc = c & 31, ob = rr * 64 + cc * 2; return st * 1024 + (ob ^ (((ob >> 9) & 1) << 5)); }
__host__ __device__ __forceinline__ void stage_rc(int b, int& R, int& C) { const int st = b / 1024, sb = b % 1024, swz = sb ^ (((sb >> 9) & 1) << 5); R = (st >> 1) * 16 + swz / 64; C = (st & 1) * 32 + (swz % 64) / 2; }
__host__ __device__ __forceinline__ int perm32(int rho) { const int n = rho >> 4, i = rho & 15; return 8 * (i >> 2) + 4 * n + (i & 3); }

struct Unit { int pm, pn; };
struct Gemm { const bf16_t* A; const bf16_t* Bt; int M, N, K; };

struct StaticOrder {
    int nM, nN, nwg, G, c;
    __host__ __device__ void init(int M, int N, int G_, int c_) { nM = M / BM; nN = N / BM; nwg = nM * nN; G = G_; c = c_; }
    __host__ __device__ bool next(int i, Unit& u) const {
        const long L = (long)i * G + c; if (L >= nwg) return false;
        int wgid = (int)L; { const int q = nwg / NXCD, r = nwg % NXCD, xcd = wgid % NXCD, off = wgid / NXCD; wgid = (xcd < r ? xcd * (q + 1) : r * (q + 1) + (xcd - r) * q) + off; }
        const int nig = WGM * nN, gid = wgid / nig, fm = gid * WGM, gsz = (nM - fm) < WGM ? (nM - fm) : WGM;
        u.pm = fm + ((wgid % nig) % gsz); u.pn = (wgid % nig) / gsz; return true;
    }
    __device__ __forceinline__ void a_ready(const Unit&) const {}
    __device__ __forceinline__ void done(const Unit&) const {}
};

__device__ __forceinline__ unsigned cvt_pk_bf16(float lo, float hi) { unsigned r; asm volatile("v_cvt_pk_bf16_f32 %0, %1, %2" : "=v"(r) : "v"(lo), "v"(hi)); return r; }
typedef float f32x2 __attribute__((ext_vector_type(2)));
__device__ __forceinline__ f32x2 gelu_pk(f32x2 v) {
    const f32x2 av = __builtin_elementwise_abs(v), d = av * 0.2316418882f + 1.0f;
    f32x2 t; t.x = __builtin_amdgcn_rcpf(d.x); t.y = __builtin_amdgcn_rcpf(d.y);
    f32x2 q = t * 0.5307027145f + (-0.7265760135f); q = q * t + 0.7107068705f; q = q * t + (-0.142248368f); q = q * t + 0.127414796f; q = q * t;
    const f32x2 s = (v * v) * (-0.72134752044f);
    f32x2 e; e.x = __builtin_amdgcn_exp2f(s.x); e.y = __builtin_amdgcn_exp2f(s.y);
    const f32x2 m = v * (q * e), r = v - m;
    f32x2 o; o.x = v.x < 0.f ? m.x : r.x; o.y = v.y < 0.f ? m.y : r.y; return o;
}

template <int ACT  > struct EpiBf16 {
    static constexpr bool PERM = true, AFTER_DRAIN = false; static_assert(ACT == 0 || ACT == 1, "EpiBf16: ACT is 0 (none) or 1 (gelu_pk)");
    bf16_t* O; int ldc; const float* bias; int split_cols; size_t split_stride; float scale0;
    __device__ __forceinline__ void operator()(const f32x4 (&acc)[2][2][4][2], const Unit& u, int wr, int wc, int fr, int fq) const {
        const int row0 = u.pm * BM + wr * 64 + fr; int colt = u.pn * BM; bf16_t* base = O;
        float sc = 1.f; if (split_cols) { const int t = colt / split_cols; base += (size_t)t * split_stride; colt -= t * split_cols; if (t == 0) sc = scale0; }
        const int col0 = colt + wc * 32 + 8 * fq, bcol0 = u.pn * BM + wc * 32 + 8 * fq;
        f32x4 bv[2][2];
#pragma unroll
        for (int bj = 0; bj < 2; ++bj)
#pragma unroll
            for (int n = 0; n < 2; ++n) bv[bj][n] = bias ? *(const f32x4*)(bias + bcol0 + bj * HALF + 4 * n) : (f32x4){0.f, 0.f, 0.f, 0.f};
#pragma unroll
        for (int ai = 0; ai < 2; ++ai)
#pragma unroll
            for (int m = 0; m < 4; ++m) { bf16_t* rowp = base + (size_t)(row0 + ai * HALF + m * 16) * ldc + col0;
#pragma unroll
                for (int bj = 0; bj < 2; ++bj) { f32x4 v0 = acc[ai][bj][m][0] + bv[bj][0], v1 = acc[ai][bj][m][1] + bv[bj][1];
                    if (ACT == 1) { f32x2 a = gelu_pk((f32x2){v0[0], v0[1]}), b = gelu_pk((f32x2){v0[2], v0[3]}), c = gelu_pk((f32x2){v1[0], v1[1]}), d = gelu_pk((f32x2){v1[2], v1[3]});
                        v0 = (f32x4){a.x, a.y, b.x, b.y}; v1 = (f32x4){c.x, c.y, d.x, d.y}; }
                    v0 = v0 * sc; v1 = v1 * sc; u32x4 w; w.x = cvt_pk_bf16(v0[0], v0[1]); w.y = cvt_pk_bf16(v0[2], v0[3]); w.z = cvt_pk_bf16(v1[0], v1[1]); w.w = cvt_pk_bf16(v1[2], v1[3]);
                    *(u32x4*)(rowp + bj * HALF) = w; } }
    }
};
template <class Epi, class Sched, bool ALIGN_EPI = false, bool SP2 = false>
__device__ __forceinline__ void gemm_phase(PG8_LAS unsigned char* lds, const Gemm g, const Sched& S, const Epi& E) {
    const int tid = threadIdx.x, wid = __builtin_amdgcn_readfirstlane(tid >> 6), lane = tid & 63, wr = wid >> 2, wc = wid & 3, fr = lane & 15, fq = lane >> 4;
    const int K = g.K, nt = K / BK;
    unsigned voffA[2], voffB[2];
#pragma unroll
    for (int i = 0; i < 2; ++i) { int R, C; stage_rc(tid * 16 + i * 8192, R, C); const int Rb = Epi::PERM ? ((R & ~31) + perm32(R & 31)) : R;
        voffA[i] = (unsigned)(R * K + C) * 2u; voffB[i] = (unsigned)(Rb * K + C) * 2u; }
    const size_t kstep = (size_t)(BK * 2);
    const size_t hstep = (size_t)HALF * K * 2;
    const size_t tstep = 2 * hstep;
    const unsigned ldsw = (unsigned)wid * 1024u;
    const int aoff = lds_byte(wr * 64 + fr, fq * 8), boff = lds_byte(wc * 32 + fr, fq * 8);
#define PG8_SA(b, h) (((b) * 2 + (h)) * HTB)
#define PG8_SB(b, h) ((4 + (b) * 2 + (h)) * HTB)
#define PG8_STAGE(bufoff, gbase, voff) do { _Pragma("unroll") for (int _i = 0; _i < 2; ++_i) \
        __builtin_amdgcn_global_load_lds((const unsigned*)((const char*)(gbase) + (voff)[_i]), (PG8_LAS unsigned*)(lds + (bufoff) + ldsw + _i * 8192), 16, 0, 0); } while (0)
#define PG8_LDA(dst, b, h) do { _Pragma("unroll") for (int m = 0; m < 4; ++m) _Pragma("unroll") for (int k = 0; k < 2; ++k) dst[m][k] = *(const PG8_LAS bf16x8*)(lds + PG8_SA(b, h) + aoff + m * 2048 + k * 1024); } while (0)
#define PG8_LDB(dst, b, h) do { _Pragma("unroll") for (int n = 0; n < 2; ++n) _Pragma("unroll") for (int k = 0; k < 2; ++k) dst[n][k] = *(const PG8_LAS bf16x8*)(lds + PG8_SB(b, h) + boff + n * 2048 + k * 1024); } while (0)
#define PG8_MMA(ai, bj, At, Bt) do { __builtin_amdgcn_s_setprio(1); _Pragma("unroll") for (int m = 0; m < 4; ++m) _Pragma("unroll") for (int n = 0; n < 2; ++n) _Pragma("unroll") for (int k = 0; k < 2; ++k) \
        acc[ai][bj][m][n] = __builtin_amdgcn_mfma_f32_16x16x32_bf16(Bt[n][k], At[m][k], acc[ai][bj][m][n], 0, 0, 0); __builtin_amdgcn_s_setprio(0); } while (0)
#define PG8_WAIT_V(n) asm volatile("s_waitcnt vmcnt(" #n ")" ::: "memory")
#define PG8_WAIT_L(n) asm volatile("s_waitcnt lgkmcnt(" #n ")" ::: "memory")
#define PG8_BAR __builtin_amdgcn_s_barrier()
#define PG8_SCHED __builtin_amdgcn_sched_barrier(0)
    Unit cur, nxt; int ui = 0;
    if (!S.next(0, cur)) return;
    f32x4 acc[2][2][4][2];
#pragma unroll
    for (int a = 0; a < 2; ++a)
#pragma unroll
        for (int b = 0; b < 2; ++b)
#pragma unroll
            for (int m = 0; m < 4; ++m)
#pragma unroll
                for (int n = 0; n < 2; ++n) acc[a][b][m][n] = (f32x4){0.f, 0.f, 0.f, 0.f};
    bf16x8 At[4][2], B0[2][2], B1[2][2];
    const char* cA = (const char*)g.A + (size_t)cur.pm * tstep; const char* cB = (const char*)g.Bt + (size_t)cur.pn * tstep;
    S.a_ready(cur);
    if constexpr (SP2) {
        PG8_STAGE(PG8_SB(0, 0), cB, voffB); PG8_STAGE(PG8_SB(0, 1), cB + hstep, voffB); PG8_STAGE(PG8_SA(0, 0), cA, voffA); PG8_STAGE(PG8_SA(0, 1), cA + hstep, voffA);
        if (wr == 1) PG8_BAR;
        PG8_WAIT_V(2); PG8_BAR;
        PG8_STAGE(PG8_SB(1, 0), cB + kstep, voffB); PG8_STAGE(PG8_SA(1, 0), cA + kstep, voffA); PG8_STAGE(PG8_SB(1, 1), cB + hstep + kstep, voffB);
        PG8_WAIT_V(6); PG8_BAR;
    } else {
        PG8_STAGE(PG8_SB(0, 0), cB, voffB); PG8_STAGE(PG8_SA(0, 0), cA, voffA); PG8_STAGE(PG8_SB(0, 1), cB + hstep, voffB); PG8_STAGE(PG8_SA(0, 1), cA + hstep, voffA);
        if (wr == 1) PG8_BAR;
        PG8_WAIT_V(4); PG8_BAR;
        PG8_STAGE(PG8_SB(1, 0), cB + kstep, voffB); PG8_STAGE(PG8_SA(1, 0), cA + kstep, voffA); PG8_STAGE(PG8_SB(1, 1), cB + hstep + kstep, voffB);
        PG8_WAIT_V(6); PG8_BAR;
    }
    for (;;) {
        const bool has_next = S.next(ui + 1, nxt);
        const char* nA = has_next ? (const char*)g.A + (size_t)nxt.pm * tstep : cA; const char* nB = has_next ? (const char*)g.Bt + (size_t)nxt.pn * tstep : cB;
        for (int t = 0; t < nt; t += 2) {
            const bool last = (t == nt - 2);
            const char* a1 = cA + (size_t)(t + 1) * kstep;
            const char* a2 = last ? nA : cA + (size_t)(t + 2) * kstep; const char* b2 = last ? nB : cB + (size_t)(t + 2) * kstep;
            const char* a3 = a2 + kstep; const char* b3 = b2 + kstep;
            if (last && has_next) S.a_ready(nxt);
            if constexpr (SP2) {
            PG8_LDB(B0, 0, 0); PG8_LDB(B1, 0, 1); PG8_SCHED; PG8_LDA(At, 0, 0); PG8_STAGE(PG8_SA(1, 1), a1 + hstep, voffA);
            PG8_WAIT_V(8); PG8_WAIT_L(0); PG8_BAR; PG8_MMA(0, 0, At, B0); PG8_MMA(0, 1, At, B1); PG8_BAR; PG8_SCHED;
            PG8_LDA(At, 0, 1); PG8_STAGE(PG8_SB(0, 0), b2, voffB); PG8_STAGE(PG8_SB(0, 1), b2 + hstep, voffB); PG8_STAGE(PG8_SA(0, 0), a2, voffA);
            PG8_WAIT_V(8); PG8_WAIT_L(0); PG8_BAR; PG8_MMA(1, 0, At, B0); PG8_MMA(1, 1, At, B1); PG8_BAR; PG8_SCHED;
            PG8_LDB(B0, 1, 0); PG8_LDB(B1, 1, 1); PG8_SCHED; PG8_LDA(At, 1, 0); PG8_STAGE(PG8_SA(0, 1), a2 + hstep, voffA);
            PG8_WAIT_V(8); PG8_WAIT_L(0); PG8_BAR; PG8_MMA(0, 0, At, B0); PG8_MMA(0, 1, At, B1); PG8_BAR; PG8_SCHED;
            PG8_LDA(At, 1, 1); PG8_STAGE(PG8_SB(1, 0), b3, voffB); PG8_STAGE(PG8_SB(1, 1), b3 + hstep, voffB); PG8_STAGE(PG8_SA(1, 0), a3, voffA);
            PG8_WAIT_V(8); PG8_WAIT_L(0); PG8_BAR; PG8_MMA(1, 0, At, B0); PG8_MMA(1, 1, At, B1); PG8_BAR; PG8_SCHED;
            } else {
            PG8_LDB(B0, 0, 0); PG8_SCHED; PG8_LDA(At, 0, 0); PG8_STAGE(PG8_SA(1, 1), a1 + hstep, voffA);
            PG8_WAIT_L(8); PG8_BAR; PG8_WAIT_L(0); PG8_MMA(0, 0, At, B0); PG8_BAR; PG8_SCHED;
            PG8_LDB(B1, 0, 1); PG8_STAGE(PG8_SB(0, 0), b2, voffB);
            PG8_BAR; PG8_WAIT_L(0); PG8_MMA(0, 1, At, B1); PG8_BAR;
            PG8_LDA(At, 0, 1); PG8_STAGE(PG8_SA(0, 0), a2, voffA);
            PG8_BAR; PG8_WAIT_L(0); PG8_MMA(1, 0, At, B0); PG8_BAR; PG8_SCHED;
            PG8_STAGE(PG8_SB(0, 1), b2 + hstep, voffB);
            PG8_WAIT_V(6); PG8_BAR; PG8_MMA(1, 1, At, B1); PG8_BAR;
            PG8_LDB(B0, 1, 0); PG8_SCHED; PG8_LDA(At, 1, 0); PG8_STAGE(PG8_SA(0, 1), a2 + hstep, voffA);
            PG8_WAIT_L(8); PG8_BAR; PG8_WAIT_L(0); PG8_MMA(0, 0, At, B0); PG8_BAR; PG8_SCHED;
            PG8_LDB(B1, 1, 1); PG8_STAGE(PG8_SB(1, 0), b3, voffB);
            PG8_BAR; PG8_WAIT_L(0); PG8_MMA(0, 1, At, B1); PG8_BAR;
            PG8_LDA(At, 1, 1); PG8_STAGE(PG8_SA(1, 0), a3, voffA);
            PG8_BAR; PG8_WAIT_L(0); PG8_MMA(1, 0, At, B0); PG8_BAR; PG8_SCHED;
            PG8_STAGE(PG8_SB(1, 1), b3 + hstep, voffB);
            PG8_WAIT_V(6); PG8_BAR; PG8_MMA(1, 1, At, B1); PG8_BAR;
            }
        }
        if constexpr (ALIGN_EPI) { if (wr == 0) PG8_BAR; }
        if constexpr (!Epi::AFTER_DRAIN) { E(acc, cur, wr, wc, fr, fq); S.done(cur); }
        if (!has_next) break;
#pragma unroll
        for (int a = 0; a < 2; ++a)
#pragma unroll
            for (int b = 0; b < 2; ++b)
#pragma unroll
                for (int m = 0; m < 4; ++m)
#pragma unroll
                    for (int n = 0; n < 2; ++n) acc[a][b][m][n] = (f32x4){0.f, 0.f, 0.f, 0.f};
        cur = nxt; cA = nA; cB = nB; ++ui;
        if constexpr (ALIGN_EPI) { if (wr == 1) PG8_BAR; }
    }
    PG8_WAIT_V(0);
    if constexpr (!ALIGN_EPI) { if (wr == 0) PG8_BAR; }
    PG8_BAR;
    if constexpr (Epi::AFTER_DRAIN) { E.fused(acc, cur, wr, wc, fr, fq, lds, wid, lane); S.done(cur); }
#undef PG8_SA
#undef PG8_SB
#undef PG8_STAGE
#undef PG8_LDA
#undef PG8_LDB
#undef PG8_MMA
#undef PG8_WAIT_V
#undef PG8_WAIT_L
#undef PG8_BAR
#undef PG8_SCHED
}
}

#define LAS __attribute__((address_space(3)))
typedef unsigned short bf16_t;
typedef short bf16x8 __attribute__((ext_vector_type(8)));
typedef short s16x4 __attribute__((ext_vector_type(4)));
typedef float f32x4 __attribute__((ext_vector_type(4)));
typedef float f32x16 __attribute__((ext_vector_type(16)));
typedef unsigned u32x4 __attribute__((ext_vector_type(4)));
typedef unsigned u32x2 __attribute__((ext_vector_type(2)));

constexpr int DM = 1024;
constexpr int NP = 16 * 2048;
constexpr int NS = 8 * 64;
constexpr int NT = NP + NS;
constexpr int DIN = 2560;
constexpr int SKV = 2112;
constexpr float EPS = 1e-6f;
constexpr float LOG2E = 1.4426950408889634f;
constexpr float QSCALE = 0.125f * LOG2E;

constexpr long OUT_Y = 0;
constexpr long OUT_KP = 34078720L, OUT_VP = 50855936L, OUT_CONVP = 67633152L, OUT_KS = 67878912L, OUT_VS = 68141056L, OUT_CONVS = 68403200L, OUT_TOTAL = 68526080L;

constexpr size_t MiB = 1u << 20;
constexpr size_t WS_CTL = 0, CTL_BYTES = 1 * MiB;
constexpr size_t WS_WINT = 1 * MiB;
constexpr size_t WS_WOUTT = 6 * MiB;
constexpr size_t WS_WQT = 8 * MiB;
constexpr size_t WS_SK = 12 * MiB;
constexpr size_t WS_PU = 16 * MiB;
constexpr size_t WS_PV = 48 * MiB;
constexpr size_t WS_KS = 80 * MiB;
constexpr size_t WS_VS = 97 * MiB;
constexpr size_t WS_H = 114 * MiB;
constexpr size_t WS_A = 179 * MiB;
constexpr size_t WS_Q = 212 * MiB;
constexpr size_t WS_QP = 114 * MiB;
constexpr size_t WS_KP = 245 * MiB;
constexpr size_t WS_VP = 277 * MiB;
constexpr size_t WS_MIX = 309 * MiB;
constexpr size_t WS_H2 = 309 * MiB;
constexpr size_t WS_TK = 375 * MiB;
constexpr size_t WS_IDX = 408 * MiB;
constexpr size_t WS_GATE = 425 * MiB;
constexpr size_t WS_END = 442 * MiB;
static_assert(WS_H + (size_t)NT * 1024 * 2 <= WS_A && WS_A + (size_t)NT * 512 * 2 <= WS_Q && WS_Q + (size_t)NT * 512 * 2 <= WS_KP, "R1");
static_assert(WS_QP + (size_t)NT * 2048 * 2 <= WS_KP && WS_KP + (size_t)NP * 512 * 2 <= WS_VP && WS_VP + (size_t)NP * 512 * 2 <= WS_MIX, "ws map");
static_assert(WS_MIX + (size_t)NT * 1024 * 2 <= WS_TK && WS_TK + (size_t)NT * 256 * 4 <= WS_IDX && WS_IDX + (size_t)NT * 128 * 4 <= WS_GATE && WS_GATE + (size_t)NT * 128 * 4 <= WS_END, "ws map 2");
static_assert(WS_KS + (size_t)8 * SKV * 512 * 2 <= WS_VS && WS_VS + (size_t)8 * SKV * 512 * 2 <= WS_H, "ws map 3");

constexpr int RING_BYTES = 131072;
constexpr int MISC_OFF = RING_BYTES;
constexpr int LDS_BYTES = RING_BYTES + 1024;

struct Params {
    const float* in[24];
    float* out;
    unsigned char* ws;
};

__device__ __forceinline__ unsigned cvtpk(float lo, float hi) { return pg8::cvt_pk_bf16(lo, hi); }
__device__ __forceinline__ float bflo(unsigned w) { return __uint_as_float(w << 16); }
__device__ __forceinline__ float bfhi(unsigned w) { return __uint_as_float(w & 0xffff0000u); }
__device__ __forceinline__ float wave_sum(float v) {
#pragma unroll
    for (int o = 1; o < 64; o <<= 1) v += __shfl_xor(v, o);
    return v;
}
typedef __bf16 bf16x2_t __attribute__((ext_vector_type(2)));
__device__ __forceinline__ float dot2(unsigned a, unsigned b, float acc) {
    return __builtin_amdgcn_fdot2_f32_bf16(__builtin_bit_cast(bf16x2_t, a), __builtin_bit_cast(bf16x2_t, b), acc, false);
}
#define LDS_WAIT() asm volatile("s_waitcnt lgkmcnt(0)" ::: "memory")

namespace pg8 {
__device__ __forceinline__ u32x2 pack4(f32x4 v) { u32x2 w; w.x = cvt_pk_bf16(v[0], v[1]); w.y = cvt_pk_bf16(v[2], v[3]); return w; }
struct EpiProj {
    static constexpr bool PERM = false, AFTER_DRAIN = false;
    bf16_t* A; bf16_t* Q; bf16_t* KP; bf16_t* VP; bf16_t* KS; bf16_t* VS; float* out;
    __device__ __forceinline__ void operator()(const f32x4 (&acc)[2][2][4][2], const Unit& u, int wr, int wc, int fr, int fq) const {
        const int pn = u.pn;
        const int row0 = u.pm * BM + wr * 64 + fr;
        if (pn < 4) {
#pragma unroll
            for (int ai = 0; ai < 2; ++ai)
#pragma unroll
                for (int m = 0; m < 4; ++m) {
                    const int row = row0 + ai * HALF + m * 16;
                    long toff = -1;
                    if (row < NP) { const int s = row & 2047; if (s >= 2018) toff = OUT_CONVP + ((long)(row >> 11) * 30 + (s - 2018)) * 512; }
                    else { const int rr = row - NP; const int i = rr & 63; if (i >= 34) toff = OUT_CONVS + ((long)(rr >> 6) * 30 + (i - 34)) * 512; }
#pragma unroll
                    for (int n = 0; n < 2; ++n) {
                        const int c = 128 * pn + 32 * wc + 16 * n + 4 * fq;
                        const f32x4 x = acc[ai][0][m][n], g = acc[ai][1][m][n];
                        f32x4 a;
#pragma unroll
                        for (int j = 0; j < 4; ++j) a[j] = x[j] / (1.f + __expf(-g[j]));
                        *(u32x2*)(A + (size_t)row * 512 + c) = pack4(a);
                        if (toff >= 0) *(f32x4*)(out + toff + c) = a;
                    }
                }
        } else {
            const int sec = (pn - 4) >> 1, colbase = ((pn - 4) & 1) * 256;
#pragma unroll
            for (int ai = 0; ai < 2; ++ai)
#pragma unroll
                for (int m = 0; m < 4; ++m) {
                    const int row = row0 + ai * HALF + m * 16;
                    const bool isp = row < NP; const int rr = row - NP;
                    bf16_t* bdst; float* fdst;
                    if (sec == 0) { bdst = Q + (size_t)row * 512; fdst = nullptr; }
                    else if (sec == 1) { bdst = isp ? KP + (size_t)row * 512 : KS + ((size_t)(rr >> 6) * SKV + 2048 + (rr & 63)) * 512; fdst = isp ? out + OUT_KP + (size_t)row * 512 : out + OUT_KS + (size_t)rr * 512; }
                    else { bdst = isp ? VP + (size_t)row * 512 : VS + ((size_t)(rr >> 6) * SKV + 2048 + (rr & 63)) * 512; fdst = isp ? out + OUT_VP + (size_t)row * 512 : out + OUT_VS + (size_t)rr * 512; }
#pragma unroll
                    for (int bj = 0; bj < 2; ++bj)
#pragma unroll
                        for (int n = 0; n < 2; ++n) {
                            const int col = colbase + 128 * bj + 32 * wc + 16 * n + 4 * fq;
                            const f32x4 v = acc[ai][bj][m][n];
                            if (sec == 0) { *(u32x2*)(bdst + col) = pack4(v * QSCALE); }
                            else { *(u32x2*)(bdst + col) = pack4(v); *(f32x4*)(fdst + col) = v; }
                        }
                }
        }
    }
};
struct EpiRes {
    static constexpr bool PERM = false, AFTER_DRAIN = false;
    const float* xp; const float* xs; float* out;
    __device__ __forceinline__ void operator()(const f32x4 (&acc)[2][2][4][2], const Unit& u, int wr, int wc, int fr, int fq) const {
        const int row0 = u.pm * BM + wr * 64 + fr;
#pragma unroll
        for (int ai = 0; ai < 2; ++ai)
#pragma unroll
            for (int m = 0; m < 4; ++m) {
                const int row = row0 + ai * HALF + m * 16;
                const float* xr = row < NP ? xp + (size_t)row * DM : xs + (size_t)(row - NP) * DM;
                float* orow = out + (size_t)row * DM;
#pragma unroll
                for (int bj = 0; bj < 2; ++bj)
#pragma unroll
                    for (int n = 0; n < 2; ++n) {
                        const int col = u.pn * BM + 128 * bj + 32 * wc + 16 * n + 4 * fq;
                        *(f32x4*)(orow + col) = *(const f32x4*)(xr + col) + acc[ai][bj][m][n];
                    }
            }
    }
};
}

__device__ __forceinline__ int winrow(int n) { return n < 1024 ? (256 * ((n & 511) >> 7) + 128 * (n >> 9) + (n & 127)) : n; }
template <bool WIN> __device__ __forceinline__ void transpose_item(const float* W, int K, int N, bf16_t* WT, LAS float* scr, int item, int lane) {
    const int nblk = N / 32, kb = item / nblk, nb = item % nblk, k0 = 64 * kb, n0 = 32 * nb;
#pragma unroll 8
    for (int i = 0; i < 32; ++i) { const int kk = 2 * i + (lane >> 5); scr[kk * 33 + (lane & 31)] = W[(size_t)(k0 + kk) * N + n0 + (lane & 31)]; }
    LDS_WAIT();
    const int c = lane & 7;
#pragma unroll
    for (int j = 0; j < 4; ++j) {
        const int n = (lane >> 3) + 8 * j; const LAS float* s = scr + (8 * c) * 33 + n;
        u32x4 o; o.x = cvtpk(s[0 * 33], s[1 * 33]); o.y = cvtpk(s[2 * 33], s[3 * 33]); o.z = cvtpk(s[4 * 33], s[5 * 33]); o.w = cvtpk(s[6 * 33], s[7 * 33]);
        const int dr = WIN ? winrow(n0 + n) : (n0 + n);
        *(u32x4*)(WT + (size_t)dr * K + k0 + 8 * c) = o;
    }
    LDS_WAIT();
}
__device__ __forceinline__ void cvt_stream(const float* src, bf16_t* dst, size_t n8, size_t gt, size_t ngt) {
    for (size_t i = gt; i < n8; i += ngt) {
        const f32x4 a = *(const f32x4*)(src + i * 8), b = *(const f32x4*)(src + i * 8 + 4);
        u32x4 o; o.x = cvtpk(a[0], a[1]); o.y = cvtpk(a[2], a[3]); o.z = cvtpk(b[0], b[1]); o.w = cvtpk(b[2], b[3]);
        *(u32x4*)(dst + i * 8) = o;
    }
}
__device__ __forceinline__ void cvt_cache(const float* src, bf16_t* dst, size_t gt, size_t ngt) {
    const size_t n8 = (size_t)8 * 2048 * 512 / 8;
    for (size_t i = gt; i < n8; i += ngt) {
        const size_t e = i * 8; const size_t row = e >> 9, col = e & 511; const size_t drow = (row >> 11) * SKV + (row & 2047);
        const f32x4 a = *(const f32x4*)(src + e), b = *(const f32x4*)(src + e + 4);
        u32x4 o; o.x = cvtpk(a[0], a[1]); o.y = cvtpk(a[2], a[3]); o.z = cvtpk(b[0], b[1]); o.w = cvtpk(b[2], b[3]);
        *(u32x4*)(dst + drow * 512 + col) = o;
    }
}
__device__ __forceinline__ void rms_row_bf16(const float* xrow, const float* g, bf16_t* orow, int lane) {
    const f32x4* xr = (const f32x4*)xrow + lane; const f32x4* gr = (const f32x4*)g + lane;
    f32x4 v[4]; float s = 0.f;
#pragma unroll
    for (int j = 0; j < 4; ++j) { v[j] = xr[64 * j]; s += (v[j][0] * v[j][0] + v[j][1] * v[j][1]) + (v[j][2] * v[j][2] + v[j][3] * v[j][3]); }
    const float rstd = 1.f / sqrtf(wave_sum(s) * (1.f / DM) + EPS);
    u32x2* o8 = (u32x2*)orow + lane;
#pragma unroll
    for (int j = 0; j < 4; ++j) { const f32x4 gg = gr[64 * j]; u32x2 w; w.x = cvtpk(v[j][0] * rstd * gg[0], v[j][1] * rstd * gg[1]); w.y = cvtpk(v[j][2] * rstd * gg[2], v[j][3] * rstd * gg[3]); o8[64 * j] = w; }
}

__device__ __forceinline__ void phase0(const Params& p, LAS unsigned char* lds, int tid, int lane, int wave) {
    const int gw = blockIdx.x * 8 + wave, NGW = gridDim.x * 8;
    LAS float* scr = (LAS float*)(lds + wave * 16384);
    bf16_t* WINT = (bf16_t*)(p.ws + WS_WINT); bf16_t* WOUTT = (bf16_t*)(p.ws + WS_WOUTT); bf16_t* WQT = (bf16_t*)(p.ws + WS_WQT);
    constexpr int I_IN = 16 * (DIN / 32), I_OUT = 16 * (1024 / 32), I_Q = 16 * (2048 / 32);
    for (int it = gw; it < I_IN + I_OUT + I_Q; it += NGW) {
        int r = it;
        if (r < I_IN) { transpose_item<true>(p.in[6], 1024, DIN, WINT, scr, r, lane); continue; } r -= I_IN;
        if (r < I_OUT) { transpose_item<false>(p.in[17], 1024, 1024, WOUTT, scr, r, lane); continue; } r -= I_OUT;
        transpose_item<false>(p.in[19], 1024, 2048, WQT, scr, r, lane);
    }
    const size_t gt = (size_t)blockIdx.x * 512 + tid, ngt = (size_t)gridDim.x * 512;
    cvt_stream(p.in[21], (bf16_t*)(p.ws + WS_PU), (size_t)16384 * 1024 / 8, gt, ngt);
    cvt_stream(p.in[22], (bf16_t*)(p.ws + WS_PV), (size_t)16384 * 1024 / 8, gt, ngt);
    cvt_stream(p.in[20], (bf16_t*)(p.ws + WS_SK), (size_t)16 * 128 * 128 / 8, gt, ngt);
    cvt_cache(p.in[2], (bf16_t*)(p.ws + WS_KS), gt, ngt);
    cvt_cache(p.in[3], (bf16_t*)(p.ws + WS_VS), gt, ngt);
    bf16_t* H = (bf16_t*)(p.ws + WS_H);
    for (int m = gw; m < NT; m += NGW) {
        const float* xr = m < NP ? p.in[0] + (size_t)m * DM : p.in[1] + (size_t)(m - NP) * DM;
        rms_row_bf16(xr, p.in[5], H + (size_t)m * DM, lane);
    }
}

namespace att {
constexpr int KPITCH = 272, VPITCH = 320;
constexpr int L_K = 0, L_V = 17408, L_BIAS = 37888, L_X = 43008, L_END = 108544;
static_assert(L_V == 64 * KPITCH && L_BIAS == L_V + 64 * VPITCH && L_X == L_BIAS + 4 * 320 * 4 && L_END == L_X + 4 * 4096 * 4 && L_END <= RING_BYTES, "attention LDS map");

__device__ __forceinline__ int rel_bucket(int rel) {
    const int ret = rel > 0 ? 16 : 0; const int n = rel < 0 ? -rel : rel; int v;
    if (n < 8) v = n; else if (n < 12) v = 8; else if (n < 16) v = 9; else if (n < 23) v = 10; else if (n < 32) v = 11;
    else if (n < 46) v = 12; else if (n < 64) v = 13; else if (n < 91) v = 14; else v = 15;
    return ret + v;
}
typedef short v4i16_t __attribute__((ext_vector_type(4)));
__device__ __forceinline__ s16x4 vtr(const LAS unsigned char* p) { return __builtin_bit_cast(s16x4, __builtin_amdgcn_ds_read_tr16_b64_v4i16((LAS v4i16_t*)p)); }
__device__ __forceinline__ f32x16 mfma32(bf16x8 a, bf16x8 b, f32x16 c) { return __builtin_amdgcn_mfma_f32_32x32x16_bf16(a, b, c, 0, 0, 0); }

__device__ __forceinline__ void attn_unit(const Params& p, LAS unsigned char* lds, int kind, int bb, int h, int qblk, float lam, int tid, int lane, int wid) {
    const bf16_t* Q = (const bf16_t*)(p.ws + WS_Q);
    const bf16_t* Kb = kind == 0 ? (const bf16_t*)(p.ws + WS_KP) + (size_t)bb * 2048 * 512 + h * 128 : (const bf16_t*)(p.ws + WS_KS) + (size_t)bb * SKV * 512 + h * 128;
    const bf16_t* Vb = kind == 0 ? (const bf16_t*)(p.ws + WS_VP) + (size_t)bb * 2048 * 512 + h * 128 : (const bf16_t*)(p.ws + WS_VS) + (size_t)bb * SKV * 512 + h * 128;
    bf16_t* MIX = (bf16_t*)(p.ws + WS_MIX);
    const int qrow0 = kind == 0 ? bb * 2048 + qblk * 128 : NP + bb * 64;
    const int qpos0 = kind == 0 ? qblk * 128 : 2048;
    const int ntiles = kind == 0 ? 2 * qblk + 2 : 33;
    const int rg = wid & 3, map = wid >> 2, r32 = lane & 31, hi = lane >> 5;
    const bool active = kind == 0 ? true : (rg < 2);
    const int cw = kind == 0 ? 2 * qblk + (rg >> 1) : 32;
    const int qw0 = qpos0 + 32 * rg;
    const int qabs = qw0 + r32;

    bf16x8 qf[4];
    if (active) {
        const bf16_t* qp = Q + (size_t)(qrow0 + 32 * rg + r32) * 512 + h * 128 + map * 64 + 8 * hi;
#pragma unroll
        for (int s = 0; s < 4; ++s) qf[s] = *(const bf16x8*)(qp + 16 * s);
    } else {
#pragma unroll
        for (int s = 0; s < 4; ++s) qf[s] = (bf16x8){0, 0, 0, 0, 0, 0, 0, 0};
    }
    float m = -1e30f, l = 0.f;
    f32x16 o[4];
#pragma unroll
    for (int mt = 0; mt < 4; ++mt)
#pragma unroll
        for (int r = 0; r < 16; ++r) o[mt][r] = 0.f;

    const int srow0 = tid >> 4, sch = tid & 15;
    u32x4 kreg[2], vreg[2];
#pragma unroll
    for (int i = 0; i < 2; ++i) { const size_t off = (size_t)(srow0 + 32 * i) * 512 + sch * 8; kreg[i] = *(const u32x4*)(Kb + off); vreg[i] = *(const u32x4*)(Vb + off); }
    const LAS float* btab = (const LAS float*)(lds + L_BIAS) + h * 320;
    const float biasfar = btab[0];
    const int vlane = (4 * hi + ((lane & 15) >> 2)) * VPITCH + (16 * ((lane >> 4) & 1) + 4 * (lane & 3)) * 2;

    for (int t = 0; t < ntiles; ++t) {
#pragma unroll
        for (int i = 0; i < 2; ++i) {
            *(LAS u32x4*)(lds + L_K + (srow0 + 32 * i) * KPITCH + sch * 16) = kreg[i];
            *(LAS u32x4*)(lds + L_V + (srow0 + 32 * i) * VPITCH + sch * 16) = vreg[i];
        }
        __syncthreads();
        if (t + 1 < ntiles) {
#pragma unroll
            for (int i = 0; i < 2; ++i) { const size_t off = (size_t)((t + 1) * 64 + srow0 + 32 * i) * 512 + sch * 8; kreg[i] = *(const u32x4*)(Kb + off); vreg[i] = *(const u32x4*)(Vb + off); }
        }
        if (active && t <= cw) {
            f32x16 p0, p1;
            const int kabs0 = t * 64;
            if (kabs0 + 63 - qw0 > -128) {
                const LAS float* bt = btab + (kabs0 - qabs + 256 + 4 * hi);
#pragma unroll
                for (int r = 0; r < 16; ++r) { p0[r] = bt[(r & 3) + 8 * (r >> 2)]; p1[r] = bt[32 + (r & 3) + 8 * (r >> 2)]; }
            } else {
#pragma unroll
                for (int r = 0; r < 16; ++r) { p0[r] = biasfar; p1[r] = biasfar; }
            }
            const LAS unsigned char* kb = lds + L_K + r32 * KPITCH + (map * 8 + hi) * 16;
#pragma unroll
            for (int s = 0; s < 4; ++s) {
                const bf16x8 a0 = *(const LAS bf16x8*)(kb + s * 32), a1 = *(const LAS bf16x8*)(kb + 32 * KPITCH + s * 32);
                p0 = mfma32(a0, qf[s], p0); p1 = mfma32(a1, qf[s], p1);
            }
            float mx = fmaxf(p0[0], p1[0]);
#pragma unroll
            for (int r = 1; r < 16; ++r) mx = fmaxf(mx, fmaxf(p0[r], p1[r]));
            mx = fmaxf(mx, __shfl_xor(mx, 32));
            const float mn = fmaxf(m, mx);
            const float alpha = __builtin_amdgcn_exp2f(m - mn);
            m = mn;
            float rs = 0.f;
#pragma unroll
            for (int r = 0; r < 16; ++r) { p0[r] = __builtin_amdgcn_exp2f(p0[r] - mn); p1[r] = __builtin_amdgcn_exp2f(p1[r] - mn); rs += p0[r] + p1[r]; }
            l = l * alpha + rs;
#pragma unroll
            for (int mt = 0; mt < 4; ++mt)
#pragma unroll
                for (int r = 0; r < 16; ++r) o[mt][r] *= alpha;
#pragma unroll
            for (int t2 = 0; t2 < 2; ++t2)
#pragma unroll
                for (int s = 0; s < 2; ++s) {
                    u32x4 bw;
                    if (t2 == 0) { bw.x = cvtpk(p0[8 * s + 0], p0[8 * s + 1]); bw.y = cvtpk(p0[8 * s + 2], p0[8 * s + 3]); bw.z = cvtpk(p0[8 * s + 4], p0[8 * s + 5]); bw.w = cvtpk(p0[8 * s + 6], p0[8 * s + 7]); }
                    else { bw.x = cvtpk(p1[8 * s + 0], p1[8 * s + 1]); bw.y = cvtpk(p1[8 * s + 2], p1[8 * s + 3]); bw.z = cvtpk(p1[8 * s + 4], p1[8 * s + 5]); bw.w = cvtpk(p1[8 * s + 6], p1[8 * s + 7]); }
                    const bf16x8 B = __builtin_bit_cast(bf16x8, bw);
                    const LAS unsigned char* vb = lds + L_V + vlane + (32 * t2 + 16 * s) * VPITCH;
#pragma unroll
                    for (int mt = 0; mt < 4; ++mt) {
                        const s16x4 lo = vtr(vb + mt * 64), hi8 = vtr(vb + mt * 64 + 8 * VPITCH);
                        const bf16x8 A = (bf16x8){lo[0], lo[1], lo[2], lo[3], hi8[0], hi8[1], hi8[2], hi8[3]};
                        o[mt] = mfma32(A, B, o[mt]);
                    }
                }
        }
        __syncthreads();
    }
    l += __shfl_xor(l, 32);
    const float inv = 1.f / l;
    LAS float* X = (LAS float*)(lds + L_X) + rg * 4096;
    if (active && map == 1) {
        const float sc = -lam * inv;
#pragma unroll
        for (int mt = 0; mt < 4; ++mt)
#pragma unroll
            for (int r = 0; r < 16; ++r) X[(mt * 16 + r) * 64 + lane] = o[mt][r] * sc;
    }
    __syncthreads();
    if (active && map == 0) {
        float ss = 0.f;
#pragma unroll
        for (int mt = 0; mt < 4; ++mt)
#pragma unroll
            for (int r = 0; r < 16; ++r) { const float v = o[mt][r] * inv + X[(mt * 16 + r) * 64 + lane]; o[mt][r] = v; ss += v * v; }
        ss += __shfl_xor(ss, 32);
        const float rsn = 0.8f / sqrtf(ss * (1.f / 128.f) + EPS);
        bf16_t* orow = MIX + (size_t)(qrow0 + 32 * rg + r32) * 1024 + 512 + h * 128;
        const float* sg = p.in[15];
#pragma unroll
        for (int mt = 0; mt < 4; ++mt)
#pragma unroll
            for (int g4 = 0; g4 < 4; ++g4) {
                const int e = 32 * mt + 8 * g4 + 4 * hi;
                const f32x4 gg = *(const f32x4*)(sg + e);
                u32x2 w; w.x = cvtpk(o[mt][4 * g4 + 0] * rsn * gg[0], o[mt][4 * g4 + 1] * rsn * gg[1]); w.y = cvtpk(o[mt][4 * g4 + 2] * rsn * gg[2], o[mt][4 * g4 + 3] * rsn * gg[3]);
                *(u32x2*)(orow + e) = w;
            }
    }
    __syncthreads();
}

__device__ __forceinline__ void conv_unit(const Params& p, int cu, int lane, int wid) {
    const bf16_t* A = (const bf16_t*)(p.ws + WS_A);
    bf16_t* MIX = (bf16_t*)(p.ws + WS_MIX);
    const float* cw = p.in[7]; const float* cb = p.in[8]; const float* lg = p.in[9]; const float* lb = p.in[10]; const float* st = p.in[4];
    const int c0 = lane * 8;
    for (int i = 0; i < 8; ++i) {
        const int row = cu * 64 + wid * 8 + i;
        const bool isp = row < NP;
        const int s = isp ? (row & 2047) : ((row - NP) & 63);
        const int rbase = row - s;
        const int bd = isp ? 0 : ((row - NP) >> 6);
        float acc[8];
        { const f32x4 b0 = *(const f32x4*)(cb + c0), b1 = *(const f32x4*)(cb + c0 + 4);
#pragma unroll
          for (int j = 0; j < 4; ++j) { acc[j] = b0[j]; acc[4 + j] = b1[j]; } }
        for (int j = 0; j < 31; ++j) {
            const int sp = s - 30 + j;
            float x[8];
            if (sp >= 0) {
                const u32x4 w = *(const u32x4*)(A + (size_t)(rbase + sp) * 512 + c0);
                x[0] = bflo(w.x); x[1] = bfhi(w.x); x[2] = bflo(w.y); x[3] = bfhi(w.y); x[4] = bflo(w.z); x[5] = bfhi(w.z); x[6] = bflo(w.w); x[7] = bfhi(w.w);
            } else if (!isp) {
                const float* sr = st + ((size_t)bd * 30 + (30 + sp)) * 512 + c0;
                const f32x4 a0 = *(const f32x4*)sr, a1 = *(const f32x4*)(sr + 4);
#pragma unroll
                for (int q = 0; q < 4; ++q) { x[q] = a0[q]; x[4 + q] = a1[q]; }
            } else continue;
            const f32x4 w0 = *(const f32x4*)(cw + (size_t)j * 512 + c0), w1 = *(const f32x4*)(cw + (size_t)j * 512 + c0 + 4);
#pragma unroll
            for (int q = 0; q < 4; ++q) { acc[q] += w0[q] * x[q]; acc[4 + q] += w1[q] * x[4 + q]; }
        }
        float sm = 0.f;
#pragma unroll
        for (int q = 0; q < 8; ++q) sm += acc[q];
        const float mu = wave_sum(sm) * (1.f / 512.f);
        float sv = 0.f;
#pragma unroll
        for (int q = 0; q < 8; ++q) { acc[q] -= mu; sv += acc[q] * acc[q]; }
        const float rstd = 1.f / sqrtf(wave_sum(sv) * (1.f / 512.f) + EPS);
        const f32x4 g0 = *(const f32x4*)(lg + c0), g1 = *(const f32x4*)(lg + c0 + 4), b0 = *(const f32x4*)(lb + c0), b1 = *(const f32x4*)(lb + c0 + 4);
        float y[8];
#pragma unroll
        for (int q = 0; q < 4; ++q) { y[q] = acc[q] * rstd * g0[q] + b0[q]; y[4 + q] = acc[4 + q] * rstd * g1[q] + b1[q]; }
#pragma unroll
        for (int q = 0; q < 8; ++q) y[q] = y[q] / (1.f + __expf(-y[q]));
        u32x4 w; w.x = cvtpk(y[0], y[1]); w.y = cvtpk(y[2], y[3]); w.z = cvtpk(y[4], y[5]); w.w = cvtpk(y[6], y[7]);
        *(u32x4*)(MIX + (size_t)row * 1024 + c0) = w;
    }
}

constexpr int N_SAMPLE_UNITS = 32, N_PROMPT_UNITS = 1024, N_CONV_UNITS = NT / 64, N_UNITS = N_SAMPLE_UNITS + N_PROMPT_UNITS + N_CONV_UNITS;

__device__ __forceinline__ void phase2(const Params& p, LAS unsigned char* lds, int tid, int lane, int wid) {
    LAS float* bt = (LAS float*)(lds + L_BIAS);
    for (int e = tid; e < 4 * 320; e += 512) { const int hh = e / 320, rel = (e % 320) - 256; bt[e] = p.in[16][rel_bucket(rel) * 4 + hh] * LOG2E; }
    const float d1 = wave_sum(p.in[11][lane] * p.in[12][lane]), d2 = wave_sum(p.in[13][lane] * p.in[14][lane]);
    const float lam = expf(d1) - expf(d2) + 0.2f;
    unsigned* ctr = (unsigned*)(p.ws + WS_CTL);
    volatile LAS unsigned* sw = (volatile LAS unsigned*)(lds + MISC_OFF);
    __syncthreads();
    for (;;) {
        __syncthreads();
        if (tid == 0) sw[0] = atomicAdd(ctr, 1u);
        __syncthreads();
        const int u = (int)sw[0];
        if (u >= N_UNITS) break;
        if (u < N_SAMPLE_UNITS) attn_unit(p, lds, 1, u >> 2, u & 3, 0, lam, tid, lane, wid);
        else if (u < N_SAMPLE_UNITS + N_PROMPT_UNITS) { const int v = u - N_SAMPLE_UNITS; const int bh = v & 63; attn_unit(p, lds, 0, bh >> 2, bh & 3, 15 - (v >> 6), lam, tid, lane, wid); }
        else conv_unit(p, u - N_SAMPLE_UNITS - N_PROMPT_UNITS, lane, wid);
    }
}
}

__device__ __forceinline__ void phase3b(const Params& p, int lane, int wave) {
    const int gw = blockIdx.x * 8 + wave, NGW = gridDim.x * 8;
    bf16_t* H2 = (bf16_t*)(p.ws + WS_H2);
    for (int m = gw; m < NT; m += NGW) rms_row_bf16(p.out + (size_t)m * DM, p.in[18], H2 + (size_t)m * DM, lane);
}

__device__ __forceinline__ void phase4b(const Params& p, int lane, int wave) {
    const int gw = blockIdx.x * 8 + wave, NGW = gridDim.x * 8;
    const bf16_t* QP = (const bf16_t*)(p.ws + WS_QP); const bf16_t* SK = (const bf16_t*)(p.ws + WS_SK);
    float* TK = (float*)(p.ws + WS_TK);
    const int r32 = lane & 31, hi = lane >> 5;
    const float NEG_INF = -__builtin_huge_valf();
    for (int wu = gw; wu < (NT / 32) * 16; wu += NGW) {
        const int rp = wu & 15, t0 = (wu >> 4) * 32;
        bf16x8 qf[8];
        const bf16_t* qp = QP + (size_t)(t0 + r32) * 2048 + rp * 128 + 8 * hi;
#pragma unroll
        for (int s = 0; s < 8; ++s) qf[s] = *(const bf16x8*)(qp + 16 * s);
        float v[64];
#pragma unroll
        for (int mt = 0; mt < 4; ++mt) {
            f32x16 S;
#pragma unroll
            for (int r = 0; r < 16; ++r) S[r] = 0.f;
            const bf16_t* kp = SK + ((size_t)rp * 128 + 32 * mt + r32) * 128 + 8 * hi;
#pragma unroll
            for (int s = 0; s < 8; ++s) S = att::mfma32(*(const bf16x8*)(kp + 16 * s), qf[s], S);
#pragma unroll
            for (int r = 0; r < 16; ++r) { const int n = 32 * mt + (r & 3) + 8 * (r >> 2) + 4 * hi; v[mt * 16 + r] = __uint_as_float((__float_as_uint(S[r]) & ~127u) | (unsigned)(127 - n)); }
        }
        float* dst = TK + ((size_t)(t0 + r32) * 16 + rp) * 16;
        for (int it = 0; it < 16; ++it) {
            float mx = v[0];
#pragma unroll
            for (int i = 1; i < 64; ++i) mx = fmaxf(mx, v[i]);
            mx = fmaxf(mx, __shfl_xor(mx, 32));
            if (hi == 0) dst[it] = mx;
#pragma unroll
            for (int i = 0; i < 64; ++i) v[i] = (v[i] == mx) ? NEG_INF : v[i];
        }
    }
}

__device__ __forceinline__ void phase5a(const Params& p, int tid) {
    const float* TK = (const float*)(p.ws + WS_TK);
    int* IDX = (int*)(p.ws + WS_IDX); float* GATE = (float*)(p.ws + WS_GATE);
    const float NEG_INF = -__builtin_huge_valf();
    for (int item = blockIdx.x * 512 + tid; item < NT * 8; item += gridDim.x * 512) {
        const int tok = item >> 3, r = item & 7;
        const f32x4* pa = (const f32x4*)(TK + ((size_t)tok * 16 + 2 * r) * 16);
        float a[16], b[16]; int ia[16], ib[16];
#pragma unroll
        for (int q = 0; q < 4; ++q) { const f32x4 x = pa[q], y = pa[4 + q];
#pragma unroll
            for (int j = 0; j < 4; ++j) { a[4 * q + j] = x[j]; b[4 * q + j] = y[j]; } }
#pragma unroll
        for (int i = 0; i < 16; ++i) { const unsigned ua = __float_as_uint(a[i]), ub = __float_as_uint(b[i]); ia[i] = 127 - (int)(ua & 127u); ib[i] = 127 - (int)(ub & 127u); a[i] = __uint_as_float(ua & ~127u); b[i] = __uint_as_float(ub & ~127u); }
        float cv[50]; int cid[50];
        {
            int c = 0;
#pragma unroll
            for (int i = 0; i < 16; ++i)
#pragma unroll
                for (int j = 0; j < 16; ++j)
                    if ((i + 1) * (j + 1) <= 16) { const float s = a[i] + b[j]; cv[c] = __uint_as_float((__float_as_uint(s) & ~63u) | (unsigned)(63 - c)); cid[c] = ia[i] * 128 + ib[j]; ++c; }
        }
        float best[16]; int bid[16];
#pragma unroll
        for (int it = 0; it < 16; ++it) {
            float mx = cv[0];
#pragma unroll
            for (int c = 1; c < 50; ++c) mx = fmaxf(mx, cv[c]);
            int id = 0;
#pragma unroll
            for (int c = 0; c < 50; ++c) { const bool hit = cv[c] == mx; id = hit ? cid[c] : id; cv[c] = hit ? NEG_INF : cv[c]; }
            best[it] = __uint_as_float(__float_as_uint(mx) & ~63u); bid[it] = id;
        }
        float e[16], sum = 0.f;
#pragma unroll
        for (int k = 0; k < 16; ++k) { e[k] = __expf(best[k] - best[0]); sum += e[k]; }
        const float rinv = 1.f / sum;
        int* io = IDX + (size_t)tok * 128 + r * 16; float* go = GATE + (size_t)tok * 128 + r * 16;
#pragma unroll
        for (int k = 0; k < 16; ++k) { io[k] = bid[k]; go[k] = e[k] * rinv; }
    }
}

__device__ __forceinline__ float gelu_erf(float x) { return 0.5f * x * (1.f + erff(x * 0.70710678118654752f)); }
__device__ __forceinline__ void phase5b(const Params& p, int lane, int wave) {
    const int gw = blockIdx.x * 8 + wave, NGW = gridDim.x * 8;
    const bf16_t* H2 = (const bf16_t*)(p.ws + WS_H2); const bf16_t* PU = (const bf16_t*)(p.ws + WS_PU); const bf16_t* PV = (const bf16_t*)(p.ws + WS_PV);
    const int* IDX = (const int*)(p.ws + WS_IDX); const float* GATE = (const float*)(p.ws + WS_GATE);
    const float* gf = p.in[23];
    for (int tok = gw; tok < NT; tok += NGW) {
        const int idxA = IDX[(size_t)tok * 128 + lane], idxB = IDX[(size_t)tok * 128 + 64 + lane];
        const float gA = GATE[(size_t)tok * 128 + lane], gB = GATE[(size_t)tok * 128 + 64 + lane];
        const u32x4 hA = *(const u32x4*)(H2 + (size_t)tok * DM + lane * 8), hB = *(const u32x4*)(H2 + (size_t)tok * DM + 512 + lane * 8);
        float actA = 0.f, actB = 0.f;
#pragma unroll 4
        for (int k = 0; k < 64; ++k) {
            const int e = __builtin_amdgcn_readlane(idxA, k);
            const bf16_t* ur = PU + (size_t)e * DM;
            const u32x4 a = *(const u32x4*)(ur + lane * 8), b = *(const u32x4*)(ur + 512 + lane * 8);
            float s = dot2(a.x, hA.x, 0.f); s = dot2(a.y, hA.y, s); s = dot2(a.z, hA.z, s); s = dot2(a.w, hA.w, s);
            s = dot2(b.x, hB.x, s); s = dot2(b.y, hB.y, s); s = dot2(b.z, hB.z, s); s = dot2(b.w, hB.w, s);
            s = wave_sum(s);
            actA = (lane == k) ? s : actA;
        }
#pragma unroll 4
        for (int k = 0; k < 64; ++k) {
            const int e = __builtin_amdgcn_readlane(idxB, k);
            const bf16_t* ur = PU + (size_t)e * DM;
            const u32x4 a = *(const u32x4*)(ur + lane * 8), b = *(const u32x4*)(ur + 512 + lane * 8);
            float s = dot2(a.x, hA.x, 0.f); s = dot2(a.y, hA.y, s); s = dot2(a.z, hA.z, s); s = dot2(a.w, hA.w, s);
            s = dot2(b.x, hB.x, s); s = dot2(b.y, hB.y, s); s = dot2(b.z, hB.z, s); s = dot2(b.w, hB.w, s);
            s = wave_sum(s);
            actB = (lane == k) ? s : actB;
        }
        const float cA = gA * gelu_erf(actA), cB = gB * gelu_erf(actB);
        float acc[16];
#pragma unroll
        for (int j = 0; j < 16; ++j) acc[j] = 0.f;
#pragma unroll 4
        for (int k = 0; k < 64; ++k) {
            const int e = __builtin_amdgcn_readlane(idxA, k);
            const float c = __uint_as_float(__builtin_amdgcn_readlane(__float_as_uint(cA), k));
            const bf16_t* vr = PV + (size_t)e * DM;
            const u32x4 a = *(const u32x4*)(vr + lane * 8), b = *(const u32x4*)(vr + 512 + lane * 8);
            acc[0] += c * bflo(a.x); acc[1] += c * bfhi(a.x); acc[2] += c * bflo(a.y); acc[3] += c * bfhi(a.y); acc[4] += c * bflo(a.z); acc[5] += c * bfhi(a.z); acc[6] += c * bflo(a.w); acc[7] += c * bfhi(a.w);
            acc[8] += c * bflo(b.x); acc[9] += c * bfhi(b.x); acc[10] += c * bflo(b.y); acc[11] += c * bfhi(b.y); acc[12] += c * bflo(b.z); acc[13] += c * bfhi(b.z); acc[14] += c * bflo(b.w); acc[15] += c * bfhi(b.w);
        }
#pragma unroll 4
        for (int k = 0; k < 64; ++k) {
            const int e = __builtin_amdgcn_readlane(idxB, k);
            const float c = __uint_as_float(__builtin_amdgcn_readlane(__float_as_uint(cB), k));
            const bf16_t* vr = PV + (size_t)e * DM;
            const u32x4 a = *(const u32x4*)(vr + lane * 8), b = *(const u32x4*)(vr + 512 + lane * 8);
            acc[0] += c * bflo(a.x); acc[1] += c * bfhi(a.x); acc[2] += c * bflo(a.y); acc[3] += c * bfhi(a.y); acc[4] += c * bflo(a.z); acc[5] += c * bfhi(a.z); acc[6] += c * bflo(a.w); acc[7] += c * bfhi(a.w);
            acc[8] += c * bflo(b.x); acc[9] += c * bfhi(b.x); acc[10] += c * bflo(b.y); acc[11] += c * bfhi(b.y); acc[12] += c * bflo(b.z); acc[13] += c * bfhi(b.z); acc[14] += c * bflo(b.w); acc[15] += c * bfhi(b.w);
        }
        float* xr = p.out + (size_t)tok * DM;
        f32x4 x[4];
        x[0] = *(const f32x4*)(xr + lane * 8); x[1] = *(const f32x4*)(xr + lane * 8 + 4); x[2] = *(const f32x4*)(xr + 512 + lane * 8); x[3] = *(const f32x4*)(xr + 512 + lane * 8 + 4);
        float ss = 0.f;
#pragma unroll
        for (int q = 0; q < 4; ++q)
#pragma unroll
            for (int j = 0; j < 4; ++j) { x[q][j] += acc[4 * q + j]; ss += x[q][j] * x[q][j]; }
        const float rstd = 1.f / sqrtf(wave_sum(ss) * (1.f / DM) + EPS);
        const f32x4 g0 = *(const f32x4*)(gf + lane * 8), g1 = *(const f32x4*)(gf + lane * 8 + 4), g2 = *(const f32x4*)(gf + 512 + lane * 8), g3 = *(const f32x4*)(gf + 512 + lane * 8 + 4);
        *(f32x4*)(xr + lane * 8) = x[0] * rstd * g0; *(f32x4*)(xr + lane * 8 + 4) = x[1] * rstd * g1;
        *(f32x4*)(xr + 512 + lane * 8) = x[2] * rstd * g2; *(f32x4*)(xr + 512 + lane * 8 + 4) = x[3] * rstd * g3;
    }
}

__global__ void __launch_bounds__(512, 2) fwd_megakernel(Params p) {
    extern __shared__ __attribute__((aligned(16))) unsigned char lds_raw[];
    LAS unsigned char* lds = (LAS unsigned char*)lds_raw;
    cg::grid_group grid = cg::this_grid();
    const int tid = threadIdx.x, lane = tid & 63, wave = __builtin_amdgcn_readfirstlane(tid >> 6);
    const int G = gridDim.x;

    phase0(p, lds, tid, lane, wave);
    grid.sync();
    {
        pg8::Gemm g{(const bf16_t*)(p.ws + WS_H), (const bf16_t*)(p.ws + WS_WINT), NT, DIN, 1024};
        pg8::StaticOrder S; S.init(NT, DIN, G, (int)blockIdx.x);
        pg8::EpiProj E{(bf16_t*)(p.ws + WS_A), (bf16_t*)(p.ws + WS_Q), (bf16_t*)(p.ws + WS_KP), (bf16_t*)(p.ws + WS_VP), (bf16_t*)(p.ws + WS_KS), (bf16_t*)(p.ws + WS_VS), p.out};
        pg8::gemm_phase<pg8::EpiProj, pg8::StaticOrder, true, true>(lds, g, S, E);
    }
    grid.sync();
    att::phase2(p, lds, tid, lane, wave);
    grid.sync();
    {
        pg8::Gemm g{(const bf16_t*)(p.ws + WS_MIX), (const bf16_t*)(p.ws + WS_WOUTT), NT, 1024, 1024};
        pg8::StaticOrder S; S.init(NT, 1024, G, (int)blockIdx.x);
        pg8::EpiRes E{p.in[0], p.in[1], p.out};
        pg8::gemm_phase<pg8::EpiRes, pg8::StaticOrder, true, true>(lds, g, S, E);
    }
    grid.sync();
    phase3b(p, lane, wave);
    grid.sync();
    {
        pg8::Gemm g{(const bf16_t*)(p.ws + WS_H2), (const bf16_t*)(p.ws + WS_WQT), NT, 2048, 1024};
        pg8::StaticOrder S; S.init(NT, 2048, G, (int)blockIdx.x);
        pg8::EpiBf16<0> E{(bf16_t*)(p.ws + WS_QP), 2048, nullptr, 0, 0, 1.f};
        pg8::gemm_phase<pg8::EpiBf16<0>, pg8::StaticOrder, true, true>(lds, g, S, E);
    }
    grid.sync();
    phase4b(p, lane, wave);
    grid.sync();
    phase5a(p, tid);
    grid.sync();
    phase5b(p, lane, wave);
}

extern "C" void kernel_launch(void* const* d_in, const int* in_sizes, int n_in, void* d_out, int out_size, void* d_ws, size_t ws_size, hipStream_t stream) {
    static int grid = 0;
    if (grid == 0) {
        if (n_in != 24 || out_size != (int)OUT_TOTAL || ws_size < WS_END) { fprintf(stderr, "kernel_launch: unexpected shapes: n_in %d out %d ws %zu (need %zu)\n", n_in, out_size, ws_size, (size_t)WS_END); grid = -1; return; }
        int dev = 0, cus = 0, per_cu = 0;
        (void)hipGetDevice(&dev);
        (void)hipDeviceGetAttribute(&cus, hipDeviceAttributeMultiprocessorCount, dev);
        if (hipFuncSetAttribute((const void*)fwd_megakernel, hipFuncAttributeMaxDynamicSharedMemorySize, LDS_BYTES) != hipSuccess) { fprintf(stderr, "kernel_launch: hipFuncSetAttribute failed\n"); grid = -1; return; }
        if (hipOccupancyMaxActiveBlocksPerMultiprocessor(&per_cu, (const void*)fwd_megakernel, 512, LDS_BYTES) != hipSuccess || per_cu < 1) { fprintf(stderr, "kernel_launch: occupancy query gave %d\n", per_cu); per_cu = 1; }
        (void)hipGetLastError();
        grid = cus * 1;
        if (per_cu < 1) grid = -1;
    }
    if (grid < 0) return;
    (void)hipMemsetAsync((char*)d_ws + WS_CTL, 0, CTL_BYTES, stream);
    Params p{};
    for (int i = 0; i < 24; ++i) p.in[i] = (const float*)d_in[i];
    p.out = (float*)d_out; p.ws = (unsigned char*)d_ws;
    void* args[] = {&p};
    hipError_t e = hipLaunchCooperativeKernel((const void*)fwd_megakernel, dim3(grid), dim3(512), args, LDS_BYTES, stream);
    if (e != hipSuccess) fprintf(stderr, "cooperative launch failed: %s (grid %d)\n", hipGetErrorString(e), grid);
}
```

```cpp
#include <hip/hip_runtime.h>
#include <hip/hip_cooperative_groups.h>
#include <cstdio>
#include <cstdint>
#include <cmath>
namespace cg = cooperative_groups;
namespace pg8 {
#define PG8_LAS __attribute__((address_space(3)))
typedef unsigned short bf16_t;
typedef short bf16x8 __attribute__((ext_vector_type(8)));
typedef float f32x4 __attribute__((ext_vector_type(4)));
typedef unsigned u32x4 __attribute__((ext_vector_type(4)));
constexpr int BM = 256, BK = 64, HALF = 128, HTB = HALF * BK * 2  , STAGE_BYTES = 8 * HTB, NXCD = 8, WGM = 8;

__host__ __device__ __forceinline__ int lds_byte(int r, int c) { const int st = (r >> 4) * 2 + (c >> 5), rr = r & 15, cc = c & 31, ob = rr * 64 + cc * 2; return st * 1024 + (ob ^ (((ob >> 9) & 1) << 5)); }
__host__ __device__ __forceinline__ void stage_rc(int b, int& R, int& C) { const int st = b / 1024, sb = b % 1024, swz = sb ^ (((sb >> 9) & 1) << 5); R = (st >> 1) * 16 + swz / 64; C = (st & 1) * 32 + (swz % 64) / 2; }
__host__ __device__ __forceinline__ int perm32(int rho) { const int n = rho >> 4, i = rho & 15; return 8 * (i >> 2) + 4 * n + (i & 3); }

struct Unit { int pm, pn; };
struct Gemm { const bf16_t* A; const bf16_t* Bt; int M, N, K; };

struct StaticOrder {
    int nM, nN, nwg, G, c;
    __host__ __device__ void init(int M, int N, int G_, int c_) { nM = M / BM; nN = N / BM; nwg = nM * nN; G = G_; c = c_; }
    __host__ __device__ bool next(int i, Unit& u) const {
        const long L = (long)i * G + c; if (L >= nwg) return false;
        int wgid = (int)L; { const int q = nwg / NXCD, r = nwg % NXCD, xcd = wgid % NXCD, off = wgid / NXCD; wgid = (xcd < r ? xcd * (q + 1) : r * (q + 1) + (xcd - r) * q) + off; }
        const int nig = WGM * nN, gid = wgid / nig, fm = gid * WGM, gsz = (nM - fm) < WGM ? (nM - fm) : WGM;
        u.pm = fm + ((wgid % nig) % gsz); u.pn = (wgid % nig) / gsz; return true;
    }
    __device__ __forceinline__ void a_ready(const Unit&) const {}
    __device__ __forceinline__ void done(const Unit&) const {}
};

__device__ __forceinline__ unsigned cvt_pk_bf16(float lo, float hi) { unsigned r; asm volatile("v_cvt_pk_bf16_f32 %0, %1, %2" : "=v"(r) : "v"(lo), "v"(hi)); return r; }
typedef float f32x2 __attribute__((ext_vector_type(2)));
__device__ __forceinline__ f32x2 gelu_pk(f32x2 v) {
    const f32x2 av = __builtin_elementwise_abs(v), d = av * 0.2316418882f + 1.0f;
    f32x2 t; t.x = __builtin_amdgcn_rcpf(d.x); t.y = __builtin_amdgcn_rcpf(d.y);
    f32x2 q = t * 0.5307027145f + (-0.7265760135f); q = q * t + 0.7107068705f; q = q * t + (-0.142248368f); q = q * t + 0.127414796f; q = q * t;
    const f32x2 s = (v * v) * (-0.72134752044f);
    f32x2 e; e.x = __builtin_amdgcn_exp2f(s.x); e.y = __builtin_amdgcn_exp2f(s.y);
    const f32x2 m = v * (q * e), r = v - m;
    f32x2 o; o.x = v.x < 0.f ? m.x : r.x; o.y = v.y < 0.f ? m.y : r.y; return o;
}

template <int ACT  > struct EpiBf16 {
    static constexpr bool PERM = true, AFTER_DRAIN = false; static_assert(ACT == 0 || ACT == 1, "EpiBf16: ACT is 0 (none) or 1 (gelu_pk)");
    bf16_t* O; int ldc; const float* bias; int split_cols; size_t split_stride; float scale0;
    __device__ __forceinline__ void operator()(const f32x4 (&acc)[2][2][4][2], const Unit& u, int wr, int wc, int fr, int fq) const {
        const int row0 = u.pm * BM + wr * 64 + fr; int colt = u.pn * BM; bf16_t* base = O;
        float sc = 1.f; if (split_cols) { const int t = colt / split_cols; base += (size_t)t * split_stride; colt -= t * split_cols; if (t == 0) sc = scale0; }
        const int col0 = colt + wc * 32 + 8 * fq, bcol0 = u.pn * BM + wc * 32 + 8 * fq;
        f32x4 bv[2][2];
#pragma unroll
        for (int bj = 0; bj < 2; ++bj)
#pragma unroll
            for (int n = 0; n < 2; ++n) bv[bj][n] = bias ? *(const f32x4*)(bias + bcol0 + bj * HALF + 4 * n) : (f32x4){0.f, 0.f, 0.f, 0.f};
#pragma unroll
        for (int ai = 0; ai < 2; ++ai)
#pragma unroll
            for (int m = 0; m < 4; ++m) { bf16_t* rowp = base + (size_t)(row0 + ai * HALF + m * 16) * ldc + col0;
#pragma unroll
                for (int bj = 0; bj < 2; ++bj) { f32x4 v0 = acc[ai][bj][m][0] + bv[bj][0], v1 = acc[ai][bj][m][1] + bv[bj][1];
                    if (ACT == 1) { f32x2 a = gelu_pk((f32x2){v0[0], v0[1]}), b = gelu_pk((f32x2){v0[2], v0[3]}), c = gelu_pk((f32x2){v1[0], v1[1]}), d = gelu_pk((f32x2){v1[2], v1[3]});
                        v0 = (f32x4){a.x, a.y, b.x, b.y}; v1 = (f32x4){c.x, c.y, d.x, d.y}; }
                    v0 = v0 * sc; v1 = v1 * sc; u32x4 w; w.x = cvt_pk_bf16(v0[0], v0[1]); w.y = cvt_pk_bf16(v0[2], v0[3]); w.z = cvt_pk_bf16(v1[0], v1[1]); w.w = cvt_pk_bf16(v1[2], v1[3]);
                    *(u32x4*)(rowp + bj * HALF) = w; } }
    }
};
template <class Epi, class Sched, bool ALIGN_EPI = false, bool SP2 = false>
__device__ __forceinline__ void gemm_phase(PG8_LAS unsigned char* lds, const Gemm g, const Sched& S, const Epi& E) {
    const int tid = threadIdx.x, wid = __builtin_amdgcn_readfirstlane(tid >> 6), lane = tid & 63, wr = wid >> 2, wc = wid & 3, fr = lane & 15, fq = lane >> 4;
    const int K = g.K, nt = K / BK;
    unsigned voffA[2], voffB[2];
#pragma unroll
    for (int i = 0; i < 2; ++i) { int R, C; stage_rc(tid * 16 + i * 8192, R, C); const int Rb = Epi::PERM ? ((R & ~31) + perm32(R & 31)) : R;
        voffA[i] = (unsigned)(R * K + C) * 2u; voffB[i] = (unsigned)(Rb * K + C) * 2u; }
    const size_t kstep = (size_t)(BK * 2);
    const size_t hstep = (size_t)HALF * K * 2;
    const size_t tstep = 2 * hstep;
    const unsigned ldsw = (unsigned)wid * 1024u;
    const int aoff = lds_byte(wr * 64 + fr, fq * 8), boff = lds_byte(wc * 32 + fr, fq * 8);
#define PG8_SA(b, h) (((b) * 2 + (h)) * HTB)
#define PG8_SB(b, h) ((4 + (b) * 2 + (h)) * HTB)
#define PG8_STAGE(bufoff, gbase, voff) do { _Pragma("unroll") for (int _i = 0; _i < 2; ++_i) \
        __builtin_amdgcn_global_load_lds((const unsigned*)((const char*)(gbase) + (voff)[_i]), (PG8_LAS unsigned*)(lds + (bufoff) + ldsw + _i * 8192), 16, 0, 0); } while (0)
#define PG8_LDA(dst, b, h) do { _Pragma("unroll") for (int m = 0; m < 4; ++m) _Pragma("unroll") for (int k = 0; k < 2; ++k) dst[m][k] = *(const PG8_LAS bf16x8*)(lds + PG8_SA(b, h) + aoff + m * 2048 + k * 1024); } while (0)
#define PG8_LDB(dst, b, h) do { _Pragma("unroll") for (int n = 0; n < 2; ++n) _Pragma("unroll") for (int k = 0; k < 2; ++k) dst[n][k] = *(const PG8_LAS bf16x8*)(lds + PG8_SB(b, h) + boff + n * 2048 + k * 1024); } while (0)
#define PG8_MMA(ai, bj, At, Bt) do { __builtin_amdgcn_s_setprio(1); _Pragma("unroll") for (int m = 0; m < 4; ++m) _Pragma("unroll") for (int n = 0; n < 2; ++n) _Pragma("unroll") for (int k = 0; k < 2; ++k) \
        acc[ai][bj][m][n] = __builtin_amdgcn_mfma_f32_16x16x32_bf16(Bt[n][k], At[m][k], acc[ai][bj][m][n], 0, 0, 0); __builtin_amdgcn_s_setprio(0); } while (0)
#define PG8_WAIT_V(n) asm volatile("s_waitcnt vmcnt(" #n ")" ::: "memory")
#define PG8_WAIT_L(n) asm volatile("s_waitcnt lgkmcnt(" #n ")" ::: "memory")
#define PG8_BAR __builtin_amdgcn_s_barrier()
#define PG8_SCHED __builtin_amdgcn_sched_barrier(0)
    Unit cur, nxt; int ui = 0;
    if (!S.next(0, cur)) return;
    f32x4 acc[2][2][4][2];
#pragma unroll
    for (int a = 0; a < 2; ++a)
#pragma unroll
        for (int b = 0; b < 2; ++b)
#pragma unroll
            for (int m = 0; m < 4; ++m)
#pragma unroll
                for (int n = 0; n < 2; ++n) acc[a][b][m][n] = (f32x4){0.f, 0.f, 0.f, 0.f};
    bf16x8 At[4][2], B0[2][2], B1[2][2];
    const char* cA = (const char*)g.A + (size_t)cur.pm * tstep; const char* cB = (const char*)g.Bt + (size_t)cur.pn * tstep;
    S.a_ready(cur);
    if constexpr (SP2) {
        PG8_STAGE(PG8_SB(0, 0), cB, voffB); PG8_STAGE(PG8_SB(0, 1), cB + hstep, voffB); PG8_STAGE(PG8_SA(0, 0), cA, voffA); PG8_STAGE(PG8_SA(0, 1), cA + hstep, voffA);
        if (wr == 1) PG8_BAR;
        PG8_WAIT_V(2); PG8_BAR;
        PG8_STAGE(PG8_SB(1, 0), cB + kstep, voffB); PG8_STAGE(PG8_SA(1, 0), cA + kstep, voffA); PG8_STAGE(PG8_SB(1, 1), cB + hstep + kstep, voffB);
        PG8_WAIT_V(6); PG8_BAR;
    } else {
        PG8_STAGE(PG8_SB(0, 0), cB, voffB); PG8_STAGE(PG8_SA(0, 0), cA, voffA); PG8_STAGE(PG8_SB(0, 1), cB + hstep, voffB); PG8_STAGE(PG8_SA(0, 1), cA + hstep, voffA);
        if (wr == 1) PG8_BAR;
        PG8_WAIT_V(4); PG8_BAR;
        PG8_STAGE(PG8_SB(1, 0), cB + kstep, voffB); PG8_STAGE(PG8_SA(1, 0), cA + kstep, voffA); PG8_STAGE(PG8_SB(1, 1), cB + hstep + kstep, voffB);
        PG8_WAIT_V(6); PG8_BAR;
    }
    for (;;) {
        const bool has_next = S.next(ui + 1, nxt);
        const char* nA = has_next ? (const char*)g.A + (size_t)nxt.pm * tstep : cA; const char* nB = has_next ? (const char*)g.Bt + (size_t)nxt.pn * tstep : cB;
        for (int t = 0; t < nt; t += 2) {
            const bool last = (t == nt - 2);
            const char* a1 = cA + (size_t)(t + 1) * kstep;
            const char* a2 = last ? nA : cA + (size_t)(t + 2) * kstep; const char* b2 = last ? nB : cB + (size_t)(t + 2) * kstep;
            const char* a3 = a2 + kstep; const char* b3 = b2 + kstep;
            if (last && has_next) S.a_ready(nxt);
            if constexpr (SP2) {
            PG8_LDB(B0, 0, 0); PG8_LDB(B1, 0, 1); PG8_SCHED; PG8_LDA(At, 0, 0); PG8_STAGE(PG8_SA(1, 1), a1 + hstep, voffA);
            PG8_WAIT_V(8); PG8_WAIT_L(0); PG8_BAR; PG8_MMA(0, 0, At, B0); PG8_MMA(0, 1, At, B1); PG8_BAR; PG8_SCHED;
            PG8_LDA(At, 0, 1); PG8_STAGE(PG8_SB(0, 0), b2, voffB); PG8_STAGE(PG8_SB(0, 1), b2 + hstep, voffB); PG8_STAGE(PG8_SA(0, 0), a2, voffA);
            PG8_WAIT_V(8); PG8_WAIT_L(0); PG8_BAR; PG8_MMA(1, 0, At, B0); PG8_MMA(1, 1, At, B1); PG8_BAR; PG8_SCHED;
            PG8_LDB(B0, 1, 0); PG8_LDB(B1, 1, 1); PG8_SCHED; PG8_LDA(At, 1, 0); PG8_STAGE(PG8_SA(0, 1), a2 + hstep, voffA);
            PG8_WAIT_V(8); PG8_WAIT_L(0); PG8_BAR; PG8_MMA(0, 0, At, B0); PG8_MMA(0, 1, At, B1); PG8_BAR; PG8_SCHED;
            PG8_LDA(At, 1, 1); PG8_STAGE(PG8_SB(1, 0), b3, voffB); PG8_STAGE(PG8_SB(1, 1), b3 + hstep, voffB); PG8_STAGE(PG8_SA(1, 0), a3, voffA);
            PG8_WAIT_V(8); PG8_WAIT_L(0); PG8_BAR; PG8_MMA(1, 0, At, B0); PG8_MMA(1, 1, At, B1); PG8_BAR; PG8_SCHED;
            } else {
            PG8_LDB(B0, 0, 0); PG8_SCHED; PG8_LDA(At, 0, 0); PG8_STAGE(PG8_SA(1, 1), a1 + hstep, voffA);
            PG8_WAIT_L(8); PG8_BAR; PG8_WAIT_L(0); PG8_MMA(0, 0, At, B0); PG8_BAR; PG8_SCHED;
            PG8_LDB(B1, 0, 1); PG8_STAGE(PG8_SB(0, 0), b2, voffB);
            PG8_BAR; PG8_WAIT_L(0); PG8_MMA(0, 1, At, B1); PG8_BAR;
            PG8_LDA(At, 0, 1); PG8_STAGE(PG8_SA(0, 0), a2, voffA);
            PG8_BAR; PG8_WAIT_L(0); PG8_MMA(1, 0, At, B0); PG8_BAR; PG8_SCHED;
            PG8_STAGE(PG8_SB(0, 1), b2 + hstep, voffB);
            PG8_WAIT_V(6); PG8_BAR; PG8_MMA(1, 1, At, B1); PG8_BAR;
            PG8_LDB(B0, 1, 0); PG8_SCHED; PG8_LDA(At, 1, 0); PG8_STAGE(PG8_SA(0, 1), a2 + hstep, voffA);
            PG8_WAIT_L(8); PG8_BAR; PG8_WAIT_L(0); PG8_MMA(0, 0, At, B0); PG8_BAR; PG8_SCHED;
            PG8_LDB(B1, 1, 1); PG8_STAGE(PG8_SB(1, 0), b3, voffB);
            PG8_BAR; PG8_WAIT_L(0); PG8_MMA(0, 1, At, B1); PG8_BAR;
            PG8_LDA(At, 1, 1); PG8_STAGE(PG8_SA(1, 0), a3, voffA);
            PG8_BAR; PG8_WAIT_L(0); PG8_MMA(1, 0, At, B0); PG8_BAR; PG8_SCHED;
            PG8_STAGE(PG8_SB(1, 1), b3 + hstep, voffB);
            PG8_WAIT_V(6); PG8_BAR; PG8_MMA(1, 1, At, B1); PG8_BAR;
            }
        }
        if constexpr (ALIGN_EPI) { if (wr == 0) PG8_BAR; }
        if constexpr (!Epi::AFTER_DRAIN) { E(acc, cur, wr, wc, fr, fq); S.done(cur); }
        if (!has_next) break;
#pragma unroll
        for (int a = 0; a < 2; ++a)
#pragma unroll
            for (int b = 0; b < 2; ++b)
#pragma unroll
                for (int m = 0; m < 4; ++m)
#pragma unroll
                    for (int n = 0; n < 2; ++n) acc[a][b][m][n] = (f32x4){0.f, 0.f, 0.f, 0.f};
        cur = nxt; cA = nA; cB = nB; ++ui;
        if constexpr (ALIGN_EPI) { if (wr == 1) PG8_BAR; }
    }
    PG8_WAIT_V(0);
    if constexpr (!ALIGN_EPI) { if (wr == 0) PG8_BAR; }
    PG8_BAR;
    if constexpr (Epi::AFTER_DRAIN) { E.fused(acc, cur, wr, wc, fr, fq, lds, wid, lane); S.done(cur); }
#undef PG8_SA
#undef PG8_SB
#undef PG8_STAGE
#undef PG8_LDA
#undef PG8_LDB
#undef PG8_MMA
#undef PG8_WAIT_V
#undef PG8_WAIT_L
#undef PG8_BAR
#undef PG8_SCHED
}
}

#define LAS __attribute__((address_space(3)))
typedef unsigned short bf16_t;
typedef short bf16x8 __attribute__((ext_vector_type(8)));
typedef short s16x4 __attribute__((ext_vector_type(4)));
typedef float f32x4 __attribute__((ext_vector_type(4)));
typedef float f32x16 __attribute__((ext_vector_type(16)));
typedef unsigned u32x4 __attribute__((ext_vector_type(4)));
typedef unsigned u32x2 __attribute__((ext_vector_type(2)));

constexpr int DM = 1024;
constexpr int NP = 16 * 2048;
constexpr int NS = 8 * 64;
constexpr int NT = NP + NS;
constexpr int DIN = 2560;
constexpr int SKV = 2112;
constexpr float EPS = 1e-6f;
constexpr float LOG2E = 1.4426950408889634f;
constexpr float QSCALE = 0.125f * LOG2E;

constexpr long OUT_Y = 0;
constexpr long OUT_KP = 34078720L, OUT_VP = 50855936L, OUT_CONVP = 67633152L, OUT_KS = 67878912L, OUT_VS = 68141056L, OUT_CONVS = 68403200L, OUT_TOTAL = 68526080L;

constexpr size_t MiB = 1u << 20;
constexpr size_t WS_CTL = 0, CTL_BYTES = 1 * MiB;
constexpr size_t WS_WINT = 1 * MiB;
constexpr size_t WS_WOUTT = 6 * MiB;
constexpr size_t WS_WQT = 8 * MiB;
constexpr size_t WS_SK = 12 * MiB;
constexpr size_t WS_PU8 = 16 * MiB;
constexpr size_t WS_PV8 = 32 * MiB;
constexpr size_t WS_SCU = 48 * MiB;
constexpr size_t WS_SCV = 49 * MiB;
constexpr size_t WS_KS = 80 * MiB;
constexpr size_t WS_VS = 97 * MiB;
constexpr size_t WS_H = 114 * MiB;
constexpr size_t WS_A = 179 * MiB;
constexpr size_t WS_Q = 212 * MiB;
constexpr size_t WS_QP = 114 * MiB;
constexpr size_t WS_KP = 245 * MiB;
constexpr size_t WS_VP = 277 * MiB;
constexpr size_t WS_MIX = 309 * MiB;
constexpr size_t WS_H2 = 309 * MiB;
constexpr size_t WS_TK = 375 * MiB;
constexpr size_t WS_IDX = 408 * MiB;
constexpr size_t WS_GATE = 425 * MiB;
constexpr size_t WS_END = 442 * MiB;
static_assert(WS_H + (size_t)NT * 1024 * 2 <= WS_A && WS_A + (size_t)NT * 512 * 2 <= WS_Q && WS_Q + (size_t)NT * 512 * 2 <= WS_KP, "R1");
static_assert(WS_QP + (size_t)NT * 2048 * 2 <= WS_KP && WS_KP + (size_t)NP * 512 * 2 <= WS_VP && WS_VP + (size_t)NP * 512 * 2 <= WS_MIX, "ws map");
static_assert(WS_MIX + (size_t)NT * 1024 * 2 <= WS_TK && WS_TK + (size_t)NT * 256 * 4 <= WS_IDX && WS_IDX + (size_t)NT * 128 * 4 <= WS_GATE && WS_GATE + (size_t)NT * 128 * 4 <= WS_END, "ws map 2");
static_assert(WS_KS + (size_t)8 * SKV * 512 * 2 <= WS_VS && WS_VS + (size_t)8 * SKV * 512 * 2 <= WS_H, "ws map 3");

constexpr int RING_BYTES = 131072;
constexpr int MISC_OFF = RING_BYTES;
constexpr int LDS_BYTES = RING_BYTES + 1024;

struct Params {
    const float* in[24];
    float* out;
    unsigned char* ws;
};

__device__ __forceinline__ unsigned cvtpk(float lo, float hi) { return pg8::cvt_pk_bf16(lo, hi); }
__device__ __forceinline__ float bflo(unsigned w) { return __uint_as_float(w << 16); }
__device__ __forceinline__ float bfhi(unsigned w) { return __uint_as_float(w & 0xffff0000u); }
__device__ __forceinline__ float wave_sum(float v) {
#pragma unroll
    for (int o = 1; o < 64; o <<= 1) v += __shfl_xor(v, o);
    return v;
}
typedef __bf16 bf16x2_t __attribute__((ext_vector_type(2)));
__device__ __forceinline__ float dot2(unsigned a, unsigned b, float acc) {
    return __builtin_amdgcn_fdot2_f32_bf16(__builtin_bit_cast(bf16x2_t, a), __builtin_bit_cast(bf16x2_t, b), acc, false);
}
#define LDS_WAIT() asm volatile("s_waitcnt lgkmcnt(0)" ::: "memory")

namespace pg8 {
__device__ __forceinline__ u32x2 pack4(f32x4 v) { u32x2 w; w.x = cvt_pk_bf16(v[0], v[1]); w.y = cvt_pk_bf16(v[2], v[3]); return w; }
struct EpiProj {
    static constexpr bool PERM = false, AFTER_DRAIN = false;
    bf16_t* A; bf16_t* Q; bf16_t* KP; bf16_t* VP; bf16_t* KS; bf16_t* VS; float* out;
    __device__ __forceinline__ void operator()(const f32x4 (&acc)[2][2][4][2], const Unit& u, int wr, int wc, int fr, int fq) const {
        const int pn = u.pn;
        const int row0 = u.pm * BM + wr * 64 + fr;
        if (pn < 4) {
#pragma unroll
            for (int ai = 0; ai < 2; ++ai)
#pragma unroll
                for (int m = 0; m < 4; ++m) {
                    const int row = row0 + ai * HALF + m * 16;
                    long toff = -1;
                    if (row < NP) { const int s = row & 2047; if (s >= 2018) toff = OUT_CONVP + ((long)(row >> 11) * 30 + (s - 2018)) * 512; }
                    else { const int rr = row - NP; const int i = rr & 63; if (i >= 34) toff = OUT_CONVS + ((long)(rr >> 6) * 30 + (i - 34)) * 512; }
#pragma unroll
                    for (int n = 0; n < 2; ++n) {
                        const int c = 128 * pn + 32 * wc + 16 * n + 4 * fq;
                        const f32x4 x = acc[ai][0][m][n], g = acc[ai][1][m][n];
                        f32x4 a;
#pragma unroll
                        for (int j = 0; j < 4; ++j) a[j] = x[j] / (1.f + __expf(-g[j]));
                        *(u32x2*)(A + (size_t)row * 512 + c) = pack4(a);
                        if (toff >= 0) *(f32x4*)(out + toff + c) = a;
                    }
                }
        } else {
            const int sec = (pn - 4) >> 1, colbase = ((pn - 4) & 1) * 256;
#pragma unroll
            for (int ai = 0; ai < 2; ++ai)
#pragma unroll
                for (int m = 0; m < 4; ++m) {
                    const int row = row0 + ai * HALF + m * 16;
                    const bool isp = row < NP; const int rr = row - NP;
                    bf16_t* bdst; float* fdst;
                    if (sec == 0) { bdst = Q + (size_t)row * 512; fdst = nullptr; }
                    else if (sec == 1) { bdst = isp ? KP + (size_t)row * 512 : KS + ((size_t)(rr >> 6) * SKV + 2048 + (rr & 63)) * 512; fdst = isp ? out + OUT_KP + (size_t)row * 512 : out + OUT_KS + (size_t)rr * 512; }
                    else { bdst = isp ? VP + (size_t)row * 512 : VS + ((size_t)(rr >> 6) * SKV + 2048 + (rr & 63)) * 512; fdst = isp ? out + OUT_VP + (size_t)row * 512 : out + OUT_VS + (size_t)rr * 512; }
#pragma unroll
                    for (int bj = 0; bj < 2; ++bj)
#pragma unroll
                        for (int n = 0; n < 2; ++n) {
                            const int col = colbase + 128 * bj + 32 * wc + 16 * n + 4 * fq;
                            const f32x4 v = acc[ai][bj][m][n];
                            if (sec == 0) { *(u32x2*)(bdst + col) = pack4(v * QSCALE); }
                            else { *(u32x2*)(bdst + col) = pack4(v); *(f32x4*)(fdst + col) = v; }
                        }
                }
        }
    }
};
struct EpiRes {
    static constexpr bool PERM = false, AFTER_DRAIN = false;
    const float* xp; const float* xs; float* out;
    __device__ __forceinline__ void operator()(const f32x4 (&acc)[2][2][4][2], const Unit& u, int wr, int wc, int fr, int fq) const {
        const int row0 = u.pm * BM + wr * 64 + fr;
#pragma unroll
        for (int ai = 0; ai < 2; ++ai)
#pragma unroll
            for (int m = 0; m < 4; ++m) {
                const int row = row0 + ai * HALF + m * 16;
                const float* xr = row < NP ? xp + (size_t)row * DM : xs + (size_t)(row - NP) * DM;
                float* orow = out + (size_t)row * DM;
#pragma unroll
                for (int bj = 0; bj < 2; ++bj)
#pragma unroll
                    for (int n = 0; n < 2; ++n) {
                        const int col = u.pn * BM + 128 * bj + 32 * wc + 16 * n + 4 * fq;
                        *(f32x4*)(orow + col) = *(const f32x4*)(xr + col) + acc[ai][bj][m][n];
                    }
            }
    }
};
}

__device__ __forceinline__ int winrow(int n) { return n < 1024 ? (256 * ((n & 511) >> 7) + 128 * (n >> 9) + (n & 127)) : n; }
template <bool WIN> __device__ __forceinline__ void transpose_item(const float* W, int K, int N, bf16_t* WT, LAS float* scr, int item, int lane) {
    const int nblk = N / 32, kb = item / nblk, nb = item % nblk, k0 = 64 * kb, n0 = 32 * nb;
#pragma unroll 8
    for (int i = 0; i < 32; ++i) { const int kk = 2 * i + (lane >> 5); scr[kk * 33 + (lane & 31)] = W[(size_t)(k0 + kk) * N + n0 + (lane & 31)]; }
    LDS_WAIT();
    const int c = lane & 7;
#pragma unroll
    for (int j = 0; j < 4; ++j) {
        const int n = (lane >> 3) + 8 * j; const LAS float* s = scr + (8 * c) * 33 + n;
        u32x4 o; o.x = cvtpk(s[0 * 33], s[1 * 33]); o.y = cvtpk(s[2 * 33], s[3 * 33]); o.z = cvtpk(s[4 * 33], s[5 * 33]); o.w = cvtpk(s[6 * 33], s[7 * 33]);
        const int dr = WIN ? winrow(n0 + n) : (n0 + n);
        *(u32x4*)(WT + (size_t)dr * K + k0 + 8 * c) = o;
    }
    LDS_WAIT();
}
__device__ __forceinline__ void cvt_stream(const float* src, bf16_t* dst, size_t n8, size_t gt, size_t ngt) {
    for (size_t i = gt; i < n8; i += ngt) {
        const f32x4 a = *(const f32x4*)(src + i * 8), b = *(const f32x4*)(src + i * 8 + 4);
        u32x4 o; o.x = cvtpk(a[0], a[1]); o.y = cvtpk(a[2], a[3]); o.z = cvtpk(b[0], b[1]); o.w = cvtpk(b[2], b[3]);
        *(u32x4*)(dst + i * 8) = o;
    }
}
__device__ __forceinline__ void cvt_cache(const float* src, bf16_t* dst, size_t gt, size_t ngt) {
    const size_t n8 = (size_t)8 * 2048 * 512 / 8;
    for (size_t i = gt; i < n8; i += ngt) {
        const size_t e = i * 8; const size_t row = e >> 9, col = e & 511; const size_t drow = (row >> 11) * SKV + (row & 2047);
        const f32x4 a = *(const f32x4*)(src + e), b = *(const f32x4*)(src + e + 4);
        u32x4 o; o.x = cvtpk(a[0], a[1]); o.y = cvtpk(a[2], a[3]); o.z = cvtpk(b[0], b[1]); o.w = cvtpk(b[2], b[3]);
        *(u32x4*)(dst + drow * 512 + col) = o;
    }
}
__device__ __forceinline__ void rms_row_bf16(const float* xrow, const float* g, bf16_t* orow, int lane) {
    const f32x4* xr = (const f32x4*)xrow + lane; const f32x4* gr = (const f32x4*)g + lane;
    f32x4 v[4]; float s = 0.f;
#pragma unroll
    for (int j = 0; j < 4; ++j) { v[j] = xr[64 * j]; s += (v[j][0] * v[j][0] + v[j][1] * v[j][1]) + (v[j][2] * v[j][2] + v[j][3] * v[j][3]); }
    const float rstd = 1.f / sqrtf(wave_sum(s) * (1.f / DM) + EPS);
    u32x2* o8 = (u32x2*)orow + lane;
#pragma unroll
    for (int j = 0; j < 4; ++j) { const f32x4 gg = gr[64 * j]; u32x2 w; w.x = cvtpk(v[j][0] * rstd * gg[0], v[j][1] * rstd * gg[1]); w.y = cvtpk(v[j][2] * rstd * gg[2], v[j][3] * rstd * gg[3]); o8[64 * j] = w; }
}

__device__ __forceinline__ void cvt_row_fp8(const float* src, unsigned char* dst, float* scale_out, int lane) {
    const f32x4* xr = (const f32x4*)src + lane;
    f32x4 v[4]; float am = 0.f;
#pragma unroll
    for (int j = 0; j < 4; ++j) { v[j] = xr[64 * j]; am = fmaxf(am, fmaxf(fmaxf(fabsf(v[j][0]), fabsf(v[j][1])), fmaxf(fabsf(v[j][2]), fabsf(v[j][3])))); }
#pragma unroll
    for (int o = 1; o < 64; o <<= 1) am = fmaxf(am, __shfl_xor(am, o));
    const float sc = am > 0.f ? am * (1.f / 448.f) : 1.f, inv = 1.f / sc;
#pragma unroll
    for (int j = 0; j < 4; ++j) {
        const int eb = 256 * j + 4 * lane;
        const int pos = 16 * ((eb & 511) >> 3) + (eb & 7) + (eb >= 512 ? 8 : 0);
        int w = __builtin_amdgcn_cvt_pk_fp8_f32(v[j][0] * inv, v[j][1] * inv, 0, false);
        w = __builtin_amdgcn_cvt_pk_fp8_f32(v[j][2] * inv, v[j][3] * inv, w, true);
        *(int*)(dst + pos) = w;
    }
    if (lane == 0) *scale_out = sc;
}

__device__ __forceinline__ void phase0(const Params& p, LAS unsigned char* lds, int tid, int lane, int wave) {
    const int gw = blockIdx.x * 8 + wave, NGW = gridDim.x * 8;
    LAS float* scr = (LAS float*)(lds + wave * 16384);
    bf16_t* WINT = (bf16_t*)(p.ws + WS_WINT); bf16_t* WOUTT = (bf16_t*)(p.ws + WS_WOUTT); bf16_t* WQT = (bf16_t*)(p.ws + WS_WQT);
    constexpr int I_IN = 16 * (DIN / 32), I_OUT = 16 * (1024 / 32), I_Q = 16 * (2048 / 32);
    for (int it = gw; it < I_IN + I_OUT + I_Q; it += NGW) {
        int r = it;
        if (r < I_IN) { transpose_item<true>(p.in[6], 1024, DIN, WINT, scr, r, lane); continue; } r -= I_IN;
        if (r < I_OUT) { transpose_item<false>(p.in[17], 1024, 1024, WOUTT, scr, r, lane); continue; } r -= I_OUT;
        transpose_item<false>(p.in[19], 1024, 2048, WQT, scr, r, lane);
    }
    const size_t gt = (size_t)blockIdx.x * 512 + tid, ngt = (size_t)gridDim.x * 512;
    for (int r = gw; r < 2 * 16384; r += NGW) {
        const int tb = r >> 14, e = r & 16383;
        cvt_row_fp8((tb ? p.in[22] : p.in[21]) + (size_t)e * DM, p.ws + (tb ? WS_PV8 : WS_PU8) + (size_t)e * DM, (float*)(p.ws + (tb ? WS_SCV : WS_SCU)) + e, lane);
    }
    cvt_stream(p.in[20], (bf16_t*)(p.ws + WS_SK), (size_t)16 * 128 * 128 / 8, gt, ngt);
    cvt_cache(p.in[2], (bf16_t*)(p.ws + WS_KS), gt, ngt);
    cvt_cache(p.in[3], (bf16_t*)(p.ws + WS_VS), gt, ngt);
    bf16_t* H = (bf16_t*)(p.ws + WS_H);
    for (int m = gw; m < NT; m += NGW) {
        const float* xr = m < NP ? p.in[0] + (size_t)m * DM : p.in[1] + (size_t)(m - NP) * DM;
        rms_row_bf16(xr, p.in[5], H + (size_t)m * DM, lane);
    }
}

namespace att {
constexpr int KPITCH = 272, VPITCH = 320;
constexpr int L_K = 0, L_V = 17408, L_BIAS = 37888, L_X = 43008, L_END = 108544;
static_assert(L_V == 64 * KPITCH && L_BIAS == L_V + 64 * VPITCH && L_X == L_BIAS + 4 * 320 * 4 && L_END == L_X + 4 * 4096 * 4 && L_END <= RING_BYTES, "attention LDS map");

__device__ __forceinline__ int rel_bucket(int rel) {
    const int ret = rel > 0 ? 16 : 0; const int n = rel < 0 ? -rel : rel; int v;
    if (n < 8) v = n; else if (n < 12) v = 8; else if (n < 16) v = 9; else if (n < 23) v = 10; else if (n < 32) v = 11;
    else if (n < 46) v = 12; else if (n < 64) v = 13; else if (n < 91) v = 14; else v = 15;
    return ret + v;
}
typedef short v4i16_t __attribute__((ext_vector_type(4)));
__device__ __forceinline__ s16x4 vtr(const LAS unsigned char* p) { return __builtin_bit_cast(s16x4, __builtin_amdgcn_ds_read_tr16_b64_v4i16((LAS v4i16_t*)p)); }
__device__ __forceinline__ f32x16 mfma32(bf16x8 a, bf16x8 b, f32x16 c) { return __builtin_amdgcn_mfma_f32_32x32x16_bf16(a, b, c, 0, 0, 0); }

__device__ __forceinline__ void attn_unit(const Params& p, LAS unsigned char* lds, int kind, int bb, int h, int qblk, float lam, int tid, int lane, int wid) {
    const bf16_t* Q = (const bf16_t*)(p.ws + WS_Q);
    const bf16_t* Kb = kind == 0 ? (const bf16_t*)(p.ws + WS_KP) + (size_t)bb * 2048 * 512 + h * 128 : (const bf16_t*)(p.ws + WS_KS) + (size_t)bb * SKV * 512 + h * 128;
    const bf16_t* Vb = kind == 0 ? (const bf16_t*)(p.ws + WS_VP) + (size_t)bb * 2048 * 512 + h * 128 : (const bf16_t*)(p.ws + WS_VS) + (size_t)bb * SKV * 512 + h * 128;
    bf16_t* MIX = (bf16_t*)(p.ws + WS_MIX);
    const int qrow0 = kind == 0 ? bb * 2048 + qblk * 128 : NP + bb * 64;
    const int qpos0 = kind == 0 ? qblk * 128 : 2048;
    const int ntiles = kind == 0 ? 2 * qblk + 2 : 33;
    const int rg = wid & 3, map = wid >> 2, r32 = lane & 31, hi = lane >> 5;
    const bool active = kind == 0 ? true : (rg < 2);
    const int cw = kind == 0 ? 2 * qblk + (rg >> 1) : 32;
    const int qw0 = qpos0 + 32 * rg;
    const int qabs = qw0 + r32;

    bf16x8 qf[4];
    if (active) {
        const bf16_t* qp = Q + (size_t)(qrow0 + 32 * rg + r32) * 512 + h * 128 + map * 64 + 8 * hi;
#pragma unroll
        for (int s = 0; s < 4; ++s) qf[s] = *(const bf16x8*)(qp + 16 * s);
    } else {
#pragma unroll
        for (int s = 0; s < 4; ++s) qf[s] = (bf16x8){0, 0, 0, 0, 0, 0, 0, 0};
    }
    float m = -1e30f, l = 0.f;
    f32x16 o[4];
#pragma unroll
    for (int mt = 0; mt < 4; ++mt)
#pragma unroll
        for (int r = 0; r < 16; ++r) o[mt][r] = 0.f;

    const int srow0 = tid >> 4, sch = tid & 15;
    u32x4 kreg[2], vreg[2];
#pragma unroll
    for (int i = 0; i < 2; ++i) { const size_t off = (size_t)(srow0 + 32 * i) * 512 + sch * 8; kreg[i] = *(const u32x4*)(Kb + off); vreg[i] = *(const u32x4*)(Vb + off); }
    const LAS float* btab = (const LAS float*)(lds + L_BIAS) + h * 320;
    const float biasfar = btab[0];
    const int vlane = (4 * hi + ((lane & 15) >> 2)) * VPITCH + (16 * ((lane >> 4) & 1) + 4 * (lane & 3)) * 2;

    for (int t = 0; t < ntiles; ++t) {
#pragma unroll
        for (int i = 0; i < 2; ++i) {
            *(LAS u32x4*)(lds + L_K + (srow0 + 32 * i) * KPITCH + sch * 16) = kreg[i];
            *(LAS u32x4*)(lds + L_V + (srow0 + 32 * i) * VPITCH + sch * 16) = vreg[i];
        }
        __syncthreads();
        if (t + 1 < ntiles) {
#pragma unroll
            for (int i = 0; i < 2; ++i) { const size_t off = (size_t)((t + 1) * 64 + srow0 + 32 * i) * 512 + sch * 8; kreg[i] = *(const u32x4*)(Kb + off); vreg[i] = *(const u32x4*)(Vb + off); }
        }
        if (active && t <= cw) {
            f32x16 p0, p1;
            const int kabs0 = t * 64;
            if (kabs0 + 63 - qw0 > -128) {
                const LAS float* bt = btab + (kabs0 - qabs + 256 + 4 * hi);
#pragma unroll
                for (int r = 0; r < 16; ++r) { p0[r] = bt[(r & 3) + 8 * (r >> 2)]; p1[r] = bt[32 + (r & 3) + 8 * (r >> 2)]; }
            } else {
#pragma unroll
                for (int r = 0; r < 16; ++r) { p0[r] = biasfar; p1[r] = biasfar; }
            }
            const LAS unsigned char* kb = lds + L_K + r32 * KPITCH + (map * 8 + hi) * 16;
#pragma unroll
            for (int s = 0; s < 4; ++s) {
                const bf16x8 a0 = *(const LAS bf16x8*)(kb + s * 32), a1 = *(const LAS bf16x8*)(kb + 32 * KPITCH + s * 32);
                p0 = mfma32(a0, qf[s], p0); p1 = mfma32(a1, qf[s], p1);
            }
            float mx = fmaxf(p0[0], p1[0]);
#pragma unroll
            for (int r = 1; r < 16; ++r) mx = fmaxf(mx, fmaxf(p0[r], p1[r]));
            mx = fmaxf(mx, __shfl_xor(mx, 32));
            const float mn = fmaxf(m, mx);
            const float alpha = __builtin_amdgcn_exp2f(m - mn);
            m = mn;
            float rs = 0.f;
#pragma unroll
            for (int r = 0; r < 16; ++r) { p0[r] = __builtin_amdgcn_exp2f(p0[r] - mn); p1[r] = __builtin_amdgcn_exp2f(p1[r] - mn); rs += p0[r] + p1[r]; }
            l = l * alpha + rs;
#pragma unroll
            for (int mt = 0; mt < 4; ++mt)
#pragma unroll
                for (int r = 0; r < 16; ++r) o[mt][r] *= alpha;
#pragma unroll
            for (int t2 = 0; t2 < 2; ++t2)
#pragma unroll
                for (int s = 0; s < 2; ++s) {
                    u32x4 bw;
                    if (t2 == 0) { bw.x = cvtpk(p0[8 * s + 0], p0[8 * s + 1]); bw.y = cvtpk(p0[8 * s + 2], p0[8 * s + 3]); bw.z = cvtpk(p0[8 * s + 4], p0[8 * s + 5]); bw.w = cvtpk(p0[8 * s + 6], p0[8 * s + 7]); }
                    else { bw.x = cvtpk(p1[8 * s + 0], p1[8 * s + 1]); bw.y = cvtpk(p1[8 * s + 2], p1[8 * s + 3]); bw.z = cvtpk(p1[8 * s + 4], p1[8 * s + 5]); bw.w = cvtpk(p1[8 * s + 6], p1[8 * s + 7]); }
                    const bf16x8 B = __builtin_bit_cast(bf16x8, bw);
                    const LAS unsigned char* vb = lds + L_V + vlane + (32 * t2 + 16 * s) * VPITCH;
#pragma unroll
                    for (int mt = 0; mt < 4; ++mt) {
                        const s16x4 lo = vtr(vb + mt * 64), hi8 = vtr(vb + mt * 64 + 8 * VPITCH);
                        const bf16x8 A = (bf16x8){lo[0], lo[1], lo[2], lo[3], hi8[0], hi8[1], hi8[2], hi8[3]};
                        o[mt] = mfma32(A, B, o[mt]);
                    }
                }
        }
        __syncthreads();
    }
    l += __shfl_xor(l, 32);
    const float inv = 1.f / l;
    LAS float* X = (LAS float*)(lds + L_X) + rg * 4096;
    if (active && map == 1) {
        const float sc = -lam * inv;
#pragma unroll
        for (int mt = 0; mt < 4; ++mt)
#pragma unroll
            for (int r = 0; r < 16; ++r) X[(mt * 16 + r) * 64 + lane] = o[mt][r] * sc;
    }
    __syncthreads();
    if (active && map == 0) {
        float ss = 0.f;
#pragma unroll
        for (int mt = 0; mt < 4; ++mt)
#pragma unroll
            for (int r = 0; r < 16; ++r) { const float v = o[mt][r] * inv + X[(mt * 16 + r) * 64 + lane]; o[mt][r] = v; ss += v * v; }
        ss += __shfl_xor(ss, 32);
        const float rsn = 0.8f / sqrtf(ss * (1.f / 128.f) + EPS);
        bf16_t* orow = MIX + (size_t)(qrow0 + 32 * rg + r32) * 1024 + 512 + h * 128;
        const float* sg = p.in[15];
#pragma unroll
        for (int mt = 0; mt < 4; ++mt)
#pragma unroll
            for (int g4 = 0; g4 < 4; ++g4) {
                const int e = 32 * mt + 8 * g4 + 4 * hi;
                const f32x4 gg = *(const f32x4*)(sg + e);
                u32x2 w; w.x = cvtpk(o[mt][4 * g4 + 0] * rsn * gg[0], o[mt][4 * g4 + 1] * rsn * gg[1]); w.y = cvtpk(o[mt][4 * g4 + 2] * rsn * gg[2], o[mt][4 * g4 + 3] * rsn * gg[3]);
                *(u32x2*)(orow + e) = w;
            }
    }
    __syncthreads();
}

__device__ __forceinline__ void conv_unit(const Params& p, int cu, int lane, int wid) {
    const bf16_t* A = (const bf16_t*)(p.ws + WS_A);
    bf16_t* MIX = (bf16_t*)(p.ws + WS_MIX);
    const float* cw = p.in[7]; const float* cb = p.in[8]; const float* lg = p.in[9]; const float* lb = p.in[10]; const float* st = p.in[4];
    const int c0 = lane * 8;
    for (int i = 0; i < 8; ++i) {
        const int row = cu * 64 + wid * 8 + i;
        const bool isp = row < NP;
        const int s = isp ? (row & 2047) : ((row - NP) & 63);
        const int rbase = row - s;
        const int bd = isp ? 0 : ((row - NP) >> 6);
        float acc[8];
        { const f32x4 b0 = *(const f32x4*)(cb + c0), b1 = *(const f32x4*)(cb + c0 + 4);
#pragma unroll
          for (int j = 0; j < 4; ++j) { acc[j] = b0[j]; acc[4 + j] = b1[j]; } }
        for (int j = 0; j < 31; ++j) {
            const int sp = s - 30 + j;
            float x[8];
            if (sp >= 0) {
                const u32x4 w = *(const u32x4*)(A + (size_t)(rbase + sp) * 512 + c0);
                x[0] = bflo(w.x); x[1] = bfhi(w.x); x[2] = bflo(w.y); x[3] = bfhi(w.y); x[4] = bflo(w.z); x[5] = bfhi(w.z); x[6] = bflo(w.w); x[7] = bfhi(w.w);
            } else if (!isp) {
                const float* sr = st + ((size_t)bd * 30 + (30 + sp)) * 512 + c0;
                const f32x4 a0 = *(const f32x4*)sr, a1 = *(const f32x4*)(sr + 4);
#pragma unroll
                for (int q = 0; q < 4; ++q) { x[q] = a0[q]; x[4 + q] = a1[q]; }
            } else continue;
            const f32x4 w0 = *(const f32x4*)(cw + (size_t)j * 512 + c0), w1 = *(const f32x4*)(cw + (size_t)j * 512 + c0 + 4);
#pragma unroll
            for (int q = 0; q < 4; ++q) { acc[q] += w0[q] * x[q]; acc[4 + q] += w1[q] * x[4 + q]; }
        }
        float sm = 0.f;
#pragma unroll
        for (int q = 0; q < 8; ++q) sm += acc[q];
        const float mu = wave_sum(sm) * (1.f / 512.f);
        float sv = 0.f;
#pragma unroll
        for (int q = 0; q < 8; ++q) { acc[q] -= mu; sv += acc[q] * acc[q]; }
        const float rstd = 1.f / sqrtf(wave_sum(sv) * (1.f / 512.f) + EPS);
        const f32x4 g0 = *(const f32x4*)(lg + c0), g1 = *(const f32x4*)(lg + c0 + 4), b0 = *(const f32x4*)(lb + c0), b1 = *(const f32x4*)(lb + c0 + 4);
        float y[8];
#pragma unroll
        for (int q = 0; q < 4; ++q) { y[q] = acc[q] * rstd * g0[q] + b0[q]; y[4 + q] = acc[4 + q] * rstd * g1[q] + b1[q]; }
#pragma unroll
        for (int q = 0; q < 8; ++q) y[q] = y[q] / (1.f + __expf(-y[q]));
        u32x4 w; w.x = cvtpk(y[0], y[1]); w.y = cvtpk(y[2], y[3]); w.z = cvtpk(y[4], y[5]); w.w = cvtpk(y[6], y[7]);
        *(u32x4*)(MIX + (size_t)row * 1024 + c0) = w;
    }
}

constexpr int N_SAMPLE_UNITS = 32, N_PROMPT_UNITS = 1024, N_CONV_UNITS = NT / 64, N_UNITS = N_SAMPLE_UNITS + N_PROMPT_UNITS + N_CONV_UNITS;

__device__ __forceinline__ void phase2(const Params& p, LAS unsigned char* lds, int tid, int lane, int wid, int cidx) {
    LAS float* bt = (LAS float*)(lds + L_BIAS);
    for (int e = tid; e < 4 * 320; e += 512) { const int hh = e / 320, rel = (e % 320) - 256; bt[e] = p.in[16][rel_bucket(rel) * 4 + hh] * LOG2E; }
    const float d1 = wave_sum(p.in[11][lane] * p.in[12][lane]), d2 = wave_sum(p.in[13][lane] * p.in[14][lane]);
    const float lam = expf(d1) - expf(d2) + 0.2f;
    unsigned* ctr = (unsigned*)(p.ws + WS_CTL) + 64 * cidx;
    volatile LAS unsigned* sw = (volatile LAS unsigned*)(lds + MISC_OFF);
    __syncthreads();
    for (;;) {
        __syncthreads();
        if (tid == 0) sw[0] = atomicAdd(ctr, 1u);
        __syncthreads();
        const int u = (int)sw[0];
        if (u >= N_UNITS) break;
        if (u < N_SAMPLE_UNITS) attn_unit(p, lds, 1, u >> 2, u & 3, 0, lam, tid, lane, wid);
        else if (u < N_SAMPLE_UNITS + N_PROMPT_UNITS) { const int v = u - N_SAMPLE_UNITS; const int bh = v & 63; attn_unit(p, lds, 0, bh >> 2, bh & 3, 15 - (v >> 6), lam, tid, lane, wid); }
        else conv_unit(p, u - N_SAMPLE_UNITS - N_PROMPT_UNITS, lane, wid);
    }
}
}

__device__ __forceinline__ void phase3b(const Params& p, int lane, int wave) {
    const int gw = blockIdx.x * 8 + wave, NGW = gridDim.x * 8;
    bf16_t* H2 = (bf16_t*)(p.ws + WS_H2);
    for (int m = gw; m < NT; m += NGW) rms_row_bf16(p.out + (size_t)m * DM, p.in[18], H2 + (size_t)m * DM, lane);
}

__device__ __forceinline__ void phase4b(const Params& p, int lane, int wave) {
    const int gw = blockIdx.x * 8 + wave, NGW = gridDim.x * 8;
    const bf16_t* QP = (const bf16_t*)(p.ws + WS_QP); const bf16_t* SK = (const bf16_t*)(p.ws + WS_SK);
    float* TK = (float*)(p.ws + WS_TK);
    const int r32 = lane & 31, hi = lane >> 5;
    const float NEG_INF = -__builtin_huge_valf();
    for (int wu = gw; wu < (NT / 32) * 16; wu += NGW) {
        const int rp = wu & 15, t0 = (wu >> 4) * 32;
        bf16x8 qf[8];
        const bf16_t* qp = QP + (size_t)(t0 + r32) * 2048 + rp * 128 + 8 * hi;
#pragma unroll
        for (int s = 0; s < 8; ++s) qf[s] = *(const bf16x8*)(qp + 16 * s);
        float v[64];
#pragma unroll
        for (int mt = 0; mt < 4; ++mt) {
            f32x16 S;
#pragma unroll
            for (int r = 0; r < 16; ++r) S[r] = 0.f;
            const bf16_t* kp = SK + ((size_t)rp * 128 + 32 * mt + r32) * 128 + 8 * hi;
#pragma unroll
            for (int s = 0; s < 8; ++s) S = att::mfma32(*(const bf16x8*)(kp + 16 * s), qf[s], S);
#pragma unroll
            for (int r = 0; r < 16; ++r) { const int n = 32 * mt + (r & 3) + 8 * (r >> 2) + 4 * hi; v[mt * 16 + r] = __uint_as_float((__float_as_uint(S[r]) & ~127u) | (unsigned)(127 - n)); }
        }
        float* dst = TK + ((size_t)(t0 + r32) * 16 + rp) * 16;
        for (int it = 0; it < 16; ++it) {
            float mx = v[0];
#pragma unroll
            for (int i = 1; i < 64; ++i) mx = fmaxf(mx, v[i]);
            mx = fmaxf(mx, __shfl_xor(mx, 32));
            if (hi == 0) dst[it] = mx;
#pragma unroll
            for (int i = 0; i < 64; ++i) v[i] = (v[i] == mx) ? NEG_INF : v[i];
        }
    }
}

__device__ __forceinline__ void phase5a(const Params& p, int tid) {
    const float* TK = (const float*)(p.ws + WS_TK);
    int* IDX = (int*)(p.ws + WS_IDX); float* GATE = (float*)(p.ws + WS_GATE);
    const float NEG_INF = -__builtin_huge_valf();
    for (int item = blockIdx.x * 512 + tid; item < NT * 8; item += gridDim.x * 512) {
        const int tok = item >> 3, r = item & 7;
        const f32x4* pa = (const f32x4*)(TK + ((size_t)tok * 16 + 2 * r) * 16);
        float a[16], b[16]; int ia[16], ib[16];
#pragma unroll
        for (int q = 0; q < 4; ++q) { const f32x4 x = pa[q], y = pa[4 + q];
#pragma unroll
            for (int j = 0; j < 4; ++j) { a[4 * q + j] = x[j]; b[4 * q + j] = y[j]; } }
#pragma unroll
        for (int i = 0; i < 16; ++i) { const unsigned ua = __float_as_uint(a[i]), ub = __float_as_uint(b[i]); ia[i] = 127 - (int)(ua & 127u); ib[i] = 127 - (int)(ub & 127u); a[i] = __uint_as_float(ua & ~127u); b[i] = __uint_as_float(ub & ~127u); }
        float cv[50]; int cid[50];
        {
            int c = 0;
#pragma unroll
            for (int i = 0; i < 16; ++i)
#pragma unroll
                for (int j = 0; j < 16; ++j)
                    if ((i + 1) * (j + 1) <= 16) { const float s = a[i] + b[j]; cv[c] = __uint_as_float((__float_as_uint(s) & ~63u) | (unsigned)(63 - c)); cid[c] = ia[i] * 128 + ib[j]; ++c; }
        }
        float best[16]; int bid[16];
#pragma unroll
        for (int it = 0; it < 16; ++it) {
            float mx = cv[0];
#pragma unroll
            for (int c = 1; c < 50; ++c) mx = fmaxf(mx, cv[c]);
            int id = 0;
#pragma unroll
            for (int c = 0; c < 50; ++c) { const bool hit = cv[c] == mx; id = hit ? cid[c] : id; cv[c] = hit ? NEG_INF : cv[c]; }
            best[it] = __uint_as_float(__float_as_uint(mx) & ~63u); bid[it] = id;
        }
        float e[16], sum = 0.f;
#pragma unroll
        for (int k = 0; k < 16; ++k) { e[k] = __expf(best[k] - best[0]); sum += e[k]; }
        const float rinv = 1.f / sum;
        int* io = IDX + (size_t)tok * 128 + r * 16; float* go = GATE + (size_t)tok * 128 + r * 16;
#pragma unroll
        for (int k = 0; k < 16; ++k) { io[k] = bid[k]; go[k] = e[k] * rinv; }
    }
}

__device__ __forceinline__ float gelu_erf(float x) { return 0.5f * x * (1.f + erff(x * 0.70710678118654752f)); }
typedef float f32x2 __attribute__((ext_vector_type(2)));
#define DPP_ADD(v, ctrl) v += __builtin_bit_cast(float, __builtin_amdgcn_update_dpp(0, __builtin_bit_cast(int, v), ctrl, 0xf, 0xf, true))
__device__ __forceinline__ float rl_f(float v, int l) { return __uint_as_float(__builtin_amdgcn_readlane(__float_as_uint(v), l)); }
__device__ __forceinline__ float wave_total(float v) {
    DPP_ADD(v, 0xB1); DPP_ADD(v, 0x4E); DPP_ADD(v, 0x141); DPP_ADD(v, 0x140);
    return (rl_f(v, 0) + rl_f(v, 16)) + (rl_f(v, 32) + rl_f(v, 48));
}
__device__ __forceinline__ void fp8x16_to_f32(const u32x4 q, float (&f)[16]) {
    const f32x2 c0 = __builtin_amdgcn_cvt_pk_f32_fp8(q.x, false), c1 = __builtin_amdgcn_cvt_pk_f32_fp8(q.x, true), c2 = __builtin_amdgcn_cvt_pk_f32_fp8(q.y, false), c3 = __builtin_amdgcn_cvt_pk_f32_fp8(q.y, true);
    const f32x2 c4 = __builtin_amdgcn_cvt_pk_f32_fp8(q.z, false), c5 = __builtin_amdgcn_cvt_pk_f32_fp8(q.z, true), c6 = __builtin_amdgcn_cvt_pk_f32_fp8(q.w, false), c7 = __builtin_amdgcn_cvt_pk_f32_fp8(q.w, true);
    f[0] = c0.x; f[1] = c0.y; f[2] = c1.x; f[3] = c1.y; f[4] = c2.x; f[5] = c2.y; f[6] = c3.x; f[7] = c3.y;
    f[8] = c4.x; f[9] = c4.y; f[10] = c5.x; f[11] = c5.y; f[12] = c6.x; f[13] = c6.y; f[14] = c7.x; f[15] = c7.y;
}
__device__ __forceinline__ void phase5b(const Params& p, int lane, int wave, float* yout) {
    const int gw = blockIdx.x * 8 + wave, NGW = gridDim.x * 8;
    const bf16_t* H2 = (const bf16_t*)(p.ws + WS_H2); const unsigned char* PU8 = p.ws + WS_PU8; const unsigned char* PV8 = p.ws + WS_PV8;
    const float* SCU = (const float*)(p.ws + WS_SCU); const float* SCV = (const float*)(p.ws + WS_SCV);
    const int* IDX = (const int*)(p.ws + WS_IDX); const float* GATE = (const float*)(p.ws + WS_GATE);
    const float* gf = p.in[23];
    for (int tok = gw; tok < NT; tok += NGW) {
        const int idxA = IDX[(size_t)tok * 128 + lane], idxB = IDX[(size_t)tok * 128 + 64 + lane];
        const float gA = GATE[(size_t)tok * 128 + lane], gB = GATE[(size_t)tok * 128 + 64 + lane];
        const float suA = SCU[idxA], suB = SCU[idxB], svA = SCV[idxA], svB = SCV[idxB];
        float hf[16];
        { const u32x4 hA = *(const u32x4*)(H2 + (size_t)tok * DM + lane * 8), hB = *(const u32x4*)(H2 + (size_t)tok * DM + 512 + lane * 8);
          hf[0] = bflo(hA.x); hf[1] = bfhi(hA.x); hf[2] = bflo(hA.y); hf[3] = bfhi(hA.y); hf[4] = bflo(hA.z); hf[5] = bfhi(hA.z); hf[6] = bflo(hA.w); hf[7] = bfhi(hA.w);
          hf[8] = bflo(hB.x); hf[9] = bfhi(hB.x); hf[10] = bflo(hB.y); hf[11] = bfhi(hB.y); hf[12] = bflo(hB.z); hf[13] = bfhi(hB.z); hf[14] = bflo(hB.w); hf[15] = bfhi(hB.w); }
        float actA = 0.f, actB = 0.f;
#pragma unroll 8
        for (int k = 0; k < 64; ++k) {
            const int e = __builtin_amdgcn_readlane(idxA, k);
            float f[16]; fp8x16_to_f32(*(const u32x4*)(PU8 + (size_t)e * DM + lane * 16), f);
            float s0 = f[0] * hf[0], s1 = f[1] * hf[1];
#pragma unroll
            for (int j = 2; j < 16; j += 2) { s0 += f[j] * hf[j]; s1 += f[j + 1] * hf[j + 1]; }
            const float s = wave_total(s0 + s1);
            actA = (lane == k) ? s : actA;
        }
#pragma unroll 8
        for (int k = 0; k < 64; ++k) {
            const int e = __builtin_amdgcn_readlane(idxB, k);
            float f[16]; fp8x16_to_f32(*(const u32x4*)(PU8 + (size_t)e * DM + lane * 16), f);
            float s0 = f[0] * hf[0], s1 = f[1] * hf[1];
#pragma unroll
            for (int j = 2; j < 16; j += 2) { s0 += f[j] * hf[j]; s1 += f[j + 1] * hf[j + 1]; }
            const float s = wave_total(s0 + s1);
            actB = (lane == k) ? s : actB;
        }
        const float cA = gA * gelu_erf(actA * suA) * svA, cB = gB * gelu_erf(actB * suB) * svB;
        float acc[16];
#pragma unroll
        for (int j = 0; j < 16; ++j) acc[j] = 0.f;
#pragma unroll 8
        for (int k = 0; k < 64; ++k) {
            const int e = __builtin_amdgcn_readlane(idxA, k);
            const float c = rl_f(cA, k);
            float f[16]; fp8x16_to_f32(*(const u32x4*)(PV8 + (size_t)e * DM + lane * 16), f);
#pragma unroll
            for (int j = 0; j < 16; ++j) acc[j] += c * f[j];
        }
#pragma unroll 8
        for (int k = 0; k < 64; ++k) {
            const int e = __builtin_amdgcn_readlane(idxB, k);
            const float c = rl_f(cB, k);
            float f[16]; fp8x16_to_f32(*(const u32x4*)(PV8 + (size_t)e * DM + lane * 16), f);
#pragma unroll
            for (int j = 0; j < 16; ++j) acc[j] += c * f[j];
        }
        const float* xr = p.out + (size_t)tok * DM; float* yr = yout + (size_t)tok * DM;
        f32x4 x[4];
        x[0] = *(const f32x4*)(xr + lane * 8); x[1] = *(const f32x4*)(xr + lane * 8 + 4); x[2] = *(const f32x4*)(xr + 512 + lane * 8); x[3] = *(const f32x4*)(xr + 512 + lane * 8 + 4);
        float ss = 0.f;
#pragma unroll
        for (int q = 0; q < 4; ++q)
#pragma unroll
            for (int j = 0; j < 4; ++j) { x[q][j] += acc[4 * q + j]; ss += x[q][j] * x[q][j]; }
        const float rstd = 1.f / sqrtf(wave_total(ss) * (1.f / DM) + EPS);
        const f32x4 g0 = *(const f32x4*)(gf + lane * 8), g1 = *(const f32x4*)(gf + lane * 8 + 4), g2 = *(const f32x4*)(gf + 512 + lane * 8), g3 = *(const f32x4*)(gf + 512 + lane * 8 + 4);
        *(f32x4*)(yr + lane * 8) = x[0] * rstd * g0; *(f32x4*)(yr + lane * 8 + 4) = x[1] * rstd * g1;
        *(f32x4*)(yr + 512 + lane * 8) = x[2] * rstd * g2; *(f32x4*)(yr + 512 + lane * 8 + 4) = x[3] * rstd * g3;
    }
}

__global__ void __launch_bounds__(512, 2) fwd_megakernel(Params p) {
    extern __shared__ __attribute__((aligned(16))) unsigned char lds_raw[];
    LAS unsigned char* lds = (LAS unsigned char*)lds_raw;
    cg::grid_group grid = cg::this_grid();
    const int tid = threadIdx.x, lane = tid & 63, wave = __builtin_amdgcn_readfirstlane(tid >> 6);
    const int G = gridDim.x;

#ifndef RPT_MASK
#define RPT_MASK 0
#endif
#define RPT(bit) for (int rpt_ = 0; rpt_ < (((RPT_MASK) >> (bit)) & 1) + 1; ++rpt_)
    RPT(0) { phase0(p, lds, tid, lane, wave); grid.sync(); }
    RPT(1) {
        pg8::Gemm g{(const bf16_t*)(p.ws + WS_H), (const bf16_t*)(p.ws + WS_WINT), NT, DIN, 1024};
        pg8::StaticOrder S; S.init(NT, DIN, G, (int)blockIdx.x);
        pg8::EpiProj E{(bf16_t*)(p.ws + WS_A), (bf16_t*)(p.ws + WS_Q), (bf16_t*)(p.ws + WS_KP), (bf16_t*)(p.ws + WS_VP), (bf16_t*)(p.ws + WS_KS), (bf16_t*)(p.ws + WS_VS), p.out};
        pg8::gemm_phase<pg8::EpiProj, pg8::StaticOrder, true, true>(lds, g, S, E);
        grid.sync();
    }
    RPT(2) { att::phase2(p, lds, tid, lane, wave, rpt_); grid.sync(); }
    RPT(3) {
        pg8::Gemm g{(const bf16_t*)(p.ws + WS_MIX), (const bf16_t*)(p.ws + WS_WOUTT), NT, 1024, 1024};
        pg8::StaticOrder S; S.init(NT, 1024, G, (int)blockIdx.x);
        pg8::EpiRes E{p.in[0], p.in[1], p.out};
        pg8::gemm_phase<pg8::EpiRes, pg8::StaticOrder, true, true>(lds, g, S, E);
        grid.sync();
    }
    RPT(4) { phase3b(p, lane, wave); grid.sync(); }
    RPT(5) {
        pg8::Gemm g{(const bf16_t*)(p.ws + WS_H2), (const bf16_t*)(p.ws + WS_WQT), NT, 2048, 1024};
        pg8::StaticOrder S; S.init(NT, 2048, G, (int)blockIdx.x);
        pg8::EpiBf16<0> E{(bf16_t*)(p.ws + WS_QP), 2048, nullptr, 0, 0, 1.f};
        pg8::gemm_phase<pg8::EpiBf16<0>, pg8::StaticOrder, true, true>(lds, g, S, E);
        grid.sync();
    }
    RPT(6) { phase4b(p, lane, wave); grid.sync(); }
    RPT(7) { phase5a(p, tid); grid.sync(); }
    if ((RPT_MASK) & 256) { phase5b(p, lane, wave, (float*)(p.ws + WS_QP)); grid.sync(); }
    phase5b(p, lane, wave, p.out);
}

extern "C" void kernel_launch(void* const* d_in, const int* in_sizes, int n_in, void* d_out, int out_size, void* d_ws, size_t ws_size, hipStream_t stream) {
    static int grid = 0;
    if (grid == 0) {
        if (n_in != 24 || out_size != (int)OUT_TOTAL || ws_size < WS_END) { fprintf(stderr, "kernel_launch: unexpected shapes: n_in %d out %d ws %zu (need %zu)\n", n_in, out_size, ws_size, (size_t)WS_END); grid = -1; return; }
        int dev = 0, cus = 0, per_cu = 0;
        (void)hipGetDevice(&dev);
        (void)hipDeviceGetAttribute(&cus, hipDeviceAttributeMultiprocessorCount, dev);
        if (hipFuncSetAttribute((const void*)fwd_megakernel, hipFuncAttributeMaxDynamicSharedMemorySize, LDS_BYTES) != hipSuccess) { fprintf(stderr, "kernel_launch: hipFuncSetAttribute failed\n"); grid = -1; return; }
        if (hipOccupancyMaxActiveBlocksPerMultiprocessor(&per_cu, (const void*)fwd_megakernel, 512, LDS_BYTES) != hipSuccess || per_cu < 1) { fprintf(stderr, "kernel_launch: occupancy query gave %d\n", per_cu); per_cu = 1; }
        (void)hipGetLastError();
        grid = cus * 1;
        if (per_cu < 1) grid = -1;
    }
    if (grid < 0) return;
    (void)hipMemsetAsync((char*)d_ws + WS_CTL, 0, CTL_BYTES, stream);
    Params p{};
    for (int i = 0; i < 24; ++i) p.in[i] = (const float*)d_in[i];
    p.out = (float*)d_out; p.ws = (unsigned char*)d_ws;
    void* args[] = {&p};
    hipError_t e = hipLaunchCooperativeKernel((const void*)fwd_megakernel, dim3(grid), dim3(512), args, LDS_BYTES, stream);
    if (e != hipSuccess) fprintf(stderr, "cooperative launch failed: %s (grid %d)\n", hipGetErrorString(e), grid);
}
```

```cpp
#include <hip/hip_runtime.h>
#include <hip/hip_cooperative_groups.h>
#include <cstdio>
#include <cstdint>
#include <cmath>
namespace cg = cooperative_groups;
namespace pg8 {
#define PG8_LAS __attribute__((address_space(3)))
typedef unsigned short bf16_t;
typedef short bf16x8 __attribute__((ext_vector_type(8)));
typedef float f32x4 __attribute__((ext_vector_type(4)));
typedef unsigned u32x4 __attribute__((ext_vector_type(4)));
constexpr int BM = 256, BK = 64, HALF = 128, HTB = HALF * BK * 2  , STAGE_BYTES = 8 * HTB, NXCD = 8, WGM = 8;

__host__ __device__ __forceinline__ int lds_byte(int r, int c) { const int st = (r >> 4) * 2 + (c >> 5), rr = r & 15, cc = c & 31, ob = rr * 64 + cc * 2; return st * 1024 + (ob ^ (((ob >> 9) & 1) << 5)); }
__host__ __device__ __forceinline__ void stage_rc(int b, int& R, int& C) { const int st = b / 1024, sb = b % 1024, swz = sb ^ (((sb >> 9) & 1) << 5); R = (st >> 1) * 16 + swz / 64; C = (st & 1) * 32 + (swz % 64) / 2; }
__host__ __device__ __forceinline__ int perm32(int rho) { const int n = rho >> 4, i = rho & 15; return 8 * (i >> 2) + 4 * n + (i & 3); }

struct Unit { int pm, pn; };
struct Gemm { const bf16_t* A; const bf16_t* Bt; int M, N, K; };

struct StaticOrder {
    int nM, nN, nwg, G, c;
    __host__ __device__ void init(int M, int N, int G_, int c_) { nM = M / BM; nN = N / BM; nwg = nM * nN; G = G_; c = c_; }
    __host__ __device__ bool next(int i, Unit& u) const {
        const long L = (long)i * G + c; if (L >= nwg) return false;
        int wgid = (int)L; { const int q = nwg / NXCD, r = nwg % NXCD, xcd = wgid % NXCD, off = wgid / NXCD; wgid = (xcd < r ? xcd * (q + 1) : r * (q + 1) + (xcd - r) * q) + off; }
        const int nig = WGM * nN, gid = wgid / nig, fm = gid * WGM, gsz = (nM - fm) < WGM ? (nM - fm) : WGM;
        u.pm = fm + ((wgid % nig) % gsz); u.pn = (wgid % nig) / gsz; return true;
    }
    __device__ __forceinline__ void a_ready(const Unit&) const {}
    __device__ __forceinline__ void done(const Unit&) const {}
};

__device__ __forceinline__ unsigned cvt_pk_bf16(float lo, float hi) { unsigned r; asm volatile("v_cvt_pk_bf16_f32 %0, %1, %2" : "=v"(r) : "v"(lo), "v"(hi)); return r; }
typedef float f32x2 __attribute__((ext_vector_type(2)));
__device__ __forceinline__ f32x2 gelu_pk(f32x2 v) {
    const f32x2 av = __builtin_elementwise_abs(v), d = av * 0.2316418882f + 1.0f;
    f32x2 t; t.x = __builtin_amdgcn_rcpf(d.x); t.y = __builtin_amdgcn_rcpf(d.y);
    f32x2 q = t * 0.5307027145f + (-0.7265760135f); q = q * t + 0.7107068705f; q = q * t + (-0.142248368f); q = q * t + 0.127414796f; q = q * t;
    const f32x2 s = (v * v) * (-0.72134752044f);
    f32x2 e; e.x = __builtin_amdgcn_exp2f(s.x); e.y = __builtin_amdgcn_exp2f(s.y);
    const f32x2 m = v * (q * e), r = v - m;
    f32x2 o; o.x = v.x < 0.f ? m.x : r.x; o.y = v.y < 0.f ? m.y : r.y; return o;
}

template <int ACT  > struct EpiBf16 {
    static constexpr bool PERM = true, AFTER_DRAIN = false; static_assert(ACT == 0 || ACT == 1, "EpiBf16: ACT is 0 (none) or 1 (gelu_pk)");
    bf16_t* O; int ldc; const float* bias; int split_cols; size_t split_stride; float scale0;
    __device__ __forceinline__ void operator()(const f32x4 (&acc)[2][2][4][2], const Unit& u, int wr, int wc, int fr, int fq) const {
        const int row0 = u.pm * BM + wr * 64 + fr; int colt = u.pn * BM; bf16_t* base = O;
        float sc = 1.f; if (split_cols) { const int t = colt / split_cols; base += (size_t)t * split_stride; colt -= t * split_cols; if (t == 0) sc = scale0; }
        const int col0 = colt + wc * 32 + 8 * fq, bcol0 = u.pn * BM + wc * 32 + 8 * fq;
        f32x4 bv[2][2];
#pragma unroll
        for (int bj = 0; bj < 2; ++bj)
#pragma unroll
            for (int n = 0; n < 2; ++n) bv[bj][n] = bias ? *(const f32x4*)(bias + bcol0 + bj * HALF + 4 * n) : (f32x4){0.f, 0.f, 0.f, 0.f};
#pragma unroll
        for (int ai = 0; ai < 2; ++ai)
#pragma unroll
            for (int m = 0; m < 4; ++m) { bf16_t* rowp = base + (size_t)(row0 + ai * HALF + m * 16) * ldc + col0;
#pragma unroll
                for (int bj = 0; bj < 2; ++bj) { f32x4 v0 = acc[ai][bj][m][0] + bv[bj][0], v1 = acc[ai][bj][m][1] + bv[bj][1];
                    if (ACT == 1) { f32x2 a = gelu_pk((f32x2){v0[0], v0[1]}), b = gelu_pk((f32x2){v0[2], v0[3]}), c = gelu_pk((f32x2){v1[0], v1[1]}), d = gelu_pk((f32x2){v1[2], v1[3]});
                        v0 = (f32x4){a.x, a.y, b.x, b.y}; v1 = (f32x4){c.x, c.y, d.x, d.y}; }
                    v0 = v0 * sc; v1 = v1 * sc; u32x4 w; w.x = cvt_pk_bf16(v0[0], v0[1]); w.y = cvt_pk_bf16(v0[2], v0[3]); w.z = cvt_pk_bf16(v1[0], v1[1]); w.w = cvt_pk_bf16(v1[2], v1[3]);
                    *(u32x4*)(rowp + bj * HALF) = w; } }
    }
};
template <class Epi, class Sched, bool ALIGN_EPI = false, bool SP2 = false>
__device__ __forceinline__ void gemm_phase(PG8_LAS unsigned char* lds, const Gemm g, const Sched& S, const Epi& E) {
    const int tid = threadIdx.x, wid = __builtin_amdgcn_readfirstlane(tid >> 6), lane = tid & 63, wr = wid >> 2, wc = wid & 3, fr = lane & 15, fq = lane >> 4;
    const int K = g.K, nt = K / BK;
    unsigned voffA[2], voffB[2];
#pragma unroll
    for (int i = 0; i < 2; ++i) { int R, C; stage_rc(tid * 16 + i * 8192, R, C); const int Rb = Epi::PERM ? ((R & ~31) + perm32(R & 31)) : R;
        voffA[i] = (unsigned)(R * K + C) * 2u; voffB[i] = (unsigned)(Rb * K + C) * 2u; }
    const size_t kstep = (size_t)(BK * 2);
    const size_t hstep = (size_t)HALF * K * 2;
    const size_t tstep = 2 * hstep;
    const unsigned ldsw = (unsigned)wid * 1024u;
    const int aoff = lds_byte(wr * 64 + fr, fq * 8), boff = lds_byte(wc * 32 + fr, fq * 8);
#define PG8_SA(b, h) (((b) * 2 + (h)) * HTB)
#define PG8_SB(b, h) ((4 + (b) * 2 + (h)) * HTB)
#define PG8_STAGE(bufoff, gbase, voff) do { _Pragma("unroll") for (int _i = 0; _i < 2; ++_i) \
        __builtin_amdgcn_global_load_lds((const unsigned*)((const char*)(gbase) + (voff)[_i]), (PG8_LAS unsigned*)(lds + (bufoff) + ldsw + _i * 8192), 16, 0, 0); } while (0)
#define PG8_LDA(dst, b, h) do { _Pragma("unroll") for (int m = 0; m < 4; ++m) _Pragma("unroll") for (int k = 0; k < 2; ++k) dst[m][k] = *(const PG8_LAS bf16x8*)(lds + PG8_SA(b, h) + aoff + m * 2048 + k * 1024); } while (0)
#define PG8_LDB(dst, b, h) do { _Pragma("unroll") for (int n = 0; n < 2; ++n) _Pragma("unroll") for (int k = 0; k < 2; ++k) dst[n][k] = *(const PG8_LAS bf16x8*)(lds + PG8_SB(b, h) + boff + n * 2048 + k * 1024); } while (0)
#define PG8_MMA(ai, bj, At, Bt) do { __builtin_amdgcn_s_setprio(1); _Pragma("unroll") for (int m = 0; m < 4; ++m) _Pragma("unroll") for (int n = 0; n < 2; ++n) _Pragma("unroll") for (int k = 0; k < 2; ++k) \
        acc[ai][bj][m][n] = __builtin_amdgcn_mfma_f32_16x16x32_bf16(Bt[n][k], At[m][k], acc[ai][bj][m][n], 0, 0, 0); __builtin_amdgcn_s_setprio(0); } while (0)
#define PG8_WAIT_V(n) asm volatile("s_waitcnt vmcnt(" #n ")" ::: "memory")
#define PG8_WAIT_L(n) asm volatile("s_waitcnt lgkmcnt(" #n ")" ::: "memory")
#define PG8_BAR __builtin_amdgcn_s_barrier()
#define PG8_SCHED __builtin_amdgcn_sched_barrier(0)
    Unit cur, nxt; int ui = 0;
    if (!S.next(0, cur)) return;
    f32x4 acc[2][2][4][2];
#pragma unroll
    for (int a = 0; a < 2; ++a)
#pragma unroll
        for (int b = 0; b < 2; ++b)
#pragma unroll
            for (int m = 0; m < 4; ++m)
#pragma unroll
                for (int n = 0; n < 2; ++n) acc[a][b][m][n] = (f32x4){0.f, 0.f, 0.f, 0.f};
    bf16x8 At[4][2], B0[2][2], B1[2][2];
    const char* cA = (const char*)g.A + (size_t)cur.pm * tstep; const char* cB = (const char*)g.Bt + (size_t)cur.pn * tstep;
    S.a_ready(cur);
    if constexpr (SP2) {
        PG8_STAGE(PG8_SB(0, 0), cB, voffB); PG8_STAGE(PG8_SB(0, 1), cB + hstep, voffB); PG8_STAGE(PG8_SA(0, 0), cA, voffA); PG8_STAGE(PG8_SA(0, 1), cA + hstep, voffA);
        if (wr == 1) PG8_BAR;
        PG8_WAIT_V(2); PG8_BAR;
        PG8_STAGE(PG8_SB(1, 0), cB + kstep, voffB); PG8_STAGE(PG8_SA(1, 0), cA + kstep, voffA); PG8_STAGE(PG8_SB(1, 1), cB + hstep + kstep, voffB);
        PG8_WAIT_V(6); PG8_BAR;
    } else {
        PG8_STAGE(PG8_SB(0, 0), cB, voffB); PG8_STAGE(PG8_SA(0, 0), cA, voffA); PG8_STAGE(PG8_SB(0, 1), cB + hstep, voffB); PG8_STAGE(PG8_SA(0, 1), cA + hstep, voffA);
        if (wr == 1) PG8_BAR;
        PG8_WAIT_V(4); PG8_BAR;
        PG8_STAGE(PG8_SB(1, 0), cB + kstep, voffB); PG8_STAGE(PG8_SA(1, 0), cA + kstep, voffA); PG8_STAGE(PG8_SB(1, 1), cB + hstep + kstep, voffB);
        PG8_WAIT_V(6); PG8_BAR;
    }
    for (;;) {
        const bool has_next = S.next(ui + 1, nxt);
        const char* nA = has_next ? (const char*)g.A + (size_t)nxt.pm * tstep : cA; const char* nB = has_next ? (const char*)g.Bt + (size_t)nxt.pn * tstep : cB;
        for (int t = 0; t < nt; t += 2) {
            const bool last = (t == nt - 2);
            const char* a1 = cA + (size_t)(t + 1) * kstep;
            const char* a2 = last ? nA : cA + (size_t)(t + 2) * kstep; const char* b2 = last ? nB : cB + (size_t)(t + 2) * kstep;
            const char* a3 = a2 + kstep; const char* b3 = b2 + kstep;
            if (last && has_next) S.a_ready(nxt);
            if constexpr (SP2) {
            PG8_LDB(B0, 0, 0); PG8_LDB(B1, 0, 1); PG8_SCHED; PG8_LDA(At, 0, 0); PG8_STAGE(PG8_SA(1, 1), a1 + hstep, voffA);
            PG8_WAIT_V(8); PG8_WAIT_L(0); PG8_BAR; PG8_MMA(0, 0, At, B0); PG8_MMA(0, 1, At, B1); PG8_BAR; PG8_SCHED;
            PG8_LDA(At, 0, 1); PG8_STAGE(PG8_SB(0, 0), b2, voffB); PG8_STAGE(PG8_SB(0, 1), b2 + hstep, voffB); PG8_STAGE(PG8_SA(0, 0), a2, voffA);
            PG8_WAIT_V(8); PG8_WAIT_L(0); PG8_BAR; PG8_MMA(1, 0, At, B0); PG8_MMA(1, 1, At, B1); PG8_BAR; PG8_SCHED;
            PG8_LDB(B0, 1, 0); PG8_LDB(B1, 1, 1); PG8_SCHED; PG8_LDA(At, 1, 0); PG8_STAGE(PG8_SA(0, 1), a2 + hstep, voffA);
            PG8_WAIT_V(8); PG8_WAIT_L(0); PG8_BAR; PG8_MMA(0, 0, At, B0); PG8_MMA(0, 1, At, B1); PG8_BAR; PG8_SCHED;
            PG8_LDA(At, 1, 1); PG8_STAGE(PG8_SB(1, 0), b3, voffB); PG8_STAGE(PG8_SB(1, 1), b3 + hstep, voffB); PG8_STAGE(PG8_SA(1, 0), a3, voffA);
            PG8_WAIT_V(8); PG8_WAIT_L(0); PG8_BAR; PG8_MMA(1, 0, At, B0); PG8_MMA(1, 1, At, B1); PG8_BAR; PG8_SCHED;
            } else {
            PG8_LDB(B0, 0, 0); PG8_SCHED; PG8_LDA(At, 0, 0); PG8_STAGE(PG8_SA(1, 1), a1 + hstep, voffA);
            PG8_WAIT_L(8); PG8_BAR; PG8_WAIT_L(0); PG8_MMA(0, 0, At, B0); PG8_BAR; PG8_SCHED;
            PG8_LDB(B1, 0, 1); PG8_STAGE(PG8_SB(0, 0), b2, voffB);
            PG8_BAR; PG8_WAIT_L(0); PG8_MMA(0, 1, At, B1); PG8_BAR;
            PG8_LDA(At, 0, 1); PG8_STAGE(PG8_SA(0, 0), a2, voffA);
            PG8_BAR; PG8_WAIT_L(0); PG8_MMA(1, 0, At, B0); PG8_BAR; PG8_SCHED;
            PG8_STAGE(PG8_SB(0, 1), b2 + hstep, voffB);
            PG8_WAIT_V(6); PG8_BAR; PG8_MMA(1, 1, At, B1); PG8_BAR;
            PG8_LDB(B0, 1, 0); PG8_SCHED; PG8_LDA(At, 1, 0); PG8_STAGE(PG8_SA(0, 1), a2 + hstep, voffA);
            PG8_WAIT_L(8); PG8_BAR; PG8_WAIT_L(0); PG8_MMA(0, 0, At, B0); PG8_BAR; PG8_SCHED;
            PG8_LDB(B1, 1, 1); PG8_STAGE(PG8_SB(1, 0), b3, voffB);
            PG8_BAR; PG8_WAIT_L(0); PG8_MMA(0, 1, At, B1); PG8_BAR;
            PG8_LDA(At, 1, 1); PG8_STAGE(PG8_SA(1, 0), a3, voffA);
            PG8_BAR; PG8_WAIT_L(0); PG8_MMA(1, 0, At, B0); PG8_BAR; PG8_SCHED;
            PG8_STAGE(PG8_SB(1, 1), b3 + hstep, voffB);
            PG8_WAIT_V(6); PG8_BAR; PG8_MMA(1, 1, At, B1); PG8_BAR;
            }
        }
        if constexpr (ALIGN_EPI) { if (wr == 0) PG8_BAR; }
        if constexpr (!Epi::AFTER_DRAIN) { E(acc, cur, wr, wc, fr, fq); S.done(cur); }
        if (!has_next) break;
#pragma unroll
        for (int a = 0; a < 2; ++a)
#pragma unroll
            for (int b = 0; b < 2; ++b)
#pragma unroll
                for (int m = 0; m < 4; ++m)
#pragma unroll
                    for (int n = 0; n < 2; ++n) acc[a][b][m][n] = (f32x4){0.f, 0.f, 0.f, 0.f};
        cur = nxt; cA = nA; cB = nB; ++ui;
        if constexpr (ALIGN_EPI) { if (wr == 1) PG8_BAR; }
    }
    PG8_WAIT_V(0);
    if constexpr (!ALIGN_EPI) { if (wr == 0) PG8_BAR; }
    PG8_BAR;
    if constexpr (Epi::AFTER_DRAIN) { E.fused(acc, cur, wr, wc, fr, fq, lds, wid, lane); S.done(cur); }
#undef PG8_SA
#undef PG8_SB
#undef PG8_STAGE
#undef PG8_LDA
#undef PG8_LDB
#undef PG8_MMA
#undef PG8_WAIT_V
#undef PG8_WAIT_L
#undef PG8_BAR
#undef PG8_SCHED
}
}

#define LAS __attribute__((address_space(3)))
typedef unsigned short bf16_t;
typedef short bf16x8 __attribute__((ext_vector_type(8)));
typedef short s16x4 __attribute__((ext_vector_type(4)));
typedef float f32x4 __attribute__((ext_vector_type(4)));
typedef float f32x16 __attribute__((ext_vector_type(16)));
typedef unsigned u32x4 __attribute__((ext_vector_type(4)));
typedef unsigned u32x2 __attribute__((ext_vector_type(2)));

constexpr int DM = 1024;
constexpr int NP = 16 * 2048;
constexpr int NS = 8 * 64;
constexpr int NT = NP + NS;
constexpr int DIN = 2560;
constexpr int SKV = 2112;
constexpr float EPS = 1e-6f;
constexpr float LOG2E = 1.4426950408889634f;
constexpr float QSCALE = 0.125f * LOG2E;

constexpr long OUT_Y = 0;
constexpr long OUT_KP = 34078720L, OUT_VP = 50855936L, OUT_CONVP = 67633152L, OUT_KS = 67878912L, OUT_VS = 68141056L, OUT_CONVS = 68403200L, OUT_TOTAL = 68526080L;

constexpr size_t MiB = 1u << 20;
constexpr size_t WS_CTL = 0, CTL_BYTES = 1 * MiB;
constexpr size_t WS_WINT = 1 * MiB;
constexpr size_t WS_WOUTT = 6 * MiB;
constexpr size_t WS_WQT = 8 * MiB;
constexpr size_t WS_SK = 12 * MiB;
constexpr size_t WS_PU8 = 16 * MiB;
constexpr size_t WS_PV8 = 32 * MiB;
constexpr size_t WS_SCU = 48 * MiB;
constexpr size_t WS_SCV = 49 * MiB;
constexpr size_t WS_KS = 80 * MiB;
constexpr size_t WS_VS = 97 * MiB;
constexpr size_t WS_H = 114 * MiB;
constexpr size_t WS_A = 179 * MiB;
constexpr size_t WS_Q = 212 * MiB;
constexpr size_t WS_QP = 114 * MiB;
constexpr size_t WS_KP = 245 * MiB;
constexpr size_t WS_VP = 277 * MiB;
constexpr size_t WS_MIX = 309 * MiB;
constexpr size_t WS_H2 = 309 * MiB;
constexpr size_t WS_TK = 375 * MiB;
constexpr size_t WS_IDX = 408 * MiB;
constexpr size_t WS_GATE = 425 * MiB;
constexpr size_t WS_END = 442 * MiB;
static_assert(WS_H + (size_t)NT * 1024 * 2 <= WS_A && WS_A + (size_t)NT * 512 * 2 <= WS_Q && WS_Q + (size_t)NT * 512 * 2 <= WS_KP, "R1");
static_assert(WS_QP + (size_t)NT * 2048 * 2 <= WS_KP && WS_KP + (size_t)NP * 512 * 2 <= WS_VP && WS_VP + (size_t)NP * 512 * 2 <= WS_MIX, "ws map");
static_assert(WS_MIX + (size_t)NT * 1024 * 2 <= WS_TK && WS_TK + (size_t)NT * 256 * 4 <= WS_IDX && WS_IDX + (size_t)NT * 128 * 4 <= WS_GATE && WS_GATE + (size_t)NT * 128 * 4 <= WS_END, "ws map 2");
static_assert(WS_KS + (size_t)8 * SKV * 512 * 2 <= WS_VS && WS_VS + (size_t)8 * SKV * 512 * 2 <= WS_H, "ws map 3");

constexpr int RING_BYTES = 131072;
constexpr int MISC_OFF = RING_BYTES;
constexpr int LDS_BYTES = RING_BYTES + 1024;

struct Params {
    const float* in[24];
    float* out;
    unsigned char* ws;
};

__device__ __forceinline__ unsigned cvtpk(float lo, float hi) { return pg8::cvt_pk_bf16(lo, hi); }
__device__ __forceinline__ float bflo(unsigned w) { return __uint_as_float(w << 16); }
__device__ __forceinline__ float bfhi(unsigned w) { return __uint_as_float(w & 0xffff0000u); }
__device__ __forceinline__ float wave_sum(float v) {
#pragma unroll
    for (int o = 1; o < 64; o <<= 1) v += __shfl_xor(v, o);
    return v;
}
typedef __bf16 bf16x2_t __attribute__((ext_vector_type(2)));
__device__ __forceinline__ float dot2(unsigned a, unsigned b, float acc) {
    return __builtin_amdgcn_fdot2_f32_bf16(__builtin_bit_cast(bf16x2_t, a), __builtin_bit_cast(bf16x2_t, b), acc, false);
}
#define LDS_WAIT() asm volatile("s_waitcnt lgkmcnt(0)" ::: "memory")

#define XB_TMO      128
#define XB_XCNT(j)  (256  + 64 * (j))
#define XB_XSUB(j)  (1280 + 64 * (j))
#define XB_XGEN(j)  (2304 + 64 * (j))
#define XB_TOP      3328
#define XB_TOPGEN   3392
#define XCD_BAR_WORDS 3456
#define XB_SPIN_CAP (1u << 18)

__device__ __forceinline__ unsigned xb_ld(unsigned* p)              { return __hip_atomic_load(p, __ATOMIC_RELAXED, __HIP_MEMORY_SCOPE_AGENT); }
__device__ __forceinline__ unsigned xb_add(unsigned* p, unsigned v) { return __hip_atomic_fetch_add(p, v, __ATOMIC_RELAXED, __HIP_MEMORY_SCOPE_AGENT); }
__device__ __forceinline__ unsigned xb_xcc_id() { return (unsigned)__builtin_amdgcn_s_getreg((3 << 11) | 20) & 0xFu; }
#define XB_SPIN(cond, bar) do { unsigned _sp = 0; while (cond) { __builtin_amdgcn_s_sleep(1); \
    if ((++_sp & 255u) == 0u) { if (xb_ld(&(bar)[XB_TMO])) break; if (_sp > XB_SPIN_CAP) { atomicAdd(&(bar)[XB_TMO], 1u); break; } } } } while (0)

struct XcdBarrier {
    unsigned* bar; unsigned x;
    volatile LAS unsigned* st;
};

__device__ __forceinline__ XcdBarrier xcd_barrier_post(unsigned* bar, volatile LAS unsigned* st) {
    XcdBarrier b; b.bar = bar; b.x = xb_xcc_id(); b.st = st;
    if (threadIdx.x == 0) (void)xb_add(&bar[XB_XCNT(b.x)], 1u);
    return b;
}
__device__ __forceinline__ void xcd_barrier_complete(unsigned* bar, unsigned x, unsigned& nloc, unsigned& nx) {
    const unsigned G = gridDim.x * gridDim.y * gridDim.z;
    unsigned sum, cnt, mine, sp = 0u;
    for (;;) {
        sum = 0u; cnt = 0u; mine = 0u;
#pragma unroll
        for (unsigned j = 0; j < 16; ++j) { const unsigned c = xb_ld(&bar[XB_XCNT(j)]); sum += c; cnt += (c > 0u) ? 1u : 0u; mine = (j == x) ? c : mine; }
        if (sum == G) break;
        __builtin_amdgcn_s_sleep(1);
        if ((++sp & 255u) == 0u) { if (xb_ld(&bar[XB_TMO])) break; if (sp > XB_SPIN_CAP) { atomicAdd(&bar[XB_TMO], 1u); break; } }
    }
    nloc = mine > 0u ? mine : 1u; nx = cnt > 0u ? cnt : 1u;
}

__device__ __forceinline__ void xcd_barrier(const XcdBarrier& b) {
    asm volatile("s_waitcnt vmcnt(0)" ::: "memory");
    __syncthreads();
    if (threadIdx.x == 0) {
        unsigned* bar = b.bar;
        __builtin_amdgcn_s_waitcnt(0);
        unsigned nloc = b.st[0], nx = b.st[1];
        if (nloc == 0u) { xcd_barrier_complete(bar, b.x, nloc, nx); b.st[0] = nloc; b.st[1] = nx; }
        const unsigned old = xb_add(&bar[XB_XSUB(b.x)], 1u);
        const unsigned gen = old / nloc;
        if (old + 1u == (gen + 1u) * nloc) {
            __builtin_amdgcn_fence(__ATOMIC_RELEASE, "agent");
            asm volatile("s_waitcnt vmcnt(0)" ::: "memory");
            const unsigned og = xb_add(&bar[XB_TOP], 1u);
            const unsigned tg = og / nx;
            if (og + 1u == (tg + 1u) * nx) xb_add(&bar[XB_TOPGEN], 1u);
            else XB_SPIN(xb_ld(&bar[XB_TOPGEN]) == tg, bar);
            __builtin_amdgcn_fence(__ATOMIC_ACQUIRE, "agent");
            xb_add(&bar[XB_XGEN(b.x)], 1u);
            asm volatile("s_waitcnt vmcnt(0)" ::: "memory");
        } else {
            XB_SPIN(xb_ld(&bar[XB_XGEN(b.x)]) == gen, bar);
            __builtin_amdgcn_fence(__ATOMIC_ACQUIRE, "agent");
            asm volatile("s_waitcnt vmcnt(0)" ::: "memory");
        }
    }
    __syncthreads();
}


namespace pg8 {
__device__ __forceinline__ u32x2 pack4(f32x4 v) { u32x2 w; w.x = cvt_pk_bf16(v[0], v[1]); w.y = cvt_pk_bf16(v[2], v[3]); return w; }
struct EpiProj {
    static constexpr bool PERM = false, AFTER_DRAIN = false;
    bf16_t* A; bf16_t* Q; bf16_t* KP; bf16_t* VP; bf16_t* KS; bf16_t* VS; float* out;
    __device__ __forceinline__ void operator()(const f32x4 (&acc)[2][2][4][2], const Unit& u, int wr, int wc, int fr, int fq) const {
        const int pn = u.pn;
        const int row0 = u.pm * BM + wr * 64 + fr;
        if (pn < 4) {
#pragma unroll
            for (int ai = 0; ai < 2; ++ai)
#pragma unroll
                for (int m = 0; m < 4; ++m) {
                    const int row = row0 + ai * HALF + m * 16;
                    long toff = -1;
                    if (row < NP) { const int s = row & 2047; if (s >= 2018) toff = OUT_CONVP + ((long)(row >> 11) * 30 + (s - 2018)) * 512; }
                    else { const int rr = row - NP; const int i = rr & 63; if (i >= 34) toff = OUT_CONVS + ((long)(rr >> 6) * 30 + (i - 34)) * 512; }
#pragma unroll
                    for (int n = 0; n < 2; ++n) {
                        const int c = 128 * pn + 32 * wc + 16 * n + 4 * fq;
                        const f32x4 x = acc[ai][0][m][n], g = acc[ai][1][m][n];
                        f32x4 a;
#pragma unroll
                        for (int j = 0; j < 4; ++j) a[j] = x[j] / (1.f + __expf(-g[j]));
                        *(u32x2*)(A + (size_t)row * 512 + c) = pack4(a);
                        if (toff >= 0) *(f32x4*)(out + toff + c) = a;
                    }
                }
        } else {
            const int sec = (pn - 4) >> 1, colbase = ((pn - 4) & 1) * 256;
#pragma unroll
            for (int ai = 0; ai < 2; ++ai)
#pragma unroll
                for (int m = 0; m < 4; ++m) {
                    const int row = row0 + ai * HALF + m * 16;
                    const bool isp = row < NP; const int rr = row - NP;
                    bf16_t* bdst; float* fdst;
                    if (sec == 0) { bdst = Q + (size_t)row * 512; fdst = nullptr; }
                    else if (sec == 1) { bdst = isp ? KP + (size_t)row * 512 : KS + ((size_t)(rr >> 6) * SKV + 2048 + (rr & 63)) * 512; fdst = isp ? out + OUT_KP + (size_t)row * 512 : out + OUT_KS + (size_t)rr * 512; }
                    else { bdst = isp ? VP + (size_t)row * 512 : VS + ((size_t)(rr >> 6) * SKV + 2048 + (rr & 63)) * 512; fdst = isp ? out + OUT_VP + (size_t)row * 512 : out + OUT_VS + (size_t)rr * 512; }
#pragma unroll
                    for (int bj = 0; bj < 2; ++bj)
#pragma unroll
                        for (int n = 0; n < 2; ++n) {
                            const int col = colbase + 128 * bj + 32 * wc + 16 * n + 4 * fq;
                            const f32x4 v = acc[ai][bj][m][n];
                            if (sec == 0) { *(u32x2*)(bdst + col) = pack4(v * QSCALE); }
                            else { *(u32x2*)(bdst + col) = pack4(v); *(f32x4*)(fdst + col) = v; }
                        }
                }
        }
    }
};
struct EpiRes {
    static constexpr bool PERM = false, AFTER_DRAIN = false;
    const float* xp; const float* xs; float* out;
    __device__ __forceinline__ void operator()(const f32x4 (&acc)[2][2][4][2], const Unit& u, int wr, int wc, int fr, int fq) const {
        const int row0 = u.pm * BM + wr * 64 + fr;
#pragma unroll
        for (int ai = 0; ai < 2; ++ai)
#pragma unroll
            for (int m = 0; m < 4; ++m) {
                const int row = row0 + ai * HALF + m * 16;
                const float* xr = row < NP ? xp + (size_t)row * DM : xs + (size_t)(row - NP) * DM;
                float* orow = out + (size_t)row * DM;
#pragma unroll
                for (int bj = 0; bj < 2; ++bj)
#pragma unroll
                    for (int n = 0; n < 2; ++n) {
                        const int col = u.pn * BM + 128 * bj + 32 * wc + 16 * n + 4 * fq;
                        *(f32x4*)(orow + col) = *(const f32x4*)(xr + col) + acc[ai][bj][m][n];
                    }
            }
    }
};
}

__device__ __forceinline__ int winrow(int n) { return n < 1024 ? (256 * ((n & 511) >> 7) + 128 * (n >> 9) + (n & 127)) : n; }
template <bool WIN> __device__ __forceinline__ void transpose_item(const float* W, int K, int N, bf16_t* WT, LAS float* scr, int item, int lane) {
    const int nblk = N / 32, kb = item / nblk, nb = item % nblk, k0 = 64 * kb, n0 = 32 * nb;
#pragma unroll 8
    for (int i = 0; i < 32; ++i) { const int kk = 2 * i + (lane >> 5); scr[kk * 33 + (lane & 31)] = W[(size_t)(k0 + kk) * N + n0 + (lane & 31)]; }
    LDS_WAIT();
    const int c = lane & 7;
#pragma unroll
    for (int j = 0; j < 4; ++j) {
        const int n = (lane >> 3) + 8 * j; const LAS float* s = scr + (8 * c) * 33 + n;
        u32x4 o; o.x = cvtpk(s[0 * 33], s[1 * 33]); o.y = cvtpk(s[2 * 33], s[3 * 33]); o.z = cvtpk(s[4 * 33], s[5 * 33]); o.w = cvtpk(s[6 * 33], s[7 * 33]);
        const int dr = WIN ? winrow(n0 + n) : (n0 + n);
        *(u32x4*)(WT + (size_t)dr * K + k0 + 8 * c) = o;
    }
    LDS_WAIT();
}
__device__ __forceinline__ void cvt_stream(const float* src, bf16_t* dst, size_t n8, size_t gt, size_t ngt) {
    for (size_t i = gt; i < n8; i += ngt) {
        const f32x4 a = *(const f32x4*)(src + i * 8), b = *(const f32x4*)(src + i * 8 + 4);
        u32x4 o; o.x = cvtpk(a[0], a[1]); o.y = cvtpk(a[2], a[3]); o.z = cvtpk(b[0], b[1]); o.w = cvtpk(b[2], b[3]);
        *(u32x4*)(dst + i * 8) = o;
    }
}
__device__ __forceinline__ void cvt_cache(const float* src, bf16_t* dst, size_t gt, size_t ngt) {
    const size_t n8 = (size_t)8 * 2048 * 512 / 8;
    for (size_t i = gt; i < n8; i += ngt) {
        const size_t e = i * 8; const size_t row = e >> 9, col = e & 511; const size_t drow = (row >> 11) * SKV + (row & 2047);
        const f32x4 a = *(const f32x4*)(src + e), b = *(const f32x4*)(src + e + 4);
        u32x4 o; o.x = cvtpk(a[0], a[1]); o.y = cvtpk(a[2], a[3]); o.z = cvtpk(b[0], b[1]); o.w = cvtpk(b[2], b[3]);
        *(u32x4*)(dst + drow * 512 + col) = o;
    }
}
__device__ __forceinline__ void rms_row_bf16(const float* xrow, const float* g, bf16_t* orow, int lane) {
    const f32x4* xr = (const f32x4*)xrow + lane; const f32x4* gr = (const f32x4*)g + lane;
    f32x4 v[4]; float s = 0.f;
#pragma unroll
    for (int j = 0; j < 4; ++j) { v[j] = xr[64 * j]; s += (v[j][0] * v[j][0] + v[j][1] * v[j][1]) + (v[j][2] * v[j][2] + v[j][3] * v[j][3]); }
    const float rstd = 1.f / sqrtf(wave_sum(s) * (1.f / DM) + EPS);
    u32x2* o8 = (u32x2*)orow + lane;
#pragma unroll
    for (int j = 0; j < 4; ++j) { const f32x4 gg = gr[64 * j]; u32x2 w; w.x = cvtpk(v[j][0] * rstd * gg[0], v[j][1] * rstd * gg[1]); w.y = cvtpk(v[j][2] * rstd * gg[2], v[j][3] * rstd * gg[3]); o8[64 * j] = w; }
}

__device__ __forceinline__ void cvt_row_fp8(const float* src, unsigned char* dst, float* scale_out, int lane) {
    const f32x4* xr = (const f32x4*)src + lane;
    f32x4 v[4]; float am = 0.f;
#pragma unroll
    for (int j = 0; j < 4; ++j) { v[j] = xr[64 * j]; am = fmaxf(am, fmaxf(fmaxf(fabsf(v[j][0]), fabsf(v[j][1])), fmaxf(fabsf(v[j][2]), fabsf(v[j][3])))); }
#pragma unroll
    for (int o = 1; o < 64; o <<= 1) am = fmaxf(am, __shfl_xor(am, o));
    const float sc = am > 0.f ? am * (1.f / 448.f) : 1.f, inv = 1.f / sc;
#pragma unroll
    for (int j = 0; j < 4; ++j) {
        const int eb = 256 * j + 4 * lane;
        const int pos = 16 * ((eb & 511) >> 3) + (eb & 7) + (eb >= 512 ? 8 : 0);
        int w = __builtin_amdgcn_cvt_pk_fp8_f32(v[j][0] * inv, v[j][1] * inv, 0, false);
        w = __builtin_amdgcn_cvt_pk_fp8_f32(v[j][2] * inv, v[j][3] * inv, w, true);
        *(int*)(dst + pos) = w;
    }
    if (lane == 0) *scale_out = sc;
}

__device__ __forceinline__ void phase0(const Params& p, LAS unsigned char* lds, int tid, int lane, int wave) {
    const int gw = blockIdx.x * 8 + wave, NGW = gridDim.x * 8;
    LAS float* scr = (LAS float*)(lds + wave * 16384);
    bf16_t* WINT = (bf16_t*)(p.ws + WS_WINT); bf16_t* WOUTT = (bf16_t*)(p.ws + WS_WOUTT); bf16_t* WQT = (bf16_t*)(p.ws + WS_WQT);
    constexpr int I_IN = 16 * (DIN / 32), I_OUT = 16 * (1024 / 32), I_Q = 16 * (2048 / 32);
    for (int it = gw; it < I_IN + I_OUT + I_Q; it += NGW) {
        int r = it;
        if (r < I_IN) { transpose_item<true>(p.in[6], 1024, DIN, WINT, scr, r, lane); continue; } r -= I_IN;
        if (r < I_OUT) { transpose_item<false>(p.in[17], 1024, 1024, WOUTT, scr, r, lane); continue; } r -= I_OUT;
        transpose_item<false>(p.in[19], 1024, 2048, WQT, scr, r, lane);
    }
    const size_t gt = (size_t)blockIdx.x * 512 + tid, ngt = (size_t)gridDim.x * 512;
    for (int r = gw; r < 2 * 16384; r += NGW) {
        const int tb = r >> 14, e = r & 16383;
        cvt_row_fp8((tb ? p.in[22] : p.in[21]) + (size_t)e * DM, p.ws + (tb ? WS_PV8 : WS_PU8) + (size_t)e * DM, (float*)(p.ws + (tb ? WS_SCV : WS_SCU)) + e, lane);
    }
    cvt_stream(p.in[20], (bf16_t*)(p.ws + WS_SK), (size_t)16 * 128 * 128 / 8, gt, ngt);
    cvt_cache(p.in[2], (bf16_t*)(p.ws + WS_KS), gt, ngt);
    cvt_cache(p.in[3], (bf16_t*)(p.ws + WS_VS), gt, ngt);
    bf16_t* H = (bf16_t*)(p.ws + WS_H);
    for (int m = gw; m < NT; m += NGW) {
        const float* xr = m < NP ? p.in[0] + (size_t)m * DM : p.in[1] + (size_t)(m - NP) * DM;
        rms_row_bf16(xr, p.in[5], H + (size_t)m * DM, lane);
    }
}

namespace att {
constexpr int KPITCH = 272, VPITCH = 320;
constexpr int L_K = 0, L_V = 17408, L_BIAS = 37888, L_X = 43008, L_END = 108544;
static_assert(L_V == 64 * KPITCH && L_BIAS == L_V + 64 * VPITCH && L_X == L_BIAS + 4 * 320 * 4 && L_END == L_X + 4 * 4096 * 4 && L_END <= RING_BYTES, "attention LDS map");

__device__ __forceinline__ int rel_bucket(int rel) {
    const int ret = rel > 0 ? 16 : 0; const int n = rel < 0 ? -rel : rel; int v;
    if (n < 8) v = n; else if (n < 12) v = 8; else if (n < 16) v = 9; else if (n < 23) v = 10; else if (n < 32) v = 11;
    else if (n < 46) v = 12; else if (n < 64) v = 13; else if (n < 91) v = 14; else v = 15;
    return ret + v;
}
typedef short v4i16_t __attribute__((ext_vector_type(4)));
__device__ __forceinline__ s16x4 vtr(const LAS unsigned char* p) { return __builtin_bit_cast(s16x4, __builtin_amdgcn_ds_read_tr16_b64_v4i16((LAS v4i16_t*)p)); }
__device__ __forceinline__ f32x16 mfma32(bf16x8 a, bf16x8 b, f32x16 c) { return __builtin_amdgcn_mfma_f32_32x32x16_bf16(a, b, c, 0, 0, 0); }

__device__ __forceinline__ void attn_unit(const Params& p, LAS unsigned char* lds, int kind, int bb, int h, int qblk, float lam, int tid, int lane, int wid) {
    const bf16_t* Q = (const bf16_t*)(p.ws + WS_Q);
    const bf16_t* Kb = kind == 0 ? (const bf16_t*)(p.ws + WS_KP) + (size_t)bb * 2048 * 512 + h * 128 : (const bf16_t*)(p.ws + WS_KS) + (size_t)bb * SKV * 512 + h * 128;
    const bf16_t* Vb = kind == 0 ? (const bf16_t*)(p.ws + WS_VP) + (size_t)bb * 2048 * 512 + h * 128 : (const bf16_t*)(p.ws + WS_VS) + (size_t)bb * SKV * 512 + h * 128;
    bf16_t* MIX = (bf16_t*)(p.ws + WS_MIX);
    const int qrow0 = kind == 0 ? bb * 2048 + qblk * 128 : NP + bb * 64;
    const int qpos0 = kind == 0 ? qblk * 128 : 2048;
    const int ntiles = kind == 0 ? 2 * qblk + 2 : 33;
    const int rg = wid & 3, map = wid >> 2, r32 = lane & 31, hi = lane >> 5;
    const bool active = kind == 0 ? true : (rg < 2);
    const int cw = kind == 0 ? 2 * qblk + (rg >> 1) : 32;
    const int qw0 = qpos0 + 32 * rg;
    const int qabs = qw0 + r32;

    bf16x8 qf[4];
    if (active) {
        const bf16_t* qp = Q + (size_t)(qrow0 + 32 * rg + r32) * 512 + h * 128 + map * 64 + 8 * hi;
#pragma unroll
        for (int s = 0; s < 4; ++s) qf[s] = *(const bf16x8*)(qp + 16 * s);
    } else {
#pragma unroll
        for (int s = 0; s < 4; ++s) qf[s] = (bf16x8){0, 0, 0, 0, 0, 0, 0, 0};
    }
    float m = -1e30f, l = 0.f;
    f32x16 o[4];
#pragma unroll
    for (int mt = 0; mt < 4; ++mt)
#pragma unroll
        for (int r = 0; r < 16; ++r) o[mt][r] = 0.f;

    const int srow0 = tid >> 4, sch = tid & 15;
    u32x4 kreg[2], vreg[2];
#pragma unroll
    for (int i = 0; i < 2; ++i) { const size_t off = (size_t)(srow0 + 32 * i) * 512 + sch * 8; kreg[i] = *(const u32x4*)(Kb + off); vreg[i] = *(const u32x4*)(Vb + off); }
    const LAS float* btab = (const LAS float*)(lds + L_BIAS) + h * 320;
    const float biasfar = btab[0];
    const int vlane = (4 * hi + ((lane & 15) >> 2)) * VPITCH + (16 * ((lane >> 4) & 1) + 4 * (lane & 3)) * 2;

    for (int t = 0; t < ntiles; ++t) {
#pragma unroll
        for (int i = 0; i < 2; ++i) {
            *(LAS u32x4*)(lds + L_K + (srow0 + 32 * i) * KPITCH + sch * 16) = kreg[i];
            *(LAS u32x4*)(lds + L_V + (srow0 + 32 * i) * VPITCH + sch * 16) = vreg[i];
        }
        __syncthreads();
        if (t + 1 < ntiles) {
#pragma unroll
            for (int i = 0; i < 2; ++i) { const size_t off = (size_t)((t + 1) * 64 + srow0 + 32 * i) * 512 + sch * 8; kreg[i] = *(const u32x4*)(Kb + off); vreg[i] = *(const u32x4*)(Vb + off); }
        }
        if (active && t <= cw) {
            f32x16 p0, p1;
            const int kabs0 = t * 64;
            if (kabs0 + 63 - qw0 > -128) {
                const LAS float* bt = btab + (kabs0 - qabs + 256 + 4 * hi);
#pragma unroll
                for (int r = 0; r < 16; ++r) { p0[r] = bt[(r & 3) + 8 * (r >> 2)]; p1[r] = bt[32 + (r & 3) + 8 * (r >> 2)]; }
            } else {
#pragma unroll
                for (int r = 0; r < 16; ++r) { p0[r] = biasfar; p1[r] = biasfar; }
            }
            const LAS unsigned char* kb = lds + L_K + r32 * KPITCH + (map * 8 + hi) * 16;
#pragma unroll
            for (int s = 0; s < 4; ++s) {
                const bf16x8 a0 = *(const LAS bf16x8*)(kb + s * 32), a1 = *(const LAS bf16x8*)(kb + 32 * KPITCH + s * 32);
                p0 = mfma32(a0, qf[s], p0); p1 = mfma32(a1, qf[s], p1);
            }
            float mx = fmaxf(p0[0], p1[0]);
#pragma unroll
            for (int r = 1; r < 16; ++r) mx = fmaxf(mx, fmaxf(p0[r], p1[r]));
            mx = fmaxf(mx, __shfl_xor(mx, 32));
            const float mn = fmaxf(m, mx);
            const float alpha = __builtin_amdgcn_exp2f(m - mn);
            m = mn;
            float rs = 0.f;
#pragma unroll
            for (int r = 0; r < 16; ++r) { p0[r] = __builtin_amdgcn_exp2f(p0[r] - mn); p1[r] = __builtin_amdgcn_exp2f(p1[r] - mn); rs += p0[r] + p1[r]; }
            l = l * alpha + rs;
#pragma unroll
            for (int mt = 0; mt < 4; ++mt)
#pragma unroll
                for (int r = 0; r < 16; ++r) o[mt][r] *= alpha;
#pragma unroll
            for (int t2 = 0; t2 < 2; ++t2)
#pragma unroll
                for (int s = 0; s < 2; ++s) {
                    u32x4 bw;
                    if (t2 == 0) { bw.x = cvtpk(p0[8 * s + 0], p0[8 * s + 1]); bw.y = cvtpk(p0[8 * s + 2], p0[8 * s + 3]); bw.z = cvtpk(p0[8 * s + 4], p0[8 * s + 5]); bw.w = cvtpk(p0[8 * s + 6], p0[8 * s + 7]); }
                    else { bw.x = cvtpk(p1[8 * s + 0], p1[8 * s + 1]); bw.y = cvtpk(p1[8 * s + 2], p1[8 * s + 3]); bw.z = cvtpk(p1[8 * s + 4], p1[8 * s + 5]); bw.w = cvtpk(p1[8 * s + 6], p1[8 * s + 7]); }
                    const bf16x8 B = __builtin_bit_cast(bf16x8, bw);
                    const LAS unsigned char* vb = lds + L_V + vlane + (32 * t2 + 16 * s) * VPITCH;
#pragma unroll
                    for (int mt = 0; mt < 4; ++mt) {
                        const s16x4 lo = vtr(vb + mt * 64), hi8 = vtr(vb + mt * 64 + 8 * VPITCH);
                        const bf16x8 A = (bf16x8){lo[0], lo[1], lo[2], lo[3], hi8[0], hi8[1], hi8[2], hi8[3]};
                        o[mt] = mfma32(A, B, o[mt]);
                    }
                }
        }
        __syncthreads();
    }
    l += __shfl_xor(l, 32);
    const float inv = 1.f / l;
    LAS float* X = (LAS float*)(lds + L_X) + rg * 4096;
    if (active && map == 1) {
        const float sc = -lam * inv;
#pragma unroll
        for (int mt = 0; mt < 4; ++mt)
#pragma unroll
            for (int r = 0; r < 16; ++r) X[(mt * 16 + r) * 64 + lane] = o[mt][r] * sc;
    }
    __syncthreads();
    if (active && map == 0) {
        float ss = 0.f;
#pragma unroll
        for (int mt = 0; mt < 4; ++mt)
#pragma unroll
            for (int r = 0; r < 16; ++r) { const float v = o[mt][r] * inv + X[(mt * 16 + r) * 64 + lane]; o[mt][r] = v; ss += v * v; }
        ss += __shfl_xor(ss, 32);
        const float rsn = 0.8f / sqrtf(ss * (1.f / 128.f) + EPS);
        bf16_t* orow = MIX + (size_t)(qrow0 + 32 * rg + r32) * 1024 + 512 + h * 128;
        const float* sg = p.in[15];
#pragma unroll
        for (int mt = 0; mt < 4; ++mt)
#pragma unroll
            for (int g4 = 0; g4 < 4; ++g4) {
                const int e = 32 * mt + 8 * g4 + 4 * hi;
                const f32x4 gg = *(const f32x4*)(sg + e);
                u32x2 w; w.x = cvtpk(o[mt][4 * g4 + 0] * rsn * gg[0], o[mt][4 * g4 + 1] * rsn * gg[1]); w.y = cvtpk(o[mt][4 * g4 + 2] * rsn * gg[2], o[mt][4 * g4 + 3] * rsn * gg[3]);
                *(u32x2*)(orow + e) = w;
            }
    }
    __syncthreads();
}

__device__ __forceinline__ void conv_unit(const Params& p, int cu, int lane, int wid) {
    const bf16_t* A = (const bf16_t*)(p.ws + WS_A);
    bf16_t* MIX = (bf16_t*)(p.ws + WS_MIX);
    const float* cw = p.in[7]; const float* cb = p.in[8]; const float* lg = p.in[9]; const float* lb = p.in[10]; const float* st = p.in[4];
    const int c0 = lane * 8;
    for (int i = 0; i < 8; ++i) {
        const int row = cu * 64 + wid * 8 + i;
        const bool isp = row < NP;
        const int s = isp ? (row & 2047) : ((row - NP) & 63);
        const int rbase = row - s;
        const int bd = isp ? 0 : ((row - NP) >> 6);
        float acc[8];
        { const f32x4 b0 = *(const f32x4*)(cb + c0), b1 = *(const f32x4*)(cb + c0 + 4);
#pragma unroll
          for (int j = 0; j < 4; ++j) { acc[j] = b0[j]; acc[4 + j] = b1[j]; } }
        for (int j = 0; j < 31; ++j) {
            const int sp = s - 30 + j;
            float x[8];
            if (sp >= 0) {
                const u32x4 w = *(const u32x4*)(A + (size_t)(rbase + sp) * 512 + c0);
                x[0] = bflo(w.x); x[1] = bfhi(w.x); x[2] = bflo(w.y); x[3] = bfhi(w.y); x[4] = bflo(w.z); x[5] = bfhi(w.z); x[6] = bflo(w.w); x[7] = bfhi(w.w);
            } else if (!isp) {
                const float* sr = st + ((size_t)bd * 30 + (30 + sp)) * 512 + c0;
                const f32x4 a0 = *(const f32x4*)sr, a1 = *(const f32x4*)(sr + 4);
#pragma unroll
                for (int q = 0; q < 4; ++q) { x[q] = a0[q]; x[4 + q] = a1[q]; }
            } else continue;
            const f32x4 w0 = *(const f32x4*)(cw + (size_t)j * 512 + c0), w1 = *(const f32x4*)(cw + (size_t)j * 512 + c0 + 4);
#pragma unroll
            for (int q = 0; q < 4; ++q) { acc[q] += w0[q] * x[q]; acc[4 + q] += w1[q] * x[4 + q]; }
        }
        float sm = 0.f;
#pragma unroll
        for (int q = 0; q < 8; ++q) sm += acc[q];
        const float mu = wave_sum(sm) * (1.f / 512.f);
        float sv = 0.f;
#pragma unroll
        for (int q = 0; q < 8; ++q) { acc[q] -= mu; sv += acc[q] * acc[q]; }
        const float rstd = 1.f / sqrtf(wave_sum(sv) * (1.f / 512.f) + EPS);
        const f32x4 g0 = *(const f32x4*)(lg + c0), g1 = *(const f32x4*)(lg + c0 + 4), b0 = *(const f32x4*)(lb + c0), b1 = *(const f32x4*)(lb + c0 + 4);
        float y[8];
#pragma unroll
        for (int q = 0; q < 4; ++q) { y[q] = acc[q] * rstd * g0[q] + b0[q]; y[4 + q] = acc[4 + q] * rstd * g1[q] + b1[q]; }
#pragma unroll
        for (int q = 0; q < 8; ++q) y[q] = y[q] / (1.f + __expf(-y[q]));
        u32x4 w; w.x = cvtpk(y[0], y[1]); w.y = cvtpk(y[2], y[3]); w.z = cvtpk(y[4], y[5]); w.w = cvtpk(y[6], y[7]);
        *(u32x4*)(MIX + (size_t)row * 1024 + c0) = w;
    }
}

constexpr int N_SAMPLE_UNITS = 32, N_PROMPT_UNITS = 1024, N_CONV_UNITS = NT / 64, N_UNITS = N_SAMPLE_UNITS + N_PROMPT_UNITS + N_CONV_UNITS;

__device__ __forceinline__ void phase2(const Params& p, LAS unsigned char* lds, int tid, int lane, int wid, int cidx) {
    LAS float* bt = (LAS float*)(lds + L_BIAS);
    for (int e = tid; e < 4 * 320; e += 512) { const int hh = e / 320, rel = (e % 320) - 256; bt[e] = p.in[16][rel_bucket(rel) * 4 + hh] * LOG2E; }
    const float d1 = wave_sum(p.in[11][lane] * p.in[12][lane]), d2 = wave_sum(p.in[13][lane] * p.in[14][lane]);
    const float lam = expf(d1) - expf(d2) + 0.2f;
    unsigned* ctr = (unsigned*)(p.ws + WS_CTL) + 64 * cidx;
    volatile LAS unsigned* sw = (volatile LAS unsigned*)(lds + MISC_OFF);
    __syncthreads();
    for (;;) {
        __syncthreads();
        if (tid == 0) sw[0] = atomicAdd(ctr, 1u);
        __syncthreads();
        const int u = (int)sw[0];
        if (u >= N_UNITS) break;
        if (u < N_SAMPLE_UNITS) attn_unit(p, lds, 1, u >> 2, u & 3, 0, lam, tid, lane, wid);
        else if (u < N_SAMPLE_UNITS + N_PROMPT_UNITS) { const int v = u - N_SAMPLE_UNITS; const int bh = v & 63; attn_unit(p, lds, 0, bh >> 2, bh & 3, 15 - (v >> 6), lam, tid, lane, wid); }
        else conv_unit(p, u - N_SAMPLE_UNITS - N_PROMPT_UNITS, lane, wid);
    }
}
}

__device__ __forceinline__ void phase3b(const Params& p, int lane, int wave) {
    const int gw = blockIdx.x * 8 + wave, NGW = gridDim.x * 8;
    bf16_t* H2 = (bf16_t*)(p.ws + WS_H2);
    for (int m = gw; m < NT; m += NGW) rms_row_bf16(p.out + (size_t)m * DM, p.in[18], H2 + (size_t)m * DM, lane);
}

__device__ __forceinline__ void phase4b(const Params& p, int lane, int wave) {
    const int gw = blockIdx.x * 8 + wave, NGW = gridDim.x * 8;
    const bf16_t* QP = (const bf16_t*)(p.ws + WS_QP); const bf16_t* SK = (const bf16_t*)(p.ws + WS_SK);
    float* TK = (float*)(p.ws + WS_TK);
    const int r32 = lane & 31, hi = lane >> 5;
    const float NEG_INF = -__builtin_huge_valf();
    for (int wu = gw; wu < (NT / 32) * 16; wu += NGW) {
        const int rp = wu & 15, t0 = (wu >> 4) * 32;
        bf16x8 qf[8];
        const bf16_t* qp = QP + (size_t)(t0 + r32) * 2048 + rp * 128 + 8 * hi;
#pragma unroll
        for (int s = 0; s < 8; ++s) qf[s] = *(const bf16x8*)(qp + 16 * s);
        float v[64];
#pragma unroll
        for (int mt = 0; mt < 4; ++mt) {
            f32x16 S;
#pragma unroll
            for (int r = 0; r < 16; ++r) S[r] = 0.f;
            const bf16_t* kp = SK + ((size_t)rp * 128 + 32 * mt + r32) * 128 + 8 * hi;
#pragma unroll
            for (int s = 0; s < 8; ++s) S = att::mfma32(*(const bf16x8*)(kp + 16 * s), qf[s], S);
#pragma unroll
            for (int r = 0; r < 16; ++r) { const int n = 32 * mt + (r & 3) + 8 * (r >> 2) + 4 * hi; v[mt * 16 + r] = __uint_as_float((__float_as_uint(S[r]) & ~127u) | (unsigned)(127 - n)); }
        }
        float* dst = TK + ((size_t)(t0 + r32) * 16 + rp) * 16;
        for (int it = 0; it < 16; ++it) {
            float mx = v[0];
#pragma unroll
            for (int i = 1; i < 64; ++i) mx = fmaxf(mx, v[i]);
            mx = fmaxf(mx, __shfl_xor(mx, 32));
            if (hi == 0) dst[it] = mx;
#pragma unroll
            for (int i = 0; i < 64; ++i) v[i] = (v[i] == mx) ? NEG_INF : v[i];
        }
    }
}

__device__ __forceinline__ void phase5a(const Params& p, int tid) {
    const float* TK = (const float*)(p.ws + WS_TK);
    int* IDX = (int*)(p.ws + WS_IDX); float* GATE = (float*)(p.ws + WS_GATE);
    const float NEG_INF = -__builtin_huge_valf();
    for (int item = blockIdx.x * 512 + tid; item < NT * 8; item += gridDim.x * 512) {
        const int tok = item >> 3, r = item & 7;
        const f32x4* pa = (const f32x4*)(TK + ((size_t)tok * 16 + 2 * r) * 16);
        float a[16], b[16]; int ia[16], ib[16];
#pragma unroll
        for (int q = 0; q < 4; ++q) { const f32x4 x = pa[q], y = pa[4 + q];
#pragma unroll
            for (int j = 0; j < 4; ++j) { a[4 * q + j] = x[j]; b[4 * q + j] = y[j]; } }
#pragma unroll
        for (int i = 0; i < 16; ++i) { const unsigned ua = __float_as_uint(a[i]), ub = __float_as_uint(b[i]); ia[i] = 127 - (int)(ua & 127u); ib[i] = 127 - (int)(ub & 127u); a[i] = __uint_as_float(ua & ~127u); b[i] = __uint_as_float(ub & ~127u); }
        float cv[50]; int cid[50];
        {
            int c = 0;
#pragma unroll
            for (int i = 0; i < 16; ++i)
#pragma unroll
                for (int j = 0; j < 16; ++j)
                    if ((i + 1) * (j + 1) <= 16) { const float s = a[i] + b[j]; cv[c] = __uint_as_float((__float_as_uint(s) & ~63u) | (unsigned)(63 - c)); cid[c] = ia[i] * 128 + ib[j]; ++c; }
        }
        float best[16]; int bid[16];
#pragma unroll
        for (int it = 0; it < 16; ++it) {
            float mx = cv[0];
#pragma unroll
            for (int c = 1; c < 50; ++c) mx = fmaxf(mx, cv[c]);
            int id = 0;
#pragma unroll
            for (int c = 0; c < 50; ++c) { const bool hit = cv[c] == mx; id = hit ? cid[c] : id; cv[c] = hit ? NEG_INF : cv[c]; }
            best[it] = __uint_as_float(__float_as_uint(mx) & ~63u); bid[it] = id;
        }
        float e[16], sum = 0.f;
#pragma unroll
        for (int k = 0; k < 16; ++k) { e[k] = __expf(best[k] - best[0]); sum += e[k]; }
        const float rinv = 1.f / sum;
        int* io = IDX + (size_t)tok * 128 + r * 16; float* go = GATE + (size_t)tok * 128 + r * 16;
#pragma unroll
        for (int k = 0; k < 16; ++k) { io[k] = bid[k]; go[k] = e[k] * rinv; }
    }
}

__device__ __forceinline__ float gelu_erf(float x) { return 0.5f * x * (1.f + erff(x * 0.70710678118654752f)); }
typedef float f32x2 __attribute__((ext_vector_type(2)));
#define DPP_ADD(v, ctrl) v += __builtin_bit_cast(float, __builtin_amdgcn_update_dpp(0, __builtin_bit_cast(int, v), ctrl, 0xf, 0xf, true))
__device__ __forceinline__ float rl_f(float v, int l) { return __uint_as_float(__builtin_amdgcn_readlane(__float_as_uint(v), l)); }
__device__ __forceinline__ float wave_total(float v) {
    DPP_ADD(v, 0xB1); DPP_ADD(v, 0x4E); DPP_ADD(v, 0x141); DPP_ADD(v, 0x140);
    return (rl_f(v, 0) + rl_f(v, 16)) + (rl_f(v, 32) + rl_f(v, 48));
}
__device__ __forceinline__ void fp8x16_to_f32(const u32x4 q, float (&f)[16]) {
    const f32x2 c0 = __builtin_amdgcn_cvt_pk_f32_fp8(q.x, false), c1 = __builtin_amdgcn_cvt_pk_f32_fp8(q.x, true), c2 = __builtin_amdgcn_cvt_pk_f32_fp8(q.y, false), c3 = __builtin_amdgcn_cvt_pk_f32_fp8(q.y, true);
    const f32x2 c4 = __builtin_amdgcn_cvt_pk_f32_fp8(q.z, false), c5 = __builtin_amdgcn_cvt_pk_f32_fp8(q.z, true), c6 = __builtin_amdgcn_cvt_pk_f32_fp8(q.w, false), c7 = __builtin_amdgcn_cvt_pk_f32_fp8(q.w, true);
    f[0] = c0.x; f[1] = c0.y; f[2] = c1.x; f[3] = c1.y; f[4] = c2.x; f[5] = c2.y; f[6] = c3.x; f[7] = c3.y;
    f[8] = c4.x; f[9] = c4.y; f[10] = c5.x; f[11] = c5.y; f[12] = c6.x; f[13] = c6.y; f[14] = c7.x; f[15] = c7.y;
}
__device__ __forceinline__ void phase5b(const Params& p, int lane, int wave, float* yout) {
    const int gw = blockIdx.x * 8 + wave, NGW = gridDim.x * 8;
    const bf16_t* H2 = (const bf16_t*)(p.ws + WS_H2); const unsigned char* PU8 = p.ws + WS_PU8; const unsigned char* PV8 = p.ws + WS_PV8;
    const float* SCU = (const float*)(p.ws + WS_SCU); const float* SCV = (const float*)(p.ws + WS_SCV);
    const int* IDX = (const int*)(p.ws + WS_IDX); const float* GATE = (const float*)(p.ws + WS_GATE);
    const float* gf = p.in[23];
    for (int tok = gw; tok < NT; tok += NGW) {
        const int idxA = IDX[(size_t)tok * 128 + lane], idxB = IDX[(size_t)tok * 128 + 64 + lane];
        const float gA = GATE[(size_t)tok * 128 + lane], gB = GATE[(size_t)tok * 128 + 64 + lane];
        const float suA = SCU[idxA], suB = SCU[idxB], svA = SCV[idxA], svB = SCV[idxB];
        float hf[16];
        { const u32x4 hA = *(const u32x4*)(H2 + (size_t)tok * DM + lane * 8), hB = *(const u32x4*)(H2 + (size_t)tok * DM + 512 + lane * 8);
          hf[0] = bflo(hA.x); hf[1] = bfhi(hA.x); hf[2] = bflo(hA.y); hf[3] = bfhi(hA.y); hf[4] = bflo(hA.z); hf[5] = bfhi(hA.z); hf[6] = bflo(hA.w); hf[7] = bfhi(hA.w);
          hf[8] = bflo(hB.x); hf[9] = bfhi(hB.x); hf[10] = bflo(hB.y); hf[11] = bfhi(hB.y); hf[12] = bflo(hB.z); hf[13] = bfhi(hB.z); hf[14] = bflo(hB.w); hf[15] = bfhi(hB.w); }
        float actA = 0.f, actB = 0.f;
#pragma unroll 8
        for (int k = 0; k < 64; ++k) {
            const int e = __builtin_amdgcn_readlane(idxA, k);
            float f[16]; fp8x16_to_f32(*(const u32x4*)(PU8 + (size_t)e * DM + lane * 16), f);
            float s0 = f[0] * hf[0], s1 = f[1] * hf[1];
#pragma unroll
            for (int j = 2; j < 16; j += 2) { s0 += f[j] * hf[j]; s1 += f[j + 1] * hf[j + 1]; }
            const float s = wave_total(s0 + s1);
            actA = (lane == k) ? s : actA;
        }
#pragma unroll 8
        for (int k = 0; k < 64; ++k) {
            const int e = __builtin_amdgcn_readlane(idxB, k);
            float f[16]; fp8x16_to_f32(*(const u32x4*)(PU8 + (size_t)e * DM + lane * 16), f);
            float s0 = f[0] * hf[0], s1 = f[1] * hf[1];
#pragma unroll
            for (int j = 2; j < 16; j += 2) { s0 += f[j] * hf[j]; s1 += f[j + 1] * hf[j + 1]; }
            const float s = wave_total(s0 + s1);
            actB = (lane == k) ? s : actB;
        }
        const float cA = gA * gelu_erf(actA * suA) * svA, cB = gB * gelu_erf(actB * suB) * svB;
        float acc[16];
#pragma unroll
        for (int j = 0; j < 16; ++j) acc[j] = 0.f;
#pragma unroll 8
        for (int k = 0; k < 64; ++k) {
            const int e = __builtin_amdgcn_readlane(idxA, k);
            const float c = rl_f(cA, k);
            float f[16]; fp8x16_to_f32(*(const u32x4*)(PV8 + (size_t)e * DM + lane * 16), f);
#pragma unroll
            for (int j = 0; j < 16; ++j) acc[j] += c * f[j];
        }
#pragma unroll 8
        for (int k = 0; k < 64; ++k) {
            const int e = __builtin_amdgcn_readlane(idxB, k);
            const float c = rl_f(cB, k);
            float f[16]; fp8x16_to_f32(*(const u32x4*)(PV8 + (size_t)e * DM + lane * 16), f);
#pragma unroll
            for (int j = 0; j < 16; ++j) acc[j] += c * f[j];
        }
        const float* xr = p.out + (size_t)tok * DM; float* yr = yout + (size_t)tok * DM;
        f32x4 x[4];
        x[0] = *(const f32x4*)(xr + lane * 8); x[1] = *(const f32x4*)(xr + lane * 8 + 4); x[2] = *(const f32x4*)(xr + 512 + lane * 8); x[3] = *(const f32x4*)(xr + 512 + lane * 8 + 4);
        float ss = 0.f;
#pragma unroll
        for (int q = 0; q < 4; ++q)
#pragma unroll
            for (int j = 0; j < 4; ++j) { x[q][j] += acc[4 * q + j]; ss += x[q][j] * x[q][j]; }
        const float rstd = 1.f / sqrtf(wave_total(ss) * (1.f / DM) + EPS);
        const f32x4 g0 = *(const f32x4*)(gf + lane * 8), g1 = *(const f32x4*)(gf + lane * 8 + 4), g2 = *(const f32x4*)(gf + 512 + lane * 8), g3 = *(const f32x4*)(gf + 512 + lane * 8 + 4);
        *(f32x4*)(yr + lane * 8) = x[0] * rstd * g0; *(f32x4*)(yr + lane * 8 + 4) = x[1] * rstd * g1;
        *(f32x4*)(yr + 512 + lane * 8) = x[2] * rstd * g2; *(f32x4*)(yr + 512 + lane * 8 + 4) = x[3] * rstd * g3;
    }
}

__global__ void __launch_bounds__(512, 2) fwd_megakernel(Params p) {
    extern __shared__ __attribute__((aligned(16))) unsigned char lds_raw[];
    LAS unsigned char* lds = (LAS unsigned char*)lds_raw;
    cg::grid_group grid = cg::this_grid();
    const int tid = threadIdx.x, lane = tid & 63, wave = __builtin_amdgcn_readfirstlane(tid >> 6);
    const int G = gridDim.x;
    volatile LAS unsigned* MISC = (volatile LAS unsigned*)(lds + MISC_OFF);
    if (tid < 32) MISC[tid] = 0u;
    __syncthreads();
    XcdBarrier bar = xcd_barrier_post((unsigned*)(p.ws + WS_CTL) + 4096, MISC + 8);
#define GSYNC() xcd_barrier(bar)

#ifndef RPT_MASK
#define RPT_MASK 0
#endif
#define RPT(bit) for (int rpt_ = 0; rpt_ < (((RPT_MASK) >> (bit)) & 1) + 1; ++rpt_)
    RPT(0) { phase0(p, lds, tid, lane, wave); grid.sync(); }
    RPT(1) {
        pg8::Gemm g{(const bf16_t*)(p.ws + WS_H), (const bf16_t*)(p.ws + WS_WINT), NT, DIN, 1024};
        pg8::StaticOrder S; S.init(NT, DIN, G, (int)blockIdx.x);
        pg8::EpiProj E{(bf16_t*)(p.ws + WS_A), (bf16_t*)(p.ws + WS_Q), (bf16_t*)(p.ws + WS_KP), (bf16_t*)(p.ws + WS_VP), (bf16_t*)(p.ws + WS_KS), (bf16_t*)(p.ws + WS_VS), p.out};
        pg8::gemm_phase<pg8::EpiProj, pg8::StaticOrder, true, true>(lds, g, S, E);
        GSYNC();
    }
    RPT(2) { att::phase2(p, lds, tid, lane, wave, rpt_); GSYNC(); }
    RPT(3) {
        pg8::Gemm g{(const bf16_t*)(p.ws + WS_MIX), (const bf16_t*)(p.ws + WS_WOUTT), NT, 1024, 1024};
        pg8::StaticOrder S; S.init(NT, 1024, G, (int)blockIdx.x);
        pg8::EpiRes E{p.in[0], p.in[1], p.out};
        pg8::gemm_phase<pg8::EpiRes, pg8::StaticOrder, true, true>(lds, g, S, E);
        GSYNC();
    }
    RPT(4) { phase3b(p, lane, wave); GSYNC(); }
    RPT(5) {
        pg8::Gemm g{(const bf16_t*)(p.ws + WS_H2), (const bf16_t*)(p.ws + WS_WQT), NT, 2048, 1024};
        pg8::StaticOrder S; S.init(NT, 2048, G, (int)blockIdx.x);
        pg8::EpiBf16<0> E{(bf16_t*)(p.ws + WS_QP), 2048, nullptr, 0, 0, 1.f};
        pg8::gemm_phase<pg8::EpiBf16<0>, pg8::StaticOrder, true, true>(lds, g, S, E);
        GSYNC();
    }
    RPT(6) { phase4b(p, lane, wave); GSYNC(); }
    RPT(7) { phase5a(p, tid); GSYNC(); }
    if ((RPT_MASK) & 256) { phase5b(p, lane, wave, (float*)(p.ws + WS_QP)); GSYNC(); }
    phase5b(p, lane, wave, p.out);
}

extern "C" void kernel_launch(void* const* d_in, const int* in_sizes, int n_in, void* d_out, int out_size, void* d_ws, size_t ws_size, hipStream_t stream) {
    static int grid = 0;
    if (grid == 0) {
        if (n_in != 24 || out_size != (int)OUT_TOTAL || ws_size < WS_END) { fprintf(stderr, "kernel_launch: unexpected shapes: n_in %d out %d ws %zu (need %zu)\n", n_in, out_size, ws_size, (size_t)WS_END); grid = -1; return; }
        int dev = 0, cus = 0, per_cu = 0;
        (void)hipGetDevice(&dev);
        (void)hipDeviceGetAttribute(&cus, hipDeviceAttributeMultiprocessorCount, dev);
        if (hipFuncSetAttribute((const void*)fwd_megakernel, hipFuncAttributeMaxDynamicSharedMemorySize, LDS_BYTES) != hipSuccess) { fprintf(stderr, "kernel_launch: hipFuncSetAttribute failed\n"); grid = -1; return; }
        if (hipOccupancyMaxActiveBlocksPerMultiprocessor(&per_cu, (const void*)fwd_megakernel, 512, LDS_BYTES) != hipSuccess || per_cu < 1) { fprintf(stderr, "kernel_launch: occupancy query gave %d\n", per_cu); per_cu = 1; }
        (void)hipGetLastError();
        grid = cus * 1;
        if (per_cu < 1) grid = -1;
    }
    if (grid < 0) return;
    (void)hipMemsetAsync((char*)d_ws + WS_CTL, 0, CTL_BYTES, stream);
    Params p{};
    for (int i = 0; i < 24; ++i) p.in[i] = (const float*)d_in[i];
    p.out = (float*)d_out; p.ws = (unsigned char*)d_ws;
    void* args[] = {&p};
    hipError_t e = hipLaunchCooperativeKernel((const void*)fwd_megakernel, dim3(grid), dim3(512), args, LDS_BYTES, stream);
    if (e != hipSuccess) fprintf(stderr, "cooperative launch failed: %s (grid %d)\n", hipGetErrorString(e), grid);
}
```

```cpp
#include <hip/hip_runtime.h>
#include <hip/hip_cooperative_groups.h>
#include <cstdio>
#include <cstdint>
#include <cmath>
namespace cg = cooperative_groups;
namespace pg8 {
#define PG8_LAS __attribute__((address_space(3)))
typedef unsigned short bf16_t;
typedef short bf16x8 __attribute__((ext_vector_type(8)));
typedef float f32x4 __attribute__((ext_vector_type(4)));
typedef unsigned u32x4 __attribute__((ext_vector_type(4)));
constexpr int BM = 256, BK = 64, HALF = 128, HTB = HALF * BK * 2  , STAGE_BYTES = 8 * HTB, NXCD = 8, WGM = 8;

__host__ __device__ __forceinline__ int lds_byte(int r, int c) { const int st = (r >> 4) * 2 + (c >> 5), rr = r & 15, cc = c & 31, ob = rr * 64 + cc * 2; return st * 1024 + (ob ^ (((ob >> 9) & 1) << 5)); }
__host__ __device__ __forceinline__ void stage_rc(int b, int& R, int& C) { const int st = b / 1024, sb = b % 1024, swz = sb ^ (((sb >> 9) & 1) << 5); R = (st >> 1) * 16 + swz / 64; C = (st & 1) * 32 + (swz % 64) / 2; }
__host__ __device__ __forceinline__ int perm32(int rho) { const int n = rho >> 4, i = rho & 15; return 8 * (i >> 2) + 4 * n + (i & 3); }

struct Unit { int pm, pn; };
struct Gemm { const bf16_t* A; const bf16_t* Bt; int M, N, K; };

struct StaticOrder {
    int nM, nN, nwg, G, c;
    __host__ __device__ void init(int M, int N, int G_, int c_) { nM = M / BM; nN = N / BM; nwg = nM * nN; G = G_; c = c_; }
    __host__ __device__ bool next(int i, Unit& u) const {
        const long L = (long)i * G + c; if (L >= nwg) return false;
        int wgid = (int)L; { const int q = nwg / NXCD, r = nwg % NXCD, xcd = wgid % NXCD, off = wgid / NXCD; wgid = (xcd < r ? xcd * (q + 1) : r * (q + 1) + (xcd - r) * q) + off; }
        const int nig = WGM * nN, gid = wgid / nig, fm = gid * WGM, gsz = (nM - fm) < WGM ? (nM - fm) : WGM;
        u.pm = fm + ((wgid % nig) % gsz); u.pn = (wgid % nig) / gsz; return true;
    }
    __device__ __forceinline__ void a_ready(const Unit&) const {}
    __device__ __forceinline__ void done(const Unit&) const {}
};

__device__ __forceinline__ unsigned cvt_pk_bf16(float lo, float hi) { unsigned r; asm volatile("v_cvt_pk_bf16_f32 %0, %1, %2" : "=v"(r) : "v"(lo), "v"(hi)); return r; }
typedef float f32x2 __attribute__((ext_vector_type(2)));
__device__ __forceinline__ f32x2 gelu_pk(f32x2 v) {
    const f32x2 av = __builtin_elementwise_abs(v), d = av * 0.2316418882f + 1.0f;
    f32x2 t; t.x = __builtin_amdgcn_rcpf(d.x); t.y = __builtin_amdgcn_rcpf(d.y);
    f32x2 q = t * 0.5307027145f + (-0.7265760135f); q = q * t + 0.7107068705f; q = q * t + (-0.142248368f); q = q * t + 0.127414796f; q = q * t;
    const f32x2 s = (v * v) * (-0.72134752044f);
    f32x2 e; e.x = __builtin_amdgcn_exp2f(s.x); e.y = __builtin_amdgcn_exp2f(s.y);
    const f32x2 m = v * (q * e), r = v - m;
    f32x2 o; o.x = v.x < 0.f ? m.x : r.x; o.y = v.y < 0.f ? m.y : r.y; return o;
}

template <int ACT  > struct EpiBf16 {
    static constexpr bool PERM = true, AFTER_DRAIN = false; static_assert(ACT == 0 || ACT == 1, "EpiBf16: ACT is 0 (none) or 1 (gelu_pk)");
    bf16_t* O; int ldc; const float* bias; int split_cols; size_t split_stride; float scale0;
    __device__ __forceinline__ void operator()(const f32x4 (&acc)[2][2][4][2], const Unit& u, int wr, int wc, int fr, int fq) const {
        const int row0 = u.pm * BM + wr * 64 + fr; int colt = u.pn * BM; bf16_t* base = O;
        float sc = 1.f; if (split_cols) { const int t = colt / split_cols; base += (size_t)t * split_stride; colt -= t * split_cols; if (t == 0) sc = scale0; }
        const int col0 = colt + wc * 32 + 8 * fq, bcol0 = u.pn * BM + wc * 32 + 8 * fq;
        f32x4 bv[2][2];
#pragma unroll
        for (int bj = 0; bj < 2; ++bj)
#pragma unroll
            for (int n = 0; n < 2; ++n) bv[bj][n] = bias ? *(const f32x4*)(bias + bcol0 + bj * HALF + 4 * n) : (f32x4){0.f, 0.f, 0.f, 0.f};
#pragma unroll
        for (int ai = 0; ai < 2; ++ai)
#pragma unroll
            for (int m = 0; m < 4; ++m) { bf16_t* rowp = base + (size_t)(row0 + ai * HALF + m * 16) * ldc + col0;
#pragma unroll
                for (int bj = 0; bj < 2; ++bj) { f32x4 v0 = acc[ai][bj][m][0] + bv[bj][0], v1 = acc[ai][bj][m][1] + bv[bj][1];
                    if (ACT == 1) { f32x2 a = gelu_pk((f32x2){v0[0], v0[1]}), b = gelu_pk((f32x2){v0[2], v0[3]}), c = gelu_pk((f32x2){v1[0], v1[1]}), d = gelu_pk((f32x2){v1[2], v1[3]});
                        v0 = (f32x4){a.x, a.y, b.x, b.y}; v1 = (f32x4){c.x, c.y, d.x, d.y}; }
                    v0 = v0 * sc; v1 = v1 * sc; u32x4 w; w.x = cvt_pk_bf16(v0[0], v0[1]); w.y = cvt_pk_bf16(v0[2], v0[3]); w.z = cvt_pk_bf16(v1[0], v1[1]); w.w = cvt_pk_bf16(v1[2], v1[3]);
                    *(u32x4*)(rowp + bj * HALF) = w; } }
    }
};
template <class Epi, class Sched, bool ALIGN_EPI = false, bool SP2 = false>
__device__ __forceinline__ void gemm_phase(PG8_LAS unsigned char* lds, const Gemm g, const Sched& S, const Epi& E) {
    const int tid = threadIdx.x, wid = __builtin_amdgcn_readfirstlane(tid >> 6), lane = tid & 63, wr = wid >> 2, wc = wid & 3, fr = lane & 15, fq = lane >> 4;
    const int K = g.K, nt = K / BK;
    unsigned voffA[2], voffB[2];
#pragma unroll
    for (int i = 0; i < 2; ++i) { int R, C; stage_rc(tid * 16 + i * 8192, R, C); const int Rb = Epi::PERM ? ((R & ~31) + perm32(R & 31)) : R;
        voffA[i] = (unsigned)(R * K + C) * 2u; voffB[i] = (unsigned)(Rb * K + C) * 2u; }
    const size_t kstep = (size_t)(BK * 2);
    const size_t hstep = (size_t)HALF * K * 2;
    const size_t tstep = 2 * hstep;
    const unsigned ldsw = (unsigned)wid * 1024u;
    const int aoff = lds_byte(wr * 64 + fr, fq * 8), boff = lds_byte(wc * 32 + fr, fq * 8);
#define PG8_SA(b, h) (((b) * 2 + (h)) * HTB)
#define PG8_SB(b, h) ((4 + (b) * 2 + (h)) * HTB)
#define PG8_STAGE(bufoff, gbase, voff) do { _Pragma("unroll") for (int _i = 0; _i < 2; ++_i) \
        __builtin_amdgcn_global_load_lds((const unsigned*)((const char*)(gbase) + (voff)[_i]), (PG8_LAS unsigned*)(lds + (bufoff) + ldsw + _i * 8192), 16, 0, 0); } while (0)
#define PG8_LDA(dst, b, h) do { _Pragma("unroll") for (int m = 0; m < 4; ++m) _Pragma("unroll") for (int k = 0; k < 2; ++k) dst[m][k] = *(const PG8_LAS bf16x8*)(lds + PG8_SA(b, h) + aoff + m * 2048 + k * 1024); } while (0)
#define PG8_LDB(dst, b, h) do { _Pragma("unroll") for (int n = 0; n < 2; ++n) _Pragma("unroll") for (int k = 0; k < 2; ++k) dst[n][k] = *(const PG8_LAS bf16x8*)(lds + PG8_SB(b, h) + boff + n * 2048 + k * 1024); } while (0)
#define PG8_MMA(ai, bj, At, Bt) do { __builtin_amdgcn_s_setprio(1); _Pragma("unroll") for (int m = 0; m < 4; ++m) _Pragma("unroll") for (int n = 0; n < 2; ++n) _Pragma("unroll") for (int k = 0; k < 2; ++k) \
        acc[ai][bj][m][n] = __builtin_amdgcn_mfma_f32_16x16x32_bf16(Bt[n][k], At[m][k], acc[ai][bj][m][n], 0, 0, 0); __builtin_amdgcn_s_setprio(0); } while (0)
#define PG8_WAIT_V(n) asm volatile("s_waitcnt vmcnt(" #n ")" ::: "memory")
#define PG8_WAIT_L(n) asm volatile("s_waitcnt lgkmcnt(" #n ")" ::: "memory")
#define PG8_BAR __builtin_amdgcn_s_barrier()
#define PG8_SCHED __builtin_amdgcn_sched_barrier(0)
    Unit cur, nxt; int ui = 0;
    if (!S.next(0, cur)) return;
    f32x4 acc[2][2][4][2];
#pragma unroll
    for (int a = 0; a < 2; ++a)
#pragma unroll
        for (int b = 0; b < 2; ++b)
#pragma unroll
            for (int m = 0; m < 4; ++m)
#pragma unroll
                for (int n = 0; n < 2; ++n) acc[a][b][m][n] = (f32x4){0.f, 0.f, 0.f, 0.f};
    bf16x8 At[4][2], B0[2][2], B1[2][2];
    const char* cA = (const char*)g.A + (size_t)cur.pm * tstep; const char* cB = (const char*)g.Bt + (size_t)cur.pn * tstep;
    S.a_ready(cur);
    if constexpr (SP2) {
        PG8_STAGE(PG8_SB(0, 0), cB, voffB); PG8_STAGE(PG8_SB(0, 1), cB + hstep, voffB); PG8_STAGE(PG8_SA(0, 0), cA, voffA); PG8_STAGE(PG8_SA(0, 1), cA + hstep, voffA);
        if (wr == 1) PG8_BAR;
        PG8_WAIT_V(2); PG8_BAR;
        PG8_STAGE(PG8_SB(1, 0), cB + kstep, voffB); PG8_STAGE(PG8_SA(1, 0), cA + kstep, voffA); PG8_STAGE(PG8_SB(1, 1), cB + hstep + kstep, voffB);
        PG8_WAIT_V(6); PG8_BAR;
    } else {
        PG8_STAGE(PG8_SB(0, 0), cB, voffB); PG8_STAGE(PG8_SA(0, 0), cA, voffA); PG8_STAGE(PG8_SB(0, 1), cB + hstep, voffB); PG8_STAGE(PG8_SA(0, 1), cA + hstep, voffA);
        if (wr == 1) PG8_BAR;
        PG8_WAIT_V(4); PG8_BAR;
        PG8_STAGE(PG8_SB(1, 0), cB + kstep, voffB); PG8_STAGE(PG8_SA(1, 0), cA + kstep, voffA); PG8_STAGE(PG8_SB(1, 1), cB + hstep + kstep, voffB);
        PG8_WAIT_V(6); PG8_BAR;
    }
    for (;;) {
        const bool has_next = S.next(ui + 1, nxt);
        const char* nA = has_next ? (const char*)g.A + (size_t)nxt.pm * tstep : cA; const char* nB = has_next ? (const char*)g.Bt + (size_t)nxt.pn * tstep : cB;
        for (int t = 0; t < nt; t += 2) {
            const bool last = (t == nt - 2);
            const char* a1 = cA + (size_t)(t + 1) * kstep;
            const char* a2 = last ? nA : cA + (size_t)(t + 2) * kstep; const char* b2 = last ? nB : cB + (size_t)(t + 2) * kstep;
            const char* a3 = a2 + kstep; const char* b3 = b2 + kstep;
            if (last && has_next) S.a_ready(nxt);
            if constexpr (SP2) {
            PG8_LDB(B0, 0, 0); PG8_LDB(B1, 0, 1); PG8_SCHED; PG8_LDA(At, 0, 0); PG8_STAGE(PG8_SA(1, 1), a1 + hstep, voffA);
            PG8_WAIT_V(8); PG8_WAIT_L(0); PG8_BAR; PG8_MMA(0, 0, At, B0); PG8_MMA(0, 1, At, B1); PG8_BAR; PG8_SCHED;
            PG8_LDA(At, 0, 1); PG8_STAGE(PG8_SB(0, 0), b2, voffB); PG8_STAGE(PG8_SB(0, 1), b2 + hstep, voffB); PG8_STAGE(PG8_SA(0, 0), a2, voffA);
            PG8_WAIT_V(8); PG8_WAIT_L(0); PG8_BAR; PG8_MMA(1, 0, At, B0); PG8_MMA(1, 1, At, B1); PG8_BAR; PG8_SCHED;
            PG8_LDB(B0, 1, 0); PG8_LDB(B1, 1, 1); PG8_SCHED; PG8_LDA(At, 1, 0); PG8_STAGE(PG8_SA(0, 1), a2 + hstep, voffA);
            PG8_WAIT_V(8); PG8_WAIT_L(0); PG8_BAR; PG8_MMA(0, 0, At, B0); PG8_MMA(0, 1, At, B1); PG8_BAR; PG8_SCHED;
            PG8_LDA(At, 1, 1); PG8_STAGE(PG8_SB(1, 0), b3, voffB); PG8_STAGE(PG8_SB(1, 1), b3 + hstep, voffB); PG8_STAGE(PG8_SA(1, 0), a3, voffA);
            PG8_WAIT_V(8); PG8_WAIT_L(0); PG8_BAR; PG8_MMA(1, 0, At, B0); PG8_MMA(1, 1, At, B1); PG8_BAR; PG8_SCHED;
            } else {
            PG8_LDB(B0, 0, 0); PG8_SCHED; PG8_LDA(At, 0, 0); PG8_STAGE(PG8_SA(1, 1), a1 + hstep, voffA);
            PG8_WAIT_L(8); PG8_BAR; PG8_WAIT_L(0); PG8_MMA(0, 0, At, B0); PG8_BAR; PG8_SCHED;
            PG8_LDB(B1, 0, 1); PG8_STAGE(PG8_SB(0, 0), b2, voffB);
            PG8_BAR; PG8_WAIT_L(0); PG8_MMA(0, 1, At, B1); PG8_BAR;
            PG8_LDA(At, 0, 1); PG8_STAGE(PG8_SA(0, 0), a2, voffA);
            PG8_BAR; PG8_WAIT_L(0); PG8_MMA(1, 0, At, B0); PG8_BAR; PG8_SCHED;
            PG8_STAGE(PG8_SB(0, 1), b2 + hstep, voffB);
            PG8_WAIT_V(6); PG8_BAR; PG8_MMA(1, 1, At, B1); PG8_BAR;
            PG8_LDB(B0, 1, 0); PG8_SCHED; PG8_LDA(At, 1, 0); PG8_STAGE(PG8_SA(0, 1), a2 + hstep, voffA);
            PG8_WAIT_L(8); PG8_BAR; PG8_WAIT_L(0); PG8_MMA(0, 0, At, B0); PG8_BAR; PG8_SCHED;
            PG8_LDB(B1, 1, 1); PG8_STAGE(PG8_SB(1, 0), b3, voffB);
            PG8_BAR; PG8_WAIT_L(0); PG8_MMA(0, 1, At, B1); PG8_BAR;
            PG8_LDA(At, 1, 1); PG8_STAGE(PG8_SA(1, 0), a3, voffA);
            PG8_BAR; PG8_WAIT_L(0); PG8_MMA(1, 0, At, B0); PG8_BAR; PG8_SCHED;
            PG8_STAGE(PG8_SB(1, 1), b3 + hstep, voffB);
            PG8_WAIT_V(6); PG8_BAR; PG8_MMA(1, 1, At, B1); PG8_BAR;
            }
        }
        if constexpr (ALIGN_EPI) { if (wr == 0) PG8_BAR; }
        if constexpr (!Epi::AFTER_DRAIN) { E(acc, cur, wr, wc, fr, fq); S.done(cur); }
        if (!has_next) break;
#pragma unroll
        for (int a = 0; a < 2; ++a)
#pragma unroll
            for (int b = 0; b < 2; ++b)
#pragma unroll
                for (int m = 0; m < 4; ++m)
#pragma unroll
                    for (int n = 0; n < 2; ++n) acc[a][b][m][n] = (f32x4){0.f, 0.f, 0.f, 0.f};
        cur = nxt; cA = nA; cB = nB; ++ui;
        if constexpr (ALIGN_EPI) { if (wr == 1) PG8_BAR; }
    }
    PG8_WAIT_V(0);
    if constexpr (!ALIGN_EPI) { if (wr == 0) PG8_BAR; }
    PG8_BAR;
    if constexpr (Epi::AFTER_DRAIN) { E.fused(acc, cur, wr, wc, fr, fq, lds, wid, lane); S.done(cur); }
#undef PG8_SA
#undef PG8_SB
#undef PG8_STAGE
#undef PG8_LDA
#undef PG8_LDB
#undef PG8_MMA
#undef PG8_WAIT_V
#undef PG8_WAIT_L
#undef PG8_BAR
#undef PG8_SCHED
}
}

#define LAS __attribute__((address_space(3)))
typedef unsigned short bf16_t;
typedef short bf16x8 __attribute__((ext_vector_type(8)));
typedef short s16x4 __attribute__((ext_vector_type(4)));
typedef float f32x4 __attribute__((ext_vector_type(4)));
typedef float f32x16 __attribute__((ext_vector_type(16)));
typedef unsigned u32x4 __attribute__((ext_vector_type(4)));
typedef unsigned u32x2 __attribute__((ext_vector_type(2)));

constexpr int DM = 1024;
constexpr int NP = 16 * 2048;
constexpr int NS = 8 * 64;
constexpr int NT = NP + NS;
constexpr int DIN = 2560;
constexpr int SKV = 2112;
constexpr float EPS = 1e-6f;
constexpr float LOG2E = 1.4426950408889634f;
constexpr float QSCALE = 0.125f * LOG2E;

constexpr long OUT_Y = 0;
constexpr long OUT_KP = 34078720L, OUT_VP = 50855936L, OUT_CONVP = 67633152L, OUT_KS = 67878912L, OUT_VS = 68141056L, OUT_CONVS = 68403200L, OUT_TOTAL = 68526080L;

constexpr size_t MiB = 1u << 20;
constexpr size_t WS_CTL = 0, CTL_BYTES = 1 * MiB;
constexpr size_t WS_WINT = 1 * MiB;
constexpr size_t WS_WOUTT = 6 * MiB;
constexpr size_t WS_WQT = 8 * MiB;
constexpr size_t WS_SK = 12 * MiB;
constexpr size_t WS_PU8 = 16 * MiB;
constexpr size_t WS_PV8 = 32 * MiB;
constexpr size_t WS_SCU = 48 * MiB;
constexpr size_t WS_SCV = 49 * MiB;
constexpr size_t WS_KS = 80 * MiB;
constexpr size_t WS_VS = 97 * MiB;
constexpr size_t WS_H = 114 * MiB;
constexpr size_t WS_A = 179 * MiB;
constexpr size_t WS_Q = 212 * MiB;
constexpr size_t WS_QP = 114 * MiB;
constexpr size_t WS_KP = 245 * MiB;
constexpr size_t WS_VP = 277 * MiB;
constexpr size_t WS_MIX = 309 * MiB;
constexpr size_t WS_H2 = 309 * MiB;
constexpr size_t WS_TK = 375 * MiB;
constexpr size_t WS_IDX = 408 * MiB;
constexpr size_t WS_GATE = 425 * MiB;
constexpr size_t WS_END = 442 * MiB;
static_assert(WS_H + (size_t)NT * 1024 * 2 <= WS_A && WS_A + (size_t)NT * 512 * 2 <= WS_Q && WS_Q + (size_t)NT * 512 * 2 <= WS_KP, "R1");
static_assert(WS_QP + (size_t)NT * 2048 * 2 <= WS_KP && WS_KP + (size_t)NP * 512 * 2 <= WS_VP && WS_VP + (size_t)NP * 512 * 2 <= WS_MIX, "ws map");
static_assert(WS_MIX + (size_t)NT * 1024 * 2 <= WS_TK && WS_TK + (size_t)NT * 256 * 4 <= WS_IDX && WS_IDX + (size_t)NT * 128 * 4 <= WS_GATE && WS_GATE + (size_t)NT * 128 * 4 <= WS_END, "ws map 2");
static_assert(WS_KS + (size_t)8 * SKV * 512 * 2 <= WS_VS && WS_VS + (size_t)8 * SKV * 512 * 2 <= WS_H, "ws map 3");

constexpr int RING_BYTES = 131072;
constexpr int BIAS_OFF = RING_BYTES;
constexpr int MISC_OFF = RING_BYTES + 5120;
constexpr int LDS_BYTES = MISC_OFF + 1024;

struct Params {
    const float* in[24];
    float* out;
    unsigned char* ws;
};

__device__ __forceinline__ unsigned cvtpk(float lo, float hi) { return pg8::cvt_pk_bf16(lo, hi); }
__device__ __forceinline__ float bflo(unsigned w) { return __uint_as_float(w << 16); }
__device__ __forceinline__ float bfhi(unsigned w) { return __uint_as_float(w & 0xffff0000u); }
__device__ __forceinline__ float wave_sum(float v) {
#pragma unroll
    for (int o = 1; o < 64; o <<= 1) v += __shfl_xor(v, o);
    return v;
}
typedef float f32x2 __attribute__((ext_vector_type(2)));
#define DPP_ADD(v, ctrl) v += __builtin_bit_cast(float, __builtin_amdgcn_update_dpp(0, __builtin_bit_cast(int, v), ctrl, 0xf, 0xf, true))
__device__ __forceinline__ float rl_f(float v, int l) { return __uint_as_float(__builtin_amdgcn_readlane(__float_as_uint(v), l)); }
__device__ __forceinline__ float wave_total(float v) {
    DPP_ADD(v, 0xB1); DPP_ADD(v, 0x4E); DPP_ADD(v, 0x141); DPP_ADD(v, 0x140);
    return (rl_f(v, 0) + rl_f(v, 16)) + (rl_f(v, 32) + rl_f(v, 48));
}
typedef __bf16 bf16x2_t __attribute__((ext_vector_type(2)));
__device__ __forceinline__ float dot2(unsigned a, unsigned b, float acc) {
    return __builtin_amdgcn_fdot2_f32_bf16(__builtin_bit_cast(bf16x2_t, a), __builtin_bit_cast(bf16x2_t, b), acc, false);
}
#define LDS_WAIT() asm volatile("s_waitcnt lgkmcnt(0)" ::: "memory")

#define XB_TMO      128
#define XB_XCNT(j)  (256  + 64 * (j))
#define XB_XSUB(j)  (1280 + 64 * (j))
#define XB_XGEN(j)  (2304 + 64 * (j))
#define XB_TOP      3328
#define XB_TOPGEN   3392
#define XCD_BAR_WORDS 3456
#define XB_SPIN_CAP (1u << 18)

__device__ __forceinline__ unsigned xb_ld(unsigned* p)              { return __hip_atomic_load(p, __ATOMIC_RELAXED, __HIP_MEMORY_SCOPE_AGENT); }
__device__ __forceinline__ unsigned xb_add(unsigned* p, unsigned v) { return __hip_atomic_fetch_add(p, v, __ATOMIC_RELAXED, __HIP_MEMORY_SCOPE_AGENT); }
__device__ __forceinline__ unsigned xb_xcc_id() { return (unsigned)__builtin_amdgcn_s_getreg((3 << 11) | 20) & 0xFu; }
#define XB_SPIN(cond, bar) do { unsigned _sp = 0; while (cond) { __builtin_amdgcn_s_sleep(1); \
    if ((++_sp & 255u) == 0u) { if (xb_ld(&(bar)[XB_TMO])) break; if (_sp > XB_SPIN_CAP) { atomicAdd(&(bar)[XB_TMO], 1u); break; } } } } while (0)

struct XcdBarrier {
    unsigned* bar; unsigned x;
    volatile LAS unsigned* st;
};

__device__ __forceinline__ XcdBarrier xcd_barrier_post(unsigned* bar, volatile LAS unsigned* st) {
    XcdBarrier b; b.bar = bar; b.x = xb_xcc_id(); b.st = st;
    if (threadIdx.x == 0) (void)xb_add(&bar[XB_XCNT(b.x)], 1u);
    return b;
}
__device__ __forceinline__ void xcd_barrier_complete(unsigned* bar, unsigned x, unsigned& nloc, unsigned& nx) {
    const unsigned G = gridDim.x * gridDim.y * gridDim.z;
    unsigned sum, cnt, mine, sp = 0u;
    for (;;) {
        sum = 0u; cnt = 0u; mine = 0u;
#pragma unroll
        for (unsigned j = 0; j < 16; ++j) { const unsigned c = xb_ld(&bar[XB_XCNT(j)]); sum += c; cnt += (c > 0u) ? 1u : 0u; mine = (j == x) ? c : mine; }
        if (sum == G) break;
        __builtin_amdgcn_s_sleep(1);
        if ((++sp & 255u) == 0u) { if (xb_ld(&bar[XB_TMO])) break; if (sp > XB_SPIN_CAP) { atomicAdd(&bar[XB_TMO], 1u); break; } }
    }
    nloc = mine > 0u ? mine : 1u; nx = cnt > 0u ? cnt : 1u;
}

__device__ __forceinline__ void xcd_barrier(const XcdBarrier& b) {
    asm volatile("s_waitcnt vmcnt(0)" ::: "memory");
    __syncthreads();
    if (threadIdx.x == 0) {
        unsigned* bar = b.bar;
        __builtin_amdgcn_s_waitcnt(0);
        unsigned nloc = b.st[0], nx = b.st[1];
        if (nloc == 0u) { xcd_barrier_complete(bar, b.x, nloc, nx); b.st[0] = nloc; b.st[1] = nx; }
        const unsigned old = xb_add(&bar[XB_XSUB(b.x)], 1u);
        const unsigned gen = old / nloc;
        if (old + 1u == (gen + 1u) * nloc) {
            __builtin_amdgcn_fence(__ATOMIC_RELEASE, "agent");
            asm volatile("s_waitcnt vmcnt(0)" ::: "memory");
            const unsigned og = xb_add(&bar[XB_TOP], 1u);
            const unsigned tg = og / nx;
            if (og + 1u == (tg + 1u) * nx) xb_add(&bar[XB_TOPGEN], 1u);
            else XB_SPIN(xb_ld(&bar[XB_TOPGEN]) == tg, bar);
            __builtin_amdgcn_fence(__ATOMIC_ACQUIRE, "agent");
            xb_add(&bar[XB_XGEN(b.x)], 1u);
            asm volatile("s_waitcnt vmcnt(0)" ::: "memory");
        } else {
            XB_SPIN(xb_ld(&bar[XB_XGEN(b.x)]) == gen, bar);
            __builtin_amdgcn_fence(__ATOMIC_ACQUIRE, "agent");
            asm volatile("s_waitcnt vmcnt(0)" ::: "memory");
        }
    }
    __syncthreads();
}


namespace pg8 {
__device__ __forceinline__ u32x2 pack4(f32x4 v) { u32x2 w; w.x = cvt_pk_bf16(v[0], v[1]); w.y = cvt_pk_bf16(v[2], v[3]); return w; }
struct EpiProj {
    static constexpr bool PERM = false, AFTER_DRAIN = false;
    bf16_t* A; bf16_t* Q; bf16_t* KP; bf16_t* VP; bf16_t* KS; bf16_t* VS; float* out;
    __device__ __forceinline__ void operator()(const f32x4 (&acc)[2][2][4][2], const Unit& u, int wr, int wc, int fr, int fq) const {
        const int pn = u.pn;
        const int row0 = u.pm * BM + wr * 64 + fr;
        if (pn < 4) {
#pragma unroll
            for (int ai = 0; ai < 2; ++ai)
#pragma unroll
                for (int m = 0; m < 4; ++m) {
                    const int row = row0 + ai * HALF + m * 16;
                    long toff = -1;
                    if (row < NP) { const int s = row & 2047; if (s >= 2018) toff = OUT_CONVP + ((long)(row >> 11) * 30 + (s - 2018)) * 512; }
                    else { const int rr = row - NP; const int i = rr & 63; if (i >= 34) toff = OUT_CONVS + ((long)(rr >> 6) * 30 + (i - 34)) * 512; }
#pragma unroll
                    for (int n = 0; n < 2; ++n) {
                        const int c = 128 * pn + 32 * wc + 16 * n + 4 * fq;
                        const f32x4 x = acc[ai][0][m][n], g = acc[ai][1][m][n];
                        f32x4 a;
#pragma unroll
                        for (int j = 0; j < 4; ++j) a[j] = x[j] / (1.f + __expf(-g[j]));
                        *(u32x2*)(A + (size_t)row * 512 + c) = pack4(a);
                        if (toff >= 0) *(f32x4*)(out + toff + c) = a;
                    }
                }
        } else {
            const int sec = (pn - 4) >> 1, colbase = ((pn - 4) & 1) * 256;
#pragma unroll
            for (int ai = 0; ai < 2; ++ai)
#pragma unroll
                for (int m = 0; m < 4; ++m) {
                    const int row = row0 + ai * HALF + m * 16;
                    const bool isp = row < NP; const int rr = row - NP;
                    bf16_t* bdst; float* fdst;
                    if (sec == 0) { bdst = Q + (size_t)row * 512; fdst = nullptr; }
                    else if (sec == 1) { bdst = isp ? KP + (size_t)row * 512 : KS + ((size_t)(rr >> 6) * SKV + 2048 + (rr & 63)) * 512; fdst = isp ? out + OUT_KP + (size_t)row * 512 : out + OUT_KS + (size_t)rr * 512; }
                    else { bdst = isp ? VP + (size_t)row * 512 : VS + ((size_t)(rr >> 6) * SKV + 2048 + (rr & 63)) * 512; fdst = isp ? out + OUT_VP + (size_t)row * 512 : out + OUT_VS + (size_t)rr * 512; }
#pragma unroll
                    for (int bj = 0; bj < 2; ++bj)
#pragma unroll
                        for (int n = 0; n < 2; ++n) {
                            const int col = colbase + 128 * bj + 32 * wc + 16 * n + 4 * fq;
                            const f32x4 v = acc[ai][bj][m][n];
                            if (sec == 0) { *(u32x2*)(bdst + col) = pack4(v * QSCALE); }
                            else { *(u32x2*)(bdst + col) = pack4(v); *(f32x4*)(fdst + col) = v; }
                        }
                }
        }
    }
};
struct EpiRes {
    static constexpr bool PERM = false, AFTER_DRAIN = false;
    const float* xp; const float* xs; float* out;
    __device__ __forceinline__ void operator()(const f32x4 (&acc)[2][2][4][2], const Unit& u, int wr, int wc, int fr, int fq) const {
        const int row0 = u.pm * BM + wr * 64 + fr;
#pragma unroll
        for (int ai = 0; ai < 2; ++ai)
#pragma unroll
            for (int m = 0; m < 4; ++m) {
                const int row = row0 + ai * HALF + m * 16;
                const float* xr = row < NP ? xp + (size_t)row * DM : xs + (size_t)(row - NP) * DM;
                float* orow = out + (size_t)row * DM;
#pragma unroll
                for (int bj = 0; bj < 2; ++bj)
#pragma unroll
                    for (int n = 0; n < 2; ++n) {
                        const int col = u.pn * BM + 128 * bj + 32 * wc + 16 * n + 4 * fq;
                        *(f32x4*)(orow + col) = *(const f32x4*)(xr + col) + acc[ai][bj][m][n];
                    }
            }
    }
};
}

__device__ __forceinline__ int winrow(int n) { return n < 1024 ? (256 * ((n & 511) >> 7) + 128 * (n >> 9) + (n & 127)) : n; }
template <bool WIN> __device__ __forceinline__ void transpose_item(const float* W, int K, int N, bf16_t* WT, LAS float* scr, int item, int lane) {
    const int nblk = N / 32, kb = item / nblk, nb = item % nblk, k0 = 64 * kb, n0 = 32 * nb;
#pragma unroll 8
    for (int i = 0; i < 32; ++i) { const int kk = 2 * i + (lane >> 5); scr[kk * 33 + (lane & 31)] = W[(size_t)(k0 + kk) * N + n0 + (lane & 31)]; }
    LDS_WAIT();
    const int c = lane & 7;
#pragma unroll
    for (int j = 0; j < 4; ++j) {
        const int n = (lane >> 3) + 8 * j; const LAS float* s = scr + (8 * c) * 33 + n;
        u32x4 o; o.x = cvtpk(s[0 * 33], s[1 * 33]); o.y = cvtpk(s[2 * 33], s[3 * 33]); o.z = cvtpk(s[4 * 33], s[5 * 33]); o.w = cvtpk(s[6 * 33], s[7 * 33]);
        const int dr = WIN ? winrow(n0 + n) : (n0 + n);
        *(u32x4*)(WT + (size_t)dr * K + k0 + 8 * c) = o;
    }
    LDS_WAIT();
}
__device__ __forceinline__ void cvt_stream(const float* src, bf16_t* dst, size_t n8, size_t gt, size_t ngt) {
    for (size_t i = gt; i < n8; i += ngt) {
        const f32x4 a = *(const f32x4*)(src + i * 8), b = *(const f32x4*)(src + i * 8 + 4);
        u32x4 o; o.x = cvtpk(a[0], a[1]); o.y = cvtpk(a[2], a[3]); o.z = cvtpk(b[0], b[1]); o.w = cvtpk(b[2], b[3]);
        *(u32x4*)(dst + i * 8) = o;
    }
}
__device__ __forceinline__ void cvt_cache(const float* src, bf16_t* dst, size_t gt, size_t ngt) {
    const size_t n8 = (size_t)8 * 2048 * 512 / 8;
    for (size_t i = gt; i < n8; i += ngt) {
        const size_t e = i * 8; const size_t row = e >> 9, col = e & 511; const size_t drow = (row >> 11) * SKV + (row & 2047);
        const f32x4 a = *(const f32x4*)(src + e), b = *(const f32x4*)(src + e + 4);
        u32x4 o; o.x = cvtpk(a[0], a[1]); o.y = cvtpk(a[2], a[3]); o.z = cvtpk(b[0], b[1]); o.w = cvtpk(b[2], b[3]);
        *(u32x4*)(dst + drow * 512 + col) = o;
    }
}
__device__ __forceinline__ void rms_row_bf16(const float* xrow, const float* g, bf16_t* orow, int lane) {
    const f32x4* xr = (const f32x4*)xrow + lane; const f32x4* gr = (const f32x4*)g + lane;
    f32x4 v[4]; float s = 0.f;
#pragma unroll
    for (int j = 0; j < 4; ++j) { v[j] = xr[64 * j]; s += (v[j][0] * v[j][0] + v[j][1] * v[j][1]) + (v[j][2] * v[j][2] + v[j][3] * v[j][3]); }
    const float rstd = 1.f / sqrtf(wave_sum(s) * (1.f / DM) + EPS);
    u32x2* o8 = (u32x2*)orow + lane;
#pragma unroll
    for (int j = 0; j < 4; ++j) { const f32x4 gg = gr[64 * j]; u32x2 w; w.x = cvtpk(v[j][0] * rstd * gg[0], v[j][1] * rstd * gg[1]); w.y = cvtpk(v[j][2] * rstd * gg[2], v[j][3] * rstd * gg[3]); o8[64 * j] = w; }
}

__device__ __forceinline__ void cvt_row_fp8(const float* src, unsigned char* dst, float* scale_out, int lane) {
    const f32x4* xr = (const f32x4*)src + lane;
    f32x4 v[4]; float am = 0.f;
#pragma unroll
    for (int j = 0; j < 4; ++j) { v[j] = xr[64 * j]; am = fmaxf(am, fmaxf(fmaxf(fabsf(v[j][0]), fabsf(v[j][1])), fmaxf(fabsf(v[j][2]), fabsf(v[j][3])))); }
#pragma unroll
    for (int o = 1; o < 64; o <<= 1) am = fmaxf(am, __shfl_xor(am, o));
    const float sc = am > 0.f ? am * (1.f / 448.f) : 1.f, inv = 1.f / sc;
#pragma unroll
    for (int j = 0; j < 4; ++j) {
        const int eb = 256 * j + 4 * lane;
        const int pos = 16 * ((eb & 511) >> 3) + (eb & 7) + (eb >= 512 ? 8 : 0);
        int w = __builtin_amdgcn_cvt_pk_fp8_f32(v[j][0] * inv, v[j][1] * inv, 0, false);
        w = __builtin_amdgcn_cvt_pk_fp8_f32(v[j][2] * inv, v[j][3] * inv, w, true);
        *(int*)(dst + pos) = w;
    }
    if (lane == 0) *scale_out = sc;
}

__device__ __forceinline__ void phase0(const Params& p, LAS unsigned char* lds, int tid, int lane, int wave) {
    const int gw = blockIdx.x * 8 + wave, NGW = gridDim.x * 8;
    LAS float* scr = (LAS float*)(lds + wave * 16384);
    bf16_t* WINT = (bf16_t*)(p.ws + WS_WINT); bf16_t* WOUTT = (bf16_t*)(p.ws + WS_WOUTT); bf16_t* WQT = (bf16_t*)(p.ws + WS_WQT);
    constexpr int I_IN = 16 * (DIN / 32), I_OUT = 16 * (1024 / 32), I_Q = 16 * (2048 / 32);
    for (int it = gw; it < I_IN + I_OUT + I_Q; it += NGW) {
        int r = it;
        if (r < I_IN) { transpose_item<true>(p.in[6], 1024, DIN, WINT, scr, r, lane); continue; } r -= I_IN;
        if (r < I_OUT) { transpose_item<false>(p.in[17], 1024, 1024, WOUTT, scr, r, lane); continue; } r -= I_OUT;
        transpose_item<false>(p.in[19], 1024, 2048, WQT, scr, r, lane);
    }
    const size_t gt = (size_t)blockIdx.x * 512 + tid, ngt = (size_t)gridDim.x * 512;
    for (int r = gw; r < 2 * 16384; r += NGW) {
        const int tb = r >> 14, e = r & 16383;
        cvt_row_fp8((tb ? p.in[22] : p.in[21]) + (size_t)e * DM, p.ws + (tb ? WS_PV8 : WS_PU8) + (size_t)e * DM, (float*)(p.ws + (tb ? WS_SCV : WS_SCU)) + e, lane);
    }
    cvt_stream(p.in[20], (bf16_t*)(p.ws + WS_SK), (size_t)16 * 128 * 128 / 8, gt, ngt);
    cvt_cache(p.in[2], (bf16_t*)(p.ws + WS_KS), gt, ngt);
    cvt_cache(p.in[3], (bf16_t*)(p.ws + WS_VS), gt, ngt);
    bf16_t* H = (bf16_t*)(p.ws + WS_H);
    for (int m = gw; m < NT; m += NGW) {
        const float* xr = m < NP ? p.in[0] + (size_t)m * DM : p.in[1] + (size_t)(m - NP) * DM;
        rms_row_bf16(xr, p.in[5], H + (size_t)m * DM, lane);
    }
}

namespace att {
constexpr int KPITCH = 272, VPITCH = 320;
constexpr int L_KV = 0, KV_BYTES = 64 * KPITCH + 64 * VPITCH  , L_X = 0  , L_BIAS = BIAS_OFF, L_CA = 0  , L_CW = 94 * 1024  ;
static_assert(4 * 4096 * 4 <= 2 * KV_BYTES && 2 * KV_BYTES <= L_CW && L_CW + 31 * 1024 <= RING_BYTES, "attention LDS map");

__device__ __forceinline__ int rel_bucket(int rel) {
    const int ret = rel > 0 ? 16 : 0; const int n = rel < 0 ? -rel : rel; int v;
    if (n < 8) v = n; else if (n < 12) v = 8; else if (n < 16) v = 9; else if (n < 23) v = 10; else if (n < 32) v = 11;
    else if (n < 46) v = 12; else if (n < 64) v = 13; else if (n < 91) v = 14; else v = 15;
    return ret + v;
}
typedef short v4i16_t __attribute__((ext_vector_type(4)));
__device__ __forceinline__ s16x4 vtr(const LAS unsigned char* p) { return __builtin_bit_cast(s16x4, __builtin_amdgcn_ds_read_tr16_b64_v4i16((LAS v4i16_t*)p)); }
__device__ __forceinline__ f32x16 mfma32(bf16x8 a, bf16x8 b, f32x16 c) { return __builtin_amdgcn_mfma_f32_32x32x16_bf16(a, b, c, 0, 0, 0); }

__device__ __forceinline__ void attn_unit(const Params& p, LAS unsigned char* lds, int kind, int bb, int h, int qblk, float lam, int tid, int lane, int wid) {
    const bf16_t* Q = (const bf16_t*)(p.ws + WS_Q);
    const bf16_t* Kb = kind == 0 ? (const bf16_t*)(p.ws + WS_KP) + (size_t)bb * 2048 * 512 + h * 128 : (const bf16_t*)(p.ws + WS_KS) + (size_t)bb * SKV * 512 + h * 128;
    const bf16_t* Vb = kind == 0 ? (const bf16_t*)(p.ws + WS_VP) + (size_t)bb * 2048 * 512 + h * 128 : (const bf16_t*)(p.ws + WS_VS) + (size_t)bb * SKV * 512 + h * 128;
    bf16_t* MIX = (bf16_t*)(p.ws + WS_MIX);
    const int qrow0 = kind == 0 ? bb * 2048 + qblk * 128 : NP + bb * 64;
    const int qpos0 = kind == 0 ? qblk * 128 : 2048;
    const int ntiles = kind == 0 ? 2 * qblk + 2 : 33;
    const int rg = wid & 3, map = wid >> 2, r32 = lane & 31, hi = lane >> 5;
    const bool active = kind == 0 ? true : (rg < 2);
    const int cw = kind == 0 ? 2 * qblk + (rg >> 1) : 32;
    const int qw0 = qpos0 + 32 * rg;
    const int qabs = qw0 + r32;

    bf16x8 qf[4];
    if (active) {
        const bf16_t* qp = Q + (size_t)(qrow0 + 32 * rg + r32) * 512 + h * 128 + map * 64 + 8 * hi;
#pragma unroll
        for (int s = 0; s < 4; ++s) qf[s] = *(const bf16x8*)(qp + 16 * s);
    } else {
#pragma unroll
        for (int s = 0; s < 4; ++s) qf[s] = (bf16x8){0, 0, 0, 0, 0, 0, 0, 0};
    }
    float m = -1e30f, l = 0.f;
    f32x16 o[4];
#pragma unroll
    for (int mt = 0; mt < 4; ++mt)
#pragma unroll
        for (int r = 0; r < 16; ++r) o[mt][r] = 0.f;

    const int srow0 = tid >> 4, sch = tid & 15;
    const LAS float* btab = (const LAS float*)(lds + L_BIAS) + h * 320;
    const float biasfar = btab[0];
    const int vlane = (4 * hi + ((lane & 15) >> 2)) * VPITCH + (16 * ((lane >> 4) & 1) + 4 * (lane & 3)) * 2;
    u32x4 kA[2], vA[2], kB[2], vB[2];
#define ATT_LOAD(KR, VR, T) do { _Pragma("unroll") for (int i_ = 0; i_ < 2; ++i_) { const size_t off_ = (size_t)((T) * 64 + srow0 + 32 * i_) * 512 + sch * 8; KR[i_] = *(const u32x4*)(Kb + off_); VR[i_] = *(const u32x4*)(Vb + off_); } } while (0)
#define ATT_STORE(KR, VR, BUF) do { _Pragma("unroll") for (int i_ = 0; i_ < 2; ++i_) { \
        *(LAS u32x4*)(lds + L_KV + (BUF) * KV_BYTES + (srow0 + 32 * i_) * KPITCH + sch * 16) = KR[i_]; \
        *(LAS u32x4*)(lds + L_KV + (BUF) * KV_BYTES + 64 * KPITCH + (srow0 + 32 * i_) * VPITCH + sch * 16) = VR[i_]; } } while (0)
    auto compute = [&](int t, int buf) {
        const LAS unsigned char* kbuf = lds + L_KV + buf * KV_BYTES;
        const LAS unsigned char* vbuf = kbuf + 64 * KPITCH;
        f32x16 p0, p1;
        const int kabs0 = t * 64;
        if (kabs0 + 63 - qw0 > -128) {
            const LAS float* bt = btab + (kabs0 - qabs + 256 + 4 * hi);
#pragma unroll
            for (int r = 0; r < 16; ++r) { p0[r] = bt[(r & 3) + 8 * (r >> 2)]; p1[r] = bt[32 + (r & 3) + 8 * (r >> 2)]; }
        } else {
#pragma unroll
            for (int r = 0; r < 16; ++r) { p0[r] = biasfar; p1[r] = biasfar; }
        }
        const LAS unsigned char* kb = kbuf + r32 * KPITCH + (map * 8 + hi) * 16;
#pragma unroll
        for (int s = 0; s < 4; ++s) {
            const bf16x8 a0 = *(const LAS bf16x8*)(kb + s * 32), a1 = *(const LAS bf16x8*)(kb + 32 * KPITCH + s * 32);
            p0 = mfma32(a0, qf[s], p0); p1 = mfma32(a1, qf[s], p1);
        }
        __builtin_amdgcn_sched_barrier(0);
        float mx = fmaxf(p0[0], p1[0]);
#pragma unroll
        for (int r = 1; r < 16; ++r) mx = fmaxf(mx, fmaxf(p0[r], p1[r]));
        mx = fmaxf(mx, __shfl_xor(mx, 32));
        const float mn = fmaxf(m, mx);
        const float alpha = __builtin_amdgcn_exp2f(m - mn);
        m = mn;
        float rs = 0.f;
#pragma unroll
        for (int r = 0; r < 16; ++r) { p0[r] = __builtin_amdgcn_exp2f(p0[r] - mn); p1[r] = __builtin_amdgcn_exp2f(p1[r] - mn); rs += p0[r] + p1[r]; }
        l = l * alpha + rs;
#pragma unroll
        for (int mt = 0; mt < 4; ++mt)
#pragma unroll
            for (int r = 0; r < 16; ++r) o[mt][r] *= alpha;
        __builtin_amdgcn_sched_barrier(0);
#pragma unroll
        for (int t2 = 0; t2 < 2; ++t2)
#pragma unroll
            for (int s = 0; s < 2; ++s) {
                u32x4 bw;
                if (t2 == 0) { bw.x = cvtpk(p0[8 * s + 0], p0[8 * s + 1]); bw.y = cvtpk(p0[8 * s + 2], p0[8 * s + 3]); bw.z = cvtpk(p0[8 * s + 4], p0[8 * s + 5]); bw.w = cvtpk(p0[8 * s + 6], p0[8 * s + 7]); }
                else { bw.x = cvtpk(p1[8 * s + 0], p1[8 * s + 1]); bw.y = cvtpk(p1[8 * s + 2], p1[8 * s + 3]); bw.z = cvtpk(p1[8 * s + 4], p1[8 * s + 5]); bw.w = cvtpk(p1[8 * s + 6], p1[8 * s + 7]); }
                const bf16x8 B = __builtin_bit_cast(bf16x8, bw);
                const LAS unsigned char* vb = vbuf + vlane + (32 * t2 + 16 * s) * VPITCH;
#pragma unroll
                for (int mt = 0; mt < 4; ++mt) {
                    const s16x4 lo = vtr(vb + mt * 64), hi8 = vtr(vb + mt * 64 + 8 * VPITCH);
                    const bf16x8 A = (bf16x8){lo[0], lo[1], lo[2], lo[3], hi8[0], hi8[1], hi8[2], hi8[3]};
                    o[mt] = mfma32(A, B, o[mt]);
                }
            }
    };
    ATT_LOAD(kA, vA, 0);
    if (ntiles > 1) ATT_LOAD(kB, vB, 1);
    ATT_STORE(kA, vA, 0);
    if (ntiles > 2) ATT_LOAD(kA, vA, 2);
    __syncthreads();
    for (int t = 0; t < ntiles; t += 2) {
        if (t + 1 < ntiles) { ATT_STORE(kB, vB, 1); if (t + 3 < ntiles) ATT_LOAD(kB, vB, t + 3); }
        if (active && t <= cw) compute(t, 0);
        __syncthreads();
        if (t + 1 >= ntiles) break;
        if (t + 2 < ntiles) { ATT_STORE(kA, vA, 0); if (t + 4 < ntiles) ATT_LOAD(kA, vA, t + 4); }
        if (active && t + 1 <= cw) compute(t + 1, 1);
        __syncthreads();
    }
#undef ATT_LOAD
#undef ATT_STORE
    l += __shfl_xor(l, 32);
    const float inv = 1.f / l;
    LAS float* X = (LAS float*)(lds + L_X) + rg * 4096;
    if (active && map == 1) {
        const float sc = -lam * inv;
#pragma unroll
        for (int mt = 0; mt < 4; ++mt)
#pragma unroll
            for (int r = 0; r < 16; ++r) X[(mt * 16 + r) * 64 + lane] = o[mt][r] * sc;
    }
    __syncthreads();
    if (active && map == 0) {
        float ss = 0.f;
#pragma unroll
        for (int mt = 0; mt < 4; ++mt)
#pragma unroll
            for (int r = 0; r < 16; ++r) { const float v = o[mt][r] * inv + X[(mt * 16 + r) * 64 + lane]; o[mt][r] = v; ss += v * v; }
        ss += __shfl_xor(ss, 32);
        const float rsn = 0.8f / sqrtf(ss * (1.f / 128.f) + EPS);
        bf16_t* orow = MIX + (size_t)(qrow0 + 32 * rg + r32) * 1024 + 512 + h * 128;
        const float* sg = p.in[15];
#pragma unroll
        for (int mt = 0; mt < 4; ++mt)
#pragma unroll
            for (int g4 = 0; g4 < 4; ++g4) {
                const int e = 32 * mt + 8 * g4 + 4 * hi;
                const f32x4 gg = *(const f32x4*)(sg + e);
                u32x2 w; w.x = cvtpk(o[mt][4 * g4 + 0] * rsn * gg[0], o[mt][4 * g4 + 1] * rsn * gg[1]); w.y = cvtpk(o[mt][4 * g4 + 2] * rsn * gg[2], o[mt][4 * g4 + 3] * rsn * gg[3]);
                *(u32x2*)(orow + e) = w;
            }
    }
    __syncthreads();
}

__device__ __forceinline__ void unpack8(const u32x4 w, float (&f)[8]) { f[0] = bflo(w.x); f[1] = bfhi(w.x); f[2] = bflo(w.y); f[3] = bfhi(w.y); f[4] = bflo(w.z); f[5] = bfhi(w.z); f[6] = bflo(w.w); f[7] = bfhi(w.w); }
__device__ __forceinline__ void conv_unit(const Params& p, LAS unsigned char* lds, int cu, int tid, int lane, int wid) {
    const bf16_t* A = (const bf16_t*)(p.ws + WS_A);
    bf16_t* MIX = (bf16_t*)(p.ws + WS_MIX);
    const float* cb = p.in[8]; const float* lg = p.in[9]; const float* lb = p.in[10]; const float* st = p.in[4];
    const int row0 = cu * 64;
    const bool isp = row0 < NP;
    const int s0 = isp ? (row0 & 2047) : 0, rbase = row0 - s0, bd = isp ? 0 : ((row0 - NP) >> 6);
    for (int c = tid; c < 94 * 64; c += 512) {
        const int rr = c >> 6, ch = c & 63, sp = s0 - 30 + rr;
        u32x4 v = (u32x4){0u, 0u, 0u, 0u};
        if (sp >= 0) v = *(const u32x4*)(A + (size_t)(rbase + sp) * 512 + ch * 8);
        else if (!isp) { const float* sr = st + ((size_t)bd * 30 + (30 + sp)) * 512 + ch * 8; const f32x4 a0 = *(const f32x4*)sr, a1 = *(const f32x4*)(sr + 4);
            v.x = cvtpk(a0[0], a0[1]); v.y = cvtpk(a0[2], a0[3]); v.z = cvtpk(a1[0], a1[1]); v.w = cvtpk(a1[2], a1[3]); }
        *(LAS u32x4*)(lds + L_CA + rr * 1024 + ch * 16) = v;
    }
    __syncthreads();
    const int c0 = lane * 8;
    float bias8[8], g8[8], b8[8];
    { const f32x4 x0 = *(const f32x4*)(cb + c0), x1 = *(const f32x4*)(cb + c0 + 4), y0 = *(const f32x4*)(lg + c0), y1 = *(const f32x4*)(lg + c0 + 4), z0 = *(const f32x4*)(lb + c0), z1 = *(const f32x4*)(lb + c0 + 4);
#pragma unroll
      for (int q = 0; q < 4; ++q) { bias8[q] = x0[q]; bias8[4 + q] = x1[q]; g8[q] = y0[q]; g8[4 + q] = y1[q]; b8[q] = z0[q]; b8[4 + q] = z1[q]; } }
    for (int grp = 0; grp < 2; ++grp) {
        const int t0 = wid * 8 + grp * 4;
        float acc[4][8];
#pragma unroll
        for (int q = 0; q < 4; ++q)
#pragma unroll
            for (int c = 0; c < 8; ++c) acc[q][c] = bias8[c];
        const LAS unsigned char* ap = lds + L_CA + t0 * 1024 + lane * 16;
        const LAS unsigned char* wp = lds + L_CW + lane * 16;
#pragma unroll 1
        for (int j = 0; j < 31; ++j) {
            float w[8]; unpack8(*(const LAS u32x4*)(wp + j * 1024), w);
#pragma unroll
            for (int q = 0; q < 4; ++q) {
                float a[8]; unpack8(*(const LAS u32x4*)(ap + (j + q) * 1024), a);
#pragma unroll
                for (int c = 0; c < 8; ++c) acc[q][c] += w[c] * a[c];
            }
        }
#pragma unroll
        for (int q = 0; q < 4; ++q) {
            float sm = 0.f;
#pragma unroll
            for (int c = 0; c < 8; ++c) sm += acc[q][c];
            const float mu = wave_total(sm) * (1.f / 512.f);
            float sv = 0.f;
#pragma unroll
            for (int c = 0; c < 8; ++c) { acc[q][c] -= mu; sv += acc[q][c] * acc[q][c]; }
            const float rstd = 1.f / sqrtf(wave_total(sv) * (1.f / 512.f) + EPS);
            float y[8];
#pragma unroll
            for (int c = 0; c < 8; ++c) { y[c] = acc[q][c] * rstd * g8[c] + b8[c]; y[c] = y[c] / (1.f + __expf(-y[c])); }
            u32x4 w; w.x = cvtpk(y[0], y[1]); w.y = cvtpk(y[2], y[3]); w.z = cvtpk(y[4], y[5]); w.w = cvtpk(y[6], y[7]);
            *(u32x4*)(MIX + (size_t)(row0 + t0 + q) * 1024 + c0) = w;
        }
    }
}

constexpr int N_SAMPLE_UNITS = 32, N_PROMPT_UNITS = 1024, N_CONV_UNITS = NT / 64, N_UNITS = N_SAMPLE_UNITS + N_PROMPT_UNITS + N_CONV_UNITS;

__device__ __forceinline__ void phase2(const Params& p, LAS unsigned char* lds, int tid, int lane, int wid, int cidx, int mode) {
    LAS float* bt = (LAS float*)(lds + L_BIAS);
    for (int e = tid; e < 4 * 320; e += 512) { const int hh = e / 320, rel = (e % 320) - 256; bt[e] = p.in[16][rel_bucket(rel) * 4 + hh] * LOG2E; }
    for (int c = tid; c < 31 * 64; c += 512) {
        const float* wr = p.in[7] + (size_t)c * 8; const f32x4 a0 = *(const f32x4*)wr, a1 = *(const f32x4*)(wr + 4);
        u32x4 v; v.x = cvtpk(a0[0], a0[1]); v.y = cvtpk(a0[2], a0[3]); v.z = cvtpk(a1[0], a1[1]); v.w = cvtpk(a1[2], a1[3]);
        *(LAS u32x4*)(lds + L_CW + c * 16) = v;
    }
    const float d1 = wave_sum(p.in[11][lane] * p.in[12][lane]), d2 = wave_sum(p.in[13][lane] * p.in[14][lane]);
    const float lam = expf(d1) - expf(d2) + 0.2f;
    unsigned* ctr = (unsigned*)(p.ws + WS_CTL) + 64 * cidx;
    volatile LAS unsigned* sw = (volatile LAS unsigned*)(lds + MISC_OFF);
    __syncthreads();
    for (;;) {
        __syncthreads();
        if (tid == 0) sw[0] = atomicAdd(ctr, 1u);
        __syncthreads();
        const int u = (int)sw[0];
        if (u >= N_UNITS) break;
        if (mode == 1 && u >= N_SAMPLE_UNITS + N_PROMPT_UNITS) continue;
        if (mode == 2 && u < N_SAMPLE_UNITS + N_PROMPT_UNITS) continue;
        int tid_ = tid; asm volatile("" : "+v"(tid_));
        if (u < N_SAMPLE_UNITS + N_PROMPT_UNITS) {
            const int v = u - N_SAMPLE_UNITS; const int bh = v & 63; const bool smp = u < N_SAMPLE_UNITS;
            attn_unit(p, lds, smp ? 1 : 0, smp ? (u >> 2) : (bh >> 2), smp ? (u & 3) : (bh & 3), smp ? 0 : 15 - (v >> 6), lam, tid_, tid_ & 63, wid);
        } else conv_unit(p, lds, u - N_SAMPLE_UNITS - N_PROMPT_UNITS, tid_, tid_ & 63, wid);
    }
}
}

__device__ __forceinline__ void phase3b(const Params& p, int lane, int wave) {
    const int gw = blockIdx.x * 8 + wave, NGW = gridDim.x * 8;
    bf16_t* H2 = (bf16_t*)(p.ws + WS_H2);
    for (int m = gw; m < NT; m += NGW) rms_row_bf16(p.out + (size_t)m * DM, p.in[18], H2 + (size_t)m * DM, lane);
}

__device__ __forceinline__ void phase4b(const Params& p, int lane, int wave) {
    const int gw = blockIdx.x * 8 + wave, NGW = gridDim.x * 8;
    const bf16_t* QP = (const bf16_t*)(p.ws + WS_QP); const bf16_t* SK = (const bf16_t*)(p.ws + WS_SK);
    float* TK = (float*)(p.ws + WS_TK);
    const int r32 = lane & 31, hi = lane >> 5;
    const float NEG_INF = -__builtin_huge_valf();
    for (int wu = gw; wu < (NT / 32) * 16; wu += NGW) {
        const int rp = wu & 15, t0 = (wu >> 4) * 32;
        bf16x8 qf[8];
        const bf16_t* qp = QP + (size_t)(t0 + r32) * 2048 + rp * 128 + 8 * hi;
#pragma unroll
        for (int s = 0; s < 8; ++s) qf[s] = *(const bf16x8*)(qp + 16 * s);
        float v[64];
#pragma unroll
        for (int mt = 0; mt < 4; ++mt) {
            f32x16 S;
#pragma unroll
            for (int r = 0; r < 16; ++r) S[r] = 0.f;
            const bf16_t* kp = SK + ((size_t)rp * 128 + 32 * mt + r32) * 128 + 8 * hi;
#pragma unroll
            for (int s = 0; s < 8; ++s) S = att::mfma32(*(const bf16x8*)(kp + 16 * s), qf[s], S);
#pragma unroll
            for (int r = 0; r < 16; ++r) { const int n = 32 * mt + (r & 3) + 8 * (r >> 2) + 4 * hi; v[mt * 16 + r] = __uint_as_float((__float_as_uint(S[r]) & ~127u) | (unsigned)(127 - n)); }
        }
        float* dst = TK + ((size_t)(t0 + r32) * 16 + rp) * 16;
        for (int it = 0; it < 16; ++it) {
            float mx = v[0];
#pragma unroll
            for (int i = 1; i < 64; ++i) mx = fmaxf(mx, v[i]);
            mx = fmaxf(mx, __shfl_xor(mx, 32));
            if (hi == 0) dst[it] = mx;
#pragma unroll
            for (int i = 0; i < 64; ++i) v[i] = (v[i] == mx) ? NEG_INF : v[i];
        }
    }
}

__device__ __forceinline__ void phase5a(const Params& p, int tid) {
    const float* TK = (const float*)(p.ws + WS_TK);
    int* IDX = (int*)(p.ws + WS_IDX); float* GATE = (float*)(p.ws + WS_GATE);
    const float NEG_INF = -__builtin_huge_valf();
    for (int item = blockIdx.x * 512 + tid; item < NT * 8; item += gridDim.x * 512) {
        const int tok = item >> 3, r = item & 7;
        const f32x4* pa = (const f32x4*)(TK + ((size_t)tok * 16 + 2 * r) * 16);
        float a[16], b[16]; int ia[16], ib[16];
#pragma unroll
        for (int q = 0; q < 4; ++q) { const f32x4 x = pa[q], y = pa[4 + q];
#pragma unroll
            for (int j = 0; j < 4; ++j) { a[4 * q + j] = x[j]; b[4 * q + j] = y[j]; } }
#pragma unroll
        for (int i = 0; i < 16; ++i) { const unsigned ua = __float_as_uint(a[i]), ub = __float_as_uint(b[i]); ia[i] = 127 - (int)(ua & 127u); ib[i] = 127 - (int)(ub & 127u); a[i] = __uint_as_float(ua & ~127u); b[i] = __uint_as_float(ub & ~127u); }
        float cv[50]; int cid[50];
        {
            int c = 0;
#pragma unroll
            for (int i = 0; i < 16; ++i)
#pragma unroll
                for (int j = 0; j < 16; ++j)
                    if ((i + 1) * (j + 1) <= 16) { const float s = a[i] + b[j]; cv[c] = __uint_as_float((__float_as_uint(s) & ~63u) | (unsigned)(63 - c)); cid[c] = ia[i] * 128 + ib[j]; ++c; }
        }
        float best[16]; int bid[16];
#pragma unroll
        for (int it = 0; it < 16; ++it) {
            float mx = cv[0];
#pragma unroll
            for (int c = 1; c < 50; ++c) mx = fmaxf(mx, cv[c]);
            int id = 0;
#pragma unroll
            for (int c = 0; c < 50; ++c) { const bool hit = cv[c] == mx; id = hit ? cid[c] : id; cv[c] = hit ? NEG_INF : cv[c]; }
            best[it] = __uint_as_float(__float_as_uint(mx) & ~63u); bid[it] = id;
        }
        float e[16], sum = 0.f;
#pragma unroll
        for (int k = 0; k < 16; ++k) { e[k] = __expf(best[k] - best[0]); sum += e[k]; }
        const float rinv = 1.f / sum;
        int* io = IDX + (size_t)tok * 128 + r * 16; float* go = GATE + (size_t)tok * 128 + r * 16;
#pragma unroll
        for (int k = 0; k < 16; ++k) { io[k] = bid[k]; go[k] = e[k] * rinv; }
    }
}

__device__ __forceinline__ float gelu_erf(float x) { return 0.5f * x * (1.f + erff(x * 0.70710678118654752f)); }
__device__ __forceinline__ void fp8x16_to_f32(const u32x4 q, float (&f)[16]) {
    const f32x2 c0 = __builtin_amdgcn_cvt_pk_f32_fp8(q.x, false), c1 = __builtin_amdgcn_cvt_pk_f32_fp8(q.x, true), c2 = __builtin_amdgcn_cvt_pk_f32_fp8(q.y, false), c3 = __builtin_amdgcn_cvt_pk_f32_fp8(q.y, true);
    const f32x2 c4 = __builtin_amdgcn_cvt_pk_f32_fp8(q.z, false), c5 = __builtin_amdgcn_cvt_pk_f32_fp8(q.z, true), c6 = __builtin_amdgcn_cvt_pk_f32_fp8(q.w, false), c7 = __builtin_amdgcn_cvt_pk_f32_fp8(q.w, true);
    f[0] = c0.x; f[1] = c0.y; f[2] = c1.x; f[3] = c1.y; f[4] = c2.x; f[5] = c2.y; f[6] = c3.x; f[7] = c3.y;
    f[8] = c4.x; f[9] = c4.y; f[10] = c5.x; f[11] = c5.y; f[12] = c6.x; f[13] = c6.y; f[14] = c7.x; f[15] = c7.y;
}
__device__ __forceinline__ void phase5b(const Params& p, int lane, int wave, float* yout) {
    const int gw = blockIdx.x * 8 + wave, NGW = gridDim.x * 8;
    const bf16_t* H2 = (const bf16_t*)(p.ws + WS_H2); const unsigned char* PU8 = p.ws + WS_PU8; const unsigned char* PV8 = p.ws + WS_PV8;
    const float* SCU = (const float*)(p.ws + WS_SCU); const float* SCV = (const float*)(p.ws + WS_SCV);
    const int* IDX = (const int*)(p.ws + WS_IDX); const float* GATE = (const float*)(p.ws + WS_GATE);
    const float* gf = p.in[23];
    for (int tok = gw; tok < NT; tok += NGW) {
        const int idxA = IDX[(size_t)tok * 128 + lane], idxB = IDX[(size_t)tok * 128 + 64 + lane];
        const float gA = GATE[(size_t)tok * 128 + lane], gB = GATE[(size_t)tok * 128 + 64 + lane];
        const float suA = SCU[idxA], suB = SCU[idxB], svA = SCV[idxA], svB = SCV[idxB];
        float hf[16];
        { const u32x4 hA = *(const u32x4*)(H2 + (size_t)tok * DM + lane * 8), hB = *(const u32x4*)(H2 + (size_t)tok * DM + 512 + lane * 8);
          hf[0] = bflo(hA.x); hf[1] = bfhi(hA.x); hf[2] = bflo(hA.y); hf[3] = bfhi(hA.y); hf[4] = bflo(hA.z); hf[5] = bfhi(hA.z); hf[6] = bflo(hA.w); hf[7] = bfhi(hA.w);
          hf[8] = bflo(hB.x); hf[9] = bfhi(hB.x); hf[10] = bflo(hB.y); hf[11] = bfhi(hB.y); hf[12] = bflo(hB.z); hf[13] = bfhi(hB.z); hf[14] = bflo(hB.w); hf[15] = bfhi(hB.w); }
        float actA = 0.f, actB = 0.f;
#pragma unroll 8
        for (int k = 0; k < 64; ++k) {
            const int e = __builtin_amdgcn_readlane(idxA, k);
            float f[16]; fp8x16_to_f32(*(const u32x4*)(PU8 + (size_t)e * DM + lane * 16), f);
            float s0 = f[0] * hf[0], s1 = f[1] * hf[1];
#pragma unroll
            for (int j = 2; j < 16; j += 2) { s0 += f[j] * hf[j]; s1 += f[j + 1] * hf[j + 1]; }
            const float s = wave_total(s0 + s1);
            actA = (lane == k) ? s : actA;
        }
#pragma unroll 8
        for (int k = 0; k < 64; ++k) {
            const int e = __builtin_amdgcn_readlane(idxB, k);
            float f[16]; fp8x16_to_f32(*(const u32x4*)(PU8 + (size_t)e * DM + lane * 16), f);
            float s0 = f[0] * hf[0], s1 = f[1] * hf[1];
#pragma unroll
            for (int j = 2; j < 16; j += 2) { s0 += f[j] * hf[j]; s1 += f[j + 1] * hf[j + 1]; }
            const float s = wave_total(s0 + s1);
            actB = (lane == k) ? s : actB;
        }
        const float cA = gA * gelu_erf(actA * suA) * svA, cB = gB * gelu_erf(actB * suB) * svB;
        float acc[16];
#pragma unroll
        for (int j = 0; j < 16; ++j) acc[j] = 0.f;
#pragma unroll 8
        for (int k = 0; k < 64; ++k) {
            const int e = __builtin_amdgcn_readlane(idxA, k);
            const float c = rl_f(cA, k);
            float f[16]; fp8x16_to_f32(*(const u32x4*)(PV8 + (size_t)e * DM + lane * 16), f);
#pragma unroll
            for (int j = 0; j < 16; ++j) acc[j] += c * f[j];
        }
#pragma unroll 8
        for (int k = 0; k < 64; ++k) {
            const int e = __builtin_amdgcn_readlane(idxB, k);
            const float c = rl_f(cB, k);
            float f[16]; fp8x16_to_f32(*(const u32x4*)(PV8 + (size_t)e * DM + lane * 16), f);
#pragma unroll
            for (int j = 0; j < 16; ++j) acc[j] += c * f[j];
        }
        const float* xr = p.out + (size_t)tok * DM; float* yr = yout + (size_t)tok * DM;
        f32x4 x[4];
        x[0] = *(const f32x4*)(xr + lane * 8); x[1] = *(const f32x4*)(xr + lane * 8 + 4); x[2] = *(const f32x4*)(xr + 512 + lane * 8); x[3] = *(const f32x4*)(xr + 512 + lane * 8 + 4);
        float ss = 0.f;
#pragma unroll
        for (int q = 0; q < 4; ++q)
#pragma unroll
            for (int j = 0; j < 4; ++j) { x[q][j] += acc[4 * q + j]; ss += x[q][j] * x[q][j]; }
        const float rstd = 1.f / sqrtf(wave_total(ss) * (1.f / DM) + EPS);
        const f32x4 g0 = *(const f32x4*)(gf + lane * 8), g1 = *(const f32x4*)(gf + lane * 8 + 4), g2 = *(const f32x4*)(gf + 512 + lane * 8), g3 = *(const f32x4*)(gf + 512 + lane * 8 + 4);
        *(f32x4*)(yr + lane * 8) = x[0] * rstd * g0; *(f32x4*)(yr + lane * 8 + 4) = x[1] * rstd * g1;
        *(f32x4*)(yr + 512 + lane * 8) = x[2] * rstd * g2; *(f32x4*)(yr + 512 + lane * 8 + 4) = x[3] * rstd * g3;
    }
}

__global__ void __launch_bounds__(512, 2) fwd_megakernel(Params p) {
    extern __shared__ __attribute__((aligned(16))) unsigned char lds_raw[];
    LAS unsigned char* lds = (LAS unsigned char*)lds_raw;
    cg::grid_group grid = cg::this_grid();
    const int tid = threadIdx.x, lane = tid & 63, wave = __builtin_amdgcn_readfirstlane(tid >> 6);
    const int G = gridDim.x;
    volatile LAS unsigned* MISC = (volatile LAS unsigned*)(lds + MISC_OFF);
    if (tid < 32) MISC[tid] = 0u;
    __syncthreads();
    XcdBarrier bar = xcd_barrier_post((unsigned*)(p.ws + WS_CTL) + 4096, MISC + 8);
#define GSYNC() xcd_barrier(bar)

#ifndef RPT_MASK
#define RPT_MASK 0
#endif
#define RPT(bit) for (int rpt_ = 0; rpt_ < (((RPT_MASK) >> (bit)) & 1) + 1; ++rpt_)
    RPT(0) { phase0(p, lds, tid, lane, wave); grid.sync(); }
    RPT(1) {
        pg8::Gemm g{(const bf16_t*)(p.ws + WS_H), (const bf16_t*)(p.ws + WS_WINT), NT, DIN, 1024};
        pg8::StaticOrder S; S.init(NT, DIN, G, (int)blockIdx.x);
        pg8::EpiProj E{(bf16_t*)(p.ws + WS_A), (bf16_t*)(p.ws + WS_Q), (bf16_t*)(p.ws + WS_KP), (bf16_t*)(p.ws + WS_VP), (bf16_t*)(p.ws + WS_KS), (bf16_t*)(p.ws + WS_VS), p.out};
        pg8::gemm_phase<pg8::EpiProj, pg8::StaticOrder, true, true>(lds, g, S, E);
        GSYNC();
    }
    #ifndef P2MODE
#define P2MODE 0
#endif
    RPT(2) { att::phase2(p, lds, tid, lane, wave, rpt_, (((RPT_MASK) >> 2) & 1) && rpt_ == 0 ? P2MODE : 0); GSYNC(); }
    RPT(3) {
        pg8::Gemm g{(const bf16_t*)(p.ws + WS_MIX), (const bf16_t*)(p.ws + WS_WOUTT), NT, 1024, 1024};
        pg8::StaticOrder S; S.init(NT, 1024, G, (int)blockIdx.x);
        pg8::EpiRes E{p.in[0], p.in[1], p.out};
        pg8::gemm_phase<pg8::EpiRes, pg8::StaticOrder, true, true>(lds, g, S, E);
        GSYNC();
    }
    RPT(4) { phase3b(p, lane, wave); GSYNC(); }
    RPT(5) {
        pg8::Gemm g{(const bf16_t*)(p.ws + WS_H2), (const bf16_t*)(p.ws + WS_WQT), NT, 2048, 1024};
        pg8::StaticOrder S; S.init(NT, 2048, G, (int)blockIdx.x);
        pg8::EpiBf16<0> E{(bf16_t*)(p.ws + WS_QP), 2048, nullptr, 0, 0, 1.f};
        pg8::gemm_phase<pg8::EpiBf16<0>, pg8::StaticOrder, true, true>(lds, g, S, E);
        GSYNC();
    }
    RPT(6) { phase4b(p, lane, wave); GSYNC(); }
    RPT(7) { phase5a(p, tid); GSYNC(); }
    if ((RPT_MASK) & 256) { phase5b(p, lane, wave, (float*)(p.ws + WS_QP)); GSYNC(); }
    phase5b(p, lane, wave, p.out);
}

extern "C" void kernel_launch(void* const* d_in, const int* in_sizes, int n_in, void* d_out, int out_size, void* d_ws, size_t ws_size, hipStream_t stream) {
    static int grid = 0;
    if (grid == 0) {
        if (n_in != 24 || out_size != (int)OUT_TOTAL || ws_size < WS_END) { fprintf(stderr, "kernel_launch: unexpected shapes: n_in %d out %d ws %zu (need %zu)\n", n_in, out_size, ws_size, (size_t)WS_END); grid = -1; return; }
        int dev = 0, cus = 0, per_cu = 0;
        (void)hipGetDevice(&dev);
        (void)hipDeviceGetAttribute(&cus, hipDeviceAttributeMultiprocessorCount, dev);
        if (hipFuncSetAttribute((const void*)fwd_megakernel, hipFuncAttributeMaxDynamicSharedMemorySize, LDS_BYTES) != hipSuccess) { fprintf(stderr, "kernel_launch: hipFuncSetAttribute failed\n"); grid = -1; return; }
        if (hipOccupancyMaxActiveBlocksPerMultiprocessor(&per_cu, (const void*)fwd_megakernel, 512, LDS_BYTES) != hipSuccess || per_cu < 1) { fprintf(stderr, "kernel_launch: occupancy query gave %d\n", per_cu); per_cu = 1; }
        (void)hipGetLastError();
        grid = cus * 1;
        if (per_cu < 1) grid = -1;
    }
    if (grid < 0) return;
    (void)hipMemsetAsync((char*)d_ws + WS_CTL, 0, CTL_BYTES, stream);
    Params p{};
    for (int i = 0; i < 24; ++i) p.in[i] = (const float*)d_in[i];
    p.out = (float*)d_out; p.ws = (unsigned char*)d_ws;
    void* args[] = {&p};
    hipError_t e = hipLaunchCooperativeKernel((const void*)fwd_megakernel, dim3(grid), dim3(512), args, LDS_BYTES, stream);
    if (e != hipSuccess) fprintf(stderr, "cooperative launch failed: %s (grid %d)\n", hipGetErrorString(e), grid);
}
```

```cpp
#include <hip/hip_runtime.h>
#include <hip/hip_cooperative_groups.h>
#include <cstdio>
#include <cstdint>
#include <cmath>
namespace cg = cooperative_groups;
namespace pg8 {
#define PG8_LAS __attribute__((address_space(3)))
typedef unsigned short bf16_t;
typedef short bf16x8 __attribute__((ext_vector_type(8)));
typedef float f32x4 __attribute__((ext_vector_type(4)));
typedef unsigned u32x4 __attribute__((ext_vector_type(4)));
constexpr int BM = 256, BK = 64, HALF = 128, HTB = HALF * BK * 2  , STAGE_BYTES = 8 * HTB, NXCD = 8, WGM = 8;

__host__ __device__ __forceinline__ int lds_byte(int r, int c) { const int st = (r >> 4) * 2 + (c >> 5), rr = r & 15, cc = c & 31, ob = rr * 64 + cc * 2; return st * 1024 + (ob ^ (((ob >> 9) & 1) << 5)); }
__host__ __device__ __forceinline__ void stage_rc(int b, int& R, int& C) { const int st = b / 1024, sb = b % 1024, swz = sb ^ (((sb >> 9) & 1) << 5); R = (st >> 1) * 16 + swz / 64; C = (st & 1) * 32 + (swz % 64) / 2; }
__host__ __device__ __forceinline__ int perm32(int rho) { const int n = rho >> 4, i = rho & 15; return 8 * (i >> 2) + 4 * n + (i & 3); }

struct Unit { int pm, pn; };
struct Gemm { const bf16_t* A; const bf16_t* Bt; int M, N, K; };

struct StaticOrder {
    int nM, nN, nwg, G, c;
    __host__ __device__ void init(int M, int N, int G_, int c_) { nM = M / BM; nN = N / BM; nwg = nM * nN; G = G_; c = c_; }
    __host__ __device__ bool next(int i, Unit& u) const {
        const long L = (long)i * G + c; if (L >= nwg) return false;
        int wgid = (int)L; { const int q = nwg / NXCD, r = nwg % NXCD, xcd = wgid % NXCD, off = wgid / NXCD; wgid = (xcd < r ? xcd * (q + 1) : r * (q + 1) + (xcd - r) * q) + off; }
        const int nig = WGM * nN, gid = wgid / nig, fm = gid * WGM, gsz = (nM - fm) < WGM ? (nM - fm) : WGM;
        u.pm = fm + ((wgid % nig) % gsz); u.pn = (wgid % nig) / gsz; return true;
    }
    __device__ __forceinline__ void a_ready(const Unit&) const {}
    __device__ __forceinline__ void done(const Unit&) const {}
};

__device__ __forceinline__ unsigned cvt_pk_bf16(float lo, float hi) { unsigned r; asm volatile("v_cvt_pk_bf16_f32 %0, %1, %2" : "=v"(r) : "v"(lo), "v"(hi)); return r; }
typedef float f32x2 __attribute__((ext_vector_type(2)));
__device__ __forceinline__ f32x2 gelu_pk(f32x2 v) {
    const f32x2 av = __builtin_elementwise_abs(v), d = av * 0.2316418882f + 1.0f;
    f32x2 t; t.x = __builtin_amdgcn_rcpf(d.x); t.y = __builtin_amdgcn_rcpf(d.y);
    f32x2 q = t * 0.5307027145f + (-0.7265760135f); q = q * t + 0.7107068705f; q = q * t + (-0.142248368f); q = q * t + 0.127414796f; q = q * t;
    const f32x2 s = (v * v) * (-0.72134752044f);
    f32x2 e; e.x = __builtin_amdgcn_exp2f(s.x); e.y = __builtin_amdgcn_exp2f(s.y);
    const f32x2 m = v * (q * e), r = v - m;
    f32x2 o; o.x = v.x < 0.f ? m.x : r.x; o.y = v.y < 0.f ? m.y : r.y; return o;
}

template <int ACT  > struct EpiBf16 {
    static constexpr bool PERM = true, AFTER_DRAIN = false; static_assert(ACT == 0 || ACT == 1, "EpiBf16: ACT is 0 (none) or 1 (gelu_pk)");
    bf16_t* O; int ldc; const float* bias; int split_cols; size_t split_stride; float scale0;
    __device__ __forceinline__ void operator()(const f32x4 (&acc)[2][2][4][2], const Unit& u, int wr, int wc, int fr, int fq) const {
        const int row0 = u.pm * BM + wr * 64 + fr; int colt = u.pn * BM; bf16_t* base = O;
        float sc = 1.f; if (split_cols) { const int t = colt / split_cols; base += (size_t)t * split_stride; colt -= t * split_cols; if (t == 0) sc = scale0; }
        const int col0 = colt + wc * 32 + 8 * fq, bcol0 = u.pn * BM + wc * 32 + 8 * fq;
        f32x4 bv[2][2];
#pragma unroll
        for (int bj = 0; bj < 2; ++bj)
#pragma unroll
            for (int n = 0; n < 2; ++n) bv[bj][n] = bias ? *(const f32x4*)(bias + bcol0 + bj * HALF + 4 * n) : (f32x4){0.f, 0.f, 0.f, 0.f};
#pragma unroll
        for (int ai = 0; ai < 2; ++ai)
#pragma unroll
            for (int m = 0; m < 4; ++m) { bf16_t* rowp = base + (size_t)(row0 + ai * HALF + m * 16) * ldc + col0;
#pragma unroll
                for (int bj = 0; bj < 2; ++bj) { f32x4 v0 = acc[ai][bj][m][0] + bv[bj][0], v1 = acc[ai][bj][m][1] + bv[bj][1];
                    if (ACT == 1) { f32x2 a = gelu_pk((f32x2){v0[0], v0[1]}), b = gelu_pk((f32x2){v0[2], v0[3]}), c = gelu_pk((f32x2){v1[0], v1[1]}), d = gelu_pk((f32x2){v1[2], v1[3]});
                        v0 = (f32x4){a.x, a.y, b.x, b.y}; v1 = (f32x4){c.x, c.y, d.x, d.y}; }
                    v0 = v0 * sc; v1 = v1 * sc; u32x4 w; w.x = cvt_pk_bf16(v0[0], v0[1]); w.y = cvt_pk_bf16(v0[2], v0[3]); w.z = cvt_pk_bf16(v1[0], v1[1]); w.w = cvt_pk_bf16(v1[2], v1[3]);
                    *(u32x4*)(rowp + bj * HALF) = w; } }
    }
};
template <class Epi, class Sched, bool ALIGN_EPI = false, bool SP2 = false>
__device__ __forceinline__ void gemm_phase(PG8_LAS unsigned char* lds, const Gemm g, const Sched& S, const Epi& E) {
    const int tid = threadIdx.x, wid = __builtin_amdgcn_readfirstlane(tid >> 6), lane = tid & 63, wr = wid >> 2, wc = wid & 3, fr = lane & 15, fq = lane >> 4;
    const int K = g.K, nt = K / BK;
    unsigned voffA[2], voffB[2];
#pragma unroll
    for (int i = 0; i < 2; ++i) { int R, C; stage_rc(tid * 16 + i * 8192, R, C); const int Rb = Epi::PERM ? ((R & ~31) + perm32(R & 31)) : R;
        voffA[i] = (unsigned)(R * K + C) * 2u; voffB[i] = (unsigned)(Rb * K + C) * 2u; }
    const size_t kstep = (size_t)(BK * 2);
    const size_t hstep = (size_t)HALF * K * 2;
    const size_t tstep = 2 * hstep;
    const unsigned ldsw = (unsigned)wid * 1024u;
    const int aoff = lds_byte(wr * 64 + fr, fq * 8), boff = lds_byte(wc * 32 + fr, fq * 8);
#define PG8_SA(b, h) (((b) * 2 + (h)) * HTB)
#define PG8_SB(b, h) ((4 + (b) * 2 + (h)) * HTB)
#define PG8_STAGE(bufoff, gbase, voff) do { _Pragma("unroll") for (int _i = 0; _i < 2; ++_i) \
        __builtin_amdgcn_global_load_lds((const unsigned*)((const char*)(gbase) + (voff)[_i]), (PG8_LAS unsigned*)(lds + (bufoff) + ldsw + _i * 8192), 16, 0, 0); } while (0)
#define PG8_LDA(dst, b, h) do { _Pragma("unroll") for (int m = 0; m < 4; ++m) _Pragma("unroll") for (int k = 0; k < 2; ++k) dst[m][k] = *(const PG8_LAS bf16x8*)(lds + PG8_SA(b, h) + aoff + m * 2048 + k * 1024); } while (0)
#define PG8_LDB(dst, b, h) do { _Pragma("unroll") for (int n = 0; n < 2; ++n) _Pragma("unroll") for (int k = 0; k < 2; ++k) dst[n][k] = *(const PG8_LAS bf16x8*)(lds + PG8_SB(b, h) + boff + n * 2048 + k * 1024); } while (0)
#define PG8_MMA(ai, bj, At, Bt) do { __builtin_amdgcn_s_setprio(1); _Pragma("unroll") for (int m = 0; m < 4; ++m) _Pragma("unroll") for (int n = 0; n < 2; ++n) _Pragma("unroll") for (int k = 0; k < 2; ++k) \
        acc[ai][bj][m][n] = __builtin_amdgcn_mfma_f32_16x16x32_bf16(Bt[n][k], At[m][k], acc[ai][bj][m][n], 0, 0, 0); __builtin_amdgcn_s_setprio(0); } while (0)
#define PG8_WAIT_V(n) asm volatile("s_waitcnt vmcnt(" #n ")" ::: "memory")
#define PG8_WAIT_L(n) asm volatile("s_waitcnt lgkmcnt(" #n ")" ::: "memory")
#define PG8_BAR __builtin_amdgcn_s_barrier()
#define PG8_SCHED __builtin_amdgcn_sched_barrier(0)
    Unit cur, nxt; int ui = 0;
    if (!S.next(0, cur)) return;
    f32x4 acc[2][2][4][2];
#pragma unroll
    for (int a = 0; a < 2; ++a)
#pragma unroll
        for (int b = 0; b < 2; ++b)
#pragma unroll
            for (int m = 0; m < 4; ++m)
#pragma unroll
                for (int n = 0; n < 2; ++n) acc[a][b][m][n] = (f32x4){0.f, 0.f, 0.f, 0.f};
    bf16x8 At[4][2], B0[2][2], B1[2][2];
    const char* cA = (const char*)g.A + (size_t)cur.pm * tstep; const char* cB = (const char*)g.Bt + (size_t)cur.pn * tstep;
    S.a_ready(cur);
    if constexpr (SP2) {
        PG8_STAGE(PG8_SB(0, 0), cB, voffB); PG8_STAGE(PG8_SB(0, 1), cB + hstep, voffB); PG8_STAGE(PG8_SA(0, 0), cA, voffA); PG8_STAGE(PG8_SA(0, 1), cA + hstep, voffA);
        if (wr == 1) PG8_BAR;
        PG8_WAIT_V(2); PG8_BAR;
        PG8_STAGE(PG8_SB(1, 0), cB + kstep, voffB); PG8_STAGE(PG8_SA(1, 0), cA + kstep, voffA); PG8_STAGE(PG8_SB(1, 1), cB + hstep + kstep, voffB);
        PG8_WAIT_V(6); PG8_BAR;
    } else {
        PG8_STAGE(PG8_SB(0, 0), cB, voffB); PG8_STAGE(PG8_SA(0, 0), cA, voffA); PG8_STAGE(PG8_SB(0, 1), cB + hstep, voffB); PG8_STAGE(PG8_SA(0, 1), cA + hstep, voffA);
        if (wr == 1) PG8_BAR;
        PG8_WAIT_V(4); PG8_BAR;
        PG8_STAGE(PG8_SB(1, 0), cB + kstep, voffB); PG8_STAGE(PG8_SA(1, 0), cA + kstep, voffA); PG8_STAGE(PG8_SB(1, 1), cB + hstep + kstep, voffB);
        PG8_WAIT_V(6); PG8_BAR;
    }
    for (;;) {
        const bool has_next = S.next(ui + 1, nxt);
        const char* nA = has_next ? (const char*)g.A + (size_t)nxt.pm * tstep : cA; const char* nB = has_next ? (const char*)g.Bt + (size_t)nxt.pn * tstep : cB;
        for (int t = 0; t < nt; t += 2) {
            const bool last = (t == nt - 2);
            const char* a1 = cA + (size_t)(t + 1) * kstep;
            const char* a2 = last ? nA : cA + (size_t)(t + 2) * kstep; const char* b2 = last ? nB : cB + (size_t)(t + 2) * kstep;
            const char* a3 = a2 + kstep; const char* b3 = b2 + kstep;
            if (last && has_next) S.a_ready(nxt);
            if constexpr (SP2) {
            PG8_LDB(B0, 0, 0); PG8_LDB(B1, 0, 1); PG8_SCHED; PG8_LDA(At, 0, 0); PG8_STAGE(PG8_SA(1, 1), a1 + hstep, voffA);
            PG8_WAIT_V(8); PG8_WAIT_L(0); PG8_BAR; PG8_MMA(0, 0, At, B0); PG8_MMA(0, 1, At, B1); PG8_BAR; PG8_SCHED;
            PG8_LDA(At, 0, 1); PG8_STAGE(PG8_SB(0, 0), b2, voffB); PG8_STAGE(PG8_SB(0, 1), b2 + hstep, voffB); PG8_STAGE(PG8_SA(0, 0), a2, voffA);
            PG8_WAIT_V(8); PG8_WAIT_L(0); PG8_BAR; PG8_MMA(1, 0, At, B0); PG8_MMA(1, 1, At, B1); PG8_BAR; PG8_SCHED;
            PG8_LDB(B0, 1, 0); PG8_LDB(B1, 1, 1); PG8_SCHED; PG8_LDA(At, 1, 0); PG8_STAGE(PG8_SA(0, 1), a2 + hstep, voffA);
            PG8_WAIT_V(8); PG8_WAIT_L(0); PG8_BAR; PG8_MMA(0, 0, At, B0); PG8_MMA(0, 1, At, B1); PG8_BAR; PG8_SCHED;
            PG8_LDA(At, 1, 1); PG8_STAGE(PG8_SB(1, 0), b3, voffB); PG8_STAGE(PG8_SB(1, 1), b3 + hstep, voffB); PG8_STAGE(PG8_SA(1, 0), a3, voffA);
            PG8_WAIT_V(8); PG8_WAIT_L(0); PG8_BAR; PG8_MMA(1, 0, At, B0); PG8_MMA(1, 1, At, B1); PG8_BAR; PG8_SCHED;
            } else {
            PG8_LDB(B0, 0, 0); PG8_SCHED; PG8_LDA(At, 0, 0); PG8_STAGE(PG8_SA(1, 1), a1 + hstep, voffA);
            PG8_WAIT_L(8); PG8_BAR; PG8_WAIT_L(0); PG8_MMA(0, 0, At, B0); PG8_BAR; PG8_SCHED;
            PG8_LDB(B1, 0, 1); PG8_STAGE(PG8_SB(0, 0), b2, voffB);
            PG8_BAR; PG8_WAIT_L(0); PG8_MMA(0, 1, At, B1); PG8_BAR;
            PG8_LDA(At, 0, 1); PG8_STAGE(PG8_SA(0, 0), a2, voffA);
            PG8_BAR; PG8_WAIT_L(0); PG8_MMA(1, 0, At, B0); PG8_BAR; PG8_SCHED;
            PG8_STAGE(PG8_SB(0, 1), b2 + hstep, voffB);
            PG8_WAIT_V(6); PG8_BAR; PG8_MMA(1, 1, At, B1); PG8_BAR;
            PG8_LDB(B0, 1, 0); PG8_SCHED; PG8_LDA(At, 1, 0); PG8_STAGE(PG8_SA(0, 1), a2 + hstep, voffA);
            PG8_WAIT_L(8); PG8_BAR; PG8_WAIT_L(0); PG8_MMA(0, 0, At, B0); PG8_BAR; PG8_SCHED;
            PG8_LDB(B1, 1, 1); PG8_STAGE(PG8_SB(1, 0), b3, voffB);
            PG8_BAR; PG8_WAIT_L(0); PG8_MMA(0, 1, At, B1); PG8_BAR;
            PG8_LDA(At, 1, 1); PG8_STAGE(PG8_SA(1, 0), a3, voffA);
            PG8_BAR; PG8_WAIT_L(0); PG8_MMA(1, 0, At, B0); PG8_BAR; PG8_SCHED;
            PG8_STAGE(PG8_SB(1, 1), b3 + hstep, voffB);
            PG8_WAIT_V(6); PG8_BAR; PG8_MMA(1, 1, At, B1); PG8_BAR;
            }
        }
        if constexpr (ALIGN_EPI) { if (wr == 0) PG8_BAR; }
        if constexpr (!Epi::AFTER_DRAIN) { E(acc, cur, wr, wc, fr, fq); S.done(cur); }
        if (!has_next) break;
#pragma unroll
        for (int a = 0; a < 2; ++a)
#pragma unroll
            for (int b = 0; b < 2; ++b)
#pragma unroll
                for (int m = 0; m < 4; ++m)
#pragma unroll
                    for (int n = 0; n < 2; ++n) acc[a][b][m][n] = (f32x4){0.f, 0.f, 0.f, 0.f};
        cur = nxt; cA = nA; cB = nB; ++ui;
        if constexpr (ALIGN_EPI) { if (wr == 1) PG8_BAR; }
    }
    PG8_WAIT_V(0);
    if constexpr (!ALIGN_EPI) { if (wr == 0) PG8_BAR; }
    PG8_BAR;
    if constexpr (Epi::AFTER_DRAIN) { E.fused(acc, cur, wr, wc, fr, fq, lds, wid, lane); S.done(cur); }
#undef PG8_SA
#undef PG8_SB
#undef PG8_STAGE
#undef PG8_LDA
#undef PG8_LDB
#undef PG8_MMA
#undef PG8_WAIT_V
#undef PG8_WAIT_L
#undef PG8_BAR
#undef PG8_SCHED
}
}

#define LAS __attribute__((address_space(3)))
typedef unsigned short bf16_t;
typedef short bf16x8 __attribute__((ext_vector_type(8)));
typedef short s16x4 __attribute__((ext_vector_type(4)));
typedef float f32x4 __attribute__((ext_vector_type(4)));
typedef float f32x16 __attribute__((ext_vector_type(16)));
typedef unsigned u32x4 __attribute__((ext_vector_type(4)));
typedef unsigned u32x2 __attribute__((ext_vector_type(2)));

constexpr int DM = 1024;
constexpr int NP = 16 * 2048;
constexpr int NS = 8 * 64;
constexpr int NT = NP + NS;
constexpr int DIN = 2560;
constexpr int SKV = 2112;
constexpr float EPS = 1e-6f;
constexpr float LOG2E = 1.4426950408889634f;
constexpr float QSCALE = 0.125f * LOG2E;

constexpr long OUT_Y = 0;
constexpr long OUT_KP = 34078720L, OUT_VP = 50855936L, OUT_CONVP = 67633152L, OUT_KS = 67878912L, OUT_VS = 68141056L, OUT_CONVS = 68403200L, OUT_TOTAL = 68526080L;

constexpr size_t MiB = 1u << 20;
constexpr size_t WS_CTL = 0, CTL_BYTES = 1 * MiB;
constexpr size_t WS_WINT = 1 * MiB;
constexpr size_t WS_WOUTT = 6 * MiB;
constexpr size_t WS_WQT = 8 * MiB;
constexpr size_t WS_SK = 12 * MiB;
constexpr size_t WS_PU8 = 16 * MiB;
constexpr size_t WS_PV8 = 32 * MiB;
constexpr size_t WS_SCU = 48 * MiB;
constexpr size_t WS_SCV = 49 * MiB;
constexpr size_t WS_KS = 80 * MiB;
constexpr size_t WS_VS = 97 * MiB;
constexpr size_t WS_H = 114 * MiB;
constexpr size_t WS_A = 179 * MiB;
constexpr size_t WS_Q = 212 * MiB;
constexpr size_t WS_QP = 114 * MiB;
constexpr size_t WS_KP = 245 * MiB;
constexpr size_t WS_VP = 277 * MiB;
constexpr size_t WS_MIX = 309 * MiB;
constexpr size_t WS_H2 = 309 * MiB;
constexpr size_t WS_TK = 375 * MiB;
constexpr size_t WS_IDX = 408 * MiB;
constexpr size_t WS_GATE = 425 * MiB;
constexpr size_t WS_PACT = 114 * MiB;
constexpr size_t WS_COEF = 375 * MiB;
constexpr size_t WS_END = 442 * MiB;
static_assert(WS_H + (size_t)NT * 1024 * 2 <= WS_A && WS_A + (size_t)NT * 512 * 2 <= WS_Q && WS_Q + (size_t)NT * 512 * 2 <= WS_KP, "R1");
static_assert(WS_QP + (size_t)NT * 2048 * 2 <= WS_KP && WS_KP + (size_t)NP * 512 * 2 <= WS_VP && WS_VP + (size_t)NP * 512 * 2 <= WS_MIX, "ws map");
static_assert(WS_MIX + (size_t)NT * 1024 * 2 <= WS_TK && WS_TK + (size_t)NT * 256 * 4 <= WS_IDX && WS_IDX + (size_t)NT * 128 * 4 <= WS_GATE && WS_GATE + (size_t)NT * 128 * 4 <= WS_END, "ws map 2");
static_assert(WS_KS + (size_t)8 * SKV * 512 * 2 <= WS_VS && WS_VS + (size_t)8 * SKV * 512 * 2 <= WS_H, "ws map 3");

constexpr int RING_BYTES = 131072;
constexpr int BIAS_OFF = RING_BYTES;
constexpr int MISC_OFF = RING_BYTES + 5120;
constexpr int LDS_BYTES = MISC_OFF + 1024;

struct Params {
    const float* in[24];
    float* out;
    unsigned char* ws;
};

__device__ __forceinline__ unsigned cvtpk(float lo, float hi) { return pg8::cvt_pk_bf16(lo, hi); }
__device__ __forceinline__ float bflo(unsigned w) { return __uint_as_float(w << 16); }
__device__ __forceinline__ float bfhi(unsigned w) { return __uint_as_float(w & 0xffff0000u); }
__device__ __forceinline__ float wave_sum(float v) {
#pragma unroll
    for (int o = 1; o < 64; o <<= 1) v += __shfl_xor(v, o);
    return v;
}
typedef float f32x2 __attribute__((ext_vector_type(2)));
#define DPP_ADD(v, ctrl) v += __builtin_bit_cast(float, __builtin_amdgcn_update_dpp(0, __builtin_bit_cast(int, v), ctrl, 0xf, 0xf, true))
__device__ __forceinline__ float rl_f(float v, int l) { return __uint_as_float(__builtin_amdgcn_readlane(__float_as_uint(v), l)); }
__device__ __forceinline__ float wave_total(float v) {
    DPP_ADD(v, 0xB1); DPP_ADD(v, 0x4E); DPP_ADD(v, 0x141); DPP_ADD(v, 0x140);
    return (rl_f(v, 0) + rl_f(v, 16)) + (rl_f(v, 32) + rl_f(v, 48));
}
typedef __bf16 bf16x2_t __attribute__((ext_vector_type(2)));
__device__ __forceinline__ float dot2(unsigned a, unsigned b, float acc) {
    return __builtin_amdgcn_fdot2_f32_bf16(__builtin_bit_cast(bf16x2_t, a), __builtin_bit_cast(bf16x2_t, b), acc, false);
}
#define LDS_WAIT() asm volatile("s_waitcnt lgkmcnt(0)" ::: "memory")

#define XB_TMO      128
#define XB_XCNT(j)  (256  + 64 * (j))
#define XB_XSUB(j)  (1280 + 64 * (j))
#define XB_XGEN(j)  (2304 + 64 * (j))
#define XB_TOP      3328
#define XB_TOPGEN   3392
#define XCD_BAR_WORDS 3456
#define XB_SPIN_CAP (1u << 18)

__device__ __forceinline__ unsigned xb_ld(unsigned* p)              { return __hip_atomic_load(p, __ATOMIC_RELAXED, __HIP_MEMORY_SCOPE_AGENT); }
__device__ __forceinline__ unsigned xb_add(unsigned* p, unsigned v) { return __hip_atomic_fetch_add(p, v, __ATOMIC_RELAXED, __HIP_MEMORY_SCOPE_AGENT); }
__device__ __forceinline__ unsigned xb_xcc_id() { return (unsigned)__builtin_amdgcn_s_getreg((3 << 11) | 20) & 0xFu; }
#define XB_SPIN(cond, bar) do { unsigned _sp = 0; while (cond) { __builtin_amdgcn_s_sleep(1); \
    if ((++_sp & 255u) == 0u) { if (xb_ld(&(bar)[XB_TMO])) break; if (_sp > XB_SPIN_CAP) { atomicAdd(&(bar)[XB_TMO], 1u); break; } } } } while (0)

struct XcdBarrier {
    unsigned* bar; unsigned x;
    volatile LAS unsigned* st;
};

__device__ __forceinline__ XcdBarrier xcd_barrier_post(unsigned* bar, volatile LAS unsigned* st) {
    XcdBarrier b; b.bar = bar; b.x = xb_xcc_id(); b.st = st;
    if (threadIdx.x == 0) (void)xb_add(&bar[XB_XCNT(b.x)], 1u);
    return b;
}
__device__ __forceinline__ void xcd_barrier_complete(unsigned* bar, unsigned x, unsigned& nloc, unsigned& nx) {
    const unsigned G = gridDim.x * gridDim.y * gridDim.z;
    unsigned sum, cnt, mine, sp = 0u;
    for (;;) {
        sum = 0u; cnt = 0u; mine = 0u;
#pragma unroll
        for (unsigned j = 0; j < 16; ++j) { const unsigned c = xb_ld(&bar[XB_XCNT(j)]); sum += c; cnt += (c > 0u) ? 1u : 0u; mine = (j == x) ? c : mine; }
        if (sum == G) break;
        __builtin_amdgcn_s_sleep(1);
        if ((++sp & 255u) == 0u) { if (xb_ld(&bar[XB_TMO])) break; if (sp > XB_SPIN_CAP) { atomicAdd(&bar[XB_TMO], 1u); break; } }
    }
    nloc = mine > 0u ? mine : 1u; nx = cnt > 0u ? cnt : 1u;
}

__device__ __forceinline__ void xcd_barrier(const XcdBarrier& b) {
    asm volatile("s_waitcnt vmcnt(0)" ::: "memory");
    __syncthreads();
    if (threadIdx.x == 0) {
        unsigned* bar = b.bar;
        __builtin_amdgcn_s_waitcnt(0);
        unsigned nloc = b.st[0], nx = b.st[1];
        if (nloc == 0u) { xcd_barrier_complete(bar, b.x, nloc, nx); b.st[0] = nloc; b.st[1] = nx; }
        const unsigned old = xb_add(&bar[XB_XSUB(b.x)], 1u);
        const unsigned gen = old / nloc;
        if (old + 1u == (gen + 1u) * nloc) {
            __builtin_amdgcn_fence(__ATOMIC_RELEASE, "agent");
            asm volatile("s_waitcnt vmcnt(0)" ::: "memory");
            const unsigned og = xb_add(&bar[XB_TOP], 1u);
            const unsigned tg = og / nx;
            if (og + 1u == (tg + 1u) * nx) xb_add(&bar[XB_TOPGEN], 1u);
            else XB_SPIN(xb_ld(&bar[XB_TOPGEN]) == tg, bar);
            __builtin_amdgcn_fence(__ATOMIC_ACQUIRE, "agent");
            xb_add(&bar[XB_XGEN(b.x)], 1u);
            asm volatile("s_waitcnt vmcnt(0)" ::: "memory");
        } else {
            XB_SPIN(xb_ld(&bar[XB_XGEN(b.x)]) == gen, bar);
            __builtin_amdgcn_fence(__ATOMIC_ACQUIRE, "agent");
            asm volatile("s_waitcnt vmcnt(0)" ::: "memory");
        }
    }
    __syncthreads();
}


namespace pg8 {
__device__ __forceinline__ u32x2 pack4(f32x4 v) { u32x2 w; w.x = cvt_pk_bf16(v[0], v[1]); w.y = cvt_pk_bf16(v[2], v[3]); return w; }
struct EpiProj {
    static constexpr bool PERM = false, AFTER_DRAIN = false;
    bf16_t* A; bf16_t* Q; bf16_t* KP; bf16_t* VP; bf16_t* KS; bf16_t* VS; float* out;
    __device__ __forceinline__ void operator()(const f32x4 (&acc)[2][2][4][2], const Unit& u, int wr, int wc, int fr, int fq) const {
        const int pn = u.pn;
        const int row0 = u.pm * BM + wr * 64 + fr;
        if (pn < 4) {
#pragma unroll
            for (int ai = 0; ai < 2; ++ai)
#pragma unroll
                for (int m = 0; m < 4; ++m) {
                    const int row = row0 + ai * HALF + m * 16;
                    long toff = -1;
                    if (row < NP) { const int s = row & 2047; if (s >= 2018) toff = OUT_CONVP + ((long)(row >> 11) * 30 + (s - 2018)) * 512; }
                    else { const int rr = row - NP; const int i = rr & 63; if (i >= 34) toff = OUT_CONVS + ((long)(rr >> 6) * 30 + (i - 34)) * 512; }
#pragma unroll
                    for (int n = 0; n < 2; ++n) {
                        const int c = 128 * pn + 32 * wc + 16 * n + 4 * fq;
                        const f32x4 x = acc[ai][0][m][n], g = acc[ai][1][m][n];
                        f32x4 a;
#pragma unroll
                        for (int j = 0; j < 4; ++j) a[j] = x[j] / (1.f + __expf(-g[j]));
                        *(u32x2*)(A + (size_t)row * 512 + c) = pack4(a);
                        if (toff >= 0) *(f32x4*)(out + toff + c) = a;
                    }
                }
        } else {
            const int sec = (pn - 4) >> 1, colbase = ((pn - 4) & 1) * 256;
#pragma unroll
            for (int ai = 0; ai < 2; ++ai)
#pragma unroll
                for (int m = 0; m < 4; ++m) {
                    const int row = row0 + ai * HALF + m * 16;
                    const bool isp = row < NP; const int rr = row - NP;
                    bf16_t* bdst; float* fdst;
                    if (sec == 0) { bdst = Q + (size_t)row * 512; fdst = nullptr; }
                    else if (sec == 1) { bdst = isp ? KP + (size_t)row * 512 : KS + ((size_t)(rr >> 6) * SKV + 2048 + (rr & 63)) * 512; fdst = isp ? out + OUT_KP + (size_t)row * 512 : out + OUT_KS + (size_t)rr * 512; }
                    else { bdst = isp ? VP + (size_t)row * 512 : VS + ((size_t)(rr >> 6) * SKV + 2048 + (rr & 63)) * 512; fdst = isp ? out + OUT_VP + (size_t)row * 512 : out + OUT_VS + (size_t)rr * 512; }
#pragma unroll
                    for (int bj = 0; bj < 2; ++bj)
#pragma unroll
                        for (int n = 0; n < 2; ++n) {
                            const int col = colbase + 128 * bj + 32 * wc + 16 * n + 4 * fq;
                            const f32x4 v = acc[ai][bj][m][n];
                            if (sec == 0) { *(u32x2*)(bdst + col) = pack4(v * QSCALE); }
                            else { *(u32x2*)(bdst + col) = pack4(v); *(f32x4*)(fdst + col) = v; }
                        }
                }
        }
    }
};
struct EpiRes {
    static constexpr bool PERM = false, AFTER_DRAIN = false;
    const float* xp; const float* xs; float* out;
    __device__ __forceinline__ void operator()(const f32x4 (&acc)[2][2][4][2], const Unit& u, int wr, int wc, int fr, int fq) const {
        const int row0 = u.pm * BM + wr * 64 + fr;
#pragma unroll
        for (int ai = 0; ai < 2; ++ai)
#pragma unroll
            for (int m = 0; m < 4; ++m) {
                const int row = row0 + ai * HALF + m * 16;
                const float* xr = row < NP ? xp + (size_t)row * DM : xs + (size_t)(row - NP) * DM;
                float* orow = out + (size_t)row * DM;
#pragma unroll
                for (int bj = 0; bj < 2; ++bj)
#pragma unroll
                    for (int n = 0; n < 2; ++n) {
                        const int col = u.pn * BM + 128 * bj + 32 * wc + 16 * n + 4 * fq;
                        *(f32x4*)(orow + col) = *(const f32x4*)(xr + col) + acc[ai][bj][m][n];
                    }
            }
    }
};
}

__device__ __forceinline__ int winrow(int n) { return n < 1024 ? (256 * ((n & 511) >> 7) + 128 * (n >> 9) + (n & 127)) : n; }
template <bool WIN> __device__ __forceinline__ void transpose_item(const float* W, int K, int N, bf16_t* WT, LAS float* scr, int item, int lane) {
    const int nblk = N / 32, kb = item / nblk, nb = item % nblk, k0 = 64 * kb, n0 = 32 * nb;
#pragma unroll 8
    for (int i = 0; i < 32; ++i) { const int kk = 2 * i + (lane >> 5); scr[kk * 33 + (lane & 31)] = W[(size_t)(k0 + kk) * N + n0 + (lane & 31)]; }
    LDS_WAIT();
    const int c = lane & 7;
#pragma unroll
    for (int j = 0; j < 4; ++j) {
        const int n = (lane >> 3) + 8 * j; const LAS float* s = scr + (8 * c) * 33 + n;
        u32x4 o; o.x = cvtpk(s[0 * 33], s[1 * 33]); o.y = cvtpk(s[2 * 33], s[3 * 33]); o.z = cvtpk(s[4 * 33], s[5 * 33]); o.w = cvtpk(s[6 * 33], s[7 * 33]);
        const int dr = WIN ? winrow(n0 + n) : (n0 + n);
        *(u32x4*)(WT + (size_t)dr * K + k0 + 8 * c) = o;
    }
    LDS_WAIT();
}
__device__ __forceinline__ void cvt_stream(const float* src, bf16_t* dst, size_t n8, size_t gt, size_t ngt) {
    for (size_t i = gt; i < n8; i += ngt) {
        const f32x4 a = *(const f32x4*)(src + i * 8), b = *(const f32x4*)(src + i * 8 + 4);
        u32x4 o; o.x = cvtpk(a[0], a[1]); o.y = cvtpk(a[2], a[3]); o.z = cvtpk(b[0], b[1]); o.w = cvtpk(b[2], b[3]);
        *(u32x4*)(dst + i * 8) = o;
    }
}
__device__ __forceinline__ void cvt_cache(const float* src, bf16_t* dst, size_t gt, size_t ngt) {
    const size_t n8 = (size_t)8 * 2048 * 512 / 8;
    for (size_t i = gt; i < n8; i += ngt) {
        const size_t e = i * 8; const size_t row = e >> 9, col = e & 511; const size_t drow = (row >> 11) * SKV + (row & 2047);
        const f32x4 a = *(const f32x4*)(src + e), b = *(const f32x4*)(src + e + 4);
        u32x4 o; o.x = cvtpk(a[0], a[1]); o.y = cvtpk(a[2], a[3]); o.z = cvtpk(b[0], b[1]); o.w = cvtpk(b[2], b[3]);
        *(u32x4*)(dst + drow * 512 + col) = o;
    }
}
__device__ __forceinline__ void rms_row_bf16(const float* xrow, const float* g, bf16_t* orow, int lane) {
    const f32x4* xr = (const f32x4*)xrow + lane; const f32x4* gr = (const f32x4*)g + lane;
    f32x4 v[4]; float s = 0.f;
#pragma unroll
    for (int j = 0; j < 4; ++j) { v[j] = xr[64 * j]; s += (v[j][0] * v[j][0] + v[j][1] * v[j][1]) + (v[j][2] * v[j][2] + v[j][3] * v[j][3]); }
    const float rstd = 1.f / sqrtf(wave_sum(s) * (1.f / DM) + EPS);
    u32x2* o8 = (u32x2*)orow + lane;
#pragma unroll
    for (int j = 0; j < 4; ++j) { const f32x4 gg = gr[64 * j]; u32x2 w; w.x = cvtpk(v[j][0] * rstd * gg[0], v[j][1] * rstd * gg[1]); w.y = cvtpk(v[j][2] * rstd * gg[2], v[j][3] * rstd * gg[3]); o8[64 * j] = w; }
}

template <bool SLICED> __device__ __forceinline__ void cvt_row_fp8(const float* src, unsigned char* dst_base, int row, float* scale_out, int lane) {
    const f32x4* xr = (const f32x4*)src + lane;
    f32x4 v[4]; float am = 0.f;
#pragma unroll
    for (int j = 0; j < 4; ++j) { v[j] = xr[64 * j]; am = fmaxf(am, fmaxf(fmaxf(fabsf(v[j][0]), fabsf(v[j][1])), fmaxf(fabsf(v[j][2]), fabsf(v[j][3])))); }
#pragma unroll
    for (int o = 1; o < 64; o <<= 1) am = fmaxf(am, __shfl_xor(am, o));
    const float sc = am > 0.f ? am * (1.f / 448.f) : 1.f, inv = 1.f / sc;
#pragma unroll
    for (int j = 0; j < 4; ++j) {
        const int eb = 256 * j + 4 * lane;
        int w = __builtin_amdgcn_cvt_pk_fp8_f32(v[j][0] * inv, v[j][1] * inv, 0, false);
        w = __builtin_amdgcn_cvt_pk_fp8_f32(v[j][2] * inv, v[j][3] * inv, w, true);
        if (SLICED) *(int*)(dst_base + ((size_t)(eb >> 7) * 16384 + row) * 128 + (eb & 127)) = w;
        else *(int*)(dst_base + (size_t)row * DM + 16 * ((eb & 511) >> 3) + (eb & 7) + (eb >= 512 ? 8 : 0)) = w;
    }
    if (lane == 0) *scale_out = sc;
}

__device__ __forceinline__ void phase0(const Params& p, LAS unsigned char* lds, int tid, int lane, int wave) {
    const int gw = blockIdx.x * 8 + wave, NGW = gridDim.x * 8;
    LAS float* scr = (LAS float*)(lds + wave * 16384);
    bf16_t* WINT = (bf16_t*)(p.ws + WS_WINT); bf16_t* WOUTT = (bf16_t*)(p.ws + WS_WOUTT); bf16_t* WQT = (bf16_t*)(p.ws + WS_WQT);
    constexpr int I_IN = 16 * (DIN / 32), I_OUT = 16 * (1024 / 32), I_Q = 16 * (2048 / 32);
    for (int it = gw; it < I_IN + I_OUT + I_Q; it += NGW) {
        int r = it;
        if (r < I_IN) { transpose_item<true>(p.in[6], 1024, DIN, WINT, scr, r, lane); continue; } r -= I_IN;
        if (r < I_OUT) { transpose_item<false>(p.in[17], 1024, 1024, WOUTT, scr, r, lane); continue; } r -= I_OUT;
        transpose_item<false>(p.in[19], 1024, 2048, WQT, scr, r, lane);
    }
    const size_t gt = (size_t)blockIdx.x * 512 + tid, ngt = (size_t)gridDim.x * 512;
    for (int r = gw; r < 2 * 16384; r += NGW) {
        const int tb = r >> 14, e = r & 16383;
        if (tb) cvt_row_fp8<true>(p.in[22] + (size_t)e * DM, p.ws + WS_PV8, e, (float*)(p.ws + WS_SCV) + e, lane);
        else cvt_row_fp8<true>(p.in[21] + (size_t)e * DM, p.ws + WS_PU8, e, (float*)(p.ws + WS_SCU) + e, lane);
    }
    cvt_stream(p.in[20], (bf16_t*)(p.ws + WS_SK), (size_t)16 * 128 * 128 / 8, gt, ngt);
    cvt_cache(p.in[2], (bf16_t*)(p.ws + WS_KS), gt, ngt);
    cvt_cache(p.in[3], (bf16_t*)(p.ws + WS_VS), gt, ngt);
    bf16_t* H = (bf16_t*)(p.ws + WS_H);
    for (int m = gw; m < NT; m += NGW) {
        const float* xr = m < NP ? p.in[0] + (size_t)m * DM : p.in[1] + (size_t)(m - NP) * DM;
        rms_row_bf16(xr, p.in[5], H + (size_t)m * DM, lane);
    }
}

namespace att {
constexpr int KPITCH = 272, VPITCH = 320;
constexpr int L_KV = 0, KV_BYTES = 64 * KPITCH + 64 * VPITCH  , L_X = 0  , L_BIAS = BIAS_OFF, L_CA = 0  , L_CW = 94 * 1024  ;
static_assert(4 * 4096 * 4 <= 2 * KV_BYTES && 2 * KV_BYTES <= L_CW && L_CW + 31 * 1024 <= RING_BYTES, "attention LDS map");

__device__ __forceinline__ int rel_bucket(int rel) {
    const int ret = rel > 0 ? 16 : 0; const int n = rel < 0 ? -rel : rel; int v;
    if (n < 8) v = n; else if (n < 12) v = 8; else if (n < 16) v = 9; else if (n < 23) v = 10; else if (n < 32) v = 11;
    else if (n < 46) v = 12; else if (n < 64) v = 13; else if (n < 91) v = 14; else v = 15;
    return ret + v;
}
typedef short v4i16_t __attribute__((ext_vector_type(4)));
__device__ __forceinline__ s16x4 vtr(const LAS unsigned char* p) { return __builtin_bit_cast(s16x4, __builtin_amdgcn_ds_read_tr16_b64_v4i16((LAS v4i16_t*)p)); }
__device__ __forceinline__ f32x16 mfma32(bf16x8 a, bf16x8 b, f32x16 c) { return __builtin_amdgcn_mfma_f32_32x32x16_bf16(a, b, c, 0, 0, 0); }

__device__ __forceinline__ void attn_unit(const Params& p, LAS unsigned char* lds, int kind, int bb, int h, int qblk, float lam, int tid, int lane, int wid) {
    const bf16_t* Q = (const bf16_t*)(p.ws + WS_Q);
    const bf16_t* Kb = kind == 0 ? (const bf16_t*)(p.ws + WS_KP) + (size_t)bb * 2048 * 512 + h * 128 : (const bf16_t*)(p.ws + WS_KS) + (size_t)bb * SKV * 512 + h * 128;
    const bf16_t* Vb = kind == 0 ? (const bf16_t*)(p.ws + WS_VP) + (size_t)bb * 2048 * 512 + h * 128 : (const bf16_t*)(p.ws + WS_VS) + (size_t)bb * SKV * 512 + h * 128;
    bf16_t* MIX = (bf16_t*)(p.ws + WS_MIX);
    const int qrow0 = kind == 0 ? bb * 2048 + qblk * 128 : NP + bb * 64;
    const int qpos0 = kind == 0 ? qblk * 128 : 2048;
    const int ntiles = kind == 0 ? 2 * qblk + 2 : 33;
    const int rg = wid & 3, map = wid >> 2, r32 = lane & 31, hi = lane >> 5;
    const bool active = kind == 0 ? true : (rg < 2);
    const int cw = kind == 0 ? 2 * qblk + (rg >> 1) : 32;
    const int qw0 = qpos0 + 32 * rg;
    const int qabs = qw0 + r32;

    bf16x8 qf[4];
    if (active) {
        const bf16_t* qp = Q + (size_t)(qrow0 + 32 * rg + r32) * 512 + h * 128 + map * 64 + 8 * hi;
#pragma unroll
        for (int s = 0; s < 4; ++s) qf[s] = *(const bf16x8*)(qp + 16 * s);
    } else {
#pragma unroll
        for (int s = 0; s < 4; ++s) qf[s] = (bf16x8){0, 0, 0, 0, 0, 0, 0, 0};
    }
    float m = -1e30f, l = 0.f;
    f32x16 o[4];
#pragma unroll
    for (int mt = 0; mt < 4; ++mt)
#pragma unroll
        for (int r = 0; r < 16; ++r) o[mt][r] = 0.f;

    const int srow0 = tid >> 4, sch = tid & 15;
    const LAS float* btab = (const LAS float*)(lds + L_BIAS) + h * 320;
    const float biasfar = btab[0];
    const int vlane = (4 * hi + ((lane & 15) >> 2)) * VPITCH + (16 * ((lane >> 4) & 1) + 4 * (lane & 3)) * 2;
    u32x4 kA[2], vA[2], kB[2], vB[2];
#define ATT_LOAD(KR, VR, T) do { _Pragma("unroll") for (int i_ = 0; i_ < 2; ++i_) { const size_t off_ = (size_t)((T) * 64 + srow0 + 32 * i_) * 512 + sch * 8; KR[i_] = *(const u32x4*)(Kb + off_); VR[i_] = *(const u32x4*)(Vb + off_); } } while (0)
#define ATT_STORE(KR, VR, BUF) do { _Pragma("unroll") for (int i_ = 0; i_ < 2; ++i_) { \
        *(LAS u32x4*)(lds + L_KV + (BUF) * KV_BYTES + (srow0 + 32 * i_) * KPITCH + sch * 16) = KR[i_]; \
        *(LAS u32x4*)(lds + L_KV + (BUF) * KV_BYTES + 64 * KPITCH + (srow0 + 32 * i_) * VPITCH + sch * 16) = VR[i_]; } } while (0)
    auto compute = [&](int t, int buf) {
        const LAS unsigned char* kbuf = lds + L_KV + buf * KV_BYTES;
        const LAS unsigned char* vbuf = kbuf + 64 * KPITCH;
        f32x16 p0, p1;
        const int kabs0 = t * 64;
        if (kabs0 + 63 - qw0 > -128) {
            const LAS float* bt = btab + (kabs0 - qabs + 256 + 4 * hi);
#pragma unroll
            for (int r = 0; r < 16; ++r) { p0[r] = bt[(r & 3) + 8 * (r >> 2)]; p1[r] = bt[32 + (r & 3) + 8 * (r >> 2)]; }
        } else {
#pragma unroll
            for (int r = 0; r < 16; ++r) { p0[r] = biasfar; p1[r] = biasfar; }
        }
        const LAS unsigned char* kb = kbuf + r32 * KPITCH + (map * 8 + hi) * 16;
#pragma unroll
        for (int s = 0; s < 4; ++s) {
            const bf16x8 a0 = *(const LAS bf16x8*)(kb + s * 32), a1 = *(const LAS bf16x8*)(kb + 32 * KPITCH + s * 32);
            p0 = mfma32(a0, qf[s], p0); p1 = mfma32(a1, qf[s], p1);
        }
        __builtin_amdgcn_sched_barrier(0);
        float mx = fmaxf(p0[0], p1[0]);
#pragma unroll
        for (int r = 1; r < 16; ++r) mx = fmaxf(mx, fmaxf(p0[r], p1[r]));
        mx = fmaxf(mx, __shfl_xor(mx, 32));
        const float mn = fmaxf(m, mx);
        const float alpha = __builtin_amdgcn_exp2f(m - mn);
        m = mn;
        float rs = 0.f;
#pragma unroll
        for (int r = 0; r < 16; ++r) { p0[r] = __builtin_amdgcn_exp2f(p0[r] - mn); p1[r] = __builtin_amdgcn_exp2f(p1[r] - mn); rs += p0[r] + p1[r]; }
        l = l * alpha + rs;
#pragma unroll
        for (int mt = 0; mt < 4; ++mt)
#pragma unroll
            for (int r = 0; r < 16; ++r) o[mt][r] *= alpha;
        __builtin_amdgcn_sched_barrier(0);
#pragma unroll
        for (int t2 = 0; t2 < 2; ++t2)
#pragma unroll
            for (int s = 0; s < 2; ++s) {
                u32x4 bw;
                if (t2 == 0) { bw.x = cvtpk(p0[8 * s + 0], p0[8 * s + 1]); bw.y = cvtpk(p0[8 * s + 2], p0[8 * s + 3]); bw.z = cvtpk(p0[8 * s + 4], p0[8 * s + 5]); bw.w = cvtpk(p0[8 * s + 6], p0[8 * s + 7]); }
                else { bw.x = cvtpk(p1[8 * s + 0], p1[8 * s + 1]); bw.y = cvtpk(p1[8 * s + 2], p1[8 * s + 3]); bw.z = cvtpk(p1[8 * s + 4], p1[8 * s + 5]); bw.w = cvtpk(p1[8 * s + 6], p1[8 * s + 7]); }
                const bf16x8 B = __builtin_bit_cast(bf16x8, bw);
                const LAS unsigned char* vb = vbuf + vlane + (32 * t2 + 16 * s) * VPITCH;
#pragma unroll
                for (int mt = 0; mt < 4; ++mt) {
                    const s16x4 lo = vtr(vb + mt * 64), hi8 = vtr(vb + mt * 64 + 8 * VPITCH);
                    const bf16x8 A = (bf16x8){lo[0], lo[1], lo[2], lo[3], hi8[0], hi8[1], hi8[2], hi8[3]};
                    o[mt] = mfma32(A, B, o[mt]);
                }
            }
    };
    ATT_LOAD(kA, vA, 0);
    if (ntiles > 1) ATT_LOAD(kB, vB, 1);
    ATT_STORE(kA, vA, 0);
    if (ntiles > 2) ATT_LOAD(kA, vA, 2);
    __syncthreads();
    for (int t = 0; t < ntiles; t += 2) {
        if (t + 1 < ntiles) { ATT_STORE(kB, vB, 1); if (t + 3 < ntiles) ATT_LOAD(kB, vB, t + 3); }
        if (active && t <= cw) compute(t, 0);
        __syncthreads();
        if (t + 1 >= ntiles) break;
        if (t + 2 < ntiles) { ATT_STORE(kA, vA, 0); if (t + 4 < ntiles) ATT_LOAD(kA, vA, t + 4); }
        if (active && t + 1 <= cw) compute(t + 1, 1);
        __syncthreads();
    }
#undef ATT_LOAD
#undef ATT_STORE
    l += __shfl_xor(l, 32);
    const float inv = 1.f / l;
    LAS float* X = (LAS float*)(lds + L_X) + rg * 4096;
    if (active && map == 1) {
        const float sc = -lam * inv;
#pragma unroll
        for (int mt = 0; mt < 4; ++mt)
#pragma unroll
            for (int r = 0; r < 16; ++r) X[(mt * 16 + r) * 64 + lane] = o[mt][r] * sc;
    }
    __syncthreads();
    if (active && map == 0) {
        float ss = 0.f;
#pragma unroll
        for (int mt = 0; mt < 4; ++mt)
#pragma unroll
            for (int r = 0; r < 16; ++r) { const float v = o[mt][r] * inv + X[(mt * 16 + r) * 64 + lane]; o[mt][r] = v; ss += v * v; }
        ss += __shfl_xor(ss, 32);
        const float rsn = 0.8f / sqrtf(ss * (1.f / 128.f) + EPS);
        bf16_t* orow = MIX + (size_t)(qrow0 + 32 * rg + r32) * 1024 + 512 + h * 128;
        const float* sg = p.in[15];
#pragma unroll
        for (int mt = 0; mt < 4; ++mt)
#pragma unroll
            for (int g4 = 0; g4 < 4; ++g4) {
                const int e = 32 * mt + 8 * g4 + 4 * hi;
                const f32x4 gg = *(const f32x4*)(sg + e);
                u32x2 w; w.x = cvtpk(o[mt][4 * g4 + 0] * rsn * gg[0], o[mt][4 * g4 + 1] * rsn * gg[1]); w.y = cvtpk(o[mt][4 * g4 + 2] * rsn * gg[2], o[mt][4 * g4 + 3] * rsn * gg[3]);
                *(u32x2*)(orow + e) = w;
            }
    }
    __syncthreads();
}

__device__ __forceinline__ void unpack8(const u32x4 w, float (&f)[8]) { f[0] = bflo(w.x); f[1] = bfhi(w.x); f[2] = bflo(w.y); f[3] = bfhi(w.y); f[4] = bflo(w.z); f[5] = bfhi(w.z); f[6] = bflo(w.w); f[7] = bfhi(w.w); }
__device__ __forceinline__ void conv_unit(const Params& p, LAS unsigned char* lds, int cu, int tid, int lane, int wid) {
    const bf16_t* A = (const bf16_t*)(p.ws + WS_A);
    bf16_t* MIX = (bf16_t*)(p.ws + WS_MIX);
    const float* cb = p.in[8]; const float* lg = p.in[9]; const float* lb = p.in[10]; const float* st = p.in[4];
    const int row0 = cu * 64;
    const bool isp = row0 < NP;
    const int s0 = isp ? (row0 & 2047) : 0, rbase = row0 - s0, bd = isp ? 0 : ((row0 - NP) >> 6);
    for (int c = tid; c < 94 * 64; c += 512) {
        const int rr = c >> 6, ch = c & 63, sp = s0 - 30 + rr;
        u32x4 v = (u32x4){0u, 0u, 0u, 0u};
        if (sp >= 0) v = *(const u32x4*)(A + (size_t)(rbase + sp) * 512 + ch * 8);
        else if (!isp) { const float* sr = st + ((size_t)bd * 30 + (30 + sp)) * 512 + ch * 8; const f32x4 a0 = *(const f32x4*)sr, a1 = *(const f32x4*)(sr + 4);
            v.x = cvtpk(a0[0], a0[1]); v.y = cvtpk(a0[2], a0[3]); v.z = cvtpk(a1[0], a1[1]); v.w = cvtpk(a1[2], a1[3]); }
        *(LAS u32x4*)(lds + L_CA + rr * 1024 + ch * 16) = v;
    }
    __syncthreads();
    const int c0 = lane * 8;
    float bias8[8], g8[8], b8[8];
    { const f32x4 x0 = *(const f32x4*)(cb + c0), x1 = *(const f32x4*)(cb + c0 + 4), y0 = *(const f32x4*)(lg + c0), y1 = *(const f32x4*)(lg + c0 + 4), z0 = *(const f32x4*)(lb + c0), z1 = *(const f32x4*)(lb + c0 + 4);
#pragma unroll
      for (int q = 0; q < 4; ++q) { bias8[q] = x0[q]; bias8[4 + q] = x1[q]; g8[q] = y0[q]; g8[4 + q] = y1[q]; b8[q] = z0[q]; b8[4 + q] = z1[q]; } }
    for (int grp = 0; grp < 2; ++grp) {
        const int t0 = wid * 8 + grp * 4;
        float acc[4][8];
#pragma unroll
        for (int q = 0; q < 4; ++q)
#pragma unroll
            for (int c = 0; c < 8; ++c) acc[q][c] = bias8[c];
        const LAS unsigned char* ap = lds + L_CA + t0 * 1024 + lane * 16;
        const LAS unsigned char* wp = lds + L_CW + lane * 16;
#pragma unroll 1
        for (int j = 0; j < 31; ++j) {
            float w[8]; unpack8(*(const LAS u32x4*)(wp + j * 1024), w);
#pragma unroll
            for (int q = 0; q < 4; ++q) {
                float a[8]; unpack8(*(const LAS u32x4*)(ap + (j + q) * 1024), a);
#pragma unroll
                for (int c = 0; c < 8; ++c) acc[q][c] += w[c] * a[c];
            }
        }
#pragma unroll
        for (int q = 0; q < 4; ++q) {
            float sm = 0.f;
#pragma unroll
            for (int c = 0; c < 8; ++c) sm += acc[q][c];
            const float mu = wave_total(sm) * (1.f / 512.f);
            float sv = 0.f;
#pragma unroll
            for (int c = 0; c < 8; ++c) { acc[q][c] -= mu; sv += acc[q][c] * acc[q][c]; }
            const float rstd = 1.f / sqrtf(wave_total(sv) * (1.f / 512.f) + EPS);
            float y[8];
#pragma unroll
            for (int c = 0; c < 8; ++c) { y[c] = acc[q][c] * rstd * g8[c] + b8[c]; y[c] = y[c] / (1.f + __expf(-y[c])); }
            u32x4 w; w.x = cvtpk(y[0], y[1]); w.y = cvtpk(y[2], y[3]); w.z = cvtpk(y[4], y[5]); w.w = cvtpk(y[6], y[7]);
            *(u32x4*)(MIX + (size_t)(row0 + t0 + q) * 1024 + c0) = w;
        }
    }
}

constexpr int N_SAMPLE_UNITS = 32, N_PROMPT_UNITS = 1024, N_CONV_UNITS = NT / 64, N_UNITS = N_SAMPLE_UNITS + N_PROMPT_UNITS + N_CONV_UNITS;

__device__ __forceinline__ void phase2(const Params& p, LAS unsigned char* lds, int tid, int lane, int wid, int cidx, int mode) {
    LAS float* bt = (LAS float*)(lds + L_BIAS);
    for (int e = tid; e < 4 * 320; e += 512) { const int hh = e / 320, rel = (e % 320) - 256; bt[e] = p.in[16][rel_bucket(rel) * 4 + hh] * LOG2E; }
    for (int c = tid; c < 31 * 64; c += 512) {
        const float* wr = p.in[7] + (size_t)c * 8; const f32x4 a0 = *(const f32x4*)wr, a1 = *(const f32x4*)(wr + 4);
        u32x4 v; v.x = cvtpk(a0[0], a0[1]); v.y = cvtpk(a0[2], a0[3]); v.z = cvtpk(a1[0], a1[1]); v.w = cvtpk(a1[2], a1[3]);
        *(LAS u32x4*)(lds + L_CW + c * 16) = v;
    }
    const float d1 = wave_sum(p.in[11][lane] * p.in[12][lane]), d2 = wave_sum(p.in[13][lane] * p.in[14][lane]);
    const float lam = expf(d1) - expf(d2) + 0.2f;
    unsigned* ctr = (unsigned*)(p.ws + WS_CTL) + 64 * cidx;
    volatile LAS unsigned* sw = (volatile LAS unsigned*)(lds + MISC_OFF);
    __syncthreads();
    for (;;) {
        __syncthreads();
        if (tid == 0) sw[0] = atomicAdd(ctr, 1u);
        __syncthreads();
        const int u = (int)sw[0];
        if (u >= N_UNITS) break;
        if (mode == 1 && u >= N_SAMPLE_UNITS + N_PROMPT_UNITS) continue;
        if (mode == 2 && u < N_SAMPLE_UNITS + N_PROMPT_UNITS) continue;
        int tid_ = tid; asm volatile("" : "+v"(tid_));
        if (u < N_SAMPLE_UNITS + N_PROMPT_UNITS) {
            const int v = u - N_SAMPLE_UNITS; const int bh = v & 63; const bool smp = u < N_SAMPLE_UNITS;
            attn_unit(p, lds, smp ? 1 : 0, smp ? (u >> 2) : (bh >> 2), smp ? (u & 3) : (bh & 3), smp ? 0 : 15 - (v >> 6), lam, tid_, tid_ & 63, wid);
        } else conv_unit(p, lds, u - N_SAMPLE_UNITS - N_PROMPT_UNITS, tid_, tid_ & 63, wid);
    }
}
}

__device__ __forceinline__ void phase3b(const Params& p, int lane, int wave) {
    const int gw = blockIdx.x * 8 + wave, NGW = gridDim.x * 8;
    bf16_t* H2 = (bf16_t*)(p.ws + WS_H2);
    for (int m = gw; m < NT; m += NGW) rms_row_bf16(p.out + (size_t)m * DM, p.in[18], H2 + (size_t)m * DM, lane);
}

__device__ __forceinline__ void phase4b(const Params& p, int lane, int wave) {
    const int gw = blockIdx.x * 8 + wave, NGW = gridDim.x * 8;
    const bf16_t* QP = (const bf16_t*)(p.ws + WS_QP); const bf16_t* SK = (const bf16_t*)(p.ws + WS_SK);
    float* TK = (float*)(p.ws + WS_TK);
    const int r32 = lane & 31, hi = lane >> 5;
    const float NEG_INF = -__builtin_huge_valf();
    for (int wu = gw; wu < (NT / 32) * 16; wu += NGW) {
        const int rp = wu & 15, t0 = (wu >> 4) * 32;
        bf16x8 qf[8];
        const bf16_t* qp = QP + (size_t)(t0 + r32) * 2048 + rp * 128 + 8 * hi;
#pragma unroll
        for (int s = 0; s < 8; ++s) qf[s] = *(const bf16x8*)(qp + 16 * s);
        float v[64];
#pragma unroll
        for (int mt = 0; mt < 4; ++mt) {
            f32x16 S;
#pragma unroll
            for (int r = 0; r < 16; ++r) S[r] = 0.f;
            const bf16_t* kp = SK + ((size_t)rp * 128 + 32 * mt + r32) * 128 + 8 * hi;
#pragma unroll
            for (int s = 0; s < 8; ++s) S = att::mfma32(*(const bf16x8*)(kp + 16 * s), qf[s], S);
#pragma unroll
            for (int r = 0; r < 16; ++r) { const int n = 32 * mt + (r & 3) + 8 * (r >> 2) + 4 * hi; v[mt * 16 + r] = __uint_as_float((__float_as_uint(S[r]) & ~127u) | (unsigned)(127 - n)); }
        }
        float* dst = TK + ((size_t)(t0 + r32) * 16 + rp) * 16;
        for (int it = 0; it < 16; ++it) {
            float mx = v[0];
#pragma unroll
            for (int i = 1; i < 64; ++i) mx = fmaxf(mx, v[i]);
            mx = fmaxf(mx, __shfl_xor(mx, 32));
            if (hi == 0) dst[it] = mx;
#pragma unroll
            for (int i = 0; i < 64; ++i) v[i] = (v[i] == mx) ? NEG_INF : v[i];
        }
    }
}

__device__ __forceinline__ void phase5a(const Params& p, int tid) {
    const float* TK = (const float*)(p.ws + WS_TK);
    int* IDX = (int*)(p.ws + WS_IDX); float* GATE = (float*)(p.ws + WS_GATE);
    const float NEG_INF = -__builtin_huge_valf();
    for (int item = blockIdx.x * 512 + tid; item < NT * 8; item += gridDim.x * 512) {
        const int tok = item >> 3, r = item & 7;
        const f32x4* pa = (const f32x4*)(TK + ((size_t)tok * 16 + 2 * r) * 16);
        float a[16], b[16]; int ia[16], ib[16];
#pragma unroll
        for (int q = 0; q < 4; ++q) { const f32x4 x = pa[q], y = pa[4 + q];
#pragma unroll
            for (int j = 0; j < 4; ++j) { a[4 * q + j] = x[j]; b[4 * q + j] = y[j]; } }
#pragma unroll
        for (int i = 0; i < 16; ++i) { const unsigned ua = __float_as_uint(a[i]), ub = __float_as_uint(b[i]); ia[i] = 127 - (int)(ua & 127u); ib[i] = 127 - (int)(ub & 127u); a[i] = __uint_as_float(ua & ~127u); b[i] = __uint_as_float(ub & ~127u); }
        float cv[50]; int cid[50];
        {
            int c = 0;
#pragma unroll
            for (int i = 0; i < 16; ++i)
#pragma unroll
                for (int j = 0; j < 16; ++j)
                    if ((i + 1) * (j + 1) <= 16) { const float s = a[i] + b[j]; cv[c] = __uint_as_float((__float_as_uint(s) & ~63u) | (unsigned)(63 - c)); cid[c] = ia[i] * 128 + ib[j]; ++c; }
        }
        float best[16]; int bid[16];
#pragma unroll
        for (int it = 0; it < 16; ++it) {
            float mx = cv[0];
#pragma unroll
            for (int c = 1; c < 50; ++c) mx = fmaxf(mx, cv[c]);
            int id = 0;
#pragma unroll
            for (int c = 0; c < 50; ++c) { const bool hit = cv[c] == mx; id = hit ? cid[c] : id; cv[c] = hit ? NEG_INF : cv[c]; }
            best[it] = __uint_as_float(__float_as_uint(mx) & ~63u); bid[it] = id;
        }
        float e[16], sum = 0.f;
#pragma unroll
        for (int k = 0; k < 16; ++k) { e[k] = __expf(best[k] - best[0]); sum += e[k]; }
        const float rinv = 1.f / sum;
        int* io = IDX + (size_t)tok * 128 + r * 16; float* go = GATE + (size_t)tok * 128 + r * 16;
#pragma unroll
        for (int k = 0; k < 16; ++k) { io[k] = bid[k]; go[k] = e[k] * rinv; }
    }
}

__device__ __forceinline__ float gelu_erf(float x) { return 0.5f * x * (1.f + erff(x * 0.70710678118654752f)); }
__device__ __forceinline__ void fp8x16_to_f32(const u32x4 q, float (&f)[16]) {
    const f32x2 c0 = __builtin_amdgcn_cvt_pk_f32_fp8(q.x, false), c1 = __builtin_amdgcn_cvt_pk_f32_fp8(q.x, true), c2 = __builtin_amdgcn_cvt_pk_f32_fp8(q.y, false), c3 = __builtin_amdgcn_cvt_pk_f32_fp8(q.y, true);
    const f32x2 c4 = __builtin_amdgcn_cvt_pk_f32_fp8(q.z, false), c5 = __builtin_amdgcn_cvt_pk_f32_fp8(q.z, true), c6 = __builtin_amdgcn_cvt_pk_f32_fp8(q.w, false), c7 = __builtin_amdgcn_cvt_pk_f32_fp8(q.w, true);
    f[0] = c0.x; f[1] = c0.y; f[2] = c1.x; f[3] = c1.y; f[4] = c2.x; f[5] = c2.y; f[6] = c3.x; f[7] = c3.y;
    f[8] = c4.x; f[9] = c4.y; f[10] = c5.x; f[11] = c5.y; f[12] = c6.x; f[13] = c6.y; f[14] = c7.x; f[15] = c7.y;
}
__device__ __forceinline__ void slice_group(int& x, int& gwx, int& nwx, int wave) {
    x = blockIdx.x & 7; const int nbx = ((int)gridDim.x - x + 7) >> 3; gwx = ((int)blockIdx.x >> 3) * 8 + wave; nwx = nbx * 8;
}
__device__ __forceinline__ void phase5u(const Params& p, LAS unsigned char* lds, int lane, int wave) {
    int x, gwx, nwx; slice_group(x, gwx, nwx, wave);
    const unsigned char* PU8 = p.ws + WS_PU8 + (size_t)x * 16384 * 128;
    const bf16_t* H2 = (const bf16_t*)(p.ws + WS_H2) + 128 * x;
    const int* IDX = (const int*)(p.ws + WS_IDX); float* PACT = (float*)(p.ws + WS_PACT) + (size_t)x * NT * 128;
    LAS int* l_idx = (LAS int*)(lds + wave * 512);
    const int g = lane >> 3, sub = lane & 7;
    int tok = gwx;
    int n_idxA = 0, n_idxB = 0; u32x4 n_h0 = (u32x4){0u, 0u, 0u, 0u}, n_h1 = n_h0;
    if (tok < NT) { n_idxA = IDX[(size_t)tok * 128 + lane]; n_idxB = IDX[(size_t)tok * 128 + 64 + lane]; n_h0 = *(const u32x4*)(H2 + (size_t)tok * DM + 16 * sub); n_h1 = *(const u32x4*)(H2 + (size_t)tok * DM + 16 * sub + 8); }
    for (; tok < NT; tok += nwx) {
        l_idx[lane] = n_idxA; l_idx[64 + lane] = n_idxB;
        const u32x4 h0 = n_h0, h1 = n_h1;
        const int nt = tok + nwx;
        if (nt < NT) { n_idxA = IDX[(size_t)nt * 128 + lane]; n_idxB = IDX[(size_t)nt * 128 + 64 + lane]; n_h0 = *(const u32x4*)(H2 + (size_t)nt * DM + 16 * sub); n_h1 = *(const u32x4*)(H2 + (size_t)nt * DM + 16 * sub + 8); }
        f32x2 hf[8];
        hf[0] = (f32x2){bflo(h0.x), bfhi(h0.x)}; hf[1] = (f32x2){bflo(h0.y), bfhi(h0.y)}; hf[2] = (f32x2){bflo(h0.z), bfhi(h0.z)}; hf[3] = (f32x2){bflo(h0.w), bfhi(h0.w)};
        hf[4] = (f32x2){bflo(h1.x), bfhi(h1.x)}; hf[5] = (f32x2){bflo(h1.y), bfhi(h1.y)}; hf[6] = (f32x2){bflo(h1.z), bfhi(h1.z)}; hf[7] = (f32x2){bflo(h1.w), bfhi(h1.w)};
        int ei[16];
#pragma unroll
        for (int q = 0; q < 4; ++q) { const u32x4 iv = *(const LAS u32x4*)(l_idx + 16 * g + 4 * q); ei[4 * q] = (int)iv.x; ei[4 * q + 1] = (int)iv.y; ei[4 * q + 2] = (int)iv.z; ei[4 * q + 3] = (int)iv.w; }
        u32x4 q[16];
#pragma unroll
        for (int i = 0; i < 16; ++i) q[i] = *(const u32x4*)(PU8 + (size_t)ei[i] * 128 + sub * 16);
        float resA = 0.f, resB = 0.f;
#pragma unroll
        for (int i = 0; i < 16; ++i) {
            f32x2 s2 = __builtin_amdgcn_cvt_pk_f32_fp8(q[i].x, false) * hf[0];
            s2 = __builtin_elementwise_fma(__builtin_amdgcn_cvt_pk_f32_fp8(q[i].x, true), hf[1], s2);
            s2 = __builtin_elementwise_fma(__builtin_amdgcn_cvt_pk_f32_fp8(q[i].y, false), hf[2], s2);
            s2 = __builtin_elementwise_fma(__builtin_amdgcn_cvt_pk_f32_fp8(q[i].y, true), hf[3], s2);
            s2 = __builtin_elementwise_fma(__builtin_amdgcn_cvt_pk_f32_fp8(q[i].z, false), hf[4], s2);
            s2 = __builtin_elementwise_fma(__builtin_amdgcn_cvt_pk_f32_fp8(q[i].z, true), hf[5], s2);
            s2 = __builtin_elementwise_fma(__builtin_amdgcn_cvt_pk_f32_fp8(q[i].w, false), hf[6], s2);
            s2 = __builtin_elementwise_fma(__builtin_amdgcn_cvt_pk_f32_fp8(q[i].w, true), hf[7], s2);
            float sr = s2.x + s2.y;
            DPP_ADD(sr, 0xB1); DPP_ADD(sr, 0x4E); DPP_ADD(sr, 0x141);
            if (i < 8) resA = (sub == i) ? sr : resA; else resB = (sub == i - 8) ? sr : resB;
        }
        PACT[(size_t)tok * 128 + 16 * g + sub] = resA; PACT[(size_t)tok * 128 + 16 * g + 8 + sub] = resB;
    }
}
__device__ __forceinline__ void phase5c(const Params& p, int tid) {
    const float* PACT = (const float*)(p.ws + WS_PACT); const float* SCU = (const float*)(p.ws + WS_SCU); const float* SCV = (const float*)(p.ws + WS_SCV);
    const int* IDX = (const int*)(p.ws + WS_IDX); const float* GATE = (const float*)(p.ws + WS_GATE); float* COEF = (float*)(p.ws + WS_COEF);
    const size_t n = (size_t)NT * 128;
    for (size_t it = (size_t)blockIdx.x * 512 + tid; it < n; it += (size_t)gridDim.x * 512) {
        float a = 0.f;
#pragma unroll
        for (int xx = 0; xx < 8; ++xx) a += PACT[(size_t)xx * n + it];
        const int e = IDX[it];
        COEF[it] = GATE[it] * gelu_erf(a * SCU[e]) * SCV[e];
    }
}

constexpr int P5V_LDS_PER_WAVE = 1024 + 8 * 136 * 4;
__device__ __forceinline__ void phase5v(const Params& p, LAS unsigned char* lds, int lane, int wave) {
    int x, gwx, nwx; slice_group(x, gwx, nwx, wave);
    const unsigned char* PV8 = p.ws + WS_PV8 + (size_t)x * 16384 * 128;
    const int* IDX = (const int*)(p.ws + WS_IDX); const float* COEF = (const float*)(p.ws + WS_COEF);
    LAS int* l_idx = (LAS int*)(lds + wave * P5V_LDS_PER_WAVE); LAS float* l_cf = (LAS float*)(l_idx + 128); LAS float* red = l_cf + 128;
    const int g = lane >> 3, sub = lane & 7;
    int tok = gwx;
    int n_idxA = 0, n_idxB = 0; float n_cA = 0.f, n_cB = 0.f;
    if (tok < NT) { n_idxA = IDX[(size_t)tok * 128 + lane]; n_idxB = IDX[(size_t)tok * 128 + 64 + lane]; n_cA = COEF[(size_t)tok * 128 + lane]; n_cB = COEF[(size_t)tok * 128 + 64 + lane]; }
    for (; tok < NT; tok += nwx) {
        l_idx[lane] = n_idxA; l_idx[64 + lane] = n_idxB; l_cf[lane] = n_cA; l_cf[64 + lane] = n_cB;
        const int nt = tok + nwx;
        if (nt < NT) { n_idxA = IDX[(size_t)nt * 128 + lane]; n_idxB = IDX[(size_t)nt * 128 + 64 + lane]; n_cA = COEF[(size_t)nt * 128 + lane]; n_cB = COEF[(size_t)nt * 128 + 64 + lane]; }
        float* xr = p.out + (size_t)tok * DM + 128 * x;
        const int c1 = 16 * (lane & 7) + (lane >> 3);
        const float x2a = xr[c1], x2b = xr[c1 + 8];
        int ei[16]; float cf[16];
#pragma unroll
        for (int q = 0; q < 4; ++q) {
            const u32x4 iv = *(const LAS u32x4*)(l_idx + 16 * g + 4 * q); const f32x4 cv = *(const LAS f32x4*)(l_cf + 16 * g + 4 * q);
            ei[4 * q] = (int)iv.x; ei[4 * q + 1] = (int)iv.y; ei[4 * q + 2] = (int)iv.z; ei[4 * q + 3] = (int)iv.w;
            cf[4 * q] = cv[0]; cf[4 * q + 1] = cv[1]; cf[4 * q + 2] = cv[2]; cf[4 * q + 3] = cv[3];
        }
        u32x4 q[16];
#pragma unroll
        for (int i = 0; i < 16; ++i) q[i] = *(const u32x4*)(PV8 + (size_t)ei[i] * 128 + sub * 16);
        f32x2 acc[8];
#pragma unroll
        for (int j = 0; j < 8; ++j) acc[j] = (f32x2){0.f, 0.f};
#pragma unroll
        for (int i = 0; i < 16; ++i) {
            const f32x2 c2 = (f32x2){cf[i], cf[i]};
            acc[0] = __builtin_elementwise_fma(__builtin_amdgcn_cvt_pk_f32_fp8(q[i].x, false), c2, acc[0]);
            acc[1] = __builtin_elementwise_fma(__builtin_amdgcn_cvt_pk_f32_fp8(q[i].x, true), c2, acc[1]);
            acc[2] = __builtin_elementwise_fma(__builtin_amdgcn_cvt_pk_f32_fp8(q[i].y, false), c2, acc[2]);
            acc[3] = __builtin_elementwise_fma(__builtin_amdgcn_cvt_pk_f32_fp8(q[i].y, true), c2, acc[3]);
            acc[4] = __builtin_elementwise_fma(__builtin_amdgcn_cvt_pk_f32_fp8(q[i].z, false), c2, acc[4]);
            acc[5] = __builtin_elementwise_fma(__builtin_amdgcn_cvt_pk_f32_fp8(q[i].z, true), c2, acc[5]);
            acc[6] = __builtin_elementwise_fma(__builtin_amdgcn_cvt_pk_f32_fp8(q[i].w, false), c2, acc[6]);
            acc[7] = __builtin_elementwise_fma(__builtin_amdgcn_cvt_pk_f32_fp8(q[i].w, true), c2, acc[7]);
        }
#pragma unroll
        for (int j = 0; j < 8; ++j) { red[g * 136 + (2 * j) * 8 + sub] = acc[j].x; red[g * 136 + (2 * j + 1) * 8 + sub] = acc[j].y; }
        float s1 = x2a, s2 = x2b;
#pragma unroll
        for (int gg = 0; gg < 8; ++gg) { s1 += red[gg * 136 + lane]; s2 += red[gg * 136 + 64 + lane]; }
        xr[c1] = s1; xr[c1 + 8] = s2;
    }
}

__device__ __forceinline__ void phase6(const Params& p, int lane, int wave) {
    const int gw = blockIdx.x * 8 + wave, NGW = gridDim.x * 8;
    const f32x4* gr = (const f32x4*)p.in[23] + lane;
    for (int m = gw; m < NT; m += NGW) {
        f32x4* xr = (f32x4*)(p.out + (size_t)m * DM) + lane;
        f32x4 v[4]; float s = 0.f;
#pragma unroll
        for (int j = 0; j < 4; ++j) { v[j] = xr[64 * j]; s += (v[j][0] * v[j][0] + v[j][1] * v[j][1]) + (v[j][2] * v[j][2] + v[j][3] * v[j][3]); }
        const float rstd = 1.f / sqrtf(wave_total(s) * (1.f / DM) + EPS);
#pragma unroll
        for (int j = 0; j < 4; ++j) xr[64 * j] = v[j] * rstd * gr[64 * j];
    }
}

__global__ void __launch_bounds__(512, 2) fwd_megakernel(Params p) {
    extern __shared__ __attribute__((aligned(16))) unsigned char lds_raw[];
    LAS unsigned char* lds = (LAS unsigned char*)lds_raw;
    cg::grid_group grid = cg::this_grid();
    const int tid = threadIdx.x, lane = tid & 63, wave = __builtin_amdgcn_readfirstlane(tid >> 6);
    const int G = gridDim.x;
    volatile LAS unsigned* MISC = (volatile LAS unsigned*)(lds + MISC_OFF);
    if (tid < 32) MISC[tid] = 0u;
    __syncthreads();
    XcdBarrier bar = xcd_barrier_post((unsigned*)(p.ws + WS_CTL) + 4096, MISC + 8);
#define GSYNC() xcd_barrier(bar)

#ifndef RPT_MASK
#define RPT_MASK 0
#endif
#define RPT(bit) for (int rpt_ = 0; rpt_ < (((RPT_MASK) >> (bit)) & 1) + 1; ++rpt_)
    RPT(0) { phase0(p, lds, tid, lane, wave); grid.sync(); }
    RPT(1) {
        pg8::Gemm g{(const bf16_t*)(p.ws + WS_H), (const bf16_t*)(p.ws + WS_WINT), NT, DIN, 1024};
        pg8::StaticOrder S; S.init(NT, DIN, G, (int)blockIdx.x);
        pg8::EpiProj E{(bf16_t*)(p.ws + WS_A), (bf16_t*)(p.ws + WS_Q), (bf16_t*)(p.ws + WS_KP), (bf16_t*)(p.ws + WS_VP), (bf16_t*)(p.ws + WS_KS), (bf16_t*)(p.ws + WS_VS), p.out};
        pg8::gemm_phase<pg8::EpiProj, pg8::StaticOrder, true, true>(lds, g, S, E);
        GSYNC();
    }
    #ifndef P2MODE
#define P2MODE 0
#endif
    RPT(2) { att::phase2(p, lds, tid, lane, wave, rpt_, (((RPT_MASK) >> 2) & 1) && rpt_ == 0 ? P2MODE : 0); GSYNC(); }
    RPT(3) {
        pg8::Gemm g{(const bf16_t*)(p.ws + WS_MIX), (const bf16_t*)(p.ws + WS_WOUTT), NT, 1024, 1024};
        pg8::StaticOrder S; S.init(NT, 1024, G, (int)blockIdx.x);
        pg8::EpiRes E{p.in[0], p.in[1], p.out};
        pg8::gemm_phase<pg8::EpiRes, pg8::StaticOrder, true, true>(lds, g, S, E);
        GSYNC();
    }
    RPT(4) { phase3b(p, lane, wave); GSYNC(); }
    RPT(5) {
        pg8::Gemm g{(const bf16_t*)(p.ws + WS_H2), (const bf16_t*)(p.ws + WS_WQT), NT, 2048, 1024};
        pg8::StaticOrder S; S.init(NT, 2048, G, (int)blockIdx.x);
        pg8::EpiBf16<0> E{(bf16_t*)(p.ws + WS_QP), 2048, nullptr, 0, 0, 1.f};
        pg8::gemm_phase<pg8::EpiBf16<0>, pg8::StaticOrder, true, true>(lds, g, S, E);
        GSYNC();
    }
    RPT(6) { phase4b(p, lane, wave); GSYNC(); }
    RPT(7) { phase5a(p, tid); GSYNC(); }
    RPT(8) { phase5u(p, lds, lane, wave); GSYNC(); }
    phase5c(p, tid);
    GSYNC();
    phase5v(p, lds, lane, wave);
    GSYNC();
    phase6(p, lane, wave);
}

extern "C" void kernel_launch(void* const* d_in, const int* in_sizes, int n_in, void* d_out, int out_size, void* d_ws, size_t ws_size, hipStream_t stream) {
    static int grid = 0;
    if (grid == 0) {
        if (n_in != 24 || out_size != (int)OUT_TOTAL || ws_size < WS_END) { fprintf(stderr, "kernel_launch: unexpected shapes: n_in %d out %d ws %zu (need %zu)\n", n_in, out_size, ws_size, (size_t)WS_END); grid = -1; return; }
        int dev = 0, cus = 0, per_cu = 0;
        (void)hipGetDevice(&dev);
        (void)hipDeviceGetAttribute(&cus, hipDeviceAttributeMultiprocessorCount, dev);
        if (hipFuncSetAttribute((const void*)fwd_megakernel, hipFuncAttributeMaxDynamicSharedMemorySize, LDS_BYTES) != hipSuccess) { fprintf(stderr, "kernel_launch: hipFuncSetAttribute failed\n"); grid = -1; return; }
        if (hipOccupancyMaxActiveBlocksPerMultiprocessor(&per_cu, (const void*)fwd_megakernel, 512, LDS_BYTES) != hipSuccess || per_cu < 1) { fprintf(stderr, "kernel_launch: occupancy query gave %d\n", per_cu); per_cu = 1; }
        (void)hipGetLastError();
        grid = cus * 1;
        if (per_cu < 1) grid = -1;
    }
    if (grid < 0) return;
    (void)hipMemsetAsync((char*)d_ws + WS_CTL, 0, CTL_BYTES, stream);
    Params p{};
    for (int i = 0; i < 24; ++i) p.in[i] = (const float*)d_in[i];
    p.out = (float*)d_out; p.ws = (unsigned char*)d_ws;
    void* args[] = {&p};
    hipError_t e = hipLaunchCooperativeKernel((const void*)fwd_megakernel, dim3(grid), dim3(512), args, LDS_BYTES, stream);
    if (e != hipSuccess) fprintf(stderr, "cooperative launch failed: %s (grid %d)\n", hipGetErrorString(e), grid);
}
```

```cpp
#include <hip/hip_runtime.h>
#include <hip/hip_cooperative_groups.h>
#include <cstdio>
#include <cstdint>
#include <cmath>
namespace cg = cooperative_groups;
namespace pg8 {
#define PG8_LAS __attribute__((address_space(3)))
typedef unsigned short bf16_t;
typedef short bf16x8 __attribute__((ext_vector_type(8)));
typedef float f32x4 __attribute__((ext_vector_type(4)));
typedef unsigned u32x4 __attribute__((ext_vector_type(4)));
constexpr int BM = 256, BK = 64, HALF = 128, HTB = HALF * BK * 2  , STAGE_BYTES = 8 * HTB, NXCD = 8, WGM = 8;

__host__ __device__ __forceinline__ int lds_byte(int r, int c) { const int st = (r >> 4) * 2 + (c >> 5), rr = r & 15, cc = c & 31, ob = rr * 64 + cc * 2; return st * 1024 + (ob ^ (((ob >> 9) & 1) << 5)); }
__host__ __device__ __forceinline__ void stage_rc(int b, int& R, int& C) { const int st = b / 1024, sb = b % 1024, swz = sb ^ (((sb >> 9) & 1) << 5); R = (st >> 1) * 16 + swz / 64; C = (st & 1) * 32 + (swz % 64) / 2; }
__host__ __device__ __forceinline__ int perm32(int rho) { const int n = rho >> 4, i = rho & 15; return 8 * (i >> 2) + 4 * n + (i & 3); }

struct Unit { int pm, pn; };
struct Gemm { const bf16_t* A; const bf16_t* Bt; int M, N, K; };

struct StaticOrder {
    int nM, nN, nwg, G, c;
    __host__ __device__ void init(int M, int N, int G_, int c_) { nM = M / BM; nN = N / BM; nwg = nM * nN; G = G_; c = c_; }
    __host__ __device__ bool next(int i, Unit& u) const {
        const long L = (long)i * G + c; if (L >= nwg) return false;
        int wgid = (int)L; { const int q = nwg / NXCD, r = nwg % NXCD, xcd = wgid % NXCD, off = wgid / NXCD; wgid = (xcd < r ? xcd * (q + 1) : r * (q + 1) + (xcd - r) * q) + off; }
        const int nig = WGM * nN, gid = wgid / nig, fm = gid * WGM, gsz = (nM - fm) < WGM ? (nM - fm) : WGM;
        u.pm = fm + ((wgid % nig) % gsz); u.pn = (wgid % nig) / gsz; return true;
    }
    __device__ __forceinline__ void a_ready(const Unit&) const {}
    __device__ __forceinline__ void done(const Unit&) const {}
};

__device__ __forceinline__ unsigned cvt_pk_bf16(float lo, float hi) { unsigned r; asm volatile("v_cvt_pk_bf16_f32 %0, %1, %2" : "=v"(r) : "v"(lo), "v"(hi)); return r; }
typedef float f32x2 __attribute__((ext_vector_type(2)));
__device__ __forceinline__ f32x2 gelu_pk(f32x2 v) {
    const f32x2 av = __builtin_elementwise_abs(v), d = av * 0.2316418882f + 1.0f;
    f32x2 t; t.x = __builtin_amdgcn_rcpf(d.x); t.y = __builtin_amdgcn_rcpf(d.y);
    f32x2 q = t * 0.5307027145f + (-0.7265760135f); q = q * t + 0.7107068705f; q = q * t + (-0.142248368f); q = q * t + 0.127414796f; q = q * t;
    const f32x2 s = (v * v) * (-0.72134752044f);
    f32x2 e; e.x = __builtin_amdgcn_exp2f(s.x); e.y = __builtin_amdgcn_exp2f(s.y);
    const f32x2 m = v * (q * e), r = v - m;
    f32x2 o; o.x = v.x < 0.f ? m.x : r.x; o.y = v.y < 0.f ? m.y : r.y; return o;
}

template <int ACT  > struct EpiBf16 {
    static constexpr bool PERM = true, AFTER_DRAIN = false; static_assert(ACT == 0 || ACT == 1, "EpiBf16: ACT is 0 (none) or 1 (gelu_pk)");
    bf16_t* O; int ldc; const float* bias; int split_cols; size_t split_stride; float scale0;
    __device__ __forceinline__ void operator()(const f32x4 (&acc)[2][2][4][2], const Unit& u, int wr, int wc, int fr, int fq) const {
        const int row0 = u.pm * BM + wr * 64 + fr; int colt = u.pn * BM; bf16_t* base = O;
        float sc = 1.f; if (split_cols) { const int t = colt / split_cols; base += (size_t)t * split_stride; colt -= t * split_cols; if (t == 0) sc = scale0; }
        const int col0 = colt + wc * 32 + 8 * fq, bcol0 = u.pn * BM + wc * 32 + 8 * fq;
        f32x4 bv[2][2];
#pragma unroll
        for (int bj = 0; bj < 2; ++bj)
#pragma unroll
            for (int n = 0; n < 2; ++n) bv[bj][n] = bias ? *(const f32x4*)(bias + bcol0 + bj * HALF + 4 * n) : (f32x4){0.f, 0.f, 0.f, 0.f};
#pragma unroll
        for (int ai = 0; ai < 2; ++ai)
#pragma unroll
            for (int m = 0; m < 4; ++m) { bf16_t* rowp = base + (size_t)(row0 + ai * HALF + m * 16) * ldc + col0;
#pragma unroll
                for (int bj = 0; bj < 2; ++bj) { f32x4 v0 = acc[ai][bj][m][0] + bv[bj][0], v1 = acc[ai][bj][m][1] + bv[bj][1];
                    if (ACT == 1) { f32x2 a = gelu_pk((f32x2){v0[0], v0[1]}), b = gelu_pk((f32x2){v0[2], v0[3]}), c = gelu_pk((f32x2){v1[0], v1[1]}), d = gelu_pk((f32x2){v1[2], v1[3]});
                        v0 = (f32x4){a.x, a.y, b.x, b.y}; v1 = (f32x4){c.x, c.y, d.x, d.y}; }
                    v0 = v0 * sc; v1 = v1 * sc; u32x4 w; w.x = cvt_pk_bf16(v0[0], v0[1]); w.y = cvt_pk_bf16(v0[2], v0[3]); w.z = cvt_pk_bf16(v1[0], v1[1]); w.w = cvt_pk_bf16(v1[2], v1[3]);
                    *(u32x4*)(rowp + bj * HALF) = w; } }
    }
};
template <class Epi, class Sched, bool ALIGN_EPI = false, bool SP2 = false>
__device__ __forceinline__ void gemm_phase(PG8_LAS unsigned char* lds, const Gemm g, const Sched& S, const Epi& E) {
    const int tid = threadIdx.x, wid = __builtin_amdgcn_readfirstlane(tid >> 6), lane = tid & 63, wr = wid >> 2, wc = wid & 3, fr = lane & 15, fq = lane >> 4;
    const int K = g.K, nt = K / BK;
    unsigned voffA[2], voffB[2];
#pragma unroll
    for (int i = 0; i < 2; ++i) { int R, C; stage_rc(tid * 16 + i * 8192, R, C); const int Rb = Epi::PERM ? ((R & ~31) + perm32(R & 31)) : R;
        voffA[i] = (unsigned)(R * K + C) * 2u; voffB[i] = (unsigned)(Rb * K + C) * 2u; }
    const size_t kstep = (size_t)(BK * 2);
    const size_t hstep = (size_t)HALF * K * 2;
    const size_t tstep = 2 * hstep;
    const unsigned ldsw = (unsigned)wid * 1024u;
    const int aoff = lds_byte(wr * 64 + fr, fq * 8), boff = lds_byte(wc * 32 + fr, fq * 8);
#define PG8_SA(b, h) (((b) * 2 + (h)) * HTB)
#define PG8_SB(b, h) ((4 + (b) * 2 + (h)) * HTB)
#define PG8_STAGE(bufoff, gbase, voff) do { _Pragma("unroll") for (int _i = 0; _i < 2; ++_i) \
        __builtin_amdgcn_global_load_lds((const unsigned*)((const char*)(gbase) + (voff)[_i]), (PG8_LAS unsigned*)(lds + (bufoff) + ldsw + _i * 8192), 16, 0, 0); } while (0)
#define PG8_LDA(dst, b, h) do { _Pragma("unroll") for (int m = 0; m < 4; ++m) _Pragma("unroll") for (int k = 0; k < 2; ++k) dst[m][k] = *(const PG8_LAS bf16x8*)(lds + PG8_SA(b, h) + aoff + m * 2048 + k * 1024); } while (0)
#define PG8_LDB(dst, b, h) do { _Pragma("unroll") for (int n = 0; n < 2; ++n) _Pragma("unroll") for (int k = 0; k < 2; ++k) dst[n][k] = *(const PG8_LAS bf16x8*)(lds + PG8_SB(b, h) + boff + n * 2048 + k * 1024); } while (0)
#define PG8_MMA(ai, bj, At, Bt) do { __builtin_amdgcn_s_setprio(1); _Pragma("unroll") for (int m = 0; m < 4; ++m) _Pragma("unroll") for (int n = 0; n < 2; ++n) _Pragma("unroll") for (int k = 0; k < 2; ++k) \
        acc[ai][bj][m][n] = __builtin_amdgcn_mfma_f32_16x16x32_bf16(Bt[n][k], At[m][k], acc[ai][bj][m][n], 0, 0, 0); __builtin_amdgcn_s_setprio(0); } while (0)
#define PG8_WAIT_V(n) asm volatile("s_waitcnt vmcnt(" #n ")" ::: "memory")
#define PG8_WAIT_L(n) asm volatile("s_waitcnt lgkmcnt(" #n ")" ::: "memory")
#define PG8_BAR __builtin_amdgcn_s_barrier()
#define PG8_SCHED __builtin_amdgcn_sched_barrier(0)
    Unit cur, nxt; int ui = 0;
    if (!S.next(0, cur)) return;
    f32x4 acc[2][2][4][2];
#pragma unroll
    for (int a = 0; a < 2; ++a)
#pragma unroll
        for (int b = 0; b < 2; ++b)
#pragma unroll
            for (int m = 0; m < 4; ++m)
#pragma unroll
                for (int n = 0; n < 2; ++n) acc[a][b][m][n] = (f32x4){0.f, 0.f, 0.f, 0.f};
    bf16x8 At[4][2], B0[2][2], B1[2][2];
    const char* cA = (const char*)g.A + (size_t)cur.pm * tstep; const char* cB = (const char*)g.Bt + (size_t)cur.pn * tstep;
    S.a_ready(cur);
    if constexpr (SP2) {
        PG8_STAGE(PG8_SB(0, 0), cB, voffB); PG8_STAGE(PG8_SB(0, 1), cB + hstep, voffB); PG8_STAGE(PG8_SA(0, 0), cA, voffA); PG8_STAGE(PG8_SA(0, 1), cA + hstep, voffA);
        if (wr == 1) PG8_BAR;
        PG8_WAIT_V(2); PG8_BAR;
        PG8_STAGE(PG8_SB(1, 0), cB + kstep, voffB); PG8_STAGE(PG8_SA(1, 0), cA + kstep, voffA); PG8_STAGE(PG8_SB(1, 1), cB + hstep + kstep, voffB);
        PG8_WAIT_V(6); PG8_BAR;
    } else {
        PG8_STAGE(PG8_SB(0, 0), cB, voffB); PG8_STAGE(PG8_SA(0, 0), cA, voffA); PG8_STAGE(PG8_SB(0, 1), cB + hstep, voffB); PG8_STAGE(PG8_SA(0, 1), cA + hstep, voffA);
        if (wr == 1) PG8_BAR;
        PG8_WAIT_V(4); PG8_BAR;
        PG8_STAGE(PG8_SB(1, 0), cB + kstep, voffB); PG8_STAGE(PG8_SA(1, 0), cA + kstep, voffA); PG8_STAGE(PG8_SB(1, 1), cB + hstep + kstep, voffB);
        PG8_WAIT_V(6); PG8_BAR;
    }
    for (;;) {
        const bool has_next = S.next(ui + 1, nxt);
        const char* nA = has_next ? (const char*)g.A + (size_t)nxt.pm * tstep : cA; const char* nB = has_next ? (const char*)g.Bt + (size_t)nxt.pn * tstep : cB;
        for (int t = 0; t < nt; t += 2) {
            const bool last = (t == nt - 2);
            const char* a1 = cA + (size_t)(t + 1) * kstep;
            const char* a2 = last ? nA : cA + (size_t)(t + 2) * kstep; const char* b2 = last ? nB : cB + (size_t)(t + 2) * kstep;
            const char* a3 = a2 + kstep; const char* b3 = b2 + kstep;
            if (last && has_next) S.a_ready(nxt);
            if constexpr (SP2) {
            PG8_LDB(B0, 0, 0); PG8_LDB(B1, 0, 1); PG8_SCHED; PG8_LDA(At, 0, 0); PG8_STAGE(PG8_SA(1, 1), a1 + hstep, voffA);
            PG8_WAIT_V(8); PG8_WAIT_L(0); PG8_BAR; PG8_MMA(0, 0, At, B0); PG8_MMA(0, 1, At, B1); PG8_BAR; PG8_SCHED;
            PG8_LDA(At, 0, 1); PG8_STAGE(PG8_SB(0, 0), b2, voffB); PG8_STAGE(PG8_SB(0, 1), b2 + hstep, voffB); PG8_STAGE(PG8_SA(0, 0), a2, voffA);
            PG8_WAIT_V(8); PG8_WAIT_L(0); PG8_BAR; PG8_MMA(1, 0, At, B0); PG8_MMA(1, 1, At, B1); PG8_BAR; PG8_SCHED;
            PG8_LDB(B0, 1, 0); PG8_LDB(B1, 1, 1); PG8_SCHED; PG8_LDA(At, 1, 0); PG8_STAGE(PG8_SA(0, 1), a2 + hstep, voffA);
            PG8_WAIT_V(8); PG8_WAIT_L(0); PG8_BAR; PG8_MMA(0, 0, At, B0); PG8_MMA(0, 1, At, B1); PG8_BAR; PG8_SCHED;
            PG8_LDA(At, 1, 1); PG8_STAGE(PG8_SB(1, 0), b3, voffB); PG8_STAGE(PG8_SB(1, 1), b3 + hstep, voffB); PG8_STAGE(PG8_SA(1, 0), a3, voffA);
            PG8_WAIT_V(8); PG8_WAIT_L(0); PG8_BAR; PG8_MMA(1, 0, At, B0); PG8_MMA(1, 1, At, B1); PG8_BAR; PG8_SCHED;
            } else {
            PG8_LDB(B0, 0, 0); PG8_SCHED; PG8_LDA(At, 0, 0); PG8_STAGE(PG8_SA(1, 1), a1 + hstep, voffA);
            PG8_WAIT_L(8); PG8_BAR; PG8_WAIT_L(0); PG8_MMA(0, 0, At, B0); PG8_BAR; PG8_SCHED;
            PG8_LDB(B1, 0, 1); PG8_STAGE(PG8_SB(0, 0), b2, voffB);
            PG8_BAR; PG8_WAIT_L(0); PG8_MMA(0, 1, At, B1); PG8_BAR;
            PG8_LDA(At, 0, 1); PG8_STAGE(PG8_SA(0, 0), a2, voffA);
            PG8_BAR; PG8_WAIT_L(0); PG8_MMA(1, 0, At, B0); PG8_BAR; PG8_SCHED;
            PG8_STAGE(PG8_SB(0, 1), b2 + hstep, voffB);
            PG8_WAIT_V(6); PG8_BAR; PG8_MMA(1, 1, At, B1); PG8_BAR;
            PG8_LDB(B0, 1, 0); PG8_SCHED; PG8_LDA(At, 1, 0); PG8_STAGE(PG8_SA(0, 1), a2 + hstep, voffA);
            PG8_WAIT_L(8); PG8_BAR; PG8_WAIT_L(0); PG8_MMA(0, 0, At, B0); PG8_BAR; PG8_SCHED;
            PG8_LDB(B1, 1, 1); PG8_STAGE(PG8_SB(1, 0), b3, voffB);
            PG8_BAR; PG8_WAIT_L(0); PG8_MMA(0, 1, At, B1); PG8_BAR;
            PG8_LDA(At, 1, 1); PG8_STAGE(PG8_SA(1, 0), a3, voffA);
            PG8_BAR; PG8_WAIT_L(0); PG8_MMA(1, 0, At, B0); PG8_BAR; PG8_SCHED;
            PG8_STAGE(PG8_SB(1, 1), b3 + hstep, voffB);
            PG8_WAIT_V(6); PG8_BAR; PG8_MMA(1, 1, At, B1); PG8_BAR;
            }
        }
        if constexpr (ALIGN_EPI) { if (wr == 0) PG8_BAR; }
        if constexpr (!Epi::AFTER_DRAIN) { E(acc, cur, wr, wc, fr, fq); S.done(cur); }
        if (!has_next) break;
#pragma unroll
        for (int a = 0; a < 2; ++a)
#pragma unroll
            for (int b = 0; b < 2; ++b)
#pragma unroll
                for (int m = 0; m < 4; ++m)
#pragma unroll
                    for (int n = 0; n < 2; ++n) acc[a][b][m][n] = (f32x4){0.f, 0.f, 0.f, 0.f};
        cur = nxt; cA = nA; cB = nB; ++ui;
        if constexpr (ALIGN_EPI) { if (wr == 1) PG8_BAR; }
    }
    PG8_WAIT_V(0);
    if constexpr (!ALIGN_EPI) { if (wr == 0) PG8_BAR; }
    PG8_BAR;
    if constexpr (Epi::AFTER_DRAIN) { E.fused(acc, cur, wr, wc, fr, fq, lds, wid, lane); S.done(cur); }
#undef PG8_SA
#undef PG8_SB
#undef PG8_STAGE
#undef PG8_LDA
#undef PG8_LDB
#undef PG8_MMA
#undef PG8_WAIT_V
#undef PG8_WAIT_L
#undef PG8_BAR
#undef PG8_SCHED
}
}

#define LAS __attribute__((address_space(3)))
typedef unsigned short bf16_t;
typedef short bf16x8 __attribute__((ext_vector_type(8)));
typedef short s16x4 __attribute__((ext_vector_type(4)));
typedef float f32x4 __attribute__((ext_vector_type(4)));
typedef float f32x16 __attribute__((ext_vector_type(16)));
typedef unsigned u32x4 __attribute__((ext_vector_type(4)));
typedef unsigned u32x2 __attribute__((ext_vector_type(2)));

constexpr int DM = 1024;
constexpr int NP = 16 * 2048;
constexpr int NS = 8 * 64;
constexpr int NT = NP + NS;
constexpr int DIN = 2560;
constexpr int SKV = 2112;
constexpr float EPS = 1e-6f;
constexpr float LOG2E = 1.4426950408889634f;
constexpr float QSCALE = 0.125f * LOG2E;

constexpr long OUT_Y = 0;
constexpr long OUT_KP = 34078720L, OUT_VP = 50855936L, OUT_CONVP = 67633152L, OUT_KS = 67878912L, OUT_VS = 68141056L, OUT_CONVS = 68403200L, OUT_TOTAL = 68526080L;

constexpr size_t MiB = 1u << 20;
constexpr size_t WS_CTL = 0, CTL_BYTES = 1 * MiB;
constexpr size_t WS_WINT = 1 * MiB;
constexpr size_t WS_WOUTT = 6 * MiB;
constexpr size_t WS_WQT = 8 * MiB;
constexpr size_t WS_SK = 12 * MiB;
constexpr size_t WS_PU8 = 16 * MiB;
constexpr size_t WS_PV8 = 32 * MiB;
constexpr size_t WS_SCU = 48 * MiB;
constexpr size_t WS_SCV = 49 * MiB;
constexpr size_t WS_KS = 80 * MiB;
constexpr size_t WS_VS = 97 * MiB;
constexpr size_t WS_H = 114 * MiB;
constexpr size_t WS_A = 179 * MiB;
constexpr size_t WS_Q = 212 * MiB;
constexpr size_t WS_QP = 114 * MiB;
constexpr size_t WS_KP = 245 * MiB;
constexpr size_t WS_VP = 277 * MiB;
constexpr size_t WS_MIX = 309 * MiB;
constexpr size_t WS_H2 = 309 * MiB;
constexpr size_t WS_TK = 375 * MiB;
constexpr size_t WS_IDX = 408 * MiB;
constexpr size_t WS_GATE = 425 * MiB;
constexpr size_t WS_PACT = 114 * MiB;
constexpr size_t WS_COEF = 375 * MiB;
constexpr size_t WS_END = 442 * MiB;
static_assert(WS_H + (size_t)NT * 1024 * 2 <= WS_A && WS_A + (size_t)NT * 512 * 2 <= WS_Q && WS_Q + (size_t)NT * 512 * 2 <= WS_KP, "R1");
static_assert(WS_QP + (size_t)NT * 2048 * 2 <= WS_KP && WS_KP + (size_t)NP * 512 * 2 <= WS_VP && WS_VP + (size_t)NP * 512 * 2 <= WS_MIX, "ws map");
static_assert(WS_MIX + (size_t)NT * 1024 * 2 <= WS_TK && WS_TK + (size_t)NT * 256 * 4 <= WS_IDX && WS_IDX + (size_t)NT * 128 * 4 <= WS_GATE && WS_GATE + (size_t)NT * 128 * 4 <= WS_END, "ws map 2");
static_assert(WS_KS + (size_t)8 * SKV * 512 * 2 <= WS_VS && WS_VS + (size_t)8 * SKV * 512 * 2 <= WS_H, "ws map 3");

constexpr int RING_BYTES = 131072;
constexpr int BIAS_OFF = RING_BYTES;
constexpr int MISC_OFF = RING_BYTES + 5120;
constexpr int LDS_BYTES = MISC_OFF + 1024;

struct Params {
    const float* in[24];
    float* out;
    unsigned char* ws;
};

__device__ __forceinline__ unsigned cvtpk(float lo, float hi) { return pg8::cvt_pk_bf16(lo, hi); }
__device__ __forceinline__ float bflo(unsigned w) { return __uint_as_float(w << 16); }
__device__ __forceinline__ float bfhi(unsigned w) { return __uint_as_float(w & 0xffff0000u); }
__device__ __forceinline__ float wave_sum(float v) {
#pragma unroll
    for (int o = 1; o < 64; o <<= 1) v += __shfl_xor(v, o);
    return v;
}
typedef float f32x2 __attribute__((ext_vector_type(2)));
#define DPP_ADD(v, ctrl) v += __builtin_bit_cast(float, __builtin_amdgcn_update_dpp(0, __builtin_bit_cast(int, v), ctrl, 0xf, 0xf, true))
__device__ __forceinline__ float rl_f(float v, int l) { return __uint_as_float(__builtin_amdgcn_readlane(__float_as_uint(v), l)); }
__device__ __forceinline__ float wave_total(float v) {
    DPP_ADD(v, 0xB1); DPP_ADD(v, 0x4E); DPP_ADD(v, 0x141); DPP_ADD(v, 0x140);
    return (rl_f(v, 0) + rl_f(v, 16)) + (rl_f(v, 32) + rl_f(v, 48));
}
typedef __bf16 bf16x2_t __attribute__((ext_vector_type(2)));
__device__ __forceinline__ float dot2(unsigned a, unsigned b, float acc) {
    return __builtin_amdgcn_fdot2_f32_bf16(__builtin_bit_cast(bf16x2_t, a), __builtin_bit_cast(bf16x2_t, b), acc, false);
}
#define LDS_WAIT() asm volatile("s_waitcnt lgkmcnt(0)" ::: "memory")

#define XB_TMO      128
#define XB_XCNT(j)  (256  + 64 * (j))
#define XB_XSUB(j)  (1280 + 64 * (j))
#define XB_XGEN(j)  (2304 + 64 * (j))
#define XB_TOP      3328
#define XB_TOPGEN   3392
#define XCD_BAR_WORDS 3456
#define XB_SPIN_CAP (1u << 18)

__device__ __forceinline__ unsigned xb_ld(unsigned* p)              { return __hip_atomic_load(p, __ATOMIC_RELAXED, __HIP_MEMORY_SCOPE_AGENT); }
__device__ __forceinline__ unsigned xb_add(unsigned* p, unsigned v) { return __hip_atomic_fetch_add(p, v, __ATOMIC_RELAXED, __HIP_MEMORY_SCOPE_AGENT); }
__device__ __forceinline__ unsigned xb_xcc_id() { return (unsigned)__builtin_amdgcn_s_getreg((3 << 11) | 20) & 0xFu; }
#define XB_SPIN(cond, bar) do { unsigned _sp = 0; while (cond) { __builtin_amdgcn_s_sleep(1); \
    if ((++_sp & 255u) == 0u) { if (xb_ld(&(bar)[XB_TMO])) break; if (_sp > XB_SPIN_CAP) { atomicAdd(&(bar)[XB_TMO], 1u); break; } } } } while (0)

struct XcdBarrier {
    unsigned* bar; unsigned x;
    volatile LAS unsigned* st;
};

__device__ __forceinline__ XcdBarrier xcd_barrier_post(unsigned* bar, volatile LAS unsigned* st) {
    XcdBarrier b; b.bar = bar; b.x = xb_xcc_id(); b.st = st;
    if (threadIdx.x == 0) (void)xb_add(&bar[XB_XCNT(b.x)], 1u);
    return b;
}
__device__ __forceinline__ void xcd_barrier_complete(unsigned* bar, unsigned x, unsigned& nloc, unsigned& nx) {
    const unsigned G = gridDim.x * gridDim.y * gridDim.z;
    unsigned sum, cnt, mine, sp = 0u;
    for (;;) {
        sum = 0u; cnt = 0u; mine = 0u;
#pragma unroll
        for (unsigned j = 0; j < 16; ++j) { const unsigned c = xb_ld(&bar[XB_XCNT(j)]); sum += c; cnt += (c > 0u) ? 1u : 0u; mine = (j == x) ? c : mine; }
        if (sum == G) break;
        __builtin_amdgcn_s_sleep(1);
        if ((++sp & 255u) == 0u) { if (xb_ld(&bar[XB_TMO])) break; if (sp > XB_SPIN_CAP) { atomicAdd(&bar[XB_TMO], 1u); break; } }
    }
    nloc = mine > 0u ? mine : 1u; nx = cnt > 0u ? cnt : 1u;
}

__device__ __forceinline__ void xcd_barrier(const XcdBarrier& b) {
    asm volatile("s_waitcnt vmcnt(0)" ::: "memory");
    __syncthreads();
    if (threadIdx.x == 0) {
        unsigned* bar = b.bar;
        __builtin_amdgcn_s_waitcnt(0);
        unsigned nloc = b.st[0], nx = b.st[1];
        if (nloc == 0u) { xcd_barrier_complete(bar, b.x, nloc, nx); b.st[0] = nloc; b.st[1] = nx; }
        const unsigned old = xb_add(&bar[XB_XSUB(b.x)], 1u);
        const unsigned gen = old / nloc;
        if (old + 1u == (gen + 1u) * nloc) {
            __builtin_amdgcn_fence(__ATOMIC_RELEASE, "agent");
            asm volatile("s_waitcnt vmcnt(0)" ::: "memory");
            const unsigned og = xb_add(&bar[XB_TOP], 1u);
            const unsigned tg = og / nx;
            if (og + 1u == (tg + 1u) * nx) xb_add(&bar[XB_TOPGEN], 1u);
            else XB_SPIN(xb_ld(&bar[XB_TOPGEN]) == tg, bar);
            __builtin_amdgcn_fence(__ATOMIC_ACQUIRE, "agent");
            xb_add(&bar[XB_XGEN(b.x)], 1u);
            asm volatile("s_waitcnt vmcnt(0)" ::: "memory");
        } else {
            XB_SPIN(xb_ld(&bar[XB_XGEN(b.x)]) == gen, bar);
            __builtin_amdgcn_fence(__ATOMIC_ACQUIRE, "agent");
            asm volatile("s_waitcnt vmcnt(0)" ::: "memory");
        }
    }
    __syncthreads();
}


namespace pg8 {
__device__ __forceinline__ u32x2 pack4(f32x4 v) { u32x2 w; w.x = cvt_pk_bf16(v[0], v[1]); w.y = cvt_pk_bf16(v[2], v[3]); return w; }
struct EpiProj {
    static constexpr bool PERM = false, AFTER_DRAIN = false;
    bf16_t* A; bf16_t* Q; bf16_t* KP; bf16_t* VP; bf16_t* KS; bf16_t* VS; float* out;
    __device__ __forceinline__ void operator()(const f32x4 (&acc)[2][2][4][2], const Unit& u, int wr, int wc, int fr, int fq) const {
        const int pn = u.pn;
        const int row0 = u.pm * BM + wr * 64 + fr;
        if (pn < 4) {
#pragma unroll
            for (int ai = 0; ai < 2; ++ai)
#pragma unroll
                for (int m = 0; m < 4; ++m) {
                    const int row = row0 + ai * HALF + m * 16;
                    long toff = -1;
                    if (row < NP) { const int s = row & 2047; if (s >= 2018) toff = OUT_CONVP + ((long)(row >> 11) * 30 + (s - 2018)) * 512; }
                    else { const int rr = row - NP; const int i = rr & 63; if (i >= 34) toff = OUT_CONVS + ((long)(rr >> 6) * 30 + (i - 34)) * 512; }
#pragma unroll
                    for (int n = 0; n < 2; ++n) {
                        const int c = 128 * pn + 32 * wc + 16 * n + 4 * fq;
                        const f32x4 x = acc[ai][0][m][n], g = acc[ai][1][m][n];
                        f32x4 a;
#pragma unroll
                        for (int j = 0; j < 4; ++j) a[j] = x[j] / (1.f + __expf(-g[j]));
                        *(u32x2*)(A + (size_t)row * 512 + c) = pack4(a);
                        if (toff >= 0) *(f32x4*)(out + toff + c) = a;
                    }
                }
        } else {
            const int sec = (pn - 4) >> 1, colbase = ((pn - 4) & 1) * 256;
#pragma unroll
            for (int ai = 0; ai < 2; ++ai)
#pragma unroll
                for (int m = 0; m < 4; ++m) {
                    const int row = row0 + ai * HALF + m * 16;
                    const bool isp = row < NP; const int rr = row - NP;
                    bf16_t* bdst; float* fdst;
                    if (sec == 0) { bdst = Q + (size_t)row * 512; fdst = nullptr; }
                    else if (sec == 1) { bdst = isp ? KP + (size_t)row * 512 : KS + ((size_t)(rr >> 6) * SKV + 2048 + (rr & 63)) * 512; fdst = isp ? out + OUT_KP + (size_t)row * 512 : out + OUT_KS + (size_t)rr * 512; }
                    else { bdst = isp ? VP + (size_t)row * 512 : VS + ((size_t)(rr >> 6) * SKV + 2048 + (rr & 63)) * 512; fdst = isp ? out + OUT_VP + (size_t)row * 512 : out + OUT_VS + (size_t)rr * 512; }
#pragma unroll
                    for (int bj = 0; bj < 2; ++bj)
#pragma unroll
                        for (int n = 0; n < 2; ++n) {
                            const int col = colbase + 128 * bj + 32 * wc + 16 * n + 4 * fq;
                            const f32x4 v = acc[ai][bj][m][n];
                            if (sec == 0) { *(u32x2*)(bdst + col) = pack4(v * QSCALE); }
                            else { *(u32x2*)(bdst + col) = pack4(v); *(f32x4*)(fdst + col) = v; }
                        }
                }
        }
    }
};
struct EpiRes {
    static constexpr bool PERM = false, AFTER_DRAIN = false;
    const float* xp; const float* xs; float* out;
    __device__ __forceinline__ void operator()(const f32x4 (&acc)[2][2][4][2], const Unit& u, int wr, int wc, int fr, int fq) const {
        const int row0 = u.pm * BM + wr * 64 + fr;
#pragma unroll
        for (int ai = 0; ai < 2; ++ai)
#pragma unroll
            for (int m = 0; m < 4; ++m) {
                const int row = row0 + ai * HALF + m * 16;
                const float* xr = row < NP ? xp + (size_t)row * DM : xs + (size_t)(row - NP) * DM;
                float* orow = out + (size_t)row * DM;
#pragma unroll
                for (int bj = 0; bj < 2; ++bj)
#pragma unroll
                    for (int n = 0; n < 2; ++n) {
                        const int col = u.pn * BM + 128 * bj + 32 * wc + 16 * n + 4 * fq;
                        *(f32x4*)(orow + col) = *(const f32x4*)(xr + col) + acc[ai][bj][m][n];
                    }
            }
    }
};
}

__device__ __forceinline__ int winrow(int n) { return n < 1024 ? (256 * ((n & 511) >> 7) + 128 * (n >> 9) + (n & 127)) : n; }
template <bool WIN> __device__ __forceinline__ void transpose_item(const float* W, int K, int N, bf16_t* WT, LAS float* scr, int item, int lane) {
    const int nblk = N / 32, kb = item / nblk, nb = item % nblk, k0 = 64 * kb, n0 = 32 * nb;
#pragma unroll 8
    for (int i = 0; i < 32; ++i) { const int kk = 2 * i + (lane >> 5); scr[kk * 33 + (lane & 31)] = W[(size_t)(k0 + kk) * N + n0 + (lane & 31)]; }
    LDS_WAIT();
    const int c = lane & 7;
#pragma unroll
    for (int j = 0; j < 4; ++j) {
        const int n = (lane >> 3) + 8 * j; const LAS float* s = scr + (8 * c) * 33 + n;
        u32x4 o; o.x = cvtpk(s[0 * 33], s[1 * 33]); o.y = cvtpk(s[2 * 33], s[3 * 33]); o.z = cvtpk(s[4 * 33], s[5 * 33]); o.w = cvtpk(s[6 * 33], s[7 * 33]);
        const int dr = WIN ? winrow(n0 + n) : (n0 + n);
        *(u32x4*)(WT + (size_t)dr * K + k0 + 8 * c) = o;
    }
    LDS_WAIT();
}
__device__ __forceinline__ void cvt_stream(const float* src, bf16_t* dst, size_t n8, size_t gt, size_t ngt) {
    for (size_t i = gt; i < n8; i += ngt) {
        const f32x4 a = *(const f32x4*)(src + i * 8), b = *(const f32x4*)(src + i * 8 + 4);
        u32x4 o; o.x = cvtpk(a[0], a[1]); o.y = cvtpk(a[2], a[3]); o.z = cvtpk(b[0], b[1]); o.w = cvtpk(b[2], b[3]);
        *(u32x4*)(dst + i * 8) = o;
    }
}
__device__ __forceinline__ void cvt_cache(const float* src, bf16_t* dst, size_t gt, size_t ngt) {
    const size_t n8 = (size_t)8 * 2048 * 512 / 8;
    for (size_t i = gt; i < n8; i += ngt) {
        const size_t e = i * 8; const size_t row = e >> 9, col = e & 511; const size_t drow = (row >> 11) * SKV + (row & 2047);
        const f32x4 a = *(const f32x4*)(src + e), b = *(const f32x4*)(src + e + 4);
        u32x4 o; o.x = cvtpk(a[0], a[1]); o.y = cvtpk(a[2], a[3]); o.z = cvtpk(b[0], b[1]); o.w = cvtpk(b[2], b[3]);
        *(u32x4*)(dst + drow * 512 + col) = o;
    }
}
__device__ __forceinline__ void rms_row_bf16(const float* xrow, const float* g, bf16_t* orow, int lane) {
    const f32x4* xr = (const f32x4*)xrow + lane; const f32x4* gr = (const f32x4*)g + lane;
    f32x4 v[4]; float s = 0.f;
#pragma unroll
    for (int j = 0; j < 4; ++j) { v[j] = xr[64 * j]; s += (v[j][0] * v[j][0] + v[j][1] * v[j][1]) + (v[j][2] * v[j][2] + v[j][3] * v[j][3]); }
    const float rstd = 1.f / sqrtf(wave_sum(s) * (1.f / DM) + EPS);
    u32x2* o8 = (u32x2*)orow + lane;
#pragma unroll
    for (int j = 0; j < 4; ++j) { const f32x4 gg = gr[64 * j]; u32x2 w; w.x = cvtpk(v[j][0] * rstd * gg[0], v[j][1] * rstd * gg[1]); w.y = cvtpk(v[j][2] * rstd * gg[2], v[j][3] * rstd * gg[3]); o8[64 * j] = w; }
}

template <bool SLICED> __device__ __forceinline__ void cvt_row_fp8(const float* src, unsigned char* dst_base, int row, float* scale_out, int lane) {
    const f32x4* xr = (const f32x4*)src + lane;
    f32x4 v[4]; float am = 0.f;
#pragma unroll
    for (int j = 0; j < 4; ++j) { v[j] = xr[64 * j]; am = fmaxf(am, fmaxf(fmaxf(fabsf(v[j][0]), fabsf(v[j][1])), fmaxf(fabsf(v[j][2]), fabsf(v[j][3])))); }
#pragma unroll
    for (int o = 1; o < 64; o <<= 1) am = fmaxf(am, __shfl_xor(am, o));
    const float sc = am > 0.f ? am * (1.f / 448.f) : 1.f, inv = 1.f / sc;
#pragma unroll
    for (int j = 0; j < 4; ++j) {
        const int eb = 256 * j + 4 * lane;
        int w = __builtin_amdgcn_cvt_pk_fp8_f32(v[j][0] * inv, v[j][1] * inv, 0, false);
        w = __builtin_amdgcn_cvt_pk_fp8_f32(v[j][2] * inv, v[j][3] * inv, w, true);
        if (SLICED) *(int*)(dst_base + ((size_t)(eb >> 7) * 16384 + row) * 128 + (eb & 127)) = w;
        else *(int*)(dst_base + (size_t)row * DM + 16 * ((eb & 511) >> 3) + (eb & 7) + (eb >= 512 ? 8 : 0)) = w;
    }
    if (lane == 0) *scale_out = sc;
}

__device__ __forceinline__ void phase0(const Params& p, LAS unsigned char* lds, int tid, int lane, int wave) {
    const int gw = blockIdx.x * 8 + wave, NGW = gridDim.x * 8;
    LAS float* scr = (LAS float*)(lds + wave * 16384);
    bf16_t* WINT = (bf16_t*)(p.ws + WS_WINT); bf16_t* WOUTT = (bf16_t*)(p.ws + WS_WOUTT); bf16_t* WQT = (bf16_t*)(p.ws + WS_WQT);
    constexpr int I_IN = 16 * (DIN / 32), I_OUT = 16 * (1024 / 32), I_Q = 16 * (2048 / 32);
    for (int it = gw; it < I_IN + I_OUT + I_Q; it += NGW) {
        int r = it;
        if (r < I_IN) { transpose_item<true>(p.in[6], 1024, DIN, WINT, scr, r, lane); continue; } r -= I_IN;
        if (r < I_OUT) { transpose_item<false>(p.in[17], 1024, 1024, WOUTT, scr, r, lane); continue; } r -= I_OUT;
        transpose_item<false>(p.in[19], 1024, 2048, WQT, scr, r, lane);
    }
    const size_t gt = (size_t)blockIdx.x * 512 + tid, ngt = (size_t)gridDim.x * 512;
    for (int r = gw; r < 2 * 16384; r += NGW) {
        const int tb = r >> 14, e = r & 16383;
        if (tb) cvt_row_fp8<true>(p.in[22] + (size_t)e * DM, p.ws + WS_PV8, e, (float*)(p.ws + WS_SCV) + e, lane);
        else cvt_row_fp8<true>(p.in[21] + (size_t)e * DM, p.ws + WS_PU8, e, (float*)(p.ws + WS_SCU) + e, lane);
    }
    cvt_stream(p.in[20], (bf16_t*)(p.ws + WS_SK), (size_t)16 * 128 * 128 / 8, gt, ngt);
    cvt_cache(p.in[2], (bf16_t*)(p.ws + WS_KS), gt, ngt);
    cvt_cache(p.in[3], (bf16_t*)(p.ws + WS_VS), gt, ngt);
    bf16_t* H = (bf16_t*)(p.ws + WS_H);
    for (int m = gw; m < NT; m += NGW) {
        const float* xr = m < NP ? p.in[0] + (size_t)m * DM : p.in[1] + (size_t)(m - NP) * DM;
        rms_row_bf16(xr, p.in[5], H + (size_t)m * DM, lane);
    }
}

namespace att {
constexpr int KPITCH = 272, VPITCH = 320;
constexpr int L_KV = 0, KV_BYTES = 64 * KPITCH + 64 * VPITCH  , L_X = 0  , L_BIAS = BIAS_OFF, L_CA = 0  , L_CW = 94 * 1024  ;
static_assert(4 * 4096 * 4 <= 2 * KV_BYTES && 2 * KV_BYTES <= L_CW && L_CW + 31 * 1024 <= RING_BYTES, "attention LDS map");

__device__ __forceinline__ int rel_bucket(int rel) {
    const int ret = rel > 0 ? 16 : 0; const int n = rel < 0 ? -rel : rel; int v;
    if (n < 8) v = n; else if (n < 12) v = 8; else if (n < 16) v = 9; else if (n < 23) v = 10; else if (n < 32) v = 11;
    else if (n < 46) v = 12; else if (n < 64) v = 13; else if (n < 91) v = 14; else v = 15;
    return ret + v;
}
typedef short v4i16_t __attribute__((ext_vector_type(4)));
__device__ __forceinline__ s16x4 vtr(const LAS unsigned char* p) { return __builtin_bit_cast(s16x4, __builtin_amdgcn_ds_read_tr16_b64_v4i16((LAS v4i16_t*)p)); }
__device__ __forceinline__ f32x16 mfma32(bf16x8 a, bf16x8 b, f32x16 c) { return __builtin_amdgcn_mfma_f32_32x32x16_bf16(a, b, c, 0, 0, 0); }

__device__ __forceinline__ void attn_unit(const Params& p, LAS unsigned char* lds, int kind, int bb, int h, int qblk, float lam, int tid, int lane, int wid) {
    const bf16_t* Q = (const bf16_t*)(p.ws + WS_Q);
    const bf16_t* Kb = kind == 0 ? (const bf16_t*)(p.ws + WS_KP) + (size_t)bb * 2048 * 512 + h * 128 : (const bf16_t*)(p.ws + WS_KS) + (size_t)bb * SKV * 512 + h * 128;
    const bf16_t* Vb = kind == 0 ? (const bf16_t*)(p.ws + WS_VP) + (size_t)bb * 2048 * 512 + h * 128 : (const bf16_t*)(p.ws + WS_VS) + (size_t)bb * SKV * 512 + h * 128;
    bf16_t* MIX = (bf16_t*)(p.ws + WS_MIX);
    const int qrow0 = kind == 0 ? bb * 2048 + qblk * 128 : NP + bb * 64;
    const int qpos0 = kind == 0 ? qblk * 128 : 2048;
    const int ntiles = kind == 0 ? 2 * qblk + 2 : 33;
    const int rg = wid & 3, map = wid >> 2, r32 = lane & 31, hi = lane >> 5;
    const bool active = kind == 0 ? true : (rg < 2);
    const int cw = kind == 0 ? 2 * qblk + (rg >> 1) : 32;
    const int qw0 = qpos0 + 32 * rg;
    const int qabs = qw0 + r32;

    bf16x8 qf[4];
    if (active) {
        const bf16_t* qp = Q + (size_t)(qrow0 + 32 * rg + r32) * 512 + h * 128 + map * 64 + 8 * hi;
#pragma unroll
        for (int s = 0; s < 4; ++s) qf[s] = *(const bf16x8*)(qp + 16 * s);
    } else {
#pragma unroll
        for (int s = 0; s < 4; ++s) qf[s] = (bf16x8){0, 0, 0, 0, 0, 0, 0, 0};
    }
    float m = -1e30f, l = 0.f;
    f32x16 o[4];
#pragma unroll
    for (int mt = 0; mt < 4; ++mt)
#pragma unroll
        for (int r = 0; r < 16; ++r) o[mt][r] = 0.f;

    const int srow0 = tid >> 4, sch = tid & 15;
    const LAS float* btab = (const LAS float*)(lds + L_BIAS) + h * 320;
    const float biasfar = btab[0];
    const int vlane = (4 * hi + ((lane & 15) >> 2)) * VPITCH + (16 * ((lane >> 4) & 1) + 4 * (lane & 3)) * 2;
    u32x4 kA[2], vA[2], kB[2], vB[2];
#define ATT_LOAD(KR, VR, T) do { _Pragma("unroll") for (int i_ = 0; i_ < 2; ++i_) { const size_t off_ = (size_t)((T) * 64 + srow0 + 32 * i_) * 512 + sch * 8; KR[i_] = *(const u32x4*)(Kb + off_); VR[i_] = *(const u32x4*)(Vb + off_); } } while (0)
#define ATT_STORE(KR, VR, BUF) do { _Pragma("unroll") for (int i_ = 0; i_ < 2; ++i_) { \
        *(LAS u32x4*)(lds + L_KV + (BUF) * KV_BYTES + (srow0 + 32 * i_) * KPITCH + sch * 16) = KR[i_]; \
        *(LAS u32x4*)(lds + L_KV + (BUF) * KV_BYTES + 64 * KPITCH + (srow0 + 32 * i_) * VPITCH + sch * 16) = VR[i_]; } } while (0)
    auto compute = [&](int t, int buf) {
        const LAS unsigned char* kbuf = lds + L_KV + buf * KV_BYTES;
        const LAS unsigned char* vbuf = kbuf + 64 * KPITCH;
        f32x16 p0, p1;
        const int kabs0 = t * 64;
        if (kabs0 + 63 - qw0 > -128) {
            const LAS float* bt = btab + (kabs0 - qabs + 256 + 4 * hi);
#pragma unroll
            for (int r = 0; r < 16; ++r) { p0[r] = bt[(r & 3) + 8 * (r >> 2)]; p1[r] = bt[32 + (r & 3) + 8 * (r >> 2)]; }
        } else {
#pragma unroll
            for (int r = 0; r < 16; ++r) { p0[r] = biasfar; p1[r] = biasfar; }
        }
        const LAS unsigned char* kb = kbuf + r32 * KPITCH + (map * 8 + hi) * 16;
#pragma unroll
        for (int s = 0; s < 4; ++s) {
            const bf16x8 a0 = *(const LAS bf16x8*)(kb + s * 32), a1 = *(const LAS bf16x8*)(kb + 32 * KPITCH + s * 32);
            p0 = mfma32(a0, qf[s], p0); p1 = mfma32(a1, qf[s], p1);
        }
        __builtin_amdgcn_sched_barrier(0);
        float mx = fmaxf(p0[0], p1[0]);
#pragma unroll
        for (int r = 1; r < 16; ++r) mx = fmaxf(mx, fmaxf(p0[r], p1[r]));
        mx = fmaxf(mx, __shfl_xor(mx, 32));
        const float mn = fmaxf(m, mx);
        const float alpha = __builtin_amdgcn_exp2f(m - mn);
        m = mn;
        float rs = 0.f;
#pragma unroll
        for (int r = 0; r < 16; ++r) { p0[r] = __builtin_amdgcn_exp2f(p0[r] - mn); p1[r] = __builtin_amdgcn_exp2f(p1[r] - mn); rs += p0[r] + p1[r]; }
        l = l * alpha + rs;
#pragma unroll
        for (int mt = 0; mt < 4; ++mt)
#pragma unroll
            for (int r = 0; r < 16; ++r) o[mt][r] *= alpha;
        __builtin_amdgcn_sched_barrier(0);
#pragma unroll
        for (int t2 = 0; t2 < 2; ++t2)
#pragma unroll
            for (int s = 0; s < 2; ++s) {
                u32x4 bw;
                if (t2 == 0) { bw.x = cvtpk(p0[8 * s + 0], p0[8 * s + 1]); bw.y = cvtpk(p0[8 * s + 2], p0[8 * s + 3]); bw.z = cvtpk(p0[8 * s + 4], p0[8 * s + 5]); bw.w = cvtpk(p0[8 * s + 6], p0[8 * s + 7]); }
                else { bw.x = cvtpk(p1[8 * s + 0], p1[8 * s + 1]); bw.y = cvtpk(p1[8 * s + 2], p1[8 * s + 3]); bw.z = cvtpk(p1[8 * s + 4], p1[8 * s + 5]); bw.w = cvtpk(p1[8 * s + 6], p1[8 * s + 7]); }
                const bf16x8 B = __builtin_bit_cast(bf16x8, bw);
                const LAS unsigned char* vb = vbuf + vlane + (32 * t2 + 16 * s) * VPITCH;
#pragma unroll
                for (int mt = 0; mt < 4; ++mt) {
                    const s16x4 lo = vtr(vb + mt * 64), hi8 = vtr(vb + mt * 64 + 8 * VPITCH);
                    const bf16x8 A = (bf16x8){lo[0], lo[1], lo[2], lo[3], hi8[0], hi8[1], hi8[2], hi8[3]};
                    o[mt] = mfma32(A, B, o[mt]);
                }
            }
    };
    ATT_LOAD(kA, vA, 0);
    if (ntiles > 1) ATT_LOAD(kB, vB, 1);
    ATT_STORE(kA, vA, 0);
    if (ntiles > 2) ATT_LOAD(kA, vA, 2);
    __syncthreads();
    for (int t = 0; t < ntiles; t += 2) {
        if (t + 1 < ntiles) { ATT_STORE(kB, vB, 1); if (t + 3 < ntiles) ATT_LOAD(kB, vB, t + 3); }
        if (active && t <= cw) compute(t, 0);
        __syncthreads();
        if (t + 1 >= ntiles) break;
        if (t + 2 < ntiles) { ATT_STORE(kA, vA, 0); if (t + 4 < ntiles) ATT_LOAD(kA, vA, t + 4); }
        if (active && t + 1 <= cw) compute(t + 1, 1);
        __syncthreads();
    }
#undef ATT_LOAD
#undef ATT_STORE
    l += __shfl_xor(l, 32);
    const float inv = 1.f / l;
    LAS float* X = (LAS float*)(lds + L_X) + rg * 4096;
    if (active && map == 1) {
        const float sc = -lam * inv;
#pragma unroll
        for (int mt = 0; mt < 4; ++mt)
#pragma unroll
            for (int r = 0; r < 16; ++r) X[(mt * 16 + r) * 64 + lane] = o[mt][r] * sc;
    }
    __syncthreads();
    if (active && map == 0) {
        float ss = 0.f;
#pragma unroll
        for (int mt = 0; mt < 4; ++mt)
#pragma unroll
            for (int r = 0; r < 16; ++r) { const float v = o[mt][r] * inv + X[(mt * 16 + r) * 64 + lane]; o[mt][r] = v; ss += v * v; }
        ss += __shfl_xor(ss, 32);
        const float rsn = 0.8f / sqrtf(ss * (1.f / 128.f) + EPS);
        bf16_t* orow = MIX + (size_t)(qrow0 + 32 * rg + r32) * 1024 + 512 + h * 128;
        const float* sg = p.in[15];
#pragma unroll
        for (int mt = 0; mt < 4; ++mt)
#pragma unroll
            for (int g4 = 0; g4 < 4; ++g4) {
                const int e = 32 * mt + 8 * g4 + 4 * hi;
                const f32x4 gg = *(const f32x4*)(sg + e);
                u32x2 w; w.x = cvtpk(o[mt][4 * g4 + 0] * rsn * gg[0], o[mt][4 * g4 + 1] * rsn * gg[1]); w.y = cvtpk(o[mt][4 * g4 + 2] * rsn * gg[2], o[mt][4 * g4 + 3] * rsn * gg[3]);
                *(u32x2*)(orow + e) = w;
            }
    }
    __syncthreads();
}

__device__ __forceinline__ void unpack8(const u32x4 w, float (&f)[8]) { f[0] = bflo(w.x); f[1] = bfhi(w.x); f[2] = bflo(w.y); f[3] = bfhi(w.y); f[4] = bflo(w.z); f[5] = bfhi(w.z); f[6] = bflo(w.w); f[7] = bfhi(w.w); }
__device__ __forceinline__ void conv_unit(const Params& p, LAS unsigned char* lds, int cu, int tid, int lane, int wid) {
    const bf16_t* A = (const bf16_t*)(p.ws + WS_A);
    bf16_t* MIX = (bf16_t*)(p.ws + WS_MIX);
    const float* cb = p.in[8]; const float* lg = p.in[9]; const float* lb = p.in[10]; const float* st = p.in[4];
    const int row0 = cu * 64;
    const bool isp = row0 < NP;
    const int s0 = isp ? (row0 & 2047) : 0, rbase = row0 - s0, bd = isp ? 0 : ((row0 - NP) >> 6);
    for (int c = tid; c < 94 * 64; c += 512) {
        const int rr = c >> 6, ch = c & 63, sp = s0 - 30 + rr;
        u32x4 v = (u32x4){0u, 0u, 0u, 0u};
        if (sp >= 0) v = *(const u32x4*)(A + (size_t)(rbase + sp) * 512 + ch * 8);
        else if (!isp) { const float* sr = st + ((size_t)bd * 30 + (30 + sp)) * 512 + ch * 8; const f32x4 a0 = *(const f32x4*)sr, a1 = *(const f32x4*)(sr + 4);
            v.x = cvtpk(a0[0], a0[1]); v.y = cvtpk(a0[2], a0[3]); v.z = cvtpk(a1[0], a1[1]); v.w = cvtpk(a1[2], a1[3]); }
        *(LAS u32x4*)(lds + L_CA + rr * 1024 + ch * 16) = v;
    }
    __syncthreads();
    const int c0 = lane * 8;
    float bias8[8], g8[8], b8[8];
    { const f32x4 x0 = *(const f32x4*)(cb + c0), x1 = *(const f32x4*)(cb + c0 + 4), y0 = *(const f32x4*)(lg + c0), y1 = *(const f32x4*)(lg + c0 + 4), z0 = *(const f32x4*)(lb + c0), z1 = *(const f32x4*)(lb + c0 + 4);
#pragma unroll
      for (int q = 0; q < 4; ++q) { bias8[q] = x0[q]; bias8[4 + q] = x1[q]; g8[q] = y0[q]; g8[4 + q] = y1[q]; b8[q] = z0[q]; b8[4 + q] = z1[q]; } }
    for (int grp = 0; grp < 2; ++grp) {
        const int t0 = wid * 8 + grp * 4;
        float acc[4][8];
#pragma unroll
        for (int q = 0; q < 4; ++q)
#pragma unroll
            for (int c = 0; c < 8; ++c) acc[q][c] = bias8[c];
        const LAS unsigned char* ap = lds + L_CA + t0 * 1024 + lane * 16;
        const LAS unsigned char* wp = lds + L_CW + lane * 16;
#pragma unroll 1
        for (int j = 0; j < 31; ++j) {
            float w[8]; unpack8(*(const LAS u32x4*)(wp + j * 1024), w);
#pragma unroll
            for (int q = 0; q < 4; ++q) {
                float a[8]; unpack8(*(const LAS u32x4*)(ap + (j + q) * 1024), a);
#pragma unroll
                for (int c = 0; c < 8; ++c) acc[q][c] += w[c] * a[c];
            }
        }
#pragma unroll
        for (int q = 0; q < 4; ++q) {
            float sm = 0.f;
#pragma unroll
            for (int c = 0; c < 8; ++c) sm += acc[q][c];
            const float mu = wave_total(sm) * (1.f / 512.f);
            float sv = 0.f;
#pragma unroll
            for (int c = 0; c < 8; ++c) { acc[q][c] -= mu; sv += acc[q][c] * acc[q][c]; }
            const float rstd = 1.f / sqrtf(wave_total(sv) * (1.f / 512.f) + EPS);
            float y[8];
#pragma unroll
            for (int c = 0; c < 8; ++c) { y[c] = acc[q][c] * rstd * g8[c] + b8[c]; y[c] = y[c] / (1.f + __expf(-y[c])); }
            u32x4 w; w.x = cvtpk(y[0], y[1]); w.y = cvtpk(y[2], y[3]); w.z = cvtpk(y[4], y[5]); w.w = cvtpk(y[6], y[7]);
            *(u32x4*)(MIX + (size_t)(row0 + t0 + q) * 1024 + c0) = w;
        }
    }
}

constexpr int N_SAMPLE_UNITS = 32, N_PROMPT_UNITS = 1024, N_CONV_UNITS = NT / 64, N_UNITS = N_SAMPLE_UNITS + N_PROMPT_UNITS + N_CONV_UNITS;

__device__ __forceinline__ void phase2(const Params& p, LAS unsigned char* lds, int tid, int lane, int wid, int cidx, int mode) {
    LAS float* bt = (LAS float*)(lds + L_BIAS);
    for (int e = tid; e < 4 * 320; e += 512) { const int hh = e / 320, rel = (e % 320) - 256; bt[e] = p.in[16][rel_bucket(rel) * 4 + hh] * LOG2E; }
    for (int c = tid; c < 31 * 64; c += 512) {
        const float* wr = p.in[7] + (size_t)c * 8; const f32x4 a0 = *(const f32x4*)wr, a1 = *(const f32x4*)(wr + 4);
        u32x4 v; v.x = cvtpk(a0[0], a0[1]); v.y = cvtpk(a0[2], a0[3]); v.z = cvtpk(a1[0], a1[1]); v.w = cvtpk(a1[2], a1[3]);
        *(LAS u32x4*)(lds + L_CW + c * 16) = v;
    }
    const float d1 = wave_sum(p.in[11][lane] * p.in[12][lane]), d2 = wave_sum(p.in[13][lane] * p.in[14][lane]);
    const float lam = expf(d1) - expf(d2) + 0.2f;
    unsigned* ctr = (unsigned*)(p.ws + WS_CTL) + 64 * cidx;
    volatile LAS unsigned* sw = (volatile LAS unsigned*)(lds + MISC_OFF);
    __syncthreads();
    for (;;) {
        __syncthreads();
        if (tid == 0) sw[0] = atomicAdd(ctr, 1u);
        __syncthreads();
        const int u = (int)sw[0];
        if (u >= N_UNITS) break;
        if (mode == 1 && u >= N_SAMPLE_UNITS + N_PROMPT_UNITS) continue;
        if (mode == 2 && u < N_SAMPLE_UNITS + N_PROMPT_UNITS) continue;
        int tid_ = tid; asm volatile("" : "+v"(tid_));
        if (u < N_SAMPLE_UNITS + N_PROMPT_UNITS) {
            const int v = u - N_SAMPLE_UNITS; const int bh = v & 63; const bool smp = u < N_SAMPLE_UNITS;
            attn_unit(p, lds, smp ? 1 : 0, smp ? (u >> 2) : (bh >> 2), smp ? (u & 3) : (bh & 3), smp ? 0 : 15 - (v >> 6), lam, tid_, tid_ & 63, wid);
        } else conv_unit(p, lds, u - N_SAMPLE_UNITS - N_PROMPT_UNITS, tid_, tid_ & 63, wid);
    }
}
}

__device__ __forceinline__ void phase3b(const Params& p, int lane, int wave) {
    const int gw = blockIdx.x * 8 + wave, NGW = gridDim.x * 8;
    bf16_t* H2 = (bf16_t*)(p.ws + WS_H2);
    for (int m = gw; m < NT; m += NGW) rms_row_bf16(p.out + (size_t)m * DM, p.in[18], H2 + (size_t)m * DM, lane);
}

__device__ __forceinline__ void phase4b(const Params& p, int lane, int wave) {
    const int gw = blockIdx.x * 8 + wave, NGW = gridDim.x * 8;
    const bf16_t* QP = (const bf16_t*)(p.ws + WS_QP); const bf16_t* SK = (const bf16_t*)(p.ws + WS_SK);
    float* TK = (float*)(p.ws + WS_TK);
    const int r32 = lane & 31, hi = lane >> 5;
    const float NEG_INF = -__builtin_huge_valf();
    for (int wu = gw; wu < (NT / 32) * 16; wu += NGW) {
        const int rp = wu & 15, t0 = (wu >> 4) * 32;
        bf16x8 qf[8];
        const bf16_t* qp = QP + (size_t)(t0 + r32) * 2048 + rp * 128 + 8 * hi;
#pragma unroll
        for (int s = 0; s < 8; ++s) qf[s] = *(const bf16x8*)(qp + 16 * s);
        float v[64];
#pragma unroll
        for (int mt = 0; mt < 4; ++mt) {
            f32x16 S;
#pragma unroll
            for (int r = 0; r < 16; ++r) S[r] = 0.f;
            const bf16_t* kp = SK + ((size_t)rp * 128 + 32 * mt + r32) * 128 + 8 * hi;
#pragma unroll
            for (int s = 0; s < 8; ++s) S = att::mfma32(*(const bf16x8*)(kp + 16 * s), qf[s], S);
#pragma unroll
            for (int r = 0; r < 16; ++r) { const int n = 32 * mt + (r & 3) + 8 * (r >> 2) + 4 * hi; v[mt * 16 + r] = __uint_as_float((__float_as_uint(S[r]) & ~127u) | (unsigned)(127 - n)); }
        }
        float* dst = TK + ((size_t)(t0 + r32) * 16 + rp) * 16;
        for (int it = 0; it < 16; ++it) {
            float mx = v[0];
#pragma unroll
            for (int i = 1; i < 64; ++i) mx = fmaxf(mx, v[i]);
            mx = fmaxf(mx, __shfl_xor(mx, 32));
            if (hi == 0) dst[it] = mx;
#pragma unroll
            for (int i = 0; i < 64; ++i) v[i] = (v[i] == mx) ? NEG_INF : v[i];
        }
    }
}

__device__ __forceinline__ void phase5a(const Params& p, int tid) {
    const float* TK = (const float*)(p.ws + WS_TK);
    int* IDX = (int*)(p.ws + WS_IDX); float* GATE = (float*)(p.ws + WS_GATE);
    const float NEG_INF = -__builtin_huge_valf();
    for (int item = blockIdx.x * 512 + tid; item < NT * 8; item += gridDim.x * 512) {
        const int tok = item >> 3, r = item & 7;
        const f32x4* pa = (const f32x4*)(TK + ((size_t)tok * 16 + 2 * r) * 16);
        float a[16], b[16]; int ia[16], ib[16];
#pragma unroll
        for (int q = 0; q < 4; ++q) { const f32x4 x = pa[q], y = pa[4 + q];
#pragma unroll
            for (int j = 0; j < 4; ++j) { a[4 * q + j] = x[j]; b[4 * q + j] = y[j]; } }
#pragma unroll
        for (int i = 0; i < 16; ++i) { const unsigned ua = __float_as_uint(a[i]), ub = __float_as_uint(b[i]); ia[i] = 127 - (int)(ua & 127u); ib[i] = 127 - (int)(ub & 127u); a[i] = __uint_as_float(ua & ~127u); b[i] = __uint_as_float(ub & ~127u); }
        float cv[50]; int cid[50];
        {
            int c = 0;
#pragma unroll
            for (int i = 0; i < 16; ++i)
#pragma unroll
                for (int j = 0; j < 16; ++j)
                    if ((i + 1) * (j + 1) <= 16) { const float s = a[i] + b[j]; cv[c] = __uint_as_float((__float_as_uint(s) & ~63u) | (unsigned)(63 - c)); cid[c] = ia[i] * 128 + ib[j]; ++c; }
        }
        float best[16]; int bid[16];
#pragma unroll
        for (int it = 0; it < 16; ++it) {
            float mx = cv[0];
#pragma unroll
            for (int c = 1; c < 50; ++c) mx = fmaxf(mx, cv[c]);
            int id = 0;
#pragma unroll
            for (int c = 0; c < 50; ++c) { const bool hit = cv[c] == mx; id = hit ? cid[c] : id; cv[c] = hit ? NEG_INF : cv[c]; }
            best[it] = __uint_as_float(__float_as_uint(mx) & ~63u); bid[it] = id;
        }
        float e[16], sum = 0.f;
#pragma unroll
        for (int k = 0; k < 16; ++k) { e[k] = __expf(best[k] - best[0]); sum += e[k]; }
        const float rinv = 1.f / sum;
        int* io = IDX + (size_t)tok * 128 + r * 16; float* go = GATE + (size_t)tok * 128 + r * 16;
#pragma unroll
        for (int k = 0; k < 16; ++k) { io[k] = bid[k]; go[k] = e[k] * rinv; }
    }
}

__device__ __forceinline__ float gelu_erf(float x) { return 0.5f * x * (1.f + erff(x * 0.70710678118654752f)); }
__device__ __forceinline__ void fp8x16_to_f32(const u32x4 q, float (&f)[16]) {
    const f32x2 c0 = __builtin_amdgcn_cvt_pk_f32_fp8(q.x, false), c1 = __builtin_amdgcn_cvt_pk_f32_fp8(q.x, true), c2 = __builtin_amdgcn_cvt_pk_f32_fp8(q.y, false), c3 = __builtin_amdgcn_cvt_pk_f32_fp8(q.y, true);
    const f32x2 c4 = __builtin_amdgcn_cvt_pk_f32_fp8(q.z, false), c5 = __builtin_amdgcn_cvt_pk_f32_fp8(q.z, true), c6 = __builtin_amdgcn_cvt_pk_f32_fp8(q.w, false), c7 = __builtin_amdgcn_cvt_pk_f32_fp8(q.w, true);
    f[0] = c0.x; f[1] = c0.y; f[2] = c1.x; f[3] = c1.y; f[4] = c2.x; f[5] = c2.y; f[6] = c3.x; f[7] = c3.y;
    f[8] = c4.x; f[9] = c4.y; f[10] = c5.x; f[11] = c5.y; f[12] = c6.x; f[13] = c6.y; f[14] = c7.x; f[15] = c7.y;
}
__device__ __forceinline__ void slice_group(int& x, int& gwx, int& nwx, int wave) {
    x = blockIdx.x & 7; const int nbx = ((int)gridDim.x - x + 7) >> 3; gwx = ((int)blockIdx.x >> 3) * 8 + wave; nwx = nbx * 8;
}
__device__ __forceinline__ void phase5u(const Params& p, LAS unsigned char* lds, int lane, int wave) {
    int x, gwx, nwx; slice_group(x, gwx, nwx, wave);
    const unsigned char* PU8 = p.ws + WS_PU8 + (size_t)x * 16384 * 128;
    const bf16_t* H2 = (const bf16_t*)(p.ws + WS_H2) + 128 * x;
    const int* IDX = (const int*)(p.ws + WS_IDX); float* PACT = (float*)(p.ws + WS_PACT) + (size_t)x * NT * 128;
    LAS int* l_idx = (LAS int*)(lds + wave * 512);
    const int g = lane >> 3, sub = lane & 7;
    const unsigned char* rowp = PU8 + sub * 16;
    int r_idxA = 0, r_idxB = 0;
    u32x4 hA0, hA1, hB0, hB1; hA0 = hA1 = hB0 = hB1 = (u32x4){0u, 0u, 0u, 0u};
    u32x4 qA[16], qB[16];
#define P5U_LOADIDX(T) do { if ((T) < NT) { r_idxA = IDX[(size_t)(T) * 128 + lane]; r_idxB = IDX[(size_t)(T) * 128 + 64 + lane]; } } while (0)
#define P5U_ISSUE(Q, H0, H1, T) do { if ((T) < NT) { l_idx[lane] = r_idxA; l_idx[64 + lane] = r_idxB; \
        H0 = *(const u32x4*)(H2 + (size_t)(T) * DM + 16 * sub); H1 = *(const u32x4*)(H2 + (size_t)(T) * DM + 16 * sub + 8); \
        _Pragma("unroll") for (int q_ = 0; q_ < 4; ++q_) { const u32x4 iv = *(const LAS u32x4*)(l_idx + 16 * g + 4 * q_); \
            Q[4 * q_] = *(const u32x4*)(rowp + (size_t)iv.x * 128); Q[4 * q_ + 1] = *(const u32x4*)(rowp + (size_t)iv.y * 128); \
            Q[4 * q_ + 2] = *(const u32x4*)(rowp + (size_t)iv.z * 128); Q[4 * q_ + 3] = *(const u32x4*)(rowp + (size_t)iv.w * 128); } } } while (0)
#define P5U_COMPUTE(Q, H0, H1, T) do { \
        f32x2 hf[8]; \
        hf[0] = (f32x2){bflo(H0.x), bfhi(H0.x)}; hf[1] = (f32x2){bflo(H0.y), bfhi(H0.y)}; hf[2] = (f32x2){bflo(H0.z), bfhi(H0.z)}; hf[3] = (f32x2){bflo(H0.w), bfhi(H0.w)}; \
        hf[4] = (f32x2){bflo(H1.x), bfhi(H1.x)}; hf[5] = (f32x2){bflo(H1.y), bfhi(H1.y)}; hf[6] = (f32x2){bflo(H1.z), bfhi(H1.z)}; hf[7] = (f32x2){bflo(H1.w), bfhi(H1.w)}; \
        float resA = 0.f, resB = 0.f; \
        _Pragma("unroll") for (int i = 0; i < 16; ++i) { \
            f32x2 s2 = __builtin_amdgcn_cvt_pk_f32_fp8(Q[i].x, false) * hf[0]; \
            s2 = __builtin_elementwise_fma(__builtin_amdgcn_cvt_pk_f32_fp8(Q[i].x, true), hf[1], s2); \
            s2 = __builtin_elementwise_fma(__builtin_amdgcn_cvt_pk_f32_fp8(Q[i].y, false), hf[2], s2); \
            s2 = __builtin_elementwise_fma(__builtin_amdgcn_cvt_pk_f32_fp8(Q[i].y, true), hf[3], s2); \
            s2 = __builtin_elementwise_fma(__builtin_amdgcn_cvt_pk_f32_fp8(Q[i].z, false), hf[4], s2); \
            s2 = __builtin_elementwise_fma(__builtin_amdgcn_cvt_pk_f32_fp8(Q[i].z, true), hf[5], s2); \
            s2 = __builtin_elementwise_fma(__builtin_amdgcn_cvt_pk_f32_fp8(Q[i].w, false), hf[6], s2); \
            s2 = __builtin_elementwise_fma(__builtin_amdgcn_cvt_pk_f32_fp8(Q[i].w, true), hf[7], s2); \
            float sr = s2.x + s2.y; \
            DPP_ADD(sr, 0xB1); DPP_ADD(sr, 0x4E); DPP_ADD(sr, 0x141); \
            if (i < 8) resA = (sub == i) ? sr : resA; else resB = (sub == i - 8) ? sr : resB; } \
        PACT[(size_t)(T) * 128 + 16 * g + sub] = resA; PACT[(size_t)(T) * 128 + 16 * g + 8 + sub] = resB; } while (0)
    int tok = gwx;
    P5U_LOADIDX(tok);
    P5U_ISSUE(qA, hA0, hA1, tok);
    P5U_LOADIDX(tok + nwx);
    for (; tok < NT; tok += 2 * nwx) {
        P5U_ISSUE(qB, hB0, hB1, tok + nwx);
        P5U_LOADIDX(tok + 2 * nwx);
        P5U_COMPUTE(qA, hA0, hA1, tok);
        if (tok + nwx >= NT) break;
        P5U_ISSUE(qA, hA0, hA1, tok + 2 * nwx);
        P5U_LOADIDX(tok + 3 * nwx);
        P5U_COMPUTE(qB, hB0, hB1, tok + nwx);
    }
#undef P5U_LOADIDX
#undef P5U_ISSUE
#undef P5U_COMPUTE
}
__device__ __forceinline__ void phase5c(const Params& p, int tid) {
    const float* PACT = (const float*)(p.ws + WS_PACT); const float* SCU = (const float*)(p.ws + WS_SCU); const float* SCV = (const float*)(p.ws + WS_SCV);
    const int* IDX = (const int*)(p.ws + WS_IDX); const float* GATE = (const float*)(p.ws + WS_GATE); float* COEF = (float*)(p.ws + WS_COEF);
    const size_t n = (size_t)NT * 128;
    for (size_t it = (size_t)blockIdx.x * 512 + tid; it < n; it += (size_t)gridDim.x * 512) {
        float a = 0.f;
#pragma unroll
        for (int xx = 0; xx < 8; ++xx) a += PACT[(size_t)xx * n + it];
        const int e = IDX[it];
        COEF[it] = GATE[it] * gelu_erf(a * SCU[e]) * SCV[e];
    }
}

constexpr int P5V_LDS_PER_WAVE = 1024 + 8 * 136 * 4;
__device__ __forceinline__ void phase5v(const Params& p, LAS unsigned char* lds, int lane, int wave) {
    int x, gwx, nwx; slice_group(x, gwx, nwx, wave);
    const unsigned char* PV8 = p.ws + WS_PV8 + (size_t)x * 16384 * 128;
    const int* IDX = (const int*)(p.ws + WS_IDX); const float* COEF = (const float*)(p.ws + WS_COEF);
    LAS int* l_idx = (LAS int*)(lds + wave * P5V_LDS_PER_WAVE); LAS float* l_cf = (LAS float*)(l_idx + 128); LAS float* red = l_cf + 128;
    const int g = lane >> 3, sub = lane & 7;
    const unsigned char* rowp = PV8 + sub * 16;
    const int c1 = 16 * (lane & 7) + (lane >> 3);
    int r_idxA = 0, r_idxB = 0; float r_cA = 0.f, r_cB = 0.f;
    u32x4 qA[16], qB[16]; f32x4 cfA[4], cfB[4]; float xA0 = 0.f, xA1 = 0.f, xB0 = 0.f, xB1 = 0.f;
#define P5V_LOADIDX(T) do { if ((T) < NT) { r_idxA = IDX[(size_t)(T) * 128 + lane]; r_idxB = IDX[(size_t)(T) * 128 + 64 + lane]; r_cA = COEF[(size_t)(T) * 128 + lane]; r_cB = COEF[(size_t)(T) * 128 + 64 + lane]; } } while (0)
#define P5V_ISSUE(Q, CF, X0, X1, T) do { if ((T) < NT) { l_idx[lane] = r_idxA; l_idx[64 + lane] = r_idxB; l_cf[lane] = r_cA; l_cf[64 + lane] = r_cB; \
        { const float* xr_ = p.out + (size_t)(T) * DM + 128 * x; X0 = xr_[c1]; X1 = xr_[c1 + 8]; } \
        _Pragma("unroll") for (int q_ = 0; q_ < 4; ++q_) { const u32x4 iv = *(const LAS u32x4*)(l_idx + 16 * g + 4 * q_); CF[q_] = *(const LAS f32x4*)(l_cf + 16 * g + 4 * q_); \
            Q[4 * q_] = *(const u32x4*)(rowp + (size_t)iv.x * 128); Q[4 * q_ + 1] = *(const u32x4*)(rowp + (size_t)iv.y * 128); \
            Q[4 * q_ + 2] = *(const u32x4*)(rowp + (size_t)iv.z * 128); Q[4 * q_ + 3] = *(const u32x4*)(rowp + (size_t)iv.w * 128); } } } while (0)
#define P5V_COMPUTE(Q, CF, X0, X1, T) do { \
        f32x2 acc[8]; \
        _Pragma("unroll") for (int j = 0; j < 8; ++j) acc[j] = (f32x2){0.f, 0.f}; \
        _Pragma("unroll") for (int i = 0; i < 16; ++i) { \
            const float cs_ = CF[i >> 2][i & 3]; const f32x2 c2 = (f32x2){cs_, cs_}; \
            acc[0] = __builtin_elementwise_fma(__builtin_amdgcn_cvt_pk_f32_fp8(Q[i].x, false), c2, acc[0]); \
            acc[1] = __builtin_elementwise_fma(__builtin_amdgcn_cvt_pk_f32_fp8(Q[i].x, true), c2, acc[1]); \
            acc[2] = __builtin_elementwise_fma(__builtin_amdgcn_cvt_pk_f32_fp8(Q[i].y, false), c2, acc[2]); \
            acc[3] = __builtin_elementwise_fma(__builtin_amdgcn_cvt_pk_f32_fp8(Q[i].y, true), c2, acc[3]); \
            acc[4] = __builtin_elementwise_fma(__builtin_amdgcn_cvt_pk_f32_fp8(Q[i].z, false), c2, acc[4]); \
            acc[5] = __builtin_elementwise_fma(__builtin_amdgcn_cvt_pk_f32_fp8(Q[i].z, true), c2, acc[5]); \
            acc[6] = __builtin_elementwise_fma(__builtin_amdgcn_cvt_pk_f32_fp8(Q[i].w, false), c2, acc[6]); \
            acc[7] = __builtin_elementwise_fma(__builtin_amdgcn_cvt_pk_f32_fp8(Q[i].w, true), c2, acc[7]); } \
        _Pragma("unroll") for (int j = 0; j < 8; ++j) { red[g * 136 + (2 * j) * 8 + sub] = acc[j].x; red[g * 136 + (2 * j + 1) * 8 + sub] = acc[j].y; } \
        float s1 = X0, s2_ = X1; \
        _Pragma("unroll") for (int gg = 0; gg < 8; ++gg) { s1 += red[gg * 136 + lane]; s2_ += red[gg * 136 + 64 + lane]; } \
        { float* xr_ = p.out + (size_t)(T) * DM + 128 * x; xr_[c1] = s1; xr_[c1 + 8] = s2_; } } while (0)
    int tok = gwx;
    P5V_LOADIDX(tok);
    P5V_ISSUE(qA, cfA, xA0, xA1, tok);
    P5V_LOADIDX(tok + nwx);
    for (; tok < NT; tok += 2 * nwx) {
        P5V_ISSUE(qB, cfB, xB0, xB1, tok + nwx);
        P5V_LOADIDX(tok + 2 * nwx);
        P5V_COMPUTE(qA, cfA, xA0, xA1, tok);
        if (tok + nwx >= NT) break;
        P5V_ISSUE(qA, cfA, xA0, xA1, tok + 2 * nwx);
        P5V_LOADIDX(tok + 3 * nwx);
        P5V_COMPUTE(qB, cfB, xB0, xB1, tok + nwx);
    }
#undef P5V_LOADIDX
#undef P5V_ISSUE
#undef P5V_COMPUTE
}

__device__ __forceinline__ void phase6(const Params& p, int lane, int wave) {
    const int gw = blockIdx.x * 8 + wave, NGW = gridDim.x * 8;
    const f32x4* gr = (const f32x4*)p.in[23] + lane;
    for (int m = gw; m < NT; m += NGW) {
        f32x4* xr = (f32x4*)(p.out + (size_t)m * DM) + lane;
        f32x4 v[4]; float s = 0.f;
#pragma unroll
        for (int j = 0; j < 4; ++j) { v[j] = xr[64 * j]; s += (v[j][0] * v[j][0] + v[j][1] * v[j][1]) + (v[j][2] * v[j][2] + v[j][3] * v[j][3]); }
        const float rstd = 1.f / sqrtf(wave_total(s) * (1.f / DM) + EPS);
#pragma unroll
        for (int j = 0; j < 4; ++j) xr[64 * j] = v[j] * rstd * gr[64 * j];
    }
}

__global__ void __launch_bounds__(512, 2) fwd_megakernel(Params p) {
    extern __shared__ __attribute__((aligned(16))) unsigned char lds_raw[];
    LAS unsigned char* lds = (LAS unsigned char*)lds_raw;
    cg::grid_group grid = cg::this_grid();
    const int tid = threadIdx.x, lane = tid & 63, wave = __builtin_amdgcn_readfirstlane(tid >> 6);
    const int G = gridDim.x;
    volatile LAS unsigned* MISC = (volatile LAS unsigned*)(lds + MISC_OFF);
    if (tid < 32) MISC[tid] = 0u;
    __syncthreads();
    XcdBarrier bar = xcd_barrier_post((unsigned*)(p.ws + WS_CTL) + 4096, MISC + 8);
#define GSYNC() xcd_barrier(bar)

#ifndef RPT_MASK
#define RPT_MASK 0
#endif
#define RPT(bit) for (int rpt_ = 0; rpt_ < (((RPT_MASK) >> (bit)) & 1) + 1; ++rpt_)
    RPT(0) { phase0(p, lds, tid, lane, wave); grid.sync(); }
    RPT(1) {
        pg8::Gemm g{(const bf16_t*)(p.ws + WS_H), (const bf16_t*)(p.ws + WS_WINT), NT, DIN, 1024};
        pg8::StaticOrder S; S.init(NT, DIN, G, (int)blockIdx.x);
        pg8::EpiProj E{(bf16_t*)(p.ws + WS_A), (bf16_t*)(p.ws + WS_Q), (bf16_t*)(p.ws + WS_KP), (bf16_t*)(p.ws + WS_VP), (bf16_t*)(p.ws + WS_KS), (bf16_t*)(p.ws + WS_VS), p.out};
        pg8::gemm_phase<pg8::EpiProj, pg8::StaticOrder, true, true>(lds, g, S, E);
        GSYNC();
    }
    #ifndef P2MODE
#define P2MODE 0
#endif
    RPT(2) { att::phase2(p, lds, tid, lane, wave, rpt_, (((RPT_MASK) >> 2) & 1) && rpt_ == 0 ? P2MODE : 0); GSYNC(); }
    RPT(3) {
        pg8::Gemm g{(const bf16_t*)(p.ws + WS_MIX), (const bf16_t*)(p.ws + WS_WOUTT), NT, 1024, 1024};
        pg8::StaticOrder S; S.init(NT, 1024, G, (int)blockIdx.x);
        pg8::EpiRes E{p.in[0], p.in[1], p.out};
        pg8::gemm_phase<pg8::EpiRes, pg8::StaticOrder, true, true>(lds, g, S, E);
        GSYNC();
    }
    RPT(4) { phase3b(p, lane, wave); GSYNC(); }
    RPT(5) {
        pg8::Gemm g{(const bf16_t*)(p.ws + WS_H2), (const bf16_t*)(p.ws + WS_WQT), NT, 2048, 1024};
        pg8::StaticOrder S; S.init(NT, 2048, G, (int)blockIdx.x);
        pg8::EpiBf16<0> E{(bf16_t*)(p.ws + WS_QP), 2048, nullptr, 0, 0, 1.f};
        pg8::gemm_phase<pg8::EpiBf16<0>, pg8::StaticOrder, true, true>(lds, g, S, E);
        GSYNC();
    }
    RPT(6) { phase4b(p, lane, wave); GSYNC(); }
    RPT(7) { phase5a(p, tid); GSYNC(); }
    RPT(8) { phase5u(p, lds, lane, wave); GSYNC(); }
    phase5c(p, tid);
    GSYNC();
    phase5v(p, lds, lane, wave);
    GSYNC();
    phase6(p, lane, wave);
}

extern "C" void kernel_launch(void* const* d_in, const int* in_sizes, int n_in, void* d_out, int out_size, void* d_ws, size_t ws_size, hipStream_t stream) {
    static int grid = 0;
    if (grid == 0) {
        if (n_in != 24 || out_size != (int)OUT_TOTAL || ws_size < WS_END) { fprintf(stderr, "kernel_launch: unexpected shapes: n_in %d out %d ws %zu (need %zu)\n", n_in, out_size, ws_size, (size_t)WS_END); grid = -1; return; }
        int dev = 0, cus = 0, per_cu = 0;
        (void)hipGetDevice(&dev);
        (void)hipDeviceGetAttribute(&cus, hipDeviceAttributeMultiprocessorCount, dev);
        if (hipFuncSetAttribute((const void*)fwd_megakernel, hipFuncAttributeMaxDynamicSharedMemorySize, LDS_BYTES) != hipSuccess) { fprintf(stderr, "kernel_launch: hipFuncSetAttribute failed\n"); grid = -1; return; }
        if (hipOccupancyMaxActiveBlocksPerMultiprocessor(&per_cu, (const void*)fwd_megakernel, 512, LDS_BYTES) != hipSuccess || per_cu < 1) { fprintf(stderr, "kernel_launch: occupancy query gave %d\n", per_cu); per_cu = 1; }
        (void)hipGetLastError();
        grid = cus * 1;
        if (per_cu < 1) grid = -1;
    }
    if (grid < 0) return;
    (void)hipMemsetAsync((char*)d_ws + WS_CTL, 0, CTL_BYTES, stream);
    Params p{};
    for (int i = 0; i < 24; ++i) p.in[i] = (const float*)d_in[i];
    p.out = (float*)d_out; p.ws = (unsigned char*)d_ws;
    void* args[] = {&p};
    hipError_t e = hipLaunchCooperativeKernel((const void*)fwd_megakernel, dim3(grid), dim3(512), args, LDS_BYTES, stream);
    if (e != hipSuccess) fprintf(stderr, "cooperative launch failed: %s (grid %d)\n", hipGetErrorString(e), grid);
}
```

```cpp
#include <hip/hip_runtime.h>
#include <hip/hip_cooperative_groups.h>
#include <cstdio>
#include <cstdint>
#include <cmath>
namespace cg = cooperative_groups;
#define CE_(a, b) do { const float t_ = fmaxf(a, b); b = fminf(a, b); a = t_; } while (0)
#define SORT16_DESC(V, O) do { CE_(V[(O)+0], V[(O)+1]); CE_(V[(O)+2], V[(O)+3]); CE_(V[(O)+0], V[(O)+2]); CE_(V[(O)+1], V[(O)+3]); CE_(V[(O)+1], V[(O)+2]); CE_(V[(O)+4], V[(O)+5]); CE_(V[(O)+6], V[(O)+7]); CE_(V[(O)+4], V[(O)+6]); CE_(V[(O)+5], V[(O)+7]); CE_(V[(O)+5], V[(O)+6]); CE_(V[(O)+0], V[(O)+4]); CE_(V[(O)+2], V[(O)+6]); CE_(V[(O)+2], V[(O)+4]); CE_(V[(O)+1], V[(O)+5]); CE_(V[(O)+3], V[(O)+7]); CE_(V[(O)+3], V[(O)+5]); CE_(V[(O)+1], V[(O)+2]); CE_(V[(O)+3], V[(O)+4]); CE_(V[(O)+5], V[(O)+6]); CE_(V[(O)+8], V[(O)+9]); CE_(V[(O)+10], V[(O)+11]); CE_(V[(O)+8], V[(O)+10]); CE_(V[(O)+9], V[(O)+11]); CE_(V[(O)+9], V[(O)+10]); CE_(V[(O)+12], V[(O)+13]); CE_(V[(O)+14], V[(O)+15]); CE_(V[(O)+12], V[(O)+14]); CE_(V[(O)+13], V[(O)+15]); CE_(V[(O)+13], V[(O)+14]); CE_(V[(O)+8], V[(O)+12]); CE_(V[(O)+10], V[(O)+14]); CE_(V[(O)+10], V[(O)+12]); CE_(V[(O)+9], V[(O)+13]); CE_(V[(O)+11], V[(O)+15]); CE_(V[(O)+11], V[(O)+13]); CE_(V[(O)+9], V[(O)+10]); CE_(V[(O)+11], V[(O)+12]); CE_(V[(O)+13], V[(O)+14]); CE_(V[(O)+0], V[(O)+8]); CE_(V[(O)+4], V[(O)+12]); CE_(V[(O)+4], V[(O)+8]); CE_(V[(O)+2], V[(O)+10]); CE_(V[(O)+6], V[(O)+14]); CE_(V[(O)+6], V[(O)+10]); CE_(V[(O)+2], V[(O)+4]); CE_(V[(O)+6], V[(O)+8]); CE_(V[(O)+10], V[(O)+12]); CE_(V[(O)+1], V[(O)+9]); CE_(V[(O)+5], V[(O)+13]); CE_(V[(O)+5], V[(O)+9]); CE_(V[(O)+3], V[(O)+11]); CE_(V[(O)+7], V[(O)+15]); CE_(V[(O)+7], V[(O)+11]); CE_(V[(O)+3], V[(O)+5]); CE_(V[(O)+7], V[(O)+9]); CE_(V[(O)+11], V[(O)+13]); CE_(V[(O)+1], V[(O)+2]); CE_(V[(O)+3], V[(O)+4]); CE_(V[(O)+5], V[(O)+6]); CE_(V[(O)+7], V[(O)+8]); CE_(V[(O)+9], V[(O)+10]); CE_(V[(O)+11], V[(O)+12]); CE_(V[(O)+13], V[(O)+14]); } while (0)
#define BITONIC16_DESC(V, O) do { CE_(V[(O)+0], V[(O)+8]); CE_(V[(O)+1], V[(O)+9]); CE_(V[(O)+2], V[(O)+10]); CE_(V[(O)+3], V[(O)+11]); CE_(V[(O)+4], V[(O)+12]); CE_(V[(O)+5], V[(O)+13]); CE_(V[(O)+6], V[(O)+14]); CE_(V[(O)+7], V[(O)+15]); CE_(V[(O)+0], V[(O)+4]); CE_(V[(O)+1], V[(O)+5]); CE_(V[(O)+2], V[(O)+6]); CE_(V[(O)+3], V[(O)+7]); CE_(V[(O)+8], V[(O)+12]); CE_(V[(O)+9], V[(O)+13]); CE_(V[(O)+10], V[(O)+14]); CE_(V[(O)+11], V[(O)+15]); CE_(V[(O)+0], V[(O)+2]); CE_(V[(O)+1], V[(O)+3]); CE_(V[(O)+4], V[(O)+6]); CE_(V[(O)+5], V[(O)+7]); CE_(V[(O)+8], V[(O)+10]); CE_(V[(O)+9], V[(O)+11]); CE_(V[(O)+12], V[(O)+14]); CE_(V[(O)+13], V[(O)+15]); CE_(V[(O)+0], V[(O)+1]); CE_(V[(O)+2], V[(O)+3]); CE_(V[(O)+4], V[(O)+5]); CE_(V[(O)+6], V[(O)+7]); CE_(V[(O)+8], V[(O)+9]); CE_(V[(O)+10], V[(O)+11]); CE_(V[(O)+12], V[(O)+13]); CE_(V[(O)+14], V[(O)+15]); } while (0)
namespace pg8 {
#define PG8_LAS __attribute__((address_space(3)))
typedef unsigned short bf16_t;
typedef short bf16x8 __attribute__((ext_vector_type(8)));
typedef float f32x4 __attribute__((ext_vector_type(4)));
typedef unsigned u32x4 __attribute__((ext_vector_type(4)));
constexpr int BM = 256, BK = 64, HALF = 128, HTB = HALF * BK * 2  , STAGE_BYTES = 8 * HTB, NXCD = 8, WGM = 8;

__host__ __device__ __forceinline__ int lds_byte(int r, int c) { const int st = (r >> 4) * 2 + (c >> 5), rr = r & 15, cc = c & 31, ob = rr * 64 + cc * 2; return st * 1024 + (ob ^ (((ob >> 9) & 1) << 5)); }
__host__ __device__ __forceinline__ void stage_rc(int b, int& R, int& C) { const int st = b / 1024, sb = b % 1024, swz = sb ^ (((sb >> 9) & 1) << 5); R = (st >> 1) * 16 + swz / 64; C = (st & 1) * 32 + (swz % 64) / 2; }
__host__ __device__ __forceinline__ int perm32(int rho) { const int n = rho >> 4, i = rho & 15; return 8 * (i >> 2) + 4 * n + (i & 3); }

struct Unit { int pm, pn; };
struct Gemm { const bf16_t* A; const bf16_t* Bt; int M, N, K; };

struct StaticOrder {
    int nM, nN, nwg, G, c;
    __host__ __device__ void init(int M, int N, int G_, int c_) { nM = M / BM; nN = N / BM; nwg = nM * nN; G = G_; c = c_; }
    __host__ __device__ bool next(int i, Unit& u) const {
        const long L = (long)i * G + c; if (L >= nwg) return false;
        int wgid = (int)L; { const int q = nwg / NXCD, r = nwg % NXCD, xcd = wgid % NXCD, off = wgid / NXCD; wgid = (xcd < r ? xcd * (q + 1) : r * (q + 1) + (xcd - r) * q) + off; }
        const int nig = WGM * nN, gid = wgid / nig, fm = gid * WGM, gsz = (nM - fm) < WGM ? (nM - fm) : WGM;
        u.pm = fm + ((wgid % nig) % gsz); u.pn = (wgid % nig) / gsz; return true;
    }
    __device__ __forceinline__ void a_ready(const Unit&) const {}
    __device__ __forceinline__ void done(const Unit&) const {}
};

__device__ __forceinline__ unsigned cvt_pk_bf16(float lo, float hi) { unsigned r; asm volatile("v_cvt_pk_bf16_f32 %0, %1, %2" : "=v"(r) : "v"(lo), "v"(hi)); return r; }
typedef float f32x2 __attribute__((ext_vector_type(2)));
__device__ __forceinline__ f32x2 gelu_pk(f32x2 v) {
    const f32x2 av = __builtin_elementwise_abs(v), d = av * 0.2316418882f + 1.0f;
    f32x2 t; t.x = __builtin_amdgcn_rcpf(d.x); t.y = __builtin_amdgcn_rcpf(d.y);
    f32x2 q = t * 0.5307027145f + (-0.7265760135f); q = q * t + 0.7107068705f; q = q * t + (-0.142248368f); q = q * t + 0.127414796f; q = q * t;
    const f32x2 s = (v * v) * (-0.72134752044f);
    f32x2 e; e.x = __builtin_amdgcn_exp2f(s.x); e.y = __builtin_amdgcn_exp2f(s.y);
    const f32x2 m = v * (q * e), r = v - m;
    f32x2 o; o.x = v.x < 0.f ? m.x : r.x; o.y = v.y < 0.f ? m.y : r.y; return o;
}

template <int ACT  > struct EpiBf16 {
    static constexpr bool PERM = true, AFTER_DRAIN = false; static_assert(ACT == 0 || ACT == 1, "EpiBf16: ACT is 0 (none) or 1 (gelu_pk)");
    bf16_t* O; int ldc; const float* bias; int split_cols; size_t split_stride; float scale0;
    __device__ __forceinline__ void operator()(const f32x4 (&acc)[2][2][4][2], const Unit& u, int wr, int wc, int fr, int fq) const {
        const int row0 = u.pm * BM + wr * 64 + fr; int colt = u.pn * BM; bf16_t* base = O;
        float sc = 1.f; if (split_cols) { const int t = colt / split_cols; base += (size_t)t * split_stride; colt -= t * split_cols; if (t == 0) sc = scale0; }
        const int col0 = colt + wc * 32 + 8 * fq, bcol0 = u.pn * BM + wc * 32 + 8 * fq;
        f32x4 bv[2][2];
#pragma unroll
        for (int bj = 0; bj < 2; ++bj)
#pragma unroll
            for (int n = 0; n < 2; ++n) bv[bj][n] = bias ? *(const f32x4*)(bias + bcol0 + bj * HALF + 4 * n) : (f32x4){0.f, 0.f, 0.f, 0.f};
#pragma unroll
        for (int ai = 0; ai < 2; ++ai)
#pragma unroll
            for (int m = 0; m < 4; ++m) { bf16_t* rowp = base + (size_t)(row0 + ai * HALF + m * 16) * ldc + col0;
#pragma unroll
                for (int bj = 0; bj < 2; ++bj) { f32x4 v0 = acc[ai][bj][m][0] + bv[bj][0], v1 = acc[ai][bj][m][1] + bv[bj][1];
                    if (ACT == 1) { f32x2 a = gelu_pk((f32x2){v0[0], v0[1]}), b = gelu_pk((f32x2){v0[2], v0[3]}), c = gelu_pk((f32x2){v1[0], v1[1]}), d = gelu_pk((f32x2){v1[2], v1[3]});
                        v0 = (f32x4){a.x, a.y, b.x, b.y}; v1 = (f32x4){c.x, c.y, d.x, d.y}; }
                    v0 = v0 * sc; v1 = v1 * sc; u32x4 w; w.x = cvt_pk_bf16(v0[0], v0[1]); w.y = cvt_pk_bf16(v0[2], v0[3]); w.z = cvt_pk_bf16(v1[0], v1[1]); w.w = cvt_pk_bf16(v1[2], v1[3]);
                    *(u32x4*)(rowp + bj * HALF) = w; } }
    }
};
template <class Epi, class Sched, bool ALIGN_EPI = false, bool SP2 = false>
__device__ __forceinline__ void gemm_phase(PG8_LAS unsigned char* lds, const Gemm g, const Sched& S, const Epi& E) {
    const int tid = threadIdx.x, wid = __builtin_amdgcn_readfirstlane(tid >> 6), lane = tid & 63, wr = wid >> 2, wc = wid & 3, fr = lane & 15, fq = lane >> 4;
    const int K = g.K, nt = K / BK;
    unsigned voffA[2], voffB[2];
#pragma unroll
    for (int i = 0; i < 2; ++i) { int R, C; stage_rc(tid * 16 + i * 8192, R, C); const int Rb = Epi::PERM ? ((R & ~31) + perm32(R & 31)) : R;
        voffA[i] = (unsigned)(R * K + C) * 2u; voffB[i] = (unsigned)(Rb * K + C) * 2u; }
    const size_t kstep = (size_t)(BK * 2);
    const size_t hstep = (size_t)HALF * K * 2;
    const size_t tstep = 2 * hstep;
    const unsigned ldsw = (unsigned)wid * 1024u;
    const int aoff = lds_byte(wr * 64 + fr, fq * 8), boff = lds_byte(wc * 32 + fr, fq * 8);
#define PG8_SA(b, h) (((b) * 2 + (h)) * HTB)
#define PG8_SB(b, h) ((4 + (b) * 2 + (h)) * HTB)
#define PG8_STAGE(bufoff, gbase, voff) do { _Pragma("unroll") for (int _i = 0; _i < 2; ++_i) \
        __builtin_amdgcn_global_load_lds((const unsigned*)((const char*)(gbase) + (voff)[_i]), (PG8_LAS unsigned*)(lds + (bufoff) + ldsw + _i * 8192), 16, 0, 0); } while (0)
#define PG8_LDA(dst, b, h) do { _Pragma("unroll") for (int m = 0; m < 4; ++m) _Pragma("unroll") for (int k = 0; k < 2; ++k) dst[m][k] = *(const PG8_LAS bf16x8*)(lds + PG8_SA(b, h) + aoff + m * 2048 + k * 1024); } while (0)
#define PG8_LDB(dst, b, h) do { _Pragma("unroll") for (int n = 0; n < 2; ++n) _Pragma("unroll") for (int k = 0; k < 2; ++k) dst[n][k] = *(const PG8_LAS bf16x8*)(lds + PG8_SB(b, h) + boff + n * 2048 + k * 1024); } while (0)
#define PG8_MMA(ai, bj, At, Bt) do { __builtin_amdgcn_s_setprio(1); _Pragma("unroll") for (int m = 0; m < 4; ++m) _Pragma("unroll") for (int n = 0; n < 2; ++n) _Pragma("unroll") for (int k = 0; k < 2; ++k) \
        acc[ai][bj][m][n] = __builtin_amdgcn_mfma_f32_16x16x32_bf16(Bt[n][k], At[m][k], acc[ai][bj][m][n], 0, 0, 0); __builtin_amdgcn_s_setprio(0); } while (0)
#define PG8_WAIT_V(n) asm volatile("s_waitcnt vmcnt(" #n ")" ::: "memory")
#define PG8_WAIT_L(n) asm volatile("s_waitcnt lgkmcnt(" #n ")" ::: "memory")
#define PG8_BAR __builtin_amdgcn_s_barrier()
#define PG8_SCHED __builtin_amdgcn_sched_barrier(0)
    Unit cur, nxt; int ui = 0;
    if (!S.next(0, cur)) return;
    f32x4 acc[2][2][4][2];
#pragma unroll
    for (int a = 0; a < 2; ++a)
#pragma unroll
        for (int b = 0; b < 2; ++b)
#pragma unroll
            for (int m = 0; m < 4; ++m)
#pragma unroll
                for (int n = 0; n < 2; ++n) acc[a][b][m][n] = (f32x4){0.f, 0.f, 0.f, 0.f};
    bf16x8 At[4][2], B0[2][2], B1[2][2];
    const char* cA = (const char*)g.A + (size_t)cur.pm * tstep; const char* cB = (const char*)g.Bt + (size_t)cur.pn * tstep;
    S.a_ready(cur);
    if constexpr (SP2) {
        PG8_STAGE(PG8_SB(0, 0), cB, voffB); PG8_STAGE(PG8_SB(0, 1), cB + hstep, voffB); PG8_STAGE(PG8_SA(0, 0), cA, voffA); PG8_STAGE(PG8_SA(0, 1), cA + hstep, voffA);
        if (wr == 1) PG8_BAR;
        PG8_WAIT_V(2); PG8_BAR;
        PG8_STAGE(PG8_SB(1, 0), cB + kstep, voffB); PG8_STAGE(PG8_SA(1, 0), cA + kstep, voffA); PG8_STAGE(PG8_SB(1, 1), cB + hstep + kstep, voffB);
        PG8_WAIT_V(6); PG8_BAR;
    } else {
        PG8_STAGE(PG8_SB(0, 0), cB, voffB); PG8_STAGE(PG8_SA(0, 0), cA, voffA); PG8_STAGE(PG8_SB(0, 1), cB + hstep, voffB); PG8_STAGE(PG8_SA(0, 1), cA + hstep, voffA);
        if (wr == 1) PG8_BAR;
        PG8_WAIT_V(4); PG8_BAR;
        PG8_STAGE(PG8_SB(1, 0), cB + kstep, voffB); PG8_STAGE(PG8_SA(1, 0), cA + kstep, voffA); PG8_STAGE(PG8_SB(1, 1), cB + hstep + kstep, voffB);
        PG8_WAIT_V(6); PG8_BAR;
    }
    for (;;) {
        const bool has_next = S.next(ui + 1, nxt);
        const char* nA = has_next ? (const char*)g.A + (size_t)nxt.pm * tstep : cA; const char* nB = has_next ? (const char*)g.Bt + (size_t)nxt.pn * tstep : cB;
        for (int t = 0; t < nt; t += 2) {
            const bool last = (t == nt - 2);
            const char* a1 = cA + (size_t)(t + 1) * kstep;
            const char* a2 = last ? nA : cA + (size_t)(t + 2) * kstep; const char* b2 = last ? nB : cB + (size_t)(t + 2) * kstep;
            const char* a3 = a2 + kstep; const char* b3 = b2 + kstep;
            if (last && has_next) S.a_ready(nxt);
            if constexpr (SP2) {
            PG8_LDB(B0, 0, 0); PG8_LDB(B1, 0, 1); PG8_SCHED; PG8_LDA(At, 0, 0); PG8_STAGE(PG8_SA(1, 1), a1 + hstep, voffA);
            PG8_WAIT_V(8); PG8_WAIT_L(0); PG8_BAR; PG8_MMA(0, 0, At, B0); PG8_MMA(0, 1, At, B1); PG8_BAR; PG8_SCHED;
            PG8_LDA(At, 0, 1); PG8_STAGE(PG8_SB(0, 0), b2, voffB); PG8_STAGE(PG8_SB(0, 1), b2 + hstep, voffB); PG8_STAGE(PG8_SA(0, 0), a2, voffA);
            PG8_WAIT_V(8); PG8_WAIT_L(0); PG8_BAR; PG8_MMA(1, 0, At, B0); PG8_MMA(1, 1, At, B1); PG8_BAR; PG8_SCHED;
            PG8_LDB(B0, 1, 0); PG8_LDB(B1, 1, 1); PG8_SCHED; PG8_LDA(At, 1, 0); PG8_STAGE(PG8_SA(0, 1), a2 + hstep, voffA);
            PG8_WAIT_V(8); PG8_WAIT_L(0); PG8_BAR; PG8_MMA(0, 0, At, B0); PG8_MMA(0, 1, At, B1); PG8_BAR; PG8_SCHED;
            PG8_LDA(At, 1, 1); PG8_STAGE(PG8_SB(1, 0), b3, voffB); PG8_STAGE(PG8_SB(1, 1), b3 + hstep, voffB); PG8_STAGE(PG8_SA(1, 0), a3, voffA);
            PG8_WAIT_V(8); PG8_WAIT_L(0); PG8_BAR; PG8_MMA(1, 0, At, B0); PG8_MMA(1, 1, At, B1); PG8_BAR; PG8_SCHED;
            } else {
            PG8_LDB(B0, 0, 0); PG8_SCHED; PG8_LDA(At, 0, 0); PG8_STAGE(PG8_SA(1, 1), a1 + hstep, voffA);
            PG8_WAIT_L(8); PG8_BAR; PG8_WAIT_L(0); PG8_MMA(0, 0, At, B0); PG8_BAR; PG8_SCHED;
            PG8_LDB(B1, 0, 1); PG8_STAGE(PG8_SB(0, 0), b2, voffB);
            PG8_BAR; PG8_WAIT_L(0); PG8_MMA(0, 1, At, B1); PG8_BAR;
            PG8_LDA(At, 0, 1); PG8_STAGE(PG8_SA(0, 0), a2, voffA);
            PG8_BAR; PG8_WAIT_L(0); PG8_MMA(1, 0, At, B0); PG8_BAR; PG8_SCHED;
            PG8_STAGE(PG8_SB(0, 1), b2 + hstep, voffB);
            PG8_WAIT_V(6); PG8_BAR; PG8_MMA(1, 1, At, B1); PG8_BAR;
            PG8_LDB(B0, 1, 0); PG8_SCHED; PG8_LDA(At, 1, 0); PG8_STAGE(PG8_SA(0, 1), a2 + hstep, voffA);
            PG8_WAIT_L(8); PG8_BAR; PG8_WAIT_L(0); PG8_MMA(0, 0, At, B0); PG8_BAR; PG8_SCHED;
            PG8_LDB(B1, 1, 1); PG8_STAGE(PG8_SB(1, 0), b3, voffB);
            PG8_BAR; PG8_WAIT_L(0); PG8_MMA(0, 1, At, B1); PG8_BAR;
            PG8_LDA(At, 1, 1); PG8_STAGE(PG8_SA(1, 0), a3, voffA);
            PG8_BAR; PG8_WAIT_L(0); PG8_MMA(1, 0, At, B0); PG8_BAR; PG8_SCHED;
            PG8_STAGE(PG8_SB(1, 1), b3 + hstep, voffB);
            PG8_WAIT_V(6); PG8_BAR; PG8_MMA(1, 1, At, B1); PG8_BAR;
            }
        }
        if constexpr (ALIGN_EPI) { if (wr == 0) PG8_BAR; }
        if constexpr (!Epi::AFTER_DRAIN) { E(acc, cur, wr, wc, fr, fq); S.done(cur); }
        if (!has_next) break;
#pragma unroll
        for (int a = 0; a < 2; ++a)
#pragma unroll
            for (int b = 0; b < 2; ++b)
#pragma unroll
                for (int m = 0; m < 4; ++m)
#pragma unroll
                    for (int n = 0; n < 2; ++n) acc[a][b][m][n] = (f32x4){0.f, 0.f, 0.f, 0.f};
        cur = nxt; cA = nA; cB = nB; ++ui;
        if constexpr (ALIGN_EPI) { if (wr == 1) PG8_BAR; }
    }
    PG8_WAIT_V(0);
    if constexpr (!ALIGN_EPI) { if (wr == 0) PG8_BAR; }
    PG8_BAR;
    if constexpr (Epi::AFTER_DRAIN) { E.fused(acc, cur, wr, wc, fr, fq, lds, wid, lane); S.done(cur); }
#undef PG8_SA
#undef PG8_SB
#undef PG8_STAGE
#undef PG8_LDA
#undef PG8_LDB
#undef PG8_MMA
#undef PG8_WAIT_V
#undef PG8_WAIT_L
#undef PG8_BAR
#undef PG8_SCHED
}
}

#define LAS __attribute__((address_space(3)))
typedef unsigned short bf16_t;
typedef short bf16x8 __attribute__((ext_vector_type(8)));
typedef short s16x4 __attribute__((ext_vector_type(4)));
typedef float f32x4 __attribute__((ext_vector_type(4)));
typedef float f32x16 __attribute__((ext_vector_type(16)));
typedef unsigned u32x4 __attribute__((ext_vector_type(4)));
typedef unsigned u32x2 __attribute__((ext_vector_type(2)));

constexpr int DM = 1024;
constexpr int NP = 16 * 2048;
constexpr int NS = 8 * 64;
constexpr int NT = NP + NS;
constexpr int DIN = 2560;
constexpr int SKV = 2112;
constexpr float EPS = 1e-6f;
constexpr float LOG2E = 1.4426950408889634f;
constexpr float QSCALE = 0.125f * LOG2E;

constexpr long OUT_Y = 0;
constexpr long OUT_KP = 34078720L, OUT_VP = 50855936L, OUT_CONVP = 67633152L, OUT_KS = 67878912L, OUT_VS = 68141056L, OUT_CONVS = 68403200L, OUT_TOTAL = 68526080L;

constexpr size_t MiB = 1u << 20;
constexpr size_t WS_CTL = 0, CTL_BYTES = 1 * MiB;
constexpr size_t WS_WINT = 1 * MiB;
constexpr size_t WS_WOUTT = 6 * MiB;
constexpr size_t WS_WQT = 8 * MiB;
constexpr size_t WS_SK = 12 * MiB;
constexpr size_t WS_PU8 = 16 * MiB;
constexpr size_t WS_PV8 = 32 * MiB;
constexpr size_t WS_SCU = 48 * MiB;
constexpr size_t WS_SCV = 49 * MiB;
constexpr size_t WS_KS = 80 * MiB;
constexpr size_t WS_VS = 97 * MiB;
constexpr size_t WS_H = 114 * MiB;
constexpr size_t WS_A = 179 * MiB;
constexpr size_t WS_Q = 212 * MiB;
constexpr size_t WS_QP = 114 * MiB;
constexpr size_t WS_KP = 245 * MiB;
constexpr size_t WS_VP = 277 * MiB;
constexpr size_t WS_MIX = 309 * MiB;
constexpr size_t WS_H2 = 309 * MiB;
constexpr size_t WS_TK = 375 * MiB;
constexpr size_t WS_IDX = 408 * MiB;
constexpr size_t WS_GATE = 425 * MiB;
constexpr size_t WS_PACT = 114 * MiB;
constexpr size_t WS_COEF = 375 * MiB;
constexpr size_t WS_END = 442 * MiB;
static_assert(WS_H + (size_t)NT * 1024 * 2 <= WS_A && WS_A + (size_t)NT * 512 * 2 <= WS_Q && WS_Q + (size_t)NT * 512 * 2 <= WS_KP, "R1");
static_assert(WS_QP + (size_t)NT * 2048 * 2 <= WS_KP && WS_KP + (size_t)NP * 512 * 2 <= WS_VP && WS_VP + (size_t)NP * 512 * 2 <= WS_MIX, "ws map");
static_assert(WS_MIX + (size_t)NT * 1024 * 2 <= WS_TK && WS_TK + (size_t)NT * 256 * 4 <= WS_IDX && WS_IDX + (size_t)NT * 128 * 4 <= WS_GATE && WS_GATE + (size_t)NT * 128 * 4 <= WS_END, "ws map 2");
static_assert(WS_KS + (size_t)8 * SKV * 512 * 2 <= WS_VS && WS_VS + (size_t)8 * SKV * 512 * 2 <= WS_H, "ws map 3");

constexpr int RING_BYTES = 131072;
constexpr int BIAS_OFF = RING_BYTES;
constexpr int MISC_OFF = RING_BYTES + 5120;
constexpr int LDS_BYTES = MISC_OFF + 1024;

struct Params {
    const float* in[24];
    float* out;
    unsigned char* ws;
};

__device__ __forceinline__ unsigned cvtpk(float lo, float hi) { return pg8::cvt_pk_bf16(lo, hi); }
__device__ __forceinline__ float bflo(unsigned w) { return __uint_as_float(w << 16); }
__device__ __forceinline__ float bfhi(unsigned w) { return __uint_as_float(w & 0xffff0000u); }
__device__ __forceinline__ float wave_sum(float v) {
#pragma unroll
    for (int o = 1; o < 64; o <<= 1) v += __shfl_xor(v, o);
    return v;
}
typedef float f32x2 __attribute__((ext_vector_type(2)));
#define DPP_ADD(v, ctrl) v += __builtin_bit_cast(float, __builtin_amdgcn_update_dpp(0, __builtin_bit_cast(int, v), ctrl, 0xf, 0xf, true))
__device__ __forceinline__ float rl_f(float v, int l) { return __uint_as_float(__builtin_amdgcn_readlane(__float_as_uint(v), l)); }
__device__ __forceinline__ float wave_total(float v) {
    DPP_ADD(v, 0xB1); DPP_ADD(v, 0x4E); DPP_ADD(v, 0x141); DPP_ADD(v, 0x140);
    return (rl_f(v, 0) + rl_f(v, 16)) + (rl_f(v, 32) + rl_f(v, 48));
}
typedef __bf16 bf16x2_t __attribute__((ext_vector_type(2)));
__device__ __forceinline__ float dot2(unsigned a, unsigned b, float acc) {
    return __builtin_amdgcn_fdot2_f32_bf16(__builtin_bit_cast(bf16x2_t, a), __builtin_bit_cast(bf16x2_t, b), acc, false);
}
#define LDS_WAIT() asm volatile("s_waitcnt lgkmcnt(0)" ::: "memory")

#define XB_TMO      128
#define XB_XCNT(j)  (256  + 64 * (j))
#define XB_XSUB(j)  (1280 + 64 * (j))
#define XB_XGEN(j)  (2304 + 64 * (j))
#define XB_TOP      3328
#define XB_TOPGEN   3392
#define XCD_BAR_WORDS 3456
#define XB_SPIN_CAP (1u << 18)

__device__ __forceinline__ unsigned xb_ld(unsigned* p)              { return __hip_atomic_load(p, __ATOMIC_RELAXED, __HIP_MEMORY_SCOPE_AGENT); }
__device__ __forceinline__ unsigned xb_add(unsigned* p, unsigned v) { return __hip_atomic_fetch_add(p, v, __ATOMIC_RELAXED, __HIP_MEMORY_SCOPE_AGENT); }
__device__ __forceinline__ unsigned xb_xcc_id() { return (unsigned)__builtin_amdgcn_s_getreg((3 << 11) | 20) & 0xFu; }
#define XB_SPIN(cond, bar) do { unsigned _sp = 0; while (cond) { __builtin_amdgcn_s_sleep(1); \
    if ((++_sp & 255u) == 0u) { if (xb_ld(&(bar)[XB_TMO])) break; if (_sp > XB_SPIN_CAP) { atomicAdd(&(bar)[XB_TMO], 1u); break; } } } } while (0)

struct XcdBarrier {
    unsigned* bar; unsigned x;
    volatile LAS unsigned* st;
};

__device__ __forceinline__ XcdBarrier xcd_barrier_post(unsigned* bar, volatile LAS unsigned* st) {
    XcdBarrier b; b.bar = bar; b.x = xb_xcc_id(); b.st = st;
    if (threadIdx.x == 0) (void)xb_add(&bar[XB_XCNT(b.x)], 1u);
    return b;
}
__device__ __forceinline__ void xcd_barrier_complete(unsigned* bar, unsigned x, unsigned& nloc, unsigned& nx) {
    const unsigned G = gridDim.x * gridDim.y * gridDim.z;
    unsigned sum, cnt, mine, sp = 0u;
    for (;;) {
        sum = 0u; cnt = 0u; mine = 0u;
#pragma unroll
        for (unsigned j = 0; j < 16; ++j) { const unsigned c = xb_ld(&bar[XB_XCNT(j)]); sum += c; cnt += (c > 0u) ? 1u : 0u; mine = (j == x) ? c : mine; }
        if (sum == G) break;
        __builtin_amdgcn_s_sleep(1);
        if ((++sp & 255u) == 0u) { if (xb_ld(&bar[XB_TMO])) break; if (sp > XB_SPIN_CAP) { atomicAdd(&bar[XB_TMO], 1u); break; } }
    }
    nloc = mine > 0u ? mine : 1u; nx = cnt > 0u ? cnt : 1u;
}

__device__ __forceinline__ void xcd_barrier(const XcdBarrier& b) {
    asm volatile("s_waitcnt vmcnt(0)" ::: "memory");
    __syncthreads();
    if (threadIdx.x == 0) {
        unsigned* bar = b.bar;
        __builtin_amdgcn_s_waitcnt(0);
        unsigned nloc = b.st[0], nx = b.st[1];
        if (nloc == 0u) { xcd_barrier_complete(bar, b.x, nloc, nx); b.st[0] = nloc; b.st[1] = nx; }
        const unsigned old = xb_add(&bar[XB_XSUB(b.x)], 1u);
        const unsigned gen = old / nloc;
        if (old + 1u == (gen + 1u) * nloc) {
            __builtin_amdgcn_fence(__ATOMIC_RELEASE, "agent");
            asm volatile("s_waitcnt vmcnt(0)" ::: "memory");
            const unsigned og = xb_add(&bar[XB_TOP], 1u);
            const unsigned tg = og / nx;
            if (og + 1u == (tg + 1u) * nx) xb_add(&bar[XB_TOPGEN], 1u);
            else XB_SPIN(xb_ld(&bar[XB_TOPGEN]) == tg, bar);
            __builtin_amdgcn_fence(__ATOMIC_ACQUIRE, "agent");
            xb_add(&bar[XB_XGEN(b.x)], 1u);
            asm volatile("s_waitcnt vmcnt(0)" ::: "memory");
        } else {
            XB_SPIN(xb_ld(&bar[XB_XGEN(b.x)]) == gen, bar);
            __builtin_amdgcn_fence(__ATOMIC_ACQUIRE, "agent");
            asm volatile("s_waitcnt vmcnt(0)" ::: "memory");
        }
    }
    __syncthreads();
}


namespace pg8 {
__device__ __forceinline__ u32x2 pack4(f32x4 v) { u32x2 w; w.x = cvt_pk_bf16(v[0], v[1]); w.y = cvt_pk_bf16(v[2], v[3]); return w; }
struct EpiProj {
    static constexpr bool PERM = false, AFTER_DRAIN = false;
    bf16_t* A; bf16_t* Q; bf16_t* KP; bf16_t* VP; bf16_t* KS; bf16_t* VS; float* out;
    __device__ __forceinline__ void operator()(const f32x4 (&acc)[2][2][4][2], const Unit& u, int wr, int wc, int fr, int fq) const {
        const int pn = u.pn;
        const int row0 = u.pm * BM + wr * 64 + fr;
        if (pn < 4) {
#pragma unroll
            for (int ai = 0; ai < 2; ++ai)
#pragma unroll
                for (int m = 0; m < 4; ++m) {
                    const int row = row0 + ai * HALF + m * 16;
                    long toff = -1;
                    if (row < NP) { const int s = row & 2047; if (s >= 2018) toff = OUT_CONVP + ((long)(row >> 11) * 30 + (s - 2018)) * 512; }
                    else { const int rr = row - NP; const int i = rr & 63; if (i >= 34) toff = OUT_CONVS + ((long)(rr >> 6) * 30 + (i - 34)) * 512; }
#pragma unroll
                    for (int n = 0; n < 2; ++n) {
                        const int c = 128 * pn + 32 * wc + 16 * n + 4 * fq;
                        const f32x4 x = acc[ai][0][m][n], g = acc[ai][1][m][n];
                        f32x4 a;
#pragma unroll
                        for (int j = 0; j < 4; ++j) a[j] = x[j] / (1.f + __expf(-g[j]));
                        *(u32x2*)(A + (size_t)row * 512 + c) = pack4(a);
                        if (toff >= 0) *(f32x4*)(out + toff + c) = a;
                    }
                }
        } else {
            const int sec = (pn - 4) >> 1, colbase = ((pn - 4) & 1) * 256;
#pragma unroll
            for (int ai = 0; ai < 2; ++ai)
#pragma unroll
                for (int m = 0; m < 4; ++m) {
                    const int row = row0 + ai * HALF + m * 16;
                    const bool isp = row < NP; const int rr = row - NP;
                    bf16_t* bdst; float* fdst;
                    if (sec == 0) { bdst = Q + (size_t)row * 512; fdst = nullptr; }
                    else if (sec == 1) { bdst = isp ? KP + (size_t)row * 512 : KS + ((size_t)(rr >> 6) * SKV + 2048 + (rr & 63)) * 512; fdst = isp ? out + OUT_KP + (size_t)row * 512 : out + OUT_KS + (size_t)rr * 512; }
                    else { bdst = isp ? VP + (size_t)row * 512 : VS + ((size_t)(rr >> 6) * SKV + 2048 + (rr & 63)) * 512; fdst = isp ? out + OUT_VP + (size_t)row * 512 : out + OUT_VS + (size_t)rr * 512; }
#pragma unroll
                    for (int bj = 0; bj < 2; ++bj)
#pragma unroll
                        for (int n = 0; n < 2; ++n) {
                            const int col = colbase + 128 * bj + 32 * wc + 16 * n + 4 * fq;
                            const f32x4 v = acc[ai][bj][m][n];
                            if (sec == 0) { *(u32x2*)(bdst + col) = pack4(v * QSCALE); }
                            else { *(u32x2*)(bdst + col) = pack4(v); *(f32x4*)(fdst + col) = v; }
                        }
                }
        }
    }
};
struct EpiRes {
    static constexpr bool PERM = false, AFTER_DRAIN = false;
    const float* xp; const float* xs; float* out;
    __device__ __forceinline__ void operator()(const f32x4 (&acc)[2][2][4][2], const Unit& u, int wr, int wc, int fr, int fq) const {
        const int row0 = u.pm * BM + wr * 64 + fr;
#pragma unroll
        for (int ai = 0; ai < 2; ++ai)
#pragma unroll
            for (int m = 0; m < 4; ++m) {
                const int row = row0 + ai * HALF + m * 16;
                const float* xr = row < NP ? xp + (size_t)row * DM : xs + (size_t)(row - NP) * DM;
                float* orow = out + (size_t)row * DM;
#pragma unroll
                for (int bj = 0; bj < 2; ++bj)
#pragma unroll
                    for (int n = 0; n < 2; ++n) {
                        const int col = u.pn * BM + 128 * bj + 32 * wc + 16 * n + 4 * fq;
                        *(f32x4*)(orow + col) = *(const f32x4*)(xr + col) + acc[ai][bj][m][n];
                    }
            }
    }
};
}

__device__ __forceinline__ int winrow(int n) { return n < 1024 ? (256 * ((n & 511) >> 7) + 128 * (n >> 9) + (n & 127)) : n; }
template <bool WIN> __device__ __forceinline__ void transpose_item(const float* W, int K, int N, bf16_t* WT, LAS float* scr, int item, int lane) {
    const int nblk = N / 32, kb = item / nblk, nb = item % nblk, k0 = 64 * kb, n0 = 32 * nb;
#pragma unroll 8
    for (int i = 0; i < 32; ++i) { const int kk = 2 * i + (lane >> 5); scr[kk * 33 + (lane & 31)] = W[(size_t)(k0 + kk) * N + n0 + (lane & 31)]; }
    LDS_WAIT();
    const int c = lane & 7;
#pragma unroll
    for (int j = 0; j < 4; ++j) {
        const int n = (lane >> 3) + 8 * j; const LAS float* s = scr + (8 * c) * 33 + n;
        u32x4 o; o.x = cvtpk(s[0 * 33], s[1 * 33]); o.y = cvtpk(s[2 * 33], s[3 * 33]); o.z = cvtpk(s[4 * 33], s[5 * 33]); o.w = cvtpk(s[6 * 33], s[7 * 33]);
        const int dr = WIN ? winrow(n0 + n) : (n0 + n);
        *(u32x4*)(WT + (size_t)dr * K + k0 + 8 * c) = o;
    }
    LDS_WAIT();
}
__device__ __forceinline__ void cvt_stream(const float* src, bf16_t* dst, size_t n8, size_t gt, size_t ngt) {
    for (size_t i = gt; i < n8; i += ngt) {
        const f32x4 a = *(const f32x4*)(src + i * 8), b = *(const f32x4*)(src + i * 8 + 4);
        u32x4 o; o.x = cvtpk(a[0], a[1]); o.y = cvtpk(a[2], a[3]); o.z = cvtpk(b[0], b[1]); o.w = cvtpk(b[2], b[3]);
        *(u32x4*)(dst + i * 8) = o;
    }
}
__device__ __forceinline__ void cvt_cache(const float* src, bf16_t* dst, size_t gt, size_t ngt) {
    const size_t n8 = (size_t)8 * 2048 * 512 / 8;
    for (size_t i = gt; i < n8; i += ngt) {
        const size_t e = i * 8; const size_t row = e >> 9, col = e & 511; const size_t drow = (row >> 11) * SKV + (row & 2047);
        const f32x4 a = *(const f32x4*)(src + e), b = *(const f32x4*)(src + e + 4);
        u32x4 o; o.x = cvtpk(a[0], a[1]); o.y = cvtpk(a[2], a[3]); o.z = cvtpk(b[0], b[1]); o.w = cvtpk(b[2], b[3]);
        *(u32x4*)(dst + drow * 512 + col) = o;
    }
}
__device__ __forceinline__ void rms_row_bf16(const float* xrow, const float* g, bf16_t* orow, int lane) {
    const f32x4* xr = (const f32x4*)xrow + lane; const f32x4* gr = (const f32x4*)g + lane;
    f32x4 v[4]; float s = 0.f;
#pragma unroll
    for (int j = 0; j < 4; ++j) { v[j] = xr[64 * j]; s += (v[j][0] * v[j][0] + v[j][1] * v[j][1]) + (v[j][2] * v[j][2] + v[j][3] * v[j][3]); }
    const float rstd = 1.f / sqrtf(wave_sum(s) * (1.f / DM) + EPS);
    u32x2* o8 = (u32x2*)orow + lane;
#pragma unroll
    for (int j = 0; j < 4; ++j) { const f32x4 gg = gr[64 * j]; u32x2 w; w.x = cvtpk(v[j][0] * rstd * gg[0], v[j][1] * rstd * gg[1]); w.y = cvtpk(v[j][2] * rstd * gg[2], v[j][3] * rstd * gg[3]); o8[64 * j] = w; }
}

template <bool SLICED> __device__ __forceinline__ void cvt_row_fp8(const float* src, unsigned char* dst_base, int row, float* scale_out, int lane) {
    const f32x4* xr = (const f32x4*)src + lane;
    f32x4 v[4]; float am = 0.f;
#pragma unroll
    for (int j = 0; j < 4; ++j) { v[j] = xr[64 * j]; am = fmaxf(am, fmaxf(fmaxf(fabsf(v[j][0]), fabsf(v[j][1])), fmaxf(fabsf(v[j][2]), fabsf(v[j][3])))); }
#pragma unroll
    for (int o = 1; o < 64; o <<= 1) am = fmaxf(am, __shfl_xor(am, o));
    const float sc = am > 0.f ? am * (1.f / 448.f) : 1.f, inv = 1.f / sc;
#pragma unroll
    for (int j = 0; j < 4; ++j) {
        const int eb = 256 * j + 4 * lane;
        int w = __builtin_amdgcn_cvt_pk_fp8_f32(v[j][0] * inv, v[j][1] * inv, 0, false);
        w = __builtin_amdgcn_cvt_pk_fp8_f32(v[j][2] * inv, v[j][3] * inv, w, true);
        if (SLICED) *(int*)(dst_base + ((size_t)(eb >> 7) * 16384 + row) * 128 + (eb & 127)) = w;
        else *(int*)(dst_base + (size_t)row * DM + 16 * ((eb & 511) >> 3) + (eb & 7) + (eb >= 512 ? 8 : 0)) = w;
    }
    if (lane == 0) *scale_out = sc;
}

__device__ __forceinline__ void phase0(const Params& p, LAS unsigned char* lds, int tid, int lane, int wave) {
    const int gw = blockIdx.x * 8 + wave, NGW = gridDim.x * 8;
    LAS float* scr = (LAS float*)(lds + wave * 16384);
    bf16_t* WINT = (bf16_t*)(p.ws + WS_WINT); bf16_t* WOUTT = (bf16_t*)(p.ws + WS_WOUTT); bf16_t* WQT = (bf16_t*)(p.ws + WS_WQT);
    constexpr int I_IN = 16 * (DIN / 32), I_OUT = 16 * (1024 / 32), I_Q = 16 * (2048 / 32);
    for (int it = gw; it < I_IN + I_OUT + I_Q; it += NGW) {
        int r = it;
        if (r < I_IN) { transpose_item<true>(p.in[6], 1024, DIN, WINT, scr, r, lane); continue; } r -= I_IN;
        if (r < I_OUT) { transpose_item<false>(p.in[17], 1024, 1024, WOUTT, scr, r, lane); continue; } r -= I_OUT;
        transpose_item<false>(p.in[19], 1024, 2048, WQT, scr, r, lane);
    }
    const size_t gt = (size_t)blockIdx.x * 512 + tid, ngt = (size_t)gridDim.x * 512;
    for (int r = gw; r < 2 * 16384; r += NGW) {
        const int tb = r >> 14, e = r & 16383;
        if (tb) cvt_row_fp8<true>(p.in[22] + (size_t)e * DM, p.ws + WS_PV8, e, (float*)(p.ws + WS_SCV) + e, lane);
        else cvt_row_fp8<true>(p.in[21] + (size_t)e * DM, p.ws + WS_PU8, e, (float*)(p.ws + WS_SCU) + e, lane);
    }
    cvt_stream(p.in[20], (bf16_t*)(p.ws + WS_SK), (size_t)16 * 128 * 128 / 8, gt, ngt);
    cvt_cache(p.in[2], (bf16_t*)(p.ws + WS_KS), gt, ngt);
    cvt_cache(p.in[3], (bf16_t*)(p.ws + WS_VS), gt, ngt);
    bf16_t* H = (bf16_t*)(p.ws + WS_H);
    for (int m = gw; m < NT; m += NGW) {
        const float* xr = m < NP ? p.in[0] + (size_t)m * DM : p.in[1] + (size_t)(m - NP) * DM;
        rms_row_bf16(xr, p.in[5], H + (size_t)m * DM, lane);
    }
}

namespace att {
constexpr int KPITCH = 272, VPITCH = 320;
constexpr int L_KV = 0, KV_BYTES = 64 * KPITCH + 64 * VPITCH  , L_X = 0  , L_BIAS = BIAS_OFF, L_CA = 0  , L_CW = 94 * 1024  ;
static_assert(4 * 4096 * 4 <= 2 * KV_BYTES && 2 * KV_BYTES <= L_CW && L_CW + 31 * 1024 <= RING_BYTES, "attention LDS map");

__device__ __forceinline__ int rel_bucket(int rel) {
    const int ret = rel > 0 ? 16 : 0; const int n = rel < 0 ? -rel : rel; int v;
    if (n < 8) v = n; else if (n < 12) v = 8; else if (n < 16) v = 9; else if (n < 23) v = 10; else if (n < 32) v = 11;
    else if (n < 46) v = 12; else if (n < 64) v = 13; else if (n < 91) v = 14; else v = 15;
    return ret + v;
}
typedef short v4i16_t __attribute__((ext_vector_type(4)));
__device__ __forceinline__ s16x4 vtr(const LAS unsigned char* p) { return __builtin_bit_cast(s16x4, __builtin_amdgcn_ds_read_tr16_b64_v4i16((LAS v4i16_t*)p)); }
__device__ __forceinline__ f32x16 mfma32(bf16x8 a, bf16x8 b, f32x16 c) { return __builtin_amdgcn_mfma_f32_32x32x16_bf16(a, b, c, 0, 0, 0); }

__device__ __forceinline__ void attn_unit(const Params& p, LAS unsigned char* lds, int kind, int bb, int h, int qblk, float lam, int tid, int lane, int wid) {
    const bf16_t* Q = (const bf16_t*)(p.ws + WS_Q);
    const bf16_t* Kb = kind == 0 ? (const bf16_t*)(p.ws + WS_KP) + (size_t)bb * 2048 * 512 + h * 128 : (const bf16_t*)(p.ws + WS_KS) + (size_t)bb * SKV * 512 + h * 128;
    const bf16_t* Vb = kind == 0 ? (const bf16_t*)(p.ws + WS_VP) + (size_t)bb * 2048 * 512 + h * 128 : (const bf16_t*)(p.ws + WS_VS) + (size_t)bb * SKV * 512 + h * 128;
    bf16_t* MIX = (bf16_t*)(p.ws + WS_MIX);
    const int qrow0 = kind == 0 ? bb * 2048 + qblk * 128 : NP + bb * 64;
    const int qpos0 = kind == 0 ? qblk * 128 : 2048;
    const int ntiles = kind == 0 ? 2 * qblk + 2 : 33;
    const int rg = wid & 3, map = wid >> 2, r32 = lane & 31, hi = lane >> 5;
    const bool active = kind == 0 ? true : (rg < 2);
    const int cw = kind == 0 ? 2 * qblk + (rg >> 1) : 32;
    const int qw0 = qpos0 + 32 * rg;
    const int qabs = qw0 + r32;

    bf16x8 qf[4];
    if (active) {
        const bf16_t* qp = Q + (size_t)(qrow0 + 32 * rg + r32) * 512 + h * 128 + map * 64 + 8 * hi;
#pragma unroll
        for (int s = 0; s < 4; ++s) qf[s] = *(const bf16x8*)(qp + 16 * s);
    } else {
#pragma unroll
        for (int s = 0; s < 4; ++s) qf[s] = (bf16x8){0, 0, 0, 0, 0, 0, 0, 0};
    }
    float m = -1e30f, l = 0.f;
    f32x16 o[4];
#pragma unroll
    for (int mt = 0; mt < 4; ++mt)
#pragma unroll
        for (int r = 0; r < 16; ++r) o[mt][r] = 0.f;

    const int srow0 = tid >> 4, sch = tid & 15;
    const LAS float* btab = (const LAS float*)(lds + L_BIAS) + h * 320;
    const float biasfar = btab[0];
    const int vlane = (4 * hi + ((lane & 15) >> 2)) * VPITCH + (16 * ((lane >> 4) & 1) + 4 * (lane & 3)) * 2;
    u32x4 kA[2], vA[2], kB[2], vB[2];
#define ATT_LOAD(KR, VR, T) do { _Pragma("unroll") for (int i_ = 0; i_ < 2; ++i_) { const size_t off_ = (size_t)((T) * 64 + srow0 + 32 * i_) * 512 + sch * 8; KR[i_] = *(const u32x4*)(Kb + off_); VR[i_] = *(const u32x4*)(Vb + off_); } } while (0)
#define ATT_STORE(KR, VR, BUF) do { _Pragma("unroll") for (int i_ = 0; i_ < 2; ++i_) { \
        *(LAS u32x4*)(lds + L_KV + (BUF) * KV_BYTES + (srow0 + 32 * i_) * KPITCH + sch * 16) = KR[i_]; \
        *(LAS u32x4*)(lds + L_KV + (BUF) * KV_BYTES + 64 * KPITCH + (srow0 + 32 * i_) * VPITCH + sch * 16) = VR[i_]; } } while (0)
    auto compute = [&](int t, int buf) {
        const LAS unsigned char* kbuf = lds + L_KV + buf * KV_BYTES;
        const LAS unsigned char* vbuf = kbuf + 64 * KPITCH;
        f32x16 p0, p1;
        const int kabs0 = t * 64;
        if (kabs0 + 63 - qw0 > -128) {
            const LAS float* bt = btab + (kabs0 - qabs + 256 + 4 * hi);
#pragma unroll
            for (int r = 0; r < 16; ++r) { p0[r] = bt[(r & 3) + 8 * (r >> 2)]; p1[r] = bt[32 + (r & 3) + 8 * (r >> 2)]; }
        } else {
#pragma unroll
            for (int r = 0; r < 16; ++r) { p0[r] = biasfar; p1[r] = biasfar; }
        }
        const LAS unsigned char* kb = kbuf + r32 * KPITCH + (map * 8 + hi) * 16;
#pragma unroll
        for (int s = 0; s < 4; ++s) {
            const bf16x8 a0 = *(const LAS bf16x8*)(kb + s * 32), a1 = *(const LAS bf16x8*)(kb + 32 * KPITCH + s * 32);
            p0 = mfma32(a0, qf[s], p0); p1 = mfma32(a1, qf[s], p1);
        }
        __builtin_amdgcn_sched_barrier(0);
        float mx = fmaxf(p0[0], p1[0]);
#pragma unroll
        for (int r = 1; r < 16; ++r) mx = fmaxf(mx, fmaxf(p0[r], p1[r]));
        mx = fmaxf(mx, __shfl_xor(mx, 32));
        const float mn = fmaxf(m, mx);
        const float alpha = __builtin_amdgcn_exp2f(m - mn);
        m = mn;
        float rs = 0.f;
#pragma unroll
        for (int r = 0; r < 16; ++r) { p0[r] = __builtin_amdgcn_exp2f(p0[r] - mn); p1[r] = __builtin_amdgcn_exp2f(p1[r] - mn); rs += p0[r] + p1[r]; }
        l = l * alpha + rs;
#pragma unroll
        for (int mt = 0; mt < 4; ++mt)
#pragma unroll
            for (int r = 0; r < 16; ++r) o[mt][r] *= alpha;
        __builtin_amdgcn_sched_barrier(0);
#pragma unroll
        for (int t2 = 0; t2 < 2; ++t2)
#pragma unroll
            for (int s = 0; s < 2; ++s) {
                u32x4 bw;
                if (t2 == 0) { bw.x = cvtpk(p0[8 * s + 0], p0[8 * s + 1]); bw.y = cvtpk(p0[8 * s + 2], p0[8 * s + 3]); bw.z = cvtpk(p0[8 * s + 4], p0[8 * s + 5]); bw.w = cvtpk(p0[8 * s + 6], p0[8 * s + 7]); }
                else { bw.x = cvtpk(p1[8 * s + 0], p1[8 * s + 1]); bw.y = cvtpk(p1[8 * s + 2], p1[8 * s + 3]); bw.z = cvtpk(p1[8 * s + 4], p1[8 * s + 5]); bw.w = cvtpk(p1[8 * s + 6], p1[8 * s + 7]); }
                const bf16x8 B = __builtin_bit_cast(bf16x8, bw);
                const LAS unsigned char* vb = vbuf + vlane + (32 * t2 + 16 * s) * VPITCH;
#pragma unroll
                for (int mt = 0; mt < 4; ++mt) {
                    const s16x4 lo = vtr(vb + mt * 64), hi8 = vtr(vb + mt * 64 + 8 * VPITCH);
                    const bf16x8 A = (bf16x8){lo[0], lo[1], lo[2], lo[3], hi8[0], hi8[1], hi8[2], hi8[3]};
                    o[mt] = mfma32(A, B, o[mt]);
                }
            }
    };
    ATT_LOAD(kA, vA, 0);
    if (ntiles > 1) ATT_LOAD(kB, vB, 1);
    ATT_STORE(kA, vA, 0);
    if (ntiles > 2) ATT_LOAD(kA, vA, 2);
    __syncthreads();
    for (int t = 0; t < ntiles; t += 2) {
        if (t + 1 < ntiles) { ATT_STORE(kB, vB, 1); if (t + 3 < ntiles) ATT_LOAD(kB, vB, t + 3); }
        if (active && t <= cw) compute(t, 0);
        __syncthreads();
        if (t + 1 >= ntiles) break;
        if (t + 2 < ntiles) { ATT_STORE(kA, vA, 0); if (t + 4 < ntiles) ATT_LOAD(kA, vA, t + 4); }
        if (active && t + 1 <= cw) compute(t + 1, 1);
        __syncthreads();
    }
#undef ATT_LOAD
#undef ATT_STORE
    l += __shfl_xor(l, 32);
    const float inv = 1.f / l;
    LAS float* X = (LAS float*)(lds + L_X) + rg * 4096;
    if (active && map == 1) {
        const float sc = -lam * inv;
#pragma unroll
        for (int mt = 0; mt < 4; ++mt)
#pragma unroll
            for (int r = 0; r < 16; ++r) X[(mt * 16 + r) * 64 + lane] = o[mt][r] * sc;
    }
    __syncthreads();
    if (active && map == 0) {
        float ss = 0.f;
#pragma unroll
        for (int mt = 0; mt < 4; ++mt)
#pragma unroll
            for (int r = 0; r < 16; ++r) { const float v = o[mt][r] * inv + X[(mt * 16 + r) * 64 + lane]; o[mt][r] = v; ss += v * v; }
        ss += __shfl_xor(ss, 32);
        const float rsn = 0.8f / sqrtf(ss * (1.f / 128.f) + EPS);
        bf16_t* orow = MIX + (size_t)(qrow0 + 32 * rg + r32) * 1024 + 512 + h * 128;
        const float* sg = p.in[15];
#pragma unroll
        for (int mt = 0; mt < 4; ++mt)
#pragma unroll
            for (int g4 = 0; g4 < 4; ++g4) {
                const int e = 32 * mt + 8 * g4 + 4 * hi;
                const f32x4 gg = *(const f32x4*)(sg + e);
                u32x2 w; w.x = cvtpk(o[mt][4 * g4 + 0] * rsn * gg[0], o[mt][4 * g4 + 1] * rsn * gg[1]); w.y = cvtpk(o[mt][4 * g4 + 2] * rsn * gg[2], o[mt][4 * g4 + 3] * rsn * gg[3]);
                *(u32x2*)(orow + e) = w;
            }
    }
    __syncthreads();
}

__device__ __forceinline__ void unpack8(const u32x4 w, float (&f)[8]) { f[0] = bflo(w.x); f[1] = bfhi(w.x); f[2] = bflo(w.y); f[3] = bfhi(w.y); f[4] = bflo(w.z); f[5] = bfhi(w.z); f[6] = bflo(w.w); f[7] = bfhi(w.w); }
__device__ __forceinline__ void conv_unit(const Params& p, LAS unsigned char* lds, int cu, int tid, int lane, int wid) {
    const bf16_t* A = (const bf16_t*)(p.ws + WS_A);
    bf16_t* MIX = (bf16_t*)(p.ws + WS_MIX);
    const float* cb = p.in[8]; const float* lg = p.in[9]; const float* lb = p.in[10]; const float* st = p.in[4];
    const int row0 = cu * 64;
    const bool isp = row0 < NP;
    const int s0 = isp ? (row0 & 2047) : 0, rbase = row0 - s0, bd = isp ? 0 : ((row0 - NP) >> 6);
    for (int c = tid; c < 94 * 64; c += 512) {
        const int rr = c >> 6, ch = c & 63, sp = s0 - 30 + rr;
        u32x4 v = (u32x4){0u, 0u, 0u, 0u};
        if (sp >= 0) v = *(const u32x4*)(A + (size_t)(rbase + sp) * 512 + ch * 8);
        else if (!isp) { const float* sr = st + ((size_t)bd * 30 + (30 + sp)) * 512 + ch * 8; const f32x4 a0 = *(const f32x4*)sr, a1 = *(const f32x4*)(sr + 4);
            v.x = cvtpk(a0[0], a0[1]); v.y = cvtpk(a0[2], a0[3]); v.z = cvtpk(a1[0], a1[1]); v.w = cvtpk(a1[2], a1[3]); }
        *(LAS u32x4*)(lds + L_CA + rr * 1024 + ch * 16) = v;
    }
    __syncthreads();
    const int c0 = lane * 8;
    float bias8[8], g8[8], b8[8];
    { const f32x4 x0 = *(const f32x4*)(cb + c0), x1 = *(const f32x4*)(cb + c0 + 4), y0 = *(const f32x4*)(lg + c0), y1 = *(const f32x4*)(lg + c0 + 4), z0 = *(const f32x4*)(lb + c0), z1 = *(const f32x4*)(lb + c0 + 4);
#pragma unroll
      for (int q = 0; q < 4; ++q) { bias8[q] = x0[q]; bias8[4 + q] = x1[q]; g8[q] = y0[q]; g8[4 + q] = y1[q]; b8[q] = z0[q]; b8[4 + q] = z1[q]; } }
    for (int grp = 0; grp < 2; ++grp) {
        const int t0 = wid * 8 + grp * 4;
        float acc[4][8];
#pragma unroll
        for (int q = 0; q < 4; ++q)
#pragma unroll
            for (int c = 0; c < 8; ++c) acc[q][c] = bias8[c];
        const LAS unsigned char* ap = lds + L_CA + t0 * 1024 + lane * 16;
        const LAS unsigned char* wp = lds + L_CW + lane * 16;
#pragma unroll 1
        for (int j = 0; j < 31; ++j) {
            float w[8]; unpack8(*(const LAS u32x4*)(wp + j * 1024), w);
#pragma unroll
            for (int q = 0; q < 4; ++q) {
                float a[8]; unpack8(*(const LAS u32x4*)(ap + (j + q) * 1024), a);
#pragma unroll
                for (int c = 0; c < 8; ++c) acc[q][c] += w[c] * a[c];
            }
        }
#pragma unroll
        for (int q = 0; q < 4; ++q) {
            float sm = 0.f;
#pragma unroll
            for (int c = 0; c < 8; ++c) sm += acc[q][c];
            const float mu = wave_total(sm) * (1.f / 512.f);
            float sv = 0.f;
#pragma unroll
            for (int c = 0; c < 8; ++c) { acc[q][c] -= mu; sv += acc[q][c] * acc[q][c]; }
            const float rstd = 1.f / sqrtf(wave_total(sv) * (1.f / 512.f) + EPS);
            float y[8];
#pragma unroll
            for (int c = 0; c < 8; ++c) { y[c] = acc[q][c] * rstd * g8[c] + b8[c]; y[c] = y[c] / (1.f + __expf(-y[c])); }
            u32x4 w; w.x = cvtpk(y[0], y[1]); w.y = cvtpk(y[2], y[3]); w.z = cvtpk(y[4], y[5]); w.w = cvtpk(y[6], y[7]);
            *(u32x4*)(MIX + (size_t)(row0 + t0 + q) * 1024 + c0) = w;
        }
    }
}

constexpr int N_SAMPLE_UNITS = 32, N_PROMPT_UNITS = 1024, N_CONV_UNITS = NT / 64, N_UNITS = N_SAMPLE_UNITS + N_PROMPT_UNITS + N_CONV_UNITS;

__device__ __forceinline__ void phase2(const Params& p, LAS unsigned char* lds, int tid, int lane, int wid, int cidx, int mode) {
    LAS float* bt = (LAS float*)(lds + L_BIAS);
    for (int e = tid; e < 4 * 320; e += 512) { const int hh = e / 320, rel = (e % 320) - 256; bt[e] = p.in[16][rel_bucket(rel) * 4 + hh] * LOG2E; }
    for (int c = tid; c < 31 * 64; c += 512) {
        const float* wr = p.in[7] + (size_t)c * 8; const f32x4 a0 = *(const f32x4*)wr, a1 = *(const f32x4*)(wr + 4);
        u32x4 v; v.x = cvtpk(a0[0], a0[1]); v.y = cvtpk(a0[2], a0[3]); v.z = cvtpk(a1[0], a1[1]); v.w = cvtpk(a1[2], a1[3]);
        *(LAS u32x4*)(lds + L_CW + c * 16) = v;
    }
    const float d1 = wave_sum(p.in[11][lane] * p.in[12][lane]), d2 = wave_sum(p.in[13][lane] * p.in[14][lane]);
    const float lam = expf(d1) - expf(d2) + 0.2f;
    unsigned* ctr = (unsigned*)(p.ws + WS_CTL) + 64 * cidx;
    volatile LAS unsigned* sw = (volatile LAS unsigned*)(lds + MISC_OFF);
    __syncthreads();
    for (;;) {
        __syncthreads();
        if (tid == 0) sw[0] = atomicAdd(ctr, 1u);
        __syncthreads();
        const int u = (int)sw[0];
        if (u >= N_UNITS) break;
        if (mode == 1 && u >= N_SAMPLE_UNITS + N_PROMPT_UNITS) continue;
        if (mode == 2 && u < N_SAMPLE_UNITS + N_PROMPT_UNITS) continue;
        int tid_ = tid; asm volatile("" : "+v"(tid_));
        if (u < N_SAMPLE_UNITS + N_PROMPT_UNITS) {
            const int v = u - N_SAMPLE_UNITS; const int bh = v & 63; const bool smp = u < N_SAMPLE_UNITS;
            attn_unit(p, lds, smp ? 1 : 0, smp ? (u >> 2) : (bh >> 2), smp ? (u & 3) : (bh & 3), smp ? 0 : 15 - (v >> 6), lam, tid_, tid_ & 63, wid);
        } else conv_unit(p, lds, u - N_SAMPLE_UNITS - N_PROMPT_UNITS, tid_, tid_ & 63, wid);
    }
}
}

__device__ __forceinline__ void phase3b(const Params& p, int lane, int wave) {
    const int gw = blockIdx.x * 8 + wave, NGW = gridDim.x * 8;
    bf16_t* H2 = (bf16_t*)(p.ws + WS_H2);
    for (int m = gw; m < NT; m += NGW) rms_row_bf16(p.out + (size_t)m * DM, p.in[18], H2 + (size_t)m * DM, lane);
}

constexpr int P4B_KPITCH = 272, P4B_K_BYTES = 128 * P4B_KPITCH, P4B_Q_BYTES = 32 * P4B_KPITCH;
static_assert(P4B_K_BYTES + 8 * P4B_Q_BYTES <= RING_BYTES, "P4b LDS map");
__device__ __forceinline__ void phase4b(const Params& p, LAS unsigned char* lds, int tid, int lane, int wave) {
    const bf16_t* QP = (const bf16_t*)(p.ws + WS_QP); const bf16_t* SK = (const bf16_t*)(p.ws + WS_SK);
    float* TK = (float*)(p.ws + WS_TK);
    const int r32 = lane & 31, hi = lane >> 5;
    const int G = gridDim.x;
    for (int rp = blockIdx.x & 15; rp < 16; rp += (G < 16 ? G : 16)) {
        const int nbr = (G - rp + 15) >> 4, member = (int)blockIdx.x >> 4;
        __syncthreads();
        for (int c = tid; c < 128 * 16; c += 512) { const int row = c >> 4, ch = c & 15; *(LAS u32x4*)(lds + row * P4B_KPITCH + ch * 16) = *(const u32x4*)(SK + ((size_t)rp * 128 + row) * 128 + ch * 8); }
        __syncthreads();
        LAS unsigned char* qs = lds + P4B_K_BYTES + wave * P4B_Q_BYTES;
        for (int tg = member * 8 + wave; tg < NT / 32; tg += nbr * 8) {
            const int t0 = tg * 32;
#pragma unroll
            for (int i = 0; i < 8; ++i) { const int row = 4 * i + (lane >> 4), ch = lane & 15; *(LAS u32x4*)(qs + row * P4B_KPITCH + ch * 16) = *(const u32x4*)(QP + (size_t)(t0 + row) * 2048 + rp * 128 + ch * 8); }
            bf16x8 qf[8];
#pragma unroll
            for (int s = 0; s < 8; ++s) qf[s] = *(const LAS bf16x8*)(qs + r32 * P4B_KPITCH + (2 * s + hi) * 16);
            float v[64];
#pragma unroll
            for (int mt = 0; mt < 4; ++mt) {
                f32x16 S;
#pragma unroll
                for (int r = 0; r < 16; ++r) S[r] = 0.f;
                const LAS unsigned char* kp = lds + (32 * mt + r32) * P4B_KPITCH + hi * 16;
#pragma unroll
                for (int s = 0; s < 8; ++s) S = att::mfma32(*(const LAS bf16x8*)(kp + s * 32), qf[s], S);
#pragma unroll
                for (int r = 0; r < 16; ++r) { const int n = 32 * mt + (r & 3) + 8 * (r >> 2) + 4 * hi; v[mt * 16 + r] = __uint_as_float((__float_as_uint(S[r]) & ~127u) | (unsigned)(127 - n)); }
            }
            SORT16_DESC(v, 0); SORT16_DESC(v, 16); SORT16_DESC(v, 32); SORT16_DESC(v, 48);
#pragma unroll
            for (int i = 0; i < 16; ++i) { v[i] = fmaxf(v[i], v[31 - i]); v[32 + i] = fmaxf(v[32 + i], v[63 - i]); }
            BITONIC16_DESC(v, 0); BITONIC16_DESC(v, 32);
#pragma unroll
            for (int i = 0; i < 16; ++i) v[i] = fmaxf(v[i], v[47 - i]);
            BITONIC16_DESC(v, 0);
            float w[16];
#pragma unroll
            for (int i = 0; i < 16; ++i) w[i] = fmaxf(v[i], __shfl_xor(v[15 - i], 32));
            BITONIC16_DESC(w, 0);
            if (hi == 0) {
                f32x4* dst = (f32x4*)(TK + ((size_t)(t0 + r32) * 16 + rp) * 16);
#pragma unroll
                for (int q = 0; q < 4; ++q) dst[q] = (f32x4){w[4 * q], w[4 * q + 1], w[4 * q + 2], w[4 * q + 3]};
            }
        }
    }
}

__device__ __forceinline__ void phase5a(const Params& p, int tid) {
    const float* TK = (const float*)(p.ws + WS_TK);
    int* IDX = (int*)(p.ws + WS_IDX); float* GATE = (float*)(p.ws + WS_GATE);
    const float NEG_INF = -__builtin_huge_valf();
    for (int item = blockIdx.x * 512 + tid; item < NT * 8; item += gridDim.x * 512) {
        const int tok = item >> 3, r = item & 7;
        const f32x4* pa = (const f32x4*)(TK + ((size_t)tok * 16 + 2 * r) * 16);
        float a[16], b[16]; int ia[16], ib[16];
#pragma unroll
        for (int q = 0; q < 4; ++q) { const f32x4 x = pa[q], y = pa[4 + q];
#pragma unroll
            for (int j = 0; j < 4; ++j) { a[4 * q + j] = x[j]; b[4 * q + j] = y[j]; } }
#pragma unroll
        for (int i = 0; i < 16; ++i) { const unsigned ua = __float_as_uint(a[i]), ub = __float_as_uint(b[i]); ia[i] = 127 - (int)(ua & 127u); ib[i] = 127 - (int)(ub & 127u); a[i] = __uint_as_float(ua & ~127u); b[i] = __uint_as_float(ub & ~127u); }
        float cv[50]; int cid[50];
        {
            int c = 0;
#pragma unroll
            for (int i = 0; i < 16; ++i)
#pragma unroll
                for (int j = 0; j < 16; ++j)
                    if ((i + 1) * (j + 1) <= 16) { const float s = a[i] + b[j]; cv[c] = __uint_as_float((__float_as_uint(s) & ~63u) | (unsigned)(63 - c)); cid[c] = ia[i] * 128 + ib[j]; ++c; }
        }
        float best[16]; int bid[16];
#pragma unroll
        for (int it = 0; it < 16; ++it) {
            float mx = cv[0];
#pragma unroll
            for (int c = 1; c < 50; ++c) mx = fmaxf(mx, cv[c]);
            int id = 0;
#pragma unroll
            for (int c = 0; c < 50; ++c) { const bool hit = cv[c] == mx; id = hit ? cid[c] : id; cv[c] = hit ? NEG_INF : cv[c]; }
            best[it] = __uint_as_float(__float_as_uint(mx) & ~63u); bid[it] = id;
        }
        float e[16], sum = 0.f;
#pragma unroll
        for (int k = 0; k < 16; ++k) { e[k] = __expf(best[k] - best[0]); sum += e[k]; }
        const float rinv = 1.f / sum;
        int* io = IDX + (size_t)tok * 128 + r * 16; float* go = GATE + (size_t)tok * 128 + r * 16;
#pragma unroll
        for (int k = 0; k < 16; ++k) { io[k] = bid[k]; go[k] = e[k] * rinv; }
    }
}

__device__ __forceinline__ float gelu_erf(float x) { return 0.5f * x * (1.f + erff(x * 0.70710678118654752f)); }
__device__ __forceinline__ void fp8x16_to_f32(const u32x4 q, float (&f)[16]) {
    const f32x2 c0 = __builtin_amdgcn_cvt_pk_f32_fp8(q.x, false), c1 = __builtin_amdgcn_cvt_pk_f32_fp8(q.x, true), c2 = __builtin_amdgcn_cvt_pk_f32_fp8(q.y, false), c3 = __builtin_amdgcn_cvt_pk_f32_fp8(q.y, true);
    const f32x2 c4 = __builtin_amdgcn_cvt_pk_f32_fp8(q.z, false), c5 = __builtin_amdgcn_cvt_pk_f32_fp8(q.z, true), c6 = __builtin_amdgcn_cvt_pk_f32_fp8(q.w, false), c7 = __builtin_amdgcn_cvt_pk_f32_fp8(q.w, true);
    f[0] = c0.x; f[1] = c0.y; f[2] = c1.x; f[3] = c1.y; f[4] = c2.x; f[5] = c2.y; f[6] = c3.x; f[7] = c3.y;
    f[8] = c4.x; f[9] = c4.y; f[10] = c5.x; f[11] = c5.y; f[12] = c6.x; f[13] = c6.y; f[14] = c7.x; f[15] = c7.y;
}
__device__ __forceinline__ void slice_group(int& x, int& gwx, int& nwx, int wave) {
    x = blockIdx.x & 7; const int nbx = ((int)gridDim.x - x + 7) >> 3; gwx = ((int)blockIdx.x >> 3) * 8 + wave; nwx = nbx * 8;
}
__device__ __forceinline__ void phase5u(const Params& p, LAS unsigned char* lds, int lane, int wave) {
    int x, gwx, nwx; slice_group(x, gwx, nwx, wave);
    const unsigned char* PU8 = p.ws + WS_PU8 + (size_t)x * 16384 * 128;
    const bf16_t* H2 = (const bf16_t*)(p.ws + WS_H2) + 128 * x;
    const int* IDX = (const int*)(p.ws + WS_IDX); float* PACT = (float*)(p.ws + WS_PACT) + (size_t)x * NT * 128;
    LAS int* l_idx = (LAS int*)(lds + wave * 512);
    const int g = lane >> 3, sub = lane & 7;
    const unsigned char* rowp = PU8 + sub * 16;
    int r_idxA = 0, r_idxB = 0;
    u32x4 hA0, hA1, hB0, hB1; hA0 = hA1 = hB0 = hB1 = (u32x4){0u, 0u, 0u, 0u};
    u32x4 qA[16], qB[16];
#define P5U_LOADIDX(T) do { if ((T) < NT) { r_idxA = IDX[(size_t)(T) * 128 + lane]; r_idxB = IDX[(size_t)(T) * 128 + 64 + lane]; } } while (0)
#define P5U_ISSUE(Q, H0, H1, T) do { if ((T) < NT) { l_idx[lane] = r_idxA; l_idx[64 + lane] = r_idxB; \
        H0 = *(const u32x4*)(H2 + (size_t)(T) * DM + 16 * sub); H1 = *(const u32x4*)(H2 + (size_t)(T) * DM + 16 * sub + 8); \
        _Pragma("unroll") for (int q_ = 0; q_ < 4; ++q_) { const u32x4 iv = *(const LAS u32x4*)(l_idx + 16 * g + 4 * q_); \
            Q[4 * q_] = *(const u32x4*)(rowp + (size_t)iv.x * 128); Q[4 * q_ + 1] = *(const u32x4*)(rowp + (size_t)iv.y * 128); \
            Q[4 * q_ + 2] = *(const u32x4*)(rowp + (size_t)iv.z * 128); Q[4 * q_ + 3] = *(const u32x4*)(rowp + (size_t)iv.w * 128); } } } while (0)
#define P5U_COMPUTE(Q, H0, H1, T) do { \
        f32x2 hf[8]; \
        hf[0] = (f32x2){bflo(H0.x), bfhi(H0.x)}; hf[1] = (f32x2){bflo(H0.y), bfhi(H0.y)}; hf[2] = (f32x2){bflo(H0.z), bfhi(H0.z)}; hf[3] = (f32x2){bflo(H0.w), bfhi(H0.w)}; \
        hf[4] = (f32x2){bflo(H1.x), bfhi(H1.x)}; hf[5] = (f32x2){bflo(H1.y), bfhi(H1.y)}; hf[6] = (f32x2){bflo(H1.z), bfhi(H1.z)}; hf[7] = (f32x2){bflo(H1.w), bfhi(H1.w)}; \
        float resA = 0.f, resB = 0.f; \
        _Pragma("unroll") for (int i = 0; i < 16; ++i) { \
            f32x2 s2 = __builtin_amdgcn_cvt_pk_f32_fp8(Q[i].x, false) * hf[0]; \
            s2 = __builtin_elementwise_fma(__builtin_amdgcn_cvt_pk_f32_fp8(Q[i].x, true), hf[1], s2); \
            s2 = __builtin_elementwise_fma(__builtin_amdgcn_cvt_pk_f32_fp8(Q[i].y, false), hf[2], s2); \
            s2 = __builtin_elementwise_fma(__builtin_amdgcn_cvt_pk_f32_fp8(Q[i].y, true), hf[3], s2); \
            s2 = __builtin_elementwise_fma(__builtin_amdgcn_cvt_pk_f32_fp8(Q[i].z, false), hf[4], s2); \
            s2 = __builtin_elementwise_fma(__builtin_amdgcn_cvt_pk_f32_fp8(Q[i].z, true), hf[5], s2); \
            s2 = __builtin_elementwise_fma(__builtin_amdgcn_cvt_pk_f32_fp8(Q[i].w, false), hf[6], s2); \
            s2 = __builtin_elementwise_fma(__builtin_amdgcn_cvt_pk_f32_fp8(Q[i].w, true), hf[7], s2); \
            float sr = s2.x + s2.y; \
            DPP_ADD(sr, 0xB1); DPP_ADD(sr, 0x4E); DPP_ADD(sr, 0x141); \
            if (i < 8) resA = (sub == i) ? sr : resA; else resB = (sub == i - 8) ? sr : resB; } \
        PACT[(size_t)(T) * 128 + 16 * g + sub] = resA; PACT[(size_t)(T) * 128 + 16 * g + 8 + sub] = resB; } while (0)
    int tok = gwx;
    P5U_LOADIDX(tok);
    P5U_ISSUE(qA, hA0, hA1, tok);
    P5U_LOADIDX(tok + nwx);
    for (; tok < NT; tok += 2 * nwx) {
        P5U_ISSUE(qB, hB0, hB1, tok + nwx);
        P5U_LOADIDX(tok + 2 * nwx);
        P5U_COMPUTE(qA, hA0, hA1, tok);
        if (tok + nwx >= NT) break;
        P5U_ISSUE(qA, hA0, hA1, tok + 2 * nwx);
        P5U_LOADIDX(tok + 3 * nwx);
        P5U_COMPUTE(qB, hB0, hB1, tok + nwx);
    }
#undef P5U_LOADIDX
#undef P5U_ISSUE
#undef P5U_COMPUTE
}
__device__ __forceinline__ void phase5c(const Params& p, int tid) {
    const float* PACT = (const float*)(p.ws + WS_PACT); const float* SCU = (const float*)(p.ws + WS_SCU); const float* SCV = (const float*)(p.ws + WS_SCV);
    const int* IDX = (const int*)(p.ws + WS_IDX); const float* GATE = (const float*)(p.ws + WS_GATE); float* COEF = (float*)(p.ws + WS_COEF);
    const size_t n = (size_t)NT * 128;
    for (size_t it = (size_t)blockIdx.x * 512 + tid; it < n; it += (size_t)gridDim.x * 512) {
        float a = 0.f;
#pragma unroll
        for (int xx = 0; xx < 8; ++xx) a += PACT[(size_t)xx * n + it];
        const int e = IDX[it];
        COEF[it] = GATE[it] * gelu_erf(a * SCU[e]) * SCV[e];
    }
}

constexpr int P5V_LDS_PER_WAVE = 1024 + 8 * 136 * 4;
__device__ __forceinline__ void phase5v(const Params& p, LAS unsigned char* lds, int lane, int wave) {
    int x, gwx, nwx; slice_group(x, gwx, nwx, wave);
    const unsigned char* PV8 = p.ws + WS_PV8 + (size_t)x * 16384 * 128;
    const int* IDX = (const int*)(p.ws + WS_IDX); const float* COEF = (const float*)(p.ws + WS_COEF);
    LAS int* l_idx = (LAS int*)(lds + wave * P5V_LDS_PER_WAVE); LAS float* l_cf = (LAS float*)(l_idx + 128); LAS float* red = l_cf + 128;
    const int g = lane >> 3, sub = lane & 7;
    const unsigned char* rowp = PV8 + sub * 16;
    const int c1 = 16 * (lane & 7) + (lane >> 3);
    int r_idxA = 0, r_idxB = 0; float r_cA = 0.f, r_cB = 0.f;
    u32x4 qA[16], qB[16]; f32x4 cfA[4], cfB[4]; float xA0 = 0.f, xA1 = 0.f, xB0 = 0.f, xB1 = 0.f;
#define P5V_LOADIDX(T) do { if ((T) < NT) { r_idxA = IDX[(size_t)(T) * 128 + lane]; r_idxB = IDX[(size_t)(T) * 128 + 64 + lane]; r_cA = COEF[(size_t)(T) * 128 + lane]; r_cB = COEF[(size_t)(T) * 128 + 64 + lane]; } } while (0)
#define P5V_ISSUE(Q, CF, X0, X1, T) do { if ((T) < NT) { l_idx[lane] = r_idxA; l_idx[64 + lane] = r_idxB; l_cf[lane] = r_cA; l_cf[64 + lane] = r_cB; \
        { const float* xr_ = p.out + (size_t)(T) * DM + 128 * x; X0 = xr_[c1]; X1 = xr_[c1 + 8]; } \
        _Pragma("unroll") for (int q_ = 0; q_ < 4; ++q_) { const u32x4 iv = *(const LAS u32x4*)(l_idx + 16 * g + 4 * q_); CF[q_] = *(const LAS f32x4*)(l_cf + 16 * g + 4 * q_); \
            Q[4 * q_] = *(const u32x4*)(rowp + (size_t)iv.x * 128); Q[4 * q_ + 1] = *(const u32x4*)(rowp + (size_t)iv.y * 128); \
            Q[4 * q_ + 2] = *(const u32x4*)(rowp + (size_t)iv.z * 128); Q[4 * q_ + 3] = *(const u32x4*)(rowp + (size_t)iv.w * 128); } } } while (0)
#define P5V_COMPUTE(Q, CF, X0, X1, T) do { \
        f32x2 acc[8]; \
        _Pragma("unroll") for (int j = 0; j < 8; ++j) acc[j] = (f32x2){0.f, 0.f}; \
        _Pragma("unroll") for (int i = 0; i < 16; ++i) { \
            const float cs_ = CF[i >> 2][i & 3]; const f32x2 c2 = (f32x2){cs_, cs_}; \
            acc[0] = __builtin_elementwise_fma(__builtin_amdgcn_cvt_pk_f32_fp8(Q[i].x, false), c2, acc[0]); \
            acc[1] = __builtin_elementwise_fma(__builtin_amdgcn_cvt_pk_f32_fp8(Q[i].x, true), c2, acc[1]); \
            acc[2] = __builtin_elementwise_fma(__builtin_amdgcn_cvt_pk_f32_fp8(Q[i].y, false), c2, acc[2]); \
            acc[3] = __builtin_elementwise_fma(__builtin_amdgcn_cvt_pk_f32_fp8(Q[i].y, true), c2, acc[3]); \
            acc[4] = __builtin_elementwise_fma(__builtin_amdgcn_cvt_pk_f32_fp8(Q[i].z, false), c2, acc[4]); \
            acc[5] = __builtin_elementwise_fma(__builtin_amdgcn_cvt_pk_f32_fp8(Q[i].z, true), c2, acc[5]); \
            acc[6] = __builtin_elementwise_fma(__builtin_amdgcn_cvt_pk_f32_fp8(Q[i].w, false), c2, acc[6]); \
            acc[7] = __builtin_elementwise_fma(__builtin_amdgcn_cvt_pk_f32_fp8(Q[i].w, true), c2, acc[7]); } \
        _Pragma("unroll") for (int j = 0; j < 8; ++j) { red[g * 136 + (2 * j) * 8 + sub] = acc[j].x; red[g * 136 + (2 * j + 1) * 8 + sub] = acc[j].y; } \
        float s1 = X0, s2_ = X1; \
        _Pragma("unroll") for (int gg = 0; gg < 8; ++gg) { s1 += red[gg * 136 + lane]; s2_ += red[gg * 136 + 64 + lane]; } \
        { float* xr_ = p.out + (size_t)(T) * DM + 128 * x; xr_[c1] = s1; xr_[c1 + 8] = s2_; } } while (0)
    int tok = gwx;
    P5V_LOADIDX(tok);
    P5V_ISSUE(qA, cfA, xA0, xA1, tok);
    P5V_LOADIDX(tok + nwx);
    for (; tok < NT; tok += 2 * nwx) {
        P5V_ISSUE(qB, cfB, xB0, xB1, tok + nwx);
        P5V_LOADIDX(tok + 2 * nwx);
        P5V_COMPUTE(qA, cfA, xA0, xA1, tok);
        if (tok + nwx >= NT) break;
        P5V_ISSUE(qA, cfA, xA0, xA1, tok + 2 * nwx);
        P5V_LOADIDX(tok + 3 * nwx);
        P5V_COMPUTE(qB, cfB, xB0, xB1, tok + nwx);
    }
#undef P5V_LOADIDX
#undef P5V_ISSUE
#undef P5V_COMPUTE
}

__device__ __forceinline__ void phase6(const Params& p, int lane, int wave) {
    const int gw = blockIdx.x * 8 + wave, NGW = gridDim.x * 8;
    const f32x4* gr = (const f32x4*)p.in[23] + lane;
    for (int m = gw; m < NT; m += NGW) {
        f32x4* xr = (f32x4*)(p.out + (size_t)m * DM) + lane;
        f32x4 v[4]; float s = 0.f;
#pragma unroll
        for (int j = 0; j < 4; ++j) { v[j] = xr[64 * j]; s += (v[j][0] * v[j][0] + v[j][1] * v[j][1]) + (v[j][2] * v[j][2] + v[j][3] * v[j][3]); }
        const float rstd = 1.f / sqrtf(wave_total(s) * (1.f / DM) + EPS);
#pragma unroll
        for (int j = 0; j < 4; ++j) xr[64 * j] = v[j] * rstd * gr[64 * j];
    }
}

__global__ void __launch_bounds__(512, 2) fwd_megakernel(Params p) {
    extern __shared__ __attribute__((aligned(16))) unsigned char lds_raw[];
    LAS unsigned char* lds = (LAS unsigned char*)lds_raw;
    cg::grid_group grid = cg::this_grid();
    const int tid = threadIdx.x, lane = tid & 63, wave = __builtin_amdgcn_readfirstlane(tid >> 6);
    const int G = gridDim.x;
    volatile LAS unsigned* MISC = (volatile LAS unsigned*)(lds + MISC_OFF);
    if (tid < 32) MISC[tid] = 0u;
    __syncthreads();
    XcdBarrier bar = xcd_barrier_post((unsigned*)(p.ws + WS_CTL) + 4096, MISC + 8);
#define GSYNC() xcd_barrier(bar)

#ifndef RPT_MASK
#define RPT_MASK 0
#endif
#define RPT(bit) for (int rpt_ = 0; rpt_ < (((RPT_MASK) >> (bit)) & 1) + 1; ++rpt_)
    RPT(0) { phase0(p, lds, tid, lane, wave); grid.sync(); }
    RPT(1) {
        pg8::Gemm g{(const bf16_t*)(p.ws + WS_H), (const bf16_t*)(p.ws + WS_WINT), NT, DIN, 1024};
        pg8::StaticOrder S; S.init(NT, DIN, G, (int)blockIdx.x);
        pg8::EpiProj E{(bf16_t*)(p.ws + WS_A), (bf16_t*)(p.ws + WS_Q), (bf16_t*)(p.ws + WS_KP), (bf16_t*)(p.ws + WS_VP), (bf16_t*)(p.ws + WS_KS), (bf16_t*)(p.ws + WS_VS), p.out};
        pg8::gemm_phase<pg8::EpiProj, pg8::StaticOrder, true, true>(lds, g, S, E);
        GSYNC();
    }
    #ifndef P2MODE
#define P2MODE 0
#endif
    RPT(2) { att::phase2(p, lds, tid, lane, wave, rpt_, (((RPT_MASK) >> 2) & 1) && rpt_ == 0 ? P2MODE : 0); GSYNC(); }
    RPT(3) {
        pg8::Gemm g{(const bf16_t*)(p.ws + WS_MIX), (const bf16_t*)(p.ws + WS_WOUTT), NT, 1024, 1024};
        pg8::StaticOrder S; S.init(NT, 1024, G, (int)blockIdx.x);
        pg8::EpiRes E{p.in[0], p.in[1], p.out};
        pg8::gemm_phase<pg8::EpiRes, pg8::StaticOrder, true, true>(lds, g, S, E);
        GSYNC();
    }
    RPT(4) { phase3b(p, lane, wave); GSYNC(); }
    RPT(5) {
        pg8::Gemm g{(const bf16_t*)(p.ws + WS_H2), (const bf16_t*)(p.ws + WS_WQT), NT, 2048, 1024};
        pg8::StaticOrder S; S.init(NT, 2048, G, (int)blockIdx.x);
        pg8::EpiBf16<0> E{(bf16_t*)(p.ws + WS_QP), 2048, nullptr, 0, 0, 1.f};
        pg8::gemm_phase<pg8::EpiBf16<0>, pg8::StaticOrder, true, true>(lds, g, S, E);
        GSYNC();
    }
    RPT(6) { phase4b(p, lds, tid, lane, wave); GSYNC(); }
    RPT(7) { phase5a(p, tid); GSYNC(); }
    RPT(8) { phase5u(p, lds, lane, wave); GSYNC(); }
    phase5c(p, tid);
    GSYNC();
    phase5v(p, lds, lane, wave);
    GSYNC();
    phase6(p, lane, wave);
}

extern "C" void kernel_launch(void* const* d_in, const int* in_sizes, int n_in, void* d_out, int out_size, void* d_ws, size_t ws_size, hipStream_t stream) {
    static int grid = 0;
    if (grid == 0) {
        if (n_in != 24 || out_size != (int)OUT_TOTAL || ws_size < WS_END) { fprintf(stderr, "kernel_launch: unexpected shapes: n_in %d out %d ws %zu (need %zu)\n", n_in, out_size, ws_size, (size_t)WS_END); grid = -1; return; }
        int dev = 0, cus = 0, per_cu = 0;
        (void)hipGetDevice(&dev);
        (void)hipDeviceGetAttribute(&cus, hipDeviceAttributeMultiprocessorCount, dev);
        if (hipFuncSetAttribute((const void*)fwd_megakernel, hipFuncAttributeMaxDynamicSharedMemorySize, LDS_BYTES) != hipSuccess) { fprintf(stderr, "kernel_launch: hipFuncSetAttribute failed\n"); grid = -1; return; }
        if (hipOccupancyMaxActiveBlocksPerMultiprocessor(&per_cu, (const void*)fwd_megakernel, 512, LDS_BYTES) != hipSuccess || per_cu < 1) { fprintf(stderr, "kernel_launch: occupancy query gave %d\n", per_cu); per_cu = 1; }
        (void)hipGetLastError();
        grid = cus * 1;
        if (per_cu < 1) grid = -1;
    }
    if (grid < 0) return;
    (void)hipMemsetAsync((char*)d_ws + WS_CTL, 0, CTL_BYTES, stream);
    Params p{};
    for (int i = 0; i < 24; ++i) p.in[i] = (const float*)d_in[i];
    p.out = (float*)d_out; p.ws = (unsigned char*)d_ws;
    void* args[] = {&p};
    hipError_t e = hipLaunchCooperativeKernel((const void*)fwd_megakernel, dim3(grid), dim3(512), args, LDS_BYTES, stream);
    if (e != hipSuccess) fprintf(stderr, "cooperative launch failed: %s (grid %d)\n", hipGetErrorString(e), grid);
}
```

```cpp
#include <hip/hip_runtime.h>
#include <hip/hip_cooperative_groups.h>
#include <cstdio>
#include <cstdint>
#include <cmath>
namespace cg = cooperative_groups;
#define CE_(a, b) do { const float t_ = fmaxf(a, b); b = fminf(a, b); a = t_; } while (0)
#define SORT16_DESC(V, O) do { CE_(V[(O)+0], V[(O)+1]); CE_(V[(O)+2], V[(O)+3]); CE_(V[(O)+0], V[(O)+2]); CE_(V[(O)+1], V[(O)+3]); CE_(V[(O)+1], V[(O)+2]); CE_(V[(O)+4], V[(O)+5]); CE_(V[(O)+6], V[(O)+7]); CE_(V[(O)+4], V[(O)+6]); CE_(V[(O)+5], V[(O)+7]); CE_(V[(O)+5], V[(O)+6]); CE_(V[(O)+0], V[(O)+4]); CE_(V[(O)+2], V[(O)+6]); CE_(V[(O)+2], V[(O)+4]); CE_(V[(O)+1], V[(O)+5]); CE_(V[(O)+3], V[(O)+7]); CE_(V[(O)+3], V[(O)+5]); CE_(V[(O)+1], V[(O)+2]); CE_(V[(O)+3], V[(O)+4]); CE_(V[(O)+5], V[(O)+6]); CE_(V[(O)+8], V[(O)+9]); CE_(V[(O)+10], V[(O)+11]); CE_(V[(O)+8], V[(O)+10]); CE_(V[(O)+9], V[(O)+11]); CE_(V[(O)+9], V[(O)+10]); CE_(V[(O)+12], V[(O)+13]); CE_(V[(O)+14], V[(O)+15]); CE_(V[(O)+12], V[(O)+14]); CE_(V[(O)+13], V[(O)+15]); CE_(V[(O)+13], V[(O)+14]); CE_(V[(O)+8], V[(O)+12]); CE_(V[(O)+10], V[(O)+14]); CE_(V[(O)+10], V[(O)+12]); CE_(V[(O)+9], V[(O)+13]); CE_(V[(O)+11], V[(O)+15]); CE_(V[(O)+11], V[(O)+13]); CE_(V[(O)+9], V[(O)+10]); CE_(V[(O)+11], V[(O)+12]); CE_(V[(O)+13], V[(O)+14]); CE_(V[(O)+0], V[(O)+8]); CE_(V[(O)+4], V[(O)+12]); CE_(V[(O)+4], V[(O)+8]); CE_(V[(O)+2], V[(O)+10]); CE_(V[(O)+6], V[(O)+14]); CE_(V[(O)+6], V[(O)+10]); CE_(V[(O)+2], V[(O)+4]); CE_(V[(O)+6], V[(O)+8]); CE_(V[(O)+10], V[(O)+12]); CE_(V[(O)+1], V[(O)+9]); CE_(V[(O)+5], V[(O)+13]); CE_(V[(O)+5], V[(O)+9]); CE_(V[(O)+3], V[(O)+11]); CE_(V[(O)+7], V[(O)+15]); CE_(V[(O)+7], V[(O)+11]); CE_(V[(O)+3], V[(O)+5]); CE_(V[(O)+7], V[(O)+9]); CE_(V[(O)+11], V[(O)+13]); CE_(V[(O)+1], V[(O)+2]); CE_(V[(O)+3], V[(O)+4]); CE_(V[(O)+5], V[(O)+6]); CE_(V[(O)+7], V[(O)+8]); CE_(V[(O)+9], V[(O)+10]); CE_(V[(O)+11], V[(O)+12]); CE_(V[(O)+13], V[(O)+14]); } while (0)
#define BITONIC16_DESC(V, O) do { CE_(V[(O)+0], V[(O)+8]); CE_(V[(O)+1], V[(O)+9]); CE_(V[(O)+2], V[(O)+10]); CE_(V[(O)+3], V[(O)+11]); CE_(V[(O)+4], V[(O)+12]); CE_(V[(O)+5], V[(O)+13]); CE_(V[(O)+6], V[(O)+14]); CE_(V[(O)+7], V[(O)+15]); CE_(V[(O)+0], V[(O)+4]); CE_(V[(O)+1], V[(O)+5]); CE_(V[(O)+2], V[(O)+6]); CE_(V[(O)+3], V[(O)+7]); CE_(V[(O)+8], V[(O)+12]); CE_(V[(O)+9], V[(O)+13]); CE_(V[(O)+10], V[(O)+14]); CE_(V[(O)+11], V[(O)+15]); CE_(V[(O)+0], V[(O)+2]); CE_(V[(O)+1], V[(O)+3]); CE_(V[(O)+4], V[(O)+6]); CE_(V[(O)+5], V[(O)+7]); CE_(V[(O)+8], V[(O)+10]); CE_(V[(O)+9], V[(O)+11]); CE_(V[(O)+12], V[(O)+14]); CE_(V[(O)+13], V[(O)+15]); CE_(V[(O)+0], V[(O)+1]); CE_(V[(O)+2], V[(O)+3]); CE_(V[(O)+4], V[(O)+5]); CE_(V[(O)+6], V[(O)+7]); CE_(V[(O)+8], V[(O)+9]); CE_(V[(O)+10], V[(O)+11]); CE_(V[(O)+12], V[(O)+13]); CE_(V[(O)+14], V[(O)+15]); } while (0)
namespace pg8 {
#define PG8_LAS __attribute__((address_space(3)))
typedef unsigned short bf16_t;
typedef short bf16x8 __attribute__((ext_vector_type(8)));
typedef float f32x4 __attribute__((ext_vector_type(4)));
typedef unsigned u32x4 __attribute__((ext_vector_type(4)));
constexpr int BM = 256, BK = 64, HALF = 128, HTB = HALF * BK * 2  , STAGE_BYTES = 8 * HTB, NXCD = 8, WGM = 8;

__host__ __device__ __forceinline__ int lds_byte(int r, int c) { const int st = (r >> 4) * 2 + (c >> 5), rr = r & 15, cc = c & 31, ob = rr * 64 + cc * 2; return st * 1024 + (ob ^ (((ob >> 9) & 1) << 5)); }
__host__ __device__ __forceinline__ void stage_rc(int b, int& R, int& C) { const int st = b / 1024, sb = b % 1024, swz = sb ^ (((sb >> 9) & 1) << 5); R = (st >> 1) * 16 + swz / 64; C = (st & 1) * 32 + (swz % 64) / 2; }
__host__ __device__ __forceinline__ int perm32(int rho) { const int n = rho >> 4, i = rho & 15; return 8 * (i >> 2) + 4 * n + (i & 3); }

struct Unit { int pm, pn; };
struct Gemm { const bf16_t* A; const bf16_t* Bt; int M, N, K; };

struct StaticOrder {
    int nM, nN, nwg, G, c;
    __host__ __device__ void init(int M, int N, int G_, int c_) { nM = M / BM; nN = N / BM; nwg = nM * nN; G = G_; c = c_; }
    __host__ __device__ bool next(int i, Unit& u) const {
        const long L = (long)i * G + c; if (L >= nwg) return false;
        int wgid = (int)L; { const int q = nwg / NXCD, r = nwg % NXCD, xcd = wgid % NXCD, off = wgid / NXCD; wgid = (xcd < r ? xcd * (q + 1) : r * (q + 1) + (xcd - r) * q) + off; }
        const int nig = WGM * nN, gid = wgid / nig, fm = gid * WGM, gsz = (nM - fm) < WGM ? (nM - fm) : WGM;
        u.pm = fm + ((wgid % nig) % gsz); u.pn = (wgid % nig) / gsz; return true;
    }
    __device__ __forceinline__ void a_ready(const Unit&) const {}
    __device__ __forceinline__ void done(const Unit&) const {}
};

__device__ __forceinline__ unsigned cvt_pk_bf16(float lo, float hi) { unsigned r; asm volatile("v_cvt_pk_bf16_f32 %0, %1, %2" : "=v"(r) : "v"(lo), "v"(hi)); return r; }
typedef float f32x2 __attribute__((ext_vector_type(2)));
__device__ __forceinline__ f32x2 gelu_pk(f32x2 v) {
    const f32x2 av = __builtin_elementwise_abs(v), d = av * 0.2316418882f + 1.0f;
    f32x2 t; t.x = __builtin_amdgcn_rcpf(d.x); t.y = __builtin_amdgcn_rcpf(d.y);
    f32x2 q = t * 0.5307027145f + (-0.7265760135f); q = q * t + 0.7107068705f; q = q * t + (-0.142248368f); q = q * t + 0.127414796f; q = q * t;
    const f32x2 s = (v * v) * (-0.72134752044f);
    f32x2 e; e.x = __builtin_amdgcn_exp2f(s.x); e.y = __builtin_amdgcn_exp2f(s.y);
    const f32x2 m = v * (q * e), r = v - m;
    f32x2 o; o.x = v.x < 0.f ? m.x : r.x; o.y = v.y < 0.f ? m.y : r.y; return o;
}

template <int ACT  > struct EpiBf16 {
    static constexpr bool PERM = true, AFTER_DRAIN = false; static_assert(ACT == 0 || ACT == 1, "EpiBf16: ACT is 0 (none) or 1 (gelu_pk)");
    bf16_t* O; int ldc; const float* bias; int split_cols; size_t split_stride; float scale0;
    __device__ __forceinline__ void operator()(const f32x4 (&acc)[2][2][4][2], const Unit& u, int wr, int wc, int fr, int fq) const {
        const int row0 = u.pm * BM + wr * 64 + fr; int colt = u.pn * BM; bf16_t* base = O;
        float sc = 1.f; if (split_cols) { const int t = colt / split_cols; base += (size_t)t * split_stride; colt -= t * split_cols; if (t == 0) sc = scale0; }
        const int col0 = colt + wc * 32 + 8 * fq, bcol0 = u.pn * BM + wc * 32 + 8 * fq;
        f32x4 bv[2][2];
#pragma unroll
        for (int bj = 0; bj < 2; ++bj)
#pragma unroll
            for (int n = 0; n < 2; ++n) bv[bj][n] = bias ? *(const f32x4*)(bias + bcol0 + bj * HALF + 4 * n) : (f32x4){0.f, 0.f, 0.f, 0.f};
#pragma unroll
        for (int ai = 0; ai < 2; ++ai)
#pragma unroll
            for (int m = 0; m < 4; ++m) { bf16_t* rowp = base + (size_t)(row0 + ai * HALF + m * 16) * ldc + col0;
#pragma unroll
                for (int bj = 0; bj < 2; ++bj) { f32x4 v0 = acc[ai][bj][m][0] + bv[bj][0], v1 = acc[ai][bj][m][1] + bv[bj][1];
                    if (ACT == 1) { f32x2 a = gelu_pk((f32x2){v0[0], v0[1]}), b = gelu_pk((f32x2){v0[2], v0[3]}), c = gelu_pk((f32x2){v1[0], v1[1]}), d = gelu_pk((f32x2){v1[2], v1[3]});
                        v0 = (f32x4){a.x, a.y, b.x, b.y}; v1 = (f32x4){c.x, c.y, d.x, d.y}; }
                    v0 = v0 * sc; v1 = v1 * sc; u32x4 w; w.x = cvt_pk_bf16(v0[0], v0[1]); w.y = cvt_pk_bf16(v0[2], v0[3]); w.z = cvt_pk_bf16(v1[0], v1[1]); w.w = cvt_pk_bf16(v1[2], v1[3]);
                    *(u32x4*)(rowp + bj * HALF) = w; } }
    }
};
template <class Epi, class Sched, bool ALIGN_EPI = false, bool SP2 = false>
__device__ __forceinline__ void gemm_phase(PG8_LAS unsigned char* lds, const Gemm g, const Sched& S, const Epi& E) {
    const int tid = threadIdx.x, wid = __builtin_amdgcn_readfirstlane(tid >> 6), lane = tid & 63, wr = wid >> 2, wc = wid & 3, fr = lane & 15, fq = lane >> 4;
    const int K = g.K, nt = K / BK;
    unsigned voffA[2], voffB[2];
#pragma unroll
    for (int i = 0; i < 2; ++i) { int R, C; stage_rc(tid * 16 + i * 8192, R, C); const int Rb = Epi::PERM ? ((R & ~31) + perm32(R & 31)) : R;
        voffA[i] = (unsigned)(R * K + C) * 2u; voffB[i] = (unsigned)(Rb * K + C) * 2u; }
    const size_t kstep = (size_t)(BK * 2);
    const size_t hstep = (size_t)HALF * K * 2;
    const size_t tstep = 2 * hstep;
    const unsigned ldsw = (unsigned)wid * 1024u;
    const int aoff = lds_byte(wr * 64 + fr, fq * 8), boff = lds_byte(wc * 32 + fr, fq * 8);
#define PG8_SA(b, h) (((b) * 2 + (h)) * HTB)
#define PG8_SB(b, h) ((4 + (b) * 2 + (h)) * HTB)
#define PG8_STAGE(bufoff, gbase, voff) do { _Pragma("unroll") for (int _i = 0; _i < 2; ++_i) \
        __builtin_amdgcn_global_load_lds((const unsigned*)((const char*)(gbase) + (voff)[_i]), (PG8_LAS unsigned*)(lds + (bufoff) + ldsw + _i * 8192), 16, 0, 0); } while (0)
#define PG8_LDA(dst, b, h) do { _Pragma("unroll") for (int m = 0; m < 4; ++m) _Pragma("unroll") for (int k = 0; k < 2; ++k) dst[m][k] = *(const PG8_LAS bf16x8*)(lds + PG8_SA(b, h) + aoff + m * 2048 + k * 1024); } while (0)
#define PG8_LDB(dst, b, h) do { _Pragma("unroll") for (int n = 0; n < 2; ++n) _Pragma("unroll") for (int k = 0; k < 2; ++k) dst[n][k] = *(const PG8_LAS bf16x8*)(lds + PG8_SB(b, h) + boff + n * 2048 + k * 1024); } while (0)
#define PG8_MMA(ai, bj, At, Bt) do { __builtin_amdgcn_s_setprio(1); _Pragma("unroll") for (int m = 0; m < 4; ++m) _Pragma("unroll") for (int n = 0; n < 2; ++n) _Pragma("unroll") for (int k = 0; k < 2; ++k) \
        acc[ai][bj][m][n] = __builtin_amdgcn_mfma_f32_16x16x32_bf16(Bt[n][k], At[m][k], acc[ai][bj][m][n], 0, 0, 0); __builtin_amdgcn_s_setprio(0); } while (0)
#define PG8_WAIT_V(n) asm volatile("s_waitcnt vmcnt(" #n ")" ::: "memory")
#define PG8_WAIT_L(n) asm volatile("s_waitcnt lgkmcnt(" #n ")" ::: "memory")
#define PG8_BAR __builtin_amdgcn_s_barrier()
#define PG8_SCHED __builtin_amdgcn_sched_barrier(0)
    Unit cur, nxt; int ui = 0;
    if (!S.next(0, cur)) return;
    f32x4 acc[2][2][4][2];
#pragma unroll
    for (int a = 0; a < 2; ++a)
#pragma unroll
        for (int b = 0; b < 2; ++b)
#pragma unroll
            for (int m = 0; m < 4; ++m)
#pragma unroll
                for (int n = 0; n < 2; ++n) acc[a][b][m][n] = (f32x4){0.f, 0.f, 0.f, 0.f};
    bf16x8 At[4][2], B0[2][2], B1[2][2];
    const char* cA = (const char*)g.A + (size_t)cur.pm * tstep; const char* cB = (const char*)g.Bt + (size_t)cur.pn * tstep;
    S.a_ready(cur);
    if constexpr (SP2) {
        PG8_STAGE(PG8_SB(0, 0), cB, voffB); PG8_STAGE(PG8_SB(0, 1), cB + hstep, voffB); PG8_STAGE(PG8_SA(0, 0), cA, voffA); PG8_STAGE(PG8_SA(0, 1), cA + hstep, voffA);
        if (wr == 1) PG8_BAR;
        PG8_WAIT_V(2); PG8_BAR;
        PG8_STAGE(PG8_SB(1, 0), cB + kstep, voffB); PG8_STAGE(PG8_SA(1, 0), cA + kstep, voffA); PG8_STAGE(PG8_SB(1, 1), cB + hstep + kstep, voffB);
        PG8_WAIT_V(6); PG8_BAR;
    } else {
        PG8_STAGE(PG8_SB(0, 0), cB, voffB); PG8_STAGE(PG8_SA(0, 0), cA, voffA); PG8_STAGE(PG8_SB(0, 1), cB + hstep, voffB); PG8_STAGE(PG8_SA(0, 1), cA + hstep, voffA);
        if (wr == 1) PG8_BAR;
        PG8_WAIT_V(4); PG8_BAR;
        PG8_STAGE(PG8_SB(1, 0), cB + kstep, voffB); PG8_STAGE(PG8_SA(1, 0), cA + kstep, voffA); PG8_STAGE(PG8_SB(1, 1), cB + hstep + kstep, voffB);
        PG8_WAIT_V(6); PG8_BAR;
    }
    for (;;) {
        const bool has_next = S.next(ui + 1, nxt);
        const char* nA = has_next ? (const char*)g.A + (size_t)nxt.pm * tstep : cA; const char* nB = has_next ? (const char*)g.Bt + (size_t)nxt.pn * tstep : cB;
        for (int t = 0; t < nt; t += 2) {
            const bool last = (t == nt - 2);
            const char* a1 = cA + (size_t)(t + 1) * kstep;
            const char* a2 = last ? nA : cA + (size_t)(t + 2) * kstep; const char* b2 = last ? nB : cB + (size_t)(t + 2) * kstep;
            const char* a3 = a2 + kstep; const char* b3 = b2 + kstep;
            if (last && has_next) S.a_ready(nxt);
            if constexpr (SP2) {
            PG8_LDB(B0, 0, 0); PG8_LDB(B1, 0, 1); PG8_SCHED; PG8_LDA(At, 0, 0); PG8_STAGE(PG8_SA(1, 1), a1 + hstep, voffA);
            PG8_WAIT_V(8); PG8_WAIT_L(0); PG8_BAR; PG8_MMA(0, 0, At, B0); PG8_MMA(0, 1, At, B1); PG8_BAR; PG8_SCHED;
            PG8_LDA(At, 0, 1); PG8_STAGE(PG8_SB(0, 0), b2, voffB); PG8_STAGE(PG8_SB(0, 1), b2 + hstep, voffB); PG8_STAGE(PG8_SA(0, 0), a2, voffA);
            PG8_WAIT_V(8); PG8_WAIT_L(0); PG8_BAR; PG8_MMA(1, 0, At, B0); PG8_MMA(1, 1, At, B1); PG8_BAR; PG8_SCHED;
            PG8_LDB(B0, 1, 0); PG8_LDB(B1, 1, 1); PG8_SCHED; PG8_LDA(At, 1, 0); PG8_STAGE(PG8_SA(0, 1), a2 + hstep, voffA);
            PG8_WAIT_V(8); PG8_WAIT_L(0); PG8_BAR; PG8_MMA(0, 0, At, B0); PG8_MMA(0, 1, At, B1); PG8_BAR; PG8_SCHED;
            PG8_LDA(At, 1, 1); PG8_STAGE(PG8_SB(1, 0), b3, voffB); PG8_STAGE(PG8_SB(1, 1), b3 + hstep, voffB); PG8_STAGE(PG8_SA(1, 0), a3, voffA);
            PG8_WAIT_V(8); PG8_WAIT_L(0); PG8_BAR; PG8_MMA(1, 0, At, B0); PG8_MMA(1, 1, At, B1); PG8_BAR; PG8_SCHED;
            } else {
            PG8_LDB(B0, 0, 0); PG8_SCHED; PG8_LDA(At, 0, 0); PG8_STAGE(PG8_SA(1, 1), a1 + hstep, voffA);
            PG8_WAIT_L(8); PG8_BAR; PG8_WAIT_L(0); PG8_MMA(0, 0, At, B0); PG8_BAR; PG8_SCHED;
            PG8_LDB(B1, 0, 1); PG8_STAGE(PG8_SB(0, 0), b2, voffB);
            PG8_BAR; PG8_WAIT_L(0); PG8_MMA(0, 1, At, B1); PG8_BAR;
            PG8_LDA(At, 0, 1); PG8_STAGE(PG8_SA(0, 0), a2, voffA);
            PG8_BAR; PG8_WAIT_L(0); PG8_MMA(1, 0, At, B0); PG8_BAR; PG8_SCHED;
            PG8_STAGE(PG8_SB(0, 1), b2 + hstep, voffB);
            PG8_WAIT_V(6); PG8_BAR; PG8_MMA(1, 1, At, B1); PG8_BAR;
            PG8_LDB(B0, 1, 0); PG8_SCHED; PG8_LDA(At, 1, 0); PG8_STAGE(PG8_SA(0, 1), a2 + hstep, voffA);
            PG8_WAIT_L(8); PG8_BAR; PG8_WAIT_L(0); PG8_MMA(0, 0, At, B0); PG8_BAR; PG8_SCHED;
            PG8_LDB(B1, 1, 1); PG8_STAGE(PG8_SB(1, 0), b3, voffB);
            PG8_BAR; PG8_WAIT_L(0); PG8_MMA(0, 1, At, B1); PG8_BAR;
            PG8_LDA(At, 1, 1); PG8_STAGE(PG8_SA(1, 0), a3, voffA);
            PG8_BAR; PG8_WAIT_L(0); PG8_MMA(1, 0, At, B0); PG8_BAR; PG8_SCHED;
            PG8_STAGE(PG8_SB(1, 1), b3 + hstep, voffB);
            PG8_WAIT_V(6); PG8_BAR; PG8_MMA(1, 1, At, B1); PG8_BAR;
            }
        }
        if constexpr (ALIGN_EPI) { if (wr == 0) PG8_BAR; }
        if constexpr (!Epi::AFTER_DRAIN) { E(acc, cur, wr, wc, fr, fq); S.done(cur); }
        if (!has_next) break;
#pragma unroll
        for (int a = 0; a < 2; ++a)
#pragma unroll
            for (int b = 0; b < 2; ++b)
#pragma unroll
                for (int m = 0; m < 4; ++m)
#pragma unroll
                    for (int n = 0; n < 2; ++n) acc[a][b][m][n] = (f32x4){0.f, 0.f, 0.f, 0.f};
        cur = nxt; cA = nA; cB = nB; ++ui;
        if constexpr (ALIGN_EPI) { if (wr == 1) PG8_BAR; }
    }
    PG8_WAIT_V(0);
    if constexpr (!ALIGN_EPI) { if (wr == 0) PG8_BAR; }
    PG8_BAR;
    if constexpr (Epi::AFTER_DRAIN) { E.fused(acc, cur, wr, wc, fr, fq, lds, wid, lane); S.done(cur); }
#undef PG8_SA
#undef PG8_SB
#undef PG8_STAGE
#undef PG8_LDA
#undef PG8_LDB
#undef PG8_MMA
#undef PG8_WAIT_V
#undef PG8_WAIT_L
#undef PG8_BAR
#undef PG8_SCHED
}
}

#define LAS __attribute__((address_space(3)))
typedef unsigned short bf16_t;
typedef short bf16x8 __attribute__((ext_vector_type(8)));
typedef short s16x4 __attribute__((ext_vector_type(4)));
typedef float f32x4 __attribute__((ext_vector_type(4)));
typedef float f32x16 __attribute__((ext_vector_type(16)));
typedef unsigned u32x4 __attribute__((ext_vector_type(4)));
typedef unsigned u32x2 __attribute__((ext_vector_type(2)));

constexpr int DM = 1024;
constexpr int NP = 16 * 2048;
constexpr int NS = 8 * 64;
constexpr int NT = NP + NS;
constexpr int DIN = 2560;
constexpr int SKV = 2112;
constexpr float EPS = 1e-6f;
constexpr float LOG2E = 1.4426950408889634f;
constexpr float QSCALE = 0.125f * LOG2E;

constexpr long OUT_Y = 0;
constexpr long OUT_KP = 34078720L, OUT_VP = 50855936L, OUT_CONVP = 67633152L, OUT_KS = 67878912L, OUT_VS = 68141056L, OUT_CONVS = 68403200L, OUT_TOTAL = 68526080L;

constexpr size_t MiB = 1u << 20;
constexpr size_t WS_CTL = 0, CTL_BYTES = 1 * MiB;
constexpr size_t WS_WINT = 1 * MiB;
constexpr size_t WS_WOUTT = 6 * MiB;
constexpr size_t WS_WQT = 8 * MiB;
constexpr size_t WS_SK = 12 * MiB;
constexpr size_t WS_PU8 = 16 * MiB;
constexpr size_t WS_PV8 = 32 * MiB;
constexpr size_t WS_SCU = 48 * MiB;
constexpr size_t WS_SCV = 49 * MiB;
constexpr size_t WS_KS = 80 * MiB;
constexpr size_t WS_VS = 97 * MiB;
constexpr size_t WS_H = 114 * MiB;
constexpr size_t WS_A = 179 * MiB;
constexpr size_t WS_Q = 212 * MiB;
constexpr size_t WS_QP = 114 * MiB;
constexpr size_t WS_KP = 245 * MiB;
constexpr size_t WS_VP = 277 * MiB;
constexpr size_t WS_MIX = 309 * MiB;
constexpr size_t WS_H2 = 309 * MiB;
constexpr size_t WS_TK = 375 * MiB;
constexpr size_t WS_IDX = 408 * MiB;
constexpr size_t WS_GATE = 425 * MiB;
constexpr size_t WS_PACT = 114 * MiB;
constexpr size_t WS_COEF = 375 * MiB;
constexpr size_t WS_END = 442 * MiB;
static_assert(WS_H + (size_t)NT * 1024 * 2 <= WS_A && WS_A + (size_t)NT * 512 * 2 <= WS_Q && WS_Q + (size_t)NT * 512 * 2 <= WS_KP, "R1");
static_assert(WS_QP + (size_t)NT * 2048 * 2 <= WS_KP && WS_KP + (size_t)NP * 512 * 2 <= WS_VP && WS_VP + (size_t)NP * 512 * 2 <= WS_MIX, "ws map");
static_assert(WS_MIX + (size_t)NT * 1024 * 2 <= WS_TK && WS_TK + (size_t)NT * 256 * 4 <= WS_IDX && WS_IDX + (size_t)NT * 128 * 4 <= WS_GATE && WS_GATE + (size_t)NT * 128 * 4 <= WS_END, "ws map 2");
static_assert(WS_KS + (size_t)8 * SKV * 512 * 2 <= WS_VS && WS_VS + (size_t)8 * SKV * 512 * 2 <= WS_H, "ws map 3");

constexpr int RING_BYTES = 131072;
constexpr int BIAS_OFF = RING_BYTES;
constexpr int MISC_OFF = RING_BYTES + 5120;
constexpr int LDS_BYTES = MISC_OFF + 1024;

struct Params {
    const float* in[24];
    float* out;
    unsigned char* ws;
};

__device__ __forceinline__ unsigned cvtpk(float lo, float hi) { return pg8::cvt_pk_bf16(lo, hi); }
__device__ __forceinline__ float bflo(unsigned w) { return __uint_as_float(w << 16); }
__device__ __forceinline__ float bfhi(unsigned w) { return __uint_as_float(w & 0xffff0000u); }
__device__ __forceinline__ float wave_sum(float v) {
#pragma unroll
    for (int o = 1; o < 64; o <<= 1) v += __shfl_xor(v, o);
    return v;
}
typedef float f32x2 __attribute__((ext_vector_type(2)));
#define DPP_ADD(v, ctrl) v += __builtin_bit_cast(float, __builtin_amdgcn_update_dpp(0, __builtin_bit_cast(int, v), ctrl, 0xf, 0xf, true))
__device__ __forceinline__ float rl_f(float v, int l) { return __uint_as_float(__builtin_amdgcn_readlane(__float_as_uint(v), l)); }
__device__ __forceinline__ float wave_total(float v) {
    DPP_ADD(v, 0xB1); DPP_ADD(v, 0x4E); DPP_ADD(v, 0x141); DPP_ADD(v, 0x140);
    return (rl_f(v, 0) + rl_f(v, 16)) + (rl_f(v, 32) + rl_f(v, 48));
}
typedef __bf16 bf16x2_t __attribute__((ext_vector_type(2)));
__device__ __forceinline__ float dot2(unsigned a, unsigned b, float acc) {
    return __builtin_amdgcn_fdot2_f32_bf16(__builtin_bit_cast(bf16x2_t, a), __builtin_bit_cast(bf16x2_t, b), acc, false);
}
#define LDS_WAIT() asm volatile("s_waitcnt lgkmcnt(0)" ::: "memory")

#define XB_TMO      128
#define XB_XCNT(j)  (256  + 64 * (j))
#define XB_XSUB(j)  (1280 + 64 * (j))
#define XB_XGEN(j)  (2304 + 64 * (j))
#define XB_TOP      3328
#define XB_TOPGEN   3392
#define XCD_BAR_WORDS 3456
#define XB_SPIN_CAP (1u << 18)

__device__ __forceinline__ unsigned xb_ld(unsigned* p)              { return __hip_atomic_load(p, __ATOMIC_RELAXED, __HIP_MEMORY_SCOPE_AGENT); }
__device__ __forceinline__ unsigned xb_add(unsigned* p, unsigned v) { return __hip_atomic_fetch_add(p, v, __ATOMIC_RELAXED, __HIP_MEMORY_SCOPE_AGENT); }
__device__ __forceinline__ unsigned xb_xcc_id() { return (unsigned)__builtin_amdgcn_s_getreg((3 << 11) | 20) & 0xFu; }
#define XB_SPIN(cond, bar) do { unsigned _sp = 0; while (cond) { __builtin_amdgcn_s_sleep(1); \
    if ((++_sp & 255u) == 0u) { if (xb_ld(&(bar)[XB_TMO])) break; if (_sp > XB_SPIN_CAP) { atomicAdd(&(bar)[XB_TMO], 1u); break; } } } } while (0)

struct XcdBarrier {
    unsigned* bar; unsigned x;
    volatile LAS unsigned* st;
};

__device__ __forceinline__ XcdBarrier xcd_barrier_post(unsigned* bar, volatile LAS unsigned* st) {
    XcdBarrier b; b.bar = bar; b.x = xb_xcc_id(); b.st = st;
    if (threadIdx.x == 0) (void)xb_add(&bar[XB_XCNT(b.x)], 1u);
    return b;
}
__device__ __forceinline__ void xcd_barrier_complete(unsigned* bar, unsigned x, unsigned& nloc, unsigned& nx) {
    const unsigned G = gridDim.x * gridDim.y * gridDim.z;
    unsigned sum, cnt, mine, sp = 0u;
    for (;;) {
        sum = 0u; cnt = 0u; mine = 0u;
#pragma unroll
        for (unsigned j = 0; j < 16; ++j) { const unsigned c = xb_ld(&bar[XB_XCNT(j)]); sum += c; cnt += (c > 0u) ? 1u : 0u; mine = (j == x) ? c : mine; }
        if (sum == G) break;
        __builtin_amdgcn_s_sleep(1);
        if ((++sp & 255u) == 0u) { if (xb_ld(&bar[XB_TMO])) break; if (sp > XB_SPIN_CAP) { atomicAdd(&bar[XB_TMO], 1u); break; } }
    }
    nloc = mine > 0u ? mine : 1u; nx = cnt > 0u ? cnt : 1u;
}

__device__ __forceinline__ void xcd_barrier(const XcdBarrier& b) {
    asm volatile("s_waitcnt vmcnt(0)" ::: "memory");
    __syncthreads();
    if (threadIdx.x == 0) {
        unsigned* bar = b.bar;
        __builtin_amdgcn_s_waitcnt(0);
        unsigned nloc = b.st[0], nx = b.st[1];
        if (nloc == 0u) { xcd_barrier_complete(bar, b.x, nloc, nx); b.st[0] = nloc; b.st[1] = nx; }
        const unsigned old = xb_add(&bar[XB_XSUB(b.x)], 1u);
        const unsigned gen = old / nloc;
        if (old + 1u == (gen + 1u) * nloc) {
            __builtin_amdgcn_fence(__ATOMIC_RELEASE, "agent");
            asm volatile("s_waitcnt vmcnt(0)" ::: "memory");
            const unsigned og = xb_add(&bar[XB_TOP], 1u);
            const unsigned tg = og / nx;
            if (og + 1u == (tg + 1u) * nx) xb_add(&bar[XB_TOPGEN], 1u);
            else XB_SPIN(xb_ld(&bar[XB_TOPGEN]) == tg, bar);
            __builtin_amdgcn_fence(__ATOMIC_ACQUIRE, "agent");
            xb_add(&bar[XB_XGEN(b.x)], 1u);
            asm volatile("s_waitcnt vmcnt(0)" ::: "memory");
        } else {
            XB_SPIN(xb_ld(&bar[XB_XGEN(b.x)]) == gen, bar);
            __builtin_amdgcn_fence(__ATOMIC_ACQUIRE, "agent");
            asm volatile("s_waitcnt vmcnt(0)" ::: "memory");
        }
    }
    __syncthreads();
}


namespace pg8 {
__device__ __forceinline__ u32x2 pack4(f32x4 v) { u32x2 w; w.x = cvt_pk_bf16(v[0], v[1]); w.y = cvt_pk_bf16(v[2], v[3]); return w; }
struct EpiProj {
    static constexpr bool PERM = false, AFTER_DRAIN = false;
    bf16_t* A; bf16_t* Q; bf16_t* KP; bf16_t* VP; bf16_t* KS; bf16_t* VS; float* out;
    __device__ __forceinline__ void operator()(const f32x4 (&acc)[2][2][4][2], const Unit& u, int wr, int wc, int fr, int fq) const {
        const int pn = u.pn;
        const int row0 = u.pm * BM + wr * 64 + fr;
        if (pn < 4) {
#pragma unroll
            for (int ai = 0; ai < 2; ++ai)
#pragma unroll
                for (int m = 0; m < 4; ++m) {
                    const int row = row0 + ai * HALF + m * 16;
                    long toff = -1;
                    if (row < NP) { const int s = row & 2047; if (s >= 2018) toff = OUT_CONVP + ((long)(row >> 11) * 30 + (s - 2018)) * 512; }
                    else { const int rr = row - NP; const int i = rr & 63; if (i >= 34) toff = OUT_CONVS + ((long)(rr >> 6) * 30 + (i - 34)) * 512; }
#pragma unroll
                    for (int n = 0; n < 2; ++n) {
                        const int c = 128 * pn + 32 * wc + 16 * n + 4 * fq;
                        const f32x4 x = acc[ai][0][m][n], g = acc[ai][1][m][n];
                        f32x4 a;
#pragma unroll
                        for (int j = 0; j < 4; ++j) a[j] = x[j] / (1.f + __expf(-g[j]));
                        *(u32x2*)(A + (size_t)row * 512 + c) = pack4(a);
                        if (toff >= 0) *(f32x4*)(out + toff + c) = a;
                    }
                }
        } else {
            const int sec = (pn - 4) >> 1, colbase = ((pn - 4) & 1) * 256;
#pragma unroll
            for (int ai = 0; ai < 2; ++ai)
#pragma unroll
                for (int m = 0; m < 4; ++m) {
                    const int row = row0 + ai * HALF + m * 16;
                    const bool isp = row < NP; const int rr = row - NP;
                    bf16_t* bdst; float* fdst;
                    if (sec == 0) { bdst = Q + (size_t)row * 512; fdst = nullptr; }
                    else if (sec == 1) { bdst = isp ? KP + (size_t)row * 512 : KS + ((size_t)(rr >> 6) * SKV + 2048 + (rr & 63)) * 512; fdst = isp ? out + OUT_KP + (size_t)row * 512 : out + OUT_KS + (size_t)rr * 512; }
                    else { bdst = isp ? VP + (size_t)row * 512 : VS + ((size_t)(rr >> 6) * SKV + 2048 + (rr & 63)) * 512; fdst = isp ? out + OUT_VP + (size_t)row * 512 : out + OUT_VS + (size_t)rr * 512; }
#pragma unroll
                    for (int bj = 0; bj < 2; ++bj)
#pragma unroll
                        for (int n = 0; n < 2; ++n) {
                            const int col = colbase + 128 * bj + 32 * wc + 16 * n + 4 * fq;
                            const f32x4 v = acc[ai][bj][m][n];
                            if (sec == 0) { *(u32x2*)(bdst + col) = pack4(v * QSCALE); }
                            else { *(u32x2*)(bdst + col) = pack4(v); *(f32x4*)(fdst + col) = v; }
                        }
                }
        }
    }
};
struct EpiRes {
    static constexpr bool PERM = false, AFTER_DRAIN = false;
    const float* xp; const float* xs; float* out;
    __device__ __forceinline__ void operator()(const f32x4 (&acc)[2][2][4][2], const Unit& u, int wr, int wc, int fr, int fq) const {
        const int row0 = u.pm * BM + wr * 64 + fr;
#pragma unroll
        for (int ai = 0; ai < 2; ++ai)
#pragma unroll
            for (int m = 0; m < 4; ++m) {
                const int row = row0 + ai * HALF + m * 16;
                const float* xr = row < NP ? xp + (size_t)row * DM : xs + (size_t)(row - NP) * DM;
                float* orow = out + (size_t)row * DM;
#pragma unroll
                for (int bj = 0; bj < 2; ++bj)
#pragma unroll
                    for (int n = 0; n < 2; ++n) {
                        const int col = u.pn * BM + 128 * bj + 32 * wc + 16 * n + 4 * fq;
                        *(f32x4*)(orow + col) = *(const f32x4*)(xr + col) + acc[ai][bj][m][n];
                    }
            }
    }
};
}

__device__ __forceinline__ int winrow(int n) { return n < 1024 ? (256 * ((n & 511) >> 7) + 128 * (n >> 9) + (n & 127)) : n; }
template <bool WIN> __device__ __forceinline__ void transpose_item(const float* W, int K, int N, bf16_t* WT, LAS float* scr, int item, int lane) {
    const int nblk = N / 32, kb = item / nblk, nb = item % nblk, k0 = 64 * kb, n0 = 32 * nb;
#pragma unroll 8
    for (int i = 0; i < 32; ++i) { const int kk = 2 * i + (lane >> 5); scr[kk * 33 + (lane & 31)] = W[(size_t)(k0 + kk) * N + n0 + (lane & 31)]; }
    LDS_WAIT();
    const int c = lane & 7;
#pragma unroll
    for (int j = 0; j < 4; ++j) {
        const int n = (lane >> 3) + 8 * j; const LAS float* s = scr + (8 * c) * 33 + n;
        u32x4 o; o.x = cvtpk(s[0 * 33], s[1 * 33]); o.y = cvtpk(s[2 * 33], s[3 * 33]); o.z = cvtpk(s[4 * 33], s[5 * 33]); o.w = cvtpk(s[6 * 33], s[7 * 33]);
        const int dr = WIN ? winrow(n0 + n) : (n0 + n);
        *(u32x4*)(WT + (size_t)dr * K + k0 + 8 * c) = o;
    }
    LDS_WAIT();
}
__device__ __forceinline__ void cvt_stream(const float* src, bf16_t* dst, size_t n8, size_t gt, size_t ngt) {
    for (size_t i = gt; i < n8; i += ngt) {
        const f32x4 a = *(const f32x4*)(src + i * 8), b = *(const f32x4*)(src + i * 8 + 4);
        u32x4 o; o.x = cvtpk(a[0], a[1]); o.y = cvtpk(a[2], a[3]); o.z = cvtpk(b[0], b[1]); o.w = cvtpk(b[2], b[3]);
        *(u32x4*)(dst + i * 8) = o;
    }
}
__device__ __forceinline__ void cvt_cache(const float* src, bf16_t* dst, size_t gt, size_t ngt) {
    const size_t n8 = (size_t)8 * 2048 * 512 / 8;
    for (size_t i = gt; i < n8; i += ngt) {
        const size_t e = i * 8; const size_t row = e >> 9, col = e & 511; const size_t drow = (row >> 11) * SKV + (row & 2047);
        const f32x4 a = *(const f32x4*)(src + e), b = *(const f32x4*)(src + e + 4);
        u32x4 o; o.x = cvtpk(a[0], a[1]); o.y = cvtpk(a[2], a[3]); o.z = cvtpk(b[0], b[1]); o.w = cvtpk(b[2], b[3]);
        *(u32x4*)(dst + drow * 512 + col) = o;
    }
}
__device__ __forceinline__ void rms_row_bf16(const float* xrow, const float* g, bf16_t* orow, int lane) {
    const f32x4* xr = (const f32x4*)xrow + lane; const f32x4* gr = (const f32x4*)g + lane;
    f32x4 v[4]; float s = 0.f;
#pragma unroll
    for (int j = 0; j < 4; ++j) { v[j] = xr[64 * j]; s += (v[j][0] * v[j][0] + v[j][1] * v[j][1]) + (v[j][2] * v[j][2] + v[j][3] * v[j][3]); }
    const float rstd = 1.f / sqrtf(wave_sum(s) * (1.f / DM) + EPS);
    u32x2* o8 = (u32x2*)orow + lane;
#pragma unroll
    for (int j = 0; j < 4; ++j) { const f32x4 gg = gr[64 * j]; u32x2 w; w.x = cvtpk(v[j][0] * rstd * gg[0], v[j][1] * rstd * gg[1]); w.y = cvtpk(v[j][2] * rstd * gg[2], v[j][3] * rstd * gg[3]); o8[64 * j] = w; }
}

template <bool SLICED> __device__ __forceinline__ void cvt_row_fp8(const float* src, unsigned char* dst_base, int row, float* scale_out, int lane) {
    const f32x4* xr = (const f32x4*)src + lane;
    f32x4 v[4]; float am = 0.f;
#pragma unroll
    for (int j = 0; j < 4; ++j) { v[j] = xr[64 * j]; am = fmaxf(am, fmaxf(fmaxf(fabsf(v[j][0]), fabsf(v[j][1])), fmaxf(fabsf(v[j][2]), fabsf(v[j][3])))); }
#pragma unroll
    for (int o = 1; o < 64; o <<= 1) am = fmaxf(am, __shfl_xor(am, o));
    const float sc = am > 0.f ? am * (1.f / 448.f) : 1.f, inv = 1.f / sc;
#pragma unroll
    for (int j = 0; j < 4; ++j) {
        const int eb = 256 * j + 4 * lane;
        int w = __builtin_amdgcn_cvt_pk_fp8_f32(v[j][0] * inv, v[j][1] * inv, 0, false);
        w = __builtin_amdgcn_cvt_pk_fp8_f32(v[j][2] * inv, v[j][3] * inv, w, true);
        if (SLICED) *(int*)(dst_base + ((size_t)(eb >> 7) * 16384 + row) * 128 + (eb & 127)) = w;
        else *(int*)(dst_base + (size_t)row * DM + 16 * ((eb & 511) >> 3) + (eb & 7) + (eb >= 512 ? 8 : 0)) = w;
    }
    if (lane == 0) *scale_out = sc;
}

__device__ __forceinline__ void phase0(const Params& p, LAS unsigned char* lds, int tid, int lane, int wave) {
    const int gw = blockIdx.x * 8 + wave, NGW = gridDim.x * 8;
    LAS float* scr = (LAS float*)(lds + wave * 16384);
    bf16_t* WINT = (bf16_t*)(p.ws + WS_WINT);
    constexpr int I_IN = 16 * (DIN / 32);
    for (int it = gw; it < I_IN; it += NGW) transpose_item<true>(p.in[6], 1024, DIN, WINT, scr, it, lane);
    bf16_t* H = (bf16_t*)(p.ws + WS_H);
    for (int m = gw; m < NT; m += NGW) {
        const float* xr = m < NP ? p.in[0] + (size_t)m * DM : p.in[1] + (size_t)(m - NP) * DM;
        rms_row_bf16(xr, p.in[5], H + (size_t)m * DM, lane);
    }
}
__device__ __forceinline__ void prep_late(const Params& p, LAS unsigned char* lds, int tid, int lane, int wave, int rank, int nparts) {
    const int gw = rank * 8 + wave, NGW = nparts * 8;
    LAS float* scr = (LAS float*)(lds + wave * 16384);
    const size_t gt = (size_t)rank * 512 + tid, ngt = (size_t)nparts * 512;
    cvt_cache(p.in[2], (bf16_t*)(p.ws + WS_KS), gt, ngt);
    cvt_cache(p.in[3], (bf16_t*)(p.ws + WS_VS), gt, ngt);
    bf16_t* WOUTT = (bf16_t*)(p.ws + WS_WOUTT); bf16_t* WQT = (bf16_t*)(p.ws + WS_WQT);
    constexpr int I_OUT = 16 * (1024 / 32), I_Q = 16 * (2048 / 32);
    for (int it = gw; it < I_OUT + I_Q; it += NGW) {
        if (it < I_OUT) transpose_item<false>(p.in[17], 1024, 1024, WOUTT, scr, it, lane);
        else transpose_item<false>(p.in[19], 1024, 2048, WQT, scr, it - I_OUT, lane);
    }
    cvt_stream(p.in[20], (bf16_t*)(p.ws + WS_SK), (size_t)16 * 128 * 128 / 8, gt, ngt);
    for (int r = gw; r < 2 * 16384; r += NGW) {
        const int tb = r >> 14, e = r & 16383;
        if (tb) cvt_row_fp8<true>(p.in[22] + (size_t)e * DM, p.ws + WS_PV8, e, (float*)(p.ws + WS_SCV) + e, lane);
        else cvt_row_fp8<true>(p.in[21] + (size_t)e * DM, p.ws + WS_PU8, e, (float*)(p.ws + WS_SCU) + e, lane);
    }
}

namespace att {
constexpr int KPITCH = 272, VPITCH = 320;
constexpr int L_KV = 0, KV_BYTES = 64 * KPITCH + 64 * VPITCH  , L_X = 0  , L_BIAS = BIAS_OFF, L_CA = 0  , L_CW = 94 * 1024  ;
static_assert(4 * 4096 * 4 <= 2 * KV_BYTES && 2 * KV_BYTES <= L_CW && L_CW + 31 * 1024 <= RING_BYTES, "attention LDS map");

__device__ __forceinline__ int rel_bucket(int rel) {
    const int ret = rel > 0 ? 16 : 0; const int n = rel < 0 ? -rel : rel; int v;
    if (n < 8) v = n; else if (n < 12) v = 8; else if (n < 16) v = 9; else if (n < 23) v = 10; else if (n < 32) v = 11;
    else if (n < 46) v = 12; else if (n < 64) v = 13; else if (n < 91) v = 14; else v = 15;
    return ret + v;
}
typedef short v4i16_t __attribute__((ext_vector_type(4)));
__device__ __forceinline__ s16x4 vtr(const LAS unsigned char* p) { return __builtin_bit_cast(s16x4, __builtin_amdgcn_ds_read_tr16_b64_v4i16((LAS v4i16_t*)p)); }
__device__ __forceinline__ f32x16 mfma32(bf16x8 a, bf16x8 b, f32x16 c) { return __builtin_amdgcn_mfma_f32_32x32x16_bf16(a, b, c, 0, 0, 0); }

__device__ __forceinline__ void attn_unit(const Params& p, LAS unsigned char* lds, int kind, int bb, int h, int qblk, float lam, int tid, int lane, int wid) {
    const bf16_t* Q = (const bf16_t*)(p.ws + WS_Q);
    const bf16_t* Kb = kind == 0 ? (const bf16_t*)(p.ws + WS_KP) + (size_t)bb * 2048 * 512 + h * 128 : (const bf16_t*)(p.ws + WS_KS) + (size_t)bb * SKV * 512 + h * 128;
    const bf16_t* Vb = kind == 0 ? (const bf16_t*)(p.ws + WS_VP) + (size_t)bb * 2048 * 512 + h * 128 : (const bf16_t*)(p.ws + WS_VS) + (size_t)bb * SKV * 512 + h * 128;
    bf16_t* MIX = (bf16_t*)(p.ws + WS_MIX);
    const int qrow0 = kind == 0 ? bb * 2048 + qblk * 128 : NP + bb * 64;
    const int qpos0 = kind == 0 ? qblk * 128 : 2048;
    const int ntiles = kind == 0 ? 2 * qblk + 2 : 33;
    const int rg = wid & 3, map = wid >> 2, r32 = lane & 31, hi = lane >> 5;
    const bool active = kind == 0 ? true : (rg < 2);
    const int cw = kind == 0 ? 2 * qblk + (rg >> 1) : 32;
    const int qw0 = qpos0 + 32 * rg;
    const int qabs = qw0 + r32;

    bf16x8 qf[4];
    if (active) {
        const bf16_t* qp = Q + (size_t)(qrow0 + 32 * rg + r32) * 512 + h * 128 + map * 64 + 8 * hi;
#pragma unroll
        for (int s = 0; s < 4; ++s) qf[s] = *(const bf16x8*)(qp + 16 * s);
    } else {
#pragma unroll
        for (int s = 0; s < 4; ++s) qf[s] = (bf16x8){0, 0, 0, 0, 0, 0, 0, 0};
    }
    float m = -1e30f, l = 0.f;
    f32x16 o[4];
#pragma unroll
    for (int mt = 0; mt < 4; ++mt)
#pragma unroll
        for (int r = 0; r < 16; ++r) o[mt][r] = 0.f;

    const int srow0 = tid >> 4, sch = tid & 15;
    const LAS float* btab = (const LAS float*)(lds + L_BIAS) + h * 320;
    const float biasfar = btab[0];
    const int vlane = (4 * hi + ((lane & 15) >> 2)) * VPITCH + (16 * ((lane >> 4) & 1) + 4 * (lane & 3)) * 2;
    u32x4 kA[2], vA[2], kB[2], vB[2];
#define ATT_LOAD(KR, VR, T) do { _Pragma("unroll") for (int i_ = 0; i_ < 2; ++i_) { const size_t off_ = (size_t)((T) * 64 + srow0 + 32 * i_) * 512 + sch * 8; KR[i_] = *(const u32x4*)(Kb + off_); VR[i_] = *(const u32x4*)(Vb + off_); } } while (0)
#define ATT_STORE(KR, VR, BUF) do { _Pragma("unroll") for (int i_ = 0; i_ < 2; ++i_) { \
        *(LAS u32x4*)(lds + L_KV + (BUF) * KV_BYTES + (srow0 + 32 * i_) * KPITCH + sch * 16) = KR[i_]; \
        *(LAS u32x4*)(lds + L_KV + (BUF) * KV_BYTES + 64 * KPITCH + (srow0 + 32 * i_) * VPITCH + sch * 16) = VR[i_]; } } while (0)
    auto compute = [&](int t, int buf) {
        const LAS unsigned char* kbuf = lds + L_KV + buf * KV_BYTES;
        const LAS unsigned char* vbuf = kbuf + 64 * KPITCH;
        f32x16 p0, p1;
        const int kabs0 = t * 64;
        if (kabs0 + 63 - qw0 > -128) {
            const LAS float* bt = btab + (kabs0 - qabs + 256 + 4 * hi);
#pragma unroll
            for (int r = 0; r < 16; ++r) { p0[r] = bt[(r & 3) + 8 * (r >> 2)]; p1[r] = bt[32 + (r & 3) + 8 * (r >> 2)]; }
        } else {
#pragma unroll
            for (int r = 0; r < 16; ++r) { p0[r] = biasfar; p1[r] = biasfar; }
        }
        const LAS unsigned char* kb = kbuf + r32 * KPITCH + (map * 8 + hi) * 16;
#pragma unroll
        for (int s = 0; s < 4; ++s) {
            const bf16x8 a0 = *(const LAS bf16x8*)(kb + s * 32), a1 = *(const LAS bf16x8*)(kb + 32 * KPITCH + s * 32);
            p0 = mfma32(a0, qf[s], p0); p1 = mfma32(a1, qf[s], p1);
        }
        __builtin_amdgcn_sched_barrier(0);
        float mx = fmaxf(p0[0], p1[0]);
#pragma unroll
        for (int r = 1; r < 16; ++r) mx = fmaxf(mx, fmaxf(p0[r], p1[r]));
        mx = fmaxf(mx, __shfl_xor(mx, 32));
        const float mn = fmaxf(m, mx);
        const float alpha = __builtin_amdgcn_exp2f(m - mn);
        m = mn;
        float rs = 0.f;
#pragma unroll
        for (int r = 0; r < 16; ++r) { p0[r] = __builtin_amdgcn_exp2f(p0[r] - mn); p1[r] = __builtin_amdgcn_exp2f(p1[r] - mn); rs += p0[r] + p1[r]; }
        l = l * alpha + rs;
#pragma unroll
        for (int mt = 0; mt < 4; ++mt)
#pragma unroll
            for (int r = 0; r < 16; ++r) o[mt][r] *= alpha;
        __builtin_amdgcn_sched_barrier(0);
#pragma unroll
        for (int t2 = 0; t2 < 2; ++t2)
#pragma unroll
            for (int s = 0; s < 2; ++s) {
                u32x4 bw;
                if (t2 == 0) { bw.x = cvtpk(p0[8 * s + 0], p0[8 * s + 1]); bw.y = cvtpk(p0[8 * s + 2], p0[8 * s + 3]); bw.z = cvtpk(p0[8 * s + 4], p0[8 * s + 5]); bw.w = cvtpk(p0[8 * s + 6], p0[8 * s + 7]); }
                else { bw.x = cvtpk(p1[8 * s + 0], p1[8 * s + 1]); bw.y = cvtpk(p1[8 * s + 2], p1[8 * s + 3]); bw.z = cvtpk(p1[8 * s + 4], p1[8 * s + 5]); bw.w = cvtpk(p1[8 * s + 6], p1[8 * s + 7]); }
                const bf16x8 B = __builtin_bit_cast(bf16x8, bw);
                const LAS unsigned char* vb = vbuf + vlane + (32 * t2 + 16 * s) * VPITCH;
#pragma unroll
                for (int mt = 0; mt < 4; ++mt) {
                    const s16x4 lo = vtr(vb + mt * 64), hi8 = vtr(vb + mt * 64 + 8 * VPITCH);
                    const bf16x8 A = (bf16x8){lo[0], lo[1], lo[2], lo[3], hi8[0], hi8[1], hi8[2], hi8[3]};
                    o[mt] = mfma32(A, B, o[mt]);
                }
            }
    };
    ATT_LOAD(kA, vA, 0);
    if (ntiles > 1) ATT_LOAD(kB, vB, 1);
    ATT_STORE(kA, vA, 0);
    if (ntiles > 2) ATT_LOAD(kA, vA, 2);
    __syncthreads();
    for (int t = 0; t < ntiles; t += 2) {
        if (t + 1 < ntiles) { ATT_STORE(kB, vB, 1); if (t + 3 < ntiles) ATT_LOAD(kB, vB, t + 3); }
        if (active && t <= cw) compute(t, 0);
        __syncthreads();
        if (t + 1 >= ntiles) break;
        if (t + 2 < ntiles) { ATT_STORE(kA, vA, 0); if (t + 4 < ntiles) ATT_LOAD(kA, vA, t + 4); }
        if (active && t + 1 <= cw) compute(t + 1, 1);
        __syncthreads();
    }
#undef ATT_LOAD
#undef ATT_STORE
    l += __shfl_xor(l, 32);
    const float inv = 1.f / l;
    LAS float* X = (LAS float*)(lds + L_X) + rg * 4096;
    if (active && map == 1) {
        const float sc = -lam * inv;
#pragma unroll
        for (int mt = 0; mt < 4; ++mt)
#pragma unroll
            for (int r = 0; r < 16; ++r) X[(mt * 16 + r) * 64 + lane] = o[mt][r] * sc;
    }
    __syncthreads();
    if (active && map == 0) {
        float ss = 0.f;
#pragma unroll
        for (int mt = 0; mt < 4; ++mt)
#pragma unroll
            for (int r = 0; r < 16; ++r) { const float v = o[mt][r] * inv + X[(mt * 16 + r) * 64 + lane]; o[mt][r] = v; ss += v * v; }
        ss += __shfl_xor(ss, 32);
        const float rsn = 0.8f / sqrtf(ss * (1.f / 128.f) + EPS);
        bf16_t* orow = MIX + (size_t)(qrow0 + 32 * rg + r32) * 1024 + 512 + h * 128;
        const float* sg = p.in[15];
#pragma unroll
        for (int mt = 0; mt < 4; ++mt)
#pragma unroll
            for (int g4 = 0; g4 < 4; ++g4) {
                const int e = 32 * mt + 8 * g4 + 4 * hi;
                const f32x4 gg = *(const f32x4*)(sg + e);
                u32x2 w; w.x = cvtpk(o[mt][4 * g4 + 0] * rsn * gg[0], o[mt][4 * g4 + 1] * rsn * gg[1]); w.y = cvtpk(o[mt][4 * g4 + 2] * rsn * gg[2], o[mt][4 * g4 + 3] * rsn * gg[3]);
                *(u32x2*)(orow + e) = w;
            }
    }
    __syncthreads();
}

__device__ __forceinline__ void unpack8(const u32x4 w, float (&f)[8]) { f[0] = bflo(w.x); f[1] = bfhi(w.x); f[2] = bflo(w.y); f[3] = bfhi(w.y); f[4] = bflo(w.z); f[5] = bfhi(w.z); f[6] = bflo(w.w); f[7] = bfhi(w.w); }
__device__ __forceinline__ void conv_unit(const Params& p, LAS unsigned char* lds, int cu, int tid, int lane, int wid) {
    const bf16_t* A = (const bf16_t*)(p.ws + WS_A);
    bf16_t* MIX = (bf16_t*)(p.ws + WS_MIX);
    const float* cb = p.in[8]; const float* lg = p.in[9]; const float* lb = p.in[10]; const float* st = p.in[4];
    const int row0 = cu * 64;
    const bool isp = row0 < NP;
    const int s0 = isp ? (row0 & 2047) : 0, rbase = row0 - s0, bd = isp ? 0 : ((row0 - NP) >> 6);
    for (int c = tid; c < 94 * 64; c += 512) {
        const int rr = c >> 6, ch = c & 63, sp = s0 - 30 + rr;
        u32x4 v = (u32x4){0u, 0u, 0u, 0u};
        if (sp >= 0) v = *(const u32x4*)(A + (size_t)(rbase + sp) * 512 + ch * 8);
        else if (!isp) { const float* sr = st + ((size_t)bd * 30 + (30 + sp)) * 512 + ch * 8; const f32x4 a0 = *(const f32x4*)sr, a1 = *(const f32x4*)(sr + 4);
            v.x = cvtpk(a0[0], a0[1]); v.y = cvtpk(a0[2], a0[3]); v.z = cvtpk(a1[0], a1[1]); v.w = cvtpk(a1[2], a1[3]); }
        *(LAS u32x4*)(lds + L_CA + rr * 1024 + ch * 16) = v;
    }
    __syncthreads();
    const int c0 = lane * 8;
    float bias8[8], g8[8], b8[8];
    { const f32x4 x0 = *(const f32x4*)(cb + c0), x1 = *(const f32x4*)(cb + c0 + 4), y0 = *(const f32x4*)(lg + c0), y1 = *(const f32x4*)(lg + c0 + 4), z0 = *(const f32x4*)(lb + c0), z1 = *(const f32x4*)(lb + c0 + 4);
#pragma unroll
      for (int q = 0; q < 4; ++q) { bias8[q] = x0[q]; bias8[4 + q] = x1[q]; g8[q] = y0[q]; g8[4 + q] = y1[q]; b8[q] = z0[q]; b8[4 + q] = z1[q]; } }
    for (int grp = 0; grp < 2; ++grp) {
        const int t0 = wid * 8 + grp * 4;
        float acc[4][8];
#pragma unroll
        for (int q = 0; q < 4; ++q)
#pragma unroll
            for (int c = 0; c < 8; ++c) acc[q][c] = bias8[c];
        const LAS unsigned char* ap = lds + L_CA + t0 * 1024 + lane * 16;
        const LAS unsigned char* wp = lds + L_CW + lane * 16;
#pragma unroll 1
        for (int j = 0; j < 31; ++j) {
            float w[8]; unpack8(*(const LAS u32x4*)(wp + j * 1024), w);
#pragma unroll
            for (int q = 0; q < 4; ++q) {
                float a[8]; unpack8(*(const LAS u32x4*)(ap + (j + q) * 1024), a);
#pragma unroll
                for (int c = 0; c < 8; ++c) acc[q][c] += w[c] * a[c];
            }
        }
#pragma unroll
        for (int q = 0; q < 4; ++q) {
            float sm = 0.f;
#pragma unroll
            for (int c = 0; c < 8; ++c) sm += acc[q][c];
            const float mu = wave_total(sm) * (1.f / 512.f);
            float sv = 0.f;
#pragma unroll
            for (int c = 0; c < 8; ++c) { acc[q][c] -= mu; sv += acc[q][c] * acc[q][c]; }
            const float rstd = 1.f / sqrtf(wave_total(sv) * (1.f / 512.f) + EPS);
            float y[8];
#pragma unroll
            for (int c = 0; c < 8; ++c) { y[c] = acc[q][c] * rstd * g8[c] + b8[c]; y[c] = y[c] / (1.f + __expf(-y[c])); }
            u32x4 w; w.x = cvtpk(y[0], y[1]); w.y = cvtpk(y[2], y[3]); w.z = cvtpk(y[4], y[5]); w.w = cvtpk(y[6], y[7]);
            *(u32x4*)(MIX + (size_t)(row0 + t0 + q) * 1024 + c0) = w;
        }
    }
}

constexpr int N_SAMPLE_UNITS = 32, N_PROMPT_UNITS = 1024, N_CONV_UNITS = NT / 64, N_UNITS = N_SAMPLE_UNITS + N_PROMPT_UNITS + N_CONV_UNITS;

__device__ __forceinline__ void phase2(const Params& p, LAS unsigned char* lds, int tid, int lane, int wid, int cidx, int mode) {
    LAS float* bt = (LAS float*)(lds + L_BIAS);
    for (int e = tid; e < 4 * 320; e += 512) { const int hh = e / 320, rel = (e % 320) - 256; bt[e] = p.in[16][rel_bucket(rel) * 4 + hh] * LOG2E; }
    for (int c = tid; c < 31 * 64; c += 512) {
        const float* wr = p.in[7] + (size_t)c * 8; const f32x4 a0 = *(const f32x4*)wr, a1 = *(const f32x4*)(wr + 4);
        u32x4 v; v.x = cvtpk(a0[0], a0[1]); v.y = cvtpk(a0[2], a0[3]); v.z = cvtpk(a1[0], a1[1]); v.w = cvtpk(a1[2], a1[3]);
        *(LAS u32x4*)(lds + L_CW + c * 16) = v;
    }
    const float d1 = wave_sum(p.in[11][lane] * p.in[12][lane]), d2 = wave_sum(p.in[13][lane] * p.in[14][lane]);
    const float lam = expf(d1) - expf(d2) + 0.2f;
    unsigned* ctr = (unsigned*)(p.ws + WS_CTL) + 64 * cidx;
    volatile LAS unsigned* sw = (volatile LAS unsigned*)(lds + MISC_OFF);
    __syncthreads();
    for (;;) {
        __syncthreads();
        if (tid == 0) sw[0] = atomicAdd(ctr, 1u);
        __syncthreads();
        const int u = (int)sw[0];
        if (u >= N_UNITS) break;
        if (mode == 1 && u >= N_SAMPLE_UNITS + N_PROMPT_UNITS) continue;
        if (mode == 2 && u < N_SAMPLE_UNITS + N_PROMPT_UNITS) continue;
        int tid_ = tid; asm volatile("" : "+v"(tid_));
        if (u < N_SAMPLE_UNITS + N_PROMPT_UNITS) {
            const int v = u - N_SAMPLE_UNITS; const int bh = v & 63; const bool smp = u < N_SAMPLE_UNITS;
            attn_unit(p, lds, smp ? 1 : 0, smp ? (u >> 2) : (bh >> 2), smp ? (u & 3) : (bh & 3), smp ? 0 : 15 - (v >> 6), lam, tid_, tid_ & 63, wid);
        } else conv_unit(p, lds, u - N_SAMPLE_UNITS - N_PROMPT_UNITS, tid_, tid_ & 63, wid);
    }
}
}

__device__ __forceinline__ void phase3b(const Params& p, int lane, int wave) {
    const int gw = blockIdx.x * 8 + wave, NGW = gridDim.x * 8;
    bf16_t* H2 = (bf16_t*)(p.ws + WS_H2);
    for (int m = gw; m < NT; m += NGW) rms_row_bf16(p.out + (size_t)m * DM, p.in[18], H2 + (size_t)m * DM, lane);
}

constexpr int P4B_KPITCH = 272, P4B_K_BYTES = 128 * P4B_KPITCH, P4B_Q_BYTES = 32 * P4B_KPITCH;
static_assert(P4B_K_BYTES + 8 * P4B_Q_BYTES <= RING_BYTES, "P4b LDS map");
__device__ __forceinline__ void phase4b(const Params& p, LAS unsigned char* lds, int tid, int lane, int wave) {
    const bf16_t* QP = (const bf16_t*)(p.ws + WS_QP); const bf16_t* SK = (const bf16_t*)(p.ws + WS_SK);
    float* TK = (float*)(p.ws + WS_TK);
    const int r32 = lane & 31, hi = lane >> 5;
    const int G = gridDim.x;
    for (int rp = blockIdx.x & 15; rp < 16; rp += (G < 16 ? G : 16)) {
        const int nbr = (G - rp + 15) >> 4, member = (int)blockIdx.x >> 4;
        __syncthreads();
        for (int c = tid; c < 128 * 16; c += 512) { const int row = c >> 4, ch = c & 15; *(LAS u32x4*)(lds + row * P4B_KPITCH + ch * 16) = *(const u32x4*)(SK + ((size_t)rp * 128 + row) * 128 + ch * 8); }
        __syncthreads();
        LAS unsigned char* qs = lds + P4B_K_BYTES + wave * P4B_Q_BYTES;
        for (int tg = member * 8 + wave; tg < NT / 32; tg += nbr * 8) {
            const int t0 = tg * 32;
#pragma unroll
            for (int i = 0; i < 8; ++i) { const int row = 4 * i + (lane >> 4), ch = lane & 15; *(LAS u32x4*)(qs + row * P4B_KPITCH + ch * 16) = *(const u32x4*)(QP + (size_t)(t0 + row) * 2048 + rp * 128 + ch * 8); }
            bf16x8 qf[8];
#pragma unroll
            for (int s = 0; s < 8; ++s) qf[s] = *(const LAS bf16x8*)(qs + r32 * P4B_KPITCH + (2 * s + hi) * 16);
            float v[64];
#pragma unroll
            for (int mt = 0; mt < 4; ++mt) {
                f32x16 S;
#pragma unroll
                for (int r = 0; r < 16; ++r) S[r] = 0.f;
                const LAS unsigned char* kp = lds + (32 * mt + r32) * P4B_KPITCH + hi * 16;
#pragma unroll
                for (int s = 0; s < 8; ++s) S = att::mfma32(*(const LAS bf16x8*)(kp + s * 32), qf[s], S);
#pragma unroll
                for (int r = 0; r < 16; ++r) { const int n = 32 * mt + (r & 3) + 8 * (r >> 2) + 4 * hi; v[mt * 16 + r] = __uint_as_float((__float_as_uint(S[r]) & ~127u) | (unsigned)(127 - n)); }
            }
            SORT16_DESC(v, 0); SORT16_DESC(v, 16); SORT16_DESC(v, 32); SORT16_DESC(v, 48);
#pragma unroll
            for (int i = 0; i < 16; ++i) { v[i] = fmaxf(v[i], v[31 - i]); v[32 + i] = fmaxf(v[32 + i], v[63 - i]); }
            BITONIC16_DESC(v, 0); BITONIC16_DESC(v, 32);
#pragma unroll
            for (int i = 0; i < 16; ++i) v[i] = fmaxf(v[i], v[47 - i]);
            BITONIC16_DESC(v, 0);
            float w[16];
#pragma unroll
            for (int i = 0; i < 16; ++i) w[i] = fmaxf(v[i], __shfl_xor(v[15 - i], 32));
            BITONIC16_DESC(w, 0);
            if (hi == 0) {
                f32x4* dst = (f32x4*)(TK + ((size_t)(t0 + r32) * 16 + rp) * 16);
#pragma unroll
                for (int q = 0; q < 4; ++q) dst[q] = (f32x4){w[4 * q], w[4 * q + 1], w[4 * q + 2], w[4 * q + 3]};
            }
        }
    }
}

__device__ __forceinline__ void phase5a(const Params& p, int tid) {
    const float* TK = (const float*)(p.ws + WS_TK);
    int* IDX = (int*)(p.ws + WS_IDX); float* GATE = (float*)(p.ws + WS_GATE);
    const float NEG_INF = -__builtin_huge_valf();
    for (int item = blockIdx.x * 512 + tid; item < NT * 8; item += gridDim.x * 512) {
        const int tok = item >> 3, r = item & 7;
        const f32x4* pa = (const f32x4*)(TK + ((size_t)tok * 16 + 2 * r) * 16);
        float a[16], b[16]; int ia[16], ib[16];
#pragma unroll
        for (int q = 0; q < 4; ++q) { const f32x4 x = pa[q], y = pa[4 + q];
#pragma unroll
            for (int j = 0; j < 4; ++j) { a[4 * q + j] = x[j]; b[4 * q + j] = y[j]; } }
#pragma unroll
        for (int i = 0; i < 16; ++i) { const unsigned ua = __float_as_uint(a[i]), ub = __float_as_uint(b[i]); ia[i] = 127 - (int)(ua & 127u); ib[i] = 127 - (int)(ub & 127u); a[i] = __uint_as_float(ua & ~127u); b[i] = __uint_as_float(ub & ~127u); }
        float cv[50]; int cid[50];
        {
            int c = 0;
#pragma unroll
            for (int i = 0; i < 16; ++i)
#pragma unroll
                for (int j = 0; j < 16; ++j)
                    if ((i + 1) * (j + 1) <= 16) { const float s = a[i] + b[j]; cv[c] = __uint_as_float((__float_as_uint(s) & ~63u) | (unsigned)(63 - c)); cid[c] = ia[i] * 128 + ib[j]; ++c; }
        }
        float best[16]; int bid[16];
#pragma unroll
        for (int it = 0; it < 16; ++it) {
            float mx = cv[0];
#pragma unroll
            for (int c = 1; c < 50; ++c) mx = fmaxf(mx, cv[c]);
            int id = 0;
#pragma unroll
            for (int c = 0; c < 50; ++c) { const bool hit = cv[c] == mx; id = hit ? cid[c] : id; cv[c] = hit ? NEG_INF : cv[c]; }
            best[it] = __uint_as_float(__float_as_uint(mx) & ~63u); bid[it] = id;
        }
        float e[16], sum = 0.f;
#pragma unroll
        for (int k = 0; k < 16; ++k) { e[k] = __expf(best[k] - best[0]); sum += e[k]; }
        const float rinv = 1.f / sum;
        int* io = IDX + (size_t)tok * 128 + r * 16; float* go = GATE + (size_t)tok * 128 + r * 16;
#pragma unroll
        for (int k = 0; k < 16; ++k) { io[k] = bid[k]; go[k] = e[k] * rinv; }
    }
}

__device__ __forceinline__ float gelu_erf(float x) { return 0.5f * x * (1.f + erff(x * 0.70710678118654752f)); }
__device__ __forceinline__ void fp8x16_to_f32(const u32x4 q, float (&f)[16]) {
    const f32x2 c0 = __builtin_amdgcn_cvt_pk_f32_fp8(q.x, false), c1 = __builtin_amdgcn_cvt_pk_f32_fp8(q.x, true), c2 = __builtin_amdgcn_cvt_pk_f32_fp8(q.y, false), c3 = __builtin_amdgcn_cvt_pk_f32_fp8(q.y, true);
    const f32x2 c4 = __builtin_amdgcn_cvt_pk_f32_fp8(q.z, false), c5 = __builtin_amdgcn_cvt_pk_f32_fp8(q.z, true), c6 = __builtin_amdgcn_cvt_pk_f32_fp8(q.w, false), c7 = __builtin_amdgcn_cvt_pk_f32_fp8(q.w, true);
    f[0] = c0.x; f[1] = c0.y; f[2] = c1.x; f[3] = c1.y; f[4] = c2.x; f[5] = c2.y; f[6] = c3.x; f[7] = c3.y;
    f[8] = c4.x; f[9] = c4.y; f[10] = c5.x; f[11] = c5.y; f[12] = c6.x; f[13] = c6.y; f[14] = c7.x; f[15] = c7.y;
}
__device__ __forceinline__ void slice_group(int& x, int& gwx, int& nwx, int wave) {
    x = blockIdx.x & 7; const int nbx = ((int)gridDim.x - x + 7) >> 3; gwx = ((int)blockIdx.x >> 3) * 8 + wave; nwx = nbx * 8;
}
__device__ __forceinline__ void phase5u(const Params& p, LAS unsigned char* lds, int lane, int wave) {
    int x, gwx, nwx; slice_group(x, gwx, nwx, wave);
    const unsigned char* PU8 = p.ws + WS_PU8 + (size_t)x * 16384 * 128;
    const bf16_t* H2 = (const bf16_t*)(p.ws + WS_H2) + 128 * x;
    const int* IDX = (const int*)(p.ws + WS_IDX); float* PACT = (float*)(p.ws + WS_PACT) + (size_t)x * NT * 128;
    LAS int* l_idx = (LAS int*)(lds + wave * 512);
    const int g = lane >> 3, sub = lane & 7;
    const unsigned char* rowp = PU8 + sub * 16;
    int r_idxA = 0, r_idxB = 0;
    u32x4 hA0, hA1, hB0, hB1; hA0 = hA1 = hB0 = hB1 = (u32x4){0u, 0u, 0u, 0u};
    u32x4 qA[16], qB[16];
#define P5U_LOADIDX(T) do { if ((T) < NT) { r_idxA = IDX[(size_t)(T) * 128 + lane]; r_idxB = IDX[(size_t)(T) * 128 + 64 + lane]; } } while (0)
#define P5U_ISSUE(Q, H0, H1, T) do { if ((T) < NT) { l_idx[lane] = r_idxA; l_idx[64 + lane] = r_idxB; \
        H0 = *(const u32x4*)(H2 + (size_t)(T) * DM + 16 * sub); H1 = *(const u32x4*)(H2 + (size_t)(T) * DM + 16 * sub + 8); \
        _Pragma("unroll") for (int q_ = 0; q_ < 4; ++q_) { const u32x4 iv = *(const LAS u32x4*)(l_idx + 16 * g + 4 * q_); \
            Q[4 * q_] = *(const u32x4*)(rowp + (size_t)iv.x * 128); Q[4 * q_ + 1] = *(const u32x4*)(rowp + (size_t)iv.y * 128); \
            Q[4 * q_ + 2] = *(const u32x4*)(rowp + (size_t)iv.z * 128); Q[4 * q_ + 3] = *(const u32x4*)(rowp + (size_t)iv.w * 128); } } } while (0)
#define P5U_COMPUTE(Q, H0, H1, T) do { \
        f32x2 hf[8]; \
        hf[0] = (f32x2){bflo(H0.x), bfhi(H0.x)}; hf[1] = (f32x2){bflo(H0.y), bfhi(H0.y)}; hf[2] = (f32x2){bflo(H0.z), bfhi(H0.z)}; hf[3] = (f32x2){bflo(H0.w), bfhi(H0.w)}; \
        hf[4] = (f32x2){bflo(H1.x), bfhi(H1.x)}; hf[5] = (f32x2){bflo(H1.y), bfhi(H1.y)}; hf[6] = (f32x2){bflo(H1.z), bfhi(H1.z)}; hf[7] = (f32x2){bflo(H1.w), bfhi(H1.w)}; \
        float resA = 0.f, resB = 0.f; \
        _Pragma("unroll") for (int i = 0; i < 16; ++i) { \
            f32x2 s2 = __builtin_amdgcn_cvt_pk_f32_fp8(Q[i].x, false) * hf[0]; \
            s2 = __builtin_elementwise_fma(__builtin_amdgcn_cvt_pk_f32_fp8(Q[i].x, true), hf[1], s2); \
            s2 = __builtin_elementwise_fma(__builtin_amdgcn_cvt_pk_f32_fp8(Q[i].y, false), hf[2], s2); \
            s2 = __builtin_elementwise_fma(__builtin_amdgcn_cvt_pk_f32_fp8(Q[i].y, true), hf[3], s2); \
            s2 = __builtin_elementwise_fma(__builtin_amdgcn_cvt_pk_f32_fp8(Q[i].z, false), hf[4], s2); \
            s2 = __builtin_elementwise_fma(__builtin_amdgcn_cvt_pk_f32_fp8(Q[i].z, true), hf[5], s2); \
            s2 = __builtin_elementwise_fma(__builtin_amdgcn_cvt_pk_f32_fp8(Q[i].w, false), hf[6], s2); \
            s2 = __builtin_elementwise_fma(__builtin_amdgcn_cvt_pk_f32_fp8(Q[i].w, true), hf[7], s2); \
            float sr = s2.x + s2.y; \
            DPP_ADD(sr, 0xB1); DPP_ADD(sr, 0x4E); DPP_ADD(sr, 0x141); \
            if (i < 8) resA = (sub == i) ? sr : resA; else resB = (sub == i - 8) ? sr : resB; } \
        PACT[(size_t)(T) * 128 + 16 * g + sub] = resA; PACT[(size_t)(T) * 128 + 16 * g + 8 + sub] = resB; } while (0)
    int tok = gwx;
    P5U_LOADIDX(tok);
    P5U_ISSUE(qA, hA0, hA1, tok);
    P5U_LOADIDX(tok + nwx);
    for (; tok < NT; tok += 2 * nwx) {
        P5U_ISSUE(qB, hB0, hB1, tok + nwx);
        P5U_LOADIDX(tok + 2 * nwx);
        P5U_COMPUTE(qA, hA0, hA1, tok);
        if (tok + nwx >= NT) break;
        P5U_ISSUE(qA, hA0, hA1, tok + 2 * nwx);
        P5U_LOADIDX(tok + 3 * nwx);
        P5U_COMPUTE(qB, hB0, hB1, tok + nwx);
    }
#undef P5U_LOADIDX
#undef P5U_ISSUE
#undef P5U_COMPUTE
}
__device__ __forceinline__ void phase5c(const Params& p, int tid) {
    const float* PACT = (const float*)(p.ws + WS_PACT); const float* SCU = (const float*)(p.ws + WS_SCU); const float* SCV = (const float*)(p.ws + WS_SCV);
    const int* IDX = (const int*)(p.ws + WS_IDX); const float* GATE = (const float*)(p.ws + WS_GATE); float* COEF = (float*)(p.ws + WS_COEF);
    const size_t n = (size_t)NT * 128;
    for (size_t it = (size_t)blockIdx.x * 512 + tid; it < n; it += (size_t)gridDim.x * 512) {
        float a = 0.f;
#pragma unroll
        for (int xx = 0; xx < 8; ++xx) a += PACT[(size_t)xx * n + it];
        const int e = IDX[it];
        COEF[it] = GATE[it] * gelu_erf(a * SCU[e]) * SCV[e];
    }
}

constexpr int P5V_LDS_PER_WAVE = 1024 + 8 * 136 * 4;
__device__ __forceinline__ void phase5v(const Params& p, LAS unsigned char* lds, int lane, int wave) {
    int x, gwx, nwx; slice_group(x, gwx, nwx, wave);
    const unsigned char* PV8 = p.ws + WS_PV8 + (size_t)x * 16384 * 128;
    const int* IDX = (const int*)(p.ws + WS_IDX); const float* COEF = (const float*)(p.ws + WS_COEF);
    LAS int* l_idx = (LAS int*)(lds + wave * P5V_LDS_PER_WAVE); LAS float* l_cf = (LAS float*)(l_idx + 128); LAS float* red = l_cf + 128;
    const int g = lane >> 3, sub = lane & 7;
    const unsigned char* rowp = PV8 + sub * 16;
    const int c1 = 16 * (lane & 7) + (lane >> 3);
    int r_idxA = 0, r_idxB = 0; float r_cA = 0.f, r_cB = 0.f;
    u32x4 qA[16], qB[16]; f32x4 cfA[4], cfB[4]; float xA0 = 0.f, xA1 = 0.f, xB0 = 0.f, xB1 = 0.f;
#define P5V_LOADIDX(T) do { if ((T) < NT) { r_idxA = IDX[(size_t)(T) * 128 + lane]; r_idxB = IDX[(size_t)(T) * 128 + 64 + lane]; r_cA = COEF[(size_t)(T) * 128 + lane]; r_cB = COEF[(size_t)(T) * 128 + 64 + lane]; } } while (0)
#define P5V_ISSUE(Q, CF, X0, X1, T) do { if ((T) < NT) { l_idx[lane] = r_idxA; l_idx[64 + lane] = r_idxB; l_cf[lane] = r_cA; l_cf[64 + lane] = r_cB; \
        { const float* xr_ = p.out + (size_t)(T) * DM + 128 * x; X0 = xr_[c1]; X1 = xr_[c1 + 8]; } \
        _Pragma("unroll") for (int q_ = 0; q_ < 4; ++q_) { const u32x4 iv = *(const LAS u32x4*)(l_idx + 16 * g + 4 * q_); CF[q_] = *(const LAS f32x4*)(l_cf + 16 * g + 4 * q_); \
            Q[4 * q_] = *(const u32x4*)(rowp + (size_t)iv.x * 128); Q[4 * q_ + 1] = *(const u32x4*)(rowp + (size_t)iv.y * 128); \
            Q[4 * q_ + 2] = *(const u32x4*)(rowp + (size_t)iv.z * 128); Q[4 * q_ + 3] = *(const u32x4*)(rowp + (size_t)iv.w * 128); } } } while (0)
#define P5V_COMPUTE(Q, CF, X0, X1, T) do { \
        f32x2 acc[8]; \
        _Pragma("unroll") for (int j = 0; j < 8; ++j) acc[j] = (f32x2){0.f, 0.f}; \
        _Pragma("unroll") for (int i = 0; i < 16; ++i) { \
            const float cs_ = CF[i >> 2][i & 3]; const f32x2 c2 = (f32x2){cs_, cs_}; \
            acc[0] = __builtin_elementwise_fma(__builtin_amdgcn_cvt_pk_f32_fp8(Q[i].x, false), c2, acc[0]); \
            acc[1] = __builtin_elementwise_fma(__builtin_amdgcn_cvt_pk_f32_fp8(Q[i].x, true), c2, acc[1]); \
            acc[2] = __builtin_elementwise_fma(__builtin_amdgcn_cvt_pk_f32_fp8(Q[i].y, false), c2, acc[2]); \
            acc[3] = __builtin_elementwise_fma(__builtin_amdgcn_cvt_pk_f32_fp8(Q[i].y, true), c2, acc[3]); \
            acc[4] = __builtin_elementwise_fma(__builtin_amdgcn_cvt_pk_f32_fp8(Q[i].z, false), c2, acc[4]); \
            acc[5] = __builtin_elementwise_fma(__builtin_amdgcn_cvt_pk_f32_fp8(Q[i].z, true), c2, acc[5]); \
            acc[6] = __builtin_elementwise_fma(__builtin_amdgcn_cvt_pk_f32_fp8(Q[i].w, false), c2, acc[6]); \
            acc[7] = __builtin_elementwise_fma(__builtin_amdgcn_cvt_pk_f32_fp8(Q[i].w, true), c2, acc[7]); } \
        _Pragma("unroll") for (int j = 0; j < 8; ++j) { red[g * 136 + (2 * j) * 8 + sub] = acc[j].x; red[g * 136 + (2 * j + 1) * 8 + sub] = acc[j].y; } \
        float s1 = X0, s2_ = X1; \
        _Pragma("unroll") for (int gg = 0; gg < 8; ++gg) { s1 += red[gg * 136 + lane]; s2_ += red[gg * 136 + 64 + lane]; } \
        { float* xr_ = p.out + (size_t)(T) * DM + 128 * x; xr_[c1] = s1; xr_[c1 + 8] = s2_; } } while (0)
    int tok = gwx;
    P5V_LOADIDX(tok);
    P5V_ISSUE(qA, cfA, xA0, xA1, tok);
    P5V_LOADIDX(tok + nwx);
    for (; tok < NT; tok += 2 * nwx) {
        P5V_ISSUE(qB, cfB, xB0, xB1, tok + nwx);
        P5V_LOADIDX(tok + 2 * nwx);
        P5V_COMPUTE(qA, cfA, xA0, xA1, tok);
        if (tok + nwx >= NT) break;
        P5V_ISSUE(qA, cfA, xA0, xA1, tok + 2 * nwx);
        P5V_LOADIDX(tok + 3 * nwx);
        P5V_COMPUTE(qB, cfB, xB0, xB1, tok + nwx);
    }
#undef P5V_LOADIDX
#undef P5V_ISSUE
#undef P5V_COMPUTE
}

__device__ __forceinline__ void phase6(const Params& p, int lane, int wave) {
    const int gw = blockIdx.x * 8 + wave, NGW = gridDim.x * 8;
    const f32x4* gr = (const f32x4*)p.in[23] + lane;
    for (int m = gw; m < NT; m += NGW) {
        f32x4* xr = (f32x4*)(p.out + (size_t)m * DM) + lane;
        f32x4 v[4]; float s = 0.f;
#pragma unroll
        for (int j = 0; j < 4; ++j) { v[j] = xr[64 * j]; s += (v[j][0] * v[j][0] + v[j][1] * v[j][1]) + (v[j][2] * v[j][2] + v[j][3] * v[j][3]); }
        const float rstd = 1.f / sqrtf(wave_total(s) * (1.f / DM) + EPS);
#pragma unroll
        for (int j = 0; j < 4; ++j) xr[64 * j] = v[j] * rstd * gr[64 * j];
    }
}

__global__ void __launch_bounds__(512, 2) fwd_megakernel(Params p) {
    extern __shared__ __attribute__((aligned(16))) unsigned char lds_raw[];
    LAS unsigned char* lds = (LAS unsigned char*)lds_raw;
    cg::grid_group grid = cg::this_grid();
    const int tid = threadIdx.x, lane = tid & 63, wave = __builtin_amdgcn_readfirstlane(tid >> 6);
    const int G = gridDim.x;
    volatile LAS unsigned* MISC = (volatile LAS unsigned*)(lds + MISC_OFF);
    if (tid < 32) MISC[tid] = 0u;
    __syncthreads();
    XcdBarrier bar = xcd_barrier_post((unsigned*)(p.ws + WS_CTL) + 4096, MISC + 8);
#define GSYNC() xcd_barrier(bar)

#ifndef RPT_MASK
#define RPT_MASK 0
#endif
#if RPT_MASK
#define RPT(bit) for (int rpt_ = 0; rpt_ < (((RPT_MASK) >> (bit)) & 1) + 1; ++rpt_)
#else
#define RPT(bit) if (constexpr int rpt_ = 0; true)
#endif
    RPT(0) { phase0(p, lds, tid, lane, wave); grid.sync(); }
    RPT(1) {
        pg8::Gemm g{(const bf16_t*)(p.ws + WS_H), (const bf16_t*)(p.ws + WS_WINT), NT, DIN, 1024};
        pg8::StaticOrder S; S.init(NT, DIN, G, (int)blockIdx.x);
        pg8::EpiProj E{(bf16_t*)(p.ws + WS_A), (bf16_t*)(p.ws + WS_Q), (bf16_t*)(p.ws + WS_KP), (bf16_t*)(p.ws + WS_VP), (bf16_t*)(p.ws + WS_KS), (bf16_t*)(p.ws + WS_VS), p.out};
        pg8::gemm_phase<pg8::EpiProj, pg8::StaticOrder, true, true>(lds, g, S, E);
        {
            const int nwg = (NT / 256) * (DIN / 256), rem = nwg % G, c = (int)blockIdx.x;
            if (rem == 0) prep_late(p, lds, tid, lane, wave, c, G);
            else if (c >= rem) prep_late(p, lds, tid, lane, wave, c - rem, G - rem);
        }
        GSYNC();
    }
    #ifndef P2MODE
#define P2MODE 0
#endif
    RPT(2) { att::phase2(p, lds, tid, lane, wave, rpt_, (((RPT_MASK) >> 2) & 1) && rpt_ == 0 ? P2MODE : 0); GSYNC(); }
    RPT(3) {
        pg8::Gemm g{(const bf16_t*)(p.ws + WS_MIX), (const bf16_t*)(p.ws + WS_WOUTT), NT, 1024, 1024};
        pg8::StaticOrder S; S.init(NT, 1024, G, (int)blockIdx.x);
        pg8::EpiRes E{p.in[0], p.in[1], p.out};
        pg8::gemm_phase<pg8::EpiRes, pg8::StaticOrder, true, true>(lds, g, S, E);
        GSYNC();
    }
    RPT(4) { phase3b(p, lane, wave); GSYNC(); }
    RPT(5) {
        pg8::Gemm g{(const bf16_t*)(p.ws + WS_H2), (const bf16_t*)(p.ws + WS_WQT), NT, 2048, 1024};
        pg8::StaticOrder S; S.init(NT, 2048, G, (int)blockIdx.x);
        pg8::EpiBf16<0> E{(bf16_t*)(p.ws + WS_QP), 2048, nullptr, 0, 0, 1.f};
        pg8::gemm_phase<pg8::EpiBf16<0>, pg8::StaticOrder, true, true>(lds, g, S, E);
        GSYNC();
    }
    RPT(6) { phase4b(p, lds, tid, lane, wave); GSYNC(); }
    RPT(7) { phase5a(p, tid); GSYNC(); }
    RPT(8) { phase5u(p, lds, lane, wave); GSYNC(); }
    phase5c(p, tid);
    GSYNC();
    phase5v(p, lds, lane, wave);
    GSYNC();
    phase6(p, lane, wave);
}

extern "C" void kernel_launch(void* const* d_in, const int* in_sizes, int n_in, void* d_out, int out_size, void* d_ws, size_t ws_size, hipStream_t stream) {
    static int grid = 0;
    if (grid == 0) {
        if (n_in != 24 || out_size != (int)OUT_TOTAL || ws_size < WS_END) { fprintf(stderr, "kernel_launch: unexpected shapes: n_in %d out %d ws %zu (need %zu)\n", n_in, out_size, ws_size, (size_t)WS_END); grid = -1; return; }
        int dev = 0, cus = 0, per_cu = 0;
        (void)hipGetDevice(&dev);
        (void)hipDeviceGetAttribute(&cus, hipDeviceAttributeMultiprocessorCount, dev);
        if (hipFuncSetAttribute((const void*)fwd_megakernel, hipFuncAttributeMaxDynamicSharedMemorySize, LDS_BYTES) != hipSuccess) { fprintf(stderr, "kernel_launch: hipFuncSetAttribute failed\n"); grid = -1; return; }
        if (hipOccupancyMaxActiveBlocksPerMultiprocessor(&per_cu, (const void*)fwd_megakernel, 512, LDS_BYTES) != hipSuccess || per_cu < 1) { fprintf(stderr, "kernel_launch: occupancy query gave %d\n", per_cu); per_cu = 1; }
        (void)hipGetLastError();
        grid = cus * 1;
        if (per_cu < 1) grid = -1;
    }
    if (grid < 0) return;
    (void)hipMemsetAsync((char*)d_ws + WS_CTL, 0, CTL_BYTES, stream);
    Params p{};
    for (int i = 0; i < 24; ++i) p.in[i] = (const float*)d_in[i];
    p.out = (float*)d_out; p.ws = (unsigned char*)d_ws;
    void* args[] = {&p};
    hipError_t e = hipLaunchCooperativeKernel((const void*)fwd_megakernel, dim3(grid), dim3(512), args, LDS_BYTES, stream);
    if (e != hipSuccess) fprintf(stderr, "cooperative launch failed: %s (grid %d)\n", hipGetErrorString(e), grid);
}
```

```cpp
#include <hip/hip_runtime.h>
#include <hip/hip_cooperative_groups.h>
#include <cstdio>
#include <cstdint>
#include <cmath>
namespace cg = cooperative_groups;
#define CE_(a, b) do { const float t_ = fmaxf(a, b); b = fminf(a, b); a = t_; } while (0)
#define SORT16_DESC(V, O) do { CE_(V[(O)+0], V[(O)+1]); CE_(V[(O)+2], V[(O)+3]); CE_(V[(O)+0], V[(O)+2]); CE_(V[(O)+1], V[(O)+3]); CE_(V[(O)+1], V[(O)+2]); CE_(V[(O)+4], V[(O)+5]); CE_(V[(O)+6], V[(O)+7]); CE_(V[(O)+4], V[(O)+6]); CE_(V[(O)+5], V[(O)+7]); CE_(V[(O)+5], V[(O)+6]); CE_(V[(O)+0], V[(O)+4]); CE_(V[(O)+2], V[(O)+6]); CE_(V[(O)+2], V[(O)+4]); CE_(V[(O)+1], V[(O)+5]); CE_(V[(O)+3], V[(O)+7]); CE_(V[(O)+3], V[(O)+5]); CE_(V[(O)+1], V[(O)+2]); CE_(V[(O)+3], V[(O)+4]); CE_(V[(O)+5], V[(O)+6]); CE_(V[(O)+8], V[(O)+9]); CE_(V[(O)+10], V[(O)+11]); CE_(V[(O)+8], V[(O)+10]); CE_(V[(O)+9], V[(O)+11]); CE_(V[(O)+9], V[(O)+10]); CE_(V[(O)+12], V[(O)+13]); CE_(V[(O)+14], V[(O)+15]); CE_(V[(O)+12], V[(O)+14]); CE_(V[(O)+13], V[(O)+15]); CE_(V[(O)+13], V[(O)+14]); CE_(V[(O)+8], V[(O)+12]); CE_(V[(O)+10], V[(O)+14]); CE_(V[(O)+10], V[(O)+12]); CE_(V[(O)+9], V[(O)+13]); CE_(V[(O)+11], V[(O)+15]); CE_(V[(O)+11], V[(O)+13]); CE_(V[(O)+9], V[(O)+10]); CE_(V[(O)+11], V[(O)+12]); CE_(V[(O)+13], V[(O)+14]); CE_(V[(O)+0], V[(O)+8]); CE_(V[(O)+4], V[(O)+12]); CE_(V[(O)+4], V[(O)+8]); CE_(V[(O)+2], V[(O)+10]); CE_(V[(O)+6], V[(O)+14]); CE_(V[(O)+6], V[(O)+10]); CE_(V[(O)+2], V[(O)+4]); CE_(V[(O)+6], V[(O)+8]); CE_(V[(O)+10], V[(O)+12]); CE_(V[(O)+1], V[(O)+9]); CE_(V[(O)+5], V[(O)+13]); CE_(V[(O)+5], V[(O)+9]); CE_(V[(O)+3], V[(O)+11]); CE_(V[(O)+7], V[(O)+15]); CE_(V[(O)+7], V[(O)+11]); CE_(V[(O)+3], V[(O)+5]); CE_(V[(O)+7], V[(O)+9]); CE_(V[(O)+11], V[(O)+13]); CE_(V[(O)+1], V[(O)+2]); CE_(V[(O)+3], V[(O)+4]); CE_(V[(O)+5], V[(O)+6]); CE_(V[(O)+7], V[(O)+8]); CE_(V[(O)+9], V[(O)+10]); CE_(V[(O)+11], V[(O)+12]); CE_(V[(O)+13], V[(O)+14]); } while (0)
#define BITONIC16_DESC(V, O) do { CE_(V[(O)+0], V[(O)+8]); CE_(V[(O)+1], V[(O)+9]); CE_(V[(O)+2], V[(O)+10]); CE_(V[(O)+3], V[(O)+11]); CE_(V[(O)+4], V[(O)+12]); CE_(V[(O)+5], V[(O)+13]); CE_(V[(O)+6], V[(O)+14]); CE_(V[(O)+7], V[(O)+15]); CE_(V[(O)+0], V[(O)+4]); CE_(V[(O)+1], V[(O)+5]); CE_(V[(O)+2], V[(O)+6]); CE_(V[(O)+3], V[(O)+7]); CE_(V[(O)+8], V[(O)+12]); CE_(V[(O)+9], V[(O)+13]); CE_(V[(O)+10], V[(O)+14]); CE_(V[(O)+11], V[(O)+15]); CE_(V[(O)+0], V[(O)+2]); CE_(V[(O)+1], V[(O)+3]); CE_(V[(O)+4], V[(O)+6]); CE_(V[(O)+5], V[(O)+7]); CE_(V[(O)+8], V[(O)+10]); CE_(V[(O)+9], V[(O)+11]); CE_(V[(O)+12], V[(O)+14]); CE_(V[(O)+13], V[(O)+15]); CE_(V[(O)+0], V[(O)+1]); CE_(V[(O)+2], V[(O)+3]); CE_(V[(O)+4], V[(O)+5]); CE_(V[(O)+6], V[(O)+7]); CE_(V[(O)+8], V[(O)+9]); CE_(V[(O)+10], V[(O)+11]); CE_(V[(O)+12], V[(O)+13]); CE_(V[(O)+14], V[(O)+15]); } while (0)
namespace pg8 {
#define PG8_LAS __attribute__((address_space(3)))
typedef unsigned short bf16_t;
typedef short bf16x8 __attribute__((ext_vector_type(8)));
typedef float f32x4 __attribute__((ext_vector_type(4)));
typedef unsigned u32x4 __attribute__((ext_vector_type(4)));
constexpr int BM = 256, BK = 64, HALF = 128, HTB = HALF * BK * 2  , STAGE_BYTES = 8 * HTB, NXCD = 8, WGM = 8;

__host__ __device__ __forceinline__ int lds_byte(int r, int c) { const int st = (r >> 4) * 2 + (c >> 5), rr = r & 15, cc = c & 31, ob = rr * 64 + cc * 2; return st * 1024 + (ob ^ (((ob >> 9) & 1) << 5)); }
__host__ __device__ __forceinline__ void stage_rc(int b, int& R, int& C) { const int st = b / 1024, sb = b % 1024, swz = sb ^ (((sb >> 9) & 1) << 5); R = (st >> 1) * 16 + swz / 64; C = (st & 1) * 32 + (swz % 64) / 2; }
__host__ __device__ __forceinline__ int perm32(int rho) { const int n = rho >> 4, i = rho & 15; return 8 * (i >> 2) + 4 * n + (i & 3); }

struct Unit { int pm, pn; };
struct Gemm { const bf16_t* A; const bf16_t* Bt; int M, N, K; };

struct StaticOrder {
    int nM, nN, nwg, G, c;
    __host__ __device__ void init(int M, int N, int G_, int c_) { nM = M / BM; nN = N / BM; nwg = nM * nN; G = G_; c = c_; }
    __host__ __device__ bool next(int i, Unit& u) const {
        const long L = (long)i * G + c; if (L >= nwg) return false;
        int wgid = (int)L; { const int q = nwg / NXCD, r = nwg % NXCD, xcd = wgid % NXCD, off = wgid / NXCD; wgid = (xcd < r ? xcd * (q + 1) : r * (q + 1) + (xcd - r) * q) + off; }
        const int nig = WGM * nN, gid = wgid / nig, fm = gid * WGM, gsz = (nM - fm) < WGM ? (nM - fm) : WGM;
        u.pm = fm + ((wgid % nig) % gsz); u.pn = (wgid % nig) / gsz; return true;
    }
    __device__ __forceinline__ void a_ready(const Unit&) const {}
    __device__ __forceinline__ void done(const Unit&) const {}
};

__device__ __forceinline__ unsigned cvt_pk_bf16(float lo, float hi) { unsigned r; asm volatile("v_cvt_pk_bf16_f32 %0, %1, %2" : "=v"(r) : "v"(lo), "v"(hi)); return r; }
typedef float f32x2 __attribute__((ext_vector_type(2)));
__device__ __forceinline__ f32x2 gelu_pk(f32x2 v) {
    const f32x2 av = __builtin_elementwise_abs(v), d = av * 0.2316418882f + 1.0f;
    f32x2 t; t.x = __builtin_amdgcn_rcpf(d.x); t.y = __builtin_amdgcn_rcpf(d.y);
    f32x2 q = t * 0.5307027145f + (-0.7265760135f); q = q * t + 0.7107068705f; q = q * t + (-0.142248368f); q = q * t + 0.127414796f; q = q * t;
    const f32x2 s = (v * v) * (-0.72134752044f);
    f32x2 e; e.x = __builtin_amdgcn_exp2f(s.x); e.y = __builtin_amdgcn_exp2f(s.y);
    const f32x2 m = v * (q * e), r = v - m;
    f32x2 o; o.x = v.x < 0.f ? m.x : r.x; o.y = v.y < 0.f ? m.y : r.y; return o;
}

template <int ACT  > struct EpiBf16 {
    static constexpr bool PERM = true, AFTER_DRAIN = false; static_assert(ACT == 0 || ACT == 1, "EpiBf16: ACT is 0 (none) or 1 (gelu_pk)");
    bf16_t* O; int ldc; const float* bias; int split_cols; size_t split_stride; float scale0;
    __device__ __forceinline__ void operator()(const f32x4 (&acc)[2][2][4][2], const Unit& u, int wr, int wc, int fr, int fq) const {
        const int row0 = u.pm * BM + wr * 64 + fr; int colt = u.pn * BM; bf16_t* base = O;
        float sc = 1.f; if (split_cols) { const int t = colt / split_cols; base += (size_t)t * split_stride; colt -= t * split_cols; if (t == 0) sc = scale0; }
        const int col0 = colt + wc * 32 + 8 * fq, bcol0 = u.pn * BM + wc * 32 + 8 * fq;
        f32x4 bv[2][2];
#pragma unroll
        for (int bj = 0; bj < 2; ++bj)
#pragma unroll
            for (int n = 0; n < 2; ++n) bv[bj][n] = bias ? *(const f32x4*)(bias + bcol0 + bj * HALF + 4 * n) : (f32x4){0.f, 0.f, 0.f, 0.f};
#pragma unroll
        for (int ai = 0; ai < 2; ++ai)
#pragma unroll
            for (int m = 0; m < 4; ++m) { bf16_t* rowp = base + (size_t)(row0 + ai * HALF + m * 16) * ldc + col0;
#pragma unroll
                for (int bj = 0; bj < 2; ++bj) { f32x4 v0 = acc[ai][bj][m][0] + bv[bj][0], v1 = acc[ai][bj][m][1] + bv[bj][1];
                    if (ACT == 1) { f32x2 a = gelu_pk((f32x2){v0[0], v0[1]}), b = gelu_pk((f32x2){v0[2], v0[3]}), c = gelu_pk((f32x2){v1[0], v1[1]}), d = gelu_pk((f32x2){v1[2], v1[3]});
                        v0 = (f32x4){a.x, a.y, b.x, b.y}; v1 = (f32x4){c.x, c.y, d.x, d.y}; }
                    v0 = v0 * sc; v1 = v1 * sc; u32x4 w; w.x = cvt_pk_bf16(v0[0], v0[1]); w.y = cvt_pk_bf16(v0[2], v0[3]); w.z = cvt_pk_bf16(v1[0], v1[1]); w.w = cvt_pk_bf16(v1[2], v1[3]);
                    *(u32x4*)(rowp + bj * HALF) = w; } }
    }
};
template <class Epi, class Sched, bool ALIGN_EPI = false, bool SP2 = false>
__device__ __forceinline__ void gemm_phase(PG8_LAS unsigned char* lds, const Gemm g, const Sched& S, const Epi& E) {
    const int tid = threadIdx.x, wid = __builtin_amdgcn_readfirstlane(tid >> 6), lane = tid & 63, wr = wid >> 2, wc = wid & 3, fr = lane & 15, fq = lane >> 4;
    const int K = g.K, nt = K / BK;
    unsigned voffA[2], voffB[2];
#pragma unroll
    for (int i = 0; i < 2; ++i) { int R, C; stage_rc(tid * 16 + i * 8192, R, C); const int Rb = Epi::PERM ? ((R & ~31) + perm32(R & 31)) : R;
        voffA[i] = (unsigned)(R * K + C) * 2u; voffB[i] = (unsigned)(Rb * K + C) * 2u; }
    const size_t kstep = (size_t)(BK * 2);
    const size_t hstep = (size_t)HALF * K * 2;
    const size_t tstep = 2 * hstep;
    const unsigned ldsw = (unsigned)wid * 1024u;
    const int aoff = lds_byte(wr * 64 + fr, fq * 8), boff = lds_byte(wc * 32 + fr, fq * 8);
#define PG8_SA(b, h) (((b) * 2 + (h)) * HTB)
#define PG8_SB(b, h) ((4 + (b) * 2 + (h)) * HTB)
#define PG8_STAGE(bufoff, gbase, voff) do { _Pragma("unroll") for (int _i = 0; _i < 2; ++_i) \
        __builtin_amdgcn_global_load_lds((const unsigned*)((const char*)(gbase) + (voff)[_i]), (PG8_LAS unsigned*)(lds + (bufoff) + ldsw + _i * 8192), 16, 0, 0); } while (0)
#define PG8_LDA(dst, b, h) do { _Pragma("unroll") for (int m = 0; m < 4; ++m) _Pragma("unroll") for (int k = 0; k < 2; ++k) dst[m][k] = *(const PG8_LAS bf16x8*)(lds + PG8_SA(b, h) + aoff + m * 2048 + k * 1024); } while (0)
#define PG8_LDB(dst, b, h) do { _Pragma("unroll") for (int n = 0; n < 2; ++n) _Pragma("unroll") for (int k = 0; k < 2; ++k) dst[n][k] = *(const PG8_LAS bf16x8*)(lds + PG8_SB(b, h) + boff + n * 2048 + k * 1024); } while (0)
#define PG8_MMA(ai, bj, At, Bt) do { __builtin_amdgcn_s_setprio(1); _Pragma("unroll") for (int m = 0; m < 4; ++m) _Pragma("unroll") for (int n = 0; n < 2; ++n) _Pragma("unroll") for (int k = 0; k < 2; ++k) \
        acc[ai][bj][m][n] = __builtin_amdgcn_mfma_f32_16x16x32_bf16(Bt[n][k], At[m][k], acc[ai][bj][m][n], 0, 0, 0); __builtin_amdgcn_s_setprio(0); } while (0)
#define PG8_WAIT_V(n) asm volatile("s_waitcnt vmcnt(" #n ")" ::: "memory")
#define PG8_WAIT_L(n) asm volatile("s_waitcnt lgkmcnt(" #n ")" ::: "memory")
#define PG8_BAR __builtin_amdgcn_s_barrier()
#define PG8_SCHED __builtin_amdgcn_sched_barrier(0)
    Unit cur, nxt; int ui = 0;
    if (!S.next(0, cur)) return;
    f32x4 acc[2][2][4][2];
#pragma unroll
    for (int a = 0; a < 2; ++a)
#pragma unroll
        for (int b = 0; b < 2; ++b)
#pragma unroll
            for (int m = 0; m < 4; ++m)
#pragma unroll
                for (int n = 0; n < 2; ++n) acc[a][b][m][n] = (f32x4){0.f, 0.f, 0.f, 0.f};
    bf16x8 At[4][2], B0[2][2], B1[2][2];
    const char* cA = (const char*)g.A + (size_t)cur.pm * tstep; const char* cB = (const char*)g.Bt + (size_t)cur.pn * tstep;
    S.a_ready(cur);
    if constexpr (SP2) {
        PG8_STAGE(PG8_SB(0, 0), cB, voffB); PG8_STAGE(PG8_SB(0, 1), cB + hstep, voffB); PG8_STAGE(PG8_SA(0, 0), cA, voffA); PG8_STAGE(PG8_SA(0, 1), cA + hstep, voffA);
        if (wr == 1) PG8_BAR;
        PG8_WAIT_V(2); PG8_BAR;
        PG8_STAGE(PG8_SB(1, 0), cB + kstep, voffB); PG8_STAGE(PG8_SA(1, 0), cA + kstep, voffA); PG8_STAGE(PG8_SB(1, 1), cB + hstep + kstep, voffB);
        PG8_WAIT_V(6); PG8_BAR;
    } else {
        PG8_STAGE(PG8_SB(0, 0), cB, voffB); PG8_STAGE(PG8_SA(0, 0), cA, voffA); PG8_STAGE(PG8_SB(0, 1), cB + hstep, voffB); PG8_STAGE(PG8_SA(0, 1), cA + hstep, voffA);
        if (wr == 1) PG8_BAR;
        PG8_WAIT_V(4); PG8_BAR;
        PG8_STAGE(PG8_SB(1, 0), cB + kstep, voffB); PG8_STAGE(PG8_SA(1, 0), cA + kstep, voffA); PG8_STAGE(PG8_SB(1, 1), cB + hstep + kstep, voffB);
        PG8_WAIT_V(6); PG8_BAR;
    }
    for (;;) {
        const bool has_next = S.next(ui + 1, nxt);
        const char* nA = has_next ? (const char*)g.A + (size_t)nxt.pm * tstep : cA; const char* nB = has_next ? (const char*)g.Bt + (size_t)nxt.pn * tstep : cB;
        for (int t = 0; t < nt; t += 2) {
            const bool last = (t == nt - 2);
            const char* a1 = cA + (size_t)(t + 1) * kstep;
            const char* a2 = last ? nA : cA + (size_t)(t + 2) * kstep; const char* b2 = last ? nB : cB + (size_t)(t + 2) * kstep;
            const char* a3 = a2 + kstep; const char* b3 = b2 + kstep;
            if (last && has_next) S.a_ready(nxt);
            if constexpr (SP2) {
            PG8_LDB(B0, 0, 0); PG8_LDB(B1, 0, 1); PG8_SCHED; PG8_LDA(At, 0, 0); PG8_STAGE(PG8_SA(1, 1), a1 + hstep, voffA);
            PG8_WAIT_V(8); PG8_WAIT_L(0); PG8_BAR; PG8_MMA(0, 0, At, B0); PG8_MMA(0, 1, At, B1); PG8_BAR; PG8_SCHED;
            PG8_LDA(At, 0, 1); PG8_STAGE(PG8_SB(0, 0), b2, voffB); PG8_STAGE(PG8_SB(0, 1), b2 + hstep, voffB); PG8_STAGE(PG8_SA(0, 0), a2, voffA);
            PG8_WAIT_V(8); PG8_WAIT_L(0); PG8_BAR; PG8_MMA(1, 0, At, B0); PG8_MMA(1, 1, At, B1); PG8_BAR; PG8_SCHED;
            PG8_LDB(B0, 1, 0); PG8_LDB(B1, 1, 1); PG8_SCHED; PG8_LDA(At, 1, 0); PG8_STAGE(PG8_SA(0, 1), a2 + hstep, voffA);
            PG8_WAIT_V(8); PG8_WAIT_L(0); PG8_BAR; PG8_MMA(0, 0, At, B0); PG8_MMA(0, 1, At, B1); PG8_BAR; PG8_SCHED;
            PG8_LDA(At, 1, 1); PG8_STAGE(PG8_SB(1, 0), b3, voffB); PG8_STAGE(PG8_SB(1, 1), b3 + hstep, voffB); PG8_STAGE(PG8_SA(1, 0), a3, voffA);
            PG8_WAIT_V(8); PG8_WAIT_L(0); PG8_BAR; PG8_MMA(1, 0, At, B0); PG8_MMA(1, 1, At, B1); PG8_BAR; PG8_SCHED;
            } else {
            PG8_LDB(B0, 0, 0); PG8_SCHED; PG8_LDA(At, 0, 0); PG8_STAGE(PG8_SA(1, 1), a1 + hstep, voffA);
            PG8_WAIT_L(8); PG8_BAR; PG8_WAIT_L(0); PG8_MMA(0, 0, At, B0); PG8_BAR; PG8_SCHED;
            PG8_LDB(B1, 0, 1); PG8_STAGE(PG8_SB(0, 0), b2, voffB);
            PG8_BAR; PG8_WAIT_L(0); PG8_MMA(0, 1, At, B1); PG8_BAR;
            PG8_LDA(At, 0, 1); PG8_STAGE(PG8_SA(0, 0), a2, voffA);
            PG8_BAR; PG8_WAIT_L(0); PG8_MMA(1, 0, At, B0); PG8_BAR; PG8_SCHED;
            PG8_STAGE(PG8_SB(0, 1), b2 + hstep, voffB);
            PG8_WAIT_V(6); PG8_BAR; PG8_MMA(1, 1, At, B1); PG8_BAR;
            PG8_LDB(B0, 1, 0); PG8_SCHED; PG8_LDA(At, 1, 0); PG8_STAGE(PG8_SA(0, 1), a2 + hstep, voffA);
            PG8_WAIT_L(8); PG8_BAR; PG8_WAIT_L(0); PG8_MMA(0, 0, At, B0); PG8_BAR; PG8_SCHED;
            PG8_LDB(B1, 1, 1); PG8_STAGE(PG8_SB(1, 0), b3, voffB);
            PG8_BAR; PG8_WAIT_L(0); PG8_MMA(0, 1, At, B1); PG8_BAR;
            PG8_LDA(At, 1, 1); PG8_STAGE(PG8_SA(1, 0), a3, voffA);
            PG8_BAR; PG8_WAIT_L(0); PG8_MMA(1, 0, At, B0); PG8_BAR; PG8_SCHED;
            PG8_STAGE(PG8_SB(1, 1), b3 + hstep, voffB);
            PG8_WAIT_V(6); PG8_BAR; PG8_MMA(1, 1, At, B1); PG8_BAR;
            }
        }
        if constexpr (ALIGN_EPI) { if (wr == 0) PG8_BAR; }
        if constexpr (!Epi::AFTER_DRAIN) { E(acc, cur, wr, wc, fr, fq); S.done(cur); }
        if (!has_next) break;
#pragma unroll
        for (int a = 0; a < 2; ++a)
#pragma unroll
            for (int b = 0; b < 2; ++b)
#pragma unroll
                for (int m = 0; m < 4; ++m)
#pragma unroll
                    for (int n = 0; n < 2; ++n) acc[a][b][m][n] = (f32x4){0.f, 0.f, 0.f, 0.f};
        cur = nxt; cA = nA; cB = nB; ++ui;
        if constexpr (ALIGN_EPI) { if (wr == 1) PG8_BAR; }
    }
    PG8_WAIT_V(0);
    if constexpr (!ALIGN_EPI) { if (wr == 0) PG8_BAR; }
    PG8_BAR;
    if constexpr (Epi::AFTER_DRAIN) { E.fused(acc, cur, wr, wc, fr, fq, lds, wid, lane); S.done(cur); }
#undef PG8_SA
#undef PG8_SB
#undef PG8_STAGE
#undef PG8_LDA
#undef PG8_LDB
#undef PG8_MMA
#undef PG8_WAIT_V
#undef PG8_WAIT_L
#undef PG8_BAR
#undef PG8_SCHED
}
}

#define LAS __attribute__((address_space(3)))
typedef unsigned short bf16_t;
typedef short bf16x8 __attribute__((ext_vector_type(8)));
typedef short s16x4 __attribute__((ext_vector_type(4)));
typedef float f32x4 __attribute__((ext_vector_type(4)));
typedef float f32x16 __attribute__((ext_vector_type(16)));
typedef unsigned u32x4 __attribute__((ext_vector_type(4)));
typedef unsigned u32x2 __attribute__((ext_vector_type(2)));

constexpr int DM = 1024;
constexpr int NP = 16 * 2048;
constexpr int NS = 8 * 64;
constexpr int NT = NP + NS;
constexpr int DIN = 2560;
constexpr int SKV = 2112;
constexpr float EPS = 1e-6f;
constexpr float LOG2E = 1.4426950408889634f;
constexpr float QSCALE = 0.125f * LOG2E;

constexpr long OUT_Y = 0;
constexpr long OUT_KP = 34078720L, OUT_VP = 50855936L, OUT_CONVP = 67633152L, OUT_KS = 67878912L, OUT_VS = 68141056L, OUT_CONVS = 68403200L, OUT_TOTAL = 68526080L;

constexpr size_t MiB = 1u << 20;
constexpr size_t WS_CTL = 0, CTL_BYTES = 1 * MiB;
constexpr size_t WS_WINT = 1 * MiB;
constexpr size_t WS_WOUTT = 6 * MiB;
constexpr size_t WS_WQT = 8 * MiB;
constexpr size_t WS_SK = 12 * MiB;
constexpr size_t WS_PU8 = 16 * MiB;
constexpr size_t WS_PV8 = 32 * MiB;
constexpr size_t WS_SCU = 48 * MiB;
constexpr size_t WS_SCV = 49 * MiB;
constexpr size_t WS_KS = 80 * MiB;
constexpr size_t WS_VS = 97 * MiB;
constexpr size_t WS_H = 114 * MiB;
constexpr size_t WS_A = 179 * MiB;
constexpr size_t WS_Q = 212 * MiB;
constexpr size_t WS_QP = 114 * MiB;
constexpr size_t WS_KP = 245 * MiB;
constexpr size_t WS_VP = 277 * MiB;
constexpr size_t WS_MIX = 309 * MiB;
constexpr size_t WS_H2 = 309 * MiB;
constexpr size_t WS_TK = 375 * MiB;
constexpr size_t WS_IDX = 408 * MiB;
constexpr size_t WS_GATE = 425 * MiB;
constexpr size_t WS_PACT = 114 * MiB;
constexpr size_t WS_COEF = 375 * MiB;
constexpr size_t WS_END = 442 * MiB;
static_assert(WS_H + (size_t)NT * 1024 * 2 <= WS_A && WS_A + (size_t)NT * 512 * 2 <= WS_Q && WS_Q + (size_t)NT * 512 * 2 <= WS_KP, "R1");
static_assert(WS_QP + (size_t)NT * 2048 * 2 <= WS_KP && WS_KP + (size_t)NP * 512 * 2 <= WS_VP && WS_VP + (size_t)NP * 512 * 2 <= WS_MIX, "ws map");
static_assert(WS_MIX + (size_t)NT * 1024 * 2 <= WS_TK && WS_TK + (size_t)NT * 256 * 4 <= WS_IDX && WS_IDX + (size_t)NT * 128 * 4 <= WS_GATE && WS_GATE + (size_t)NT * 128 * 4 <= WS_END, "ws map 2");
static_assert(WS_KS + (size_t)8 * SKV * 512 * 2 <= WS_VS && WS_VS + (size_t)8 * SKV * 512 * 2 <= WS_H, "ws map 3");

constexpr int RING_BYTES = 131072;
constexpr int BIAS_OFF = RING_BYTES;
constexpr int MISC_OFF = RING_BYTES + 5120;
constexpr int LDS_BYTES = MISC_OFF + 1024;

struct Params {
    const float* in[24];
    float* out;
    unsigned char* ws;
};

__device__ __forceinline__ unsigned cvtpk(float lo, float hi) { return pg8::cvt_pk_bf16(lo, hi); }
__device__ __forceinline__ float bflo(unsigned w) { return __uint_as_float(w << 16); }
__device__ __forceinline__ float bfhi(unsigned w) { return __uint_as_float(w & 0xffff0000u); }
__device__ __forceinline__ float wave_sum(float v) {
#pragma unroll
    for (int o = 1; o < 64; o <<= 1) v += __shfl_xor(v, o);
    return v;
}
typedef float f32x2 __attribute__((ext_vector_type(2)));
#define DPP_ADD(v, ctrl) v += __builtin_bit_cast(float, __builtin_amdgcn_update_dpp(0, __builtin_bit_cast(int, v), ctrl, 0xf, 0xf, true))
__device__ __forceinline__ float rl_f(float v, int l) { return __uint_as_float(__builtin_amdgcn_readlane(__float_as_uint(v), l)); }
__device__ __forceinline__ float wave_total(float v) {
    DPP_ADD(v, 0xB1); DPP_ADD(v, 0x4E); DPP_ADD(v, 0x141); DPP_ADD(v, 0x140);
    return (rl_f(v, 0) + rl_f(v, 16)) + (rl_f(v, 32) + rl_f(v, 48));
}
typedef __bf16 bf16x2_t __attribute__((ext_vector_type(2)));
__device__ __forceinline__ float dot2(unsigned a, unsigned b, float acc) {
    return __builtin_amdgcn_fdot2_f32_bf16(__builtin_bit_cast(bf16x2_t, a), __builtin_bit_cast(bf16x2_t, b), acc, false);
}
#define LDS_WAIT() asm volatile("s_waitcnt lgkmcnt(0)" ::: "memory")

#define XB_TMO      128
#define XB_XCNT(j)  (256  + 64 * (j))
#define XB_XSUB(j)  (1280 + 64 * (j))
#define XB_XGEN(j)  (2304 + 64 * (j))
#define XB_TOP      3328
#define XB_TOPGEN   3392
#define XCD_BAR_WORDS 3456
#define XB_SPIN_CAP (1u << 18)

__device__ __forceinline__ unsigned xb_ld(unsigned* p)              { return __hip_atomic_load(p, __ATOMIC_RELAXED, __HIP_MEMORY_SCOPE_AGENT); }
__device__ __forceinline__ unsigned xb_add(unsigned* p, unsigned v) { return __hip_atomic_fetch_add(p, v, __ATOMIC_RELAXED, __HIP_MEMORY_SCOPE_AGENT); }
__device__ __forceinline__ unsigned xb_xcc_id() { return (unsigned)__builtin_amdgcn_s_getreg((3 << 11) | 20) & 0xFu; }
#define XB_SPIN(cond, bar) do { unsigned _sp = 0; while (cond) { __builtin_amdgcn_s_sleep(1); \
    if ((++_sp & 255u) == 0u) { if (xb_ld(&(bar)[XB_TMO])) break; if (_sp > XB_SPIN_CAP) { atomicAdd(&(bar)[XB_TMO], 1u); break; } } } } while (0)

struct XcdBarrier {
    unsigned* bar; unsigned x;
    volatile LAS unsigned* st;
};

__device__ __forceinline__ XcdBarrier xcd_barrier_post(unsigned* bar, volatile LAS unsigned* st) {
    XcdBarrier b; b.bar = bar; b.x = xb_xcc_id(); b.st = st;
    if (threadIdx.x == 0) (void)xb_add(&bar[XB_XCNT(b.x)], 1u);
    return b;
}
__device__ __forceinline__ void xcd_barrier_complete(unsigned* bar, unsigned x, unsigned& nloc, unsigned& nx) {
    const unsigned G = gridDim.x * gridDim.y * gridDim.z;
    unsigned sum, cnt, mine, sp = 0u;
    for (;;) {
        sum = 0u; cnt = 0u; mine = 0u;
#pragma unroll
        for (unsigned j = 0; j < 16; ++j) { const unsigned c = xb_ld(&bar[XB_XCNT(j)]); sum += c; cnt += (c > 0u) ? 1u : 0u; mine = (j == x) ? c : mine; }
        if (sum == G) break;
        __builtin_amdgcn_s_sleep(1);
        if ((++sp & 255u) == 0u) { if (xb_ld(&bar[XB_TMO])) break; if (sp > XB_SPIN_CAP) { atomicAdd(&bar[XB_TMO], 1u); break; } }
    }
    nloc = mine > 0u ? mine : 1u; nx = cnt > 0u ? cnt : 1u;
}

__device__ __forceinline__ void xcd_barrier(const XcdBarrier& b) {
    asm volatile("s_waitcnt vmcnt(0)" ::: "memory");
    __syncthreads();
    if (threadIdx.x == 0) {
        unsigned* bar = b.bar;
        __builtin_amdgcn_s_waitcnt(0);
        unsigned nloc = b.st[0], nx = b.st[1];
        if (nloc == 0u) { xcd_barrier_complete(bar, b.x, nloc, nx); b.st[0] = nloc; b.st[1] = nx; }
        const unsigned old = xb_add(&bar[XB_XSUB(b.x)], 1u);
        const unsigned gen = old / nloc;
        if (old + 1u == (gen + 1u) * nloc) {
            __builtin_amdgcn_fence(__ATOMIC_RELEASE, "agent");
            asm volatile("s_waitcnt vmcnt(0)" ::: "memory");
            const unsigned og = xb_add(&bar[XB_TOP], 1u);
            const unsigned tg = og / nx;
            if (og + 1u == (tg + 1u) * nx) xb_add(&bar[XB_TOPGEN], 1u);
            else XB_SPIN(xb_ld(&bar[XB_TOPGEN]) == tg, bar);
            __builtin_amdgcn_fence(__ATOMIC_ACQUIRE, "agent");
            xb_add(&bar[XB_XGEN(b.x)], 1u);
            asm volatile("s_waitcnt vmcnt(0)" ::: "memory");
        } else {
            XB_SPIN(xb_ld(&bar[XB_XGEN(b.x)]) == gen, bar);
            __builtin_amdgcn_fence(__ATOMIC_ACQUIRE, "agent");
            asm volatile("s_waitcnt vmcnt(0)" ::: "memory");
        }
    }
    __syncthreads();
}


namespace pg8 {
__device__ __forceinline__ u32x2 pack4(f32x4 v) { u32x2 w; w.x = cvt_pk_bf16(v[0], v[1]); w.y = cvt_pk_bf16(v[2], v[3]); return w; }
struct EpiProj {
    static constexpr bool PERM = false, AFTER_DRAIN = false;
    bf16_t* A; bf16_t* Q; bf16_t* KP; bf16_t* VP; bf16_t* KS; bf16_t* VS; float* out;
    __device__ __forceinline__ void operator()(const f32x4 (&acc)[2][2][4][2], const Unit& u, int wr, int wc, int fr, int fq) const {
        const int pn = u.pn;
        const int row0 = u.pm * BM + wr * 64 + fr;
        if (pn < 4) {
#pragma unroll
            for (int ai = 0; ai < 2; ++ai)
#pragma unroll
                for (int m = 0; m < 4; ++m) {
                    const int row = row0 + ai * HALF + m * 16;
                    long toff = -1;
                    if (row < NP) { const int s = row & 2047; if (s >= 2018) toff = OUT_CONVP + ((long)(row >> 11) * 30 + (s - 2018)) * 512; }
                    else { const int rr = row - NP; const int i = rr & 63; if (i >= 34) toff = OUT_CONVS + ((long)(rr >> 6) * 30 + (i - 34)) * 512; }
#pragma unroll
                    for (int n = 0; n < 2; ++n) {
                        const int c = 128 * pn + 32 * wc + 16 * n + 4 * fq;
                        const f32x4 x = acc[ai][0][m][n], g = acc[ai][1][m][n];
                        f32x4 a;
#pragma unroll
                        for (int j = 0; j < 4; ++j) a[j] = x[j] / (1.f + __expf(-g[j]));
                        *(u32x2*)(A + (size_t)row * 512 + c) = pack4(a);
                        if (toff >= 0) *(f32x4*)(out + toff + c) = a;
                    }
                }
        } else {
            const int sec = (pn - 4) >> 1, colbase = ((pn - 4) & 1) * 256;
#pragma unroll
            for (int ai = 0; ai < 2; ++ai)
#pragma unroll
                for (int m = 0; m < 4; ++m) {
                    const int row = row0 + ai * HALF + m * 16;
                    const bool isp = row < NP; const int rr = row - NP;
                    bf16_t* bdst; float* fdst;
                    if (sec == 0) { bdst = Q + (size_t)row * 512; fdst = nullptr; }
                    else if (sec == 1) { bdst = isp ? KP + (size_t)row * 512 : KS + ((size_t)(rr >> 6) * SKV + 2048 + (rr & 63)) * 512; fdst = isp ? out + OUT_KP + (size_t)row * 512 : out + OUT_KS + (size_t)rr * 512; }
                    else { bdst = isp ? VP + (size_t)row * 512 : VS + ((size_t)(rr >> 6) * SKV + 2048 + (rr & 63)) * 512; fdst = isp ? out + OUT_VP + (size_t)row * 512 : out + OUT_VS + (size_t)rr * 512; }
#pragma unroll
                    for (int bj = 0; bj < 2; ++bj)
#pragma unroll
                        for (int n = 0; n < 2; ++n) {
                            const int col = colbase + 128 * bj + 32 * wc + 16 * n + 4 * fq;
                            const f32x4 v = acc[ai][bj][m][n];
                            if (sec == 0) { *(u32x2*)(bdst + col) = pack4(v * QSCALE); }
                            else { *(u32x2*)(bdst + col) = pack4(v); *(f32x4*)(fdst + col) = v; }
                        }
                }
        }
    }
};
struct EpiRes {
    static constexpr bool PERM = false, AFTER_DRAIN = false;
    const float* xp; const float* xs; float* out;
    __device__ __forceinline__ void operator()(const f32x4 (&acc)[2][2][4][2], const Unit& u, int wr, int wc, int fr, int fq) const {
        const int row0 = u.pm * BM + wr * 64 + fr;
#pragma unroll
        for (int ai = 0; ai < 2; ++ai)
#pragma unroll
            for (int m = 0; m < 4; ++m) {
                const int row = row0 + ai * HALF + m * 16;
                const float* xr = row < NP ? xp + (size_t)row * DM : xs + (size_t)(row - NP) * DM;
                float* orow = out + (size_t)row * DM;
#pragma unroll
                for (int bj = 0; bj < 2; ++bj)
#pragma unroll
                    for (int n = 0; n < 2; ++n) {
                        const int col = u.pn * BM + 128 * bj + 32 * wc + 16 * n + 4 * fq;
                        *(f32x4*)(orow + col) = *(const f32x4*)(xr + col) + acc[ai][bj][m][n];
                    }
            }
    }
};
}

__device__ __forceinline__ int winrow(int n) { return n < 1024 ? (256 * ((n & 511) >> 7) + 128 * (n >> 9) + (n & 127)) : n; }
template <bool WIN> __device__ __forceinline__ void transpose_item(const float* W, int K, int N, bf16_t* WT, LAS float* scr, int item, int lane) {
    const int nblk = N / 32, kb = item / nblk, nb = item % nblk, k0 = 64 * kb, n0 = 32 * nb;
#pragma unroll 8
    for (int i = 0; i < 32; ++i) { const int kk = 2 * i + (lane >> 5); scr[kk * 33 + (lane & 31)] = W[(size_t)(k0 + kk) * N + n0 + (lane & 31)]; }
    LDS_WAIT();
    const int c = lane & 7;
#pragma unroll
    for (int j = 0; j < 4; ++j) {
        const int n = (lane >> 3) + 8 * j; const LAS float* s = scr + (8 * c) * 33 + n;
        u32x4 o; o.x = cvtpk(s[0 * 33], s[1 * 33]); o.y = cvtpk(s[2 * 33], s[3 * 33]); o.z = cvtpk(s[4 * 33], s[5 * 33]); o.w = cvtpk(s[6 * 33], s[7 * 33]);
        const int dr = WIN ? winrow(n0 + n) : (n0 + n);
        *(u32x4*)(WT + (size_t)dr * K + k0 + 8 * c) = o;
    }
    LDS_WAIT();
}
__device__ __forceinline__ void cvt_stream(const float* src, bf16_t* dst, size_t n8, size_t gt, size_t ngt) {
    for (size_t i = gt; i < n8; i += ngt) {
        const f32x4 a = *(const f32x4*)(src + i * 8), b = *(const f32x4*)(src + i * 8 + 4);
        u32x4 o; o.x = cvtpk(a[0], a[1]); o.y = cvtpk(a[2], a[3]); o.z = cvtpk(b[0], b[1]); o.w = cvtpk(b[2], b[3]);
        *(u32x4*)(dst + i * 8) = o;
    }
}
__device__ __forceinline__ void cvt_cache(const float* src, bf16_t* dst, size_t gt, size_t ngt) {
    const size_t n8 = (size_t)8 * 2048 * 512 / 8;
    for (size_t i = gt; i < n8; i += ngt) {
        const size_t e = i * 8; const size_t row = e >> 9, col = e & 511; const size_t drow = (row >> 11) * SKV + (row & 2047);
        const f32x4 a = *(const f32x4*)(src + e), b = *(const f32x4*)(src + e + 4);
        u32x4 o; o.x = cvtpk(a[0], a[1]); o.y = cvtpk(a[2], a[3]); o.z = cvtpk(b[0], b[1]); o.w = cvtpk(b[2], b[3]);
        *(u32x4*)(dst + drow * 512 + col) = o;
    }
}
__device__ __forceinline__ void rms_row_bf16(const float* xrow, const float* g, bf16_t* orow, int lane) {
    const f32x4* xr = (const f32x4*)xrow + lane; const f32x4* gr = (const f32x4*)g + lane;
    f32x4 v[4]; float s = 0.f;
#pragma unroll
    for (int j = 0; j < 4; ++j) { v[j] = xr[64 * j]; s += (v[j][0] * v[j][0] + v[j][1] * v[j][1]) + (v[j][2] * v[j][2] + v[j][3] * v[j][3]); }
    const float rstd = 1.f / sqrtf(wave_sum(s) * (1.f / DM) + EPS);
    u32x2* o8 = (u32x2*)orow + lane;
#pragma unroll
    for (int j = 0; j < 4; ++j) { const f32x4 gg = gr[64 * j]; u32x2 w; w.x = cvtpk(v[j][0] * rstd * gg[0], v[j][1] * rstd * gg[1]); w.y = cvtpk(v[j][2] * rstd * gg[2], v[j][3] * rstd * gg[3]); o8[64 * j] = w; }
}

template <bool SLICED> __device__ __forceinline__ void cvt_row_fp8(const float* src, unsigned char* dst_base, int row, float* scale_out, int lane) {
    const f32x4* xr = (const f32x4*)src + lane;
    f32x4 v[4]; float am = 0.f;
#pragma unroll
    for (int j = 0; j < 4; ++j) { v[j] = xr[64 * j]; am = fmaxf(am, fmaxf(fmaxf(fabsf(v[j][0]), fabsf(v[j][1])), fmaxf(fabsf(v[j][2]), fabsf(v[j][3])))); }
#pragma unroll
    for (int o = 1; o < 64; o <<= 1) am = fmaxf(am, __shfl_xor(am, o));
    const float sc = am > 0.f ? am * (1.f / 448.f) : 1.f, inv = 1.f / sc;
#pragma unroll
    for (int j = 0; j < 4; ++j) {
        const int eb = 256 * j + 4 * lane;
        int w = __builtin_amdgcn_cvt_pk_fp8_f32(v[j][0] * inv, v[j][1] * inv, 0, false);
        w = __builtin_amdgcn_cvt_pk_fp8_f32(v[j][2] * inv, v[j][3] * inv, w, true);
        if (SLICED) *(int*)(dst_base + ((size_t)(eb >> 7) * 16384 + row) * 128 + (eb & 127)) = w;
        else *(int*)(dst_base + (size_t)row * DM + 16 * ((eb & 511) >> 3) + (eb & 7) + (eb >= 512 ? 8 : 0)) = w;
    }
    if (lane == 0) *scale_out = sc;
}

__device__ __forceinline__ void phase0(const Params& p, LAS unsigned char* lds, int tid, int lane, int wave) {
    const int gw = blockIdx.x * 8 + wave, NGW = gridDim.x * 8;
    LAS float* scr = (LAS float*)(lds + wave * 16384);
    bf16_t* WINT = (bf16_t*)(p.ws + WS_WINT);
    constexpr int I_IN = 16 * (DIN / 32);
    for (int it = gw; it < I_IN; it += NGW) transpose_item<true>(p.in[6], 1024, DIN, WINT, scr, it, lane);
    bf16_t* H = (bf16_t*)(p.ws + WS_H);
    for (int m = gw; m < NT; m += NGW) {
        const float* xr = m < NP ? p.in[0] + (size_t)m * DM : p.in[1] + (size_t)(m - NP) * DM;
        rms_row_bf16(xr, p.in[5], H + (size_t)m * DM, lane);
    }
}
__device__ __forceinline__ void prep_late(const Params& p, LAS unsigned char* lds, int tid, int lane, int wave, int rank, int nparts) {
    const int gw = rank * 8 + wave, NGW = nparts * 8;
    LAS float* scr = (LAS float*)(lds + wave * 16384);
    const size_t gt = (size_t)rank * 512 + tid, ngt = (size_t)nparts * 512;
    cvt_cache(p.in[2], (bf16_t*)(p.ws + WS_KS), gt, ngt);
    cvt_cache(p.in[3], (bf16_t*)(p.ws + WS_VS), gt, ngt);
    bf16_t* WOUTT = (bf16_t*)(p.ws + WS_WOUTT); bf16_t* WQT = (bf16_t*)(p.ws + WS_WQT);
    constexpr int I_OUT = 16 * (1024 / 32), I_Q = 16 * (2048 / 32);
    for (int it = gw; it < I_OUT + I_Q; it += NGW) {
        if (it < I_OUT) transpose_item<false>(p.in[17], 1024, 1024, WOUTT, scr, it, lane);
        else transpose_item<false>(p.in[19], 1024, 2048, WQT, scr, it - I_OUT, lane);
    }
    cvt_stream(p.in[20], (bf16_t*)(p.ws + WS_SK), (size_t)16 * 128 * 128 / 8, gt, ngt);
    for (int r = gw; r < 2 * 16384; r += NGW) {
        const int tb = r >> 14, e = r & 16383;
        if (tb) cvt_row_fp8<true>(p.in[22] + (size_t)e * DM, p.ws + WS_PV8, e, (float*)(p.ws + WS_SCV) + e, lane);
        else cvt_row_fp8<true>(p.in[21] + (size_t)e * DM, p.ws + WS_PU8, e, (float*)(p.ws + WS_SCU) + e, lane);
    }
}

namespace att {
constexpr int KPITCH = 272, VPITCH = 320;
constexpr int L_KV = 0, KV_BYTES = 64 * KPITCH + 64 * VPITCH  , L_X = 0  , L_BIAS = BIAS_OFF, L_CA = 0  , L_CW = 94 * 1024  ;
static_assert(4 * 4096 * 4 <= 2 * KV_BYTES && 2 * KV_BYTES <= L_CW && L_CW + 31 * 1024 <= RING_BYTES, "attention LDS map");

__device__ __forceinline__ int rel_bucket(int rel) {
    const int ret = rel > 0 ? 16 : 0; const int n = rel < 0 ? -rel : rel; int v;
    if (n < 8) v = n; else if (n < 12) v = 8; else if (n < 16) v = 9; else if (n < 23) v = 10; else if (n < 32) v = 11;
    else if (n < 46) v = 12; else if (n < 64) v = 13; else if (n < 91) v = 14; else v = 15;
    return ret + v;
}
typedef short v4i16_t __attribute__((ext_vector_type(4)));
__device__ __forceinline__ s16x4 vtr(const LAS unsigned char* p) { return __builtin_bit_cast(s16x4, __builtin_amdgcn_ds_read_tr16_b64_v4i16((LAS v4i16_t*)p)); }
__device__ __forceinline__ f32x16 mfma32(bf16x8 a, bf16x8 b, f32x16 c) { return __builtin_amdgcn_mfma_f32_32x32x16_bf16(a, b, c, 0, 0, 0); }

__device__ __forceinline__ void attn_unit(const Params& p, LAS unsigned char* lds, int kind, int bb, int h, int qblk, float lam, int tid, int lane, int wid) {
    const bf16_t* Q = (const bf16_t*)(p.ws + WS_Q);
    const bf16_t* Kb = kind == 0 ? (const bf16_t*)(p.ws + WS_KP) + (size_t)bb * 2048 * 512 + h * 128 : (const bf16_t*)(p.ws + WS_KS) + (size_t)bb * SKV * 512 + h * 128;
    const bf16_t* Vb = kind == 0 ? (const bf16_t*)(p.ws + WS_VP) + (size_t)bb * 2048 * 512 + h * 128 : (const bf16_t*)(p.ws + WS_VS) + (size_t)bb * SKV * 512 + h * 128;
    bf16_t* MIX = (bf16_t*)(p.ws + WS_MIX);
    const int qrow0 = kind == 0 ? bb * 2048 + qblk * 128 : NP + bb * 64;
    const int qpos0 = kind == 0 ? qblk * 128 : 2048;
    const int ntiles = kind == 0 ? 2 * qblk + 2 : 33;
    const int rg = wid & 3, map = wid >> 2, r32 = lane & 31, hi = lane >> 5;
    const bool active = kind == 0 ? true : (rg < 2);
    const int cw = kind == 0 ? 2 * qblk + (rg >> 1) : 32;
    const int qw0 = qpos0 + 32 * rg;
    const int qabs = qw0 + r32;

    bf16x8 qf[4];
    if (active) {
        const bf16_t* qp = Q + (size_t)(qrow0 + 32 * rg + r32) * 512 + h * 128 + map * 64 + 8 * hi;
#pragma unroll
        for (int s = 0; s < 4; ++s) qf[s] = *(const bf16x8*)(qp + 16 * s);
    } else {
#pragma unroll
        for (int s = 0; s < 4; ++s) qf[s] = (bf16x8){0, 0, 0, 0, 0, 0, 0, 0};
    }
    float m = 0.f, l = 0.f;
    f32x16 negm;
#pragma unroll
    for (int r = 0; r < 16; ++r) negm[r] = 0.f;
    f32x16 o[4];
#pragma unroll
    for (int mt = 0; mt < 4; ++mt)
#pragma unroll
        for (int r = 0; r < 16; ++r) o[mt][r] = 0.f;

    const int srow0 = tid >> 4, sch = tid & 15;
    const LAS float* btab = (const LAS float*)(lds + L_BIAS) + h * 320;
    const int vlane = (4 * hi + ((lane & 15) >> 2)) * VPITCH + (16 * ((lane >> 4) & 1) + 4 * (lane & 3)) * 2;
    u32x4 kA[2], vA[2], kB[2], vB[2];
#define ATT_LOAD(KR, VR, T) do { _Pragma("unroll") for (int i_ = 0; i_ < 2; ++i_) { const size_t off_ = (size_t)((T) * 64 + srow0 + 32 * i_) * 512 + sch * 8; KR[i_] = *(const u32x4*)(Kb + off_); VR[i_] = *(const u32x4*)(Vb + off_); } } while (0)
#define ATT_STORE(KR, VR, BUF) do { _Pragma("unroll") for (int i_ = 0; i_ < 2; ++i_) { \
        *(LAS u32x4*)(lds + L_KV + (BUF) * KV_BYTES + (srow0 + 32 * i_) * KPITCH + sch * 16) = KR[i_]; \
        *(LAS u32x4*)(lds + L_KV + (BUF) * KV_BYTES + 64 * KPITCH + (srow0 + 32 * i_) * VPITCH + sch * 16) = VR[i_]; } } while (0)
    auto compute = [&](int t, int buf) {
        const LAS unsigned char* kbuf = lds + L_KV + buf * KV_BYTES;
        const LAS unsigned char* vbuf = kbuf + 64 * KPITCH;
        f32x16 p0, p1;
        const int kabs0 = t * 64;
        const LAS unsigned char* kb = kbuf + r32 * KPITCH + (map * 8 + hi) * 16;
        {
            const bf16x8 a0 = *(const LAS bf16x8*)(kb), a1 = *(const LAS bf16x8*)(kb + 32 * KPITCH);
            if (kabs0 + 63 - qw0 > -128) {
                const LAS float* bt = btab + (kabs0 - qabs + 256 + 4 * hi);
#pragma unroll
                for (int r = 0; r < 16; ++r) { p0[r] = bt[(r & 3) + 8 * (r >> 2)] - m; p1[r] = bt[32 + (r & 3) + 8 * (r >> 2)] - m; }
                p0 = mfma32(a0, qf[0], p0); p1 = mfma32(a1, qf[0], p1);
            } else { p0 = mfma32(a0, qf[0], negm); p1 = mfma32(a1, qf[0], negm); }
        }
#pragma unroll
        for (int s = 1; s < 4; ++s) {
            const bf16x8 a0 = *(const LAS bf16x8*)(kb + s * 32), a1 = *(const LAS bf16x8*)(kb + 32 * KPITCH + s * 32);
            p0 = mfma32(a0, qf[s], p0); p1 = mfma32(a1, qf[s], p1);
        }
        float mx = fmaxf(p0[0], p1[0]);
#pragma unroll
        for (int r = 1; r < 16; ++r) mx = fmaxf(mx, fmaxf(p0[r], p1[r]));
        { const auto rr = __builtin_amdgcn_permlane32_swap(__float_as_uint(mx), __float_as_uint(mx), false, false); mx = fmaxf(__uint_as_float(rr[0]), __uint_as_float(rr[1])); }
        if (__any(mx > 8.f)) {
            const float dl = fmaxf(mx, 0.f);
            m += dl;
            const float alpha = __builtin_amdgcn_exp2f(-dl);
            l *= alpha;
#pragma unroll
            for (int r = 0; r < 16; ++r) { p0[r] -= dl; p1[r] -= dl; negm[r] = -m; }
#pragma unroll
            for (int mt = 0; mt < 4; ++mt)
#pragma unroll
                for (int r = 0; r < 16; ++r) o[mt][r] *= alpha;
        }
        float rs = 0.f;
#pragma unroll
        for (int r = 0; r < 16; ++r) { p0[r] = __builtin_amdgcn_exp2f(p0[r]); p1[r] = __builtin_amdgcn_exp2f(p1[r]); rs += p0[r] + p1[r]; }
        l += rs;
#pragma unroll
        for (int t2 = 0; t2 < 2; ++t2)
#pragma unroll
            for (int s = 0; s < 2; ++s) {
                u32x4 bw;
                if (t2 == 0) { bw.x = cvtpk(p0[8 * s + 0], p0[8 * s + 1]); bw.y = cvtpk(p0[8 * s + 2], p0[8 * s + 3]); bw.z = cvtpk(p0[8 * s + 4], p0[8 * s + 5]); bw.w = cvtpk(p0[8 * s + 6], p0[8 * s + 7]); }
                else { bw.x = cvtpk(p1[8 * s + 0], p1[8 * s + 1]); bw.y = cvtpk(p1[8 * s + 2], p1[8 * s + 3]); bw.z = cvtpk(p1[8 * s + 4], p1[8 * s + 5]); bw.w = cvtpk(p1[8 * s + 6], p1[8 * s + 7]); }
                const bf16x8 B = __builtin_bit_cast(bf16x8, bw);
                const LAS unsigned char* vb = vbuf + vlane + (32 * t2 + 16 * s) * VPITCH;
#pragma unroll
                for (int mt = 0; mt < 4; ++mt) {
                    const s16x4 lo = vtr(vb + mt * 64), hi8 = vtr(vb + mt * 64 + 8 * VPITCH);
                    const bf16x8 A = (bf16x8){lo[0], lo[1], lo[2], lo[3], hi8[0], hi8[1], hi8[2], hi8[3]};
                    o[mt] = mfma32(A, B, o[mt]);
                }
            }
    };
    ATT_LOAD(kA, vA, 0);
    if (ntiles > 1) ATT_LOAD(kB, vB, 1);
    ATT_STORE(kA, vA, 0);
    if (ntiles > 2) ATT_LOAD(kA, vA, 2);
    __syncthreads();
    for (int t = 0; t < ntiles; t += 2) {
        if (t + 1 < ntiles) { ATT_STORE(kB, vB, 1); if (t + 3 < ntiles) ATT_LOAD(kB, vB, t + 3); }
        if (active && t <= cw) compute(t, 0);
        __syncthreads();
        if (t + 1 >= ntiles) break;
        if (t + 2 < ntiles) { ATT_STORE(kA, vA, 0); if (t + 4 < ntiles) ATT_LOAD(kA, vA, t + 4); }
        if (active && t + 1 <= cw) compute(t + 1, 1);
        __syncthreads();
    }
#undef ATT_LOAD
#undef ATT_STORE
    l += __shfl_xor(l, 32);
    const float inv = 1.f / l;
    LAS float* X = (LAS float*)(lds + L_X) + rg * 4096;
    if (active && map == 1) {
        const float sc = -lam * inv;
#pragma unroll
        for (int mt = 0; mt < 4; ++mt)
#pragma unroll
            for (int r = 0; r < 16; ++r) X[(mt * 16 + r) * 64 + lane] = o[mt][r] * sc;
    }
    __syncthreads();
    if (active && map == 0) {
        float ss = 0.f;
#pragma unroll
        for (int mt = 0; mt < 4; ++mt)
#pragma unroll
            for (int r = 0; r < 16; ++r) { const float v = o[mt][r] * inv + X[(mt * 16 + r) * 64 + lane]; o[mt][r] = v; ss += v * v; }
        ss += __shfl_xor(ss, 32);
        const float rsn = 0.8f / sqrtf(ss * (1.f / 128.f) + EPS);
        bf16_t* orow = MIX + (size_t)(qrow0 + 32 * rg + r32) * 1024 + 512 + h * 128;
        const float* sg = p.in[15];
#pragma unroll
        for (int mt = 0; mt < 4; ++mt)
#pragma unroll
            for (int g4 = 0; g4 < 4; ++g4) {
                const int e = 32 * mt + 8 * g4 + 4 * hi;
                const f32x4 gg = *(const f32x4*)(sg + e);
                u32x2 w; w.x = cvtpk(o[mt][4 * g4 + 0] * rsn * gg[0], o[mt][4 * g4 + 1] * rsn * gg[1]); w.y = cvtpk(o[mt][4 * g4 + 2] * rsn * gg[2], o[mt][4 * g4 + 3] * rsn * gg[3]);
                *(u32x2*)(orow + e) = w;
            }
    }
    __syncthreads();
}

__device__ __forceinline__ void unpack8(const u32x4 w, float (&f)[8]) { f[0] = bflo(w.x); f[1] = bfhi(w.x); f[2] = bflo(w.y); f[3] = bfhi(w.y); f[4] = bflo(w.z); f[5] = bfhi(w.z); f[6] = bflo(w.w); f[7] = bfhi(w.w); }
__device__ __forceinline__ void conv_unit(const Params& p, LAS unsigned char* lds, int cu, int tid, int lane, int wid) {
    const bf16_t* A = (const bf16_t*)(p.ws + WS_A);
    bf16_t* MIX = (bf16_t*)(p.ws + WS_MIX);
    const float* cb = p.in[8]; const float* lg = p.in[9]; const float* lb = p.in[10]; const float* st = p.in[4];
    const int row0 = cu * 64;
    const bool isp = row0 < NP;
    const int s0 = isp ? (row0 & 2047) : 0, rbase = row0 - s0, bd = isp ? 0 : ((row0 - NP) >> 6);
    for (int c = tid; c < 94 * 64; c += 512) {
        const int rr = c >> 6, ch = c & 63, sp = s0 - 30 + rr;
        u32x4 v = (u32x4){0u, 0u, 0u, 0u};
        if (sp >= 0) v = *(const u32x4*)(A + (size_t)(rbase + sp) * 512 + ch * 8);
        else if (!isp) { const float* sr = st + ((size_t)bd * 30 + (30 + sp)) * 512 + ch * 8; const f32x4 a0 = *(const f32x4*)sr, a1 = *(const f32x4*)(sr + 4);
            v.x = cvtpk(a0[0], a0[1]); v.y = cvtpk(a0[2], a0[3]); v.z = cvtpk(a1[0], a1[1]); v.w = cvtpk(a1[2], a1[3]); }
        *(LAS u32x4*)(lds + L_CA + rr * 1024 + ch * 16) = v;
    }
    __syncthreads();
    const int c0 = lane * 8;
    float bias8[8], g8[8], b8[8];
    { const f32x4 x0 = *(const f32x4*)(cb + c0), x1 = *(const f32x4*)(cb + c0 + 4), y0 = *(const f32x4*)(lg + c0), y1 = *(const f32x4*)(lg + c0 + 4), z0 = *(const f32x4*)(lb + c0), z1 = *(const f32x4*)(lb + c0 + 4);
#pragma unroll
      for (int q = 0; q < 4; ++q) { bias8[q] = x0[q]; bias8[4 + q] = x1[q]; g8[q] = y0[q]; g8[4 + q] = y1[q]; b8[q] = z0[q]; b8[4 + q] = z1[q]; } }
    for (int grp = 0; grp < 2; ++grp) {
        const int t0 = wid * 8 + grp * 4;
        float acc[4][8];
#pragma unroll
        for (int q = 0; q < 4; ++q)
#pragma unroll
            for (int c = 0; c < 8; ++c) acc[q][c] = bias8[c];
        const LAS unsigned char* ap = lds + L_CA + t0 * 1024 + lane * 16;
        const LAS unsigned char* wp = lds + L_CW + lane * 16;
#pragma unroll 1
        for (int j = 0; j < 31; ++j) {
            float w[8]; unpack8(*(const LAS u32x4*)(wp + j * 1024), w);
#pragma unroll
            for (int q = 0; q < 4; ++q) {
                float a[8]; unpack8(*(const LAS u32x4*)(ap + (j + q) * 1024), a);
#pragma unroll
                for (int c = 0; c < 8; ++c) acc[q][c] += w[c] * a[c];
            }
        }
#pragma unroll
        for (int q = 0; q < 4; ++q) {
            float sm = 0.f;
#pragma unroll
            for (int c = 0; c < 8; ++c) sm += acc[q][c];
            const float mu = wave_total(sm) * (1.f / 512.f);
            float sv = 0.f;
#pragma unroll
            for (int c = 0; c < 8; ++c) { acc[q][c] -= mu; sv += acc[q][c] * acc[q][c]; }
            const float rstd = 1.f / sqrtf(wave_total(sv) * (1.f / 512.f) + EPS);
            float y[8];
#pragma unroll
            for (int c = 0; c < 8; ++c) { y[c] = acc[q][c] * rstd * g8[c] + b8[c]; y[c] = y[c] / (1.f + __expf(-y[c])); }
            u32x4 w; w.x = cvtpk(y[0], y[1]); w.y = cvtpk(y[2], y[3]); w.z = cvtpk(y[4], y[5]); w.w = cvtpk(y[6], y[7]);
            *(u32x4*)(MIX + (size_t)(row0 + t0 + q) * 1024 + c0) = w;
        }
    }
}

constexpr int N_SAMPLE_UNITS = 32, N_PROMPT_UNITS = 1024, N_CONV_UNITS = NT / 64, N_UNITS = N_SAMPLE_UNITS + N_PROMPT_UNITS + N_CONV_UNITS;

__device__ __forceinline__ void phase2(const Params& p, LAS unsigned char* lds, int tid, int lane, int wid, int cidx, int mode) {
    LAS float* bt = (LAS float*)(lds + L_BIAS);
    for (int e = tid; e < 4 * 320; e += 512) { const int hh = e / 320, rel = (e % 320) - 256; bt[e] = (p.in[16][rel_bucket(rel) * 4 + hh] - p.in[16][15 * 4 + hh]) * LOG2E; }
    for (int c = tid; c < 31 * 64; c += 512) {
        const float* wr = p.in[7] + (size_t)c * 8; const f32x4 a0 = *(const f32x4*)wr, a1 = *(const f32x4*)(wr + 4);
        u32x4 v; v.x = cvtpk(a0[0], a0[1]); v.y = cvtpk(a0[2], a0[3]); v.z = cvtpk(a1[0], a1[1]); v.w = cvtpk(a1[2], a1[3]);
        *(LAS u32x4*)(lds + L_CW + c * 16) = v;
    }
    const float d1 = wave_sum(p.in[11][lane] * p.in[12][lane]), d2 = wave_sum(p.in[13][lane] * p.in[14][lane]);
    const float lam = expf(d1) - expf(d2) + 0.2f;
    unsigned* ctr = (unsigned*)(p.ws + WS_CTL) + 64 * cidx;
    volatile LAS unsigned* sw = (volatile LAS unsigned*)(lds + MISC_OFF);
    __syncthreads();
    for (;;) {
        __syncthreads();
        if (tid == 0) sw[0] = atomicAdd(ctr, 1u);
        __syncthreads();
        const int u = (int)sw[0];
        if (u >= N_UNITS) break;
        if (mode == 1 && u >= N_SAMPLE_UNITS + N_PROMPT_UNITS) continue;
        if (mode == 2 && u < N_SAMPLE_UNITS + N_PROMPT_UNITS) continue;
        int tid_ = tid; asm volatile("" : "+v"(tid_));
        if (u < N_SAMPLE_UNITS + N_PROMPT_UNITS) {
            const int v = u - N_SAMPLE_UNITS; const int bh = v & 63; const bool smp = u < N_SAMPLE_UNITS;
            attn_unit(p, lds, smp ? 1 : 0, smp ? (u >> 2) : (bh >> 2), smp ? (u & 3) : (bh & 3), smp ? 0 : 15 - (v >> 6), lam, tid_, tid_ & 63, wid);
        } else conv_unit(p, lds, u - N_SAMPLE_UNITS - N_PROMPT_UNITS, tid_, tid_ & 63, wid);
    }
}
}

template <class F> __device__ __forceinline__ void mini_gemm(const bf16_t* A, const bf16_t* Bt, int N, int lane, int wave, F epi) {
    const int ntasks = 16 * (N / 64), G = gridDim.x;
    const int fr = lane & 15, fq = lane >> 4;
    for (int task = wave * G + (int)blockIdx.x; task < ntasks; task += 8 * G) {
        const int rb = task & 15, cb = task >> 4;
        pg8::f32x4 acc[2][4];
#pragma unroll
        for (int m = 0; m < 2; ++m)
#pragma unroll
            for (int n = 0; n < 4; ++n) acc[m][n] = (pg8::f32x4){0.f, 0.f, 0.f, 0.f};
        const bf16_t* ap = A + (size_t)(rb * 32 + fr) * 1024 + 8 * fq;
        const bf16_t* bp = Bt + (size_t)(cb * 64 + fr) * 1024 + 8 * fq;
#pragma unroll 4
        for (int k0 = 0; k0 < 1024; k0 += 32) {
            const bf16x8 a0 = *(const bf16x8*)(ap + k0), a1 = *(const bf16x8*)(ap + 16 * 1024 + k0);
            bf16x8 b[4];
#pragma unroll
            for (int n = 0; n < 4; ++n) b[n] = *(const bf16x8*)(bp + (size_t)n * 16 * 1024 + k0);
#pragma unroll
            for (int n = 0; n < 4; ++n) { acc[0][n] = __builtin_amdgcn_mfma_f32_16x16x32_bf16(b[n], a0, acc[0][n], 0, 0, 0); acc[1][n] = __builtin_amdgcn_mfma_f32_16x16x32_bf16(b[n], a1, acc[1][n], 0, 0, 0); }
        }
#pragma unroll
        for (int m = 0; m < 2; ++m)
#pragma unroll
            for (int n = 0; n < 4; ++n) epi(rb * 32 + 16 * m + fr, cb * 64 + 16 * n + 4 * fq, acc[m][n]);
    }
}

__device__ __forceinline__ void phase3b(const Params& p, int lane, int wave) {
    const int gw = blockIdx.x * 8 + wave, NGW = gridDim.x * 8;
    bf16_t* H2 = (bf16_t*)(p.ws + WS_H2);
    for (int m = gw; m < NT; m += NGW) rms_row_bf16(p.out + (size_t)m * DM, p.in[18], H2 + (size_t)m * DM, lane);
}

constexpr int P4B_KPITCH = 272, P4B_K_BYTES = 128 * P4B_KPITCH, P4B_Q_BYTES = 32 * P4B_KPITCH;
static_assert(P4B_K_BYTES + 8 * P4B_Q_BYTES <= RING_BYTES, "P4b LDS map");
__device__ __forceinline__ void phase4b(const Params& p, LAS unsigned char* lds, int tid, int lane, int wave) {
    const bf16_t* QP = (const bf16_t*)(p.ws + WS_QP); const bf16_t* SK = (const bf16_t*)(p.ws + WS_SK);
    float* TK = (float*)(p.ws + WS_TK);
    const int r32 = lane & 31, hi = lane >> 5;
    const int G = gridDim.x;
    for (int rp = blockIdx.x & 15; rp < 16; rp += (G < 16 ? G : 16)) {
        const int nbr = (G - rp + 15) >> 4, member = (int)blockIdx.x >> 4;
        __syncthreads();
        for (int c = tid; c < 128 * 16; c += 512) { const int row = c >> 4, ch = c & 15; *(LAS u32x4*)(lds + row * P4B_KPITCH + ch * 16) = *(const u32x4*)(SK + ((size_t)rp * 128 + row) * 128 + ch * 8); }
        __syncthreads();
        LAS unsigned char* qs = lds + P4B_K_BYTES + wave * P4B_Q_BYTES;
        for (int tg = member * 8 + wave; tg < NT / 32; tg += nbr * 8) {
            const int t0 = tg * 32;
#pragma unroll
            for (int i = 0; i < 8; ++i) { const int row = 4 * i + (lane >> 4), ch = lane & 15; *(LAS u32x4*)(qs + row * P4B_KPITCH + ch * 16) = *(const u32x4*)(QP + (size_t)(t0 + row) * 2048 + rp * 128 + ch * 8); }
            bf16x8 qf[8];
#pragma unroll
            for (int s = 0; s < 8; ++s) qf[s] = *(const LAS bf16x8*)(qs + r32 * P4B_KPITCH + (2 * s + hi) * 16);
            float v[64];
#pragma unroll
            for (int mt = 0; mt < 4; ++mt) {
                f32x16 S;
#pragma unroll
                for (int r = 0; r < 16; ++r) S[r] = 0.f;
                const LAS unsigned char* kp = lds + (32 * mt + r32) * P4B_KPITCH + hi * 16;
#pragma unroll
                for (int s = 0; s < 8; ++s) S = att::mfma32(*(const LAS bf16x8*)(kp + s * 32), qf[s], S);
#pragma unroll
                for (int r = 0; r < 16; ++r) { const int n = 32 * mt + (r & 3) + 8 * (r >> 2) + 4 * hi; v[mt * 16 + r] = __uint_as_float((__float_as_uint(S[r]) & ~127u) | (unsigned)(127 - n)); }
            }
            SORT16_DESC(v, 0); SORT16_DESC(v, 16); SORT16_DESC(v, 32); SORT16_DESC(v, 48);
#pragma unroll
            for (int i = 0; i < 16; ++i) { v[i] = fmaxf(v[i], v[31 - i]); v[32 + i] = fmaxf(v[32 + i], v[63 - i]); }
            BITONIC16_DESC(v, 0); BITONIC16_DESC(v, 32);
#pragma unroll
            for (int i = 0; i < 16; ++i) v[i] = fmaxf(v[i], v[47 - i]);
            BITONIC16_DESC(v, 0);
            float w[16];
#pragma unroll
            for (int i = 0; i < 16; ++i) w[i] = fmaxf(v[i], __shfl_xor(v[15 - i], 32));
            BITONIC16_DESC(w, 0);
            if (hi == 0) {
                f32x4* dst = (f32x4*)(TK + ((size_t)(t0 + r32) * 16 + rp) * 16);
#pragma unroll
                for (int q = 0; q < 4; ++q) dst[q] = (f32x4){w[4 * q], w[4 * q + 1], w[4 * q + 2], w[4 * q + 3]};
            }
        }
    }
}

__device__ __forceinline__ void phase5a(const Params& p, int tid) {
    const float* TK = (const float*)(p.ws + WS_TK);
    int* IDX = (int*)(p.ws + WS_IDX); float* GATE = (float*)(p.ws + WS_GATE);
    const float NEG_INF = -__builtin_huge_valf();
    for (int item = blockIdx.x * 512 + tid; item < NT * 8; item += gridDim.x * 512) {
        const int tok = item >> 3, r = item & 7;
        const f32x4* pa = (const f32x4*)(TK + ((size_t)tok * 16 + 2 * r) * 16);
        float a[16], b[16]; int ia[16], ib[16];
#pragma unroll
        for (int q = 0; q < 4; ++q) { const f32x4 x = pa[q], y = pa[4 + q];
#pragma unroll
            for (int j = 0; j < 4; ++j) { a[4 * q + j] = x[j]; b[4 * q + j] = y[j]; } }
#pragma unroll
        for (int i = 0; i < 16; ++i) { const unsigned ua = __float_as_uint(a[i]), ub = __float_as_uint(b[i]); ia[i] = 127 - (int)(ua & 127u); ib[i] = 127 - (int)(ub & 127u); a[i] = __uint_as_float(ua & ~127u); b[i] = __uint_as_float(ub & ~127u); }
        float cv[50]; int cid[50];
        {
            int c = 0;
#pragma unroll
            for (int i = 0; i < 16; ++i)
#pragma unroll
                for (int j = 0; j < 16; ++j)
                    if ((i + 1) * (j + 1) <= 16) { const float s = a[i] + b[j]; cv[c] = __uint_as_float((__float_as_uint(s) & ~63u) | (unsigned)(63 - c)); cid[c] = ia[i] * 128 + ib[j]; ++c; }
        }
        float best[16]; int bid[16];
#pragma unroll
        for (int it = 0; it < 16; ++it) {
            float mx = cv[0];
#pragma unroll
            for (int c = 1; c < 50; ++c) mx = fmaxf(mx, cv[c]);
            int id = 0;
#pragma unroll
            for (int c = 0; c < 50; ++c) { const bool hit = cv[c] == mx; id = hit ? cid[c] : id; cv[c] = hit ? NEG_INF : cv[c]; }
            best[it] = __uint_as_float(__float_as_uint(mx) & ~63u); bid[it] = id;
        }
        float e[16], sum = 0.f;
#pragma unroll
        for (int k = 0; k < 16; ++k) { e[k] = __expf(best[k] - best[0]); sum += e[k]; }
        const float rinv = 1.f / sum;
        int* io = IDX + (size_t)tok * 128 + r * 16; float* go = GATE + (size_t)tok * 128 + r * 16;
#pragma unroll
        for (int k = 0; k < 16; ++k) { io[k] = bid[k]; go[k] = e[k] * rinv; }
    }
}

__device__ __forceinline__ float gelu_erf(float x) { return 0.5f * x * (1.f + erff(x * 0.70710678118654752f)); }
__device__ __forceinline__ void fp8x16_to_f32(const u32x4 q, float (&f)[16]) {
    const f32x2 c0 = __builtin_amdgcn_cvt_pk_f32_fp8(q.x, false), c1 = __builtin_amdgcn_cvt_pk_f32_fp8(q.x, true), c2 = __builtin_amdgcn_cvt_pk_f32_fp8(q.y, false), c3 = __builtin_amdgcn_cvt_pk_f32_fp8(q.y, true);
    const f32x2 c4 = __builtin_amdgcn_cvt_pk_f32_fp8(q.z, false), c5 = __builtin_amdgcn_cvt_pk_f32_fp8(q.z, true), c6 = __builtin_amdgcn_cvt_pk_f32_fp8(q.w, false), c7 = __builtin_amdgcn_cvt_pk_f32_fp8(q.w, true);
    f[0] = c0.x; f[1] = c0.y; f[2] = c1.x; f[3] = c1.y; f[4] = c2.x; f[5] = c2.y; f[6] = c3.x; f[7] = c3.y;
    f[8] = c4.x; f[9] = c4.y; f[10] = c5.x; f[11] = c5.y; f[12] = c6.x; f[13] = c6.y; f[14] = c7.x; f[15] = c7.y;
}
__device__ __forceinline__ void slice_group(int& x, int& gwx, int& nwx, int wave) {
    x = blockIdx.x & 7; const int nbx = ((int)gridDim.x - x + 7) >> 3; gwx = ((int)blockIdx.x >> 3) * 8 + wave; nwx = nbx * 8;
}
__device__ __forceinline__ void phase5u(const Params& p, LAS unsigned char* lds, int lane, int wave) {
    int x, gwx, nwx; slice_group(x, gwx, nwx, wave);
    const unsigned char* PU8 = p.ws + WS_PU8 + (size_t)x * 16384 * 128;
    const bf16_t* H2 = (const bf16_t*)(p.ws + WS_H2) + 128 * x;
    const int* IDX = (const int*)(p.ws + WS_IDX); float* PACT = (float*)(p.ws + WS_PACT) + (size_t)x * NT * 128;
    LAS int* l_idx = (LAS int*)(lds + wave * 512);
    const int g = lane >> 3, sub = lane & 7;
    const unsigned char* rowp = PU8 + sub * 16;
    int r_idxA = 0, r_idxB = 0;
    u32x4 hA0, hA1, hB0, hB1; hA0 = hA1 = hB0 = hB1 = (u32x4){0u, 0u, 0u, 0u};
    u32x4 qA[16], qB[16];
#define P5U_LOADIDX(T) do { if ((T) < NT) { r_idxA = IDX[(size_t)(T) * 128 + lane]; r_idxB = IDX[(size_t)(T) * 128 + 64 + lane]; } } while (0)
#define P5U_ISSUE(Q, H0, H1, T) do { if ((T) < NT) { l_idx[lane] = r_idxA; l_idx[64 + lane] = r_idxB; \
        H0 = *(const u32x4*)(H2 + (size_t)(T) * DM + 16 * sub); H1 = *(const u32x4*)(H2 + (size_t)(T) * DM + 16 * sub + 8); \
        _Pragma("unroll") for (int q_ = 0; q_ < 4; ++q_) { const u32x4 iv = *(const LAS u32x4*)(l_idx + 16 * g + 4 * q_); \
            Q[4 * q_] = *(const u32x4*)(rowp + (size_t)iv.x * 128); Q[4 * q_ + 1] = *(const u32x4*)(rowp + (size_t)iv.y * 128); \
            Q[4 * q_ + 2] = *(const u32x4*)(rowp + (size_t)iv.z * 128); Q[4 * q_ + 3] = *(const u32x4*)(rowp + (size_t)iv.w * 128); } } } while (0)
#define P5U_COMPUTE(Q, H0, H1, T) do { \
        f32x2 hf[8]; \
        hf[0] = (f32x2){bflo(H0.x), bfhi(H0.x)}; hf[1] = (f32x2){bflo(H0.y), bfhi(H0.y)}; hf[2] = (f32x2){bflo(H0.z), bfhi(H0.z)}; hf[3] = (f32x2){bflo(H0.w), bfhi(H0.w)}; \
        hf[4] = (f32x2){bflo(H1.x), bfhi(H1.x)}; hf[5] = (f32x2){bflo(H1.y), bfhi(H1.y)}; hf[6] = (f32x2){bflo(H1.z), bfhi(H1.z)}; hf[7] = (f32x2){bflo(H1.w), bfhi(H1.w)}; \
        float resA = 0.f, resB = 0.f; \
        _Pragma("unroll") for (int i = 0; i < 16; ++i) { \
            f32x2 s2 = __builtin_amdgcn_cvt_pk_f32_fp8(Q[i].x, false) * hf[0]; \
            s2 = __builtin_elementwise_fma(__builtin_amdgcn_cvt_pk_f32_fp8(Q[i].x, true), hf[1], s2); \
            s2 = __builtin_elementwise_fma(__builtin_amdgcn_cvt_pk_f32_fp8(Q[i].y, false), hf[2], s2); \
            s2 = __builtin_elementwise_fma(__builtin_amdgcn_cvt_pk_f32_fp8(Q[i].y, true), hf[3], s2); \
            s2 = __builtin_elementwise_fma(__builtin_amdgcn_cvt_pk_f32_fp8(Q[i].z, false), hf[4], s2); \
            s2 = __builtin_elementwise_fma(__builtin_amdgcn_cvt_pk_f32_fp8(Q[i].z, true), hf[5], s2); \
            s2 = __builtin_elementwise_fma(__builtin_amdgcn_cvt_pk_f32_fp8(Q[i].w, false), hf[6], s2); \
            s2 = __builtin_elementwise_fma(__builtin_amdgcn_cvt_pk_f32_fp8(Q[i].w, true), hf[7], s2); \
            float sr = s2.x + s2.y; \
            DPP_ADD(sr, 0xB1); DPP_ADD(sr, 0x4E); DPP_ADD(sr, 0x141); \
            if (i < 8) resA = (sub == i) ? sr : resA; else resB = (sub == i - 8) ? sr : resB; } \
        PACT[(size_t)(T) * 128 + 16 * g + sub] = resA; PACT[(size_t)(T) * 128 + 16 * g + 8 + sub] = resB; } while (0)
    int tok = gwx;
    P5U_LOADIDX(tok);
    P5U_ISSUE(qA, hA0, hA1, tok);
    P5U_LOADIDX(tok + nwx);
    for (; tok < NT; tok += 2 * nwx) {
        P5U_ISSUE(qB, hB0, hB1, tok + nwx);
        P5U_LOADIDX(tok + 2 * nwx);
        P5U_COMPUTE(qA, hA0, hA1, tok);
        if (tok + nwx >= NT) break;
        P5U_ISSUE(qA, hA0, hA1, tok + 2 * nwx);
        P5U_LOADIDX(tok + 3 * nwx);
        P5U_COMPUTE(qB, hB0, hB1, tok + nwx);
    }
#undef P5U_LOADIDX
#undef P5U_ISSUE
#undef P5U_COMPUTE
}
__device__ __forceinline__ void phase5c(const Params& p, int tid) {
    const float* PACT = (const float*)(p.ws + WS_PACT); const float* SCU = (const float*)(p.ws + WS_SCU); const float* SCV = (const float*)(p.ws + WS_SCV);
    const int* IDX = (const int*)(p.ws + WS_IDX); const float* GATE = (const float*)(p.ws + WS_GATE); float* COEF = (float*)(p.ws + WS_COEF);
    const size_t n = (size_t)NT * 128;
    for (size_t it = (size_t)blockIdx.x * 512 + tid; it < n; it += (size_t)gridDim.x * 512) {
        float a = 0.f;
#pragma unroll
        for (int xx = 0; xx < 8; ++xx) a += PACT[(size_t)xx * n + it];
        const int e = IDX[it];
        COEF[it] = GATE[it] * gelu_erf(a * SCU[e]) * SCV[e];
    }
}

constexpr int P5V_LDS_PER_WAVE = 1024 + 8 * 136 * 4;
__device__ __forceinline__ void phase5v(const Params& p, LAS unsigned char* lds, int lane, int wave) {
    int x, gwx, nwx; slice_group(x, gwx, nwx, wave);
    const unsigned char* PV8 = p.ws + WS_PV8 + (size_t)x * 16384 * 128;
    const int* IDX = (const int*)(p.ws + WS_IDX); const float* COEF = (const float*)(p.ws + WS_COEF);
    LAS int* l_idx = (LAS int*)(lds + wave * P5V_LDS_PER_WAVE); LAS float* l_cf = (LAS float*)(l_idx + 128); LAS float* red = l_cf + 128;
    const int g = lane >> 3, sub = lane & 7;
    const unsigned char* rowp = PV8 + sub * 16;
    const int c1 = 16 * (lane & 7) + (lane >> 3);
    int r_idxA = 0, r_idxB = 0; float r_cA = 0.f, r_cB = 0.f;
    u32x4 qA[16], qB[16]; f32x4 cfA[4], cfB[4]; float xA0 = 0.f, xA1 = 0.f, xB0 = 0.f, xB1 = 0.f;
#define P5V_LOADIDX(T) do { if ((T) < NT) { r_idxA = IDX[(size_t)(T) * 128 + lane]; r_idxB = IDX[(size_t)(T) * 128 + 64 + lane]; r_cA = COEF[(size_t)(T) * 128 + lane]; r_cB = COEF[(size_t)(T) * 128 + 64 + lane]; } } while (0)
#define P5V_ISSUE(Q, CF, X0, X1, T) do { if ((T) < NT) { l_idx[lane] = r_idxA; l_idx[64 + lane] = r_idxB; l_cf[lane] = r_cA; l_cf[64 + lane] = r_cB; \
        { const float* xr_ = p.out + (size_t)(T) * DM + 128 * x; X0 = xr_[c1]; X1 = xr_[c1 + 8]; } \
        _Pragma("unroll") for (int q_ = 0; q_ < 4; ++q_) { const u32x4 iv = *(const LAS u32x4*)(l_idx + 16 * g + 4 * q_); CF[q_] = *(const LAS f32x4*)(l_cf + 16 * g + 4 * q_); \
            Q[4 * q_] = *(const u32x4*)(rowp + (size_t)iv.x * 128); Q[4 * q_ + 1] = *(const u32x4*)(rowp + (size_t)iv.y * 128); \
            Q[4 * q_ + 2] = *(const u32x4*)(rowp + (size_t)iv.z * 128); Q[4 * q_ + 3] = *(const u32x4*)(rowp + (size_t)iv.w * 128); } } } while (0)
#define P5V_COMPUTE(Q, CF, X0, X1, T) do { \
        f32x2 acc[8]; \
        _Pragma("unroll") for (int j = 0; j < 8; ++j) acc[j] = (f32x2){0.f, 0.f}; \
        _Pragma("unroll") for (int i = 0; i < 16; ++i) { \
            const float cs_ = CF[i >> 2][i & 3]; const f32x2 c2 = (f32x2){cs_, cs_}; \
            acc[0] = __builtin_elementwise_fma(__builtin_amdgcn_cvt_pk_f32_fp8(Q[i].x, false), c2, acc[0]); \
            acc[1] = __builtin_elementwise_fma(__builtin_amdgcn_cvt_pk_f32_fp8(Q[i].x, true), c2, acc[1]); \
            acc[2] = __builtin_elementwise_fma(__builtin_amdgcn_cvt_pk_f32_fp8(Q[i].y, false), c2, acc[2]); \
            acc[3] = __builtin_elementwise_fma(__builtin_amdgcn_cvt_pk_f32_fp8(Q[i].y, true), c2, acc[3]); \
            acc[4] = __builtin_elementwise_fma(__builtin_amdgcn_cvt_pk_f32_fp8(Q[i].z, false), c2, acc[4]); \
            acc[5] = __builtin_elementwise_fma(__builtin_amdgcn_cvt_pk_f32_fp8(Q[i].z, true), c2, acc[5]); \
            acc[6] = __builtin_elementwise_fma(__builtin_amdgcn_cvt_pk_f32_fp8(Q[i].w, false), c2, acc[6]); \
            acc[7] = __builtin_elementwise_fma(__builtin_amdgcn_cvt_pk_f32_fp8(Q[i].w, true), c2, acc[7]); } \
        _Pragma("unroll") for (int j = 0; j < 8; ++j) { red[g * 136 + (2 * j) * 8 + sub] = acc[j].x; red[g * 136 + (2 * j + 1) * 8 + sub] = acc[j].y; } \
        float s1 = X0, s2_ = X1; \
        _Pragma("unroll") for (int gg = 0; gg < 8; ++gg) { s1 += red[gg * 136 + lane]; s2_ += red[gg * 136 + 64 + lane]; } \
        { float* xr_ = p.out + (size_t)(T) * DM + 128 * x; xr_[c1] = s1; xr_[c1 + 8] = s2_; } } while (0)
    int tok = gwx;
    P5V_LOADIDX(tok);
    P5V_ISSUE(qA, cfA, xA0, xA1, tok);
    P5V_LOADIDX(tok + nwx);
    for (; tok < NT; tok += 2 * nwx) {
        P5V_ISSUE(qB, cfB, xB0, xB1, tok + nwx);
        P5V_LOADIDX(tok + 2 * nwx);
        P5V_COMPUTE(qA, cfA, xA0, xA1, tok);
        if (tok + nwx >= NT) break;
        P5V_ISSUE(qA, cfA, xA0, xA1, tok + 2 * nwx);
        P5V_LOADIDX(tok + 3 * nwx);
        P5V_COMPUTE(qB, cfB, xB0, xB1, tok + nwx);
    }
#undef P5V_LOADIDX
#undef P5V_ISSUE
#undef P5V_COMPUTE
}

__device__ __forceinline__ void phase6(const Params& p, int lane, int wave) {
    const int gw = blockIdx.x * 8 + wave, NGW = gridDim.x * 8;
    const f32x4* gr = (const f32x4*)p.in[23] + lane;
    for (int m = gw; m < NT; m += NGW) {
        f32x4* xr = (f32x4*)(p.out + (size_t)m * DM) + lane;
        f32x4 v[4]; float s = 0.f;
#pragma unroll
        for (int j = 0; j < 4; ++j) { v[j] = xr[64 * j]; s += (v[j][0] * v[j][0] + v[j][1] * v[j][1]) + (v[j][2] * v[j][2] + v[j][3] * v[j][3]); }
        const float rstd = 1.f / sqrtf(wave_total(s) * (1.f / DM) + EPS);
#pragma unroll
        for (int j = 0; j < 4; ++j) xr[64 * j] = v[j] * rstd * gr[64 * j];
    }
}

__global__ void __launch_bounds__(512, 2) fwd_megakernel(Params p) {
    extern __shared__ __attribute__((aligned(16))) unsigned char lds_raw[];
    LAS unsigned char* lds = (LAS unsigned char*)lds_raw;
    cg::grid_group grid = cg::this_grid();
    const int tid = threadIdx.x, lane = tid & 63, wave = __builtin_amdgcn_readfirstlane(tid >> 6);
    const int G = gridDim.x;
    volatile LAS unsigned* MISC = (volatile LAS unsigned*)(lds + MISC_OFF);
    if (tid < 32) MISC[tid] = 0u;
    __syncthreads();
    XcdBarrier bar = xcd_barrier_post((unsigned*)(p.ws + WS_CTL) + 4096, MISC + 8);
#define GSYNC() xcd_barrier(bar)

#ifndef RPT_MASK
#define RPT_MASK 0
#endif
#if RPT_MASK
#define RPT(bit) for (int rpt_ = 0; rpt_ < (((RPT_MASK) >> (bit)) & 1) + 1; ++rpt_)
#else
#define RPT(bit) if (constexpr int rpt_ = 0; true)
#endif
    RPT(0) { phase0(p, lds, tid, lane, wave); grid.sync(); }
    RPT(1) {
        pg8::Gemm g{(const bf16_t*)(p.ws + WS_H), (const bf16_t*)(p.ws + WS_WINT), NT, DIN, 1024};
        pg8::StaticOrder S; S.init(NT, DIN, G, (int)blockIdx.x);
        pg8::EpiProj E{(bf16_t*)(p.ws + WS_A), (bf16_t*)(p.ws + WS_Q), (bf16_t*)(p.ws + WS_KP), (bf16_t*)(p.ws + WS_VP), (bf16_t*)(p.ws + WS_KS), (bf16_t*)(p.ws + WS_VS), p.out};
        pg8::gemm_phase<pg8::EpiProj, pg8::StaticOrder, true, true>(lds, g, S, E);
        {
            const int nwg = (NT / 256) * (DIN / 256), rem = nwg % G, c = (int)blockIdx.x;
            if (rem == 0) prep_late(p, lds, tid, lane, wave, c, G);
            else if (c >= rem) prep_late(p, lds, tid, lane, wave, c - rem, G - rem);
        }
        GSYNC();
    }
    #ifndef P2MODE
#define P2MODE 0
#endif
    RPT(2) { att::phase2(p, lds, tid, lane, wave, rpt_, (((RPT_MASK) >> 2) & 1) && rpt_ == 0 ? P2MODE : 0); GSYNC(); }
    RPT(3) {
        pg8::Gemm g{(const bf16_t*)(p.ws + WS_MIX), (const bf16_t*)(p.ws + WS_WOUTT), NP, 1024, 1024};
        pg8::StaticOrder S; S.init(NP, 1024, G, (int)blockIdx.x);
        pg8::EpiRes E{p.in[0], p.in[1], p.out};
        pg8::gemm_phase<pg8::EpiRes, pg8::StaticOrder, true, true>(lds, g, S, E);
        {
            const float* xs = p.in[1]; float* xo = p.out + (size_t)NP * DM;
            mini_gemm((const bf16_t*)(p.ws + WS_MIX) + (size_t)NP * DM, (const bf16_t*)(p.ws + WS_WOUTT), 1024, lane, wave,
                      [=](int row, int col, pg8::f32x4 v) { *(pg8::f32x4*)(xo + (size_t)row * DM + col) = *(const pg8::f32x4*)(xs + (size_t)row * DM + col) + v; });
        }
        GSYNC();
    }
    RPT(4) { phase3b(p, lane, wave); GSYNC(); }
    RPT(5) {
        pg8::Gemm g{(const bf16_t*)(p.ws + WS_H2), (const bf16_t*)(p.ws + WS_WQT), NP, 2048, 1024};
        pg8::StaticOrder S; S.init(NP, 2048, G, (int)blockIdx.x);
        pg8::EpiBf16<0> E{(bf16_t*)(p.ws + WS_QP), 2048, nullptr, 0, 0, 1.f};
        pg8::gemm_phase<pg8::EpiBf16<0>, pg8::StaticOrder, true, true>(lds, g, S, E);
        {
            bf16_t* qo = (bf16_t*)(p.ws + WS_QP) + (size_t)NP * 2048;
            mini_gemm((const bf16_t*)(p.ws + WS_H2) + (size_t)NP * DM, (const bf16_t*)(p.ws + WS_WQT), 2048, lane, wave,
                      [=](int row, int col, pg8::f32x4 v) { *(u32x2*)(qo + (size_t)row * 2048 + col) = pg8::pack4(v); });
        }
        GSYNC();
    }
    RPT(6) { phase4b(p, lds, tid, lane, wave); GSYNC(); }
    RPT(7) { phase5a(p, tid); GSYNC(); }
    RPT(8) { phase5u(p, lds, lane, wave); GSYNC(); }
    phase5c(p, tid);
    GSYNC();
    phase5v(p, lds, lane, wave);
    GSYNC();
    phase6(p, lane, wave);
}

extern "C" void kernel_launch(void* const* d_in, const int* in_sizes, int n_in, void* d_out, int out_size, void* d_ws, size_t ws_size, hipStream_t stream) {
    static int grid = 0;
    if (grid == 0) {
        if (n_in != 24 || out_size != (int)OUT_TOTAL || ws_size < WS_END) { fprintf(stderr, "kernel_launch: unexpected shapes: n_in %d out %d ws %zu (need %zu)\n", n_in, out_size, ws_size, (size_t)WS_END); grid = -1; return; }
        int dev = 0, cus = 0, per_cu = 0;
        (void)hipGetDevice(&dev);
        (void)hipDeviceGetAttribute(&cus, hipDeviceAttributeMultiprocessorCount, dev);
        if (hipFuncSetAttribute((const void*)fwd_megakernel, hipFuncAttributeMaxDynamicSharedMemorySize, LDS_BYTES) != hipSuccess) { fprintf(stderr, "kernel_launch: hipFuncSetAttribute failed\n"); grid = -1; return; }
        if (hipOccupancyMaxActiveBlocksPerMultiprocessor(&per_cu, (const void*)fwd_megakernel, 512, LDS_BYTES) != hipSuccess || per_cu < 1) { fprintf(stderr, "kernel_launch: occupancy query gave %d\n", per_cu); per_cu = 1; }
        (void)hipGetLastError();
        grid = cus * 1;
        if (per_cu < 1) grid = -1;
    }
    if (grid < 0) return;
    (void)hipMemsetAsync((char*)d_ws + WS_CTL, 0, CTL_BYTES, stream);
    Params p{};
    for (int i = 0; i < 24; ++i) p.in[i] = (const float*)d_in[i];
    p.out = (float*)d_out; p.ws = (unsigned char*)d_ws;
    void* args[] = {&p};
    hipError_t e = hipLaunchCooperativeKernel((const void*)fwd_megakernel, dim3(grid), dim3(512), args, LDS_BYTES, stream);
    if (e != hipSuccess) fprintf(stderr, "cooperative launch failed: %s (grid %d)\n", hipGetErrorString(e), grid);
}
```

```cpp
#include <hip/hip_runtime.h>
#include <hip/hip_cooperative_groups.h>
#include <cstdio>
#include <cstdint>
#include <cmath>
namespace cg = cooperative_groups;
#define CE_(a, b) do { const float t_ = fmaxf(a, b); b = fminf(a, b); a = t_; } while (0)
#define SORT16_DESC(V, O) do { CE_(V[(O)+0], V[(O)+1]); CE_(V[(O)+2], V[(O)+3]); CE_(V[(O)+0], V[(O)+2]); CE_(V[(O)+1], V[(O)+3]); CE_(V[(O)+1], V[(O)+2]); CE_(V[(O)+4], V[(O)+5]); CE_(V[(O)+6], V[(O)+7]); CE_(V[(O)+4], V[(O)+6]); CE_(V[(O)+5], V[(O)+7]); CE_(V[(O)+5], V[(O)+6]); CE_(V[(O)+0], V[(O)+4]); CE_(V[(O)+2], V[(O)+6]); CE_(V[(O)+2], V[(O)+4]); CE_(V[(O)+1], V[(O)+5]); CE_(V[(O)+3], V[(O)+7]); CE_(V[(O)+3], V[(O)+5]); CE_(V[(O)+1], V[(O)+2]); CE_(V[(O)+3], V[(O)+4]); CE_(V[(O)+5], V[(O)+6]); CE_(V[(O)+8], V[(O)+9]); CE_(V[(O)+10], V[(O)+11]); CE_(V[(O)+8], V[(O)+10]); CE_(V[(O)+9], V[(O)+11]); CE_(V[(O)+9], V[(O)+10]); CE_(V[(O)+12], V[(O)+13]); CE_(V[(O)+14], V[(O)+15]); CE_(V[(O)+12], V[(O)+14]); CE_(V[(O)+13], V[(O)+15]); CE_(V[(O)+13], V[(O)+14]); CE_(V[(O)+8], V[(O)+12]); CE_(V[(O)+10], V[(O)+14]); CE_(V[(O)+10], V[(O)+12]); CE_(V[(O)+9], V[(O)+13]); CE_(V[(O)+11], V[(O)+15]); CE_(V[(O)+11], V[(O)+13]); CE_(V[(O)+9], V[(O)+10]); CE_(V[(O)+11], V[(O)+12]); CE_(V[(O)+13], V[(O)+14]); CE_(V[(O)+0], V[(O)+8]); CE_(V[(O)+4], V[(O)+12]); CE_(V[(O)+4], V[(O)+8]); CE_(V[(O)+2], V[(O)+10]); CE_(V[(O)+6], V[(O)+14]); CE_(V[(O)+6], V[(O)+10]); CE_(V[(O)+2], V[(O)+4]); CE_(V[(O)+6], V[(O)+8]); CE_(V[(O)+10], V[(O)+12]); CE_(V[(O)+1], V[(O)+9]); CE_(V[(O)+5], V[(O)+13]); CE_(V[(O)+5], V[(O)+9]); CE_(V[(O)+3], V[(O)+11]); CE_(V[(O)+7], V[(O)+15]); CE_(V[(O)+7], V[(O)+11]); CE_(V[(O)+3], V[(O)+5]); CE_(V[(O)+7], V[(O)+9]); CE_(V[(O)+11], V[(O)+13]); CE_(V[(O)+1], V[(O)+2]); CE_(V[(O)+3], V[(O)+4]); CE_(V[(O)+5], V[(O)+6]); CE_(V[(O)+7], V[(O)+8]); CE_(V[(O)+9], V[(O)+10]); CE_(V[(O)+11], V[(O)+12]); CE_(V[(O)+13], V[(O)+14]); } while (0)
#define BITONIC16_DESC(V, O) do { CE_(V[(O)+0], V[(O)+8]); CE_(V[(O)+1], V[(O)+9]); CE_(V[(O)+2], V[(O)+10]); CE_(V[(O)+3], V[(O)+11]); CE_(V[(O)+4], V[(O)+12]); CE_(V[(O)+5], V[(O)+13]); CE_(V[(O)+6], V[(O)+14]); CE_(V[(O)+7], V[(O)+15]); CE_(V[(O)+0], V[(O)+4]); CE_(V[(O)+1], V[(O)+5]); CE_(V[(O)+2], V[(O)+6]); CE_(V[(O)+3], V[(O)+7]); CE_(V[(O)+8], V[(O)+12]); CE_(V[(O)+9], V[(O)+13]); CE_(V[(O)+10], V[(O)+14]); CE_(V[(O)+11], V[(O)+15]); CE_(V[(O)+0], V[(O)+2]); CE_(V[(O)+1], V[(O)+3]); CE_(V[(O)+4], V[(O)+6]); CE_(V[(O)+5], V[(O)+7]); CE_(V[(O)+8], V[(O)+10]); CE_(V[(O)+9], V[(O)+11]); CE_(V[(O)+12], V[(O)+14]); CE_(V[(O)+13], V[(O)+15]); CE_(V[(O)+0], V[(O)+1]); CE_(V[(O)+2], V[(O)+3]); CE_(V[(O)+4], V[(O)+5]); CE_(V[(O)+6], V[(O)+7]); CE_(V[(O)+8], V[(O)+9]); CE_(V[(O)+10], V[(O)+11]); CE_(V[(O)+12], V[(O)+13]); CE_(V[(O)+14], V[(O)+15]); } while (0)
namespace pg8 {
#define PG8_LAS __attribute__((address_space(3)))
typedef unsigned short bf16_t;
typedef short bf16x8 __attribute__((ext_vector_type(8)));
typedef float f32x4 __attribute__((ext_vector_type(4)));
typedef unsigned u32x4 __attribute__((ext_vector_type(4)));
constexpr int BM = 256, BK = 64, HALF = 128, HTB = HALF * BK * 2  , STAGE_BYTES = 8 * HTB, NXCD = 8, WGM = 8;

__host__ __device__ __forceinline__ int lds_byte(int r, int c) { const int st = (r >> 4) * 2 + (c >> 5), rr = r & 15, cc = c & 31, ob = rr * 64 + cc * 2; return st * 1024 + (ob ^ (((ob >> 9) & 1) << 5)); }
__host__ __device__ __forceinline__ void stage_rc(int b, int& R, int& C) { const int st = b / 1024, sb = b % 1024, swz = sb ^ (((sb >> 9) & 1) << 5); R = (st >> 1) * 16 + swz / 64; C = (st & 1) * 32 + (swz % 64) / 2; }
__host__ __device__ __forceinline__ int perm32(int rho) { const int n = rho >> 4, i = rho & 15; return 8 * (i >> 2) + 4 * n + (i & 3); }

struct Unit { int pm, pn; };
struct Gemm { const bf16_t* A; const bf16_t* Bt; int M, N, K; };

struct StaticOrder {
    int nM, nN, nwg, G, c;
    __host__ __device__ void init(int M, int N, int G_, int c_) { nM = M / BM; nN = N / BM; nwg = nM * nN; G = G_; c = c_; }
    __host__ __device__ bool next(int i, Unit& u) const {
        const long L = (long)i * G + c; if (L >= nwg) return false;
        int wgid = (int)L; { const int q = nwg / NXCD, r = nwg % NXCD, xcd = wgid % NXCD, off = wgid / NXCD; wgid = (xcd < r ? xcd * (q + 1) : r * (q + 1) + (xcd - r) * q) + off; }
        const int nig = WGM * nN, gid = wgid / nig, fm = gid * WGM, gsz = (nM - fm) < WGM ? (nM - fm) : WGM;
        u.pm = fm + ((wgid % nig) % gsz); u.pn = (wgid % nig) / gsz; return true;
    }
    __device__ __forceinline__ void a_ready(const Unit&) const {}
    __device__ __forceinline__ void done(const Unit&) const {}
};

__device__ __forceinline__ unsigned cvt_pk_bf16(float lo, float hi) { unsigned r; asm volatile("v_cvt_pk_bf16_f32 %0, %1, %2" : "=v"(r) : "v"(lo), "v"(hi)); return r; }
typedef float f32x2 __attribute__((ext_vector_type(2)));
__device__ __forceinline__ f32x2 gelu_pk(f32x2 v) {
    const f32x2 av = __builtin_elementwise_abs(v), d = av * 0.2316418882f + 1.0f;
    f32x2 t; t.x = __builtin_amdgcn_rcpf(d.x); t.y = __builtin_amdgcn_rcpf(d.y);
    f32x2 q = t * 0.5307027145f + (-0.7265760135f); q = q * t + 0.7107068705f; q = q * t + (-0.142248368f); q = q * t + 0.127414796f; q = q * t;
    const f32x2 s = (v * v) * (-0.72134752044f);
    f32x2 e; e.x = __builtin_amdgcn_exp2f(s.x); e.y = __builtin_amdgcn_exp2f(s.y);
    const f32x2 m = v * (q * e), r = v - m;
    f32x2 o; o.x = v.x < 0.f ? m.x : r.x; o.y = v.y < 0.f ? m.y : r.y; return o;
}

template <int ACT  > struct EpiBf16 {
    static constexpr bool PERM = true, AFTER_DRAIN = false; static_assert(ACT == 0 || ACT == 1, "EpiBf16: ACT is 0 (none) or 1 (gelu_pk)");
    bf16_t* O; int ldc; const float* bias; int split_cols; size_t split_stride; float scale0;
    __device__ __forceinline__ void operator()(const f32x4 (&acc)[2][2][4][2], const Unit& u, int wr, int wc, int fr, int fq) const {
        const int row0 = u.pm * BM + wr * 64 + fr; int colt = u.pn * BM; bf16_t* base = O;
        float sc = 1.f; if (split_cols) { const int t = colt / split_cols; base += (size_t)t * split_stride; colt -= t * split_cols; if (t == 0) sc = scale0; }
        const int col0 = colt + wc * 32 + 8 * fq, bcol0 = u.pn * BM + wc * 32 + 8 * fq;
        f32x4 bv[2][2];
#pragma unroll
        for (int bj = 0; bj < 2; ++bj)
#pragma unroll
            for (int n = 0; n < 2; ++n) bv[bj][n] = bias ? *(const f32x4*)(bias + bcol0 + bj * HALF + 4 * n) : (f32x4){0.f, 0.f, 0.f, 0.f};
#pragma unroll
        for (int ai = 0; ai < 2; ++ai)
#pragma unroll
            for (int m = 0; m < 4; ++m) { bf16_t* rowp = base + (size_t)(row0 + ai * HALF + m * 16) * ldc + col0;
#pragma unroll
                for (int bj = 0; bj < 2; ++bj) { f32x4 v0 = acc[ai][bj][m][0] + bv[bj][0], v1 = acc[ai][bj][m][1] + bv[bj][1];
                    if (ACT == 1) { f32x2 a = gelu_pk((f32x2){v0[0], v0[1]}), b = gelu_pk((f32x2){v0[2], v0[3]}), c = gelu_pk((f32x2){v1[0], v1[1]}), d = gelu_pk((f32x2){v1[2], v1[3]});
                        v0 = (f32x4){a.x, a.y, b.x, b.y}; v1 = (f32x4){c.x, c.y, d.x, d.y}; }
                    v0 = v0 * sc; v1 = v1 * sc; u32x4 w; w.x = cvt_pk_bf16(v0[0], v0[1]); w.y = cvt_pk_bf16(v0[2], v0[3]); w.z = cvt_pk_bf16(v1[0], v1[1]); w.w = cvt_pk_bf16(v1[2], v1[3]);
                    *(u32x4*)(rowp + bj * HALF) = w; } }
    }
};
template <class Epi, class Sched, bool ALIGN_EPI = false, bool SP2 = false>
__device__ __forceinline__ void gemm_phase(PG8_LAS unsigned char* lds, const Gemm g, const Sched& S, const Epi& E) {
    int tid = threadIdx.x; asm volatile("" : "+v"(tid));
    const int wid = __builtin_amdgcn_readfirstlane(tid >> 6), lane = tid & 63, wr = wid >> 2, wc = wid & 3, fr = lane & 15, fq = lane >> 4;
    const int K = g.K, nt = K / BK;
    unsigned voffA[2], voffB[2];
#pragma unroll
    for (int i = 0; i < 2; ++i) { int R, C; stage_rc(tid * 16 + i * 8192, R, C); const int Rb = Epi::PERM ? ((R & ~31) + perm32(R & 31)) : R;
        voffA[i] = (unsigned)(R * K + C) * 2u; voffB[i] = (unsigned)(Rb * K + C) * 2u; }
    const size_t kstep = (size_t)(BK * 2);
    const size_t hstep = (size_t)HALF * K * 2;
    const size_t tstep = 2 * hstep;
    const unsigned ldsw = (unsigned)wid * 1024u;
    const int aoff = lds_byte(wr * 64 + fr, fq * 8), boff = lds_byte(wc * 32 + fr, fq * 8);
#define PG8_SA(b, h) (((b) * 2 + (h)) * HTB)
#define PG8_SB(b, h) ((4 + (b) * 2 + (h)) * HTB)
#define PG8_STAGE(bufoff, gbase, voff) do { _Pragma("unroll") for (int _i = 0; _i < 2; ++_i) \
        __builtin_amdgcn_global_load_lds((const unsigned*)((const char*)(gbase) + (voff)[_i]), (PG8_LAS unsigned*)(lds + (bufoff) + ldsw + _i * 8192), 16, 0, 0); } while (0)
#define PG8_LDA(dst, b, h) do { _Pragma("unroll") for (int m = 0; m < 4; ++m) _Pragma("unroll") for (int k = 0; k < 2; ++k) dst[m][k] = *(const PG8_LAS bf16x8*)(lds + PG8_SA(b, h) + aoff + m * 2048 + k * 1024); } while (0)
#define PG8_LDB(dst, b, h) do { _Pragma("unroll") for (int n = 0; n < 2; ++n) _Pragma("unroll") for (int k = 0; k < 2; ++k) dst[n][k] = *(const PG8_LAS bf16x8*)(lds + PG8_SB(b, h) + boff + n * 2048 + k * 1024); } while (0)
#define PG8_MMA(ai, bj, At, Bt) do { __builtin_amdgcn_s_setprio(1); _Pragma("unroll") for (int m = 0; m < 4; ++m) _Pragma("unroll") for (int n = 0; n < 2; ++n) _Pragma("unroll") for (int k = 0; k < 2; ++k) \
        acc[ai][bj][m][n] = __builtin_amdgcn_mfma_f32_16x16x32_bf16(Bt[n][k], At[m][k], acc[ai][bj][m][n], 0, 0, 0); __builtin_amdgcn_s_setprio(0); } while (0)
#define PG8_WAIT_V(n) asm volatile("s_waitcnt vmcnt(" #n ")" ::: "memory")
#define PG8_WAIT_L(n) asm volatile("s_waitcnt lgkmcnt(" #n ")" ::: "memory")
#define PG8_BAR __builtin_amdgcn_s_barrier()
#define PG8_SCHED __builtin_amdgcn_sched_barrier(0)
    Unit cur, nxt; int ui = 0;
    if (!S.next(0, cur)) return;
    f32x4 acc[2][2][4][2];
#pragma unroll
    for (int a = 0; a < 2; ++a)
#pragma unroll
        for (int b = 0; b < 2; ++b)
#pragma unroll
            for (int m = 0; m < 4; ++m)
#pragma unroll
                for (int n = 0; n < 2; ++n) acc[a][b][m][n] = (f32x4){0.f, 0.f, 0.f, 0.f};
    bf16x8 At[4][2], B0[2][2], B1[2][2];
    const char* cA = (const char*)g.A + (size_t)cur.pm * tstep; const char* cB = (const char*)g.Bt + (size_t)cur.pn * tstep;
    S.a_ready(cur);
    if constexpr (SP2) {
        PG8_STAGE(PG8_SB(0, 0), cB, voffB); PG8_STAGE(PG8_SB(0, 1), cB + hstep, voffB); PG8_STAGE(PG8_SA(0, 0), cA, voffA); PG8_STAGE(PG8_SA(0, 1), cA + hstep, voffA);
        if (wr == 1) PG8_BAR;
        PG8_WAIT_V(2); PG8_BAR;
        PG8_STAGE(PG8_SB(1, 0), cB + kstep, voffB); PG8_STAGE(PG8_SA(1, 0), cA + kstep, voffA); PG8_STAGE(PG8_SB(1, 1), cB + hstep + kstep, voffB);
        PG8_WAIT_V(6); PG8_BAR;
    } else {
        PG8_STAGE(PG8_SB(0, 0), cB, voffB); PG8_STAGE(PG8_SA(0, 0), cA, voffA); PG8_STAGE(PG8_SB(0, 1), cB + hstep, voffB); PG8_STAGE(PG8_SA(0, 1), cA + hstep, voffA);
        if (wr == 1) PG8_BAR;
        PG8_WAIT_V(4); PG8_BAR;
        PG8_STAGE(PG8_SB(1, 0), cB + kstep, voffB); PG8_STAGE(PG8_SA(1, 0), cA + kstep, voffA); PG8_STAGE(PG8_SB(1, 1), cB + hstep + kstep, voffB);
        PG8_WAIT_V(6); PG8_BAR;
    }
    for (;;) {
        const bool has_next = S.next(ui + 1, nxt);
        const char* nA = has_next ? (const char*)g.A + (size_t)nxt.pm * tstep : cA; const char* nB = has_next ? (const char*)g.Bt + (size_t)nxt.pn * tstep : cB;
        for (int t = 0; t < nt; t += 2) {
            const bool last = (t == nt - 2);
            const char* a1 = cA + (size_t)(t + 1) * kstep;
            const char* a2 = last ? nA : cA + (size_t)(t + 2) * kstep; const char* b2 = last ? nB : cB + (size_t)(t + 2) * kstep;
            const char* a3 = a2 + kstep; const char* b3 = b2 + kstep;
            if (last && has_next) S.a_ready(nxt);
            if constexpr (SP2) {
            PG8_LDB(B0, 0, 0); PG8_LDB(B1, 0, 1); PG8_SCHED; PG8_LDA(At, 0, 0); PG8_STAGE(PG8_SA(1, 1), a1 + hstep, voffA);
            PG8_WAIT_V(8); PG8_WAIT_L(0); PG8_BAR; PG8_MMA(0, 0, At, B0); PG8_MMA(0, 1, At, B1); PG8_BAR; PG8_SCHED;
            PG8_LDA(At, 0, 1); PG8_STAGE(PG8_SB(0, 0), b2, voffB); PG8_STAGE(PG8_SB(0, 1), b2 + hstep, voffB); PG8_STAGE(PG8_SA(0, 0), a2, voffA);
            PG8_WAIT_V(8); PG8_WAIT_L(0); PG8_BAR; PG8_MMA(1, 0, At, B0); PG8_MMA(1, 1, At, B1); PG8_BAR; PG8_SCHED;
            PG8_LDB(B0, 1, 0); PG8_LDB(B1, 1, 1); PG8_SCHED; PG8_LDA(At, 1, 0); PG8_STAGE(PG8_SA(0, 1), a2 + hstep, voffA);
            PG8_WAIT_V(8); PG8_WAIT_L(0); PG8_BAR; PG8_MMA(0, 0, At, B0); PG8_MMA(0, 1, At, B1); PG8_BAR; PG8_SCHED;
            PG8_LDA(At, 1, 1); PG8_STAGE(PG8_SB(1, 0), b3, voffB); PG8_STAGE(PG8_SB(1, 1), b3 + hstep, voffB); PG8_STAGE(PG8_SA(1, 0), a3, voffA);
            PG8_WAIT_V(8); PG8_WAIT_L(0); PG8_BAR; PG8_MMA(1, 0, At, B0); PG8_MMA(1, 1, At, B1); PG8_BAR; PG8_SCHED;
            } else {
            PG8_LDB(B0, 0, 0); PG8_SCHED; PG8_LDA(At, 0, 0); PG8_STAGE(PG8_SA(1, 1), a1 + hstep, voffA);
            PG8_WAIT_L(8); PG8_BAR; PG8_WAIT_L(0); PG8_MMA(0, 0, At, B0); PG8_BAR; PG8_SCHED;
            PG8_LDB(B1, 0, 1); PG8_STAGE(PG8_SB(0, 0), b2, voffB);
            PG8_BAR; PG8_WAIT_L(0); PG8_MMA(0, 1, At, B1); PG8_BAR;
            PG8_LDA(At, 0, 1); PG8_STAGE(PG8_SA(0, 0), a2, voffA);
            PG8_BAR; PG8_WAIT_L(0); PG8_MMA(1, 0, At, B0); PG8_BAR; PG8_SCHED;
            PG8_STAGE(PG8_SB(0, 1), b2 + hstep, voffB);
            PG8_WAIT_V(6); PG8_BAR; PG8_MMA(1, 1, At, B1); PG8_BAR;
            PG8_LDB(B0, 1, 0); PG8_SCHED; PG8_LDA(At, 1, 0); PG8_STAGE(PG8_SA(0, 1), a2 + hstep, voffA);
            PG8_WAIT_L(8); PG8_BAR; PG8_WAIT_L(0); PG8_MMA(0, 0, At, B0); PG8_BAR; PG8_SCHED;
            PG8_LDB(B1, 1, 1); PG8_STAGE(PG8_SB(1, 0), b3, voffB);
            PG8_BAR; PG8_WAIT_L(0); PG8_MMA(0, 1, At, B1); PG8_BAR;
            PG8_LDA(At, 1, 1); PG8_STAGE(PG8_SA(1, 0), a3, voffA);
            PG8_BAR; PG8_WAIT_L(0); PG8_MMA(1, 0, At, B0); PG8_BAR; PG8_SCHED;
            PG8_STAGE(PG8_SB(1, 1), b3 + hstep, voffB);
            PG8_WAIT_V(6); PG8_BAR; PG8_MMA(1, 1, At, B1); PG8_BAR;
            }
        }
        if constexpr (ALIGN_EPI) { if (wr == 0) PG8_BAR; }
        if constexpr (!Epi::AFTER_DRAIN) { E(acc, cur, wr, wc, fr, fq); S.done(cur); }
        if (!has_next) break;
#pragma unroll
        for (int a = 0; a < 2; ++a)
#pragma unroll
            for (int b = 0; b < 2; ++b)
#pragma unroll
                for (int m = 0; m < 4; ++m)
#pragma unroll
                    for (int n = 0; n < 2; ++n) acc[a][b][m][n] = (f32x4){0.f, 0.f, 0.f, 0.f};
        cur = nxt; cA = nA; cB = nB; ++ui;
        if constexpr (ALIGN_EPI) { if (wr == 1) PG8_BAR; }
    }
    PG8_WAIT_V(0);
    if constexpr (!ALIGN_EPI) { if (wr == 0) PG8_BAR; }
    PG8_BAR;
    if constexpr (Epi::AFTER_DRAIN) { E.fused(acc, cur, wr, wc, fr, fq, lds, wid, lane); S.done(cur); }
#undef PG8_SA
#undef PG8_SB
#undef PG8_STAGE
#undef PG8_LDA
#undef PG8_LDB
#undef PG8_MMA
#undef PG8_WAIT_V
#undef PG8_WAIT_L
#undef PG8_BAR
#undef PG8_SCHED
}
}

#define LAS __attribute__((address_space(3)))
typedef unsigned short bf16_t;
typedef short bf16x8 __attribute__((ext_vector_type(8)));
typedef short s16x4 __attribute__((ext_vector_type(4)));
typedef float f32x4 __attribute__((ext_vector_type(4)));
typedef float f32x16 __attribute__((ext_vector_type(16)));
typedef unsigned u32x4 __attribute__((ext_vector_type(4)));
typedef unsigned u32x2 __attribute__((ext_vector_type(2)));

constexpr int DM = 1024;
constexpr int NP = 16 * 2048;
constexpr int NS = 8 * 64;
constexpr int NT = NP + NS;
constexpr int DIN = 2560;
constexpr int SKV = 2112;
constexpr float EPS = 1e-6f;
constexpr float LOG2E = 1.4426950408889634f;
constexpr float QSCALE = 0.125f * LOG2E;

constexpr long OUT_Y = 0;
constexpr long OUT_KP = 34078720L, OUT_VP = 50855936L, OUT_CONVP = 67633152L, OUT_KS = 67878912L, OUT_VS = 68141056L, OUT_CONVS = 68403200L, OUT_TOTAL = 68526080L;

constexpr size_t MiB = 1u << 20;
constexpr size_t WS_CTL = 0, CTL_BYTES = 1 * MiB;
constexpr size_t WS_WINT = 1 * MiB;
constexpr size_t WS_WOUTT = 6 * MiB;
constexpr size_t WS_WQT = 8 * MiB;
constexpr size_t WS_SK = 12 * MiB;
constexpr size_t WS_PU8 = 16 * MiB;
constexpr size_t WS_PV8 = 32 * MiB;
constexpr size_t WS_SCU = 48 * MiB;
constexpr size_t WS_SCV = 49 * MiB;
constexpr size_t WS_KS = 80 * MiB;
constexpr size_t WS_VS = 97 * MiB;
constexpr size_t WS_H = 114 * MiB;
constexpr size_t WS_A = 179 * MiB;
constexpr size_t WS_Q = 212 * MiB;
constexpr size_t WS_QP = 114 * MiB;
constexpr size_t WS_KP = 245 * MiB;
constexpr size_t WS_VP = 277 * MiB;
constexpr size_t WS_MIX = 309 * MiB;
constexpr size_t WS_H2 = 309 * MiB;
constexpr size_t WS_TK = 375 * MiB;
constexpr size_t WS_IDX = 408 * MiB;
constexpr size_t WS_GATE = 425 * MiB;
constexpr size_t WS_PACT = 114 * MiB;
constexpr size_t WS_COEF = 375 * MiB;
constexpr size_t WS_END = 442 * MiB;
static_assert(WS_H + (size_t)NT * 1024 * 2 <= WS_A && WS_A + (size_t)NT * 512 * 2 <= WS_Q && WS_Q + (size_t)NT * 512 * 2 <= WS_KP, "R1");
static_assert(WS_QP + (size_t)NT * 2048 * 2 <= WS_KP && WS_KP + (size_t)NP * 512 * 2 <= WS_VP && WS_VP + (size_t)NP * 512 * 2 <= WS_MIX, "ws map");
static_assert(WS_MIX + (size_t)NT * 1024 * 2 <= WS_TK && WS_TK + (size_t)NT * 256 * 4 <= WS_IDX && WS_IDX + (size_t)NT * 128 * 4 <= WS_GATE && WS_GATE + (size_t)NT * 128 * 4 <= WS_END, "ws map 2");
static_assert(WS_KS + (size_t)8 * SKV * 512 * 2 <= WS_VS && WS_VS + (size_t)8 * SKV * 512 * 2 <= WS_H, "ws map 3");

constexpr int RING_BYTES = 131072;
constexpr int BIAS_OFF = RING_BYTES;
constexpr int MISC_OFF = RING_BYTES + 5120;
constexpr int LDS_BYTES = MISC_OFF + 1024;

struct Params {
    const float* in[24];
    float* out;
    unsigned char* ws;
};

__device__ __forceinline__ unsigned cvtpk(float lo, float hi) { return pg8::cvt_pk_bf16(lo, hi); }
__device__ __forceinline__ float bflo(unsigned w) { return __uint_as_float(w << 16); }
__device__ __forceinline__ float bfhi(unsigned w) { return __uint_as_float(w & 0xffff0000u); }
__device__ __forceinline__ float wave_sum(float v) {
#pragma unroll
    for (int o = 1; o < 64; o <<= 1) v += __shfl_xor(v, o);
    return v;
}
typedef float f32x2 __attribute__((ext_vector_type(2)));
#define DPP_ADD(v, ctrl) v += __builtin_bit_cast(float, __builtin_amdgcn_update_dpp(0, __builtin_bit_cast(int, v), ctrl, 0xf, 0xf, true))
__device__ __forceinline__ float rl_f(float v, int l) { return __uint_as_float(__builtin_amdgcn_readlane(__float_as_uint(v), l)); }
__device__ __forceinline__ float wave_total(float v) {
    DPP_ADD(v, 0xB1); DPP_ADD(v, 0x4E); DPP_ADD(v, 0x141); DPP_ADD(v, 0x140);
    return (rl_f(v, 0) + rl_f(v, 16)) + (rl_f(v, 32) + rl_f(v, 48));
}
typedef __bf16 bf16x2_t __attribute__((ext_vector_type(2)));
__device__ __forceinline__ float dot2(unsigned a, unsigned b, float acc) {
    return __builtin_amdgcn_fdot2_f32_bf16(__builtin_bit_cast(bf16x2_t, a), __builtin_bit_cast(bf16x2_t, b), acc, false);
}
#define LDS_WAIT() asm volatile("s_waitcnt lgkmcnt(0)" ::: "memory")

#define XB_TMO      128
#define XB_XCNT(j)  (256  + 64 * (j))
#define XB_XSUB(j)  (1280 + 64 * (j))
#define XB_XGEN(j)  (2304 + 64 * (j))
#define XB_TOP      3328
#define XB_TOPGEN   3392
#define XCD_BAR_WORDS 3456
#define XB_SPIN_CAP (1u << 18)

__device__ __forceinline__ unsigned xb_ld(unsigned* p)              { return __hip_atomic_load(p, __ATOMIC_RELAXED, __HIP_MEMORY_SCOPE_AGENT); }
__device__ __forceinline__ unsigned xb_add(unsigned* p, unsigned v) { return __hip_atomic_fetch_add(p, v, __ATOMIC_RELAXED, __HIP_MEMORY_SCOPE_AGENT); }
__device__ __forceinline__ unsigned xb_xcc_id() { return (unsigned)__builtin_amdgcn_s_getreg((3 << 11) | 20) & 0xFu; }
#define XB_SPIN(cond, bar) do { unsigned _sp = 0; while (cond) { __builtin_amdgcn_s_sleep(1); \
    if ((++_sp & 255u) == 0u) { if (xb_ld(&(bar)[XB_TMO])) break; if (_sp > XB_SPIN_CAP) { atomicAdd(&(bar)[XB_TMO], 1u); break; } } } } while (0)

struct XcdBarrier {
    unsigned* bar; unsigned x;
    volatile LAS unsigned* st;
};

__device__ __forceinline__ XcdBarrier xcd_barrier_post(unsigned* bar, volatile LAS unsigned* st) {
    XcdBarrier b; b.bar = bar; b.x = xb_xcc_id(); b.st = st;
    if (threadIdx.x == 0) (void)xb_add(&bar[XB_XCNT(b.x)], 1u);
    return b;
}
__device__ __forceinline__ void xcd_barrier_complete(unsigned* bar, unsigned x, unsigned& nloc, unsigned& nx) {
    const unsigned G = gridDim.x * gridDim.y * gridDim.z;
    unsigned sum, cnt, mine, sp = 0u;
    for (;;) {
        sum = 0u; cnt = 0u; mine = 0u;
#pragma unroll
        for (unsigned j = 0; j < 16; ++j) { const unsigned c = xb_ld(&bar[XB_XCNT(j)]); sum += c; cnt += (c > 0u) ? 1u : 0u; mine = (j == x) ? c : mine; }
        if (sum == G) break;
        __builtin_amdgcn_s_sleep(1);
        if ((++sp & 255u) == 0u) { if (xb_ld(&bar[XB_TMO])) break; if (sp > XB_SPIN_CAP) { atomicAdd(&bar[XB_TMO], 1u); break; } }
    }
    nloc = mine > 0u ? mine : 1u; nx = cnt > 0u ? cnt : 1u;
}

__device__ __forceinline__ void xcd_barrier(const XcdBarrier& b) {
    asm volatile("s_waitcnt vmcnt(0)" ::: "memory");
    __syncthreads();
    if (threadIdx.x == 0) {
        unsigned* bar = b.bar;
        __builtin_amdgcn_s_waitcnt(0);
        unsigned nloc = b.st[0], nx = b.st[1];
        if (nloc == 0u) { xcd_barrier_complete(bar, b.x, nloc, nx); b.st[0] = nloc; b.st[1] = nx; }
        const unsigned old = xb_add(&bar[XB_XSUB(b.x)], 1u);
        const unsigned gen = old / nloc;
        if (old + 1u == (gen + 1u) * nloc) {
            __builtin_amdgcn_fence(__ATOMIC_RELEASE, "agent");
            asm volatile("s_waitcnt vmcnt(0)" ::: "memory");
            const unsigned og = xb_add(&bar[XB_TOP], 1u);
            const unsigned tg = og / nx;
            if (og + 1u == (tg + 1u) * nx) xb_add(&bar[XB_TOPGEN], 1u);
            else XB_SPIN(xb_ld(&bar[XB_TOPGEN]) == tg, bar);
            __builtin_amdgcn_fence(__ATOMIC_ACQUIRE, "agent");
            xb_add(&bar[XB_XGEN(b.x)], 1u);
            asm volatile("s_waitcnt vmcnt(0)" ::: "memory");
        } else {
            XB_SPIN(xb_ld(&bar[XB_XGEN(b.x)]) == gen, bar);
            __builtin_amdgcn_fence(__ATOMIC_ACQUIRE, "agent");
            asm volatile("s_waitcnt vmcnt(0)" ::: "memory");
        }
    }
    __syncthreads();
}


namespace pg8 {
__device__ __forceinline__ u32x2 pack4(f32x4 v) { u32x2 w; w.x = cvt_pk_bf16(v[0], v[1]); w.y = cvt_pk_bf16(v[2], v[3]); return w; }
struct EpiProj {
    static constexpr bool PERM = false, AFTER_DRAIN = false;
    bf16_t* A; bf16_t* Q; bf16_t* KP; bf16_t* VP; bf16_t* KS; bf16_t* VS; float* out;
    __device__ __forceinline__ void operator()(const f32x4 (&acc)[2][2][4][2], const Unit& u, int wr, int wc, int fr, int fq) const {
        const int pn = u.pn;
        const int row0 = u.pm * BM + wr * 64 + fr;
        if (pn < 4) {
#pragma unroll
            for (int ai = 0; ai < 2; ++ai)
#pragma unroll
                for (int m = 0; m < 4; ++m) {
                    const int row = row0 + ai * HALF + m * 16;
                    long toff = -1;
                    if (row < NP) { const int s = row & 2047; if (s >= 2018) toff = OUT_CONVP + ((long)(row >> 11) * 30 + (s - 2018)) * 512; }
                    else { const int rr = row - NP; const int i = rr & 63; if (i >= 34) toff = OUT_CONVS + ((long)(rr >> 6) * 30 + (i - 34)) * 512; }
#pragma unroll
                    for (int n = 0; n < 2; ++n) {
                        const int c = 128 * pn + 32 * wc + 16 * n + 4 * fq;
                        const f32x4 x = acc[ai][0][m][n], g = acc[ai][1][m][n];
                        f32x4 a;
#pragma unroll
                        for (int j = 0; j < 4; ++j) a[j] = x[j] / (1.f + __expf(-g[j]));
                        *(u32x2*)(A + (size_t)row * 512 + c) = pack4(a);
                        if (toff >= 0) *(f32x4*)(out + toff + c) = a;
                    }
                }
        } else {
            const int sec = (pn - 4) >> 1, colbase = ((pn - 4) & 1) * 256;
#pragma unroll
            for (int ai = 0; ai < 2; ++ai)
#pragma unroll
                for (int m = 0; m < 4; ++m) {
                    const int row = row0 + ai * HALF + m * 16;
                    const bool isp = row < NP; const int rr = row - NP;
                    bf16_t* bdst; float* fdst;
                    if (sec == 0) { bdst = Q + (size_t)row * 512; fdst = nullptr; }
                    else if (sec == 1) { bdst = isp ? KP + (size_t)row * 512 : KS + ((size_t)(rr >> 6) * SKV + 2048 + (rr & 63)) * 512; fdst = isp ? out + OUT_KP + (size_t)row * 512 : out + OUT_KS + (size_t)rr * 512; }
                    else { bdst = isp ? VP + (size_t)row * 512 : VS + ((size_t)(rr >> 6) * SKV + 2048 + (rr & 63)) * 512; fdst = isp ? out + OUT_VP + (size_t)row * 512 : out + OUT_VS + (size_t)rr * 512; }
#pragma unroll
                    for (int bj = 0; bj < 2; ++bj)
#pragma unroll
                        for (int n = 0; n < 2; ++n) {
                            const int col = colbase + 128 * bj + 32 * wc + 16 * n + 4 * fq;
                            const f32x4 v = acc[ai][bj][m][n];
                            if (sec == 0) { *(u32x2*)(bdst + col) = pack4(v * QSCALE); }
                            else { *(u32x2*)(bdst + col) = pack4(v); *(f32x4*)(fdst + col) = v; }
                        }
                }
        }
    }
};
struct EpiRes {
    static constexpr bool PERM = false, AFTER_DRAIN = false;
    const float* xp; const float* xs; float* out;
    __device__ __forceinline__ void operator()(const f32x4 (&acc)[2][2][4][2], const Unit& u, int wr, int wc, int fr, int fq) const {
        const int row0 = u.pm * BM + wr * 64 + fr;
#pragma unroll
        for (int ai = 0; ai < 2; ++ai)
#pragma unroll
            for (int m = 0; m < 4; ++m) {
                const int row = row0 + ai * HALF + m * 16;
                const float* xr = row < NP ? xp + (size_t)row * DM : xs + (size_t)(row - NP) * DM;
                float* orow = out + (size_t)row * DM;
#pragma unroll
                for (int bj = 0; bj < 2; ++bj)
#pragma unroll
                    for (int n = 0; n < 2; ++n) {
                        const int col = u.pn * BM + 128 * bj + 32 * wc + 16 * n + 4 * fq;
                        *(f32x4*)(orow + col) = *(const f32x4*)(xr + col) + acc[ai][bj][m][n];
                    }
            }
    }
};
}

__device__ __forceinline__ int winrow(int n) { return n < 1024 ? (256 * ((n & 511) >> 7) + 128 * (n >> 9) + (n & 127)) : n; }
template <bool WIN> __device__ __forceinline__ void transpose_item(const float* W, int K, int N, bf16_t* WT, LAS float* scr, int item, int lane) {
    const int nblk = N / 32, kb = item / nblk, nb = item % nblk, k0 = 64 * kb, n0 = 32 * nb;
#pragma unroll 8
    for (int i = 0; i < 32; ++i) { const int kk = 2 * i + (lane >> 5); scr[kk * 33 + (lane & 31)] = W[(size_t)(k0 + kk) * N + n0 + (lane & 31)]; }
    LDS_WAIT();
    const int c = lane & 7;
#pragma unroll
    for (int j = 0; j < 4; ++j) {
        const int n = (lane >> 3) + 8 * j; const LAS float* s = scr + (8 * c) * 33 + n;
        u32x4 o; o.x = cvtpk(s[0 * 33], s[1 * 33]); o.y = cvtpk(s[2 * 33], s[3 * 33]); o.z = cvtpk(s[4 * 33], s[5 * 33]); o.w = cvtpk(s[6 * 33], s[7 * 33]);
        const int dr = WIN ? winrow(n0 + n) : (n0 + n);
        *(u32x4*)(WT + (size_t)dr * K + k0 + 8 * c) = o;
    }
    LDS_WAIT();
}
__device__ __forceinline__ void cvt_stream(const float* src, bf16_t* dst, size_t n8, size_t gt, size_t ngt) {
    for (size_t i = gt; i < n8; i += ngt) {
        const f32x4 a = *(const f32x4*)(src + i * 8), b = *(const f32x4*)(src + i * 8 + 4);
        u32x4 o; o.x = cvtpk(a[0], a[1]); o.y = cvtpk(a[2], a[3]); o.z = cvtpk(b[0], b[1]); o.w = cvtpk(b[2], b[3]);
        *(u32x4*)(dst + i * 8) = o;
    }
}
__device__ __forceinline__ void cvt_cache(const float* src, bf16_t* dst, size_t gt, size_t ngt) {
    const size_t n8 = (size_t)8 * 2048 * 512 / 8;
    for (size_t i = gt; i < n8; i += ngt) {
        const size_t e = i * 8; const size_t row = e >> 9, col = e & 511; const size_t drow = (row >> 11) * SKV + (row & 2047);
        const f32x4 a = *(const f32x4*)(src + e), b = *(const f32x4*)(src + e + 4);
        u32x4 o; o.x = cvtpk(a[0], a[1]); o.y = cvtpk(a[2], a[3]); o.z = cvtpk(b[0], b[1]); o.w = cvtpk(b[2], b[3]);
        *(u32x4*)(dst + drow * 512 + col) = o;
    }
}
__device__ __forceinline__ void rms_row_bf16(const float* xrow, const float* g, bf16_t* orow, int lane) {
    const f32x4* xr = (const f32x4*)xrow + lane; const f32x4* gr = (const f32x4*)g + lane;
    f32x4 v[4]; float s = 0.f;
#pragma unroll
    for (int j = 0; j < 4; ++j) { v[j] = xr[64 * j]; s += (v[j][0] * v[j][0] + v[j][1] * v[j][1]) + (v[j][2] * v[j][2] + v[j][3] * v[j][3]); }
    const float rstd = 1.f / sqrtf(wave_sum(s) * (1.f / DM) + EPS);
    u32x2* o8 = (u32x2*)orow + lane;
#pragma unroll
    for (int j = 0; j < 4; ++j) { const f32x4 gg = gr[64 * j]; u32x2 w; w.x = cvtpk(v[j][0] * rstd * gg[0], v[j][1] * rstd * gg[1]); w.y = cvtpk(v[j][2] * rstd * gg[2], v[j][3] * rstd * gg[3]); o8[64 * j] = w; }
}

template <bool SLICED> __device__ __forceinline__ void cvt_row_fp8(const float* src, unsigned char* dst_base, int row, float* scale_out, int lane) {
    const f32x4* xr = (const f32x4*)src + lane;
    f32x4 v[4]; float am = 0.f;
#pragma unroll
    for (int j = 0; j < 4; ++j) { v[j] = xr[64 * j]; am = fmaxf(am, fmaxf(fmaxf(fabsf(v[j][0]), fabsf(v[j][1])), fmaxf(fabsf(v[j][2]), fabsf(v[j][3])))); }
#pragma unroll
    for (int o = 1; o < 64; o <<= 1) am = fmaxf(am, __shfl_xor(am, o));
    const float sc = am > 0.f ? am * (1.f / 448.f) : 1.f, inv = 1.f / sc;
#pragma unroll
    for (int j = 0; j < 4; ++j) {
        const int eb = 256 * j + 4 * lane;
        int w = __builtin_amdgcn_cvt_pk_fp8_f32(v[j][0] * inv, v[j][1] * inv, 0, false);
        w = __builtin_amdgcn_cvt_pk_fp8_f32(v[j][2] * inv, v[j][3] * inv, w, true);
        if (SLICED) *(int*)(dst_base + ((size_t)(eb >> 7) * 16384 + row) * 128 + (eb & 127)) = w;
        else *(int*)(dst_base + (size_t)row * DM + 16 * ((eb & 511) >> 3) + (eb & 7) + (eb >= 512 ? 8 : 0)) = w;
    }
    if (lane == 0) *scale_out = sc;
}

__device__ __forceinline__ void phase0(const Params& p, LAS unsigned char* lds, int tid, int lane, int wave) {
    const int gw = blockIdx.x * 8 + wave, NGW = gridDim.x * 8;
    LAS float* scr = (LAS float*)(lds + wave * 16384);
    bf16_t* WINT = (bf16_t*)(p.ws + WS_WINT);
    constexpr int I_IN = 16 * (DIN / 32);
    for (int it = gw; it < I_IN; it += NGW) transpose_item<true>(p.in[6], 1024, DIN, WINT, scr, it, lane);
    bf16_t* H = (bf16_t*)(p.ws + WS_H);
    for (int m = gw; m < NT; m += NGW) {
        const float* xr = m < NP ? p.in[0] + (size_t)m * DM : p.in[1] + (size_t)(m - NP) * DM;
        rms_row_bf16(xr, p.in[5], H + (size_t)m * DM, lane);
    }
}
__device__ __forceinline__ void prep_late(const Params& p, LAS unsigned char* lds, int tid, int lane, int wave, int rank, int nparts) {
    const int gw = rank * 8 + wave, NGW = nparts * 8;
    LAS float* scr = (LAS float*)(lds + wave * 16384);
    const size_t gt = (size_t)rank * 512 + tid, ngt = (size_t)nparts * 512;
    cvt_cache(p.in[2], (bf16_t*)(p.ws + WS_KS), gt, ngt);
    cvt_cache(p.in[3], (bf16_t*)(p.ws + WS_VS), gt, ngt);
    bf16_t* WOUTT = (bf16_t*)(p.ws + WS_WOUTT); bf16_t* WQT = (bf16_t*)(p.ws + WS_WQT);
    constexpr int I_OUT = 16 * (1024 / 32), I_Q = 16 * (2048 / 32);
    for (int it = gw; it < I_OUT + I_Q; it += NGW) {
        if (it < I_OUT) transpose_item<false>(p.in[17], 1024, 1024, WOUTT, scr, it, lane);
        else transpose_item<false>(p.in[19], 1024, 2048, WQT, scr, it - I_OUT, lane);
    }
    cvt_stream(p.in[20], (bf16_t*)(p.ws + WS_SK), (size_t)16 * 128 * 128 / 8, gt, ngt);
    for (int r = gw; r < 2 * 16384; r += NGW) {
        const int tb = r >> 14, e = r & 16383;
        if (tb) cvt_row_fp8<true>(p.in[22] + (size_t)e * DM, p.ws + WS_PV8, e, (float*)(p.ws + WS_SCV) + e, lane);
        else cvt_row_fp8<true>(p.in[21] + (size_t)e * DM, p.ws + WS_PU8, e, (float*)(p.ws + WS_SCU) + e, lane);
    }
}

namespace att {
constexpr int KPITCH = 272, VPITCH = 320;
constexpr int L_KV = 0, KV_BYTES = 64 * KPITCH + 64 * VPITCH  , L_X = 0  , L_BIAS = BIAS_OFF, L_CA = 0  , L_CW = 94 * 1024  ;
static_assert(4 * 4096 * 4 <= 2 * KV_BYTES && 2 * KV_BYTES <= L_CW && L_CW + 31 * 1024 <= RING_BYTES, "attention LDS map");

__device__ __forceinline__ int rel_bucket(int rel) {
    const int ret = rel > 0 ? 16 : 0; const int n = rel < 0 ? -rel : rel; int v;
    if (n < 8) v = n; else if (n < 12) v = 8; else if (n < 16) v = 9; else if (n < 23) v = 10; else if (n < 32) v = 11;
    else if (n < 46) v = 12; else if (n < 64) v = 13; else if (n < 91) v = 14; else v = 15;
    return ret + v;
}
typedef short v4i16_t __attribute__((ext_vector_type(4)));
__device__ __forceinline__ s16x4 vtr(const LAS unsigned char* p) { return __builtin_bit_cast(s16x4, __builtin_amdgcn_ds_read_tr16_b64_v4i16((LAS v4i16_t*)p)); }
__device__ __forceinline__ f32x16 mfma32(bf16x8 a, bf16x8 b, f32x16 c) { return __builtin_amdgcn_mfma_f32_32x32x16_bf16(a, b, c, 0, 0, 0); }

__device__ __forceinline__ void attn_unit(const Params& p, LAS unsigned char* lds, int kind, int bb, int h, int qblk, float lam, int tid, int lane, int wid) {
    const bf16_t* Q = (const bf16_t*)(p.ws + WS_Q);
    const bf16_t* Kb = kind == 0 ? (const bf16_t*)(p.ws + WS_KP) + (size_t)bb * 2048 * 512 + h * 128 : (const bf16_t*)(p.ws + WS_KS) + (size_t)bb * SKV * 512 + h * 128;
    const bf16_t* Vb = kind == 0 ? (const bf16_t*)(p.ws + WS_VP) + (size_t)bb * 2048 * 512 + h * 128 : (const bf16_t*)(p.ws + WS_VS) + (size_t)bb * SKV * 512 + h * 128;
    bf16_t* MIX = (bf16_t*)(p.ws + WS_MIX);
    const int qrow0 = kind == 0 ? bb * 2048 + qblk * 128 : NP + bb * 64;
    const int qpos0 = kind == 0 ? qblk * 128 : 2048;
    const int ntiles = kind == 0 ? 2 * qblk + 2 : 33;
    const int rg = wid & 3, map = wid >> 2, r32 = lane & 31, hi = lane >> 5;
    const bool active = kind == 0 ? true : (rg < 2);
    const int cw = kind == 0 ? 2 * qblk + (rg >> 1) : 32;
    const int qw0 = qpos0 + 32 * rg;
    const int qabs = qw0 + r32;

    bf16x8 qf[4];
    if (active) {
        const bf16_t* qp = Q + (size_t)(qrow0 + 32 * rg + r32) * 512 + h * 128 + map * 64 + 8 * hi;
#pragma unroll
        for (int s = 0; s < 4; ++s) qf[s] = *(const bf16x8*)(qp + 16 * s);
    } else {
#pragma unroll
        for (int s = 0; s < 4; ++s) qf[s] = (bf16x8){0, 0, 0, 0, 0, 0, 0, 0};
    }
    float m = 0.f, l = 0.f;
    f32x16 negm;
#pragma unroll
    for (int r = 0; r < 16; ++r) negm[r] = 0.f;
    f32x16 o[4];
#pragma unroll
    for (int mt = 0; mt < 4; ++mt)
#pragma unroll
        for (int r = 0; r < 16; ++r) o[mt][r] = 0.f;

    const int srow0 = tid >> 4, sch = tid & 15;
    const LAS float* btab = (const LAS float*)(lds + L_BIAS) + h * 320;
    const int vlane = (4 * hi + ((lane & 15) >> 2)) * VPITCH + (16 * ((lane >> 4) & 1) + 4 * (lane & 3)) * 2;
    u32x4 kA[2], vA[2], kB[2], vB[2];
#define ATT_LOAD(KR, VR, T) do { _Pragma("unroll") for (int i_ = 0; i_ < 2; ++i_) { const size_t off_ = (size_t)((T) * 64 + srow0 + 32 * i_) * 512 + sch * 8; KR[i_] = *(const u32x4*)(Kb + off_); VR[i_] = *(const u32x4*)(Vb + off_); } } while (0)
#define ATT_STORE(KR, VR, BUF) do { _Pragma("unroll") for (int i_ = 0; i_ < 2; ++i_) { \
        *(LAS u32x4*)(lds + L_KV + (BUF) * KV_BYTES + (srow0 + 32 * i_) * KPITCH + sch * 16) = KR[i_]; \
        *(LAS u32x4*)(lds + L_KV + (BUF) * KV_BYTES + 64 * KPITCH + (srow0 + 32 * i_) * VPITCH + sch * 16) = VR[i_]; } } while (0)
    auto compute = [&](int t, int buf) {
        const LAS unsigned char* kbuf = lds + L_KV + buf * KV_BYTES;
        const LAS unsigned char* vbuf = kbuf + 64 * KPITCH;
        f32x16 p0, p1;
        const int kabs0 = t * 64;
        const LAS unsigned char* kb = kbuf + r32 * KPITCH + (map * 8 + hi) * 16;
        {
            const bf16x8 a0 = *(const LAS bf16x8*)(kb), a1 = *(const LAS bf16x8*)(kb + 32 * KPITCH);
            if (kabs0 + 63 - qw0 > -128) {
                const LAS float* bt = btab + (kabs0 - qabs + 256 + 4 * hi);
#pragma unroll
                for (int r = 0; r < 16; ++r) { p0[r] = bt[(r & 3) + 8 * (r >> 2)] - m; p1[r] = bt[32 + (r & 3) + 8 * (r >> 2)] - m; }
                p0 = mfma32(a0, qf[0], p0); p1 = mfma32(a1, qf[0], p1);
            } else { p0 = mfma32(a0, qf[0], negm); p1 = mfma32(a1, qf[0], negm); }
        }
#pragma unroll
        for (int s = 1; s < 4; ++s) {
            const bf16x8 a0 = *(const LAS bf16x8*)(kb + s * 32), a1 = *(const LAS bf16x8*)(kb + 32 * KPITCH + s * 32);
            p0 = mfma32(a0, qf[s], p0); p1 = mfma32(a1, qf[s], p1);
        }
        float mx = fmaxf(p0[0], p1[0]);
#pragma unroll
        for (int r = 1; r < 16; ++r) mx = fmaxf(mx, fmaxf(p0[r], p1[r]));
        { const auto rr = __builtin_amdgcn_permlane32_swap(__float_as_uint(mx), __float_as_uint(mx), false, false); mx = fmaxf(__uint_as_float(rr[0]), __uint_as_float(rr[1])); }
        if (__any(mx > 8.f)) {
            const float dl = fmaxf(mx, 0.f);
            m += dl;
            const float alpha = __builtin_amdgcn_exp2f(-dl);
            l *= alpha;
#pragma unroll
            for (int r = 0; r < 16; ++r) { p0[r] -= dl; p1[r] -= dl; negm[r] = -m; }
#pragma unroll
            for (int mt = 0; mt < 4; ++mt)
#pragma unroll
                for (int r = 0; r < 16; ++r) o[mt][r] *= alpha;
        }
        float rs = 0.f;
#pragma unroll
        for (int r = 0; r < 16; ++r) { p0[r] = __builtin_amdgcn_exp2f(p0[r]); p1[r] = __builtin_amdgcn_exp2f(p1[r]); rs += p0[r] + p1[r]; }
        l += rs;
#pragma unroll
        for (int t2 = 0; t2 < 2; ++t2)
#pragma unroll
            for (int s = 0; s < 2; ++s) {
                u32x4 bw;
                if (t2 == 0) { bw.x = cvtpk(p0[8 * s + 0], p0[8 * s + 1]); bw.y = cvtpk(p0[8 * s + 2], p0[8 * s + 3]); bw.z = cvtpk(p0[8 * s + 4], p0[8 * s + 5]); bw.w = cvtpk(p0[8 * s + 6], p0[8 * s + 7]); }
                else { bw.x = cvtpk(p1[8 * s + 0], p1[8 * s + 1]); bw.y = cvtpk(p1[8 * s + 2], p1[8 * s + 3]); bw.z = cvtpk(p1[8 * s + 4], p1[8 * s + 5]); bw.w = cvtpk(p1[8 * s + 6], p1[8 * s + 7]); }
                const bf16x8 B = __builtin_bit_cast(bf16x8, bw);
                const LAS unsigned char* vb = vbuf + vlane + (32 * t2 + 16 * s) * VPITCH;
#pragma unroll
                for (int mt = 0; mt < 4; ++mt) {
                    const s16x4 lo = vtr(vb + mt * 64), hi8 = vtr(vb + mt * 64 + 8 * VPITCH);
                    const bf16x8 A = (bf16x8){lo[0], lo[1], lo[2], lo[3], hi8[0], hi8[1], hi8[2], hi8[3]};
                    o[mt] = mfma32(A, B, o[mt]);
                }
            }
    };
    ATT_LOAD(kA, vA, 0);
    if (ntiles > 1) ATT_LOAD(kB, vB, 1);
    ATT_STORE(kA, vA, 0);
    if (ntiles > 2) ATT_LOAD(kA, vA, 2);
    __syncthreads();
    for (int t = 0; t < ntiles; t += 2) {
        if (t + 1 < ntiles) { ATT_STORE(kB, vB, 1); if (t + 3 < ntiles) ATT_LOAD(kB, vB, t + 3); }
        if (active && t <= cw) compute(t, 0);
        __syncthreads();
        if (t + 1 >= ntiles) break;
        if (t + 2 < ntiles) { ATT_STORE(kA, vA, 0); if (t + 4 < ntiles) ATT_LOAD(kA, vA, t + 4); }
        if (active && t + 1 <= cw) compute(t + 1, 1);
        __syncthreads();
    }
#undef ATT_LOAD
#undef ATT_STORE
    l += __shfl_xor(l, 32);
    const float inv = 1.f / l;
    LAS float* X = (LAS float*)(lds + L_X) + rg * 4096;
    if (active && map == 1) {
        const float sc = -lam * inv;
#pragma unroll
        for (int mt = 0; mt < 4; ++mt)
#pragma unroll
            for (int r = 0; r < 16; ++r) X[(mt * 16 + r) * 64 + lane] = o[mt][r] * sc;
    }
    __syncthreads();
    if (active && map == 0) {
        float ss = 0.f;
#pragma unroll
        for (int mt = 0; mt < 4; ++mt)
#pragma unroll
            for (int r = 0; r < 16; ++r) { const float v = o[mt][r] * inv + X[(mt * 16 + r) * 64 + lane]; o[mt][r] = v; ss += v * v; }
        ss += __shfl_xor(ss, 32);
        const float rsn = 0.8f / sqrtf(ss * (1.f / 128.f) + EPS);
        bf16_t* orow = MIX + (size_t)(qrow0 + 32 * rg + r32) * 1024 + 512 + h * 128;
        const float* sg = p.in[15];
#pragma unroll
        for (int mt = 0; mt < 4; ++mt)
#pragma unroll
            for (int g4 = 0; g4 < 4; ++g4) {
                const int e = 32 * mt + 8 * g4 + 4 * hi;
                const f32x4 gg = *(const f32x4*)(sg + e);
                u32x2 w; w.x = cvtpk(o[mt][4 * g4 + 0] * rsn * gg[0], o[mt][4 * g4 + 1] * rsn * gg[1]); w.y = cvtpk(o[mt][4 * g4 + 2] * rsn * gg[2], o[mt][4 * g4 + 3] * rsn * gg[3]);
                *(u32x2*)(orow + e) = w;
            }
    }
    __syncthreads();
}

__device__ __forceinline__ void unpack8(const u32x4 w, float (&f)[8]) { f[0] = bflo(w.x); f[1] = bfhi(w.x); f[2] = bflo(w.y); f[3] = bfhi(w.y); f[4] = bflo(w.z); f[5] = bfhi(w.z); f[6] = bflo(w.w); f[7] = bfhi(w.w); }
__device__ __forceinline__ void conv_unit(const Params& p, LAS unsigned char* lds, int cu, int tid, int lane, int wid) {
    const bf16_t* A = (const bf16_t*)(p.ws + WS_A);
    bf16_t* MIX = (bf16_t*)(p.ws + WS_MIX);
    const float* cb = p.in[8]; const float* lg = p.in[9]; const float* lb = p.in[10]; const float* st = p.in[4];
    const int row0 = cu * 64;
    const bool isp = row0 < NP;
    const int s0 = isp ? (row0 & 2047) : 0, rbase = row0 - s0, bd = isp ? 0 : ((row0 - NP) >> 6);
    for (int c = tid; c < 94 * 64; c += 512) {
        const int rr = c >> 6, ch = c & 63, sp = s0 - 30 + rr;
        u32x4 v = (u32x4){0u, 0u, 0u, 0u};
        if (sp >= 0) v = *(const u32x4*)(A + (size_t)(rbase + sp) * 512 + ch * 8);
        else if (!isp) { const float* sr = st + ((size_t)bd * 30 + (30 + sp)) * 512 + ch * 8; const f32x4 a0 = *(const f32x4*)sr, a1 = *(const f32x4*)(sr + 4);
            v.x = cvtpk(a0[0], a0[1]); v.y = cvtpk(a0[2], a0[3]); v.z = cvtpk(a1[0], a1[1]); v.w = cvtpk(a1[2], a1[3]); }
        *(LAS u32x4*)(lds + L_CA + rr * 1024 + ch * 16) = v;
    }
    __syncthreads();
    const int c0 = lane * 8;
    float bias8[8], g8[8], b8[8];
    { const f32x4 x0 = *(const f32x4*)(cb + c0), x1 = *(const f32x4*)(cb + c0 + 4), y0 = *(const f32x4*)(lg + c0), y1 = *(const f32x4*)(lg + c0 + 4), z0 = *(const f32x4*)(lb + c0), z1 = *(const f32x4*)(lb + c0 + 4);
#pragma unroll
      for (int q = 0; q < 4; ++q) { bias8[q] = x0[q]; bias8[4 + q] = x1[q]; g8[q] = y0[q]; g8[4 + q] = y1[q]; b8[q] = z0[q]; b8[4 + q] = z1[q]; } }
    for (int grp = 0; grp < 2; ++grp) {
        const int t0 = wid * 8 + grp * 4;
        float acc[4][8];
#pragma unroll
        for (int q = 0; q < 4; ++q)
#pragma unroll
            for (int c = 0; c < 8; ++c) acc[q][c] = bias8[c];
        const LAS unsigned char* ap = lds + L_CA + t0 * 1024 + lane * 16;
        const LAS unsigned char* wp = lds + L_CW + lane * 16;
#pragma unroll 1
        for (int j = 0; j < 31; ++j) {
            float w[8]; unpack8(*(const LAS u32x4*)(wp + j * 1024), w);
#pragma unroll
            for (int q = 0; q < 4; ++q) {
                float a[8]; unpack8(*(const LAS u32x4*)(ap + (j + q) * 1024), a);
#pragma unroll
                for (int c = 0; c < 8; ++c) acc[q][c] += w[c] * a[c];
            }
        }
#pragma unroll
        for (int q = 0; q < 4; ++q) {
            float sm = 0.f;
#pragma unroll
            for (int c = 0; c < 8; ++c) sm += acc[q][c];
            const float mu = wave_total(sm) * (1.f / 512.f);
            float sv = 0.f;
#pragma unroll
            for (int c = 0; c < 8; ++c) { acc[q][c] -= mu; sv += acc[q][c] * acc[q][c]; }
            const float rstd = 1.f / sqrtf(wave_total(sv) * (1.f / 512.f) + EPS);
            float y[8];
#pragma unroll
            for (int c = 0; c < 8; ++c) { y[c] = acc[q][c] * rstd * g8[c] + b8[c]; y[c] = y[c] / (1.f + __expf(-y[c])); }
            u32x4 w; w.x = cvtpk(y[0], y[1]); w.y = cvtpk(y[2], y[3]); w.z = cvtpk(y[4], y[5]); w.w = cvtpk(y[6], y[7]);
            *(u32x4*)(MIX + (size_t)(row0 + t0 + q) * 1024 + c0) = w;
        }
    }
}

constexpr int N_SAMPLE_UNITS = 32, N_PROMPT_UNITS = 1024, N_CONV_UNITS = NT / 64, N_UNITS = N_SAMPLE_UNITS + N_PROMPT_UNITS + N_CONV_UNITS;

__device__ __forceinline__ void phase2(const Params& p, LAS unsigned char* lds, int tid, int lane, int wid, int cidx, int mode) {
    LAS float* bt = (LAS float*)(lds + L_BIAS);
    for (int e = tid; e < 4 * 320; e += 512) { const int hh = e / 320, rel = (e % 320) - 256; bt[e] = (p.in[16][rel_bucket(rel) * 4 + hh] - p.in[16][15 * 4 + hh]) * LOG2E; }
    for (int c = tid; c < 31 * 64; c += 512) {
        const float* wr = p.in[7] + (size_t)c * 8; const f32x4 a0 = *(const f32x4*)wr, a1 = *(const f32x4*)(wr + 4);
        u32x4 v; v.x = cvtpk(a0[0], a0[1]); v.y = cvtpk(a0[2], a0[3]); v.z = cvtpk(a1[0], a1[1]); v.w = cvtpk(a1[2], a1[3]);
        *(LAS u32x4*)(lds + L_CW + c * 16) = v;
    }
    const float d1 = wave_sum(p.in[11][lane] * p.in[12][lane]), d2 = wave_sum(p.in[13][lane] * p.in[14][lane]);
    const float lam = expf(d1) - expf(d2) + 0.2f;
    unsigned* ctr = (unsigned*)(p.ws + WS_CTL) + 64 * cidx;
    volatile LAS unsigned* sw = (volatile LAS unsigned*)(lds + MISC_OFF);
    __syncthreads();
    for (;;) {
        __syncthreads();
        if (tid == 0) sw[0] = atomicAdd(ctr, 1u);
        __syncthreads();
        const int u = (int)sw[0];
        if (u >= N_UNITS) break;
        if (mode == 1 && u >= N_SAMPLE_UNITS + N_PROMPT_UNITS) continue;
        if (mode == 2 && u < N_SAMPLE_UNITS + N_PROMPT_UNITS) continue;
        int tid_ = tid; asm volatile("" : "+v"(tid_));
        if (u < N_SAMPLE_UNITS + N_PROMPT_UNITS) {
            const int v = u - N_SAMPLE_UNITS; const int bh = v & 63; const bool smp = u < N_SAMPLE_UNITS;
            attn_unit(p, lds, smp ? 1 : 0, smp ? (u >> 2) : (bh >> 2), smp ? (u & 3) : (bh & 3), smp ? 0 : 15 - (v >> 6), lam, tid_, tid_ & 63, wid);
        } else conv_unit(p, lds, u - N_SAMPLE_UNITS - N_PROMPT_UNITS, tid_, tid_ & 63, wid);
    }
}
}

template <class F> __device__ __forceinline__ void mini_gemm(const bf16_t* A, const bf16_t* Bt, int N, int lane, int wave, F epi) {
    const int ntasks = 16 * (N / 64), G = gridDim.x;
    const int fr = lane & 15, fq = lane >> 4;
    for (int task = wave * G + (int)blockIdx.x; task < ntasks; task += 8 * G) {
        const int rb = task & 15, cb = task >> 4;
        pg8::f32x4 acc[2][4];
#pragma unroll
        for (int m = 0; m < 2; ++m)
#pragma unroll
            for (int n = 0; n < 4; ++n) acc[m][n] = (pg8::f32x4){0.f, 0.f, 0.f, 0.f};
        const bf16_t* ap = A + (size_t)(rb * 32 + fr) * 1024 + 8 * fq;
        const bf16_t* bp = Bt + (size_t)(cb * 64 + fr) * 1024 + 8 * fq;
#pragma unroll 4
        for (int k0 = 0; k0 < 1024; k0 += 32) {
            const bf16x8 a0 = *(const bf16x8*)(ap + k0), a1 = *(const bf16x8*)(ap + 16 * 1024 + k0);
            bf16x8 b[4];
#pragma unroll
            for (int n = 0; n < 4; ++n) b[n] = *(const bf16x8*)(bp + (size_t)n * 16 * 1024 + k0);
#pragma unroll
            for (int n = 0; n < 4; ++n) { acc[0][n] = __builtin_amdgcn_mfma_f32_16x16x32_bf16(b[n], a0, acc[0][n], 0, 0, 0); acc[1][n] = __builtin_amdgcn_mfma_f32_16x16x32_bf16(b[n], a1, acc[1][n], 0, 0, 0); }
        }
#pragma unroll
        for (int m = 0; m < 2; ++m)
#pragma unroll
            for (int n = 0; n < 4; ++n) epi(rb * 32 + 16 * m + fr, cb * 64 + 16 * n + 4 * fq, acc[m][n]);
    }
}

__device__ __forceinline__ void phase3b(const Params& p, int lane, int wave) {
    const int gw = blockIdx.x * 8 + wave, NGW = gridDim.x * 8;
    bf16_t* H2 = (bf16_t*)(p.ws + WS_H2);
    for (int m = gw; m < NT; m += NGW) rms_row_bf16(p.out + (size_t)m * DM, p.in[18], H2 + (size_t)m * DM, lane);
}

constexpr int P4B_KPITCH = 272, P4B_K_BYTES = 128 * P4B_KPITCH, P4B_Q_BYTES = 32 * P4B_KPITCH;
static_assert(P4B_K_BYTES + 8 * P4B_Q_BYTES <= RING_BYTES, "P4b LDS map");
__device__ __forceinline__ void phase4b(const Params& p, LAS unsigned char* lds, int tid, int lane, int wave) {
    const bf16_t* QP = (const bf16_t*)(p.ws + WS_QP); const bf16_t* SK = (const bf16_t*)(p.ws + WS_SK);
    float* TK = (float*)(p.ws + WS_TK);
    const int r32 = lane & 31, hi = lane >> 5;
    const int G = gridDim.x;
    for (int rp = blockIdx.x & 15; rp < 16; rp += (G < 16 ? G : 16)) {
        const int nbr = (G - rp + 15) >> 4, member = (int)blockIdx.x >> 4;
        __syncthreads();
        for (int c = tid; c < 128 * 16; c += 512) { const int row = c >> 4, ch = c & 15; *(LAS u32x4*)(lds + row * P4B_KPITCH + ch * 16) = *(const u32x4*)(SK + ((size_t)rp * 128 + row) * 128 + ch * 8); }
        __syncthreads();
        LAS unsigned char* qs = lds + P4B_K_BYTES + wave * P4B_Q_BYTES;
        for (int tg = member * 8 + wave; tg < NT / 32; tg += nbr * 8) {
            const int t0 = tg * 32;
#pragma unroll
            for (int i = 0; i < 8; ++i) { const int row = 4 * i + (lane >> 4), ch = lane & 15; *(LAS u32x4*)(qs + row * P4B_KPITCH + ch * 16) = *(const u32x4*)(QP + (size_t)(t0 + row) * 2048 + rp * 128 + ch * 8); }
            bf16x8 qf[8];
#pragma unroll
            for (int s = 0; s < 8; ++s) qf[s] = *(const LAS bf16x8*)(qs + r32 * P4B_KPITCH + (2 * s + hi) * 16);
            float v[64];
#pragma unroll
            for (int mt = 0; mt < 4; ++mt) {
                f32x16 S;
#pragma unroll
                for (int r = 0; r < 16; ++r) S[r] = 0.f;
                const LAS unsigned char* kp = lds + (32 * mt + r32) * P4B_KPITCH + hi * 16;
#pragma unroll
                for (int s = 0; s < 8; ++s) S = att::mfma32(*(const LAS bf16x8*)(kp + s * 32), qf[s], S);
#pragma unroll
                for (int r = 0; r < 16; ++r) { const int n = 32 * mt + (r & 3) + 8 * (r >> 2) + 4 * hi; v[mt * 16 + r] = __uint_as_float((__float_as_uint(S[r]) & ~127u) | (unsigned)(127 - n)); }
            }
            SORT16_DESC(v, 0); SORT16_DESC(v, 16); SORT16_DESC(v, 32); SORT16_DESC(v, 48);
#pragma unroll
            for (int i = 0; i < 16; ++i) { v[i] = fmaxf(v[i], v[31 - i]); v[32 + i] = fmaxf(v[32 + i], v[63 - i]); }
            BITONIC16_DESC(v, 0); BITONIC16_DESC(v, 32);
#pragma unroll
            for (int i = 0; i < 16; ++i) v[i] = fmaxf(v[i], v[47 - i]);
            BITONIC16_DESC(v, 0);
            float w[16];
#pragma unroll
            for (int i = 0; i < 16; ++i) w[i] = fmaxf(v[i], __shfl_xor(v[15 - i], 32));
            BITONIC16_DESC(w, 0);
            if (hi == 0) {
                f32x4* dst = (f32x4*)(TK + ((size_t)(t0 + r32) * 16 + rp) * 16);
#pragma unroll
                for (int q = 0; q < 4; ++q) dst[q] = (f32x4){w[4 * q], w[4 * q + 1], w[4 * q + 2], w[4 * q + 3]};
            }
        }
    }
}

__device__ __forceinline__ void phase5a(const Params& p, int tid) {
    const float* TK = (const float*)(p.ws + WS_TK);
    int* IDX = (int*)(p.ws + WS_IDX); float* GATE = (float*)(p.ws + WS_GATE);
    const float NEG_INF = -__builtin_huge_valf();
    for (int item = blockIdx.x * 512 + tid; item < NT * 8; item += gridDim.x * 512) {
        const int tok = item >> 3, r = item & 7;
        const f32x4* pa = (const f32x4*)(TK + ((size_t)tok * 16 + 2 * r) * 16);
        float a[16], b[16]; int ia[16], ib[16];
#pragma unroll
        for (int q = 0; q < 4; ++q) { const f32x4 x = pa[q], y = pa[4 + q];
#pragma unroll
            for (int j = 0; j < 4; ++j) { a[4 * q + j] = x[j]; b[4 * q + j] = y[j]; } }
#pragma unroll
        for (int i = 0; i < 16; ++i) { const unsigned ua = __float_as_uint(a[i]), ub = __float_as_uint(b[i]); ia[i] = 127 - (int)(ua & 127u); ib[i] = 127 - (int)(ub & 127u); a[i] = __uint_as_float(ua & ~127u); b[i] = __uint_as_float(ub & ~127u); }
        float cv[50]; int cid[50];
        {
            int c = 0;
#pragma unroll
            for (int i = 0; i < 16; ++i)
#pragma unroll
                for (int j = 0; j < 16; ++j)
                    if ((i + 1) * (j + 1) <= 16) { const float s = a[i] + b[j]; cv[c] = __uint_as_float((__float_as_uint(s) & ~63u) | (unsigned)(63 - c)); cid[c] = ia[i] * 128 + ib[j]; ++c; }
        }
        float best[16]; int bid[16];
#pragma unroll
        for (int it = 0; it < 16; ++it) {
            float mx = cv[0];
#pragma unroll
            for (int c = 1; c < 50; ++c) mx = fmaxf(mx, cv[c]);
            int id = 0;
#pragma unroll
            for (int c = 0; c < 50; ++c) { const bool hit = cv[c] == mx; id = hit ? cid[c] : id; cv[c] = hit ? NEG_INF : cv[c]; }
            best[it] = __uint_as_float(__float_as_uint(mx) & ~63u); bid[it] = id;
        }
        float e[16], sum = 0.f;
#pragma unroll
        for (int k = 0; k < 16; ++k) { e[k] = __expf(best[k] - best[0]); sum += e[k]; }
        const float rinv = 1.f / sum;
        int* io = IDX + (size_t)tok * 128 + r * 16; float* go = GATE + (size_t)tok * 128 + r * 16;
#pragma unroll
        for (int k = 0; k < 16; ++k) { io[k] = bid[k]; go[k] = e[k] * rinv; }
    }
}

__device__ __forceinline__ float gelu_erf(float x) { return 0.5f * x * (1.f + erff(x * 0.70710678118654752f)); }
__device__ __forceinline__ void fp8x16_to_f32(const u32x4 q, float (&f)[16]) {
    const f32x2 c0 = __builtin_amdgcn_cvt_pk_f32_fp8(q.x, false), c1 = __builtin_amdgcn_cvt_pk_f32_fp8(q.x, true), c2 = __builtin_amdgcn_cvt_pk_f32_fp8(q.y, false), c3 = __builtin_amdgcn_cvt_pk_f32_fp8(q.y, true);
    const f32x2 c4 = __builtin_amdgcn_cvt_pk_f32_fp8(q.z, false), c5 = __builtin_amdgcn_cvt_pk_f32_fp8(q.z, true), c6 = __builtin_amdgcn_cvt_pk_f32_fp8(q.w, false), c7 = __builtin_amdgcn_cvt_pk_f32_fp8(q.w, true);
    f[0] = c0.x; f[1] = c0.y; f[2] = c1.x; f[3] = c1.y; f[4] = c2.x; f[5] = c2.y; f[6] = c3.x; f[7] = c3.y;
    f[8] = c4.x; f[9] = c4.y; f[10] = c5.x; f[11] = c5.y; f[12] = c6.x; f[13] = c6.y; f[14] = c7.x; f[15] = c7.y;
}
__device__ __forceinline__ void slice_group(int& x, int& gwx, int& nwx, int wave) {
    x = blockIdx.x & 7; const int nbx = ((int)gridDim.x - x + 7) >> 3; gwx = ((int)blockIdx.x >> 3) * 8 + wave; nwx = nbx * 8;
}
__device__ __forceinline__ void phase5u(const Params& p, LAS unsigned char* lds, int lane, int wave) {
    int x, gwx, nwx; slice_group(x, gwx, nwx, wave);
    const unsigned char* PU8 = p.ws + WS_PU8 + (size_t)x * 16384 * 128;
    const bf16_t* H2 = (const bf16_t*)(p.ws + WS_H2) + 128 * x;
    const int* IDX = (const int*)(p.ws + WS_IDX); float* PACT = (float*)(p.ws + WS_PACT) + (size_t)x * NT * 128;
    LAS int* l_idx = (LAS int*)(lds + wave * 512);
    const int g = lane >> 3, sub = lane & 7;
    const unsigned char* rowp = PU8 + sub * 16;
    int r_idxA = 0, r_idxB = 0;
    u32x4 hA0, hA1, hB0, hB1; hA0 = hA1 = hB0 = hB1 = (u32x4){0u, 0u, 0u, 0u};
    u32x4 qA[16], qB[16];
#define P5U_LOADIDX(T) do { if ((T) < NT) { r_idxA = IDX[(size_t)(T) * 128 + lane]; r_idxB = IDX[(size_t)(T) * 128 + 64 + lane]; } } while (0)
#define P5U_ISSUE(Q, H0, H1, T) do { if ((T) < NT) { l_idx[lane] = r_idxA; l_idx[64 + lane] = r_idxB; \
        H0 = *(const u32x4*)(H2 + (size_t)(T) * DM + 16 * sub); H1 = *(const u32x4*)(H2 + (size_t)(T) * DM + 16 * sub + 8); \
        _Pragma("unroll") for (int q_ = 0; q_ < 4; ++q_) { const u32x4 iv = *(const LAS u32x4*)(l_idx + 16 * g + 4 * q_); \
            Q[4 * q_] = *(const u32x4*)(rowp + (size_t)iv.x * 128); Q[4 * q_ + 1] = *(const u32x4*)(rowp + (size_t)iv.y * 128); \
            Q[4 * q_ + 2] = *(const u32x4*)(rowp + (size_t)iv.z * 128); Q[4 * q_ + 3] = *(const u32x4*)(rowp + (size_t)iv.w * 128); } } } while (0)
#define P5U_COMPUTE(Q, H0, H1, T) do { \
        f32x2 hf[8]; \
        hf[0] = (f32x2){bflo(H0.x), bfhi(H0.x)}; hf[1] = (f32x2){bflo(H0.y), bfhi(H0.y)}; hf[2] = (f32x2){bflo(H0.z), bfhi(H0.z)}; hf[3] = (f32x2){bflo(H0.w), bfhi(H0.w)}; \
        hf[4] = (f32x2){bflo(H1.x), bfhi(H1.x)}; hf[5] = (f32x2){bflo(H1.y), bfhi(H1.y)}; hf[6] = (f32x2){bflo(H1.z), bfhi(H1.z)}; hf[7] = (f32x2){bflo(H1.w), bfhi(H1.w)}; \
        float resA = 0.f, resB = 0.f; \
        _Pragma("unroll") for (int i = 0; i < 16; ++i) { \
            f32x2 s2 = __builtin_amdgcn_cvt_pk_f32_fp8(Q[i].x, false) * hf[0]; \
            s2 = __builtin_elementwise_fma(__builtin_amdgcn_cvt_pk_f32_fp8(Q[i].x, true), hf[1], s2); \
            s2 = __builtin_elementwise_fma(__builtin_amdgcn_cvt_pk_f32_fp8(Q[i].y, false), hf[2], s2); \
            s2 = __builtin_elementwise_fma(__builtin_amdgcn_cvt_pk_f32_fp8(Q[i].y, true), hf[3], s2); \
            s2 = __builtin_elementwise_fma(__builtin_amdgcn_cvt_pk_f32_fp8(Q[i].z, false), hf[4], s2); \
            s2 = __builtin_elementwise_fma(__builtin_amdgcn_cvt_pk_f32_fp8(Q[i].z, true), hf[5], s2); \
            s2 = __builtin_elementwise_fma(__builtin_amdgcn_cvt_pk_f32_fp8(Q[i].w, false), hf[6], s2); \
            s2 = __builtin_elementwise_fma(__builtin_amdgcn_cvt_pk_f32_fp8(Q[i].w, true), hf[7], s2); \
            float sr = s2.x + s2.y; \
            DPP_ADD(sr, 0xB1); DPP_ADD(sr, 0x4E); DPP_ADD(sr, 0x141); \
            if (i < 8) resA = (sub == i) ? sr : resA; else resB = (sub == i - 8) ? sr : resB; } \
        PACT[(size_t)(T) * 128 + 16 * g + sub] = resA; PACT[(size_t)(T) * 128 + 16 * g + 8 + sub] = resB; } while (0)
    int tok = gwx;
    P5U_LOADIDX(tok);
    P5U_ISSUE(qA, hA0, hA1, tok);
    P5U_LOADIDX(tok + nwx);
    for (; tok < NT; tok += 2 * nwx) {
        P5U_ISSUE(qB, hB0, hB1, tok + nwx);
        P5U_LOADIDX(tok + 2 * nwx);
        P5U_COMPUTE(qA, hA0, hA1, tok);
        if (tok + nwx >= NT) break;
        P5U_ISSUE(qA, hA0, hA1, tok + 2 * nwx);
        P5U_LOADIDX(tok + 3 * nwx);
        P5U_COMPUTE(qB, hB0, hB1, tok + nwx);
    }
#undef P5U_LOADIDX
#undef P5U_ISSUE
#undef P5U_COMPUTE
}
__device__ __forceinline__ void phase5c(const Params& p, int tid) {
    const float* PACT = (const float*)(p.ws + WS_PACT); const float* SCU = (const float*)(p.ws + WS_SCU); const float* SCV = (const float*)(p.ws + WS_SCV);
    const int* IDX = (const int*)(p.ws + WS_IDX); const float* GATE = (const float*)(p.ws + WS_GATE); float* COEF = (float*)(p.ws + WS_COEF);
    const size_t n = (size_t)NT * 128;
    for (size_t it = (size_t)blockIdx.x * 512 + tid; it < n; it += (size_t)gridDim.x * 512) {
        float a = 0.f;
#pragma unroll
        for (int xx = 0; xx < 8; ++xx) a += PACT[(size_t)xx * n + it];
        const int e = IDX[it];
        COEF[it] = GATE[it] * gelu_erf(a * SCU[e]) * SCV[e];
    }
}

constexpr int P5V_LDS_PER_WAVE = 1024 + 8 * 136 * 4;
__device__ __forceinline__ void phase5v(const Params& p, LAS unsigned char* lds, int lane, int wave) {
    int x, gwx, nwx; slice_group(x, gwx, nwx, wave);
    const unsigned char* PV8 = p.ws + WS_PV8 + (size_t)x * 16384 * 128;
    const int* IDX = (const int*)(p.ws + WS_IDX); const float* COEF = (const float*)(p.ws + WS_COEF);
    LAS int* l_idx = (LAS int*)(lds + wave * P5V_LDS_PER_WAVE); LAS float* l_cf = (LAS float*)(l_idx + 128); LAS float* red = l_cf + 128;
    const int g = lane >> 3, sub = lane & 7;
    const unsigned char* rowp = PV8 + sub * 16;
    const int c1 = 16 * (lane & 7) + (lane >> 3);
    int r_idxA = 0, r_idxB = 0; float r_cA = 0.f, r_cB = 0.f;
    u32x4 qA[16], qB[16]; f32x4 cfA[4], cfB[4]; float xA0 = 0.f, xA1 = 0.f, xB0 = 0.f, xB1 = 0.f;
#define P5V_LOADIDX(T) do { if ((T) < NT) { r_idxA = IDX[(size_t)(T) * 128 + lane]; r_idxB = IDX[(size_t)(T) * 128 + 64 + lane]; r_cA = COEF[(size_t)(T) * 128 + lane]; r_cB = COEF[(size_t)(T) * 128 + 64 + lane]; } } while (0)
#define P5V_ISSUE(Q, CF, X0, X1, T) do { if ((T) < NT) { l_idx[lane] = r_idxA; l_idx[64 + lane] = r_idxB; l_cf[lane] = r_cA; l_cf[64 + lane] = r_cB; \
        { const float* xr_ = p.out + (size_t)(T) * DM + 128 * x; X0 = xr_[c1]; X1 = xr_[c1 + 8]; } \
        _Pragma("unroll") for (int q_ = 0; q_ < 4; ++q_) { const u32x4 iv = *(const LAS u32x4*)(l_idx + 16 * g + 4 * q_); CF[q_] = *(const LAS f32x4*)(l_cf + 16 * g + 4 * q_); \
            Q[4 * q_] = *(const u32x4*)(rowp + (size_t)iv.x * 128); Q[4 * q_ + 1] = *(const u32x4*)(rowp + (size_t)iv.y * 128); \
            Q[4 * q_ + 2] = *(const u32x4*)(rowp + (size_t)iv.z * 128); Q[4 * q_ + 3] = *(const u32x4*)(rowp + (size_t)iv.w * 128); } } } while (0)
#define P5V_COMPUTE(Q, CF, X0, X1, T) do { \
        f32x2 acc[8]; \
        _Pragma("unroll") for (int j = 0; j < 8; ++j) acc[j] = (f32x2){0.f, 0.f}; \
        _Pragma("unroll") for (int i = 0; i < 16; ++i) { \
            const float cs_ = CF[i >> 2][i & 3]; const f32x2 c2 = (f32x2){cs_, cs_}; \
            acc[0] = __builtin_elementwise_fma(__builtin_amdgcn_cvt_pk_f32_fp8(Q[i].x, false), c2, acc[0]); \
            acc[1] = __builtin_elementwise_fma(__builtin_amdgcn_cvt_pk_f32_fp8(Q[i].x, true), c2, acc[1]); \
            acc[2] = __builtin_elementwise_fma(__builtin_amdgcn_cvt_pk_f32_fp8(Q[i].y, false), c2, acc[2]); \
            acc[3] = __builtin_elementwise_fma(__builtin_amdgcn_cvt_pk_f32_fp8(Q[i].y, true), c2, acc[3]); \
            acc[4] = __builtin_elementwise_fma(__builtin_amdgcn_cvt_pk_f32_fp8(Q[i].z, false), c2, acc[4]); \
            acc[5] = __builtin_elementwise_fma(__builtin_amdgcn_cvt_pk_f32_fp8(Q[i].z, true), c2, acc[5]); \
            acc[6] = __builtin_elementwise_fma(__builtin_amdgcn_cvt_pk_f32_fp8(Q[i].w, false), c2, acc[6]); \
            acc[7] = __builtin_elementwise_fma(__builtin_amdgcn_cvt_pk_f32_fp8(Q[i].w, true), c2, acc[7]); } \
        _Pragma("unroll") for (int j = 0; j < 8; ++j) { red[g * 136 + (2 * j) * 8 + sub] = acc[j].x; red[g * 136 + (2 * j + 1) * 8 + sub] = acc[j].y; } \
        float s1 = X0, s2_ = X1; \
        _Pragma("unroll") for (int gg = 0; gg < 8; ++gg) { s1 += red[gg * 136 + lane]; s2_ += red[gg * 136 + 64 + lane]; } \
        { float* xr_ = p.out + (size_t)(T) * DM + 128 * x; xr_[c1] = s1; xr_[c1 + 8] = s2_; } } while (0)
    int tok = gwx;
    P5V_LOADIDX(tok);
    P5V_ISSUE(qA, cfA, xA0, xA1, tok);
    P5V_LOADIDX(tok + nwx);
    for (; tok < NT; tok += 2 * nwx) {
        P5V_ISSUE(qB, cfB, xB0, xB1, tok + nwx);
        P5V_LOADIDX(tok + 2 * nwx);
        P5V_COMPUTE(qA, cfA, xA0, xA1, tok);
        if (tok + nwx >= NT) break;
        P5V_ISSUE(qA, cfA, xA0, xA1, tok + 2 * nwx);
        P5V_LOADIDX(tok + 3 * nwx);
        P5V_COMPUTE(qB, cfB, xB0, xB1, tok + nwx);
    }
#undef P5V_LOADIDX
#undef P5V_ISSUE
#undef P5V_COMPUTE
}

__device__ __forceinline__ void phase6(const Params& p, int lane, int wave) {
    const int gw = blockIdx.x * 8 + wave, NGW = gridDim.x * 8;
    const f32x4* gr = (const f32x4*)p.in[23] + lane;
    for (int m = gw; m < NT; m += NGW) {
        f32x4* xr = (f32x4*)(p.out + (size_t)m * DM) + lane;
        f32x4 v[4]; float s = 0.f;
#pragma unroll
        for (int j = 0; j < 4; ++j) { v[j] = xr[64 * j]; s += (v[j][0] * v[j][0] + v[j][1] * v[j][1]) + (v[j][2] * v[j][2] + v[j][3] * v[j][3]); }
        const float rstd = 1.f / sqrtf(wave_total(s) * (1.f / DM) + EPS);
#pragma unroll
        for (int j = 0; j < 4; ++j) xr[64 * j] = v[j] * rstd * gr[64 * j];
    }
}

__global__ void __launch_bounds__(512, 2) fwd_megakernel(Params p) {
    extern __shared__ __attribute__((aligned(16))) unsigned char lds_raw[];
    LAS unsigned char* lds = (LAS unsigned char*)lds_raw;
    cg::grid_group grid = cg::this_grid();
    const int tid0 = threadIdx.x, wave = __builtin_amdgcn_readfirstlane(tid0 >> 6);
#define PHASE_IDS() int tid = tid0; asm volatile("" : "+v"(tid)); const int lane = tid & 63; (void)lane
    const int G = gridDim.x;
    volatile LAS unsigned* MISC = (volatile LAS unsigned*)(lds + MISC_OFF);
    if (tid0 < 32) MISC[tid0] = 0u;
    __syncthreads();
    XcdBarrier bar = xcd_barrier_post((unsigned*)(p.ws + WS_CTL) + 4096, MISC + 8);
#define GSYNC() xcd_barrier(bar)

#ifndef RPT_MASK
#define RPT_MASK 0
#endif
#if RPT_MASK
#define RPT(bit) for (int rpt_ = 0; rpt_ < (((RPT_MASK) >> (bit)) & 1) + 1; ++rpt_)
#else
#define RPT(bit) if (constexpr int rpt_ = 0; true)
#endif
    RPT(0) { PHASE_IDS(); phase0(p, lds, tid, lane, wave); grid.sync(); }
    RPT(1) {
        PHASE_IDS();
        pg8::Gemm g{(const bf16_t*)(p.ws + WS_H), (const bf16_t*)(p.ws + WS_WINT), NT, DIN, 1024};
        pg8::StaticOrder S; S.init(NT, DIN, G, (int)blockIdx.x);
        pg8::EpiProj E{(bf16_t*)(p.ws + WS_A), (bf16_t*)(p.ws + WS_Q), (bf16_t*)(p.ws + WS_KP), (bf16_t*)(p.ws + WS_VP), (bf16_t*)(p.ws + WS_KS), (bf16_t*)(p.ws + WS_VS), p.out};
        pg8::gemm_phase<pg8::EpiProj, pg8::StaticOrder, true, true>(lds, g, S, E);
        {
            const int nwg = (NT / 256) * (DIN / 256), rem = nwg % G, c = (int)blockIdx.x;
            if (rem == 0) prep_late(p, lds, tid, lane, wave, c, G);
            else if (c >= rem) prep_late(p, lds, tid, lane, wave, c - rem, G - rem);
        }
        GSYNC();
    }
    #ifndef P2MODE
#define P2MODE 0
#endif
    RPT(2) { PHASE_IDS(); att::phase2(p, lds, tid, lane, wave, rpt_, (((RPT_MASK) >> 2) & 1) && rpt_ == 0 ? P2MODE : 0); GSYNC(); }
    RPT(3) {
        PHASE_IDS();
        pg8::Gemm g{(const bf16_t*)(p.ws + WS_MIX), (const bf16_t*)(p.ws + WS_WOUTT), NP, 1024, 1024};
        pg8::StaticOrder S; S.init(NP, 1024, G, (int)blockIdx.x);
        pg8::EpiRes E{p.in[0], p.in[1], p.out};
        pg8::gemm_phase<pg8::EpiRes, pg8::StaticOrder, true, true>(lds, g, S, E);
        {
            const float* xs = p.in[1]; float* xo = p.out + (size_t)NP * DM;
            mini_gemm((const bf16_t*)(p.ws + WS_MIX) + (size_t)NP * DM, (const bf16_t*)(p.ws + WS_WOUTT), 1024, lane, wave,
                      [=](int row, int col, pg8::f32x4 v) { *(pg8::f32x4*)(xo + (size_t)row * DM + col) = *(const pg8::f32x4*)(xs + (size_t)row * DM + col) + v; });
        }
        GSYNC();
    }
    RPT(4) { PHASE_IDS(); phase3b(p, lane, wave); GSYNC(); }
    RPT(5) {
        PHASE_IDS();
        pg8::Gemm g{(const bf16_t*)(p.ws + WS_H2), (const bf16_t*)(p.ws + WS_WQT), NP, 2048, 1024};
        pg8::StaticOrder S; S.init(NP, 2048, G, (int)blockIdx.x);
        pg8::EpiBf16<0> E{(bf16_t*)(p.ws + WS_QP), 2048, nullptr, 0, 0, 1.f};
        pg8::gemm_phase<pg8::EpiBf16<0>, pg8::StaticOrder, true, true>(lds, g, S, E);
        {
            bf16_t* qo = (bf16_t*)(p.ws + WS_QP) + (size_t)NP * 2048;
            mini_gemm((const bf16_t*)(p.ws + WS_H2) + (size_t)NP * DM, (const bf16_t*)(p.ws + WS_WQT), 2048, lane, wave,
                      [=](int row, int col, pg8::f32x4 v) { *(u32x2*)(qo + (size_t)row * 2048 + col) = pg8::pack4(v); });
        }
        GSYNC();
    }
    RPT(6) { PHASE_IDS(); phase4b(p, lds, tid, lane, wave); GSYNC(); }
    RPT(7) { PHASE_IDS(); phase5a(p, tid); GSYNC(); }
    RPT(8) { PHASE_IDS(); phase5u(p, lds, lane, wave); GSYNC(); }
    { PHASE_IDS(); phase5c(p, tid); }
    GSYNC();
    { PHASE_IDS(); phase5v(p, lds, lane, wave); }
    GSYNC();
    { PHASE_IDS(); phase6(p, lane, wave); }
}

extern "C" void kernel_launch(void* const* d_in, const int* in_sizes, int n_in, void* d_out, int out_size, void* d_ws, size_t ws_size, hipStream_t stream) {
    static int grid = 0;
    if (grid == 0) {
        if (n_in != 24 || out_size != (int)OUT_TOTAL || ws_size < WS_END) { fprintf(stderr, "kernel_launch: unexpected shapes: n_in %d out %d ws %zu (need %zu)\n", n_in, out_size, ws_size, (size_t)WS_END); grid = -1; return; }
        int dev = 0, cus = 0, per_cu = 0;
        (void)hipGetDevice(&dev);
        (void)hipDeviceGetAttribute(&cus, hipDeviceAttributeMultiprocessorCount, dev);
        if (hipFuncSetAttribute((const void*)fwd_megakernel, hipFuncAttributeMaxDynamicSharedMemorySize, LDS_BYTES) != hipSuccess) { fprintf(stderr, "kernel_launch: hipFuncSetAttribute failed\n"); grid = -1; return; }
        if (hipOccupancyMaxActiveBlocksPerMultiprocessor(&per_cu, (const void*)fwd_megakernel, 512, LDS_BYTES) != hipSuccess || per_cu < 1) { fprintf(stderr, "kernel_launch: occupancy query gave %d\n", per_cu); per_cu = 1; }
        (void)hipGetLastError();
        grid = cus * 1;
        if (per_cu < 1) grid = -1;
    }
    if (grid < 0) return;
    (void)hipMemsetAsync((char*)d_ws + WS_CTL, 0, CTL_BYTES, stream);
    Params p{};
    for (int i = 0; i < 24; ++i) p.in[i] = (const float*)d_in[i];
    p.out = (float*)d_out; p.ws = (unsigned char*)d_ws;
    void* args[] = {&p};
    hipError_t e = hipLaunchCooperativeKernel((const void*)fwd_megakernel, dim3(grid), dim3(512), args, LDS_BYTES, stream);
    if (e != hipSuccess) fprintf(stderr, "cooperative launch failed: %s (grid %d)\n", hipGetErrorString(e), grid);
}
```

```cpp
#include <hip/hip_runtime.h>
#include <hip/hip_cooperative_groups.h>
#include <cstdio>
#include <cstdint>
#include <cmath>
namespace cg = cooperative_groups;
#define CE_(a, b) do { const float t_ = fmaxf(a, b); b = fminf(a, b); a = t_; } while (0)
#define SORT16_DESC(V, O) do { CE_(V[(O)+0], V[(O)+1]); CE_(V[(O)+2], V[(O)+3]); CE_(V[(O)+0], V[(O)+2]); CE_(V[(O)+1], V[(O)+3]); CE_(V[(O)+1], V[(O)+2]); CE_(V[(O)+4], V[(O)+5]); CE_(V[(O)+6], V[(O)+7]); CE_(V[(O)+4], V[(O)+6]); CE_(V[(O)+5], V[(O)+7]); CE_(V[(O)+5], V[(O)+6]); CE_(V[(O)+0], V[(O)+4]); CE_(V[(O)+2], V[(O)+6]); CE_(V[(O)+2], V[(O)+4]); CE_(V[(O)+1], V[(O)+5]); CE_(V[(O)+3], V[(O)+7]); CE_(V[(O)+3], V[(O)+5]); CE_(V[(O)+1], V[(O)+2]); CE_(V[(O)+3], V[(O)+4]); CE_(V[(O)+5], V[(O)+6]); CE_(V[(O)+8], V[(O)+9]); CE_(V[(O)+10], V[(O)+11]); CE_(V[(O)+8], V[(O)+10]); CE_(V[(O)+9], V[(O)+11]); CE_(V[(O)+9], V[(O)+10]); CE_(V[(O)+12], V[(O)+13]); CE_(V[(O)+14], V[(O)+15]); CE_(V[(O)+12], V[(O)+14]); CE_(V[(O)+13], V[(O)+15]); CE_(V[(O)+13], V[(O)+14]); CE_(V[(O)+8], V[(O)+12]); CE_(V[(O)+10], V[(O)+14]); CE_(V[(O)+10], V[(O)+12]); CE_(V[(O)+9], V[(O)+13]); CE_(V[(O)+11], V[(O)+15]); CE_(V[(O)+11], V[(O)+13]); CE_(V[(O)+9], V[(O)+10]); CE_(V[(O)+11], V[(O)+12]); CE_(V[(O)+13], V[(O)+14]); CE_(V[(O)+0], V[(O)+8]); CE_(V[(O)+4], V[(O)+12]); CE_(V[(O)+4], V[(O)+8]); CE_(V[(O)+2], V[(O)+10]); CE_(V[(O)+6], V[(O)+14]); CE_(V[(O)+6], V[(O)+10]); CE_(V[(O)+2], V[(O)+4]); CE_(V[(O)+6], V[(O)+8]); CE_(V[(O)+10], V[(O)+12]); CE_(V[(O)+1], V[(O)+9]); CE_(V[(O)+5], V[(O)+13]); CE_(V[(O)+5], V[(O)+9]); CE_(V[(O)+3], V[(O)+11]); CE_(V[(O)+7], V[(O)+15]); CE_(V[(O)+7], V[(O)+11]); CE_(V[(O)+3], V[(O)+5]); CE_(V[(O)+7], V[(O)+9]); CE_(V[(O)+11], V[(O)+13]); CE_(V[(O)+1], V[(O)+2]); CE_(V[(O)+3], V[(O)+4]); CE_(V[(O)+5], V[(O)+6]); CE_(V[(O)+7], V[(O)+8]); CE_(V[(O)+9], V[(O)+10]); CE_(V[(O)+11], V[(O)+12]); CE_(V[(O)+13], V[(O)+14]); } while (0)
#define BITONIC16_DESC(V, O) do { CE_(V[(O)+0], V[(O)+8]); CE_(V[(O)+1], V[(O)+9]); CE_(V[(O)+2], V[(O)+10]); CE_(V[(O)+3], V[(O)+11]); CE_(V[(O)+4], V[(O)+12]); CE_(V[(O)+5], V[(O)+13]); CE_(V[(O)+6], V[(O)+14]); CE_(V[(O)+7], V[(O)+15]); CE_(V[(O)+0], V[(O)+4]); CE_(V[(O)+1], V[(O)+5]); CE_(V[(O)+2], V[(O)+6]); CE_(V[(O)+3], V[(O)+7]); CE_(V[(O)+8], V[(O)+12]); CE_(V[(O)+9], V[(O)+13]); CE_(V[(O)+10], V[(O)+14]); CE_(V[(O)+11], V[(O)+15]); CE_(V[(O)+0], V[(O)+2]); CE_(V[(O)+1], V[(O)+3]); CE_(V[(O)+4], V[(O)+6]); CE_(V[(O)+5], V[(O)+7]); CE_(V[(O)+8], V[(O)+10]); CE_(V[(O)+9], V[(O)+11]); CE_(V[(O)+12], V[(O)+14]); CE_(V[(O)+13], V[(O)+15]); CE_(V[(O)+0], V[(O)+1]); CE_(V[(O)+2], V[(O)+3]); CE_(V[(O)+4], V[(O)+5]); CE_(V[(O)+6], V[(O)+7]); CE_(V[(O)+8], V[(O)+9]); CE_(V[(O)+10], V[(O)+11]); CE_(V[(O)+12], V[(O)+13]); CE_(V[(O)+14], V[(O)+15]); } while (0)
namespace pg8 {
#define PG8_LAS __attribute__((address_space(3)))
typedef unsigned short bf16_t;
typedef short bf16x8 __attribute__((ext_vector_type(8)));
typedef float f32x4 __attribute__((ext_vector_type(4)));
typedef unsigned u32x4 __attribute__((ext_vector_type(4)));
constexpr int BM = 256, BK = 64, HALF = 128, HTB = HALF * BK * 2  , STAGE_BYTES = 8 * HTB, NXCD = 8, WGM = 8;

__host__ __device__ __forceinline__ int lds_byte(int r, int c) { const int st = (r >> 4) * 2 + (c >> 5), rr = r & 15, cc = c & 31, ob = rr * 64 + cc * 2; return st * 1024 + (ob ^ (((ob >> 9) & 1) << 5)); }
__host__ __device__ __forceinline__ void stage_rc(int b, int& R, int& C) { const int st = b / 1024, sb = b % 1024, swz = sb ^ (((sb >> 9) & 1) << 5); R = (st >> 1) * 16 + swz / 64; C = (st & 1) * 32 + (swz % 64) / 2; }
__host__ __device__ __forceinline__ int perm32(int rho) { const int n = rho >> 4, i = rho & 15; return 8 * (i >> 2) + 4 * n + (i & 3); }

struct Unit { int pm, pn; };
struct Gemm { const bf16_t* A; const bf16_t* Bt; int M, N, K; };

struct StaticOrder {
    int nM, nN, nwg, G, c;
    __host__ __device__ void init(int M, int N, int G_, int c_) { nM = M / BM; nN = N / BM; nwg = nM * nN; G = G_; c = c_; }
    __host__ __device__ bool next(int i, Unit& u) const {
        const long L = (long)i * G + c; if (L >= nwg) return false;
        int wgid = (int)L; { const int q = nwg / NXCD, r = nwg % NXCD, xcd = wgid % NXCD, off = wgid / NXCD; wgid = (xcd < r ? xcd * (q + 1) : r * (q + 1) + (xcd - r) * q) + off; }
        const int nig = WGM * nN, gid = wgid / nig, fm = gid * WGM, gsz = (nM - fm) < WGM ? (nM - fm) : WGM;
        u.pm = fm + ((wgid % nig) % gsz); u.pn = (wgid % nig) / gsz; return true;
    }
    __device__ __forceinline__ void a_ready(const Unit&) const {}
    __device__ __forceinline__ void done(const Unit&) const {}
};

__device__ __forceinline__ unsigned cvt_pk_bf16(float lo, float hi) { unsigned r; asm volatile("v_cvt_pk_bf16_f32 %0, %1, %2" : "=v"(r) : "v"(lo), "v"(hi)); return r; }
typedef float f32x2 __attribute__((ext_vector_type(2)));
__device__ __forceinline__ f32x2 gelu_pk(f32x2 v) {
    const f32x2 av = __builtin_elementwise_abs(v), d = av * 0.2316418882f + 1.0f;
    f32x2 t; t.x = __builtin_amdgcn_rcpf(d.x); t.y = __builtin_amdgcn_rcpf(d.y);
    f32x2 q = t * 0.5307027145f + (-0.7265760135f); q = q * t + 0.7107068705f; q = q * t + (-0.142248368f); q = q * t + 0.127414796f; q = q * t;
    const f32x2 s = (v * v) * (-0.72134752044f);
    f32x2 e; e.x = __builtin_amdgcn_exp2f(s.x); e.y = __builtin_amdgcn_exp2f(s.y);
    const f32x2 m = v * (q * e), r = v - m;
    f32x2 o; o.x = v.x < 0.f ? m.x : r.x; o.y = v.y < 0.f ? m.y : r.y; return o;
}

template <int ACT  > struct EpiBf16 {
    static constexpr bool PERM = true, AFTER_DRAIN = false; static_assert(ACT == 0 || ACT == 1, "EpiBf16: ACT is 0 (none) or 1 (gelu_pk)");
    bf16_t* O; int ldc; const float* bias; int split_cols; size_t split_stride; float scale0;
    __device__ __forceinline__ void operator()(const f32x4 (&acc)[2][2][4][2], const Unit& u, int wr, int wc, int fr, int fq) const {
        const int row0 = u.pm * BM + wr * 64 + fr; int colt = u.pn * BM; bf16_t* base = O;
        float sc = 1.f; if (split_cols) { const int t = colt / split_cols; base += (size_t)t * split_stride; colt -= t * split_cols; if (t == 0) sc = scale0; }
        const int col0 = colt + wc * 32 + 8 * fq, bcol0 = u.pn * BM + wc * 32 + 8 * fq;
        f32x4 bv[2][2];
#pragma unroll
        for (int bj = 0; bj < 2; ++bj)
#pragma unroll
            for (int n = 0; n < 2; ++n) bv[bj][n] = bias ? *(const f32x4*)(bias + bcol0 + bj * HALF + 4 * n) : (f32x4){0.f, 0.f, 0.f, 0.f};
#pragma unroll
        for (int ai = 0; ai < 2; ++ai)
#pragma unroll
            for (int m = 0; m < 4; ++m) { bf16_t* rowp = base + (size_t)(row0 + ai * HALF + m * 16) * ldc + col0;
#pragma unroll
                for (int bj = 0; bj < 2; ++bj) { f32x4 v0 = acc[ai][bj][m][0] + bv[bj][0], v1 = acc[ai][bj][m][1] + bv[bj][1];
                    if (ACT == 1) { f32x2 a = gelu_pk((f32x2){v0[0], v0[1]}), b = gelu_pk((f32x2){v0[2], v0[3]}), c = gelu_pk((f32x2){v1[0], v1[1]}), d = gelu_pk((f32x2){v1[2], v1[3]});
                        v0 = (f32x4){a.x, a.y, b.x, b.y}; v1 = (f32x4){c.x, c.y, d.x, d.y}; }
                    v0 = v0 * sc; v1 = v1 * sc; u32x4 w; w.x = cvt_pk_bf16(v0[0], v0[1]); w.y = cvt_pk_bf16(v0[2], v0[3]); w.z = cvt_pk_bf16(v1[0], v1[1]); w.w = cvt_pk_bf16(v1[2], v1[3]);
                    *(u32x4*)(rowp + bj * HALF) = w; } }
    }
};
template <class Epi, class Sched, bool ALIGN_EPI = false, bool SP2 = false>
__device__ __forceinline__ void gemm_phase(PG8_LAS unsigned char* lds, const Gemm g, const Sched& S, const Epi& E) {
    int tid = threadIdx.x; asm volatile("" : "+v"(tid));
    const int wid = __builtin_amdgcn_readfirstlane(tid >> 6), lane = tid & 63, wr = wid >> 2, wc = wid & 3, fr = lane & 15, fq = lane >> 4;
    const int K = g.K, nt = K / BK;
    unsigned voffA[2], voffB[2];
#pragma unroll
    for (int i = 0; i < 2; ++i) { int R, C; stage_rc(tid * 16 + i * 8192, R, C); const int Rb = Epi::PERM ? ((R & ~31) + perm32(R & 31)) : R;
        voffA[i] = (unsigned)(R * K + C) * 2u; voffB[i] = (unsigned)(Rb * K + C) * 2u; }
    const size_t kstep = (size_t)(BK * 2);
    const size_t hstep = (size_t)HALF * K * 2;
    const size_t tstep = 2 * hstep;
    const unsigned ldsw = (unsigned)wid * 1024u;
    const int aoff = lds_byte(wr * 64 + fr, fq * 8), boff = lds_byte(wc * 32 + fr, fq * 8);
#define PG8_SA(b, h) (((b) * 2 + (h)) * HTB)
#define PG8_SB(b, h) ((4 + (b) * 2 + (h)) * HTB)
#define PG8_STAGE(bufoff, gbase, voff) do { _Pragma("unroll") for (int _i = 0; _i < 2; ++_i) \
        __builtin_amdgcn_global_load_lds((const unsigned*)((const char*)(gbase) + (voff)[_i]), (PG8_LAS unsigned*)(lds + (bufoff) + ldsw + _i * 8192), 16, 0, 0); } while (0)
#define PG8_LDA(dst, b, h) do { _Pragma("unroll") for (int m = 0; m < 4; ++m) _Pragma("unroll") for (int k = 0; k < 2; ++k) dst[m][k] = *(const PG8_LAS bf16x8*)(lds + PG8_SA(b, h) + aoff + m * 2048 + k * 1024); } while (0)
#define PG8_LDB(dst, b, h) do { _Pragma("unroll") for (int n = 0; n < 2; ++n) _Pragma("unroll") for (int k = 0; k < 2; ++k) dst[n][k] = *(const PG8_LAS bf16x8*)(lds + PG8_SB(b, h) + boff + n * 2048 + k * 1024); } while (0)
#define PG8_MMA(ai, bj, At, Bt) do { __builtin_amdgcn_s_setprio(1); _Pragma("unroll") for (int m = 0; m < 4; ++m) _Pragma("unroll") for (int n = 0; n < 2; ++n) _Pragma("unroll") for (int k = 0; k < 2; ++k) \
        acc[ai][bj][m][n] = __builtin_amdgcn_mfma_f32_16x16x32_bf16(Bt[n][k], At[m][k], acc[ai][bj][m][n], 0, 0, 0); __builtin_amdgcn_s_setprio(0); } while (0)
#define PG8_WAIT_V(n) asm volatile("s_waitcnt vmcnt(" #n ")" ::: "memory")
#define PG8_WAIT_L(n) asm volatile("s_waitcnt lgkmcnt(" #n ")" ::: "memory")
#define PG8_BAR __builtin_amdgcn_s_barrier()
#define PG8_SCHED __builtin_amdgcn_sched_barrier(0)
    Unit cur, nxt; int ui = 0;
    if (!S.next(0, cur)) return;
    f32x4 acc[2][2][4][2];
#pragma unroll
    for (int a = 0; a < 2; ++a)
#pragma unroll
        for (int b = 0; b < 2; ++b)
#pragma unroll
            for (int m = 0; m < 4; ++m)
#pragma unroll
                for (int n = 0; n < 2; ++n) acc[a][b][m][n] = (f32x4){0.f, 0.f, 0.f, 0.f};
    bf16x8 At[4][2], B0[2][2], B1[2][2];
    const char* cA = (const char*)g.A + (size_t)cur.pm * tstep; const char* cB = (const char*)g.Bt + (size_t)cur.pn * tstep;
    S.a_ready(cur);
    if constexpr (SP2) {
        PG8_STAGE(PG8_SB(0, 0), cB, voffB); PG8_STAGE(PG8_SB(0, 1), cB + hstep, voffB); PG8_STAGE(PG8_SA(0, 0), cA, voffA); PG8_STAGE(PG8_SA(0, 1), cA + hstep, voffA);
        if (wr == 1) PG8_BAR;
        PG8_WAIT_V(2); PG8_BAR;
        PG8_STAGE(PG8_SB(1, 0), cB + kstep, voffB); PG8_STAGE(PG8_SA(1, 0), cA + kstep, voffA); PG8_STAGE(PG8_SB(1, 1), cB + hstep + kstep, voffB);
        PG8_WAIT_V(6); PG8_BAR;
    } else {
        PG8_STAGE(PG8_SB(0, 0), cB, voffB); PG8_STAGE(PG8_SA(0, 0), cA, voffA); PG8_STAGE(PG8_SB(0, 1), cB + hstep, voffB); PG8_STAGE(PG8_SA(0, 1), cA + hstep, voffA);
        if (wr == 1) PG8_BAR;
        PG8_WAIT_V(4); PG8_BAR;
        PG8_STAGE(PG8_SB(1, 0), cB + kstep, voffB); PG8_STAGE(PG8_SA(1, 0), cA + kstep, voffA); PG8_STAGE(PG8_SB(1, 1), cB + hstep + kstep, voffB);
        PG8_WAIT_V(6); PG8_BAR;
    }
    for (;;) {
        const bool has_next = S.next(ui + 1, nxt);
        const char* nA = has_next ? (const char*)g.A + (size_t)nxt.pm * tstep : cA; const char* nB = has_next ? (const char*)g.Bt + (size_t)nxt.pn * tstep : cB;
        for (int t = 0; t < nt; t += 2) {
            const bool last = (t == nt - 2);
            const char* a1 = cA + (size_t)(t + 1) * kstep;
            const char* a2 = last ? nA : cA + (size_t)(t + 2) * kstep; const char* b2 = last ? nB : cB + (size_t)(t + 2) * kstep;
            const char* a3 = a2 + kstep; const char* b3 = b2 + kstep;
            if (last && has_next) S.a_ready(nxt);
            if constexpr (SP2) {
            PG8_LDB(B0, 0, 0); PG8_LDB(B1, 0, 1); PG8_SCHED; PG8_LDA(At, 0, 0); PG8_STAGE(PG8_SA(1, 1), a1 + hstep, voffA);
            PG8_WAIT_V(8); PG8_WAIT_L(0); PG8_BAR; PG8_MMA(0, 0, At, B0); PG8_MMA(0, 1, At, B1); PG8_BAR; PG8_SCHED;
            PG8_LDA(At, 0, 1); PG8_STAGE(PG8_SB(0, 0), b2, voffB); PG8_STAGE(PG8_SB(0, 1), b2 + hstep, voffB); PG8_STAGE(PG8_SA(0, 0), a2, voffA);
            PG8_WAIT_V(8); PG8_WAIT_L(0); PG8_BAR; PG8_MMA(1, 0, At, B0); PG8_MMA(1, 1, At, B1); PG8_BAR; PG8_SCHED;
            PG8_LDB(B0, 1, 0); PG8_LDB(B1, 1, 1); PG8_SCHED; PG8_LDA(At, 1, 0); PG8_STAGE(PG8_SA(0, 1), a2 + hstep, voffA);
            PG8_WAIT_V(8); PG8_WAIT_L(0); PG8_BAR; PG8_MMA(0, 0, At, B0); PG8_MMA(0, 1, At, B1); PG8_BAR; PG8_SCHED;
            PG8_LDA(At, 1, 1); PG8_STAGE(PG8_SB(1, 0), b3, voffB); PG8_STAGE(PG8_SB(1, 1), b3 + hstep, voffB); PG8_STAGE(PG8_SA(1, 0), a3, voffA);
            PG8_WAIT_V(8); PG8_WAIT_L(0); PG8_BAR; PG8_MMA(1, 0, At, B0); PG8_MMA(1, 1, At, B1); PG8_BAR; PG8_SCHED;
            } else {
            PG8_LDB(B0, 0, 0); PG8_SCHED; PG8_LDA(At, 0, 0); PG8_STAGE(PG8_SA(1, 1), a1 + hstep, voffA);
            PG8_WAIT_L(8); PG8_BAR; PG8_WAIT_L(0); PG8_MMA(0, 0, At, B0); PG8_BAR; PG8_SCHED;
            PG8_LDB(B1, 0, 1); PG8_STAGE(PG8_SB(0, 0), b2, voffB);
            PG8_BAR; PG8_WAIT_L(0); PG8_MMA(0, 1, At, B1); PG8_BAR;
            PG8_LDA(At, 0, 1); PG8_STAGE(PG8_SA(0, 0), a2, voffA);
            PG8_BAR; PG8_WAIT_L(0); PG8_MMA(1, 0, At, B0); PG8_BAR; PG8_SCHED;
            PG8_STAGE(PG8_SB(0, 1), b2 + hstep, voffB);
            PG8_WAIT_V(6); PG8_BAR; PG8_MMA(1, 1, At, B1); PG8_BAR;
            PG8_LDB(B0, 1, 0); PG8_SCHED; PG8_LDA(At, 1, 0); PG8_STAGE(PG8_SA(0, 1), a2 + hstep, voffA);
            PG8_WAIT_L(8); PG8_BAR; PG8_WAIT_L(0); PG8_MMA(0, 0, At, B0); PG8_BAR; PG8_SCHED;
            PG8_LDB(B1, 1, 1); PG8_STAGE(PG8_SB(1, 0), b3, voffB);
            PG8_BAR; PG8_WAIT_L(0); PG8_MMA(0, 1, At, B1); PG8_BAR;
            PG8_LDA(At, 1, 1); PG8_STAGE(PG8_SA(1, 0), a3, voffA);
            PG8_BAR; PG8_WAIT_L(0); PG8_MMA(1, 0, At, B0); PG8_BAR; PG8_SCHED;
            PG8_STAGE(PG8_SB(1, 1), b3 + hstep, voffB);
            PG8_WAIT_V(6); PG8_BAR; PG8_MMA(1, 1, At, B1); PG8_BAR;
            }
        }
        if constexpr (ALIGN_EPI) { if (wr == 0) PG8_BAR; }
        if constexpr (!Epi::AFTER_DRAIN) { E(acc, cur, wr, wc, fr, fq); S.done(cur); }
        if (!has_next) break;
#pragma unroll
        for (int a = 0; a < 2; ++a)
#pragma unroll
            for (int b = 0; b < 2; ++b)
#pragma unroll
                for (int m = 0; m < 4; ++m)
#pragma unroll
                    for (int n = 0; n < 2; ++n) acc[a][b][m][n] = (f32x4){0.f, 0.f, 0.f, 0.f};
        cur = nxt; cA = nA; cB = nB; ++ui;
        if constexpr (ALIGN_EPI) { if (wr == 1) PG8_BAR; }
    }
    PG8_WAIT_V(0);
    if constexpr (!ALIGN_EPI) { if (wr == 0) PG8_BAR; }
    PG8_BAR;
    if constexpr (Epi::AFTER_DRAIN) { E.fused(acc, cur, wr, wc, fr, fq, lds, wid, lane); S.done(cur); }
#undef PG8_SA
#undef PG8_SB
#undef PG8_STAGE
#undef PG8_LDA
#undef PG8_LDB
#undef PG8_MMA
#undef PG8_WAIT_V
#undef PG8_WAIT_L
#undef PG8_BAR
#undef PG8_SCHED
}
}

#define LAS __attribute__((address_space(3)))
typedef unsigned short bf16_t;
typedef short bf16x8 __attribute__((ext_vector_type(8)));
typedef short s16x4 __attribute__((ext_vector_type(4)));
typedef float f32x4 __attribute__((ext_vector_type(4)));
typedef float f32x16 __attribute__((ext_vector_type(16)));
typedef unsigned u32x4 __attribute__((ext_vector_type(4)));
typedef unsigned u32x2 __attribute__((ext_vector_type(2)));

constexpr int DM = 1024;
constexpr int NP = 16 * 2048;
constexpr int NS = 8 * 64;
constexpr int NT = NP + NS;
constexpr int DIN = 2560;
constexpr int SKV = 2112;
constexpr float EPS = 1e-6f;
constexpr float LOG2E = 1.4426950408889634f;
constexpr float QSCALE = 0.125f * LOG2E;

constexpr long OUT_Y = 0;
constexpr long OUT_KP = 34078720L, OUT_VP = 50855936L, OUT_CONVP = 67633152L, OUT_KS = 67878912L, OUT_VS = 68141056L, OUT_CONVS = 68403200L, OUT_TOTAL = 68526080L;

constexpr size_t MiB = 1u << 20;
constexpr size_t WS_CTL = 0, CTL_BYTES = 1 * MiB;
constexpr size_t WS_WINT = 1 * MiB;
constexpr size_t WS_WOUTT = 6 * MiB;
constexpr size_t WS_WQT = 8 * MiB;
constexpr size_t WS_SK = 12 * MiB;
constexpr size_t WS_PU8 = 16 * MiB;
constexpr size_t WS_PV8 = 32 * MiB;
constexpr size_t WS_SCU = 48 * MiB;
constexpr size_t WS_SCV = 49 * MiB;
constexpr size_t WS_KS = 80 * MiB;
constexpr size_t WS_VS = 97 * MiB;
constexpr size_t WS_H = 114 * MiB;
constexpr size_t WS_A = 179 * MiB;
constexpr size_t WS_Q = 212 * MiB;
constexpr size_t WS_QP = 114 * MiB;
constexpr size_t WS_KP = 245 * MiB;
constexpr size_t WS_VP = 277 * MiB;
constexpr size_t WS_MIX = 309 * MiB;
constexpr size_t WS_H2 = 309 * MiB;
constexpr size_t WS_TK = 375 * MiB;
constexpr size_t WS_IDX = 408 * MiB;
constexpr size_t WS_GATE = 425 * MiB;
constexpr size_t WS_PACT = 114 * MiB;
constexpr size_t WS_COEF = 375 * MiB;
constexpr size_t WS_END = 442 * MiB;
static_assert(WS_H + (size_t)NT * 1024 * 2 <= WS_A && WS_A + (size_t)NT * 512 * 2 <= WS_Q && WS_Q + (size_t)NT * 512 * 2 <= WS_KP, "R1");
static_assert(WS_QP + (size_t)NT * 2048 * 2 <= WS_KP && WS_KP + (size_t)NP * 512 * 2 <= WS_VP && WS_VP + (size_t)NP * 512 * 2 <= WS_MIX, "ws map");
static_assert(WS_MIX + (size_t)NT * 1024 * 2 <= WS_TK && WS_TK + (size_t)NT * 256 * 4 <= WS_IDX && WS_IDX + (size_t)NT * 128 * 4 <= WS_GATE && WS_GATE + (size_t)NT * 128 * 4 <= WS_END, "ws map 2");
static_assert(WS_KS + (size_t)8 * SKV * 512 * 2 <= WS_VS && WS_VS + (size_t)8 * SKV * 512 * 2 <= WS_H, "ws map 3");

constexpr int RING_BYTES = 131072;
constexpr int BIAS_OFF = RING_BYTES;
constexpr int MISC_OFF = RING_BYTES + 5120;
constexpr int LDS_BYTES = MISC_OFF + 1024;

struct Params {
    const float* in[24];
    float* out;
    unsigned char* ws;
};

__device__ __forceinline__ unsigned cvtpk(float lo, float hi) { return pg8::cvt_pk_bf16(lo, hi); }
__device__ __forceinline__ float bflo(unsigned w) { return __uint_as_float(w << 16); }
__device__ __forceinline__ float bfhi(unsigned w) { return __uint_as_float(w & 0xffff0000u); }
__device__ __forceinline__ float wave_sum(float v) {
#pragma unroll
    for (int o = 1; o < 64; o <<= 1) v += __shfl_xor(v, o);
    return v;
}
typedef float f32x2 __attribute__((ext_vector_type(2)));
#define DPP_ADD(v, ctrl) v += __builtin_bit_cast(float, __builtin_amdgcn_update_dpp(0, __builtin_bit_cast(int, v), ctrl, 0xf, 0xf, true))
__device__ __forceinline__ float rl_f(float v, int l) { return __uint_as_float(__builtin_amdgcn_readlane(__float_as_uint(v), l)); }
__device__ __forceinline__ float wave_total(float v) {
    DPP_ADD(v, 0xB1); DPP_ADD(v, 0x4E); DPP_ADD(v, 0x141); DPP_ADD(v, 0x140);
    return (rl_f(v, 0) + rl_f(v, 16)) + (rl_f(v, 32) + rl_f(v, 48));
}
typedef __bf16 bf16x2_t __attribute__((ext_vector_type(2)));
__device__ __forceinline__ float dot2(unsigned a, unsigned b, float acc) {
    return __builtin_amdgcn_fdot2_f32_bf16(__builtin_bit_cast(bf16x2_t, a), __builtin_bit_cast(bf16x2_t, b), acc, false);
}
#define LDS_WAIT() asm volatile("s_waitcnt lgkmcnt(0)" ::: "memory")

#define XB_TMO      128
#define XB_XCNT(j)  (256  + 64 * (j))
#define XB_XSUB(j)  (1280 + 64 * (j))
#define XB_XGEN(j)  (2304 + 64 * (j))
#define XB_TOP      3328
#define XB_TOPGEN   3392
#define XCD_BAR_WORDS 3456
#define XB_SPIN_CAP (1u << 18)

__device__ __forceinline__ unsigned xb_ld(unsigned* p)              { return __hip_atomic_load(p, __ATOMIC_RELAXED, __HIP_MEMORY_SCOPE_AGENT); }
__device__ __forceinline__ unsigned xb_add(unsigned* p, unsigned v) { return __hip_atomic_fetch_add(p, v, __ATOMIC_RELAXED, __HIP_MEMORY_SCOPE_AGENT); }
__device__ __forceinline__ unsigned xb_xcc_id() { return (unsigned)__builtin_amdgcn_s_getreg((3 << 11) | 20) & 0xFu; }
#define XB_SPIN(cond, bar) do { unsigned _sp = 0; while (cond) { __builtin_amdgcn_s_sleep(1); \
    if ((++_sp & 255u) == 0u) { if (xb_ld(&(bar)[XB_TMO])) break; if (_sp > XB_SPIN_CAP) { atomicAdd(&(bar)[XB_TMO], 1u); break; } } } } while (0)

struct XcdBarrier {
    unsigned* bar; unsigned x;
    volatile LAS unsigned* st;
};

__device__ __forceinline__ XcdBarrier xcd_barrier_post(unsigned* bar, volatile LAS unsigned* st) {
    XcdBarrier b; b.bar = bar; b.x = xb_xcc_id(); b.st = st;
    if (threadIdx.x == 0) (void)xb_add(&bar[XB_XCNT(b.x)], 1u);
    return b;
}
__device__ __forceinline__ void xcd_barrier_complete(unsigned* bar, unsigned x, unsigned& nloc, unsigned& nx) {
    const unsigned G = gridDim.x * gridDim.y * gridDim.z;
    unsigned sum, cnt, mine, sp = 0u;
    for (;;) {
        sum = 0u; cnt = 0u; mine = 0u;
#pragma unroll
        for (unsigned j = 0; j < 16; ++j) { const unsigned c = xb_ld(&bar[XB_XCNT(j)]); sum += c; cnt += (c > 0u) ? 1u : 0u; mine = (j == x) ? c : mine; }
        if (sum == G) break;
        __builtin_amdgcn_s_sleep(1);
        if ((++sp & 255u) == 0u) { if (xb_ld(&bar[XB_TMO])) break; if (sp > XB_SPIN_CAP) { atomicAdd(&bar[XB_TMO], 1u); break; } }
    }
    nloc = mine > 0u ? mine : 1u; nx = cnt > 0u ? cnt : 1u;
}

__device__ __forceinline__ void xcd_barrier(const XcdBarrier& b) {
    asm volatile("s_waitcnt vmcnt(0)" ::: "memory");
    __syncthreads();
    if (threadIdx.x == 0) {
        unsigned* bar = b.bar;
        __builtin_amdgcn_s_waitcnt(0);
        unsigned nloc = b.st[0], nx = b.st[1];
        if (nloc == 0u) { xcd_barrier_complete(bar, b.x, nloc, nx); b.st[0] = nloc; b.st[1] = nx; }
        const unsigned old = xb_add(&bar[XB_XSUB(b.x)], 1u);
        const unsigned gen = old / nloc;
        if (old + 1u == (gen + 1u) * nloc) {
            __builtin_amdgcn_fence(__ATOMIC_RELEASE, "agent");
            asm volatile("s_waitcnt vmcnt(0)" ::: "memory");
            const unsigned og = xb_add(&bar[XB_TOP], 1u);
            const unsigned tg = og / nx;
            if (og + 1u == (tg + 1u) * nx) xb_add(&bar[XB_TOPGEN], 1u);
            else XB_SPIN(xb_ld(&bar[XB_TOPGEN]) == tg, bar);
            __builtin_amdgcn_fence(__ATOMIC_ACQUIRE, "agent");
            xb_add(&bar[XB_XGEN(b.x)], 1u);
            asm volatile("s_waitcnt vmcnt(0)" ::: "memory");
        } else {
            XB_SPIN(xb_ld(&bar[XB_XGEN(b.x)]) == gen, bar);
            __builtin_amdgcn_fence(__ATOMIC_ACQUIRE, "agent");
            asm volatile("s_waitcnt vmcnt(0)" ::: "memory");
        }
    }
    __syncthreads();
}


namespace pg8 {
__device__ __forceinline__ u32x2 pack4(f32x4 v) { u32x2 w; w.x = cvt_pk_bf16(v[0], v[1]); w.y = cvt_pk_bf16(v[2], v[3]); return w; }
struct EpiProj {
    static constexpr bool PERM = false, AFTER_DRAIN = false;
    bf16_t* A; bf16_t* Q; bf16_t* KP; bf16_t* VP; bf16_t* KS; bf16_t* VS; float* out;
    __device__ __forceinline__ void operator()(const f32x4 (&acc)[2][2][4][2], const Unit& u, int wr, int wc, int fr, int fq) const {
        const int pn = u.pn;
        const int row0 = u.pm * BM + wr * 64 + fr;
        if (pn < 4) {
#pragma unroll
            for (int ai = 0; ai < 2; ++ai)
#pragma unroll
                for (int m = 0; m < 4; ++m) {
                    const int row = row0 + ai * HALF + m * 16;
                    long toff = -1;
                    if (row < NP) { const int s = row & 2047; if (s >= 2018) toff = OUT_CONVP + ((long)(row >> 11) * 30 + (s - 2018)) * 512; }
                    else { const int rr = row - NP; const int i = rr & 63; if (i >= 34) toff = OUT_CONVS + ((long)(rr >> 6) * 30 + (i - 34)) * 512; }
#pragma unroll
                    for (int n = 0; n < 2; ++n) {
                        const int c = 128 * pn + 32 * wc + 16 * n + 4 * fq;
                        const f32x4 x = acc[ai][0][m][n], g = acc[ai][1][m][n];
                        f32x4 a;
#pragma unroll
                        for (int j = 0; j < 4; ++j) a[j] = x[j] / (1.f + __expf(-g[j]));
                        *(u32x2*)(A + (size_t)row * 512 + c) = pack4(a);
                        if (toff >= 0) *(f32x4*)(out + toff + c) = a;
                    }
                }
        } else {
            const int sec = (pn - 4) >> 1, colbase = ((pn - 4) & 1) * 256;
#pragma unroll
            for (int ai = 0; ai < 2; ++ai)
#pragma unroll
                for (int m = 0; m < 4; ++m) {
                    const int row = row0 + ai * HALF + m * 16;
                    const bool isp = row < NP; const int rr = row - NP;
                    bf16_t* bdst; float* fdst;
                    if (sec == 0) { bdst = Q + (size_t)row * 512; fdst = nullptr; }
                    else if (sec == 1) { bdst = isp ? KP + (size_t)row * 512 : KS + ((size_t)(rr >> 6) * SKV + 2048 + (rr & 63)) * 512; fdst = isp ? out + OUT_KP + (size_t)row * 512 : out + OUT_KS + (size_t)rr * 512; }
                    else { bdst = isp ? VP + (size_t)row * 512 : VS + ((size_t)(rr >> 6) * SKV + 2048 + (rr & 63)) * 512; fdst = isp ? out + OUT_VP + (size_t)row * 512 : out + OUT_VS + (size_t)rr * 512; }
#pragma unroll
                    for (int bj = 0; bj < 2; ++bj)
#pragma unroll
                        for (int n = 0; n < 2; ++n) {
                            const int col = colbase + 128 * bj + 32 * wc + 16 * n + 4 * fq;
                            const f32x4 v = acc[ai][bj][m][n];
                            if (sec == 0) { *(u32x2*)(bdst + col) = pack4(v * QSCALE); }
                            else { *(u32x2*)(bdst + col) = pack4(v); *(f32x4*)(fdst + col) = v; }
                        }
                }
        }
    }
};
struct EpiRes {
    static constexpr bool PERM = false, AFTER_DRAIN = false;
    const float* xp; const float* xs; float* out;
    __device__ __forceinline__ void operator()(const f32x4 (&acc)[2][2][4][2], const Unit& u, int wr, int wc, int fr, int fq) const {
        const int row0 = u.pm * BM + wr * 64 + fr;
#pragma unroll
        for (int ai = 0; ai < 2; ++ai)
#pragma unroll
            for (int m = 0; m < 4; ++m) {
                const int row = row0 + ai * HALF + m * 16;
                const float* xr = row < NP ? xp + (size_t)row * DM : xs + (size_t)(row - NP) * DM;
                float* orow = out + (size_t)row * DM;
#pragma unroll
                for (int bj = 0; bj < 2; ++bj)
#pragma unroll
                    for (int n = 0; n < 2; ++n) {
                        const int col = u.pn * BM + 128 * bj + 32 * wc + 16 * n + 4 * fq;
                        *(f32x4*)(orow + col) = *(const f32x4*)(xr + col) + acc[ai][bj][m][n];
                    }
            }
    }
};
}

__device__ __forceinline__ int winrow(int n) { return n < 1024 ? (256 * ((n & 511) >> 7) + 128 * (n >> 9) + (n & 127)) : n; }
template <bool WIN> __device__ __forceinline__ void transpose_item(const float* W, int K, int N, bf16_t* WT, LAS float* scr, int item, int lane) {
    const int nblk = N / 32, kb = item / nblk, nb = item % nblk, k0 = 64 * kb, n0 = 32 * nb;
#pragma unroll 8
    for (int i = 0; i < 32; ++i) { const int kk = 2 * i + (lane >> 5); scr[kk * 33 + (lane & 31)] = W[(size_t)(k0 + kk) * N + n0 + (lane & 31)]; }
    LDS_WAIT();
    const int c = lane & 7;
#pragma unroll
    for (int j = 0; j < 4; ++j) {
        const int n = (lane >> 3) + 8 * j; const LAS float* s = scr + (8 * c) * 33 + n;
        u32x4 o; o.x = cvtpk(s[0 * 33], s[1 * 33]); o.y = cvtpk(s[2 * 33], s[3 * 33]); o.z = cvtpk(s[4 * 33], s[5 * 33]); o.w = cvtpk(s[6 * 33], s[7 * 33]);
        const int dr = WIN ? winrow(n0 + n) : (n0 + n);
        *(u32x4*)(WT + (size_t)dr * K + k0 + 8 * c) = o;
    }
    LDS_WAIT();
}
__device__ __forceinline__ void cvt_stream(const float* src, bf16_t* dst, size_t n8, size_t gt, size_t ngt) {
    for (size_t i = gt; i < n8; i += ngt) {
        const f32x4 a = *(const f32x4*)(src + i * 8), b = *(const f32x4*)(src + i * 8 + 4);
        u32x4 o; o.x = cvtpk(a[0], a[1]); o.y = cvtpk(a[2], a[3]); o.z = cvtpk(b[0], b[1]); o.w = cvtpk(b[2], b[3]);
        *(u32x4*)(dst + i * 8) = o;
    }
}
__device__ __forceinline__ void cvt_cache(const float* src, bf16_t* dst, size_t gt, size_t ngt) {
    const size_t n8 = (size_t)8 * 2048 * 512 / 8;
    for (size_t i = gt; i < n8; i += ngt) {
        const size_t e = i * 8; const size_t row = e >> 9, col = e & 511; const size_t drow = (row >> 11) * SKV + (row & 2047);
        const f32x4 a = *(const f32x4*)(src + e), b = *(const f32x4*)(src + e + 4);
        u32x4 o; o.x = cvtpk(a[0], a[1]); o.y = cvtpk(a[2], a[3]); o.z = cvtpk(b[0], b[1]); o.w = cvtpk(b[2], b[3]);
        *(u32x4*)(dst + drow * 512 + col) = o;
    }
}
__device__ __forceinline__ void rms_row_bf16(const float* xrow, const float* g, bf16_t* orow, int lane) {
    const f32x4* xr = (const f32x4*)xrow + lane; const f32x4* gr = (const f32x4*)g + lane;
    f32x4 v[4]; float s = 0.f;
#pragma unroll
    for (int j = 0; j < 4; ++j) { v[j] = xr[64 * j]; s += (v[j][0] * v[j][0] + v[j][1] * v[j][1]) + (v[j][2] * v[j][2] + v[j][3] * v[j][3]); }
    const float rstd = 1.f / sqrtf(wave_sum(s) * (1.f / DM) + EPS);
    u32x2* o8 = (u32x2*)orow + lane;
#pragma unroll
    for (int j = 0; j < 4; ++j) { const f32x4 gg = gr[64 * j]; u32x2 w; w.x = cvtpk(v[j][0] * rstd * gg[0], v[j][1] * rstd * gg[1]); w.y = cvtpk(v[j][2] * rstd * gg[2], v[j][3] * rstd * gg[3]); o8[64 * j] = w; }
}

template <bool SLICED> __device__ __forceinline__ void cvt_row_fp8(const float* src, unsigned char* dst_base, int row, float* scale_out, int lane) {
    const f32x4* xr = (const f32x4*)src + lane;
    f32x4 v[4]; float am = 0.f;
#pragma unroll
    for (int j = 0; j < 4; ++j) { v[j] = xr[64 * j]; am = fmaxf(am, fmaxf(fmaxf(fabsf(v[j][0]), fabsf(v[j][1])), fmaxf(fabsf(v[j][2]), fabsf(v[j][3])))); }
#pragma unroll
    for (int o = 1; o < 64; o <<= 1) am = fmaxf(am, __shfl_xor(am, o));
    const float sc = am > 0.f ? am * (1.f / 448.f) : 1.f, inv = 1.f / sc;
#pragma unroll
    for (int j = 0; j < 4; ++j) {
        const int eb = 256 * j + 4 * lane;
        int w = __builtin_amdgcn_cvt_pk_fp8_f32(v[j][0] * inv, v[j][1] * inv, 0, false);
        w = __builtin_amdgcn_cvt_pk_fp8_f32(v[j][2] * inv, v[j][3] * inv, w, true);
        if (SLICED) *(int*)(dst_base + ((size_t)(eb >> 7) * 16384 + row) * 128 + (eb & 127)) = w;
        else *(int*)(dst_base + (size_t)row * DM + 16 * ((eb & 511) >> 3) + (eb & 7) + (eb >= 512 ? 8 : 0)) = w;
    }
    if (lane == 0) *scale_out = sc;
}

__device__ __forceinline__ void phase0(const Params& p, LAS unsigned char* lds, int tid, int lane, int wave) {
    const int gw = blockIdx.x * 8 + wave, NGW = gridDim.x * 8;
    LAS float* scr = (LAS float*)(lds + wave * 16384);
    bf16_t* WINT = (bf16_t*)(p.ws + WS_WINT);
    constexpr int I_IN = 16 * (DIN / 32);
    for (int it = gw; it < I_IN; it += NGW) transpose_item<true>(p.in[6], 1024, DIN, WINT, scr, it, lane);
    bf16_t* H = (bf16_t*)(p.ws + WS_H);
    for (int m = gw; m < NT; m += NGW) {
        const float* xr = m < NP ? p.in[0] + (size_t)m * DM : p.in[1] + (size_t)(m - NP) * DM;
        rms_row_bf16(xr, p.in[5], H + (size_t)m * DM, lane);
    }
}
__device__ __forceinline__ void prep_late(const Params& p, LAS unsigned char* lds, int tid, int lane, int wave, int rank, int nparts) {
    const int gw = rank * 8 + wave, NGW = nparts * 8;
    LAS float* scr = (LAS float*)(lds + wave * 16384);
    const size_t gt = (size_t)rank * 512 + tid, ngt = (size_t)nparts * 512;
    cvt_cache(p.in[2], (bf16_t*)(p.ws + WS_KS), gt, ngt);
    cvt_cache(p.in[3], (bf16_t*)(p.ws + WS_VS), gt, ngt);
    bf16_t* WOUTT = (bf16_t*)(p.ws + WS_WOUTT); bf16_t* WQT = (bf16_t*)(p.ws + WS_WQT);
    constexpr int I_OUT = 16 * (1024 / 32), I_Q = 16 * (2048 / 32);
    for (int it = gw; it < I_OUT + I_Q; it += NGW) {
        if (it < I_OUT) transpose_item<false>(p.in[17], 1024, 1024, WOUTT, scr, it, lane);
        else transpose_item<false>(p.in[19], 1024, 2048, WQT, scr, it - I_OUT, lane);
    }
    cvt_stream(p.in[20], (bf16_t*)(p.ws + WS_SK), (size_t)16 * 128 * 128 / 8, gt, ngt);
    for (int r = gw; r < 2 * 16384; r += NGW) {
        const int tb = r >> 14, e = r & 16383;
        if (tb) cvt_row_fp8<true>(p.in[22] + (size_t)e * DM, p.ws + WS_PV8, e, (float*)(p.ws + WS_SCV) + e, lane);
        else cvt_row_fp8<true>(p.in[21] + (size_t)e * DM, p.ws + WS_PU8, e, (float*)(p.ws + WS_SCU) + e, lane);
    }
}

namespace att {
constexpr int KPITCH = 272, VPITCH = 320;
constexpr int L_KV = 0, KV_BYTES = 64 * KPITCH + 64 * VPITCH  , L_X = 0  , L_BIAS = BIAS_OFF, L_CA = 0  , L_CW = 94 * 1024  ;
static_assert(4 * 4096 * 4 <= 2 * KV_BYTES && 2 * KV_BYTES <= L_CW && L_CW + 31 * 1024 <= RING_BYTES, "attention LDS map");

__device__ __forceinline__ int rel_bucket(int rel) {
    const int ret = rel > 0 ? 16 : 0; const int n = rel < 0 ? -rel : rel; int v;
    if (n < 8) v = n; else if (n < 12) v = 8; else if (n < 16) v = 9; else if (n < 23) v = 10; else if (n < 32) v = 11;
    else if (n < 46) v = 12; else if (n < 64) v = 13; else if (n < 91) v = 14; else v = 15;
    return ret + v;
}
typedef short v4i16_t __attribute__((ext_vector_type(4)));
__device__ __forceinline__ s16x4 vtr(const LAS unsigned char* p) { return __builtin_bit_cast(s16x4, __builtin_amdgcn_ds_read_tr16_b64_v4i16((LAS v4i16_t*)p)); }
__device__ __forceinline__ f32x16 mfma32(bf16x8 a, bf16x8 b, f32x16 c) { return __builtin_amdgcn_mfma_f32_32x32x16_bf16(a, b, c, 0, 0, 0); }

__device__ __forceinline__ void attn_unit(const Params& p, LAS unsigned char* lds, int kind, int bb, int h, int qblk, float lam, int tid, int lane, int wid) {
    const bf16_t* Q = (const bf16_t*)(p.ws + WS_Q);
    const bf16_t* Kb = kind == 0 ? (const bf16_t*)(p.ws + WS_KP) + (size_t)bb * 2048 * 512 + h * 128 : (const bf16_t*)(p.ws + WS_KS) + (size_t)bb * SKV * 512 + h * 128;
    const bf16_t* Vb = kind == 0 ? (const bf16_t*)(p.ws + WS_VP) + (size_t)bb * 2048 * 512 + h * 128 : (const bf16_t*)(p.ws + WS_VS) + (size_t)bb * SKV * 512 + h * 128;
    bf16_t* MIX = (bf16_t*)(p.ws + WS_MIX);
    const int qrow0 = kind == 0 ? bb * 2048 + qblk * 128 : NP + bb * 64;
    const int qpos0 = kind == 0 ? qblk * 128 : 2048;
    const int ntiles = kind == 0 ? 2 * qblk + 2 : 33;
    const int rg = wid & 3, map = wid >> 2, r32 = lane & 31, hi = lane >> 5;
    const bool active = kind == 0 ? true : (rg < 2);
    const int cw = kind == 0 ? 2 * qblk + (rg >> 1) : 32;
    const int qw0 = qpos0 + 32 * rg;
    const int qabs = qw0 + r32;

    bf16x8 qf[4];
    if (active) {
        const bf16_t* qp = Q + (size_t)(qrow0 + 32 * rg + r32) * 512 + h * 128 + map * 64 + 8 * hi;
#pragma unroll
        for (int s = 0; s < 4; ++s) qf[s] = *(const bf16x8*)(qp + 16 * s);
    } else {
#pragma unroll
        for (int s = 0; s < 4; ++s) qf[s] = (bf16x8){0, 0, 0, 0, 0, 0, 0, 0};
    }
    float m = 0.f, l = 0.f;
    f32x16 negm;
#pragma unroll
    for (int r = 0; r < 16; ++r) negm[r] = 0.f;
    f32x16 o[4];
#pragma unroll
    for (int mt = 0; mt < 4; ++mt)
#pragma unroll
        for (int r = 0; r < 16; ++r) o[mt][r] = 0.f;

    const int srow0 = tid >> 4, sch = tid & 15;
    const LAS float* btab = (const LAS float*)(lds + L_BIAS) + h * 320;
    const int vlane = (4 * hi + ((lane & 15) >> 2)) * VPITCH + (16 * ((lane >> 4) & 1) + 4 * (lane & 3)) * 2;
    u32x4 kA[2], vA[2], kB[2], vB[2];
#define ATT_LOAD(KR, VR, T) do { _Pragma("unroll") for (int i_ = 0; i_ < 2; ++i_) { const size_t off_ = (size_t)((T) * 64 + srow0 + 32 * i_) * 512 + sch * 8; KR[i_] = *(const u32x4*)(Kb + off_); VR[i_] = *(const u32x4*)(Vb + off_); } } while (0)
#define ATT_STORE(KR, VR, BUF) do { _Pragma("unroll") for (int i_ = 0; i_ < 2; ++i_) { \
        *(LAS u32x4*)(lds + L_KV + (BUF) * KV_BYTES + (srow0 + 32 * i_) * KPITCH + sch * 16) = KR[i_]; \
        *(LAS u32x4*)(lds + L_KV + (BUF) * KV_BYTES + 64 * KPITCH + (srow0 + 32 * i_) * VPITCH + sch * 16) = VR[i_]; } } while (0)
    auto compute = [&](int t, int buf) {
        const LAS unsigned char* kbuf = lds + L_KV + buf * KV_BYTES;
        const LAS unsigned char* vbuf = kbuf + 64 * KPITCH;
        f32x16 p0, p1;
        const int kabs0 = t * 64;
        const LAS unsigned char* kb = kbuf + r32 * KPITCH + (map * 8 + hi) * 16;
        {
            const bf16x8 a0 = *(const LAS bf16x8*)(kb), a1 = *(const LAS bf16x8*)(kb + 32 * KPITCH);
            if (kabs0 + 63 - qw0 > -128) {
                const LAS float* bt = btab + (kabs0 - qabs + 256 + 4 * hi);
#pragma unroll
                for (int r = 0; r < 16; ++r) { p0[r] = bt[(r & 3) + 8 * (r >> 2)] - m; p1[r] = bt[32 + (r & 3) + 8 * (r >> 2)] - m; }
                p0 = mfma32(a0, qf[0], p0); p1 = mfma32(a1, qf[0], p1);
            } else { p0 = mfma32(a0, qf[0], negm); p1 = mfma32(a1, qf[0], negm); }
        }
#pragma unroll
        for (int s = 1; s < 4; ++s) {
            const bf16x8 a0 = *(const LAS bf16x8*)(kb + s * 32), a1 = *(const LAS bf16x8*)(kb + 32 * KPITCH + s * 32);
            p0 = mfma32(a0, qf[s], p0); p1 = mfma32(a1, qf[s], p1);
        }
        float mx = fmaxf(p0[0], p1[0]);
#pragma unroll
        for (int r = 1; r < 16; ++r) mx = fmaxf(mx, fmaxf(p0[r], p1[r]));
        { const auto rr = __builtin_amdgcn_permlane32_swap(__float_as_uint(mx), __float_as_uint(mx), false, false); mx = fmaxf(__uint_as_float(rr[0]), __uint_as_float(rr[1])); }
        if (__any(mx > 8.f)) {
            const float dl = fmaxf(mx, 0.f);
            m += dl;
            const float alpha = __builtin_amdgcn_exp2f(-dl);
            l *= alpha;
#pragma unroll
            for (int r = 0; r < 16; ++r) { p0[r] -= dl; p1[r] -= dl; negm[r] = -m; }
#pragma unroll
            for (int mt = 0; mt < 4; ++mt)
#pragma unroll
                for (int r = 0; r < 16; ++r) o[mt][r] *= alpha;
        }
        float rs = 0.f;
#pragma unroll
        for (int r = 0; r < 16; ++r) { p0[r] = __builtin_amdgcn_exp2f(p0[r]); p1[r] = __builtin_amdgcn_exp2f(p1[r]); rs += p0[r] + p1[r]; }
        l += rs;
#pragma unroll
        for (int t2 = 0; t2 < 2; ++t2)
#pragma unroll
            for (int s = 0; s < 2; ++s) {
                u32x4 bw;
                if (t2 == 0) { bw.x = cvtpk(p0[8 * s + 0], p0[8 * s + 1]); bw.y = cvtpk(p0[8 * s + 2], p0[8 * s + 3]); bw.z = cvtpk(p0[8 * s + 4], p0[8 * s + 5]); bw.w = cvtpk(p0[8 * s + 6], p0[8 * s + 7]); }
                else { bw.x = cvtpk(p1[8 * s + 0], p1[8 * s + 1]); bw.y = cvtpk(p1[8 * s + 2], p1[8 * s + 3]); bw.z = cvtpk(p1[8 * s + 4], p1[8 * s + 5]); bw.w = cvtpk(p1[8 * s + 6], p1[8 * s + 7]); }
                const bf16x8 B = __builtin_bit_cast(bf16x8, bw);
                const LAS unsigned char* vb = vbuf + vlane + (32 * t2 + 16 * s) * VPITCH;
#pragma unroll
                for (int mt = 0; mt < 4; ++mt) {
                    const s16x4 lo = vtr(vb + mt * 64), hi8 = vtr(vb + mt * 64 + 8 * VPITCH);
                    const bf16x8 A = (bf16x8){lo[0], lo[1], lo[2], lo[3], hi8[0], hi8[1], hi8[2], hi8[3]};
                    o[mt] = mfma32(A, B, o[mt]);
                }
            }
    };
    ATT_LOAD(kA, vA, 0);
    if (ntiles > 1) ATT_LOAD(kB, vB, 1);
    ATT_STORE(kA, vA, 0);
    if (ntiles > 2) ATT_LOAD(kA, vA, 2);
    __syncthreads();
    for (int t = 0; t < ntiles; t += 2) {
        if (t + 1 < ntiles) { ATT_STORE(kB, vB, 1); if (t + 3 < ntiles) ATT_LOAD(kB, vB, t + 3); }
        if (active && t <= cw) compute(t, 0);
        __syncthreads();
        if (t + 1 >= ntiles) break;
        if (t + 2 < ntiles) { ATT_STORE(kA, vA, 0); if (t + 4 < ntiles) ATT_LOAD(kA, vA, t + 4); }
        if (active && t + 1 <= cw) compute(t + 1, 1);
        __syncthreads();
    }
#undef ATT_LOAD
#undef ATT_STORE
    l += __shfl_xor(l, 32);
    const float inv = 1.f / l;
    LAS float* X = (LAS float*)(lds + L_X) + rg * 4096;
    if (active && map == 1) {
        const float sc = -lam * inv;
#pragma unroll
        for (int mt = 0; mt < 4; ++mt)
#pragma unroll
            for (int r = 0; r < 16; ++r) X[(mt * 16 + r) * 64 + lane] = o[mt][r] * sc;
    }
    __syncthreads();
    if (active && map == 0) {
        float ss = 0.f;
#pragma unroll
        for (int mt = 0; mt < 4; ++mt)
#pragma unroll
            for (int r = 0; r < 16; ++r) { const float v = o[mt][r] * inv + X[(mt * 16 + r) * 64 + lane]; o[mt][r] = v; ss += v * v; }
        ss += __shfl_xor(ss, 32);
        const float rsn = 0.8f / sqrtf(ss * (1.f / 128.f) + EPS);
        bf16_t* orow = MIX + (size_t)(qrow0 + 32 * rg + r32) * 1024 + 512 + h * 128;
        const float* sg = p.in[15];
#pragma unroll
        for (int mt = 0; mt < 4; ++mt)
#pragma unroll
            for (int g4 = 0; g4 < 4; ++g4) {
                const int e = 32 * mt + 8 * g4 + 4 * hi;
                const f32x4 gg = *(const f32x4*)(sg + e);
                u32x2 w; w.x = cvtpk(o[mt][4 * g4 + 0] * rsn * gg[0], o[mt][4 * g4 + 1] * rsn * gg[1]); w.y = cvtpk(o[mt][4 * g4 + 2] * rsn * gg[2], o[mt][4 * g4 + 3] * rsn * gg[3]);
                *(u32x2*)(orow + e) = w;
            }
    }
    __syncthreads();
}

__device__ __forceinline__ void unpack8(const u32x4 w, float (&f)[8]) { f[0] = bflo(w.x); f[1] = bfhi(w.x); f[2] = bflo(w.y); f[3] = bfhi(w.y); f[4] = bflo(w.z); f[5] = bfhi(w.z); f[6] = bflo(w.w); f[7] = bfhi(w.w); }
__device__ __forceinline__ void conv_unit(const Params& p, LAS unsigned char* lds, int cu, int tid, int lane, int wid) {
    const bf16_t* A = (const bf16_t*)(p.ws + WS_A);
    bf16_t* MIX = (bf16_t*)(p.ws + WS_MIX);
    const float* cb = p.in[8]; const float* lg = p.in[9]; const float* lb = p.in[10]; const float* st = p.in[4];
    const int row0 = cu * 64;
    const bool isp = row0 < NP;
    const int s0 = isp ? (row0 & 2047) : 0, rbase = row0 - s0, bd = isp ? 0 : ((row0 - NP) >> 6);
    for (int c = tid; c < 94 * 64; c += 512) {
        const int rr = c >> 6, ch = c & 63, sp = s0 - 30 + rr;
        u32x4 v = (u32x4){0u, 0u, 0u, 0u};
        if (sp >= 0) v = *(const u32x4*)(A + (size_t)(rbase + sp) * 512 + ch * 8);
        else if (!isp) { const float* sr = st + ((size_t)bd * 30 + (30 + sp)) * 512 + ch * 8; const f32x4 a0 = *(const f32x4*)sr, a1 = *(const f32x4*)(sr + 4);
            v.x = cvtpk(a0[0], a0[1]); v.y = cvtpk(a0[2], a0[3]); v.z = cvtpk(a1[0], a1[1]); v.w = cvtpk(a1[2], a1[3]); }
        *(LAS u32x4*)(lds + L_CA + rr * 1024 + ch * 16) = v;
    }
    __syncthreads();
    const int c0 = lane * 8;
    float bias8[8], g8[8], b8[8];
    { const f32x4 x0 = *(const f32x4*)(cb + c0), x1 = *(const f32x4*)(cb + c0 + 4), y0 = *(const f32x4*)(lg + c0), y1 = *(const f32x4*)(lg + c0 + 4), z0 = *(const f32x4*)(lb + c0), z1 = *(const f32x4*)(lb + c0 + 4);
#pragma unroll
      for (int q = 0; q < 4; ++q) { bias8[q] = x0[q]; bias8[4 + q] = x1[q]; g8[q] = y0[q]; g8[4 + q] = y1[q]; b8[q] = z0[q]; b8[4 + q] = z1[q]; } }
    for (int grp = 0; grp < 2; ++grp) {
        const int t0 = wid * 8 + grp * 4;
        float acc[4][8];
#pragma unroll
        for (int q = 0; q < 4; ++q)
#pragma unroll
            for (int c = 0; c < 8; ++c) acc[q][c] = bias8[c];
        const LAS unsigned char* ap = lds + L_CA + t0 * 1024 + lane * 16;
        const LAS unsigned char* wp = lds + L_CW + lane * 16;
#pragma unroll 1
        for (int j = 0; j < 31; ++j) {
            float w[8]; unpack8(*(const LAS u32x4*)(wp + j * 1024), w);
#pragma unroll
            for (int q = 0; q < 4; ++q) {
                float a[8]; unpack8(*(const LAS u32x4*)(ap + (j + q) * 1024), a);
#pragma unroll
                for (int c = 0; c < 8; ++c) acc[q][c] += w[c] * a[c];
            }
        }
#pragma unroll
        for (int q = 0; q < 4; ++q) {
            float sm = 0.f;
#pragma unroll
            for (int c = 0; c < 8; ++c) sm += acc[q][c];
            const float mu = wave_total(sm) * (1.f / 512.f);
            float sv = 0.f;
#pragma unroll
            for (int c = 0; c < 8; ++c) { acc[q][c] -= mu; sv += acc[q][c] * acc[q][c]; }
            const float rstd = 1.f / sqrtf(wave_total(sv) * (1.f / 512.f) + EPS);
            float y[8];
#pragma unroll
            for (int c = 0; c < 8; ++c) { y[c] = acc[q][c] * rstd * g8[c] + b8[c]; y[c] = y[c] / (1.f + __expf(-y[c])); }
            u32x4 w; w.x = cvtpk(y[0], y[1]); w.y = cvtpk(y[2], y[3]); w.z = cvtpk(y[4], y[5]); w.w = cvtpk(y[6], y[7]);
            *(u32x4*)(MIX + (size_t)(row0 + t0 + q) * 1024 + c0) = w;
        }
    }
}

constexpr int N_SAMPLE_UNITS = 32, N_PROMPT_UNITS = 1024, N_CONV_UNITS = NT / 64, N_UNITS = N_SAMPLE_UNITS + N_PROMPT_UNITS + N_CONV_UNITS;

__device__ __forceinline__ void phase2(const Params& p, LAS unsigned char* lds, int tid, int lane, int wid, int cidx, int mode) {
    LAS float* bt = (LAS float*)(lds + L_BIAS);
    for (int e = tid; e < 4 * 320; e += 512) { const int hh = e / 320, rel = (e % 320) - 256; bt[e] = (p.in[16][rel_bucket(rel) * 4 + hh] - p.in[16][15 * 4 + hh]) * LOG2E; }
    for (int c = tid; c < 31 * 64; c += 512) {
        const float* wr = p.in[7] + (size_t)c * 8; const f32x4 a0 = *(const f32x4*)wr, a1 = *(const f32x4*)(wr + 4);
        u32x4 v; v.x = cvtpk(a0[0], a0[1]); v.y = cvtpk(a0[2], a0[3]); v.z = cvtpk(a1[0], a1[1]); v.w = cvtpk(a1[2], a1[3]);
        *(LAS u32x4*)(lds + L_CW + c * 16) = v;
    }
    const float d1 = wave_sum(p.in[11][lane] * p.in[12][lane]), d2 = wave_sum(p.in[13][lane] * p.in[14][lane]);
    const float lam = expf(d1) - expf(d2) + 0.2f;
    unsigned* ctr = (unsigned*)(p.ws + WS_CTL) + 64 * cidx;
    volatile LAS unsigned* sw = (volatile LAS unsigned*)(lds + MISC_OFF);
    __syncthreads();
    for (;;) {
        __syncthreads();
        if (tid == 0) sw[0] = atomicAdd(ctr, 1u);
        __syncthreads();
        const int u = (int)sw[0];
        if (u >= N_UNITS) break;
        if (mode == 1 && u >= N_SAMPLE_UNITS + N_PROMPT_UNITS) continue;
        if (mode == 2 && u < N_SAMPLE_UNITS + N_PROMPT_UNITS) continue;
        int tid_ = tid; asm volatile("" : "+v"(tid_));
        if (u < N_SAMPLE_UNITS + N_PROMPT_UNITS) {
            const int v = u - N_SAMPLE_UNITS; const int bh = v & 63; const bool smp = u < N_SAMPLE_UNITS;
            attn_unit(p, lds, smp ? 1 : 0, smp ? (u >> 2) : (bh >> 2), smp ? (u & 3) : (bh & 3), smp ? 0 : 15 - (v >> 6), lam, tid_, tid_ & 63, wid);
        } else conv_unit(p, lds, u - N_SAMPLE_UNITS - N_PROMPT_UNITS, tid_, tid_ & 63, wid);
    }
}
}

template <class F> __device__ __forceinline__ void mini_gemm(const bf16_t* A, const bf16_t* Bt, int N, int lane, int wave, F epi) {
    const int ntasks = 16 * (N / 64), G = gridDim.x;
    const int fr = lane & 15, fq = lane >> 4;
    for (int task = wave * G + (int)blockIdx.x; task < ntasks; task += 8 * G) {
        const int rb = task & 15, cb = task >> 4;
        pg8::f32x4 acc[2][4];
#pragma unroll
        for (int m = 0; m < 2; ++m)
#pragma unroll
            for (int n = 0; n < 4; ++n) acc[m][n] = (pg8::f32x4){0.f, 0.f, 0.f, 0.f};
        const bf16_t* ap = A + (size_t)(rb * 32 + fr) * 1024 + 8 * fq;
        const bf16_t* bp = Bt + (size_t)(cb * 64 + fr) * 1024 + 8 * fq;
#pragma unroll 4
        for (int k0 = 0; k0 < 1024; k0 += 32) {
            const bf16x8 a0 = *(const bf16x8*)(ap + k0), a1 = *(const bf16x8*)(ap + 16 * 1024 + k0);
            bf16x8 b[4];
#pragma unroll
            for (int n = 0; n < 4; ++n) b[n] = *(const bf16x8*)(bp + (size_t)n * 16 * 1024 + k0);
#pragma unroll
            for (int n = 0; n < 4; ++n) { acc[0][n] = __builtin_amdgcn_mfma_f32_16x16x32_bf16(b[n], a0, acc[0][n], 0, 0, 0); acc[1][n] = __builtin_amdgcn_mfma_f32_16x16x32_bf16(b[n], a1, acc[1][n], 0, 0, 0); }
        }
#pragma unroll
        for (int m = 0; m < 2; ++m)
#pragma unroll
            for (int n = 0; n < 4; ++n) epi(rb * 32 + 16 * m + fr, cb * 64 + 16 * n + 4 * fq, acc[m][n]);
    }
}

__device__ __forceinline__ void phase3b(const Params& p, int lane, int wave) {
    const int gw = blockIdx.x * 8 + wave, NGW = gridDim.x * 8;
    bf16_t* H2 = (bf16_t*)(p.ws + WS_H2);
    for (int m = gw; m < NT; m += NGW) rms_row_bf16(p.out + (size_t)m * DM, p.in[18], H2 + (size_t)m * DM, lane);
}

constexpr int P4B_KPITCH = 272, P4B_K_BYTES = 128 * P4B_KPITCH, P4B_Q_BYTES = 32 * P4B_KPITCH;
static_assert(P4B_K_BYTES + 8 * P4B_Q_BYTES <= RING_BYTES, "P4b LDS map");
__device__ __forceinline__ void phase4b(const Params& p, LAS unsigned char* lds, int tid, int lane, int wave) {
    const bf16_t* QP = (const bf16_t*)(p.ws + WS_QP); const bf16_t* SK = (const bf16_t*)(p.ws + WS_SK);
    float* TK = (float*)(p.ws + WS_TK);
    const int r32 = lane & 31, hi = lane >> 5;
    const int G = gridDim.x;
    for (int rp = blockIdx.x & 15; rp < 16; rp += (G < 16 ? G : 16)) {
        const int nbr = (G - rp + 15) >> 4, member = (int)blockIdx.x >> 4;
        __syncthreads();
        for (int c = tid; c < 128 * 16; c += 512) { const int row = c >> 4, ch = c & 15; *(LAS u32x4*)(lds + row * P4B_KPITCH + ch * 16) = *(const u32x4*)(SK + ((size_t)rp * 128 + row) * 128 + ch * 8); }
        __syncthreads();
        LAS unsigned char* qs = lds + P4B_K_BYTES + wave * P4B_Q_BYTES;
        for (int tg = member * 8 + wave; tg < NT / 32; tg += nbr * 8) {
            const int t0 = tg * 32;
#pragma unroll
            for (int i = 0; i < 8; ++i) { const int row = 4 * i + (lane >> 4), ch = lane & 15; *(LAS u32x4*)(qs + row * P4B_KPITCH + ch * 16) = *(const u32x4*)(QP + (size_t)(t0 + row) * 2048 + rp * 128 + ch * 8); }
            bf16x8 qf[8];
#pragma unroll
            for (int s = 0; s < 8; ++s) qf[s] = *(const LAS bf16x8*)(qs + r32 * P4B_KPITCH + (2 * s + hi) * 16);
            float v[64];
#pragma unroll
            for (int mt = 0; mt < 4; ++mt) {
                f32x16 S;
#pragma unroll
                for (int r = 0; r < 16; ++r) S[r] = 0.f;
                const LAS unsigned char* kp = lds + (32 * mt + r32) * P4B_KPITCH + hi * 16;
#pragma unroll
                for (int s = 0; s < 8; ++s) S = att::mfma32(*(const LAS bf16x8*)(kp + s * 32), qf[s], S);
#pragma unroll
                for (int r = 0; r < 16; ++r) { const int n = 32 * mt + (r & 3) + 8 * (r >> 2) + 4 * hi; v[mt * 16 + r] = __uint_as_float((__float_as_uint(S[r]) & ~127u) | (unsigned)(127 - n)); }
            }
            SORT16_DESC(v, 0); SORT16_DESC(v, 16); SORT16_DESC(v, 32); SORT16_DESC(v, 48);
#pragma unroll
            for (int i = 0; i < 16; ++i) { v[i] = fmaxf(v[i], v[31 - i]); v[32 + i] = fmaxf(v[32 + i], v[63 - i]); }
            BITONIC16_DESC(v, 0); BITONIC16_DESC(v, 32);
#pragma unroll
            for (int i = 0; i < 16; ++i) v[i] = fmaxf(v[i], v[47 - i]);
            BITONIC16_DESC(v, 0);
            float w[16];
#pragma unroll
            for (int i = 0; i < 16; ++i) w[i] = fmaxf(v[i], __shfl_xor(v[15 - i], 32));
            BITONIC16_DESC(w, 0);
            if (hi == 0) {
                f32x4* dst = (f32x4*)(TK + ((size_t)(t0 + r32) * 16 + rp) * 16);
#pragma unroll
                for (int q = 0; q < 4; ++q) dst[q] = (f32x4){w[4 * q], w[4 * q + 1], w[4 * q + 2], w[4 * q + 3]};
            }
        }
    }
}

__device__ __forceinline__ void phase5a(const Params& p, int tid) {
    const float* TK = (const float*)(p.ws + WS_TK);
    int* IDX = (int*)(p.ws + WS_IDX); float* GATE = (float*)(p.ws + WS_GATE);
    const float NEG_INF = -__builtin_huge_valf();
    for (int item = blockIdx.x * 512 + tid; item < NT * 8; item += gridDim.x * 512) {
        const int tok = item >> 3, r = item & 7;
        const f32x4* pa = (const f32x4*)(TK + ((size_t)tok * 16 + 2 * r) * 16);
        float a[16], b[16]; int ia[16], ib[16];
#pragma unroll
        for (int q = 0; q < 4; ++q) { const f32x4 x = pa[q], y = pa[4 + q];
#pragma unroll
            for (int j = 0; j < 4; ++j) { a[4 * q + j] = x[j]; b[4 * q + j] = y[j]; } }
#pragma unroll
        for (int i = 0; i < 16; ++i) { const unsigned ua = __float_as_uint(a[i]), ub = __float_as_uint(b[i]); ia[i] = 127 - (int)(ua & 127u); ib[i] = 127 - (int)(ub & 127u); a[i] = __uint_as_float(ua & ~127u); b[i] = __uint_as_float(ub & ~127u); }
        float cv[50]; int cid[50];
        {
            int c = 0;
#pragma unroll
            for (int i = 0; i < 16; ++i)
#pragma unroll
                for (int j = 0; j < 16; ++j)
                    if ((i + 1) * (j + 1) <= 16) { const float s = a[i] + b[j]; cv[c] = __uint_as_float((__float_as_uint(s) & ~63u) | (unsigned)(63 - c)); cid[c] = ia[i] * 128 + ib[j]; ++c; }
        }
        float best[16]; int bid[16];
#pragma unroll
        for (int it = 0; it < 16; ++it) {
            float mx = cv[0];
#pragma unroll
            for (int c = 1; c < 50; ++c) mx = fmaxf(mx, cv[c]);
            int id = 0;
#pragma unroll
            for (int c = 0; c < 50; ++c) { const bool hit = cv[c] == mx; id = hit ? cid[c] : id; cv[c] = hit ? NEG_INF : cv[c]; }
            best[it] = __uint_as_float(__float_as_uint(mx) & ~63u); bid[it] = id;
        }
        float e[16], sum = 0.f;
#pragma unroll
        for (int k = 0; k < 16; ++k) { e[k] = __expf(best[k] - best[0]); sum += e[k]; }
        const float rinv = 1.f / sum;
        int* io = IDX + (size_t)tok * 128 + r * 16; float* go = GATE + (size_t)tok * 128 + r * 16;
#pragma unroll
        for (int k = 0; k < 16; ++k) { io[k] = bid[k]; go[k] = e[k] * rinv; }
    }
}

__device__ __forceinline__ float gelu_erf(float x) { return 0.5f * x * (1.f + erff(x * 0.70710678118654752f)); }
__device__ __forceinline__ void fp8x16_to_f32(const u32x4 q, float (&f)[16]) {
    const f32x2 c0 = __builtin_amdgcn_cvt_pk_f32_fp8(q.x, false), c1 = __builtin_amdgcn_cvt_pk_f32_fp8(q.x, true), c2 = __builtin_amdgcn_cvt_pk_f32_fp8(q.y, false), c3 = __builtin_amdgcn_cvt_pk_f32_fp8(q.y, true);
    const f32x2 c4 = __builtin_amdgcn_cvt_pk_f32_fp8(q.z, false), c5 = __builtin_amdgcn_cvt_pk_f32_fp8(q.z, true), c6 = __builtin_amdgcn_cvt_pk_f32_fp8(q.w, false), c7 = __builtin_amdgcn_cvt_pk_f32_fp8(q.w, true);
    f[0] = c0.x; f[1] = c0.y; f[2] = c1.x; f[3] = c1.y; f[4] = c2.x; f[5] = c2.y; f[6] = c3.x; f[7] = c3.y;
    f[8] = c4.x; f[9] = c4.y; f[10] = c5.x; f[11] = c5.y; f[12] = c6.x; f[13] = c6.y; f[14] = c7.x; f[15] = c7.y;
}
__device__ __forceinline__ void slice_group(int& x, int& gwx, int& nwx, int wave) {
    x = blockIdx.x & 7; const int nbx = ((int)gridDim.x - x + 7) >> 3; gwx = ((int)blockIdx.x >> 3) * 8 + wave; nwx = nbx * 8;
}
__device__ __forceinline__ void phase5u(const Params& p, LAS unsigned char* lds, int lane, int wave) {
    int x, gwx, nwx; slice_group(x, gwx, nwx, wave);
    const unsigned char* PU8 = p.ws + WS_PU8 + (size_t)x * 16384 * 128;
    const bf16_t* H2 = (const bf16_t*)(p.ws + WS_H2) + 128 * x;
    const int* IDX = (const int*)(p.ws + WS_IDX); float* PACT = (float*)(p.ws + WS_PACT) + (size_t)x * NT * 128;
    LAS int* l_idx = (LAS int*)(lds + wave * 512);
    const int g = lane >> 3, sub = lane & 7;
    const unsigned char* rowp = PU8 + sub * 16;
    int r_idxA = 0, r_idxB = 0;
    u32x4 hA0, hA1, hB0, hB1; hA0 = hA1 = hB0 = hB1 = (u32x4){0u, 0u, 0u, 0u};
    u32x4 qA[16], qB[16];
#define P5U_LOADIDX(T) do { if ((T) < NT) { r_idxA = IDX[(size_t)(T) * 128 + lane]; r_idxB = IDX[(size_t)(T) * 128 + 64 + lane]; } } while (0)
#define P5U_ISSUE(Q, H0, H1, T) do { if ((T) < NT) { l_idx[lane] = r_idxA; l_idx[64 + lane] = r_idxB; \
        H0 = *(const u32x4*)(H2 + (size_t)(T) * DM + 16 * sub); H1 = *(const u32x4*)(H2 + (size_t)(T) * DM + 16 * sub + 8); \
        _Pragma("unroll") for (int q_ = 0; q_ < 4; ++q_) { const u32x4 iv = *(const LAS u32x4*)(l_idx + 16 * g + 4 * q_); \
            Q[4 * q_] = *(const u32x4*)(rowp + (size_t)iv.x * 128); Q[4 * q_ + 1] = *(const u32x4*)(rowp + (size_t)iv.y * 128); \
            Q[4 * q_ + 2] = *(const u32x4*)(rowp + (size_t)iv.z * 128); Q[4 * q_ + 3] = *(const u32x4*)(rowp + (size_t)iv.w * 128); } } } while (0)
#define P5U_COMPUTE(Q, H0, H1, T) do { \
        f32x2 hf[8]; \
        hf[0] = (f32x2){bflo(H0.x), bfhi(H0.x)}; hf[1] = (f32x2){bflo(H0.y), bfhi(H0.y)}; hf[2] = (f32x2){bflo(H0.z), bfhi(H0.z)}; hf[3] = (f32x2){bflo(H0.w), bfhi(H0.w)}; \
        hf[4] = (f32x2){bflo(H1.x), bfhi(H1.x)}; hf[5] = (f32x2){bflo(H1.y), bfhi(H1.y)}; hf[6] = (f32x2){bflo(H1.z), bfhi(H1.z)}; hf[7] = (f32x2){bflo(H1.w), bfhi(H1.w)}; \
        float resA = 0.f, resB = 0.f; \
        _Pragma("unroll") for (int i = 0; i < 16; ++i) { \
            f32x2 s2 = __builtin_amdgcn_cvt_pk_f32_fp8(Q[i].x, false) * hf[0]; \
            s2 = __builtin_elementwise_fma(__builtin_amdgcn_cvt_pk_f32_fp8(Q[i].x, true), hf[1], s2); \
            s2 = __builtin_elementwise_fma(__builtin_amdgcn_cvt_pk_f32_fp8(Q[i].y, false), hf[2], s2); \
            s2 = __builtin_elementwise_fma(__builtin_amdgcn_cvt_pk_f32_fp8(Q[i].y, true), hf[3], s2); \
            s2 = __builtin_elementwise_fma(__builtin_amdgcn_cvt_pk_f32_fp8(Q[i].z, false), hf[4], s2); \
            s2 = __builtin_elementwise_fma(__builtin_amdgcn_cvt_pk_f32_fp8(Q[i].z, true), hf[5], s2); \
            s2 = __builtin_elementwise_fma(__builtin_amdgcn_cvt_pk_f32_fp8(Q[i].w, false), hf[6], s2); \
            s2 = __builtin_elementwise_fma(__builtin_amdgcn_cvt_pk_f32_fp8(Q[i].w, true), hf[7], s2); \
            float sr = s2.x + s2.y; \
            DPP_ADD(sr, 0xB1); DPP_ADD(sr, 0x4E); DPP_ADD(sr, 0x141); \
            if (i < 8) resA = (sub == i) ? sr : resA; else resB = (sub == i - 8) ? sr : resB; } \
        PACT[(size_t)(T) * 128 + 16 * g + sub] = resA; PACT[(size_t)(T) * 128 + 16 * g + 8 + sub] = resB; } while (0)
    int tok = gwx;
    P5U_LOADIDX(tok);
    P5U_ISSUE(qA, hA0, hA1, tok);
    P5U_LOADIDX(tok + nwx);
    for (; tok < NT; tok += 2 * nwx) {
        P5U_ISSUE(qB, hB0, hB1, tok + nwx);
        P5U_LOADIDX(tok + 2 * nwx);
        P5U_COMPUTE(qA, hA0, hA1, tok);
        if (tok + nwx >= NT) break;
        P5U_ISSUE(qA, hA0, hA1, tok + 2 * nwx);
        P5U_LOADIDX(tok + 3 * nwx);
        P5U_COMPUTE(qB, hB0, hB1, tok + nwx);
    }
#undef P5U_LOADIDX
#undef P5U_ISSUE
#undef P5U_COMPUTE
}
__device__ __forceinline__ void phase5c(const Params& p, int tid) {
    const float* PACT = (const float*)(p.ws + WS_PACT); const float* SCU = (const float*)(p.ws + WS_SCU); const float* SCV = (const float*)(p.ws + WS_SCV);
    const int* IDX = (const int*)(p.ws + WS_IDX); const float* GATE = (const float*)(p.ws + WS_GATE); float* COEF = (float*)(p.ws + WS_COEF);
    const size_t n = (size_t)NT * 128, n4 = n / 4, stride = (size_t)gridDim.x * 512;
    for (size_t i0 = (size_t)blockIdx.x * 512 + tid; i0 < n4; i0 += 2 * stride) {
        f32x4 a[2], g[2]; u32x4 e[2]; f32x4 pa[2][8];
#pragma unroll
        for (int u = 0; u < 2; ++u) {
            const size_t it = (i0 + u * stride < n4 ? i0 + u * stride : i0) * 4;
#pragma unroll
            for (int xx = 0; xx < 8; ++xx) pa[u][xx] = *(const f32x4*)(PACT + (size_t)xx * n + it);
            e[u] = *(const u32x4*)(IDX + it); g[u] = *(const f32x4*)(GATE + it);
        }
        float su[2][4], sv[2][4];
#pragma unroll
        for (int u = 0; u < 2; ++u)
#pragma unroll
            for (int j = 0; j < 4; ++j) { su[u][j] = SCU[e[u][j]]; sv[u][j] = SCV[e[u][j]]; }
#pragma unroll
        for (int u = 0; u < 2; ++u) {
            a[u] = ((pa[u][0] + pa[u][1]) + (pa[u][2] + pa[u][3])) + ((pa[u][4] + pa[u][5]) + (pa[u][6] + pa[u][7]));
            f32x4 c;
#pragma unroll
            for (int j = 0; j < 4; ++j) c[j] = g[u][j] * gelu_erf(a[u][j] * su[u][j]) * sv[u][j];
            if (i0 + u * stride < n4) *(f32x4*)(COEF + (i0 + u * stride) * 4) = c;
        }
    }
}

constexpr int P5V_LDS_PER_WAVE = 1024 + 8 * 136 * 4;
__device__ __forceinline__ void phase5v(const Params& p, LAS unsigned char* lds, int lane, int wave) {
    int x, gwx, nwx; slice_group(x, gwx, nwx, wave);
    const unsigned char* PV8 = p.ws + WS_PV8 + (size_t)x * 16384 * 128;
    const int* IDX = (const int*)(p.ws + WS_IDX); const float* COEF = (const float*)(p.ws + WS_COEF);
    LAS int* l_idx = (LAS int*)(lds + wave * P5V_LDS_PER_WAVE); LAS float* l_cf = (LAS float*)(l_idx + 128); LAS float* red = l_cf + 128;
    const int g = lane >> 3, sub = lane & 7;
    const unsigned char* rowp = PV8 + sub * 16;
    const int c1 = 16 * (lane & 7) + (lane >> 3);
    int r_idxA = 0, r_idxB = 0; float r_cA = 0.f, r_cB = 0.f;
    u32x4 qA[16], qB[16]; f32x4 cfA[4], cfB[4]; float xA0 = 0.f, xA1 = 0.f, xB0 = 0.f, xB1 = 0.f;
#define P5V_LOADIDX(T) do { if ((T) < NT) { r_idxA = IDX[(size_t)(T) * 128 + lane]; r_idxB = IDX[(size_t)(T) * 128 + 64 + lane]; r_cA = COEF[(size_t)(T) * 128 + lane]; r_cB = COEF[(size_t)(T) * 128 + 64 + lane]; } } while (0)
#define P5V_ISSUE(Q, CF, X0, X1, T) do { if ((T) < NT) { l_idx[lane] = r_idxA; l_idx[64 + lane] = r_idxB; l_cf[lane] = r_cA; l_cf[64 + lane] = r_cB; \
        { const float* xr_ = p.out + (size_t)(T) * DM + 128 * x; X0 = xr_[c1]; X1 = xr_[c1 + 8]; } \
        _Pragma("unroll") for (int q_ = 0; q_ < 4; ++q_) { const u32x4 iv = *(const LAS u32x4*)(l_idx + 16 * g + 4 * q_); CF[q_] = *(const LAS f32x4*)(l_cf + 16 * g + 4 * q_); \
            Q[4 * q_] = *(const u32x4*)(rowp + (size_t)iv.x * 128); Q[4 * q_ + 1] = *(const u32x4*)(rowp + (size_t)iv.y * 128); \
            Q[4 * q_ + 2] = *(const u32x4*)(rowp + (size_t)iv.z * 128); Q[4 * q_ + 3] = *(const u32x4*)(rowp + (size_t)iv.w * 128); } } } while (0)
#define P5V_COMPUTE(Q, CF, X0, X1, T) do { \
        f32x2 acc[8]; \
        _Pragma("unroll") for (int j = 0; j < 8; ++j) acc[j] = (f32x2){0.f, 0.f}; \
        _Pragma("unroll") for (int i = 0; i < 16; ++i) { \
            const float cs_ = CF[i >> 2][i & 3]; const f32x2 c2 = (f32x2){cs_, cs_}; \
            acc[0] = __builtin_elementwise_fma(__builtin_amdgcn_cvt_pk_f32_fp8(Q[i].x, false), c2, acc[0]); \
            acc[1] = __builtin_elementwise_fma(__builtin_amdgcn_cvt_pk_f32_fp8(Q[i].x, true), c2, acc[1]); \
            acc[2] = __builtin_elementwise_fma(__builtin_amdgcn_cvt_pk_f32_fp8(Q[i].y, false), c2, acc[2]); \
            acc[3] = __builtin_elementwise_fma(__builtin_amdgcn_cvt_pk_f32_fp8(Q[i].y, true), c2, acc[3]); \
            acc[4] = __builtin_elementwise_fma(__builtin_amdgcn_cvt_pk_f32_fp8(Q[i].z, false), c2, acc[4]); \
            acc[5] = __builtin_elementwise_fma(__builtin_amdgcn_cvt_pk_f32_fp8(Q[i].z, true), c2, acc[5]); \
            acc[6] = __builtin_elementwise_fma(__builtin_amdgcn_cvt_pk_f32_fp8(Q[i].w, false), c2, acc[6]); \
            acc[7] = __builtin_elementwise_fma(__builtin_amdgcn_cvt_pk_f32_fp8(Q[i].w, true), c2, acc[7]); } \
        _Pragma("unroll") for (int j = 0; j < 8; ++j) { red[g * 136 + (2 * j) * 8 + sub] = acc[j].x; red[g * 136 + (2 * j + 1) * 8 + sub] = acc[j].y; } \
        float s1 = X0, s2_ = X1; \
        _Pragma("unroll") for (int gg = 0; gg < 8; ++gg) { s1 += red[gg * 136 + lane]; s2_ += red[gg * 136 + 64 + lane]; } \
        { float* xr_ = p.out + (size_t)(T) * DM + 128 * x; xr_[c1] = s1; xr_[c1 + 8] = s2_; } } while (0)
    int tok = gwx;
    P5V_LOADIDX(tok);
    P5V_ISSUE(qA, cfA, xA0, xA1, tok);
    P5V_LOADIDX(tok + nwx);
    for (; tok < NT; tok += 2 * nwx) {
        P5V_ISSUE(qB, cfB, xB0, xB1, tok + nwx);
        P5V_LOADIDX(tok + 2 * nwx);
        P5V_COMPUTE(qA, cfA, xA0, xA1, tok);
        if (tok + nwx >= NT) break;
        P5V_ISSUE(qA, cfA, xA0, xA1, tok + 2 * nwx);
        P5V_LOADIDX(tok + 3 * nwx);
        P5V_COMPUTE(qB, cfB, xB0, xB1, tok + nwx);
    }
#undef P5V_LOADIDX
#undef P5V_ISSUE
#undef P5V_COMPUTE
}

__device__ __forceinline__ void phase6(const Params& p, int lane, int wave) {
    const int gw = blockIdx.x * 8 + wave, NGW = gridDim.x * 8;
    const f32x4* gr = (const f32x4*)p.in[23] + lane;
    for (int m = gw; m < NT; m += NGW) {
        f32x4* xr = (f32x4*)(p.out + (size_t)m * DM) + lane;
        f32x4 v[4]; float s = 0.f;
#pragma unroll
        for (int j = 0; j < 4; ++j) { v[j] = xr[64 * j]; s += (v[j][0] * v[j][0] + v[j][1] * v[j][1]) + (v[j][2] * v[j][2] + v[j][3] * v[j][3]); }
        const float rstd = 1.f / sqrtf(wave_total(s) * (1.f / DM) + EPS);
#pragma unroll
        for (int j = 0; j < 4; ++j) xr[64 * j] = v[j] * rstd * gr[64 * j];
    }
}

__global__ void __launch_bounds__(512, 2) fwd_megakernel(Params p) {
    extern __shared__ __attribute__((aligned(16))) unsigned char lds_raw[];
    LAS unsigned char* lds = (LAS unsigned char*)lds_raw;
    cg::grid_group grid = cg::this_grid();
    const int tid0 = threadIdx.x, wave = __builtin_amdgcn_readfirstlane(tid0 >> 6);
#define PHASE_IDS() int tid = tid0; asm volatile("" : "+v"(tid)); const int lane = tid & 63; (void)lane
    const int G = gridDim.x;
    volatile LAS unsigned* MISC = (volatile LAS unsigned*)(lds + MISC_OFF);
    if (tid0 < 32) MISC[tid0] = 0u;
    __syncthreads();
    XcdBarrier bar = xcd_barrier_post((unsigned*)(p.ws + WS_CTL) + 4096, MISC + 8);
#define GSYNC() xcd_barrier(bar)

#ifndef RPT_MASK
#define RPT_MASK 0
#endif
#if RPT_MASK
#define RPT(bit) for (int rpt_ = 0; rpt_ < (((RPT_MASK) >> (bit)) & 1) + 1; ++rpt_)
#else
#define RPT(bit) if (constexpr int rpt_ = 0; true)
#endif
    RPT(0) { PHASE_IDS(); phase0(p, lds, tid, lane, wave); grid.sync(); }
    RPT(1) {
        PHASE_IDS();
        pg8::Gemm g{(const bf16_t*)(p.ws + WS_H), (const bf16_t*)(p.ws + WS_WINT), NT, DIN, 1024};
        pg8::StaticOrder S; S.init(NT, DIN, G, (int)blockIdx.x);
        pg8::EpiProj E{(bf16_t*)(p.ws + WS_A), (bf16_t*)(p.ws + WS_Q), (bf16_t*)(p.ws + WS_KP), (bf16_t*)(p.ws + WS_VP), (bf16_t*)(p.ws + WS_KS), (bf16_t*)(p.ws + WS_VS), p.out};
        pg8::gemm_phase<pg8::EpiProj, pg8::StaticOrder, true, true>(lds, g, S, E);
        {
            const int nwg = (NT / 256) * (DIN / 256), rem = nwg % G, c = (int)blockIdx.x;
            if (rem == 0) prep_late(p, lds, tid, lane, wave, c, G);
            else if (c >= rem) prep_late(p, lds, tid, lane, wave, c - rem, G - rem);
        }
        GSYNC();
    }
    #ifndef P2MODE
#define P2MODE 0
#endif
    RPT(2) { PHASE_IDS(); att::phase2(p, lds, tid, lane, wave, rpt_, (((RPT_MASK) >> 2) & 1) && rpt_ == 0 ? P2MODE : 0); GSYNC(); }
    RPT(3) {
        PHASE_IDS();
        pg8::Gemm g{(const bf16_t*)(p.ws + WS_MIX), (const bf16_t*)(p.ws + WS_WOUTT), NP, 1024, 1024};
        pg8::StaticOrder S; S.init(NP, 1024, G, (int)blockIdx.x);
        pg8::EpiRes E{p.in[0], p.in[1], p.out};
        pg8::gemm_phase<pg8::EpiRes, pg8::StaticOrder, true, true>(lds, g, S, E);
        {
            const float* xs = p.in[1]; float* xo = p.out + (size_t)NP * DM;
            mini_gemm((const bf16_t*)(p.ws + WS_MIX) + (size_t)NP * DM, (const bf16_t*)(p.ws + WS_WOUTT), 1024, lane, wave,
                      [=](int row, int col, pg8::f32x4 v) { *(pg8::f32x4*)(xo + (size_t)row * DM + col) = *(const pg8::f32x4*)(xs + (size_t)row * DM + col) + v; });
        }
        GSYNC();
    }
    RPT(4) { PHASE_IDS(); phase3b(p, lane, wave); GSYNC(); }
    RPT(5) {
        PHASE_IDS();
        pg8::Gemm g{(const bf16_t*)(p.ws + WS_H2), (const bf16_t*)(p.ws + WS_WQT), NP, 2048, 1024};
        pg8::StaticOrder S; S.init(NP, 2048, G, (int)blockIdx.x);
        pg8::EpiBf16<0> E{(bf16_t*)(p.ws + WS_QP), 2048, nullptr, 0, 0, 1.f};
        pg8::gemm_phase<pg8::EpiBf16<0>, pg8::StaticOrder, true, true>(lds, g, S, E);
        {
            bf16_t* qo = (bf16_t*)(p.ws + WS_QP) + (size_t)NP * 2048;
            mini_gemm((const bf16_t*)(p.ws + WS_H2) + (size_t)NP * DM, (const bf16_t*)(p.ws + WS_WQT), 2048, lane, wave,
                      [=](int row, int col, pg8::f32x4 v) { *(u32x2*)(qo + (size_t)row * 2048 + col) = pg8::pack4(v); });
        }
        GSYNC();
    }
    RPT(6) { PHASE_IDS(); phase4b(p, lds, tid, lane, wave); GSYNC(); }
    RPT(7) { PHASE_IDS(); phase5a(p, tid); GSYNC(); }
    RPT(8) { PHASE_IDS(); phase5u(p, lds, lane, wave); GSYNC(); }
    RPT(9) { PHASE_IDS(); phase5c(p, tid); GSYNC(); }
    { PHASE_IDS(); phase5v(p, lds, lane, wave); }
    GSYNC();
    { PHASE_IDS(); phase6(p, lane, wave); }
}

extern "C" void kernel_launch(void* const* d_in, const int* in_sizes, int n_in, void* d_out, int out_size, void* d_ws, size_t ws_size, hipStream_t stream) {
    static int grid = 0;
    if (grid == 0) {
        if (n_in != 24 || out_size != (int)OUT_TOTAL || ws_size < WS_END) { fprintf(stderr, "kernel_launch: unexpected shapes: n_in %d out %d ws %zu (need %zu)\n", n_in, out_size, ws_size, (size_t)WS_END); grid = -1; return; }
        int dev = 0, cus = 0, per_cu = 0;
        (void)hipGetDevice(&dev);
        (void)hipDeviceGetAttribute(&cus, hipDeviceAttributeMultiprocessorCount, dev);
        if (hipFuncSetAttribute((const void*)fwd_megakernel, hipFuncAttributeMaxDynamicSharedMemorySize, LDS_BYTES) != hipSuccess) { fprintf(stderr, "kernel_launch: hipFuncSetAttribute failed\n"); grid = -1; return; }
        if (hipOccupancyMaxActiveBlocksPerMultiprocessor(&per_cu, (const void*)fwd_megakernel, 512, LDS_BYTES) != hipSuccess || per_cu < 1) { fprintf(stderr, "kernel_launch: occupancy query gave %d\n", per_cu); per_cu = 1; }
        (void)hipGetLastError();
        grid = cus * 1;
        if (per_cu < 1) grid = -1;
    }
    if (grid < 0) return;
    (void)hipMemsetAsync((char*)d_ws + WS_CTL, 0, CTL_BYTES, stream);
    Params p{};
    for (int i = 0; i < 24; ++i) p.in[i] = (const float*)d_in[i];
    p.out = (float*)d_out; p.ws = (unsigned char*)d_ws;
    void* args[] = {&p};
    hipError_t e = hipLaunchCooperativeKernel((const void*)fwd_megakernel, dim3(grid), dim3(512), args, LDS_BYTES, stream);
    if (e != hipSuccess) fprintf(stderr, "cooperative launch failed: %s (grid %d)\n", hipGetErrorString(e), grid);
}
```

```cpp
#include <hip/hip_runtime.h>
#include <hip/hip_cooperative_groups.h>
#include <cstdio>
#include <cstdint>
#include <cmath>
namespace cg = cooperative_groups;
#define CE_(a, b) do { const float t_ = fmaxf(a, b); b = fminf(a, b); a = t_; } while (0)
#define SORT16_DESC(V, O) do { CE_(V[(O)+0], V[(O)+1]); CE_(V[(O)+2], V[(O)+3]); CE_(V[(O)+0], V[(O)+2]); CE_(V[(O)+1], V[(O)+3]); CE_(V[(O)+1], V[(O)+2]); CE_(V[(O)+4], V[(O)+5]); CE_(V[(O)+6], V[(O)+7]); CE_(V[(O)+4], V[(O)+6]); CE_(V[(O)+5], V[(O)+7]); CE_(V[(O)+5], V[(O)+6]); CE_(V[(O)+0], V[(O)+4]); CE_(V[(O)+2], V[(O)+6]); CE_(V[(O)+2], V[(O)+4]); CE_(V[(O)+1], V[(O)+5]); CE_(V[(O)+3], V[(O)+7]); CE_(V[(O)+3], V[(O)+5]); CE_(V[(O)+1], V[(O)+2]); CE_(V[(O)+3], V[(O)+4]); CE_(V[(O)+5], V[(O)+6]); CE_(V[(O)+8], V[(O)+9]); CE_(V[(O)+10], V[(O)+11]); CE_(V[(O)+8], V[(O)+10]); CE_(V[(O)+9], V[(O)+11]); CE_(V[(O)+9], V[(O)+10]); CE_(V[(O)+12], V[(O)+13]); CE_(V[(O)+14], V[(O)+15]); CE_(V[(O)+12], V[(O)+14]); CE_(V[(O)+13], V[(O)+15]); CE_(V[(O)+13], V[(O)+14]); CE_(V[(O)+8], V[(O)+12]); CE_(V[(O)+10], V[(O)+14]); CE_(V[(O)+10], V[(O)+12]); CE_(V[(O)+9], V[(O)+13]); CE_(V[(O)+11], V[(O)+15]); CE_(V[(O)+11], V[(O)+13]); CE_(V[(O)+9], V[(O)+10]); CE_(V[(O)+11], V[(O)+12]); CE_(V[(O)+13], V[(O)+14]); CE_(V[(O)+0], V[(O)+8]); CE_(V[(O)+4], V[(O)+12]); CE_(V[(O)+4], V[(O)+8]); CE_(V[(O)+2], V[(O)+10]); CE_(V[(O)+6], V[(O)+14]); CE_(V[(O)+6], V[(O)+10]); CE_(V[(O)+2], V[(O)+4]); CE_(V[(O)+6], V[(O)+8]); CE_(V[(O)+10], V[(O)+12]); CE_(V[(O)+1], V[(O)+9]); CE_(V[(O)+5], V[(O)+13]); CE_(V[(O)+5], V[(O)+9]); CE_(V[(O)+3], V[(O)+11]); CE_(V[(O)+7], V[(O)+15]); CE_(V[(O)+7], V[(O)+11]); CE_(V[(O)+3], V[(O)+5]); CE_(V[(O)+7], V[(O)+9]); CE_(V[(O)+11], V[(O)+13]); CE_(V[(O)+1], V[(O)+2]); CE_(V[(O)+3], V[(O)+4]); CE_(V[(O)+5], V[(O)+6]); CE_(V[(O)+7], V[(O)+8]); CE_(V[(O)+9], V[(O)+10]); CE_(V[(O)+11], V[(O)+12]); CE_(V[(O)+13], V[(O)+14]); } while (0)
#define BITONIC16_DESC(V, O) do { CE_(V[(O)+0], V[(O)+8]); CE_(V[(O)+1], V[(O)+9]); CE_(V[(O)+2], V[(O)+10]); CE_(V[(O)+3], V[(O)+11]); CE_(V[(O)+4], V[(O)+12]); CE_(V[(O)+5], V[(O)+13]); CE_(V[(O)+6], V[(O)+14]); CE_(V[(O)+7], V[(O)+15]); CE_(V[(O)+0], V[(O)+4]); CE_(V[(O)+1], V[(O)+5]); CE_(V[(O)+2], V[(O)+6]); CE_(V[(O)+3], V[(O)+7]); CE_(V[(O)+8], V[(O)+12]); CE_(V[(O)+9], V[(O)+13]); CE_(V[(O)+10], V[(O)+14]); CE_(V[(O)+11], V[(O)+15]); CE_(V[(O)+0], V[(O)+2]); CE_(V[(O)+1], V[(O)+3]); CE_(V[(O)+4], V[(O)+6]); CE_(V[(O)+5], V[(O)+7]); CE_(V[(O)+8], V[(O)+10]); CE_(V[(O)+9], V[(O)+11]); CE_(V[(O)+12], V[(O)+14]); CE_(V[(O)+13], V[(O)+15]); CE_(V[(O)+0], V[(O)+1]); CE_(V[(O)+2], V[(O)+3]); CE_(V[(O)+4], V[(O)+5]); CE_(V[(O)+6], V[(O)+7]); CE_(V[(O)+8], V[(O)+9]); CE_(V[(O)+10], V[(O)+11]); CE_(V[(O)+12], V[(O)+13]); CE_(V[(O)+14], V[(O)+15]); } while (0)
namespace pg8 {
#define PG8_LAS __attribute__((address_space(3)))
typedef unsigned short bf16_t;
typedef short bf16x8 __attribute__((ext_vector_type(8)));
typedef float f32x4 __attribute__((ext_vector_type(4)));
typedef unsigned u32x4 __attribute__((ext_vector_type(4)));
constexpr int BM = 256, BK = 64, HALF = 128, HTB = HALF * BK * 2  , STAGE_BYTES = 8 * HTB, NXCD = 8, WGM = 8;

__host__ __device__ __forceinline__ int lds_byte(int r, int c) { const int st = (r >> 4) * 2 + (c >> 5), rr = r & 15, cc = c & 31, ob = rr * 64 + cc * 2; return st * 1024 + (ob ^ (((ob >> 9) & 1) << 5)); }
__host__ __device__ __forceinline__ void stage_rc(int b, int& R, int& C) { const int st = b / 1024, sb = b % 1024, swz = sb ^ (((sb >> 9) & 1) << 5); R = (st >> 1) * 16 + swz / 64; C = (st & 1) * 32 + (swz % 64) / 2; }
__host__ __device__ __forceinline__ int perm32(int rho) { const int n = rho >> 4, i = rho & 15; return 8 * (i >> 2) + 4 * n + (i & 3); }

struct Unit { int pm, pn; };
struct Gemm { const bf16_t* A; const bf16_t* Bt; int M, N, K; };

struct StaticOrder {
    int nM, nN, nwg, G, c;
    __host__ __device__ void init(int M, int N, int G_, int c_) { nM = M / BM; nN = N / BM; nwg = nM * nN; G = G_; c = c_; }
    __host__ __device__ bool next(int i, Unit& u) const {
        const long L = (long)i * G + c; if (L >= nwg) return false;
        int wgid = (int)L; { const int q = nwg / NXCD, r = nwg % NXCD, xcd = wgid % NXCD, off = wgid / NXCD; wgid = (xcd < r ? xcd * (q + 1) : r * (q + 1) + (xcd - r) * q) + off; }
        const int nig = WGM * nN, gid = wgid / nig, fm = gid * WGM, gsz = (nM - fm) < WGM ? (nM - fm) : WGM;
        u.pm = fm + ((wgid % nig) % gsz); u.pn = (wgid % nig) / gsz; return true;
    }
    __device__ __forceinline__ void a_ready(const Unit&) const {}
    __device__ __forceinline__ void done(const Unit&) const {}
};

__device__ __forceinline__ unsigned cvt_pk_bf16(float lo, float hi) { unsigned r; asm volatile("v_cvt_pk_bf16_f32 %0, %1, %2" : "=v"(r) : "v"(lo), "v"(hi)); return r; }
typedef float f32x2 __attribute__((ext_vector_type(2)));
__device__ __forceinline__ f32x2 gelu_pk(f32x2 v) {
    const f32x2 av = __builtin_elementwise_abs(v), d = av * 0.2316418882f + 1.0f;
    f32x2 t; t.x = __builtin_amdgcn_rcpf(d.x); t.y = __builtin_amdgcn_rcpf(d.y);
    f32x2 q = t * 0.5307027145f + (-0.7265760135f); q = q * t + 0.7107068705f; q = q * t + (-0.142248368f); q = q * t + 0.127414796f; q = q * t;
    const f32x2 s = (v * v) * (-0.72134752044f);
    f32x2 e; e.x = __builtin_amdgcn_exp2f(s.x); e.y = __builtin_amdgcn_exp2f(s.y);
    const f32x2 m = v * (q * e), r = v - m;
    f32x2 o; o.x = v.x < 0.f ? m.x : r.x; o.y = v.y < 0.f ? m.y : r.y; return o;
}

template <int ACT  > struct EpiBf16 {
    static constexpr bool PERM = true, AFTER_DRAIN = false; static_assert(ACT == 0 || ACT == 1, "EpiBf16: ACT is 0 (none) or 1 (gelu_pk)");
    bf16_t* O; int ldc; const float* bias; int split_cols; size_t split_stride; float scale0;
    __device__ __forceinline__ void operator()(const f32x4 (&acc)[2][2][4][2], const Unit& u, int wr, int wc, int fr, int fq) const {
        const int row0 = u.pm * BM + wr * 64 + fr; int colt = u.pn * BM; bf16_t* base = O;
        float sc = 1.f; if (split_cols) { const int t = colt / split_cols; base += (size_t)t * split_stride; colt -= t * split_cols; if (t == 0) sc = scale0; }
        const int col0 = colt + wc * 32 + 8 * fq, bcol0 = u.pn * BM + wc * 32 + 8 * fq;
        f32x4 bv[2][2];
#pragma unroll
        for (int bj = 0; bj < 2; ++bj)
#pragma unroll
            for (int n = 0; n < 2; ++n) bv[bj][n] = bias ? *(const f32x4*)(bias + bcol0 + bj * HALF + 4 * n) : (f32x4){0.f, 0.f, 0.f, 0.f};
#pragma unroll
        for (int ai = 0; ai < 2; ++ai)
#pragma unroll
            for (int m = 0; m < 4; ++m) { bf16_t* rowp = base + (size_t)(row0 + ai * HALF + m * 16) * ldc + col0;
#pragma unroll
                for (int bj = 0; bj < 2; ++bj) { f32x4 v0 = acc[ai][bj][m][0] + bv[bj][0], v1 = acc[ai][bj][m][1] + bv[bj][1];
                    if (ACT == 1) { f32x2 a = gelu_pk((f32x2){v0[0], v0[1]}), b = gelu_pk((f32x2){v0[2], v0[3]}), c = gelu_pk((f32x2){v1[0], v1[1]}), d = gelu_pk((f32x2){v1[2], v1[3]});
                        v0 = (f32x4){a.x, a.y, b.x, b.y}; v1 = (f32x4){c.x, c.y, d.x, d.y}; }
                    v0 = v0 * sc; v1 = v1 * sc; u32x4 w; w.x = cvt_pk_bf16(v0[0], v0[1]); w.y = cvt_pk_bf16(v0[2], v0[3]); w.z = cvt_pk_bf16(v1[0], v1[1]); w.w = cvt_pk_bf16(v1[2], v1[3]);
                    *(u32x4*)(rowp + bj * HALF) = w; } }
    }
};
template <class Epi, class Sched, bool ALIGN_EPI = false, bool SP2 = false>
__device__ __forceinline__ void gemm_phase(PG8_LAS unsigned char* lds, const Gemm g, const Sched& S, const Epi& E) {
    int tid = threadIdx.x; asm volatile("" : "+v"(tid));
    const int wid = __builtin_amdgcn_readfirstlane(tid >> 6), lane = tid & 63, wr = wid >> 2, wc = wid & 3, fr = lane & 15, fq = lane >> 4;
    const int K = g.K, nt = K / BK;
    unsigned voffA[2], voffB[2];
#pragma unroll
    for (int i = 0; i < 2; ++i) { int R, C; stage_rc(tid * 16 + i * 8192, R, C); const int Rb = Epi::PERM ? ((R & ~31) + perm32(R & 31)) : R;
        voffA[i] = (unsigned)(R * K + C) * 2u; voffB[i] = (unsigned)(Rb * K + C) * 2u; }
    const size_t kstep = (size_t)(BK * 2);
    const size_t hstep = (size_t)HALF * K * 2;
    const size_t tstep = 2 * hstep;
    const unsigned ldsw = (unsigned)wid * 1024u;
    const int aoff = lds_byte(wr * 64 + fr, fq * 8), boff = lds_byte(wc * 32 + fr, fq * 8);
#define PG8_SA(b, h) (((b) * 2 + (h)) * HTB)
#define PG8_SB(b, h) ((4 + (b) * 2 + (h)) * HTB)
#define PG8_STAGE(bufoff, gbase, voff) do { _Pragma("unroll") for (int _i = 0; _i < 2; ++_i) \
        __builtin_amdgcn_global_load_lds((const unsigned*)((const char*)(gbase) + (voff)[_i]), (PG8_LAS unsigned*)(lds + (bufoff) + ldsw + _i * 8192), 16, 0, 0); } while (0)
#define PG8_LDA(dst, b, h) do { _Pragma("unroll") for (int m = 0; m < 4; ++m) _Pragma("unroll") for (int k = 0; k < 2; ++k) dst[m][k] = *(const PG8_LAS bf16x8*)(lds + PG8_SA(b, h) + aoff + m * 2048 + k * 1024); } while (0)
#define PG8_LDB(dst, b, h) do { _Pragma("unroll") for (int n = 0; n < 2; ++n) _Pragma("unroll") for (int k = 0; k < 2; ++k) dst[n][k] = *(const PG8_LAS bf16x8*)(lds + PG8_SB(b, h) + boff + n * 2048 + k * 1024); } while (0)
#define PG8_MMA(ai, bj, At, Bt) do { __builtin_amdgcn_s_setprio(1); _Pragma("unroll") for (int m = 0; m < 4; ++m) _Pragma("unroll") for (int n = 0; n < 2; ++n) _Pragma("unroll") for (int k = 0; k < 2; ++k) \
        acc[ai][bj][m][n] = __builtin_amdgcn_mfma_f32_16x16x32_bf16(Bt[n][k], At[m][k], acc[ai][bj][m][n], 0, 0, 0); __builtin_amdgcn_s_setprio(0); } while (0)
#define PG8_WAIT_V(n) asm volatile("s_waitcnt vmcnt(" #n ")" ::: "memory")
#define PG8_WAIT_L(n) asm volatile("s_waitcnt lgkmcnt(" #n ")" ::: "memory")
#define PG8_BAR __builtin_amdgcn_s_barrier()
#define PG8_SCHED __builtin_amdgcn_sched_barrier(0)
    Unit cur, nxt; int ui = 0;
    if (!S.next(0, cur)) return;
    f32x4 acc[2][2][4][2];
#pragma unroll
    for (int a = 0; a < 2; ++a)
#pragma unroll
        for (int b = 0; b < 2; ++b)
#pragma unroll
            for (int m = 0; m < 4; ++m)
#pragma unroll
                for (int n = 0; n < 2; ++n) acc[a][b][m][n] = (f32x4){0.f, 0.f, 0.f, 0.f};
    bf16x8 At[4][2], B0[2][2], B1[2][2];
    const char* cA = (const char*)g.A + (size_t)cur.pm * tstep; const char* cB = (const char*)g.Bt + (size_t)cur.pn * tstep;
    S.a_ready(cur);
    if constexpr (SP2) {
        PG8_STAGE(PG8_SB(0, 0), cB, voffB); PG8_STAGE(PG8_SB(0, 1), cB + hstep, voffB); PG8_STAGE(PG8_SA(0, 0), cA, voffA); PG8_STAGE(PG8_SA(0, 1), cA + hstep, voffA);
        if (wr == 1) PG8_BAR;
        PG8_WAIT_V(2); PG8_BAR;
        PG8_STAGE(PG8_SB(1, 0), cB + kstep, voffB); PG8_STAGE(PG8_SA(1, 0), cA + kstep, voffA); PG8_STAGE(PG8_SB(1, 1), cB + hstep + kstep, voffB);
        PG8_WAIT_V(6); PG8_BAR;
    } else {
        PG8_STAGE(PG8_SB(0, 0), cB, voffB); PG8_STAGE(PG8_SA(0, 0), cA, voffA); PG8_STAGE(PG8_SB(0, 1), cB + hstep, voffB); PG8_STAGE(PG8_SA(0, 1), cA + hstep, voffA);
        if (wr == 1) PG8_BAR;
        PG8_WAIT_V(4); PG8_BAR;
        PG8_STAGE(PG8_SB(1, 0), cB + kstep, voffB); PG8_STAGE(PG8_SA(1, 0), cA + kstep, voffA); PG8_STAGE(PG8_SB(1, 1), cB + hstep + kstep, voffB);
        PG8_WAIT_V(6); PG8_BAR;
    }
    for (;;) {
        const bool has_next = S.next(ui + 1, nxt);
        const char* nA = has_next ? (const char*)g.A + (size_t)nxt.pm * tstep : cA; const char* nB = has_next ? (const char*)g.Bt + (size_t)nxt.pn * tstep : cB;
        for (int t = 0; t < nt; t += 2) {
            const bool last = (t == nt - 2);
            const char* a1 = cA + (size_t)(t + 1) * kstep;
            const char* a2 = last ? nA : cA + (size_t)(t + 2) * kstep; const char* b2 = last ? nB : cB + (size_t)(t + 2) * kstep;
            const char* a3 = a2 + kstep; const char* b3 = b2 + kstep;
            if (last && has_next) S.a_ready(nxt);
            if constexpr (SP2) {
            PG8_LDB(B0, 0, 0); PG8_LDB(B1, 0, 1); PG8_SCHED; PG8_LDA(At, 0, 0); PG8_STAGE(PG8_SA(1, 1), a1 + hstep, voffA);
            PG8_WAIT_V(8); PG8_WAIT_L(0); PG8_BAR; PG8_MMA(0, 0, At, B0); PG8_MMA(0, 1, At, B1); PG8_BAR; PG8_SCHED;
            PG8_LDA(At, 0, 1); PG8_STAGE(PG8_SB(0, 0), b2, voffB); PG8_STAGE(PG8_SB(0, 1), b2 + hstep, voffB); PG8_STAGE(PG8_SA(0, 0), a2, voffA);
            PG8_WAIT_V(8); PG8_WAIT_L(0); PG8_BAR; PG8_MMA(1, 0, At, B0); PG8_MMA(1, 1, At, B1); PG8_BAR; PG8_SCHED;
            PG8_LDB(B0, 1, 0); PG8_LDB(B1, 1, 1); PG8_SCHED; PG8_LDA(At, 1, 0); PG8_STAGE(PG8_SA(0, 1), a2 + hstep, voffA);
            PG8_WAIT_V(8); PG8_WAIT_L(0); PG8_BAR; PG8_MMA(0, 0, At, B0); PG8_MMA(0, 1, At, B1); PG8_BAR; PG8_SCHED;
            PG8_LDA(At, 1, 1); PG8_STAGE(PG8_SB(1, 0), b3, voffB); PG8_STAGE(PG8_SB(1, 1), b3 + hstep, voffB); PG8_STAGE(PG8_SA(1, 0), a3, voffA);
            PG8_WAIT_V(8); PG8_WAIT_L(0); PG8_BAR; PG8_MMA(1, 0, At, B0); PG8_MMA(1, 1, At, B1); PG8_BAR; PG8_SCHED;
            } else {
            PG8_LDB(B0, 0, 0); PG8_SCHED; PG8_LDA(At, 0, 0); PG8_STAGE(PG8_SA(1, 1), a1 + hstep, voffA);
            PG8_WAIT_L(8); PG8_BAR; PG8_WAIT_L(0); PG8_MMA(0, 0, At, B0); PG8_BAR; PG8_SCHED;
            PG8_LDB(B1, 0, 1); PG8_STAGE(PG8_SB(0, 0), b2, voffB);
            PG8_BAR; PG8_WAIT_L(0); PG8_MMA(0, 1, At, B1); PG8_BAR;
            PG8_LDA(At, 0, 1); PG8_STAGE(PG8_SA(0, 0), a2, voffA);
            PG8_BAR; PG8_WAIT_L(0); PG8_MMA(1, 0, At, B0); PG8_BAR; PG8_SCHED;
            PG8_STAGE(PG8_SB(0, 1), b2 + hstep, voffB);
            PG8_WAIT_V(6); PG8_BAR; PG8_MMA(1, 1, At, B1); PG8_BAR;
            PG8_LDB(B0, 1, 0); PG8_SCHED; PG8_LDA(At, 1, 0); PG8_STAGE(PG8_SA(0, 1), a2 + hstep, voffA);
            PG8_WAIT_L(8); PG8_BAR; PG8_WAIT_L(0); PG8_MMA(0, 0, At, B0); PG8_BAR; PG8_SCHED;
            PG8_LDB(B1, 1, 1); PG8_STAGE(PG8_SB(1, 0), b3, voffB);
            PG8_BAR; PG8_WAIT_L(0); PG8_MMA(0, 1, At, B1); PG8_BAR;
            PG8_LDA(At, 1, 1); PG8_STAGE(PG8_SA(1, 0), a3, voffA);
            PG8_BAR; PG8_WAIT_L(0); PG8_MMA(1, 0, At, B0); PG8_BAR; PG8_SCHED;
            PG8_STAGE(PG8_SB(1, 1), b3 + hstep, voffB);
            PG8_WAIT_V(6); PG8_BAR; PG8_MMA(1, 1, At, B1); PG8_BAR;
            }
        }
        if constexpr (ALIGN_EPI) { if (wr == 0) PG8_BAR; }
        if constexpr (!Epi::AFTER_DRAIN) { E(acc, cur, wr, wc, fr, fq); S.done(cur); }
        if (!has_next) break;
#pragma unroll
        for (int a = 0; a < 2; ++a)
#pragma unroll
            for (int b = 0; b < 2; ++b)
#pragma unroll
                for (int m = 0; m < 4; ++m)
#pragma unroll
                    for (int n = 0; n < 2; ++n) acc[a][b][m][n] = (f32x4){0.f, 0.f, 0.f, 0.f};
        cur = nxt; cA = nA; cB = nB; ++ui;
        if constexpr (ALIGN_EPI) { if (wr == 1) PG8_BAR; }
    }
    PG8_WAIT_V(0);
    if constexpr (!ALIGN_EPI) { if (wr == 0) PG8_BAR; }
    PG8_BAR;
    if constexpr (Epi::AFTER_DRAIN) { E.fused(acc, cur, wr, wc, fr, fq, lds, wid, lane); S.done(cur); }
#undef PG8_SA
#undef PG8_SB
#undef PG8_STAGE
#undef PG8_LDA
#undef PG8_LDB
#undef PG8_MMA
#undef PG8_WAIT_V
#undef PG8_WAIT_L
#undef PG8_BAR
#undef PG8_SCHED
}
}

#define LAS __attribute__((address_space(3)))
typedef unsigned short bf16_t;
typedef short bf16x8 __attribute__((ext_vector_type(8)));
typedef short s16x4 __attribute__((ext_vector_type(4)));
typedef float f32x4 __attribute__((ext_vector_type(4)));
typedef float f32x16 __attribute__((ext_vector_type(16)));
typedef unsigned u32x4 __attribute__((ext_vector_type(4)));
typedef unsigned u32x2 __attribute__((ext_vector_type(2)));

constexpr int DM = 1024;
constexpr int NP = 16 * 2048;
constexpr int NS = 8 * 64;
constexpr int NT = NP + NS;
constexpr int DIN = 2560;
constexpr int SKV = 2112;
constexpr float EPS = 1e-6f;
constexpr float LOG2E = 1.4426950408889634f;
constexpr float QSCALE = 0.125f * LOG2E;

constexpr long OUT_Y = 0;
constexpr long OUT_KP = 34078720L, OUT_VP = 50855936L, OUT_CONVP = 67633152L, OUT_KS = 67878912L, OUT_VS = 68141056L, OUT_CONVS = 68403200L, OUT_TOTAL = 68526080L;

constexpr size_t MiB = 1u << 20;
constexpr size_t WS_CTL = 0, CTL_BYTES = 1 * MiB;
constexpr size_t WS_WINT = 1 * MiB;
constexpr size_t WS_WOUTT = 6 * MiB;
constexpr size_t WS_WQT = 8 * MiB;
constexpr size_t WS_SK = 12 * MiB;
constexpr size_t WS_PU8 = 16 * MiB;
constexpr size_t WS_PV8 = 32 * MiB;
constexpr size_t WS_SCU = 48 * MiB;
constexpr size_t WS_SCV = 49 * MiB;
constexpr size_t WS_KS = 80 * MiB;
constexpr size_t WS_VS = 97 * MiB;
constexpr size_t WS_H = 114 * MiB;
constexpr size_t WS_A = 179 * MiB;
constexpr size_t WS_Q = 212 * MiB;
constexpr size_t WS_QP = 114 * MiB;
constexpr size_t WS_KP = 245 * MiB;
constexpr size_t WS_VP = 277 * MiB;
constexpr size_t WS_MIX = 309 * MiB;
constexpr size_t WS_H2 = 309 * MiB;
constexpr size_t WS_TK = 375 * MiB;
constexpr size_t WS_IDX = 408 * MiB;
constexpr size_t WS_GATE = 425 * MiB;
constexpr size_t WS_PACT = 114 * MiB;
constexpr size_t WS_COEF = 375 * MiB;
constexpr size_t WS_END = 442 * MiB;
static_assert(WS_H + (size_t)NT * 1024 * 2 <= WS_A && WS_A + (size_t)NT * 512 * 2 <= WS_Q && WS_Q + (size_t)NT * 512 * 2 <= WS_KP, "R1");
static_assert(WS_QP + (size_t)NT * 2048 * 2 <= WS_KP && WS_KP + (size_t)NP * 512 * 2 <= WS_VP && WS_VP + (size_t)NP * 512 * 2 <= WS_MIX, "ws map");
static_assert(WS_MIX + (size_t)NT * 1024 * 2 <= WS_TK && WS_TK + (size_t)NT * 256 * 4 <= WS_IDX && WS_IDX + (size_t)NT * 128 * 4 <= WS_GATE && WS_GATE + (size_t)NT * 128 * 4 <= WS_END, "ws map 2");
static_assert(WS_KS + (size_t)8 * SKV * 512 * 2 <= WS_VS && WS_VS + (size_t)8 * SKV * 512 * 2 <= WS_H, "ws map 3");

constexpr int RING_BYTES = 131072;
constexpr int BIAS_OFF = RING_BYTES;
constexpr int MISC_OFF = RING_BYTES + 5120;
constexpr int LDS_BYTES = MISC_OFF + 1024;

struct Params {
    const float* in[24];
    float* out;
    unsigned char* ws;
};

__device__ __forceinline__ unsigned cvtpk(float lo, float hi) { return pg8::cvt_pk_bf16(lo, hi); }
__device__ __forceinline__ float bflo(unsigned w) { return __uint_as_float(w << 16); }
__device__ __forceinline__ float bfhi(unsigned w) { return __uint_as_float(w & 0xffff0000u); }
__device__ __forceinline__ float wave_sum(float v) {
#pragma unroll
    for (int o = 1; o < 64; o <<= 1) v += __shfl_xor(v, o);
    return v;
}
typedef float f32x2 __attribute__((ext_vector_type(2)));
#define DPP_ADD(v, ctrl) v += __builtin_bit_cast(float, __builtin_amdgcn_update_dpp(0, __builtin_bit_cast(int, v), ctrl, 0xf, 0xf, true))
__device__ __forceinline__ float rl_f(float v, int l) { return __uint_as_float(__builtin_amdgcn_readlane(__float_as_uint(v), l)); }
__device__ __forceinline__ float wave_total(float v) {
    DPP_ADD(v, 0xB1); DPP_ADD(v, 0x4E); DPP_ADD(v, 0x141); DPP_ADD(v, 0x140);
    return (rl_f(v, 0) + rl_f(v, 16)) + (rl_f(v, 32) + rl_f(v, 48));
}
typedef __bf16 bf16x2_t __attribute__((ext_vector_type(2)));
__device__ __forceinline__ float dot2(unsigned a, unsigned b, float acc) {
    return __builtin_amdgcn_fdot2_f32_bf16(__builtin_bit_cast(bf16x2_t, a), __builtin_bit_cast(bf16x2_t, b), acc, false);
}
#define LDS_WAIT() asm volatile("s_waitcnt lgkmcnt(0)" ::: "memory")

#define XB_TMO      128
#define XB_XCNT(j)  (256  + 64 * (j))
#define XB_XSUB(j)  (1280 + 64 * (j))
#define XB_XGEN(j)  (2304 + 64 * (j))
#define XB_TOP      3328
#define XB_TOPGEN   3392
#define XCD_BAR_WORDS 3456
#define XB_SPIN_CAP (1u << 18)

__device__ __forceinline__ unsigned xb_ld(unsigned* p)              { return __hip_atomic_load(p, __ATOMIC_RELAXED, __HIP_MEMORY_SCOPE_AGENT); }
__device__ __forceinline__ unsigned xb_add(unsigned* p, unsigned v) { return __hip_atomic_fetch_add(p, v, __ATOMIC_RELAXED, __HIP_MEMORY_SCOPE_AGENT); }
__device__ __forceinline__ unsigned xb_xcc_id() { return (unsigned)__builtin_amdgcn_s_getreg((3 << 11) | 20) & 0xFu; }
#define XB_SPIN(cond, bar) do { unsigned _sp = 0; while (cond) { __builtin_amdgcn_s_sleep(1); \
    if ((++_sp & 255u) == 0u) { if (xb_ld(&(bar)[XB_TMO])) break; if (_sp > XB_SPIN_CAP) { atomicAdd(&(bar)[XB_TMO], 1u); break; } } } } while (0)

struct XcdBarrier {
    unsigned* bar; unsigned x;
    volatile LAS unsigned* st;
};

__device__ __forceinline__ XcdBarrier xcd_barrier_post(unsigned* bar, volatile LAS unsigned* st) {
    XcdBarrier b; b.bar = bar; b.x = xb_xcc_id(); b.st = st;
    if (threadIdx.x == 0) (void)xb_add(&bar[XB_XCNT(b.x)], 1u);
    return b;
}
__device__ __forceinline__ void xcd_barrier_complete(unsigned* bar, unsigned x, unsigned& nloc, unsigned& nx) {
    const unsigned G = gridDim.x * gridDim.y * gridDim.z;
    unsigned sum, cnt, mine, sp = 0u;
    for (;;) {
        sum = 0u; cnt = 0u; mine = 0u;
#pragma unroll
        for (unsigned j = 0; j < 16; ++j) { const unsigned c = xb_ld(&bar[XB_XCNT(j)]); sum += c; cnt += (c > 0u) ? 1u : 0u; mine = (j == x) ? c : mine; }
        if (sum == G) break;
        __builtin_amdgcn_s_sleep(1);
        if ((++sp & 255u) == 0u) { if (xb_ld(&bar[XB_TMO])) break; if (sp > XB_SPIN_CAP) { atomicAdd(&bar[XB_TMO], 1u); break; } }
    }
    nloc = mine > 0u ? mine : 1u; nx = cnt > 0u ? cnt : 1u;
}

__device__ __forceinline__ void xcd_barrier(const XcdBarrier& b) {
    asm volatile("s_waitcnt vmcnt(0)" ::: "memory");
    __syncthreads();
    if (threadIdx.x == 0) {
        unsigned* bar = b.bar;
        __builtin_amdgcn_s_waitcnt(0);
        unsigned nloc = b.st[0], nx = b.st[1];
        if (nloc == 0u) { xcd_barrier_complete(bar, b.x, nloc, nx); b.st[0] = nloc; b.st[1] = nx; }
        const unsigned old = xb_add(&bar[XB_XSUB(b.x)], 1u);
        const unsigned gen = old / nloc;
        if (old + 1u == (gen + 1u) * nloc) {
            __builtin_amdgcn_fence(__ATOMIC_RELEASE, "agent");
            asm volatile("s_waitcnt vmcnt(0)" ::: "memory");
            const unsigned og = xb_add(&bar[XB_TOP], 1u);
            const unsigned tg = og / nx;
            if (og + 1u == (tg + 1u) * nx) xb_add(&bar[XB_TOPGEN], 1u);
            else XB_SPIN(xb_ld(&bar[XB_TOPGEN]) == tg, bar);
            __builtin_amdgcn_fence(__ATOMIC_ACQUIRE, "agent");
            xb_add(&bar[XB_XGEN(b.x)], 1u);
            asm volatile("s_waitcnt vmcnt(0)" ::: "memory");
        } else {
            XB_SPIN(xb_ld(&bar[XB_XGEN(b.x)]) == gen, bar);
            __builtin_amdgcn_fence(__ATOMIC_ACQUIRE, "agent");
            asm volatile("s_waitcnt vmcnt(0)" ::: "memory");
        }
    }
    __syncthreads();
}


namespace pg8 {
__device__ __forceinline__ u32x2 pack4(f32x4 v) { u32x2 w; w.x = cvt_pk_bf16(v[0], v[1]); w.y = cvt_pk_bf16(v[2], v[3]); return w; }
struct EpiProj {
    static constexpr bool PERM = false, AFTER_DRAIN = false;
    bf16_t* A; bf16_t* Q; bf16_t* KP; bf16_t* VP; bf16_t* KS; bf16_t* VS; float* out;
    __device__ __forceinline__ void operator()(const f32x4 (&acc)[2][2][4][2], const Unit& u, int wr, int wc, int fr, int fq) const {
        const int pn = u.pn;
        const int row0 = u.pm * BM + wr * 64 + fr;
        if (pn < 4) {
#pragma unroll
            for (int ai = 0; ai < 2; ++ai)
#pragma unroll
                for (int m = 0; m < 4; ++m) {
                    const int row = row0 + ai * HALF + m * 16;
                    long toff = -1;
                    if (row < NP) { const int s = row & 2047; if (s >= 2018) toff = OUT_CONVP + ((long)(row >> 11) * 30 + (s - 2018)) * 512; }
                    else { const int rr = row - NP; const int i = rr & 63; if (i >= 34) toff = OUT_CONVS + ((long)(rr >> 6) * 30 + (i - 34)) * 512; }
#pragma unroll
                    for (int n = 0; n < 2; ++n) {
                        const int c = 128 * pn + 32 * wc + 16 * n + 4 * fq;
                        const f32x4 x = acc[ai][0][m][n], g = acc[ai][1][m][n];
                        f32x4 a;
#pragma unroll
                        for (int j = 0; j < 4; ++j) a[j] = x[j] / (1.f + __expf(-g[j]));
                        *(u32x2*)(A + (size_t)row * 512 + c) = pack4(a);
                        if (toff >= 0) *(f32x4*)(out + toff + c) = a;
                    }
                }
        } else {
            const int sec = (pn - 4) >> 1, colbase = ((pn - 4) & 1) * 256;
#pragma unroll
            for (int ai = 0; ai < 2; ++ai)
#pragma unroll
                for (int m = 0; m < 4; ++m) {
                    const int row = row0 + ai * HALF + m * 16;
                    const bool isp = row < NP; const int rr = row - NP;
                    bf16_t* bdst; float* fdst;
                    if (sec == 0) { bdst = Q + (size_t)row * 512; fdst = nullptr; }
                    else if (sec == 1) { bdst = isp ? KP + (size_t)row * 512 : KS + ((size_t)(rr >> 6) * SKV + 2048 + (rr & 63)) * 512; fdst = isp ? out + OUT_KP + (size_t)row * 512 : out + OUT_KS + (size_t)rr * 512; }
                    else { bdst = isp ? VP + (size_t)row * 512 : VS + ((size_t)(rr >> 6) * SKV + 2048 + (rr & 63)) * 512; fdst = isp ? out + OUT_VP + (size_t)row * 512 : out + OUT_VS + (size_t)rr * 512; }
#pragma unroll
                    for (int bj = 0; bj < 2; ++bj)
#pragma unroll
                        for (int n = 0; n < 2; ++n) {
                            const int col = colbase + 128 * bj + 32 * wc + 16 * n + 4 * fq;
                            const f32x4 v = acc[ai][bj][m][n];
                            if (sec == 0) { *(u32x2*)(bdst + col) = pack4(v * QSCALE); }
                            else { *(u32x2*)(bdst + col) = pack4(v); *(f32x4*)(fdst + col) = v; }
                        }
                }
        }
    }
};
struct EpiRes {
    static constexpr bool PERM = false, AFTER_DRAIN = false;
    const float* xp; const float* xs; float* out;
    __device__ __forceinline__ void operator()(const f32x4 (&acc)[2][2][4][2], const Unit& u, int wr, int wc, int fr, int fq) const {
        const int row0 = u.pm * BM + wr * 64 + fr;
#pragma unroll
        for (int ai = 0; ai < 2; ++ai)
#pragma unroll
            for (int m = 0; m < 4; ++m) {
                const int row = row0 + ai * HALF + m * 16;
                const float* xr = row < NP ? xp + (size_t)row * DM : xs + (size_t)(row - NP) * DM;
                float* orow = out + (size_t)row * DM;
#pragma unroll
                for (int bj = 0; bj < 2; ++bj)
#pragma unroll
                    for (int n = 0; n < 2; ++n) {
                        const int col = u.pn * BM + 128 * bj + 32 * wc + 16 * n + 4 * fq;
                        *(f32x4*)(orow + col) = *(const f32x4*)(xr + col) + acc[ai][bj][m][n];
                    }
            }
    }
};
}

__device__ __forceinline__ int winrow(int n) { return n < 1024 ? (256 * ((n & 511) >> 7) + 128 * (n >> 9) + (n & 127)) : n; }
template <bool WIN> __device__ __forceinline__ void transpose_item(const float* W, int K, int N, bf16_t* WT, LAS float* scr, int item, int lane) {
    const int nblk = N / 32, kb = item / nblk, nb = item % nblk, k0 = 64 * kb, n0 = 32 * nb;
#pragma unroll 8
    for (int i = 0; i < 32; ++i) { const int kk = 2 * i + (lane >> 5); scr[kk * 33 + (lane & 31)] = W[(size_t)(k0 + kk) * N + n0 + (lane & 31)]; }
    LDS_WAIT();
    const int c = lane & 7;
#pragma unroll
    for (int j = 0; j < 4; ++j) {
        const int n = (lane >> 3) + 8 * j; const LAS float* s = scr + (8 * c) * 33 + n;
        u32x4 o; o.x = cvtpk(s[0 * 33], s[1 * 33]); o.y = cvtpk(s[2 * 33], s[3 * 33]); o.z = cvtpk(s[4 * 33], s[5 * 33]); o.w = cvtpk(s[6 * 33], s[7 * 33]);
        const int dr = WIN ? winrow(n0 + n) : (n0 + n);
        *(u32x4*)(WT + (size_t)dr * K + k0 + 8 * c) = o;
    }
    LDS_WAIT();
}
__device__ __forceinline__ void cvt_stream(const float* src, bf16_t* dst, size_t n8, size_t gt, size_t ngt) {
    for (size_t i = gt; i < n8; i += ngt) {
        const f32x4 a = *(const f32x4*)(src + i * 8), b = *(const f32x4*)(src + i * 8 + 4);
        u32x4 o; o.x = cvtpk(a[0], a[1]); o.y = cvtpk(a[2], a[3]); o.z = cvtpk(b[0], b[1]); o.w = cvtpk(b[2], b[3]);
        *(u32x4*)(dst + i * 8) = o;
    }
}
__device__ __forceinline__ void cvt_cache(const float* src, bf16_t* dst, size_t gt, size_t ngt) {
    const size_t n8 = (size_t)8 * 2048 * 512 / 8;
    for (size_t i = gt; i < n8; i += ngt) {
        const size_t e = i * 8; const size_t row = e >> 9, col = e & 511; const size_t drow = (row >> 11) * SKV + (row & 2047);
        const f32x4 a = *(const f32x4*)(src + e), b = *(const f32x4*)(src + e + 4);
        u32x4 o; o.x = cvtpk(a[0], a[1]); o.y = cvtpk(a[2], a[3]); o.z = cvtpk(b[0], b[1]); o.w = cvtpk(b[2], b[3]);
        *(u32x4*)(dst + drow * 512 + col) = o;
    }
}
__device__ __forceinline__ void rms_row_bf16(const float* xrow, const float* g, bf16_t* orow, int lane) {
    const f32x4* xr = (const f32x4*)xrow + lane; const f32x4* gr = (const f32x4*)g + lane;
    f32x4 v[4]; float s = 0.f;
#pragma unroll
    for (int j = 0; j < 4; ++j) { v[j] = xr[64 * j]; s += (v[j][0] * v[j][0] + v[j][1] * v[j][1]) + (v[j][2] * v[j][2] + v[j][3] * v[j][3]); }
    const float rstd = 1.f / sqrtf(wave_sum(s) * (1.f / DM) + EPS);
    u32x2* o8 = (u32x2*)orow + lane;
#pragma unroll
    for (int j = 0; j < 4; ++j) { const f32x4 gg = gr[64 * j]; u32x2 w; w.x = cvtpk(v[j][0] * rstd * gg[0], v[j][1] * rstd * gg[1]); w.y = cvtpk(v[j][2] * rstd * gg[2], v[j][3] * rstd * gg[3]); o8[64 * j] = w; }
}

template <bool SLICED> __device__ __forceinline__ void cvt_row_fp8(const float* src, unsigned char* dst_base, int row, float* scale_out, int lane) {
    const f32x4* xr = (const f32x4*)src + lane;
    f32x4 v[4]; float am = 0.f;
#pragma unroll
    for (int j = 0; j < 4; ++j) { v[j] = xr[64 * j]; am = fmaxf(am, fmaxf(fmaxf(fabsf(v[j][0]), fabsf(v[j][1])), fmaxf(fabsf(v[j][2]), fabsf(v[j][3])))); }
#pragma unroll
    for (int o = 1; o < 64; o <<= 1) am = fmaxf(am, __shfl_xor(am, o));
    const float sc = am > 0.f ? am * (1.f / 448.f) : 1.f, inv = 1.f / sc;
#pragma unroll
    for (int j = 0; j < 4; ++j) {
        const int eb = 256 * j + 4 * lane;
        int w = __builtin_amdgcn_cvt_pk_fp8_f32(v[j][0] * inv, v[j][1] * inv, 0, false);
        w = __builtin_amdgcn_cvt_pk_fp8_f32(v[j][2] * inv, v[j][3] * inv, w, true);
        if (SLICED) *(int*)(dst_base + ((size_t)(eb >> 7) * 16384 + row) * 128 + (eb & 127)) = w;
        else *(int*)(dst_base + (size_t)row * DM + 16 * ((eb & 511) >> 3) + (eb & 7) + (eb >= 512 ? 8 : 0)) = w;
    }
    if (lane == 0) *scale_out = sc;
}

__device__ __forceinline__ void rms_row2_bf16(const float* xa, const float* xb, const float* g, bf16_t* oa, bf16_t* ob, int lane) {
    const f32x4* ra = (const f32x4*)xa + lane; const f32x4* rb = (const f32x4*)xb + lane; const f32x4* gr = (const f32x4*)g + lane;
    f32x4 va[4], vb[4]; float sa = 0.f, sb = 0.f;
#pragma unroll
    for (int j = 0; j < 4; ++j) { va[j] = ra[64 * j]; vb[j] = rb[64 * j]; }
#pragma unroll
    for (int j = 0; j < 4; ++j) { sa += (va[j][0] * va[j][0] + va[j][1] * va[j][1]) + (va[j][2] * va[j][2] + va[j][3] * va[j][3]); sb += (vb[j][0] * vb[j][0] + vb[j][1] * vb[j][1]) + (vb[j][2] * vb[j][2] + vb[j][3] * vb[j][3]); }
    const float ra_ = 1.f / sqrtf(wave_total(sa) * (1.f / DM) + EPS), rb_ = 1.f / sqrtf(wave_total(sb) * (1.f / DM) + EPS);
    u32x2* o8a = (u32x2*)oa + lane; u32x2* o8b = (u32x2*)ob + lane;
#pragma unroll
    for (int j = 0; j < 4; ++j) { const f32x4 gg = gr[64 * j];
        u32x2 w; w.x = cvtpk(va[j][0] * ra_ * gg[0], va[j][1] * ra_ * gg[1]); w.y = cvtpk(va[j][2] * ra_ * gg[2], va[j][3] * ra_ * gg[3]); o8a[64 * j] = w;
        u32x2 z; z.x = cvtpk(vb[j][0] * rb_ * gg[0], vb[j][1] * rb_ * gg[1]); z.y = cvtpk(vb[j][2] * rb_ * gg[2], vb[j][3] * rb_ * gg[3]); o8b[64 * j] = z; }
}
__device__ __forceinline__ void phase0(const Params& p, LAS unsigned char* lds, int tid, int lane, int wave) {
    const int gw = blockIdx.x * 8 + wave, NGW = gridDim.x * 8;
    LAS float* scr = (LAS float*)(lds + wave * 16384);
    bf16_t* WINT = (bf16_t*)(p.ws + WS_WINT);
    constexpr int I_IN = 16 * (DIN / 32);
    for (int it = gw; it < I_IN; it += NGW) transpose_item<true>(p.in[6], 1024, DIN, WINT, scr, it, lane);
    bf16_t* H = (bf16_t*)(p.ws + WS_H);
    for (int m = gw; m < NT; m += 2 * NGW) {
        const int m2 = m + NGW < NT ? m + NGW : m;
        const float* xr = m < NP ? p.in[0] + (size_t)m * DM : p.in[1] + (size_t)(m - NP) * DM;
        const float* xr2 = m2 < NP ? p.in[0] + (size_t)m2 * DM : p.in[1] + (size_t)(m2 - NP) * DM;
        rms_row2_bf16(xr, xr2, p.in[5], H + (size_t)m * DM, H + (size_t)m2 * DM, lane);
    }
}
__device__ __forceinline__ void prep_late(const Params& p, LAS unsigned char* lds, int tid, int lane, int wave, int rank, int nparts) {
    const int gw = rank * 8 + wave, NGW = nparts * 8;
    LAS float* scr = (LAS float*)(lds + wave * 16384);
    const size_t gt = (size_t)rank * 512 + tid, ngt = (size_t)nparts * 512;
    cvt_cache(p.in[2], (bf16_t*)(p.ws + WS_KS), gt, ngt);
    cvt_cache(p.in[3], (bf16_t*)(p.ws + WS_VS), gt, ngt);
    bf16_t* WOUTT = (bf16_t*)(p.ws + WS_WOUTT); bf16_t* WQT = (bf16_t*)(p.ws + WS_WQT);
    constexpr int I_OUT = 16 * (1024 / 32), I_Q = 16 * (2048 / 32);
    for (int it = gw; it < I_OUT + I_Q; it += NGW) {
        if (it < I_OUT) transpose_item<false>(p.in[17], 1024, 1024, WOUTT, scr, it, lane);
        else transpose_item<false>(p.in[19], 1024, 2048, WQT, scr, it - I_OUT, lane);
    }
    cvt_stream(p.in[20], (bf16_t*)(p.ws + WS_SK), (size_t)16 * 128 * 128 / 8, gt, ngt);
    for (int r = gw; r < 2 * 16384; r += NGW) {
        const int tb = r >> 14, e = r & 16383;
        if (tb) cvt_row_fp8<true>(p.in[22] + (size_t)e * DM, p.ws + WS_PV8, e, (float*)(p.ws + WS_SCV) + e, lane);
        else cvt_row_fp8<true>(p.in[21] + (size_t)e * DM, p.ws + WS_PU8, e, (float*)(p.ws + WS_SCU) + e, lane);
    }
}

namespace att {
constexpr int KPITCH = 272, VPITCH = 320;
constexpr int L_KV = 0, KV_BYTES = 64 * KPITCH + 64 * VPITCH  , L_X = 0  , L_BIAS = BIAS_OFF, L_CA = 0  , L_CW = 94 * 1024  ;
static_assert(4 * 4096 * 4 <= 2 * KV_BYTES && 2 * KV_BYTES <= L_CW && L_CW + 31 * 1024 <= RING_BYTES, "attention LDS map");

__device__ __forceinline__ int rel_bucket(int rel) {
    const int ret = rel > 0 ? 16 : 0; const int n = rel < 0 ? -rel : rel; int v;
    if (n < 8) v = n; else if (n < 12) v = 8; else if (n < 16) v = 9; else if (n < 23) v = 10; else if (n < 32) v = 11;
    else if (n < 46) v = 12; else if (n < 64) v = 13; else if (n < 91) v = 14; else v = 15;
    return ret + v;
}
typedef short v4i16_t __attribute__((ext_vector_type(4)));
__device__ __forceinline__ s16x4 vtr(const LAS unsigned char* p) { return __builtin_bit_cast(s16x4, __builtin_amdgcn_ds_read_tr16_b64_v4i16((LAS v4i16_t*)p)); }
__device__ __forceinline__ f32x16 mfma32(bf16x8 a, bf16x8 b, f32x16 c) { return __builtin_amdgcn_mfma_f32_32x32x16_bf16(a, b, c, 0, 0, 0); }

__device__ __forceinline__ void attn_unit(const Params& p, LAS unsigned char* lds, int kind, int bb, int h, int qblk, float lam, int tid, int lane, int wid) {
    const bf16_t* Q = (const bf16_t*)(p.ws + WS_Q);
    const bf16_t* Kb = kind == 0 ? (const bf16_t*)(p.ws + WS_KP) + (size_t)bb * 2048 * 512 + h * 128 : (const bf16_t*)(p.ws + WS_KS) + (size_t)bb * SKV * 512 + h * 128;
    const bf16_t* Vb = kind == 0 ? (const bf16_t*)(p.ws + WS_VP) + (size_t)bb * 2048 * 512 + h * 128 : (const bf16_t*)(p.ws + WS_VS) + (size_t)bb * SKV * 512 + h * 128;
    bf16_t* MIX = (bf16_t*)(p.ws + WS_MIX);
    const int qrow0 = kind == 0 ? bb * 2048 + qblk * 128 : NP + bb * 64;
    const int qpos0 = kind == 0 ? qblk * 128 : 2048;
    const int ntiles = kind == 0 ? 2 * qblk + 2 : 33;
    const int rg = wid & 3, map = wid >> 2, r32 = lane & 31, hi = lane >> 5;
    const bool active = kind == 0 ? true : (rg < 2);
    const int cw = kind == 0 ? 2 * qblk + (rg >> 1) : 32;
    const int qw0 = qpos0 + 32 * rg;
    const int qabs = qw0 + r32;

    bf16x8 qf[4];
    if (active) {
        const bf16_t* qp = Q + (size_t)(qrow0 + 32 * rg + r32) * 512 + h * 128 + map * 64 + 8 * hi;
#pragma unroll
        for (int s = 0; s < 4; ++s) qf[s] = *(const bf16x8*)(qp + 16 * s);
    } else {
#pragma unroll
        for (int s = 0; s < 4; ++s) qf[s] = (bf16x8){0, 0, 0, 0, 0, 0, 0, 0};
    }
    float m = 0.f, l = 0.f;
    f32x16 negm;
#pragma unroll
    for (int r = 0; r < 16; ++r) negm[r] = 0.f;
    f32x16 o[4];
#pragma unroll
    for (int mt = 0; mt < 4; ++mt)
#pragma unroll
        for (int r = 0; r < 16; ++r) o[mt][r] = 0.f;

    const int srow0 = tid >> 4, sch = tid & 15;
    const LAS float* btab = (const LAS float*)(lds + L_BIAS) + h * 320;
    const int vlane = (4 * hi + ((lane & 15) >> 2)) * VPITCH + (16 * ((lane >> 4) & 1) + 4 * (lane & 3)) * 2;
    u32x4 kA[2], vA[2], kB[2], vB[2];
#define ATT_LOAD(KR, VR, T) do { _Pragma("unroll") for (int i_ = 0; i_ < 2; ++i_) { const size_t off_ = (size_t)((T) * 64 + srow0 + 32 * i_) * 512 + sch * 8; KR[i_] = *(const u32x4*)(Kb + off_); VR[i_] = *(const u32x4*)(Vb + off_); } } while (0)
#define ATT_STORE(KR, VR, BUF) do { _Pragma("unroll") for (int i_ = 0; i_ < 2; ++i_) { \
        *(LAS u32x4*)(lds + L_KV + (BUF) * KV_BYTES + (srow0 + 32 * i_) * KPITCH + sch * 16) = KR[i_]; \
        *(LAS u32x4*)(lds + L_KV + (BUF) * KV_BYTES + 64 * KPITCH + (srow0 + 32 * i_) * VPITCH + sch * 16) = VR[i_]; } } while (0)
    auto compute = [&](int t, int buf) {
        const LAS unsigned char* kbuf = lds + L_KV + buf * KV_BYTES;
        const LAS unsigned char* vbuf = kbuf + 64 * KPITCH;
        f32x16 p0, p1;
        const int kabs0 = t * 64;
        const LAS unsigned char* kb = kbuf + r32 * KPITCH + (map * 8 + hi) * 16;
        {
            const bf16x8 a0 = *(const LAS bf16x8*)(kb), a1 = *(const LAS bf16x8*)(kb + 32 * KPITCH);
            if (kabs0 + 63 - qw0 > -128) {
                const LAS float* bt = btab + (kabs0 - qabs + 256 + 4 * hi);
#pragma unroll
                for (int r = 0; r < 16; ++r) { p0[r] = bt[(r & 3) + 8 * (r >> 2)] - m; p1[r] = bt[32 + (r & 3) + 8 * (r >> 2)] - m; }
                p0 = mfma32(a0, qf[0], p0); p1 = mfma32(a1, qf[0], p1);
            } else { p0 = mfma32(a0, qf[0], negm); p1 = mfma32(a1, qf[0], negm); }
        }
#pragma unroll
        for (int s = 1; s < 4; ++s) {
            const bf16x8 a0 = *(const LAS bf16x8*)(kb + s * 32), a1 = *(const LAS bf16x8*)(kb + 32 * KPITCH + s * 32);
            p0 = mfma32(a0, qf[s], p0); p1 = mfma32(a1, qf[s], p1);
        }
        float mx = fmaxf(p0[0], p1[0]);
#pragma unroll
        for (int r = 1; r < 16; ++r) mx = fmaxf(mx, fmaxf(p0[r], p1[r]));
        { const auto rr = __builtin_amdgcn_permlane32_swap(__float_as_uint(mx), __float_as_uint(mx), false, false); mx = fmaxf(__uint_as_float(rr[0]), __uint_as_float(rr[1])); }
        if (__any(mx > 8.f)) {
            const float dl = fmaxf(mx, 0.f);
            m += dl;
            const float alpha = __builtin_amdgcn_exp2f(-dl);
            l *= alpha;
#pragma unroll
            for (int r = 0; r < 16; ++r) { p0[r] -= dl; p1[r] -= dl; negm[r] = -m; }
#pragma unroll
            for (int mt = 0; mt < 4; ++mt)
#pragma unroll
                for (int r = 0; r < 16; ++r) o[mt][r] *= alpha;
        }
        float rs = 0.f;
#pragma unroll
        for (int r = 0; r < 16; ++r) { p0[r] = __builtin_amdgcn_exp2f(p0[r]); p1[r] = __builtin_amdgcn_exp2f(p1[r]); rs += p0[r] + p1[r]; }
        l += rs;
#pragma unroll
        for (int t2 = 0; t2 < 2; ++t2)
#pragma unroll
            for (int s = 0; s < 2; ++s) {
                u32x4 bw;
                if (t2 == 0) { bw.x = cvtpk(p0[8 * s + 0], p0[8 * s + 1]); bw.y = cvtpk(p0[8 * s + 2], p0[8 * s + 3]); bw.z = cvtpk(p0[8 * s + 4], p0[8 * s + 5]); bw.w = cvtpk(p0[8 * s + 6], p0[8 * s + 7]); }
                else { bw.x = cvtpk(p1[8 * s + 0], p1[8 * s + 1]); bw.y = cvtpk(p1[8 * s + 2], p1[8 * s + 3]); bw.z = cvtpk(p1[8 * s + 4], p1[8 * s + 5]); bw.w = cvtpk(p1[8 * s + 6], p1[8 * s + 7]); }
                const bf16x8 B = __builtin_bit_cast(bf16x8, bw);
                const LAS unsigned char* vb = vbuf + vlane + (32 * t2 + 16 * s) * VPITCH;
#pragma unroll
                for (int mt = 0; mt < 4; ++mt) {
                    const s16x4 lo = vtr(vb + mt * 64), hi8 = vtr(vb + mt * 64 + 8 * VPITCH);
                    const bf16x8 A = (bf16x8){lo[0], lo[1], lo[2], lo[3], hi8[0], hi8[1], hi8[2], hi8[3]};
                    o[mt] = mfma32(A, B, o[mt]);
                }
            }
    };
    ATT_LOAD(kA, vA, 0);
    if (ntiles > 1) ATT_LOAD(kB, vB, 1);
    ATT_STORE(kA, vA, 0);
    if (ntiles > 2) ATT_LOAD(kA, vA, 2);
    __syncthreads();
    for (int t = 0; t < ntiles; t += 2) {
        if (t + 1 < ntiles) { ATT_STORE(kB, vB, 1); if (t + 3 < ntiles) ATT_LOAD(kB, vB, t + 3); }
        if (active && t <= cw) compute(t, 0);
        __syncthreads();
        if (t + 1 >= ntiles) break;
        if (t + 2 < ntiles) { ATT_STORE(kA, vA, 0); if (t + 4 < ntiles) ATT_LOAD(kA, vA, t + 4); }
        if (active && t + 1 <= cw) compute(t + 1, 1);
        __syncthreads();
    }
#undef ATT_LOAD
#undef ATT_STORE
    l += __shfl_xor(l, 32);
    const float inv = 1.f / l;
    LAS float* X = (LAS float*)(lds + L_X) + rg * 4096;
    if (active && map == 1) {
        const float sc = -lam * inv;
#pragma unroll
        for (int mt = 0; mt < 4; ++mt)
#pragma unroll
            for (int r = 0; r < 16; ++r) X[(mt * 16 + r) * 64 + lane] = o[mt][r] * sc;
    }
    __syncthreads();
    if (active && map == 0) {
        float ss = 0.f;
#pragma unroll
        for (int mt = 0; mt < 4; ++mt)
#pragma unroll
            for (int r = 0; r < 16; ++r) { const float v = o[mt][r] * inv + X[(mt * 16 + r) * 64 + lane]; o[mt][r] = v; ss += v * v; }
        ss += __shfl_xor(ss, 32);
        const float rsn = 0.8f / sqrtf(ss * (1.f / 128.f) + EPS);
        bf16_t* orow = MIX + (size_t)(qrow0 + 32 * rg + r32) * 1024 + 512 + h * 128;
        const float* sg = p.in[15];
#pragma unroll
        for (int mt = 0; mt < 4; ++mt)
#pragma unroll
            for (int g4 = 0; g4 < 4; ++g4) {
                const int e = 32 * mt + 8 * g4 + 4 * hi;
                const f32x4 gg = *(const f32x4*)(sg + e);
                u32x2 w; w.x = cvtpk(o[mt][4 * g4 + 0] * rsn * gg[0], o[mt][4 * g4 + 1] * rsn * gg[1]); w.y = cvtpk(o[mt][4 * g4 + 2] * rsn * gg[2], o[mt][4 * g4 + 3] * rsn * gg[3]);
                *(u32x2*)(orow + e) = w;
            }
    }
    __syncthreads();
}

__device__ __forceinline__ void unpack8(const u32x4 w, float (&f)[8]) { f[0] = bflo(w.x); f[1] = bfhi(w.x); f[2] = bflo(w.y); f[3] = bfhi(w.y); f[4] = bflo(w.z); f[5] = bfhi(w.z); f[6] = bflo(w.w); f[7] = bfhi(w.w); }
__device__ __forceinline__ void conv_unit(const Params& p, LAS unsigned char* lds, int cu, int tid, int lane, int wid) {
    const bf16_t* A = (const bf16_t*)(p.ws + WS_A);
    bf16_t* MIX = (bf16_t*)(p.ws + WS_MIX);
    const float* cb = p.in[8]; const float* lg = p.in[9]; const float* lb = p.in[10]; const float* st = p.in[4];
    const int row0 = cu * 64;
    const bool isp = row0 < NP;
    const int s0 = isp ? (row0 & 2047) : 0, rbase = row0 - s0, bd = isp ? 0 : ((row0 - NP) >> 6);
    for (int c = tid; c < 94 * 64; c += 512) {
        const int rr = c >> 6, ch = c & 63, sp = s0 - 30 + rr;
        u32x4 v = (u32x4){0u, 0u, 0u, 0u};
        if (sp >= 0) v = *(const u32x4*)(A + (size_t)(rbase + sp) * 512 + ch * 8);
        else if (!isp) { const float* sr = st + ((size_t)bd * 30 + (30 + sp)) * 512 + ch * 8; const f32x4 a0 = *(const f32x4*)sr, a1 = *(const f32x4*)(sr + 4);
            v.x = cvtpk(a0[0], a0[1]); v.y = cvtpk(a0[2], a0[3]); v.z = cvtpk(a1[0], a1[1]); v.w = cvtpk(a1[2], a1[3]); }
        *(LAS u32x4*)(lds + L_CA + rr * 1024 + ch * 16) = v;
    }
    __syncthreads();
    const int c0 = lane * 8;
    float bias8[8], g8[8], b8[8];
    { const f32x4 x0 = *(const f32x4*)(cb + c0), x1 = *(const f32x4*)(cb + c0 + 4), y0 = *(const f32x4*)(lg + c0), y1 = *(const f32x4*)(lg + c0 + 4), z0 = *(const f32x4*)(lb + c0), z1 = *(const f32x4*)(lb + c0 + 4);
#pragma unroll
      for (int q = 0; q < 4; ++q) { bias8[q] = x0[q]; bias8[4 + q] = x1[q]; g8[q] = y0[q]; g8[4 + q] = y1[q]; b8[q] = z0[q]; b8[4 + q] = z1[q]; } }
    for (int grp = 0; grp < 2; ++grp) {
        const int t0 = wid * 8 + grp * 4;
        float acc[4][8];
#pragma unroll
        for (int q = 0; q < 4; ++q)
#pragma unroll
            for (int c = 0; c < 8; ++c) acc[q][c] = bias8[c];
        const LAS unsigned char* ap = lds + L_CA + t0 * 1024 + lane * 16;
        const LAS unsigned char* wp = lds + L_CW + lane * 16;
#pragma unroll 1
        for (int j = 0; j < 31; ++j) {
            float w[8]; unpack8(*(const LAS u32x4*)(wp + j * 1024), w);
#pragma unroll
            for (int q = 0; q < 4; ++q) {
                float a[8]; unpack8(*(const LAS u32x4*)(ap + (j + q) * 1024), a);
#pragma unroll
                for (int c = 0; c < 8; ++c) acc[q][c] += w[c] * a[c];
            }
        }
#pragma unroll
        for (int q = 0; q < 4; ++q) {
            float sm = 0.f;
#pragma unroll
            for (int c = 0; c < 8; ++c) sm += acc[q][c];
            const float mu = wave_total(sm) * (1.f / 512.f);
            float sv = 0.f;
#pragma unroll
            for (int c = 0; c < 8; ++c) { acc[q][c] -= mu; sv += acc[q][c] * acc[q][c]; }
            const float rstd = 1.f / sqrtf(wave_total(sv) * (1.f / 512.f) + EPS);
            float y[8];
#pragma unroll
            for (int c = 0; c < 8; ++c) { y[c] = acc[q][c] * rstd * g8[c] + b8[c]; y[c] = y[c] / (1.f + __expf(-y[c])); }
            u32x4 w; w.x = cvtpk(y[0], y[1]); w.y = cvtpk(y[2], y[3]); w.z = cvtpk(y[4], y[5]); w.w = cvtpk(y[6], y[7]);
            *(u32x4*)(MIX + (size_t)(row0 + t0 + q) * 1024 + c0) = w;
        }
    }
}

constexpr int N_SAMPLE_UNITS = 32, N_PROMPT_UNITS = 1024, N_CONV_UNITS = NT / 64, N_UNITS = N_SAMPLE_UNITS + N_PROMPT_UNITS + N_CONV_UNITS;

__device__ __forceinline__ void phase2(const Params& p, LAS unsigned char* lds, int tid, int lane, int wid, int cidx, int mode) {
    LAS float* bt = (LAS float*)(lds + L_BIAS);
    for (int e = tid; e < 4 * 320; e += 512) { const int hh = e / 320, rel = (e % 320) - 256; bt[e] = (p.in[16][rel_bucket(rel) * 4 + hh] - p.in[16][15 * 4 + hh]) * LOG2E; }
    for (int c = tid; c < 31 * 64; c += 512) {
        const float* wr = p.in[7] + (size_t)c * 8; const f32x4 a0 = *(const f32x4*)wr, a1 = *(const f32x4*)(wr + 4);
        u32x4 v; v.x = cvtpk(a0[0], a0[1]); v.y = cvtpk(a0[2], a0[3]); v.z = cvtpk(a1[0], a1[1]); v.w = cvtpk(a1[2], a1[3]);
        *(LAS u32x4*)(lds + L_CW + c * 16) = v;
    }
    const float d1 = wave_sum(p.in[11][lane] * p.in[12][lane]), d2 = wave_sum(p.in[13][lane] * p.in[14][lane]);
    const float lam = expf(d1) - expf(d2) + 0.2f;
    unsigned* ctr = (unsigned*)(p.ws + WS_CTL) + 64 * cidx;
    volatile LAS unsigned* sw = (volatile LAS unsigned*)(lds + MISC_OFF);
    __syncthreads();
    for (;;) {
        __syncthreads();
        if (tid == 0) sw[0] = atomicAdd(ctr, 1u);
        __syncthreads();
        const int u = (int)sw[0];
        if (u >= N_UNITS) break;
        if (mode == 1 && u >= N_SAMPLE_UNITS + N_PROMPT_UNITS) continue;
        if (mode == 2 && u < N_SAMPLE_UNITS + N_PROMPT_UNITS) continue;
        int tid_ = tid; asm volatile("" : "+v"(tid_));
        if (u < N_SAMPLE_UNITS + N_PROMPT_UNITS) {
            const int v = u - N_SAMPLE_UNITS; const int bh = v & 63; const bool smp = u < N_SAMPLE_UNITS;
            attn_unit(p, lds, smp ? 1 : 0, smp ? (u >> 2) : (bh >> 2), smp ? (u & 3) : (bh & 3), smp ? 0 : 15 - (v >> 6), lam, tid_, tid_ & 63, wid);
        } else conv_unit(p, lds, u - N_SAMPLE_UNITS - N_PROMPT_UNITS, tid_, tid_ & 63, wid);
    }
}
}

template <class F> __device__ __forceinline__ void mini_gemm(const bf16_t* A, const bf16_t* Bt, int N, int lane, int wave, F epi) {
    const int ntasks = 16 * (N / 64), G = gridDim.x;
    const int fr = lane & 15, fq = lane >> 4;
    for (int task = wave * G + (int)blockIdx.x; task < ntasks; task += 8 * G) {
        const int rb = task & 15, cb = task >> 4;
        pg8::f32x4 acc[2][4];
#pragma unroll
        for (int m = 0; m < 2; ++m)
#pragma unroll
            for (int n = 0; n < 4; ++n) acc[m][n] = (pg8::f32x4){0.f, 0.f, 0.f, 0.f};
        const bf16_t* ap = A + (size_t)(rb * 32 + fr) * 1024 + 8 * fq;
        const bf16_t* bp = Bt + (size_t)(cb * 64 + fr) * 1024 + 8 * fq;
#pragma unroll 4
        for (int k0 = 0; k0 < 1024; k0 += 32) {
            const bf16x8 a0 = *(const bf16x8*)(ap + k0), a1 = *(const bf16x8*)(ap + 16 * 1024 + k0);
            bf16x8 b[4];
#pragma unroll
            for (int n = 0; n < 4; ++n) b[n] = *(const bf16x8*)(bp + (size_t)n * 16 * 1024 + k0);
#pragma unroll
            for (int n = 0; n < 4; ++n) { acc[0][n] = __builtin_amdgcn_mfma_f32_16x16x32_bf16(b[n], a0, acc[0][n], 0, 0, 0); acc[1][n] = __builtin_amdgcn_mfma_f32_16x16x32_bf16(b[n], a1, acc[1][n], 0, 0, 0); }
        }
#pragma unroll
        for (int m = 0; m < 2; ++m)
#pragma unroll
            for (int n = 0; n < 4; ++n) epi(rb * 32 + 16 * m + fr, cb * 64 + 16 * n + 4 * fq, acc[m][n]);
    }
}

__device__ __forceinline__ void phase3b(const Params& p, int lane, int wave) {
    const int gw = blockIdx.x * 8 + wave, NGW = gridDim.x * 8;
    bf16_t* H2 = (bf16_t*)(p.ws + WS_H2);
    for (int m = gw; m < NT; m += 2 * NGW) { const int m2 = m + NGW < NT ? m + NGW : m; rms_row2_bf16(p.out + (size_t)m * DM, p.out + (size_t)m2 * DM, p.in[18], H2 + (size_t)m * DM, H2 + (size_t)m2 * DM, lane); }
}

constexpr int P4B_KPITCH = 272, P4B_K_BYTES = 128 * P4B_KPITCH, P4B_Q_BYTES = 32 * P4B_KPITCH;
static_assert(P4B_K_BYTES + 8 * P4B_Q_BYTES <= RING_BYTES, "P4b LDS map");
__device__ __forceinline__ void phase4b(const Params& p, LAS unsigned char* lds, int tid, int lane, int wave) {
    const bf16_t* QP = (const bf16_t*)(p.ws + WS_QP); const bf16_t* SK = (const bf16_t*)(p.ws + WS_SK);
    float* TK = (float*)(p.ws + WS_TK);
    const int r32 = lane & 31, hi = lane >> 5;
    const int G = gridDim.x;
    for (int rp = blockIdx.x & 15; rp < 16; rp += (G < 16 ? G : 16)) {
        const int nbr = (G - rp + 15) >> 4, member = (int)blockIdx.x >> 4;
        __syncthreads();
        for (int c = tid; c < 128 * 16; c += 512) { const int row = c >> 4, ch = c & 15; *(LAS u32x4*)(lds + row * P4B_KPITCH + ch * 16) = *(const u32x4*)(SK + ((size_t)rp * 128 + row) * 128 + ch * 8); }
        __syncthreads();
        LAS unsigned char* qs = lds + P4B_K_BYTES + wave * P4B_Q_BYTES;
        for (int tg = member * 8 + wave; tg < NT / 32; tg += nbr * 8) {
            const int t0 = tg * 32;
#pragma unroll
            for (int i = 0; i < 8; ++i) { const int row = 4 * i + (lane >> 4), ch = lane & 15; *(LAS u32x4*)(qs + row * P4B_KPITCH + ch * 16) = *(const u32x4*)(QP + (size_t)(t0 + row) * 2048 + rp * 128 + ch * 8); }
            bf16x8 qf[8];
#pragma unroll
            for (int s = 0; s < 8; ++s) qf[s] = *(const LAS bf16x8*)(qs + r32 * P4B_KPITCH + (2 * s + hi) * 16);
            float v[64];
#pragma unroll
            for (int mt = 0; mt < 4; ++mt) {
                f32x16 S;
#pragma unroll
                for (int r = 0; r < 16; ++r) S[r] = 0.f;
                const LAS unsigned char* kp = lds + (32 * mt + r32) * P4B_KPITCH + hi * 16;
#pragma unroll
                for (int s = 0; s < 8; ++s) S = att::mfma32(*(const LAS bf16x8*)(kp + s * 32), qf[s], S);
#pragma unroll
                for (int r = 0; r < 16; ++r) { const int n = 32 * mt + (r & 3) + 8 * (r >> 2) + 4 * hi; v[mt * 16 + r] = __uint_as_float((__float_as_uint(S[r]) & ~127u) | (unsigned)(127 - n)); }
            }
            SORT16_DESC(v, 0); SORT16_DESC(v, 16); SORT16_DESC(v, 32); SORT16_DESC(v, 48);
#pragma unroll
            for (int i = 0; i < 16; ++i) { v[i] = fmaxf(v[i], v[31 - i]); v[32 + i] = fmaxf(v[32 + i], v[63 - i]); }
            BITONIC16_DESC(v, 0); BITONIC16_DESC(v, 32);
#pragma unroll
            for (int i = 0; i < 16; ++i) v[i] = fmaxf(v[i], v[47 - i]);
            BITONIC16_DESC(v, 0);
            float w[16];
#pragma unroll
            for (int i = 0; i < 16; ++i) w[i] = fmaxf(v[i], __shfl_xor(v[15 - i], 32));
            BITONIC16_DESC(w, 0);
            if (hi == 0) {
                f32x4* dst = (f32x4*)(TK + ((size_t)(t0 + r32) * 16 + rp) * 16);
#pragma unroll
                for (int q = 0; q < 4; ++q) dst[q] = (f32x4){w[4 * q], w[4 * q + 1], w[4 * q + 2], w[4 * q + 3]};
            }
        }
    }
}

__device__ __forceinline__ void phase5a(const Params& p, int tid) {
    const float* TK = (const float*)(p.ws + WS_TK);
    int* IDX = (int*)(p.ws + WS_IDX); float* GATE = (float*)(p.ws + WS_GATE);
    const float NEG_INF = -__builtin_huge_valf();
    for (int item = blockIdx.x * 512 + tid; item < NT * 8; item += gridDim.x * 512) {
        const int tok = item >> 3, r = item & 7;
        const f32x4* pa = (const f32x4*)(TK + ((size_t)tok * 16 + 2 * r) * 16);
        float a[16], b[16]; int ia[16], ib[16];
#pragma unroll
        for (int q = 0; q < 4; ++q) { const f32x4 x = pa[q], y = pa[4 + q];
#pragma unroll
            for (int j = 0; j < 4; ++j) { a[4 * q + j] = x[j]; b[4 * q + j] = y[j]; } }
#pragma unroll
        for (int i = 0; i < 16; ++i) { const unsigned ua = __float_as_uint(a[i]), ub = __float_as_uint(b[i]); ia[i] = 127 - (int)(ua & 127u); ib[i] = 127 - (int)(ub & 127u); a[i] = __uint_as_float(ua & ~127u); b[i] = __uint_as_float(ub & ~127u); }
        float cv[50]; int cid[50];
        {
            int c = 0;
#pragma unroll
            for (int i = 0; i < 16; ++i)
#pragma unroll
                for (int j = 0; j < 16; ++j)
                    if ((i + 1) * (j + 1) <= 16) { const float s = a[i] + b[j]; cv[c] = __uint_as_float((__float_as_uint(s) & ~63u) | (unsigned)(63 - c)); cid[c] = ia[i] * 128 + ib[j]; ++c; }
        }
        float best[16]; int bid[16];
#pragma unroll
        for (int it = 0; it < 16; ++it) {
            float mx = cv[0];
#pragma unroll
            for (int c = 1; c < 50; ++c) mx = fmaxf(mx, cv[c]);
            int id = 0;
#pragma unroll
            for (int c = 0; c < 50; ++c) { const bool hit = cv[c] == mx; id = hit ? cid[c] : id; cv[c] = hit ? NEG_INF : cv[c]; }
            best[it] = __uint_as_float(__float_as_uint(mx) & ~63u); bid[it] = id;
        }
        float e[16], sum = 0.f;
#pragma unroll
        for (int k = 0; k < 16; ++k) { e[k] = __expf(best[k] - best[0]); sum += e[k]; }
        const float rinv = 1.f / sum;
        int* io = IDX + (size_t)tok * 128 + r * 16; float* go = GATE + (size_t)tok * 128 + r * 16;
#pragma unroll
        for (int k = 0; k < 16; ++k) { io[k] = bid[k]; go[k] = e[k] * rinv; }
    }
}

__device__ __forceinline__ float gelu_erf(float x) { return 0.5f * x * (1.f + erff(x * 0.70710678118654752f)); }
__device__ __forceinline__ void fp8x16_to_f32(const u32x4 q, float (&f)[16]) {
    const f32x2 c0 = __builtin_amdgcn_cvt_pk_f32_fp8(q.x, false), c1 = __builtin_amdgcn_cvt_pk_f32_fp8(q.x, true), c2 = __builtin_amdgcn_cvt_pk_f32_fp8(q.y, false), c3 = __builtin_amdgcn_cvt_pk_f32_fp8(q.y, true);
    const f32x2 c4 = __builtin_amdgcn_cvt_pk_f32_fp8(q.z, false), c5 = __builtin_amdgcn_cvt_pk_f32_fp8(q.z, true), c6 = __builtin_amdgcn_cvt_pk_f32_fp8(q.w, false), c7 = __builtin_amdgcn_cvt_pk_f32_fp8(q.w, true);
    f[0] = c0.x; f[1] = c0.y; f[2] = c1.x; f[3] = c1.y; f[4] = c2.x; f[5] = c2.y; f[6] = c3.x; f[7] = c3.y;
    f[8] = c4.x; f[9] = c4.y; f[10] = c5.x; f[11] = c5.y; f[12] = c6.x; f[13] = c6.y; f[14] = c7.x; f[15] = c7.y;
}
__device__ __forceinline__ void slice_group(int& x, int& gwx, int& nwx, int wave) {
    x = blockIdx.x & 7; const int nbx = ((int)gridDim.x - x + 7) >> 3; gwx = ((int)blockIdx.x >> 3) * 8 + wave; nwx = nbx * 8;
}
__device__ __forceinline__ void phase5u(const Params& p, LAS unsigned char* lds, int lane, int wave) {
    int x, gwx, nwx; slice_group(x, gwx, nwx, wave);
    const unsigned char* PU8 = p.ws + WS_PU8 + (size_t)x * 16384 * 128;
    const bf16_t* H2 = (const bf16_t*)(p.ws + WS_H2) + 128 * x;
    const int* IDX = (const int*)(p.ws + WS_IDX); float* PACT = (float*)(p.ws + WS_PACT) + (size_t)x * NT * 128;
    LAS int* l_idx = (LAS int*)(lds + wave * 512);
    const int g = lane >> 3, sub = lane & 7;
    const unsigned char* rowp = PU8 + sub * 16;
    int r_idxA = 0, r_idxB = 0;
    u32x4 hA0, hA1, hB0, hB1; hA0 = hA1 = hB0 = hB1 = (u32x4){0u, 0u, 0u, 0u};
    u32x4 qA[16], qB[16];
#define P5U_LOADIDX(T) do { if ((T) < NT) { r_idxA = IDX[(size_t)(T) * 128 + lane]; r_idxB = IDX[(size_t)(T) * 128 + 64 + lane]; } } while (0)
#define P5U_ISSUE(Q, H0, H1, T) do { if ((T) < NT) { l_idx[lane] = r_idxA; l_idx[64 + lane] = r_idxB; \
        H0 = *(const u32x4*)(H2 + (size_t)(T) * DM + 16 * sub); H1 = *(const u32x4*)(H2 + (size_t)(T) * DM + 16 * sub + 8); \
        _Pragma("unroll") for (int q_ = 0; q_ < 4; ++q_) { const u32x4 iv = *(const LAS u32x4*)(l_idx + 16 * g + 4 * q_); \
            Q[4 * q_] = *(const u32x4*)(rowp + (size_t)iv.x * 128); Q[4 * q_ + 1] = *(const u32x4*)(rowp + (size_t)iv.y * 128); \
            Q[4 * q_ + 2] = *(const u32x4*)(rowp + (size_t)iv.z * 128); Q[4 * q_ + 3] = *(const u32x4*)(rowp + (size_t)iv.w * 128); } } } while (0)
#define P5U_COMPUTE(Q, H0, H1, T) do { \
        f32x2 hf[8]; \
        hf[0] = (f32x2){bflo(H0.x), bfhi(H0.x)}; hf[1] = (f32x2){bflo(H0.y), bfhi(H0.y)}; hf[2] = (f32x2){bflo(H0.z), bfhi(H0.z)}; hf[3] = (f32x2){bflo(H0.w), bfhi(H0.w)}; \
        hf[4] = (f32x2){bflo(H1.x), bfhi(H1.x)}; hf[5] = (f32x2){bflo(H1.y), bfhi(H1.y)}; hf[6] = (f32x2){bflo(H1.z), bfhi(H1.z)}; hf[7] = (f32x2){bflo(H1.w), bfhi(H1.w)}; \
        float resA = 0.f, resB = 0.f; \
        _Pragma("unroll") for (int i = 0; i < 16; ++i) { \
            f32x2 s2 = __builtin_amdgcn_cvt_pk_f32_fp8(Q[i].x, false) * hf[0]; \
            s2 = __builtin_elementwise_fma(__builtin_amdgcn_cvt_pk_f32_fp8(Q[i].x, true), hf[1], s2); \
            s2 = __builtin_elementwise_fma(__builtin_amdgcn_cvt_pk_f32_fp8(Q[i].y, false), hf[2], s2); \
            s2 = __builtin_elementwise_fma(__builtin_amdgcn_cvt_pk_f32_fp8(Q[i].y, true), hf[3], s2); \
            s2 = __builtin_elementwise_fma(__builtin_amdgcn_cvt_pk_f32_fp8(Q[i].z, false), hf[4], s2); \
            s2 = __builtin_elementwise_fma(__builtin_amdgcn_cvt_pk_f32_fp8(Q[i].z, true), hf[5], s2); \
            s2 = __builtin_elementwise_fma(__builtin_amdgcn_cvt_pk_f32_fp8(Q[i].w, false), hf[6], s2); \
            s2 = __builtin_elementwise_fma(__builtin_amdgcn_cvt_pk_f32_fp8(Q[i].w, true), hf[7], s2); \
            float sr = s2.x + s2.y; \
            DPP_ADD(sr, 0xB1); DPP_ADD(sr, 0x4E); DPP_ADD(sr, 0x141); \
            if (i < 8) resA = (sub == i) ? sr : resA; else resB = (sub == i - 8) ? sr : resB; } \
        PACT[(size_t)(T) * 128 + 16 * g + sub] = resA; PACT[(size_t)(T) * 128 + 16 * g + 8 + sub] = resB; } while (0)
    int tok = gwx;
    P5U_LOADIDX(tok);
    P5U_ISSUE(qA, hA0, hA1, tok);
    P5U_LOADIDX(tok + nwx);
    for (; tok < NT; tok += 2 * nwx) {
        P5U_ISSUE(qB, hB0, hB1, tok + nwx);
        P5U_LOADIDX(tok + 2 * nwx);
        P5U_COMPUTE(qA, hA0, hA1, tok);
        if (tok + nwx >= NT) break;
        P5U_ISSUE(qA, hA0, hA1, tok + 2 * nwx);
        P5U_LOADIDX(tok + 3 * nwx);
        P5U_COMPUTE(qB, hB0, hB1, tok + nwx);
    }
#undef P5U_LOADIDX
#undef P5U_ISSUE
#undef P5U_COMPUTE
}
__device__ __forceinline__ void phase5c(const Params& p, int tid) {
    const float* PACT = (const float*)(p.ws + WS_PACT); const float* SCU = (const float*)(p.ws + WS_SCU); const float* SCV = (const float*)(p.ws + WS_SCV);
    const int* IDX = (const int*)(p.ws + WS_IDX); const float* GATE = (const float*)(p.ws + WS_GATE); float* COEF = (float*)(p.ws + WS_COEF);
    const size_t n = (size_t)NT * 128, n4 = n / 4, stride = (size_t)gridDim.x * 512;
    for (size_t i0 = (size_t)blockIdx.x * 512 + tid; i0 < n4; i0 += 2 * stride) {
        f32x4 a[2], g[2]; u32x4 e[2]; f32x4 pa[2][8];
#pragma unroll
        for (int u = 0; u < 2; ++u) {
            const size_t it = (i0 + u * stride < n4 ? i0 + u * stride : i0) * 4;
#pragma unroll
            for (int xx = 0; xx < 8; ++xx) pa[u][xx] = *(const f32x4*)(PACT + (size_t)xx * n + it);
            e[u] = *(const u32x4*)(IDX + it); g[u] = *(const f32x4*)(GATE + it);
        }
        float su[2][4], sv[2][4];
#pragma unroll
        for (int u = 0; u < 2; ++u)
#pragma unroll
            for (int j = 0; j < 4; ++j) { su[u][j] = SCU[e[u][j]]; sv[u][j] = SCV[e[u][j]]; }
#pragma unroll
        for (int u = 0; u < 2; ++u) {
            a[u] = ((pa[u][0] + pa[u][1]) + (pa[u][2] + pa[u][3])) + ((pa[u][4] + pa[u][5]) + (pa[u][6] + pa[u][7]));
            f32x4 c;
#pragma unroll
            for (int j = 0; j < 4; ++j) c[j] = g[u][j] * gelu_erf(a[u][j] * su[u][j]) * sv[u][j];
            if (i0 + u * stride < n4) *(f32x4*)(COEF + (i0 + u * stride) * 4) = c;
        }
    }
}

constexpr int P5V_LDS_PER_WAVE = 1024 + 8 * 136 * 4;
__device__ __forceinline__ void phase5v(const Params& p, LAS unsigned char* lds, int lane, int wave) {
    int x, gwx, nwx; slice_group(x, gwx, nwx, wave);
    const unsigned char* PV8 = p.ws + WS_PV8 + (size_t)x * 16384 * 128;
    const int* IDX = (const int*)(p.ws + WS_IDX); const float* COEF = (const float*)(p.ws + WS_COEF);
    LAS int* l_idx = (LAS int*)(lds + wave * P5V_LDS_PER_WAVE); LAS float* l_cf = (LAS float*)(l_idx + 128); LAS float* red = l_cf + 128;
    const int g = lane >> 3, sub = lane & 7;
    const unsigned char* rowp = PV8 + sub * 16;
    const int c1 = 16 * (lane & 7) + (lane >> 3);
    int r_idxA = 0, r_idxB = 0; float r_cA = 0.f, r_cB = 0.f;
    u32x4 qA[16], qB[16]; f32x4 cfA[4], cfB[4]; float xA0 = 0.f, xA1 = 0.f, xB0 = 0.f, xB1 = 0.f;
#define P5V_LOADIDX(T) do { if ((T) < NT) { r_idxA = IDX[(size_t)(T) * 128 + lane]; r_idxB = IDX[(size_t)(T) * 128 + 64 + lane]; r_cA = COEF[(size_t)(T) * 128 + lane]; r_cB = COEF[(size_t)(T) * 128 + 64 + lane]; } } while (0)
#define P5V_ISSUE(Q, CF, X0, X1, T) do { if ((T) < NT) { l_idx[lane] = r_idxA; l_idx[64 + lane] = r_idxB; l_cf[lane] = r_cA; l_cf[64 + lane] = r_cB; \
        { const float* xr_ = p.out + (size_t)(T) * DM + 128 * x; X0 = xr_[c1]; X1 = xr_[c1 + 8]; } \
        _Pragma("unroll") for (int q_ = 0; q_ < 4; ++q_) { const u32x4 iv = *(const LAS u32x4*)(l_idx + 16 * g + 4 * q_); CF[q_] = *(const LAS f32x4*)(l_cf + 16 * g + 4 * q_); \
            Q[4 * q_] = *(const u32x4*)(rowp + (size_t)iv.x * 128); Q[4 * q_ + 1] = *(const u32x4*)(rowp + (size_t)iv.y * 128); \
            Q[4 * q_ + 2] = *(const u32x4*)(rowp + (size_t)iv.z * 128); Q[4 * q_ + 3] = *(const u32x4*)(rowp + (size_t)iv.w * 128); } } } while (0)
#define P5V_COMPUTE(Q, CF, X0, X1, T) do { \
        f32x2 acc[8]; \
        _Pragma("unroll") for (int j = 0; j < 8; ++j) acc[j] = (f32x2){0.f, 0.f}; \
        _Pragma("unroll") for (int i = 0; i < 16; ++i) { \
            const float cs_ = CF[i >> 2][i & 3]; const f32x2 c2 = (f32x2){cs_, cs_}; \
            acc[0] = __builtin_elementwise_fma(__builtin_amdgcn_cvt_pk_f32_fp8(Q[i].x, false), c2, acc[0]); \
            acc[1] = __builtin_elementwise_fma(__builtin_amdgcn_cvt_pk_f32_fp8(Q[i].x, true), c2, acc[1]); \
            acc[2] = __builtin_elementwise_fma(__builtin_amdgcn_cvt_pk_f32_fp8(Q[i].y, false), c2, acc[2]); \
            acc[3] = __builtin_elementwise_fma(__builtin_amdgcn_cvt_pk_f32_fp8(Q[i].y, true), c2, acc[3]); \
            acc[4] = __builtin_elementwise_fma(__builtin_amdgcn_cvt_pk_f32_fp8(Q[i].z, false), c2, acc[4]); \
            acc[5] = __builtin_elementwise_fma(__builtin_amdgcn_cvt_pk_f32_fp8(Q[i].z, true), c2, acc[5]); \
            acc[6] = __builtin_elementwise_fma(__builtin_amdgcn_cvt_pk_f32_fp8(Q[i].w, false), c2, acc[6]); \
            acc[7] = __builtin_elementwise_fma(__builtin_amdgcn_cvt_pk_f32_fp8(Q[i].w, true), c2, acc[7]); } \
        _Pragma("unroll") for (int j = 0; j < 8; ++j) { red[g * 136 + (2 * j) * 8 + sub] = acc[j].x; red[g * 136 + (2 * j + 1) * 8 + sub] = acc[j].y; } \
        float s1 = X0, s2_ = X1; \
        _Pragma("unroll") for (int gg = 0; gg < 8; ++gg) { s1 += red[gg * 136 + lane]; s2_ += red[gg * 136 + 64 + lane]; } \
        { float* xr_ = p.out + (size_t)(T) * DM + 128 * x; xr_[c1] = s1; xr_[c1 + 8] = s2_; } } while (0)
    int tok = gwx;
    P5V_LOADIDX(tok);
    P5V_ISSUE(qA, cfA, xA0, xA1, tok);
    P5V_LOADIDX(tok + nwx);
    for (; tok < NT; tok += 2 * nwx) {
        P5V_ISSUE(qB, cfB, xB0, xB1, tok + nwx);
        P5V_LOADIDX(tok + 2 * nwx);
        P5V_COMPUTE(qA, cfA, xA0, xA1, tok);
        if (tok + nwx >= NT) break;
        P5V_ISSUE(qA, cfA, xA0, xA1, tok + 2 * nwx);
        P5V_LOADIDX(tok + 3 * nwx);
        P5V_COMPUTE(qB, cfB, xB0, xB1, tok + nwx);
    }
#undef P5V_LOADIDX
#undef P5V_ISSUE
#undef P5V_COMPUTE
}

__device__ __forceinline__ void phase6(const Params& p, int lane, int wave) {
    const int gw = blockIdx.x * 8 + wave, NGW = gridDim.x * 8;
    const f32x4* gr = (const f32x4*)p.in[23] + lane;
    for (int m = gw; m < NT; m += 2 * NGW) {
        const bool two = m + NGW < NT;
        f32x4* xa = (f32x4*)(p.out + (size_t)m * DM) + lane; f32x4* xb = (f32x4*)(p.out + (size_t)(two ? m + NGW : m) * DM) + lane;
        f32x4 va[4], vb[4]; float sa = 0.f, sb = 0.f;
#pragma unroll
        for (int j = 0; j < 4; ++j) { va[j] = xa[64 * j]; vb[j] = xb[64 * j]; }
#pragma unroll
        for (int j = 0; j < 4; ++j) { sa += (va[j][0] * va[j][0] + va[j][1] * va[j][1]) + (va[j][2] * va[j][2] + va[j][3] * va[j][3]); sb += (vb[j][0] * vb[j][0] + vb[j][1] * vb[j][1]) + (vb[j][2] * vb[j][2] + vb[j][3] * vb[j][3]); }
        const float ra_ = 1.f / sqrtf(wave_total(sa) * (1.f / DM) + EPS), rb_ = 1.f / sqrtf(wave_total(sb) * (1.f / DM) + EPS);
#pragma unroll
        for (int j = 0; j < 4; ++j) { const f32x4 gg = gr[64 * j]; xa[64 * j] = va[j] * ra_ * gg; if (two) xb[64 * j] = vb[j] * rb_ * gg; }
    }
}

__global__ void __launch_bounds__(512, 2) fwd_megakernel(Params p) {
    extern __shared__ __attribute__((aligned(16))) unsigned char lds_raw[];
    LAS unsigned char* lds = (LAS unsigned char*)lds_raw;
    cg::grid_group grid = cg::this_grid();
    const int tid0 = threadIdx.x, wave = __builtin_amdgcn_readfirstlane(tid0 >> 6);
#define PHASE_IDS() int tid = tid0; asm volatile("" : "+v"(tid)); const int lane = tid & 63; (void)lane
    const int G = gridDim.x;
    volatile LAS unsigned* MISC = (volatile LAS unsigned*)(lds + MISC_OFF);
    if (tid0 < 32) MISC[tid0] = 0u;
    __syncthreads();
    XcdBarrier bar = xcd_barrier_post((unsigned*)(p.ws + WS_CTL) + 4096, MISC + 8);
#define GSYNC() xcd_barrier(bar)

#ifndef RPT_MASK
#define RPT_MASK 0
#endif
#if RPT_MASK
#define RPT(bit) for (int rpt_ = 0; rpt_ < (((RPT_MASK) >> (bit)) & 1) + 1; ++rpt_)
#else
#define RPT(bit) if (constexpr int rpt_ = 0; true)
#endif
    RPT(0) { PHASE_IDS(); phase0(p, lds, tid, lane, wave); grid.sync(); }
    RPT(1) {
        PHASE_IDS();
        pg8::Gemm g{(const bf16_t*)(p.ws + WS_H), (const bf16_t*)(p.ws + WS_WINT), NT, DIN, 1024};
        pg8::StaticOrder S; S.init(NT, DIN, G, (int)blockIdx.x);
        pg8::EpiProj E{(bf16_t*)(p.ws + WS_A), (bf16_t*)(p.ws + WS_Q), (bf16_t*)(p.ws + WS_KP), (bf16_t*)(p.ws + WS_VP), (bf16_t*)(p.ws + WS_KS), (bf16_t*)(p.ws + WS_VS), p.out};
        pg8::gemm_phase<pg8::EpiProj, pg8::StaticOrder, true, true>(lds, g, S, E);
        {
            const int nwg = (NT / 256) * (DIN / 256), rem = nwg % G, c = (int)blockIdx.x;
            if (rem == 0) prep_late(p, lds, tid, lane, wave, c, G);
            else if (c >= rem) prep_late(p, lds, tid, lane, wave, c - rem, G - rem);
        }
        GSYNC();
    }
    #ifndef P2MODE
#define P2MODE 0
#endif
    RPT(2) { PHASE_IDS(); att::phase2(p, lds, tid, lane, wave, rpt_, (((RPT_MASK) >> 2) & 1) && rpt_ == 0 ? P2MODE : 0); GSYNC(); }
    RPT(3) {
        PHASE_IDS();
        pg8::Gemm g{(const bf16_t*)(p.ws + WS_MIX), (const bf16_t*)(p.ws + WS_WOUTT), NP, 1024, 1024};
        pg8::StaticOrder S; S.init(NP, 1024, G, (int)blockIdx.x);
        pg8::EpiRes E{p.in[0], p.in[1], p.out};
        pg8::gemm_phase<pg8::EpiRes, pg8::StaticOrder, true, true>(lds, g, S, E);
        {
            const float* xs = p.in[1]; float* xo = p.out + (size_t)NP * DM;
            mini_gemm((const bf16_t*)(p.ws + WS_MIX) + (size_t)NP * DM, (const bf16_t*)(p.ws + WS_WOUTT), 1024, lane, wave,
                      [=](int row, int col, pg8::f32x4 v) { *(pg8::f32x4*)(xo + (size_t)row * DM + col) = *(const pg8::f32x4*)(xs + (size_t)row * DM + col) + v; });
        }
        GSYNC();
    }
    RPT(4) { PHASE_IDS(); phase3b(p, lane, wave); GSYNC(); }
    RPT(5) {
        PHASE_IDS();
        pg8::Gemm g{(const bf16_t*)(p.ws + WS_H2), (const bf16_t*)(p.ws + WS_WQT), NP, 2048, 1024};
        pg8::StaticOrder S; S.init(NP, 2048, G, (int)blockIdx.x);
        pg8::EpiBf16<0> E{(bf16_t*)(p.ws + WS_QP), 2048, nullptr, 0, 0, 1.f};
        pg8::gemm_phase<pg8::EpiBf16<0>, pg8::StaticOrder, true, true>(lds, g, S, E);
        {
            bf16_t* qo = (bf16_t*)(p.ws + WS_QP) + (size_t)NP * 2048;
            mini_gemm((const bf16_t*)(p.ws + WS_H2) + (size_t)NP * DM, (const bf16_t*)(p.ws + WS_WQT), 2048, lane, wave,
                      [=](int row, int col, pg8::f32x4 v) { *(u32x2*)(qo + (size_t)row * 2048 + col) = pg8::pack4(v); });
        }
        GSYNC();
    }
    RPT(6) { PHASE_IDS(); phase4b(p, lds, tid, lane, wave); GSYNC(); }
    RPT(7) { PHASE_IDS(); phase5a(p, tid); GSYNC(); }
    RPT(8) { PHASE_IDS(); phase5u(p, lds, lane, wave); GSYNC(); }
    RPT(9) { PHASE_IDS(); phase5c(p, tid); GSYNC(); }
    { PHASE_IDS(); phase5v(p, lds, lane, wave); }
    GSYNC();
    { PHASE_IDS(); phase6(p, lane, wave); }
}

extern "C" void kernel_launch(void* const* d_in, const int* in_sizes, int n_in, void* d_out, int out_size, void* d_ws, size_t ws_size, hipStream_t stream) {
    static int grid = 0;
    if (grid == 0) {
        if (n_in != 24 || out_size != (int)OUT_TOTAL || ws_size < WS_END) { fprintf(stderr, "kernel_launch: unexpected shapes: n_in %d out %d ws %zu (need %zu)\n", n_in, out_size, ws_size, (size_t)WS_END); grid = -1; return; }
        int dev = 0, cus = 0, per_cu = 0;
        (void)hipGetDevice(&dev);
        (void)hipDeviceGetAttribute(&cus, hipDeviceAttributeMultiprocessorCount, dev);
        if (hipFuncSetAttribute((const void*)fwd_megakernel, hipFuncAttributeMaxDynamicSharedMemorySize, LDS_BYTES) != hipSuccess) { fprintf(stderr, "kernel_launch: hipFuncSetAttribute failed\n"); grid = -1; return; }
        if (hipOccupancyMaxActiveBlocksPerMultiprocessor(&per_cu, (const void*)fwd_megakernel, 512, LDS_BYTES) != hipSuccess || per_cu < 1) { fprintf(stderr, "kernel_launch: occupancy query gave %d\n", per_cu); per_cu = 1; }
        (void)hipGetLastError();
        grid = cus * 1;
        if (per_cu < 1) grid = -1;
    }
    if (grid < 0) return;
    (void)hipMemsetAsync((char*)d_ws + WS_CTL, 0, CTL_BYTES, stream);
    Params p{};
    for (int i = 0; i < 24; ++i) p.in[i] = (const float*)d_in[i];
    p.out = (float*)d_out; p.ws = (unsigned char*)d_ws;
    void* args[] = {&p};
    hipError_t e = hipLaunchCooperativeKernel((const void*)fwd_megakernel, dim3(grid), dim3(512), args, LDS_BYTES, stream);
    if (e != hipSuccess) fprintf(stderr, "cooperative launch failed: %s (grid %d)\n", hipGetErrorString(e), grid);
}
```

```cpp
#include <hip/hip_runtime.h>
#include <hip/hip_cooperative_groups.h>
#include <cstdio>
#include <cstdint>
#include <cmath>
namespace cg = cooperative_groups;
#define CE_(a, b) do { const float t_ = fmaxf(a, b); b = fminf(a, b); a = t_; } while (0)
#define SORT16_DESC(V, O) do { CE_(V[(O)+0], V[(O)+1]); CE_(V[(O)+2], V[(O)+3]); CE_(V[(O)+0], V[(O)+2]); CE_(V[(O)+1], V[(O)+3]); CE_(V[(O)+1], V[(O)+2]); CE_(V[(O)+4], V[(O)+5]); CE_(V[(O)+6], V[(O)+7]); CE_(V[(O)+4], V[(O)+6]); CE_(V[(O)+5], V[(O)+7]); CE_(V[(O)+5], V[(O)+6]); CE_(V[(O)+0], V[(O)+4]); CE_(V[(O)+2], V[(O)+6]); CE_(V[(O)+2], V[(O)+4]); CE_(V[(O)+1], V[(O)+5]); CE_(V[(O)+3], V[(O)+7]); CE_(V[(O)+3], V[(O)+5]); CE_(V[(O)+1], V[(O)+2]); CE_(V[(O)+3], V[(O)+4]); CE_(V[(O)+5], V[(O)+6]); CE_(V[(O)+8], V[(O)+9]); CE_(V[(O)+10], V[(O)+11]); CE_(V[(O)+8], V[(O)+10]); CE_(V[(O)+9], V[(O)+11]); CE_(V[(O)+9], V[(O)+10]); CE_(V[(O)+12], V[(O)+13]); CE_(V[(O)+14], V[(O)+15]); CE_(V[(O)+12], V[(O)+14]); CE_(V[(O)+13], V[(O)+15]); CE_(V[(O)+13], V[(O)+14]); CE_(V[(O)+8], V[(O)+12]); CE_(V[(O)+10], V[(O)+14]); CE_(V[(O)+10], V[(O)+12]); CE_(V[(O)+9], V[(O)+13]); CE_(V[(O)+11], V[(O)+15]); CE_(V[(O)+11], V[(O)+13]); CE_(V[(O)+9], V[(O)+10]); CE_(V[(O)+11], V[(O)+12]); CE_(V[(O)+13], V[(O)+14]); CE_(V[(O)+0], V[(O)+8]); CE_(V[(O)+4], V[(O)+12]); CE_(V[(O)+4], V[(O)+8]); CE_(V[(O)+2], V[(O)+10]); CE_(V[(O)+6], V[(O)+14]); CE_(V[(O)+6], V[(O)+10]); CE_(V[(O)+2], V[(O)+4]); CE_(V[(O)+6], V[(O)+8]); CE_(V[(O)+10], V[(O)+12]); CE_(V[(O)+1], V[(O)+9]); CE_(V[(O)+5], V[(O)+13]); CE_(V[(O)+5], V[(O)+9]); CE_(V[(O)+3], V[(O)+11]); CE_(V[(O)+7], V[(O)+15]); CE_(V[(O)+7], V[(O)+11]); CE_(V[(O)+3], V[(O)+5]); CE_(V[(O)+7], V[(O)+9]); CE_(V[(O)+11], V[(O)+13]); CE_(V[(O)+1], V[(O)+2]); CE_(V[(O)+3], V[(O)+4]); CE_(V[(O)+5], V[(O)+6]); CE_(V[(O)+7], V[(O)+8]); CE_(V[(O)+9], V[(O)+10]); CE_(V[(O)+11], V[(O)+12]); CE_(V[(O)+13], V[(O)+14]); } while (0)
#define BITONIC16_DESC(V, O) do { CE_(V[(O)+0], V[(O)+8]); CE_(V[(O)+1], V[(O)+9]); CE_(V[(O)+2], V[(O)+10]); CE_(V[(O)+3], V[(O)+11]); CE_(V[(O)+4], V[(O)+12]); CE_(V[(O)+5], V[(O)+13]); CE_(V[(O)+6], V[(O)+14]); CE_(V[(O)+7], V[(O)+15]); CE_(V[(O)+0], V[(O)+4]); CE_(V[(O)+1], V[(O)+5]); CE_(V[(O)+2], V[(O)+6]); CE_(V[(O)+3], V[(O)+7]); CE_(V[(O)+8], V[(O)+12]); CE_(V[(O)+9], V[(O)+13]); CE_(V[(O)+10], V[(O)+14]); CE_(V[(O)+11], V[(O)+15]); CE_(V[(O)+0], V[(O)+2]); CE_(V[(O)+1], V[(O)+3]); CE_(V[(O)+4], V[(O)+6]); CE_(V[(O)+5], V[(O)+7]); CE_(V[(O)+8], V[(O)+10]); CE_(V[(O)+9], V[(O)+11]); CE_(V[(O)+12], V[(O)+14]); CE_(V[(O)+13], V[(O)+15]); CE_(V[(O)+0], V[(O)+1]); CE_(V[(O)+2], V[(O)+3]); CE_(V[(O)+4], V[(O)+5]); CE_(V[(O)+6], V[(O)+7]); CE_(V[(O)+8], V[(O)+9]); CE_(V[(O)+10], V[(O)+11]); CE_(V[(O)+12], V[(O)+13]); CE_(V[(O)+14], V[(O)+15]); } while (0)
namespace pg8 {
#define PG8_LAS __attribute__((address_space(3)))
typedef unsigned short bf16_t;
typedef short bf16x8 __attribute__((ext_vector_type(8)));
typedef float f32x4 __attribute__((ext_vector_type(4)));
typedef unsigned u32x4 __attribute__((ext_vector_type(4)));
constexpr int BM = 256, BK = 64, HALF = 128, HTB = HALF * BK * 2  , STAGE_BYTES = 8 * HTB, NXCD = 8, WGM = 8;

__host__ __device__ __forceinline__ int lds_byte(int r, int c) { const int st = (r >> 4) * 2 + (c >> 5), rr = r & 15, cc = c & 31, ob = rr * 64 + cc * 2; return st * 1024 + (ob ^ (((ob >> 9) & 1) << 5)); }
__host__ __device__ __forceinline__ void stage_rc(int b, int& R, int& C) { const int st = b / 1024, sb = b % 1024, swz = sb ^ (((sb >> 9) & 1) << 5); R = (st >> 1) * 16 + swz / 64; C = (st & 1) * 32 + (swz % 64) / 2; }
__host__ __device__ __forceinline__ int perm32(int rho) { const int n = rho >> 4, i = rho & 15; return 8 * (i >> 2) + 4 * n + (i & 3); }

struct Unit { int pm, pn; };
struct Gemm { const bf16_t* A; const bf16_t* Bt; int M, N, K; };

struct StaticOrder {
    int nM, nN, nwg, G, c;
    __host__ __device__ void init(int M, int N, int G_, int c_) { nM = M / BM; nN = N / BM; nwg = nM * nN; G = G_; c = c_; }
    __host__ __device__ bool next(int i, Unit& u) const {
        const long L = (long)i * G + c; if (L >= nwg) return false;
        int wgid = (int)L; { const int q = nwg / NXCD, r = nwg % NXCD, xcd = wgid % NXCD, off = wgid / NXCD; wgid = (xcd < r ? xcd * (q + 1) : r * (q + 1) + (xcd - r) * q) + off; }
        const int nig = WGM * nN, gid = wgid / nig, fm = gid * WGM, gsz = (nM - fm) < WGM ? (nM - fm) : WGM;
        u.pm = fm + ((wgid % nig) % gsz); u.pn = (wgid % nig) / gsz; return true;
    }
    __device__ __forceinline__ void a_ready(const Unit&) const {}
    __device__ __forceinline__ void done(const Unit&) const {}
};

__device__ __forceinline__ unsigned cvt_pk_bf16(float lo, float hi) { unsigned r; asm volatile("v_cvt_pk_bf16_f32 %0, %1, %2" : "=v"(r) : "v"(lo), "v"(hi)); return r; }
typedef float f32x2 __attribute__((ext_vector_type(2)));
__device__ __forceinline__ f32x2 gelu_pk(f32x2 v) {
    const f32x2 av = __builtin_elementwise_abs(v), d = av * 0.2316418882f + 1.0f;
    f32x2 t; t.x = __builtin_amdgcn_rcpf(d.x); t.y = __builtin_amdgcn_rcpf(d.y);
    f32x2 q = t * 0.5307027145f + (-0.7265760135f); q = q * t + 0.7107068705f; q = q * t + (-0.142248368f); q = q * t + 0.127414796f; q = q * t;
    const f32x2 s = (v * v) * (-0.72134752044f);
    f32x2 e; e.x = __builtin_amdgcn_exp2f(s.x); e.y = __builtin_amdgcn_exp2f(s.y);
    const f32x2 m = v * (q * e), r = v - m;
    f32x2 o; o.x = v.x < 0.f ? m.x : r.x; o.y = v.y < 0.f ? m.y : r.y; return o;
}

template <int ACT  > struct EpiBf16 {
    static constexpr bool PERM = true, AFTER_DRAIN = false; static_assert(ACT == 0 || ACT == 1, "EpiBf16: ACT is 0 (none) or 1 (gelu_pk)");
    bf16_t* O; int ldc; const float* bias; int split_cols; size_t split_stride; float scale0;
    __device__ __forceinline__ void operator()(const f32x4 (&acc)[2][2][4][2], const Unit& u, int wr, int wc, int fr, int fq) const {
        const int row0 = u.pm * BM + wr * 64 + fr; int colt = u.pn * BM; bf16_t* base = O;
        float sc = 1.f; if (split_cols) { const int t = colt / split_cols; base += (size_t)t * split_stride; colt -= t * split_cols; if (t == 0) sc = scale0; }
        const int col0 = colt + wc * 32 + 8 * fq, bcol0 = u.pn * BM + wc * 32 + 8 * fq;
        f32x4 bv[2][2];
#pragma unroll
        for (int bj = 0; bj < 2; ++bj)
#pragma unroll
            for (int n = 0; n < 2; ++n) bv[bj][n] = bias ? *(const f32x4*)(bias + bcol0 + bj * HALF + 4 * n) : (f32x4){0.f, 0.f, 0.f, 0.f};
#pragma unroll
        for (int ai = 0; ai < 2; ++ai)
#pragma unroll
            for (int m = 0; m < 4; ++m) { bf16_t* rowp = base + (size_t)(row0 + ai * HALF + m * 16) * ldc + col0;
#pragma unroll
                for (int bj = 0; bj < 2; ++bj) { f32x4 v0 = acc[ai][bj][m][0] + bv[bj][0], v1 = acc[ai][bj][m][1] + bv[bj][1];
                    if (ACT == 1) { f32x2 a = gelu_pk((f32x2){v0[0], v0[1]}), b = gelu_pk((f32x2){v0[2], v0[3]}), c = gelu_pk((f32x2){v1[0], v1[1]}), d = gelu_pk((f32x2){v1[2], v1[3]});
                        v0 = (f32x4){a.x, a.y, b.x, b.y}; v1 = (f32x4){c.x, c.y, d.x, d.y}; }
                    v0 = v0 * sc; v1 = v1 * sc; u32x4 w; w.x = cvt_pk_bf16(v0[0], v0[1]); w.y = cvt_pk_bf16(v0[2], v0[3]); w.z = cvt_pk_bf16(v1[0], v1[1]); w.w = cvt_pk_bf16(v1[2], v1[3]);
                    *(u32x4*)(rowp + bj * HALF) = w; } }
    }
};
template <class Epi, class Sched, bool ALIGN_EPI = false, bool SP2 = false>
__device__ __forceinline__ void gemm_phase(PG8_LAS unsigned char* lds, const Gemm g, const Sched& S, const Epi& E) {
    int tid = threadIdx.x; asm volatile("" : "+v"(tid));
    const int wid = __builtin_amdgcn_readfirstlane(tid >> 6), lane = tid & 63, wr = wid >> 2, wc = wid & 3, fr = lane & 15, fq = lane >> 4;
    const int K = g.K, nt = K / BK;
    unsigned voffA[2], voffB[2];
#pragma unroll
    for (int i = 0; i < 2; ++i) { int R, C; stage_rc(tid * 16 + i * 8192, R, C); const int Rb = Epi::PERM ? ((R & ~31) + perm32(R & 31)) : R;
        voffA[i] = (unsigned)(R * K + C) * 2u; voffB[i] = (unsigned)(Rb * K + C) * 2u; }
    const size_t kstep = (size_t)(BK * 2);
    const size_t hstep = (size_t)HALF * K * 2;
    const size_t tstep = 2 * hstep;
    const unsigned ldsw = (unsigned)wid * 1024u;
    const int aoff = lds_byte(wr * 64 + fr, fq * 8), boff = lds_byte(wc * 32 + fr, fq * 8);
#define PG8_SA(b, h) (((b) * 2 + (h)) * HTB)
#define PG8_SB(b, h) ((4 + (b) * 2 + (h)) * HTB)
#define PG8_STAGE(bufoff, gbase, voff) do { _Pragma("unroll") for (int _i = 0; _i < 2; ++_i) \
        __builtin_amdgcn_global_load_lds((const unsigned*)((const char*)(gbase) + (voff)[_i]), (PG8_LAS unsigned*)(lds + (bufoff) + ldsw + _i * 8192), 16, 0, 0); } while (0)
#define PG8_LDA(dst, b, h) do { _Pragma("unroll") for (int m = 0; m < 4; ++m) _Pragma("unroll") for (int k = 0; k < 2; ++k) dst[m][k] = *(const PG8_LAS bf16x8*)(lds + PG8_SA(b, h) + aoff + m * 2048 + k * 1024); } while (0)
#define PG8_LDB(dst, b, h) do { _Pragma("unroll") for (int n = 0; n < 2; ++n) _Pragma("unroll") for (int k = 0; k < 2; ++k) dst[n][k] = *(const PG8_LAS bf16x8*)(lds + PG8_SB(b, h) + boff + n * 2048 + k * 1024); } while (0)
#define PG8_MMA(ai, bj, At, Bt) do { __builtin_amdgcn_s_setprio(1); _Pragma("unroll") for (int m = 0; m < 4; ++m) _Pragma("unroll") for (int n = 0; n < 2; ++n) _Pragma("unroll") for (int k = 0; k < 2; ++k) \
        acc[ai][bj][m][n] = __builtin_amdgcn_mfma_f32_16x16x32_bf16(Bt[n][k], At[m][k], acc[ai][bj][m][n], 0, 0, 0); __builtin_amdgcn_s_setprio(0); } while (0)
#define PG8_WAIT_V(n) asm volatile("s_waitcnt vmcnt(" #n ")" ::: "memory")
#define PG8_WAIT_L(n) asm volatile("s_waitcnt lgkmcnt(" #n ")" ::: "memory")
#define PG8_BAR __builtin_amdgcn_s_barrier()
#define PG8_SCHED __builtin_amdgcn_sched_barrier(0)
    Unit cur, nxt; int ui = 0;
    if (!S.next(0, cur)) return;
    f32x4 acc[2][2][4][2];
#pragma unroll
    for (int a = 0; a < 2; ++a)
#pragma unroll
        for (int b = 0; b < 2; ++b)
#pragma unroll
            for (int m = 0; m < 4; ++m)
#pragma unroll
                for (int n = 0; n < 2; ++n) acc[a][b][m][n] = (f32x4){0.f, 0.f, 0.f, 0.f};
    bf16x8 At[4][2], B0[2][2], B1[2][2];
    const char* cA = (const char*)g.A + (size_t)cur.pm * tstep; const char* cB = (const char*)g.Bt + (size_t)cur.pn * tstep;
    S.a_ready(cur);
    if constexpr (SP2) {
        PG8_STAGE(PG8_SB(0, 0), cB, voffB); PG8_STAGE(PG8_SB(0, 1), cB + hstep, voffB); PG8_STAGE(PG8_SA(0, 0), cA, voffA); PG8_STAGE(PG8_SA(0, 1), cA + hstep, voffA);
        if (wr == 1) PG8_BAR;
        PG8_WAIT_V(2); PG8_BAR;
        PG8_STAGE(PG8_SB(1, 0), cB + kstep, voffB); PG8_STAGE(PG8_SA(1, 0), cA + kstep, voffA); PG8_STAGE(PG8_SB(1, 1), cB + hstep + kstep, voffB);
        PG8_WAIT_V(6); PG8_BAR;
    } else {
        PG8_STAGE(PG8_SB(0, 0), cB, voffB); PG8_STAGE(PG8_SA(0, 0), cA, voffA); PG8_STAGE(PG8_SB(0, 1), cB + hstep, voffB); PG8_STAGE(PG8_SA(0, 1), cA + hstep, voffA);
        if (wr == 1) PG8_BAR;
        PG8_WAIT_V(4); PG8_BAR;
        PG8_STAGE(PG8_SB(1, 0), cB + kstep, voffB); PG8_STAGE(PG8_SA(1, 0), cA + kstep, voffA); PG8_STAGE(PG8_SB(1, 1), cB + hstep + kstep, voffB);
        PG8_WAIT_V(6); PG8_BAR;
    }
    for (;;) {
        const bool has_next = S.next(ui + 1, nxt);
        const char* nA = has_next ? (const char*)g.A + (size_t)nxt.pm * tstep : cA; const char* nB = has_next ? (const char*)g.Bt + (size_t)nxt.pn * tstep : cB;
        for (int t = 0; t < nt; t += 2) {
            const bool last = (t == nt - 2);
            const char* a1 = cA + (size_t)(t + 1) * kstep;
            const char* a2 = last ? nA : cA + (size_t)(t + 2) * kstep; const char* b2 = last ? nB : cB + (size_t)(t + 2) * kstep;
            const char* a3 = a2 + kstep; const char* b3 = b2 + kstep;
            if (last && has_next) S.a_ready(nxt);
            if constexpr (SP2) {
            PG8_LDB(B0, 0, 0); PG8_LDB(B1, 0, 1); PG8_SCHED; PG8_LDA(At, 0, 0); PG8_STAGE(PG8_SA(1, 1), a1 + hstep, voffA);
            PG8_WAIT_V(8); PG8_WAIT_L(0); PG8_BAR; PG8_MMA(0, 0, At, B0); PG8_MMA(0, 1, At, B1); PG8_BAR; PG8_SCHED;
            PG8_LDA(At, 0, 1); PG8_STAGE(PG8_SB(0, 0), b2, voffB); PG8_STAGE(PG8_SB(0, 1), b2 + hstep, voffB); PG8_STAGE(PG8_SA(0, 0), a2, voffA);
            PG8_WAIT_V(8); PG8_WAIT_L(0); PG8_BAR; PG8_MMA(1, 0, At, B0); PG8_MMA(1, 1, At, B1); PG8_BAR; PG8_SCHED;
            PG8_LDB(B0, 1, 0); PG8_LDB(B1, 1, 1); PG8_SCHED; PG8_LDA(At, 1, 0); PG8_STAGE(PG8_SA(0, 1), a2 + hstep, voffA);
            PG8_WAIT_V(8); PG8_WAIT_L(0); PG8_BAR; PG8_MMA(0, 0, At, B0); PG8_MMA(0, 1, At, B1); PG8_BAR; PG8_SCHED;
            PG8_LDA(At, 1, 1); PG8_STAGE(PG8_SB(1, 0), b3, voffB); PG8_STAGE(PG8_SB(1, 1), b3 + hstep, voffB); PG8_STAGE(PG8_SA(1, 0), a3, voffA);
            PG8_WAIT_V(8); PG8_WAIT_L(0); PG8_BAR; PG8_MMA(1, 0, At, B0); PG8_MMA(1, 1, At, B1); PG8_BAR; PG8_SCHED;
            } else {
            PG8_LDB(B0, 0, 0); PG8_SCHED; PG8_LDA(At, 0, 0); PG8_STAGE(PG8_SA(1, 1), a1 + hstep, voffA);
            PG8_WAIT_L(8); PG8_BAR; PG8_WAIT_L(0); PG8_MMA(0, 0, At, B0); PG8_BAR; PG8_SCHED;
            PG8_LDB(B1, 0, 1); PG8_STAGE(PG8_SB(0, 0), b2, voffB);
            PG8_BAR; PG8_WAIT_L(0); PG8_MMA(0, 1, At, B1); PG8_BAR;
            PG8_LDA(At, 0, 1); PG8_STAGE(PG8_SA(0, 0), a2, voffA);
            PG8_BAR; PG8_WAIT_L(0); PG8_MMA(1, 0, At, B0); PG8_BAR; PG8_SCHED;
            PG8_STAGE(PG8_SB(0, 1), b2 + hstep, voffB);
            PG8_WAIT_V(6); PG8_BAR; PG8_MMA(1, 1, At, B1); PG8_BAR;
            PG8_LDB(B0, 1, 0); PG8_SCHED; PG8_LDA(At, 1, 0); PG8_STAGE(PG8_SA(0, 1), a2 + hstep, voffA);
            PG8_WAIT_L(8); PG8_BAR; PG8_WAIT_L(0); PG8_MMA(0, 0, At, B0); PG8_BAR; PG8_SCHED;
            PG8_LDB(B1, 1, 1); PG8_STAGE(PG8_SB(1, 0), b3, voffB);
            PG8_BAR; PG8_WAIT_L(0); PG8_MMA(0, 1, At, B1); PG8_BAR;
            PG8_LDA(At, 1, 1); PG8_STAGE(PG8_SA(1, 0), a3, voffA);
            PG8_BAR; PG8_WAIT_L(0); PG8_MMA(1, 0, At, B0); PG8_BAR; PG8_SCHED;
            PG8_STAGE(PG8_SB(1, 1), b3 + hstep, voffB);
            PG8_WAIT_V(6); PG8_BAR; PG8_MMA(1, 1, At, B1); PG8_BAR;
            }
        }
        if constexpr (ALIGN_EPI) { if (wr == 0) PG8_BAR; }
        if constexpr (!Epi::AFTER_DRAIN) { E(acc, cur, wr, wc, fr, fq); S.done(cur); }
        if (!has_next) break;
#pragma unroll
        for (int a = 0; a < 2; ++a)
#pragma unroll
            for (int b = 0; b < 2; ++b)
#pragma unroll
                for (int m = 0; m < 4; ++m)
#pragma unroll
                    for (int n = 0; n < 2; ++n) acc[a][b][m][n] = (f32x4){0.f, 0.f, 0.f, 0.f};
        cur = nxt; cA = nA; cB = nB; ++ui;
        if constexpr (ALIGN_EPI) { if (wr == 1) PG8_BAR; }
    }
    PG8_WAIT_V(0);
    if constexpr (!ALIGN_EPI) { if (wr == 0) PG8_BAR; }
    PG8_BAR;
    if constexpr (Epi::AFTER_DRAIN) { E.fused(acc, cur, wr, wc, fr, fq, lds, wid, lane); S.done(cur); }
#undef PG8_SA
#undef PG8_SB
#undef PG8_STAGE
#undef PG8_LDA
#undef PG8_LDB
#undef PG8_MMA
#undef PG8_WAIT_V
#undef PG8_WAIT_L
#undef PG8_BAR
#undef PG8_SCHED
}
}

#define LAS __attribute__((address_space(3)))
typedef unsigned short bf16_t;
typedef short bf16x8 __attribute__((ext_vector_type(8)));
typedef short s16x4 __attribute__((ext_vector_type(4)));
typedef float f32x4 __attribute__((ext_vector_type(4)));
typedef float f32x16 __attribute__((ext_vector_type(16)));
typedef unsigned u32x4 __attribute__((ext_vector_type(4)));
typedef unsigned u32x2 __attribute__((ext_vector_type(2)));

constexpr int DM = 1024;
constexpr int NP = 16 * 2048;
constexpr int NS = 8 * 64;
constexpr int NT = NP + NS;
constexpr int DIN = 2560;
constexpr int SKV = 2112;
constexpr float EPS = 1e-6f;
constexpr float LOG2E = 1.4426950408889634f;
constexpr float QSCALE = 0.125f * LOG2E;

constexpr long OUT_Y = 0;
constexpr long OUT_KP = 34078720L, OUT_VP = 50855936L, OUT_CONVP = 67633152L, OUT_KS = 67878912L, OUT_VS = 68141056L, OUT_CONVS = 68403200L, OUT_TOTAL = 68526080L;

constexpr size_t MiB = 1u << 20;
constexpr size_t WS_CTL = 0, CTL_BYTES = 1 * MiB;
constexpr size_t WS_WINT = 1 * MiB;
constexpr size_t WS_WOUTT = 6 * MiB;
constexpr size_t WS_WQT = 8 * MiB;
constexpr size_t WS_SK = 12 * MiB;
constexpr size_t WS_PU8 = 16 * MiB;
constexpr size_t WS_PV8 = 32 * MiB;
constexpr size_t WS_SCU = 48 * MiB;
constexpr size_t WS_SCV = 49 * MiB;
constexpr size_t WS_KS = 80 * MiB;
constexpr size_t WS_VS = 97 * MiB;
constexpr size_t WS_H = 114 * MiB;
constexpr size_t WS_A = 179 * MiB;
constexpr size_t WS_Q = 212 * MiB;
constexpr size_t WS_QP = 114 * MiB;
constexpr size_t WS_KP = 245 * MiB;
constexpr size_t WS_VP = 277 * MiB;
constexpr size_t WS_MIX = 309 * MiB;
constexpr size_t WS_H2 = 309 * MiB;
constexpr size_t WS_TK = 375 * MiB;
constexpr size_t WS_IDX = 408 * MiB;
constexpr size_t WS_GATE = 425 * MiB;
constexpr size_t WS_PACT = 114 * MiB;
constexpr size_t WS_COEF = 375 * MiB;
constexpr size_t WS_XG = 442 * MiB;
constexpr size_t WS_SSQ = 507 * MiB;
constexpr size_t WS_RSTD = 510 * MiB;
constexpr size_t WS_END = 511 * MiB;
static_assert(WS_H + (size_t)NT * 1024 * 2 <= WS_A && WS_A + (size_t)NT * 512 * 2 <= WS_Q && WS_Q + (size_t)NT * 512 * 2 <= WS_KP, "R1");
static_assert(WS_QP + (size_t)NT * 2048 * 2 <= WS_KP && WS_KP + (size_t)NP * 512 * 2 <= WS_VP && WS_VP + (size_t)NP * 512 * 2 <= WS_MIX, "ws map");
static_assert(WS_MIX + (size_t)NT * 1024 * 2 <= WS_TK && WS_TK + (size_t)NT * 256 * 4 <= WS_IDX && WS_IDX + (size_t)NT * 128 * 4 <= WS_GATE && WS_GATE + (size_t)NT * 128 * 4 <= WS_END, "ws map 2");
static_assert(WS_KS + (size_t)8 * SKV * 512 * 2 <= WS_VS && WS_VS + (size_t)8 * SKV * 512 * 2 <= WS_H, "ws map 3");

constexpr int RING_BYTES = 131072;
constexpr int BIAS_OFF = RING_BYTES;
constexpr int MISC_OFF = RING_BYTES + 5120;
constexpr int LDS_BYTES = MISC_OFF + 1024;

struct Params {
    const float* in[24];
    float* out;
    unsigned char* ws;
};

__device__ __forceinline__ unsigned cvtpk(float lo, float hi) { return pg8::cvt_pk_bf16(lo, hi); }
__device__ __forceinline__ float bflo(unsigned w) { return __uint_as_float(w << 16); }
__device__ __forceinline__ float bfhi(unsigned w) { return __uint_as_float(w & 0xffff0000u); }
__device__ __forceinline__ float wave_sum(float v) {
#pragma unroll
    for (int o = 1; o < 64; o <<= 1) v += __shfl_xor(v, o);
    return v;
}
typedef float f32x2 __attribute__((ext_vector_type(2)));
#define DPP_ADD(v, ctrl) v += __builtin_bit_cast(float, __builtin_amdgcn_update_dpp(0, __builtin_bit_cast(int, v), ctrl, 0xf, 0xf, true))
__device__ __forceinline__ float rl_f(float v, int l) { return __uint_as_float(__builtin_amdgcn_readlane(__float_as_uint(v), l)); }
__device__ __forceinline__ float wave_total(float v) {
    DPP_ADD(v, 0xB1); DPP_ADD(v, 0x4E); DPP_ADD(v, 0x141); DPP_ADD(v, 0x140);
    return (rl_f(v, 0) + rl_f(v, 16)) + (rl_f(v, 32) + rl_f(v, 48));
}
typedef __bf16 bf16x2_t __attribute__((ext_vector_type(2)));
__device__ __forceinline__ float dot2(unsigned a, unsigned b, float acc) {
    return __builtin_amdgcn_fdot2_f32_bf16(__builtin_bit_cast(bf16x2_t, a), __builtin_bit_cast(bf16x2_t, b), acc, false);
}
#define LDS_WAIT() asm volatile("s_waitcnt lgkmcnt(0)" ::: "memory")

#define XB_TMO      128
#define XB_XCNT(j)  (256  + 64 * (j))
#define XB_XSUB(j)  (1280 + 64 * (j))
#define XB_XGEN(j)  (2304 + 64 * (j))
#define XB_TOP      3328
#define XB_TOPGEN   3392
#define XCD_BAR_WORDS 3456
#define XB_SPIN_CAP (1u << 18)

__device__ __forceinline__ unsigned xb_ld(unsigned* p)              { return __hip_atomic_load(p, __ATOMIC_RELAXED, __HIP_MEMORY_SCOPE_AGENT); }
__device__ __forceinline__ unsigned xb_add(unsigned* p, unsigned v) { return __hip_atomic_fetch_add(p, v, __ATOMIC_RELAXED, __HIP_MEMORY_SCOPE_AGENT); }
__device__ __forceinline__ unsigned xb_xcc_id() { return (unsigned)__builtin_amdgcn_s_getreg((3 << 11) | 20) & 0xFu; }
#define XB_SPIN(cond, bar) do { unsigned _sp = 0; while (cond) { __builtin_amdgcn_s_sleep(1); \
    if ((++_sp & 255u) == 0u) { if (xb_ld(&(bar)[XB_TMO])) break; if (_sp > XB_SPIN_CAP) { atomicAdd(&(bar)[XB_TMO], 1u); break; } } } } while (0)

struct XcdBarrier {
    unsigned* bar; unsigned x;
    volatile LAS unsigned* st;
};

__device__ __forceinline__ XcdBarrier xcd_barrier_post(unsigned* bar, volatile LAS unsigned* st) {
    XcdBarrier b; b.bar = bar; b.x = xb_xcc_id(); b.st = st;
    if (threadIdx.x == 0) (void)xb_add(&bar[XB_XCNT(b.x)], 1u);
    return b;
}
__device__ __forceinline__ void xcd_barrier_complete(unsigned* bar, unsigned x, unsigned& nloc, unsigned& nx) {
    const unsigned G = gridDim.x * gridDim.y * gridDim.z;
    unsigned sum, cnt, mine, sp = 0u;
    for (;;) {
        sum = 0u; cnt = 0u; mine = 0u;
#pragma unroll
        for (unsigned j = 0; j < 16; ++j) { const unsigned c = xb_ld(&bar[XB_XCNT(j)]); sum += c; cnt += (c > 0u) ? 1u : 0u; mine = (j == x) ? c : mine; }
        if (sum == G) break;
        __builtin_amdgcn_s_sleep(1);
        if ((++sp & 255u) == 0u) { if (xb_ld(&bar[XB_TMO])) break; if (sp > XB_SPIN_CAP) { atomicAdd(&bar[XB_TMO], 1u); break; } }
    }
    nloc = mine > 0u ? mine : 1u; nx = cnt > 0u ? cnt : 1u;
}

__device__ __forceinline__ void xcd_barrier(const XcdBarrier& b) {
    asm volatile("s_waitcnt vmcnt(0)" ::: "memory");
    __syncthreads();
    if (threadIdx.x == 0) {
        unsigned* bar = b.bar;
        __builtin_amdgcn_s_waitcnt(0);
        unsigned nloc = b.st[0], nx = b.st[1];
        if (nloc == 0u) { xcd_barrier_complete(bar, b.x, nloc, nx); b.st[0] = nloc; b.st[1] = nx; }
        const unsigned old = xb_add(&bar[XB_XSUB(b.x)], 1u);
        const unsigned gen = old / nloc;
        if (old + 1u == (gen + 1u) * nloc) {
            __builtin_amdgcn_fence(__ATOMIC_RELEASE, "agent");
            asm volatile("s_waitcnt vmcnt(0)" ::: "memory");
            const unsigned og = xb_add(&bar[XB_TOP], 1u);
            const unsigned tg = og / nx;
            if (og + 1u == (tg + 1u) * nx) xb_add(&bar[XB_TOPGEN], 1u);
            else XB_SPIN(xb_ld(&bar[XB_TOPGEN]) == tg, bar);
            __builtin_amdgcn_fence(__ATOMIC_ACQUIRE, "agent");
            xb_add(&bar[XB_XGEN(b.x)], 1u);
            asm volatile("s_waitcnt vmcnt(0)" ::: "memory");
        } else {
            XB_SPIN(xb_ld(&bar[XB_XGEN(b.x)]) == gen, bar);
            __builtin_amdgcn_fence(__ATOMIC_ACQUIRE, "agent");
            asm volatile("s_waitcnt vmcnt(0)" ::: "memory");
        }
    }
    __syncthreads();
}


namespace pg8 {
__device__ __forceinline__ u32x2 pack4(f32x4 v) { u32x2 w; w.x = cvt_pk_bf16(v[0], v[1]); w.y = cvt_pk_bf16(v[2], v[3]); return w; }
struct EpiProj {
    static constexpr bool PERM = false, AFTER_DRAIN = false;
    bf16_t* A; bf16_t* Q; bf16_t* KP; bf16_t* VP; bf16_t* KS; bf16_t* VS; float* out;
    __device__ __forceinline__ void operator()(const f32x4 (&acc)[2][2][4][2], const Unit& u, int wr, int wc, int fr, int fq) const {
        const int pn = u.pn;
        const int row0 = u.pm * BM + wr * 64 + fr;
        if (pn < 4) {
#pragma unroll
            for (int ai = 0; ai < 2; ++ai)
#pragma unroll
                for (int m = 0; m < 4; ++m) {
                    const int row = row0 + ai * HALF + m * 16;
                    long toff = -1;
                    if (row < NP) { const int s = row & 2047; if (s >= 2018) toff = OUT_CONVP + ((long)(row >> 11) * 30 + (s - 2018)) * 512; }
                    else { const int rr = row - NP; const int i = rr & 63; if (i >= 34) toff = OUT_CONVS + ((long)(rr >> 6) * 30 + (i - 34)) * 512; }
#pragma unroll
                    for (int n = 0; n < 2; ++n) {
                        const int c = 128 * pn + 32 * wc + 16 * n + 4 * fq;
                        const f32x4 x = acc[ai][0][m][n], g = acc[ai][1][m][n];
                        f32x4 a;
#pragma unroll
                        for (int j = 0; j < 4; ++j) a[j] = x[j] / (1.f + __expf(-g[j]));
                        *(u32x2*)(A + (size_t)row * 512 + c) = pack4(a);
                        if (toff >= 0) *(f32x4*)(out + toff + c) = a;
                    }
                }
        } else {
            const int sec = (pn - 4) >> 1, colbase = ((pn - 4) & 1) * 256;
#pragma unroll
            for (int ai = 0; ai < 2; ++ai)
#pragma unroll
                for (int m = 0; m < 4; ++m) {
                    const int row = row0 + ai * HALF + m * 16;
                    const bool isp = row < NP; const int rr = row - NP;
                    bf16_t* bdst; float* fdst;
                    if (sec == 0) { bdst = Q + (size_t)row * 512; fdst = nullptr; }
                    else if (sec == 1) { bdst = isp ? KP + (size_t)row * 512 : KS + ((size_t)(rr >> 6) * SKV + 2048 + (rr & 63)) * 512; fdst = isp ? out + OUT_KP + (size_t)row * 512 : out + OUT_KS + (size_t)rr * 512; }
                    else { bdst = isp ? VP + (size_t)row * 512 : VS + ((size_t)(rr >> 6) * SKV + 2048 + (rr & 63)) * 512; fdst = isp ? out + OUT_VP + (size_t)row * 512 : out + OUT_VS + (size_t)rr * 512; }
#pragma unroll
                    for (int bj = 0; bj < 2; ++bj)
#pragma unroll
                        for (int n = 0; n < 2; ++n) {
                            const int col = colbase + 128 * bj + 32 * wc + 16 * n + 4 * fq;
                            const f32x4 v = acc[ai][bj][m][n];
                            if (sec == 0) { *(u32x2*)(bdst + col) = pack4(v * QSCALE); }
                            else { *(u32x2*)(bdst + col) = pack4(v); *(f32x4*)(fdst + col) = v; }
                        }
                }
        }
    }
};
struct EpiRes {
    static constexpr bool PERM = false, AFTER_DRAIN = false;
    const float* xp; const float* xs; float* out; bf16_t* xg; const float* gff; float* ssq;
    __device__ __forceinline__ void operator()(const f32x4 (&acc)[2][2][4][2], const Unit& u, int wr, int wc, int fr, int fq) const {
        const int row0 = u.pm * BM + wr * 64 + fr;
        f32x4 gg[2][2];
#pragma unroll
        for (int bj = 0; bj < 2; ++bj)
#pragma unroll
            for (int n = 0; n < 2; ++n) gg[bj][n] = *(const f32x4*)(gff + u.pn * BM + 128 * bj + 32 * wc + 16 * n + 4 * fq);
#pragma unroll
        for (int ai = 0; ai < 2; ++ai)
#pragma unroll
            for (int m = 0; m < 4; ++m) {
                const int row = row0 + ai * HALF + m * 16;
                const float* xr = row < NP ? xp + (size_t)row * DM : xs + (size_t)(row - NP) * DM;
                float* orow = out + (size_t)row * DM; bf16_t* grow = xg + (size_t)row * DM;
                float sq = 0.f;
#pragma unroll
                for (int bj = 0; bj < 2; ++bj)
#pragma unroll
                    for (int n = 0; n < 2; ++n) {
                        const int col = u.pn * BM + 128 * bj + 32 * wc + 16 * n + 4 * fq;
                        const f32x4 v = *(const f32x4*)(xr + col) + acc[ai][bj][m][n];
                        *(f32x4*)(orow + col) = v;
                        *(u32x2*)(grow + col) = pack4(v * gg[bj][n]);
                        sq += (v[0] * v[0] + v[1] * v[1]) + (v[2] * v[2] + v[3] * v[3]);
                    }
                sq += __shfl_xor(sq, 16); sq += __shfl_xor(sq, 32);
                if (fq == 0) ssq[(size_t)row * 16 + u.pn * 4 + wc] = sq;
            }
    }
};
}

__device__ __forceinline__ int winrow(int n) { return n < 1024 ? (256 * ((n & 511) >> 7) + 128 * (n >> 9) + (n & 127)) : n; }
template <bool WIN> __device__ __forceinline__ void transpose_item(const float* W, int K, int N, bf16_t* WT, LAS float* scr, int item, int lane) {
    const int nblk = N / 32, kb = item / nblk, nb = item % nblk, k0 = 64 * kb, n0 = 32 * nb;
#pragma unroll 8
    for (int i = 0; i < 32; ++i) { const int kk = 2 * i + (lane >> 5); scr[kk * 33 + (lane & 31)] = W[(size_t)(k0 + kk) * N + n0 + (lane & 31)]; }
    LDS_WAIT();
    const int c = lane & 7;
#pragma unroll
    for (int j = 0; j < 4; ++j) {
        const int n = (lane >> 3) + 8 * j; const LAS float* s = scr + (8 * c) * 33 + n;
        u32x4 o; o.x = cvtpk(s[0 * 33], s[1 * 33]); o.y = cvtpk(s[2 * 33], s[3 * 33]); o.z = cvtpk(s[4 * 33], s[5 * 33]); o.w = cvtpk(s[6 * 33], s[7 * 33]);
        const int dr = WIN ? winrow(n0 + n) : (n0 + n);
        *(u32x4*)(WT + (size_t)dr * K + k0 + 8 * c) = o;
    }
    LDS_WAIT();
}
__device__ __forceinline__ void cvt_stream(const float* src, bf16_t* dst, size_t n8, size_t gt, size_t ngt) {
    for (size_t i = gt; i < n8; i += ngt) {
        const f32x4 a = *(const f32x4*)(src + i * 8), b = *(const f32x4*)(src + i * 8 + 4);
        u32x4 o; o.x = cvtpk(a[0], a[1]); o.y = cvtpk(a[2], a[3]); o.z = cvtpk(b[0], b[1]); o.w = cvtpk(b[2], b[3]);
        *(u32x4*)(dst + i * 8) = o;
    }
}
__device__ __forceinline__ void cvt_cache(const float* src, bf16_t* dst, size_t gt, size_t ngt) {
    const size_t n8 = (size_t)8 * 2048 * 512 / 8;
    for (size_t i = gt; i < n8; i += ngt) {
        const size_t e = i * 8; const size_t row = e >> 9, col = e & 511; const size_t drow = (row >> 11) * SKV + (row & 2047);
        const f32x4 a = *(const f32x4*)(src + e), b = *(const f32x4*)(src + e + 4);
        u32x4 o; o.x = cvtpk(a[0], a[1]); o.y = cvtpk(a[2], a[3]); o.z = cvtpk(b[0], b[1]); o.w = cvtpk(b[2], b[3]);
        *(u32x4*)(dst + drow * 512 + col) = o;
    }
}
__device__ __forceinline__ void rms_row_bf16(const float* xrow, const float* g, bf16_t* orow, int lane) {
    const f32x4* xr = (const f32x4*)xrow + lane; const f32x4* gr = (const f32x4*)g + lane;
    f32x4 v[4]; float s = 0.f;
#pragma unroll
    for (int j = 0; j < 4; ++j) { v[j] = xr[64 * j]; s += (v[j][0] * v[j][0] + v[j][1] * v[j][1]) + (v[j][2] * v[j][2] + v[j][3] * v[j][3]); }
    const float rstd = 1.f / sqrtf(wave_sum(s) * (1.f / DM) + EPS);
    u32x2* o8 = (u32x2*)orow + lane;
#pragma unroll
    for (int j = 0; j < 4; ++j) { const f32x4 gg = gr[64 * j]; u32x2 w; w.x = cvtpk(v[j][0] * rstd * gg[0], v[j][1] * rstd * gg[1]); w.y = cvtpk(v[j][2] * rstd * gg[2], v[j][3] * rstd * gg[3]); o8[64 * j] = w; }
}

template <bool SLICED> __device__ __forceinline__ void cvt_row_fp8(const float* src, unsigned char* dst_base, int row, float* scale_out, int lane) {
    const f32x4* xr = (const f32x4*)src + lane;
    f32x4 v[4]; float am = 0.f;
#pragma unroll
    for (int j = 0; j < 4; ++j) { v[j] = xr[64 * j]; am = fmaxf(am, fmaxf(fmaxf(fabsf(v[j][0]), fabsf(v[j][1])), fmaxf(fabsf(v[j][2]), fabsf(v[j][3])))); }
#pragma unroll
    for (int o = 1; o < 64; o <<= 1) am = fmaxf(am, __shfl_xor(am, o));
    const float sc = am > 0.f ? am * (1.f / 448.f) : 1.f, inv = 1.f / sc;
#pragma unroll
    for (int j = 0; j < 4; ++j) {
        const int eb = 256 * j + 4 * lane;
        int w = __builtin_amdgcn_cvt_pk_fp8_f32(v[j][0] * inv, v[j][1] * inv, 0, false);
        w = __builtin_amdgcn_cvt_pk_fp8_f32(v[j][2] * inv, v[j][3] * inv, w, true);
        if (SLICED) *(int*)(dst_base + ((size_t)(eb >> 7) * 16384 + row) * 128 + (eb & 127)) = w;
        else *(int*)(dst_base + (size_t)row * DM + 16 * ((eb & 511) >> 3) + (eb & 7) + (eb >= 512 ? 8 : 0)) = w;
    }
    if (lane == 0) *scale_out = sc;
}

__device__ __forceinline__ void rms_row2_bf16(const float* xa, const float* xb, const float* g, bf16_t* oa, bf16_t* ob, int lane) {
    const f32x4* ra = (const f32x4*)xa + lane; const f32x4* rb = (const f32x4*)xb + lane; const f32x4* gr = (const f32x4*)g + lane;
    f32x4 va[4], vb[4]; float sa = 0.f, sb = 0.f;
#pragma unroll
    for (int j = 0; j < 4; ++j) { va[j] = ra[64 * j]; vb[j] = rb[64 * j]; }
#pragma unroll
    for (int j = 0; j < 4; ++j) { sa += (va[j][0] * va[j][0] + va[j][1] * va[j][1]) + (va[j][2] * va[j][2] + va[j][3] * va[j][3]); sb += (vb[j][0] * vb[j][0] + vb[j][1] * vb[j][1]) + (vb[j][2] * vb[j][2] + vb[j][3] * vb[j][3]); }
    const float ra_ = 1.f / sqrtf(wave_total(sa) * (1.f / DM) + EPS), rb_ = 1.f / sqrtf(wave_total(sb) * (1.f / DM) + EPS);
    u32x2* o8a = (u32x2*)oa + lane; u32x2* o8b = (u32x2*)ob + lane;
#pragma unroll
    for (int j = 0; j < 4; ++j) { const f32x4 gg = gr[64 * j];
        u32x2 w; w.x = cvtpk(va[j][0] * ra_ * gg[0], va[j][1] * ra_ * gg[1]); w.y = cvtpk(va[j][2] * ra_ * gg[2], va[j][3] * ra_ * gg[3]); o8a[64 * j] = w;
        u32x2 z; z.x = cvtpk(vb[j][0] * rb_ * gg[0], vb[j][1] * rb_ * gg[1]); z.y = cvtpk(vb[j][2] * rb_ * gg[2], vb[j][3] * rb_ * gg[3]); o8b[64 * j] = z; }
}
__device__ __forceinline__ void phase0(const Params& p, LAS unsigned char* lds, int tid, int lane, int wave) {
    const int gw = blockIdx.x * 8 + wave, NGW = gridDim.x * 8;
    LAS float* scr = (LAS float*)(lds + wave * 16384);
    bf16_t* WINT = (bf16_t*)(p.ws + WS_WINT);
    constexpr int I_IN = 16 * (DIN / 32);
    for (int it = gw; it < I_IN; it += NGW) transpose_item<true>(p.in[6], 1024, DIN, WINT, scr, it, lane);
    bf16_t* H = (bf16_t*)(p.ws + WS_H);
    for (int m = gw; m < NT; m += 2 * NGW) {
        const int m2 = m + NGW < NT ? m + NGW : m;
        const float* xr = m < NP ? p.in[0] + (size_t)m * DM : p.in[1] + (size_t)(m - NP) * DM;
        const float* xr2 = m2 < NP ? p.in[0] + (size_t)m2 * DM : p.in[1] + (size_t)(m2 - NP) * DM;
        rms_row2_bf16(xr, xr2, p.in[5], H + (size_t)m * DM, H + (size_t)m2 * DM, lane);
    }
}
__device__ __forceinline__ void prep_late(const Params& p, LAS unsigned char* lds, int tid, int lane, int wave, int rank, int nparts) {
    const int gw = rank * 8 + wave, NGW = nparts * 8;
    LAS float* scr = (LAS float*)(lds + wave * 16384);
    const size_t gt = (size_t)rank * 512 + tid, ngt = (size_t)nparts * 512;
    cvt_cache(p.in[2], (bf16_t*)(p.ws + WS_KS), gt, ngt);
    cvt_cache(p.in[3], (bf16_t*)(p.ws + WS_VS), gt, ngt);
    bf16_t* WOUTT = (bf16_t*)(p.ws + WS_WOUTT); bf16_t* WQT = (bf16_t*)(p.ws + WS_WQT);
    constexpr int I_OUT = 16 * (1024 / 32), I_Q = 16 * (2048 / 32);
    for (int it = gw; it < I_OUT + I_Q; it += NGW) {
        if (it < I_OUT) transpose_item<false>(p.in[17], 1024, 1024, WOUTT, scr, it, lane);
        else transpose_item<false>(p.in[19], 1024, 2048, WQT, scr, it - I_OUT, lane);
    }
    cvt_stream(p.in[20], (bf16_t*)(p.ws + WS_SK), (size_t)16 * 128 * 128 / 8, gt, ngt);
    for (int r = gw; r < 2 * 16384; r += NGW) {
        const int tb = r >> 14, e = r & 16383;
        if (tb) cvt_row_fp8<true>(p.in[22] + (size_t)e * DM, p.ws + WS_PV8, e, (float*)(p.ws + WS_SCV) + e, lane);
        else cvt_row_fp8<true>(p.in[21] + (size_t)e * DM, p.ws + WS_PU8, e, (float*)(p.ws + WS_SCU) + e, lane);
    }
}

namespace att {
constexpr int KPITCH = 272, VPITCH = 320;
constexpr int L_KV = 0, KV_BYTES = 64 * KPITCH + 64 * VPITCH  , L_X = 0  , L_BIAS = BIAS_OFF, L_CA = 0  , L_CW = 94 * 1024  ;
static_assert(4 * 4096 * 4 <= 2 * KV_BYTES && 2 * KV_BYTES <= L_CW && L_CW + 31 * 1024 <= RING_BYTES, "attention LDS map");

__device__ __forceinline__ int rel_bucket(int rel) {
    const int ret = rel > 0 ? 16 : 0; const int n = rel < 0 ? -rel : rel; int v;
    if (n < 8) v = n; else if (n < 12) v = 8; else if (n < 16) v = 9; else if (n < 23) v = 10; else if (n < 32) v = 11;
    else if (n < 46) v = 12; else if (n < 64) v = 13; else if (n < 91) v = 14; else v = 15;
    return ret + v;
}
typedef short v4i16_t __attribute__((ext_vector_type(4)));
__device__ __forceinline__ s16x4 vtr(const LAS unsigned char* p) { return __builtin_bit_cast(s16x4, __builtin_amdgcn_ds_read_tr16_b64_v4i16((LAS v4i16_t*)p)); }
__device__ __forceinline__ f32x16 mfma32(bf16x8 a, bf16x8 b, f32x16 c) { return __builtin_amdgcn_mfma_f32_32x32x16_bf16(a, b, c, 0, 0, 0); }

__device__ __forceinline__ void attn_unit(const Params& p, LAS unsigned char* lds, int kind, int bb, int h, int qblk, float lam, int tid, int lane, int wid) {
    const bf16_t* Q = (const bf16_t*)(p.ws + WS_Q);
    const bf16_t* Kb = kind == 0 ? (const bf16_t*)(p.ws + WS_KP) + (size_t)bb * 2048 * 512 + h * 128 : (const bf16_t*)(p.ws + WS_KS) + (size_t)bb * SKV * 512 + h * 128;
    const bf16_t* Vb = kind == 0 ? (const bf16_t*)(p.ws + WS_VP) + (size_t)bb * 2048 * 512 + h * 128 : (const bf16_t*)(p.ws + WS_VS) + (size_t)bb * SKV * 512 + h * 128;
    bf16_t* MIX = (bf16_t*)(p.ws + WS_MIX);
    const int qrow0 = kind == 0 ? bb * 2048 + qblk * 128 : NP + bb * 64;
    const int qpos0 = kind == 0 ? qblk * 128 : 2048;
    const int ntiles = kind == 0 ? 2 * qblk + 2 : 33;
    const int rg = wid & 3, map = wid >> 2, r32 = lane & 31, hi = lane >> 5;
    const bool active = kind == 0 ? true : (rg < 2);
    const int cw = kind == 0 ? 2 * qblk + (rg >> 1) : 32;
    const int qw0 = qpos0 + 32 * rg;
    const int qabs = qw0 + r32;

    bf16x8 qf[4];
    if (active) {
        const bf16_t* qp = Q + (size_t)(qrow0 + 32 * rg + r32) * 512 + h * 128 + map * 64 + 8 * hi;
#pragma unroll
        for (int s = 0; s < 4; ++s) qf[s] = *(const bf16x8*)(qp + 16 * s);
    } else {
#pragma unroll
        for (int s = 0; s < 4; ++s) qf[s] = (bf16x8){0, 0, 0, 0, 0, 0, 0, 0};
    }
    float m = 0.f, l = 0.f;
    f32x16 negm;
#pragma unroll
    for (int r = 0; r < 16; ++r) negm[r] = 0.f;
    f32x16 o[4];
#pragma unroll
    for (int mt = 0; mt < 4; ++mt)
#pragma unroll
        for (int r = 0; r < 16; ++r) o[mt][r] = 0.f;

    const int srow0 = tid >> 4, sch = tid & 15;
    const LAS float* btab = (const LAS float*)(lds + L_BIAS) + h * 320;
    const int vlane = (4 * hi + ((lane & 15) >> 2)) * VPITCH + (16 * ((lane >> 4) & 1) + 4 * (lane & 3)) * 2;
    u32x4 kA[2], vA[2], kB[2], vB[2];
#define ATT_LOAD(KR, VR, T) do { _Pragma("unroll") for (int i_ = 0; i_ < 2; ++i_) { const size_t off_ = (size_t)((T) * 64 + srow0 + 32 * i_) * 512 + sch * 8; KR[i_] = *(const u32x4*)(Kb + off_); VR[i_] = *(const u32x4*)(Vb + off_); } } while (0)
#define ATT_STORE(KR, VR, BUF) do { _Pragma("unroll") for (int i_ = 0; i_ < 2; ++i_) { \
        *(LAS u32x4*)(lds + L_KV + (BUF) * KV_BYTES + (srow0 + 32 * i_) * KPITCH + sch * 16) = KR[i_]; \
        *(LAS u32x4*)(lds + L_KV + (BUF) * KV_BYTES + 64 * KPITCH + (srow0 + 32 * i_) * VPITCH + sch * 16) = VR[i_]; } } while (0)
    auto compute = [&](int t, int buf) {
        const LAS unsigned char* kbuf = lds + L_KV + buf * KV_BYTES;
        const LAS unsigned char* vbuf = kbuf + 64 * KPITCH;
        f32x16 p0, p1;
        const int kabs0 = t * 64;
        const LAS unsigned char* kb = kbuf + r32 * KPITCH + (map * 8 + hi) * 16;
        {
            const bf16x8 a0 = *(const LAS bf16x8*)(kb), a1 = *(const LAS bf16x8*)(kb + 32 * KPITCH);
            if (kabs0 + 63 - qw0 > -128) {
                const LAS float* bt = btab + (kabs0 - qabs + 256 + 4 * hi);
#pragma unroll
                for (int r = 0; r < 16; ++r) { p0[r] = bt[(r & 3) + 8 * (r >> 2)] - m; p1[r] = bt[32 + (r & 3) + 8 * (r >> 2)] - m; }
                p0 = mfma32(a0, qf[0], p0); p1 = mfma32(a1, qf[0], p1);
            } else { p0 = mfma32(a0, qf[0], negm); p1 = mfma32(a1, qf[0], negm); }
        }
#pragma unroll
        for (int s = 1; s < 4; ++s) {
            const bf16x8 a0 = *(const LAS bf16x8*)(kb + s * 32), a1 = *(const LAS bf16x8*)(kb + 32 * KPITCH + s * 32);
            p0 = mfma32(a0, qf[s], p0); p1 = mfma32(a1, qf[s], p1);
        }
        float mx = fmaxf(p0[0], p1[0]);
#pragma unroll
        for (int r = 1; r < 16; ++r) mx = fmaxf(mx, fmaxf(p0[r], p1[r]));
        { const auto rr = __builtin_amdgcn_permlane32_swap(__float_as_uint(mx), __float_as_uint(mx), false, false); mx = fmaxf(__uint_as_float(rr[0]), __uint_as_float(rr[1])); }
        if (__any(mx > 8.f)) {
            const float dl = fmaxf(mx, 0.f);
            m += dl;
            const float alpha = __builtin_amdgcn_exp2f(-dl);
            l *= alpha;
#pragma unroll
            for (int r = 0; r < 16; ++r) { p0[r] -= dl; p1[r] -= dl; negm[r] = -m; }
#pragma unroll
            for (int mt = 0; mt < 4; ++mt)
#pragma unroll
                for (int r = 0; r < 16; ++r) o[mt][r] *= alpha;
        }
        float rs = 0.f;
#pragma unroll
        for (int r = 0; r < 16; ++r) { p0[r] = __builtin_amdgcn_exp2f(p0[r]); p1[r] = __builtin_amdgcn_exp2f(p1[r]); rs += p0[r] + p1[r]; }
        l += rs;
#pragma unroll
        for (int t2 = 0; t2 < 2; ++t2)
#pragma unroll
            for (int s = 0; s < 2; ++s) {
                u32x4 bw;
                if (t2 == 0) { bw.x = cvtpk(p0[8 * s + 0], p0[8 * s + 1]); bw.y = cvtpk(p0[8 * s + 2], p0[8 * s + 3]); bw.z = cvtpk(p0[8 * s + 4], p0[8 * s + 5]); bw.w = cvtpk(p0[8 * s + 6], p0[8 * s + 7]); }
                else { bw.x = cvtpk(p1[8 * s + 0], p1[8 * s + 1]); bw.y = cvtpk(p1[8 * s + 2], p1[8 * s + 3]); bw.z = cvtpk(p1[8 * s + 4], p1[8 * s + 5]); bw.w = cvtpk(p1[8 * s + 6], p1[8 * s + 7]); }
                const bf16x8 B = __builtin_bit_cast(bf16x8, bw);
                const LAS unsigned char* vb = vbuf + vlane + (32 * t2 + 16 * s) * VPITCH;
#pragma unroll
                for (int mt = 0; mt < 4; ++mt) {
                    const s16x4 lo = vtr(vb + mt * 64), hi8 = vtr(vb + mt * 64 + 8 * VPITCH);
                    const bf16x8 A = (bf16x8){lo[0], lo[1], lo[2], lo[3], hi8[0], hi8[1], hi8[2], hi8[3]};
                    o[mt] = mfma32(A, B, o[mt]);
                }
            }
    };
    ATT_LOAD(kA, vA, 0);
    if (ntiles > 1) ATT_LOAD(kB, vB, 1);
    ATT_STORE(kA, vA, 0);
    if (ntiles > 2) ATT_LOAD(kA, vA, 2);
    __syncthreads();
    for (int t = 0; t < ntiles; t += 2) {
        if (t + 1 < ntiles) { ATT_STORE(kB, vB, 1); if (t + 3 < ntiles) ATT_LOAD(kB, vB, t + 3); }
        if (active && t <= cw) compute(t, 0);
        __syncthreads();
        if (t + 1 >= ntiles) break;
        if (t + 2 < ntiles) { ATT_STORE(kA, vA, 0); if (t + 4 < ntiles) ATT_LOAD(kA, vA, t + 4); }
        if (active && t + 1 <= cw) compute(t + 1, 1);
        __syncthreads();
    }
#undef ATT_LOAD
#undef ATT_STORE
    l += __shfl_xor(l, 32);
    const float inv = 1.f / l;
    LAS float* X = (LAS float*)(lds + L_X) + rg * 4096;
    if (active && map == 1) {
        const float sc = -lam * inv;
#pragma unroll
        for (int mt = 0; mt < 4; ++mt)
#pragma unroll
            for (int r = 0; r < 16; ++r) X[(mt * 16 + r) * 64 + lane] = o[mt][r] * sc;
    }
    __syncthreads();
    if (active && map == 0) {
        float ss = 0.f;
#pragma unroll
        for (int mt = 0; mt < 4; ++mt)
#pragma unroll
            for (int r = 0; r < 16; ++r) { const float v = o[mt][r] * inv + X[(mt * 16 + r) * 64 + lane]; o[mt][r] = v; ss += v * v; }
        ss += __shfl_xor(ss, 32);
        const float rsn = 0.8f / sqrtf(ss * (1.f / 128.f) + EPS);
        bf16_t* orow = MIX + (size_t)(qrow0 + 32 * rg + r32) * 1024 + 512 + h * 128;
        const float* sg = p.in[15];
#pragma unroll
        for (int mt = 0; mt < 4; ++mt)
#pragma unroll
            for (int g4 = 0; g4 < 4; ++g4) {
                const int e = 32 * mt + 8 * g4 + 4 * hi;
                const f32x4 gg = *(const f32x4*)(sg + e);
                u32x2 w; w.x = cvtpk(o[mt][4 * g4 + 0] * rsn * gg[0], o[mt][4 * g4 + 1] * rsn * gg[1]); w.y = cvtpk(o[mt][4 * g4 + 2] * rsn * gg[2], o[mt][4 * g4 + 3] * rsn * gg[3]);
                *(u32x2*)(orow + e) = w;
            }
    }
    __syncthreads();
}

__device__ __forceinline__ void unpack8(const u32x4 w, float (&f)[8]) { f[0] = bflo(w.x); f[1] = bfhi(w.x); f[2] = bflo(w.y); f[3] = bfhi(w.y); f[4] = bflo(w.z); f[5] = bfhi(w.z); f[6] = bflo(w.w); f[7] = bfhi(w.w); }
__device__ __forceinline__ void conv_unit(const Params& p, LAS unsigned char* lds, int cu, int tid, int lane, int wid) {
    const bf16_t* A = (const bf16_t*)(p.ws + WS_A);
    bf16_t* MIX = (bf16_t*)(p.ws + WS_MIX);
    const float* cb = p.in[8]; const float* lg = p.in[9]; const float* lb = p.in[10]; const float* st = p.in[4];
    const int row0 = cu * 64;
    const bool isp = row0 < NP;
    const int s0 = isp ? (row0 & 2047) : 0, rbase = row0 - s0, bd = isp ? 0 : ((row0 - NP) >> 6);
    for (int c = tid; c < 94 * 64; c += 512) {
        const int rr = c >> 6, ch = c & 63, sp = s0 - 30 + rr;
        u32x4 v = (u32x4){0u, 0u, 0u, 0u};
        if (sp >= 0) v = *(const u32x4*)(A + (size_t)(rbase + sp) * 512 + ch * 8);
        else if (!isp) { const float* sr = st + ((size_t)bd * 30 + (30 + sp)) * 512 + ch * 8; const f32x4 a0 = *(const f32x4*)sr, a1 = *(const f32x4*)(sr + 4);
            v.x = cvtpk(a0[0], a0[1]); v.y = cvtpk(a0[2], a0[3]); v.z = cvtpk(a1[0], a1[1]); v.w = cvtpk(a1[2], a1[3]); }
        *(LAS u32x4*)(lds + L_CA + rr * 1024 + ch * 16) = v;
    }
    __syncthreads();
    const int c0 = lane * 8;
    float bias8[8], g8[8], b8[8];
    { const f32x4 x0 = *(const f32x4*)(cb + c0), x1 = *(const f32x4*)(cb + c0 + 4), y0 = *(const f32x4*)(lg + c0), y1 = *(const f32x4*)(lg + c0 + 4), z0 = *(const f32x4*)(lb + c0), z1 = *(const f32x4*)(lb + c0 + 4);
#pragma unroll
      for (int q = 0; q < 4; ++q) { bias8[q] = x0[q]; bias8[4 + q] = x1[q]; g8[q] = y0[q]; g8[4 + q] = y1[q]; b8[q] = z0[q]; b8[4 + q] = z1[q]; } }
    for (int grp = 0; grp < 2; ++grp) {
        const int t0 = wid * 8 + grp * 4;
        float acc[4][8];
#pragma unroll
        for (int q = 0; q < 4; ++q)
#pragma unroll
            for (int c = 0; c < 8; ++c) acc[q][c] = bias8[c];
        const LAS unsigned char* ap = lds + L_CA + t0 * 1024 + lane * 16;
        const LAS unsigned char* wp = lds + L_CW + lane * 16;
#pragma unroll 1
        for (int j = 0; j < 31; ++j) {
            float w[8]; unpack8(*(const LAS u32x4*)(wp + j * 1024), w);
#pragma unroll
            for (int q = 0; q < 4; ++q) {
                float a[8]; unpack8(*(const LAS u32x4*)(ap + (j + q) * 1024), a);
#pragma unroll
                for (int c = 0; c < 8; ++c) acc[q][c] += w[c] * a[c];
            }
        }
#pragma unroll
        for (int q = 0; q < 4; ++q) {
            float sm = 0.f;
#pragma unroll
            for (int c = 0; c < 8; ++c) sm += acc[q][c];
            const float mu = wave_total(sm) * (1.f / 512.f);
            float sv = 0.f;
#pragma unroll
            for (int c = 0; c < 8; ++c) { acc[q][c] -= mu; sv += acc[q][c] * acc[q][c]; }
            const float rstd = 1.f / sqrtf(wave_total(sv) * (1.f / 512.f) + EPS);
            float y[8];
#pragma unroll
            for (int c = 0; c < 8; ++c) { y[c] = acc[q][c] * rstd * g8[c] + b8[c]; y[c] = y[c] / (1.f + __expf(-y[c])); }
            u32x4 w; w.x = cvtpk(y[0], y[1]); w.y = cvtpk(y[2], y[3]); w.z = cvtpk(y[4], y[5]); w.w = cvtpk(y[6], y[7]);
            *(u32x4*)(MIX + (size_t)(row0 + t0 + q) * 1024 + c0) = w;
        }
    }
}

constexpr int N_SAMPLE_UNITS = 32, N_PROMPT_UNITS = 1024, N_CONV_UNITS = NT / 64, N_UNITS = N_SAMPLE_UNITS + N_PROMPT_UNITS + N_CONV_UNITS;

__device__ __forceinline__ void phase2(const Params& p, LAS unsigned char* lds, int tid, int lane, int wid, int cidx, int mode) {
    LAS float* bt = (LAS float*)(lds + L_BIAS);
    for (int e = tid; e < 4 * 320; e += 512) { const int hh = e / 320, rel = (e % 320) - 256; bt[e] = (p.in[16][rel_bucket(rel) * 4 + hh] - p.in[16][15 * 4 + hh]) * LOG2E; }
    for (int c = tid; c < 31 * 64; c += 512) {
        const float* wr = p.in[7] + (size_t)c * 8; const f32x4 a0 = *(const f32x4*)wr, a1 = *(const f32x4*)(wr + 4);
        u32x4 v; v.x = cvtpk(a0[0], a0[1]); v.y = cvtpk(a0[2], a0[3]); v.z = cvtpk(a1[0], a1[1]); v.w = cvtpk(a1[2], a1[3]);
        *(LAS u32x4*)(lds + L_CW + c * 16) = v;
    }
    const float d1 = wave_sum(p.in[11][lane] * p.in[12][lane]), d2 = wave_sum(p.in[13][lane] * p.in[14][lane]);
    const float lam = expf(d1) - expf(d2) + 0.2f;
    unsigned* ctr = (unsigned*)(p.ws + WS_CTL) + 64 * cidx;
    volatile LAS unsigned* sw = (volatile LAS unsigned*)(lds + MISC_OFF);
    __syncthreads();
    for (;;) {
        __syncthreads();
        if (tid == 0) sw[0] = atomicAdd(ctr, 1u);
        __syncthreads();
        const int u = (int)sw[0];
        if (u >= N_UNITS) break;
        if (mode == 1 && u >= N_SAMPLE_UNITS + N_PROMPT_UNITS) continue;
        if (mode == 2 && u < N_SAMPLE_UNITS + N_PROMPT_UNITS) continue;
        int tid_ = tid; asm volatile("" : "+v"(tid_));
        if (u < N_SAMPLE_UNITS + N_PROMPT_UNITS) {
            const int v = u - N_SAMPLE_UNITS; const int bh = v & 63; const bool smp = u < N_SAMPLE_UNITS;
            attn_unit(p, lds, smp ? 1 : 0, smp ? (u >> 2) : (bh >> 2), smp ? (u & 3) : (bh & 3), smp ? 0 : 15 - (v >> 6), lam, tid_, tid_ & 63, wid);
        } else conv_unit(p, lds, u - N_SAMPLE_UNITS - N_PROMPT_UNITS, tid_, tid_ & 63, wid);
    }
}
}

template <class F> __device__ __forceinline__ void mini_gemm(const bf16_t* A, const bf16_t* Bt, int N, int lane, int wave, F epi) {
    const int ntasks = 16 * (N / 64), G = gridDim.x;
    const int fr = lane & 15, fq = lane >> 4;
    for (int task = wave * G + (int)blockIdx.x; task < ntasks; task += 8 * G) {
        const int rb = task & 15, cb = task >> 4;
        pg8::f32x4 acc[2][4];
#pragma unroll
        for (int m = 0; m < 2; ++m)
#pragma unroll
            for (int n = 0; n < 4; ++n) acc[m][n] = (pg8::f32x4){0.f, 0.f, 0.f, 0.f};
        const bf16_t* ap = A + (size_t)(rb * 32 + fr) * 1024 + 8 * fq;
        const bf16_t* bp = Bt + (size_t)(cb * 64 + fr) * 1024 + 8 * fq;
#pragma unroll 4
        for (int k0 = 0; k0 < 1024; k0 += 32) {
            const bf16x8 a0 = *(const bf16x8*)(ap + k0), a1 = *(const bf16x8*)(ap + 16 * 1024 + k0);
            bf16x8 b[4];
#pragma unroll
            for (int n = 0; n < 4; ++n) b[n] = *(const bf16x8*)(bp + (size_t)n * 16 * 1024 + k0);
#pragma unroll
            for (int n = 0; n < 4; ++n) { acc[0][n] = __builtin_amdgcn_mfma_f32_16x16x32_bf16(b[n], a0, acc[0][n], 0, 0, 0); acc[1][n] = __builtin_amdgcn_mfma_f32_16x16x32_bf16(b[n], a1, acc[1][n], 0, 0, 0); }
        }
#pragma unroll
        for (int m = 0; m < 2; ++m) epi(rb * 32 + 16 * m + fr, cb, fq, acc[m]);
    }
}

__device__ __forceinline__ void phase3b(const Params& p, int lane, int wave) {
    const int gw = blockIdx.x * 8 + wave, NGW = gridDim.x * 8;
    bf16_t* H2 = (bf16_t*)(p.ws + WS_H2);
    for (int m = gw; m < NT; m += 2 * NGW) { const int m2 = m + NGW < NT ? m + NGW : m; rms_row2_bf16(p.out + (size_t)m * DM, p.out + (size_t)m2 * DM, p.in[18], H2 + (size_t)m * DM, H2 + (size_t)m2 * DM, lane); }
}

constexpr int P4B_KPITCH = 272, P4B_K_BYTES = 128 * P4B_KPITCH, P4B_Q_BYTES = 32 * P4B_KPITCH;
static_assert(P4B_K_BYTES + 8 * P4B_Q_BYTES <= RING_BYTES, "P4b LDS map");
__device__ __forceinline__ void phase4b(const Params& p, LAS unsigned char* lds, int tid, int lane, int wave) {
    const bf16_t* QP = (const bf16_t*)(p.ws + WS_QP); const bf16_t* SK = (const bf16_t*)(p.ws + WS_SK);
    float* TK = (float*)(p.ws + WS_TK);
    const int r32 = lane & 31, hi = lane >> 5;
    const int G = gridDim.x;
    for (int rp = blockIdx.x & 15; rp < 16; rp += (G < 16 ? G : 16)) {
        const int nbr = (G - rp + 15) >> 4, member = (int)blockIdx.x >> 4;
        __syncthreads();
        for (int c = tid; c < 128 * 16; c += 512) { const int row = c >> 4, ch = c & 15; *(LAS u32x4*)(lds + row * P4B_KPITCH + ch * 16) = *(const u32x4*)(SK + ((size_t)rp * 128 + row) * 128 + ch * 8); }
        __syncthreads();
        LAS unsigned char* qs = lds + P4B_K_BYTES + wave * P4B_Q_BYTES;
        for (int tg = member * 8 + wave; tg < NT / 32; tg += nbr * 8) {
            const int t0 = tg * 32;
#pragma unroll
            for (int i = 0; i < 8; ++i) { const int row = 4 * i + (lane >> 4), ch = lane & 15; *(LAS u32x4*)(qs + row * P4B_KPITCH + ch * 16) = *(const u32x4*)(QP + (size_t)(t0 + row) * 2048 + rp * 128 + ch * 8); }
            bf16x8 qf[8];
#pragma unroll
            for (int s = 0; s < 8; ++s) qf[s] = *(const LAS bf16x8*)(qs + r32 * P4B_KPITCH + (2 * s + hi) * 16);
            float v[64];
#pragma unroll
            for (int mt = 0; mt < 4; ++mt) {
                f32x16 S;
#pragma unroll
                for (int r = 0; r < 16; ++r) S[r] = 0.f;
                const LAS unsigned char* kp = lds + (32 * mt + r32) * P4B_KPITCH + hi * 16;
#pragma unroll
                for (int s = 0; s < 8; ++s) S = att::mfma32(*(const LAS bf16x8*)(kp + s * 32), qf[s], S);
#pragma unroll
                for (int r = 0; r < 16; ++r) { const int n = 32 * mt + (r & 3) + 8 * (r >> 2) + 4 * hi; v[mt * 16 + r] = __uint_as_float((__float_as_uint(S[r]) & ~127u) | (unsigned)(127 - n)); }
            }
            SORT16_DESC(v, 0); SORT16_DESC(v, 16); SORT16_DESC(v, 32); SORT16_DESC(v, 48);
#pragma unroll
            for (int i = 0; i < 16; ++i) { v[i] = fmaxf(v[i], v[31 - i]); v[32 + i] = fmaxf(v[32 + i], v[63 - i]); }
            BITONIC16_DESC(v, 0); BITONIC16_DESC(v, 32);
#pragma unroll
            for (int i = 0; i < 16; ++i) v[i] = fmaxf(v[i], v[47 - i]);
            BITONIC16_DESC(v, 0);
            float w[16];
#pragma unroll
            for (int i = 0; i < 16; ++i) w[i] = fmaxf(v[i], __shfl_xor(v[15 - i], 32));
            BITONIC16_DESC(w, 0);
            if (hi == 0) {
                f32x4* dst = (f32x4*)(TK + ((size_t)(t0 + r32) * 16 + rp) * 16);
#pragma unroll
                for (int q = 0; q < 4; ++q) dst[q] = (f32x4){w[4 * q], w[4 * q + 1], w[4 * q + 2], w[4 * q + 3]};
            }
        }
    }
}

__device__ __forceinline__ void phase5a(const Params& p, int tid) {
    const float* TK = (const float*)(p.ws + WS_TK);
    int* IDX = (int*)(p.ws + WS_IDX); float* GATE = (float*)(p.ws + WS_GATE);
    const float NEG_INF = -__builtin_huge_valf();
    for (int item = blockIdx.x * 512 + tid; item < NT * 8; item += gridDim.x * 512) {
        const int tok = item >> 3, r = item & 7;
        const f32x4* pa = (const f32x4*)(TK + ((size_t)tok * 16 + 2 * r) * 16);
        float a[16], b[16]; int ia[16], ib[16];
#pragma unroll
        for (int q = 0; q < 4; ++q) { const f32x4 x = pa[q], y = pa[4 + q];
#pragma unroll
            for (int j = 0; j < 4; ++j) { a[4 * q + j] = x[j]; b[4 * q + j] = y[j]; } }
#pragma unroll
        for (int i = 0; i < 16; ++i) { const unsigned ua = __float_as_uint(a[i]), ub = __float_as_uint(b[i]); ia[i] = 127 - (int)(ua & 127u); ib[i] = 127 - (int)(ub & 127u); a[i] = __uint_as_float(ua & ~127u); b[i] = __uint_as_float(ub & ~127u); }
        float cv[50]; int cid[50];
        {
            int c = 0;
#pragma unroll
            for (int i = 0; i < 16; ++i)
#pragma unroll
                for (int j = 0; j < 16; ++j)
                    if ((i + 1) * (j + 1) <= 16) { const float s = a[i] + b[j]; cv[c] = __uint_as_float((__float_as_uint(s) & ~63u) | (unsigned)(63 - c)); cid[c] = ia[i] * 128 + ib[j]; ++c; }
        }
        float best[16]; int bid[16];
#pragma unroll
        for (int it = 0; it < 16; ++it) {
            float mx = cv[0];
#pragma unroll
            for (int c = 1; c < 50; ++c) mx = fmaxf(mx, cv[c]);
            int id = 0;
#pragma unroll
            for (int c = 0; c < 50; ++c) { const bool hit = cv[c] == mx; id = hit ? cid[c] : id; cv[c] = hit ? NEG_INF : cv[c]; }
            best[it] = __uint_as_float(__float_as_uint(mx) & ~63u); bid[it] = id;
        }
        float ssum = 0.f;
        { const f32x4* sp = (const f32x4*)((const float*)(p.ws + WS_SSQ) + (size_t)tok * 16);
#pragma unroll
          for (int q = 0; q < 4; ++q) { const f32x4 v4 = sp[q]; ssum += (v4[0] + v4[1]) + (v4[2] + v4[3]); } }
        const float rstd = 1.f / sqrtf(ssum * (1.f / DM) + EPS);
        if (r == 0) ((float*)(p.ws + WS_RSTD))[tok] = rstd;
        float e[16], sum = 0.f;
#pragma unroll
        for (int k = 0; k < 16; ++k) { e[k] = __expf((best[k] - best[0]) * rstd); sum += e[k]; }
        const float rinv = 1.f / sum;
        int* io = IDX + (size_t)tok * 128 + r * 16; float* go = GATE + (size_t)tok * 128 + r * 16;
#pragma unroll
        for (int k = 0; k < 16; ++k) { io[k] = bid[k]; go[k] = e[k] * rinv; }
    }
}

__device__ __forceinline__ float gelu_erf(float x) { return 0.5f * x * (1.f + erff(x * 0.70710678118654752f)); }
__device__ __forceinline__ void fp8x16_to_f32(const u32x4 q, float (&f)[16]) {
    const f32x2 c0 = __builtin_amdgcn_cvt_pk_f32_fp8(q.x, false), c1 = __builtin_amdgcn_cvt_pk_f32_fp8(q.x, true), c2 = __builtin_amdgcn_cvt_pk_f32_fp8(q.y, false), c3 = __builtin_amdgcn_cvt_pk_f32_fp8(q.y, true);
    const f32x2 c4 = __builtin_amdgcn_cvt_pk_f32_fp8(q.z, false), c5 = __builtin_amdgcn_cvt_pk_f32_fp8(q.z, true), c6 = __builtin_amdgcn_cvt_pk_f32_fp8(q.w, false), c7 = __builtin_amdgcn_cvt_pk_f32_fp8(q.w, true);
    f[0] = c0.x; f[1] = c0.y; f[2] = c1.x; f[3] = c1.y; f[4] = c2.x; f[5] = c2.y; f[6] = c3.x; f[7] = c3.y;
    f[8] = c4.x; f[9] = c4.y; f[10] = c5.x; f[11] = c5.y; f[12] = c6.x; f[13] = c6.y; f[14] = c7.x; f[15] = c7.y;
}
__device__ __forceinline__ void slice_group(int& x, int& gwx, int& nwx, int wave) {
    x = blockIdx.x & 7; const int nbx = ((int)gridDim.x - x + 7) >> 3; gwx = ((int)blockIdx.x >> 3) * 8 + wave; nwx = nbx * 8;
}
__device__ __forceinline__ void phase5u(const Params& p, LAS unsigned char* lds, int lane, int wave) {
    int x, gwx, nwx; slice_group(x, gwx, nwx, wave);
    const unsigned char* PU8 = p.ws + WS_PU8 + (size_t)x * 16384 * 128;
    const bf16_t* H2 = (const bf16_t*)(p.ws + WS_XG) + 128 * x;
    const int* IDX = (const int*)(p.ws + WS_IDX); float* PACT = (float*)(p.ws + WS_PACT) + (size_t)x * NT * 128;
    LAS int* l_idx = (LAS int*)(lds + wave * 512);
    const int g = lane >> 3, sub = lane & 7;
    const unsigned char* rowp = PU8 + sub * 16;
    int r_idxA = 0, r_idxB = 0;
    u32x4 hA0, hA1, hB0, hB1; hA0 = hA1 = hB0 = hB1 = (u32x4){0u, 0u, 0u, 0u};
    u32x4 qA[16], qB[16];
#define P5U_LOADIDX(T) do { if ((T) < NT) { r_idxA = IDX[(size_t)(T) * 128 + lane]; r_idxB = IDX[(size_t)(T) * 128 + 64 + lane]; } } while (0)
#define P5U_ISSUE(Q, H0, H1, T) do { if ((T) < NT) { l_idx[lane] = r_idxA; l_idx[64 + lane] = r_idxB; \
        H0 = *(const u32x4*)(H2 + (size_t)(T) * DM + 16 * sub); H1 = *(const u32x4*)(H2 + (size_t)(T) * DM + 16 * sub + 8); \
        _Pragma("unroll") for (int q_ = 0; q_ < 4; ++q_) { const u32x4 iv = *(const LAS u32x4*)(l_idx + 16 * g + 4 * q_); \
            Q[4 * q_] = *(const u32x4*)(rowp + (size_t)iv.x * 128); Q[4 * q_ + 1] = *(const u32x4*)(rowp + (size_t)iv.y * 128); \
            Q[4 * q_ + 2] = *(const u32x4*)(rowp + (size_t)iv.z * 128); Q[4 * q_ + 3] = *(const u32x4*)(rowp + (size_t)iv.w * 128); } } } while (0)
#define P5U_COMPUTE(Q, H0, H1, T) do { \
        f32x2 hf[8]; \
        hf[0] = (f32x2){bflo(H0.x), bfhi(H0.x)}; hf[1] = (f32x2){bflo(H0.y), bfhi(H0.y)}; hf[2] = (f32x2){bflo(H0.z), bfhi(H0.z)}; hf[3] = (f32x2){bflo(H0.w), bfhi(H0.w)}; \
        hf[4] = (f32x2){bflo(H1.x), bfhi(H1.x)}; hf[5] = (f32x2){bflo(H1.y), bfhi(H1.y)}; hf[6] = (f32x2){bflo(H1.z), bfhi(H1.z)}; hf[7] = (f32x2){bflo(H1.w), bfhi(H1.w)}; \
        float resA = 0.f, resB = 0.f; \
        _Pragma("unroll") for (int i = 0; i < 16; ++i) { \
            f32x2 s2 = __builtin_amdgcn_cvt_pk_f32_fp8(Q[i].x, false) * hf[0]; \
            s2 = __builtin_elementwise_fma(__builtin_amdgcn_cvt_pk_f32_fp8(Q[i].x, true), hf[1], s2); \
            s2 = __builtin_elementwise_fma(__builtin_amdgcn_cvt_pk_f32_fp8(Q[i].y, false), hf[2], s2); \
            s2 = __builtin_elementwise_fma(__builtin_amdgcn_cvt_pk_f32_fp8(Q[i].y, true), hf[3], s2); \
            s2 = __builtin_elementwise_fma(__builtin_amdgcn_cvt_pk_f32_fp8(Q[i].z, false), hf[4], s2); \
            s2 = __builtin_elementwise_fma(__builtin_amdgcn_cvt_pk_f32_fp8(Q[i].z, true), hf[5], s2); \
            s2 = __builtin_elementwise_fma(__builtin_amdgcn_cvt_pk_f32_fp8(Q[i].w, false), hf[6], s2); \
            s2 = __builtin_elementwise_fma(__builtin_amdgcn_cvt_pk_f32_fp8(Q[i].w, true), hf[7], s2); \
            float sr = s2.x + s2.y; \
            DPP_ADD(sr, 0xB1); DPP_ADD(sr, 0x4E); DPP_ADD(sr, 0x141); \
            if (i < 8) resA = (sub == i) ? sr : resA; else resB = (sub == i - 8) ? sr : resB; } \
        PACT[(size_t)(T) * 128 + 16 * g + sub] = resA; PACT[(size_t)(T) * 128 + 16 * g + 8 + sub] = resB; } while (0)
    int tok = gwx;
    P5U_LOADIDX(tok);
    P5U_ISSUE(qA, hA0, hA1, tok);
    P5U_LOADIDX(tok + nwx);
    for (; tok < NT; tok += 2 * nwx) {
        P5U_ISSUE(qB, hB0, hB1, tok + nwx);
        P5U_LOADIDX(tok + 2 * nwx);
        P5U_COMPUTE(qA, hA0, hA1, tok);
        if (tok + nwx >= NT) break;
        P5U_ISSUE(qA, hA0, hA1, tok + 2 * nwx);
        P5U_LOADIDX(tok + 3 * nwx);
        P5U_COMPUTE(qB, hB0, hB1, tok + nwx);
    }
#undef P5U_LOADIDX
#undef P5U_ISSUE
#undef P5U_COMPUTE
}
__device__ __forceinline__ void phase5c(const Params& p, int tid) {
    const float* PACT = (const float*)(p.ws + WS_PACT); const float* SCU = (const float*)(p.ws + WS_SCU); const float* SCV = (const float*)(p.ws + WS_SCV);
    const int* IDX = (const int*)(p.ws + WS_IDX); const float* GATE = (const float*)(p.ws + WS_GATE); float* COEF = (float*)(p.ws + WS_COEF); const float* RSTD = (const float*)(p.ws + WS_RSTD);
    const size_t n = (size_t)NT * 128, n4 = n / 4, stride = (size_t)gridDim.x * 512;
    for (size_t i0 = (size_t)blockIdx.x * 512 + tid; i0 < n4; i0 += 2 * stride) {
        f32x4 a[2], g[2]; u32x4 e[2]; f32x4 pa[2][8]; float rs[2];
#pragma unroll
        for (int u = 0; u < 2; ++u) {
            const size_t it = (i0 + u * stride < n4 ? i0 + u * stride : i0) * 4;
#pragma unroll
            for (int xx = 0; xx < 8; ++xx) pa[u][xx] = *(const f32x4*)(PACT + (size_t)xx * n + it);
            e[u] = *(const u32x4*)(IDX + it); g[u] = *(const f32x4*)(GATE + it); rs[u] = RSTD[it >> 7];
        }
        float su[2][4], sv[2][4];
#pragma unroll
        for (int u = 0; u < 2; ++u)
#pragma unroll
            for (int j = 0; j < 4; ++j) { su[u][j] = SCU[e[u][j]]; sv[u][j] = SCV[e[u][j]]; }
#pragma unroll
        for (int u = 0; u < 2; ++u) {
            a[u] = ((pa[u][0] + pa[u][1]) + (pa[u][2] + pa[u][3])) + ((pa[u][4] + pa[u][5]) + (pa[u][6] + pa[u][7]));
            f32x4 c;
#pragma unroll
            for (int j = 0; j < 4; ++j) c[j] = g[u][j] * gelu_erf(a[u][j] * (rs[u] * su[u][j])) * sv[u][j];
            if (i0 + u * stride < n4) *(f32x4*)(COEF + (i0 + u * stride) * 4) = c;
        }
    }
}

constexpr int P5V_LDS_PER_WAVE = 1024 + 8 * 136 * 4;
__device__ __forceinline__ void phase5v(const Params& p, LAS unsigned char* lds, int lane, int wave) {
    int x, gwx, nwx; slice_group(x, gwx, nwx, wave);
    const unsigned char* PV8 = p.ws + WS_PV8 + (size_t)x * 16384 * 128;
    const int* IDX = (const int*)(p.ws + WS_IDX); const float* COEF = (const float*)(p.ws + WS_COEF);
    LAS int* l_idx = (LAS int*)(lds + wave * P5V_LDS_PER_WAVE); LAS float* l_cf = (LAS float*)(l_idx + 128); LAS float* red = l_cf + 128;
    const int g = lane >> 3, sub = lane & 7;
    const unsigned char* rowp = PV8 + sub * 16;
    const int c1 = 16 * (lane & 7) + (lane >> 3);
    int r_idxA = 0, r_idxB = 0; float r_cA = 0.f, r_cB = 0.f;
    u32x4 qA[16], qB[16]; f32x4 cfA[4], cfB[4]; float xA0 = 0.f, xA1 = 0.f, xB0 = 0.f, xB1 = 0.f;
#define P5V_LOADIDX(T) do { if ((T) < NT) { r_idxA = IDX[(size_t)(T) * 128 + lane]; r_idxB = IDX[(size_t)(T) * 128 + 64 + lane]; r_cA = COEF[(size_t)(T) * 128 + lane]; r_cB = COEF[(size_t)(T) * 128 + 64 + lane]; } } while (0)
#define P5V_ISSUE(Q, CF, X0, X1, T) do { if ((T) < NT) { l_idx[lane] = r_idxA; l_idx[64 + lane] = r_idxB; l_cf[lane] = r_cA; l_cf[64 + lane] = r_cB; \
        { const float* xr_ = p.out + (size_t)(T) * DM + 128 * x; X0 = xr_[c1]; X1 = xr_[c1 + 8]; } \
        _Pragma("unroll") for (int q_ = 0; q_ < 4; ++q_) { const u32x4 iv = *(const LAS u32x4*)(l_idx + 16 * g + 4 * q_); CF[q_] = *(const LAS f32x4*)(l_cf + 16 * g + 4 * q_); \
            Q[4 * q_] = *(const u32x4*)(rowp + (size_t)iv.x * 128); Q[4 * q_ + 1] = *(const u32x4*)(rowp + (size_t)iv.y * 128); \
            Q[4 * q_ + 2] = *(const u32x4*)(rowp + (size_t)iv.z * 128); Q[4 * q_ + 3] = *(const u32x4*)(rowp + (size_t)iv.w * 128); } } } while (0)
#define P5V_COMPUTE(Q, CF, X0, X1, T) do { \
        f32x2 acc[8]; \
        _Pragma("unroll") for (int j = 0; j < 8; ++j) acc[j] = (f32x2){0.f, 0.f}; \
        _Pragma("unroll") for (int i = 0; i < 16; ++i) { \
            const float cs_ = CF[i >> 2][i & 3]; const f32x2 c2 = (f32x2){cs_, cs_}; \
            acc[0] = __builtin_elementwise_fma(__builtin_amdgcn_cvt_pk_f32_fp8(Q[i].x, false), c2, acc[0]); \
            acc[1] = __builtin_elementwise_fma(__builtin_amdgcn_cvt_pk_f32_fp8(Q[i].x, true), c2, acc[1]); \
            acc[2] = __builtin_elementwise_fma(__builtin_amdgcn_cvt_pk_f32_fp8(Q[i].y, false), c2, acc[2]); \
            acc[3] = __builtin_elementwise_fma(__builtin_amdgcn_cvt_pk_f32_fp8(Q[i].y, true), c2, acc[3]); \
            acc[4] = __builtin_elementwise_fma(__builtin_amdgcn_cvt_pk_f32_fp8(Q[i].z, false), c2, acc[4]); \
            acc[5] = __builtin_elementwise_fma(__builtin_amdgcn_cvt_pk_f32_fp8(Q[i].z, true), c2, acc[5]); \
            acc[6] = __builtin_elementwise_fma(__builtin_amdgcn_cvt_pk_f32_fp8(Q[i].w, false), c2, acc[6]); \
            acc[7] = __builtin_elementwise_fma(__builtin_amdgcn_cvt_pk_f32_fp8(Q[i].w, true), c2, acc[7]); } \
        _Pragma("unroll") for (int j = 0; j < 8; ++j) { red[g * 136 + (2 * j) * 8 + sub] = acc[j].x; red[g * 136 + (2 * j + 1) * 8 + sub] = acc[j].y; } \
        float s1 = X0, s2_ = X1; \
        _Pragma("unroll") for (int gg = 0; gg < 8; ++gg) { s1 += red[gg * 136 + lane]; s2_ += red[gg * 136 + 64 + lane]; } \
        { float* xr_ = p.out + (size_t)(T) * DM + 128 * x; xr_[c1] = s1; xr_[c1 + 8] = s2_; } } while (0)
    int tok = gwx;
    P5V_LOADIDX(tok);
    P5V_ISSUE(qA, cfA, xA0, xA1, tok);
    P5V_LOADIDX(tok + nwx);
    for (; tok < NT; tok += 2 * nwx) {
        P5V_ISSUE(qB, cfB, xB0, xB1, tok + nwx);
        P5V_LOADIDX(tok + 2 * nwx);
        P5V_COMPUTE(qA, cfA, xA0, xA1, tok);
        if (tok + nwx >= NT) break;
        P5V_ISSUE(qA, cfA, xA0, xA1, tok + 2 * nwx);
        P5V_LOADIDX(tok + 3 * nwx);
        P5V_COMPUTE(qB, cfB, xB0, xB1, tok + nwx);
    }
#undef P5V_LOADIDX
#undef P5V_ISSUE
#undef P5V_COMPUTE
}

__device__ __forceinline__ void phase6(const Params& p, int lane, int wave) {
    const int gw = blockIdx.x * 8 + wave, NGW = gridDim.x * 8;
    const f32x4* gr = (const f32x4*)p.in[23] + lane;
    for (int m = gw; m < NT; m += 2 * NGW) {
        const bool two = m + NGW < NT;
        f32x4* xa = (f32x4*)(p.out + (size_t)m * DM) + lane; f32x4* xb = (f32x4*)(p.out + (size_t)(two ? m + NGW : m) * DM) + lane;
        f32x4 va[4], vb[4]; float sa = 0.f, sb = 0.f;
#pragma unroll
        for (int j = 0; j < 4; ++j) { va[j] = xa[64 * j]; vb[j] = xb[64 * j]; }
#pragma unroll
        for (int j = 0; j < 4; ++j) { sa += (va[j][0] * va[j][0] + va[j][1] * va[j][1]) + (va[j][2] * va[j][2] + va[j][3] * va[j][3]); sb += (vb[j][0] * vb[j][0] + vb[j][1] * vb[j][1]) + (vb[j][2] * vb[j][2] + vb[j][3] * vb[j][3]); }
        const float ra_ = 1.f / sqrtf(wave_total(sa) * (1.f / DM) + EPS), rb_ = 1.f / sqrtf(wave_total(sb) * (1.f / DM) + EPS);
#pragma unroll
        for (int j = 0; j < 4; ++j) { const f32x4 gg = gr[64 * j]; xa[64 * j] = va[j] * ra_ * gg; if (two) xb[64 * j] = vb[j] * rb_ * gg; }
    }
}

__global__ void __launch_bounds__(512, 2) fwd_megakernel(Params p) {
    extern __shared__ __attribute__((aligned(16))) unsigned char lds_raw[];
    LAS unsigned char* lds = (LAS unsigned char*)lds_raw;
    cg::grid_group grid = cg::this_grid();
    const int tid0 = threadIdx.x, wave = __builtin_amdgcn_readfirstlane(tid0 >> 6);
#define PHASE_IDS() int tid = tid0; asm volatile("" : "+v"(tid)); const int lane = tid & 63; (void)lane
    const int G = gridDim.x;
    volatile LAS unsigned* MISC = (volatile LAS unsigned*)(lds + MISC_OFF);
    if (tid0 < 32) MISC[tid0] = 0u;
    __syncthreads();
    XcdBarrier bar = xcd_barrier_post((unsigned*)(p.ws + WS_CTL) + 4096, MISC + 8);
#define GSYNC() xcd_barrier(bar)

#ifndef RPT_MASK
#define RPT_MASK 0
#endif
#if RPT_MASK
#define RPT(bit) for (int rpt_ = 0; rpt_ < (((RPT_MASK) >> (bit)) & 1) + 1; ++rpt_)
#else
#define RPT(bit) if (constexpr int rpt_ = 0; true)
#endif
    RPT(0) { PHASE_IDS(); phase0(p, lds, tid, lane, wave); grid.sync(); }
    RPT(1) {
        PHASE_IDS();
        pg8::Gemm g{(const bf16_t*)(p.ws + WS_H), (const bf16_t*)(p.ws + WS_WINT), NT, DIN, 1024};
        pg8::StaticOrder S; S.init(NT, DIN, G, (int)blockIdx.x);
        pg8::EpiProj E{(bf16_t*)(p.ws + WS_A), (bf16_t*)(p.ws + WS_Q), (bf16_t*)(p.ws + WS_KP), (bf16_t*)(p.ws + WS_VP), (bf16_t*)(p.ws + WS_KS), (bf16_t*)(p.ws + WS_VS), p.out};
        pg8::gemm_phase<pg8::EpiProj, pg8::StaticOrder, true, true>(lds, g, S, E);
        {
            const int nwg = (NT / 256) * (DIN / 256), rem = nwg % G, c = (int)blockIdx.x;
            if (rem == 0) prep_late(p, lds, tid, lane, wave, c, G);
            else if (c >= rem) prep_late(p, lds, tid, lane, wave, c - rem, G - rem);
        }
        GSYNC();
    }
    #ifndef P2MODE
#define P2MODE 0
#endif
    RPT(2) { PHASE_IDS(); att::phase2(p, lds, tid, lane, wave, rpt_, (((RPT_MASK) >> 2) & 1) && rpt_ == 0 ? P2MODE : 0); GSYNC(); }
    RPT(3) {
        PHASE_IDS();
        pg8::Gemm g{(const bf16_t*)(p.ws + WS_MIX), (const bf16_t*)(p.ws + WS_WOUTT), NP, 1024, 1024};
        pg8::StaticOrder S; S.init(NP, 1024, G, (int)blockIdx.x);
        pg8::EpiRes E{p.in[0], p.in[1], p.out, (bf16_t*)(p.ws + WS_XG), p.in[18], (float*)(p.ws + WS_SSQ)};
        pg8::gemm_phase<pg8::EpiRes, pg8::StaticOrder, true, true>(lds, g, S, E);
        {
            const float* xs = p.in[1]; float* xo = p.out + (size_t)NP * DM; bf16_t* go = (bf16_t*)(p.ws + WS_XG) + (size_t)NP * DM; const float* gff = p.in[18]; float* sso = (float*)(p.ws + WS_SSQ) + (size_t)NP * 16;
            mini_gemm((const bf16_t*)(p.ws + WS_MIX) + (size_t)NP * DM, (const bf16_t*)(p.ws + WS_WOUTT), 1024, lane, wave,
                      [=](int row, int cb, int fq, const pg8::f32x4 (&a)[4]) {
                          float sq = 0.f;
#pragma unroll
                          for (int n = 0; n < 4; ++n) {
                              const int col = cb * 64 + 16 * n + 4 * fq;
                              const pg8::f32x4 v = *(const pg8::f32x4*)(xs + (size_t)row * DM + col) + a[n];
                              *(pg8::f32x4*)(xo + (size_t)row * DM + col) = v;
                              *(u32x2*)(go + (size_t)row * DM + col) = pg8::pack4(v * *(const pg8::f32x4*)(gff + col));
                              sq += (v[0] * v[0] + v[1] * v[1]) + (v[2] * v[2] + v[3] * v[3]);
                          }
                          sq += __shfl_xor(sq, 16); sq += __shfl_xor(sq, 32);
                          if (fq == 0) sso[(size_t)row * 16 + cb] = sq;
                      });
        }
        GSYNC();
    }
    RPT(5) {
        PHASE_IDS();
        pg8::Gemm g{(const bf16_t*)(p.ws + WS_XG), (const bf16_t*)(p.ws + WS_WQT), NP, 2048, 1024};
        pg8::StaticOrder S; S.init(NP, 2048, G, (int)blockIdx.x);
        pg8::EpiBf16<0> E{(bf16_t*)(p.ws + WS_QP), 2048, nullptr, 0, 0, 1.f};
        pg8::gemm_phase<pg8::EpiBf16<0>, pg8::StaticOrder, true, true>(lds, g, S, E);
        {
            bf16_t* qo = (bf16_t*)(p.ws + WS_QP) + (size_t)NP * 2048;
            mini_gemm((const bf16_t*)(p.ws + WS_XG) + (size_t)NP * DM, (const bf16_t*)(p.ws + WS_WQT), 2048, lane, wave,
                      [=](int row, int cb, int fq, const pg8::f32x4 (&a)[4]) {
#pragma unroll
                          for (int n = 0; n < 4; ++n) *(u32x2*)(qo + (size_t)row * 2048 + cb * 64 + 16 * n + 4 * fq) = pg8::pack4(a[n]);
                      });
        }
        GSYNC();
    }
    RPT(6) { PHASE_IDS(); phase4b(p, lds, tid, lane, wave); GSYNC(); }
    RPT(7) { PHASE_IDS(); phase5a(p, tid); GSYNC(); }
    RPT(8) { PHASE_IDS(); phase5u(p, lds, lane, wave); GSYNC(); }
    RPT(9) { PHASE_IDS(); phase5c(p, tid); GSYNC(); }
    { PHASE_IDS(); phase5v(p, lds, lane, wave); }
    GSYNC();
    { PHASE_IDS(); phase6(p, lane, wave); }
}

extern "C" void kernel_launch(void* const* d_in, const int* in_sizes, int n_in, void* d_out, int out_size, void* d_ws, size_t ws_size, hipStream_t stream) {
    static int grid = 0;
    if (grid == 0) {
        if (n_in != 24 || out_size != (int)OUT_TOTAL || ws_size < WS_END) { fprintf(stderr, "kernel_launch: unexpected shapes: n_in %d out %d ws %zu (need %zu)\n", n_in, out_size, ws_size, (size_t)WS_END); grid = -1; return; }
        int dev = 0, cus = 0, per_cu = 0;
        (void)hipGetDevice(&dev);
        (void)hipDeviceGetAttribute(&cus, hipDeviceAttributeMultiprocessorCount, dev);
        if (hipFuncSetAttribute((const void*)fwd_megakernel, hipFuncAttributeMaxDynamicSharedMemorySize, LDS_BYTES) != hipSuccess) { fprintf(stderr, "kernel_launch: hipFuncSetAttribute failed\n"); grid = -1; return; }
        if (hipOccupancyMaxActiveBlocksPerMultiprocessor(&per_cu, (const void*)fwd_megakernel, 512, LDS_BYTES) != hipSuccess || per_cu < 1) { fprintf(stderr, "kernel_launch: occupancy query gave %d\n", per_cu); per_cu = 1; }
        (void)hipGetLastError();
        grid = cus * 1;
        if (per_cu < 1) grid = -1;
    }
    if (grid < 0) return;
    (void)hipMemsetAsync((char*)d_ws + WS_CTL, 0, CTL_BYTES, stream);
    Params p{};
    for (int i = 0; i < 24; ++i) p.in[i] = (const float*)d_in[i];
    p.out = (float*)d_out; p.ws = (unsigned char*)d_ws;
    void* args[] = {&p};
    hipError_t e = hipLaunchCooperativeKernel((const void*)fwd_megakernel, dim3(grid), dim3(512), args, LDS_BYTES, stream);
    if (e != hipSuccess) fprintf(stderr, "cooperative launch failed: %s (grid %d)\n", hipGetErrorString(e), grid);
}
```

```cpp
#include <hip/hip_runtime.h>
#include <hip/hip_cooperative_groups.h>
#include <cstdio>
#include <cstdint>
#include <cmath>
namespace cg = cooperative_groups;
#define CE_(a, b) do { const float t_ = fmaxf(a, b); b = fminf(a, b); a = t_; } while (0)
#define SORT16_DESC(V, O) do { CE_(V[(O)+0], V[(O)+1]); CE_(V[(O)+2], V[(O)+3]); CE_(V[(O)+0], V[(O)+2]); CE_(V[(O)+1], V[(O)+3]); CE_(V[(O)+1], V[(O)+2]); CE_(V[(O)+4], V[(O)+5]); CE_(V[(O)+6], V[(O)+7]); CE_(V[(O)+4], V[(O)+6]); CE_(V[(O)+5], V[(O)+7]); CE_(V[(O)+5], V[(O)+6]); CE_(V[(O)+0], V[(O)+4]); CE_(V[(O)+2], V[(O)+6]); CE_(V[(O)+2], V[(O)+4]); CE_(V[(O)+1], V[(O)+5]); CE_(V[(O)+3], V[(O)+7]); CE_(V[(O)+3], V[(O)+5]); CE_(V[(O)+1], V[(O)+2]); CE_(V[(O)+3], V[(O)+4]); CE_(V[(O)+5], V[(O)+6]); CE_(V[(O)+8], V[(O)+9]); CE_(V[(O)+10], V[(O)+11]); CE_(V[(O)+8], V[(O)+10]); CE_(V[(O)+9], V[(O)+11]); CE_(V[(O)+9], V[(O)+10]); CE_(V[(O)+12], V[(O)+13]); CE_(V[(O)+14], V[(O)+15]); CE_(V[(O)+12], V[(O)+14]); CE_(V[(O)+13], V[(O)+15]); CE_(V[(O)+13], V[(O)+14]); CE_(V[(O)+8], V[(O)+12]); CE_(V[(O)+10], V[(O)+14]); CE_(V[(O)+10], V[(O)+12]); CE_(V[(O)+9], V[(O)+13]); CE_(V[(O)+11], V[(O)+15]); CE_(V[(O)+11], V[(O)+13]); CE_(V[(O)+9], V[(O)+10]); CE_(V[(O)+11], V[(O)+12]); CE_(V[(O)+13], V[(O)+14]); CE_(V[(O)+0], V[(O)+8]); CE_(V[(O)+4], V[(O)+12]); CE_(V[(O)+4], V[(O)+8]); CE_(V[(O)+2], V[(O)+10]); CE_(V[(O)+6], V[(O)+14]); CE_(V[(O)+6], V[(O)+10]); CE_(V[(O)+2], V[(O)+4]); CE_(V[(O)+6], V[(O)+8]); CE_(V[(O)+10], V[(O)+12]); CE_(V[(O)+1], V[(O)+9]); CE_(V[(O)+5], V[(O)+13]); CE_(V[(O)+5], V[(O)+9]); CE_(V[(O)+3], V[(O)+11]); CE_(V[(O)+7], V[(O)+15]); CE_(V[(O)+7], V[(O)+11]); CE_(V[(O)+3], V[(O)+5]); CE_(V[(O)+7], V[(O)+9]); CE_(V[(O)+11], V[(O)+13]); CE_(V[(O)+1], V[(O)+2]); CE_(V[(O)+3], V[(O)+4]); CE_(V[(O)+5], V[(O)+6]); CE_(V[(O)+7], V[(O)+8]); CE_(V[(O)+9], V[(O)+10]); CE_(V[(O)+11], V[(O)+12]); CE_(V[(O)+13], V[(O)+14]); } while (0)
#define BITONIC16_DESC(V, O) do { CE_(V[(O)+0], V[(O)+8]); CE_(V[(O)+1], V[(O)+9]); CE_(V[(O)+2], V[(O)+10]); CE_(V[(O)+3], V[(O)+11]); CE_(V[(O)+4], V[(O)+12]); CE_(V[(O)+5], V[(O)+13]); CE_(V[(O)+6], V[(O)+14]); CE_(V[(O)+7], V[(O)+15]); CE_(V[(O)+0], V[(O)+4]); CE_(V[(O)+1], V[(O)+5]); CE_(V[(O)+2], V[(O)+6]); CE_(V[(O)+3], V[(O)+7]); CE_(V[(O)+8], V[(O)+12]); CE_(V[(O)+9], V[(O)+13]); CE_(V[(O)+10], V[(O)+14]); CE_(V[(O)+11], V[(O)+15]); CE_(V[(O)+0], V[(O)+2]); CE_(V[(O)+1], V[(O)+3]); CE_(V[(O)+4], V[(O)+6]); CE_(V[(O)+5], V[(O)+7]); CE_(V[(O)+8], V[(O)+10]); CE_(V[(O)+9], V[(O)+11]); CE_(V[(O)+12], V[(O)+14]); CE_(V[(O)+13], V[(O)+15]); CE_(V[(O)+0], V[(O)+1]); CE_(V[(O)+2], V[(O)+3]); CE_(V[(O)+4], V[(O)+5]); CE_(V[(O)+6], V[(O)+7]); CE_(V[(O)+8], V[(O)+9]); CE_(V[(O)+10], V[(O)+11]); CE_(V[(O)+12], V[(O)+13]); CE_(V[(O)+14], V[(O)+15]); } while (0)
namespace pg8 {
#define PG8_LAS __attribute__((address_space(3)))
typedef unsigned short bf16_t;
typedef short bf16x8 __attribute__((ext_vector_type(8)));
typedef float f32x4 __attribute__((ext_vector_type(4)));
typedef unsigned u32x4 __attribute__((ext_vector_type(4)));
constexpr int BM = 256, BK = 64, HALF = 128, HTB = HALF * BK * 2  , STAGE_BYTES = 8 * HTB, NXCD = 8, WGM = 8;

__host__ __device__ __forceinline__ int lds_byte(int r, int c) { const int st = (r >> 4) * 2 + (c >> 5), rr = r & 15, cc = c & 31, ob = rr * 64 + cc * 2; return st * 1024 + (ob ^ (((ob >> 9) & 1) << 5)); }
__host__ __device__ __forceinline__ void stage_rc(int b, int& R, int& C) { const int st = b / 1024, sb = b % 1024, swz = sb ^ (((sb >> 9) & 1) << 5); R = (st >> 1) * 16 + swz / 64; C = (st & 1) * 32 + (swz % 64) / 2; }
__host__ __device__ __forceinline__ int perm32(int rho) { const int n = rho >> 4, i = rho & 15; return 8 * (i >> 2) + 4 * n + (i & 3); }

struct Unit { int pm, pn; };
struct Gemm { const bf16_t* A; const bf16_t* Bt; int M, N, K; };

struct StaticOrder {
    int nM, nN, nwg, G, c;
    __host__ __device__ void init(int M, int N, int G_, int c_) { nM = M / BM; nN = N / BM; nwg = nM * nN; G = G_; c = c_; }
    __host__ __device__ bool next(int i, Unit& u) const {
        const long L = (long)i * G + c; if (L >= nwg) return false;
        int wgid = (int)L; { const int q = nwg / NXCD, r = nwg % NXCD, xcd = wgid % NXCD, off = wgid / NXCD; wgid = (xcd < r ? xcd * (q + 1) : r * (q + 1) + (xcd - r) * q) + off; }
        const int nig = WGM * nN, gid = wgid / nig, fm = gid * WGM, gsz = (nM - fm) < WGM ? (nM - fm) : WGM;
        u.pm = fm + ((wgid % nig) % gsz); u.pn = (wgid % nig) / gsz; return true;
    }
    __device__ __forceinline__ void a_ready(const Unit&) const {}
    __device__ __forceinline__ void done(const Unit&) const {}
};

__device__ __forceinline__ unsigned cvt_pk_bf16(float lo, float hi) { unsigned r; asm volatile("v_cvt_pk_bf16_f32 %0, %1, %2" : "=v"(r) : "v"(lo), "v"(hi)); return r; }
typedef float f32x2 __attribute__((ext_vector_type(2)));
__device__ __forceinline__ f32x2 gelu_pk(f32x2 v) {
    const f32x2 av = __builtin_elementwise_abs(v), d = av * 0.2316418882f + 1.0f;
    f32x2 t; t.x = __builtin_amdgcn_rcpf(d.x); t.y = __builtin_amdgcn_rcpf(d.y);
    f32x2 q = t * 0.5307027145f + (-0.7265760135f); q = q * t + 0.7107068705f; q = q * t + (-0.142248368f); q = q * t + 0.127414796f; q = q * t;
    const f32x2 s = (v * v) * (-0.72134752044f);
    f32x2 e; e.x = __builtin_amdgcn_exp2f(s.x); e.y = __builtin_amdgcn_exp2f(s.y);
    const f32x2 m = v * (q * e), r = v - m;
    f32x2 o; o.x = v.x < 0.f ? m.x : r.x; o.y = v.y < 0.f ? m.y : r.y; return o;
}

template <int ACT  > struct EpiBf16 {
    static constexpr bool PERM = true, AFTER_DRAIN = false; static_assert(ACT == 0 || ACT == 1, "EpiBf16: ACT is 0 (none) or 1 (gelu_pk)");
    bf16_t* O; int ldc; const float* bias; int split_cols; size_t split_stride; float scale0;
    __device__ __forceinline__ void operator()(const f32x4 (&acc)[2][2][4][2], const Unit& u, int wr, int wc, int fr, int fq) const {
        const int row0 = u.pm * BM + wr * 64 + fr; int colt = u.pn * BM; bf16_t* base = O;
        float sc = 1.f; if (split_cols) { const int t = colt / split_cols; base += (size_t)t * split_stride; colt -= t * split_cols; if (t == 0) sc = scale0; }
        const int col0 = colt + wc * 32 + 8 * fq, bcol0 = u.pn * BM + wc * 32 + 8 * fq;
        f32x4 bv[2][2];
#pragma unroll
        for (int bj = 0; bj < 2; ++bj)
#pragma unroll
            for (int n = 0; n < 2; ++n) bv[bj][n] = bias ? *(const f32x4*)(bias + bcol0 + bj * HALF + 4 * n) : (f32x4){0.f, 0.f, 0.f, 0.f};
#pragma unroll
        for (int ai = 0; ai < 2; ++ai)
#pragma unroll
            for (int m = 0; m < 4; ++m) { bf16_t* rowp = base + (size_t)(row0 + ai * HALF + m * 16) * ldc + col0;
#pragma unroll
                for (int bj = 0; bj < 2; ++bj) { f32x4 v0 = acc[ai][bj][m][0] + bv[bj][0], v1 = acc[ai][bj][m][1] + bv[bj][1];
                    if (ACT == 1) { f32x2 a = gelu_pk((f32x2){v0[0], v0[1]}), b = gelu_pk((f32x2){v0[2], v0[3]}), c = gelu_pk((f32x2){v1[0], v1[1]}), d = gelu_pk((f32x2){v1[2], v1[3]});
                        v0 = (f32x4){a.x, a.y, b.x, b.y}; v1 = (f32x4){c.x, c.y, d.x, d.y}; }
                    v0 = v0 * sc; v1 = v1 * sc; u32x4 w; w.x = cvt_pk_bf16(v0[0], v0[1]); w.y = cvt_pk_bf16(v0[2], v0[3]); w.z = cvt_pk_bf16(v1[0], v1[1]); w.w = cvt_pk_bf16(v1[2], v1[3]);
                    *(u32x4*)(rowp + bj * HALF) = w; } }
    }
};
template <class Epi, class Sched, bool ALIGN_EPI = false, bool SP2 = false>
__device__ __forceinline__ void gemm_phase(PG8_LAS unsigned char* lds, const Gemm g, const Sched& S, const Epi& E) {
    int tid = threadIdx.x; asm volatile("" : "+v"(tid));
    const int wid = __builtin_amdgcn_readfirstlane(tid >> 6), lane = tid & 63, wr = wid >> 2, wc = wid & 3, fr = lane & 15, fq = lane >> 4;
    const int K = g.K, nt = K / BK;
    unsigned voffA[2], voffB[2];
#pragma unroll
    for (int i = 0; i < 2; ++i) { int R, C; stage_rc(tid * 16 + i * 8192, R, C); const int Rb = Epi::PERM ? ((R & ~31) + perm32(R & 31)) : R;
        voffA[i] = (unsigned)(R * K + C) * 2u; voffB[i] = (unsigned)(Rb * K + C) * 2u; }
    const size_t kstep = (size_t)(BK * 2);
    const size_t hstep = (size_t)HALF * K * 2;
    const size_t tstep = 2 * hstep;
    const unsigned ldsw = (unsigned)wid * 1024u;
    const int aoff = lds_byte(wr * 64 + fr, fq * 8), boff = lds_byte(wc * 32 + fr, fq * 8);
#define PG8_SA(b, h) (((b) * 2 + (h)) * HTB)
#define PG8_SB(b, h) ((4 + (b) * 2 + (h)) * HTB)
#define PG8_STAGE(bufoff, gbase, voff) do { _Pragma("unroll") for (int _i = 0; _i < 2; ++_i) \
        __builtin_amdgcn_global_load_lds((const unsigned*)((const char*)(gbase) + (voff)[_i]), (PG8_LAS unsigned*)(lds + (bufoff) + ldsw + _i * 8192), 16, 0, 0); } while (0)
#define PG8_LDA(dst, b, h) do { _Pragma("unroll") for (int m = 0; m < 4; ++m) _Pragma("unroll") for (int k = 0; k < 2; ++k) dst[m][k] = *(const PG8_LAS bf16x8*)(lds + PG8_SA(b, h) + aoff + m * 2048 + k * 1024); } while (0)
#define PG8_LDB(dst, b, h) do { _Pragma("unroll") for (int n = 0; n < 2; ++n) _Pragma("unroll") for (int k = 0; k < 2; ++k) dst[n][k] = *(const PG8_LAS bf16x8*)(lds + PG8_SB(b, h) + boff + n * 2048 + k * 1024); } while (0)
#define PG8_MMA(ai, bj, At, Bt) do { __builtin_amdgcn_s_setprio(1); _Pragma("unroll") for (int m = 0; m < 4; ++m) _Pragma("unroll") for (int n = 0; n < 2; ++n) _Pragma("unroll") for (int k = 0; k < 2; ++k) \
        acc[ai][bj][m][n] = __builtin_amdgcn_mfma_f32_16x16x32_bf16(Bt[n][k], At[m][k], acc[ai][bj][m][n], 0, 0, 0); __builtin_amdgcn_s_setprio(0); } while (0)
#define PG8_WAIT_V(n) asm volatile("s_waitcnt vmcnt(" #n ")" ::: "memory")
#define PG8_WAIT_L(n) asm volatile("s_waitcnt lgkmcnt(" #n ")" ::: "memory")
#define PG8_BAR __builtin_amdgcn_s_barrier()
#define PG8_SCHED __builtin_amdgcn_sched_barrier(0)
    Unit cur, nxt; int ui = 0;
    if (!S.next(0, cur)) return;
    f32x4 acc[2][2][4][2];
#pragma unroll
    for (int a = 0; a < 2; ++a)
#pragma unroll
        for (int b = 0; b < 2; ++b)
#pragma unroll
            for (int m = 0; m < 4; ++m)
#pragma unroll
                for (int n = 0; n < 2; ++n) acc[a][b][m][n] = (f32x4){0.f, 0.f, 0.f, 0.f};
    bf16x8 At[4][2], B0[2][2], B1[2][2];
    const char* cA = (const char*)g.A + (size_t)cur.pm * tstep; const char* cB = (const char*)g.Bt + (size_t)cur.pn * tstep;
    S.a_ready(cur);
    if constexpr (SP2) {
        PG8_STAGE(PG8_SB(0, 0), cB, voffB); PG8_STAGE(PG8_SB(0, 1), cB + hstep, voffB); PG8_STAGE(PG8_SA(0, 0), cA, voffA); PG8_STAGE(PG8_SA(0, 1), cA + hstep, voffA);
        if (wr == 1) PG8_BAR;
        PG8_WAIT_V(2); PG8_BAR;
        PG8_STAGE(PG8_SB(1, 0), cB + kstep, voffB); PG8_STAGE(PG8_SA(1, 0), cA + kstep, voffA); PG8_STAGE(PG8_SB(1, 1), cB + hstep + kstep, voffB);
        PG8_WAIT_V(6); PG8_BAR;
    } else {
        PG8_STAGE(PG8_SB(0, 0), cB, voffB); PG8_STAGE(PG8_SA(0, 0), cA, voffA); PG8_STAGE(PG8_SB(0, 1), cB + hstep, voffB); PG8_STAGE(PG8_SA(0, 1), cA + hstep, voffA);
        if (wr == 1) PG8_BAR;
        PG8_WAIT_V(4); PG8_BAR;
        PG8_STAGE(PG8_SB(1, 0), cB + kstep, voffB); PG8_STAGE(PG8_SA(1, 0), cA + kstep, voffA); PG8_STAGE(PG8_SB(1, 1), cB + hstep + kstep, voffB);
        PG8_WAIT_V(6); PG8_BAR;
    }
    for (;;) {
        const bool has_next = S.next(ui + 1, nxt);
        const char* nA = has_next ? (const char*)g.A + (size_t)nxt.pm * tstep : cA; const char* nB = has_next ? (const char*)g.Bt + (size_t)nxt.pn * tstep : cB;
        for (int t = 0; t < nt; t += 2) {
            const bool last = (t == nt - 2);
            const char* a1 = cA + (size_t)(t + 1) * kstep;
            const char* a2 = last ? nA : cA + (size_t)(t + 2) * kstep; const char* b2 = last ? nB : cB + (size_t)(t + 2) * kstep;
            const char* a3 = a2 + kstep; const char* b3 = b2 + kstep;
            if (last && has_next) S.a_ready(nxt);
            if constexpr (SP2) {
            PG8_LDB(B0, 0, 0); PG8_LDB(B1, 0, 1); PG8_SCHED; PG8_LDA(At, 0, 0); PG8_STAGE(PG8_SA(1, 1), a1 + hstep, voffA);
            PG8_WAIT_V(8); PG8_WAIT_L(0); PG8_BAR; PG8_MMA(0, 0, At, B0); PG8_MMA(0, 1, At, B1); PG8_BAR; PG8_SCHED;
            PG8_LDA(At, 0, 1); PG8_STAGE(PG8_SB(0, 0), b2, voffB); PG8_STAGE(PG8_SB(0, 1), b2 + hstep, voffB); PG8_STAGE(PG8_SA(0, 0), a2, voffA);
            PG8_WAIT_V(8); PG8_WAIT_L(0); PG8_BAR; PG8_MMA(1, 0, At, B0); PG8_MMA(1, 1, At, B1); PG8_BAR; PG8_SCHED;
            PG8_LDB(B0, 1, 0); PG8_LDB(B1, 1, 1); PG8_SCHED; PG8_LDA(At, 1, 0); PG8_STAGE(PG8_SA(0, 1), a2 + hstep, voffA);
            PG8_WAIT_V(8); PG8_WAIT_L(0); PG8_BAR; PG8_MMA(0, 0, At, B0); PG8_MMA(0, 1, At, B1); PG8_BAR; PG8_SCHED;
            PG8_LDA(At, 1, 1); PG8_STAGE(PG8_SB(1, 0), b3, voffB); PG8_STAGE(PG8_SB(1, 1), b3 + hstep, voffB); PG8_STAGE(PG8_SA(1, 0), a3, voffA);
            PG8_WAIT_V(8); PG8_WAIT_L(0); PG8_BAR; PG8_MMA(1, 0, At, B0); PG8_MMA(1, 1, At, B1); PG8_BAR; PG8_SCHED;
            } else {
            PG8_LDB(B0, 0, 0); PG8_SCHED; PG8_LDA(At, 0, 0); PG8_STAGE(PG8_SA(1, 1), a1 + hstep, voffA);
            PG8_WAIT_L(8); PG8_BAR; PG8_WAIT_L(0); PG8_MMA(0, 0, At, B0); PG8_BAR; PG8_SCHED;
            PG8_LDB(B1, 0, 1); PG8_STAGE(PG8_SB(0, 0), b2, voffB);
            PG8_BAR; PG8_WAIT_L(0); PG8_MMA(0, 1, At, B1); PG8_BAR;
            PG8_LDA(At, 0, 1); PG8_STAGE(PG8_SA(0, 0), a2, voffA);
            PG8_BAR; PG8_WAIT_L(0); PG8_MMA(1, 0, At, B0); PG8_BAR; PG8_SCHED;
            PG8_STAGE(PG8_SB(0, 1), b2 + hstep, voffB);
            PG8_WAIT_V(6); PG8_BAR; PG8_MMA(1, 1, At, B1); PG8_BAR;
            PG8_LDB(B0, 1, 0); PG8_SCHED; PG8_LDA(At, 1, 0); PG8_STAGE(PG8_SA(0, 1), a2 + hstep, voffA);
            PG8_WAIT_L(8); PG8_BAR; PG8_WAIT_L(0); PG8_MMA(0, 0, At, B0); PG8_BAR; PG8_SCHED;
            PG8_LDB(B1, 1, 1); PG8_STAGE(PG8_SB(1, 0), b3, voffB);
            PG8_BAR; PG8_WAIT_L(0); PG8_MMA(0, 1, At, B1); PG8_BAR;
            PG8_LDA(At, 1, 1); PG8_STAGE(PG8_SA(1, 0), a3, voffA);
            PG8_BAR; PG8_WAIT_L(0); PG8_MMA(1, 0, At, B0); PG8_BAR; PG8_SCHED;
            PG8_STAGE(PG8_SB(1, 1), b3 + hstep, voffB);
            PG8_WAIT_V(6); PG8_BAR; PG8_MMA(1, 1, At, B1); PG8_BAR;
            }
        }
        if constexpr (ALIGN_EPI) { if (wr == 0) PG8_BAR; }
        if constexpr (!Epi::AFTER_DRAIN) { E(acc, cur, wr, wc, fr, fq); S.done(cur); }
        if (!has_next) break;
#pragma unroll
        for (int a = 0; a < 2; ++a)
#pragma unroll
            for (int b = 0; b < 2; ++b)
#pragma unroll
                for (int m = 0; m < 4; ++m)
#pragma unroll
                    for (int n = 0; n < 2; ++n) acc[a][b][m][n] = (f32x4){0.f, 0.f, 0.f, 0.f};
        cur = nxt; cA = nA; cB = nB; ++ui;
        if constexpr (ALIGN_EPI) { if (wr == 1) PG8_BAR; }
    }
    PG8_WAIT_V(0);
    if constexpr (!ALIGN_EPI) { if (wr == 0) PG8_BAR; }
    PG8_BAR;
    if constexpr (Epi::AFTER_DRAIN) { E.fused(acc, cur, wr, wc, fr, fq, lds, wid, lane); S.done(cur); }
#undef PG8_SA
#undef PG8_SB
#undef PG8_STAGE
#undef PG8_LDA
#undef PG8_LDB
#undef PG8_MMA
#undef PG8_WAIT_V
#undef PG8_WAIT_L
#undef PG8_BAR
#undef PG8_SCHED
}
}

#define LAS __attribute__((address_space(3)))
typedef unsigned short bf16_t;
typedef short bf16x8 __attribute__((ext_vector_type(8)));
typedef short s16x4 __attribute__((ext_vector_type(4)));
typedef float f32x4 __attribute__((ext_vector_type(4)));
typedef float f32x16 __attribute__((ext_vector_type(16)));
typedef unsigned u32x4 __attribute__((ext_vector_type(4)));
typedef unsigned u32x2 __attribute__((ext_vector_type(2)));

constexpr int DM = 1024;
constexpr int NP = 16 * 2048;
constexpr int NS = 8 * 64;
constexpr int NT = NP + NS;
constexpr int DIN = 2560;
constexpr int SKV = 2112;
constexpr float EPS = 1e-6f;
constexpr float LOG2E = 1.4426950408889634f;
constexpr float QSCALE = 0.125f * LOG2E;

constexpr long OUT_Y = 0;
constexpr long OUT_KP = 34078720L, OUT_VP = 50855936L, OUT_CONVP = 67633152L, OUT_KS = 67878912L, OUT_VS = 68141056L, OUT_CONVS = 68403200L, OUT_TOTAL = 68526080L;

constexpr size_t MiB = 1u << 20;
constexpr size_t WS_CTL = 0, CTL_BYTES = 1 * MiB;
constexpr size_t WS_WINT = 1 * MiB;
constexpr size_t WS_WOUTT = 6 * MiB;
constexpr size_t WS_WQT = 8 * MiB;
constexpr size_t WS_SK = 12 * MiB;
constexpr size_t WS_PU8 = 16 * MiB;
constexpr size_t WS_PV8 = 32 * MiB;
constexpr size_t WS_SCU = 48 * MiB;
constexpr size_t WS_SCV = 49 * MiB;
constexpr size_t WS_KS = 80 * MiB;
constexpr size_t WS_VS = 97 * MiB;
constexpr size_t WS_H = 114 * MiB;
constexpr size_t WS_A = 179 * MiB;
constexpr size_t WS_Q = 212 * MiB;
constexpr size_t WS_QP = 114 * MiB;
constexpr size_t WS_KP = 245 * MiB;
constexpr size_t WS_VP = 277 * MiB;
constexpr size_t WS_MIX = 309 * MiB;
constexpr size_t WS_H2 = 309 * MiB;
constexpr size_t WS_TK = 375 * MiB;
constexpr size_t WS_IDX = 408 * MiB;
constexpr size_t WS_GATE = 425 * MiB;
constexpr size_t WS_PACT = 114 * MiB;
constexpr size_t WS_COEF = 375 * MiB;
constexpr size_t WS_XG = 442 * MiB;
constexpr size_t WS_SSQ = 507 * MiB;
constexpr size_t WS_RSTD = 510 * MiB;
constexpr size_t WS_END = 511 * MiB;
static_assert(WS_H + (size_t)NT * 1024 * 2 <= WS_A && WS_A + (size_t)NT * 512 * 2 <= WS_Q && WS_Q + (size_t)NT * 512 * 2 <= WS_KP, "R1");
static_assert(WS_QP + (size_t)NT * 2048 * 2 <= WS_KP && WS_KP + (size_t)NP * 512 * 2 <= WS_VP && WS_VP + (size_t)NP * 512 * 2 <= WS_MIX, "ws map");
static_assert(WS_MIX + (size_t)NT * 1024 * 2 <= WS_TK && WS_TK + (size_t)NT * 256 * 4 <= WS_IDX && WS_IDX + (size_t)NT * 128 * 4 <= WS_GATE && WS_GATE + (size_t)NT * 128 * 4 <= WS_END, "ws map 2");
static_assert(WS_KS + (size_t)8 * SKV * 512 * 2 <= WS_VS && WS_VS + (size_t)8 * SKV * 512 * 2 <= WS_H, "ws map 3");

constexpr int RING_BYTES = 131072;
constexpr int BIAS_OFF = RING_BYTES;
constexpr int MISC_OFF = RING_BYTES + 5120;
constexpr int LDS_BYTES = MISC_OFF + 1024;

struct Params {
    const float* in[24];
    float* out;
    unsigned char* ws;
};

__device__ __forceinline__ unsigned cvtpk(float lo, float hi) { return pg8::cvt_pk_bf16(lo, hi); }
__device__ __forceinline__ float bflo(unsigned w) { return __uint_as_float(w << 16); }
__device__ __forceinline__ float bfhi(unsigned w) { return __uint_as_float(w & 0xffff0000u); }
__device__ __forceinline__ float wave_sum(float v) {
#pragma unroll
    for (int o = 1; o < 64; o <<= 1) v += __shfl_xor(v, o);
    return v;
}
typedef float f32x2 __attribute__((ext_vector_type(2)));
#define DPP_ADD(v, ctrl) v += __builtin_bit_cast(float, __builtin_amdgcn_update_dpp(0, __builtin_bit_cast(int, v), ctrl, 0xf, 0xf, true))
__device__ __forceinline__ float rl_f(float v, int l) { return __uint_as_float(__builtin_amdgcn_readlane(__float_as_uint(v), l)); }
__device__ __forceinline__ float wave_total(float v) {
    DPP_ADD(v, 0xB1); DPP_ADD(v, 0x4E); DPP_ADD(v, 0x141); DPP_ADD(v, 0x140);
    return (rl_f(v, 0) + rl_f(v, 16)) + (rl_f(v, 32) + rl_f(v, 48));
}
typedef __bf16 bf16x2_t __attribute__((ext_vector_type(2)));
__device__ __forceinline__ float dot2(unsigned a, unsigned b, float acc) {
    return __builtin_amdgcn_fdot2_f32_bf16(__builtin_bit_cast(bf16x2_t, a), __builtin_bit_cast(bf16x2_t, b), acc, false);
}
#define LDS_WAIT() asm volatile("s_waitcnt lgkmcnt(0)" ::: "memory")

#define XB_TMO      128
#define XB_XCNT(j)  (256  + 64 * (j))
#define XB_XSUB(j)  (1280 + 64 * (j))
#define XB_XGEN(j)  (2304 + 64 * (j))
#define XB_TOP      3328
#define XB_TOPGEN   3392
#define XCD_BAR_WORDS 3456
#define XB_SPIN_CAP (1u << 18)

__device__ __forceinline__ unsigned xb_ld(unsigned* p)              { return __hip_atomic_load(p, __ATOMIC_RELAXED, __HIP_MEMORY_SCOPE_AGENT); }
__device__ __forceinline__ unsigned xb_add(unsigned* p, unsigned v) { return __hip_atomic_fetch_add(p, v, __ATOMIC_RELAXED, __HIP_MEMORY_SCOPE_AGENT); }
__device__ __forceinline__ unsigned xb_xcc_id() { return (unsigned)__builtin_amdgcn_s_getreg((3 << 11) | 20) & 0xFu; }
#define XB_SPIN(cond, bar) do { unsigned _sp = 0; while (cond) { __builtin_amdgcn_s_sleep(1); \
    if ((++_sp & 255u) == 0u) { if (xb_ld(&(bar)[XB_TMO])) break; if (_sp > XB_SPIN_CAP) { atomicAdd(&(bar)[XB_TMO], 1u); break; } } } } while (0)

struct XcdBarrier {
    unsigned* bar; unsigned x;
    volatile LAS unsigned* st;
};

__device__ __forceinline__ XcdBarrier xcd_barrier_post(unsigned* bar, volatile LAS unsigned* st) {
    XcdBarrier b; b.bar = bar; b.x = xb_xcc_id(); b.st = st;
    if (threadIdx.x == 0) (void)xb_add(&bar[XB_XCNT(b.x)], 1u);
    return b;
}
__device__ __forceinline__ void xcd_barrier_complete(unsigned* bar, unsigned x, unsigned& nloc, unsigned& nx) {
    const unsigned G = gridDim.x * gridDim.y * gridDim.z;
    unsigned sum, cnt, mine, sp = 0u;
    for (;;) {
        sum = 0u; cnt = 0u; mine = 0u;
#pragma unroll
        for (unsigned j = 0; j < 16; ++j) { const unsigned c = xb_ld(&bar[XB_XCNT(j)]); sum += c; cnt += (c > 0u) ? 1u : 0u; mine = (j == x) ? c : mine; }
        if (sum == G) break;
        __builtin_amdgcn_s_sleep(1);
        if ((++sp & 255u) == 0u) { if (xb_ld(&bar[XB_TMO])) break; if (sp > XB_SPIN_CAP) { atomicAdd(&bar[XB_TMO], 1u); break; } }
    }
    nloc = mine > 0u ? mine : 1u; nx = cnt > 0u ? cnt : 1u;
}

__device__ __forceinline__ void xcd_barrier(const XcdBarrier& b) {
    asm volatile("s_waitcnt vmcnt(0)" ::: "memory");
    __syncthreads();
    if (threadIdx.x == 0) {
        unsigned* bar = b.bar;
        __builtin_amdgcn_s_waitcnt(0);
        unsigned nloc = b.st[0], nx = b.st[1];
        if (nloc == 0u) { xcd_barrier_complete(bar, b.x, nloc, nx); b.st[0] = nloc; b.st[1] = nx; }
        const unsigned old = xb_add(&bar[XB_XSUB(b.x)], 1u);
        const unsigned gen = old / nloc;
        if (old + 1u == (gen + 1u) * nloc) {
            __builtin_amdgcn_fence(__ATOMIC_RELEASE, "agent");
            asm volatile("s_waitcnt vmcnt(0)" ::: "memory");
            const unsigned og = xb_add(&bar[XB_TOP], 1u);
            const unsigned tg = og / nx;
            if (og + 1u == (tg + 1u) * nx) xb_add(&bar[XB_TOPGEN], 1u);
            else XB_SPIN(xb_ld(&bar[XB_TOPGEN]) == tg, bar);
            __builtin_amdgcn_fence(__ATOMIC_ACQUIRE, "agent");
            xb_add(&bar[XB_XGEN(b.x)], 1u);
            asm volatile("s_waitcnt vmcnt(0)" ::: "memory");
        } else {
            XB_SPIN(xb_ld(&bar[XB_XGEN(b.x)]) == gen, bar);
            __builtin_amdgcn_fence(__ATOMIC_ACQUIRE, "agent");
            asm volatile("s_waitcnt vmcnt(0)" ::: "memory");
        }
    }
    __syncthreads();
}


namespace pg8 {
__device__ __forceinline__ u32x2 pack4(f32x4 v) { u32x2 w; w.x = cvt_pk_bf16(v[0], v[1]); w.y = cvt_pk_bf16(v[2], v[3]); return w; }
struct EpiProj {
    static constexpr bool PERM = true, AFTER_DRAIN = false;
    bf16_t* A; bf16_t* Q; bf16_t* KP; bf16_t* VP; bf16_t* KS; bf16_t* VS; float* out;
    __device__ __forceinline__ void operator()(const f32x4 (&acc)[2][2][4][2], const Unit& u, int wr, int wc, int fr, int fq) const {
        const int pn = u.pn;
        const int row0 = u.pm * BM + wr * 64 + fr;
        if (pn < 4) {
#pragma unroll
            for (int ai = 0; ai < 2; ++ai)
#pragma unroll
                for (int m = 0; m < 4; ++m) {
                    const int row = row0 + ai * HALF + m * 16;
                    long toff = -1;
                    if (row < NP) { const int s = row & 2047; if (s >= 2018) toff = OUT_CONVP + ((long)(row >> 11) * 30 + (s - 2018)) * 512; }
                    else { const int rr = row - NP; const int i = rr & 63; if (i >= 34) toff = OUT_CONVS + ((long)(rr >> 6) * 30 + (i - 34)) * 512; }
                    const int c = 128 * pn + 32 * wc + 8 * fq;
                    f32x4 a[2];
#pragma unroll
                    for (int n = 0; n < 2; ++n) {
                        const f32x4 x = acc[ai][0][m][n], g = acc[ai][1][m][n];
#pragma unroll
                        for (int j = 0; j < 4; ++j) a[n][j] = x[j] / (1.f + __expf(-g[j]));
                    }
                    u32x4 w; w.x = cvt_pk_bf16(a[0][0], a[0][1]); w.y = cvt_pk_bf16(a[0][2], a[0][3]); w.z = cvt_pk_bf16(a[1][0], a[1][1]); w.w = cvt_pk_bf16(a[1][2], a[1][3]);
                    *(u32x4*)(A + (size_t)row * 512 + c) = w;
                    if (toff >= 0) { *(f32x4*)(out + toff + c) = a[0]; *(f32x4*)(out + toff + c + 4) = a[1]; }
                }
        } else {
            const int sec = (pn - 4) >> 1, colbase = ((pn - 4) & 1) * 256;
#pragma unroll
            for (int ai = 0; ai < 2; ++ai)
#pragma unroll
                for (int m = 0; m < 4; ++m) {
                    const int row = row0 + ai * HALF + m * 16;
                    const bool isp = row < NP; const int rr = row - NP;
                    bf16_t* bdst; float* fdst;
                    if (sec == 0) { bdst = Q + (size_t)row * 512; fdst = nullptr; }
                    else if (sec == 1) { bdst = isp ? KP + (size_t)row * 512 : KS + ((size_t)(rr >> 6) * SKV + 2048 + (rr & 63)) * 512; fdst = isp ? out + OUT_KP + (size_t)row * 512 : out + OUT_KS + (size_t)rr * 512; }
                    else { bdst = isp ? VP + (size_t)row * 512 : VS + ((size_t)(rr >> 6) * SKV + 2048 + (rr & 63)) * 512; fdst = isp ? out + OUT_VP + (size_t)row * 512 : out + OUT_VS + (size_t)rr * 512; }
#pragma unroll
                    for (int bj = 0; bj < 2; ++bj) {
                        const int col = colbase + 128 * bj + 32 * wc + 8 * fq;
                        const f32x4 v0 = acc[ai][bj][m][0], v1 = acc[ai][bj][m][1];
                        if (sec == 0) { const f32x4 s0 = v0 * QSCALE, s1 = v1 * QSCALE; u32x4 w; w.x = cvt_pk_bf16(s0[0], s0[1]); w.y = cvt_pk_bf16(s0[2], s0[3]); w.z = cvt_pk_bf16(s1[0], s1[1]); w.w = cvt_pk_bf16(s1[2], s1[3]); *(u32x4*)(bdst + col) = w; }
                        else { u32x4 w; w.x = cvt_pk_bf16(v0[0], v0[1]); w.y = cvt_pk_bf16(v0[2], v0[3]); w.z = cvt_pk_bf16(v1[0], v1[1]); w.w = cvt_pk_bf16(v1[2], v1[3]); *(u32x4*)(bdst + col) = w;
                               *(f32x4*)(fdst + col) = v0; *(f32x4*)(fdst + col + 4) = v1; }
                    }
                }
        }
    }
};
struct EpiRes {
    static constexpr bool PERM = true, AFTER_DRAIN = false;
    const float* xp; const float* xs; float* out; bf16_t* xg; const float* gff; float* ssq;
    __device__ __forceinline__ void operator()(const f32x4 (&acc)[2][2][4][2], const Unit& u, int wr, int wc, int fr, int fq) const {
        const int row0 = u.pm * BM + wr * 64 + fr;
        f32x4 gg[2][2];
#pragma unroll
        for (int bj = 0; bj < 2; ++bj)
#pragma unroll
            for (int n = 0; n < 2; ++n) gg[bj][n] = *(const f32x4*)(gff + u.pn * BM + 128 * bj + 32 * wc + 8 * fq + 4 * n);
#pragma unroll
        for (int ai = 0; ai < 2; ++ai)
#pragma unroll
            for (int m = 0; m < 4; ++m) {
                const int row = row0 + ai * HALF + m * 16;
                const float* xr = row < NP ? xp + (size_t)row * DM : xs + (size_t)(row - NP) * DM;
                float* orow = out + (size_t)row * DM; bf16_t* grow = xg + (size_t)row * DM;
                float sq = 0.f;
#pragma unroll
                for (int bj = 0; bj < 2; ++bj) {
                    const int col = u.pn * BM + 128 * bj + 32 * wc + 8 * fq;
                    const f32x4 v0 = *(const f32x4*)(xr + col) + acc[ai][bj][m][0], v1 = *(const f32x4*)(xr + col + 4) + acc[ai][bj][m][1];
                    *(f32x4*)(orow + col) = v0; *(f32x4*)(orow + col + 4) = v1;
                    const f32x4 h0 = v0 * gg[bj][0], h1 = v1 * gg[bj][1];
                    u32x4 w; w.x = cvt_pk_bf16(h0[0], h0[1]); w.y = cvt_pk_bf16(h0[2], h0[3]); w.z = cvt_pk_bf16(h1[0], h1[1]); w.w = cvt_pk_bf16(h1[2], h1[3]);
                    *(u32x4*)(grow + col) = w;
                    sq += ((v0[0] * v0[0] + v0[1] * v0[1]) + (v0[2] * v0[2] + v0[3] * v0[3])) + ((v1[0] * v1[0] + v1[1] * v1[1]) + (v1[2] * v1[2] + v1[3] * v1[3]));
                }
                sq += __shfl_xor(sq, 16); sq += __shfl_xor(sq, 32);
                if (fq == 0) ssq[(size_t)row * 16 + u.pn * 4 + wc] = sq;
            }
    }
};
}

__device__ __forceinline__ int winrow(int n) { return n < 1024 ? (256 * ((n & 511) >> 7) + 128 * (n >> 9) + (n & 127)) : n; }
template <bool WIN> __device__ __forceinline__ void transpose_item(const float* W, int K, int N, bf16_t* WT, LAS float* scr, int item, int lane) {
    const int nblk = N / 32, kb = item / nblk, nb = item % nblk, k0 = 64 * kb, n0 = 32 * nb;
#pragma unroll 8
    for (int i = 0; i < 32; ++i) { const int kk = 2 * i + (lane >> 5); scr[kk * 33 + (lane & 31)] = W[(size_t)(k0 + kk) * N + n0 + (lane & 31)]; }
    LDS_WAIT();
    const int c = lane & 7;
#pragma unroll
    for (int j = 0; j < 4; ++j) {
        const int n = (lane >> 3) + 8 * j; const LAS float* s = scr + (8 * c) * 33 + n;
        u32x4 o; o.x = cvtpk(s[0 * 33], s[1 * 33]); o.y = cvtpk(s[2 * 33], s[3 * 33]); o.z = cvtpk(s[4 * 33], s[5 * 33]); o.w = cvtpk(s[6 * 33], s[7 * 33]);
        const int dr = WIN ? winrow(n0 + n) : (n0 + n);
        *(u32x4*)(WT + (size_t)dr * K + k0 + 8 * c) = o;
    }
    LDS_WAIT();
}
__device__ __forceinline__ void cvt_stream(const float* src, bf16_t* dst, size_t n8, size_t gt, size_t ngt) {
    for (size_t i = gt; i < n8; i += ngt) {
        const f32x4 a = *(const f32x4*)(src + i * 8), b = *(const f32x4*)(src + i * 8 + 4);
        u32x4 o; o.x = cvtpk(a[0], a[1]); o.y = cvtpk(a[2], a[3]); o.z = cvtpk(b[0], b[1]); o.w = cvtpk(b[2], b[3]);
        *(u32x4*)(dst + i * 8) = o;
    }
}
__device__ __forceinline__ void cvt_cache(const float* src, bf16_t* dst, size_t gt, size_t ngt) {
    const size_t n8 = (size_t)8 * 2048 * 512 / 8;
    for (size_t i = gt; i < n8; i += ngt) {
        const size_t e = i * 8; const size_t row = e >> 9, col = e & 511; const size_t drow = (row >> 11) * SKV + (row & 2047);
        const f32x4 a = *(const f32x4*)(src + e), b = *(const f32x4*)(src + e + 4);
        u32x4 o; o.x = cvtpk(a[0], a[1]); o.y = cvtpk(a[2], a[3]); o.z = cvtpk(b[0], b[1]); o.w = cvtpk(b[2], b[3]);
        *(u32x4*)(dst + drow * 512 + col) = o;
    }
}
__device__ __forceinline__ void rms_row_bf16(const float* xrow, const float* g, bf16_t* orow, int lane) {
    const f32x4* xr = (const f32x4*)xrow + lane; const f32x4* gr = (const f32x4*)g + lane;
    f32x4 v[4]; float s = 0.f;
#pragma unroll
    for (int j = 0; j < 4; ++j) { v[j] = xr[64 * j]; s += (v[j][0] * v[j][0] + v[j][1] * v[j][1]) + (v[j][2] * v[j][2] + v[j][3] * v[j][3]); }
    const float rstd = 1.f / sqrtf(wave_sum(s) * (1.f / DM) + EPS);
    u32x2* o8 = (u32x2*)orow + lane;
#pragma unroll
    for (int j = 0; j < 4; ++j) { const f32x4 gg = gr[64 * j]; u32x2 w; w.x = cvtpk(v[j][0] * rstd * gg[0], v[j][1] * rstd * gg[1]); w.y = cvtpk(v[j][2] * rstd * gg[2], v[j][3] * rstd * gg[3]); o8[64 * j] = w; }
}

template <bool SLICED> __device__ __forceinline__ void cvt_row_fp8(const float* src, unsigned char* dst_base, int row, float* scale_out, int lane) {
    const f32x4* xr = (const f32x4*)src + lane;
    f32x4 v[4]; float am = 0.f;
#pragma unroll
    for (int j = 0; j < 4; ++j) { v[j] = xr[64 * j]; am = fmaxf(am, fmaxf(fmaxf(fabsf(v[j][0]), fabsf(v[j][1])), fmaxf(fabsf(v[j][2]), fabsf(v[j][3])))); }
#pragma unroll
    for (int o = 1; o < 64; o <<= 1) am = fmaxf(am, __shfl_xor(am, o));
    const float sc = am > 0.f ? am * (1.f / 448.f) : 1.f, inv = 1.f / sc;
#pragma unroll
    for (int j = 0; j < 4; ++j) {
        const int eb = 256 * j + 4 * lane;
        int w = __builtin_amdgcn_cvt_pk_fp8_f32(v[j][0] * inv, v[j][1] * inv, 0, false);
        w = __builtin_amdgcn_cvt_pk_fp8_f32(v[j][2] * inv, v[j][3] * inv, w, true);
        if (SLICED) *(int*)(dst_base + ((size_t)(eb >> 7) * 16384 + row) * 128 + (eb & 127)) = w;
        else *(int*)(dst_base + (size_t)row * DM + 16 * ((eb & 511) >> 3) + (eb & 7) + (eb >= 512 ? 8 : 0)) = w;
    }
    if (lane == 0) *scale_out = sc;
}

__device__ __forceinline__ void rms_row2_bf16(const float* xa, const float* xb, const float* g, bf16_t* oa, bf16_t* ob, int lane) {
    const f32x4* ra = (const f32x4*)xa + lane; const f32x4* rb = (const f32x4*)xb + lane; const f32x4* gr = (const f32x4*)g + lane;
    f32x4 va[4], vb[4]; float sa = 0.f, sb = 0.f;
#pragma unroll
    for (int j = 0; j < 4; ++j) { va[j] = ra[64 * j]; vb[j] = rb[64 * j]; }
#pragma unroll
    for (int j = 0; j < 4; ++j) { sa += (va[j][0] * va[j][0] + va[j][1] * va[j][1]) + (va[j][2] * va[j][2] + va[j][3] * va[j][3]); sb += (vb[j][0] * vb[j][0] + vb[j][1] * vb[j][1]) + (vb[j][2] * vb[j][2] + vb[j][3] * vb[j][3]); }
    const float ra_ = 1.f / sqrtf(wave_total(sa) * (1.f / DM) + EPS), rb_ = 1.f / sqrtf(wave_total(sb) * (1.f / DM) + EPS);
    u32x2* o8a = (u32x2*)oa + lane; u32x2* o8b = (u32x2*)ob + lane;
#pragma unroll
    for (int j = 0; j < 4; ++j) { const f32x4 gg = gr[64 * j];
        u32x2 w; w.x = cvtpk(va[j][0] * ra_ * gg[0], va[j][1] * ra_ * gg[1]); w.y = cvtpk(va[j][2] * ra_ * gg[2], va[j][3] * ra_ * gg[3]); o8a[64 * j] = w;
        u32x2 z; z.x = cvtpk(vb[j][0] * rb_ * gg[0], vb[j][1] * rb_ * gg[1]); z.y = cvtpk(vb[j][2] * rb_ * gg[2], vb[j][3] * rb_ * gg[3]); o8b[64 * j] = z; }
}
__device__ __forceinline__ void phase0(const Params& p, LAS unsigned char* lds, int tid, int lane, int wave) {
    const int gw = blockIdx.x * 8 + wave, NGW = gridDim.x * 8;
    LAS float* scr = (LAS float*)(lds + wave * 16384);
    bf16_t* WINT = (bf16_t*)(p.ws + WS_WINT);
    constexpr int I_IN = 16 * (DIN / 32);
    for (int it = gw; it < I_IN; it += NGW) transpose_item<true>(p.in[6], 1024, DIN, WINT, scr, it, lane);
    bf16_t* H = (bf16_t*)(p.ws + WS_H);
    for (int m = gw; m < NT; m += 2 * NGW) {
        const int m2 = m + NGW < NT ? m + NGW : m;
        const float* xr = m < NP ? p.in[0] + (size_t)m * DM : p.in[1] + (size_t)(m - NP) * DM;
        const float* xr2 = m2 < NP ? p.in[0] + (size_t)m2 * DM : p.in[1] + (size_t)(m2 - NP) * DM;
        rms_row2_bf16(xr, xr2, p.in[5], H + (size_t)m * DM, H + (size_t)m2 * DM, lane);
    }
}
__device__ __forceinline__ void prep_late(const Params& p, LAS unsigned char* lds, int tid, int lane, int wave, int rank, int nparts) {
    const int gw = rank * 8 + wave, NGW = nparts * 8;
    LAS float* scr = (LAS float*)(lds + wave * 16384);
    const size_t gt = (size_t)rank * 512 + tid, ngt = (size_t)nparts * 512;
    cvt_cache(p.in[2], (bf16_t*)(p.ws + WS_KS), gt, ngt);
    cvt_cache(p.in[3], (bf16_t*)(p.ws + WS_VS), gt, ngt);
    bf16_t* WOUTT = (bf16_t*)(p.ws + WS_WOUTT); bf16_t* WQT = (bf16_t*)(p.ws + WS_WQT);
    constexpr int I_OUT = 16 * (1024 / 32), I_Q = 16 * (2048 / 32);
    for (int it = gw; it < I_OUT + I_Q; it += NGW) {
        if (it < I_OUT) transpose_item<false>(p.in[17], 1024, 1024, WOUTT, scr, it, lane);
        else transpose_item<false>(p.in[19], 1024, 2048, WQT, scr, it - I_OUT, lane);
    }
    cvt_stream(p.in[20], (bf16_t*)(p.ws + WS_SK), (size_t)16 * 128 * 128 / 8, gt, ngt);
    for (int r = gw; r < 2 * 16384; r += NGW) {
        const int tb = r >> 14, e = r & 16383;
        if (tb) cvt_row_fp8<true>(p.in[22] + (size_t)e * DM, p.ws + WS_PV8, e, (float*)(p.ws + WS_SCV) + e, lane);
        else cvt_row_fp8<true>(p.in[21] + (size_t)e * DM, p.ws + WS_PU8, e, (float*)(p.ws + WS_SCU) + e, lane);
    }
}

namespace att {
constexpr int KPITCH = 272, VPITCH = 320;
constexpr int L_KV = 0, KV_BYTES = 64 * KPITCH + 64 * VPITCH  , L_X = 0  , L_BIAS = BIAS_OFF, L_CA = 0  , L_CW = 94 * 1024  ;
static_assert(4 * 4096 * 4 <= 2 * KV_BYTES && 2 * KV_BYTES <= L_CW && L_CW + 31 * 1024 <= RING_BYTES, "attention LDS map");

__device__ __forceinline__ int rel_bucket(int rel) {
    const int ret = rel > 0 ? 16 : 0; const int n = rel < 0 ? -rel : rel; int v;
    if (n < 8) v = n; else if (n < 12) v = 8; else if (n < 16) v = 9; else if (n < 23) v = 10; else if (n < 32) v = 11;
    else if (n < 46) v = 12; else if (n < 64) v = 13; else if (n < 91) v = 14; else v = 15;
    return ret + v;
}
typedef short v4i16_t __attribute__((ext_vector_type(4)));
__device__ __forceinline__ s16x4 vtr(const LAS unsigned char* p) { return __builtin_bit_cast(s16x4, __builtin_amdgcn_ds_read_tr16_b64_v4i16((LAS v4i16_t*)p)); }
__device__ __forceinline__ f32x16 mfma32(bf16x8 a, bf16x8 b, f32x16 c) { return __builtin_amdgcn_mfma_f32_32x32x16_bf16(a, b, c, 0, 0, 0); }

__device__ __forceinline__ void attn_unit(const Params& p, LAS unsigned char* lds, int kind, int bb, int h, int qblk, float lam, int tid, int lane, int wid) {
    const bf16_t* Q = (const bf16_t*)(p.ws + WS_Q);
    const bf16_t* Kb = kind == 0 ? (const bf16_t*)(p.ws + WS_KP) + (size_t)bb * 2048 * 512 + h * 128 : (const bf16_t*)(p.ws + WS_KS) + (size_t)bb * SKV * 512 + h * 128;
    const bf16_t* Vb = kind == 0 ? (const bf16_t*)(p.ws + WS_VP) + (size_t)bb * 2048 * 512 + h * 128 : (const bf16_t*)(p.ws + WS_VS) + (size_t)bb * SKV * 512 + h * 128;
    bf16_t* MIX = (bf16_t*)(p.ws + WS_MIX);
    const int qrow0 = kind == 0 ? bb * 2048 + qblk * 128 : NP + bb * 64;
    const int qpos0 = kind == 0 ? qblk * 128 : 2048;
    const int ntiles = kind == 0 ? 2 * qblk + 2 : 33;
    const int rg = wid & 3, map = wid >> 2, r32 = lane & 31, hi = lane >> 5;
    const bool active = kind == 0 ? true : (rg < 2);
    const int cw = kind == 0 ? 2 * qblk + (rg >> 1) : 32;
    const int qw0 = qpos0 + 32 * rg;
    const int qabs = qw0 + r32;

    bf16x8 qf[4];
    if (active) {
        const bf16_t* qp = Q + (size_t)(qrow0 + 32 * rg + r32) * 512 + h * 128 + map * 64 + 8 * hi;
#pragma unroll
        for (int s = 0; s < 4; ++s) qf[s] = *(const bf16x8*)(qp + 16 * s);
    } else {
#pragma unroll
        for (int s = 0; s < 4; ++s) qf[s] = (bf16x8){0, 0, 0, 0, 0, 0, 0, 0};
    }
    float m = 0.f, l = 0.f;
    f32x16 negm;
#pragma unroll
    for (int r = 0; r < 16; ++r) negm[r] = 0.f;
    f32x16 o[4];
#pragma unroll
    for (int mt = 0; mt < 4; ++mt)
#pragma unroll
        for (int r = 0; r < 16; ++r) o[mt][r] = 0.f;

    const int srow0 = tid >> 4, sch = tid & 15;
    const LAS float* btab = (const LAS float*)(lds + L_BIAS) + h * 320;
    const int vlane = (4 * hi + ((lane & 15) >> 2)) * VPITCH + (16 * ((lane >> 4) & 1) + 4 * (lane & 3)) * 2;
    u32x4 kA[2], vA[2], kB[2], vB[2];
#define ATT_LOAD(KR, VR, T) do { _Pragma("unroll") for (int i_ = 0; i_ < 2; ++i_) { const size_t off_ = (size_t)((T) * 64 + srow0 + 32 * i_) * 512 + sch * 8; KR[i_] = *(const u32x4*)(Kb + off_); VR[i_] = *(const u32x4*)(Vb + off_); } } while (0)
#define ATT_STORE(KR, VR, BUF) do { _Pragma("unroll") for (int i_ = 0; i_ < 2; ++i_) { \
        *(LAS u32x4*)(lds + L_KV + (BUF) * KV_BYTES + (srow0 + 32 * i_) * KPITCH + sch * 16) = KR[i_]; \
        *(LAS u32x4*)(lds + L_KV + (BUF) * KV_BYTES + 64 * KPITCH + (srow0 + 32 * i_) * VPITCH + sch * 16) = VR[i_]; } } while (0)
    auto compute = [&](int t, int buf) {
        const LAS unsigned char* kbuf = lds + L_KV + buf * KV_BYTES;
        const LAS unsigned char* vbuf = kbuf + 64 * KPITCH;
        f32x16 p0, p1;
        const int kabs0 = t * 64;
        const LAS unsigned char* kb = kbuf + r32 * KPITCH + (map * 8 + hi) * 16;
        {
            const bf16x8 a0 = *(const LAS bf16x8*)(kb), a1 = *(const LAS bf16x8*)(kb + 32 * KPITCH);
            if (kabs0 + 63 - qw0 > -128) {
                const LAS float* bt = btab + (kabs0 - qabs + 256 + 4 * hi);
#pragma unroll
                for (int r = 0; r < 16; ++r) { p0[r] = bt[(r & 3) + 8 * (r >> 2)] - m; p1[r] = bt[32 + (r & 3) + 8 * (r >> 2)] - m; }
                p0 = mfma32(a0, qf[0], p0); p1 = mfma32(a1, qf[0], p1);
            } else { p0 = mfma32(a0, qf[0], negm); p1 = mfma32(a1, qf[0], negm); }
        }
#pragma unroll
        for (int s = 1; s < 4; ++s) {
            const bf16x8 a0 = *(const LAS bf16x8*)(kb + s * 32), a1 = *(const LAS bf16x8*)(kb + 32 * KPITCH + s * 32);
            p0 = mfma32(a0, qf[s], p0); p1 = mfma32(a1, qf[s], p1);
        }
        float mx = fmaxf(p0[0], p1[0]);
#pragma unroll
        for (int r = 1; r < 16; ++r) mx = fmaxf(mx, fmaxf(p0[r], p1[r]));
        { const auto rr = __builtin_amdgcn_permlane32_swap(__float_as_uint(mx), __float_as_uint(mx), false, false); mx = fmaxf(__uint_as_float(rr[0]), __uint_as_float(rr[1])); }
        if (__any(mx > 8.f)) {
            const float dl = fmaxf(mx, 0.f);
            m += dl;
            const float alpha = __builtin_amdgcn_exp2f(-dl);
            l *= alpha;
#pragma unroll
            for (int r = 0; r < 16; ++r) { p0[r] -= dl; p1[r] -= dl; negm[r] = -m; }
#pragma unroll
            for (int mt = 0; mt < 4; ++mt)
#pragma unroll
                for (int r = 0; r < 16; ++r) o[mt][r] *= alpha;
        }
        float rs = 0.f;
#pragma unroll
        for (int r = 0; r < 16; ++r) { p0[r] = __builtin_amdgcn_exp2f(p0[r]); p1[r] = __builtin_amdgcn_exp2f(p1[r]); rs += p0[r] + p1[r]; }
        l += rs;
#pragma unroll
        for (int t2 = 0; t2 < 2; ++t2)
#pragma unroll
            for (int s = 0; s < 2; ++s) {
                u32x4 bw;
                if (t2 == 0) { bw.x = cvtpk(p0[8 * s + 0], p0[8 * s + 1]); bw.y = cvtpk(p0[8 * s + 2], p0[8 * s + 3]); bw.z = cvtpk(p0[8 * s + 4], p0[8 * s + 5]); bw.w = cvtpk(p0[8 * s + 6], p0[8 * s + 7]); }
                else { bw.x = cvtpk(p1[8 * s + 0], p1[8 * s + 1]); bw.y = cvtpk(p1[8 * s + 2], p1[8 * s + 3]); bw.z = cvtpk(p1[8 * s + 4], p1[8 * s + 5]); bw.w = cvtpk(p1[8 * s + 6], p1[8 * s + 7]); }
                const bf16x8 B = __builtin_bit_cast(bf16x8, bw);
                const LAS unsigned char* vb = vbuf + vlane + (32 * t2 + 16 * s) * VPITCH;
#pragma unroll
                for (int mt = 0; mt < 4; ++mt) {
                    const s16x4 lo = vtr(vb + mt * 64), hi8 = vtr(vb + mt * 64 + 8 * VPITCH);
                    const bf16x8 A = (bf16x8){lo[0], lo[1], lo[2], lo[3], hi8[0], hi8[1], hi8[2], hi8[3]};
                    o[mt] = mfma32(A, B, o[mt]);
                }
            }
    };
    ATT_LOAD(kA, vA, 0);
    if (ntiles > 1) ATT_LOAD(kB, vB, 1);
    ATT_STORE(kA, vA, 0);
    if (ntiles > 2) ATT_LOAD(kA, vA, 2);
    __syncthreads();
    for (int t = 0; t < ntiles; t += 2) {
        if (t + 1 < ntiles) { ATT_STORE(kB, vB, 1); if (t + 3 < ntiles) ATT_LOAD(kB, vB, t + 3); }
        if (active && t <= cw) compute(t, 0);
        __syncthreads();
        if (t + 1 >= ntiles) break;
        if (t + 2 < ntiles) { ATT_STORE(kA, vA, 0); if (t + 4 < ntiles) ATT_LOAD(kA, vA, t + 4); }
        if (active && t + 1 <= cw) compute(t + 1, 1);
        __syncthreads();
    }
#undef ATT_LOAD
#undef ATT_STORE
    l += __shfl_xor(l, 32);
    const float inv = 1.f / l;
    LAS float* X = (LAS float*)(lds + L_X) + rg * 4096;
    if (active && map == 1) {
        const float sc = -lam * inv;
#pragma unroll
        for (int mt = 0; mt < 4; ++mt)
#pragma unroll
            for (int r = 0; r < 16; ++r) X[(mt * 16 + r) * 64 + lane] = o[mt][r] * sc;
    }
    __syncthreads();
    if (active && map == 0) {
        float ss = 0.f;
#pragma unroll
        for (int mt = 0; mt < 4; ++mt)
#pragma unroll
            for (int r = 0; r < 16; ++r) { const float v = o[mt][r] * inv + X[(mt * 16 + r) * 64 + lane]; o[mt][r] = v; ss += v * v; }
        ss += __shfl_xor(ss, 32);
        const float rsn = 0.8f / sqrtf(ss * (1.f / 128.f) + EPS);
        bf16_t* orow = MIX + (size_t)(qrow0 + 32 * rg + r32) * 1024 + 512 + h * 128;
        const float* sg = p.in[15];
#pragma unroll
        for (int mt = 0; mt < 4; ++mt)
#pragma unroll
            for (int g4 = 0; g4 < 4; ++g4) {
                const int e = 32 * mt + 8 * g4 + 4 * hi;
                const f32x4 gg = *(const f32x4*)(sg + e);
                u32x2 w; w.x = cvtpk(o[mt][4 * g4 + 0] * rsn * gg[0], o[mt][4 * g4 + 1] * rsn * gg[1]); w.y = cvtpk(o[mt][4 * g4 + 2] * rsn * gg[2], o[mt][4 * g4 + 3] * rsn * gg[3]);
                *(u32x2*)(orow + e) = w;
            }
    }
    __syncthreads();
}

__device__ __forceinline__ void unpack8(const u32x4 w, float (&f)[8]) { f[0] = bflo(w.x); f[1] = bfhi(w.x); f[2] = bflo(w.y); f[3] = bfhi(w.y); f[4] = bflo(w.z); f[5] = bfhi(w.z); f[6] = bflo(w.w); f[7] = bfhi(w.w); }
__device__ __forceinline__ void conv_unit(const Params& p, LAS unsigned char* lds, int cu, int tid, int lane, int wid) {
    const bf16_t* A = (const bf16_t*)(p.ws + WS_A);
    bf16_t* MIX = (bf16_t*)(p.ws + WS_MIX);
    const float* cb = p.in[8]; const float* lg = p.in[9]; const float* lb = p.in[10]; const float* st = p.in[4];
    const int row0 = cu * 64;
    const bool isp = row0 < NP;
    const int s0 = isp ? (row0 & 2047) : 0, rbase = row0 - s0, bd = isp ? 0 : ((row0 - NP) >> 6);
    for (int c = tid; c < 94 * 64; c += 512) {
        const int rr = c >> 6, ch = c & 63, sp = s0 - 30 + rr;
        u32x4 v = (u32x4){0u, 0u, 0u, 0u};
        if (sp >= 0) v = *(const u32x4*)(A + (size_t)(rbase + sp) * 512 + ch * 8);
        else if (!isp) { const float* sr = st + ((size_t)bd * 30 + (30 + sp)) * 512 + ch * 8; const f32x4 a0 = *(const f32x4*)sr, a1 = *(const f32x4*)(sr + 4);
            v.x = cvtpk(a0[0], a0[1]); v.y = cvtpk(a0[2], a0[3]); v.z = cvtpk(a1[0], a1[1]); v.w = cvtpk(a1[2], a1[3]); }
        *(LAS u32x4*)(lds + L_CA + rr * 1024 + ch * 16) = v;
    }
    __syncthreads();
    const int c0 = lane * 8;
    float bias8[8], g8[8], b8[8];
    { const f32x4 x0 = *(const f32x4*)(cb + c0), x1 = *(const f32x4*)(cb + c0 + 4), y0 = *(const f32x4*)(lg + c0), y1 = *(const f32x4*)(lg + c0 + 4), z0 = *(const f32x4*)(lb + c0), z1 = *(const f32x4*)(lb + c0 + 4);
#pragma unroll
      for (int q = 0; q < 4; ++q) { bias8[q] = x0[q]; bias8[4 + q] = x1[q]; g8[q] = y0[q]; g8[4 + q] = y1[q]; b8[q] = z0[q]; b8[4 + q] = z1[q]; } }
    for (int grp = 0; grp < 2; ++grp) {
        const int t0 = wid * 8 + grp * 4;
        float acc[4][8];
#pragma unroll
        for (int q = 0; q < 4; ++q)
#pragma unroll
            for (int c = 0; c < 8; ++c) acc[q][c] = bias8[c];
        const LAS unsigned char* ap = lds + L_CA + t0 * 1024 + lane * 16;
        const LAS unsigned char* wp = lds + L_CW + lane * 16;
#pragma unroll 1
        for (int j = 0; j < 31; ++j) {
            float w[8]; unpack8(*(const LAS u32x4*)(wp + j * 1024), w);
#pragma unroll
            for (int q = 0; q < 4; ++q) {
                float a[8]; unpack8(*(const LAS u32x4*)(ap + (j + q) * 1024), a);
#pragma unroll
                for (int c = 0; c < 8; ++c) acc[q][c] += w[c] * a[c];
            }
        }
#pragma unroll
        for (int q = 0; q < 4; ++q) {
            float sm = 0.f;
#pragma unroll
            for (int c = 0; c < 8; ++c) sm += acc[q][c];
            const float mu = wave_total(sm) * (1.f / 512.f);
            float sv = 0.f;
#pragma unroll
            for (int c = 0; c < 8; ++c) { acc[q][c] -= mu; sv += acc[q][c] * acc[q][c]; }
            const float rstd = 1.f / sqrtf(wave_total(sv) * (1.f / 512.f) + EPS);
            float y[8];
#pragma unroll
            for (int c = 0; c < 8; ++c) { y[c] = acc[q][c] * rstd * g8[c] + b8[c]; y[c] = y[c] / (1.f + __expf(-y[c])); }
            u32x4 w; w.x = cvtpk(y[0], y[1]); w.y = cvtpk(y[2], y[3]); w.z = cvtpk(y[4], y[5]); w.w = cvtpk(y[6], y[7]);
            *(u32x4*)(MIX + (size_t)(row0 + t0 + q) * 1024 + c0) = w;
        }
    }
}

constexpr int N_SAMPLE_UNITS = 32, N_PROMPT_UNITS = 1024, N_CONV_UNITS = NT / 64, N_UNITS = N_SAMPLE_UNITS + N_PROMPT_UNITS + N_CONV_UNITS;

__device__ __forceinline__ void phase2(const Params& p, LAS unsigned char* lds, int tid, int lane, int wid, int cidx, int mode) {
    LAS float* bt = (LAS float*)(lds + L_BIAS);
    for (int e = tid; e < 4 * 320; e += 512) { const int hh = e / 320, rel = (e % 320) - 256; bt[e] = (p.in[16][rel_bucket(rel) * 4 + hh] - p.in[16][15 * 4 + hh]) * LOG2E; }
    for (int c = tid; c < 31 * 64; c += 512) {
        const float* wr = p.in[7] + (size_t)c * 8; const f32x4 a0 = *(const f32x4*)wr, a1 = *(const f32x4*)(wr + 4);
        u32x4 v; v.x = cvtpk(a0[0], a0[1]); v.y = cvtpk(a0[2], a0[3]); v.z = cvtpk(a1[0], a1[1]); v.w = cvtpk(a1[2], a1[3]);
        *(LAS u32x4*)(lds + L_CW + c * 16) = v;
    }
    const float d1 = wave_sum(p.in[11][lane] * p.in[12][lane]), d2 = wave_sum(p.in[13][lane] * p.in[14][lane]);
    const float lam = expf(d1) - expf(d2) + 0.2f;
    unsigned* ctr = (unsigned*)(p.ws + WS_CTL) + 64 * cidx;
    volatile LAS unsigned* sw = (volatile LAS unsigned*)(lds + MISC_OFF);
    __syncthreads();
    for (;;) {
        __syncthreads();
        if (tid == 0) sw[0] = atomicAdd(ctr, 1u);
        __syncthreads();
        const int u = (int)sw[0];
        if (u >= N_UNITS) break;
        if (mode == 1 && u >= N_SAMPLE_UNITS + N_PROMPT_UNITS) continue;
        if (mode == 2 && u < N_SAMPLE_UNITS + N_PROMPT_UNITS) continue;
        int tid_ = tid; asm volatile("" : "+v"(tid_));
        if (u < N_SAMPLE_UNITS + N_PROMPT_UNITS) {
            const int v = u - N_SAMPLE_UNITS; const int bh = v & 63; const bool smp = u < N_SAMPLE_UNITS;
            attn_unit(p, lds, smp ? 1 : 0, smp ? (u >> 2) : (bh >> 2), smp ? (u & 3) : (bh & 3), smp ? 0 : 15 - (v >> 6), lam, tid_, tid_ & 63, wid);
        } else conv_unit(p, lds, u - N_SAMPLE_UNITS - N_PROMPT_UNITS, tid_, tid_ & 63, wid);
    }
}
}

template <class F> __device__ __forceinline__ void mini_gemm(const bf16_t* A, const bf16_t* Bt, int N, int lane, int wave, F epi) {
    const int ntasks = 16 * (N / 64), G = gridDim.x;
    const int fr = lane & 15, fq = lane >> 4;
    for (int task = wave * G + (int)blockIdx.x; task < ntasks; task += 8 * G) {
        const int rb = task & 15, cb = task >> 4;
        pg8::f32x4 acc[2][4];
#pragma unroll
        for (int m = 0; m < 2; ++m)
#pragma unroll
            for (int n = 0; n < 4; ++n) acc[m][n] = (pg8::f32x4){0.f, 0.f, 0.f, 0.f};
        const bf16_t* ap = A + (size_t)(rb * 32 + fr) * 1024 + 8 * fq;
        const bf16_t* bp = Bt + (size_t)(cb * 64 + fr) * 1024 + 8 * fq;
#pragma unroll 4
        for (int k0 = 0; k0 < 1024; k0 += 32) {
            const bf16x8 a0 = *(const bf16x8*)(ap + k0), a1 = *(const bf16x8*)(ap + 16 * 1024 + k0);
            bf16x8 b[4];
#pragma unroll
            for (int n = 0; n < 4; ++n) b[n] = *(const bf16x8*)(bp + (size_t)n * 16 * 1024 + k0);
#pragma unroll
            for (int n = 0; n < 4; ++n) { acc[0][n] = __builtin_amdgcn_mfma_f32_16x16x32_bf16(b[n], a0, acc[0][n], 0, 0, 0); acc[1][n] = __builtin_amdgcn_mfma_f32_16x16x32_bf16(b[n], a1, acc[1][n], 0, 0, 0); }
        }
#pragma unroll
        for (int m = 0; m < 2; ++m) epi(rb * 32 + 16 * m + fr, cb, fq, acc[m]);
    }
}

__device__ __forceinline__ void phase3b(const Params& p, int lane, int wave) {
    const int gw = blockIdx.x * 8 + wave, NGW = gridDim.x * 8;
    bf16_t* H2 = (bf16_t*)(p.ws + WS_H2);
    for (int m = gw; m < NT; m += 2 * NGW) { const int m2 = m + NGW < NT ? m + NGW : m; rms_row2_bf16(p.out + (size_t)m * DM, p.out + (size_t)m2 * DM, p.in[18], H2 + (size_t)m * DM, H2 + (size_t)m2 * DM, lane); }
}

constexpr int P4B_KPITCH = 272, P4B_K_BYTES = 128 * P4B_KPITCH, P4B_Q_BYTES = 32 * P4B_KPITCH;
static_assert(P4B_K_BYTES + 8 * P4B_Q_BYTES <= RING_BYTES, "P4b LDS map");
__device__ __forceinline__ void phase4b(const Params& p, LAS unsigned char* lds, int tid, int lane, int wave) {
    const bf16_t* QP = (const bf16_t*)(p.ws + WS_QP); const bf16_t* SK = (const bf16_t*)(p.ws + WS_SK);
    float* TK = (float*)(p.ws + WS_TK);
    const int r32 = lane & 31, hi = lane >> 5;
    const int G = gridDim.x;
    for (int rp = blockIdx.x & 15; rp < 16; rp += (G < 16 ? G : 16)) {
        const int nbr = (G - rp + 15) >> 4, member = (int)blockIdx.x >> 4;
        __syncthreads();
        for (int c = tid; c < 128 * 16; c += 512) { const int row = c >> 4, ch = c & 15; *(LAS u32x4*)(lds + row * P4B_KPITCH + ch * 16) = *(const u32x4*)(SK + ((size_t)rp * 128 + row) * 128 + ch * 8); }
        __syncthreads();
        LAS unsigned char* qs = lds + P4B_K_BYTES + wave * P4B_Q_BYTES;
        for (int tg = member * 8 + wave; tg < NT / 32; tg += nbr * 8) {
            const int t0 = tg * 32;
#pragma unroll
            for (int i = 0; i < 8; ++i) { const int row = 4 * i + (lane >> 4), ch = lane & 15; *(LAS u32x4*)(qs + row * P4B_KPITCH + ch * 16) = *(const u32x4*)(QP + (size_t)(t0 + row) * 2048 + rp * 128 + ch * 8); }
            bf16x8 qf[8];
#pragma unroll
            for (int s = 0; s < 8; ++s) qf[s] = *(const LAS bf16x8*)(qs + r32 * P4B_KPITCH + (2 * s + hi) * 16);
            float v[64];
#pragma unroll
            for (int mt = 0; mt < 4; ++mt) {
                f32x16 S;
#pragma unroll
                for (int r = 0; r < 16; ++r) S[r] = 0.f;
                const LAS unsigned char* kp = lds + (32 * mt + r32) * P4B_KPITCH + hi * 16;
#pragma unroll
                for (int s = 0; s < 8; ++s) S = att::mfma32(*(const LAS bf16x8*)(kp + s * 32), qf[s], S);
#pragma unroll
                for (int r = 0; r < 16; ++r) { const int n = 32 * mt + (r & 3) + 8 * (r >> 2) + 4 * hi; v[mt * 16 + r] = __uint_as_float((__float_as_uint(S[r]) & ~127u) | (unsigned)(127 - n)); }
            }
            SORT16_DESC(v, 0); SORT16_DESC(v, 16); SORT16_DESC(v, 32); SORT16_DESC(v, 48);
#pragma unroll
            for (int i = 0; i < 16; ++i) { v[i] = fmaxf(v[i], v[31 - i]); v[32 + i] = fmaxf(v[32 + i], v[63 - i]); }
            BITONIC16_DESC(v, 0); BITONIC16_DESC(v, 32);
#pragma unroll
            for (int i = 0; i < 16; ++i) v[i] = fmaxf(v[i], v[47 - i]);
            BITONIC16_DESC(v, 0);
            float w[16];
#pragma unroll
            for (int i = 0; i < 16; ++i) w[i] = fmaxf(v[i], __shfl_xor(v[15 - i], 32));
            BITONIC16_DESC(w, 0);
            if (hi == 0) {
                f32x4* dst = (f32x4*)(TK + ((size_t)(t0 + r32) * 16 + rp) * 16);
#pragma unroll
                for (int q = 0; q < 4; ++q) dst[q] = (f32x4){w[4 * q], w[4 * q + 1], w[4 * q + 2], w[4 * q + 3]};
            }
        }
    }
}

__device__ __forceinline__ void phase5a(const Params& p, int tid) {
    const float* TK = (const float*)(p.ws + WS_TK);
    int* IDX = (int*)(p.ws + WS_IDX); float* GATE = (float*)(p.ws + WS_GATE);
    const float NEG_INF = -__builtin_huge_valf();
    for (int item = blockIdx.x * 512 + tid; item < NT * 8; item += gridDim.x * 512) {
        const int tok = item >> 3, r = item & 7;
        const f32x4* pa = (const f32x4*)(TK + ((size_t)tok * 16 + 2 * r) * 16);
        float a[16], b[16]; int ia[16], ib[16];
#pragma unroll
        for (int q = 0; q < 4; ++q) { const f32x4 x = pa[q], y = pa[4 + q];
#pragma unroll
            for (int j = 0; j < 4; ++j) { a[4 * q + j] = x[j]; b[4 * q + j] = y[j]; } }
#pragma unroll
        for (int i = 0; i < 16; ++i) { const unsigned ua = __float_as_uint(a[i]), ub = __float_as_uint(b[i]); ia[i] = 127 - (int)(ua & 127u); ib[i] = 127 - (int)(ub & 127u); a[i] = __uint_as_float(ua & ~127u); b[i] = __uint_as_float(ub & ~127u); }
        float cv[50]; int cid[50];
        {
            int c = 0;
#pragma unroll
            for (int i = 0; i < 16; ++i)
#pragma unroll
                for (int j = 0; j < 16; ++j)
                    if ((i + 1) * (j + 1) <= 16) { const float s = a[i] + b[j]; cv[c] = __uint_as_float((__float_as_uint(s) & ~63u) | (unsigned)(63 - c)); cid[c] = ia[i] * 128 + ib[j]; ++c; }
        }
        float best[16]; int bid[16];
#pragma unroll
        for (int it = 0; it < 16; ++it) {
            float mx = cv[0];
#pragma unroll
            for (int c = 1; c < 50; ++c) mx = fmaxf(mx, cv[c]);
            int id = 0;
#pragma unroll
            for (int c = 0; c < 50; ++c) { const bool hit = cv[c] == mx; id = hit ? cid[c] : id; cv[c] = hit ? NEG_INF : cv[c]; }
            best[it] = __uint_as_float(__float_as_uint(mx) & ~63u); bid[it] = id;
        }
        float ssum = 0.f;
        { const f32x4* sp = (const f32x4*)((const float*)(p.ws + WS_SSQ) + (size_t)tok * 16);
#pragma unroll
          for (int q = 0; q < 4; ++q) { const f32x4 v4 = sp[q]; ssum += (v4[0] + v4[1]) + (v4[2] + v4[3]); } }
        const float rstd = 1.f / sqrtf(ssum * (1.f / DM) + EPS);
        if (r == 0) ((float*)(p.ws + WS_RSTD))[tok] = rstd;
        float e[16], sum = 0.f;
#pragma unroll
        for (int k = 0; k < 16; ++k) { e[k] = __expf((best[k] - best[0]) * rstd); sum += e[k]; }
        const float rinv = 1.f / sum;
        int* io = IDX + (size_t)tok * 128 + r * 16; float* go = GATE + (size_t)tok * 128 + r * 16;
#pragma unroll
        for (int k = 0; k < 16; ++k) { io[k] = bid[k]; go[k] = e[k] * rinv; }
    }
}

__device__ __forceinline__ float gelu_erf(float x) { return 0.5f * x * (1.f + erff(x * 0.70710678118654752f)); }
__device__ __forceinline__ void fp8x16_to_f32(const u32x4 q, float (&f)[16]) {
    const f32x2 c0 = __builtin_amdgcn_cvt_pk_f32_fp8(q.x, false), c1 = __builtin_amdgcn_cvt_pk_f32_fp8(q.x, true), c2 = __builtin_amdgcn_cvt_pk_f32_fp8(q.y, false), c3 = __builtin_amdgcn_cvt_pk_f32_fp8(q.y, true);
    const f32x2 c4 = __builtin_amdgcn_cvt_pk_f32_fp8(q.z, false), c5 = __builtin_amdgcn_cvt_pk_f32_fp8(q.z, true), c6 = __builtin_amdgcn_cvt_pk_f32_fp8(q.w, false), c7 = __builtin_amdgcn_cvt_pk_f32_fp8(q.w, true);
    f[0] = c0.x; f[1] = c0.y; f[2] = c1.x; f[3] = c1.y; f[4] = c2.x; f[5] = c2.y; f[6] = c3.x; f[7] = c3.y;
    f[8] = c4.x; f[9] = c4.y; f[10] = c5.x; f[11] = c5.y; f[12] = c6.x; f[13] = c6.y; f[14] = c7.x; f[15] = c7.y;
}
__device__ __forceinline__ void slice_group(int& x, int& gwx, int& nwx, int wave) {
    x = blockIdx.x & 7; const int nbx = ((int)gridDim.x - x + 7) >> 3; gwx = ((int)blockIdx.x >> 3) * 8 + wave; nwx = nbx * 8;
}
__device__ __forceinline__ void phase5u(const Params& p, LAS unsigned char* lds, int lane, int wave) {
    int x, gwx, nwx; slice_group(x, gwx, nwx, wave);
    const unsigned char* PU8 = p.ws + WS_PU8 + (size_t)x * 16384 * 128;
    const bf16_t* H2 = (const bf16_t*)(p.ws + WS_XG) + 128 * x;
    const int* IDX = (const int*)(p.ws + WS_IDX); float* PACT = (float*)(p.ws + WS_PACT) + (size_t)x * NT * 128;
    LAS int* l_idx = (LAS int*)(lds + wave * 512);
    const int g = lane >> 3, sub = lane & 7;
    const unsigned char* rowp = PU8 + sub * 16;
    int r_idxA = 0, r_idxB = 0;
    u32x4 hA0, hA1, hB0, hB1; hA0 = hA1 = hB0 = hB1 = (u32x4){0u, 0u, 0u, 0u};
    u32x4 qA[16], qB[16];
#define P5U_LOADIDX(T) do { if ((T) < NT) { r_idxA = IDX[(size_t)(T) * 128 + lane]; r_idxB = IDX[(size_t)(T) * 128 + 64 + lane]; } } while (0)
#define P5U_ISSUE(Q, H0, H1, T) do { if ((T) < NT) { l_idx[lane] = r_idxA; l_idx[64 + lane] = r_idxB; \
        H0 = *(const u32x4*)(H2 + (size_t)(T) * DM + 16 * sub); H1 = *(const u32x4*)(H2 + (size_t)(T) * DM + 16 * sub + 8); \
        _Pragma("unroll") for (int q_ = 0; q_ < 4; ++q_) { const u32x4 iv = *(const LAS u32x4*)(l_idx + 16 * g + 4 * q_); \
            Q[4 * q_] = *(const u32x4*)(rowp + (size_t)iv.x * 128); Q[4 * q_ + 1] = *(const u32x4*)(rowp + (size_t)iv.y * 128); \
            Q[4 * q_ + 2] = *(const u32x4*)(rowp + (size_t)iv.z * 128); Q[4 * q_ + 3] = *(const u32x4*)(rowp + (size_t)iv.w * 128); } } } while (0)
#define P5U_COMPUTE(Q, H0, H1, T) do { \
        f32x2 hf[8]; \
        hf[0] = (f32x2){bflo(H0.x), bfhi(H0.x)}; hf[1] = (f32x2){bflo(H0.y), bfhi(H0.y)}; hf[2] = (f32x2){bflo(H0.z), bfhi(H0.z)}; hf[3] = (f32x2){bflo(H0.w), bfhi(H0.w)}; \
        hf[4] = (f32x2){bflo(H1.x), bfhi(H1.x)}; hf[5] = (f32x2){bflo(H1.y), bfhi(H1.y)}; hf[6] = (f32x2){bflo(H1.z), bfhi(H1.z)}; hf[7] = (f32x2){bflo(H1.w), bfhi(H1.w)}; \
        float resA = 0.f, resB = 0.f; \
        _Pragma("unroll") for (int i = 0; i < 16; ++i) { \
            f32x2 s2 = __builtin_amdgcn_cvt_pk_f32_fp8(Q[i].x, false) * hf[0]; \
            s2 = __builtin_elementwise_fma(__builtin_amdgcn_cvt_pk_f32_fp8(Q[i].x, true), hf[1], s2); \
            s2 = __builtin_elementwise_fma(__builtin_amdgcn_cvt_pk_f32_fp8(Q[i].y, false), hf[2], s2); \
            s2 = __builtin_elementwise_fma(__builtin_amdgcn_cvt_pk_f32_fp8(Q[i].y, true), hf[3], s2); \
            s2 = __builtin_elementwise_fma(__builtin_amdgcn_cvt_pk_f32_fp8(Q[i].z, false), hf[4], s2); \
            s2 = __builtin_elementwise_fma(__builtin_amdgcn_cvt_pk_f32_fp8(Q[i].z, true), hf[5], s2); \
            s2 = __builtin_elementwise_fma(__builtin_amdgcn_cvt_pk_f32_fp8(Q[i].w, false), hf[6], s2); \
            s2 = __builtin_elementwise_fma(__builtin_amdgcn_cvt_pk_f32_fp8(Q[i].w, true), hf[7], s2); \
            float sr = s2.x + s2.y; \
            DPP_ADD(sr, 0xB1); DPP_ADD(sr, 0x4E); DPP_ADD(sr, 0x141); \
            if (i < 8) resA = (sub == i) ? sr : resA; else resB = (sub == i - 8) ? sr : resB; } \
        PACT[(size_t)(T) * 128 + 16 * g + sub] = resA; PACT[(size_t)(T) * 128 + 16 * g + 8 + sub] = resB; } while (0)
    int tok = gwx;
    P5U_LOADIDX(tok);
    P5U_ISSUE(qA, hA0, hA1, tok);
    P5U_LOADIDX(tok + nwx);
    for (; tok < NT; tok += 2 * nwx) {
        P5U_ISSUE(qB, hB0, hB1, tok + nwx);
        P5U_LOADIDX(tok + 2 * nwx);
        P5U_COMPUTE(qA, hA0, hA1, tok);
        if (tok + nwx >= NT) break;
        P5U_ISSUE(qA, hA0, hA1, tok + 2 * nwx);
        P5U_LOADIDX(tok + 3 * nwx);
        P5U_COMPUTE(qB, hB0, hB1, tok + nwx);
    }
#undef P5U_LOADIDX
#undef P5U_ISSUE
#undef P5U_COMPUTE
}
__device__ __forceinline__ void phase5c(const Params& p, int tid) {
    const float* PACT = (const float*)(p.ws + WS_PACT); const float* SCU = (const float*)(p.ws + WS_SCU); const float* SCV = (const float*)(p.ws + WS_SCV);
    const int* IDX = (const int*)(p.ws + WS_IDX); const float* GATE = (const float*)(p.ws + WS_GATE); float* COEF = (float*)(p.ws + WS_COEF); const float* RSTD = (const float*)(p.ws + WS_RSTD);
    const size_t n = (size_t)NT * 128, n4 = n / 4, stride = (size_t)gridDim.x * 512;
    for (size_t i0 = (size_t)blockIdx.x * 512 + tid; i0 < n4; i0 += 2 * stride) {
        f32x4 a[2], g[2]; u32x4 e[2]; f32x4 pa[2][8]; float rs[2];
#pragma unroll
        for (int u = 0; u < 2; ++u) {
            const size_t it = (i0 + u * stride < n4 ? i0 + u * stride : i0) * 4;
#pragma unroll
            for (int xx = 0; xx < 8; ++xx) pa[u][xx] = *(const f32x4*)(PACT + (size_t)xx * n + it);
            e[u] = *(const u32x4*)(IDX + it); g[u] = *(const f32x4*)(GATE + it); rs[u] = RSTD[it >> 7];
        }
        float su[2][4], sv[2][4];
#pragma unroll
        for (int u = 0; u < 2; ++u)
#pragma unroll
            for (int j = 0; j < 4; ++j) { su[u][j] = SCU[e[u][j]]; sv[u][j] = SCV[e[u][j]]; }
#pragma unroll
        for (int u = 0; u < 2; ++u) {
            a[u] = ((pa[u][0] + pa[u][1]) + (pa[u][2] + pa[u][3])) + ((pa[u][4] + pa[u][5]) + (pa[u][6] + pa[u][7]));
            f32x4 c;
#pragma unroll
            for (int j = 0; j < 4; ++j) c[j] = g[u][j] * gelu_erf(a[u][j] * (rs[u] * su[u][j])) * sv[u][j];
            if (i0 + u * stride < n4) *(f32x4*)(COEF + (i0 + u * stride) * 4) = c;
        }
    }
}

constexpr int P5V_LDS_PER_WAVE = 1024 + 8 * 136 * 4;
__device__ __forceinline__ void phase5v(const Params& p, LAS unsigned char* lds, int lane, int wave) {
    int x, gwx, nwx; slice_group(x, gwx, nwx, wave);
    const unsigned char* PV8 = p.ws + WS_PV8 + (size_t)x * 16384 * 128;
    const int* IDX = (const int*)(p.ws + WS_IDX); const float* COEF = (const float*)(p.ws + WS_COEF);
    LAS int* l_idx = (LAS int*)(lds + wave * P5V_LDS_PER_WAVE); LAS float* l_cf = (LAS float*)(l_idx + 128); LAS float* red = l_cf + 128;
    const int g = lane >> 3, sub = lane & 7;
    const unsigned char* rowp = PV8 + sub * 16;
    const int c1 = 16 * (lane & 7) + (lane >> 3);
    int r_idxA = 0, r_idxB = 0; float r_cA = 0.f, r_cB = 0.f;
    u32x4 qA[16], qB[16]; f32x4 cfA[4], cfB[4]; float xA0 = 0.f, xA1 = 0.f, xB0 = 0.f, xB1 = 0.f;
#define P5V_LOADIDX(T) do { if ((T) < NT) { r_idxA = IDX[(size_t)(T) * 128 + lane]; r_idxB = IDX[(size_t)(T) * 128 + 64 + lane]; r_cA = COEF[(size_t)(T) * 128 + lane]; r_cB = COEF[(size_t)(T) * 128 + 64 + lane]; } } while (0)
#define P5V_ISSUE(Q, CF, X0, X1, T) do { if ((T) < NT) { l_idx[lane] = r_idxA; l_idx[64 + lane] = r_idxB; l_cf[lane] = r_cA; l_cf[64 + lane] = r_cB; \
        { const float* xr_ = p.out + (size_t)(T) * DM + 128 * x; X0 = xr_[c1]; X1 = xr_[c1 + 8]; } \
        _Pragma("unroll") for (int q_ = 0; q_ < 4; ++q_) { const u32x4 iv = *(const LAS u32x4*)(l_idx + 16 * g + 4 * q_); CF[q_] = *(const LAS f32x4*)(l_cf + 16 * g + 4 * q_); \
            Q[4 * q_] = *(const u32x4*)(rowp + (size_t)iv.x * 128); Q[4 * q_ + 1] = *(const u32x4*)(rowp + (size_t)iv.y * 128); \
            Q[4 * q_ + 2] = *(const u32x4*)(rowp + (size_t)iv.z * 128); Q[4 * q_ + 3] = *(const u32x4*)(rowp + (size_t)iv.w * 128); } } } while (0)
#define P5V_COMPUTE(Q, CF, X0, X1, T) do { \
        f32x2 acc[8]; \
        _Pragma("unroll") for (int j = 0; j < 8; ++j) acc[j] = (f32x2){0.f, 0.f}; \
        _Pragma("unroll") for (int i = 0; i < 16; ++i) { \
            const float cs_ = CF[i >> 2][i & 3]; const f32x2 c2 = (f32x2){cs_, cs_}; \
            acc[0] = __builtin_elementwise_fma(__builtin_amdgcn_cvt_pk_f32_fp8(Q[i].x, false), c2, acc[0]); \
            acc[1] = __builtin_elementwise_fma(__builtin_amdgcn_cvt_pk_f32_fp8(Q[i].x, true), c2, acc[1]); \
            acc[2] = __builtin_elementwise_fma(__builtin_amdgcn_cvt_pk_f32_fp8(Q[i].y, false), c2, acc[2]); \
            acc[3] = __builtin_elementwise_fma(__builtin_amdgcn_cvt_pk_f32_fp8(Q[i].y, true), c2, acc[3]); \
            acc[4] = __builtin_elementwise_fma(__builtin_amdgcn_cvt_pk_f32_fp8(Q[i].z, false), c2, acc[4]); \
            acc[5] = __builtin_elementwise_fma(__builtin_amdgcn_cvt_pk_f32_fp8(Q[i].z, true), c2, acc[5]); \
            acc[6] = __builtin_elementwise_fma(__builtin_amdgcn_cvt_pk_f32_fp8(Q[i].w, false), c2, acc[6]); \
            acc[7] = __builtin_elementwise_fma(__builtin_amdgcn_cvt_pk_f32_fp8(Q[i].w, true), c2, acc[7]); } \
        _Pragma("unroll") for (int j = 0; j < 8; ++j) { red[g * 136 + (2 * j) * 8 + sub] = acc[j].x; red[g * 136 + (2 * j + 1) * 8 + sub] = acc[j].y; } \
        float s1 = X0, s2_ = X1; \
        _Pragma("unroll") for (int gg = 0; gg < 8; ++gg) { s1 += red[gg * 136 + lane]; s2_ += red[gg * 136 + 64 + lane]; } \
        { float* xr_ = p.out + (size_t)(T) * DM + 128 * x; xr_[c1] = s1; xr_[c1 + 8] = s2_; } } while (0)
    int tok = gwx;
    P5V_LOADIDX(tok);
    P5V_ISSUE(qA, cfA, xA0, xA1, tok);
    P5V_LOADIDX(tok + nwx);
    for (; tok < NT; tok += 2 * nwx) {
        P5V_ISSUE(qB, cfB, xB0, xB1, tok + nwx);
        P5V_LOADIDX(tok + 2 * nwx);
        P5V_COMPUTE(qA, cfA, xA0, xA1, tok);
        if (tok + nwx >= NT) break;
        P5V_ISSUE(qA, cfA, xA0, xA1, tok + 2 * nwx);
        P5V_LOADIDX(tok + 3 * nwx);
        P5V_COMPUTE(qB, cfB, xB0, xB1, tok + nwx);
    }
#undef P5V_LOADIDX
#undef P5V_ISSUE
#undef P5V_COMPUTE
}

__device__ __forceinline__ void phase6(const Params& p, int lane, int wave) {
    const int gw = blockIdx.x * 8 + wave, NGW = gridDim.x * 8;
    const f32x4* gr = (const f32x4*)p.in[23] + lane;
    for (int m = gw; m < NT; m += 2 * NGW) {
        const bool two = m + NGW < NT;
        f32x4* xa = (f32x4*)(p.out + (size_t)m * DM) + lane; f32x4* xb = (f32x4*)(p.out + (size_t)(two ? m + NGW : m) * DM) + lane;
        f32x4 va[4], vb[4]; float sa = 0.f, sb = 0.f;
#pragma unroll
        for (int j = 0; j < 4; ++j) { va[j] = xa[64 * j]; vb[j] = xb[64 * j]; }
#pragma unroll
        for (int j = 0; j < 4; ++j) { sa += (va[j][0] * va[j][0] + va[j][1] * va[j][1]) + (va[j][2] * va[j][2] + va[j][3] * va[j][3]); sb += (vb[j][0] * vb[j][0] + vb[j][1] * vb[j][1]) + (vb[j][2] * vb[j][2] + vb[j][3] * vb[j][3]); }
        const float ra_ = 1.f / sqrtf(wave_total(sa) * (1.f / DM) + EPS), rb_ = 1.f / sqrtf(wave_total(sb) * (1.f / DM) + EPS);
#pragma unroll
        for (int j = 0; j < 4; ++j) { const f32x4 gg = gr[64 * j]; xa[64 * j] = va[j] * ra_ * gg; if (two) xb[64 * j] = vb[j] * rb_ * gg; }
    }
}

__global__ void __launch_bounds__(512, 2) fwd_megakernel(Params p) {
    extern __shared__ __attribute__((aligned(16))) unsigned char lds_raw[];
    LAS unsigned char* lds = (LAS unsigned char*)lds_raw;
    cg::grid_group grid = cg::this_grid();
    const int tid0 = threadIdx.x, wave = __builtin_amdgcn_readfirstlane(tid0 >> 6);
#define PHASE_IDS() int tid = tid0; asm volatile("" : "+v"(tid)); const int lane = tid & 63; (void)lane
    const int G = gridDim.x;
    volatile LAS unsigned* MISC = (volatile LAS unsigned*)(lds + MISC_OFF);
    if (tid0 < 32) MISC[tid0] = 0u;
    __syncthreads();
    XcdBarrier bar = xcd_barrier_post((unsigned*)(p.ws + WS_CTL) + 4096, MISC + 8);
#define GSYNC() xcd_barrier(bar)

#ifndef RPT_MASK
#define RPT_MASK 0
#endif
#if RPT_MASK
#define RPT(bit) for (int rpt_ = 0; rpt_ < (((RPT_MASK) >> (bit)) & 1) + 1; ++rpt_)
#else
#define RPT(bit) if (constexpr int rpt_ = 0; true)
#endif
    RPT(0) { PHASE_IDS(); phase0(p, lds, tid, lane, wave); grid.sync(); }
    RPT(1) {
        PHASE_IDS();
        pg8::Gemm g{(const bf16_t*)(p.ws + WS_H), (const bf16_t*)(p.ws + WS_WINT), NT, DIN, 1024};
        pg8::StaticOrder S; S.init(NT, DIN, G, (int)blockIdx.x);
        pg8::EpiProj E{(bf16_t*)(p.ws + WS_A), (bf16_t*)(p.ws + WS_Q), (bf16_t*)(p.ws + WS_KP), (bf16_t*)(p.ws + WS_VP), (bf16_t*)(p.ws + WS_KS), (bf16_t*)(p.ws + WS_VS), p.out};
        pg8::gemm_phase<pg8::EpiProj, pg8::StaticOrder, true, true>(lds, g, S, E);
        {
            const int nwg = (NT / 256) * (DIN / 256), rem = nwg % G, c = (int)blockIdx.x;
            if (rem == 0) prep_late(p, lds, tid, lane, wave, c, G);
            else if (c >= rem) prep_late(p, lds, tid, lane, wave, c - rem, G - rem);
        }
        GSYNC();
    }
    #ifndef P2MODE
#define P2MODE 0
#endif
    RPT(2) { PHASE_IDS(); att::phase2(p, lds, tid, lane, wave, rpt_, (((RPT_MASK) >> 2) & 1) && rpt_ == 0 ? P2MODE : 0); GSYNC(); }
    RPT(3) {
        PHASE_IDS();
        pg8::Gemm g{(const bf16_t*)(p.ws + WS_MIX), (const bf16_t*)(p.ws + WS_WOUTT), NP, 1024, 1024};
        pg8::StaticOrder S; S.init(NP, 1024, G, (int)blockIdx.x);
        pg8::EpiRes E{p.in[0], p.in[1], p.out, (bf16_t*)(p.ws + WS_XG), p.in[18], (float*)(p.ws + WS_SSQ)};
        pg8::gemm_phase<pg8::EpiRes, pg8::StaticOrder, true, true>(lds, g, S, E);
        {
            const float* xs = p.in[1]; float* xo = p.out + (size_t)NP * DM; bf16_t* go = (bf16_t*)(p.ws + WS_XG) + (size_t)NP * DM; const float* gff = p.in[18]; float* sso = (float*)(p.ws + WS_SSQ) + (size_t)NP * 16;
            mini_gemm((const bf16_t*)(p.ws + WS_MIX) + (size_t)NP * DM, (const bf16_t*)(p.ws + WS_WOUTT), 1024, lane, wave,
                      [=](int row, int cb, int fq, const pg8::f32x4 (&a)[4]) {
                          float sq = 0.f;
#pragma unroll
                          for (int n = 0; n < 4; ++n) {
                              const int col = cb * 64 + 16 * n + 4 * fq;
                              const pg8::f32x4 v = *(const pg8::f32x4*)(xs + (size_t)row * DM + col) + a[n];
                              *(pg8::f32x4*)(xo + (size_t)row * DM + col) = v;
                              *(u32x2*)(go + (size_t)row * DM + col) = pg8::pack4(v * *(const pg8::f32x4*)(gff + col));
                              sq += (v[0] * v[0] + v[1] * v[1]) + (v[2] * v[2] + v[3] * v[3]);
                          }
                          sq += __shfl_xor(sq, 16); sq += __shfl_xor(sq, 32);
                          if (fq == 0) sso[(size_t)row * 16 + cb] = sq;
                      });
        }
        GSYNC();
    }
    RPT(5) {
        PHASE_IDS();
        pg8::Gemm g{(const bf16_t*)(p.ws + WS_XG), (const bf16_t*)(p.ws + WS_WQT), NP, 2048, 1024};
        pg8::StaticOrder S; S.init(NP, 2048, G, (int)blockIdx.x);
        pg8::EpiBf16<0> E{(bf16_t*)(p.ws + WS_QP), 2048, nullptr, 0, 0, 1.f};
        pg8::gemm_phase<pg8::EpiBf16<0>, pg8::StaticOrder, true, true>(lds, g, S, E);
        {
            bf16_t* qo = (bf16_t*)(p.ws + WS_QP) + (size_t)NP * 2048;
            mini_gemm((const bf16_t*)(p.ws + WS_XG) + (size_t)NP * DM, (const bf16_t*)(p.ws + WS_WQT), 2048, lane, wave,
                      [=](int row, int cb, int fq, const pg8::f32x4 (&a)[4]) {
#pragma unroll
                          for (int n = 0; n < 4; ++n) *(u32x2*)(qo + (size_t)row * 2048 + cb * 64 + 16 * n + 4 * fq) = pg8::pack4(a[n]);
                      });
        }
        GSYNC();
    }
    RPT(6) { PHASE_IDS(); phase4b(p, lds, tid, lane, wave); GSYNC(); }
    RPT(7) { PHASE_IDS(); phase5a(p, tid); GSYNC(); }
    RPT(8) { PHASE_IDS(); phase5u(p, lds, lane, wave); GSYNC(); }
    RPT(9) { PHASE_IDS(); phase5c(p, tid); GSYNC(); }
    { PHASE_IDS(); phase5v(p, lds, lane, wave); }
    GSYNC();
    { PHASE_IDS(); phase6(p, lane, wave); }
}

extern "C" void kernel_launch(void* const* d_in, const int* in_sizes, int n_in, void* d_out, int out_size, void* d_ws, size_t ws_size, hipStream_t stream) {
    static int grid = 0;
    if (grid == 0) {
        if (n_in != 24 || out_size != (int)OUT_TOTAL || ws_size < WS_END) { fprintf(stderr, "kernel_launch: unexpected shapes: n_in %d out %d ws %zu (need %zu)\n", n_in, out_size, ws_size, (size_t)WS_END); grid = -1; return; }
        int dev = 0, cus = 0, per_cu = 0;
        (void)hipGetDevice(&dev);
        (void)hipDeviceGetAttribute(&cus, hipDeviceAttributeMultiprocessorCount, dev);
        if (hipFuncSetAttribute((const void*)fwd_megakernel, hipFuncAttributeMaxDynamicSharedMemorySize, LDS_BYTES) != hipSuccess) { fprintf(stderr, "kernel_launch: hipFuncSetAttribute failed\n"); grid = -1; return; }
        if (hipOccupancyMaxActiveBlocksPerMultiprocessor(&per_cu, (const void*)fwd_megakernel, 512, LDS_BYTES) != hipSuccess || per_cu < 1) { fprintf(stderr, "kernel_launch: occupancy query gave %d\n", per_cu); per_cu = 1; }
        (void)hipGetLastError();
        grid = cus * 1;
        if (per_cu < 1) grid = -1;
    }
    if (grid < 0) return;
    (void)hipMemsetAsync((char*)d_ws + WS_CTL, 0, CTL_BYTES, stream);
    Params p{};
    for (int i = 0; i < 24; ++i) p.in[i] = (const float*)d_in[i];
    p.out = (float*)d_out; p.ws = (unsigned char*)d_ws;
    void* args[] = {&p};
    hipError_t e = hipLaunchCooperativeKernel((const void*)fwd_megakernel, dim3(grid), dim3(512), args, LDS_BYTES, stream);
    if (e != hipSuccess) fprintf(stderr, "cooperative launch failed: %s (grid %d)\n", hipGetErrorString(e), grid);
}
```

```cpp
#include <hip/hip_runtime.h>
#include <hip/hip_cooperative_groups.h>
#include <cstdio>
#include <cstdint>
#include <cmath>
namespace cg = cooperative_groups;
#define CE_(a, b) do { const float t_ = fmaxf(a, b); b = fminf(a, b); a = t_; } while (0)
#define SORT16_DESC(V, O) do { CE_(V[(O)+0], V[(O)+1]); CE_(V[(O)+2], V[(O)+3]); CE_(V[(O)+0], V[(O)+2]); CE_(V[(O)+1], V[(O)+3]); CE_(V[(O)+1], V[(O)+2]); CE_(V[(O)+4], V[(O)+5]); CE_(V[(O)+6], V[(O)+7]); CE_(V[(O)+4], V[(O)+6]); CE_(V[(O)+5], V[(O)+7]); CE_(V[(O)+5], V[(O)+6]); CE_(V[(O)+0], V[(O)+4]); CE_(V[(O)+2], V[(O)+6]); CE_(V[(O)+2], V[(O)+4]); CE_(V[(O)+1], V[(O)+5]); CE_(V[(O)+3], V[(O)+7]); CE_(V[(O)+3], V[(O)+5]); CE_(V[(O)+1], V[(O)+2]); CE_(V[(O)+3], V[(O)+4]); CE_(V[(O)+5], V[(O)+6]); CE_(V[(O)+8], V[(O)+9]); CE_(V[(O)+10], V[(O)+11]); CE_(V[(O)+8], V[(O)+10]); CE_(V[(O)+9], V[(O)+11]); CE_(V[(O)+9], V[(O)+10]); CE_(V[(O)+12], V[(O)+13]); CE_(V[(O)+14], V[(O)+15]); CE_(V[(O)+12], V[(O)+14]); CE_(V[(O)+13], V[(O)+15]); CE_(V[(O)+13], V[(O)+14]); CE_(V[(O)+8], V[(O)+12]); CE_(V[(O)+10], V[(O)+14]); CE_(V[(O)+10], V[(O)+12]); CE_(V[(O)+9], V[(O)+13]); CE_(V[(O)+11], V[(O)+15]); CE_(V[(O)+11], V[(O)+13]); CE_(V[(O)+9], V[(O)+10]); CE_(V[(O)+11], V[(O)+12]); CE_(V[(O)+13], V[(O)+14]); CE_(V[(O)+0], V[(O)+8]); CE_(V[(O)+4], V[(O)+12]); CE_(V[(O)+4], V[(O)+8]); CE_(V[(O)+2], V[(O)+10]); CE_(V[(O)+6], V[(O)+14]); CE_(V[(O)+6], V[(O)+10]); CE_(V[(O)+2], V[(O)+4]); CE_(V[(O)+6], V[(O)+8]); CE_(V[(O)+10], V[(O)+12]); CE_(V[(O)+1], V[(O)+9]); CE_(V[(O)+5], V[(O)+13]); CE_(V[(O)+5], V[(O)+9]); CE_(V[(O)+3], V[(O)+11]); CE_(V[(O)+7], V[(O)+15]); CE_(V[(O)+7], V[(O)+11]); CE_(V[(O)+3], V[(O)+5]); CE_(V[(O)+7], V[(O)+9]); CE_(V[(O)+11], V[(O)+13]); CE_(V[(O)+1], V[(O)+2]); CE_(V[(O)+3], V[(O)+4]); CE_(V[(O)+5], V[(O)+6]); CE_(V[(O)+7], V[(O)+8]); CE_(V[(O)+9], V[(O)+10]); CE_(V[(O)+11], V[(O)+12]); CE_(V[(O)+13], V[(O)+14]); } while (0)
#define BITONIC16_DESC(V, O) do { CE_(V[(O)+0], V[(O)+8]); CE_(V[(O)+1], V[(O)+9]); CE_(V[(O)+2], V[(O)+10]); CE_(V[(O)+3], V[(O)+11]); CE_(V[(O)+4], V[(O)+12]); CE_(V[(O)+5], V[(O)+13]); CE_(V[(O)+6], V[(O)+14]); CE_(V[(O)+7], V[(O)+15]); CE_(V[(O)+0], V[(O)+4]); CE_(V[(O)+1], V[(O)+5]); CE_(V[(O)+2], V[(O)+6]); CE_(V[(O)+3], V[(O)+7]); CE_(V[(O)+8], V[(O)+12]); CE_(V[(O)+9], V[(O)+13]); CE_(V[(O)+10], V[(O)+14]); CE_(V[(O)+11], V[(O)+15]); CE_(V[(O)+0], V[(O)+2]); CE_(V[(O)+1], V[(O)+3]); CE_(V[(O)+4], V[(O)+6]); CE_(V[(O)+5], V[(O)+7]); CE_(V[(O)+8], V[(O)+10]); CE_(V[(O)+9], V[(O)+11]); CE_(V[(O)+12], V[(O)+14]); CE_(V[(O)+13], V[(O)+15]); CE_(V[(O)+0], V[(O)+1]); CE_(V[(O)+2], V[(O)+3]); CE_(V[(O)+4], V[(O)+5]); CE_(V[(O)+6], V[(O)+7]); CE_(V[(O)+8], V[(O)+9]); CE_(V[(O)+10], V[(O)+11]); CE_(V[(O)+12], V[(O)+13]); CE_(V[(O)+14], V[(O)+15]); } while (0)
namespace pg8 {
#define PG8_LAS __attribute__((address_space(3)))
typedef unsigned short bf16_t;
typedef short bf16x8 __attribute__((ext_vector_type(8)));
typedef float f32x4 __attribute__((ext_vector_type(4)));
typedef unsigned u32x4 __attribute__((ext_vector_type(4)));
constexpr int BM = 256, BK = 64, HALF = 128, HTB = HALF * BK * 2  , STAGE_BYTES = 8 * HTB, NXCD = 8, WGM = 8;

__host__ __device__ __forceinline__ int lds_byte(int r, int c) { const int st = (r >> 4) * 2 + (c >> 5), rr = r & 15, cc = c & 31, ob = rr * 64 + cc * 2; return st * 1024 + (ob ^ (((ob >> 9) & 1) << 5)); }
__host__ __device__ __forceinline__ void stage_rc(int b, int& R, int& C) { const int st = b / 1024, sb = b % 1024, swz = sb ^ (((sb >> 9) & 1) << 5); R = (st >> 1) * 16 + swz / 64; C = (st & 1) * 32 + (swz % 64) / 2; }
__host__ __device__ __forceinline__ int perm32(int rho) { const int n = rho >> 4, i = rho & 15; return 8 * (i >> 2) + 4 * n + (i & 3); }

struct Unit { int pm, pn; };
struct Gemm { const bf16_t* A; const bf16_t* Bt; int M, N, K; };

struct StaticOrder {
    int nM, nN, nwg, G, c;
    __host__ __device__ void init(int M, int N, int G_, int c_) { nM = M / BM; nN = N / BM; nwg = nM * nN; G = G_; c = c_; }
    __host__ __device__ bool next(int i, Unit& u) const {
        const long L = (long)i * G + c; if (L >= nwg) return false;
        int wgid = (int)L; { const int q = nwg / NXCD, r = nwg % NXCD, xcd = wgid % NXCD, off = wgid / NXCD; wgid = (xcd < r ? xcd * (q + 1) : r * (q + 1) + (xcd - r) * q) + off; }
        const int nig = WGM * nN, gid = wgid / nig, fm = gid * WGM, gsz = (nM - fm) < WGM ? (nM - fm) : WGM;
        u.pm = fm + ((wgid % nig) % gsz); u.pn = (wgid % nig) / gsz; return true;
    }
    __device__ __forceinline__ void a_ready(const Unit&) const {}
    __device__ __forceinline__ void done(const Unit&) const {}
};

__device__ __forceinline__ unsigned cvt_pk_bf16(float lo, float hi) { unsigned r; asm volatile("v_cvt_pk_bf16_f32 %0, %1, %2" : "=v"(r) : "v"(lo), "v"(hi)); return r; }
typedef float f32x2 __attribute__((ext_vector_type(2)));
__device__ __forceinline__ f32x2 gelu_pk(f32x2 v) {
    const f32x2 av = __builtin_elementwise_abs(v), d = av * 0.2316418882f + 1.0f;
    f32x2 t; t.x = __builtin_amdgcn_rcpf(d.x); t.y = __builtin_amdgcn_rcpf(d.y);
    f32x2 q = t * 0.5307027145f + (-0.7265760135f); q = q * t + 0.7107068705f; q = q * t + (-0.142248368f); q = q * t + 0.127414796f; q = q * t;
    const f32x2 s = (v * v) * (-0.72134752044f);
    f32x2 e; e.x = __builtin_amdgcn_exp2f(s.x); e.y = __builtin_amdgcn_exp2f(s.y);
    const f32x2 m = v * (q * e), r = v - m;
    f32x2 o; o.x = v.x < 0.f ? m.x : r.x; o.y = v.y < 0.f ? m.y : r.y; return o;
}

template <int ACT  > struct EpiBf16 {
    static constexpr bool PERM = true, AFTER_DRAIN = false; static_assert(ACT == 0 || ACT == 1, "EpiBf16: ACT is 0 (none) or 1 (gelu_pk)");
    bf16_t* O; int ldc; const float* bias; int split_cols; size_t split_stride; float scale0;
    __device__ __forceinline__ void operator()(const f32x4 (&acc)[2][2][4][2], const Unit& u, int wr, int wc, int fr, int fq) const {
        const int row0 = u.pm * BM + wr * 64 + fr; int colt = u.pn * BM; bf16_t* base = O;
        float sc = 1.f; if (split_cols) { const int t = colt / split_cols; base += (size_t)t * split_stride; colt -= t * split_cols; if (t == 0) sc = scale0; }
        const int col0 = colt + wc * 32 + 8 * fq, bcol0 = u.pn * BM + wc * 32 + 8 * fq;
        f32x4 bv[2][2];
#pragma unroll
        for (int bj = 0; bj < 2; ++bj)
#pragma unroll
            for (int n = 0; n < 2; ++n) bv[bj][n] = bias ? *(const f32x4*)(bias + bcol0 + bj * HALF + 4 * n) : (f32x4){0.f, 0.f, 0.f, 0.f};
#pragma unroll
        for (int ai = 0; ai < 2; ++ai)
#pragma unroll
            for (int m = 0; m < 4; ++m) { bf16_t* rowp = base + (size_t)(row0 + ai * HALF + m * 16) * ldc + col0;
#pragma unroll
                for (int bj = 0; bj < 2; ++bj) { f32x4 v0 = acc[ai][bj][m][0] + bv[bj][0], v1 = acc[ai][bj][m][1] + bv[bj][1];
                    if (ACT == 1) { f32x2 a = gelu_pk((f32x2){v0[0], v0[1]}), b = gelu_pk((f32x2){v0[2], v0[3]}), c = gelu_pk((f32x2){v1[0], v1[1]}), d = gelu_pk((f32x2){v1[2], v1[3]});
                        v0 = (f32x4){a.x, a.y, b.x, b.y}; v1 = (f32x4){c.x, c.y, d.x, d.y}; }
                    v0 = v0 * sc; v1 = v1 * sc; u32x4 w; w.x = cvt_pk_bf16(v0[0], v0[1]); w.y = cvt_pk_bf16(v0[2], v0[3]); w.z = cvt_pk_bf16(v1[0], v1[1]); w.w = cvt_pk_bf16(v1[2], v1[3]);
                    *(u32x4*)(rowp + bj * HALF) = w; } }
    }
};
template <class Epi, class Sched, bool ALIGN_EPI = false, bool SP2 = false>
__device__ __forceinline__ void gemm_phase(PG8_LAS unsigned char* lds, const Gemm g, const Sched& S, const Epi& E) {
    int tid = threadIdx.x; asm volatile("" : "+v"(tid));
    const int wid = __builtin_amdgcn_readfirstlane(tid >> 6), lane = tid & 63, wr = wid >> 2, wc = wid & 3, fr = lane & 15, fq = lane >> 4;
    const int K = g.K, nt = K / BK;
    unsigned voffA[2], voffB[2];
#pragma unroll
    for (int i = 0; i < 2; ++i) { int R, C; stage_rc(tid * 16 + i * 8192, R, C); const int Rb = Epi::PERM ? ((R & ~31) + perm32(R & 31)) : R;
        voffA[i] = (unsigned)(R * K + C) * 2u; voffB[i] = (unsigned)(Rb * K + C) * 2u; }
    const size_t kstep = (size_t)(BK * 2);
    const size_t hstep = (size_t)HALF * K * 2;
    const size_t tstep = 2 * hstep;
    const unsigned ldsw = (unsigned)wid * 1024u;
    const int aoff = lds_byte(wr * 64 + fr, fq * 8), boff = lds_byte(wc * 32 + fr, fq * 8);
#define PG8_SA(b, h) (((b) * 2 + (h)) * HTB)
#define PG8_SB(b, h) ((4 + (b) * 2 + (h)) * HTB)
#define PG8_STAGE(bufoff, gbase, voff) do { _Pragma("unroll") for (int _i = 0; _i < 2; ++_i) \
        __builtin_amdgcn_global_load_lds((const unsigned*)((const char*)(gbase) + (voff)[_i]), (PG8_LAS unsigned*)(lds + (bufoff) + ldsw + _i * 8192), 16, 0, 0); } while (0)
#define PG8_LDA(dst, b, h) do { _Pragma("unroll") for (int m = 0; m < 4; ++m) _Pragma("unroll") for (int k = 0; k < 2; ++k) dst[m][k] = *(const PG8_LAS bf16x8*)(lds + PG8_SA(b, h) + aoff + m * 2048 + k * 1024); } while (0)
#define PG8_LDB(dst, b, h) do { _Pragma("unroll") for (int n = 0; n < 2; ++n) _Pragma("unroll") for (int k = 0; k < 2; ++k) dst[n][k] = *(const PG8_LAS bf16x8*)(lds + PG8_SB(b, h) + boff + n * 2048 + k * 1024); } while (0)
#define PG8_MMA(ai, bj, At, Bt) do { __builtin_amdgcn_s_setprio(1); _Pragma("unroll") for (int m = 0; m < 4; ++m) _Pragma("unroll") for (int n = 0; n < 2; ++n) _Pragma("unroll") for (int k = 0; k < 2; ++k) \
        acc[ai][bj][m][n] = __builtin_amdgcn_mfma_f32_16x16x32_bf16(Bt[n][k], At[m][k], acc[ai][bj][m][n], 0, 0, 0); __builtin_amdgcn_s_setprio(0); } while (0)
#define PG8_WAIT_V(n) asm volatile("s_waitcnt vmcnt(" #n ")" ::: "memory")
#define PG8_WAIT_L(n) asm volatile("s_waitcnt lgkmcnt(" #n ")" ::: "memory")
#define PG8_BAR __builtin_amdgcn_s_barrier()
#define PG8_SCHED __builtin_amdgcn_sched_barrier(0)
    Unit cur, nxt; int ui = 0;
    if (!S.next(0, cur)) return;
    f32x4 acc[2][2][4][2];
#pragma unroll
    for (int a = 0; a < 2; ++a)
#pragma unroll
        for (int b = 0; b < 2; ++b)
#pragma unroll
            for (int m = 0; m < 4; ++m)
#pragma unroll
                for (int n = 0; n < 2; ++n) acc[a][b][m][n] = (f32x4){0.f, 0.f, 0.f, 0.f};
    bf16x8 At[4][2], B0[2][2], B1[2][2];
    const char* cA = (const char*)g.A + (size_t)cur.pm * tstep; const char* cB = (const char*)g.Bt + (size_t)cur.pn * tstep;
    S.a_ready(cur);
    if constexpr (SP2) {
        PG8_STAGE(PG8_SB(0, 0), cB, voffB); PG8_STAGE(PG8_SB(0, 1), cB + hstep, voffB); PG8_STAGE(PG8_SA(0, 0), cA, voffA); PG8_STAGE(PG8_SA(0, 1), cA + hstep, voffA);
        if (wr == 1) PG8_BAR;
        PG8_WAIT_V(2); PG8_BAR;
        PG8_STAGE(PG8_SB(1, 0), cB + kstep, voffB); PG8_STAGE(PG8_SA(1, 0), cA + kstep, voffA); PG8_STAGE(PG8_SB(1, 1), cB + hstep + kstep, voffB);
        PG8_WAIT_V(6); PG8_BAR;
    } else {
        PG8_STAGE(PG8_SB(0, 0), cB, voffB); PG8_STAGE(PG8_SA(0, 0), cA, voffA); PG8_STAGE(PG8_SB(0, 1), cB + hstep, voffB); PG8_STAGE(PG8_SA(0, 1), cA + hstep, voffA);
        if (wr == 1) PG8_BAR;
        PG8_WAIT_V(4); PG8_BAR;
        PG8_STAGE(PG8_SB(1, 0), cB + kstep, voffB); PG8_STAGE(PG8_SA(1, 0), cA + kstep, voffA); PG8_STAGE(PG8_SB(1, 1), cB + hstep + kstep, voffB);
        PG8_WAIT_V(6); PG8_BAR;
    }
    for (;;) {
        const bool has_next = S.next(ui + 1, nxt);
        const char* nA = has_next ? (const char*)g.A + (size_t)nxt.pm * tstep : cA; const char* nB = has_next ? (const char*)g.Bt + (size_t)nxt.pn * tstep : cB;
        for (int t = 0; t < nt; t += 2) {
            const bool last = (t == nt - 2);
            const char* a1 = cA + (size_t)(t + 1) * kstep;
            const char* a2 = last ? nA : cA + (size_t)(t + 2) * kstep; const char* b2 = last ? nB : cB + (size_t)(t + 2) * kstep;
            const char* a3 = a2 + kstep; const char* b3 = b2 + kstep;
            if (last && has_next) S.a_ready(nxt);
            if constexpr (SP2) {
            PG8_LDB(B0, 0, 0); PG8_LDB(B1, 0, 1); PG8_SCHED; PG8_LDA(At, 0, 0); PG8_STAGE(PG8_SA(1, 1), a1 + hstep, voffA);
            PG8_WAIT_V(8); PG8_WAIT_L(0); PG8_BAR; PG8_MMA(0, 0, At, B0); PG8_MMA(0, 1, At, B1); PG8_BAR; PG8_SCHED;
            PG8_LDA(At, 0, 1); PG8_STAGE(PG8_SB(0, 0), b2, voffB); PG8_STAGE(PG8_SB(0, 1), b2 + hstep, voffB); PG8_STAGE(PG8_SA(0, 0), a2, voffA);
            PG8_WAIT_V(8); PG8_WAIT_L(0); PG8_BAR; PG8_MMA(1, 0, At, B0); PG8_MMA(1, 1, At, B1); PG8_BAR; PG8_SCHED;
            PG8_LDB(B0, 1, 0); PG8_LDB(B1, 1, 1); PG8_SCHED; PG8_LDA(At, 1, 0); PG8_STAGE(PG8_SA(0, 1), a2 + hstep, voffA);
            PG8_WAIT_V(8); PG8_WAIT_L(0); PG8_BAR; PG8_MMA(0, 0, At, B0); PG8_MMA(0, 1, At, B1); PG8_BAR; PG8_SCHED;
            PG8_LDA(At, 1, 1); PG8_STAGE(PG8_SB(1, 0), b3, voffB); PG8_STAGE(PG8_SB(1, 1), b3 + hstep, voffB); PG8_STAGE(PG8_SA(1, 0), a3, voffA);
            PG8_WAIT_V(8); PG8_WAIT_L(0); PG8_BAR; PG8_MMA(1, 0, At, B0); PG8_MMA(1, 1, At, B1); PG8_BAR; PG8_SCHED;
            } else {
            PG8_LDB(B0, 0, 0); PG8_SCHED; PG8_LDA(At, 0, 0); PG8_STAGE(PG8_SA(1, 1), a1 + hstep, voffA);
            PG8_WAIT_L(8); PG8_BAR; PG8_WAIT_L(0); PG8_MMA(0, 0, At, B0); PG8_BAR; PG8_SCHED;
            PG8_LDB(B1, 0, 1); PG8_STAGE(PG8_SB(0, 0), b2, voffB);
            PG8_BAR; PG8_WAIT_L(0); PG8_MMA(0, 1, At, B1); PG8_BAR;
            PG8_LDA(At, 0, 1); PG8_STAGE(PG8_SA(0, 0), a2, voffA);
            PG8_BAR; PG8_WAIT_L(0); PG8_MMA(1, 0, At, B0); PG8_BAR; PG8_SCHED;
            PG8_STAGE(PG8_SB(0, 1), b2 + hstep, voffB);
            PG8_WAIT_V(6); PG8_BAR; PG8_MMA(1, 1, At, B1); PG8_BAR;
            PG8_LDB(B0, 1, 0); PG8_SCHED; PG8_LDA(At, 1, 0); PG8_STAGE(PG8_SA(0, 1), a2 + hstep, voffA);
            PG8_WAIT_L(8); PG8_BAR; PG8_WAIT_L(0); PG8_MMA(0, 0, At, B0); PG8_BAR; PG8_SCHED;
            PG8_LDB(B1, 1, 1); PG8_STAGE(PG8_SB(1, 0), b3, voffB);
            PG8_BAR; PG8_WAIT_L(0); PG8_MMA(0, 1, At, B1); PG8_BAR;
            PG8_LDA(At, 1, 1); PG8_STAGE(PG8_SA(1, 0), a3, voffA);
            PG8_BAR; PG8_WAIT_L(0); PG8_MMA(1, 0, At, B0); PG8_BAR; PG8_SCHED;
            PG8_STAGE(PG8_SB(1, 1), b3 + hstep, voffB);
            PG8_WAIT_V(6); PG8_BAR; PG8_MMA(1, 1, At, B1); PG8_BAR;
            }
        }
        if constexpr (ALIGN_EPI) { if (wr == 0) PG8_BAR; }
        if constexpr (!Epi::AFTER_DRAIN) { E(acc, cur, wr, wc, fr, fq); S.done(cur); }
        if (!has_next) break;
#pragma unroll
        for (int a = 0; a < 2; ++a)
#pragma unroll
            for (int b = 0; b < 2; ++b)
#pragma unroll
                for (int m = 0; m < 4; ++m)
#pragma unroll
                    for (int n = 0; n < 2; ++n) acc[a][b][m][n] = (f32x4){0.f, 0.f, 0.f, 0.f};
        cur = nxt; cA = nA; cB = nB; ++ui;
        if constexpr (ALIGN_EPI) { if (wr == 1) PG8_BAR; }
    }
    PG8_WAIT_V(0);
    if constexpr (!ALIGN_EPI) { if (wr == 0) PG8_BAR; }
    PG8_BAR;
    if constexpr (Epi::AFTER_DRAIN) { E.fused(acc, cur, wr, wc, fr, fq, lds, wid, lane); S.done(cur); }
#undef PG8_SA
#undef PG8_SB
#undef PG8_STAGE
#undef PG8_LDA
#undef PG8_LDB
#undef PG8_MMA
#undef PG8_WAIT_V
#undef PG8_WAIT_L
#undef PG8_BAR
#undef PG8_SCHED
}
}

#define LAS __attribute__((address_space(3)))
typedef unsigned short bf16_t;
typedef short bf16x8 __attribute__((ext_vector_type(8)));
typedef short s16x4 __attribute__((ext_vector_type(4)));
typedef float f32x4 __attribute__((ext_vector_type(4)));
typedef float f32x16 __attribute__((ext_vector_type(16)));
typedef unsigned u32x4 __attribute__((ext_vector_type(4)));
typedef unsigned u32x2 __attribute__((ext_vector_type(2)));

constexpr int DM = 1024;
constexpr int NP = 16 * 2048;
constexpr int NS = 8 * 64;
constexpr int NT = NP + NS;
constexpr int DIN = 2560;
constexpr int SKV = 2112;
constexpr float EPS = 1e-6f;
constexpr float LOG2E = 1.4426950408889634f;
constexpr float QSCALE = 0.125f * LOG2E;

constexpr long OUT_Y = 0;
constexpr long OUT_KP = 34078720L, OUT_VP = 50855936L, OUT_CONVP = 67633152L, OUT_KS = 67878912L, OUT_VS = 68141056L, OUT_CONVS = 68403200L, OUT_TOTAL = 68526080L;

constexpr size_t MiB = 1u << 20;
constexpr size_t WS_CTL = 0, CTL_BYTES = 1 * MiB;
constexpr size_t WS_WINT = 1 * MiB;
constexpr size_t WS_WOUTT = 6 * MiB;
constexpr size_t WS_WQT = 8 * MiB;
constexpr size_t WS_SK = 12 * MiB;
constexpr size_t WS_PU8 = 16 * MiB;
constexpr size_t WS_PV8 = 32 * MiB;
constexpr size_t WS_SCU = 48 * MiB;
constexpr size_t WS_SCV = 49 * MiB;
constexpr size_t WS_KS = 80 * MiB;
constexpr size_t WS_VS = 97 * MiB;
constexpr size_t WS_H = 114 * MiB;
constexpr size_t WS_A = 179 * MiB;
constexpr size_t WS_Q = 212 * MiB;
constexpr size_t WS_QP = 114 * MiB;
constexpr size_t WS_KP = 245 * MiB;
constexpr size_t WS_VP = 277 * MiB;
constexpr size_t WS_MIX = 309 * MiB;
constexpr size_t WS_H2 = 309 * MiB;
constexpr size_t WS_TK = 375 * MiB;
constexpr size_t WS_IDX = 408 * MiB;
constexpr size_t WS_GATE = 425 * MiB;
constexpr size_t WS_PACT = 114 * MiB;
constexpr size_t WS_COEF = 375 * MiB;
constexpr size_t WS_XG = 442 * MiB;
constexpr size_t WS_SSQ = 507 * MiB;
constexpr size_t WS_RSTD = 510 * MiB;
constexpr size_t WS_END = 511 * MiB;
static_assert(WS_H + (size_t)NT * 1024 * 2 <= WS_A && WS_A + (size_t)NT * 512 * 2 <= WS_Q && WS_Q + (size_t)NT * 512 * 2 <= WS_KP, "R1");
static_assert(WS_QP + (size_t)NT * 2048 * 2 <= WS_KP && WS_KP + (size_t)NP * 512 * 2 <= WS_VP && WS_VP + (size_t)NP * 512 * 2 <= WS_MIX, "ws map");
static_assert(WS_MIX + (size_t)NT * 1024 * 2 <= WS_TK && WS_TK + (size_t)NT * 256 * 4 <= WS_IDX && WS_IDX + (size_t)NT * 128 * 4 <= WS_GATE && WS_GATE + (size_t)NT * 128 * 4 <= WS_END, "ws map 2");
static_assert(WS_KS + (size_t)8 * SKV * 512 * 2 <= WS_VS && WS_VS + (size_t)8 * SKV * 512 * 2 <= WS_H, "ws map 3");

constexpr int RING_BYTES = 131072;
constexpr int BIAS_OFF = RING_BYTES;
constexpr int MISC_OFF = RING_BYTES + 5120;
constexpr int LDS_BYTES = MISC_OFF + 1024;

struct Params {
    const float* in[24];
    float* out;
    unsigned char* ws;
};

__device__ __forceinline__ unsigned cvtpk(float lo, float hi) { return pg8::cvt_pk_bf16(lo, hi); }
__device__ __forceinline__ float bflo(unsigned w) { return __uint_as_float(w << 16); }
__device__ __forceinline__ float bfhi(unsigned w) { return __uint_as_float(w & 0xffff0000u); }
__device__ __forceinline__ float wave_sum(float v) {
#pragma unroll
    for (int o = 1; o < 64; o <<= 1) v += __shfl_xor(v, o);
    return v;
}
typedef float f32x2 __attribute__((ext_vector_type(2)));
#define DPP_ADD(v, ctrl) v += __builtin_bit_cast(float, __builtin_amdgcn_update_dpp(0, __builtin_bit_cast(int, v), ctrl, 0xf, 0xf, true))
__device__ __forceinline__ float rl_f(float v, int l) { return __uint_as_float(__builtin_amdgcn_readlane(__float_as_uint(v), l)); }
__device__ __forceinline__ float wave_total(float v) {
    DPP_ADD(v, 0xB1); DPP_ADD(v, 0x4E); DPP_ADD(v, 0x141); DPP_ADD(v, 0x140);
    return (rl_f(v, 0) + rl_f(v, 16)) + (rl_f(v, 32) + rl_f(v, 48));
}
typedef __bf16 bf16x2_t __attribute__((ext_vector_type(2)));
__device__ __forceinline__ float dot2(unsigned a, unsigned b, float acc) {
    return __builtin_amdgcn_fdot2_f32_bf16(__builtin_bit_cast(bf16x2_t, a), __builtin_bit_cast(bf16x2_t, b), acc, false);
}
#define LDS_WAIT() asm volatile("s_waitcnt lgkmcnt(0)" ::: "memory")

#define XB_TMO      128
#define XB_XCNT(j)  (256  + 64 * (j))
#define XB_XSUB(j)  (1280 + 64 * (j))
#define XB_XGEN(j)  (2304 + 64 * (j))
#define XB_TOP      3328
#define XB_TOPGEN   3392
#define XCD_BAR_WORDS 3456
#define XB_SPIN_CAP (1u << 18)

__device__ __forceinline__ unsigned xb_ld(unsigned* p)              { return __hip_atomic_load(p, __ATOMIC_RELAXED, __HIP_MEMORY_SCOPE_AGENT); }
__device__ __forceinline__ unsigned xb_add(unsigned* p, unsigned v) { return __hip_atomic_fetch_add(p, v, __ATOMIC_RELAXED, __HIP_MEMORY_SCOPE_AGENT); }
__device__ __forceinline__ unsigned xb_xcc_id() { return (unsigned)__builtin_amdgcn_s_getreg((3 << 11) | 20) & 0xFu; }
#define XB_SPIN(cond, bar) do { unsigned _sp = 0; while (cond) { __builtin_amdgcn_s_sleep(1); \
    if ((++_sp & 255u) == 0u) { if (xb_ld(&(bar)[XB_TMO])) break; if (_sp > XB_SPIN_CAP) { atomicAdd(&(bar)[XB_TMO], 1u); break; } } } } while (0)

struct XcdBarrier {
    unsigned* bar; unsigned x;
    volatile LAS unsigned* st;
};

__device__ __forceinline__ XcdBarrier xcd_barrier_post(unsigned* bar, volatile LAS unsigned* st) {
    XcdBarrier b; b.bar = bar; b.x = xb_xcc_id(); b.st = st;
    if (threadIdx.x == 0) (void)xb_add(&bar[XB_XCNT(b.x)], 1u);
    return b;
}
__device__ __forceinline__ void xcd_barrier_complete(unsigned* bar, unsigned x, unsigned& nloc, unsigned& nx) {
    const unsigned G = gridDim.x * gridDim.y * gridDim.z;
    unsigned sum, cnt, mine, sp = 0u;
    for (;;) {
        sum = 0u; cnt = 0u; mine = 0u;
#pragma unroll
        for (unsigned j = 0; j < 16; ++j) { const unsigned c = xb_ld(&bar[XB_XCNT(j)]); sum += c; cnt += (c > 0u) ? 1u : 0u; mine = (j == x) ? c : mine; }
        if (sum == G) break;
        __builtin_amdgcn_s_sleep(1);
        if ((++sp & 255u) == 0u) { if (xb_ld(&bar[XB_TMO])) break; if (sp > XB_SPIN_CAP) { atomicAdd(&bar[XB_TMO], 1u); break; } }
    }
    nloc = mine > 0u ? mine : 1u; nx = cnt > 0u ? cnt : 1u;
}

__device__ __forceinline__ void xcd_barrier(const XcdBarrier& b) {
    asm volatile("s_waitcnt vmcnt(0)" ::: "memory");
    __syncthreads();
    if (threadIdx.x == 0) {
        unsigned* bar = b.bar;
        __builtin_amdgcn_s_waitcnt(0);
        unsigned nloc = b.st[0], nx = b.st[1];
        if (nloc == 0u) { xcd_barrier_complete(bar, b.x, nloc, nx); b.st[0] = nloc; b.st[1] = nx; }
        const unsigned old = xb_add(&bar[XB_XSUB(b.x)], 1u);
        const unsigned gen = old / nloc;
        if (old + 1u == (gen + 1u) * nloc) {
            __builtin_amdgcn_fence(__ATOMIC_RELEASE, "agent");
            asm volatile("s_waitcnt vmcnt(0)" ::: "memory");
            const unsigned og = xb_add(&bar[XB_TOP], 1u);
            const unsigned tg = og / nx;
            if (og + 1u == (tg + 1u) * nx) xb_add(&bar[XB_TOPGEN], 1u);
            else XB_SPIN(xb_ld(&bar[XB_TOPGEN]) == tg, bar);
            __builtin_amdgcn_fence(__ATOMIC_ACQUIRE, "agent");
            xb_add(&bar[XB_XGEN(b.x)], 1u);
            asm volatile("s_waitcnt vmcnt(0)" ::: "memory");
        } else {
            XB_SPIN(xb_ld(&bar[XB_XGEN(b.x)]) == gen, bar);
            __builtin_amdgcn_fence(__ATOMIC_ACQUIRE, "agent");
            asm volatile("s_waitcnt vmcnt(0)" ::: "memory");
        }
    }
    __syncthreads();
}


namespace pg8 {
__device__ __forceinline__ u32x2 pack4(f32x4 v) { u32x2 w; w.x = cvt_pk_bf16(v[0], v[1]); w.y = cvt_pk_bf16(v[2], v[3]); return w; }
struct EpiProj {
    static constexpr bool PERM = true, AFTER_DRAIN = false;
    bf16_t* A; bf16_t* Q; bf16_t* KP; bf16_t* VP; bf16_t* KS; bf16_t* VS; float* out;
    __device__ __forceinline__ void operator()(const f32x4 (&acc)[2][2][4][2], const Unit& u, int wr, int wc, int fr, int fq) const {
        const int pn = u.pn;
        const int row0 = u.pm * BM + wr * 64 + fr;
        if (pn < 4) {
#pragma unroll
            for (int ai = 0; ai < 2; ++ai)
#pragma unroll
                for (int m = 0; m < 4; ++m) {
                    const int row = row0 + ai * HALF + m * 16;
                    long toff = -1;
                    if (row < NP) { const int s = row & 2047; if (s >= 2018) toff = OUT_CONVP + ((long)(row >> 11) * 30 + (s - 2018)) * 512; }
                    else { const int rr = row - NP; const int i = rr & 63; if (i >= 34) toff = OUT_CONVS + ((long)(rr >> 6) * 30 + (i - 34)) * 512; }
                    const int c = 128 * pn + 32 * wc + 8 * fq;
                    f32x4 a[2];
#pragma unroll
                    for (int n = 0; n < 2; ++n) {
                        const f32x4 x = acc[ai][0][m][n], g = acc[ai][1][m][n];
#pragma unroll
                        for (int j = 0; j < 4; ++j) a[n][j] = x[j] / (1.f + __expf(-g[j]));
                    }
                    u32x4 w; w.x = cvt_pk_bf16(a[0][0], a[0][1]); w.y = cvt_pk_bf16(a[0][2], a[0][3]); w.z = cvt_pk_bf16(a[1][0], a[1][1]); w.w = cvt_pk_bf16(a[1][2], a[1][3]);
                    *(u32x4*)(A + (size_t)row * 512 + c) = w;
                    if (toff >= 0) { *(f32x4*)(out + toff + c) = a[0]; *(f32x4*)(out + toff + c + 4) = a[1]; }
                }
        } else {
            const int sec = (pn - 4) >> 1, colbase = ((pn - 4) & 1) * 256;
#pragma unroll
            for (int ai = 0; ai < 2; ++ai)
#pragma unroll
                for (int m = 0; m < 4; ++m) {
                    const int row = row0 + ai * HALF + m * 16;
                    const bool isp = row < NP; const int rr = row - NP;
                    bf16_t* bdst; float* fdst;
                    if (sec == 0) { bdst = Q + (size_t)row * 512; fdst = nullptr; }
                    else if (sec == 1) { bdst = isp ? KP + (size_t)row * 512 : KS + ((size_t)(rr >> 6) * SKV + 2048 + (rr & 63)) * 512; fdst = isp ? out + OUT_KP + (size_t)row * 512 : out + OUT_KS + (size_t)rr * 512; }
                    else { bdst = isp ? VP + (size_t)row * 512 : VS + ((size_t)(rr >> 6) * SKV + 2048 + (rr & 63)) * 512; fdst = isp ? out + OUT_VP + (size_t)row * 512 : out + OUT_VS + (size_t)rr * 512; }
#pragma unroll
                    for (int bj = 0; bj < 2; ++bj) {
                        const int col = colbase + 128 * bj + 32 * wc + 8 * fq;
                        const f32x4 v0 = acc[ai][bj][m][0], v1 = acc[ai][bj][m][1];
                        if (sec == 0) { const f32x4 s0 = v0 * QSCALE, s1 = v1 * QSCALE; u32x4 w; w.x = cvt_pk_bf16(s0[0], s0[1]); w.y = cvt_pk_bf16(s0[2], s0[3]); w.z = cvt_pk_bf16(s1[0], s1[1]); w.w = cvt_pk_bf16(s1[2], s1[3]); *(u32x4*)(bdst + col) = w; }
                        else { u32x4 w; w.x = cvt_pk_bf16(v0[0], v0[1]); w.y = cvt_pk_bf16(v0[2], v0[3]); w.z = cvt_pk_bf16(v1[0], v1[1]); w.w = cvt_pk_bf16(v1[2], v1[3]); *(u32x4*)(bdst + col) = w;
                               *(f32x4*)(fdst + col) = v0; *(f32x4*)(fdst + col + 4) = v1; }
                    }
                }
        }
    }
};
struct EpiRes {
    static constexpr bool PERM = true, AFTER_DRAIN = false;
    const float* xp; const float* xs; float* out; bf16_t* xg; const float* gff; float* ssq;
    __device__ __forceinline__ void operator()(const f32x4 (&acc)[2][2][4][2], const Unit& u, int wr, int wc, int fr, int fq) const {
        const int row0 = u.pm * BM + wr * 64 + fr;
        f32x4 gg[2][2];
#pragma unroll
        for (int bj = 0; bj < 2; ++bj)
#pragma unroll
            for (int n = 0; n < 2; ++n) gg[bj][n] = *(const f32x4*)(gff + u.pn * BM + 128 * bj + 32 * wc + 8 * fq + 4 * n);
#pragma unroll
        for (int ai = 0; ai < 2; ++ai)
#pragma unroll
            for (int m = 0; m < 4; ++m) {
                const int row = row0 + ai * HALF + m * 16;
                const float* xr = row < NP ? xp + (size_t)row * DM : xs + (size_t)(row - NP) * DM;
                float* orow = out + (size_t)row * DM; bf16_t* grow = xg + (size_t)row * DM;
                float sq = 0.f;
#pragma unroll
                for (int bj = 0; bj < 2; ++bj) {
                    const int col = u.pn * BM + 128 * bj + 32 * wc + 8 * fq;
                    const f32x4 v0 = *(const f32x4*)(xr + col) + acc[ai][bj][m][0], v1 = *(const f32x4*)(xr + col + 4) + acc[ai][bj][m][1];
                    *(f32x4*)(orow + col) = v0; *(f32x4*)(orow + col + 4) = v1;
                    const f32x4 h0 = v0 * gg[bj][0], h1 = v1 * gg[bj][1];
                    u32x4 w; w.x = cvt_pk_bf16(h0[0], h0[1]); w.y = cvt_pk_bf16(h0[2], h0[3]); w.z = cvt_pk_bf16(h1[0], h1[1]); w.w = cvt_pk_bf16(h1[2], h1[3]);
                    *(u32x4*)(grow + col) = w;
                    sq += ((v0[0] * v0[0] + v0[1] * v0[1]) + (v0[2] * v0[2] + v0[3] * v0[3])) + ((v1[0] * v1[0] + v1[1] * v1[1]) + (v1[2] * v1[2] + v1[3] * v1[3]));
                }
                sq += __shfl_xor(sq, 16); sq += __shfl_xor(sq, 32);
                if (fq == 0) ssq[(size_t)row * 16 + u.pn * 4 + wc] = sq;
            }
    }
};
}

__device__ __forceinline__ int winrow(int n) { return n < 1024 ? (256 * ((n & 511) >> 7) + 128 * (n >> 9) + (n & 127)) : n; }
template <bool WIN> __device__ __forceinline__ void transpose_item(const float* W, int K, int N, bf16_t* WT, LAS float* scr, int item, int lane) {
    const int nblk = N / 32, kb = item / nblk, nb = item % nblk, k0 = 64 * kb, n0 = 32 * nb;
#pragma unroll 8
    for (int i = 0; i < 32; ++i) { const int kk = 2 * i + (lane >> 5); scr[kk * 33 + (lane & 31)] = W[(size_t)(k0 + kk) * N + n0 + (lane & 31)]; }
    LDS_WAIT();
    const int c = lane & 7;
#pragma unroll
    for (int j = 0; j < 4; ++j) {
        const int n = (lane >> 3) + 8 * j; const LAS float* s = scr + (8 * c) * 33 + n;
        u32x4 o; o.x = cvtpk(s[0 * 33], s[1 * 33]); o.y = cvtpk(s[2 * 33], s[3 * 33]); o.z = cvtpk(s[4 * 33], s[5 * 33]); o.w = cvtpk(s[6 * 33], s[7 * 33]);
        const int dr = WIN ? winrow(n0 + n) : (n0 + n);
        *(u32x4*)(WT + (size_t)dr * K + k0 + 8 * c) = o;
    }
    LDS_WAIT();
}
__device__ __forceinline__ void cvt_stream(const float* src, bf16_t* dst, size_t n8, size_t gt, size_t ngt) {
    for (size_t i = gt; i < n8; i += ngt) {
        const f32x4 a = *(const f32x4*)(src + i * 8), b = *(const f32x4*)(src + i * 8 + 4);
        u32x4 o; o.x = cvtpk(a[0], a[1]); o.y = cvtpk(a[2], a[3]); o.z = cvtpk(b[0], b[1]); o.w = cvtpk(b[2], b[3]);
        *(u32x4*)(dst + i * 8) = o;
    }
}
__device__ __forceinline__ void cvt_cache(const float* src, bf16_t* dst, size_t gt, size_t ngt) {
    const size_t n8 = (size_t)8 * 2048 * 512 / 8;
    for (size_t i = gt; i < n8; i += ngt) {
        const size_t e = i * 8; const size_t row = e >> 9, col = e & 511; const size_t drow = (row >> 11) * SKV + (row & 2047);
        const f32x4 a = *(const f32x4*)(src + e), b = *(const f32x4*)(src + e + 4);
        u32x4 o; o.x = cvtpk(a[0], a[1]); o.y = cvtpk(a[2], a[3]); o.z = cvtpk(b[0], b[1]); o.w = cvtpk(b[2], b[3]);
        *(u32x4*)(dst + drow * 512 + col) = o;
    }
}
__device__ __forceinline__ void rms_row_bf16(const float* xrow, const float* g, bf16_t* orow, int lane) {
    const f32x4* xr = (const f32x4*)xrow + lane; const f32x4* gr = (const f32x4*)g + lane;
    f32x4 v[4]; float s = 0.f;
#pragma unroll
    for (int j = 0; j < 4; ++j) { v[j] = xr[64 * j]; s += (v[j][0] * v[j][0] + v[j][1] * v[j][1]) + (v[j][2] * v[j][2] + v[j][3] * v[j][3]); }
    const float rstd = 1.f / sqrtf(wave_sum(s) * (1.f / DM) + EPS);
    u32x2* o8 = (u32x2*)orow + lane;
#pragma unroll
    for (int j = 0; j < 4; ++j) { const f32x4 gg = gr[64 * j]; u32x2 w; w.x = cvtpk(v[j][0] * rstd * gg[0], v[j][1] * rstd * gg[1]); w.y = cvtpk(v[j][2] * rstd * gg[2], v[j][3] * rstd * gg[3]); o8[64 * j] = w; }
}

template <bool SLICED> __device__ __forceinline__ void cvt_row_fp8(const float* src, unsigned char* dst_base, int row, float* scale_out, int lane) {
    const f32x4* xr = (const f32x4*)src + lane;
    f32x4 v[4]; float am = 0.f;
#pragma unroll
    for (int j = 0; j < 4; ++j) { v[j] = xr[64 * j]; am = fmaxf(am, fmaxf(fmaxf(fabsf(v[j][0]), fabsf(v[j][1])), fmaxf(fabsf(v[j][2]), fabsf(v[j][3])))); }
#pragma unroll
    for (int o = 1; o < 64; o <<= 1) am = fmaxf(am, __shfl_xor(am, o));
    const float sc = am > 0.f ? am * (1.f / 448.f) : 1.f, inv = 1.f / sc;
#pragma unroll
    for (int j = 0; j < 4; ++j) {
        const int eb = 256 * j + 4 * lane;
        int w = __builtin_amdgcn_cvt_pk_fp8_f32(v[j][0] * inv, v[j][1] * inv, 0, false);
        w = __builtin_amdgcn_cvt_pk_fp8_f32(v[j][2] * inv, v[j][3] * inv, w, true);
        if (SLICED) *(int*)(dst_base + ((size_t)(eb >> 7) * 16384 + row) * 128 + (eb & 127)) = w;
        else *(int*)(dst_base + (size_t)row * DM + 16 * ((eb & 511) >> 3) + (eb & 7) + (eb >= 512 ? 8 : 0)) = w;
    }
    if (lane == 0) *scale_out = sc;
}

__device__ __forceinline__ void rms_row2_bf16(const float* xa, const float* xb, const float* g, bf16_t* oa, bf16_t* ob, int lane) {
    const f32x4* ra = (const f32x4*)xa + lane; const f32x4* rb = (const f32x4*)xb + lane; const f32x4* gr = (const f32x4*)g + lane;
    f32x4 va[4], vb[4]; float sa = 0.f, sb = 0.f;
#pragma unroll
    for (int j = 0; j < 4; ++j) { va[j] = ra[64 * j]; vb[j] = rb[64 * j]; }
#pragma unroll
    for (int j = 0; j < 4; ++j) { sa += (va[j][0] * va[j][0] + va[j][1] * va[j][1]) + (va[j][2] * va[j][2] + va[j][3] * va[j][3]); sb += (vb[j][0] * vb[j][0] + vb[j][1] * vb[j][1]) + (vb[j][2] * vb[j][2] + vb[j][3] * vb[j][3]); }
    const float ra_ = 1.f / sqrtf(wave_total(sa) * (1.f / DM) + EPS), rb_ = 1.f / sqrtf(wave_total(sb) * (1.f / DM) + EPS);
    u32x2* o8a = (u32x2*)oa + lane; u32x2* o8b = (u32x2*)ob + lane;
#pragma unroll
    for (int j = 0; j < 4; ++j) { const f32x4 gg = gr[64 * j];
        u32x2 w; w.x = cvtpk(va[j][0] * ra_ * gg[0], va[j][1] * ra_ * gg[1]); w.y = cvtpk(va[j][2] * ra_ * gg[2], va[j][3] * ra_ * gg[3]); o8a[64 * j] = w;
        u32x2 z; z.x = cvtpk(vb[j][0] * rb_ * gg[0], vb[j][1] * rb_ * gg[1]); z.y = cvtpk(vb[j][2] * rb_ * gg[2], vb[j][3] * rb_ * gg[3]); o8b[64 * j] = z; }
}
__device__ __forceinline__ void phase0(const Params& p, LAS unsigned char* lds, int tid, int lane, int wave) {
    const int gw = blockIdx.x * 8 + wave, NGW = gridDim.x * 8;
    LAS float* scr = (LAS float*)(lds + wave * 16384);
    bf16_t* WINT = (bf16_t*)(p.ws + WS_WINT);
    constexpr int I_IN = 16 * (DIN / 32);
    for (int it = gw; it < I_IN; it += NGW) transpose_item<true>(p.in[6], 1024, DIN, WINT, scr, it, lane);
    bf16_t* H = (bf16_t*)(p.ws + WS_H);
    for (int m = gw; m < NT; m += 2 * NGW) {
        const int m2 = m + NGW < NT ? m + NGW : m;
        const float* xr = m < NP ? p.in[0] + (size_t)m * DM : p.in[1] + (size_t)(m - NP) * DM;
        const float* xr2 = m2 < NP ? p.in[0] + (size_t)m2 * DM : p.in[1] + (size_t)(m2 - NP) * DM;
        rms_row2_bf16(xr, xr2, p.in[5], H + (size_t)m * DM, H + (size_t)m2 * DM, lane);
    }
}
__device__ __forceinline__ void prep_late(const Params& p, LAS unsigned char* lds, int tid, int lane, int wave, int rank, int nparts) {
    const int gw = rank * 8 + wave, NGW = nparts * 8;
    LAS float* scr = (LAS float*)(lds + wave * 16384);
    const size_t gt = (size_t)rank * 512 + tid, ngt = (size_t)nparts * 512;
    cvt_cache(p.in[2], (bf16_t*)(p.ws + WS_KS), gt, ngt);
    cvt_cache(p.in[3], (bf16_t*)(p.ws + WS_VS), gt, ngt);
    bf16_t* WOUTT = (bf16_t*)(p.ws + WS_WOUTT); bf16_t* WQT = (bf16_t*)(p.ws + WS_WQT);
    constexpr int I_OUT = 16 * (1024 / 32), I_Q = 16 * (2048 / 32);
    for (int it = gw; it < I_OUT + I_Q; it += NGW) {
        if (it < I_OUT) transpose_item<false>(p.in[17], 1024, 1024, WOUTT, scr, it, lane);
        else transpose_item<false>(p.in[19], 1024, 2048, WQT, scr, it - I_OUT, lane);
    }
    cvt_stream(p.in[20], (bf16_t*)(p.ws + WS_SK), (size_t)16 * 128 * 128 / 8, gt, ngt);
    for (int r = gw; r < 2 * 16384; r += NGW) {
        const int tb = r >> 14, e = r & 16383;
        if (tb) cvt_row_fp8<true>(p.in[22] + (size_t)e * DM, p.ws + WS_PV8, e, (float*)(p.ws + WS_SCV) + e, lane);
        else cvt_row_fp8<true>(p.in[21] + (size_t)e * DM, p.ws + WS_PU8, e, (float*)(p.ws + WS_SCU) + e, lane);
    }
}

namespace att {
constexpr int KPITCH = 272, VPITCH = 320;
constexpr int L_KV = 0, KV_BYTES = 64 * KPITCH + 64 * VPITCH  , L_X = 0  , L_BIAS = BIAS_OFF, L_CA = 0  , L_CW = 94 * 1024  ;
static_assert(4 * 4096 * 4 <= 2 * KV_BYTES && 2 * KV_BYTES <= L_CW && L_CW + 31 * 1024 <= RING_BYTES, "attention LDS map");

__device__ __forceinline__ int rel_bucket(int rel) {
    const int ret = rel > 0 ? 16 : 0; const int n = rel < 0 ? -rel : rel; int v;
    if (n < 8) v = n; else if (n < 12) v = 8; else if (n < 16) v = 9; else if (n < 23) v = 10; else if (n < 32) v = 11;
    else if (n < 46) v = 12; else if (n < 64) v = 13; else if (n < 91) v = 14; else v = 15;
    return ret + v;
}
typedef short v4i16_t __attribute__((ext_vector_type(4)));
__device__ __forceinline__ s16x4 vtr(const LAS unsigned char* p) { return __builtin_bit_cast(s16x4, __builtin_amdgcn_ds_read_tr16_b64_v4i16((LAS v4i16_t*)p)); }
__device__ __forceinline__ f32x16 mfma32(bf16x8 a, bf16x8 b, f32x16 c) { return __builtin_amdgcn_mfma_f32_32x32x16_bf16(a, b, c, 0, 0, 0); }

__device__ __forceinline__ void attn_unit(const Params& p, LAS unsigned char* lds, int kind, int bb, int h, int qblk, float lam, int tid, int lane, int wid) {
    const bf16_t* Q = (const bf16_t*)(p.ws + WS_Q);
    const bf16_t* Kb = kind == 0 ? (const bf16_t*)(p.ws + WS_KP) + (size_t)bb * 2048 * 512 + h * 128 : (const bf16_t*)(p.ws + WS_KS) + (size_t)bb * SKV * 512 + h * 128;
    const bf16_t* Vb = kind == 0 ? (const bf16_t*)(p.ws + WS_VP) + (size_t)bb * 2048 * 512 + h * 128 : (const bf16_t*)(p.ws + WS_VS) + (size_t)bb * SKV * 512 + h * 128;
    bf16_t* MIX = (bf16_t*)(p.ws + WS_MIX);
    const int qrow0 = kind == 0 ? bb * 2048 + qblk * 128 : NP + bb * 64;
    const int qpos0 = kind == 0 ? qblk * 128 : 2048;
    const int ntiles = kind == 0 ? 2 * qblk + 2 : 33;
    const int rg = wid & 3, map = wid >> 2, r32 = lane & 31, hi = lane >> 5;
    const bool active = kind == 0 ? true : (rg < 2);
    const int cw = kind == 0 ? 2 * qblk + (rg >> 1) : 32;
    const int qw0 = qpos0 + 32 * rg;
    const int qabs = qw0 + r32;

    bf16x8 qf[4];
    if (active) {
        const bf16_t* qp = Q + (size_t)(qrow0 + 32 * rg + r32) * 512 + h * 128 + map * 64 + 8 * hi;
#pragma unroll
        for (int s = 0; s < 4; ++s) qf[s] = *(const bf16x8*)(qp + 16 * s);
    } else {
#pragma unroll
        for (int s = 0; s < 4; ++s) qf[s] = (bf16x8){0, 0, 0, 0, 0, 0, 0, 0};
    }
    float m = 0.f, l = 0.f;
    f32x16 negm;
#pragma unroll
    for (int r = 0; r < 16; ++r) negm[r] = 0.f;
    f32x16 o[4];
#pragma unroll
    for (int mt = 0; mt < 4; ++mt)
#pragma unroll
        for (int r = 0; r < 16; ++r) o[mt][r] = 0.f;

    const int srow0 = tid >> 4, sch = tid & 15;
    const LAS float* btab = (const LAS float*)(lds + L_BIAS) + h * 320;
    const int vlane = (4 * hi + ((lane & 15) >> 2)) * VPITCH + (16 * ((lane >> 4) & 1) + 4 * (lane & 3)) * 2;
    u32x4 kA[2], vA[2], kB[2], vB[2];
#define ATT_LOAD(KR, VR, T) do { _Pragma("unroll") for (int i_ = 0; i_ < 2; ++i_) { const size_t off_ = (size_t)((T) * 64 + srow0 + 32 * i_) * 512 + sch * 8; KR[i_] = *(const u32x4*)(Kb + off_); VR[i_] = *(const u32x4*)(Vb + off_); } } while (0)
#define ATT_STORE(KR, VR, BUF) do { _Pragma("unroll") for (int i_ = 0; i_ < 2; ++i_) { \
        *(LAS u32x4*)(lds + L_KV + (BUF) * KV_BYTES + (srow0 + 32 * i_) * KPITCH + sch * 16) = KR[i_]; \
        *(LAS u32x4*)(lds + L_KV + (BUF) * KV_BYTES + 64 * KPITCH + (srow0 + 32 * i_) * VPITCH + sch * 16) = VR[i_]; } } while (0)
    auto compute = [&](int t, int buf) {
        const LAS unsigned char* kbuf = lds + L_KV + buf * KV_BYTES;
        const LAS unsigned char* vbuf = kbuf + 64 * KPITCH;
        f32x16 p0, p1;
        const int kabs0 = t * 64;
        const LAS unsigned char* kb = kbuf + r32 * KPITCH + (map * 8 + hi) * 16;
        {
            const bf16x8 a0 = *(const LAS bf16x8*)(kb), a1 = *(const LAS bf16x8*)(kb + 32 * KPITCH);
            if (kabs0 + 63 - qw0 > -128) {
                const LAS float* bt = btab + (kabs0 - qabs + 256 + 4 * hi);
#pragma unroll
                for (int r = 0; r < 16; ++r) { p0[r] = bt[(r & 3) + 8 * (r >> 2)] - m; p1[r] = bt[32 + (r & 3) + 8 * (r >> 2)] - m; }
                p0 = mfma32(a0, qf[0], p0); p1 = mfma32(a1, qf[0], p1);
            } else { p0 = mfma32(a0, qf[0], negm); p1 = mfma32(a1, qf[0], negm); }
        }
#pragma unroll
        for (int s = 1; s < 4; ++s) {
            const bf16x8 a0 = *(const LAS bf16x8*)(kb + s * 32), a1 = *(const LAS bf16x8*)(kb + 32 * KPITCH + s * 32);
            p0 = mfma32(a0, qf[s], p0); p1 = mfma32(a1, qf[s], p1);
        }
        float mx = fmaxf(p0[0], p1[0]);
#pragma unroll
        for (int r = 1; r < 16; ++r) mx = fmaxf(mx, fmaxf(p0[r], p1[r]));
        { const auto rr = __builtin_amdgcn_permlane32_swap(__float_as_uint(mx), __float_as_uint(mx), false, false); mx = fmaxf(__uint_as_float(rr[0]), __uint_as_float(rr[1])); }
        if (__any(mx > 8.f)) {
            const float dl = fmaxf(mx, 0.f);
            m += dl;
            const float alpha = __builtin_amdgcn_exp2f(-dl);
            l *= alpha;
#pragma unroll
            for (int r = 0; r < 16; ++r) { p0[r] -= dl; p1[r] -= dl; negm[r] = -m; }
#pragma unroll
            for (int mt = 0; mt < 4; ++mt)
#pragma unroll
                for (int r = 0; r < 16; ++r) o[mt][r] *= alpha;
        }
        float rs = 0.f;
#pragma unroll
        for (int r = 0; r < 16; ++r) { p0[r] = __builtin_amdgcn_exp2f(p0[r]); p1[r] = __builtin_amdgcn_exp2f(p1[r]); rs += p0[r] + p1[r]; }
        l += rs;
#pragma unroll
        for (int t2 = 0; t2 < 2; ++t2)
#pragma unroll
            for (int s = 0; s < 2; ++s) {
                u32x4 bw;
                if (t2 == 0) { bw.x = cvtpk(p0[8 * s + 0], p0[8 * s + 1]); bw.y = cvtpk(p0[8 * s + 2], p0[8 * s + 3]); bw.z = cvtpk(p0[8 * s + 4], p0[8 * s + 5]); bw.w = cvtpk(p0[8 * s + 6], p0[8 * s + 7]); }
                else { bw.x = cvtpk(p1[8 * s + 0], p1[8 * s + 1]); bw.y = cvtpk(p1[8 * s + 2], p1[8 * s + 3]); bw.z = cvtpk(p1[8 * s + 4], p1[8 * s + 5]); bw.w = cvtpk(p1[8 * s + 6], p1[8 * s + 7]); }
                const bf16x8 B = __builtin_bit_cast(bf16x8, bw);
                const LAS unsigned char* vb = vbuf + vlane + (32 * t2 + 16 * s) * VPITCH;
#pragma unroll
                for (int mt = 0; mt < 4; ++mt) {
                    const s16x4 lo = vtr(vb + mt * 64), hi8 = vtr(vb + mt * 64 + 8 * VPITCH);
                    const bf16x8 A = (bf16x8){lo[0], lo[1], lo[2], lo[3], hi8[0], hi8[1], hi8[2], hi8[3]};
                    o[mt] = mfma32(A, B, o[mt]);
                }
            }
    };
    ATT_LOAD(kA, vA, 0);
    if (ntiles > 1) ATT_LOAD(kB, vB, 1);
    ATT_STORE(kA, vA, 0);
    if (ntiles > 2) ATT_LOAD(kA, vA, 2);
    __syncthreads();
    for (int t = 0; t < ntiles; t += 2) {
        if (t + 1 < ntiles) { ATT_STORE(kB, vB, 1); if (t + 3 < ntiles) ATT_LOAD(kB, vB, t + 3); }
        if (active && t <= cw) compute(t, 0);
        __syncthreads();
        if (t + 1 >= ntiles) break;
        if (t + 2 < ntiles) { ATT_STORE(kA, vA, 0); if (t + 4 < ntiles) ATT_LOAD(kA, vA, t + 4); }
        if (active && t + 1 <= cw) compute(t + 1, 1);
        __syncthreads();
    }
#undef ATT_LOAD
#undef ATT_STORE
    l += __shfl_xor(l, 32);
    const float inv = 1.f / l;
    LAS float* X = (LAS float*)(lds + L_X) + rg * 4096;
    if (active && map == 1) {
        const float sc = -lam * inv;
#pragma unroll
        for (int mt = 0; mt < 4; ++mt)
#pragma unroll
            for (int r = 0; r < 16; ++r) X[(mt * 16 + r) * 64 + lane] = o[mt][r] * sc;
    }
    __syncthreads();
    if (active && map == 0) {
        float ss = 0.f;
#pragma unroll
        for (int mt = 0; mt < 4; ++mt)
#pragma unroll
            for (int r = 0; r < 16; ++r) { const float v = o[mt][r] * inv + X[(mt * 16 + r) * 64 + lane]; o[mt][r] = v; ss += v * v; }
        ss += __shfl_xor(ss, 32);
        const float rsn = 0.8f / sqrtf(ss * (1.f / 128.f) + EPS);
        bf16_t* orow = MIX + (size_t)(qrow0 + 32 * rg + r32) * 1024 + 512 + h * 128;
        const float* sg = p.in[15];
#pragma unroll
        for (int mt = 0; mt < 4; ++mt)
#pragma unroll
            for (int g4 = 0; g4 < 4; ++g4) {
                const int e = 32 * mt + 8 * g4 + 4 * hi;
                const f32x4 gg = *(const f32x4*)(sg + e);
                u32x2 w; w.x = cvtpk(o[mt][4 * g4 + 0] * rsn * gg[0], o[mt][4 * g4 + 1] * rsn * gg[1]); w.y = cvtpk(o[mt][4 * g4 + 2] * rsn * gg[2], o[mt][4 * g4 + 3] * rsn * gg[3]);
                *(u32x2*)(orow + e) = w;
            }
    }
    __syncthreads();
}

__device__ __forceinline__ void unpack8(const u32x4 w, float (&f)[8]) { f[0] = bflo(w.x); f[1] = bfhi(w.x); f[2] = bflo(w.y); f[3] = bfhi(w.y); f[4] = bflo(w.z); f[5] = bfhi(w.z); f[6] = bflo(w.w); f[7] = bfhi(w.w); }
__device__ __forceinline__ void conv_unit(const Params& p, LAS unsigned char* lds, int cu, int tid, int lane, int wid) {
    const bf16_t* A = (const bf16_t*)(p.ws + WS_A);
    bf16_t* MIX = (bf16_t*)(p.ws + WS_MIX);
    const float* cb = p.in[8]; const float* lg = p.in[9]; const float* lb = p.in[10]; const float* st = p.in[4];
    const int row0 = cu * 64;
    const bool isp = row0 < NP;
    const int s0 = isp ? (row0 & 2047) : 0, rbase = row0 - s0, bd = isp ? 0 : ((row0 - NP) >> 6);
    for (int c = tid; c < 94 * 64; c += 512) {
        const int rr = c >> 6, ch = c & 63, sp = s0 - 30 + rr;
        u32x4 v = (u32x4){0u, 0u, 0u, 0u};
        if (sp >= 0) v = *(const u32x4*)(A + (size_t)(rbase + sp) * 512 + ch * 8);
        else if (!isp) { const float* sr = st + ((size_t)bd * 30 + (30 + sp)) * 512 + ch * 8; const f32x4 a0 = *(const f32x4*)sr, a1 = *(const f32x4*)(sr + 4);
            v.x = cvtpk(a0[0], a0[1]); v.y = cvtpk(a0[2], a0[3]); v.z = cvtpk(a1[0], a1[1]); v.w = cvtpk(a1[2], a1[3]); }
        *(LAS u32x4*)(lds + L_CA + rr * 1024 + ch * 16) = v;
    }
    __syncthreads();
    const int c0 = lane * 8;
    float bias8[8], g8[8], b8[8];
    { const f32x4 x0 = *(const f32x4*)(cb + c0), x1 = *(const f32x4*)(cb + c0 + 4), y0 = *(const f32x4*)(lg + c0), y1 = *(const f32x4*)(lg + c0 + 4), z0 = *(const f32x4*)(lb + c0), z1 = *(const f32x4*)(lb + c0 + 4);
#pragma unroll
      for (int q = 0; q < 4; ++q) { bias8[q] = x0[q]; bias8[4 + q] = x1[q]; g8[q] = y0[q]; g8[4 + q] = y1[q]; b8[q] = z0[q]; b8[4 + q] = z1[q]; } }
    for (int grp = 0; grp < 2; ++grp) {
        const int t0 = wid * 8 + grp * 4;
        float acc[4][8];
#pragma unroll
        for (int q = 0; q < 4; ++q)
#pragma unroll
            for (int c = 0; c < 8; ++c) acc[q][c] = bias8[c];
        const LAS unsigned char* ap = lds + L_CA + t0 * 1024 + lane * 16;
        const LAS unsigned char* wp = lds + L_CW + lane * 16;
#pragma unroll 1
        for (int j = 0; j < 31; ++j) {
            float w[8]; unpack8(*(const LAS u32x4*)(wp + j * 1024), w);
#pragma unroll
            for (int q = 0; q < 4; ++q) {
                float a[8]; unpack8(*(const LAS u32x4*)(ap + (j + q) * 1024), a);
#pragma unroll
                for (int c = 0; c < 8; ++c) acc[q][c] += w[c] * a[c];
            }
        }
#pragma unroll
        for (int q = 0; q < 4; ++q) {
            float sm = 0.f;
#pragma unroll
            for (int c = 0; c < 8; ++c) sm += acc[q][c];
            const float mu = wave_total(sm) * (1.f / 512.f);
            float sv = 0.f;
#pragma unroll
            for (int c = 0; c < 8; ++c) { acc[q][c] -= mu; sv += acc[q][c] * acc[q][c]; }
            const float rstd = 1.f / sqrtf(wave_total(sv) * (1.f / 512.f) + EPS);
            float y[8];
#pragma unroll
            for (int c = 0; c < 8; ++c) { y[c] = acc[q][c] * rstd * g8[c] + b8[c]; y[c] = y[c] / (1.f + __expf(-y[c])); }
            u32x4 w; w.x = cvtpk(y[0], y[1]); w.y = cvtpk(y[2], y[3]); w.z = cvtpk(y[4], y[5]); w.w = cvtpk(y[6], y[7]);
            *(u32x4*)(MIX + (size_t)(row0 + t0 + q) * 1024 + c0) = w;
        }
    }
}

constexpr int N_SAMPLE_UNITS = 32, N_PROMPT_UNITS = 1024, N_CONV_UNITS = NT / 64, N_UNITS = N_SAMPLE_UNITS + N_PROMPT_UNITS + N_CONV_UNITS;

__device__ __forceinline__ void phase2(const Params& p, LAS unsigned char* lds, int tid, int lane, int wid, int cidx, int mode) {
    LAS float* bt = (LAS float*)(lds + L_BIAS);
    for (int e = tid; e < 4 * 320; e += 512) { const int hh = e / 320, rel = (e % 320) - 256; bt[e] = (p.in[16][rel_bucket(rel) * 4 + hh] - p.in[16][15 * 4 + hh]) * LOG2E; }
    for (int c = tid; c < 31 * 64; c += 512) {
        const float* wr = p.in[7] + (size_t)c * 8; const f32x4 a0 = *(const f32x4*)wr, a1 = *(const f32x4*)(wr + 4);
        u32x4 v; v.x = cvtpk(a0[0], a0[1]); v.y = cvtpk(a0[2], a0[3]); v.z = cvtpk(a1[0], a1[1]); v.w = cvtpk(a1[2], a1[3]);
        *(LAS u32x4*)(lds + L_CW + c * 16) = v;
    }
    const float d1 = wave_sum(p.in[11][lane] * p.in[12][lane]), d2 = wave_sum(p.in[13][lane] * p.in[14][lane]);
    const float lam = expf(d1) - expf(d2) + 0.2f;
    unsigned* ctr = (unsigned*)(p.ws + WS_CTL) + 64 * cidx;
    volatile LAS unsigned* sw = (volatile LAS unsigned*)(lds + MISC_OFF);
    __syncthreads();
    for (;;) {
        __syncthreads();
        if (tid == 0) sw[0] = atomicAdd(ctr, 1u);
        __syncthreads();
        const int u = (int)sw[0];
        if (u >= N_UNITS) break;
        if (mode == 1 && u >= N_SAMPLE_UNITS + N_PROMPT_UNITS) continue;
        if (mode == 2 && u < N_SAMPLE_UNITS + N_PROMPT_UNITS) continue;
        int tid_ = tid; asm volatile("" : "+v"(tid_));
        if (u < N_SAMPLE_UNITS + N_PROMPT_UNITS) {
            const int v = u - N_SAMPLE_UNITS; const int bh = v & 63; const bool smp = u < N_SAMPLE_UNITS;
            attn_unit(p, lds, smp ? 1 : 0, smp ? (u >> 2) : (bh >> 2), smp ? (u & 3) : (bh & 3), smp ? 0 : 15 - (v >> 6), lam, tid_, tid_ & 63, wid);
        } else conv_unit(p, lds, u - N_SAMPLE_UNITS - N_PROMPT_UNITS, tid_, tid_ & 63, wid);
    }
}
}

template <class F> __device__ __forceinline__ void mini_gemm(const bf16_t* A, const bf16_t* Bt, int N, int lane, int wave, F epi) {
    const int ntasks = 32 * (N / 64), G = gridDim.x;
    const int fr = lane & 15, fq = lane >> 4;
    for (int task = wave * G + (int)blockIdx.x; task < ntasks; task += 8 * G) {
        const int rb = task & 31, cb = task >> 5;
        pg8::f32x4 acc[4];
#pragma unroll
        for (int n = 0; n < 4; ++n) acc[n] = (pg8::f32x4){0.f, 0.f, 0.f, 0.f};
        const bf16_t* ap = A + (size_t)(rb * 16 + fr) * 1024 + 8 * fq;
        const bf16_t* bp = Bt + (size_t)(cb * 64 + fr) * 1024 + 8 * fq;
#pragma unroll 8
        for (int k0 = 0; k0 < 1024; k0 += 32) {
            const bf16x8 a0 = *(const bf16x8*)(ap + k0);
            bf16x8 b[4];
#pragma unroll
            for (int n = 0; n < 4; ++n) b[n] = *(const bf16x8*)(bp + (size_t)n * 16 * 1024 + k0);
#pragma unroll
            for (int n = 0; n < 4; ++n) acc[n] = __builtin_amdgcn_mfma_f32_16x16x32_bf16(b[n], a0, acc[n], 0, 0, 0);
        }
        epi(rb * 16 + fr, cb, fq, acc);
    }
}

__device__ __forceinline__ void phase3b(const Params& p, int lane, int wave) {
    const int gw = blockIdx.x * 8 + wave, NGW = gridDim.x * 8;
    bf16_t* H2 = (bf16_t*)(p.ws + WS_H2);
    for (int m = gw; m < NT; m += 2 * NGW) { const int m2 = m + NGW < NT ? m + NGW : m; rms_row2_bf16(p.out + (size_t)m * DM, p.out + (size_t)m2 * DM, p.in[18], H2 + (size_t)m * DM, H2 + (size_t)m2 * DM, lane); }
}

constexpr int P4B_KPITCH = 272, P4B_K_BYTES = 128 * P4B_KPITCH, P4B_Q_BYTES = 32 * P4B_KPITCH;
static_assert(P4B_K_BYTES + 8 * P4B_Q_BYTES <= RING_BYTES, "P4b LDS map");
__device__ __forceinline__ void phase4b(const Params& p, LAS unsigned char* lds, int tid, int lane, int wave) {
    const bf16_t* QP = (const bf16_t*)(p.ws + WS_QP); const bf16_t* SK = (const bf16_t*)(p.ws + WS_SK);
    float* TK = (float*)(p.ws + WS_TK);
    const int r32 = lane & 31, hi = lane >> 5;
    const int G = gridDim.x;
    for (int rp = blockIdx.x & 15; rp < 16; rp += (G < 16 ? G : 16)) {
        const int nbr = (G - rp + 15) >> 4, member = (int)blockIdx.x >> 4;
        __syncthreads();
        for (int c = tid; c < 128 * 16; c += 512) { const int row = c >> 4, ch = c & 15; *(LAS u32x4*)(lds + row * P4B_KPITCH + ch * 16) = *(const u32x4*)(SK + ((size_t)rp * 128 + row) * 128 + ch * 8); }
        __syncthreads();
        LAS unsigned char* qs = lds + P4B_K_BYTES + wave * P4B_Q_BYTES;
        for (int tg = member * 8 + wave; tg < NT / 32; tg += nbr * 8) {
            const int t0 = tg * 32;
#pragma unroll
            for (int i = 0; i < 8; ++i) { const int row = 4 * i + (lane >> 4), ch = lane & 15; *(LAS u32x4*)(qs + row * P4B_KPITCH + ch * 16) = *(const u32x4*)(QP + (size_t)(t0 + row) * 2048 + rp * 128 + ch * 8); }
            bf16x8 qf[8];
#pragma unroll
            for (int s = 0; s < 8; ++s) qf[s] = *(const LAS bf16x8*)(qs + r32 * P4B_KPITCH + (2 * s + hi) * 16);
            float v[64];
#pragma unroll
            for (int mt = 0; mt < 4; ++mt) {
                f32x16 S;
#pragma unroll
                for (int r = 0; r < 16; ++r) S[r] = 0.f;
                const LAS unsigned char* kp = lds + (32 * mt + r32) * P4B_KPITCH + hi * 16;
#pragma unroll
                for (int s = 0; s < 8; ++s) S = att::mfma32(*(const LAS bf16x8*)(kp + s * 32), qf[s], S);
#pragma unroll
                for (int r = 0; r < 16; ++r) { const int n = 32 * mt + (r & 3) + 8 * (r >> 2) + 4 * hi; v[mt * 16 + r] = __uint_as_float((__float_as_uint(S[r]) & ~127u) | (unsigned)(127 - n)); }
            }
            SORT16_DESC(v, 0); SORT16_DESC(v, 16); SORT16_DESC(v, 32); SORT16_DESC(v, 48);
#pragma unroll
            for (int i = 0; i < 16; ++i) { v[i] = fmaxf(v[i], v[31 - i]); v[32 + i] = fmaxf(v[32 + i], v[63 - i]); }
            BITONIC16_DESC(v, 0); BITONIC16_DESC(v, 32);
#pragma unroll
            for (int i = 0; i < 16; ++i) v[i] = fmaxf(v[i], v[47 - i]);
            BITONIC16_DESC(v, 0);
            float w[16];
#pragma unroll
            for (int i = 0; i < 16; ++i) w[i] = fmaxf(v[i], __shfl_xor(v[15 - i], 32));
            BITONIC16_DESC(w, 0);
            if (hi == 0) {
                f32x4* dst = (f32x4*)(TK + ((size_t)(t0 + r32) * 16 + rp) * 16);
#pragma unroll
                for (int q = 0; q < 4; ++q) dst[q] = (f32x4){w[4 * q], w[4 * q + 1], w[4 * q + 2], w[4 * q + 3]};
            }
        }
    }
}

__device__ __forceinline__ void phase5a(const Params& p, LAS unsigned char* lds, int tid) {
    const float* TK = (const float*)(p.ws + WS_TK);
    int* IDX = (int*)(p.ws + WS_IDX); float* GATE = (float*)(p.ws + WS_GATE);
    const float NEG_INF = -__builtin_huge_valf();
    LAS unsigned* rec = (LAS unsigned*)(lds + tid * 36);
    for (int item = blockIdx.x * 512 + tid; item < NT * 8; item += gridDim.x * 512) {
        const int tok = item >> 3, r = item & 7;
        const f32x4* pa = (const f32x4*)(TK + ((size_t)tok * 16 + 2 * r) * 16);
        float a[16], b[16];
#pragma unroll
        for (int q = 0; q < 4; ++q) { const f32x4 x = pa[q], y = pa[4 + q];
#pragma unroll
            for (int j = 0; j < 4; ++j) { a[4 * q + j] = x[j]; b[4 * q + j] = y[j]; } }
        float ssum = 0.f;
        { const f32x4* sp = (const f32x4*)((const float*)(p.ws + WS_SSQ) + (size_t)tok * 16);
#pragma unroll
          for (int q = 0; q < 4; ++q) { const f32x4 v4 = sp[q]; ssum += (v4[0] + v4[1]) + (v4[2] + v4[3]); } }
#pragma unroll
        for (int q = 0; q < 4; ++q) {
            unsigned wa = 0u, wb = 0u;
#pragma unroll
            for (int j = 0; j < 4; ++j) { const unsigned ua = __float_as_uint(a[4 * q + j]), ub = __float_as_uint(b[4 * q + j]);
                wa |= (127u - (ua & 127u)) << (8 * j); wb |= (127u - (ub & 127u)) << (8 * j);
                a[4 * q + j] = __uint_as_float(ua & ~127u); b[4 * q + j] = __uint_as_float(ub & ~127u); }
            rec[q] = wa; rec[4 + q] = wb;
        }
        float v[64];
        {
            int c = 0;
#pragma unroll
            for (int i = 0; i < 16; ++i)
#pragma unroll
                for (int j = 0; j < 16; ++j)
                    if ((i + 1) * (j + 1) <= 16) { v[c] = __uint_as_float((__float_as_uint(a[i] + b[j]) & ~255u) | (unsigned)(255 - (16 * i + j))); ++c; }
#pragma unroll
            for (int c2 = 50; c2 < 64; ++c2) v[c2] = NEG_INF;
        }
        SORT16_DESC(v, 0); SORT16_DESC(v, 16); SORT16_DESC(v, 32); SORT16_DESC(v, 48);
#pragma unroll
        for (int i = 0; i < 16; ++i) { v[i] = fmaxf(v[i], v[31 - i]); v[32 + i] = fmaxf(v[32 + i], v[63 - i]); }
        BITONIC16_DESC(v, 0); BITONIC16_DESC(v, 32);
#pragma unroll
        for (int i = 0; i < 16; ++i) v[i] = fmaxf(v[i], v[47 - i]);
        BITONIC16_DESC(v, 0);
        const float rstd = 1.f / sqrtf(ssum * (1.f / DM) + EPS);
        if (r == 0) ((float*)(p.ws + WS_RSTD))[tok] = rstd;
        const LAS unsigned char* rb = (const LAS unsigned char*)rec;
        float e[16], sum = 0.f; int bid[16];
        const float best0 = __uint_as_float(__float_as_uint(v[0]) & ~255u);
#pragma unroll
        for (int k = 0; k < 16; ++k) {
            const unsigned u = __float_as_uint(v[k]); const unsigned code = 255u - (u & 255u);
            bid[k] = (int)rb[code >> 4] * 128 + (int)rb[16 + (code & 15u)];
            e[k] = __expf((__uint_as_float(u & ~255u) - best0) * rstd); sum += e[k];
        }
        const float rinv = 1.f / sum;
        int* io = IDX + (size_t)tok * 128 + r * 16; float* go = GATE + (size_t)tok * 128 + r * 16;
#pragma unroll
        for (int k = 0; k < 16; ++k) { io[k] = bid[k]; go[k] = e[k] * rinv; }
    }
}

__device__ __forceinline__ float gelu_erf(float x) { return 0.5f * x * (1.f + erff(x * 0.70710678118654752f)); }
__device__ __forceinline__ void fp8x16_to_f32(const u32x4 q, float (&f)[16]) {
    const f32x2 c0 = __builtin_amdgcn_cvt_pk_f32_fp8(q.x, false), c1 = __builtin_amdgcn_cvt_pk_f32_fp8(q.x, true), c2 = __builtin_amdgcn_cvt_pk_f32_fp8(q.y, false), c3 = __builtin_amdgcn_cvt_pk_f32_fp8(q.y, true);
    const f32x2 c4 = __builtin_amdgcn_cvt_pk_f32_fp8(q.z, false), c5 = __builtin_amdgcn_cvt_pk_f32_fp8(q.z, true), c6 = __builtin_amdgcn_cvt_pk_f32_fp8(q.w, false), c7 = __builtin_amdgcn_cvt_pk_f32_fp8(q.w, true);
    f[0] = c0.x; f[1] = c0.y; f[2] = c1.x; f[3] = c1.y; f[4] = c2.x; f[5] = c2.y; f[6] = c3.x; f[7] = c3.y;
    f[8] = c4.x; f[9] = c4.y; f[10] = c5.x; f[11] = c5.y; f[12] = c6.x; f[13] = c6.y; f[14] = c7.x; f[15] = c7.y;
}
__device__ __forceinline__ void slice_group(int& x, int& gwx, int& nwx, int wave) {
    x = blockIdx.x & 7; const int nbx = ((int)gridDim.x - x + 7) >> 3; gwx = ((int)blockIdx.x >> 3) * 8 + wave; nwx = nbx * 8;
}
__device__ __forceinline__ void phase5u(const Params& p, LAS unsigned char* lds, int lane, int wave) {
    int x, gwx, nwx; slice_group(x, gwx, nwx, wave);
    const unsigned char* PU8 = p.ws + WS_PU8 + (size_t)x * 16384 * 128;
    const bf16_t* H2 = (const bf16_t*)(p.ws + WS_XG) + 128 * x;
    const int* IDX = (const int*)(p.ws + WS_IDX); float* PACT = (float*)(p.ws + WS_PACT) + (size_t)x * NT * 128;
    LAS int* l_idx = (LAS int*)(lds + wave * 512);
    const int g = lane >> 3, sub = lane & 7;
    const unsigned char* rowp = PU8 + sub * 16;
    int r_idxA = 0, r_idxB = 0;
    u32x4 hA0, hA1, hB0, hB1; hA0 = hA1 = hB0 = hB1 = (u32x4){0u, 0u, 0u, 0u};
    u32x4 qA[16], qB[16];
#define P5U_LOADIDX(T) do { if ((T) < NT) { r_idxA = IDX[(size_t)(T) * 128 + lane]; r_idxB = IDX[(size_t)(T) * 128 + 64 + lane]; } } while (0)
#define P5U_ISSUE(Q, H0, H1, T) do { if ((T) < NT) { l_idx[lane] = r_idxA; l_idx[64 + lane] = r_idxB; \
        H0 = *(const u32x4*)(H2 + (size_t)(T) * DM + 16 * sub); H1 = *(const u32x4*)(H2 + (size_t)(T) * DM + 16 * sub + 8); \
        _Pragma("unroll") for (int q_ = 0; q_ < 4; ++q_) { const u32x4 iv = *(const LAS u32x4*)(l_idx + 16 * g + 4 * q_); \
            Q[4 * q_] = *(const u32x4*)(rowp + (size_t)iv.x * 128); Q[4 * q_ + 1] = *(const u32x4*)(rowp + (size_t)iv.y * 128); \
            Q[4 * q_ + 2] = *(const u32x4*)(rowp + (size_t)iv.z * 128); Q[4 * q_ + 3] = *(const u32x4*)(rowp + (size_t)iv.w * 128); } } } while (0)
#define P5U_COMPUTE(Q, H0, H1, T) do { \
        f32x2 hf[8]; \
        hf[0] = (f32x2){bflo(H0.x), bfhi(H0.x)}; hf[1] = (f32x2){bflo(H0.y), bfhi(H0.y)}; hf[2] = (f32x2){bflo(H0.z), bfhi(H0.z)}; hf[3] = (f32x2){bflo(H0.w), bfhi(H0.w)}; \
        hf[4] = (f32x2){bflo(H1.x), bfhi(H1.x)}; hf[5] = (f32x2){bflo(H1.y), bfhi(H1.y)}; hf[6] = (f32x2){bflo(H1.z), bfhi(H1.z)}; hf[7] = (f32x2){bflo(H1.w), bfhi(H1.w)}; \
        float resA = 0.f, resB = 0.f; \
        _Pragma("unroll") for (int i = 0; i < 16; ++i) { \
            f32x2 s2 = __builtin_amdgcn_cvt_pk_f32_fp8(Q[i].x, false) * hf[0]; \
            s2 = __builtin_elementwise_fma(__builtin_amdgcn_cvt_pk_f32_fp8(Q[i].x, true), hf[1], s2); \
            s2 = __builtin_elementwise_fma(__builtin_amdgcn_cvt_pk_f32_fp8(Q[i].y, false), hf[2], s2); \
            s2 = __builtin_elementwise_fma(__builtin_amdgcn_cvt_pk_f32_fp8(Q[i].y, true), hf[3], s2); \
            s2 = __builtin_elementwise_fma(__builtin_amdgcn_cvt_pk_f32_fp8(Q[i].z, false), hf[4], s2); \
            s2 = __builtin_elementwise_fma(__builtin_amdgcn_cvt_pk_f32_fp8(Q[i].z, true), hf[5], s2); \
            s2 = __builtin_elementwise_fma(__builtin_amdgcn_cvt_pk_f32_fp8(Q[i].w, false), hf[6], s2); \
            s2 = __builtin_elementwise_fma(__builtin_amdgcn_cvt_pk_f32_fp8(Q[i].w, true), hf[7], s2); \
            float sr = s2.x + s2.y; \
            DPP_ADD(sr, 0xB1); DPP_ADD(sr, 0x4E); DPP_ADD(sr, 0x141); \
            if (i < 8) resA = (sub == i) ? sr : resA; else resB = (sub == i - 8) ? sr : resB; } \
        PACT[(size_t)(T) * 128 + 16 * g + sub] = resA; PACT[(size_t)(T) * 128 + 16 * g + 8 + sub] = resB; } while (0)
    int tok = gwx;
    P5U_LOADIDX(tok);
    P5U_ISSUE(qA, hA0, hA1, tok);
    P5U_LOADIDX(tok + nwx);
    for (; tok < NT; tok += 2 * nwx) {
        P5U_ISSUE(qB, hB0, hB1, tok + nwx);
        P5U_LOADIDX(tok + 2 * nwx);
        P5U_COMPUTE(qA, hA0, hA1, tok);
        if (tok + nwx >= NT) break;
        P5U_ISSUE(qA, hA0, hA1, tok + 2 * nwx);
        P5U_LOADIDX(tok + 3 * nwx);
        P5U_COMPUTE(qB, hB0, hB1, tok + nwx);
    }
#undef P5U_LOADIDX
#undef P5U_ISSUE
#undef P5U_COMPUTE
}
__device__ __forceinline__ void phase5c(const Params& p, int tid) {
    const float* PACT = (const float*)(p.ws + WS_PACT); const float* SCU = (const float*)(p.ws + WS_SCU); const float* SCV = (const float*)(p.ws + WS_SCV);
    const int* IDX = (const int*)(p.ws + WS_IDX); const float* GATE = (const float*)(p.ws + WS_GATE); float* COEF = (float*)(p.ws + WS_COEF); const float* RSTD = (const float*)(p.ws + WS_RSTD);
    const size_t n = (size_t)NT * 128, n4 = n / 4, stride = (size_t)gridDim.x * 512;
    for (size_t i0 = (size_t)blockIdx.x * 512 + tid; i0 < n4; i0 += 2 * stride) {
        f32x4 a[2], g[2]; u32x4 e[2]; f32x4 pa[2][8]; float rs[2];
#pragma unroll
        for (int u = 0; u < 2; ++u) {
            const size_t it = (i0 + u * stride < n4 ? i0 + u * stride : i0) * 4;
#pragma unroll
            for (int xx = 0; xx < 8; ++xx) pa[u][xx] = *(const f32x4*)(PACT + (size_t)xx * n + it);
            e[u] = *(const u32x4*)(IDX + it); g[u] = *(const f32x4*)(GATE + it); rs[u] = RSTD[it >> 7];
        }
        float su[2][4], sv[2][4];
#pragma unroll
        for (int u = 0; u < 2; ++u)
#pragma unroll
            for (int j = 0; j < 4; ++j) { su[u][j] = SCU[e[u][j]]; sv[u][j] = SCV[e[u][j]]; }
#pragma unroll
        for (int u = 0; u < 2; ++u) {
            a[u] = ((pa[u][0] + pa[u][1]) + (pa[u][2] + pa[u][3])) + ((pa[u][4] + pa[u][5]) + (pa[u][6] + pa[u][7]));
            f32x4 c;
#pragma unroll
            for (int j = 0; j < 4; ++j) c[j] = g[u][j] * gelu_erf(a[u][j] * (rs[u] * su[u][j])) * sv[u][j];
            if (i0 + u * stride < n4) *(f32x4*)(COEF + (i0 + u * stride) * 4) = c;
        }
    }
}

constexpr int P5V_LDS_PER_WAVE = 1024 + 8 * 136 * 4;
__device__ __forceinline__ void phase5v(const Params& p, LAS unsigned char* lds, int lane, int wave) {
    int x, gwx, nwx; slice_group(x, gwx, nwx, wave);
    const unsigned char* PV8 = p.ws + WS_PV8 + (size_t)x * 16384 * 128;
    const int* IDX = (const int*)(p.ws + WS_IDX); const float* COEF = (const float*)(p.ws + WS_COEF);
    LAS int* l_idx = (LAS int*)(lds + wave * P5V_LDS_PER_WAVE); LAS float* l_cf = (LAS float*)(l_idx + 128); LAS float* red = l_cf + 128;
    const int g = lane >> 3, sub = lane & 7;
    const unsigned char* rowp = PV8 + sub * 16;
    const int c1 = 16 * (lane & 7) + (lane >> 3);
    int r_idxA = 0, r_idxB = 0; float r_cA = 0.f, r_cB = 0.f;
    u32x4 qA[16], qB[16]; f32x4 cfA[4], cfB[4]; float xA0 = 0.f, xA1 = 0.f, xB0 = 0.f, xB1 = 0.f;
#define P5V_LOADIDX(T) do { if ((T) < NT) { r_idxA = IDX[(size_t)(T) * 128 + lane]; r_idxB = IDX[(size_t)(T) * 128 + 64 + lane]; r_cA = COEF[(size_t)(T) * 128 + lane]; r_cB = COEF[(size_t)(T) * 128 + 64 + lane]; } } while (0)
#define P5V_ISSUE(Q, CF, X0, X1, T) do { if ((T) < NT) { l_idx[lane] = r_idxA; l_idx[64 + lane] = r_idxB; l_cf[lane] = r_cA; l_cf[64 + lane] = r_cB; \
        { const float* xr_ = p.out + (size_t)(T) * DM + 128 * x; X0 = xr_[c1]; X1 = xr_[c1 + 8]; } \
        _Pragma("unroll") for (int q_ = 0; q_ < 4; ++q_) { const u32x4 iv = *(const LAS u32x4*)(l_idx + 16 * g + 4 * q_); CF[q_] = *(const LAS f32x4*)(l_cf + 16 * g + 4 * q_); \
            Q[4 * q_] = *(const u32x4*)(rowp + (size_t)iv.x * 128); Q[4 * q_ + 1] = *(const u32x4*)(rowp + (size_t)iv.y * 128); \
            Q[4 * q_ + 2] = *(const u32x4*)(rowp + (size_t)iv.z * 128); Q[4 * q_ + 3] = *(const u32x4*)(rowp + (size_t)iv.w * 128); } } } while (0)
#define P5V_COMPUTE(Q, CF, X0, X1, T) do { \
        f32x2 acc[8]; \
        _Pragma("unroll") for (int j = 0; j < 8; ++j) acc[j] = (f32x2){0.f, 0.f}; \
        _Pragma("unroll") for (int i = 0; i < 16; ++i) { \
            const float cs_ = CF[i >> 2][i & 3]; const f32x2 c2 = (f32x2){cs_, cs_}; \
            acc[0] = __builtin_elementwise_fma(__builtin_amdgcn_cvt_pk_f32_fp8(Q[i].x, false), c2, acc[0]); \
            acc[1] = __builtin_elementwise_fma(__builtin_amdgcn_cvt_pk_f32_fp8(Q[i].x, true), c2, acc[1]); \
            acc[2] = __builtin_elementwise_fma(__builtin_amdgcn_cvt_pk_f32_fp8(Q[i].y, false), c2, acc[2]); \
            acc[3] = __builtin_elementwise_fma(__builtin_amdgcn_cvt_pk_f32_fp8(Q[i].y, true), c2, acc[3]); \
            acc[4] = __builtin_elementwise_fma(__builtin_amdgcn_cvt_pk_f32_fp8(Q[i].z, false), c2, acc[4]); \
            acc[5] = __builtin_elementwise_fma(__builtin_amdgcn_cvt_pk_f32_fp8(Q[i].z, true), c2, acc[5]); \
            acc[6] = __builtin_elementwise_fma(__builtin_amdgcn_cvt_pk_f32_fp8(Q[i].w, false), c2, acc[6]); \
            acc[7] = __builtin_elementwise_fma(__builtin_amdgcn_cvt_pk_f32_fp8(Q[i].w, true), c2, acc[7]); } \
        _Pragma("unroll") for (int j = 0; j < 8; ++j) { red[g * 136 + (2 * j) * 8 + sub] = acc[j].x; red[g * 136 + (2 * j + 1) * 8 + sub] = acc[j].y; } \
        float s1 = X0, s2_ = X1; \
        _Pragma("unroll") for (int gg = 0; gg < 8; ++gg) { s1 += red[gg * 136 + lane]; s2_ += red[gg * 136 + 64 + lane]; } \
        { float* xr_ = p.out + (size_t)(T) * DM + 128 * x; xr_[c1] = s1; xr_[c1 + 8] = s2_; } } while (0)
    int tok = gwx;
    P5V_LOADIDX(tok);
    P5V_ISSUE(qA, cfA, xA0, xA1, tok);
    P5V_LOADIDX(tok + nwx);
    for (; tok < NT; tok += 2 * nwx) {
        P5V_ISSUE(qB, cfB, xB0, xB1, tok + nwx);
        P5V_LOADIDX(tok + 2 * nwx);
        P5V_COMPUTE(qA, cfA, xA0, xA1, tok);
        if (tok + nwx >= NT) break;
        P5V_ISSUE(qA, cfA, xA0, xA1, tok + 2 * nwx);
        P5V_LOADIDX(tok + 3 * nwx);
        P5V_COMPUTE(qB, cfB, xB0, xB1, tok + nwx);
    }
#undef P5V_LOADIDX
#undef P5V_ISSUE
#undef P5V_COMPUTE
}

__device__ __forceinline__ void phase6(const Params& p, int lane, int wave) {
    const int gw = blockIdx.x * 8 + wave, NGW = gridDim.x * 8;
    const f32x4* gr = (const f32x4*)p.in[23] + lane;
    for (int m = gw; m < NT; m += 2 * NGW) {
        const bool two = m + NGW < NT;
        f32x4* xa = (f32x4*)(p.out + (size_t)m * DM) + lane; f32x4* xb = (f32x4*)(p.out + (size_t)(two ? m + NGW : m) * DM) + lane;
        f32x4 va[4], vb[4]; float sa = 0.f, sb = 0.f;
#pragma unroll
        for (int j = 0; j < 4; ++j) { va[j] = xa[64 * j]; vb[j] = xb[64 * j]; }
#pragma unroll
        for (int j = 0; j < 4; ++j) { sa += (va[j][0] * va[j][0] + va[j][1] * va[j][1]) + (va[j][2] * va[j][2] + va[j][3] * va[j][3]); sb += (vb[j][0] * vb[j][0] + vb[j][1] * vb[j][1]) + (vb[j][2] * vb[j][2] + vb[j][3] * vb[j][3]); }
        const float ra_ = 1.f / sqrtf(wave_total(sa) * (1.f / DM) + EPS), rb_ = 1.f / sqrtf(wave_total(sb) * (1.f / DM) + EPS);
#pragma unroll
        for (int j = 0; j < 4; ++j) { const f32x4 gg = gr[64 * j]; xa[64 * j] = va[j] * ra_ * gg; if (two) xb[64 * j] = vb[j] * rb_ * gg; }
    }
}

__global__ void __launch_bounds__(512, 2) fwd_megakernel(Params p) {
    extern __shared__ __attribute__((aligned(16))) unsigned char lds_raw[];
    LAS unsigned char* lds = (LAS unsigned char*)lds_raw;
    const int tid0 = threadIdx.x, wave = __builtin_amdgcn_readfirstlane(tid0 >> 6);
#define PHASE_IDS() int tid = tid0; asm volatile("" : "+v"(tid)); const int lane = tid & 63; (void)lane
    const int G = gridDim.x;
    volatile LAS unsigned* MISC = (volatile LAS unsigned*)(lds + MISC_OFF);
    if (tid0 < 32) MISC[tid0] = 0u;
    __syncthreads();
    XcdBarrier bar = xcd_barrier_post((unsigned*)(p.ws + WS_CTL) + 4096, MISC + 8);
#define GSYNC() xcd_barrier(bar)

#ifndef RPT_MASK
#define RPT_MASK 0
#endif
#if RPT_MASK
#define RPT(bit) for (int rpt_ = 0; rpt_ < (((RPT_MASK) >> (bit)) & 1) + 1; ++rpt_)
#else
#define RPT(bit) if (constexpr int rpt_ = 0; true)
#endif
    RPT(0) { PHASE_IDS(); phase0(p, lds, tid, lane, wave); GSYNC(); }
    RPT(1) {
        PHASE_IDS();
        pg8::Gemm g{(const bf16_t*)(p.ws + WS_H), (const bf16_t*)(p.ws + WS_WINT), NT, DIN, 1024};
        pg8::StaticOrder S; S.init(NT, DIN, G, (int)blockIdx.x);
        pg8::EpiProj E{(bf16_t*)(p.ws + WS_A), (bf16_t*)(p.ws + WS_Q), (bf16_t*)(p.ws + WS_KP), (bf16_t*)(p.ws + WS_VP), (bf16_t*)(p.ws + WS_KS), (bf16_t*)(p.ws + WS_VS), p.out};
        pg8::gemm_phase<pg8::EpiProj, pg8::StaticOrder, true, true>(lds, g, S, E);
        {
            const int nwg = (NT / 256) * (DIN / 256), rem = nwg % G, c = (int)blockIdx.x;
            if (rem == 0) prep_late(p, lds, tid, lane, wave, c, G);
            else if (c >= rem) prep_late(p, lds, tid, lane, wave, c - rem, G - rem);
        }
        GSYNC();
    }
    #ifndef P2MODE
#define P2MODE 0
#endif
    RPT(2) { PHASE_IDS(); att::phase2(p, lds, tid, lane, wave, rpt_, (((RPT_MASK) >> 2) & 1) && rpt_ == 0 ? P2MODE : 0); GSYNC(); }
    RPT(3) {
        PHASE_IDS();
        pg8::Gemm g{(const bf16_t*)(p.ws + WS_MIX), (const bf16_t*)(p.ws + WS_WOUTT), NP, 1024, 1024};
        pg8::StaticOrder S; S.init(NP, 1024, G, (int)blockIdx.x);
        pg8::EpiRes E{p.in[0], p.in[1], p.out, (bf16_t*)(p.ws + WS_XG), p.in[18], (float*)(p.ws + WS_SSQ)};
        pg8::gemm_phase<pg8::EpiRes, pg8::StaticOrder, true, true>(lds, g, S, E);
        {
            const float* xs = p.in[1]; float* xo = p.out + (size_t)NP * DM; bf16_t* go = (bf16_t*)(p.ws + WS_XG) + (size_t)NP * DM; const float* gff = p.in[18]; float* sso = (float*)(p.ws + WS_SSQ) + (size_t)NP * 16;
            mini_gemm((const bf16_t*)(p.ws + WS_MIX) + (size_t)NP * DM, (const bf16_t*)(p.ws + WS_WOUTT), 1024, lane, wave,
                      [=](int row, int cb, int fq, const pg8::f32x4 (&a)[4]) {
                          float sq = 0.f;
#pragma unroll
                          for (int n = 0; n < 4; ++n) {
                              const int col = cb * 64 + 16 * n + 4 * fq;
                              const pg8::f32x4 v = *(const pg8::f32x4*)(xs + (size_t)row * DM + col) + a[n];
                              *(pg8::f32x4*)(xo + (size_t)row * DM + col) = v;
                              *(u32x2*)(go + (size_t)row * DM + col) = pg8::pack4(v * *(const pg8::f32x4*)(gff + col));
                              sq += (v[0] * v[0] + v[1] * v[1]) + (v[2] * v[2] + v[3] * v[3]);
                          }
                          sq += __shfl_xor(sq, 16); sq += __shfl_xor(sq, 32);
                          if (fq == 0) sso[(size_t)row * 16 + cb] = sq;
                      });
        }
        GSYNC();
    }
    RPT(5) {
        PHASE_IDS();
        pg8::Gemm g{(const bf16_t*)(p.ws + WS_XG), (const bf16_t*)(p.ws + WS_WQT), NP, 2048, 1024};
        pg8::StaticOrder S; S.init(NP, 2048, G, (int)blockIdx.x);
        pg8::EpiBf16<0> E{(bf16_t*)(p.ws + WS_QP), 2048, nullptr, 0, 0, 1.f};
        pg8::gemm_phase<pg8::EpiBf16<0>, pg8::StaticOrder, true, true>(lds, g, S, E);
        {
            bf16_t* qo = (bf16_t*)(p.ws + WS_QP) + (size_t)NP * 2048;
            mini_gemm((const bf16_t*)(p.ws + WS_XG) + (size_t)NP * DM, (const bf16_t*)(p.ws + WS_WQT), 2048, lane, wave,
                      [=](int row, int cb, int fq, const pg8::f32x4 (&a)[4]) {
#pragma unroll
                          for (int n = 0; n < 4; ++n) *(u32x2*)(qo + (size_t)row * 2048 + cb * 64 + 16 * n + 4 * fq) = pg8::pack4(a[n]);
                      });
        }
        GSYNC();
    }
    RPT(6) { PHASE_IDS(); phase4b(p, lds, tid, lane, wave); GSYNC(); }
    RPT(7) { PHASE_IDS(); phase5a(p, lds, tid); GSYNC(); }
    RPT(8) { PHASE_IDS(); phase5u(p, lds, lane, wave); GSYNC(); }
    RPT(9) { PHASE_IDS(); phase5c(p, tid); GSYNC(); }
    { PHASE_IDS(); phase5v(p, lds, lane, wave); }
    GSYNC();
    { PHASE_IDS(); phase6(p, lane, wave); }
}

extern "C" void kernel_launch(void* const* d_in, const int* in_sizes, int n_in, void* d_out, int out_size, void* d_ws, size_t ws_size, hipStream_t stream) {
    static int grid = 0;
    if (grid == 0) {
        if (n_in != 24 || out_size != (int)OUT_TOTAL || ws_size < WS_END) { fprintf(stderr, "kernel_launch: unexpected shapes: n_in %d out %d ws %zu (need %zu)\n", n_in, out_size, ws_size, (size_t)WS_END); grid = -1; return; }
        int dev = 0, cus = 0, per_cu = 0;
        (void)hipGetDevice(&dev);
        (void)hipDeviceGetAttribute(&cus, hipDeviceAttributeMultiprocessorCount, dev);
        if (hipFuncSetAttribute((const void*)fwd_megakernel, hipFuncAttributeMaxDynamicSharedMemorySize, LDS_BYTES) != hipSuccess) { fprintf(stderr, "kernel_launch: hipFuncSetAttribute failed\n"); grid = -1; return; }
        if (hipOccupancyMaxActiveBlocksPerMultiprocessor(&per_cu, (const void*)fwd_megakernel, 512, LDS_BYTES) != hipSuccess || per_cu < 1) { fprintf(stderr, "kernel_launch: occupancy query gave %d\n", per_cu); per_cu = 1; }
        (void)hipGetLastError();
        grid = cus * 1;
        if (per_cu < 1) grid = -1;
    }
    if (grid < 0) return;
    (void)hipMemsetAsync((char*)d_ws + WS_CTL, 0, CTL_BYTES, stream);
    Params p{};
    for (int i = 0; i < 24; ++i) p.in[i] = (const float*)d_in[i];
    p.out = (float*)d_out; p.ws = (unsigned char*)d_ws;
    void* args[] = {&p};
    hipError_t e = hipLaunchCooperativeKernel((const void*)fwd_megakernel, dim3(grid), dim3(512), args, LDS_BYTES, stream);
    if (e != hipSuccess) fprintf(stderr, "cooperative launch failed: %s (grid %d)\n", hipGetErrorString(e), grid);
}
```

```cpp
#include <hip/hip_runtime.h>
#include <hip/hip_cooperative_groups.h>
#include <cstdio>
#include <cstdint>
#include <cmath>
namespace cg = cooperative_groups;
#define CE_(a, b) do { const float t_ = fmaxf(a, b); b = fminf(a, b); a = t_; } while (0)
#define SORT16_DESC(V, O) do { CE_(V[(O)+0], V[(O)+1]); CE_(V[(O)+2], V[(O)+3]); CE_(V[(O)+0], V[(O)+2]); CE_(V[(O)+1], V[(O)+3]); CE_(V[(O)+1], V[(O)+2]); CE_(V[(O)+4], V[(O)+5]); CE_(V[(O)+6], V[(O)+7]); CE_(V[(O)+4], V[(O)+6]); CE_(V[(O)+5], V[(O)+7]); CE_(V[(O)+5], V[(O)+6]); CE_(V[(O)+0], V[(O)+4]); CE_(V[(O)+2], V[(O)+6]); CE_(V[(O)+2], V[(O)+4]); CE_(V[(O)+1], V[(O)+5]); CE_(V[(O)+3], V[(O)+7]); CE_(V[(O)+3], V[(O)+5]); CE_(V[(O)+1], V[(O)+2]); CE_(V[(O)+3], V[(O)+4]); CE_(V[(O)+5], V[(O)+6]); CE_(V[(O)+8], V[(O)+9]); CE_(V[(O)+10], V[(O)+11]); CE_(V[(O)+8], V[(O)+10]); CE_(V[(O)+9], V[(O)+11]); CE_(V[(O)+9], V[(O)+10]); CE_(V[(O)+12], V[(O)+13]); CE_(V[(O)+14], V[(O)+15]); CE_(V[(O)+12], V[(O)+14]); CE_(V[(O)+13], V[(O)+15]); CE_(V[(O)+13], V[(O)+14]); CE_(V[(O)+8], V[(O)+12]); CE_(V[(O)+10], V[(O)+14]); CE_(V[(O)+10], V[(O)+12]); CE_(V[(O)+9], V[(O)+13]); CE_(V[(O)+11], V[(O)+15]); CE_(V[(O)+11], V[(O)+13]); CE_(V[(O)+9], V[(O)+10]); CE_(V[(O)+11], V[(O)+12]); CE_(V[(O)+13], V[(O)+14]); CE_(V[(O)+0], V[(O)+8]); CE_(V[(O)+4], V[(O)+12]); CE_(V[(O)+4], V[(O)+8]); CE_(V[(O)+2], V[(O)+10]); CE_(V[(O)+6], V[(O)+14]); CE_(V[(O)+6], V[(O)+10]); CE_(V[(O)+2], V[(O)+4]); CE_(V[(O)+6], V[(O)+8]); CE_(V[(O)+10], V[(O)+12]); CE_(V[(O)+1], V[(O)+9]); CE_(V[(O)+5], V[(O)+13]); CE_(V[(O)+5], V[(O)+9]); CE_(V[(O)+3], V[(O)+11]); CE_(V[(O)+7], V[(O)+15]); CE_(V[(O)+7], V[(O)+11]); CE_(V[(O)+3], V[(O)+5]); CE_(V[(O)+7], V[(O)+9]); CE_(V[(O)+11], V[(O)+13]); CE_(V[(O)+1], V[(O)+2]); CE_(V[(O)+3], V[(O)+4]); CE_(V[(O)+5], V[(O)+6]); CE_(V[(O)+7], V[(O)+8]); CE_(V[(O)+9], V[(O)+10]); CE_(V[(O)+11], V[(O)+12]); CE_(V[(O)+13], V[(O)+14]); } while (0)
#define BITONIC16_DESC(V, O) do { CE_(V[(O)+0], V[(O)+8]); CE_(V[(O)+1], V[(O)+9]); CE_(V[(O)+2], V[(O)+10]); CE_(V[(O)+3], V[(O)+11]); CE_(V[(O)+4], V[(O)+12]); CE_(V[(O)+5], V[(O)+13]); CE_(V[(O)+6], V[(O)+14]); CE_(V[(O)+7], V[(O)+15]); CE_(V[(O)+0], V[(O)+4]); CE_(V[(O)+1], V[(O)+5]); CE_(V[(O)+2], V[(O)+6]); CE_(V[(O)+3], V[(O)+7]); CE_(V[(O)+8], V[(O)+12]); CE_(V[(O)+9], V[(O)+13]); CE_(V[(O)+10], V[(O)+14]); CE_(V[(O)+11], V[(O)+15]); CE_(V[(O)+0], V[(O)+2]); CE_(V[(O)+1], V[(O)+3]); CE_(V[(O)+4], V[(O)+6]); CE_(V[(O)+5], V[(O)+7]); CE_(V[(O)+8], V[(O)+10]); CE_(V[(O)+9], V[(O)+11]); CE_(V[(O)+12], V[(O)+14]); CE_(V[(O)+13], V[(O)+15]); CE_(V[(O)+0], V[(O)+1]); CE_(V[(O)+2], V[(O)+3]); CE_(V[(O)+4], V[(O)+5]); CE_(V[(O)+6], V[(O)+7]); CE_(V[(O)+8], V[(O)+9]); CE_(V[(O)+10], V[(O)+11]); CE_(V[(O)+12], V[(O)+13]); CE_(V[(O)+14], V[(O)+15]); } while (0)
namespace pg8 {
#define PG8_LAS __attribute__((address_space(3)))
typedef unsigned short bf16_t;
typedef short bf16x8 __attribute__((ext_vector_type(8)));
typedef float f32x4 __attribute__((ext_vector_type(4)));
typedef unsigned u32x4 __attribute__((ext_vector_type(4)));
constexpr int BM = 256, BK = 64, HALF = 128, HTB = HALF * BK * 2  , STAGE_BYTES = 8 * HTB, NXCD = 8, WGM = 8;

__host__ __device__ __forceinline__ int lds_byte(int r, int c) { const int st = (r >> 4) * 2 + (c >> 5), rr = r & 15, cc = c & 31, ob = rr * 64 + cc * 2; return st * 1024 + (ob ^ (((ob >> 9) & 1) << 5)); }
__host__ __device__ __forceinline__ void stage_rc(int b, int& R, int& C) { const int st = b / 1024, sb = b % 1024, swz = sb ^ (((sb >> 9) & 1) << 5); R = (st >> 1) * 16 + swz / 64; C = (st & 1) * 32 + (swz % 64) / 2; }
__host__ __device__ __forceinline__ int perm32(int rho) { const int n = rho >> 4, i = rho & 15; return 8 * (i >> 2) + 4 * n + (i & 3); }

struct Unit { int pm, pn; };
struct Gemm { const bf16_t* A; const bf16_t* Bt; int M, N, K; };

struct StaticOrder {
    int nM, nN, nwg, G, c;
    __host__ __device__ void init(int M, int N, int G_, int c_) { nM = M / BM; nN = N / BM; nwg = nM * nN; G = G_; c = c_; }
    __host__ __device__ bool next(int i, Unit& u) const {
        const long L = (long)i * G + c; if (L >= nwg) return false;
        int wgid = (int)L; { const int q = nwg / NXCD, r = nwg % NXCD, xcd = wgid % NXCD, off = wgid / NXCD; wgid = (xcd < r ? xcd * (q + 1) : r * (q + 1) + (xcd - r) * q) + off; }
        const int nig = WGM * nN, gid = wgid / nig, fm = gid * WGM, gsz = (nM - fm) < WGM ? (nM - fm) : WGM;
        u.pm = fm + ((wgid % nig) % gsz); u.pn = (wgid % nig) / gsz; return true;
    }
    __device__ __forceinline__ void a_ready(const Unit&) const {}
    __device__ __forceinline__ void done(const Unit&) const {}
};

__device__ __forceinline__ unsigned cvt_pk_bf16(float lo, float hi) { unsigned r; asm volatile("v_cvt_pk_bf16_f32 %0, %1, %2" : "=v"(r) : "v"(lo), "v"(hi)); return r; }
typedef float f32x2 __attribute__((ext_vector_type(2)));
__device__ __forceinline__ f32x2 gelu_pk(f32x2 v) {
    const f32x2 av = __builtin_elementwise_abs(v), d = av * 0.2316418882f + 1.0f;
    f32x2 t; t.x = __builtin_amdgcn_rcpf(d.x); t.y = __builtin_amdgcn_rcpf(d.y);
    f32x2 q = t * 0.5307027145f + (-0.7265760135f); q = q * t + 0.7107068705f; q = q * t + (-0.142248368f); q = q * t + 0.127414796f; q = q * t;
    const f32x2 s = (v * v) * (-0.72134752044f);
    f32x2 e; e.x = __builtin_amdgcn_exp2f(s.x); e.y = __builtin_amdgcn_exp2f(s.y);
    const f32x2 m = v * (q * e), r = v - m;
    f32x2 o; o.x = v.x < 0.f ? m.x : r.x; o.y = v.y < 0.f ? m.y : r.y; return o;
}

template <int ACT  > struct EpiBf16 {
    static constexpr bool PERM = true, AFTER_DRAIN = false; static_assert(ACT == 0 || ACT == 1, "EpiBf16: ACT is 0 (none) or 1 (gelu_pk)");
    bf16_t* O; int ldc; const float* bias; int split_cols; size_t split_stride; float scale0;
    __device__ __forceinline__ void operator()(const f32x4 (&acc)[2][2][4][2], const Unit& u, int wr, int wc, int fr, int fq) const {
        const int row0 = u.pm * BM + wr * 64 + fr; int colt = u.pn * BM; bf16_t* base = O;
        float sc = 1.f; if (split_cols) { const int t = colt / split_cols; base += (size_t)t * split_stride; colt -= t * split_cols; if (t == 0) sc = scale0; }
        const int col0 = colt + wc * 32 + 8 * fq, bcol0 = u.pn * BM + wc * 32 + 8 * fq;
        f32x4 bv[2][2];
#pragma unroll
        for (int bj = 0; bj < 2; ++bj)
#pragma unroll
            for (int n = 0; n < 2; ++n) bv[bj][n] = bias ? *(const f32x4*)(bias + bcol0 + bj * HALF + 4 * n) : (f32x4){0.f, 0.f, 0.f, 0.f};
#pragma unroll
        for (int ai = 0; ai < 2; ++ai)
#pragma unroll
            for (int m = 0; m < 4; ++m) { bf16_t* rowp = base + (size_t)(row0 + ai * HALF + m * 16) * ldc + col0;
#pragma unroll
                for (int bj = 0; bj < 2; ++bj) { f32x4 v0 = acc[ai][bj][m][0] + bv[bj][0], v1 = acc[ai][bj][m][1] + bv[bj][1];
                    if (ACT == 1) { f32x2 a = gelu_pk((f32x2){v0[0], v0[1]}), b = gelu_pk((f32x2){v0[2], v0[3]}), c = gelu_pk((f32x2){v1[0], v1[1]}), d = gelu_pk((f32x2){v1[2], v1[3]});
                        v0 = (f32x4){a.x, a.y, b.x, b.y}; v1 = (f32x4){c.x, c.y, d.x, d.y}; }
                    v0 = v0 * sc; v1 = v1 * sc; u32x4 w; w.x = cvt_pk_bf16(v0[0], v0[1]); w.y = cvt_pk_bf16(v0[2], v0[3]); w.z = cvt_pk_bf16(v1[0], v1[1]); w.w = cvt_pk_bf16(v1[2], v1[3]);
                    *(u32x4*)(rowp + bj * HALF) = w; } }
    }
};
template <class Epi, class Sched, bool ALIGN_EPI = false, bool SP2 = false>
__device__ __forceinline__ void gemm_phase(PG8_LAS unsigned char* lds, const Gemm g, const Sched& S, const Epi& E) {
    int tid = threadIdx.x; asm volatile("" : "+v"(tid));
    const int wid = __builtin_amdgcn_readfirstlane(tid >> 6), lane = tid & 63, wr = wid >> 2, wc = wid & 3, fr = lane & 15, fq = lane >> 4;
    const int K = g.K, nt = K / BK;
    unsigned voffA[2], voffB[2];
#pragma unroll
    for (int i = 0; i < 2; ++i) { int R, C; stage_rc(tid * 16 + i * 8192, R, C); const int Rb = Epi::PERM ? ((R & ~31) + perm32(R & 31)) : R;
        voffA[i] = (unsigned)(R * K + C) * 2u; voffB[i] = (unsigned)(Rb * K + C) * 2u; }
    const size_t kstep = (size_t)(BK * 2);
    const size_t hstep = (size_t)HALF * K * 2;
    const size_t tstep = 2 * hstep;
    const unsigned ldsw = (unsigned)wid * 1024u;
    const int aoff = lds_byte(wr * 64 + fr, fq * 8), boff = lds_byte(wc * 32 + fr, fq * 8);
#define PG8_SA(b, h) (((b) * 2 + (h)) * HTB)
#define PG8_SB(b, h) ((4 + (b) * 2 + (h)) * HTB)
#define PG8_STAGE(bufoff, gbase, voff) do { _Pragma("unroll") for (int _i = 0; _i < 2; ++_i) \
        __builtin_amdgcn_global_load_lds((const unsigned*)((const char*)(gbase) + (voff)[_i]), (PG8_LAS unsigned*)(lds + (bufoff) + ldsw + _i * 8192), 16, 0, 0); } while (0)
#define PG8_LDA(dst, b, h) do { _Pragma("unroll") for (int m = 0; m < 4; ++m) _Pragma("unroll") for (int k = 0; k < 2; ++k) dst[m][k] = *(const PG8_LAS bf16x8*)(lds + PG8_SA(b, h) + aoff + m * 2048 + k * 1024); } while (0)
#define PG8_LDB(dst, b, h) do { _Pragma("unroll") for (int n = 0; n < 2; ++n) _Pragma("unroll") for (int k = 0; k < 2; ++k) dst[n][k] = *(const PG8_LAS bf16x8*)(lds + PG8_SB(b, h) + boff + n * 2048 + k * 1024); } while (0)
#define PG8_MMA(ai, bj, At, Bt) do { __builtin_amdgcn_s_setprio(1); _Pragma("unroll") for (int m = 0; m < 4; ++m) _Pragma("unroll") for (int n = 0; n < 2; ++n) _Pragma("unroll") for (int k = 0; k < 2; ++k) \
        acc[ai][bj][m][n] = __builtin_amdgcn_mfma_f32_16x16x32_bf16(Bt[n][k], At[m][k], acc[ai][bj][m][n], 0, 0, 0); __builtin_amdgcn_s_setprio(0); } while (0)
#define PG8_WAIT_V(n) asm volatile("s_waitcnt vmcnt(" #n ")" ::: "memory")
#define PG8_WAIT_L(n) asm volatile("s_waitcnt lgkmcnt(" #n ")" ::: "memory")
#define PG8_BAR __builtin_amdgcn_s_barrier()
#define PG8_SCHED __builtin_amdgcn_sched_barrier(0)
    Unit cur, nxt; int ui = 0;
    if (!S.next(0, cur)) return;
    f32x4 acc[2][2][4][2];
#pragma unroll
    for (int a = 0; a < 2; ++a)
#pragma unroll
        for (int b = 0; b < 2; ++b)
#pragma unroll
            for (int m = 0; m < 4; ++m)
#pragma unroll
                for (int n = 0; n < 2; ++n) acc[a][b][m][n] = (f32x4){0.f, 0.f, 0.f, 0.f};
    bf16x8 At[4][2], B0[2][2], B1[2][2];
    const char* cA = (const char*)g.A + (size_t)cur.pm * tstep; const char* cB = (const char*)g.Bt + (size_t)cur.pn * tstep;
    S.a_ready(cur);
    if constexpr (SP2) {
        PG8_STAGE(PG8_SB(0, 0), cB, voffB); PG8_STAGE(PG8_SB(0, 1), cB + hstep, voffB); PG8_STAGE(PG8_SA(0, 0), cA, voffA); PG8_STAGE(PG8_SA(0, 1), cA + hstep, voffA);
        if (wr == 1) PG8_BAR;
        PG8_WAIT_V(2); PG8_BAR;
        PG8_STAGE(PG8_SB(1, 0), cB + kstep, voffB); PG8_STAGE(PG8_SA(1, 0), cA + kstep, voffA); PG8_STAGE(PG8_SB(1, 1), cB + hstep + kstep, voffB);
        PG8_WAIT_V(6); PG8_BAR;
    } else {
        PG8_STAGE(PG8_SB(0, 0), cB, voffB); PG8_STAGE(PG8_SA(0, 0), cA, voffA); PG8_STAGE(PG8_SB(0, 1), cB + hstep, voffB); PG8_STAGE(PG8_SA(0, 1), cA + hstep, voffA);
        if (wr == 1) PG8_BAR;
        PG8_WAIT_V(4); PG8_BAR;
        PG8_STAGE(PG8_SB(1, 0), cB + kstep, voffB); PG8_STAGE(PG8_SA(1, 0), cA + kstep, voffA); PG8_STAGE(PG8_SB(1, 1), cB + hstep + kstep, voffB);
        PG8_WAIT_V(6); PG8_BAR;
    }
    for (;;) {
        const bool has_next = S.next(ui + 1, nxt);
        const char* nA = has_next ? (const char*)g.A + (size_t)nxt.pm * tstep : cA; const char* nB = has_next ? (const char*)g.Bt + (size_t)nxt.pn * tstep : cB;
        for (int t = 0; t < nt; t += 2) {
            const bool last = (t == nt - 2);
            const char* a1 = cA + (size_t)(t + 1) * kstep;
            const char* a2 = last ? nA : cA + (size_t)(t + 2) * kstep; const char* b2 = last ? nB : cB + (size_t)(t + 2) * kstep;
            const char* a3 = a2 + kstep; const char* b3 = b2 + kstep;
            if (last && has_next) S.a_ready(nxt);
            if constexpr (SP2) {
            PG8_LDB(B0, 0, 0); PG8_LDB(B1, 0, 1); PG8_SCHED; PG8_LDA(At, 0, 0); PG8_STAGE(PG8_SA(1, 1), a1 + hstep, voffA);
            PG8_WAIT_V(8); PG8_WAIT_L(0); PG8_BAR; PG8_MMA(0, 0, At, B0); PG8_MMA(0, 1, At, B1); PG8_BAR; PG8_SCHED;
            PG8_LDA(At, 0, 1); PG8_STAGE(PG8_SB(0, 0), b2, voffB); PG8_STAGE(PG8_SB(0, 1), b2 + hstep, voffB); PG8_STAGE(PG8_SA(0, 0), a2, voffA);
            PG8_WAIT_V(8); PG8_WAIT_L(0); PG8_BAR; PG8_MMA(1, 0, At, B0); PG8_MMA(1, 1, At, B1); PG8_BAR; PG8_SCHED;
            PG8_LDB(B0, 1, 0); PG8_LDB(B1, 1, 1); PG8_SCHED; PG8_LDA(At, 1, 0); PG8_STAGE(PG8_SA(0, 1), a2 + hstep, voffA);
            PG8_WAIT_V(8); PG8_WAIT_L(0); PG8_BAR; PG8_MMA(0, 0, At, B0); PG8_MMA(0, 1, At, B1); PG8_BAR; PG8_SCHED;
            PG8_LDA(At, 1, 1); PG8_STAGE(PG8_SB(1, 0), b3, voffB); PG8_STAGE(PG8_SB(1, 1), b3 + hstep, voffB); PG8_STAGE(PG8_SA(1, 0), a3, voffA);
            PG8_WAIT_V(8); PG8_WAIT_L(0); PG8_BAR; PG8_MMA(1, 0, At, B0); PG8_MMA(1, 1, At, B1); PG8_BAR; PG8_SCHED;
            } else {
            PG8_LDB(B0, 0, 0); PG8_SCHED; PG8_LDA(At, 0, 0); PG8_STAGE(PG8_SA(1, 1), a1 + hstep, voffA);
            PG8_WAIT_L(8); PG8_BAR; PG8_WAIT_L(0); PG8_MMA(0, 0, At, B0); PG8_BAR; PG8_SCHED;
            PG8_LDB(B1, 0, 1); PG8_STAGE(PG8_SB(0, 0), b2, voffB);
            PG8_BAR; PG8_WAIT_L(0); PG8_MMA(0, 1, At, B1); PG8_BAR;
            PG8_LDA(At, 0, 1); PG8_STAGE(PG8_SA(0, 0), a2, voffA);
            PG8_BAR; PG8_WAIT_L(0); PG8_MMA(1, 0, At, B0); PG8_BAR; PG8_SCHED;
            PG8_STAGE(PG8_SB(0, 1), b2 + hstep, voffB);
            PG8_WAIT_V(6); PG8_BAR; PG8_MMA(1, 1, At, B1); PG8_BAR;
            PG8_LDB(B0, 1, 0); PG8_SCHED; PG8_LDA(At, 1, 0); PG8_STAGE(PG8_SA(0, 1), a2 + hstep, voffA);
            PG8_WAIT_L(8); PG8_BAR; PG8_WAIT_L(0); PG8_MMA(0, 0, At, B0); PG8_BAR; PG8_SCHED;
            PG8_LDB(B1, 1, 1); PG8_STAGE(PG8_SB(1, 0), b3, voffB);
            PG8_BAR; PG8_WAIT_L(0); PG8_MMA(0, 1, At, B1); PG8_BAR;
            PG8_LDA(At, 1, 1); PG8_STAGE(PG8_SA(1, 0), a3, voffA);
            PG8_BAR; PG8_WAIT_L(0); PG8_MMA(1, 0, At, B0); PG8_BAR; PG8_SCHED;
            PG8_STAGE(PG8_SB(1, 1), b3 + hstep, voffB);
            PG8_WAIT_V(6); PG8_BAR; PG8_MMA(1, 1, At, B1); PG8_BAR;
            }
        }
        if constexpr (ALIGN_EPI) { if (wr == 0) PG8_BAR; }
        if constexpr (!Epi::AFTER_DRAIN) { E(acc, cur, wr, wc, fr, fq); S.done(cur); }
        if (!has_next) break;
#pragma unroll
        for (int a = 0; a < 2; ++a)
#pragma unroll
            for (int b = 0; b < 2; ++b)
#pragma unroll
                for (int m = 0; m < 4; ++m)
#pragma unroll
                    for (int n = 0; n < 2; ++n) acc[a][b][m][n] = (f32x4){0.f, 0.f, 0.f, 0.f};
        cur = nxt; cA = nA; cB = nB; ++ui;
        if constexpr (ALIGN_EPI) { if (wr == 1) PG8_BAR; }
    }
    PG8_WAIT_V(0);
    if constexpr (!ALIGN_EPI) { if (wr == 0) PG8_BAR; }
    PG8_BAR;
    if constexpr (Epi::AFTER_DRAIN) { E.fused(acc, cur, wr, wc, fr, fq, lds, wid, lane); S.done(cur); }
#undef PG8_SA
#undef PG8_SB
#undef PG8_STAGE
#undef PG8_LDA
#undef PG8_LDB
#undef PG8_MMA
#undef PG8_WAIT_V
#undef PG8_WAIT_L
#undef PG8_BAR
#undef PG8_SCHED
}
}

#define LAS __attribute__((address_space(3)))
typedef unsigned short bf16_t;
typedef short bf16x8 __attribute__((ext_vector_type(8)));
typedef short s16x4 __attribute__((ext_vector_type(4)));
typedef float f32x4 __attribute__((ext_vector_type(4)));
typedef float f32x16 __attribute__((ext_vector_type(16)));
typedef unsigned u32x4 __attribute__((ext_vector_type(4)));
typedef unsigned u32x2 __attribute__((ext_vector_type(2)));

constexpr int DM = 1024;
constexpr int NP = 16 * 2048;
constexpr int NS = 8 * 64;
constexpr int NT = NP + NS;
constexpr int DIN = 2560;
constexpr int SKV = 2112;
constexpr float EPS = 1e-6f;
constexpr float LOG2E = 1.4426950408889634f;
constexpr float QSCALE = 0.125f * LOG2E;

constexpr long OUT_Y = 0;
constexpr long OUT_KP = 34078720L, OUT_VP = 50855936L, OUT_CONVP = 67633152L, OUT_KS = 67878912L, OUT_VS = 68141056L, OUT_CONVS = 68403200L, OUT_TOTAL = 68526080L;

constexpr size_t MiB = 1u << 20;
constexpr size_t WS_CTL = 0, CTL_BYTES = 1 * MiB;
constexpr size_t WS_WINT = 1 * MiB;
constexpr size_t WS_WOUTT = 6 * MiB;
constexpr size_t WS_WQT = 8 * MiB;
constexpr size_t WS_SK = 12 * MiB;
constexpr size_t WS_PU8 = 16 * MiB;
constexpr size_t WS_PV8 = 32 * MiB;
constexpr size_t WS_SCU = 48 * MiB;
constexpr size_t WS_SCV = 49 * MiB;
constexpr size_t WS_KS = 80 * MiB;
constexpr size_t WS_VS = 97 * MiB;
constexpr size_t WS_H = 114 * MiB;
constexpr size_t WS_A = 179 * MiB;
constexpr size_t WS_Q = 212 * MiB;
constexpr size_t WS_QP = 114 * MiB;
constexpr size_t WS_KP = 245 * MiB;
constexpr size_t WS_VP = 277 * MiB;
constexpr size_t WS_MIX = 309 * MiB;
constexpr size_t WS_H2 = 309 * MiB;
constexpr size_t WS_TK = 375 * MiB;
constexpr size_t WS_IDX = 408 * MiB;
constexpr size_t WS_GATE = 425 * MiB;
constexpr size_t WS_PACT = 114 * MiB;
constexpr size_t WS_COEF = 375 * MiB;
constexpr size_t WS_XG = 442 * MiB;
constexpr size_t WS_SSQ = 507 * MiB;
constexpr size_t WS_RSTD = 510 * MiB;
constexpr size_t WS_END = 511 * MiB;
static_assert(WS_H + (size_t)NT * 1024 * 2 <= WS_A && WS_A + (size_t)NT * 512 * 2 <= WS_Q && WS_Q + (size_t)NT * 512 * 2 <= WS_KP, "R1");
static_assert(WS_QP + (size_t)NT * 2048 * 2 <= WS_KP && WS_KP + (size_t)NP * 512 * 2 <= WS_VP && WS_VP + (size_t)NP * 512 * 2 <= WS_MIX, "ws map");
static_assert(WS_MIX + (size_t)NT * 1024 * 2 <= WS_TK && WS_TK + (size_t)NT * 256 * 4 <= WS_IDX && WS_IDX + (size_t)NT * 128 * 4 <= WS_GATE && WS_GATE + (size_t)NT * 128 * 4 <= WS_END, "ws map 2");
static_assert(WS_KS + (size_t)8 * SKV * 512 * 2 <= WS_VS && WS_VS + (size_t)8 * SKV * 512 * 2 <= WS_H, "ws map 3");

constexpr int RING_BYTES = 131072;
constexpr int BIAS_OFF = RING_BYTES;
constexpr int MISC_OFF = RING_BYTES + 5120;
constexpr int LDS_BYTES = MISC_OFF + 1024;

struct Params {
    const float* in[24];
    float* out;
    unsigned char* ws;
};

__device__ __forceinline__ unsigned cvtpk(float lo, float hi) { return pg8::cvt_pk_bf16(lo, hi); }
__device__ __forceinline__ float bflo(unsigned w) { return __uint_as_float(w << 16); }
__device__ __forceinline__ float bfhi(unsigned w) { return __uint_as_float(w & 0xffff0000u); }
__device__ __forceinline__ float wave_sum(float v) {
#pragma unroll
    for (int o = 1; o < 64; o <<= 1) v += __shfl_xor(v, o);
    return v;
}
typedef float f32x2 __attribute__((ext_vector_type(2)));
#define DPP_ADD(v, ctrl) v += __builtin_bit_cast(float, __builtin_amdgcn_update_dpp(0, __builtin_bit_cast(int, v), ctrl, 0xf, 0xf, true))
__device__ __forceinline__ float rl_f(float v, int l) { return __uint_as_float(__builtin_amdgcn_readlane(__float_as_uint(v), l)); }
__device__ __forceinline__ float wave_total(float v) {
    DPP_ADD(v, 0xB1); DPP_ADD(v, 0x4E); DPP_ADD(v, 0x141); DPP_ADD(v, 0x140);
    return (rl_f(v, 0) + rl_f(v, 16)) + (rl_f(v, 32) + rl_f(v, 48));
}
typedef __bf16 bf16x2_t __attribute__((ext_vector_type(2)));
__device__ __forceinline__ float dot2(unsigned a, unsigned b, float acc) {
    return __builtin_amdgcn_fdot2_f32_bf16(__builtin_bit_cast(bf16x2_t, a), __builtin_bit_cast(bf16x2_t, b), acc, false);
}
#define LDS_WAIT() asm volatile("s_waitcnt lgkmcnt(0)" ::: "memory")

#define XB_TMO      128
#define XB_XCNT(j)  (256  + 64 * (j))
#define XB_XSUB(j)  (1280 + 64 * (j))
#define XB_XGEN(j)  (2304 + 64 * (j))
#define XB_TOP      3328
#define XB_TOPGEN   3392
#define XCD_BAR_WORDS 3456
#define XB_SPIN_CAP (1u << 18)

__device__ __forceinline__ unsigned xb_ld(unsigned* p)              { return __hip_atomic_load(p, __ATOMIC_RELAXED, __HIP_MEMORY_SCOPE_AGENT); }
__device__ __forceinline__ unsigned xb_add(unsigned* p, unsigned v) { return __hip_atomic_fetch_add(p, v, __ATOMIC_RELAXED, __HIP_MEMORY_SCOPE_AGENT); }
__device__ __forceinline__ unsigned xb_xcc_id() { return (unsigned)__builtin_amdgcn_s_getreg((3 << 11) | 20) & 0xFu; }
#define XB_SPIN(cond, bar) do { unsigned _sp = 0; while (cond) { __builtin_amdgcn_s_sleep(1); \
    if ((++_sp & 255u) == 0u) { if (xb_ld(&(bar)[XB_TMO])) break; if (_sp > XB_SPIN_CAP) { atomicAdd(&(bar)[XB_TMO], 1u); break; } } } } while (0)

struct XcdBarrier {
    unsigned* bar; unsigned x;
    volatile LAS unsigned* st;
};

__device__ __forceinline__ XcdBarrier xcd_barrier_post(unsigned* bar, volatile LAS unsigned* st) {
    XcdBarrier b; b.bar = bar; b.x = xb_xcc_id(); b.st = st;
    if (threadIdx.x == 0) (void)xb_add(&bar[XB_XCNT(b.x)], 1u);
    return b;
}
__device__ __forceinline__ void xcd_barrier_complete(unsigned* bar, unsigned x, unsigned& nloc, unsigned& nx) {
    const unsigned G = gridDim.x * gridDim.y * gridDim.z;
    unsigned sum, cnt, mine, sp = 0u;
    for (;;) {
        sum = 0u; cnt = 0u; mine = 0u;
#pragma unroll
        for (unsigned j = 0; j < 16; ++j) { const unsigned c = xb_ld(&bar[XB_XCNT(j)]); sum += c; cnt += (c > 0u) ? 1u : 0u; mine = (j == x) ? c : mine; }
        if (sum == G) break;
        __builtin_amdgcn_s_sleep(1);
        if ((++sp & 255u) == 0u) { if (xb_ld(&bar[XB_TMO])) break; if (sp > XB_SPIN_CAP) { atomicAdd(&bar[XB_TMO], 1u); break; } }
    }
    nloc = mine > 0u ? mine : 1u; nx = cnt > 0u ? cnt : 1u;
}

__device__ __forceinline__ void xcd_barrier(const XcdBarrier& b) {
    asm volatile("s_waitcnt vmcnt(0)" ::: "memory");
    __syncthreads();
    if (threadIdx.x == 0) {
        unsigned* bar = b.bar;
        __builtin_amdgcn_s_waitcnt(0);
        unsigned nloc = b.st[0], nx = b.st[1];
        if (nloc == 0u) { xcd_barrier_complete(bar, b.x, nloc, nx); b.st[0] = nloc; b.st[1] = nx; }
        const unsigned old = xb_add(&bar[XB_XSUB(b.x)], 1u);
        const unsigned gen = old / nloc;
        if (old + 1u == (gen + 1u) * nloc) {
            __builtin_amdgcn_fence(__ATOMIC_RELEASE, "agent");
            asm volatile("s_waitcnt vmcnt(0)" ::: "memory");
            const unsigned og = xb_add(&bar[XB_TOP], 1u);
            const unsigned tg = og / nx;
            if (og + 1u == (tg + 1u) * nx) xb_add(&bar[XB_TOPGEN], 1u);
            else XB_SPIN(xb_ld(&bar[XB_TOPGEN]) == tg, bar);
            __builtin_amdgcn_fence(__ATOMIC_ACQUIRE, "agent");
            xb_add(&bar[XB_XGEN(b.x)], 1u);
            asm volatile("s_waitcnt vmcnt(0)" ::: "memory");
        } else {
            XB_SPIN(xb_ld(&bar[XB_XGEN(b.x)]) == gen, bar);
            __builtin_amdgcn_fence(__ATOMIC_ACQUIRE, "agent");
            asm volatile("s_waitcnt vmcnt(0)" ::: "memory");
        }
    }
    __syncthreads();
}


namespace pg8 {
__device__ __forceinline__ u32x2 pack4(f32x4 v) { u32x2 w; w.x = cvt_pk_bf16(v[0], v[1]); w.y = cvt_pk_bf16(v[2], v[3]); return w; }
struct EpiProj {
    static constexpr bool PERM = true, AFTER_DRAIN = false;
    bf16_t* A; bf16_t* Q; bf16_t* KP; bf16_t* VP; bf16_t* KS; bf16_t* VS; float* out;
    __device__ __forceinline__ void operator()(const f32x4 (&acc)[2][2][4][2], const Unit& u, int wr, int wc, int fr, int fq) const {
        const int pn = u.pn;
        const int row0 = u.pm * BM + wr * 64 + fr;
        if (pn < 4) {
#pragma unroll
            for (int ai = 0; ai < 2; ++ai)
#pragma unroll
                for (int m = 0; m < 4; ++m) {
                    const int row = row0 + ai * HALF + m * 16;
                    long toff = -1;
                    if (row < NP) { const int s = row & 2047; if (s >= 2018) toff = OUT_CONVP + ((long)(row >> 11) * 30 + (s - 2018)) * 512; }
                    else { const int rr = row - NP; const int i = rr & 63; if (i >= 34) toff = OUT_CONVS + ((long)(rr >> 6) * 30 + (i - 34)) * 512; }
                    const int c = 128 * pn + 32 * wc + 8 * fq;
                    f32x4 a[2];
#pragma unroll
                    for (int n = 0; n < 2; ++n) {
                        const f32x4 x = acc[ai][0][m][n], g = acc[ai][1][m][n];
#pragma unroll
                        for (int j = 0; j < 4; ++j) a[n][j] = x[j] / (1.f + __expf(-g[j]));
                    }
                    u32x4 w; w.x = cvt_pk_bf16(a[0][0], a[0][1]); w.y = cvt_pk_bf16(a[0][2], a[0][3]); w.z = cvt_pk_bf16(a[1][0], a[1][1]); w.w = cvt_pk_bf16(a[1][2], a[1][3]);
                    *(u32x4*)(A + (size_t)row * 512 + c) = w;
                    if (toff >= 0) { *(f32x4*)(out + toff + c) = a[0]; *(f32x4*)(out + toff + c + 4) = a[1]; }
                }
        } else {
            const int sec = (pn - 4) >> 1, colbase = ((pn - 4) & 1) * 256;
#pragma unroll
            for (int ai = 0; ai < 2; ++ai)
#pragma unroll
                for (int m = 0; m < 4; ++m) {
                    const int row = row0 + ai * HALF + m * 16;
                    const bool isp = row < NP; const int rr = row - NP;
                    bf16_t* bdst; float* fdst;
                    if (sec == 0) { bdst = Q + (size_t)row * 512; fdst = nullptr; }
                    else if (sec == 1) { bdst = isp ? KP + (size_t)row * 512 : KS + ((size_t)(rr >> 6) * SKV + 2048 + (rr & 63)) * 512; fdst = isp ? out + OUT_KP + (size_t)row * 512 : out + OUT_KS + (size_t)rr * 512; }
                    else { bdst = isp ? VP + (size_t)row * 512 : VS + ((size_t)(rr >> 6) * SKV + 2048 + (rr & 63)) * 512; fdst = isp ? out + OUT_VP + (size_t)row * 512 : out + OUT_VS + (size_t)rr * 512; }
#pragma unroll
                    for (int bj = 0; bj < 2; ++bj) {
                        const int col = colbase + 128 * bj + 32 * wc + 8 * fq;
                        const f32x4 v0 = acc[ai][bj][m][0], v1 = acc[ai][bj][m][1];
                        if (sec == 0) { const f32x4 s0 = v0 * QSCALE, s1 = v1 * QSCALE; u32x4 w; w.x = cvt_pk_bf16(s0[0], s0[1]); w.y = cvt_pk_bf16(s0[2], s0[3]); w.z = cvt_pk_bf16(s1[0], s1[1]); w.w = cvt_pk_bf16(s1[2], s1[3]); *(u32x4*)(bdst + col) = w; }
                        else { u32x4 w; w.x = cvt_pk_bf16(v0[0], v0[1]); w.y = cvt_pk_bf16(v0[2], v0[3]); w.z = cvt_pk_bf16(v1[0], v1[1]); w.w = cvt_pk_bf16(v1[2], v1[3]); *(u32x4*)(bdst + col) = w;
                               __builtin_nontemporal_store(v0, (f32x4*)(fdst + col)); __builtin_nontemporal_store(v1, (f32x4*)(fdst + col + 4)); }
                    }
                }
        }
    }
};
struct EpiRes {
    static constexpr bool PERM = true, AFTER_DRAIN = false;
    const float* xp; const float* xs; float* out; bf16_t* xg; const float* gff; float* ssq;
    __device__ __forceinline__ void operator()(const f32x4 (&acc)[2][2][4][2], const Unit& u, int wr, int wc, int fr, int fq) const {
        const int row0 = u.pm * BM + wr * 64 + fr;
        f32x4 gg[2][2];
#pragma unroll
        for (int bj = 0; bj < 2; ++bj)
#pragma unroll
            for (int n = 0; n < 2; ++n) gg[bj][n] = *(const f32x4*)(gff + u.pn * BM + 128 * bj + 32 * wc + 8 * fq + 4 * n);
#pragma unroll
        for (int ai = 0; ai < 2; ++ai)
#pragma unroll
            for (int m = 0; m < 4; ++m) {
                const int row = row0 + ai * HALF + m * 16;
                const float* xr = row < NP ? xp + (size_t)row * DM : xs + (size_t)(row - NP) * DM;
                float* orow = out + (size_t)row * DM; bf16_t* grow = xg + (size_t)row * DM;
                float sq = 0.f;
#pragma unroll
                for (int bj = 0; bj < 2; ++bj) {
                    const int col = u.pn * BM + 128 * bj + 32 * wc + 8 * fq;
                    const f32x4 v0 = *(const f32x4*)(xr + col) + acc[ai][bj][m][0], v1 = *(const f32x4*)(xr + col + 4) + acc[ai][bj][m][1];
                    *(f32x4*)(orow + col) = v0; *(f32x4*)(orow + col + 4) = v1;
                    const f32x4 h0 = v0 * gg[bj][0], h1 = v1 * gg[bj][1];
                    u32x4 w; w.x = cvt_pk_bf16(h0[0], h0[1]); w.y = cvt_pk_bf16(h0[2], h0[3]); w.z = cvt_pk_bf16(h1[0], h1[1]); w.w = cvt_pk_bf16(h1[2], h1[3]);
                    *(u32x4*)(grow + col) = w;
                    sq += ((v0[0] * v0[0] + v0[1] * v0[1]) + (v0[2] * v0[2] + v0[3] * v0[3])) + ((v1[0] * v1[0] + v1[1] * v1[1]) + (v1[2] * v1[2] + v1[3] * v1[3]));
                }
                sq += __shfl_xor(sq, 16); sq += __shfl_xor(sq, 32);
                if (fq == 0) ssq[(size_t)row * 16 + u.pn * 4 + wc] = sq;
            }
    }
};
}

__device__ __forceinline__ int winrow(int n) { return n < 1024 ? (256 * ((n & 511) >> 7) + 128 * (n >> 9) + (n & 127)) : n; }
template <bool WIN> __device__ __forceinline__ void transpose_item(const float* W, int K, int N, bf16_t* WT, LAS float* scr, int item, int lane) {
    const int nblk = N / 32, kb = item / nblk, nb = item % nblk, k0 = 64 * kb, n0 = 32 * nb;
#pragma unroll 8
    for (int i = 0; i < 32; ++i) { const int kk = 2 * i + (lane >> 5); scr[kk * 33 + (lane & 31)] = W[(size_t)(k0 + kk) * N + n0 + (lane & 31)]; }
    LDS_WAIT();
    const int c = lane & 7;
#pragma unroll
    for (int j = 0; j < 4; ++j) {
        const int n = (lane >> 3) + 8 * j; const LAS float* s = scr + (8 * c) * 33 + n;
        u32x4 o; o.x = cvtpk(s[0 * 33], s[1 * 33]); o.y = cvtpk(s[2 * 33], s[3 * 33]); o.z = cvtpk(s[4 * 33], s[5 * 33]); o.w = cvtpk(s[6 * 33], s[7 * 33]);
        const int dr = WIN ? winrow(n0 + n) : (n0 + n);
        *(u32x4*)(WT + (size_t)dr * K + k0 + 8 * c) = o;
    }
    LDS_WAIT();
}
__device__ __forceinline__ void cvt_stream(const float* src, bf16_t* dst, size_t n8, size_t gt, size_t ngt) {
    for (size_t i = gt; i < n8; i += ngt) {
        const f32x4 a = *(const f32x4*)(src + i * 8), b = *(const f32x4*)(src + i * 8 + 4);
        u32x4 o; o.x = cvtpk(a[0], a[1]); o.y = cvtpk(a[2], a[3]); o.z = cvtpk(b[0], b[1]); o.w = cvtpk(b[2], b[3]);
        *(u32x4*)(dst + i * 8) = o;
    }
}
__device__ __forceinline__ void cvt_cache(const float* src, bf16_t* dst, size_t gt, size_t ngt) {
    const size_t n8 = (size_t)8 * 2048 * 512 / 8;
    for (size_t i = gt; i < n8; i += ngt) {
        const size_t e = i * 8; const size_t row = e >> 9, col = e & 511; const size_t drow = (row >> 11) * SKV + (row & 2047);
        const f32x4 a = *(const f32x4*)(src + e), b = *(const f32x4*)(src + e + 4);
        u32x4 o; o.x = cvtpk(a[0], a[1]); o.y = cvtpk(a[2], a[3]); o.z = cvtpk(b[0], b[1]); o.w = cvtpk(b[2], b[3]);
        *(u32x4*)(dst + drow * 512 + col) = o;
    }
}
__device__ __forceinline__ void rms_row_bf16(const float* xrow, const float* g, bf16_t* orow, int lane) {
    const f32x4* xr = (const f32x4*)xrow + lane; const f32x4* gr = (const f32x4*)g + lane;
    f32x4 v[4]; float s = 0.f;
#pragma unroll
    for (int j = 0; j < 4; ++j) { v[j] = xr[64 * j]; s += (v[j][0] * v[j][0] + v[j][1] * v[j][1]) + (v[j][2] * v[j][2] + v[j][3] * v[j][3]); }
    const float rstd = 1.f / sqrtf(wave_sum(s) * (1.f / DM) + EPS);
    u32x2* o8 = (u32x2*)orow + lane;
#pragma unroll
    for (int j = 0; j < 4; ++j) { const f32x4 gg = gr[64 * j]; u32x2 w; w.x = cvtpk(v[j][0] * rstd * gg[0], v[j][1] * rstd * gg[1]); w.y = cvtpk(v[j][2] * rstd * gg[2], v[j][3] * rstd * gg[3]); o8[64 * j] = w; }
}

template <bool SLICED> __device__ __forceinline__ void cvt_row_fp8(const float* src, unsigned char* dst_base, int row, float* scale_out, int lane) {
    const f32x4* xr = (const f32x4*)src + lane;
    f32x4 v[4]; float am = 0.f;
#pragma unroll
    for (int j = 0; j < 4; ++j) { v[j] = xr[64 * j]; am = fmaxf(am, fmaxf(fmaxf(fabsf(v[j][0]), fabsf(v[j][1])), fmaxf(fabsf(v[j][2]), fabsf(v[j][3])))); }
#pragma unroll
    for (int o = 1; o < 64; o <<= 1) am = fmaxf(am, __shfl_xor(am, o));
    const float sc = am > 0.f ? am * (1.f / 448.f) : 1.f, inv = 1.f / sc;
#pragma unroll
    for (int j = 0; j < 4; ++j) {
        const int eb = 256 * j + 4 * lane;
        int w = __builtin_amdgcn_cvt_pk_fp8_f32(v[j][0] * inv, v[j][1] * inv, 0, false);
        w = __builtin_amdgcn_cvt_pk_fp8_f32(v[j][2] * inv, v[j][3] * inv, w, true);
        if (SLICED) *(int*)(dst_base + ((size_t)(eb >> 7) * 16384 + row) * 128 + (eb & 127)) = w;
        else *(int*)(dst_base + (size_t)row * DM + 16 * ((eb & 511) >> 3) + (eb & 7) + (eb >= 512 ? 8 : 0)) = w;
    }
    if (lane == 0) *scale_out = sc;
}

__device__ __forceinline__ void rms_row2_bf16(const float* xa, const float* xb, const float* g, bf16_t* oa, bf16_t* ob, int lane) {
    const f32x4* ra = (const f32x4*)xa + lane; const f32x4* rb = (const f32x4*)xb + lane; const f32x4* gr = (const f32x4*)g + lane;
    f32x4 va[4], vb[4]; float sa = 0.f, sb = 0.f;
#pragma unroll
    for (int j = 0; j < 4; ++j) { va[j] = ra[64 * j]; vb[j] = rb[64 * j]; }
#pragma unroll
    for (int j = 0; j < 4; ++j) { sa += (va[j][0] * va[j][0] + va[j][1] * va[j][1]) + (va[j][2] * va[j][2] + va[j][3] * va[j][3]); sb += (vb[j][0] * vb[j][0] + vb[j][1] * vb[j][1]) + (vb[j][2] * vb[j][2] + vb[j][3] * vb[j][3]); }
    const float ra_ = 1.f / sqrtf(wave_total(sa) * (1.f / DM) + EPS), rb_ = 1.f / sqrtf(wave_total(sb) * (1.f / DM) + EPS);
    u32x2* o8a = (u32x2*)oa + lane; u32x2* o8b = (u32x2*)ob + lane;
#pragma unroll
    for (int j = 0; j < 4; ++j) { const f32x4 gg = gr[64 * j];
        u32x2 w; w.x = cvtpk(va[j][0] * ra_ * gg[0], va[j][1] * ra_ * gg[1]); w.y = cvtpk(va[j][2] * ra_ * gg[2], va[j][3] * ra_ * gg[3]); o8a[64 * j] = w;
        u32x2 z; z.x = cvtpk(vb[j][0] * rb_ * gg[0], vb[j][1] * rb_ * gg[1]); z.y = cvtpk(vb[j][2] * rb_ * gg[2], vb[j][3] * rb_ * gg[3]); o8b[64 * j] = z; }
}
__device__ __forceinline__ void cvt_row_i8(const float* src, unsigned char* dst_base, int row, float* scale_out, int lane) {
    const f32x4* xr = (const f32x4*)src + lane;
    f32x4 v[4]; float am = 0.f;
#pragma unroll
    for (int j = 0; j < 4; ++j) { v[j] = xr[64 * j]; am = fmaxf(am, fmaxf(fmaxf(fabsf(v[j][0]), fabsf(v[j][1])), fmaxf(fabsf(v[j][2]), fabsf(v[j][3])))); }
#pragma unroll
    for (int o = 1; o < 64; o <<= 1) am = fmaxf(am, __shfl_xor(am, o));
    const float sc = am > 0.f ? am * (1.f / 127.f) : 1.f, inv = 1.f / sc;
#pragma unroll
    for (int j = 0; j < 4; ++j) {
        const int eb = 256 * j + 4 * lane;
        const int q0 = __float2int_rn(v[j][0] * inv), q1 = __float2int_rn(v[j][1] * inv), q2 = __float2int_rn(v[j][2] * inv), q3 = __float2int_rn(v[j][3] * inv);
        const unsigned w = (unsigned)(q0 & 255) | ((unsigned)(q1 & 255) << 8) | ((unsigned)(q2 & 255) << 16) | ((unsigned)(q3 & 255) << 24);
        *(unsigned*)(dst_base + ((size_t)(eb >> 7) * 16384 + row) * 128 + (eb & 127)) = w;
    }
    if (lane == 0) *scale_out = sc;
}
__device__ __forceinline__ void phase0(const Params& p, LAS unsigned char* lds, int tid, int lane, int wave) {
    const int gw = blockIdx.x * 8 + wave, NGW = gridDim.x * 8;
    LAS float* scr = (LAS float*)(lds + wave * 16384);
    bf16_t* WINT = (bf16_t*)(p.ws + WS_WINT);
    constexpr int I_IN = 16 * (DIN / 32);
    for (int it = gw; it < I_IN; it += NGW) transpose_item<true>(p.in[6], 1024, DIN, WINT, scr, it, lane);
    bf16_t* H = (bf16_t*)(p.ws + WS_H);
    for (int m = gw; m < NT; m += 2 * NGW) {
        const int m2 = m + NGW < NT ? m + NGW : m;
        const float* xr = m < NP ? p.in[0] + (size_t)m * DM : p.in[1] + (size_t)(m - NP) * DM;
        const float* xr2 = m2 < NP ? p.in[0] + (size_t)m2 * DM : p.in[1] + (size_t)(m2 - NP) * DM;
        rms_row2_bf16(xr, xr2, p.in[5], H + (size_t)m * DM, H + (size_t)m2 * DM, lane);
    }
}
__device__ __forceinline__ void prep_late(const Params& p, LAS unsigned char* lds, int tid, int lane, int wave, int rank, int nparts) {
    const int gw = rank * 8 + wave, NGW = nparts * 8;
    LAS float* scr = (LAS float*)(lds + wave * 16384);
    const size_t gt = (size_t)rank * 512 + tid, ngt = (size_t)nparts * 512;
    cvt_cache(p.in[2], (bf16_t*)(p.ws + WS_KS), gt, ngt);
    cvt_cache(p.in[3], (bf16_t*)(p.ws + WS_VS), gt, ngt);
    bf16_t* WOUTT = (bf16_t*)(p.ws + WS_WOUTT); bf16_t* WQT = (bf16_t*)(p.ws + WS_WQT);
    constexpr int I_OUT = 16 * (1024 / 32), I_Q = 16 * (2048 / 32);
    for (int it = gw; it < I_OUT + I_Q; it += NGW) {
        if (it < I_OUT) transpose_item<false>(p.in[17], 1024, 1024, WOUTT, scr, it, lane);
        else transpose_item<false>(p.in[19], 1024, 2048, WQT, scr, it - I_OUT, lane);
    }
    cvt_stream(p.in[20], (bf16_t*)(p.ws + WS_SK), (size_t)16 * 128 * 128 / 8, gt, ngt);
    for (int r = gw; r < 2 * 16384; r += NGW) {
        const int tb = r >> 14, e = r & 16383;
        if (tb) cvt_row_fp8<true>(p.in[22] + (size_t)e * DM, p.ws + WS_PV8, e, (float*)(p.ws + WS_SCV) + e, lane);
        else cvt_row_i8(p.in[21] + (size_t)e * DM, p.ws + WS_PU8, e, (float*)(p.ws + WS_SCU) + e, lane);
    }
}

namespace att {
constexpr int KPITCH = 272, VPITCH = 320;
constexpr int L_KV = 0, KV_BYTES = 64 * KPITCH + 64 * VPITCH  , L_X = 0  , L_BIAS = BIAS_OFF, L_CA = 0  , L_CW = 94 * 1024  ;
static_assert(4 * 4096 * 4 <= 2 * KV_BYTES && 2 * KV_BYTES <= L_CW && L_CW + 31 * 1024 <= RING_BYTES, "attention LDS map");

__device__ __forceinline__ int rel_bucket(int rel) {
    const int ret = rel > 0 ? 16 : 0; const int n = rel < 0 ? -rel : rel; int v;
    if (n < 8) v = n; else if (n < 12) v = 8; else if (n < 16) v = 9; else if (n < 23) v = 10; else if (n < 32) v = 11;
    else if (n < 46) v = 12; else if (n < 64) v = 13; else if (n < 91) v = 14; else v = 15;
    return ret + v;
}
typedef short v4i16_t __attribute__((ext_vector_type(4)));
__device__ __forceinline__ s16x4 vtr(const LAS unsigned char* p) { return __builtin_bit_cast(s16x4, __builtin_amdgcn_ds_read_tr16_b64_v4i16((LAS v4i16_t*)p)); }
__device__ __forceinline__ f32x16 mfma32(bf16x8 a, bf16x8 b, f32x16 c) { return __builtin_amdgcn_mfma_f32_32x32x16_bf16(a, b, c, 0, 0, 0); }

__device__ __forceinline__ void attn_unit(const Params& p, LAS unsigned char* lds, int kind, int bb, int h, int qblk, float lam, int tid, int lane, int wid) {
    const bf16_t* Q = (const bf16_t*)(p.ws + WS_Q);
    const bf16_t* Kb = kind == 0 ? (const bf16_t*)(p.ws + WS_KP) + (size_t)bb * 2048 * 512 + h * 128 : (const bf16_t*)(p.ws + WS_KS) + (size_t)bb * SKV * 512 + h * 128;
    const bf16_t* Vb = kind == 0 ? (const bf16_t*)(p.ws + WS_VP) + (size_t)bb * 2048 * 512 + h * 128 : (const bf16_t*)(p.ws + WS_VS) + (size_t)bb * SKV * 512 + h * 128;
    bf16_t* MIX = (bf16_t*)(p.ws + WS_MIX);
    const int qrow0 = kind == 0 ? bb * 2048 + qblk * 128 : NP + bb * 64;
    const int qpos0 = kind == 0 ? qblk * 128 : 2048;
    const int ntiles = kind == 0 ? 2 * qblk + 2 : 33;
    const int rg = wid & 3, map = wid >> 2, r32 = lane & 31, hi = lane >> 5;
    const bool active = kind == 0 ? true : (rg < 2);
    const int cw = kind == 0 ? 2 * qblk + (rg >> 1) : 32;
    const int qw0 = qpos0 + 32 * rg;
    const int qabs = qw0 + r32;

    bf16x8 qf[4];
    if (active) {
        const bf16_t* qp = Q + (size_t)(qrow0 + 32 * rg + r32) * 512 + h * 128 + map * 64 + 8 * hi;
#pragma unroll
        for (int s = 0; s < 4; ++s) qf[s] = *(const bf16x8*)(qp + 16 * s);
    } else {
#pragma unroll
        for (int s = 0; s < 4; ++s) qf[s] = (bf16x8){0, 0, 0, 0, 0, 0, 0, 0};
    }
    float m = 0.f, l = 0.f;
    f32x16 negm;
#pragma unroll
    for (int r = 0; r < 16; ++r) negm[r] = 0.f;
    f32x16 o[4];
#pragma unroll
    for (int mt = 0; mt < 4; ++mt)
#pragma unroll
        for (int r = 0; r < 16; ++r) o[mt][r] = 0.f;

    const int srow0 = tid >> 4, sch = tid & 15;
    const LAS float* btab = (const LAS float*)(lds + L_BIAS) + h * 320;
    const int vlane = (4 * hi + ((lane & 15) >> 2)) * VPITCH + (16 * ((lane >> 4) & 1) + 4 * (lane & 3)) * 2;
    u32x4 kA[2], vA[2], kB[2], vB[2];
#define ATT_LOAD(KR, VR, T) do { _Pragma("unroll") for (int i_ = 0; i_ < 2; ++i_) { const size_t off_ = (size_t)((T) * 64 + srow0 + 32 * i_) * 512 + sch * 8; KR[i_] = *(const u32x4*)(Kb + off_); VR[i_] = *(const u32x4*)(Vb + off_); } } while (0)
#define ATT_STORE(KR, VR, BUF) do { _Pragma("unroll") for (int i_ = 0; i_ < 2; ++i_) { \
        *(LAS u32x4*)(lds + L_KV + (BUF) * KV_BYTES + (srow0 + 32 * i_) * KPITCH + sch * 16) = KR[i_]; \
        *(LAS u32x4*)(lds + L_KV + (BUF) * KV_BYTES + 64 * KPITCH + (srow0 + 32 * i_) * VPITCH + sch * 16) = VR[i_]; } } while (0)
    auto compute = [&](int t, int buf) {
        const LAS unsigned char* kbuf = lds + L_KV + buf * KV_BYTES;
        const LAS unsigned char* vbuf = kbuf + 64 * KPITCH;
        f32x16 p0, p1;
        const int kabs0 = t * 64;
        const LAS unsigned char* kb = kbuf + r32 * KPITCH + (map * 8 + hi) * 16;
        {
            const bf16x8 a0 = *(const LAS bf16x8*)(kb), a1 = *(const LAS bf16x8*)(kb + 32 * KPITCH);
            if (kabs0 + 63 - qw0 > -128) {
                const LAS float* bt = btab + (kabs0 - qabs + 256 + 4 * hi);
#pragma unroll
                for (int r = 0; r < 16; ++r) { p0[r] = bt[(r & 3) + 8 * (r >> 2)] - m; p1[r] = bt[32 + (r & 3) + 8 * (r >> 2)] - m; }
                p0 = mfma32(a0, qf[0], p0); p1 = mfma32(a1, qf[0], p1);
            } else { p0 = mfma32(a0, qf[0], negm); p1 = mfma32(a1, qf[0], negm); }
        }
#pragma unroll
        for (int s = 1; s < 4; ++s) {
            const bf16x8 a0 = *(const LAS bf16x8*)(kb + s * 32), a1 = *(const LAS bf16x8*)(kb + 32 * KPITCH + s * 32);
            p0 = mfma32(a0, qf[s], p0); p1 = mfma32(a1, qf[s], p1);
        }
        float mx = fmaxf(p0[0], p1[0]);
#pragma unroll
        for (int r = 1; r < 16; ++r) mx = fmaxf(mx, fmaxf(p0[r], p1[r]));
        { const auto rr = __builtin_amdgcn_permlane32_swap(__float_as_uint(mx), __float_as_uint(mx), false, false); mx = fmaxf(__uint_as_float(rr[0]), __uint_as_float(rr[1])); }
        if (__any(mx > 8.f)) {
            const float dl = fmaxf(mx, 0.f);
            m += dl;
            const float alpha = __builtin_amdgcn_exp2f(-dl);
            l *= alpha;
#pragma unroll
            for (int r = 0; r < 16; ++r) { p0[r] -= dl; p1[r] -= dl; negm[r] = -m; }
#pragma unroll
            for (int mt = 0; mt < 4; ++mt)
#pragma unroll
                for (int r = 0; r < 16; ++r) o[mt][r] *= alpha;
        }
        float rs = 0.f;
#pragma unroll
        for (int r = 0; r < 16; ++r) { p0[r] = __builtin_amdgcn_exp2f(p0[r]); p1[r] = __builtin_amdgcn_exp2f(p1[r]); rs += p0[r] + p1[r]; }
        l += rs;
#pragma unroll
        for (int t2 = 0; t2 < 2; ++t2)
#pragma unroll
            for (int s = 0; s < 2; ++s) {
                u32x4 bw;
                if (t2 == 0) { bw.x = cvtpk(p0[8 * s + 0], p0[8 * s + 1]); bw.y = cvtpk(p0[8 * s + 2], p0[8 * s + 3]); bw.z = cvtpk(p0[8 * s + 4], p0[8 * s + 5]); bw.w = cvtpk(p0[8 * s + 6], p0[8 * s + 7]); }
                else { bw.x = cvtpk(p1[8 * s + 0], p1[8 * s + 1]); bw.y = cvtpk(p1[8 * s + 2], p1[8 * s + 3]); bw.z = cvtpk(p1[8 * s + 4], p1[8 * s + 5]); bw.w = cvtpk(p1[8 * s + 6], p1[8 * s + 7]); }
                const bf16x8 B = __builtin_bit_cast(bf16x8, bw);
                const LAS unsigned char* vb = vbuf + vlane + (32 * t2 + 16 * s) * VPITCH;
#pragma unroll
                for (int mt = 0; mt < 4; ++mt) {
                    const s16x4 lo = vtr(vb + mt * 64), hi8 = vtr(vb + mt * 64 + 8 * VPITCH);
                    const bf16x8 A = (bf16x8){lo[0], lo[1], lo[2], lo[3], hi8[0], hi8[1], hi8[2], hi8[3]};
                    o[mt] = mfma32(A, B, o[mt]);
                }
            }
    };
    ATT_LOAD(kA, vA, 0);
    if (ntiles > 1) ATT_LOAD(kB, vB, 1);
    ATT_STORE(kA, vA, 0);
    if (ntiles > 2) ATT_LOAD(kA, vA, 2);
    __syncthreads();
    for (int t = 0; t < ntiles; t += 2) {
        if (t + 1 < ntiles) { ATT_STORE(kB, vB, 1); if (t + 3 < ntiles) ATT_LOAD(kB, vB, t + 3); }
        if (active && t <= cw) compute(t, 0);
        __syncthreads();
        if (t + 1 >= ntiles) break;
        if (t + 2 < ntiles) { ATT_STORE(kA, vA, 0); if (t + 4 < ntiles) ATT_LOAD(kA, vA, t + 4); }
        if (active && t + 1 <= cw) compute(t + 1, 1);
        __syncthreads();
    }
#undef ATT_LOAD
#undef ATT_STORE
    l += __shfl_xor(l, 32);
    const float inv = 1.f / l;
    LAS float* X = (LAS float*)(lds + L_X) + rg * 4096;
    if (active && map == 1) {
        const float sc = -lam * inv;
#pragma unroll
        for (int mt = 0; mt < 4; ++mt)
#pragma unroll
            for (int r = 0; r < 16; ++r) X[(mt * 16 + r) * 64 + lane] = o[mt][r] * sc;
    }
    __syncthreads();
    if (active && map == 0) {
        float ss = 0.f;
#pragma unroll
        for (int mt = 0; mt < 4; ++mt)
#pragma unroll
            for (int r = 0; r < 16; ++r) { const float v = o[mt][r] * inv + X[(mt * 16 + r) * 64 + lane]; o[mt][r] = v; ss += v * v; }
        ss += __shfl_xor(ss, 32);
        const float rsn = 0.8f / sqrtf(ss * (1.f / 128.f) + EPS);
        bf16_t* orow = MIX + (size_t)(qrow0 + 32 * rg + r32) * 1024 + 512 + h * 128;
        const float* sg = p.in[15];
#pragma unroll
        for (int mt = 0; mt < 4; ++mt)
#pragma unroll
            for (int g4 = 0; g4 < 4; ++g4) {
                const int e = 32 * mt + 8 * g4 + 4 * hi;
                const f32x4 gg = *(const f32x4*)(sg + e);
                u32x2 w; w.x = cvtpk(o[mt][4 * g4 + 0] * rsn * gg[0], o[mt][4 * g4 + 1] * rsn * gg[1]); w.y = cvtpk(o[mt][4 * g4 + 2] * rsn * gg[2], o[mt][4 * g4 + 3] * rsn * gg[3]);
                *(u32x2*)(orow + e) = w;
            }
    }
    __syncthreads();
}

__device__ __forceinline__ void unpack8(const u32x4 w, float (&f)[8]) { f[0] = bflo(w.x); f[1] = bfhi(w.x); f[2] = bflo(w.y); f[3] = bfhi(w.y); f[4] = bflo(w.z); f[5] = bfhi(w.z); f[6] = bflo(w.w); f[7] = bfhi(w.w); }
__device__ __forceinline__ void conv_unit(const Params& p, LAS unsigned char* lds, int cu, int tid, int lane, int wid) {
    const bf16_t* A = (const bf16_t*)(p.ws + WS_A);
    bf16_t* MIX = (bf16_t*)(p.ws + WS_MIX);
    const float* cb = p.in[8]; const float* lg = p.in[9]; const float* lb = p.in[10]; const float* st = p.in[4];
    const int row0 = cu * 64;
    const bool isp = row0 < NP;
    const int s0 = isp ? (row0 & 2047) : 0, rbase = row0 - s0, bd = isp ? 0 : ((row0 - NP) >> 6);
    for (int c = tid; c < 94 * 64; c += 512) {
        const int rr = c >> 6, ch = c & 63, sp = s0 - 30 + rr;
        u32x4 v = (u32x4){0u, 0u, 0u, 0u};
        if (sp >= 0) v = *(const u32x4*)(A + (size_t)(rbase + sp) * 512 + ch * 8);
        else if (!isp) { const float* sr = st + ((size_t)bd * 30 + (30 + sp)) * 512 + ch * 8; const f32x4 a0 = *(const f32x4*)sr, a1 = *(const f32x4*)(sr + 4);
            v.x = cvtpk(a0[0], a0[1]); v.y = cvtpk(a0[2], a0[3]); v.z = cvtpk(a1[0], a1[1]); v.w = cvtpk(a1[2], a1[3]); }
        *(LAS u32x4*)(lds + L_CA + rr * 1024 + ch * 16) = v;
    }
    __syncthreads();
    const int c0 = lane * 8;
    float bias8[8], g8[8], b8[8];
    { const f32x4 x0 = *(const f32x4*)(cb + c0), x1 = *(const f32x4*)(cb + c0 + 4), y0 = *(const f32x4*)(lg + c0), y1 = *(const f32x4*)(lg + c0 + 4), z0 = *(const f32x4*)(lb + c0), z1 = *(const f32x4*)(lb + c0 + 4);
#pragma unroll
      for (int q = 0; q < 4; ++q) { bias8[q] = x0[q]; bias8[4 + q] = x1[q]; g8[q] = y0[q]; g8[4 + q] = y1[q]; b8[q] = z0[q]; b8[4 + q] = z1[q]; } }
    for (int grp = 0; grp < 2; ++grp) {
        const int t0 = wid * 8 + grp * 4;
        float acc[4][8];
#pragma unroll
        for (int q = 0; q < 4; ++q)
#pragma unroll
            for (int c = 0; c < 8; ++c) acc[q][c] = bias8[c];
        const LAS unsigned char* ap = lds + L_CA + t0 * 1024 + lane * 16;
        const LAS unsigned char* wp = lds + L_CW + lane * 16;
#pragma unroll 1
        for (int j = 0; j < 31; ++j) {
            float w[8]; unpack8(*(const LAS u32x4*)(wp + j * 1024), w);
#pragma unroll
            for (int q = 0; q < 4; ++q) {
                float a[8]; unpack8(*(const LAS u32x4*)(ap + (j + q) * 1024), a);
#pragma unroll
                for (int c = 0; c < 8; ++c) acc[q][c] += w[c] * a[c];
            }
        }
#pragma unroll
        for (int q = 0; q < 4; ++q) {
            float sm = 0.f;
#pragma unroll
            for (int c = 0; c < 8; ++c) sm += acc[q][c];
            const float mu = wave_total(sm) * (1.f / 512.f);
            float sv = 0.f;
#pragma unroll
            for (int c = 0; c < 8; ++c) { acc[q][c] -= mu; sv += acc[q][c] * acc[q][c]; }
            const float rstd = 1.f / sqrtf(wave_total(sv) * (1.f / 512.f) + EPS);
            float y[8];
#pragma unroll
            for (int c = 0; c < 8; ++c) { y[c] = acc[q][c] * rstd * g8[c] + b8[c]; y[c] = y[c] / (1.f + __expf(-y[c])); }
            u32x4 w; w.x = cvtpk(y[0], y[1]); w.y = cvtpk(y[2], y[3]); w.z = cvtpk(y[4], y[5]); w.w = cvtpk(y[6], y[7]);
            *(u32x4*)(MIX + (size_t)(row0 + t0 + q) * 1024 + c0) = w;
        }
    }
}

constexpr int N_SAMPLE_UNITS = 32, N_PROMPT_UNITS = 1024, N_CONV_UNITS = NT / 64, N_UNITS = N_SAMPLE_UNITS + N_PROMPT_UNITS + N_CONV_UNITS;

__device__ __forceinline__ void phase2(const Params& p, LAS unsigned char* lds, int tid, int lane, int wid, int cidx, int mode) {
    LAS float* bt = (LAS float*)(lds + L_BIAS);
    for (int e = tid; e < 4 * 320; e += 512) { const int hh = e / 320, rel = (e % 320) - 256; bt[e] = (p.in[16][rel_bucket(rel) * 4 + hh] - p.in[16][15 * 4 + hh]) * LOG2E; }
    for (int c = tid; c < 31 * 64; c += 512) {
        const float* wr = p.in[7] + (size_t)c * 8; const f32x4 a0 = *(const f32x4*)wr, a1 = *(const f32x4*)(wr + 4);
        u32x4 v; v.x = cvtpk(a0[0], a0[1]); v.y = cvtpk(a0[2], a0[3]); v.z = cvtpk(a1[0], a1[1]); v.w = cvtpk(a1[2], a1[3]);
        *(LAS u32x4*)(lds + L_CW + c * 16) = v;
    }
    const float d1 = wave_sum(p.in[11][lane] * p.in[12][lane]), d2 = wave_sum(p.in[13][lane] * p.in[14][lane]);
    const float lam = expf(d1) - expf(d2) + 0.2f;
    unsigned* ctr = (unsigned*)(p.ws + WS_CTL) + 64 * cidx;
    volatile LAS unsigned* sw = (volatile LAS unsigned*)(lds + MISC_OFF);
    __syncthreads();
    for (;;) {
        __syncthreads();
        if (tid == 0) sw[0] = atomicAdd(ctr, 1u);
        __syncthreads();
        const int u = (int)sw[0];
        if (u >= N_UNITS) break;
        if (mode == 1 && u >= N_SAMPLE_UNITS + N_PROMPT_UNITS) continue;
        if (mode == 2 && u < N_SAMPLE_UNITS + N_PROMPT_UNITS) continue;
        int tid_ = tid; asm volatile("" : "+v"(tid_));
        if (u < N_SAMPLE_UNITS + N_PROMPT_UNITS) {
            const int v = u - N_SAMPLE_UNITS; const int bh = v & 63; const bool smp = u < N_SAMPLE_UNITS;
            attn_unit(p, lds, smp ? 1 : 0, smp ? (u >> 2) : (bh >> 2), smp ? (u & 3) : (bh & 3), smp ? 0 : 15 - (v >> 6), lam, tid_, tid_ & 63, wid);
        } else conv_unit(p, lds, u - N_SAMPLE_UNITS - N_PROMPT_UNITS, tid_, tid_ & 63, wid);
    }
}
}

template <class F> __device__ __forceinline__ void mini_gemm(const bf16_t* A, const bf16_t* Bt, int N, int lane, int wave, F epi) {
    const int ntasks = 32 * (N / 64), G = gridDim.x;
    const int fr = lane & 15, fq = lane >> 4;
    for (int task = wave * G + (int)blockIdx.x; task < ntasks; task += 8 * G) {
        const int rb = task & 31, cb = task >> 5;
        pg8::f32x4 acc[4];
#pragma unroll
        for (int n = 0; n < 4; ++n) acc[n] = (pg8::f32x4){0.f, 0.f, 0.f, 0.f};
        const bf16_t* ap = A + (size_t)(rb * 16 + fr) * 1024 + 8 * fq;
        const bf16_t* bp = Bt + (size_t)(cb * 64 + fr) * 1024 + 8 * fq;
#pragma unroll 8
        for (int k0 = 0; k0 < 1024; k0 += 32) {
            const bf16x8 a0 = *(const bf16x8*)(ap + k0);
            bf16x8 b[4];
#pragma unroll
            for (int n = 0; n < 4; ++n) b[n] = *(const bf16x8*)(bp + (size_t)n * 16 * 1024 + k0);
#pragma unroll
            for (int n = 0; n < 4; ++n) acc[n] = __builtin_amdgcn_mfma_f32_16x16x32_bf16(b[n], a0, acc[n], 0, 0, 0);
        }
        epi(rb * 16 + fr, cb, fq, acc);
    }
}

__device__ __forceinline__ void phase3b(const Params& p, int lane, int wave) {
    const int gw = blockIdx.x * 8 + wave, NGW = gridDim.x * 8;
    bf16_t* H2 = (bf16_t*)(p.ws + WS_H2);
    for (int m = gw; m < NT; m += 2 * NGW) { const int m2 = m + NGW < NT ? m + NGW : m; rms_row2_bf16(p.out + (size_t)m * DM, p.out + (size_t)m2 * DM, p.in[18], H2 + (size_t)m * DM, H2 + (size_t)m2 * DM, lane); }
}

constexpr int P4B_KPITCH = 272, P4B_K_BYTES = 128 * P4B_KPITCH, P4B_Q_BYTES = 32 * P4B_KPITCH;
static_assert(P4B_K_BYTES + 8 * P4B_Q_BYTES <= RING_BYTES, "P4b LDS map");
__device__ __forceinline__ void phase4b(const Params& p, LAS unsigned char* lds, int tid, int lane, int wave) {
    const bf16_t* QP = (const bf16_t*)(p.ws + WS_QP); const bf16_t* SK = (const bf16_t*)(p.ws + WS_SK);
    float* TK = (float*)(p.ws + WS_TK);
    const int r32 = lane & 31, hi = lane >> 5;
    const int G = gridDim.x;
    for (int rp = blockIdx.x & 15; rp < 16; rp += (G < 16 ? G : 16)) {
        const int nbr = (G - rp + 15) >> 4, member = (int)blockIdx.x >> 4;
        __syncthreads();
        for (int c = tid; c < 128 * 16; c += 512) { const int row = c >> 4, ch = c & 15; *(LAS u32x4*)(lds + row * P4B_KPITCH + ch * 16) = *(const u32x4*)(SK + ((size_t)rp * 128 + row) * 128 + ch * 8); }
        __syncthreads();
        LAS unsigned char* qs = lds + P4B_K_BYTES + wave * P4B_Q_BYTES;
        u32x4 qn[8];
        { const int tg0 = member * 8 + wave;
          if (tg0 < NT / 32) {
#pragma unroll
            for (int i = 0; i < 8; ++i) { const int row = 4 * i + (lane >> 4), ch = lane & 15; qn[i] = *(const u32x4*)(QP + (size_t)(tg0 * 32 + row) * 2048 + rp * 128 + ch * 8); } } }
        for (int tg = member * 8 + wave; tg < NT / 32; tg += nbr * 8) {
            const int t0 = tg * 32;
#pragma unroll
            for (int i = 0; i < 8; ++i) { const int row = 4 * i + (lane >> 4), ch = lane & 15; *(LAS u32x4*)(qs + row * P4B_KPITCH + ch * 16) = qn[i]; }
            { const int tgn = tg + nbr * 8;
              if (tgn < NT / 32) {
#pragma unroll
                for (int i = 0; i < 8; ++i) { const int row = 4 * i + (lane >> 4), ch = lane & 15; qn[i] = *(const u32x4*)(QP + (size_t)(tgn * 32 + row) * 2048 + rp * 128 + ch * 8); } } }
            bf16x8 qf[8];
#pragma unroll
            for (int s = 0; s < 8; ++s) qf[s] = *(const LAS bf16x8*)(qs + r32 * P4B_KPITCH + (2 * s + hi) * 16);
            float v[64];
#pragma unroll
            for (int mt = 0; mt < 4; ++mt) {
                f32x16 S;
#pragma unroll
                for (int r = 0; r < 16; ++r) S[r] = 0.f;
                const LAS unsigned char* kp = lds + (32 * mt + r32) * P4B_KPITCH + hi * 16;
#pragma unroll
                for (int s = 0; s < 8; ++s) S = att::mfma32(*(const LAS bf16x8*)(kp + s * 32), qf[s], S);
#pragma unroll
                for (int r = 0; r < 16; ++r) { const int n = 32 * mt + (r & 3) + 8 * (r >> 2) + 4 * hi; v[mt * 16 + r] = __uint_as_float((__float_as_uint(S[r]) & ~127u) | (unsigned)(127 - n)); }
            }
            SORT16_DESC(v, 0); SORT16_DESC(v, 16); SORT16_DESC(v, 32); SORT16_DESC(v, 48);
#pragma unroll
            for (int i = 0; i < 16; ++i) { v[i] = fmaxf(v[i], v[31 - i]); v[32 + i] = fmaxf(v[32 + i], v[63 - i]); }
            BITONIC16_DESC(v, 0); BITONIC16_DESC(v, 32);
#pragma unroll
            for (int i = 0; i < 16; ++i) v[i] = fmaxf(v[i], v[47 - i]);
            BITONIC16_DESC(v, 0);
            float w[16];
#pragma unroll
            for (int i = 0; i < 16; ++i) w[i] = fmaxf(v[i], __shfl_xor(v[15 - i], 32));
            BITONIC16_DESC(w, 0);
            if (hi == 0) {
                f32x4* dst = (f32x4*)(TK + ((size_t)(t0 + r32) * 16 + rp) * 16);
#pragma unroll
                for (int q = 0; q < 4; ++q) dst[q] = (f32x4){w[4 * q], w[4 * q + 1], w[4 * q + 2], w[4 * q + 3]};
            }
        }
    }
}

__device__ __forceinline__ void phase5a(const Params& p, LAS unsigned char* lds, int tid) {
    const float* TK = (const float*)(p.ws + WS_TK);
    int* IDX = (int*)(p.ws + WS_IDX); float* GATE = (float*)(p.ws + WS_GATE);
    const float NEG_INF = -__builtin_huge_valf();
    LAS unsigned* rec = (LAS unsigned*)(lds + tid * 36);
    for (int item = blockIdx.x * 512 + tid; item < NT * 8; item += gridDim.x * 512) {
        const int tok = item >> 3, r = item & 7;
        const f32x4* pa = (const f32x4*)(TK + ((size_t)tok * 16 + 2 * r) * 16);
        float a[16], b[16];
#pragma unroll
        for (int q = 0; q < 4; ++q) { const f32x4 x = pa[q], y = pa[4 + q];
#pragma unroll
            for (int j = 0; j < 4; ++j) { a[4 * q + j] = x[j]; b[4 * q + j] = y[j]; } }
        float ssum = 0.f;
        { const f32x4* sp = (const f32x4*)((const float*)(p.ws + WS_SSQ) + (size_t)tok * 16);
#pragma unroll
          for (int q = 0; q < 4; ++q) { const f32x4 v4 = sp[q]; ssum += (v4[0] + v4[1]) + (v4[2] + v4[3]); } }
#pragma unroll
        for (int q = 0; q < 4; ++q) {
            unsigned wa = 0u, wb = 0u;
#pragma unroll
            for (int j = 0; j < 4; ++j) { const unsigned ua = __float_as_uint(a[4 * q + j]), ub = __float_as_uint(b[4 * q + j]);
                wa |= (127u - (ua & 127u)) << (8 * j); wb |= (127u - (ub & 127u)) << (8 * j);
                a[4 * q + j] = __uint_as_float(ua & ~127u); b[4 * q + j] = __uint_as_float(ub & ~127u); }
            rec[q] = wa; rec[4 + q] = wb;
        }
        float v[64];
        {
            int c = 0;
#pragma unroll
            for (int i = 0; i < 16; ++i)
#pragma unroll
                for (int j = 0; j < 16; ++j)
                    if ((i + 1) * (j + 1) <= 16) { v[c] = __uint_as_float((__float_as_uint(a[i] + b[j]) & ~255u) | (unsigned)(255 - (16 * i + j))); ++c; }
#pragma unroll
            for (int c2 = 50; c2 < 64; ++c2) v[c2] = NEG_INF;
        }
        SORT16_DESC(v, 0); SORT16_DESC(v, 16); SORT16_DESC(v, 32); SORT16_DESC(v, 48);
#pragma unroll
        for (int i = 0; i < 16; ++i) { v[i] = fmaxf(v[i], v[31 - i]); v[32 + i] = fmaxf(v[32 + i], v[63 - i]); }
        BITONIC16_DESC(v, 0); BITONIC16_DESC(v, 32);
#pragma unroll
        for (int i = 0; i < 16; ++i) v[i] = fmaxf(v[i], v[47 - i]);
        BITONIC16_DESC(v, 0);
        const float rstd = 1.f / sqrtf(ssum * (1.f / DM) + EPS);
        if (r == 0) ((float*)(p.ws + WS_RSTD))[tok] = rstd;
        const LAS unsigned char* rb = (const LAS unsigned char*)rec;
        float e[16], sum = 0.f; int bid[16];
        const float best0 = __uint_as_float(__float_as_uint(v[0]) & ~255u);
#pragma unroll
        for (int k = 0; k < 16; ++k) {
            const unsigned u = __float_as_uint(v[k]); const unsigned code = 255u - (u & 255u);
            bid[k] = (int)rb[code >> 4] * 128 + (int)rb[16 + (code & 15u)];
            e[k] = __expf((__uint_as_float(u & ~255u) - best0) * rstd); sum += e[k];
        }
        const float rinv = 1.f / sum;
        int* io = IDX + (size_t)tok * 128 + r * 16; float* go = GATE + (size_t)tok * 128 + r * 16;
#pragma unroll
        for (int k = 0; k < 16; ++k) { io[k] = bid[k]; go[k] = e[k] * rinv; }
    }
}

__device__ __forceinline__ float gelu_erf(float x) { return 0.5f * x * (1.f + erff(x * 0.70710678118654752f)); }
__device__ __forceinline__ void fp8x16_to_f32(const u32x4 q, float (&f)[16]) {
    const f32x2 c0 = __builtin_amdgcn_cvt_pk_f32_fp8(q.x, false), c1 = __builtin_amdgcn_cvt_pk_f32_fp8(q.x, true), c2 = __builtin_amdgcn_cvt_pk_f32_fp8(q.y, false), c3 = __builtin_amdgcn_cvt_pk_f32_fp8(q.y, true);
    const f32x2 c4 = __builtin_amdgcn_cvt_pk_f32_fp8(q.z, false), c5 = __builtin_amdgcn_cvt_pk_f32_fp8(q.z, true), c6 = __builtin_amdgcn_cvt_pk_f32_fp8(q.w, false), c7 = __builtin_amdgcn_cvt_pk_f32_fp8(q.w, true);
    f[0] = c0.x; f[1] = c0.y; f[2] = c1.x; f[3] = c1.y; f[4] = c2.x; f[5] = c2.y; f[6] = c3.x; f[7] = c3.y;
    f[8] = c4.x; f[9] = c4.y; f[10] = c5.x; f[11] = c5.y; f[12] = c6.x; f[13] = c6.y; f[14] = c7.x; f[15] = c7.y;
}
__device__ __forceinline__ void slice_group(int& x, int& gwx, int& nwx, int wave) {
    x = blockIdx.x & 7; const int nbx = ((int)gridDim.x - x + 7) >> 3; gwx = ((int)blockIdx.x >> 3) * 8 + wave; nwx = nbx * 8;
}
__device__ __forceinline__ void phase5u(const Params& p, LAS unsigned char* lds, int lane, int wave) {
    int x, gwx, nwx; slice_group(x, gwx, nwx, wave);
    const unsigned char* PU8 = p.ws + WS_PU8 + (size_t)x * 16384 * 128;
    const bf16_t* H2 = (const bf16_t*)(p.ws + WS_XG) + 128 * x;
    const int* IDX = (const int*)(p.ws + WS_IDX); float* PACT = (float*)(p.ws + WS_PACT) + (size_t)x * NT * 128;
    LAS int* l_idx = (LAS int*)(lds + wave * 512);
    const int g = lane >> 3, sub = lane & 7;
    const unsigned char* rowp = PU8 + sub * 16;
    int r_idxA = 0, r_idxB = 0;
    u32x4 hA0, hA1, hB0, hB1; hA0 = hA1 = hB0 = hB1 = (u32x4){0u, 0u, 0u, 0u};
    u32x4 qA[16], qB[16];
#define P5U_LOADIDX(T) do { if ((T) < NT) { r_idxA = IDX[(size_t)(T) * 128 + lane]; r_idxB = IDX[(size_t)(T) * 128 + 64 + lane]; } } while (0)
#define P5U_ISSUE(Q, H0, H1, T) do { if ((T) < NT) { l_idx[lane] = r_idxA; l_idx[64 + lane] = r_idxB; \
        H0 = *(const u32x4*)(H2 + (size_t)(T) * DM + 16 * sub); H1 = *(const u32x4*)(H2 + (size_t)(T) * DM + 16 * sub + 8); \
        _Pragma("unroll") for (int q_ = 0; q_ < 4; ++q_) { const u32x4 iv = *(const LAS u32x4*)(l_idx + 16 * g + 4 * q_); \
            Q[4 * q_] = *(const u32x4*)(rowp + (size_t)iv.x * 128); Q[4 * q_ + 1] = *(const u32x4*)(rowp + (size_t)iv.y * 128); \
            Q[4 * q_ + 2] = *(const u32x4*)(rowp + (size_t)iv.z * 128); Q[4 * q_ + 3] = *(const u32x4*)(rowp + (size_t)iv.w * 128); } } } while (0)
#define IDPP_ADD(v, ctrl) v += __builtin_amdgcn_update_dpp(0, v, ctrl, 0xf, 0xf, true)
#define FDPP_MAX(v, ctrl) v = fmaxf(v, __builtin_bit_cast(float, __builtin_amdgcn_update_dpp(0, __builtin_bit_cast(int, v), ctrl, 0xf, 0xf, true)))
#define P5U_COMPUTE(Q, H0, H1, T) do { \
        float hf[16]; \
        hf[0] = bflo(H0.x); hf[1] = bfhi(H0.x); hf[2] = bflo(H0.y); hf[3] = bfhi(H0.y); hf[4] = bflo(H0.z); hf[5] = bfhi(H0.z); hf[6] = bflo(H0.w); hf[7] = bfhi(H0.w); \
        hf[8] = bflo(H1.x); hf[9] = bfhi(H1.x); hf[10] = bflo(H1.y); hf[11] = bfhi(H1.y); hf[12] = bflo(H1.z); hf[13] = bfhi(H1.z); hf[14] = bflo(H1.w); hf[15] = bfhi(H1.w); \
        float am = 0.f; \
        _Pragma("unroll") for (int j = 0; j < 16; ++j) am = fmaxf(am, fabsf(hf[j])); \
        FDPP_MAX(am, 0xB1); FDPP_MAX(am, 0x4E); FDPP_MAX(am, 0x141);              \
        const float sh = am > 0.f ? am * (1.f / 127.f) : 1.f, ih = 1.f / sh; \
        int hq[4]; \
        _Pragma("unroll") for (int w_ = 0; w_ < 4; ++w_) { \
            const int q0 = __float2int_rn(hf[4 * w_] * ih), q1 = __float2int_rn(hf[4 * w_ + 1] * ih), q2 = __float2int_rn(hf[4 * w_ + 2] * ih), q3 = __float2int_rn(hf[4 * w_ + 3] * ih); \
            hq[w_] = (int)((unsigned)(q0 & 255) | ((unsigned)(q1 & 255) << 8) | ((unsigned)(q2 & 255) << 16) | ((unsigned)(q3 & 255) << 24)); } \
        int resA = 0, resB = 0; \
        _Pragma("unroll") for (int i = 0; i < 16; ++i) { \
            int d = __builtin_amdgcn_sdot4((int)Q[i].x, hq[0], 0, false); d = __builtin_amdgcn_sdot4((int)Q[i].y, hq[1], d, false); \
            d = __builtin_amdgcn_sdot4((int)Q[i].z, hq[2], d, false); d = __builtin_amdgcn_sdot4((int)Q[i].w, hq[3], d, false); \
            IDPP_ADD(d, 0xB1); IDPP_ADD(d, 0x4E); IDPP_ADD(d, 0x141); \
            if (i < 8) resA = (sub == i) ? d : resA; else resB = (sub == i - 8) ? d : resB; } \
        PACT[(size_t)(T) * 128 + 16 * g + sub] = (float)resA * sh; PACT[(size_t)(T) * 128 + 16 * g + 8 + sub] = (float)resB * sh; } while (0)
    int tok = gwx;
    P5U_LOADIDX(tok);
    P5U_ISSUE(qA, hA0, hA1, tok);
    P5U_LOADIDX(tok + nwx);
    for (; tok < NT; tok += 2 * nwx) {
        P5U_ISSUE(qB, hB0, hB1, tok + nwx);
        P5U_LOADIDX(tok + 2 * nwx);
        P5U_COMPUTE(qA, hA0, hA1, tok);
        if (tok + nwx >= NT) break;
        P5U_ISSUE(qA, hA0, hA1, tok + 2 * nwx);
        P5U_LOADIDX(tok + 3 * nwx);
        P5U_COMPUTE(qB, hB0, hB1, tok + nwx);
    }
#undef P5U_LOADIDX
#undef P5U_ISSUE
#undef P5U_COMPUTE
#undef IDPP_ADD
#undef FDPP_MAX
}
__device__ __forceinline__ void phase5c(const Params& p, int tid) {
    const float* PACT = (const float*)(p.ws + WS_PACT); const float* SCU = (const float*)(p.ws + WS_SCU); const float* SCV = (const float*)(p.ws + WS_SCV);
    const int* IDX = (const int*)(p.ws + WS_IDX); const float* GATE = (const float*)(p.ws + WS_GATE); float* COEF = (float*)(p.ws + WS_COEF); const float* RSTD = (const float*)(p.ws + WS_RSTD);
    const size_t n = (size_t)NT * 128, n4 = n / 4, stride = (size_t)gridDim.x * 512;
    for (size_t i0 = (size_t)blockIdx.x * 512 + tid; i0 < n4; i0 += 2 * stride) {
        f32x4 a[2], g[2]; u32x4 e[2]; f32x4 pa[2][8]; float rs[2];
#pragma unroll
        for (int u = 0; u < 2; ++u) {
            const size_t it = (i0 + u * stride < n4 ? i0 + u * stride : i0) * 4;
#pragma unroll
            for (int xx = 0; xx < 8; ++xx) pa[u][xx] = *(const f32x4*)(PACT + (size_t)xx * n + it);
            e[u] = *(const u32x4*)(IDX + it); g[u] = *(const f32x4*)(GATE + it); rs[u] = RSTD[it >> 7];
        }
        float su[2][4], sv[2][4];
#pragma unroll
        for (int u = 0; u < 2; ++u)
#pragma unroll
            for (int j = 0; j < 4; ++j) { su[u][j] = SCU[e[u][j]]; sv[u][j] = SCV[e[u][j]]; }
#pragma unroll
        for (int u = 0; u < 2; ++u) {
            a[u] = ((pa[u][0] + pa[u][1]) + (pa[u][2] + pa[u][3])) + ((pa[u][4] + pa[u][5]) + (pa[u][6] + pa[u][7]));
            f32x4 c;
#pragma unroll
            for (int j = 0; j < 4; ++j) c[j] = g[u][j] * gelu_erf(a[u][j] * (rs[u] * su[u][j])) * sv[u][j];
            if (i0 + u * stride < n4) *(f32x4*)(COEF + (i0 + u * stride) * 4) = c;
        }
    }
}

constexpr int P5V_LDS_PER_WAVE = 1024 + 8 * 136 * 4;
__device__ __forceinline__ void phase5v(const Params& p, LAS unsigned char* lds, int lane, int wave) {
    int x, gwx, nwx; slice_group(x, gwx, nwx, wave);
    const unsigned char* PV8 = p.ws + WS_PV8 + (size_t)x * 16384 * 128;
    const int* IDX = (const int*)(p.ws + WS_IDX); const float* COEF = (const float*)(p.ws + WS_COEF);
    LAS int* l_idx = (LAS int*)(lds + wave * P5V_LDS_PER_WAVE); LAS float* l_cf = (LAS float*)(l_idx + 128); LAS float* red = l_cf + 128;
    const int g = lane >> 3, sub = lane & 7;
    const unsigned char* rowp = PV8 + sub * 16;
    const int c1 = 16 * (lane & 7) + (lane >> 3);
    int r_idxA = 0, r_idxB = 0; float r_cA = 0.f, r_cB = 0.f;
    u32x4 qA[16], qB[16]; f32x4 cfA[4], cfB[4]; float xA0 = 0.f, xA1 = 0.f, xB0 = 0.f, xB1 = 0.f;
#define P5V_LOADIDX(T) do { if ((T) < NT) { r_idxA = IDX[(size_t)(T) * 128 + lane]; r_idxB = IDX[(size_t)(T) * 128 + 64 + lane]; r_cA = COEF[(size_t)(T) * 128 + lane]; r_cB = COEF[(size_t)(T) * 128 + 64 + lane]; } } while (0)
#define P5V_ISSUE(Q, CF, X0, X1, T) do { if ((T) < NT) { l_idx[lane] = r_idxA; l_idx[64 + lane] = r_idxB; l_cf[lane] = r_cA; l_cf[64 + lane] = r_cB; \
        { const float* xr_ = p.out + (size_t)(T) * DM + 128 * x; X0 = xr_[c1]; X1 = xr_[c1 + 8]; } \
        _Pragma("unroll") for (int q_ = 0; q_ < 4; ++q_) { const u32x4 iv = *(const LAS u32x4*)(l_idx + 16 * g + 4 * q_); CF[q_] = *(const LAS f32x4*)(l_cf + 16 * g + 4 * q_); \
            Q[4 * q_] = *(const u32x4*)(rowp + (size_t)iv.x * 128); Q[4 * q_ + 1] = *(const u32x4*)(rowp + (size_t)iv.y * 128); \
            Q[4 * q_ + 2] = *(const u32x4*)(rowp + (size_t)iv.z * 128); Q[4 * q_ + 3] = *(const u32x4*)(rowp + (size_t)iv.w * 128); } } } while (0)
#define P5V_COMPUTE(Q, CF, X0, X1, T) do { \
        f32x2 acc[8]; \
        _Pragma("unroll") for (int j = 0; j < 8; ++j) acc[j] = (f32x2){0.f, 0.f}; \
        _Pragma("unroll") for (int i = 0; i < 16; ++i) { \
            const float cs_ = CF[i >> 2][i & 3]; const f32x2 c2 = (f32x2){cs_, cs_}; \
            acc[0] = __builtin_elementwise_fma(__builtin_amdgcn_cvt_pk_f32_fp8(Q[i].x, false), c2, acc[0]); \
            acc[1] = __builtin_elementwise_fma(__builtin_amdgcn_cvt_pk_f32_fp8(Q[i].x, true), c2, acc[1]); \
            acc[2] = __builtin_elementwise_fma(__builtin_amdgcn_cvt_pk_f32_fp8(Q[i].y, false), c2, acc[2]); \
            acc[3] = __builtin_elementwise_fma(__builtin_amdgcn_cvt_pk_f32_fp8(Q[i].y, true), c2, acc[3]); \
            acc[4] = __builtin_elementwise_fma(__builtin_amdgcn_cvt_pk_f32_fp8(Q[i].z, false), c2, acc[4]); \
            acc[5] = __builtin_elementwise_fma(__builtin_amdgcn_cvt_pk_f32_fp8(Q[i].z, true), c2, acc[5]); \
            acc[6] = __builtin_elementwise_fma(__builtin_amdgcn_cvt_pk_f32_fp8(Q[i].w, false), c2, acc[6]); \
            acc[7] = __builtin_elementwise_fma(__builtin_amdgcn_cvt_pk_f32_fp8(Q[i].w, true), c2, acc[7]); } \
        _Pragma("unroll") for (int j = 0; j < 8; ++j) { red[g * 136 + (2 * j) * 8 + sub] = acc[j].x; red[g * 136 + (2 * j + 1) * 8 + sub] = acc[j].y; } \
        float s1 = X0, s2_ = X1; \
        _Pragma("unroll") for (int gg = 0; gg < 8; ++gg) { s1 += red[gg * 136 + lane]; s2_ += red[gg * 136 + 64 + lane]; } \
        { float* xr_ = p.out + (size_t)(T) * DM + 128 * x; xr_[c1] = s1; xr_[c1 + 8] = s2_; } } while (0)
    int tok = gwx;
    P5V_LOADIDX(tok);
    P5V_ISSUE(qA, cfA, xA0, xA1, tok);
    P5V_LOADIDX(tok + nwx);
    for (; tok < NT; tok += 2 * nwx) {
        P5V_ISSUE(qB, cfB, xB0, xB1, tok + nwx);
        P5V_LOADIDX(tok + 2 * nwx);
        P5V_COMPUTE(qA, cfA, xA0, xA1, tok);
        if (tok + nwx >= NT) break;
        P5V_ISSUE(qA, cfA, xA0, xA1, tok + 2 * nwx);
        P5V_LOADIDX(tok + 3 * nwx);
        P5V_COMPUTE(qB, cfB, xB0, xB1, tok + nwx);
    }
#undef P5V_LOADIDX
#undef P5V_ISSUE
#undef P5V_COMPUTE
}

__device__ __forceinline__ void phase6(const Params& p, int lane, int wave) {
    const int gw = blockIdx.x * 8 + wave, NGW = gridDim.x * 8;
    const f32x4* gr = (const f32x4*)p.in[23] + lane;
    for (int m = gw; m < NT; m += 2 * NGW) {
        const bool two = m + NGW < NT;
        f32x4* xa = (f32x4*)(p.out + (size_t)m * DM) + lane; f32x4* xb = (f32x4*)(p.out + (size_t)(two ? m + NGW : m) * DM) + lane;
        f32x4 va[4], vb[4]; float sa = 0.f, sb = 0.f;
#pragma unroll
        for (int j = 0; j < 4; ++j) { va[j] = xa[64 * j]; vb[j] = xb[64 * j]; }
#pragma unroll
        for (int j = 0; j < 4; ++j) { sa += (va[j][0] * va[j][0] + va[j][1] * va[j][1]) + (va[j][2] * va[j][2] + va[j][3] * va[j][3]); sb += (vb[j][0] * vb[j][0] + vb[j][1] * vb[j][1]) + (vb[j][2] * vb[j][2] + vb[j][3] * vb[j][3]); }
        const float ra_ = 1.f / sqrtf(wave_total(sa) * (1.f / DM) + EPS), rb_ = 1.f / sqrtf(wave_total(sb) * (1.f / DM) + EPS);
#pragma unroll
        for (int j = 0; j < 4; ++j) { const f32x4 gg = gr[64 * j]; __builtin_nontemporal_store(va[j] * ra_ * gg, xa + 64 * j); if (two) __builtin_nontemporal_store(vb[j] * rb_ * gg, xb + 64 * j); }
    }
}

__global__ void __launch_bounds__(512, 2) fwd_megakernel(Params p) {
    extern __shared__ __attribute__((aligned(16))) unsigned char lds_raw[];
    LAS unsigned char* lds = (LAS unsigned char*)lds_raw;
    const int tid0 = threadIdx.x, wave = __builtin_amdgcn_readfirstlane(tid0 >> 6);
#define PHASE_IDS() int tid = tid0; asm volatile("" : "+v"(tid)); const int lane = tid & 63; (void)lane
    const int G = gridDim.x;
    volatile LAS unsigned* MISC = (volatile LAS unsigned*)(lds + MISC_OFF);
    if (tid0 < 32) MISC[tid0] = 0u;
    __syncthreads();
    XcdBarrier bar = xcd_barrier_post((unsigned*)(p.ws + WS_CTL) + 4096, MISC + 8);
#define GSYNC() xcd_barrier(bar)

#ifndef RPT_MASK
#define RPT_MASK 0
#endif
#if RPT_MASK
#define RPT(bit) for (int rpt_ = 0; rpt_ < (((RPT_MASK) >> (bit)) & 1) + 1; ++rpt_)
#else
#define RPT(bit) if (constexpr int rpt_ = 0; true)
#endif
    RPT(0) { PHASE_IDS(); phase0(p, lds, tid, lane, wave); GSYNC(); }
    RPT(1) {
        PHASE_IDS();
        pg8::Gemm g{(const bf16_t*)(p.ws + WS_H), (const bf16_t*)(p.ws + WS_WINT), NT, DIN, 1024};
        pg8::StaticOrder S; S.init(NT, DIN, G, (int)blockIdx.x);
        pg8::EpiProj E{(bf16_t*)(p.ws + WS_A), (bf16_t*)(p.ws + WS_Q), (bf16_t*)(p.ws + WS_KP), (bf16_t*)(p.ws + WS_VP), (bf16_t*)(p.ws + WS_KS), (bf16_t*)(p.ws + WS_VS), p.out};
        pg8::gemm_phase<pg8::EpiProj, pg8::StaticOrder, true, true>(lds, g, S, E);
        {
            const int nwg = (NT / 256) * (DIN / 256), rem = nwg % G, c = (int)blockIdx.x;
            if (rem == 0) prep_late(p, lds, tid, lane, wave, c, G);
            else if (c >= rem) prep_late(p, lds, tid, lane, wave, c - rem, G - rem);
        }
        GSYNC();
    }
    #ifndef P2MODE
#define P2MODE 0
#endif
    RPT(2) { PHASE_IDS(); att::phase2(p, lds, tid, lane, wave, rpt_, (((RPT_MASK) >> 2) & 1) && rpt_ == 0 ? P2MODE : 0); GSYNC(); }
    RPT(3) {
        PHASE_IDS();
        pg8::Gemm g{(const bf16_t*)(p.ws + WS_MIX), (const bf16_t*)(p.ws + WS_WOUTT), NP, 1024, 1024};
        pg8::StaticOrder S; S.init(NP, 1024, G, (int)blockIdx.x);
        pg8::EpiRes E{p.in[0], p.in[1], p.out, (bf16_t*)(p.ws + WS_XG), p.in[18], (float*)(p.ws + WS_SSQ)};
        pg8::gemm_phase<pg8::EpiRes, pg8::StaticOrder, true, true>(lds, g, S, E);
        {
            const float* xs = p.in[1]; float* xo = p.out + (size_t)NP * DM; bf16_t* go = (bf16_t*)(p.ws + WS_XG) + (size_t)NP * DM; const float* gff = p.in[18]; float* sso = (float*)(p.ws + WS_SSQ) + (size_t)NP * 16;
            mini_gemm((const bf16_t*)(p.ws + WS_MIX) + (size_t)NP * DM, (const bf16_t*)(p.ws + WS_WOUTT), 1024, lane, wave,
                      [=](int row, int cb, int fq, const pg8::f32x4 (&a)[4]) {
                          float sq = 0.f;
#pragma unroll
                          for (int n = 0; n < 4; ++n) {
                              const int col = cb * 64 + 16 * n + 4 * fq;
                              const pg8::f32x4 v = *(const pg8::f32x4*)(xs + (size_t)row * DM + col) + a[n];
                              *(pg8::f32x4*)(xo + (size_t)row * DM + col) = v;
                              *(u32x2*)(go + (size_t)row * DM + col) = pg8::pack4(v * *(const pg8::f32x4*)(gff + col));
                              sq += (v[0] * v[0] + v[1] * v[1]) + (v[2] * v[2] + v[3] * v[3]);
                          }
                          sq += __shfl_xor(sq, 16); sq += __shfl_xor(sq, 32);
                          if (fq == 0) sso[(size_t)row * 16 + cb] = sq;
                      });
        }
        GSYNC();
    }
    RPT(5) {
        PHASE_IDS();
        pg8::Gemm g{(const bf16_t*)(p.ws + WS_XG), (const bf16_t*)(p.ws + WS_WQT), NP, 2048, 1024};
        pg8::StaticOrder S; S.init(NP, 2048, G, (int)blockIdx.x);
        pg8::EpiBf16<0> E{(bf16_t*)(p.ws + WS_QP), 2048, nullptr, 0, 0, 1.f};
        pg8::gemm_phase<pg8::EpiBf16<0>, pg8::StaticOrder, true, true>(lds, g, S, E);
        {
            bf16_t* qo = (bf16_t*)(p.ws + WS_QP) + (size_t)NP * 2048;
            mini_gemm((const bf16_t*)(p.ws + WS_XG) + (size_t)NP * DM, (const bf16_t*)(p.ws + WS_WQT), 2048, lane, wave,
                      [=](int row, int cb, int fq, const pg8::f32x4 (&a)[4]) {
#pragma unroll
                          for (int n = 0; n < 4; ++n) *(u32x2*)(qo + (size_t)row * 2048 + cb * 64 + 16 * n + 4 * fq) = pg8::pack4(a[n]);
                      });
        }
        GSYNC();
    }
    RPT(6) { PHASE_IDS(); phase4b(p, lds, tid, lane, wave); GSYNC(); }
    RPT(7) { PHASE_IDS(); phase5a(p, lds, tid); GSYNC(); }
    RPT(8) { PHASE_IDS(); phase5u(p, lds, lane, wave); GSYNC(); }
    RPT(9) { PHASE_IDS(); phase5c(p, tid); GSYNC(); }
    { PHASE_IDS(); phase5v(p, lds, lane, wave); }
    GSYNC();
    { PHASE_IDS(); phase6(p, lane, wave); }
}

extern "C" void kernel_launch(void* const* d_in, const int* in_sizes, int n_in, void* d_out, int out_size, void* d_ws, size_t ws_size, hipStream_t stream) {
    static int grid = 0;
    if (grid == 0) {
        if (n_in != 24 || out_size != (int)OUT_TOTAL || ws_size < WS_END) { fprintf(stderr, "kernel_launch: unexpected shapes: n_in %d out %d ws %zu (need %zu)\n", n_in, out_size, ws_size, (size_t)WS_END); grid = -1; return; }
        int dev = 0, cus = 0, per_cu = 0;
        (void)hipGetDevice(&dev);
        (void)hipDeviceGetAttribute(&cus, hipDeviceAttributeMultiprocessorCount, dev);
        if (hipFuncSetAttribute((const void*)fwd_megakernel, hipFuncAttributeMaxDynamicSharedMemorySize, LDS_BYTES) != hipSuccess) { fprintf(stderr, "kernel_launch: hipFuncSetAttribute failed\n"); grid = -1; return; }
        if (hipOccupancyMaxActiveBlocksPerMultiprocessor(&per_cu, (const void*)fwd_megakernel, 512, LDS_BYTES) != hipSuccess || per_cu < 1) { fprintf(stderr, "kernel_launch: occupancy query gave %d\n", per_cu); per_cu = 1; }
        (void)hipGetLastError();
        grid = cus * 1;
        if (per_cu < 1) grid = -1;
    }
    if (grid < 0) return;
    (void)hipMemsetAsync((char*)d_ws + WS_CTL, 0, CTL_BYTES, stream);
    Params p{};
    for (int i = 0; i < 24; ++i) p.in[i] = (const float*)d_in[i];
    p.out = (float*)d_out; p.ws = (unsigned char*)d_ws;
    void* args[] = {&p};
    hipError_t e = hipLaunchCooperativeKernel((const void*)fwd_megakernel, dim3(grid), dim3(512), args, LDS_BYTES, stream);
    if (e != hipSuccess) fprintf(stderr, "cooperative launch failed: %s (grid %d)\n", hipGetErrorString(e), grid);
}
```

```cpp
#include <hip/hip_runtime.h>
#include <hip/hip_cooperative_groups.h>
#include <cstdio>
#include <cstdint>
#include <cmath>
namespace cg = cooperative_groups;
#define CE_(a, b) do { const float t_ = fmaxf(a, b); b = fminf(a, b); a = t_; } while (0)
#define SORT16_DESC(V, O) do { CE_(V[(O)+0], V[(O)+1]); CE_(V[(O)+2], V[(O)+3]); CE_(V[(O)+0], V[(O)+2]); CE_(V[(O)+1], V[(O)+3]); CE_(V[(O)+1], V[(O)+2]); CE_(V[(O)+4], V[(O)+5]); CE_(V[(O)+6], V[(O)+7]); CE_(V[(O)+4], V[(O)+6]); CE_(V[(O)+5], V[(O)+7]); CE_(V[(O)+5], V[(O)+6]); CE_(V[(O)+0], V[(O)+4]); CE_(V[(O)+2], V[(O)+6]); CE_(V[(O)+2], V[(O)+4]); CE_(V[(O)+1], V[(O)+5]); CE_(V[(O)+3], V[(O)+7]); CE_(V[(O)+3], V[(O)+5]); CE_(V[(O)+1], V[(O)+2]); CE_(V[(O)+3], V[(O)+4]); CE_(V[(O)+5], V[(O)+6]); CE_(V[(O)+8], V[(O)+9]); CE_(V[(O)+10], V[(O)+11]); CE_(V[(O)+8], V[(O)+10]); CE_(V[(O)+9], V[(O)+11]); CE_(V[(O)+9], V[(O)+10]); CE_(V[(O)+12], V[(O)+13]); CE_(V[(O)+14], V[(O)+15]); CE_(V[(O)+12], V[(O)+14]); CE_(V[(O)+13], V[(O)+15]); CE_(V[(O)+13], V[(O)+14]); CE_(V[(O)+8], V[(O)+12]); CE_(V[(O)+10], V[(O)+14]); CE_(V[(O)+10], V[(O)+12]); CE_(V[(O)+9], V[(O)+13]); CE_(V[(O)+11], V[(O)+15]); CE_(V[(O)+11], V[(O)+13]); CE_(V[(O)+9], V[(O)+10]); CE_(V[(O)+11], V[(O)+12]); CE_(V[(O)+13], V[(O)+14]); CE_(V[(O)+0], V[(O)+8]); CE_(V[(O)+4], V[(O)+12]); CE_(V[(O)+4], V[(O)+8]); CE_(V[(O)+2], V[(O)+10]); CE_(V[(O)+6], V[(O)+14]); CE_(V[(O)+6], V[(O)+10]); CE_(V[(O)+2], V[(O)+4]); CE_(V[(O)+6], V[(O)+8]); CE_(V[(O)+10], V[(O)+12]); CE_(V[(O)+1], V[(O)+9]); CE_(V[(O)+5], V[(O)+13]); CE_(V[(O)+5], V[(O)+9]); CE_(V[(O)+3], V[(O)+11]); CE_(V[(O)+7], V[(O)+15]); CE_(V[(O)+7], V[(O)+11]); CE_(V[(O)+3], V[(O)+5]); CE_(V[(O)+7], V[(O)+9]); CE_(V[(O)+11], V[(O)+13]); CE_(V[(O)+1], V[(O)+2]); CE_(V[(O)+3], V[(O)+4]); CE_(V[(O)+5], V[(O)+6]); CE_(V[(O)+7], V[(O)+8]); CE_(V[(O)+9], V[(O)+10]); CE_(V[(O)+11], V[(O)+12]); CE_(V[(O)+13], V[(O)+14]); } while (0)
#define BITONIC16_DESC(V, O) do { CE_(V[(O)+0], V[(O)+8]); CE_(V[(O)+1], V[(O)+9]); CE_(V[(O)+2], V[(O)+10]); CE_(V[(O)+3], V[(O)+11]); CE_(V[(O)+4], V[(O)+12]); CE_(V[(O)+5], V[(O)+13]); CE_(V[(O)+6], V[(O)+14]); CE_(V[(O)+7], V[(O)+15]); CE_(V[(O)+0], V[(O)+4]); CE_(V[(O)+1], V[(O)+5]); CE_(V[(O)+2], V[(O)+6]); CE_(V[(O)+3], V[(O)+7]); CE_(V[(O)+8], V[(O)+12]); CE_(V[(O)+9], V[(O)+13]); CE_(V[(O)+10], V[(O)+14]); CE_(V[(O)+11], V[(O)+15]); CE_(V[(O)+0], V[(O)+2]); CE_(V[(O)+1], V[(O)+3]); CE_(V[(O)+4], V[(O)+6]); CE_(V[(O)+5], V[(O)+7]); CE_(V[(O)+8], V[(O)+10]); CE_(V[(O)+9], V[(O)+11]); CE_(V[(O)+12], V[(O)+14]); CE_(V[(O)+13], V[(O)+15]); CE_(V[(O)+0], V[(O)+1]); CE_(V[(O)+2], V[(O)+3]); CE_(V[(O)+4], V[(O)+5]); CE_(V[(O)+6], V[(O)+7]); CE_(V[(O)+8], V[(O)+9]); CE_(V[(O)+10], V[(O)+11]); CE_(V[(O)+12], V[(O)+13]); CE_(V[(O)+14], V[(O)+15]); } while (0)
namespace pg8 {
#define PG8_LAS __attribute__((address_space(3)))
typedef unsigned short bf16_t;
typedef short bf16x8 __attribute__((ext_vector_type(8)));
typedef float f32x4 __attribute__((ext_vector_type(4)));
typedef unsigned u32x4 __attribute__((ext_vector_type(4)));
constexpr int BM = 256, BK = 64, HALF = 128, HTB = HALF * BK * 2  , STAGE_BYTES = 8 * HTB, NXCD = 8, WGM = 8;

__host__ __device__ __forceinline__ int lds_byte(int r, int c) { const int st = (r >> 4) * 2 + (c >> 5), rr = r & 15, cc = c & 31, ob = rr * 64 + cc * 2; return st * 1024 + (ob ^ (((ob >> 9) & 1) << 5)); }
__host__ __device__ __forceinline__ void stage_rc(int b, int& R, int& C) { const int st = b / 1024, sb = b % 1024, swz = sb ^ (((sb >> 9) & 1) << 5); R = (st >> 1) * 16 + swz / 64; C = (st & 1) * 32 + (swz % 64) / 2; }
__host__ __device__ __forceinline__ int perm32(int rho) { const int n = rho >> 4, i = rho & 15; return 8 * (i >> 2) + 4 * n + (i & 3); }

struct Unit { int pm, pn; };
struct Gemm { const bf16_t* A; const bf16_t* Bt; int M, N, K; };

struct StaticOrder {
    int nM, nN, nwg, G, c;
    __host__ __device__ void init(int M, int N, int G_, int c_) { nM = M / BM; nN = N / BM; nwg = nM * nN; G = G_; c = c_; }
    __host__ __device__ bool next(int i, Unit& u) const {
        const long L = (long)i * G + c; if (L >= nwg) return false;
        int wgid = (int)L; { const int q = nwg / NXCD, r = nwg % NXCD, xcd = wgid % NXCD, off = wgid / NXCD; wgid = (xcd < r ? xcd * (q + 1) : r * (q + 1) + (xcd - r) * q) + off; }
        const int nig = WGM * nN, gid = wgid / nig, fm = gid * WGM, gsz = (nM - fm) < WGM ? (nM - fm) : WGM;
        u.pm = fm + ((wgid % nig) % gsz); u.pn = (wgid % nig) / gsz; return true;
    }
    __device__ __forceinline__ void a_ready(const Unit&) const {}
    __device__ __forceinline__ void done(const Unit&) const {}
};

__device__ __forceinline__ unsigned cvt_pk_bf16(float lo, float hi) { unsigned r; asm volatile("v_cvt_pk_bf16_f32 %0, %1, %2" : "=v"(r) : "v"(lo), "v"(hi)); return r; }
typedef float f32x2 __attribute__((ext_vector_type(2)));
__device__ __forceinline__ f32x2 gelu_pk(f32x2 v) {
    const f32x2 av = __builtin_elementwise_abs(v), d = av * 0.2316418882f + 1.0f;
    f32x2 t; t.x = __builtin_amdgcn_rcpf(d.x); t.y = __builtin_amdgcn_rcpf(d.y);
    f32x2 q = t * 0.5307027145f + (-0.7265760135f); q = q * t + 0.7107068705f; q = q * t + (-0.142248368f); q = q * t + 0.127414796f; q = q * t;
    const f32x2 s = (v * v) * (-0.72134752044f);
    f32x2 e; e.x = __builtin_amdgcn_exp2f(s.x); e.y = __builtin_amdgcn_exp2f(s.y);
    const f32x2 m = v * (q * e), r = v - m;
    f32x2 o; o.x = v.x < 0.f ? m.x : r.x; o.y = v.y < 0.f ? m.y : r.y; return o;
}

template <int ACT  > struct EpiBf16 {
    static constexpr bool PERM = true, AFTER_DRAIN = false; static_assert(ACT == 0 || ACT == 1, "EpiBf16: ACT is 0 (none) or 1 (gelu_pk)");
    bf16_t* O; int ldc; const float* bias; int split_cols; size_t split_stride; float scale0;
    __device__ __forceinline__ void operator()(const f32x4 (&acc)[2][2][4][2], const Unit& u, int wr, int wc, int fr, int fq) const {
        const int row0 = u.pm * BM + wr * 64 + fr; int colt = u.pn * BM; bf16_t* base = O;
        float sc = 1.f; if (split_cols) { const int t = colt / split_cols; base += (size_t)t * split_stride; colt -= t * split_cols; if (t == 0) sc = scale0; }
        const int col0 = colt + wc * 32 + 8 * fq, bcol0 = u.pn * BM + wc * 32 + 8 * fq;
        f32x4 bv[2][2];
#pragma unroll
        for (int bj = 0; bj < 2; ++bj)
#pragma unroll
            for (int n = 0; n < 2; ++n) bv[bj][n] = bias ? *(const f32x4*)(bias + bcol0 + bj * HALF + 4 * n) : (f32x4){0.f, 0.f, 0.f, 0.f};
#pragma unroll
        for (int ai = 0; ai < 2; ++ai)
#pragma unroll
            for (int m = 0; m < 4; ++m) { bf16_t* rowp = base + (size_t)(row0 + ai * HALF + m * 16) * ldc + col0;
#pragma unroll
                for (int bj = 0; bj < 2; ++bj) { f32x4 v0 = acc[ai][bj][m][0] + bv[bj][0], v1 = acc[ai][bj][m][1] + bv[bj][1];
                    if (ACT == 1) { f32x2 a = gelu_pk((f32x2){v0[0], v0[1]}), b = gelu_pk((f32x2){v0[2], v0[3]}), c = gelu_pk((f32x2){v1[0], v1[1]}), d = gelu_pk((f32x2){v1[2], v1[3]});
                        v0 = (f32x4){a.x, a.y, b.x, b.y}; v1 = (f32x4){c.x, c.y, d.x, d.y}; }
                    v0 = v0 * sc; v1 = v1 * sc; u32x4 w; w.x = cvt_pk_bf16(v0[0], v0[1]); w.y = cvt_pk_bf16(v0[2], v0[3]); w.z = cvt_pk_bf16(v1[0], v1[1]); w.w = cvt_pk_bf16(v1[2], v1[3]);
                    *(u32x4*)(rowp + bj * HALF) = w; } }
    }
};
template <class Epi, class Sched, bool ALIGN_EPI = false, bool SP2 = false>
__device__ __forceinline__ void gemm_phase(PG8_LAS unsigned char* lds, const Gemm g, const Sched& S, const Epi& E) {
    int tid = threadIdx.x; asm volatile("" : "+v"(tid));
    const int wid = __builtin_amdgcn_readfirstlane(tid >> 6), lane = tid & 63, wr = wid >> 2, wc = wid & 3, fr = lane & 15, fq = lane >> 4;
    const int K = g.K, nt = K / BK;
    unsigned voffA[2], voffB[2];
#pragma unroll
    for (int i = 0; i < 2; ++i) { int R, C; stage_rc(tid * 16 + i * 8192, R, C); const int Rb = Epi::PERM ? ((R & ~31) + perm32(R & 31)) : R;
        voffA[i] = (unsigned)(R * K + C) * 2u; voffB[i] = (unsigned)(Rb * K + C) * 2u; }
    const size_t kstep = (size_t)(BK * 2);
    const size_t hstep = (size_t)HALF * K * 2;
    const size_t tstep = 2 * hstep;
    const unsigned ldsw = (unsigned)wid * 1024u;
    const int aoff = lds_byte(wr * 64 + fr, fq * 8), boff = lds_byte(wc * 32 + fr, fq * 8);
#define PG8_SA(b, h) (((b) * 2 + (h)) * HTB)
#define PG8_SB(b, h) ((4 + (b) * 2 + (h)) * HTB)
#define PG8_STAGE(bufoff, gbase, voff) do { _Pragma("unroll") for (int _i = 0; _i < 2; ++_i) \
        __builtin_amdgcn_global_load_lds((const unsigned*)((const char*)(gbase) + (voff)[_i]), (PG8_LAS unsigned*)(lds + (bufoff) + ldsw + _i * 8192), 16, 0, 0); } while (0)
#define PG8_LDA(dst, b, h) do { _Pragma("unroll") for (int m = 0; m < 4; ++m) _Pragma("unroll") for (int k = 0; k < 2; ++k) dst[m][k] = *(const PG8_LAS bf16x8*)(lds + PG8_SA(b, h) + aoff + m * 2048 + k * 1024); } while (0)
#define PG8_LDB(dst, b, h) do { _Pragma("unroll") for (int n = 0; n < 2; ++n) _Pragma("unroll") for (int k = 0; k < 2; ++k) dst[n][k] = *(const PG8_LAS bf16x8*)(lds + PG8_SB(b, h) + boff + n * 2048 + k * 1024); } while (0)
#define PG8_MMA(ai, bj, At, Bt) do { __builtin_amdgcn_s_setprio(1); _Pragma("unroll") for (int m = 0; m < 4; ++m) _Pragma("unroll") for (int n = 0; n < 2; ++n) _Pragma("unroll") for (int k = 0; k < 2; ++k) \
        acc[ai][bj][m][n] = __builtin_amdgcn_mfma_f32_16x16x32_bf16(Bt[n][k], At[m][k], acc[ai][bj][m][n], 0, 0, 0); __builtin_amdgcn_s_setprio(0); } while (0)
#define PG8_WAIT_V(n) asm volatile("s_waitcnt vmcnt(" #n ")" ::: "memory")
#define PG8_WAIT_L(n) asm volatile("s_waitcnt lgkmcnt(" #n ")" ::: "memory")
#define PG8_BAR __builtin_amdgcn_s_barrier()
#define PG8_SCHED __builtin_amdgcn_sched_barrier(0)
    Unit cur, nxt; int ui = 0;
    if (!S.next(0, cur)) return;
    f32x4 acc[2][2][4][2];
#pragma unroll
    for (int a = 0; a < 2; ++a)
#pragma unroll
        for (int b = 0; b < 2; ++b)
#pragma unroll
            for (int m = 0; m < 4; ++m)
#pragma unroll
                for (int n = 0; n < 2; ++n) acc[a][b][m][n] = (f32x4){0.f, 0.f, 0.f, 0.f};
    bf16x8 At[4][2], B0[2][2], B1[2][2];
    const char* cA = (const char*)g.A + (size_t)cur.pm * tstep; const char* cB = (const char*)g.Bt + (size_t)cur.pn * tstep;
    S.a_ready(cur);
    if constexpr (SP2) {
        PG8_STAGE(PG8_SB(0, 0), cB, voffB); PG8_STAGE(PG8_SB(0, 1), cB + hstep, voffB); PG8_STAGE(PG8_SA(0, 0), cA, voffA); PG8_STAGE(PG8_SA(0, 1), cA + hstep, voffA);
        if (wr == 1) PG8_BAR;
        PG8_WAIT_V(2); PG8_BAR;
        PG8_STAGE(PG8_SB(1, 0), cB + kstep, voffB); PG8_STAGE(PG8_SA(1, 0), cA + kstep, voffA); PG8_STAGE(PG8_SB(1, 1), cB + hstep + kstep, voffB);
        PG8_WAIT_V(6); PG8_BAR;
    } else {
        PG8_STAGE(PG8_SB(0, 0), cB, voffB); PG8_STAGE(PG8_SA(0, 0), cA, voffA); PG8_STAGE(PG8_SB(0, 1), cB + hstep, voffB); PG8_STAGE(PG8_SA(0, 1), cA + hstep, voffA);
        if (wr == 1) PG8_BAR;
        PG8_WAIT_V(4); PG8_BAR;
        PG8_STAGE(PG8_SB(1, 0), cB + kstep, voffB); PG8_STAGE(PG8_SA(1, 0), cA + kstep, voffA); PG8_STAGE(PG8_SB(1, 1), cB + hstep + kstep, voffB);
        PG8_WAIT_V(6); PG8_BAR;
    }
    for (;;) {
        const bool has_next = S.next(ui + 1, nxt);
        const char* nA = has_next ? (const char*)g.A + (size_t)nxt.pm * tstep : cA; const char* nB = has_next ? (const char*)g.Bt + (size_t)nxt.pn * tstep : cB;
        for (int t = 0; t < nt; t += 2) {
            const bool last = (t == nt - 2);
            const char* a1 = cA + (size_t)(t + 1) * kstep;
            const char* a2 = last ? nA : cA + (size_t)(t + 2) * kstep; const char* b2 = last ? nB : cB + (size_t)(t + 2) * kstep;
            const char* a3 = a2 + kstep; const char* b3 = b2 + kstep;
            if (last && has_next) S.a_ready(nxt);
            if constexpr (SP2) {
            PG8_LDB(B0, 0, 0); PG8_LDB(B1, 0, 1); PG8_SCHED; PG8_LDA(At, 0, 0); PG8_STAGE(PG8_SA(1, 1), a1 + hstep, voffA);
            PG8_WAIT_V(8); PG8_WAIT_L(0); PG8_BAR; PG8_MMA(0, 0, At, B0); PG8_MMA(0, 1, At, B1); PG8_BAR; PG8_SCHED;
            PG8_LDA(At, 0, 1); PG8_STAGE(PG8_SB(0, 0), b2, voffB); PG8_STAGE(PG8_SB(0, 1), b2 + hstep, voffB); PG8_STAGE(PG8_SA(0, 0), a2, voffA);
            PG8_WAIT_V(8); PG8_WAIT_L(0); PG8_BAR; PG8_MMA(1, 0, At, B0); PG8_MMA(1, 1, At, B1); PG8_BAR; PG8_SCHED;
            PG8_LDB(B0, 1, 0); PG8_LDB(B1, 1, 1); PG8_SCHED; PG8_LDA(At, 1, 0); PG8_STAGE(PG8_SA(0, 1), a2 + hstep, voffA);
            PG8_WAIT_V(8); PG8_WAIT_L(0); PG8_BAR; PG8_MMA(0, 0, At, B0); PG8_MMA(0, 1, At, B1); PG8_BAR; PG8_SCHED;
            PG8_LDA(At, 1, 1); PG8_STAGE(PG8_SB(1, 0), b3, voffB); PG8_STAGE(PG8_SB(1, 1), b3 + hstep, voffB); PG8_STAGE(PG8_SA(1, 0), a3, voffA);
            PG8_WAIT_V(8); PG8_WAIT_L(0); PG8_BAR; PG8_MMA(1, 0, At, B0); PG8_MMA(1, 1, At, B1); PG8_BAR; PG8_SCHED;
            } else {
            PG8_LDB(B0, 0, 0); PG8_SCHED; PG8_LDA(At, 0, 0); PG8_STAGE(PG8_SA(1, 1), a1 + hstep, voffA);
            PG8_WAIT_L(8); PG8_BAR; PG8_WAIT_L(0); PG8_MMA(0, 0, At, B0); PG8_BAR; PG8_SCHED;
            PG8_LDB(B1, 0, 1); PG8_STAGE(PG8_SB(0, 0), b2, voffB);
            PG8_BAR; PG8_WAIT_L(0); PG8_MMA(0, 1, At, B1); PG8_BAR;
            PG8_LDA(At, 0, 1); PG8_STAGE(PG8_SA(0, 0), a2, voffA);
            PG8_BAR; PG8_WAIT_L(0); PG8_MMA(1, 0, At, B0); PG8_BAR; PG8_SCHED;
            PG8_STAGE(PG8_SB(0, 1), b2 + hstep, voffB);
            PG8_WAIT_V(6); PG8_BAR; PG8_MMA(1, 1, At, B1); PG8_BAR;
            PG8_LDB(B0, 1, 0); PG8_SCHED; PG8_LDA(At, 1, 0); PG8_STAGE(PG8_SA(0, 1), a2 + hstep, voffA);
            PG8_WAIT_L(8); PG8_BAR; PG8_WAIT_L(0); PG8_MMA(0, 0, At, B0); PG8_BAR; PG8_SCHED;
            PG8_LDB(B1, 1, 1); PG8_STAGE(PG8_SB(1, 0), b3, voffB);
            PG8_BAR; PG8_WAIT_L(0); PG8_MMA(0, 1, At, B1); PG8_BAR;
            PG8_LDA(At, 1, 1); PG8_STAGE(PG8_SA(1, 0), a3, voffA);
            PG8_BAR; PG8_WAIT_L(0); PG8_MMA(1, 0, At, B0); PG8_BAR; PG8_SCHED;
            PG8_STAGE(PG8_SB(1, 1), b3 + hstep, voffB);
            PG8_WAIT_V(6); PG8_BAR; PG8_MMA(1, 1, At, B1); PG8_BAR;
            }
        }
        if constexpr (ALIGN_EPI) { if (wr == 0) PG8_BAR; }
        if constexpr (!Epi::AFTER_DRAIN) { E(acc, cur, wr, wc, fr, fq); S.done(cur); }
        if (!has_next) break;
#pragma unroll
        for (int a = 0; a < 2; ++a)
#pragma unroll
            for (int b = 0; b < 2; ++b)
#pragma unroll
                for (int m = 0; m < 4; ++m)
#pragma unroll
                    for (int n = 0; n < 2; ++n) acc[a][b][m][n] = (f32x4){0.f, 0.f, 0.f, 0.f};
        cur = nxt; cA = nA; cB = nB; ++ui;
        if constexpr (ALIGN_EPI) { if (wr == 1) PG8_BAR; }
    }
    PG8_WAIT_V(0);
    if constexpr (!ALIGN_EPI) { if (wr == 0) PG8_BAR; }
    PG8_BAR;
    if constexpr (Epi::AFTER_DRAIN) { E.fused(acc, cur, wr, wc, fr, fq, lds, wid, lane); S.done(cur); }
#undef PG8_SA
#undef PG8_SB
#undef PG8_STAGE
#undef PG8_LDA
#undef PG8_LDB
#undef PG8_MMA
#undef PG8_WAIT_V
#undef PG8_WAIT_L
#undef PG8_BAR
#undef PG8_SCHED
}
}

#define LAS __attribute__((address_space(3)))
typedef unsigned short bf16_t;
typedef short bf16x8 __attribute__((ext_vector_type(8)));
typedef short s16x4 __attribute__((ext_vector_type(4)));
typedef float f32x4 __attribute__((ext_vector_type(4)));
typedef float f32x16 __attribute__((ext_vector_type(16)));
typedef unsigned u32x4 __attribute__((ext_vector_type(4)));
typedef unsigned u32x2 __attribute__((ext_vector_type(2)));

constexpr int DM = 1024;
constexpr int NP = 16 * 2048;
constexpr int NS = 8 * 64;
constexpr int NT = NP + NS;
constexpr int DIN = 2560;
constexpr int SKV = 2112;
constexpr float EPS = 1e-6f;
constexpr float LOG2E = 1.4426950408889634f;
constexpr float QSCALE = 0.125f * LOG2E;

constexpr long OUT_Y = 0;
constexpr long OUT_KP = 34078720L, OUT_VP = 50855936L, OUT_CONVP = 67633152L, OUT_KS = 67878912L, OUT_VS = 68141056L, OUT_CONVS = 68403200L, OUT_TOTAL = 68526080L;

constexpr size_t MiB = 1u << 20;
constexpr size_t WS_CTL = 0, CTL_BYTES = 1 * MiB;
constexpr size_t WS_WINT = 1 * MiB;
constexpr size_t WS_WOUTT = 6 * MiB;
constexpr size_t WS_WQT = 8 * MiB;
constexpr size_t WS_SK = 12 * MiB;
constexpr size_t WS_PU8 = 16 * MiB;
constexpr size_t WS_PV8 = 32 * MiB;
constexpr size_t WS_SCU = 48 * MiB;
constexpr size_t WS_SCV = 49 * MiB;
constexpr size_t WS_KS = 80 * MiB;
constexpr size_t WS_VS = 97 * MiB;
constexpr size_t WS_H = 114 * MiB;
constexpr size_t WS_A = 179 * MiB;
constexpr size_t WS_Q = 212 * MiB;
constexpr size_t WS_QP = 114 * MiB;
constexpr size_t WS_KP = 245 * MiB;
constexpr size_t WS_VP = 277 * MiB;
constexpr size_t WS_MIX = 309 * MiB;
constexpr size_t WS_H2 = 309 * MiB;
constexpr size_t WS_TK = 375 * MiB;
constexpr size_t WS_IDX = 408 * MiB;
constexpr size_t WS_GATE = 425 * MiB;
constexpr size_t WS_PACT = 114 * MiB;
constexpr size_t WS_COEF = 375 * MiB;
constexpr size_t WS_XG = 442 * MiB;
constexpr size_t WS_SSQ = 507 * MiB;
constexpr size_t WS_RSTD = 510 * MiB;
constexpr size_t WS_END = 511 * MiB;
static_assert(WS_H + (size_t)NT * 1024 * 2 <= WS_A && WS_A + (size_t)NT * 512 * 2 <= WS_Q && WS_Q + (size_t)NT * 512 * 2 <= WS_KP, "R1");
static_assert(WS_QP + (size_t)NT * 2048 * 2 <= WS_KP && WS_KP + (size_t)NP * 512 * 2 <= WS_VP && WS_VP + (size_t)NP * 512 * 2 <= WS_MIX, "ws map");
static_assert(WS_MIX + (size_t)NT * 1024 * 2 <= WS_TK && WS_TK + (size_t)NT * 256 * 4 <= WS_IDX && WS_IDX + (size_t)NT * 128 * 4 <= WS_GATE && WS_GATE + (size_t)NT * 128 * 4 <= WS_END, "ws map 2");
static_assert(WS_KS + (size_t)8 * SKV * 512 * 2 <= WS_VS && WS_VS + (size_t)8 * SKV * 512 * 2 <= WS_H, "ws map 3");

constexpr int RING_BYTES = 131072;
constexpr int BIAS_OFF = RING_BYTES;
constexpr int MISC_OFF = RING_BYTES + 5120;
constexpr int LDS_BYTES = MISC_OFF + 1024;

struct Params {
    const float* in[24];
    float* out;
    unsigned char* ws;
};

__device__ __forceinline__ unsigned cvtpk(float lo, float hi) { return pg8::cvt_pk_bf16(lo, hi); }
__device__ __forceinline__ float bflo(unsigned w) { return __uint_as_float(w << 16); }
__device__ __forceinline__ float bfhi(unsigned w) { return __uint_as_float(w & 0xffff0000u); }
__device__ __forceinline__ float wave_sum(float v) {
#pragma unroll
    for (int o = 1; o < 64; o <<= 1) v += __shfl_xor(v, o);
    return v;
}
typedef float f32x2 __attribute__((ext_vector_type(2)));
#define DPP_ADD(v, ctrl) v += __builtin_bit_cast(float, __builtin_amdgcn_update_dpp(0, __builtin_bit_cast(int, v), ctrl, 0xf, 0xf, true))
__device__ __forceinline__ float rl_f(float v, int l) { return __uint_as_float(__builtin_amdgcn_readlane(__float_as_uint(v), l)); }
__device__ __forceinline__ float wave_total(float v) {
    DPP_ADD(v, 0xB1); DPP_ADD(v, 0x4E); DPP_ADD(v, 0x141); DPP_ADD(v, 0x140);
    return (rl_f(v, 0) + rl_f(v, 16)) + (rl_f(v, 32) + rl_f(v, 48));
}
typedef __bf16 bf16x2_t __attribute__((ext_vector_type(2)));
__device__ __forceinline__ float dot2(unsigned a, unsigned b, float acc) {
    return __builtin_amdgcn_fdot2_f32_bf16(__builtin_bit_cast(bf16x2_t, a), __builtin_bit_cast(bf16x2_t, b), acc, false);
}
#define LDS_WAIT() asm volatile("s_waitcnt lgkmcnt(0)" ::: "memory")

#define XB_TMO      128
#define XB_XCNT(j)  (256  + 64 * (j))
#define XB_XSUB(j)  (1280 + 64 * (j))
#define XB_XGEN(j)  (2304 + 64 * (j))
#define XB_TOP      3328
#define XB_TOPGEN   3392
#define XCD_BAR_WORDS 3456
#define XB_SPIN_CAP (1u << 18)

__device__ __forceinline__ unsigned xb_ld(unsigned* p)              { return __hip_atomic_load(p, __ATOMIC_RELAXED, __HIP_MEMORY_SCOPE_AGENT); }
__device__ __forceinline__ unsigned xb_add(unsigned* p, unsigned v) { return __hip_atomic_fetch_add(p, v, __ATOMIC_RELAXED, __HIP_MEMORY_SCOPE_AGENT); }
__device__ __forceinline__ unsigned xb_xcc_id() { return (unsigned)__builtin_amdgcn_s_getreg((3 << 11) | 20) & 0xFu; }
#define XB_SPIN(cond, bar) do { unsigned _sp = 0; while (cond) { __builtin_amdgcn_s_sleep(1); \
    if ((++_sp & 255u) == 0u) { if (xb_ld(&(bar)[XB_TMO])) break; if (_sp > XB_SPIN_CAP) { atomicAdd(&(bar)[XB_TMO], 1u); break; } } } } while (0)

struct XcdBarrier {
    unsigned* bar; unsigned x;
    volatile LAS unsigned* st;
};

__device__ __forceinline__ XcdBarrier xcd_barrier_post(unsigned* bar, volatile LAS unsigned* st) {
    XcdBarrier b; b.bar = bar; b.x = xb_xcc_id(); b.st = st;
    if (threadIdx.x == 0) (void)xb_add(&bar[XB_XCNT(b.x)], 1u);
    return b;
}
__device__ __forceinline__ void xcd_barrier_complete(unsigned* bar, unsigned x, unsigned& nloc, unsigned& nx) {
    const unsigned G = gridDim.x * gridDim.y * gridDim.z;
    unsigned sum, cnt, mine, sp = 0u;
    for (;;) {
        sum = 0u; cnt = 0u; mine = 0u;
#pragma unroll
        for (unsigned j = 0; j < 16; ++j) { const unsigned c = xb_ld(&bar[XB_XCNT(j)]); sum += c; cnt += (c > 0u) ? 1u : 0u; mine = (j == x) ? c : mine; }
        if (sum == G) break;
        __builtin_amdgcn_s_sleep(1);
        if ((++sp & 255u) == 0u) { if (xb_ld(&bar[XB_TMO])) break; if (sp > XB_SPIN_CAP) { atomicAdd(&bar[XB_TMO], 1u); break; } }
    }
    nloc = mine > 0u ? mine : 1u; nx = cnt > 0u ? cnt : 1u;
}

__device__ __forceinline__ void xcd_barrier(const XcdBarrier& b) {
    asm volatile("s_waitcnt vmcnt(0)" ::: "memory");
    __syncthreads();
    if (threadIdx.x == 0) {
        unsigned* bar = b.bar;
        __builtin_amdgcn_s_waitcnt(0);
        unsigned nloc = b.st[0], nx = b.st[1];
        if (nloc == 0u) { xcd_barrier_complete(bar, b.x, nloc, nx); b.st[0] = nloc; b.st[1] = nx; }
        const unsigned old = xb_add(&bar[XB_XSUB(b.x)], 1u);
        const unsigned gen = old / nloc;
        if (old + 1u == (gen + 1u) * nloc) {
            __builtin_amdgcn_fence(__ATOMIC_RELEASE, "agent");
            asm volatile("s_waitcnt vmcnt(0)" ::: "memory");
            const unsigned og = xb_add(&bar[XB_TOP], 1u);
            const unsigned tg = og / nx;
            if (og + 1u == (tg + 1u) * nx) xb_add(&bar[XB_TOPGEN], 1u);
            else XB_SPIN(xb_ld(&bar[XB_TOPGEN]) == tg, bar);
            __builtin_amdgcn_fence(__ATOMIC_ACQUIRE, "agent");
            xb_add(&bar[XB_XGEN(b.x)], 1u);
            asm volatile("s_waitcnt vmcnt(0)" ::: "memory");
        } else {
            XB_SPIN(xb_ld(&bar[XB_XGEN(b.x)]) == gen, bar);
            __builtin_amdgcn_fence(__ATOMIC_ACQUIRE, "agent");
            asm volatile("s_waitcnt vmcnt(0)" ::: "memory");
        }
    }
    __syncthreads();
}


namespace pg8 {
__device__ __forceinline__ u32x2 pack4(f32x4 v) { u32x2 w; w.x = cvt_pk_bf16(v[0], v[1]); w.y = cvt_pk_bf16(v[2], v[3]); return w; }
struct EpiProj {
    static constexpr bool PERM = true, AFTER_DRAIN = false;
    bf16_t* A; bf16_t* Q; bf16_t* KP; bf16_t* VP; bf16_t* KS; bf16_t* VS; float* out;
    __device__ __forceinline__ void operator()(const f32x4 (&acc)[2][2][4][2], const Unit& u, int wr, int wc, int fr, int fq) const {
        const int pn = u.pn;
        const int row0 = u.pm * BM + wr * 64 + fr;
        if (pn < 4) {
#pragma unroll
            for (int ai = 0; ai < 2; ++ai)
#pragma unroll
                for (int m = 0; m < 4; ++m) {
                    const int row = row0 + ai * HALF + m * 16;
                    long toff = -1;
                    if (row < NP) { const int s = row & 2047; if (s >= 2018) toff = OUT_CONVP + ((long)(row >> 11) * 30 + (s - 2018)) * 512; }
                    else { const int rr = row - NP; const int i = rr & 63; if (i >= 34) toff = OUT_CONVS + ((long)(rr >> 6) * 30 + (i - 34)) * 512; }
                    const int c = 128 * pn + 32 * wc + 8 * fq;
                    f32x4 a[2];
#pragma unroll
                    for (int n = 0; n < 2; ++n) {
                        const f32x4 x = acc[ai][0][m][n], g = acc[ai][1][m][n];
#pragma unroll
                        for (int j = 0; j < 4; ++j) a[n][j] = x[j] / (1.f + __expf(-g[j]));
                    }
                    u32x4 w; w.x = cvt_pk_bf16(a[0][0], a[0][1]); w.y = cvt_pk_bf16(a[0][2], a[0][3]); w.z = cvt_pk_bf16(a[1][0], a[1][1]); w.w = cvt_pk_bf16(a[1][2], a[1][3]);
                    *(u32x4*)(A + (size_t)row * 512 + c) = w;
                    if (toff >= 0) { *(f32x4*)(out + toff + c) = a[0]; *(f32x4*)(out + toff + c + 4) = a[1]; }
                }
        } else {
            const int sec = (pn - 4) >> 1, colbase = ((pn - 4) & 1) * 256;
#pragma unroll
            for (int ai = 0; ai < 2; ++ai)
#pragma unroll
                for (int m = 0; m < 4; ++m) {
                    const int row = row0 + ai * HALF + m * 16;
                    const bool isp = row < NP; const int rr = row - NP;
                    bf16_t* bdst; float* fdst;
                    if (sec == 0) { bdst = Q + (size_t)row * 512; fdst = nullptr; }
                    else if (sec == 1) { bdst = isp ? KP + (size_t)row * 512 : KS + ((size_t)(rr >> 6) * SKV + 2048 + (rr & 63)) * 512; fdst = isp ? out + OUT_KP + (size_t)row * 512 : out + OUT_KS + (size_t)rr * 512; }
                    else { bdst = isp ? VP + (size_t)row * 512 : VS + ((size_t)(rr >> 6) * SKV + 2048 + (rr & 63)) * 512; fdst = isp ? out + OUT_VP + (size_t)row * 512 : out + OUT_VS + (size_t)rr * 512; }
#pragma unroll
                    for (int bj = 0; bj < 2; ++bj) {
                        const int col = colbase + 128 * bj + 32 * wc + 8 * fq;
                        const f32x4 v0 = acc[ai][bj][m][0], v1 = acc[ai][bj][m][1];
                        if (sec == 0) { const f32x4 s0 = v0 * QSCALE, s1 = v1 * QSCALE; u32x4 w; w.x = cvt_pk_bf16(s0[0], s0[1]); w.y = cvt_pk_bf16(s0[2], s0[3]); w.z = cvt_pk_bf16(s1[0], s1[1]); w.w = cvt_pk_bf16(s1[2], s1[3]); *(u32x4*)(bdst + col) = w; }
                        else { u32x4 w; w.x = cvt_pk_bf16(v0[0], v0[1]); w.y = cvt_pk_bf16(v0[2], v0[3]); w.z = cvt_pk_bf16(v1[0], v1[1]); w.w = cvt_pk_bf16(v1[2], v1[3]); *(u32x4*)(bdst + col) = w;
                               __builtin_nontemporal_store(v0, (f32x4*)(fdst + col)); __builtin_nontemporal_store(v1, (f32x4*)(fdst + col + 4)); }
                    }
                }
        }
    }
};
struct EpiRes {
    static constexpr bool PERM = true, AFTER_DRAIN = false;
    const float* xp; const float* xs; float* out; bf16_t* xg; const float* gff; float* ssq;
    __device__ __forceinline__ void operator()(const f32x4 (&acc)[2][2][4][2], const Unit& u, int wr, int wc, int fr, int fq) const {
        const int row0 = u.pm * BM + wr * 64 + fr;
        f32x4 gg[2][2];
#pragma unroll
        for (int bj = 0; bj < 2; ++bj)
#pragma unroll
            for (int n = 0; n < 2; ++n) gg[bj][n] = *(const f32x4*)(gff + u.pn * BM + 128 * bj + 32 * wc + 8 * fq + 4 * n);
#pragma unroll
        for (int ai = 0; ai < 2; ++ai)
#pragma unroll
            for (int m = 0; m < 4; ++m) {
                const int row = row0 + ai * HALF + m * 16;
                const float* xr = row < NP ? xp + (size_t)row * DM : xs + (size_t)(row - NP) * DM;
                float* orow = out + (size_t)row * DM; bf16_t* grow = xg + (size_t)row * DM;
                float sq = 0.f;
#pragma unroll
                for (int bj = 0; bj < 2; ++bj) {
                    const int col = u.pn * BM + 128 * bj + 32 * wc + 8 * fq;
                    const f32x4 v0 = *(const f32x4*)(xr + col) + acc[ai][bj][m][0], v1 = *(const f32x4*)(xr + col + 4) + acc[ai][bj][m][1];
                    *(f32x4*)(orow + col) = v0; *(f32x4*)(orow + col + 4) = v1;
                    const f32x4 h0 = v0 * gg[bj][0], h1 = v1 * gg[bj][1];
                    u32x4 w; w.x = cvt_pk_bf16(h0[0], h0[1]); w.y = cvt_pk_bf16(h0[2], h0[3]); w.z = cvt_pk_bf16(h1[0], h1[1]); w.w = cvt_pk_bf16(h1[2], h1[3]);
                    *(u32x4*)(grow + col) = w;
                    sq += ((v0[0] * v0[0] + v0[1] * v0[1]) + (v0[2] * v0[2] + v0[3] * v0[3])) + ((v1[0] * v1[0] + v1[1] * v1[1]) + (v1[2] * v1[2] + v1[3] * v1[3]));
                }
                sq += __shfl_xor(sq, 16); sq += __shfl_xor(sq, 32);
                if (fq == 0) ssq[(size_t)row * 16 + u.pn * 4 + wc] = sq;
            }
    }
};
}

__device__ __forceinline__ int winrow(int n) { return n < 1024 ? (256 * ((n & 511) >> 7) + 128 * (n >> 9) + (n & 127)) : n; }
template <bool WIN> __device__ __forceinline__ void transpose_item(const float* W, int K, int N, bf16_t* WT, LAS float* scr, int item, int lane) {
    const int nblk = N / 32, kb = item / nblk, nb = item % nblk, k0 = 64 * kb, n0 = 32 * nb;
#pragma unroll 8
    for (int i = 0; i < 32; ++i) { const int kk = 2 * i + (lane >> 5); scr[kk * 33 + (lane & 31)] = W[(size_t)(k0 + kk) * N + n0 + (lane & 31)]; }
    LDS_WAIT();
    const int c = lane & 7;
#pragma unroll
    for (int j = 0; j < 4; ++j) {
        const int n = (lane >> 3) + 8 * j; const LAS float* s = scr + (8 * c) * 33 + n;
        u32x4 o; o.x = cvtpk(s[0 * 33], s[1 * 33]); o.y = cvtpk(s[2 * 33], s[3 * 33]); o.z = cvtpk(s[4 * 33], s[5 * 33]); o.w = cvtpk(s[6 * 33], s[7 * 33]);
        const int dr = WIN ? winrow(n0 + n) : (n0 + n);
        *(u32x4*)(WT + (size_t)dr * K + k0 + 8 * c) = o;
    }
    LDS_WAIT();
}
__device__ __forceinline__ void cvt_stream(const float* src, bf16_t* dst, size_t n8, size_t gt, size_t ngt) {
    for (size_t i = gt; i < n8; i += ngt) {
        const f32x4 a = *(const f32x4*)(src + i * 8), b = *(const f32x4*)(src + i * 8 + 4);
        u32x4 o; o.x = cvtpk(a[0], a[1]); o.y = cvtpk(a[2], a[3]); o.z = cvtpk(b[0], b[1]); o.w = cvtpk(b[2], b[3]);
        *(u32x4*)(dst + i * 8) = o;
    }
}
__device__ __forceinline__ void cvt_cache(const float* src, bf16_t* dst, size_t gt, size_t ngt) {
    const size_t n8 = (size_t)8 * 2048 * 512 / 8;
    for (size_t i = gt; i < n8; i += ngt) {
        const size_t e = i * 8; const size_t row = e >> 9, col = e & 511; const size_t drow = (row >> 11) * SKV + (row & 2047);
        const f32x4 a = *(const f32x4*)(src + e), b = *(const f32x4*)(src + e + 4);
        u32x4 o; o.x = cvtpk(a[0], a[1]); o.y = cvtpk(a[2], a[3]); o.z = cvtpk(b[0], b[1]); o.w = cvtpk(b[2], b[3]);
        *(u32x4*)(dst + drow * 512 + col) = o;
    }
}
__device__ __forceinline__ void rms_row_bf16(const float* xrow, const float* g, bf16_t* orow, int lane) {
    const f32x4* xr = (const f32x4*)xrow + lane; const f32x4* gr = (const f32x4*)g + lane;
    f32x4 v[4]; float s = 0.f;
#pragma unroll
    for (int j = 0; j < 4; ++j) { v[j] = xr[64 * j]; s += (v[j][0] * v[j][0] + v[j][1] * v[j][1]) + (v[j][2] * v[j][2] + v[j][3] * v[j][3]); }
    const float rstd = 1.f / sqrtf(wave_sum(s) * (1.f / DM) + EPS);
    u32x2* o8 = (u32x2*)orow + lane;
#pragma unroll
    for (int j = 0; j < 4; ++j) { const f32x4 gg = gr[64 * j]; u32x2 w; w.x = cvtpk(v[j][0] * rstd * gg[0], v[j][1] * rstd * gg[1]); w.y = cvtpk(v[j][2] * rstd * gg[2], v[j][3] * rstd * gg[3]); o8[64 * j] = w; }
}

template <bool SLICED> __device__ __forceinline__ void cvt_row_fp8(const float* src, unsigned char* dst_base, int row, float* scale_out, int lane) {
    const f32x4* xr = (const f32x4*)src + lane;
    f32x4 v[4]; float am = 0.f;
#pragma unroll
    for (int j = 0; j < 4; ++j) { v[j] = xr[64 * j]; am = fmaxf(am, fmaxf(fmaxf(fabsf(v[j][0]), fabsf(v[j][1])), fmaxf(fabsf(v[j][2]), fabsf(v[j][3])))); }
#pragma unroll
    for (int o = 1; o < 64; o <<= 1) am = fmaxf(am, __shfl_xor(am, o));
    const float sc = am > 0.f ? am * (1.f / 448.f) : 1.f, inv = 1.f / sc;
#pragma unroll
    for (int j = 0; j < 4; ++j) {
        const int eb = 256 * j + 4 * lane;
        int w = __builtin_amdgcn_cvt_pk_fp8_f32(v[j][0] * inv, v[j][1] * inv, 0, false);
        w = __builtin_amdgcn_cvt_pk_fp8_f32(v[j][2] * inv, v[j][3] * inv, w, true);
        if (SLICED) *(int*)(dst_base + ((size_t)(eb >> 7) * 16384 + row) * 128 + (eb & 127)) = w;
        else *(int*)(dst_base + (size_t)row * DM + 16 * ((eb & 511) >> 3) + (eb & 7) + (eb >= 512 ? 8 : 0)) = w;
    }
    if (lane == 0) *scale_out = sc;
}

__device__ __forceinline__ void rms_row2_bf16(const float* xa, const float* xb, const float* g, bf16_t* oa, bf16_t* ob, int lane) {
    const f32x4* ra = (const f32x4*)xa + lane; const f32x4* rb = (const f32x4*)xb + lane; const f32x4* gr = (const f32x4*)g + lane;
    f32x4 va[4], vb[4]; float sa = 0.f, sb = 0.f;
#pragma unroll
    for (int j = 0; j < 4; ++j) { va[j] = ra[64 * j]; vb[j] = rb[64 * j]; }
#pragma unroll
    for (int j = 0; j < 4; ++j) { sa += (va[j][0] * va[j][0] + va[j][1] * va[j][1]) + (va[j][2] * va[j][2] + va[j][3] * va[j][3]); sb += (vb[j][0] * vb[j][0] + vb[j][1] * vb[j][1]) + (vb[j][2] * vb[j][2] + vb[j][3] * vb[j][3]); }
    const float ra_ = 1.f / sqrtf(wave_total(sa) * (1.f / DM) + EPS), rb_ = 1.f / sqrtf(wave_total(sb) * (1.f / DM) + EPS);
    u32x2* o8a = (u32x2*)oa + lane; u32x2* o8b = (u32x2*)ob + lane;
#pragma unroll
    for (int j = 0; j < 4; ++j) { const f32x4 gg = gr[64 * j];
        u32x2 w; w.x = cvtpk(va[j][0] * ra_ * gg[0], va[j][1] * ra_ * gg[1]); w.y = cvtpk(va[j][2] * ra_ * gg[2], va[j][3] * ra_ * gg[3]); o8a[64 * j] = w;
        u32x2 z; z.x = cvtpk(vb[j][0] * rb_ * gg[0], vb[j][1] * rb_ * gg[1]); z.y = cvtpk(vb[j][2] * rb_ * gg[2], vb[j][3] * rb_ * gg[3]); o8b[64 * j] = z; }
}
__device__ __forceinline__ void cvt_row_i8(const float* src, unsigned char* dst_base, int row, float* scale_out, int lane) {
    const f32x4* xr = (const f32x4*)src + lane;
    f32x4 v[4]; float am = 0.f;
#pragma unroll
    for (int j = 0; j < 4; ++j) { v[j] = xr[64 * j]; am = fmaxf(am, fmaxf(fmaxf(fabsf(v[j][0]), fabsf(v[j][1])), fmaxf(fabsf(v[j][2]), fabsf(v[j][3])))); }
#pragma unroll
    for (int o = 1; o < 64; o <<= 1) am = fmaxf(am, __shfl_xor(am, o));
    const float sc = am > 0.f ? am * (1.f / 127.f) : 1.f, inv = 1.f / sc;
#pragma unroll
    for (int j = 0; j < 4; ++j) {
        const int eb = 256 * j + 4 * lane;
        const int q0 = __float2int_rn(v[j][0] * inv), q1 = __float2int_rn(v[j][1] * inv), q2 = __float2int_rn(v[j][2] * inv), q3 = __float2int_rn(v[j][3] * inv);
        const unsigned w = (unsigned)(q0 & 255) | ((unsigned)(q1 & 255) << 8) | ((unsigned)(q2 & 255) << 16) | ((unsigned)(q3 & 255) << 24);
        *(unsigned*)(dst_base + ((size_t)(eb >> 7) * 16384 + row) * 128 + (eb & 127)) = w;
    }
    if (lane == 0) *scale_out = sc;
}
__device__ __forceinline__ void phase0(const Params& p, LAS unsigned char* lds, int tid, int lane, int wave) {
    const int gw = blockIdx.x * 8 + wave, NGW = gridDim.x * 8;
    LAS float* scr = (LAS float*)(lds + wave * 16384);
    bf16_t* WINT = (bf16_t*)(p.ws + WS_WINT);
    constexpr int I_IN = 16 * (DIN / 32);
    for (int it = gw; it < I_IN; it += NGW) transpose_item<true>(p.in[6], 1024, DIN, WINT, scr, it, lane);
    bf16_t* H = (bf16_t*)(p.ws + WS_H);
    for (int m = gw; m < NT; m += 2 * NGW) {
        const int m2 = m + NGW < NT ? m + NGW : m;
        const float* xr = m < NP ? p.in[0] + (size_t)m * DM : p.in[1] + (size_t)(m - NP) * DM;
        const float* xr2 = m2 < NP ? p.in[0] + (size_t)m2 * DM : p.in[1] + (size_t)(m2 - NP) * DM;
        rms_row2_bf16(xr, xr2, p.in[5], H + (size_t)m * DM, H + (size_t)m2 * DM, lane);
    }
}
__device__ __forceinline__ void prep_late(const Params& p, LAS unsigned char* lds, int tid, int lane, int wave, int rank, int nparts) {
    const int gw = rank * 8 + wave, NGW = nparts * 8;
    LAS float* scr = (LAS float*)(lds + wave * 16384);
    const size_t gt = (size_t)rank * 512 + tid, ngt = (size_t)nparts * 512;
    cvt_cache(p.in[2], (bf16_t*)(p.ws + WS_KS), gt, ngt);
    cvt_cache(p.in[3], (bf16_t*)(p.ws + WS_VS), gt, ngt);
    bf16_t* WOUTT = (bf16_t*)(p.ws + WS_WOUTT); bf16_t* WQT = (bf16_t*)(p.ws + WS_WQT);
    constexpr int I_OUT = 16 * (1024 / 32), I_Q = 16 * (2048 / 32);
    for (int it = gw; it < I_OUT + I_Q; it += NGW) {
        if (it < I_OUT) transpose_item<false>(p.in[17], 1024, 1024, WOUTT, scr, it, lane);
        else transpose_item<false>(p.in[19], 1024, 2048, WQT, scr, it - I_OUT, lane);
    }
    cvt_stream(p.in[20], (bf16_t*)(p.ws + WS_SK), (size_t)16 * 128 * 128 / 8, gt, ngt);
    for (int r = gw; r < 2 * 16384; r += NGW) {
        const int tb = r >> 14, e = r & 16383;
        if (tb) cvt_row_fp8<true>(p.in[22] + (size_t)e * DM, p.ws + WS_PV8, e, (float*)(p.ws + WS_SCV) + e, lane);
        else cvt_row_i8(p.in[21] + (size_t)e * DM, p.ws + WS_PU8, e, (float*)(p.ws + WS_SCU) + e, lane);
    }
}

namespace att {
constexpr int KPITCH = 272, VPITCH = 320;
constexpr int L_KV = 0, KV_BYTES = 64 * KPITCH + 64 * VPITCH  , L_X = 0  , L_BIAS = BIAS_OFF, L_CA = 0  , L_CW = 94 * 1024  ;
static_assert(4 * 4096 * 4 <= 2 * KV_BYTES && 2 * KV_BYTES <= L_CW && L_CW + 31 * 1024 <= RING_BYTES, "attention LDS map");

__device__ __forceinline__ int rel_bucket(int rel) {
    const int ret = rel > 0 ? 16 : 0; const int n = rel < 0 ? -rel : rel; int v;
    if (n < 8) v = n; else if (n < 12) v = 8; else if (n < 16) v = 9; else if (n < 23) v = 10; else if (n < 32) v = 11;
    else if (n < 46) v = 12; else if (n < 64) v = 13; else if (n < 91) v = 14; else v = 15;
    return ret + v;
}
typedef short v4i16_t __attribute__((ext_vector_type(4)));
__device__ __forceinline__ s16x4 vtr(const LAS unsigned char* p) { return __builtin_bit_cast(s16x4, __builtin_amdgcn_ds_read_tr16_b64_v4i16((LAS v4i16_t*)p)); }
__device__ __forceinline__ f32x16 mfma32(bf16x8 a, bf16x8 b, f32x16 c) { return __builtin_amdgcn_mfma_f32_32x32x16_bf16(a, b, c, 0, 0, 0); }

__device__ __forceinline__ void attn_unit(const Params& p, LAS unsigned char* lds, int kind, int bb, int h, int qblk, float lam, int tid, int lane, int wid) {
    const bf16_t* Q = (const bf16_t*)(p.ws + WS_Q);
    const bf16_t* Kb = kind == 0 ? (const bf16_t*)(p.ws + WS_KP) + (size_t)bb * 2048 * 512 + h * 128 : (const bf16_t*)(p.ws + WS_KS) + (size_t)bb * SKV * 512 + h * 128;
    const bf16_t* Vb = kind == 0 ? (const bf16_t*)(p.ws + WS_VP) + (size_t)bb * 2048 * 512 + h * 128 : (const bf16_t*)(p.ws + WS_VS) + (size_t)bb * SKV * 512 + h * 128;
    bf16_t* MIX = (bf16_t*)(p.ws + WS_MIX);
    const int qrow0 = kind == 0 ? bb * 2048 + qblk * 128 : NP + bb * 64;
    const int qpos0 = kind == 0 ? qblk * 128 : 2048;
    const int ntiles = kind == 0 ? 2 * qblk + 2 : 33;
    const int rg = wid & 3, map = wid >> 2, r32 = lane & 31, hi = lane >> 5;
    const bool active = kind == 0 ? true : (rg < 2);
    const int cw = kind == 0 ? 2 * qblk + (rg >> 1) : 32;
    const int qw0 = qpos0 + 32 * rg;
    const int qabs = qw0 + r32;

    bf16x8 qf[4];
    if (active) {
        const bf16_t* qp = Q + (size_t)(qrow0 + 32 * rg + r32) * 512 + h * 128 + map * 64 + 8 * hi;
#pragma unroll
        for (int s = 0; s < 4; ++s) qf[s] = *(const bf16x8*)(qp + 16 * s);
    } else {
#pragma unroll
        for (int s = 0; s < 4; ++s) qf[s] = (bf16x8){0, 0, 0, 0, 0, 0, 0, 0};
    }
    float m = 0.f, l = 0.f;
    f32x16 negm;
#pragma unroll
    for (int r = 0; r < 16; ++r) negm[r] = 0.f;
    f32x16 o[4];
#pragma unroll
    for (int mt = 0; mt < 4; ++mt)
#pragma unroll
        for (int r = 0; r < 16; ++r) o[mt][r] = 0.f;

    const int srow0 = tid >> 4, sch = tid & 15;
    const LAS float* btab = (const LAS float*)(lds + L_BIAS) + h * 320;
    const int vlane = (4 * hi + ((lane & 15) >> 2)) * VPITCH + (16 * ((lane >> 4) & 1) + 4 * (lane & 3)) * 2;
    u32x4 kA[2], vA[2], kB[2], vB[2];
#define ATT_LOAD(KR, VR, T) do { _Pragma("unroll") for (int i_ = 0; i_ < 2; ++i_) { const size_t off_ = (size_t)((T) * 64 + srow0 + 32 * i_) * 512 + sch * 8; KR[i_] = *(const u32x4*)(Kb + off_); VR[i_] = *(const u32x4*)(Vb + off_); } } while (0)
#define ATT_STORE(KR, VR, BUF) do { _Pragma("unroll") for (int i_ = 0; i_ < 2; ++i_) { \
        *(LAS u32x4*)(lds + L_KV + (BUF) * KV_BYTES + (srow0 + 32 * i_) * KPITCH + sch * 16) = KR[i_]; \
        *(LAS u32x4*)(lds + L_KV + (BUF) * KV_BYTES + 64 * KPITCH + (srow0 + 32 * i_) * VPITCH + sch * 16) = VR[i_]; } } while (0)
    auto compute = [&](int t, int buf) {
        const LAS unsigned char* kbuf = lds + L_KV + buf * KV_BYTES;
        const LAS unsigned char* vbuf = kbuf + 64 * KPITCH;
        f32x16 p0, p1;
        const int kabs0 = t * 64;
        const LAS unsigned char* kb = kbuf + r32 * KPITCH + (map * 8 + hi) * 16;
        {
            const bf16x8 a0 = *(const LAS bf16x8*)(kb), a1 = *(const LAS bf16x8*)(kb + 32 * KPITCH);
            if (kabs0 + 63 - qw0 > -128) {
                const LAS float* bt = btab + (kabs0 - qabs + 256 + 4 * hi);
#pragma unroll
                for (int r = 0; r < 16; ++r) { p0[r] = bt[(r & 3) + 8 * (r >> 2)] - m; p1[r] = bt[32 + (r & 3) + 8 * (r >> 2)] - m; }
                p0 = mfma32(a0, qf[0], p0); p1 = mfma32(a1, qf[0], p1);
            } else { p0 = mfma32(a0, qf[0], negm); p1 = mfma32(a1, qf[0], negm); }
        }
#pragma unroll
        for (int s = 1; s < 4; ++s) {
            const bf16x8 a0 = *(const LAS bf16x8*)(kb + s * 32), a1 = *(const LAS bf16x8*)(kb + 32 * KPITCH + s * 32);
            p0 = mfma32(a0, qf[s], p0); p1 = mfma32(a1, qf[s], p1);
        }
        float mx = fmaxf(p0[0], p1[0]);
#pragma unroll
        for (int r = 1; r < 16; ++r) mx = fmaxf(mx, fmaxf(p0[r], p1[r]));
        { const auto rr = __builtin_amdgcn_permlane32_swap(__float_as_uint(mx), __float_as_uint(mx), false, false); mx = fmaxf(__uint_as_float(rr[0]), __uint_as_float(rr[1])); }
        if (__any(mx > 8.f)) {
            const float dl = fmaxf(mx, 0.f);
            m += dl;
            const float alpha = __builtin_amdgcn_exp2f(-dl);
            l *= alpha;
#pragma unroll
            for (int r = 0; r < 16; ++r) { p0[r] -= dl; p1[r] -= dl; negm[r] = -m; }
#pragma unroll
            for (int mt = 0; mt < 4; ++mt)
#pragma unroll
                for (int r = 0; r < 16; ++r) o[mt][r] *= alpha;
        }
        float rs = 0.f;
#pragma unroll
        for (int r = 0; r < 16; ++r) { p0[r] = __builtin_amdgcn_exp2f(p0[r]); p1[r] = __builtin_amdgcn_exp2f(p1[r]); rs += p0[r] + p1[r]; }
        l += rs;
#pragma unroll
        for (int t2 = 0; t2 < 2; ++t2)
#pragma unroll
            for (int s = 0; s < 2; ++s) {
                u32x4 bw;
                if (t2 == 0) { bw.x = cvtpk(p0[8 * s + 0], p0[8 * s + 1]); bw.y = cvtpk(p0[8 * s + 2], p0[8 * s + 3]); bw.z = cvtpk(p0[8 * s + 4], p0[8 * s + 5]); bw.w = cvtpk(p0[8 * s + 6], p0[8 * s + 7]); }
                else { bw.x = cvtpk(p1[8 * s + 0], p1[8 * s + 1]); bw.y = cvtpk(p1[8 * s + 2], p1[8 * s + 3]); bw.z = cvtpk(p1[8 * s + 4], p1[8 * s + 5]); bw.w = cvtpk(p1[8 * s + 6], p1[8 * s + 7]); }
                const bf16x8 B = __builtin_bit_cast(bf16x8, bw);
                const LAS unsigned char* vb = vbuf + vlane + (32 * t2 + 16 * s) * VPITCH;
#pragma unroll
                for (int mt = 0; mt < 4; ++mt) {
                    const s16x4 lo = vtr(vb + mt * 64), hi8 = vtr(vb + mt * 64 + 8 * VPITCH);
                    const bf16x8 A = (bf16x8){lo[0], lo[1], lo[2], lo[3], hi8[0], hi8[1], hi8[2], hi8[3]};
                    o[mt] = mfma32(A, B, o[mt]);
                }
            }
    };
    ATT_LOAD(kA, vA, 0);
    if (ntiles > 1) ATT_LOAD(kB, vB, 1);
    ATT_STORE(kA, vA, 0);
    if (ntiles > 2) ATT_LOAD(kA, vA, 2);
    __syncthreads();
    for (int t = 0; t < ntiles; t += 2) {
        if (t + 1 < ntiles) { ATT_STORE(kB, vB, 1); if (t + 3 < ntiles) ATT_LOAD(kB, vB, t + 3); }
        if (active && t <= cw) compute(t, 0);
        __syncthreads();
        if (t + 1 >= ntiles) break;
        if (t + 2 < ntiles) { ATT_STORE(kA, vA, 0); if (t + 4 < ntiles) ATT_LOAD(kA, vA, t + 4); }
        if (active && t + 1 <= cw) compute(t + 1, 1);
        __syncthreads();
    }
#undef ATT_LOAD
#undef ATT_STORE
    l += __shfl_xor(l, 32);
    const float inv = 1.f / l;
    LAS float* X = (LAS float*)(lds + L_X) + rg * 4096;
    if (active && map == 1) {
        const float sc = -lam * inv;
#pragma unroll
        for (int mt = 0; mt < 4; ++mt)
#pragma unroll
            for (int r = 0; r < 16; ++r) X[(mt * 16 + r) * 64 + lane] = o[mt][r] * sc;
    }
    __syncthreads();
    if (active && map == 0) {
        float ss = 0.f;
#pragma unroll
        for (int mt = 0; mt < 4; ++mt)
#pragma unroll
            for (int r = 0; r < 16; ++r) { const float v = o[mt][r] * inv + X[(mt * 16 + r) * 64 + lane]; o[mt][r] = v; ss += v * v; }
        ss += __shfl_xor(ss, 32);
        const float rsn = 0.8f / sqrtf(ss * (1.f / 128.f) + EPS);
        bf16_t* orow = MIX + (size_t)(qrow0 + 32 * rg + r32) * 1024 + 512 + h * 128;
        const float* sg = p.in[15];
#pragma unroll
        for (int mt = 0; mt < 4; ++mt)
#pragma unroll
            for (int g4 = 0; g4 < 4; ++g4) {
                const int e = 32 * mt + 8 * g4 + 4 * hi;
                const f32x4 gg = *(const f32x4*)(sg + e);
                u32x2 w; w.x = cvtpk(o[mt][4 * g4 + 0] * rsn * gg[0], o[mt][4 * g4 + 1] * rsn * gg[1]); w.y = cvtpk(o[mt][4 * g4 + 2] * rsn * gg[2], o[mt][4 * g4 + 3] * rsn * gg[3]);
                *(u32x2*)(orow + e) = w;
            }
    }
    __syncthreads();
}

__device__ __forceinline__ void unpack8(const u32x4 w, float (&f)[8]) { f[0] = bflo(w.x); f[1] = bfhi(w.x); f[2] = bflo(w.y); f[3] = bfhi(w.y); f[4] = bflo(w.z); f[5] = bfhi(w.z); f[6] = bflo(w.w); f[7] = bfhi(w.w); }
__device__ __forceinline__ void conv_unit(const Params& p, LAS unsigned char* lds, int cu, int tid, int lane, int wid) {
    const bf16_t* A = (const bf16_t*)(p.ws + WS_A);
    bf16_t* MIX = (bf16_t*)(p.ws + WS_MIX);
    const float* cb = p.in[8]; const float* lg = p.in[9]; const float* lb = p.in[10]; const float* st = p.in[4];
    const int row0 = cu * 64;
    const bool isp = row0 < NP;
    const int s0 = isp ? (row0 & 2047) : 0, rbase = row0 - s0, bd = isp ? 0 : ((row0 - NP) >> 6);
    __syncthreads();
    for (int c = tid; c < 94 * 64; c += 512) {
        const int rr = c >> 6, ch = c & 63, sp = s0 - 30 + rr;
        u32x4 v = (u32x4){0u, 0u, 0u, 0u};
        if (sp >= 0) v = *(const u32x4*)(A + (size_t)(rbase + sp) * 512 + ch * 8);
        else if (!isp) { const float* sr = st + ((size_t)bd * 30 + (30 + sp)) * 512 + ch * 8; const f32x4 a0 = *(const f32x4*)sr, a1 = *(const f32x4*)(sr + 4);
            v.x = cvtpk(a0[0], a0[1]); v.y = cvtpk(a0[2], a0[3]); v.z = cvtpk(a1[0], a1[1]); v.w = cvtpk(a1[2], a1[3]); }
        *(LAS u32x4*)(lds + L_CA + rr * 1024 + ch * 16) = v;
    }
    __syncthreads();
    {
        const LAS unsigned short* ac = (const LAS unsigned short*)(lds + L_CA) + tid;
        const LAS unsigned short* wc = (const LAS unsigned short*)(lds + L_CW) + tid;
        unsigned P[47];
#pragma unroll
        for (int k = 0; k < 47; ++k) P[k] = (unsigned)ac[(2 * k) * 512] | ((unsigned)ac[(2 * k + 1) * 512] << 16);
        unsigned WE[16], WO[16];
#pragma unroll
        for (int m = 0; m < 16; ++m) {
            const unsigned w0 = wc[(2 * m) * 512], w1 = (2 * m + 1 <= 30) ? (unsigned)wc[(2 * m + 1) * 512] : 0u, wm = (m > 0) ? (unsigned)wc[(2 * m - 1) * 512] : 0u;
            WE[m] = w0 | (w1 << 16);
            WO[m] = wm | (w0 << 16);
        }
        const float bias = cb[tid];
        __syncthreads();
        LAS unsigned short* yc = (LAS unsigned short*)(lds + L_CA) + tid;
#pragma unroll
        for (int u = 0; u < 32; ++u) {
            float ye = bias, yo = bias;
#pragma unroll
            for (int m = 0; m < 16; ++m) {
                const unsigned pp = P[u + m];
                ye += bflo(WE[m]) * bflo(pp) + bfhi(WE[m]) * bfhi(pp);
                yo += bflo(WO[m]) * bflo(pp) + bfhi(WO[m]) * bfhi(pp);
            }
            const unsigned w = cvtpk(ye, yo);
            yc[(2 * u) * 512] = (unsigned short)(w & 0xffffu); yc[(2 * u + 1) * 512] = (unsigned short)(w >> 16);
        }
    }
    __syncthreads();
    {
        const int c0 = lane * 8;
        float g8[8], b8[8];
        { const f32x4 y0 = *(const f32x4*)(lg + c0), y1 = *(const f32x4*)(lg + c0 + 4), z0 = *(const f32x4*)(lb + c0), z1 = *(const f32x4*)(lb + c0 + 4);
#pragma unroll
          for (int q = 0; q < 4; ++q) { g8[q] = y0[q]; g8[4 + q] = y1[q]; b8[q] = z0[q]; b8[4 + q] = z1[q]; } }
#pragma unroll 2
        for (int i = 0; i < 8; ++i) {
            const int t = wid * 8 + i;
            float y[8]; unpack8(*(const LAS u32x4*)(lds + L_CA + t * 1024 + lane * 16), y);
            float sm = 0.f, sq = 0.f;
#pragma unroll
            for (int c = 0; c < 8; ++c) { sm += y[c]; sq += y[c] * y[c]; }
            const float mu = wave_total(sm) * (1.f / 512.f);
            const float var = fmaxf(wave_total(sq) * (1.f / 512.f) - mu * mu, 0.f);
            const float rstd = 1.f / sqrtf(var + EPS);
#pragma unroll
            for (int c = 0; c < 8; ++c) { y[c] = (y[c] - mu) * rstd * g8[c] + b8[c]; y[c] = y[c] / (1.f + __expf(-y[c])); }
            u32x4 w; w.x = cvtpk(y[0], y[1]); w.y = cvtpk(y[2], y[3]); w.z = cvtpk(y[4], y[5]); w.w = cvtpk(y[6], y[7]);
            *(u32x4*)(MIX + (size_t)(row0 + t) * 1024 + c0) = w;
        }
    }
    __syncthreads();
}

constexpr int N_SAMPLE_UNITS = 32, N_PROMPT_UNITS = 1024, N_CONV_UNITS = NT / 64, N_UNITS = N_SAMPLE_UNITS + N_PROMPT_UNITS + N_CONV_UNITS;

__device__ __forceinline__ void phase2(const Params& p, LAS unsigned char* lds, int tid, int lane, int wid, int cidx, int mode) {
    LAS float* bt = (LAS float*)(lds + L_BIAS);
    for (int e = tid; e < 4 * 320; e += 512) { const int hh = e / 320, rel = (e % 320) - 256; bt[e] = (p.in[16][rel_bucket(rel) * 4 + hh] - p.in[16][15 * 4 + hh]) * LOG2E; }
    for (int c = tid; c < 31 * 64; c += 512) {
        const float* wr = p.in[7] + (size_t)c * 8; const f32x4 a0 = *(const f32x4*)wr, a1 = *(const f32x4*)(wr + 4);
        u32x4 v; v.x = cvtpk(a0[0], a0[1]); v.y = cvtpk(a0[2], a0[3]); v.z = cvtpk(a1[0], a1[1]); v.w = cvtpk(a1[2], a1[3]);
        *(LAS u32x4*)(lds + L_CW + c * 16) = v;
    }
    const float d1 = wave_sum(p.in[11][lane] * p.in[12][lane]), d2 = wave_sum(p.in[13][lane] * p.in[14][lane]);
    const float lam = expf(d1) - expf(d2) + 0.2f;
    unsigned* ctr = (unsigned*)(p.ws + WS_CTL) + 64 * cidx;
    volatile LAS unsigned* sw = (volatile LAS unsigned*)(lds + MISC_OFF);
    __syncthreads();
    for (;;) {
        __syncthreads();
        if (tid == 0) sw[0] = atomicAdd(ctr, 1u);
        __syncthreads();
        const int u = (int)sw[0];
        if (u >= N_UNITS) break;
        if (mode == 1 && u >= N_SAMPLE_UNITS + N_PROMPT_UNITS) continue;
        if (mode == 2 && u < N_SAMPLE_UNITS + N_PROMPT_UNITS) continue;
        int tid_ = tid; asm volatile("" : "+v"(tid_));
        if (u < N_SAMPLE_UNITS + N_PROMPT_UNITS) {
            const int v = u - N_SAMPLE_UNITS; const int bh = v & 63; const bool smp = u < N_SAMPLE_UNITS;
            attn_unit(p, lds, smp ? 1 : 0, smp ? (u >> 2) : (bh >> 2), smp ? (u & 3) : (bh & 3), smp ? 0 : 15 - (v >> 6), lam, tid_, tid_ & 63, wid);
        } else conv_unit(p, lds, u - N_SAMPLE_UNITS - N_PROMPT_UNITS, tid_, tid_ & 63, wid);
    }
}
}

template <class F> __device__ __forceinline__ void mini_gemm(const bf16_t* A, const bf16_t* Bt, int N, int lane, int wave, F epi) {
    const int ntasks = 32 * (N / 64), G = gridDim.x;
    const int fr = lane & 15, fq = lane >> 4;
    for (int task = wave * G + (int)blockIdx.x; task < ntasks; task += 8 * G) {
        const int rb = task & 31, cb = task >> 5;
        pg8::f32x4 acc[4];
#pragma unroll
        for (int n = 0; n < 4; ++n) acc[n] = (pg8::f32x4){0.f, 0.f, 0.f, 0.f};
        const bf16_t* ap = A + (size_t)(rb * 16 + fr) * 1024 + 8 * fq;
        const bf16_t* bp = Bt + (size_t)(cb * 64 + fr) * 1024 + 8 * fq;
#pragma unroll 8
        for (int k0 = 0; k0 < 1024; k0 += 32) {
            const bf16x8 a0 = *(const bf16x8*)(ap + k0);
            bf16x8 b[4];
#pragma unroll
            for (int n = 0; n < 4; ++n) b[n] = *(const bf16x8*)(bp + (size_t)n * 16 * 1024 + k0);
#pragma unroll
            for (int n = 0; n < 4; ++n) acc[n] = __builtin_amdgcn_mfma_f32_16x16x32_bf16(b[n], a0, acc[n], 0, 0, 0);
        }
        epi(rb * 16 + fr, cb, fq, acc);
    }
}

__device__ __forceinline__ void phase3b(const Params& p, int lane, int wave) {
    const int gw = blockIdx.x * 8 + wave, NGW = gridDim.x * 8;
    bf16_t* H2 = (bf16_t*)(p.ws + WS_H2);
    for (int m = gw; m < NT; m += 2 * NGW) { const int m2 = m + NGW < NT ? m + NGW : m; rms_row2_bf16(p.out + (size_t)m * DM, p.out + (size_t)m2 * DM, p.in[18], H2 + (size_t)m * DM, H2 + (size_t)m2 * DM, lane); }
}

constexpr int P4B_KPITCH = 272, P4B_K_BYTES = 128 * P4B_KPITCH, P4B_Q_BYTES = 32 * P4B_KPITCH;
static_assert(P4B_K_BYTES + 8 * P4B_Q_BYTES <= RING_BYTES, "P4b LDS map");
__device__ __forceinline__ void phase4b(const Params& p, LAS unsigned char* lds, int tid, int lane, int wave) {
    const bf16_t* QP = (const bf16_t*)(p.ws + WS_QP); const bf16_t* SK = (const bf16_t*)(p.ws + WS_SK);
    float* TK = (float*)(p.ws + WS_TK);
    const int r32 = lane & 31, hi = lane >> 5;
    const int G = gridDim.x;
    for (int rp = blockIdx.x & 15; rp < 16; rp += (G < 16 ? G : 16)) {
        const int nbr = (G - rp + 15) >> 4, member = (int)blockIdx.x >> 4;
        __syncthreads();
        for (int c = tid; c < 128 * 16; c += 512) { const int row = c >> 4, ch = c & 15; *(LAS u32x4*)(lds + row * P4B_KPITCH + ch * 16) = *(const u32x4*)(SK + ((size_t)rp * 128 + row) * 128 + ch * 8); }
        __syncthreads();
        LAS unsigned char* qs = lds + P4B_K_BYTES + wave * P4B_Q_BYTES;
        u32x4 qn[8];
        { const int tg0 = member * 8 + wave;
          if (tg0 < NT / 32) {
#pragma unroll
            for (int i = 0; i < 8; ++i) { const int row = 4 * i + (lane >> 4), ch = lane & 15; qn[i] = *(const u32x4*)(QP + (size_t)(tg0 * 32 + row) * 2048 + rp * 128 + ch * 8); } } }
        for (int tg = member * 8 + wave; tg < NT / 32; tg += nbr * 8) {
            const int t0 = tg * 32;
#pragma unroll
            for (int i = 0; i < 8; ++i) { const int row = 4 * i + (lane >> 4), ch = lane & 15; *(LAS u32x4*)(qs + row * P4B_KPITCH + ch * 16) = qn[i]; }
            { const int tgn = tg + nbr * 8;
              if (tgn < NT / 32) {
#pragma unroll
                for (int i = 0; i < 8; ++i) { const int row = 4 * i + (lane >> 4), ch = lane & 15; qn[i] = *(const u32x4*)(QP + (size_t)(tgn * 32 + row) * 2048 + rp * 128 + ch * 8); } } }
            bf16x8 qf[8];
#pragma unroll
            for (int s = 0; s < 8; ++s) qf[s] = *(const LAS bf16x8*)(qs + r32 * P4B_KPITCH + (2 * s + hi) * 16);
            float v[64];
#pragma unroll
            for (int mt = 0; mt < 4; ++mt) {
                f32x16 S;
#pragma unroll
                for (int r = 0; r < 16; ++r) S[r] = 0.f;
                const LAS unsigned char* kp = lds + (32 * mt + r32) * P4B_KPITCH + hi * 16;
#pragma unroll
                for (int s = 0; s < 8; ++s) S = att::mfma32(*(const LAS bf16x8*)(kp + s * 32), qf[s], S);
#pragma unroll
                for (int r = 0; r < 16; ++r) { const int n = 32 * mt + (r & 3) + 8 * (r >> 2) + 4 * hi; v[mt * 16 + r] = __uint_as_float((__float_as_uint(S[r]) & ~127u) | (unsigned)(127 - n)); }
            }
            SORT16_DESC(v, 0); SORT16_DESC(v, 16); SORT16_DESC(v, 32); SORT16_DESC(v, 48);
#pragma unroll
            for (int i = 0; i < 16; ++i) { v[i] = fmaxf(v[i], v[31 - i]); v[32 + i] = fmaxf(v[32 + i], v[63 - i]); }
            BITONIC16_DESC(v, 0); BITONIC16_DESC(v, 32);
#pragma unroll
            for (int i = 0; i < 16; ++i) v[i] = fmaxf(v[i], v[47 - i]);
            BITONIC16_DESC(v, 0);
            float w[16];
#pragma unroll
            for (int i = 0; i < 16; ++i) w[i] = fmaxf(v[i], __shfl_xor(v[15 - i], 32));
            BITONIC16_DESC(w, 0);
            if (hi == 0) {
                f32x4* dst = (f32x4*)(TK + ((size_t)(t0 + r32) * 16 + rp) * 16);
#pragma unroll
                for (int q = 0; q < 4; ++q) dst[q] = (f32x4){w[4 * q], w[4 * q + 1], w[4 * q + 2], w[4 * q + 3]};
            }
        }
    }
}

__device__ __forceinline__ void phase5a(const Params& p, LAS unsigned char* lds, int tid) {
    const float* TK = (const float*)(p.ws + WS_TK);
    int* IDX = (int*)(p.ws + WS_IDX); float* GATE = (float*)(p.ws + WS_GATE);
    const float NEG_INF = -__builtin_huge_valf();
    LAS unsigned* rec = (LAS unsigned*)(lds + tid * 36);
    for (int item = blockIdx.x * 512 + tid; item < NT * 8; item += gridDim.x * 512) {
        const int tok = item >> 3, r = item & 7;
        const f32x4* pa = (const f32x4*)(TK + ((size_t)tok * 16 + 2 * r) * 16);
        float a[16], b[16];
#pragma unroll
        for (int q = 0; q < 4; ++q) { const f32x4 x = pa[q], y = pa[4 + q];
#pragma unroll
            for (int j = 0; j < 4; ++j) { a[4 * q + j] = x[j]; b[4 * q + j] = y[j]; } }
        float ssum = 0.f;
        { const f32x4* sp = (const f32x4*)((const float*)(p.ws + WS_SSQ) + (size_t)tok * 16);
#pragma unroll
          for (int q = 0; q < 4; ++q) { const f32x4 v4 = sp[q]; ssum += (v4[0] + v4[1]) + (v4[2] + v4[3]); } }
#pragma unroll
        for (int q = 0; q < 4; ++q) {
            unsigned wa = 0u, wb = 0u;
#pragma unroll
            for (int j = 0; j < 4; ++j) { const unsigned ua = __float_as_uint(a[4 * q + j]), ub = __float_as_uint(b[4 * q + j]);
                wa |= (127u - (ua & 127u)) << (8 * j); wb |= (127u - (ub & 127u)) << (8 * j);
                a[4 * q + j] = __uint_as_float(ua & ~127u); b[4 * q + j] = __uint_as_float(ub & ~127u); }
            rec[q] = wa; rec[4 + q] = wb;
        }
        float v[64];
        {
            int c = 0;
#pragma unroll
            for (int i = 0; i < 16; ++i)
#pragma unroll
                for (int j = 0; j < 16; ++j)
                    if ((i + 1) * (j + 1) <= 16) { v[c] = __uint_as_float((__float_as_uint(a[i] + b[j]) & ~255u) | (unsigned)(255 - (16 * i + j))); ++c; }
#pragma unroll
            for (int c2 = 50; c2 < 64; ++c2) v[c2] = NEG_INF;
        }
        SORT16_DESC(v, 0); SORT16_DESC(v, 16); SORT16_DESC(v, 32); SORT16_DESC(v, 48);
#pragma unroll
        for (int i = 0; i < 16; ++i) { v[i] = fmaxf(v[i], v[31 - i]); v[32 + i] = fmaxf(v[32 + i], v[63 - i]); }
        BITONIC16_DESC(v, 0); BITONIC16_DESC(v, 32);
#pragma unroll
        for (int i = 0; i < 16; ++i) v[i] = fmaxf(v[i], v[47 - i]);
        BITONIC16_DESC(v, 0);
        const float rstd = 1.f / sqrtf(ssum * (1.f / DM) + EPS);
        if (r == 0) ((float*)(p.ws + WS_RSTD))[tok] = rstd;
        const LAS unsigned char* rb = (const LAS unsigned char*)rec;
        float e[16], sum = 0.f; int bid[16];
        const float best0 = __uint_as_float(__float_as_uint(v[0]) & ~255u);
#pragma unroll
        for (int k = 0; k < 16; ++k) {
            const unsigned u = __float_as_uint(v[k]); const unsigned code = 255u - (u & 255u);
            bid[k] = (int)rb[code >> 4] * 128 + (int)rb[16 + (code & 15u)];
            e[k] = __expf((__uint_as_float(u & ~255u) - best0) * rstd); sum += e[k];
        }
        const float rinv = 1.f / sum;
        int* io = IDX + (size_t)tok * 128 + r * 16; float* go = GATE + (size_t)tok * 128 + r * 16;
#pragma unroll
        for (int k = 0; k < 16; ++k) { io[k] = bid[k]; go[k] = e[k] * rinv; }
    }
}

__device__ __forceinline__ float gelu_erf(float x) { return 0.5f * x * (1.f + erff(x * 0.70710678118654752f)); }
__device__ __forceinline__ void fp8x16_to_f32(const u32x4 q, float (&f)[16]) {
    const f32x2 c0 = __builtin_amdgcn_cvt_pk_f32_fp8(q.x, false), c1 = __builtin_amdgcn_cvt_pk_f32_fp8(q.x, true), c2 = __builtin_amdgcn_cvt_pk_f32_fp8(q.y, false), c3 = __builtin_amdgcn_cvt_pk_f32_fp8(q.y, true);
    const f32x2 c4 = __builtin_amdgcn_cvt_pk_f32_fp8(q.z, false), c5 = __builtin_amdgcn_cvt_pk_f32_fp8(q.z, true), c6 = __builtin_amdgcn_cvt_pk_f32_fp8(q.w, false), c7 = __builtin_amdgcn_cvt_pk_f32_fp8(q.w, true);
    f[0] = c0.x; f[1] = c0.y; f[2] = c1.x; f[3] = c1.y; f[4] = c2.x; f[5] = c2.y; f[6] = c3.x; f[7] = c3.y;
    f[8] = c4.x; f[9] = c4.y; f[10] = c5.x; f[11] = c5.y; f[12] = c6.x; f[13] = c6.y; f[14] = c7.x; f[15] = c7.y;
}
__device__ __forceinline__ void slice_group(int& x, int& gwx, int& nwx, int wave) {
    x = blockIdx.x & 7; const int nbx = ((int)gridDim.x - x + 7) >> 3; gwx = ((int)blockIdx.x >> 3) * 8 + wave; nwx = nbx * 8;
}
__device__ __forceinline__ void phase5u(const Params& p, LAS unsigned char* lds, int lane, int wave) {
    int x, gwx, nwx; slice_group(x, gwx, nwx, wave);
    const unsigned char* PU8 = p.ws + WS_PU8 + (size_t)x * 16384 * 128;
    const bf16_t* H2 = (const bf16_t*)(p.ws + WS_XG) + 128 * x;
    const int* IDX = (const int*)(p.ws + WS_IDX); float* PACT = (float*)(p.ws + WS_PACT) + (size_t)x * NT * 128;
    LAS int* l_idx = (LAS int*)(lds + wave * 512);
    const int g = lane >> 3, sub = lane & 7;
    const unsigned char* rowp = PU8 + sub * 16;
    int r_idxA = 0, r_idxB = 0;
    u32x4 hA0, hA1, hB0, hB1; hA0 = hA1 = hB0 = hB1 = (u32x4){0u, 0u, 0u, 0u};
    u32x4 qA[16], qB[16];
#define P5U_LOADIDX(T) do { if ((T) < NT) { r_idxA = IDX[(size_t)(T) * 128 + lane]; r_idxB = IDX[(size_t)(T) * 128 + 64 + lane]; } } while (0)
#define P5U_ISSUE(Q, H0, H1, T) do { if ((T) < NT) { l_idx[lane] = r_idxA; l_idx[64 + lane] = r_idxB; \
        H0 = *(const u32x4*)(H2 + (size_t)(T) * DM + 16 * sub); H1 = *(const u32x4*)(H2 + (size_t)(T) * DM + 16 * sub + 8); \
        _Pragma("unroll") for (int q_ = 0; q_ < 4; ++q_) { const u32x4 iv = *(const LAS u32x4*)(l_idx + 16 * g + 4 * q_); \
            Q[4 * q_] = *(const u32x4*)(rowp + (size_t)iv.x * 128); Q[4 * q_ + 1] = *(const u32x4*)(rowp + (size_t)iv.y * 128); \
            Q[4 * q_ + 2] = *(const u32x4*)(rowp + (size_t)iv.z * 128); Q[4 * q_ + 3] = *(const u32x4*)(rowp + (size_t)iv.w * 128); } } } while (0)
#define IDPP_ADD(v, ctrl) v += __builtin_amdgcn_update_dpp(0, v, ctrl, 0xf, 0xf, true)
#define FDPP_MAX(v, ctrl) v = fmaxf(v, __builtin_bit_cast(float, __builtin_amdgcn_update_dpp(0, __builtin_bit_cast(int, v), ctrl, 0xf, 0xf, true)))
#define P5U_COMPUTE(Q, H0, H1, T) do { \
        float hf[16]; \
        hf[0] = bflo(H0.x); hf[1] = bfhi(H0.x); hf[2] = bflo(H0.y); hf[3] = bfhi(H0.y); hf[4] = bflo(H0.z); hf[5] = bfhi(H0.z); hf[6] = bflo(H0.w); hf[7] = bfhi(H0.w); \
        hf[8] = bflo(H1.x); hf[9] = bfhi(H1.x); hf[10] = bflo(H1.y); hf[11] = bfhi(H1.y); hf[12] = bflo(H1.z); hf[13] = bfhi(H1.z); hf[14] = bflo(H1.w); hf[15] = bfhi(H1.w); \
        float am = 0.f; \
        _Pragma("unroll") for (int j = 0; j < 16; ++j) am = fmaxf(am, fabsf(hf[j])); \
        FDPP_MAX(am, 0xB1); FDPP_MAX(am, 0x4E); FDPP_MAX(am, 0x141);              \
        const float sh = am > 0.f ? am * (1.f / 127.f) : 1.f, ih = 1.f / sh; \
        int hq[4]; \
        _Pragma("unroll") for (int w_ = 0; w_ < 4; ++w_) { \
            const int q0 = __float2int_rn(hf[4 * w_] * ih), q1 = __float2int_rn(hf[4 * w_ + 1] * ih), q2 = __float2int_rn(hf[4 * w_ + 2] * ih), q3 = __float2int_rn(hf[4 * w_ + 3] * ih); \
            hq[w_] = (int)((unsigned)(q0 & 255) | ((unsigned)(q1 & 255) << 8) | ((unsigned)(q2 & 255) << 16) | ((unsigned)(q3 & 255) << 24)); } \
        int resA = 0, resB = 0; \
        _Pragma("unroll") for (int i = 0; i < 16; ++i) { \
            int d = __builtin_amdgcn_sdot4((int)Q[i].x, hq[0], 0, false); d = __builtin_amdgcn_sdot4((int)Q[i].y, hq[1], d, false); \
            d = __builtin_amdgcn_sdot4((int)Q[i].z, hq[2], d, false); d = __builtin_amdgcn_sdot4((int)Q[i].w, hq[3], d, false); \
            IDPP_ADD(d, 0xB1); IDPP_ADD(d, 0x4E); IDPP_ADD(d, 0x141); \
            if (i < 8) resA = (sub == i) ? d : resA; else resB = (sub == i - 8) ? d : resB; } \
        PACT[(size_t)(T) * 128 + 16 * g + sub] = (float)resA * sh; PACT[(size_t)(T) * 128 + 16 * g + 8 + sub] = (float)resB * sh; } while (0)
    int tok = gwx;
    P5U_LOADIDX(tok);
    P5U_ISSUE(qA, hA0, hA1, tok);
    P5U_LOADIDX(tok + nwx);
    for (; tok < NT; tok += 2 * nwx) {
        P5U_ISSUE(qB, hB0, hB1, tok + nwx);
        P5U_LOADIDX(tok + 2 * nwx);
        P5U_COMPUTE(qA, hA0, hA1, tok);
        if (tok + nwx >= NT) break;
        P5U_ISSUE(qA, hA0, hA1, tok + 2 * nwx);
        P5U_LOADIDX(tok + 3 * nwx);
        P5U_COMPUTE(qB, hB0, hB1, tok + nwx);
    }
#undef P5U_LOADIDX
#undef P5U_ISSUE
#undef P5U_COMPUTE
#undef IDPP_ADD
#undef FDPP_MAX
}
__device__ __forceinline__ void phase5c(const Params& p, int tid) {
    const float* PACT = (const float*)(p.ws + WS_PACT); const float* SCU = (const float*)(p.ws + WS_SCU); const float* SCV = (const float*)(p.ws + WS_SCV);
    const int* IDX = (const int*)(p.ws + WS_IDX); const float* GATE = (const float*)(p.ws + WS_GATE); float* COEF = (float*)(p.ws + WS_COEF); const float* RSTD = (const float*)(p.ws + WS_RSTD);
    const size_t n = (size_t)NT * 128, n4 = n / 4, stride = (size_t)gridDim.x * 512;
    for (size_t i0 = (size_t)blockIdx.x * 512 + tid; i0 < n4; i0 += 2 * stride) {
        f32x4 a[2], g[2]; u32x4 e[2]; f32x4 pa[2][8]; float rs[2];
#pragma unroll
        for (int u = 0; u < 2; ++u) {
            const size_t it = (i0 + u * stride < n4 ? i0 + u * stride : i0) * 4;
#pragma unroll
            for (int xx = 0; xx < 8; ++xx) pa[u][xx] = *(const f32x4*)(PACT + (size_t)xx * n + it);
            e[u] = *(const u32x4*)(IDX + it); g[u] = *(const f32x4*)(GATE + it); rs[u] = RSTD[it >> 7];
        }
        float su[2][4], sv[2][4];
#pragma unroll
        for (int u = 0; u < 2; ++u)
#pragma unroll
            for (int j = 0; j < 4; ++j) { su[u][j] = SCU[e[u][j]]; sv[u][j] = SCV[e[u][j]]; }
#pragma unroll
        for (int u = 0; u < 2; ++u) {
            a[u] = ((pa[u][0] + pa[u][1]) + (pa[u][2] + pa[u][3])) + ((pa[u][4] + pa[u][5]) + (pa[u][6] + pa[u][7]));
            f32x4 c;
#pragma unroll
            for (int j = 0; j < 4; ++j) c[j] = g[u][j] * gelu_erf(a[u][j] * (rs[u] * su[u][j])) * sv[u][j];
            if (i0 + u * stride < n4) *(f32x4*)(COEF + (i0 + u * stride) * 4) = c;
        }
    }
}

constexpr int P5V_LDS_PER_WAVE = 1024 + 8 * 136 * 4;
__device__ __forceinline__ void phase5v(const Params& p, LAS unsigned char* lds, int lane, int wave) {
    int x, gwx, nwx; slice_group(x, gwx, nwx, wave);
    const unsigned char* PV8 = p.ws + WS_PV8 + (size_t)x * 16384 * 128;
    const int* IDX = (const int*)(p.ws + WS_IDX); const float* COEF = (const float*)(p.ws + WS_COEF);
    LAS int* l_idx = (LAS int*)(lds + wave * P5V_LDS_PER_WAVE); LAS float* l_cf = (LAS float*)(l_idx + 128); LAS float* red = l_cf + 128;
    const int g = lane >> 3, sub = lane & 7;
    const unsigned char* rowp = PV8 + sub * 16;
    const int c1 = 16 * (lane & 7) + (lane >> 3);
    int r_idxA = 0, r_idxB = 0; float r_cA = 0.f, r_cB = 0.f;
    u32x4 qA[16], qB[16]; f32x4 cfA[4], cfB[4]; float xA0 = 0.f, xA1 = 0.f, xB0 = 0.f, xB1 = 0.f;
#define P5V_LOADIDX(T) do { if ((T) < NT) { r_idxA = IDX[(size_t)(T) * 128 + lane]; r_idxB = IDX[(size_t)(T) * 128 + 64 + lane]; r_cA = COEF[(size_t)(T) * 128 + lane]; r_cB = COEF[(size_t)(T) * 128 + 64 + lane]; } } while (0)
#define P5V_ISSUE(Q, CF, X0, X1, T) do { if ((T) < NT) { l_idx[lane] = r_idxA; l_idx[64 + lane] = r_idxB; l_cf[lane] = r_cA; l_cf[64 + lane] = r_cB; \
        { const float* xr_ = p.out + (size_t)(T) * DM + 128 * x; X0 = xr_[c1]; X1 = xr_[c1 + 8]; } \
        _Pragma("unroll") for (int q_ = 0; q_ < 4; ++q_) { const u32x4 iv = *(const LAS u32x4*)(l_idx + 16 * g + 4 * q_); CF[q_] = *(const LAS f32x4*)(l_cf + 16 * g + 4 * q_); \
            Q[4 * q_] = *(const u32x4*)(rowp + (size_t)iv.x * 128); Q[4 * q_ + 1] = *(const u32x4*)(rowp + (size_t)iv.y * 128); \
            Q[4 * q_ + 2] = *(const u32x4*)(rowp + (size_t)iv.z * 128); Q[4 * q_ + 3] = *(const u32x4*)(rowp + (size_t)iv.w * 128); } } } while (0)
#define P5V_COMPUTE(Q, CF, X0, X1, T) do { \
        f32x2 acc[8]; \
        _Pragma("unroll") for (int j = 0; j < 8; ++j) acc[j] = (f32x2){0.f, 0.f}; \
        _Pragma("unroll") for (int i = 0; i < 16; ++i) { \
            const float cs_ = CF[i >> 2][i & 3]; const f32x2 c2 = (f32x2){cs_, cs_}; \
            acc[0] = __builtin_elementwise_fma(__builtin_amdgcn_cvt_pk_f32_fp8(Q[i].x, false), c2, acc[0]); \
            acc[1] = __builtin_elementwise_fma(__builtin_amdgcn_cvt_pk_f32_fp8(Q[i].x, true), c2, acc[1]); \
            acc[2] = __builtin_elementwise_fma(__builtin_amdgcn_cvt_pk_f32_fp8(Q[i].y, false), c2, acc[2]); \
            acc[3] = __builtin_elementwise_fma(__builtin_amdgcn_cvt_pk_f32_fp8(Q[i].y, true), c2, acc[3]); \
            acc[4] = __builtin_elementwise_fma(__builtin_amdgcn_cvt_pk_f32_fp8(Q[i].z, false), c2, acc[4]); \
            acc[5] = __builtin_elementwise_fma(__builtin_amdgcn_cvt_pk_f32_fp8(Q[i].z, true), c2, acc[5]); \
            acc[6] = __builtin_elementwise_fma(__builtin_amdgcn_cvt_pk_f32_fp8(Q[i].w, false), c2, acc[6]); \
            acc[7] = __builtin_elementwise_fma(__builtin_amdgcn_cvt_pk_f32_fp8(Q[i].w, true), c2, acc[7]); } \
        _Pragma("unroll") for (int j = 0; j < 8; ++j) { red[g * 136 + (2 * j) * 8 + sub] = acc[j].x; red[g * 136 + (2 * j + 1) * 8 + sub] = acc[j].y; } \
        float s1 = X0, s2_ = X1; \
        _Pragma("unroll") for (int gg = 0; gg < 8; ++gg) { s1 += red[gg * 136 + lane]; s2_ += red[gg * 136 + 64 + lane]; } \
        { float* xr_ = p.out + (size_t)(T) * DM + 128 * x; xr_[c1] = s1; xr_[c1 + 8] = s2_; } } while (0)
    int tok = gwx;
    P5V_LOADIDX(tok);
    P5V_ISSUE(qA, cfA, xA0, xA1, tok);
    P5V_LOADIDX(tok + nwx);
    for (; tok < NT; tok += 2 * nwx) {
        P5V_ISSUE(qB, cfB, xB0, xB1, tok + nwx);
        P5V_LOADIDX(tok + 2 * nwx);
        P5V_COMPUTE(qA, cfA, xA0, xA1, tok);
        if (tok + nwx >= NT) break;
        P5V_ISSUE(qA, cfA, xA0, xA1, tok + 2 * nwx);
        P5V_LOADIDX(tok + 3 * nwx);
        P5V_COMPUTE(qB, cfB, xB0, xB1, tok + nwx);
    }
#undef P5V_LOADIDX
#undef P5V_ISSUE
#undef P5V_COMPUTE
}

__device__ __forceinline__ void phase6(const Params& p, int lane, int wave) {
    const int gw = blockIdx.x * 8 + wave, NGW = gridDim.x * 8;
    const f32x4* gr = (const f32x4*)p.in[23] + lane;
    for (int m = gw; m < NT; m += 2 * NGW) {
        const bool two = m + NGW < NT;
        f32x4* xa = (f32x4*)(p.out + (size_t)m * DM) + lane; f32x4* xb = (f32x4*)(p.out + (size_t)(two ? m + NGW : m) * DM) + lane;
        f32x4 va[4], vb[4]; float sa = 0.f, sb = 0.f;
#pragma unroll
        for (int j = 0; j < 4; ++j) { va[j] = xa[64 * j]; vb[j] = xb[64 * j]; }
#pragma unroll
        for (int j = 0; j < 4; ++j) { sa += (va[j][0] * va[j][0] + va[j][1] * va[j][1]) + (va[j][2] * va[j][2] + va[j][3] * va[j][3]); sb += (vb[j][0] * vb[j][0] + vb[j][1] * vb[j][1]) + (vb[j][2] * vb[j][2] + vb[j][3] * vb[j][3]); }
        const float ra_ = 1.f / sqrtf(wave_total(sa) * (1.f / DM) + EPS), rb_ = 1.f / sqrtf(wave_total(sb) * (1.f / DM) + EPS);
#pragma unroll
        for (int j = 0; j < 4; ++j) { const f32x4 gg = gr[64 * j]; __builtin_nontemporal_store(va[j] * ra_ * gg, xa + 64 * j); if (two) __builtin_nontemporal_store(vb[j] * rb_ * gg, xb + 64 * j); }
    }
}

__global__ void __launch_bounds__(512, 2) fwd_megakernel(Params p) {
    extern __shared__ __attribute__((aligned(16))) unsigned char lds_raw[];
    LAS unsigned char* lds = (LAS unsigned char*)lds_raw;
    const int tid0 = threadIdx.x, wave = __builtin_amdgcn_readfirstlane(tid0 >> 6);
#define PHASE_IDS() int tid = tid0; asm volatile("" : "+v"(tid)); const int lane = tid & 63; (void)lane
    const int G = gridDim.x;
    volatile LAS unsigned* MISC = (volatile LAS unsigned*)(lds + MISC_OFF);
    if (tid0 < 32) MISC[tid0] = 0u;
    __syncthreads();
    XcdBarrier bar = xcd_barrier_post((unsigned*)(p.ws + WS_CTL) + 4096, MISC + 8);
#define GSYNC() xcd_barrier(bar)

#ifndef RPT_MASK
#define RPT_MASK 0
#endif
#if RPT_MASK
#define RPT(bit) for (int rpt_ = 0; rpt_ < (((RPT_MASK) >> (bit)) & 1) + 1; ++rpt_)
#else
#define RPT(bit) if (constexpr int rpt_ = 0; true)
#endif
    RPT(0) { PHASE_IDS(); phase0(p, lds, tid, lane, wave); GSYNC(); }
    RPT(1) {
        PHASE_IDS();
        pg8::Gemm g{(const bf16_t*)(p.ws + WS_H), (const bf16_t*)(p.ws + WS_WINT), NT, DIN, 1024};
        pg8::StaticOrder S; S.init(NT, DIN, G, (int)blockIdx.x);
        pg8::EpiProj E{(bf16_t*)(p.ws + WS_A), (bf16_t*)(p.ws + WS_Q), (bf16_t*)(p.ws + WS_KP), (bf16_t*)(p.ws + WS_VP), (bf16_t*)(p.ws + WS_KS), (bf16_t*)(p.ws + WS_VS), p.out};
        pg8::gemm_phase<pg8::EpiProj, pg8::StaticOrder, true, true>(lds, g, S, E);
        {
            const int nwg = (NT / 256) * (DIN / 256), rem = nwg % G, c = (int)blockIdx.x;
            if (rem == 0) prep_late(p, lds, tid, lane, wave, c, G);
            else if (c >= rem) prep_late(p, lds, tid, lane, wave, c - rem, G - rem);
        }
        GSYNC();
    }
    #ifndef P2MODE
#define P2MODE 0
#endif
    RPT(2) { PHASE_IDS(); att::phase2(p, lds, tid, lane, wave, rpt_, (((RPT_MASK) >> 2) & 1) && rpt_ == 0 ? P2MODE : 0); GSYNC(); }
    RPT(3) {
        PHASE_IDS();
        pg8::Gemm g{(const bf16_t*)(p.ws + WS_MIX), (const bf16_t*)(p.ws + WS_WOUTT), NP, 1024, 1024};
        pg8::StaticOrder S; S.init(NP, 1024, G, (int)blockIdx.x);
        pg8::EpiRes E{p.in[0], p.in[1], p.out, (bf16_t*)(p.ws + WS_XG), p.in[18], (float*)(p.ws + WS_SSQ)};
        pg8::gemm_phase<pg8::EpiRes, pg8::StaticOrder, true, true>(lds, g, S, E);
        {
            const float* xs = p.in[1]; float* xo = p.out + (size_t)NP * DM; bf16_t* go = (bf16_t*)(p.ws + WS_XG) + (size_t)NP * DM; const float* gff = p.in[18]; float* sso = (float*)(p.ws + WS_SSQ) + (size_t)NP * 16;
            mini_gemm((const bf16_t*)(p.ws + WS_MIX) + (size_t)NP * DM, (const bf16_t*)(p.ws + WS_WOUTT), 1024, lane, wave,
                      [=](int row, int cb, int fq, const pg8::f32x4 (&a)[4]) {
                          float sq = 0.f;
#pragma unroll
                          for (int n = 0; n < 4; ++n) {
                              const int col = cb * 64 + 16 * n + 4 * fq;
                              const pg8::f32x4 v = *(const pg8::f32x4*)(xs + (size_t)row * DM + col) + a[n];
                              *(pg8::f32x4*)(xo + (size_t)row * DM + col) = v;
                              *(u32x2*)(go + (size_t)row * DM + col) = pg8::pack4(v * *(const pg8::f32x4*)(gff + col));
                              sq += (v[0] * v[0] + v[1] * v[1]) + (v[2] * v[2] + v[3] * v[3]);
                          }
                          sq += __shfl_xor(sq, 16); sq += __shfl_xor(sq, 32);
                          if (fq == 0) sso[(size_t)row * 16 + cb] = sq;
                      });
        }
        GSYNC();
    }
    RPT(5) {
        PHASE_IDS();
        pg8::Gemm g{(const bf16_t*)(p.ws + WS_XG), (const bf16_t*)(p.ws + WS_WQT), NP, 2048, 1024};
        pg8::StaticOrder S; S.init(NP, 2048, G, (int)blockIdx.x);
        pg8::EpiBf16<0> E{(bf16_t*)(p.ws + WS_QP), 2048, nullptr, 0, 0, 1.f};
        pg8::gemm_phase<pg8::EpiBf16<0>, pg8::StaticOrder, true, true>(lds, g, S, E);
        {
            bf16_t* qo = (bf16_t*)(p.ws + WS_QP) + (size_t)NP * 2048;
            mini_gemm((const bf16_t*)(p.ws + WS_XG) + (size_t)NP * DM, (const bf16_t*)(p.ws + WS_WQT), 2048, lane, wave,
                      [=](int row, int cb, int fq, const pg8::f32x4 (&a)[4]) {
#pragma unroll
                          for (int n = 0; n < 4; ++n) *(u32x2*)(qo + (size_t)row * 2048 + cb * 64 + 16 * n + 4 * fq) = pg8::pack4(a[n]);
                      });
        }
        GSYNC();
    }
    RPT(6) { PHASE_IDS(); phase4b(p, lds, tid, lane, wave); GSYNC(); }
    RPT(7) { PHASE_IDS(); phase5a(p, lds, tid); GSYNC(); }
    RPT(8) { PHASE_IDS(); phase5u(p, lds, lane, wave); GSYNC(); }
    RPT(9) { PHASE_IDS(); phase5c(p, tid); GSYNC(); }
    { PHASE_IDS(); phase5v(p, lds, lane, wave); }
    GSYNC();
    { PHASE_IDS(); phase6(p, lane, wave); }
}

extern "C" void kernel_launch(void* const* d_in, const int* in_sizes, int n_in, void* d_out, int out_size, void* d_ws, size_t ws_size, hipStream_t stream) {
    static int grid = 0;
    if (grid == 0) {
        if (n_in != 24 || out_size != (int)OUT_TOTAL || ws_size < WS_END) { fprintf(stderr, "kernel_launch: unexpected shapes: n_in %d out %d ws %zu (need %zu)\n", n_in, out_size, ws_size, (size_t)WS_END); grid = -1; return; }
        int dev = 0, cus = 0, per_cu = 0;
        (void)hipGetDevice(&dev);
        (void)hipDeviceGetAttribute(&cus, hipDeviceAttributeMultiprocessorCount, dev);
        if (hipFuncSetAttribute((const void*)fwd_megakernel, hipFuncAttributeMaxDynamicSharedMemorySize, LDS_BYTES) != hipSuccess) { fprintf(stderr, "kernel_launch: hipFuncSetAttribute failed\n"); grid = -1; return; }
        if (hipOccupancyMaxActiveBlocksPerMultiprocessor(&per_cu, (const void*)fwd_megakernel, 512, LDS_BYTES) != hipSuccess || per_cu < 1) { fprintf(stderr, "kernel_launch: occupancy query gave %d\n", per_cu); per_cu = 1; }
        (void)hipGetLastError();
        grid = cus * 1;
        if (per_cu < 1) grid = -1;
    }
    if (grid < 0) return;
    (void)hipMemsetAsync((char*)d_ws + WS_CTL, 0, CTL_BYTES, stream);
    Params p{};
    for (int i = 0; i < 24; ++i) p.in[i] = (const float*)d_in[i];
    p.out = (float*)d_out; p.ws = (unsigned char*)d_ws;
    void* args[] = {&p};
    hipError_t e = hipLaunchCooperativeKernel((const void*)fwd_megakernel, dim3(grid), dim3(512), args, LDS_BYTES, stream);
    if (e != hipSuccess) fprintf(stderr, "cooperative launch failed: %s (grid %d)\n", hipGetErrorString(e), grid);
}
```

```cpp
#include <hip/hip_runtime.h>
#include <hip/hip_cooperative_groups.h>
#include <cstdio>
#include <cstdint>
#include <cmath>
namespace cg = cooperative_groups;
#define CE_(a, b) do { const float t_ = fmaxf(a, b); b = fminf(a, b); a = t_; } while (0)
#define SORT16_DESC(V, O) do { CE_(V[(O)+0], V[(O)+1]); CE_(V[(O)+2], V[(O)+3]); CE_(V[(O)+0], V[(O)+2]); CE_(V[(O)+1], V[(O)+3]); CE_(V[(O)+1], V[(O)+2]); CE_(V[(O)+4], V[(O)+5]); CE_(V[(O)+6], V[(O)+7]); CE_(V[(O)+4], V[(O)+6]); CE_(V[(O)+5], V[(O)+7]); CE_(V[(O)+5], V[(O)+6]); CE_(V[(O)+0], V[(O)+4]); CE_(V[(O)+2], V[(O)+6]); CE_(V[(O)+2], V[(O)+4]); CE_(V[(O)+1], V[(O)+5]); CE_(V[(O)+3], V[(O)+7]); CE_(V[(O)+3], V[(O)+5]); CE_(V[(O)+1], V[(O)+2]); CE_(V[(O)+3], V[(O)+4]); CE_(V[(O)+5], V[(O)+6]); CE_(V[(O)+8], V[(O)+9]); CE_(V[(O)+10], V[(O)+11]); CE_(V[(O)+8], V[(O)+10]); CE_(V[(O)+9], V[(O)+11]); CE_(V[(O)+9], V[(O)+10]); CE_(V[(O)+12], V[(O)+13]); CE_(V[(O)+14], V[(O)+15]); CE_(V[(O)+12], V[(O)+14]); CE_(V[(O)+13], V[(O)+15]); CE_(V[(O)+13], V[(O)+14]); CE_(V[(O)+8], V[(O)+12]); CE_(V[(O)+10], V[(O)+14]); CE_(V[(O)+10], V[(O)+12]); CE_(V[(O)+9], V[(O)+13]); CE_(V[(O)+11], V[(O)+15]); CE_(V[(O)+11], V[(O)+13]); CE_(V[(O)+9], V[(O)+10]); CE_(V[(O)+11], V[(O)+12]); CE_(V[(O)+13], V[(O)+14]); CE_(V[(O)+0], V[(O)+8]); CE_(V[(O)+4], V[(O)+12]); CE_(V[(O)+4], V[(O)+8]); CE_(V[(O)+2], V[(O)+10]); CE_(V[(O)+6], V[(O)+14]); CE_(V[(O)+6], V[(O)+10]); CE_(V[(O)+2], V[(O)+4]); CE_(V[(O)+6], V[(O)+8]); CE_(V[(O)+10], V[(O)+12]); CE_(V[(O)+1], V[(O)+9]); CE_(V[(O)+5], V[(O)+13]); CE_(V[(O)+5], V[(O)+9]); CE_(V[(O)+3], V[(O)+11]); CE_(V[(O)+7], V[(O)+15]); CE_(V[(O)+7], V[(O)+11]); CE_(V[(O)+3], V[(O)+5]); CE_(V[(O)+7], V[(O)+9]); CE_(V[(O)+11], V[(O)+13]); CE_(V[(O)+1], V[(O)+2]); CE_(V[(O)+3], V[(O)+4]); CE_(V[(O)+5], V[(O)+6]); CE_(V[(O)+7], V[(O)+8]); CE_(V[(O)+9], V[(O)+10]); CE_(V[(O)+11], V[(O)+12]); CE_(V[(O)+13], V[(O)+14]); } while (0)
#define BITONIC16_DESC(V, O) do { CE_(V[(O)+0], V[(O)+8]); CE_(V[(O)+1], V[(O)+9]); CE_(V[(O)+2], V[(O)+10]); CE_(V[(O)+3], V[(O)+11]); CE_(V[(O)+4], V[(O)+12]); CE_(V[(O)+5], V[(O)+13]); CE_(V[(O)+6], V[(O)+14]); CE_(V[(O)+7], V[(O)+15]); CE_(V[(O)+0], V[(O)+4]); CE_(V[(O)+1], V[(O)+5]); CE_(V[(O)+2], V[(O)+6]); CE_(V[(O)+3], V[(O)+7]); CE_(V[(O)+8], V[(O)+12]); CE_(V[(O)+9], V[(O)+13]); CE_(V[(O)+10], V[(O)+14]); CE_(V[(O)+11], V[(O)+15]); CE_(V[(O)+0], V[(O)+2]); CE_(V[(O)+1], V[(O)+3]); CE_(V[(O)+4], V[(O)+6]); CE_(V[(O)+5], V[(O)+7]); CE_(V[(O)+8], V[(O)+10]); CE_(V[(O)+9], V[(O)+11]); CE_(V[(O)+12], V[(O)+14]); CE_(V[(O)+13], V[(O)+15]); CE_(V[(O)+0], V[(O)+1]); CE_(V[(O)+2], V[(O)+3]); CE_(V[(O)+4], V[(O)+5]); CE_(V[(O)+6], V[(O)+7]); CE_(V[(O)+8], V[(O)+9]); CE_(V[(O)+10], V[(O)+11]); CE_(V[(O)+12], V[(O)+13]); CE_(V[(O)+14], V[(O)+15]); } while (0)
namespace pg8 {
#define PG8_LAS __attribute__((address_space(3)))
typedef unsigned short bf16_t;
typedef short bf16x8 __attribute__((ext_vector_type(8)));
typedef float f32x4 __attribute__((ext_vector_type(4)));
typedef unsigned u32x4 __attribute__((ext_vector_type(4)));
constexpr int BM = 256, BK = 64, HALF = 128, HTB = HALF * BK * 2  , STAGE_BYTES = 8 * HTB, NXCD = 8, WGM = 8;

__host__ __device__ __forceinline__ int lds_byte(int r, int c) { const int st = (r >> 4) * 2 + (c >> 5), rr = r & 15, cc = c & 31, ob = rr * 64 + cc * 2; return st * 1024 + (ob ^ (((ob >> 9) & 1) << 5)); }
__host__ __device__ __forceinline__ void stage_rc(int b, int& R, int& C) { const int st = b / 1024, sb = b % 1024, swz = sb ^ (((sb >> 9) & 1) << 5); R = (st >> 1) * 16 + swz / 64; C = (st & 1) * 32 + (swz % 64) / 2; }
__host__ __device__ __forceinline__ int perm32(int rho) { const int n = rho >> 4, i = rho & 15; return 8 * (i >> 2) + 4 * n + (i & 3); }

struct Unit { int pm, pn; };
struct Gemm { const bf16_t* A; const bf16_t* Bt; int M, N, K; };

struct StaticOrder {
    int nM, nN, nwg, G, c;
    __host__ __device__ void init(int M, int N, int G_, int c_) { nM = M / BM; nN = N / BM; nwg = nM * nN; G = G_; c = c_; }
    __host__ __device__ bool next(int i, Unit& u) const {
        const long L = (long)i * G + c; if (L >= nwg) return false;
        int wgid = (int)L; { const int q = nwg / NXCD, r = nwg % NXCD, xcd = wgid % NXCD, off = wgid / NXCD; wgid = (xcd < r ? xcd * (q + 1) : r * (q + 1) + (xcd - r) * q) + off; }
        const int nig = WGM * nN, gid = wgid / nig, fm = gid * WGM, gsz = (nM - fm) < WGM ? (nM - fm) : WGM;
        u.pm = fm + ((wgid % nig) % gsz); u.pn = (wgid % nig) / gsz; return true;
    }
    __device__ __forceinline__ void a_ready(const Unit&) const {}
    __device__ __forceinline__ void done(const Unit&) const {}
};

__device__ __forceinline__ unsigned cvt_pk_bf16(float lo, float hi) { unsigned r; asm volatile("v_cvt_pk_bf16_f32 %0, %1, %2" : "=v"(r) : "v"(lo), "v"(hi)); return r; }
typedef float f32x2 __attribute__((ext_vector_type(2)));
__device__ __forceinline__ f32x2 gelu_pk(f32x2 v) {
    const f32x2 av = __builtin_elementwise_abs(v), d = av * 0.2316418882f + 1.0f;
    f32x2 t; t.x = __builtin_amdgcn_rcpf(d.x); t.y = __builtin_amdgcn_rcpf(d.y);
    f32x2 q = t * 0.5307027145f + (-0.7265760135f); q = q * t + 0.7107068705f; q = q * t + (-0.142248368f); q = q * t + 0.127414796f; q = q * t;
    const f32x2 s = (v * v) * (-0.72134752044f);
    f32x2 e; e.x = __builtin_amdgcn_exp2f(s.x); e.y = __builtin_amdgcn_exp2f(s.y);
    const f32x2 m = v * (q * e), r = v - m;
    f32x2 o; o.x = v.x < 0.f ? m.x : r.x; o.y = v.y < 0.f ? m.y : r.y; return o;
}

template <int ACT  > struct EpiBf16 {
    static constexpr bool PERM = true, AFTER_DRAIN = false; static_assert(ACT == 0 || ACT == 1, "EpiBf16: ACT is 0 (none) or 1 (gelu_pk)");
    bf16_t* O; int ldc; const float* bias; int split_cols; size_t split_stride; float scale0;
    __device__ __forceinline__ void operator()(const f32x4 (&acc)[2][2][4][2], const Unit& u, int wr, int wc, int fr, int fq) const {
        const int row0 = u.pm * BM + wr * 64 + fr; int colt = u.pn * BM; bf16_t* base = O;
        float sc = 1.f; if (split_cols) { const int t = colt / split_cols; base += (size_t)t * split_stride; colt -= t * split_cols; if (t == 0) sc = scale0; }
        const int col0 = colt + wc * 32 + 8 * fq, bcol0 = u.pn * BM + wc * 32 + 8 * fq;
        f32x4 bv[2][2];
#pragma unroll
        for (int bj = 0; bj < 2; ++bj)
#pragma unroll
            for (int n = 0; n < 2; ++n) bv[bj][n] = bias ? *(const f32x4*)(bias + bcol0 + bj * HALF + 4 * n) : (f32x4){0.f, 0.f, 0.f, 0.f};
#pragma unroll
        for (int ai = 0; ai < 2; ++ai)
#pragma unroll
            for (int m = 0; m < 4; ++m) { bf16_t* rowp = base + (size_t)(row0 + ai * HALF + m * 16) * ldc + col0;
#pragma unroll
                for (int bj = 0; bj < 2; ++bj) { f32x4 v0 = acc[ai][bj][m][0] + bv[bj][0], v1 = acc[ai][bj][m][1] + bv[bj][1];
                    if (ACT == 1) { f32x2 a = gelu_pk((f32x2){v0[0], v0[1]}), b = gelu_pk((f32x2){v0[2], v0[3]}), c = gelu_pk((f32x2){v1[0], v1[1]}), d = gelu_pk((f32x2){v1[2], v1[3]});
                        v0 = (f32x4){a.x, a.y, b.x, b.y}; v1 = (f32x4){c.x, c.y, d.x, d.y}; }
                    v0 = v0 * sc; v1 = v1 * sc; u32x4 w; w.x = cvt_pk_bf16(v0[0], v0[1]); w.y = cvt_pk_bf16(v0[2], v0[3]); w.z = cvt_pk_bf16(v1[0], v1[1]); w.w = cvt_pk_bf16(v1[2], v1[3]);
                    *(u32x4*)(rowp + bj * HALF) = w; } }
    }
};
template <class Epi, class Sched, bool ALIGN_EPI = false, bool SP2 = false>
__device__ __forceinline__ void gemm_phase(PG8_LAS unsigned char* lds, const Gemm g, const Sched& S, const Epi& E) {
    int tid = threadIdx.x; asm volatile("" : "+v"(tid));
    const int wid = __builtin_amdgcn_readfirstlane(tid >> 6), lane = tid & 63, wr = wid >> 2, wc = wid & 3, fr = lane & 15, fq = lane >> 4;
    const int K = g.K, nt = K / BK;
    unsigned voffA[2], voffB[2];
#pragma unroll
    for (int i = 0; i < 2; ++i) { int R, C; stage_rc(tid * 16 + i * 8192, R, C); const int Rb = Epi::PERM ? ((R & ~31) + perm32(R & 31)) : R;
        voffA[i] = (unsigned)(R * K + C) * 2u; voffB[i] = (unsigned)(Rb * K + C) * 2u; }
    const size_t kstep = (size_t)(BK * 2);
    const size_t hstep = (size_t)HALF * K * 2;
    const size_t tstep = 2 * hstep;
    const unsigned ldsw = (unsigned)wid * 1024u;
    const int aoff = lds_byte(wr * 64 + fr, fq * 8), boff = lds_byte(wc * 32 + fr, fq * 8);
#define PG8_SA(b, h) (((b) * 2 + (h)) * HTB)
#define PG8_SB(b, h) ((4 + (b) * 2 + (h)) * HTB)
#define PG8_STAGE(bufoff, gbase, voff) do { _Pragma("unroll") for (int _i = 0; _i < 2; ++_i) \
        __builtin_amdgcn_global_load_lds((const unsigned*)((const char*)(gbase) + (voff)[_i]), (PG8_LAS unsigned*)(lds + (bufoff) + ldsw + _i * 8192), 16, 0, 0); } while (0)
#define PG8_LDA(dst, b, h) do { _Pragma("unroll") for (int m = 0; m < 4; ++m) _Pragma("unroll") for (int k = 0; k < 2; ++k) dst[m][k] = *(const PG8_LAS bf16x8*)(lds + PG8_SA(b, h) + aoff + m * 2048 + k * 1024); } while (0)
#define PG8_LDB(dst, b, h) do { _Pragma("unroll") for (int n = 0; n < 2; ++n) _Pragma("unroll") for (int k = 0; k < 2; ++k) dst[n][k] = *(const PG8_LAS bf16x8*)(lds + PG8_SB(b, h) + boff + n * 2048 + k * 1024); } while (0)
#define PG8_MMA(ai, bj, At, Bt) do { __builtin_amdgcn_s_setprio(1); _Pragma("unroll") for (int m = 0; m < 4; ++m) _Pragma("unroll") for (int n = 0; n < 2; ++n) _Pragma("unroll") for (int k = 0; k < 2; ++k) \
        acc[ai][bj][m][n] = __builtin_amdgcn_mfma_f32_16x16x32_bf16(Bt[n][k], At[m][k], acc[ai][bj][m][n], 0, 0, 0); __builtin_amdgcn_s_setprio(0); } while (0)
#define PG8_WAIT_V(n) asm volatile("s_waitcnt vmcnt(" #n ")" ::: "memory")
#define PG8_WAIT_L(n) asm volatile("s_waitcnt lgkmcnt(" #n ")" ::: "memory")
#define PG8_BAR __builtin_amdgcn_s_barrier()
#define PG8_SCHED __builtin_amdgcn_sched_barrier(0)
    Unit cur, nxt; int ui = 0;
    if (!S.next(0, cur)) return;
    f32x4 acc[2][2][4][2];
#pragma unroll
    for (int a = 0; a < 2; ++a)
#pragma unroll
        for (int b = 0; b < 2; ++b)
#pragma unroll
            for (int m = 0; m < 4; ++m)
#pragma unroll
                for (int n = 0; n < 2; ++n) acc[a][b][m][n] = (f32x4){0.f, 0.f, 0.f, 0.f};
    bf16x8 At[4][2], B0[2][2], B1[2][2];
    const char* cA = (const char*)g.A + (size_t)cur.pm * tstep; const char* cB = (const char*)g.Bt + (size_t)cur.pn * tstep;
    S.a_ready(cur);
    if constexpr (SP2) {
        PG8_STAGE(PG8_SB(0, 0), cB, voffB); PG8_STAGE(PG8_SB(0, 1), cB + hstep, voffB); PG8_STAGE(PG8_SA(0, 0), cA, voffA); PG8_STAGE(PG8_SA(0, 1), cA + hstep, voffA);
        if (wr == 1) PG8_BAR;
        PG8_WAIT_V(2); PG8_BAR;
        PG8_STAGE(PG8_SB(1, 0), cB + kstep, voffB); PG8_STAGE(PG8_SA(1, 0), cA + kstep, voffA); PG8_STAGE(PG8_SB(1, 1), cB + hstep + kstep, voffB);
        PG8_WAIT_V(6); PG8_BAR;
    } else {
        PG8_STAGE(PG8_SB(0, 0), cB, voffB); PG8_STAGE(PG8_SA(0, 0), cA, voffA); PG8_STAGE(PG8_SB(0, 1), cB + hstep, voffB); PG8_STAGE(PG8_SA(0, 1), cA + hstep, voffA);
        if (wr == 1) PG8_BAR;
        PG8_WAIT_V(4); PG8_BAR;
        PG8_STAGE(PG8_SB(1, 0), cB + kstep, voffB); PG8_STAGE(PG8_SA(1, 0), cA + kstep, voffA); PG8_STAGE(PG8_SB(1, 1), cB + hstep + kstep, voffB);
        PG8_WAIT_V(6); PG8_BAR;
    }
    for (;;) {
        const bool has_next = S.next(ui + 1, nxt);
        const char* nA = has_next ? (const char*)g.A + (size_t)nxt.pm * tstep : cA; const char* nB = has_next ? (const char*)g.Bt + (size_t)nxt.pn * tstep : cB;
        for (int t = 0; t < nt; t += 2) {
            const bool last = (t == nt - 2);
            const char* a1 = cA + (size_t)(t + 1) * kstep;
            const char* a2 = last ? nA : cA + (size_t)(t + 2) * kstep; const char* b2 = last ? nB : cB + (size_t)(t + 2) * kstep;
            const char* a3 = a2 + kstep; const char* b3 = b2 + kstep;
            if (last && has_next) S.a_ready(nxt);
            if constexpr (SP2) {
            PG8_LDB(B0, 0, 0); PG8_LDB(B1, 0, 1); PG8_SCHED; PG8_LDA(At, 0, 0); PG8_STAGE(PG8_SA(1, 1), a1 + hstep, voffA);
            PG8_WAIT_V(8); PG8_WAIT_L(0); PG8_BAR; PG8_MMA(0, 0, At, B0); PG8_MMA(0, 1, At, B1); PG8_BAR; PG8_SCHED;
            PG8_LDA(At, 0, 1); PG8_STAGE(PG8_SB(0, 0), b2, voffB); PG8_STAGE(PG8_SB(0, 1), b2 + hstep, voffB); PG8_STAGE(PG8_SA(0, 0), a2, voffA);
            PG8_WAIT_V(8); PG8_WAIT_L(0); PG8_BAR; PG8_MMA(1, 0, At, B0); PG8_MMA(1, 1, At, B1); PG8_BAR; PG8_SCHED;
            PG8_LDB(B0, 1, 0); PG8_LDB(B1, 1, 1); PG8_SCHED; PG8_LDA(At, 1, 0); PG8_STAGE(PG8_SA(0, 1), a2 + hstep, voffA);
            PG8_WAIT_V(8); PG8_WAIT_L(0); PG8_BAR; PG8_MMA(0, 0, At, B0); PG8_MMA(0, 1, At, B1); PG8_BAR; PG8_SCHED;
            PG8_LDA(At, 1, 1); PG8_STAGE(PG8_SB(1, 0), b3, voffB); PG8_STAGE(PG8_SB(1, 1), b3 + hstep, voffB); PG8_STAGE(PG8_SA(1, 0), a3, voffA);
            PG8_WAIT_V(8); PG8_WAIT_L(0); PG8_BAR; PG8_MMA(1, 0, At, B0); PG8_MMA(1, 1, At, B1); PG8_BAR; PG8_SCHED;
            } else {
            PG8_LDB(B0, 0, 0); PG8_SCHED; PG8_LDA(At, 0, 0); PG8_STAGE(PG8_SA(1, 1), a1 + hstep, voffA);
            PG8_WAIT_L(8); PG8_BAR; PG8_WAIT_L(0); PG8_MMA(0, 0, At, B0); PG8_BAR; PG8_SCHED;
            PG8_LDB(B1, 0, 1); PG8_STAGE(PG8_SB(0, 0), b2, voffB);
            PG8_BAR; PG8_WAIT_L(0); PG8_MMA(0, 1, At, B1); PG8_BAR;
            PG8_LDA(At, 0, 1); PG8_STAGE(PG8_SA(0, 0), a2, voffA);
            PG8_BAR; PG8_WAIT_L(0); PG8_MMA(1, 0, At, B0); PG8_BAR; PG8_SCHED;
            PG8_STAGE(PG8_SB(0, 1), b2 + hstep, voffB);
            PG8_WAIT_V(6); PG8_BAR; PG8_MMA(1, 1, At, B1); PG8_BAR;
            PG8_LDB(B0, 1, 0); PG8_SCHED; PG8_LDA(At, 1, 0); PG8_STAGE(PG8_SA(0, 1), a2 + hstep, voffA);
            PG8_WAIT_L(8); PG8_BAR; PG8_WAIT_L(0); PG8_MMA(0, 0, At, B0); PG8_BAR; PG8_SCHED;
            PG8_LDB(B1, 1, 1); PG8_STAGE(PG8_SB(1, 0), b3, voffB);
            PG8_BAR; PG8_WAIT_L(0); PG8_MMA(0, 1, At, B1); PG8_BAR;
            PG8_LDA(At, 1, 1); PG8_STAGE(PG8_SA(1, 0), a3, voffA);
            PG8_BAR; PG8_WAIT_L(0); PG8_MMA(1, 0, At, B0); PG8_BAR; PG8_SCHED;
            PG8_STAGE(PG8_SB(1, 1), b3 + hstep, voffB);
            PG8_WAIT_V(6); PG8_BAR; PG8_MMA(1, 1, At, B1); PG8_BAR;
            }
        }
        if constexpr (ALIGN_EPI) { if (wr == 0) PG8_BAR; }
        if constexpr (!Epi::AFTER_DRAIN) { E(acc, cur, wr, wc, fr, fq); S.done(cur); }
        if (!has_next) break;
#pragma unroll
        for (int a = 0; a < 2; ++a)
#pragma unroll
            for (int b = 0; b < 2; ++b)
#pragma unroll
                for (int m = 0; m < 4; ++m)
#pragma unroll
                    for (int n = 0; n < 2; ++n) acc[a][b][m][n] = (f32x4){0.f, 0.f, 0.f, 0.f};
        cur = nxt; cA = nA; cB = nB; ++ui;
        if constexpr (ALIGN_EPI) { if (wr == 1) PG8_BAR; }
    }
    PG8_WAIT_V(0);
    if constexpr (!ALIGN_EPI) { if (wr == 0) PG8_BAR; }
    PG8_BAR;
    if constexpr (Epi::AFTER_DRAIN) { E.fused(acc, cur, wr, wc, fr, fq, lds, wid, lane); S.done(cur); }
#undef PG8_SA
#undef PG8_SB
#undef PG8_STAGE
#undef PG8_LDA
#undef PG8_LDB
#undef PG8_MMA
#undef PG8_WAIT_V
#undef PG8_WAIT_L
#undef PG8_BAR
#undef PG8_SCHED
}
}

#define LAS __attribute__((address_space(3)))
typedef unsigned short bf16_t;
typedef short bf16x8 __attribute__((ext_vector_type(8)));
typedef short s16x4 __attribute__((ext_vector_type(4)));
typedef float f32x4 __attribute__((ext_vector_type(4)));
typedef float f32x16 __attribute__((ext_vector_type(16)));
typedef unsigned u32x4 __attribute__((ext_vector_type(4)));
typedef unsigned u32x2 __attribute__((ext_vector_type(2)));

constexpr int DM = 1024;
constexpr int NP = 16 * 2048;
constexpr int NS = 8 * 64;
constexpr int NT = NP + NS;
constexpr int DIN = 2560;
constexpr int SKV = 2112;
constexpr float EPS = 1e-6f;
constexpr float LOG2E = 1.4426950408889634f;
constexpr float QSCALE = 0.125f * LOG2E;

constexpr long OUT_Y = 0;
constexpr long OUT_KP = 34078720L, OUT_VP = 50855936L, OUT_CONVP = 67633152L, OUT_KS = 67878912L, OUT_VS = 68141056L, OUT_CONVS = 68403200L, OUT_TOTAL = 68526080L;

constexpr size_t MiB = 1u << 20;
constexpr size_t WS_CTL = 0, CTL_BYTES = 1 * MiB;
constexpr size_t WS_WINT = 1 * MiB;
constexpr size_t WS_WOUTT = 6 * MiB;
constexpr size_t WS_WQT = 8 * MiB;
constexpr size_t WS_SK = 12 * MiB;
constexpr size_t WS_PU8 = 16 * MiB;
constexpr size_t WS_PV8 = 32 * MiB;
constexpr size_t WS_SCU = 48 * MiB;
constexpr size_t WS_SCV = 49 * MiB;
constexpr size_t WS_KS = 80 * MiB;
constexpr size_t WS_VS = 97 * MiB;
constexpr size_t WS_H = 114 * MiB;
constexpr size_t WS_A = 179 * MiB;
constexpr size_t WS_Q = 212 * MiB;
constexpr size_t WS_QP = 114 * MiB;
constexpr size_t WS_KP = 245 * MiB;
constexpr size_t WS_VP = 277 * MiB;
constexpr size_t WS_MIX = 309 * MiB;
constexpr size_t WS_H2 = 309 * MiB;
constexpr size_t WS_TK = 375 * MiB;
constexpr size_t WS_IDX = 408 * MiB;
constexpr size_t WS_GATE = 425 * MiB;
constexpr size_t WS_PACT = 114 * MiB;
constexpr size_t WS_X3 = 114 * MiB;
constexpr size_t WS_COEF = 375 * MiB;
constexpr size_t WS_XG = 442 * MiB;
constexpr size_t WS_SSQ = 507 * MiB;
constexpr size_t WS_RSTD = 510 * MiB;
constexpr size_t WS_END = 511 * MiB;
static_assert(WS_H + (size_t)NT * 1024 * 2 <= WS_A && WS_A + (size_t)NT * 512 * 2 <= WS_Q && WS_Q + (size_t)NT * 512 * 2 <= WS_KP, "R1");
static_assert(WS_QP + (size_t)NT * 2048 * 2 <= WS_KP && WS_KP + (size_t)NP * 512 * 2 <= WS_VP && WS_VP + (size_t)NP * 512 * 2 <= WS_MIX, "ws map");
static_assert(WS_MIX + (size_t)NT * 1024 * 2 <= WS_TK && WS_TK + (size_t)NT * 256 * 4 <= WS_IDX && WS_IDX + (size_t)NT * 128 * 4 <= WS_GATE && WS_GATE + (size_t)NT * 128 * 4 <= WS_END, "ws map 2");
static_assert(WS_KS + (size_t)8 * SKV * 512 * 2 <= WS_VS && WS_VS + (size_t)8 * SKV * 512 * 2 <= WS_H, "ws map 3");

constexpr int RING_BYTES = 131072;
constexpr int BIAS_OFF = RING_BYTES;
constexpr int MISC_OFF = RING_BYTES + 5120;
constexpr int LDS_BYTES = MISC_OFF + 1024;

struct Params {
    const float* in[24];
    float* out;
    unsigned char* ws;
};

__device__ __forceinline__ unsigned cvtpk(float lo, float hi) { return pg8::cvt_pk_bf16(lo, hi); }
__device__ __forceinline__ float bflo(unsigned w) { return __uint_as_float(w << 16); }
__device__ __forceinline__ float bfhi(unsigned w) { return __uint_as_float(w & 0xffff0000u); }
__device__ __forceinline__ float wave_sum(float v) {
#pragma unroll
    for (int o = 1; o < 64; o <<= 1) v += __shfl_xor(v, o);
    return v;
}
typedef float f32x2 __attribute__((ext_vector_type(2)));
#define DPP_ADD(v, ctrl) v += __builtin_bit_cast(float, __builtin_amdgcn_update_dpp(0, __builtin_bit_cast(int, v), ctrl, 0xf, 0xf, true))
__device__ __forceinline__ float rl_f(float v, int l) { return __uint_as_float(__builtin_amdgcn_readlane(__float_as_uint(v), l)); }
__device__ __forceinline__ float wave_total(float v) {
    DPP_ADD(v, 0xB1); DPP_ADD(v, 0x4E); DPP_ADD(v, 0x141); DPP_ADD(v, 0x140);
    return (rl_f(v, 0) + rl_f(v, 16)) + (rl_f(v, 32) + rl_f(v, 48));
}
typedef __bf16 bf16x2_t __attribute__((ext_vector_type(2)));
__device__ __forceinline__ float dot2(unsigned a, unsigned b, float acc) {
    return __builtin_amdgcn_fdot2_f32_bf16(__builtin_bit_cast(bf16x2_t, a), __builtin_bit_cast(bf16x2_t, b), acc, false);
}
#define LDS_WAIT() asm volatile("s_waitcnt lgkmcnt(0)" ::: "memory")

#define XB_TMO      128
#define XB_XCNT(j)  (256  + 64 * (j))
#define XB_XSUB(j)  (1280 + 64 * (j))
#define XB_XGEN(j)  (2304 + 64 * (j))
#define XB_TOP      3328
#define XB_TOPGEN   3392
#define XCD_BAR_WORDS 3456
#define XB_SPIN_CAP (1u << 18)

__device__ __forceinline__ unsigned xb_ld(unsigned* p)              { return __hip_atomic_load(p, __ATOMIC_RELAXED, __HIP_MEMORY_SCOPE_AGENT); }
__device__ __forceinline__ unsigned xb_add(unsigned* p, unsigned v) { return __hip_atomic_fetch_add(p, v, __ATOMIC_RELAXED, __HIP_MEMORY_SCOPE_AGENT); }
__device__ __forceinline__ unsigned xb_xcc_id() { return (unsigned)__builtin_amdgcn_s_getreg((3 << 11) | 20) & 0xFu; }
#define XB_SPIN(cond, bar) do { unsigned _sp = 0; while (cond) { __builtin_amdgcn_s_sleep(1); \
    if ((++_sp & 255u) == 0u) { if (xb_ld(&(bar)[XB_TMO])) break; if (_sp > XB_SPIN_CAP) { atomicAdd(&(bar)[XB_TMO], 1u); break; } } } } while (0)

struct XcdBarrier {
    unsigned* bar; unsigned x;
    volatile LAS unsigned* st;
};

__device__ __forceinline__ XcdBarrier xcd_barrier_post(unsigned* bar, volatile LAS unsigned* st) {
    XcdBarrier b; b.bar = bar; b.x = xb_xcc_id(); b.st = st;
    if (threadIdx.x == 0) (void)xb_add(&bar[XB_XCNT(b.x)], 1u);
    return b;
}
__device__ __forceinline__ void xcd_barrier_complete(unsigned* bar, unsigned x, unsigned& nloc, unsigned& nx) {
    const unsigned G = gridDim.x * gridDim.y * gridDim.z;
    unsigned sum, cnt, mine, sp = 0u;
    for (;;) {
        sum = 0u; cnt = 0u; mine = 0u;
#pragma unroll
        for (unsigned j = 0; j < 16; ++j) { const unsigned c = xb_ld(&bar[XB_XCNT(j)]); sum += c; cnt += (c > 0u) ? 1u : 0u; mine = (j == x) ? c : mine; }
        if (sum == G) break;
        __builtin_amdgcn_s_sleep(1);
        if ((++sp & 255u) == 0u) { if (xb_ld(&bar[XB_TMO])) break; if (sp > XB_SPIN_CAP) { atomicAdd(&bar[XB_TMO], 1u); break; } }
    }
    nloc = mine > 0u ? mine : 1u; nx = cnt > 0u ? cnt : 1u;
}

__device__ __forceinline__ void xcd_barrier(const XcdBarrier& b) {
    asm volatile("s_waitcnt vmcnt(0)" ::: "memory");
    __syncthreads();
    if (threadIdx.x == 0) {
        unsigned* bar = b.bar;
        __builtin_amdgcn_s_waitcnt(0);
        unsigned nloc = b.st[0], nx = b.st[1];
        if (nloc == 0u) { xcd_barrier_complete(bar, b.x, nloc, nx); b.st[0] = nloc; b.st[1] = nx; }
        const unsigned old = xb_add(&bar[XB_XSUB(b.x)], 1u);
        const unsigned gen = old / nloc;
        if (old + 1u == (gen + 1u) * nloc) {
            __builtin_amdgcn_fence(__ATOMIC_RELEASE, "agent");
            asm volatile("s_waitcnt vmcnt(0)" ::: "memory");
            const unsigned og = xb_add(&bar[XB_TOP], 1u);
            const unsigned tg = og / nx;
            if (og + 1u == (tg + 1u) * nx) xb_add(&bar[XB_TOPGEN], 1u);
            else XB_SPIN(xb_ld(&bar[XB_TOPGEN]) == tg, bar);
            __builtin_amdgcn_fence(__ATOMIC_ACQUIRE, "agent");
            xb_add(&bar[XB_XGEN(b.x)], 1u);
            asm volatile("s_waitcnt vmcnt(0)" ::: "memory");
        } else {
            XB_SPIN(xb_ld(&bar[XB_XGEN(b.x)]) == gen, bar);
            __builtin_amdgcn_fence(__ATOMIC_ACQUIRE, "agent");
            asm volatile("s_waitcnt vmcnt(0)" ::: "memory");
        }
    }
    __syncthreads();
}


namespace pg8 {
__device__ __forceinline__ u32x2 pack4(f32x4 v) { u32x2 w; w.x = cvt_pk_bf16(v[0], v[1]); w.y = cvt_pk_bf16(v[2], v[3]); return w; }
struct EpiProj {
    static constexpr bool PERM = true, AFTER_DRAIN = false;
    bf16_t* A; bf16_t* Q; bf16_t* KP; bf16_t* VP; bf16_t* KS; bf16_t* VS; float* out;
    __device__ __forceinline__ void operator()(const f32x4 (&acc)[2][2][4][2], const Unit& u, int wr, int wc, int fr, int fq) const {
        const int pn = u.pn;
        const int row0 = u.pm * BM + wr * 64 + fr;
        if (pn < 4) {
#pragma unroll
            for (int ai = 0; ai < 2; ++ai)
#pragma unroll
                for (int m = 0; m < 4; ++m) {
                    const int row = row0 + ai * HALF + m * 16;
                    long toff = -1;
                    if (row < NP) { const int s = row & 2047; if (s >= 2018) toff = OUT_CONVP + ((long)(row >> 11) * 30 + (s - 2018)) * 512; }
                    else { const int rr = row - NP; const int i = rr & 63; if (i >= 34) toff = OUT_CONVS + ((long)(rr >> 6) * 30 + (i - 34)) * 512; }
                    const int c = 128 * pn + 32 * wc + 8 * fq;
                    f32x4 a[2];
#pragma unroll
                    for (int n = 0; n < 2; ++n) {
                        const f32x4 x = acc[ai][0][m][n], g = acc[ai][1][m][n];
#pragma unroll
                        for (int j = 0; j < 4; ++j) a[n][j] = x[j] / (1.f + __expf(-g[j]));
                    }
                    u32x4 w; w.x = cvt_pk_bf16(a[0][0], a[0][1]); w.y = cvt_pk_bf16(a[0][2], a[0][3]); w.z = cvt_pk_bf16(a[1][0], a[1][1]); w.w = cvt_pk_bf16(a[1][2], a[1][3]);
                    *(u32x4*)(A + (size_t)row * 512 + c) = w;
                    if (toff >= 0) { *(f32x4*)(out + toff + c) = a[0]; *(f32x4*)(out + toff + c + 4) = a[1]; }
                }
        } else {
            const int sec = (pn - 4) >> 1, colbase = ((pn - 4) & 1) * 256;
#pragma unroll
            for (int ai = 0; ai < 2; ++ai)
#pragma unroll
                for (int m = 0; m < 4; ++m) {
                    const int row = row0 + ai * HALF + m * 16;
                    const bool isp = row < NP; const int rr = row - NP;
                    bf16_t* bdst; float* fdst;
                    if (sec == 0) { bdst = Q + (size_t)row * 512; fdst = nullptr; }
                    else if (sec == 1) { bdst = isp ? KP + (size_t)row * 512 : KS + ((size_t)(rr >> 6) * SKV + 2048 + (rr & 63)) * 512; fdst = isp ? out + OUT_KP + (size_t)row * 512 : out + OUT_KS + (size_t)rr * 512; }
                    else { bdst = isp ? VP + (size_t)row * 512 : VS + ((size_t)(rr >> 6) * SKV + 2048 + (rr & 63)) * 512; fdst = isp ? out + OUT_VP + (size_t)row * 512 : out + OUT_VS + (size_t)rr * 512; }
#pragma unroll
                    for (int bj = 0; bj < 2; ++bj) {
                        const int col = colbase + 128 * bj + 32 * wc + 8 * fq;
                        const f32x4 v0 = acc[ai][bj][m][0], v1 = acc[ai][bj][m][1];
                        if (sec == 0) { const f32x4 s0 = v0 * QSCALE, s1 = v1 * QSCALE; u32x4 w; w.x = cvt_pk_bf16(s0[0], s0[1]); w.y = cvt_pk_bf16(s0[2], s0[3]); w.z = cvt_pk_bf16(s1[0], s1[1]); w.w = cvt_pk_bf16(s1[2], s1[3]); *(u32x4*)(bdst + col) = w; }
                        else { u32x4 w; w.x = cvt_pk_bf16(v0[0], v0[1]); w.y = cvt_pk_bf16(v0[2], v0[3]); w.z = cvt_pk_bf16(v1[0], v1[1]); w.w = cvt_pk_bf16(v1[2], v1[3]); *(u32x4*)(bdst + col) = w;
                               __builtin_nontemporal_store(v0, (f32x4*)(fdst + col)); __builtin_nontemporal_store(v1, (f32x4*)(fdst + col + 4)); }
                    }
                }
        }
    }
};
struct EpiRes {
    static constexpr bool PERM = true, AFTER_DRAIN = false;
    const float* xp; const float* xs; bf16_t* xg; const float* gff; float* ssq;
    __device__ __forceinline__ void operator()(const f32x4 (&acc)[2][2][4][2], const Unit& u, int wr, int wc, int fr, int fq) const {
        const int row0 = u.pm * BM + wr * 64 + fr;
        f32x4 gg[2][2];
#pragma unroll
        for (int bj = 0; bj < 2; ++bj)
#pragma unroll
            for (int n = 0; n < 2; ++n) gg[bj][n] = *(const f32x4*)(gff + u.pn * BM + 128 * bj + 32 * wc + 8 * fq + 4 * n);
#pragma unroll
        for (int ai = 0; ai < 2; ++ai)
#pragma unroll
            for (int m = 0; m < 4; ++m) {
                const int row = row0 + ai * HALF + m * 16;
                const float* xr = row < NP ? xp + (size_t)row * DM : xs + (size_t)(row - NP) * DM;
                bf16_t* grow = xg + (size_t)row * DM;
                float sq = 0.f;
#pragma unroll
                for (int bj = 0; bj < 2; ++bj) {
                    const int col = u.pn * BM + 128 * bj + 32 * wc + 8 * fq;
                    const f32x4 v0 = *(const f32x4*)(xr + col) + acc[ai][bj][m][0], v1 = *(const f32x4*)(xr + col + 4) + acc[ai][bj][m][1];
                    const f32x4 h0 = v0 * gg[bj][0], h1 = v1 * gg[bj][1];
                    u32x4 w; w.x = cvt_pk_bf16(h0[0], h0[1]); w.y = cvt_pk_bf16(h0[2], h0[3]); w.z = cvt_pk_bf16(h1[0], h1[1]); w.w = cvt_pk_bf16(h1[2], h1[3]);
                    *(u32x4*)(grow + col) = w;
                    sq += ((v0[0] * v0[0] + v0[1] * v0[1]) + (v0[2] * v0[2] + v0[3] * v0[3])) + ((v1[0] * v1[0] + v1[1] * v1[1]) + (v1[2] * v1[2] + v1[3] * v1[3]));
                }
                sq += __shfl_xor(sq, 16); sq += __shfl_xor(sq, 32);
                if (fq == 0) ssq[(size_t)row * 16 + u.pn * 4 + wc] = sq;
            }
    }
};
}

__device__ __forceinline__ int winrow(int n) { return n < 1024 ? (256 * ((n & 511) >> 7) + 128 * (n >> 9) + (n & 127)) : n; }
template <bool WIN> __device__ __forceinline__ void transpose_item(const float* W, int K, int N, bf16_t* WT, LAS float* scr, int item, int lane) {
    const int nblk = N / 32, kb = item / nblk, nb = item % nblk, k0 = 64 * kb, n0 = 32 * nb;
#pragma unroll 8
    for (int i = 0; i < 32; ++i) { const int kk = 2 * i + (lane >> 5); scr[kk * 33 + (lane & 31)] = W[(size_t)(k0 + kk) * N + n0 + (lane & 31)]; }
    LDS_WAIT();
    const int c = lane & 7;
#pragma unroll
    for (int j = 0; j < 4; ++j) {
        const int n = (lane >> 3) + 8 * j; const LAS float* s = scr + (8 * c) * 33 + n;
        u32x4 o; o.x = cvtpk(s[0 * 33], s[1 * 33]); o.y = cvtpk(s[2 * 33], s[3 * 33]); o.z = cvtpk(s[4 * 33], s[5 * 33]); o.w = cvtpk(s[6 * 33], s[7 * 33]);
        const int dr = WIN ? winrow(n0 + n) : (n0 + n);
        *(u32x4*)(WT + (size_t)dr * K + k0 + 8 * c) = o;
    }
    LDS_WAIT();
}
__device__ __forceinline__ void cvt_stream(const float* src, bf16_t* dst, size_t n8, size_t gt, size_t ngt) {
    for (size_t i = gt; i < n8; i += ngt) {
        const f32x4 a = *(const f32x4*)(src + i * 8), b = *(const f32x4*)(src + i * 8 + 4);
        u32x4 o; o.x = cvtpk(a[0], a[1]); o.y = cvtpk(a[2], a[3]); o.z = cvtpk(b[0], b[1]); o.w = cvtpk(b[2], b[3]);
        *(u32x4*)(dst + i * 8) = o;
    }
}
__device__ __forceinline__ void cvt_cache(const float* src, bf16_t* dst, size_t gt, size_t ngt) {
    const size_t n8 = (size_t)8 * 2048 * 512 / 8;
    for (size_t i = gt; i < n8; i += ngt) {
        const size_t e = i * 8; const size_t row = e >> 9, col = e & 511; const size_t drow = (row >> 11) * SKV + (row & 2047);
        const f32x4 a = *(const f32x4*)(src + e), b = *(const f32x4*)(src + e + 4);
        u32x4 o; o.x = cvtpk(a[0], a[1]); o.y = cvtpk(a[2], a[3]); o.z = cvtpk(b[0], b[1]); o.w = cvtpk(b[2], b[3]);
        *(u32x4*)(dst + drow * 512 + col) = o;
    }
}
__device__ __forceinline__ void rms_row_bf16(const float* xrow, const float* g, bf16_t* orow, int lane) {
    const f32x4* xr = (const f32x4*)xrow + lane; const f32x4* gr = (const f32x4*)g + lane;
    f32x4 v[4]; float s = 0.f;
#pragma unroll
    for (int j = 0; j < 4; ++j) { v[j] = xr[64 * j]; s += (v[j][0] * v[j][0] + v[j][1] * v[j][1]) + (v[j][2] * v[j][2] + v[j][3] * v[j][3]); }
    const float rstd = 1.f / sqrtf(wave_sum(s) * (1.f / DM) + EPS);
    u32x2* o8 = (u32x2*)orow + lane;
#pragma unroll
    for (int j = 0; j < 4; ++j) { const f32x4 gg = gr[64 * j]; u32x2 w; w.x = cvtpk(v[j][0] * rstd * gg[0], v[j][1] * rstd * gg[1]); w.y = cvtpk(v[j][2] * rstd * gg[2], v[j][3] * rstd * gg[3]); o8[64 * j] = w; }
}

template <bool SLICED> __device__ __forceinline__ void cvt_row_fp8(const float* src, unsigned char* dst_base, int row, float* scale_out, int lane) {
    const f32x4* xr = (const f32x4*)src + lane;
    f32x4 v[4]; float am = 0.f;
#pragma unroll
    for (int j = 0; j < 4; ++j) { v[j] = xr[64 * j]; am = fmaxf(am, fmaxf(fmaxf(fabsf(v[j][0]), fabsf(v[j][1])), fmaxf(fabsf(v[j][2]), fabsf(v[j][3])))); }
#pragma unroll
    for (int o = 1; o < 64; o <<= 1) am = fmaxf(am, __shfl_xor(am, o));
    const float sc = am > 0.f ? am * (1.f / 448.f) : 1.f, inv = 1.f / sc;
#pragma unroll
    for (int j = 0; j < 4; ++j) {
        const int eb = 256 * j + 4 * lane;
        int w = __builtin_amdgcn_cvt_pk_fp8_f32(v[j][0] * inv, v[j][1] * inv, 0, false);
        w = __builtin_amdgcn_cvt_pk_fp8_f32(v[j][2] * inv, v[j][3] * inv, w, true);
        if (SLICED) *(int*)(dst_base + ((size_t)(eb >> 7) * 16384 + row) * 128 + (eb & 127)) = w;
        else *(int*)(dst_base + (size_t)row * DM + 16 * ((eb & 511) >> 3) + (eb & 7) + (eb >= 512 ? 8 : 0)) = w;
    }
    if (lane == 0) *scale_out = sc;
}

__device__ __forceinline__ void rms_row2_bf16(const float* xa, const float* xb, const float* g, bf16_t* oa, bf16_t* ob, int lane) {
    const f32x4* ra = (const f32x4*)xa + lane; const f32x4* rb = (const f32x4*)xb + lane; const f32x4* gr = (const f32x4*)g + lane;
    f32x4 va[4], vb[4]; float sa = 0.f, sb = 0.f;
#pragma unroll
    for (int j = 0; j < 4; ++j) { va[j] = ra[64 * j]; vb[j] = rb[64 * j]; }
#pragma unroll
    for (int j = 0; j < 4; ++j) { sa += (va[j][0] * va[j][0] + va[j][1] * va[j][1]) + (va[j][2] * va[j][2] + va[j][3] * va[j][3]); sb += (vb[j][0] * vb[j][0] + vb[j][1] * vb[j][1]) + (vb[j][2] * vb[j][2] + vb[j][3] * vb[j][3]); }
    const float ra_ = 1.f / sqrtf(wave_total(sa) * (1.f / DM) + EPS), rb_ = 1.f / sqrtf(wave_total(sb) * (1.f / DM) + EPS);
    u32x2* o8a = (u32x2*)oa + lane; u32x2* o8b = (u32x2*)ob + lane;
#pragma unroll
    for (int j = 0; j < 4; ++j) { const f32x4 gg = gr[64 * j];
        u32x2 w; w.x = cvtpk(va[j][0] * ra_ * gg[0], va[j][1] * ra_ * gg[1]); w.y = cvtpk(va[j][2] * ra_ * gg[2], va[j][3] * ra_ * gg[3]); o8a[64 * j] = w;
        u32x2 z; z.x = cvtpk(vb[j][0] * rb_ * gg[0], vb[j][1] * rb_ * gg[1]); z.y = cvtpk(vb[j][2] * rb_ * gg[2], vb[j][3] * rb_ * gg[3]); o8b[64 * j] = z; }
}
__device__ __forceinline__ void cvt_row_i8(const float* src, unsigned char* dst_base, int row, float* scale_out, int lane) {
    const f32x4* xr = (const f32x4*)src + lane;
    f32x4 v[4]; float am = 0.f;
#pragma unroll
    for (int j = 0; j < 4; ++j) { v[j] = xr[64 * j]; am = fmaxf(am, fmaxf(fmaxf(fabsf(v[j][0]), fabsf(v[j][1])), fmaxf(fabsf(v[j][2]), fabsf(v[j][3])))); }
#pragma unroll
    for (int o = 1; o < 64; o <<= 1) am = fmaxf(am, __shfl_xor(am, o));
    const float sc = am > 0.f ? am * (1.f / 127.f) : 1.f, inv = 1.f / sc;
#pragma unroll
    for (int j = 0; j < 4; ++j) {
        const int eb = 256 * j + 4 * lane;
        const int q0 = __float2int_rn(v[j][0] * inv), q1 = __float2int_rn(v[j][1] * inv), q2 = __float2int_rn(v[j][2] * inv), q3 = __float2int_rn(v[j][3] * inv);
        const unsigned w = (unsigned)(q0 & 255) | ((unsigned)(q1 & 255) << 8) | ((unsigned)(q2 & 255) << 16) | ((unsigned)(q3 & 255) << 24);
        *(unsigned*)(dst_base + ((size_t)(eb >> 7) * 16384 + row) * 128 + (eb & 127)) = w;
    }
    if (lane == 0) *scale_out = sc;
}
__device__ __forceinline__ void phase0(const Params& p, LAS unsigned char* lds, int tid, int lane, int wave) {
    const int gw = blockIdx.x * 8 + wave, NGW = gridDim.x * 8;
    LAS float* scr = (LAS float*)(lds + wave * 16384);
    bf16_t* WINT = (bf16_t*)(p.ws + WS_WINT);
    constexpr int I_IN = 16 * (DIN / 32);
    for (int it = gw; it < I_IN; it += NGW) transpose_item<true>(p.in[6], 1024, DIN, WINT, scr, it, lane);
    bf16_t* H = (bf16_t*)(p.ws + WS_H);
    for (int m = gw; m < NT; m += 2 * NGW) {
        const int m2 = m + NGW < NT ? m + NGW : m;
        const float* xr = m < NP ? p.in[0] + (size_t)m * DM : p.in[1] + (size_t)(m - NP) * DM;
        const float* xr2 = m2 < NP ? p.in[0] + (size_t)m2 * DM : p.in[1] + (size_t)(m2 - NP) * DM;
        rms_row2_bf16(xr, xr2, p.in[5], H + (size_t)m * DM, H + (size_t)m2 * DM, lane);
    }
}
__device__ __forceinline__ void prep_late(const Params& p, LAS unsigned char* lds, int tid, int lane, int wave, int rank, int nparts) {
    const int gw = rank * 8 + wave, NGW = nparts * 8;
    LAS float* scr = (LAS float*)(lds + wave * 16384);
    const size_t gt = (size_t)rank * 512 + tid, ngt = (size_t)nparts * 512;
    cvt_cache(p.in[2], (bf16_t*)(p.ws + WS_KS), gt, ngt);
    cvt_cache(p.in[3], (bf16_t*)(p.ws + WS_VS), gt, ngt);
    bf16_t* WOUTT = (bf16_t*)(p.ws + WS_WOUTT); bf16_t* WQT = (bf16_t*)(p.ws + WS_WQT);
    constexpr int I_OUT = 16 * (1024 / 32), I_Q = 16 * (2048 / 32);
    for (int it = gw; it < I_OUT + I_Q; it += NGW) {
        if (it < I_OUT) transpose_item<false>(p.in[17], 1024, 1024, WOUTT, scr, it, lane);
        else transpose_item<false>(p.in[19], 1024, 2048, WQT, scr, it - I_OUT, lane);
    }
    cvt_stream(p.in[20], (bf16_t*)(p.ws + WS_SK), (size_t)16 * 128 * 128 / 8, gt, ngt);
    for (int r = gw; r < 2 * 16384; r += NGW) {
        const int tb = r >> 14, e = r & 16383;
        if (tb) cvt_row_fp8<true>(p.in[22] + (size_t)e * DM, p.ws + WS_PV8, e, (float*)(p.ws + WS_SCV) + e, lane);
        else cvt_row_i8(p.in[21] + (size_t)e * DM, p.ws + WS_PU8, e, (float*)(p.ws + WS_SCU) + e, lane);
    }
}

namespace att {
constexpr int KPITCH = 272, VPITCH = 320;
constexpr int L_KV = 0, KV_BYTES = 64 * KPITCH + 64 * VPITCH  , L_X = 0  , L_BIAS = BIAS_OFF, L_CA = 0  , L_CW = 94 * 1024  ;
static_assert(4 * 4096 * 4 <= 2 * KV_BYTES && 2 * KV_BYTES <= L_CW && L_CW + 31 * 1024 <= RING_BYTES, "attention LDS map");

__device__ __forceinline__ int rel_bucket(int rel) {
    const int ret = rel > 0 ? 16 : 0; const int n = rel < 0 ? -rel : rel; int v;
    if (n < 8) v = n; else if (n < 12) v = 8; else if (n < 16) v = 9; else if (n < 23) v = 10; else if (n < 32) v = 11;
    else if (n < 46) v = 12; else if (n < 64) v = 13; else if (n < 91) v = 14; else v = 15;
    return ret + v;
}
typedef short v4i16_t __attribute__((ext_vector_type(4)));
__device__ __forceinline__ s16x4 vtr(const LAS unsigned char* p) { return __builtin_bit_cast(s16x4, __builtin_amdgcn_ds_read_tr16_b64_v4i16((LAS v4i16_t*)p)); }
__device__ __forceinline__ f32x16 mfma32(bf16x8 a, bf16x8 b, f32x16 c) { return __builtin_amdgcn_mfma_f32_32x32x16_bf16(a, b, c, 0, 0, 0); }

__device__ __forceinline__ void attn_unit(const Params& p, LAS unsigned char* lds, int kind, int bb, int h, int qblk, float lam, int tid, int lane, int wid) {
    const bf16_t* Q = (const bf16_t*)(p.ws + WS_Q);
    const bf16_t* Kb = kind == 0 ? (const bf16_t*)(p.ws + WS_KP) + (size_t)bb * 2048 * 512 + h * 128 : (const bf16_t*)(p.ws + WS_KS) + (size_t)bb * SKV * 512 + h * 128;
    const bf16_t* Vb = kind == 0 ? (const bf16_t*)(p.ws + WS_VP) + (size_t)bb * 2048 * 512 + h * 128 : (const bf16_t*)(p.ws + WS_VS) + (size_t)bb * SKV * 512 + h * 128;
    bf16_t* MIX = (bf16_t*)(p.ws + WS_MIX);
    const int qrow0 = kind == 0 ? bb * 2048 + qblk * 128 : NP + bb * 64;
    const int qpos0 = kind == 0 ? qblk * 128 : 2048;
    const int ntiles = kind == 0 ? 2 * qblk + 2 : 33;
    const int rg = wid & 3, map = wid >> 2, r32 = lane & 31, hi = lane >> 5;
    const bool active = kind == 0 ? true : (rg < 2);
    const int cw = kind == 0 ? 2 * qblk + (rg >> 1) : 32;
    const int qw0 = qpos0 + 32 * rg;
    const int qabs = qw0 + r32;

    bf16x8 qf[4];
    if (active) {
        const bf16_t* qp = Q + (size_t)(qrow0 + 32 * rg + r32) * 512 + h * 128 + map * 64 + 8 * hi;
#pragma unroll
        for (int s = 0; s < 4; ++s) qf[s] = *(const bf16x8*)(qp + 16 * s);
    } else {
#pragma unroll
        for (int s = 0; s < 4; ++s) qf[s] = (bf16x8){0, 0, 0, 0, 0, 0, 0, 0};
    }
    float m = 0.f, l = 0.f;
    f32x16 negm;
#pragma unroll
    for (int r = 0; r < 16; ++r) negm[r] = 0.f;
    f32x16 o[4];
#pragma unroll
    for (int mt = 0; mt < 4; ++mt)
#pragma unroll
        for (int r = 0; r < 16; ++r) o[mt][r] = 0.f;

    const int srow0 = tid >> 4, sch = tid & 15;
    const LAS float* btab = (const LAS float*)(lds + L_BIAS) + h * 320;
    const int vlane = (4 * hi + ((lane & 15) >> 2)) * VPITCH + (16 * ((lane >> 4) & 1) + 4 * (lane & 3)) * 2;
    u32x4 kA[2], vA[2], kB[2], vB[2];
#define ATT_LOAD(KR, VR, T) do { _Pragma("unroll") for (int i_ = 0; i_ < 2; ++i_) { const size_t off_ = (size_t)((T) * 64 + srow0 + 32 * i_) * 512 + sch * 8; KR[i_] = *(const u32x4*)(Kb + off_); VR[i_] = *(const u32x4*)(Vb + off_); } } while (0)
#define ATT_STORE(KR, VR, BUF) do { _Pragma("unroll") for (int i_ = 0; i_ < 2; ++i_) { \
        *(LAS u32x4*)(lds + L_KV + (BUF) * KV_BYTES + (srow0 + 32 * i_) * KPITCH + sch * 16) = KR[i_]; \
        *(LAS u32x4*)(lds + L_KV + (BUF) * KV_BYTES + 64 * KPITCH + (srow0 + 32 * i_) * VPITCH + sch * 16) = VR[i_]; } } while (0)
    auto compute = [&](int t, int buf) {
        const LAS unsigned char* kbuf = lds + L_KV + buf * KV_BYTES;
        const LAS unsigned char* vbuf = kbuf + 64 * KPITCH;
        f32x16 p0, p1;
        const int kabs0 = t * 64;
        const LAS unsigned char* kb = kbuf + r32 * KPITCH + (map * 8 + hi) * 16;
        {
            const bf16x8 a0 = *(const LAS bf16x8*)(kb), a1 = *(const LAS bf16x8*)(kb + 32 * KPITCH);
            if (kabs0 + 63 - qw0 > -128) {
                const LAS float* bt = btab + (kabs0 - qabs + 256 + 4 * hi);
#pragma unroll
                for (int r = 0; r < 16; ++r) { p0[r] = bt[(r & 3) + 8 * (r >> 2)] - m; p1[r] = bt[32 + (r & 3) + 8 * (r >> 2)] - m; }
                p0 = mfma32(a0, qf[0], p0); p1 = mfma32(a1, qf[0], p1);
            } else { p0 = mfma32(a0, qf[0], negm); p1 = mfma32(a1, qf[0], negm); }
        }
#pragma unroll
        for (int s = 1; s < 4; ++s) {
            const bf16x8 a0 = *(const LAS bf16x8*)(kb + s * 32), a1 = *(const LAS bf16x8*)(kb + 32 * KPITCH + s * 32);
            p0 = mfma32(a0, qf[s], p0); p1 = mfma32(a1, qf[s], p1);
        }
        float mx = fmaxf(p0[0], p1[0]);
#pragma unroll
        for (int r = 1; r < 16; ++r) mx = fmaxf(mx, fmaxf(p0[r], p1[r]));
        { const auto rr = __builtin_amdgcn_permlane32_swap(__float_as_uint(mx), __float_as_uint(mx), false, false); mx = fmaxf(__uint_as_float(rr[0]), __uint_as_float(rr[1])); }
        if (__any(mx > 8.f)) {
            const float dl = fmaxf(mx, 0.f);
            m += dl;
            const float alpha = __builtin_amdgcn_exp2f(-dl);
            l *= alpha;
#pragma unroll
            for (int r = 0; r < 16; ++r) { p0[r] -= dl; p1[r] -= dl; negm[r] = -m; }
#pragma unroll
            for (int mt = 0; mt < 4; ++mt)
#pragma unroll
                for (int r = 0; r < 16; ++r) o[mt][r] *= alpha;
        }
        float rs = 0.f;
#pragma unroll
        for (int r = 0; r < 16; ++r) { p0[r] = __builtin_amdgcn_exp2f(p0[r]); p1[r] = __builtin_amdgcn_exp2f(p1[r]); rs += p0[r] + p1[r]; }
        l += rs;
#pragma unroll
        for (int t2 = 0; t2 < 2; ++t2)
#pragma unroll
            for (int s = 0; s < 2; ++s) {
                u32x4 bw;
                if (t2 == 0) { bw.x = cvtpk(p0[8 * s + 0], p0[8 * s + 1]); bw.y = cvtpk(p0[8 * s + 2], p0[8 * s + 3]); bw.z = cvtpk(p0[8 * s + 4], p0[8 * s + 5]); bw.w = cvtpk(p0[8 * s + 6], p0[8 * s + 7]); }
                else { bw.x = cvtpk(p1[8 * s + 0], p1[8 * s + 1]); bw.y = cvtpk(p1[8 * s + 2], p1[8 * s + 3]); bw.z = cvtpk(p1[8 * s + 4], p1[8 * s + 5]); bw.w = cvtpk(p1[8 * s + 6], p1[8 * s + 7]); }
                const bf16x8 B = __builtin_bit_cast(bf16x8, bw);
                const LAS unsigned char* vb = vbuf + vlane + (32 * t2 + 16 * s) * VPITCH;
#pragma unroll
                for (int mt = 0; mt < 4; ++mt) {
                    const s16x4 lo = vtr(vb + mt * 64), hi8 = vtr(vb + mt * 64 + 8 * VPITCH);
                    const bf16x8 A = (bf16x8){lo[0], lo[1], lo[2], lo[3], hi8[0], hi8[1], hi8[2], hi8[3]};
                    o[mt] = mfma32(A, B, o[mt]);
                }
            }
    };
    ATT_LOAD(kA, vA, 0);
    if (ntiles > 1) ATT_LOAD(kB, vB, 1);
    ATT_STORE(kA, vA, 0);
    if (ntiles > 2) ATT_LOAD(kA, vA, 2);
    __syncthreads();
    for (int t = 0; t < ntiles; t += 2) {
        if (t + 1 < ntiles) { ATT_STORE(kB, vB, 1); if (t + 3 < ntiles) ATT_LOAD(kB, vB, t + 3); }
        if (active && t <= cw) compute(t, 0);
        __syncthreads();
        if (t + 1 >= ntiles) break;
        if (t + 2 < ntiles) { ATT_STORE(kA, vA, 0); if (t + 4 < ntiles) ATT_LOAD(kA, vA, t + 4); }
        if (active && t + 1 <= cw) compute(t + 1, 1);
        __syncthreads();
    }
#undef ATT_LOAD
#undef ATT_STORE
    l += __shfl_xor(l, 32);
    const float inv = 1.f / l;
    LAS float* X = (LAS float*)(lds + L_X) + rg * 4096;
    if (active && map == 1) {
        const float sc = -lam * inv;
#pragma unroll
        for (int mt = 0; mt < 4; ++mt)
#pragma unroll
            for (int r = 0; r < 16; ++r) X[(mt * 16 + r) * 64 + lane] = o[mt][r] * sc;
    }
    __syncthreads();
    if (active && map == 0) {
        float ss = 0.f;
#pragma unroll
        for (int mt = 0; mt < 4; ++mt)
#pragma unroll
            for (int r = 0; r < 16; ++r) { const float v = o[mt][r] * inv + X[(mt * 16 + r) * 64 + lane]; o[mt][r] = v; ss += v * v; }
        ss += __shfl_xor(ss, 32);
        const float rsn = 0.8f / sqrtf(ss * (1.f / 128.f) + EPS);
        bf16_t* orow = MIX + (size_t)(qrow0 + 32 * rg + r32) * 1024 + 512 + h * 128;
        const float* sg = p.in[15];
#pragma unroll
        for (int mt = 0; mt < 4; ++mt)
#pragma unroll
            for (int g4 = 0; g4 < 4; ++g4) {
                const int e = 32 * mt + 8 * g4 + 4 * hi;
                const f32x4 gg = *(const f32x4*)(sg + e);
                u32x2 w; w.x = cvtpk(o[mt][4 * g4 + 0] * rsn * gg[0], o[mt][4 * g4 + 1] * rsn * gg[1]); w.y = cvtpk(o[mt][4 * g4 + 2] * rsn * gg[2], o[mt][4 * g4 + 3] * rsn * gg[3]);
                *(u32x2*)(orow + e) = w;
            }
    }
    __syncthreads();
}

__device__ __forceinline__ void unpack8(const u32x4 w, float (&f)[8]) { f[0] = bflo(w.x); f[1] = bfhi(w.x); f[2] = bflo(w.y); f[3] = bfhi(w.y); f[4] = bflo(w.z); f[5] = bfhi(w.z); f[6] = bflo(w.w); f[7] = bfhi(w.w); }
__device__ __forceinline__ void conv_unit(const Params& p, LAS unsigned char* lds, int cu, int tid, int lane, int wid) {
    const bf16_t* A = (const bf16_t*)(p.ws + WS_A);
    bf16_t* MIX = (bf16_t*)(p.ws + WS_MIX);
    const float* cb = p.in[8]; const float* lg = p.in[9]; const float* lb = p.in[10]; const float* st = p.in[4];
    const int row0 = cu * 64;
    const bool isp = row0 < NP;
    const int s0 = isp ? (row0 & 2047) : 0, rbase = row0 - s0, bd = isp ? 0 : ((row0 - NP) >> 6);
    for (int c = tid; c < 94 * 64; c += 512) {
        const int rr = c >> 6, ch = c & 63, sp = s0 - 30 + rr;
        u32x4 v = (u32x4){0u, 0u, 0u, 0u};
        if (sp >= 0) v = *(const u32x4*)(A + (size_t)(rbase + sp) * 512 + ch * 8);
        else if (!isp) { const float* sr = st + ((size_t)bd * 30 + (30 + sp)) * 512 + ch * 8; const f32x4 a0 = *(const f32x4*)sr, a1 = *(const f32x4*)(sr + 4);
            v.x = cvtpk(a0[0], a0[1]); v.y = cvtpk(a0[2], a0[3]); v.z = cvtpk(a1[0], a1[1]); v.w = cvtpk(a1[2], a1[3]); }
        *(LAS u32x4*)(lds + L_CA + rr * 1024 + ch * 16) = v;
    }
    __syncthreads();
    {
        const LAS unsigned short* ac = (const LAS unsigned short*)(lds + L_CA) + tid;
        const LAS unsigned short* wc = (const LAS unsigned short*)(lds + L_CW) + tid;
        unsigned P[47];
#pragma unroll
        for (int k = 0; k < 47; ++k) P[k] = (unsigned)ac[(2 * k) * 512] | ((unsigned)ac[(2 * k + 1) * 512] << 16);
        unsigned WE[16], WO[16];
#pragma unroll
        for (int m = 0; m < 16; ++m) {
            const unsigned w0 = wc[(2 * m) * 512], w1 = (2 * m + 1 <= 30) ? (unsigned)wc[(2 * m + 1) * 512] : 0u, wm = (m > 0) ? (unsigned)wc[(2 * m - 1) * 512] : 0u;
            WE[m] = w0 | (w1 << 16);
            WO[m] = wm | (w0 << 16);
        }
        const float bias = cb[tid];
        __syncthreads();
        LAS unsigned short* yc = (LAS unsigned short*)(lds + L_CA) + tid;
#pragma unroll
        for (int u = 0; u < 32; ++u) {
            float ye = bias, yo = bias;
#pragma unroll
            for (int m = 0; m < 16; ++m) {
                const unsigned pp = P[u + m];
                ye += bflo(WE[m]) * bflo(pp) + bfhi(WE[m]) * bfhi(pp);
                yo += bflo(WO[m]) * bflo(pp) + bfhi(WO[m]) * bfhi(pp);
            }
            const unsigned w = cvtpk(ye, yo);
            yc[(2 * u) * 512] = (unsigned short)(w & 0xffffu); yc[(2 * u + 1) * 512] = (unsigned short)(w >> 16);
        }
    }
    __syncthreads();
    {
        const int c0 = lane * 8;
        float g8[8], b8[8];
        { const f32x4 y0 = *(const f32x4*)(lg + c0), y1 = *(const f32x4*)(lg + c0 + 4), z0 = *(const f32x4*)(lb + c0), z1 = *(const f32x4*)(lb + c0 + 4);
#pragma unroll
          for (int q = 0; q < 4; ++q) { g8[q] = y0[q]; g8[4 + q] = y1[q]; b8[q] = z0[q]; b8[4 + q] = z1[q]; } }
#pragma unroll 2
        for (int i = 0; i < 8; ++i) {
            const int t = wid * 8 + i;
            float y[8]; unpack8(*(const LAS u32x4*)(lds + L_CA + t * 1024 + lane * 16), y);
            float sm = 0.f, sq = 0.f;
#pragma unroll
            for (int c = 0; c < 8; ++c) { sm += y[c]; sq += y[c] * y[c]; }
            const float mu = wave_total(sm) * (1.f / 512.f);
            const float var = fmaxf(wave_total(sq) * (1.f / 512.f) - mu * mu, 0.f);
            const float rstd = 1.f / sqrtf(var + EPS);
#pragma unroll
            for (int c = 0; c < 8; ++c) { y[c] = (y[c] - mu) * rstd * g8[c] + b8[c]; y[c] = y[c] / (1.f + __expf(-y[c])); }
            u32x4 w; w.x = cvtpk(y[0], y[1]); w.y = cvtpk(y[2], y[3]); w.z = cvtpk(y[4], y[5]); w.w = cvtpk(y[6], y[7]);
            *(u32x4*)(MIX + (size_t)(row0 + t) * 1024 + c0) = w;
        }
    }
}

constexpr int N_SAMPLE_UNITS = 32, N_PROMPT_UNITS = 1024, N_CONV_UNITS = NT / 64, N_UNITS = N_SAMPLE_UNITS + N_PROMPT_UNITS + N_CONV_UNITS;

__device__ __forceinline__ void phase2(const Params& p, LAS unsigned char* lds, int tid, int lane, int wid, int cidx, int mode) {
    LAS float* bt = (LAS float*)(lds + L_BIAS);
    for (int e = tid; e < 4 * 320; e += 512) { const int hh = e / 320, rel = (e % 320) - 256; bt[e] = (p.in[16][rel_bucket(rel) * 4 + hh] - p.in[16][15 * 4 + hh]) * LOG2E; }
    for (int c = tid; c < 31 * 64; c += 512) {
        const float* wr = p.in[7] + (size_t)c * 8; const f32x4 a0 = *(const f32x4*)wr, a1 = *(const f32x4*)(wr + 4);
        u32x4 v; v.x = cvtpk(a0[0], a0[1]); v.y = cvtpk(a0[2], a0[3]); v.z = cvtpk(a1[0], a1[1]); v.w = cvtpk(a1[2], a1[3]);
        *(LAS u32x4*)(lds + L_CW + c * 16) = v;
    }
    const float d1 = wave_sum(p.in[11][lane] * p.in[12][lane]), d2 = wave_sum(p.in[13][lane] * p.in[14][lane]);
    const float lam = expf(d1) - expf(d2) + 0.2f;
    unsigned* ctr = (unsigned*)(p.ws + WS_CTL) + 64 * cidx;
    volatile LAS unsigned* sw = (volatile LAS unsigned*)(lds + MISC_OFF);
    __syncthreads();
    for (;;) {
        __syncthreads();
        if (tid == 0) sw[0] = atomicAdd(ctr, 1u);
        __syncthreads();
        const int u = (int)sw[0];
        if (u >= N_UNITS) break;
        if (mode == 1 && u >= N_SAMPLE_UNITS + N_PROMPT_UNITS) continue;
        if (mode == 2 && u < N_SAMPLE_UNITS + N_PROMPT_UNITS) continue;
        int tid_ = tid; asm volatile("" : "+v"(tid_));
        if (u < N_SAMPLE_UNITS + N_PROMPT_UNITS) {
            const int v = u - N_SAMPLE_UNITS; const int bh = v & 63; const bool smp = u < N_SAMPLE_UNITS;
            attn_unit(p, lds, smp ? 1 : 0, smp ? (u >> 2) : (bh >> 2), smp ? (u & 3) : (bh & 3), smp ? 0 : 15 - (v >> 6), lam, tid_, tid_ & 63, wid);
        } else conv_unit(p, lds, u - N_SAMPLE_UNITS - N_PROMPT_UNITS, tid_, tid_ & 63, wid);
    }
}
}

template <class F> __device__ __forceinline__ void mini_gemm(const bf16_t* A, const bf16_t* Bt, int N, int lane, int wave, F epi) {
    const int ntasks = 32 * (N / 64), G = gridDim.x;
    const int fr = lane & 15, fq = lane >> 4;
    for (int task = wave * G + (int)blockIdx.x; task < ntasks; task += 8 * G) {
        const int rb = task & 31, cb = task >> 5;
        pg8::f32x4 acc[4];
#pragma unroll
        for (int n = 0; n < 4; ++n) acc[n] = (pg8::f32x4){0.f, 0.f, 0.f, 0.f};
        const bf16_t* ap = A + (size_t)(rb * 16 + fr) * 1024 + 8 * fq;
        const bf16_t* bp = Bt + (size_t)(cb * 64 + fr) * 1024 + 8 * fq;
#pragma unroll 8
        for (int k0 = 0; k0 < 1024; k0 += 32) {
            const bf16x8 a0 = *(const bf16x8*)(ap + k0);
            bf16x8 b[4];
#pragma unroll
            for (int n = 0; n < 4; ++n) b[n] = *(const bf16x8*)(bp + (size_t)n * 16 * 1024 + k0);
#pragma unroll
            for (int n = 0; n < 4; ++n) acc[n] = __builtin_amdgcn_mfma_f32_16x16x32_bf16(b[n], a0, acc[n], 0, 0, 0);
        }
        epi(rb * 16 + fr, cb, fq, acc);
    }
}

__device__ __forceinline__ void phase3b(const Params& p, int lane, int wave) {
    const int gw = blockIdx.x * 8 + wave, NGW = gridDim.x * 8;
    bf16_t* H2 = (bf16_t*)(p.ws + WS_H2);
    for (int m = gw; m < NT; m += 2 * NGW) { const int m2 = m + NGW < NT ? m + NGW : m; rms_row2_bf16(p.out + (size_t)m * DM, p.out + (size_t)m2 * DM, p.in[18], H2 + (size_t)m * DM, H2 + (size_t)m2 * DM, lane); }
}

constexpr int P4B_KPITCH = 272, P4B_K_BYTES = 128 * P4B_KPITCH, P4B_Q_BYTES = 32 * P4B_KPITCH;
static_assert(P4B_K_BYTES + 8 * P4B_Q_BYTES <= RING_BYTES, "P4b LDS map");
__device__ __forceinline__ void phase4b(const Params& p, LAS unsigned char* lds, int tid, int lane, int wave) {
    const bf16_t* QP = (const bf16_t*)(p.ws + WS_QP); const bf16_t* SK = (const bf16_t*)(p.ws + WS_SK);
    float* TK = (float*)(p.ws + WS_TK);
    const int r32 = lane & 31, hi = lane >> 5;
    const int G = gridDim.x;
    for (int rp = blockIdx.x & 15; rp < 16; rp += (G < 16 ? G : 16)) {
        const int nbr = (G - rp + 15) >> 4, member = (int)blockIdx.x >> 4;
        __syncthreads();
        for (int c = tid; c < 128 * 16; c += 512) { const int row = c >> 4, ch = c & 15; *(LAS u32x4*)(lds + row * P4B_KPITCH + ch * 16) = *(const u32x4*)(SK + ((size_t)rp * 128 + row) * 128 + ch * 8); }
        __syncthreads();
        LAS unsigned char* qs = lds + P4B_K_BYTES + wave * P4B_Q_BYTES;
        u32x4 qn[8];
        { const int tg0 = member * 8 + wave;
          if (tg0 < NT / 32) {
#pragma unroll
            for (int i = 0; i < 8; ++i) { const int row = 4 * i + (lane >> 4), ch = lane & 15; qn[i] = *(const u32x4*)(QP + (size_t)(tg0 * 32 + row) * 2048 + rp * 128 + ch * 8); } } }
        for (int tg = member * 8 + wave; tg < NT / 32; tg += nbr * 8) {
            const int t0 = tg * 32;
#pragma unroll
            for (int i = 0; i < 8; ++i) { const int row = 4 * i + (lane >> 4), ch = lane & 15; *(LAS u32x4*)(qs + row * P4B_KPITCH + ch * 16) = qn[i]; }
            { const int tgn = tg + nbr * 8;
              if (tgn < NT / 32) {
#pragma unroll
                for (int i = 0; i < 8; ++i) { const int row = 4 * i + (lane >> 4), ch = lane & 15; qn[i] = *(const u32x4*)(QP + (size_t)(tgn * 32 + row) * 2048 + rp * 128 + ch * 8); } } }
            bf16x8 qf[8];
#pragma unroll
            for (int s = 0; s < 8; ++s) qf[s] = *(const LAS bf16x8*)(qs + r32 * P4B_KPITCH + (2 * s + hi) * 16);
            float v[64];
#pragma unroll
            for (int mt = 0; mt < 4; ++mt) {
                f32x16 S;
#pragma unroll
                for (int r = 0; r < 16; ++r) S[r] = 0.f;
                const LAS unsigned char* kp = lds + (32 * mt + r32) * P4B_KPITCH + hi * 16;
#pragma unroll
                for (int s = 0; s < 8; ++s) S = att::mfma32(*(const LAS bf16x8*)(kp + s * 32), qf[s], S);
#pragma unroll
                for (int r = 0; r < 16; ++r) { const int n = 32 * mt + (r & 3) + 8 * (r >> 2) + 4 * hi; v[mt * 16 + r] = __uint_as_float((__float_as_uint(S[r]) & ~127u) | (unsigned)(127 - n)); }
            }
            SORT16_DESC(v, 0); SORT16_DESC(v, 16); SORT16_DESC(v, 32); SORT16_DESC(v, 48);
#pragma unroll
            for (int i = 0; i < 16; ++i) { v[i] = fmaxf(v[i], v[31 - i]); v[32 + i] = fmaxf(v[32 + i], v[63 - i]); }
            BITONIC16_DESC(v, 0); BITONIC16_DESC(v, 32);
#pragma unroll
            for (int i = 0; i < 16; ++i) v[i] = fmaxf(v[i], v[47 - i]);
            BITONIC16_DESC(v, 0);
            float w[16];
#pragma unroll
            for (int i = 0; i < 16; ++i) w[i] = fmaxf(v[i], __shfl_xor(v[15 - i], 32));
            BITONIC16_DESC(w, 0);
            if (hi == 0) {
                f32x4* dst = (f32x4*)(TK + ((size_t)(t0 + r32) * 16 + rp) * 16);
#pragma unroll
                for (int q = 0; q < 4; ++q) dst[q] = (f32x4){w[4 * q], w[4 * q + 1], w[4 * q + 2], w[4 * q + 3]};
            }
        }
    }
}

__device__ __forceinline__ void phase5a(const Params& p, LAS unsigned char* lds, int tid) {
    const float* TK = (const float*)(p.ws + WS_TK);
    int* IDX = (int*)(p.ws + WS_IDX); float* GATE = (float*)(p.ws + WS_GATE);
    const float NEG_INF = -__builtin_huge_valf();
    LAS unsigned* rec = (LAS unsigned*)(lds + tid * 36);
    for (int item = blockIdx.x * 512 + tid; item < NT * 8; item += gridDim.x * 512) {
        const int tok = item >> 3, r = item & 7;
        const f32x4* pa = (const f32x4*)(TK + ((size_t)tok * 16 + 2 * r) * 16);
        float a[16], b[16];
#pragma unroll
        for (int q = 0; q < 4; ++q) { const f32x4 x = pa[q], y = pa[4 + q];
#pragma unroll
            for (int j = 0; j < 4; ++j) { a[4 * q + j] = x[j]; b[4 * q + j] = y[j]; } }
        float ssum = 0.f;
        { const f32x4* sp = (const f32x4*)((const float*)(p.ws + WS_SSQ) + (size_t)tok * 16);
#pragma unroll
          for (int q = 0; q < 4; ++q) { const f32x4 v4 = sp[q]; ssum += (v4[0] + v4[1]) + (v4[2] + v4[3]); } }
#pragma unroll
        for (int q = 0; q < 4; ++q) {
            unsigned wa = 0u, wb = 0u;
#pragma unroll
            for (int j = 0; j < 4; ++j) { const unsigned ua = __float_as_uint(a[4 * q + j]), ub = __float_as_uint(b[4 * q + j]);
                wa |= (127u - (ua & 127u)) << (8 * j); wb |= (127u - (ub & 127u)) << (8 * j);
                a[4 * q + j] = __uint_as_float(ua & ~127u); b[4 * q + j] = __uint_as_float(ub & ~127u); }
            rec[q] = wa; rec[4 + q] = wb;
        }
        float v[64];
        {
            int c = 0;
#pragma unroll
            for (int i = 0; i < 16; ++i)
#pragma unroll
                for (int j = 0; j < 16; ++j)
                    if ((i + 1) * (j + 1) <= 16) { v[c] = __uint_as_float((__float_as_uint(a[i] + b[j]) & ~255u) | (unsigned)(255 - (16 * i + j))); ++c; }
#pragma unroll
            for (int c2 = 50; c2 < 64; ++c2) v[c2] = NEG_INF;
        }
        SORT16_DESC(v, 0); SORT16_DESC(v, 16); SORT16_DESC(v, 32); SORT16_DESC(v, 48);
#pragma unroll
        for (int i = 0; i < 16; ++i) { v[i] = fmaxf(v[i], v[31 - i]); v[32 + i] = fmaxf(v[32 + i], v[63 - i]); }
        BITONIC16_DESC(v, 0); BITONIC16_DESC(v, 32);
#pragma unroll
        for (int i = 0; i < 16; ++i) v[i] = fmaxf(v[i], v[47 - i]);
        BITONIC16_DESC(v, 0);
        const float rstd = 1.f / sqrtf(ssum * (1.f / DM) + EPS);
        if (r == 0) ((float*)(p.ws + WS_RSTD))[tok] = rstd;
        const LAS unsigned char* rb = (const LAS unsigned char*)rec;
        float e[16], sum = 0.f; int bid[16];
        const float best0 = __uint_as_float(__float_as_uint(v[0]) & ~255u);
#pragma unroll
        for (int k = 0; k < 16; ++k) {
            const unsigned u = __float_as_uint(v[k]); const unsigned code = 255u - (u & 255u);
            bid[k] = (int)rb[code >> 4] * 128 + (int)rb[16 + (code & 15u)];
            e[k] = __expf((__uint_as_float(u & ~255u) - best0) * rstd); sum += e[k];
        }
        const float rinv = 1.f / sum;
        int* io = IDX + (size_t)tok * 128 + r * 16; float* go = GATE + (size_t)tok * 128 + r * 16;
#pragma unroll
        for (int k = 0; k < 16; ++k) { io[k] = bid[k]; go[k] = e[k] * rinv; }
    }
}

__device__ __forceinline__ float gelu_erf(float x) { return 0.5f * x * (1.f + erff(x * 0.70710678118654752f)); }
__device__ __forceinline__ void fp8x16_to_f32(const u32x4 q, float (&f)[16]) {
    const f32x2 c0 = __builtin_amdgcn_cvt_pk_f32_fp8(q.x, false), c1 = __builtin_amdgcn_cvt_pk_f32_fp8(q.x, true), c2 = __builtin_amdgcn_cvt_pk_f32_fp8(q.y, false), c3 = __builtin_amdgcn_cvt_pk_f32_fp8(q.y, true);
    const f32x2 c4 = __builtin_amdgcn_cvt_pk_f32_fp8(q.z, false), c5 = __builtin_amdgcn_cvt_pk_f32_fp8(q.z, true), c6 = __builtin_amdgcn_cvt_pk_f32_fp8(q.w, false), c7 = __builtin_amdgcn_cvt_pk_f32_fp8(q.w, true);
    f[0] = c0.x; f[1] = c0.y; f[2] = c1.x; f[3] = c1.y; f[4] = c2.x; f[5] = c2.y; f[6] = c3.x; f[7] = c3.y;
    f[8] = c4.x; f[9] = c4.y; f[10] = c5.x; f[11] = c5.y; f[12] = c6.x; f[13] = c6.y; f[14] = c7.x; f[15] = c7.y;
}
__device__ __forceinline__ void slice_group(int& x, int& gwx, int& nwx, int wave) {
    x = blockIdx.x & 7; const int nbx = ((int)gridDim.x - x + 7) >> 3; gwx = ((int)blockIdx.x >> 3) * 8 + wave; nwx = nbx * 8;
}
__device__ __forceinline__ void phase5u(const Params& p, LAS unsigned char* lds, int lane, int wave) {
    int x, gwx, nwx; slice_group(x, gwx, nwx, wave);
    const unsigned char* PU8 = p.ws + WS_PU8 + (size_t)x * 16384 * 128;
    const bf16_t* H2 = (const bf16_t*)(p.ws + WS_XG) + 128 * x;
    const int* IDX = (const int*)(p.ws + WS_IDX); float* PACT = (float*)(p.ws + WS_PACT) + (size_t)x * NT * 128;
    LAS int* l_idx = (LAS int*)(lds + wave * 512);
    const int g = lane >> 3, sub = lane & 7;
    const unsigned char* rowp = PU8 + sub * 16;
    int r_idxA = 0, r_idxB = 0;
    u32x4 hA0, hA1, hB0, hB1; hA0 = hA1 = hB0 = hB1 = (u32x4){0u, 0u, 0u, 0u};
    u32x4 qA[16], qB[16];
#define P5U_LOADIDX(T) do { if ((T) < NT) { r_idxA = IDX[(size_t)(T) * 128 + lane]; r_idxB = IDX[(size_t)(T) * 128 + 64 + lane]; } } while (0)
#define P5U_ISSUE(Q, H0, H1, T) do { if ((T) < NT) { l_idx[lane] = r_idxA; l_idx[64 + lane] = r_idxB; \
        H0 = *(const u32x4*)(H2 + (size_t)(T) * DM + 16 * sub); H1 = *(const u32x4*)(H2 + (size_t)(T) * DM + 16 * sub + 8); \
        _Pragma("unroll") for (int q_ = 0; q_ < 4; ++q_) { const u32x4 iv = *(const LAS u32x4*)(l_idx + 16 * g + 4 * q_); \
            Q[4 * q_] = *(const u32x4*)(rowp + (size_t)iv.x * 128); Q[4 * q_ + 1] = *(const u32x4*)(rowp + (size_t)iv.y * 128); \
            Q[4 * q_ + 2] = *(const u32x4*)(rowp + (size_t)iv.z * 128); Q[4 * q_ + 3] = *(const u32x4*)(rowp + (size_t)iv.w * 128); } } } while (0)
#define IDPP_ADD(v, ctrl) v += __builtin_amdgcn_update_dpp(0, v, ctrl, 0xf, 0xf, true)
#define FDPP_MAX(v, ctrl) v = fmaxf(v, __builtin_bit_cast(float, __builtin_amdgcn_update_dpp(0, __builtin_bit_cast(int, v), ctrl, 0xf, 0xf, true)))
#define P5U_COMPUTE(Q, H0, H1, T) do { \
        float hf[16]; \
        hf[0] = bflo(H0.x); hf[1] = bfhi(H0.x); hf[2] = bflo(H0.y); hf[3] = bfhi(H0.y); hf[4] = bflo(H0.z); hf[5] = bfhi(H0.z); hf[6] = bflo(H0.w); hf[7] = bfhi(H0.w); \
        hf[8] = bflo(H1.x); hf[9] = bfhi(H1.x); hf[10] = bflo(H1.y); hf[11] = bfhi(H1.y); hf[12] = bflo(H1.z); hf[13] = bfhi(H1.z); hf[14] = bflo(H1.w); hf[15] = bfhi(H1.w); \
        float am = 0.f; \
        _Pragma("unroll") for (int j = 0; j < 16; ++j) am = fmaxf(am, fabsf(hf[j])); \
        FDPP_MAX(am, 0xB1); FDPP_MAX(am, 0x4E); FDPP_MAX(am, 0x141);              \
        const float sh = am > 0.f ? am * (1.f / 127.f) : 1.f, ih = 1.f / sh; \
        int hq[4]; \
        _Pragma("unroll") for (int w_ = 0; w_ < 4; ++w_) { \
            const int q0 = __float2int_rn(hf[4 * w_] * ih), q1 = __float2int_rn(hf[4 * w_ + 1] * ih), q2 = __float2int_rn(hf[4 * w_ + 2] * ih), q3 = __float2int_rn(hf[4 * w_ + 3] * ih); \
            hq[w_] = (int)((unsigned)(q0 & 255) | ((unsigned)(q1 & 255) << 8) | ((unsigned)(q2 & 255) << 16) | ((unsigned)(q3 & 255) << 24)); } \
        int resA = 0, resB = 0; \
        _Pragma("unroll") for (int i = 0; i < 16; ++i) { \
            int d = __builtin_amdgcn_sdot4((int)Q[i].x, hq[0], 0, false); d = __builtin_amdgcn_sdot4((int)Q[i].y, hq[1], d, false); \
            d = __builtin_amdgcn_sdot4((int)Q[i].z, hq[2], d, false); d = __builtin_amdgcn_sdot4((int)Q[i].w, hq[3], d, false); \
            IDPP_ADD(d, 0xB1); IDPP_ADD(d, 0x4E); IDPP_ADD(d, 0x141); \
            if (i < 8) resA = (sub == i) ? d : resA; else resB = (sub == i - 8) ? d : resB; } \
        PACT[(size_t)(T) * 128 + 16 * g + sub] = (float)resA * sh; PACT[(size_t)(T) * 128 + 16 * g + 8 + sub] = (float)resB * sh; } while (0)
    int tok = gwx;
    P5U_LOADIDX(tok);
    P5U_ISSUE(qA, hA0, hA1, tok);
    P5U_LOADIDX(tok + nwx);
    for (; tok < NT; tok += 2 * nwx) {
        P5U_ISSUE(qB, hB0, hB1, tok + nwx);
        P5U_LOADIDX(tok + 2 * nwx);
        P5U_COMPUTE(qA, hA0, hA1, tok);
        if (tok + nwx >= NT) break;
        P5U_ISSUE(qA, hA0, hA1, tok + 2 * nwx);
        P5U_LOADIDX(tok + 3 * nwx);
        P5U_COMPUTE(qB, hB0, hB1, tok + nwx);
    }
#undef P5U_LOADIDX
#undef P5U_ISSUE
#undef P5U_COMPUTE
#undef IDPP_ADD
#undef FDPP_MAX
}
__device__ __forceinline__ void phase5c(const Params& p, int tid) {
    const float* PACT = (const float*)(p.ws + WS_PACT); const float* SCU = (const float*)(p.ws + WS_SCU); const float* SCV = (const float*)(p.ws + WS_SCV);
    const int* IDX = (const int*)(p.ws + WS_IDX); const float* GATE = (const float*)(p.ws + WS_GATE); float* COEF = (float*)(p.ws + WS_COEF); const float* RSTD = (const float*)(p.ws + WS_RSTD);
    const size_t n = (size_t)NT * 128, n4 = n / 4, stride = (size_t)gridDim.x * 512;
    for (size_t i0 = (size_t)blockIdx.x * 512 + tid; i0 < n4; i0 += 2 * stride) {
        f32x4 a[2], g[2]; u32x4 e[2]; f32x4 pa[2][8]; float rs[2];
#pragma unroll
        for (int u = 0; u < 2; ++u) {
            const size_t it = (i0 + u * stride < n4 ? i0 + u * stride : i0) * 4;
#pragma unroll
            for (int xx = 0; xx < 8; ++xx) pa[u][xx] = *(const f32x4*)(PACT + (size_t)xx * n + it);
            e[u] = *(const u32x4*)(IDX + it); g[u] = *(const f32x4*)(GATE + it); rs[u] = RSTD[it >> 7];
        }
        float su[2][4], sv[2][4];
#pragma unroll
        for (int u = 0; u < 2; ++u)
#pragma unroll
            for (int j = 0; j < 4; ++j) { su[u][j] = SCU[e[u][j]]; sv[u][j] = SCV[e[u][j]]; }
#pragma unroll
        for (int u = 0; u < 2; ++u) {
            a[u] = ((pa[u][0] + pa[u][1]) + (pa[u][2] + pa[u][3])) + ((pa[u][4] + pa[u][5]) + (pa[u][6] + pa[u][7]));
            f32x4 c;
#pragma unroll
            for (int j = 0; j < 4; ++j) c[j] = g[u][j] * gelu_erf(a[u][j] * (rs[u] * su[u][j])) * sv[u][j];
            if (i0 + u * stride < n4) *(f32x4*)(COEF + (i0 + u * stride) * 4) = c;
        }
    }
}

constexpr int P5V_LDS_PER_WAVE = 1024 + 8 * 136 * 4;
__device__ __forceinline__ void phase5v(const Params& p, LAS unsigned char* lds, int lane, int wave) {
    int x, gwx, nwx; slice_group(x, gwx, nwx, wave);
    const unsigned char* PV8 = p.ws + WS_PV8 + (size_t)x * 16384 * 128;
    const int* IDX = (const int*)(p.ws + WS_IDX); const float* COEF = (const float*)(p.ws + WS_COEF);
    LAS int* l_idx = (LAS int*)(lds + wave * P5V_LDS_PER_WAVE); LAS float* l_cf = (LAS float*)(l_idx + 128); LAS float* red = l_cf + 128;
    const int g = lane >> 3, sub = lane & 7;
    const unsigned char* rowp = PV8 + sub * 16;
    const int c1 = 2 * lane;
    const bf16_t* XG = (const bf16_t*)(p.ws + WS_XG) + 128 * x + c1; bf16_t* X3 = (bf16_t*)(p.ws + WS_X3) + 128 * x + c1;
    const float ig0 = 1.f / p.in[18][128 * x + c1], ig1 = 1.f / p.in[18][128 * x + c1 + 1];
    int r_idxA = 0, r_idxB = 0; float r_cA = 0.f, r_cB = 0.f;
    u32x4 qA[16], qB[16]; f32x4 cfA[4], cfB[4]; unsigned xA0 = 0u, xA1 = 0u, xB0 = 0u, xB1 = 0u;
#define P5V_LOADIDX(T) do { if ((T) < NT) { r_idxA = IDX[(size_t)(T) * 128 + lane]; r_idxB = IDX[(size_t)(T) * 128 + 64 + lane]; r_cA = COEF[(size_t)(T) * 128 + lane]; r_cB = COEF[(size_t)(T) * 128 + 64 + lane]; } } while (0)
#define P5V_ISSUE(Q, CF, X0, X1, T) do { if ((T) < NT) { l_idx[lane] = r_idxA; l_idx[64 + lane] = r_idxB; l_cf[lane] = r_cA; l_cf[64 + lane] = r_cB; \
        X0 = *(const unsigned*)(XG + (size_t)(T) * DM); (void)X1; \
        _Pragma("unroll") for (int q_ = 0; q_ < 4; ++q_) { const u32x4 iv = *(const LAS u32x4*)(l_idx + 16 * g + 4 * q_); CF[q_] = *(const LAS f32x4*)(l_cf + 16 * g + 4 * q_); \
            Q[4 * q_] = *(const u32x4*)(rowp + (size_t)iv.x * 128); Q[4 * q_ + 1] = *(const u32x4*)(rowp + (size_t)iv.y * 128); \
            Q[4 * q_ + 2] = *(const u32x4*)(rowp + (size_t)iv.z * 128); Q[4 * q_ + 3] = *(const u32x4*)(rowp + (size_t)iv.w * 128); } } } while (0)
#define P5V_COMPUTE(Q, CF, X0, X1, T) do { \
        f32x2 acc[8]; \
        _Pragma("unroll") for (int j = 0; j < 8; ++j) acc[j] = (f32x2){0.f, 0.f}; \
        _Pragma("unroll") for (int i = 0; i < 16; ++i) { \
            const float cs_ = CF[i >> 2][i & 3]; const f32x2 c2 = (f32x2){cs_, cs_}; \
            acc[0] = __builtin_elementwise_fma(__builtin_amdgcn_cvt_pk_f32_fp8(Q[i].x, false), c2, acc[0]); \
            acc[1] = __builtin_elementwise_fma(__builtin_amdgcn_cvt_pk_f32_fp8(Q[i].x, true), c2, acc[1]); \
            acc[2] = __builtin_elementwise_fma(__builtin_amdgcn_cvt_pk_f32_fp8(Q[i].y, false), c2, acc[2]); \
            acc[3] = __builtin_elementwise_fma(__builtin_amdgcn_cvt_pk_f32_fp8(Q[i].y, true), c2, acc[3]); \
            acc[4] = __builtin_elementwise_fma(__builtin_amdgcn_cvt_pk_f32_fp8(Q[i].z, false), c2, acc[4]); \
            acc[5] = __builtin_elementwise_fma(__builtin_amdgcn_cvt_pk_f32_fp8(Q[i].z, true), c2, acc[5]); \
            acc[6] = __builtin_elementwise_fma(__builtin_amdgcn_cvt_pk_f32_fp8(Q[i].w, false), c2, acc[6]); \
            acc[7] = __builtin_elementwise_fma(__builtin_amdgcn_cvt_pk_f32_fp8(Q[i].w, true), c2, acc[7]); } \
        _Pragma("unroll") for (int j = 0; j < 8; ++j) *(LAS f32x2*)(red + g * 136 + 16 * sub + 2 * j) = acc[j]; \
        f32x2 s12 = (f32x2){bflo(X0) * ig0, bfhi(X0) * ig1}; \
        _Pragma("unroll") for (int gg = 0; gg < 8; ++gg) s12 += *(const LAS f32x2*)(red + gg * 136 + 2 * lane); \
        *(unsigned*)(X3 + (size_t)(T) * DM) = cvtpk(s12.x, s12.y); } while (0)
    int tok = gwx;
    P5V_LOADIDX(tok);
    P5V_ISSUE(qA, cfA, xA0, xA1, tok);
    P5V_LOADIDX(tok + nwx);
    for (; tok < NT; tok += 2 * nwx) {
        P5V_ISSUE(qB, cfB, xB0, xB1, tok + nwx);
        P5V_LOADIDX(tok + 2 * nwx);
        P5V_COMPUTE(qA, cfA, xA0, xA1, tok);
        if (tok + nwx >= NT) break;
        P5V_ISSUE(qA, cfA, xA0, xA1, tok + 2 * nwx);
        P5V_LOADIDX(tok + 3 * nwx);
        P5V_COMPUTE(qB, cfB, xB0, xB1, tok + nwx);
    }
#undef P5V_LOADIDX
#undef P5V_ISSUE
#undef P5V_COMPUTE
}

__device__ __forceinline__ void phase6(const Params& p, int lane, int wave) {
    const int gw = blockIdx.x * 8 + wave, NGW = gridDim.x * 8;
    const f32x4* gr = (const f32x4*)p.in[23] + lane;
    const bf16_t* X3 = (const bf16_t*)(p.ws + WS_X3);
    for (int m = gw; m < NT; m += 2 * NGW) {
        const bool two = m + NGW < NT; const int m2 = two ? m + NGW : m;
        const u32x2* xa = (const u32x2*)(X3 + (size_t)m * DM) + lane; const u32x2* xb = (const u32x2*)(X3 + (size_t)m2 * DM) + lane;
        u32x2 wa[4], wb[4];
#pragma unroll
        for (int j = 0; j < 4; ++j) { wa[j] = xa[64 * j]; wb[j] = xb[64 * j]; }
        f32x4 va[4], vb[4]; float sa = 0.f, sb = 0.f;
#pragma unroll
        for (int j = 0; j < 4; ++j) {
            va[j] = (f32x4){bflo(wa[j].x), bfhi(wa[j].x), bflo(wa[j].y), bfhi(wa[j].y)}; vb[j] = (f32x4){bflo(wb[j].x), bfhi(wb[j].x), bflo(wb[j].y), bfhi(wb[j].y)};
            sa += (va[j][0] * va[j][0] + va[j][1] * va[j][1]) + (va[j][2] * va[j][2] + va[j][3] * va[j][3]); sb += (vb[j][0] * vb[j][0] + vb[j][1] * vb[j][1]) + (vb[j][2] * vb[j][2] + vb[j][3] * vb[j][3]);
        }
        const float ra_ = 1.f / sqrtf(wave_total(sa) * (1.f / DM) + EPS), rb_ = 1.f / sqrtf(wave_total(sb) * (1.f / DM) + EPS);
        f32x4* ya = (f32x4*)(p.out + (size_t)m * DM) + lane; f32x4* yb = (f32x4*)(p.out + (size_t)m2 * DM) + lane;
#pragma unroll
        for (int j = 0; j < 4; ++j) { const f32x4 gg = gr[64 * j]; __builtin_nontemporal_store(va[j] * ra_ * gg, ya + 64 * j); if (two) __builtin_nontemporal_store(vb[j] * rb_ * gg, yb + 64 * j); }
    }
}

__global__ void __launch_bounds__(512, 2) fwd_megakernel(Params p) {
    extern __shared__ __attribute__((aligned(16))) unsigned char lds_raw[];
    LAS unsigned char* lds = (LAS unsigned char*)lds_raw;
    const int tid0 = threadIdx.x, wave = __builtin_amdgcn_readfirstlane(tid0 >> 6);
#define PHASE_IDS() int tid = tid0; asm volatile("" : "+v"(tid)); const int lane = tid & 63; (void)lane
    const int G = gridDim.x;
    volatile LAS unsigned* MISC = (volatile LAS unsigned*)(lds + MISC_OFF);
    if (tid0 < 32) MISC[tid0] = 0u;
    __syncthreads();
    XcdBarrier bar = xcd_barrier_post((unsigned*)(p.ws + WS_CTL) + 4096, MISC + 8);
#define GSYNC() xcd_barrier(bar)

#ifndef RPT_MASK
#define RPT_MASK 0
#endif
#if RPT_MASK
#define RPT(bit) for (int rpt_ = 0; rpt_ < (((RPT_MASK) >> (bit)) & 1) + 1; ++rpt_)
#else
#define RPT(bit) if (constexpr int rpt_ = 0; true)
#endif
    RPT(0) { PHASE_IDS(); phase0(p, lds, tid, lane, wave); GSYNC(); }
    RPT(1) {
        PHASE_IDS();
        pg8::Gemm g{(const bf16_t*)(p.ws + WS_H), (const bf16_t*)(p.ws + WS_WINT), NT, DIN, 1024};
        pg8::StaticOrder S; S.init(NT, DIN, G, (int)blockIdx.x);
        pg8::EpiProj E{(bf16_t*)(p.ws + WS_A), (bf16_t*)(p.ws + WS_Q), (bf16_t*)(p.ws + WS_KP), (bf16_t*)(p.ws + WS_VP), (bf16_t*)(p.ws + WS_KS), (bf16_t*)(p.ws + WS_VS), p.out};
        pg8::gemm_phase<pg8::EpiProj, pg8::StaticOrder, true, true>(lds, g, S, E);
        {
            const int nwg = (NT / 256) * (DIN / 256), rem = nwg % G, c = (int)blockIdx.x;
            if (rem == 0) prep_late(p, lds, tid, lane, wave, c, G);
            else if (c >= rem) prep_late(p, lds, tid, lane, wave, c - rem, G - rem);
        }
        GSYNC();
    }
    #ifndef P2MODE
#define P2MODE 0
#endif
    RPT(2) { PHASE_IDS(); att::phase2(p, lds, tid, lane, wave, rpt_, (((RPT_MASK) >> 2) & 1) && rpt_ == 0 ? P2MODE : 0); GSYNC(); }
    RPT(3) {
        PHASE_IDS();
        pg8::Gemm g{(const bf16_t*)(p.ws + WS_MIX), (const bf16_t*)(p.ws + WS_WOUTT), NP, 1024, 1024};
        pg8::StaticOrder S; S.init(NP, 1024, G, (int)blockIdx.x);
        pg8::EpiRes E{p.in[0], p.in[1], (bf16_t*)(p.ws + WS_XG), p.in[18], (float*)(p.ws + WS_SSQ)};
        pg8::gemm_phase<pg8::EpiRes, pg8::StaticOrder, true, true>(lds, g, S, E);
        {
            const float* xs = p.in[1]; bf16_t* go = (bf16_t*)(p.ws + WS_XG) + (size_t)NP * DM; const float* gff = p.in[18]; float* sso = (float*)(p.ws + WS_SSQ) + (size_t)NP * 16;
            mini_gemm((const bf16_t*)(p.ws + WS_MIX) + (size_t)NP * DM, (const bf16_t*)(p.ws + WS_WOUTT), 1024, lane, wave,
                      [=](int row, int cb, int fq, const pg8::f32x4 (&a)[4]) {
                          float sq = 0.f;
#pragma unroll
                          for (int n = 0; n < 4; ++n) {
                              const int col = cb * 64 + 16 * n + 4 * fq;
                              const pg8::f32x4 v = *(const pg8::f32x4*)(xs + (size_t)row * DM + col) + a[n];
                              *(u32x2*)(go + (size_t)row * DM + col) = pg8::pack4(v * *(const pg8::f32x4*)(gff + col));
                              sq += (v[0] * v[0] + v[1] * v[1]) + (v[2] * v[2] + v[3] * v[3]);
                          }
                          sq += __shfl_xor(sq, 16); sq += __shfl_xor(sq, 32);
                          if (fq == 0) sso[(size_t)row * 16 + cb] = sq;
                      });
        }
        GSYNC();
    }
    RPT(5) {
        PHASE_IDS();
        pg8::Gemm g{(const bf16_t*)(p.ws + WS_XG), (const bf16_t*)(p.ws + WS_WQT), NP, 2048, 1024};
        pg8::StaticOrder S; S.init(NP, 2048, G, (int)blockIdx.x);
        pg8::EpiBf16<0> E{(bf16_t*)(p.ws + WS_QP), 2048, nullptr, 0, 0, 1.f};
        pg8::gemm_phase<pg8::EpiBf16<0>, pg8::StaticOrder, true, true>(lds, g, S, E);
        {
            bf16_t* qo = (bf16_t*)(p.ws + WS_QP) + (size_t)NP * 2048;
            mini_gemm((const bf16_t*)(p.ws + WS_XG) + (size_t)NP * DM, (const bf16_t*)(p.ws + WS_WQT), 2048, lane, wave,
                      [=](int row, int cb, int fq, const pg8::f32x4 (&a)[4]) {
#pragma unroll
                          for (int n = 0; n < 4; ++n) *(u32x2*)(qo + (size_t)row * 2048 + cb * 64 + 16 * n + 4 * fq) = pg8::pack4(a[n]);
                      });
        }
        GSYNC();
    }
    RPT(6) { PHASE_IDS(); phase4b(p, lds, tid, lane, wave); GSYNC(); }
    RPT(7) { PHASE_IDS(); phase5a(p, lds, tid); GSYNC(); }
    RPT(8) { PHASE_IDS(); phase5u(p, lds, lane, wave); GSYNC(); }
    RPT(9) { PHASE_IDS(); phase5c(p, tid); GSYNC(); }
    { PHASE_IDS(); phase5v(p, lds, lane, wave); }
    GSYNC();
    { PHASE_IDS(); phase6(p, lane, wave); }
}

extern "C" void kernel_launch(void* const* d_in, const int* in_sizes, int n_in, void* d_out, int out_size, void* d_ws, size_t ws_size, hipStream_t stream) {
    static int grid = 0;
    if (grid == 0) {
        if (n_in != 24 || out_size != (int)OUT_TOTAL || ws_size < WS_END) { fprintf(stderr, "kernel_launch: unexpected shapes: n_in %d out %d ws %zu (need %zu)\n", n_in, out_size, ws_size, (size_t)WS_END); grid = -1; return; }
        int dev = 0, cus = 0, per_cu = 0;
        (void)hipGetDevice(&dev);
        (void)hipDeviceGetAttribute(&cus, hipDeviceAttributeMultiprocessorCount, dev);
        if (hipFuncSetAttribute((const void*)fwd_megakernel, hipFuncAttributeMaxDynamicSharedMemorySize, LDS_BYTES) != hipSuccess) { fprintf(stderr, "kernel_launch: hipFuncSetAttribute failed\n"); grid = -1; return; }
        if (hipOccupancyMaxActiveBlocksPerMultiprocessor(&per_cu, (const void*)fwd_megakernel, 512, LDS_BYTES) != hipSuccess || per_cu < 1) { fprintf(stderr, "kernel_launch: occupancy query gave %d\n", per_cu); per_cu = 1; }
        (void)hipGetLastError();
        grid = cus * 1;
        if (per_cu < 1) grid = -1;
    }
    if (grid < 0) return;
    (void)hipMemsetAsync((char*)d_ws + WS_CTL, 0, CTL_BYTES, stream);
    Params p{};
    for (int i = 0; i < 24; ++i) p.in[i] = (const float*)d_in[i];
    p.out = (float*)d_out; p.ws = (unsigned char*)d_ws;
    void* args[] = {&p};
    hipError_t e = hipLaunchCooperativeKernel((const void*)fwd_megakernel, dim3(grid), dim3(512), args, LDS_BYTES, stream);
    if (e != hipSuccess) fprintf(stderr, "cooperative launch failed: %s (grid %d)\n", hipGetErrorString(e), grid);
}
```

```cpp
#include <hip/hip_runtime.h>
#include <cstdio>
#include <cstdint>
#include <cmath>
#define CE_(a, b) do { const float t_ = fmaxf(a, b); b = fminf(a, b); a = t_; } while (0)
#define SORT16_DESC(V, O) do { CE_(V[(O)+0], V[(O)+1]); CE_(V[(O)+2], V[(O)+3]); CE_(V[(O)+0], V[(O)+2]); CE_(V[(O)+1], V[(O)+3]); CE_(V[(O)+1], V[(O)+2]); CE_(V[(O)+4], V[(O)+5]); CE_(V[(O)+6], V[(O)+7]); CE_(V[(O)+4], V[(O)+6]); CE_(V[(O)+5], V[(O)+7]); CE_(V[(O)+5], V[(O)+6]); CE_(V[(O)+0], V[(O)+4]); CE_(V[(O)+2], V[(O)+6]); CE_(V[(O)+2], V[(O)+4]); CE_(V[(O)+1], V[(O)+5]); CE_(V[(O)+3], V[(O)+7]); CE_(V[(O)+3], V[(O)+5]); CE_(V[(O)+1], V[(O)+2]); CE_(V[(O)+3], V[(O)+4]); CE_(V[(O)+5], V[(O)+6]); CE_(V[(O)+8], V[(O)+9]); CE_(V[(O)+10], V[(O)+11]); CE_(V[(O)+8], V[(O)+10]); CE_(V[(O)+9], V[(O)+11]); CE_(V[(O)+9], V[(O)+10]); CE_(V[(O)+12], V[(O)+13]); CE_(V[(O)+14], V[(O)+15]); CE_(V[(O)+12], V[(O)+14]); CE_(V[(O)+13], V[(O)+15]); CE_(V[(O)+13], V[(O)+14]); CE_(V[(O)+8], V[(O)+12]); CE_(V[(O)+10], V[(O)+14]); CE_(V[(O)+10], V[(O)+12]); CE_(V[(O)+9], V[(O)+13]); CE_(V[(O)+11], V[(O)+15]); CE_(V[(O)+11], V[(O)+13]); CE_(V[(O)+9], V[(O)+10]); CE_(V[(O)+11], V[(O)+12]); CE_(V[(O)+13], V[(O)+14]); CE_(V[(O)+0], V[(O)+8]); CE_(V[(O)+4], V[(O)+12]); CE_(V[(O)+4], V[(O)+8]); CE_(V[(O)+2], V[(O)+10]); CE_(V[(O)+6], V[(O)+14]); CE_(V[(O)+6], V[(O)+10]); CE_(V[(O)+2], V[(O)+4]); CE_(V[(O)+6], V[(O)+8]); CE_(V[(O)+10], V[(O)+12]); CE_(V[(O)+1], V[(O)+9]); CE_(V[(O)+5], V[(O)+13]); CE_(V[(O)+5], V[(O)+9]); CE_(V[(O)+3], V[(O)+11]); CE_(V[(O)+7], V[(O)+15]); CE_(V[(O)+7], V[(O)+11]); CE_(V[(O)+3], V[(O)+5]); CE_(V[(O)+7], V[(O)+9]); CE_(V[(O)+11], V[(O)+13]); CE_(V[(O)+1], V[(O)+2]); CE_(V[(O)+3], V[(O)+4]); CE_(V[(O)+5], V[(O)+6]); CE_(V[(O)+7], V[(O)+8]); CE_(V[(O)+9], V[(O)+10]); CE_(V[(O)+11], V[(O)+12]); CE_(V[(O)+13], V[(O)+14]); } while (0)
#define BITONIC16_DESC(V, O) do { CE_(V[(O)+0], V[(O)+8]); CE_(V[(O)+1], V[(O)+9]); CE_(V[(O)+2], V[(O)+10]); CE_(V[(O)+3], V[(O)+11]); CE_(V[(O)+4], V[(O)+12]); CE_(V[(O)+5], V[(O)+13]); CE_(V[(O)+6], V[(O)+14]); CE_(V[(O)+7], V[(O)+15]); CE_(V[(O)+0], V[(O)+4]); CE_(V[(O)+1], V[(O)+5]); CE_(V[(O)+2], V[(O)+6]); CE_(V[(O)+3], V[(O)+7]); CE_(V[(O)+8], V[(O)+12]); CE_(V[(O)+9], V[(O)+13]); CE_(V[(O)+10], V[(O)+14]); CE_(V[(O)+11], V[(O)+15]); CE_(V[(O)+0], V[(O)+2]); CE_(V[(O)+1], V[(O)+3]); CE_(V[(O)+4], V[(O)+6]); CE_(V[(O)+5], V[(O)+7]); CE_(V[(O)+8], V[(O)+10]); CE_(V[(O)+9], V[(O)+11]); CE_(V[(O)+12], V[(O)+14]); CE_(V[(O)+13], V[(O)+15]); CE_(V[(O)+0], V[(O)+1]); CE_(V[(O)+2], V[(O)+3]); CE_(V[(O)+4], V[(O)+5]); CE_(V[(O)+6], V[(O)+7]); CE_(V[(O)+8], V[(O)+9]); CE_(V[(O)+10], V[(O)+11]); CE_(V[(O)+12], V[(O)+13]); CE_(V[(O)+14], V[(O)+15]); } while (0)
namespace pg8 {
#define PG8_LAS __attribute__((address_space(3)))
typedef unsigned short bf16_t;
typedef short bf16x8 __attribute__((ext_vector_type(8)));
typedef float f32x4 __attribute__((ext_vector_type(4)));
typedef unsigned u32x4 __attribute__((ext_vector_type(4)));
constexpr int BM = 256, BK = 64, HALF = 128, HTB = HALF * BK * 2  , STAGE_BYTES = 8 * HTB, NXCD = 8, WGM = 8;

__host__ __device__ __forceinline__ int lds_byte(int r, int c) { const int st = (r >> 4) * 2 + (c >> 5), rr = r & 15, cc = c & 31, ob = rr * 64 + cc * 2; return st * 1024 + (ob ^ (((ob >> 9) & 1) << 5)); }
__host__ __device__ __forceinline__ void stage_rc(int b, int& R, int& C) { const int st = b / 1024, sb = b % 1024, swz = sb ^ (((sb >> 9) & 1) << 5); R = (st >> 1) * 16 + swz / 64; C = (st & 1) * 32 + (swz % 64) / 2; }
__host__ __device__ __forceinline__ int perm32(int rho) { const int n = rho >> 4, i = rho & 15; return 8 * (i >> 2) + 4 * n + (i & 3); }

struct Unit { int pm, pn; };
struct Gemm { const bf16_t* A; const bf16_t* Bt; int M, N, K; };

struct StaticOrder {
    int nM, nN, nwg, G, c;
    __host__ __device__ void init(int M, int N, int G_, int c_) { nM = M / BM; nN = N / BM; nwg = nM * nN; G = G_; c = c_; }
    __host__ __device__ bool next(int i, Unit& u) const {
        const long L = (long)i * G + c; if (L >= nwg) return false;
        int wgid = (int)L; { const int q = nwg / NXCD, r = nwg % NXCD, xcd = wgid % NXCD, off = wgid / NXCD; wgid = (xcd < r ? xcd * (q + 1) : r * (q + 1) + (xcd - r) * q) + off; }
        const int nig = WGM * nN, gid = wgid / nig, fm = gid * WGM, gsz = (nM - fm) < WGM ? (nM - fm) : WGM;
        u.pm = fm + ((wgid % nig) % gsz); u.pn = (wgid % nig) / gsz; return true;
    }
    __device__ __forceinline__ void a_ready(const Unit&) const {}
    __device__ __forceinline__ void done(const Unit&) const {}
};

__device__ __forceinline__ unsigned cvt_pk_bf16(float lo, float hi) { unsigned r; asm volatile("v_cvt_pk_bf16_f32 %0, %1, %2" : "=v"(r) : "v"(lo), "v"(hi)); return r; }
typedef float f32x2 __attribute__((ext_vector_type(2)));
__device__ __forceinline__ f32x2 gelu_pk(f32x2 v) {
    const f32x2 av = __builtin_elementwise_abs(v), d = av * 0.2316418882f + 1.0f;
    f32x2 t; t.x = __builtin_amdgcn_rcpf(d.x); t.y = __builtin_amdgcn_rcpf(d.y);
    f32x2 q = t * 0.5307027145f + (-0.7265760135f); q = q * t + 0.7107068705f; q = q * t + (-0.142248368f); q = q * t + 0.127414796f; q = q * t;
    const f32x2 s = (v * v) * (-0.72134752044f);
    f32x2 e; e.x = __builtin_amdgcn_exp2f(s.x); e.y = __builtin_amdgcn_exp2f(s.y);
    const f32x2 m = v * (q * e), r = v - m;
    f32x2 o; o.x = v.x < 0.f ? m.x : r.x; o.y = v.y < 0.f ? m.y : r.y; return o;
}

template <int ACT  > struct EpiBf16 {
    static constexpr bool PERM = true, AFTER_DRAIN = false; static_assert(ACT == 0 || ACT == 1, "EpiBf16: ACT is 0 (none) or 1 (gelu_pk)");
    bf16_t* O; int ldc; const float* bias; int split_cols; size_t split_stride; float scale0;
    __device__ __forceinline__ void operator()(const f32x4 (&acc)[2][2][4][2], const Unit& u, int wr, int wc, int fr, int fq) const {
        const int row0 = u.pm * BM + wr * 64 + fr; int colt = u.pn * BM; bf16_t* base = O;
        float sc = 1.f; if (split_cols) { const int t = colt / split_cols; base += (size_t)t * split_stride; colt -= t * split_cols; if (t == 0) sc = scale0; }
        const int col0 = colt + wc * 32 + 8 * fq, bcol0 = u.pn * BM + wc * 32 + 8 * fq;
        f32x4 bv[2][2];
#pragma unroll
        for (int bj = 0; bj < 2; ++bj)
#pragma unroll
            for (int n = 0; n < 2; ++n) bv[bj][n] = bias ? *(const f32x4*)(bias + bcol0 + bj * HALF + 4 * n) : (f32x4){0.f, 0.f, 0.f, 0.f};
#pragma unroll
        for (int ai = 0; ai < 2; ++ai)
#pragma unroll
            for (int m = 0; m < 4; ++m) { bf16_t* rowp = base + (size_t)(row0 + ai * HALF + m * 16) * ldc + col0;
#pragma unroll
                for (int bj = 0; bj < 2; ++bj) { f32x4 v0 = acc[ai][bj][m][0] + bv[bj][0], v1 = acc[ai][bj][m][1] + bv[bj][1];
                    if (ACT == 1) { f32x2 a = gelu_pk((f32x2){v0[0], v0[1]}), b = gelu_pk((f32x2){v0[2], v0[3]}), c = gelu_pk((f32x2){v1[0], v1[1]}), d = gelu_pk((f32x2){v1[2], v1[3]});
                        v0 = (f32x4){a.x, a.y, b.x, b.y}; v1 = (f32x4){c.x, c.y, d.x, d.y}; }
                    v0 = v0 * sc; v1 = v1 * sc; u32x4 w; w.x = cvt_pk_bf16(v0[0], v0[1]); w.y = cvt_pk_bf16(v0[2], v0[3]); w.z = cvt_pk_bf16(v1[0], v1[1]); w.w = cvt_pk_bf16(v1[2], v1[3]);
                    *(u32x4*)(rowp + bj * HALF) = w; } }
    }
};
template <class Epi, class Sched, bool ALIGN_EPI = false, bool SP2 = false>
__device__ __forceinline__ void gemm_phase(PG8_LAS unsigned char* lds, const Gemm g, const Sched& S, const Epi& E) {
    int tid = threadIdx.x; asm volatile("" : "+v"(tid));
    const int wid = __builtin_amdgcn_readfirstlane(tid >> 6), lane = tid & 63, wr = wid >> 2, wc = wid & 3, fr = lane & 15, fq = lane >> 4;
    const int K = g.K, nt = K / BK;
    unsigned voffA[2], voffB[2];
#pragma unroll
    for (int i = 0; i < 2; ++i) { int R, C; stage_rc(tid * 16 + i * 8192, R, C); const int Rb = Epi::PERM ? ((R & ~31) + perm32(R & 31)) : R;
        voffA[i] = (unsigned)(R * K + C) * 2u; voffB[i] = (unsigned)(Rb * K + C) * 2u; }
    const size_t kstep = (size_t)(BK * 2);
    const size_t hstep = (size_t)HALF * K * 2;
    const size_t tstep = 2 * hstep;
    const unsigned ldsw = (unsigned)wid * 1024u;
    const int aoff = lds_byte(wr * 64 + fr, fq * 8), boff = lds_byte(wc * 32 + fr, fq * 8);
#define PG8_SA(b, h) (((b) * 2 + (h)) * HTB)
#define PG8_SB(b, h) ((4 + (b) * 2 + (h)) * HTB)
#define PG8_STAGE(bufoff, gbase, voff) do { _Pragma("unroll") for (int _i = 0; _i < 2; ++_i) \
        __builtin_amdgcn_global_load_lds((const unsigned*)((const char*)(gbase) + (voff)[_i]), (PG8_LAS unsigned*)(lds + (bufoff) + ldsw + _i * 8192), 16, 0, 0); } while (0)
#define PG8_LDA(dst, b, h) do { _Pragma("unroll") for (int m = 0; m < 4; ++m) _Pragma("unroll") for (int k = 0; k < 2; ++k) dst[m][k] = *(const PG8_LAS bf16x8*)(lds + PG8_SA(b, h) + aoff + m * 2048 + k * 1024); } while (0)
#define PG8_LDB(dst, b, h) do { _Pragma("unroll") for (int n = 0; n < 2; ++n) _Pragma("unroll") for (int k = 0; k < 2; ++k) dst[n][k] = *(const PG8_LAS bf16x8*)(lds + PG8_SB(b, h) + boff + n * 2048 + k * 1024); } while (0)
#define PG8_MMA(ai, bj, At, Bt) do { __builtin_amdgcn_s_setprio(1); _Pragma("unroll") for (int m = 0; m < 4; ++m) _Pragma("unroll") for (int n = 0; n < 2; ++n) _Pragma("unroll") for (int k = 0; k < 2; ++k) \
        acc[ai][bj][m][n] = __builtin_amdgcn_mfma_f32_16x16x32_bf16(Bt[n][k], At[m][k], acc[ai][bj][m][n], 0, 0, 0); __builtin_amdgcn_s_setprio(0); } while (0)
#define PG8_WAIT_V(n) asm volatile("s_waitcnt vmcnt(" #n ")" ::: "memory")
#define PG8_WAIT_L(n) asm volatile("s_waitcnt lgkmcnt(" #n ")" ::: "memory")
#define PG8_BAR __builtin_amdgcn_s_barrier()
#define PG8_SCHED __builtin_amdgcn_sched_barrier(0)
    Unit cur, nxt; int ui = 0;
    if (!S.next(0, cur)) return;
    f32x4 acc[2][2][4][2];
#pragma unroll
    for (int a = 0; a < 2; ++a)
#pragma unroll
        for (int b = 0; b < 2; ++b)
#pragma unroll
            for (int m = 0; m < 4; ++m)
#pragma unroll
                for (int n = 0; n < 2; ++n) acc[a][b][m][n] = (f32x4){0.f, 0.f, 0.f, 0.f};
    bf16x8 At[4][2], B0[2][2], B1[2][2];
    const char* cA = (const char*)g.A + (size_t)cur.pm * tstep; const char* cB = (const char*)g.Bt + (size_t)cur.pn * tstep;
    S.a_ready(cur);
    if constexpr (SP2) {
        PG8_STAGE(PG8_SB(0, 0), cB, voffB); PG8_STAGE(PG8_SB(0, 1), cB + hstep, voffB); PG8_STAGE(PG8_SA(0, 0), cA, voffA); PG8_STAGE(PG8_SA(0, 1), cA + hstep, voffA);
        if (wr == 1) PG8_BAR;
        PG8_WAIT_V(2); PG8_BAR;
        PG8_STAGE(PG8_SB(1, 0), cB + kstep, voffB); PG8_STAGE(PG8_SA(1, 0), cA + kstep, voffA); PG8_STAGE(PG8_SB(1, 1), cB + hstep + kstep, voffB);
        PG8_WAIT_V(6); PG8_BAR;
    } else {
        PG8_STAGE(PG8_SB(0, 0), cB, voffB); PG8_STAGE(PG8_SA(0, 0), cA, voffA); PG8_STAGE(PG8_SB(0, 1), cB + hstep, voffB); PG8_STAGE(PG8_SA(0, 1), cA + hstep, voffA);
        if (wr == 1) PG8_BAR;
        PG8_WAIT_V(4); PG8_BAR;
        PG8_STAGE(PG8_SB(1, 0), cB + kstep, voffB); PG8_STAGE(PG8_SA(1, 0), cA + kstep, voffA); PG8_STAGE(PG8_SB(1, 1), cB + hstep + kstep, voffB);
        PG8_WAIT_V(6); PG8_BAR;
    }
    for (;;) {
        const bool has_next = S.next(ui + 1, nxt);
        const char* nA = has_next ? (const char*)g.A + (size_t)nxt.pm * tstep : cA; const char* nB = has_next ? (const char*)g.Bt + (size_t)nxt.pn * tstep : cB;
        for (int t = 0; t < nt; t += 2) {
            const bool last = (t == nt - 2);
            const char* a1 = cA + (size_t)(t + 1) * kstep;
            const char* a2 = last ? nA : cA + (size_t)(t + 2) * kstep; const char* b2 = last ? nB : cB + (size_t)(t + 2) * kstep;
            const char* a3 = a2 + kstep; const char* b3 = b2 + kstep;
            if (last && has_next) S.a_ready(nxt);
            if constexpr (SP2) {
            PG8_LDB(B0, 0, 0); PG8_LDB(B1, 0, 1); PG8_SCHED; PG8_LDA(At, 0, 0); PG8_STAGE(PG8_SA(1, 1), a1 + hstep, voffA);
            PG8_WAIT_V(8); PG8_WAIT_L(0); PG8_BAR; PG8_MMA(0, 0, At, B0); PG8_MMA(0, 1, At, B1); PG8_BAR; PG8_SCHED;
            PG8_LDA(At, 0, 1); PG8_STAGE(PG8_SB(0, 0), b2, voffB); PG8_STAGE(PG8_SB(0, 1), b2 + hstep, voffB); PG8_STAGE(PG8_SA(0, 0), a2, voffA);
            PG8_WAIT_V(8); PG8_WAIT_L(0); PG8_BAR; PG8_MMA(1, 0, At, B0); PG8_MMA(1, 1, At, B1); PG8_BAR; PG8_SCHED;
            PG8_LDB(B0, 1, 0); PG8_LDB(B1, 1, 1); PG8_SCHED; PG8_LDA(At, 1, 0); PG8_STAGE(PG8_SA(0, 1), a2 + hstep, voffA);
            PG8_WAIT_V(8); PG8_WAIT_L(0); PG8_BAR; PG8_MMA(0, 0, At, B0); PG8_MMA(0, 1, At, B1); PG8_BAR; PG8_SCHED;
            PG8_LDA(At, 1, 1); PG8_STAGE(PG8_SB(1, 0), b3, voffB); PG8_STAGE(PG8_SB(1, 1), b3 + hstep, voffB); PG8_STAGE(PG8_SA(1, 0), a3, voffA);
            PG8_WAIT_V(8); PG8_WAIT_L(0); PG8_BAR; PG8_MMA(1, 0, At, B0); PG8_MMA(1, 1, At, B1); PG8_BAR; PG8_SCHED;
            } else {
            PG8_LDB(B0, 0, 0); PG8_SCHED; PG8_LDA(At, 0, 0); PG8_STAGE(PG8_SA(1, 1), a1 + hstep, voffA);
            PG8_WAIT_L(8); PG8_BAR; PG8_WAIT_L(0); PG8_MMA(0, 0, At, B0); PG8_BAR; PG8_SCHED;
            PG8_LDB(B1, 0, 1); PG8_STAGE(PG8_SB(0, 0), b2, voffB);
            PG8_BAR; PG8_WAIT_L(0); PG8_MMA(0, 1, At, B1); PG8_BAR;
            PG8_LDA(At, 0, 1); PG8_STAGE(PG8_SA(0, 0), a2, voffA);
            PG8_BAR; PG8_WAIT_L(0); PG8_MMA(1, 0, At, B0); PG8_BAR; PG8_SCHED;
            PG8_STAGE(PG8_SB(0, 1), b2 + hstep, voffB);
            PG8_WAIT_V(6); PG8_BAR; PG8_MMA(1, 1, At, B1); PG8_BAR;
            PG8_LDB(B0, 1, 0); PG8_SCHED; PG8_LDA(At, 1, 0); PG8_STAGE(PG8_SA(0, 1), a2 + hstep, voffA);
            PG8_WAIT_L(8); PG8_BAR; PG8_WAIT_L(0); PG8_MMA(0, 0, At, B0); PG8_BAR; PG8_SCHED;
            PG8_LDB(B1, 1, 1); PG8_STAGE(PG8_SB(1, 0), b3, voffB);
            PG8_BAR; PG8_WAIT_L(0); PG8_MMA(0, 1, At, B1); PG8_BAR;
            PG8_LDA(At, 1, 1); PG8_STAGE(PG8_SA(1, 0), a3, voffA);
            PG8_BAR; PG8_WAIT_L(0); PG8_MMA(1, 0, At, B0); PG8_BAR; PG8_SCHED;
            PG8_STAGE(PG8_SB(1, 1), b3 + hstep, voffB);
            PG8_WAIT_V(6); PG8_BAR; PG8_MMA(1, 1, At, B1); PG8_BAR;
            }
        }
        if constexpr (ALIGN_EPI) { if (wr == 0) PG8_BAR; }
        if constexpr (!Epi::AFTER_DRAIN) { E(acc, cur, wr, wc, fr, fq); S.done(cur); }
        if (!has_next) break;
#pragma unroll
        for (int a = 0; a < 2; ++a)
#pragma unroll
            for (int b = 0; b < 2; ++b)
#pragma unroll
                for (int m = 0; m < 4; ++m)
#pragma unroll
                    for (int n = 0; n < 2; ++n) acc[a][b][m][n] = (f32x4){0.f, 0.f, 0.f, 0.f};
        cur = nxt; cA = nA; cB = nB; ++ui;
        if constexpr (ALIGN_EPI) { if (wr == 1) PG8_BAR; }
    }
    PG8_WAIT_V(0);
    if constexpr (!ALIGN_EPI) { if (wr == 0) PG8_BAR; }
    PG8_BAR;
    if constexpr (Epi::AFTER_DRAIN) { E.fused(acc, cur, wr, wc, fr, fq, lds, wid, lane); S.done(cur); }
#undef PG8_SA
#undef PG8_SB
#undef PG8_STAGE
#undef PG8_LDA
#undef PG8_LDB
#undef PG8_MMA
#undef PG8_WAIT_V
#undef PG8_WAIT_L
#undef PG8_BAR
#undef PG8_SCHED
}
}

#define LAS __attribute__((address_space(3)))
typedef unsigned short bf16_t;
typedef short bf16x8 __attribute__((ext_vector_type(8)));
typedef short s16x4 __attribute__((ext_vector_type(4)));
typedef float f32x4 __attribute__((ext_vector_type(4)));
typedef float f32x16 __attribute__((ext_vector_type(16)));
typedef unsigned u32x4 __attribute__((ext_vector_type(4)));
typedef unsigned u32x2 __attribute__((ext_vector_type(2)));

constexpr int DM = 1024;
constexpr int NP = 16 * 2048;
constexpr int NS = 8 * 64;
constexpr int NT = NP + NS;
constexpr int DIN = 2560;
constexpr int SKV = 2112;
constexpr float EPS = 1e-6f;
constexpr float LOG2E = 1.4426950408889634f;
constexpr float QSCALE = 0.125f * LOG2E;

constexpr long OUT_Y = 0;
constexpr long OUT_KP = 34078720L, OUT_VP = 50855936L, OUT_CONVP = 67633152L, OUT_KS = 67878912L, OUT_VS = 68141056L, OUT_CONVS = 68403200L, OUT_TOTAL = 68526080L;

constexpr size_t MiB = 1u << 20;
constexpr size_t WS_CTL = 0, CTL_BYTES = 1 * MiB;
constexpr size_t WS_WINT = 1 * MiB;
constexpr size_t WS_WOUTT = 6 * MiB;
constexpr size_t WS_WQT = 8 * MiB;
constexpr size_t WS_SK = 12 * MiB;
constexpr size_t WS_PU8 = 16 * MiB;
constexpr size_t WS_PV8 = 32 * MiB;
constexpr size_t WS_SCU = 48 * MiB;
constexpr size_t WS_SCV = 49 * MiB;
constexpr size_t WS_KS = 80 * MiB;
constexpr size_t WS_VS = 97 * MiB;
constexpr size_t WS_H = 114 * MiB;
constexpr size_t WS_A = 179 * MiB;
constexpr size_t WS_Q = 212 * MiB;
constexpr size_t WS_QP = 114 * MiB;
constexpr size_t WS_KP = 245 * MiB;
constexpr size_t WS_VP = 277 * MiB;
constexpr size_t WS_MIX = 309 * MiB;
constexpr size_t WS_H2 = 309 * MiB;
constexpr size_t WS_TK = 375 * MiB;
constexpr size_t WS_IDX = 408 * MiB;
constexpr size_t WS_GATE = 425 * MiB;
constexpr size_t WS_PACT = 180 * MiB;
constexpr size_t WS_X3 = 114 * MiB;
constexpr size_t WS_COEF = 375 * MiB;
constexpr size_t WS_XG = 442 * MiB;
constexpr size_t WS_SSQ = 507 * MiB;
constexpr size_t WS_RSTD = 510 * MiB;
constexpr size_t WS_END = 511 * MiB;
static_assert(WS_H + (size_t)NT * 1024 * 2 <= WS_A && WS_A + (size_t)NT * 512 * 2 <= WS_Q && WS_Q + (size_t)NT * 512 * 2 <= WS_KP, "R1");
static_assert(WS_QP + (size_t)NT * 2048 * 2 <= WS_KP && WS_KP + (size_t)NP * 512 * 2 <= WS_VP && WS_VP + (size_t)NP * 512 * 2 <= WS_MIX, "ws map");
static_assert(WS_MIX + (size_t)NT * 1024 * 2 <= WS_TK && WS_TK + (size_t)NT * 256 * 4 <= WS_IDX && WS_IDX + (size_t)NT * 128 * 4 <= WS_GATE && WS_GATE + (size_t)NT * 128 * 4 <= WS_END, "ws map 2");
static_assert(WS_KS + (size_t)8 * SKV * 512 * 2 <= WS_VS && WS_VS + (size_t)8 * SKV * 512 * 2 <= WS_H, "ws map 3");

constexpr int RING_BYTES = 131072;
constexpr int BIAS_OFF = RING_BYTES;
constexpr int MISC_OFF = RING_BYTES + 5120;
constexpr int LDS_BYTES = MISC_OFF + 1024;

struct Params {
    const float* in[24];
    float* out;
    unsigned char* ws;
};

__device__ __forceinline__ unsigned cvtpk(float lo, float hi) { return pg8::cvt_pk_bf16(lo, hi); }
__device__ __forceinline__ float bflo(unsigned w) { return __uint_as_float(w << 16); }
__device__ __forceinline__ float bfhi(unsigned w) { return __uint_as_float(w & 0xffff0000u); }
__device__ __forceinline__ float wave_sum(float v) {
#pragma unroll
    for (int o = 1; o < 64; o <<= 1) v += __shfl_xor(v, o);
    return v;
}
typedef float f32x2 __attribute__((ext_vector_type(2)));
#define DPP_ADD(v, ctrl) v += __builtin_bit_cast(float, __builtin_amdgcn_update_dpp(0, __builtin_bit_cast(int, v), ctrl, 0xf, 0xf, true))
__device__ __forceinline__ float rl_f(float v, int l) { return __uint_as_float(__builtin_amdgcn_readlane(__float_as_uint(v), l)); }
__device__ __forceinline__ float wave_total(float v) {
    DPP_ADD(v, 0xB1); DPP_ADD(v, 0x4E); DPP_ADD(v, 0x141); DPP_ADD(v, 0x140);
    return (rl_f(v, 0) + rl_f(v, 16)) + (rl_f(v, 32) + rl_f(v, 48));
}
typedef __bf16 bf16x2_t __attribute__((ext_vector_type(2)));
__device__ __forceinline__ float dot2(unsigned a, unsigned b, float acc) {
    return __builtin_amdgcn_fdot2_f32_bf16(__builtin_bit_cast(bf16x2_t, a), __builtin_bit_cast(bf16x2_t, b), acc, false);
}
#define LDS_WAIT() asm volatile("s_waitcnt lgkmcnt(0)" ::: "memory")

#define XB_TMO      128
#define XB_XCNT(j)  (256  + 64 * (j))
#define XB_XSUB(j)  (1280 + 64 * (j))
#define XB_XGEN(j)  (2304 + 64 * (j))
#define XB_TOP      3328
#define XB_TOPGEN   3392
#define XCD_BAR_WORDS 3456
#define XB_SPIN_CAP (1u << 18)

__device__ __forceinline__ unsigned xb_ld(unsigned* p)              { return __hip_atomic_load(p, __ATOMIC_RELAXED, __HIP_MEMORY_SCOPE_AGENT); }
__device__ __forceinline__ unsigned xb_add(unsigned* p, unsigned v) { return __hip_atomic_fetch_add(p, v, __ATOMIC_RELAXED, __HIP_MEMORY_SCOPE_AGENT); }
__device__ __forceinline__ unsigned xb_xcc_id() { return (unsigned)__builtin_amdgcn_s_getreg((3 << 11) | 20) & 0xFu; }
#define XB_SPIN(cond, bar) do { unsigned _sp = 0; while (cond) { __builtin_amdgcn_s_sleep(1); \
    if ((++_sp & 255u) == 0u) { if (xb_ld(&(bar)[XB_TMO])) break; if (_sp > XB_SPIN_CAP) { atomicAdd(&(bar)[XB_TMO], 1u); break; } } } } while (0)

struct XcdBarrier {
    unsigned* bar; unsigned x;
    volatile LAS unsigned* st;
};

__device__ __forceinline__ XcdBarrier xcd_barrier_post(unsigned* bar, volatile LAS unsigned* st) {
    XcdBarrier b; b.bar = bar; b.x = xb_xcc_id(); b.st = st;
    if (threadIdx.x == 0) (void)xb_add(&bar[XB_XCNT(b.x)], 1u);
    return b;
}
__device__ __forceinline__ void xcd_barrier_complete(unsigned* bar, unsigned x, unsigned& nloc, unsigned& nx) {
    const unsigned G = gridDim.x * gridDim.y * gridDim.z;
    unsigned sum, cnt, mine, sp = 0u;
    for (;;) {
        sum = 0u; cnt = 0u; mine = 0u;
#pragma unroll
        for (unsigned j = 0; j < 16; ++j) { const unsigned c = xb_ld(&bar[XB_XCNT(j)]); sum += c; cnt += (c > 0u) ? 1u : 0u; mine = (j == x) ? c : mine; }
        if (sum == G) break;
        __builtin_amdgcn_s_sleep(1);
        if ((++sp & 255u) == 0u) { if (xb_ld(&bar[XB_TMO])) break; if (sp > XB_SPIN_CAP) { atomicAdd(&bar[XB_TMO], 1u); break; } }
    }
    nloc = mine > 0u ? mine : 1u; nx = cnt > 0u ? cnt : 1u;
}

__device__ __forceinline__ void xcd_barrier(const XcdBarrier& b) {
    asm volatile("s_waitcnt vmcnt(0)" ::: "memory");
    __syncthreads();
    if (threadIdx.x == 0) {
        unsigned* bar = b.bar;
        __builtin_amdgcn_s_waitcnt(0);
        unsigned nloc = b.st[0], nx = b.st[1];
        if (nloc == 0u) { xcd_barrier_complete(bar, b.x, nloc, nx); b.st[0] = nloc; b.st[1] = nx; }
        const unsigned old = xb_add(&bar[XB_XSUB(b.x)], 1u);
        const unsigned gen = old / nloc;
        if (old + 1u == (gen + 1u) * nloc) {
            __builtin_amdgcn_fence(__ATOMIC_RELEASE, "agent");
            asm volatile("s_waitcnt vmcnt(0)" ::: "memory");
            const unsigned og = xb_add(&bar[XB_TOP], 1u);
            const unsigned tg = og / nx;
            if (og + 1u == (tg + 1u) * nx) xb_add(&bar[XB_TOPGEN], 1u);
            else XB_SPIN(xb_ld(&bar[XB_TOPGEN]) == tg, bar);
            __builtin_amdgcn_fence(__ATOMIC_ACQUIRE, "agent");
            xb_add(&bar[XB_XGEN(b.x)], 1u);
            asm volatile("s_waitcnt vmcnt(0)" ::: "memory");
        } else {
            XB_SPIN(xb_ld(&bar[XB_XGEN(b.x)]) == gen, bar);
            __builtin_amdgcn_fence(__ATOMIC_ACQUIRE, "agent");
            asm volatile("s_waitcnt vmcnt(0)" ::: "memory");
        }
    }
    __syncthreads();
}


namespace pg8 {
__device__ __forceinline__ u32x2 pack4(f32x4 v) { u32x2 w; w.x = cvt_pk_bf16(v[0], v[1]); w.y = cvt_pk_bf16(v[2], v[3]); return w; }
struct EpiProj {
    static constexpr bool PERM = true, AFTER_DRAIN = false;
    bf16_t* A; bf16_t* Q; bf16_t* KP; bf16_t* VP; bf16_t* KS; bf16_t* VS; float* out;
    __device__ __forceinline__ void operator()(const f32x4 (&acc)[2][2][4][2], const Unit& u, int wr, int wc, int fr, int fq) const {
        const int pn = u.pn;
        const int row0 = u.pm * BM + wr * 64 + fr;
        if (pn < 4) {
#pragma unroll
            for (int ai = 0; ai < 2; ++ai)
#pragma unroll
                for (int m = 0; m < 4; ++m) {
                    const int row = row0 + ai * HALF + m * 16;
                    long toff = -1;
                    if (row < NP) { const int s = row & 2047; if (s >= 2018) toff = OUT_CONVP + ((long)(row >> 11) * 30 + (s - 2018)) * 512; }
                    else { const int rr = row - NP; const int i = rr & 63; if (i >= 34) toff = OUT_CONVS + ((long)(rr >> 6) * 30 + (i - 34)) * 512; }
                    const int c = 128 * pn + 32 * wc + 8 * fq;
                    f32x4 a[2];
#pragma unroll
                    for (int n = 0; n < 2; ++n) {
                        const f32x4 x = acc[ai][0][m][n], g = acc[ai][1][m][n];
#pragma unroll
                        for (int j = 0; j < 4; ++j) a[n][j] = x[j] / (1.f + __expf(-g[j]));
                    }
                    u32x4 w; w.x = cvt_pk_bf16(a[0][0], a[0][1]); w.y = cvt_pk_bf16(a[0][2], a[0][3]); w.z = cvt_pk_bf16(a[1][0], a[1][1]); w.w = cvt_pk_bf16(a[1][2], a[1][3]);
                    *(u32x4*)(A + (size_t)row * 512 + c) = w;
                    if (toff >= 0) { *(f32x4*)(out + toff + c) = a[0]; *(f32x4*)(out + toff + c + 4) = a[1]; }
                }
        } else {
            const int sec = (pn - 4) >> 1, colbase = ((pn - 4) & 1) * 256;
#pragma unroll
            for (int ai = 0; ai < 2; ++ai)
#pragma unroll
                for (int m = 0; m < 4; ++m) {
                    const int row = row0 + ai * HALF + m * 16;
                    const bool isp = row < NP; const int rr = row - NP;
                    bf16_t* bdst; float* fdst;
                    if (sec == 0) { bdst = Q + (size_t)row * 512; fdst = nullptr; }
                    else if (sec == 1) { bdst = isp ? KP + (size_t)row * 512 : KS + ((size_t)(rr >> 6) * SKV + 2048 + (rr & 63)) * 512; fdst = isp ? out + OUT_KP + (size_t)row * 512 : out + OUT_KS + (size_t)rr * 512; }
                    else { bdst = isp ? VP + (size_t)row * 512 : VS + ((size_t)(rr >> 6) * SKV + 2048 + (rr & 63)) * 512; fdst = isp ? out + OUT_VP + (size_t)row * 512 : out + OUT_VS + (size_t)rr * 512; }
#pragma unroll
                    for (int bj = 0; bj < 2; ++bj) {
                        const int col = colbase + 128 * bj + 32 * wc + 8 * fq;
                        const f32x4 v0 = acc[ai][bj][m][0], v1 = acc[ai][bj][m][1];
                        if (sec == 0) { const f32x4 s0 = v0 * QSCALE, s1 = v1 * QSCALE; u32x4 w; w.x = cvt_pk_bf16(s0[0], s0[1]); w.y = cvt_pk_bf16(s0[2], s0[3]); w.z = cvt_pk_bf16(s1[0], s1[1]); w.w = cvt_pk_bf16(s1[2], s1[3]); *(u32x4*)(bdst + col) = w; }
                        else { u32x4 w; w.x = cvt_pk_bf16(v0[0], v0[1]); w.y = cvt_pk_bf16(v0[2], v0[3]); w.z = cvt_pk_bf16(v1[0], v1[1]); w.w = cvt_pk_bf16(v1[2], v1[3]); *(u32x4*)(bdst + col) = w;
                               __builtin_nontemporal_store(v0, (f32x4*)(fdst + col)); __builtin_nontemporal_store(v1, (f32x4*)(fdst + col + 4)); }
                    }
                }
        }
    }
};
struct EpiRes {
    static constexpr bool PERM = true, AFTER_DRAIN = false;
    const float* xp; const float* xs; bf16_t* xg; const float* gff; float* ssq;
    __device__ __forceinline__ void operator()(const f32x4 (&acc)[2][2][4][2], const Unit& u, int wr, int wc, int fr, int fq) const {
        const int row0 = u.pm * BM + wr * 64 + fr;
        const int colb = u.pn * BM + 32 * wc + 8 * fq;
        f32x4 gg[2][2];
#pragma unroll
        for (int bj = 0; bj < 2; ++bj)
#pragma unroll
            for (int n = 0; n < 2; ++n) gg[bj][n] = *(const f32x4*)(gff + colb + 128 * bj + 4 * n);
        f32x4 xq[2][2][2];
#define EPR_LOAD(SLOT, I) do { const int row_ = row0 + ((I) >> 2) * HALF + ((I) & 3) * 16; const float* xr_ = row_ < NP ? xp + (size_t)row_ * DM : xs + (size_t)(row_ - NP) * DM; \
            _Pragma("unroll") for (int bj_ = 0; bj_ < 2; ++bj_) { xq[SLOT][bj_][0] = *(const f32x4*)(xr_ + colb + 128 * bj_); xq[SLOT][bj_][1] = *(const f32x4*)(xr_ + colb + 128 * bj_ + 4); } } while (0)
        EPR_LOAD(0, 0); EPR_LOAD(1, 1);
#pragma unroll
        for (int i = 0; i < 8; ++i) {
            const int ai = i >> 2, m = i & 3;
            const int row = row0 + ai * HALF + m * 16;
            bf16_t* grow = xg + (size_t)row * DM;
            f32x4 v[2][2];
#pragma unroll
            for (int bj = 0; bj < 2; ++bj) { v[bj][0] = xq[i & 1][bj][0] + acc[ai][bj][m][0]; v[bj][1] = xq[i & 1][bj][1] + acc[ai][bj][m][1]; }
            if (i + 2 < 8) EPR_LOAD(i & 1, i + 2);
            float sq = 0.f;
#pragma unroll
            for (int bj = 0; bj < 2; ++bj) {
                const f32x4 v0 = v[bj][0], v1 = v[bj][1];
                const f32x4 h0 = v0 * gg[bj][0], h1 = v1 * gg[bj][1];
                u32x4 w; w.x = cvt_pk_bf16(h0[0], h0[1]); w.y = cvt_pk_bf16(h0[2], h0[3]); w.z = cvt_pk_bf16(h1[0], h1[1]); w.w = cvt_pk_bf16(h1[2], h1[3]);
                *(u32x4*)(grow + colb + 128 * bj) = w;
                sq += ((v0[0] * v0[0] + v0[1] * v0[1]) + (v0[2] * v0[2] + v0[3] * v0[3])) + ((v1[0] * v1[0] + v1[1] * v1[1]) + (v1[2] * v1[2] + v1[3] * v1[3]));
            }
            sq += __shfl_xor(sq, 16); sq += __shfl_xor(sq, 32);
            if (fq == 0) ssq[(size_t)row * 16 + u.pn * 4 + wc] = sq;
        }
#undef EPR_LOAD
    }
};
}

__device__ __forceinline__ int winrow(int n) { return n < 1024 ? (256 * ((n & 511) >> 7) + 128 * (n >> 9) + (n & 127)) : n; }
template <bool WIN> __device__ __forceinline__ void transpose_item(const float* W, int K, int N, bf16_t* WT, LAS float* scr, int item, int lane) {
    const int nblk = N / 32, kb = item / nblk, nb = item % nblk, k0 = 64 * kb, n0 = 32 * nb;
#pragma unroll 8
    for (int i = 0; i < 32; ++i) { const int kk = 2 * i + (lane >> 5); scr[kk * 33 + (lane & 31)] = W[(size_t)(k0 + kk) * N + n0 + (lane & 31)]; }
    LDS_WAIT();
    const int c = lane & 7;
#pragma unroll
    for (int j = 0; j < 4; ++j) {
        const int n = (lane >> 3) + 8 * j; const LAS float* s = scr + (8 * c) * 33 + n;
        u32x4 o; o.x = cvtpk(s[0 * 33], s[1 * 33]); o.y = cvtpk(s[2 * 33], s[3 * 33]); o.z = cvtpk(s[4 * 33], s[5 * 33]); o.w = cvtpk(s[6 * 33], s[7 * 33]);
        const int dr = WIN ? winrow(n0 + n) : (n0 + n);
        *(u32x4*)(WT + (size_t)dr * K + k0 + 8 * c) = o;
    }
    LDS_WAIT();
}
__device__ __forceinline__ void cvt_stream(const float* src, bf16_t* dst, size_t n8, size_t gt, size_t ngt) {
    for (size_t i = gt; i < n8; i += ngt) {
        const f32x4 a = *(const f32x4*)(src + i * 8), b = *(const f32x4*)(src + i * 8 + 4);
        u32x4 o; o.x = cvtpk(a[0], a[1]); o.y = cvtpk(a[2], a[3]); o.z = cvtpk(b[0], b[1]); o.w = cvtpk(b[2], b[3]);
        *(u32x4*)(dst + i * 8) = o;
    }
}
__device__ __forceinline__ void cvt_cache(const float* src, bf16_t* dst, size_t gt, size_t ngt) {
    const size_t n8 = (size_t)8 * 2048 * 512 / 8;
    for (size_t i = gt; i < n8; i += ngt) {
        const size_t e = i * 8; const size_t row = e >> 9, col = e & 511; const size_t drow = (row >> 11) * SKV + (row & 2047);
        const f32x4 a = *(const f32x4*)(src + e), b = *(const f32x4*)(src + e + 4);
        u32x4 o; o.x = cvtpk(a[0], a[1]); o.y = cvtpk(a[2], a[3]); o.z = cvtpk(b[0], b[1]); o.w = cvtpk(b[2], b[3]);
        *(u32x4*)(dst + drow * 512 + col) = o;
    }
}
__device__ __forceinline__ void rms_row_bf16(const float* xrow, const float* g, bf16_t* orow, int lane) {
    const f32x4* xr = (const f32x4*)xrow + lane; const f32x4* gr = (const f32x4*)g + lane;
    f32x4 v[4]; float s = 0.f;
#pragma unroll
    for (int j = 0; j < 4; ++j) { v[j] = xr[64 * j]; s += (v[j][0] * v[j][0] + v[j][1] * v[j][1]) + (v[j][2] * v[j][2] + v[j][3] * v[j][3]); }
    const float rstd = 1.f / sqrtf(wave_sum(s) * (1.f / DM) + EPS);
    u32x2* o8 = (u32x2*)orow + lane;
#pragma unroll
    for (int j = 0; j < 4; ++j) { const f32x4 gg = gr[64 * j]; u32x2 w; w.x = cvtpk(v[j][0] * rstd * gg[0], v[j][1] * rstd * gg[1]); w.y = cvtpk(v[j][2] * rstd * gg[2], v[j][3] * rstd * gg[3]); o8[64 * j] = w; }
}

template <bool SLICED> __device__ __forceinline__ void cvt_row_fp8(const float* src, unsigned char* dst_base, int row, float* scale_out, int lane) {
    const f32x4* xr = (const f32x4*)src + lane;
    f32x4 v[4]; float am = 0.f;
#pragma unroll
    for (int j = 0; j < 4; ++j) { v[j] = xr[64 * j]; am = fmaxf(am, fmaxf(fmaxf(fabsf(v[j][0]), fabsf(v[j][1])), fmaxf(fabsf(v[j][2]), fabsf(v[j][3])))); }
#pragma unroll
    for (int o = 1; o < 64; o <<= 1) am = fmaxf(am, __shfl_xor(am, o));
    const float sc = am > 0.f ? am * (1.f / 448.f) : 1.f, inv = 1.f / sc;
#pragma unroll
    for (int j = 0; j < 4; ++j) {
        const int eb = 256 * j + 4 * lane;
        int w = __builtin_amdgcn_cvt_pk_fp8_f32(v[j][0] * inv, v[j][1] * inv, 0, false);
        w = __builtin_amdgcn_cvt_pk_fp8_f32(v[j][2] * inv, v[j][3] * inv, w, true);
        if (SLICED) *(int*)(dst_base + ((size_t)(eb >> 7) * 16384 + row) * 128 + (eb & 127)) = w;
        else *(int*)(dst_base + (size_t)row * DM + 16 * ((eb & 511) >> 3) + (eb & 7) + (eb >= 512 ? 8 : 0)) = w;
    }
    if (lane == 0) *scale_out = sc;
}

__device__ __forceinline__ void rms_row2_bf16(const float* xa, const float* xb, const float* g, bf16_t* oa, bf16_t* ob, int lane) {
    const f32x4* ra = (const f32x4*)xa + lane; const f32x4* rb = (const f32x4*)xb + lane; const f32x4* gr = (const f32x4*)g + lane;
    f32x4 va[4], vb[4]; float sa = 0.f, sb = 0.f;
#pragma unroll
    for (int j = 0; j < 4; ++j) { va[j] = ra[64 * j]; vb[j] = rb[64 * j]; }
#pragma unroll
    for (int j = 0; j < 4; ++j) { sa += (va[j][0] * va[j][0] + va[j][1] * va[j][1]) + (va[j][2] * va[j][2] + va[j][3] * va[j][3]); sb += (vb[j][0] * vb[j][0] + vb[j][1] * vb[j][1]) + (vb[j][2] * vb[j][2] + vb[j][3] * vb[j][3]); }
    const float ra_ = 1.f / sqrtf(wave_total(sa) * (1.f / DM) + EPS), rb_ = 1.f / sqrtf(wave_total(sb) * (1.f / DM) + EPS);
    u32x2* o8a = (u32x2*)oa + lane; u32x2* o8b = (u32x2*)ob + lane;
#pragma unroll
    for (int j = 0; j < 4; ++j) { const f32x4 gg = gr[64 * j];
        u32x2 w; w.x = cvtpk(va[j][0] * ra_ * gg[0], va[j][1] * ra_ * gg[1]); w.y = cvtpk(va[j][2] * ra_ * gg[2], va[j][3] * ra_ * gg[3]); o8a[64 * j] = w;
        u32x2 z; z.x = cvtpk(vb[j][0] * rb_ * gg[0], vb[j][1] * rb_ * gg[1]); z.y = cvtpk(vb[j][2] * rb_ * gg[2], vb[j][3] * rb_ * gg[3]); o8b[64 * j] = z; }
}
__device__ __forceinline__ void cvt_row_i8(const float* src, unsigned char* dst_base, int row, float* scale_out, int lane) {
    const f32x4* xr = (const f32x4*)src + lane;
    f32x4 v[4]; float am = 0.f;
#pragma unroll
    for (int j = 0; j < 4; ++j) { v[j] = xr[64 * j]; am = fmaxf(am, fmaxf(fmaxf(fabsf(v[j][0]), fabsf(v[j][1])), fmaxf(fabsf(v[j][2]), fabsf(v[j][3])))); }
#pragma unroll
    for (int o = 1; o < 64; o <<= 1) am = fmaxf(am, __shfl_xor(am, o));
    const float sc = am > 0.f ? am * (1.f / 127.f) : 1.f, inv = 1.f / sc;
#pragma unroll
    for (int j = 0; j < 4; ++j) {
        const int eb = 256 * j + 4 * lane;
        const int q0 = __float2int_rn(v[j][0] * inv), q1 = __float2int_rn(v[j][1] * inv), q2 = __float2int_rn(v[j][2] * inv), q3 = __float2int_rn(v[j][3] * inv);
        const unsigned w = (unsigned)(q0 & 255) | ((unsigned)(q1 & 255) << 8) | ((unsigned)(q2 & 255) << 16) | ((unsigned)(q3 & 255) << 24);
        *(unsigned*)(dst_base + ((size_t)(eb >> 7) * 16384 + row) * 128 + (eb & 127)) = w;
    }
    if (lane == 0) *scale_out = sc;
}
__device__ __forceinline__ void phase0(const Params& p, LAS unsigned char* lds, int tid, int lane, int wave) {
    const int gw = blockIdx.x * 8 + wave, NGW = gridDim.x * 8;
    LAS float* scr = (LAS float*)(lds + wave * 16384);
    bf16_t* WINT = (bf16_t*)(p.ws + WS_WINT);
    constexpr int I_IN = 16 * (DIN / 32);
    for (int it = gw; it < I_IN; it += NGW) transpose_item<true>(p.in[6], 1024, DIN, WINT, scr, it, lane);
    bf16_t* H = (bf16_t*)(p.ws + WS_H);
    for (int m = gw; m < NT; m += 2 * NGW) {
        const int m2 = m + NGW < NT ? m + NGW : m;
        const float* xr = m < NP ? p.in[0] + (size_t)m * DM : p.in[1] + (size_t)(m - NP) * DM;
        const float* xr2 = m2 < NP ? p.in[0] + (size_t)m2 * DM : p.in[1] + (size_t)(m2 - NP) * DM;
        rms_row2_bf16(xr, xr2, p.in[5], H + (size_t)m * DM, H + (size_t)m2 * DM, lane);
    }
}
__device__ __forceinline__ void prep_late(const Params& p, LAS unsigned char* lds, int tid, int lane, int wave, int rank, int nparts, int which) {
    const int gw = rank * 8 + wave, NGW = nparts * 8;
    LAS float* scr = (LAS float*)(lds + wave * 16384);
    const size_t gt = (size_t)rank * 512 + tid, ngt = (size_t)nparts * 512;
    if (which & 2) {
    cvt_cache(p.in[2], (bf16_t*)(p.ws + WS_KS), gt, ngt);
    cvt_cache(p.in[3], (bf16_t*)(p.ws + WS_VS), gt, ngt);
    bf16_t* WOUTT = (bf16_t*)(p.ws + WS_WOUTT); bf16_t* WQT = (bf16_t*)(p.ws + WS_WQT);
    constexpr int I_OUT = 16 * (1024 / 32), I_Q = 16 * (2048 / 32);
    for (int it = gw; it < I_OUT + I_Q; it += NGW) {
        if (it < I_OUT) transpose_item<false>(p.in[17], 1024, 1024, WOUTT, scr, it, lane);
        else transpose_item<false>(p.in[19], 1024, 2048, WQT, scr, it - I_OUT, lane);
    }
    cvt_stream(p.in[20], (bf16_t*)(p.ws + WS_SK), (size_t)16 * 128 * 128 / 8, gt, ngt);
    }
    if (which & 1)
    for (int r = gw; r < 2 * 16384; r += NGW) {
        const int tb = r >> 14, e = r & 16383;
        if (tb) cvt_row_fp8<true>(p.in[22] + (size_t)e * DM, p.ws + WS_PV8, e, (float*)(p.ws + WS_SCV) + e, lane);
        else cvt_row_i8(p.in[21] + (size_t)e * DM, p.ws + WS_PU8, e, (float*)(p.ws + WS_SCU) + e, lane);
    }
}

namespace att {
constexpr int KPITCH = 272, VPITCH = 320;
constexpr int L_KV = 0, KV_BYTES = 64 * KPITCH + 64 * VPITCH  , L_X = 0  , L_BIAS = BIAS_OFF, L_CA = 0  , L_CW = 94 * 1024  ;
static_assert(4 * 4096 * 4 <= 2 * KV_BYTES && 2 * KV_BYTES <= L_CW && L_CW + 31 * 1024 <= RING_BYTES, "attention LDS map");

__device__ __forceinline__ int rel_bucket(int rel) {
    const int ret = rel > 0 ? 16 : 0; const int n = rel < 0 ? -rel : rel; int v;
    if (n < 8) v = n; else if (n < 12) v = 8; else if (n < 16) v = 9; else if (n < 23) v = 10; else if (n < 32) v = 11;
    else if (n < 46) v = 12; else if (n < 64) v = 13; else if (n < 91) v = 14; else v = 15;
    return ret + v;
}
typedef short v4i16_t __attribute__((ext_vector_type(4)));
__device__ __forceinline__ s16x4 vtr(const LAS unsigned char* p) { return __builtin_bit_cast(s16x4, __builtin_amdgcn_ds_read_tr16_b64_v4i16((LAS v4i16_t*)p)); }
__device__ __forceinline__ f32x16 mfma32(bf16x8 a, bf16x8 b, f32x16 c) { return __builtin_amdgcn_mfma_f32_32x32x16_bf16(a, b, c, 0, 0, 0); }

__device__ __forceinline__ void attn_unit(const Params& p, LAS unsigned char* lds, int kind, int bb, int h, int qblk, float lam, int tid, int lane, int wid) {
    const bf16_t* Q = (const bf16_t*)(p.ws + WS_Q);
    const bf16_t* Kb = kind == 0 ? (const bf16_t*)(p.ws + WS_KP) + (size_t)bb * 2048 * 512 + h * 128 : (const bf16_t*)(p.ws + WS_KS) + (size_t)bb * SKV * 512 + h * 128;
    const bf16_t* Vb = kind == 0 ? (const bf16_t*)(p.ws + WS_VP) + (size_t)bb * 2048 * 512 + h * 128 : (const bf16_t*)(p.ws + WS_VS) + (size_t)bb * SKV * 512 + h * 128;
    bf16_t* MIX = (bf16_t*)(p.ws + WS_MIX);
    const int qrow0 = kind == 0 ? bb * 2048 + qblk * 128 : NP + bb * 64;
    const int qpos0 = kind == 0 ? qblk * 128 : 2048;
    const int ntiles = kind == 0 ? 2 * qblk + 2 : 33;
    const int rg = wid & 3, map = wid >> 2, r32 = lane & 31, hi = lane >> 5;
    const bool active = kind == 0 ? true : (rg < 2);
    const int cw = kind == 0 ? 2 * qblk + (rg >> 1) : 32;
    const int qw0 = qpos0 + 32 * rg;
    const int qabs = qw0 + r32;

    bf16x8 qf[4];
    if (active) {
        const bf16_t* qp = Q + (size_t)(qrow0 + 32 * rg + r32) * 512 + h * 128 + map * 64 + 8 * hi;
#pragma unroll
        for (int s = 0; s < 4; ++s) qf[s] = *(const bf16x8*)(qp + 16 * s);
    } else {
#pragma unroll
        for (int s = 0; s < 4; ++s) qf[s] = (bf16x8){0, 0, 0, 0, 0, 0, 0, 0};
    }
    float m = 0.f, l = 0.f;
    f32x16 negm;
#pragma unroll
    for (int r = 0; r < 16; ++r) negm[r] = 0.f;
    f32x16 o[4];
#pragma unroll
    for (int mt = 0; mt < 4; ++mt)
#pragma unroll
        for (int r = 0; r < 16; ++r) o[mt][r] = 0.f;

    const int srow0 = tid >> 4, sch = tid & 15;
    const LAS float* btab = (const LAS float*)(lds + L_BIAS) + h * 320;
    const int vlane = (4 * hi + ((lane & 15) >> 2)) * VPITCH + (16 * ((lane >> 4) & 1) + 4 * (lane & 3)) * 2;
    u32x4 kA[2], vA[2], kB[2], vB[2];
#define ATT_LOAD(KR, VR, T) do { _Pragma("unroll") for (int i_ = 0; i_ < 2; ++i_) { const size_t off_ = (size_t)((T) * 64 + srow0 + 32 * i_) * 512 + sch * 8; KR[i_] = *(const u32x4*)(Kb + off_); VR[i_] = *(const u32x4*)(Vb + off_); } } while (0)
#define ATT_STORE(KR, VR, BUF) do { _Pragma("unroll") for (int i_ = 0; i_ < 2; ++i_) { \
        *(LAS u32x4*)(lds + L_KV + (BUF) * KV_BYTES + (srow0 + 32 * i_) * KPITCH + sch * 16) = KR[i_]; \
        *(LAS u32x4*)(lds + L_KV + (BUF) * KV_BYTES + 64 * KPITCH + (srow0 + 32 * i_) * VPITCH + sch * 16) = VR[i_]; } } while (0)
    auto compute = [&](int t, int buf) {
        const LAS unsigned char* kbuf = lds + L_KV + buf * KV_BYTES;
        const LAS unsigned char* vbuf = kbuf + 64 * KPITCH;
        f32x16 p0, p1;
        const int kabs0 = t * 64;
        const LAS unsigned char* kb = kbuf + r32 * KPITCH + (map * 8 + hi) * 16;
        {
            const bf16x8 a0 = *(const LAS bf16x8*)(kb), a1 = *(const LAS bf16x8*)(kb + 32 * KPITCH);
            if (kabs0 + 63 - qw0 > -128) {
                const LAS float* bt = btab + (kabs0 - qabs + 256 + 4 * hi);
#pragma unroll
                for (int r = 0; r < 16; ++r) { p0[r] = bt[(r & 3) + 8 * (r >> 2)] - m; p1[r] = bt[32 + (r & 3) + 8 * (r >> 2)] - m; }
                p0 = mfma32(a0, qf[0], p0); p1 = mfma32(a1, qf[0], p1);
            } else { p0 = mfma32(a0, qf[0], negm); p1 = mfma32(a1, qf[0], negm); }
        }
#pragma unroll
        for (int s = 1; s < 4; ++s) {
            const bf16x8 a0 = *(const LAS bf16x8*)(kb + s * 32), a1 = *(const LAS bf16x8*)(kb + 32 * KPITCH + s * 32);
            p0 = mfma32(a0, qf[s], p0); p1 = mfma32(a1, qf[s], p1);
        }
        float mx = fmaxf(p0[0], p1[0]);
#pragma unroll
        for (int r = 1; r < 16; ++r) mx = fmaxf(mx, fmaxf(p0[r], p1[r]));
        { const auto rr = __builtin_amdgcn_permlane32_swap(__float_as_uint(mx), __float_as_uint(mx), false, false); mx = fmaxf(__uint_as_float(rr[0]), __uint_as_float(rr[1])); }
        if (__any(mx > 8.f)) {
            const float dl = fmaxf(mx, 0.f);
            m += dl;
            const float alpha = __builtin_amdgcn_exp2f(-dl);
            l *= alpha;
#pragma unroll
            for (int r = 0; r < 16; ++r) { p0[r] -= dl; p1[r] -= dl; negm[r] = -m; }
#pragma unroll
            for (int mt = 0; mt < 4; ++mt)
#pragma unroll
                for (int r = 0; r < 16; ++r) o[mt][r] *= alpha;
        }
        float rs = 0.f;
#pragma unroll
        for (int r = 0; r < 16; ++r) { p0[r] = __builtin_amdgcn_exp2f(p0[r]); p1[r] = __builtin_amdgcn_exp2f(p1[r]); rs += p0[r] + p1[r]; }
        l += rs;
#pragma unroll
        for (int t2 = 0; t2 < 2; ++t2)
#pragma unroll
            for (int s = 0; s < 2; ++s) {
                u32x4 bw;
                if (t2 == 0) { bw.x = cvtpk(p0[8 * s + 0], p0[8 * s + 1]); bw.y = cvtpk(p0[8 * s + 2], p0[8 * s + 3]); bw.z = cvtpk(p0[8 * s + 4], p0[8 * s + 5]); bw.w = cvtpk(p0[8 * s + 6], p0[8 * s + 7]); }
                else { bw.x = cvtpk(p1[8 * s + 0], p1[8 * s + 1]); bw.y = cvtpk(p1[8 * s + 2], p1[8 * s + 3]); bw.z = cvtpk(p1[8 * s + 4], p1[8 * s + 5]); bw.w = cvtpk(p1[8 * s + 6], p1[8 * s + 7]); }
                const bf16x8 B = __builtin_bit_cast(bf16x8, bw);
                const LAS unsigned char* vb = vbuf + vlane + (32 * t2 + 16 * s) * VPITCH;
#pragma unroll
                for (int mt = 0; mt < 4; ++mt) {
                    const s16x4 lo = vtr(vb + mt * 64), hi8 = vtr(vb + mt * 64 + 8 * VPITCH);
                    const bf16x8 A = (bf16x8){lo[0], lo[1], lo[2], lo[3], hi8[0], hi8[1], hi8[2], hi8[3]};
                    o[mt] = mfma32(A, B, o[mt]);
                }
            }
    };
    ATT_LOAD(kA, vA, 0);
    if (ntiles > 1) ATT_LOAD(kB, vB, 1);
    ATT_STORE(kA, vA, 0);
    if (ntiles > 2) ATT_LOAD(kA, vA, 2);
    __syncthreads();
    for (int t = 0; t < ntiles; t += 2) {
        if (t + 1 < ntiles) { ATT_STORE(kB, vB, 1); if (t + 3 < ntiles) ATT_LOAD(kB, vB, t + 3); }
        if (active && t <= cw) compute(t, 0);
        __syncthreads();
        if (t + 1 >= ntiles) break;
        if (t + 2 < ntiles) { ATT_STORE(kA, vA, 0); if (t + 4 < ntiles) ATT_LOAD(kA, vA, t + 4); }
        if (active && t + 1 <= cw) compute(t + 1, 1);
        __syncthreads();
    }
#undef ATT_LOAD
#undef ATT_STORE
    l += __shfl_xor(l, 32);
    const float inv = 1.f / l;
    LAS unsigned* X = (LAS unsigned*)(lds + L_X) + rg * 2048;
    if (active && map == 1) {
        const float sc = -lam * inv;
#pragma unroll
        for (int mt = 0; mt < 4; ++mt)
#pragma unroll
            for (int r = 0; r < 16; r += 2) X[(mt * 8 + (r >> 1)) * 64 + lane] = cvtpk(o[mt][r] * sc, o[mt][r + 1] * sc);
    }
    __syncthreads();
    if (active && map == 0) {
        float ss = 0.f;
#pragma unroll
        for (int mt = 0; mt < 4; ++mt)
#pragma unroll
            for (int r = 0; r < 16; r += 2) { const unsigned xw = X[(mt * 8 + (r >> 1)) * 64 + lane];
                const float v0 = o[mt][r] * inv + bflo(xw), v1 = o[mt][r + 1] * inv + bfhi(xw); o[mt][r] = v0; o[mt][r + 1] = v1; ss += v0 * v0 + v1 * v1; }
        ss += __shfl_xor(ss, 32);
        const float rsn = 0.8f / sqrtf(ss * (1.f / 128.f) + EPS);
        bf16_t* orow = MIX + (size_t)(qrow0 + 32 * rg + r32) * 1024 + 512 + h * 128;
        const float* sg = p.in[15];
#pragma unroll
        for (int mt = 0; mt < 4; ++mt)
#pragma unroll
            for (int jp = 0; jp < 2; ++jp) {
                const int e0 = 32 * mt + 16 * jp + 4 * hi;
                const f32x4 ga = *(const f32x4*)(sg + e0), gb = *(const f32x4*)(sg + e0 + 8);
                const int ra = 8 * jp, rb = 8 * jp + 4;
                const unsigned ex = cvtpk(o[mt][ra + 0] * rsn * ga[0], o[mt][ra + 1] * rsn * ga[1]), ey = cvtpk(o[mt][ra + 2] * rsn * ga[2], o[mt][ra + 3] * rsn * ga[3]);
                const unsigned ox = cvtpk(o[mt][rb + 0] * rsn * gb[0], o[mt][rb + 1] * rsn * gb[1]), oy = cvtpk(o[mt][rb + 2] * rsn * gb[2], o[mt][rb + 3] * rsn * gb[3]);
                const auto sx = __builtin_amdgcn_permlane32_swap(ex, ox, false, false), sy = __builtin_amdgcn_permlane32_swap(ey, oy, false, false);
                *(u32x4*)(orow + 32 * mt + 16 * jp + 8 * hi) = (u32x4){(unsigned)sx[0], (unsigned)sy[0], (unsigned)sx[1], (unsigned)sy[1]};
            }
    }
    __syncthreads();
}

__device__ __forceinline__ void unpack8(const u32x4 w, float (&f)[8]) { f[0] = bflo(w.x); f[1] = bfhi(w.x); f[2] = bflo(w.y); f[3] = bfhi(w.y); f[4] = bflo(w.z); f[5] = bfhi(w.z); f[6] = bflo(w.w); f[7] = bfhi(w.w); }
__device__ __forceinline__ void conv_unit(const Params& p, LAS unsigned char* lds, int cu, int tid, int lane, int wid) {
    const bf16_t* A = (const bf16_t*)(p.ws + WS_A);
    bf16_t* MIX = (bf16_t*)(p.ws + WS_MIX);
    const float* cb = p.in[8]; const float* lg = p.in[9]; const float* lb = p.in[10]; const float* st = p.in[4];
    const int row0 = cu * 64;
    const bool isp = row0 < NP;
    const int s0 = isp ? (row0 & 2047) : 0, rbase = row0 - s0, bd = isp ? 0 : ((row0 - NP) >> 6);
    for (int c = tid; c < 94 * 64; c += 512) {
        const int rr = c >> 6, ch = c & 63, sp = s0 - 30 + rr;
        u32x4 v = (u32x4){0u, 0u, 0u, 0u};
        if (sp >= 0) v = *(const u32x4*)(A + (size_t)(rbase + sp) * 512 + ch * 8);
        else if (!isp) { const float* sr = st + ((size_t)bd * 30 + (30 + sp)) * 512 + ch * 8; const f32x4 a0 = *(const f32x4*)sr, a1 = *(const f32x4*)(sr + 4);
            v.x = cvtpk(a0[0], a0[1]); v.y = cvtpk(a0[2], a0[3]); v.z = cvtpk(a1[0], a1[1]); v.w = cvtpk(a1[2], a1[3]); }
        *(LAS u32x4*)(lds + L_CA + rr * 1024 + ch * 16) = v;
    }
    __syncthreads();
    {
        const LAS unsigned short* ac = (const LAS unsigned short*)(lds + L_CA) + tid;
        const LAS unsigned short* wc = (const LAS unsigned short*)(lds + L_CW) + tid;
        unsigned P[47];
#pragma unroll
        for (int k = 0; k < 47; ++k) P[k] = (unsigned)ac[(2 * k) * 512] | ((unsigned)ac[(2 * k + 1) * 512] << 16);
        unsigned WE[16], WO[16];
#pragma unroll
        for (int m = 0; m < 16; ++m) {
            const unsigned w0 = wc[(2 * m) * 512], w1 = (2 * m + 1 <= 30) ? (unsigned)wc[(2 * m + 1) * 512] : 0u, wm = (m > 0) ? (unsigned)wc[(2 * m - 1) * 512] : 0u;
            WE[m] = w0 | (w1 << 16);
            WO[m] = wm | (w0 << 16);
        }
        const float bias = cb[tid];
        __syncthreads();
        LAS unsigned short* yc = (LAS unsigned short*)(lds + L_CA) + tid;
#pragma unroll
        for (int u = 0; u < 32; ++u) {
            float ye = bias, yo = bias;
#pragma unroll
            for (int m = 0; m < 16; ++m) {
                const unsigned pp = P[u + m];
                ye += bflo(WE[m]) * bflo(pp) + bfhi(WE[m]) * bfhi(pp);
                yo += bflo(WO[m]) * bflo(pp) + bfhi(WO[m]) * bfhi(pp);
            }
            const unsigned w = cvtpk(ye, yo);
            yc[(2 * u) * 512] = (unsigned short)(w & 0xffffu); yc[(2 * u + 1) * 512] = (unsigned short)(w >> 16);
        }
    }
    __syncthreads();
    {
        const int c0 = lane * 8;
        float g8[8], b8[8];
        { const f32x4 y0 = *(const f32x4*)(lg + c0), y1 = *(const f32x4*)(lg + c0 + 4), z0 = *(const f32x4*)(lb + c0), z1 = *(const f32x4*)(lb + c0 + 4);
#pragma unroll
          for (int q = 0; q < 4; ++q) { g8[q] = y0[q]; g8[4 + q] = y1[q]; b8[q] = z0[q]; b8[4 + q] = z1[q]; } }
#pragma unroll 2
        for (int i = 0; i < 8; ++i) {
            const int t = wid * 8 + i;
            float y[8]; unpack8(*(const LAS u32x4*)(lds + L_CA + t * 1024 + lane * 16), y);
            float sm = 0.f, sq = 0.f;
#pragma unroll
            for (int c = 0; c < 8; ++c) { sm += y[c]; sq += y[c] * y[c]; }
            const float mu = wave_total(sm) * (1.f / 512.f);
            const float var = fmaxf(wave_total(sq) * (1.f / 512.f) - mu * mu, 0.f);
            const float rstd = 1.f / sqrtf(var + EPS);
#pragma unroll
            for (int c = 0; c < 8; ++c) { y[c] = (y[c] - mu) * rstd * g8[c] + b8[c]; y[c] = y[c] / (1.f + __expf(-y[c])); }
            u32x4 w; w.x = cvtpk(y[0], y[1]); w.y = cvtpk(y[2], y[3]); w.z = cvtpk(y[4], y[5]); w.w = cvtpk(y[6], y[7]);
            *(u32x4*)(MIX + (size_t)(row0 + t) * 1024 + c0) = w;
        }
    }
}

constexpr int N_SAMPLE_UNITS = 32, N_PROMPT_UNITS = 1024, N_CONV_UNITS = NT / 64, N_UNITS = N_SAMPLE_UNITS + N_PROMPT_UNITS + N_CONV_UNITS;

__device__ __forceinline__ void phase2(const Params& p, LAS unsigned char* lds, int tid, int lane, int wid, int cidx, int mode) {
    LAS float* bt = (LAS float*)(lds + L_BIAS);
    for (int e = tid; e < 4 * 320; e += 512) { const int hh = e / 320, rel = (e % 320) - 256; bt[e] = (p.in[16][rel_bucket(rel) * 4 + hh] - p.in[16][15 * 4 + hh]) * LOG2E; }
    for (int c = tid; c < 31 * 64; c += 512) {
        const float* wr = p.in[7] + (size_t)c * 8; const f32x4 a0 = *(const f32x4*)wr, a1 = *(const f32x4*)(wr + 4);
        u32x4 v; v.x = cvtpk(a0[0], a0[1]); v.y = cvtpk(a0[2], a0[3]); v.z = cvtpk(a1[0], a1[1]); v.w = cvtpk(a1[2], a1[3]);
        *(LAS u32x4*)(lds + L_CW + c * 16) = v;
    }
    const float d1 = wave_sum(p.in[11][lane] * p.in[12][lane]), d2 = wave_sum(p.in[13][lane] * p.in[14][lane]);
    const float lam = expf(d1) - expf(d2) + 0.2f;
    unsigned* ctr = (unsigned*)(p.ws + WS_CTL) + 64 * cidx;
    volatile LAS unsigned* sw = (volatile LAS unsigned*)(lds + MISC_OFF);
    __syncthreads();
    for (;;) {
        __syncthreads();
        if (tid == 0) sw[0] = atomicAdd(ctr, 1u);
        __syncthreads();
        const int u = (int)sw[0];
        if (u >= N_UNITS) break;
        if (mode == 1 && u >= N_SAMPLE_UNITS + N_PROMPT_UNITS) continue;
        if (mode == 2 && u < N_SAMPLE_UNITS + N_PROMPT_UNITS) continue;
        int tid_ = tid; asm volatile("" : "+v"(tid_));
        if (u < N_SAMPLE_UNITS + N_PROMPT_UNITS) {
            const int v = u - N_SAMPLE_UNITS; const int bh = v & 63; const bool smp = u < N_SAMPLE_UNITS;
            attn_unit(p, lds, smp ? 1 : 0, smp ? (u >> 2) : (bh >> 2), smp ? (u & 3) : (bh & 3), smp ? 0 : 15 - (v >> 6), lam, tid_, tid_ & 63, wid);
        } else conv_unit(p, lds, u - N_SAMPLE_UNITS - N_PROMPT_UNITS, tid_, tid_ & 63, wid);
    }
}
}

template <class F> __device__ __forceinline__ void mini_gemm(const bf16_t* A, const bf16_t* Bt, int N, int lane, int wave, F epi) {
    const int ntasks = 32 * (N / 64), G = gridDim.x;
    const int fr = lane & 15, fq = lane >> 4;
    for (int task = wave * G + (int)blockIdx.x; task < ntasks; task += 8 * G) {
        const int rb = task & 31, cb = task >> 5;
        pg8::f32x4 acc[4];
#pragma unroll
        for (int n = 0; n < 4; ++n) acc[n] = (pg8::f32x4){0.f, 0.f, 0.f, 0.f};
        const bf16_t* ap = A + (size_t)(rb * 16 + fr) * 1024 + 8 * fq;
        const bf16_t* bp = Bt + (size_t)(cb * 64 + fr) * 1024 + 8 * fq;
#pragma unroll 8
        for (int k0 = 0; k0 < 1024; k0 += 32) {
            const bf16x8 a0 = *(const bf16x8*)(ap + k0);
            bf16x8 b[4];
#pragma unroll
            for (int n = 0; n < 4; ++n) b[n] = *(const bf16x8*)(bp + (size_t)n * 16 * 1024 + k0);
#pragma unroll
            for (int n = 0; n < 4; ++n) acc[n] = __builtin_amdgcn_mfma_f32_16x16x32_bf16(b[n], a0, acc[n], 0, 0, 0);
        }
        epi(rb * 16 + fr, cb, fq, acc);
    }
}

__device__ __forceinline__ void phase3b(const Params& p, int lane, int wave) {
    const int gw = blockIdx.x * 8 + wave, NGW = gridDim.x * 8;
    bf16_t* H2 = (bf16_t*)(p.ws + WS_H2);
    for (int m = gw; m < NT; m += 2 * NGW) { const int m2 = m + NGW < NT ? m + NGW : m; rms_row2_bf16(p.out + (size_t)m * DM, p.out + (size_t)m2 * DM, p.in[18], H2 + (size_t)m * DM, H2 + (size_t)m2 * DM, lane); }
}

constexpr int P4B_KPITCH = 272, P4B_K_BYTES = 128 * P4B_KPITCH, P4B_Q_BYTES = 32 * P4B_KPITCH;
static_assert(P4B_K_BYTES + 8 * P4B_Q_BYTES <= RING_BYTES, "P4b LDS map");
__device__ __forceinline__ void phase4b(const Params& p, LAS unsigned char* lds, int tid, int lane, int wave) {
    const bf16_t* QP = (const bf16_t*)(p.ws + WS_QP); const bf16_t* SK = (const bf16_t*)(p.ws + WS_SK);
    float* TK = (float*)(p.ws + WS_TK);
    const int r32 = lane & 31, hi = lane >> 5;
    const int G = gridDim.x;
    for (int rp = blockIdx.x & 15; rp < 16; rp += (G < 16 ? G : 16)) {
        const int nbr = (G - rp + 15) >> 4, member = (int)blockIdx.x >> 4;
        __syncthreads();
        for (int c = tid; c < 128 * 16; c += 512) { const int row = c >> 4, ch = c & 15; *(LAS u32x4*)(lds + row * P4B_KPITCH + ch * 16) = *(const u32x4*)(SK + ((size_t)rp * 128 + row) * 128 + ch * 8); }
        __syncthreads();
        LAS unsigned char* qs = lds + P4B_K_BYTES + wave * P4B_Q_BYTES;
        u32x4 qn[8];
        { const int tg0 = member * 8 + wave;
          if (tg0 < NT / 32) {
#pragma unroll
            for (int i = 0; i < 8; ++i) { const int row = 4 * i + (lane >> 4), ch = lane & 15; qn[i] = *(const u32x4*)(QP + (size_t)(tg0 * 32 + row) * 2048 + rp * 128 + ch * 8); } } }
        for (int tg = member * 8 + wave; tg < NT / 32; tg += nbr * 8) {
            const int t0 = tg * 32;
#pragma unroll
            for (int i = 0; i < 8; ++i) { const int row = 4 * i + (lane >> 4), ch = lane & 15; *(LAS u32x4*)(qs + row * P4B_KPITCH + ch * 16) = qn[i]; }
            { const int tgn = tg + nbr * 8;
              if (tgn < NT / 32) {
#pragma unroll
                for (int i = 0; i < 8; ++i) { const int row = 4 * i + (lane >> 4), ch = lane & 15; qn[i] = *(const u32x4*)(QP + (size_t)(tgn * 32 + row) * 2048 + rp * 128 + ch * 8); } } }
            bf16x8 qf[8];
#pragma unroll
            for (int s = 0; s < 8; ++s) qf[s] = *(const LAS bf16x8*)(qs + r32 * P4B_KPITCH + (2 * s + hi) * 16);
            float v[64];
#pragma unroll
            for (int mt = 0; mt < 4; ++mt) {
                f32x16 S;
#pragma unroll
                for (int r = 0; r < 16; ++r) S[r] = 0.f;
                const LAS unsigned char* kp = lds + (32 * mt + r32) * P4B_KPITCH + hi * 16;
#pragma unroll
                for (int s = 0; s < 8; ++s) S = att::mfma32(*(const LAS bf16x8*)(kp + s * 32), qf[s], S);
#pragma unroll
                for (int r = 0; r < 16; ++r) { const int n = 32 * mt + (r & 3) + 8 * (r >> 2) + 4 * hi; v[mt * 16 + r] = __uint_as_float((__float_as_uint(S[r]) & ~127u) | (unsigned)(127 - n)); }
            }
            SORT16_DESC(v, 0); SORT16_DESC(v, 16); SORT16_DESC(v, 32); SORT16_DESC(v, 48);
#pragma unroll
            for (int i = 0; i < 16; ++i) { v[i] = fmaxf(v[i], v[31 - i]); v[32 + i] = fmaxf(v[32 + i], v[63 - i]); }
            BITONIC16_DESC(v, 0); BITONIC16_DESC(v, 32);
#pragma unroll
            for (int i = 0; i < 16; ++i) v[i] = fmaxf(v[i], v[47 - i]);
            BITONIC16_DESC(v, 0);
            float w[16];
#pragma unroll
            for (int i = 0; i < 16; ++i) w[i] = fmaxf(v[i], __shfl_xor(v[15 - i], 32));
            BITONIC16_DESC(w, 0);
            if (hi == 0) {
                f32x4* dst = (f32x4*)(TK + ((size_t)(t0 + r32) * 16 + rp) * 16);
#pragma unroll
                for (int q = 0; q < 4; ++q) dst[q] = (f32x4){w[4 * q], w[4 * q + 1], w[4 * q + 2], w[4 * q + 3]};
            }
        }
    }
}

__device__ __forceinline__ void phase5a(const Params& p, LAS unsigned char* lds, int tid) {
    const float* TK = (const float*)(p.ws + WS_TK);
    int* IDX = (int*)(p.ws + WS_IDX); float* GATE = (float*)(p.ws + WS_GATE);
    const float NEG_INF = -__builtin_huge_valf();
    LAS unsigned* rec = (LAS unsigned*)(lds + tid * 36);
    for (int item = blockIdx.x * 512 + tid; item < NT * 8; item += gridDim.x * 512) {
        const int tok = item >> 3, r = item & 7;
        const f32x4* pa = (const f32x4*)(TK + ((size_t)tok * 16 + 2 * r) * 16);
        float a[16], b[16];
#pragma unroll
        for (int q = 0; q < 4; ++q) { const f32x4 x = pa[q], y = pa[4 + q];
#pragma unroll
            for (int j = 0; j < 4; ++j) { a[4 * q + j] = x[j]; b[4 * q + j] = y[j]; } }
        float ssum = 0.f;
        { const f32x4* sp = (const f32x4*)((const float*)(p.ws + WS_SSQ) + (size_t)tok * 16);
#pragma unroll
          for (int q = 0; q < 4; ++q) { const f32x4 v4 = sp[q]; ssum += (v4[0] + v4[1]) + (v4[2] + v4[3]); } }
#pragma unroll
        for (int q = 0; q < 4; ++q) {
            unsigned wa = 0u, wb = 0u;
#pragma unroll
            for (int j = 0; j < 4; ++j) { const unsigned ua = __float_as_uint(a[4 * q + j]), ub = __float_as_uint(b[4 * q + j]);
                wa |= (127u - (ua & 127u)) << (8 * j); wb |= (127u - (ub & 127u)) << (8 * j);
                a[4 * q + j] = __uint_as_float(ua & ~127u); b[4 * q + j] = __uint_as_float(ub & ~127u); }
            rec[q] = wa; rec[4 + q] = wb;
        }
        float v[64];
        {
            int c = 0;
#pragma unroll
            for (int i = 0; i < 16; ++i)
#pragma unroll
                for (int j = 0; j < 16; ++j)
                    if ((i + 1) * (j + 1) <= 16) { v[c] = __uint_as_float((__float_as_uint(a[i] + b[j]) & ~255u) | (unsigned)(255 - (16 * i + j))); ++c; }
#pragma unroll
            for (int c2 = 50; c2 < 64; ++c2) v[c2] = NEG_INF;
        }
        SORT16_DESC(v, 0); SORT16_DESC(v, 16); SORT16_DESC(v, 32); SORT16_DESC(v, 48);
#pragma unroll
        for (int i = 0; i < 16; ++i) { v[i] = fmaxf(v[i], v[31 - i]); v[32 + i] = fmaxf(v[32 + i], v[63 - i]); }
        BITONIC16_DESC(v, 0); BITONIC16_DESC(v, 32);
#pragma unroll
        for (int i = 0; i < 16; ++i) v[i] = fmaxf(v[i], v[47 - i]);
        BITONIC16_DESC(v, 0);
        const float rstd = 1.f / sqrtf(ssum * (1.f / DM) + EPS);
        if (r == 0) ((float*)(p.ws + WS_RSTD))[tok] = rstd;
        const LAS unsigned char* rb = (const LAS unsigned char*)rec;
        float e[16], sum = 0.f; int bid[16];
        const float best0 = __uint_as_float(__float_as_uint(v[0]) & ~255u);
#pragma unroll
        for (int k = 0; k < 16; ++k) {
            const unsigned u = __float_as_uint(v[k]); const unsigned code = 255u - (u & 255u);
            bid[k] = (int)rb[code >> 4] * 128 + (int)rb[16 + (code & 15u)];
            e[k] = __expf((__uint_as_float(u & ~255u) - best0) * rstd); sum += e[k];
        }
        const float rinv = 1.f / sum;
        int* io = IDX + (size_t)tok * 128 + r * 16; float* go = GATE + (size_t)tok * 128 + r * 16;
#pragma unroll
        for (int k = 0; k < 16; ++k) { io[k] = bid[k]; go[k] = e[k] * rinv; }
    }
}

__device__ __forceinline__ float gelu_erf(float x) { return 0.5f * x * (1.f + erff(x * 0.70710678118654752f)); }
__device__ __forceinline__ void fp8x16_to_f32(const u32x4 q, float (&f)[16]) {
    const f32x2 c0 = __builtin_amdgcn_cvt_pk_f32_fp8(q.x, false), c1 = __builtin_amdgcn_cvt_pk_f32_fp8(q.x, true), c2 = __builtin_amdgcn_cvt_pk_f32_fp8(q.y, false), c3 = __builtin_amdgcn_cvt_pk_f32_fp8(q.y, true);
    const f32x2 c4 = __builtin_amdgcn_cvt_pk_f32_fp8(q.z, false), c5 = __builtin_amdgcn_cvt_pk_f32_fp8(q.z, true), c6 = __builtin_amdgcn_cvt_pk_f32_fp8(q.w, false), c7 = __builtin_amdgcn_cvt_pk_f32_fp8(q.w, true);
    f[0] = c0.x; f[1] = c0.y; f[2] = c1.x; f[3] = c1.y; f[4] = c2.x; f[5] = c2.y; f[6] = c3.x; f[7] = c3.y;
    f[8] = c4.x; f[9] = c4.y; f[10] = c5.x; f[11] = c5.y; f[12] = c6.x; f[13] = c6.y; f[14] = c7.x; f[15] = c7.y;
}
__device__ __forceinline__ void slice_group(int& x, int& gwx, int& nwx, int wave) {
    x = blockIdx.x & 7; const int nbx = ((int)gridDim.x - x + 7) >> 3; gwx = ((int)blockIdx.x >> 3) * 8 + wave; nwx = nbx * 8;
}
__device__ __forceinline__ void phase5u(const Params& p, LAS unsigned char* lds, int lane, int wave) {
    int x, gwx, nwx; slice_group(x, gwx, nwx, wave);
    const unsigned char* PU8 = p.ws + WS_PU8 + (size_t)x * 16384 * 128;
    const bf16_t* H2 = (const bf16_t*)(p.ws + WS_XG) + 128 * x;
    const int* IDX = (const int*)(p.ws + WS_IDX); bf16_t* PACT = (bf16_t*)(p.ws + WS_PACT) + (size_t)x * NT * 128;
    LAS int* l_idx = (LAS int*)(lds + wave * 512);
    const int g = lane >> 3, sub = lane & 7;
    const unsigned char* rowp = PU8 + sub * 16;
    int r_idxA = 0, r_idxB = 0;
    u32x4 hA0, hA1, hB0, hB1; hA0 = hA1 = hB0 = hB1 = (u32x4){0u, 0u, 0u, 0u};
    u32x4 qA[16], qB[16];
#define P5U_LOADIDX(T) do { if ((T) < NT) { r_idxA = IDX[(size_t)(T) * 128 + lane]; r_idxB = IDX[(size_t)(T) * 128 + 64 + lane]; } } while (0)
#define P5U_ISSUE(Q, H0, H1, T) do { if ((T) < NT) { l_idx[lane] = r_idxA; l_idx[64 + lane] = r_idxB; \
        H0 = *(const u32x4*)(H2 + (size_t)(T) * DM + 16 * sub); H1 = *(const u32x4*)(H2 + (size_t)(T) * DM + 16 * sub + 8); \
        _Pragma("unroll") for (int q_ = 0; q_ < 4; ++q_) { const u32x4 iv = *(const LAS u32x4*)(l_idx + 16 * g + 4 * q_); \
            Q[4 * q_] = *(const u32x4*)(rowp + (size_t)iv.x * 128); Q[4 * q_ + 1] = *(const u32x4*)(rowp + (size_t)iv.y * 128); \
            Q[4 * q_ + 2] = *(const u32x4*)(rowp + (size_t)iv.z * 128); Q[4 * q_ + 3] = *(const u32x4*)(rowp + (size_t)iv.w * 128); } } } while (0)
#define IDPP_ADD(v, ctrl) v += __builtin_amdgcn_update_dpp(0, v, ctrl, 0xf, 0xf, true)
#define FDPP_MAX(v, ctrl) v = fmaxf(v, __builtin_bit_cast(float, __builtin_amdgcn_update_dpp(0, __builtin_bit_cast(int, v), ctrl, 0xf, 0xf, true)))
#define P5U_COMPUTE(Q, H0, H1, T) do { \
        float hf[16]; \
        hf[0] = bflo(H0.x); hf[1] = bfhi(H0.x); hf[2] = bflo(H0.y); hf[3] = bfhi(H0.y); hf[4] = bflo(H0.z); hf[5] = bfhi(H0.z); hf[6] = bflo(H0.w); hf[7] = bfhi(H0.w); \
        hf[8] = bflo(H1.x); hf[9] = bfhi(H1.x); hf[10] = bflo(H1.y); hf[11] = bfhi(H1.y); hf[12] = bflo(H1.z); hf[13] = bfhi(H1.z); hf[14] = bflo(H1.w); hf[15] = bfhi(H1.w); \
        float am = 0.f; \
        _Pragma("unroll") for (int j = 0; j < 16; ++j) am = fmaxf(am, fabsf(hf[j])); \
        FDPP_MAX(am, 0xB1); FDPP_MAX(am, 0x4E); FDPP_MAX(am, 0x141);              \
        const float sh = am > 0.f ? am * (1.f / 127.f) : 1.f, ih = 1.f / sh; \
        int hq[4]; \
        _Pragma("unroll") for (int w_ = 0; w_ < 4; ++w_) { \
            const int q0 = __float2int_rn(hf[4 * w_] * ih), q1 = __float2int_rn(hf[4 * w_ + 1] * ih), q2 = __float2int_rn(hf[4 * w_ + 2] * ih), q3 = __float2int_rn(hf[4 * w_ + 3] * ih); \
            hq[w_] = (int)((unsigned)(q0 & 255) | ((unsigned)(q1 & 255) << 8) | ((unsigned)(q2 & 255) << 16) | ((unsigned)(q3 & 255) << 24)); } \
        int resA = 0, resB = 0; \
        _Pragma("unroll") for (int i = 0; i < 16; ++i) { \
            int d = __builtin_amdgcn_sdot4((int)Q[i].x, hq[0], 0, false); d = __builtin_amdgcn_sdot4((int)Q[i].y, hq[1], d, false); \
            d = __builtin_amdgcn_sdot4((int)Q[i].z, hq[2], d, false); d = __builtin_amdgcn_sdot4((int)Q[i].w, hq[3], d, false); \
            IDPP_ADD(d, 0xB1); IDPP_ADD(d, 0x4E); IDPP_ADD(d, 0x141); \
            if ((i & 1) == 0) resA = (sub == (i >> 1)) ? d : resA; else resB = (sub == (i >> 1)) ? d : resB; } \
        *(unsigned*)(PACT + (size_t)(T) * 128 + 16 * g + 2 * sub) = cvtpk((float)resA * sh, (float)resB * sh); } while (0)
    int tok = gwx;
    P5U_LOADIDX(tok);
    P5U_ISSUE(qA, hA0, hA1, tok);
    P5U_LOADIDX(tok + nwx);
    for (; tok < NT; tok += 2 * nwx) {
        P5U_ISSUE(qB, hB0, hB1, tok + nwx);
        P5U_LOADIDX(tok + 2 * nwx);
        P5U_COMPUTE(qA, hA0, hA1, tok);
        if (tok + nwx >= NT) break;
        P5U_ISSUE(qA, hA0, hA1, tok + 2 * nwx);
        P5U_LOADIDX(tok + 3 * nwx);
        P5U_COMPUTE(qB, hB0, hB1, tok + nwx);
    }
#undef P5U_LOADIDX
#undef P5U_ISSUE
#undef P5U_COMPUTE
#undef IDPP_ADD
#undef FDPP_MAX
}
__device__ __forceinline__ void phase5c(const Params& p, int tid) {
    const bf16_t* PACT = (const bf16_t*)(p.ws + WS_PACT); const float* SCU = (const float*)(p.ws + WS_SCU); const float* SCV = (const float*)(p.ws + WS_SCV);
    const int* IDX = (const int*)(p.ws + WS_IDX); const float* GATE = (const float*)(p.ws + WS_GATE); float* COEF = (float*)(p.ws + WS_COEF); const float* RSTD = (const float*)(p.ws + WS_RSTD);
    const size_t n = (size_t)NT * 128, n4 = n / 4, stride = (size_t)gridDim.x * 512;
    for (size_t i0 = (size_t)blockIdx.x * 512 + tid; i0 < n4; i0 += 2 * stride) {
        f32x4 a[2], g[2]; u32x4 e[2]; f32x4 pa[2][8]; float rs[2];
#pragma unroll
        for (int u = 0; u < 2; ++u) {
            const size_t it = (i0 + u * stride < n4 ? i0 + u * stride : i0) * 4;
#pragma unroll
            for (int xx = 0; xx < 8; ++xx) { const u32x2 w2 = *(const u32x2*)(PACT + (size_t)xx * n + it); pa[u][xx] = (f32x4){bflo(w2.x), bfhi(w2.x), bflo(w2.y), bfhi(w2.y)}; }
            e[u] = *(const u32x4*)(IDX + it); g[u] = *(const f32x4*)(GATE + it); rs[u] = RSTD[it >> 7];
        }
        float su[2][4], sv[2][4];
#pragma unroll
        for (int u = 0; u < 2; ++u)
#pragma unroll
            for (int j = 0; j < 4; ++j) { su[u][j] = SCU[e[u][j]]; sv[u][j] = SCV[e[u][j]]; }
#pragma unroll
        for (int u = 0; u < 2; ++u) {
            a[u] = ((pa[u][0] + pa[u][1]) + (pa[u][2] + pa[u][3])) + ((pa[u][4] + pa[u][5]) + (pa[u][6] + pa[u][7]));
            f32x4 c;
#pragma unroll
            for (int j = 0; j < 4; ++j) c[j] = g[u][j] * gelu_erf(a[u][j] * (rs[u] * su[u][j])) * sv[u][j];
            if (i0 + u * stride < n4) *(f32x4*)(COEF + (i0 + u * stride) * 4) = c;
        }
    }
}

constexpr int P5V_LDS_PER_WAVE = 1024 + 8 * 136 * 4;
__device__ __forceinline__ void phase5v(const Params& p, LAS unsigned char* lds, int lane, int wave) {
    int x, gwx, nwx; slice_group(x, gwx, nwx, wave);
    const unsigned char* PV8 = p.ws + WS_PV8 + (size_t)x * 16384 * 128;
    const int* IDX = (const int*)(p.ws + WS_IDX); const float* COEF = (const float*)(p.ws + WS_COEF);
    LAS int* l_idx = (LAS int*)(lds + wave * P5V_LDS_PER_WAVE); LAS float* l_cf = (LAS float*)(l_idx + 128); LAS float* red = l_cf + 128;
    const int g = lane >> 3, sub = lane & 7;
    const unsigned char* rowp = PV8 + sub * 16;
    const int c1 = 2 * lane;
    const bf16_t* XG = (const bf16_t*)(p.ws + WS_XG) + 128 * x + c1; bf16_t* X3 = (bf16_t*)(p.ws + WS_X3) + 128 * x + c1;
    const float ig0 = 1.f / p.in[18][128 * x + c1], ig1 = 1.f / p.in[18][128 * x + c1 + 1];
    int r_idxA = 0, r_idxB = 0; float r_cA = 0.f, r_cB = 0.f;
    u32x4 qA[16], qB[16]; f32x4 cfA[4], cfB[4]; unsigned xA0 = 0u, xA1 = 0u, xB0 = 0u, xB1 = 0u;
#define P5V_LOADIDX(T) do { if ((T) < NT) { r_idxA = IDX[(size_t)(T) * 128 + lane]; r_idxB = IDX[(size_t)(T) * 128 + 64 + lane]; r_cA = COEF[(size_t)(T) * 128 + lane]; r_cB = COEF[(size_t)(T) * 128 + 64 + lane]; } } while (0)
#define P5V_ISSUE(Q, CF, X0, X1, T) do { if ((T) < NT) { l_idx[lane] = r_idxA; l_idx[64 + lane] = r_idxB; l_cf[lane] = r_cA; l_cf[64 + lane] = r_cB; \
        X0 = *(const unsigned*)(XG + (size_t)(T) * DM); (void)X1; \
        _Pragma("unroll") for (int q_ = 0; q_ < 4; ++q_) { const u32x4 iv = *(const LAS u32x4*)(l_idx + 16 * g + 4 * q_); CF[q_] = *(const LAS f32x4*)(l_cf + 16 * g + 4 * q_); \
            Q[4 * q_] = *(const u32x4*)(rowp + (size_t)iv.x * 128); Q[4 * q_ + 1] = *(const u32x4*)(rowp + (size_t)iv.y * 128); \
            Q[4 * q_ + 2] = *(const u32x4*)(rowp + (size_t)iv.z * 128); Q[4 * q_ + 3] = *(const u32x4*)(rowp + (size_t)iv.w * 128); } } } while (0)
#define P5V_COMPUTE(Q, CF, X0, X1, T) do { \
        f32x2 acc[8]; \
        _Pragma("unroll") for (int j = 0; j < 8; ++j) acc[j] = (f32x2){0.f, 0.f}; \
        _Pragma("unroll") for (int i = 0; i < 16; ++i) { \
            const float cs_ = CF[i >> 2][i & 3]; const f32x2 c2 = (f32x2){cs_, cs_}; \
            acc[0] = __builtin_elementwise_fma(__builtin_amdgcn_cvt_pk_f32_fp8(Q[i].x, false), c2, acc[0]); \
            acc[1] = __builtin_elementwise_fma(__builtin_amdgcn_cvt_pk_f32_fp8(Q[i].x, true), c2, acc[1]); \
            acc[2] = __builtin_elementwise_fma(__builtin_amdgcn_cvt_pk_f32_fp8(Q[i].y, false), c2, acc[2]); \
            acc[3] = __builtin_elementwise_fma(__builtin_amdgcn_cvt_pk_f32_fp8(Q[i].y, true), c2, acc[3]); \
            acc[4] = __builtin_elementwise_fma(__builtin_amdgcn_cvt_pk_f32_fp8(Q[i].z, false), c2, acc[4]); \
            acc[5] = __builtin_elementwise_fma(__builtin_amdgcn_cvt_pk_f32_fp8(Q[i].z, true), c2, acc[5]); \
            acc[6] = __builtin_elementwise_fma(__builtin_amdgcn_cvt_pk_f32_fp8(Q[i].w, false), c2, acc[6]); \
            acc[7] = __builtin_elementwise_fma(__builtin_amdgcn_cvt_pk_f32_fp8(Q[i].w, true), c2, acc[7]); } \
        _Pragma("unroll") for (int j = 0; j < 8; ++j) *(LAS f32x2*)(red + g * 136 + 16 * sub + 2 * j) = acc[j]; \
        f32x2 s12 = (f32x2){bflo(X0) * ig0, bfhi(X0) * ig1}; \
        _Pragma("unroll") for (int gg = 0; gg < 8; ++gg) s12 += *(const LAS f32x2*)(red + gg * 136 + 2 * lane); \
        *(unsigned*)(X3 + (size_t)(T) * DM) = cvtpk(s12.x, s12.y); } while (0)
    int tok = gwx;
    P5V_LOADIDX(tok);
    P5V_ISSUE(qA, cfA, xA0, xA1, tok);
    P5V_LOADIDX(tok + nwx);
    for (; tok < NT; tok += 2 * nwx) {
        P5V_ISSUE(qB, cfB, xB0, xB1, tok + nwx);
        P5V_LOADIDX(tok + 2 * nwx);
        P5V_COMPUTE(qA, cfA, xA0, xA1, tok);
        if (tok + nwx >= NT) break;
        P5V_ISSUE(qA, cfA, xA0, xA1, tok + 2 * nwx);
        P5V_LOADIDX(tok + 3 * nwx);
        P5V_COMPUTE(qB, cfB, xB0, xB1, tok + nwx);
    }
#undef P5V_LOADIDX
#undef P5V_ISSUE
#undef P5V_COMPUTE
}

__device__ __forceinline__ void phase6(const Params& p, int lane, int wave) {
    const int gw = blockIdx.x * 8 + wave, NGW = gridDim.x * 8;
    const f32x4* gr = (const f32x4*)p.in[23] + lane;
    const bf16_t* X3 = (const bf16_t*)(p.ws + WS_X3);
    for (int m = gw; m < NT; m += 2 * NGW) {
        const bool two = m + NGW < NT; const int m2 = two ? m + NGW : m;
        const u32x2* xa = (const u32x2*)(X3 + (size_t)m * DM) + lane; const u32x2* xb = (const u32x2*)(X3 + (size_t)m2 * DM) + lane;
        u32x2 wa[4], wb[4];
#pragma unroll
        for (int j = 0; j < 4; ++j) { wa[j] = xa[64 * j]; wb[j] = xb[64 * j]; }
        f32x4 va[4], vb[4]; float sa = 0.f, sb = 0.f;
#pragma unroll
        for (int j = 0; j < 4; ++j) {
            va[j] = (f32x4){bflo(wa[j].x), bfhi(wa[j].x), bflo(wa[j].y), bfhi(wa[j].y)}; vb[j] = (f32x4){bflo(wb[j].x), bfhi(wb[j].x), bflo(wb[j].y), bfhi(wb[j].y)};
            sa += (va[j][0] * va[j][0] + va[j][1] * va[j][1]) + (va[j][2] * va[j][2] + va[j][3] * va[j][3]); sb += (vb[j][0] * vb[j][0] + vb[j][1] * vb[j][1]) + (vb[j][2] * vb[j][2] + vb[j][3] * vb[j][3]);
        }
        const float ra_ = 1.f / sqrtf(wave_total(sa) * (1.f / DM) + EPS), rb_ = 1.f / sqrtf(wave_total(sb) * (1.f / DM) + EPS);
        f32x4* ya = (f32x4*)(p.out + (size_t)m * DM) + lane; f32x4* yb = (f32x4*)(p.out + (size_t)m2 * DM) + lane;
#pragma unroll
        for (int j = 0; j < 4; ++j) { const f32x4 gg = gr[64 * j]; __builtin_nontemporal_store(va[j] * ra_ * gg, ya + 64 * j); if (two) __builtin_nontemporal_store(vb[j] * rb_ * gg, yb + 64 * j); }
    }
}

__global__ void __launch_bounds__(512, 2) fwd_megakernel(Params p) {
    extern __shared__ __attribute__((aligned(16))) unsigned char lds_raw[];
    LAS unsigned char* lds = (LAS unsigned char*)lds_raw;
    const int tid0 = threadIdx.x, wave = __builtin_amdgcn_readfirstlane(tid0 >> 6);
#define PHASE_IDS() int tid = tid0; asm volatile("" : "+v"(tid)); const int lane = tid & 63; (void)lane
    const int G = gridDim.x;
    volatile LAS unsigned* MISC = (volatile LAS unsigned*)(lds + MISC_OFF);
    if (tid0 < 32) MISC[tid0] = 0u;
    __syncthreads();
    XcdBarrier bar = xcd_barrier_post((unsigned*)(p.ws + WS_CTL) + 4096, MISC + 8);
#define GSYNC() xcd_barrier(bar)

#ifndef RPT_MASK
#define RPT_MASK 0
#endif
#if RPT_MASK
#define RPT(bit) for (int rpt_ = 0; rpt_ < (((RPT_MASK) >> (bit)) & 1) + 1; ++rpt_)
#else
#define RPT(bit) if (constexpr int rpt_ = 0; true)
#endif
    RPT(0) { PHASE_IDS(); phase0(p, lds, tid, lane, wave); GSYNC(); }
    RPT(1) {
        PHASE_IDS();
        pg8::Gemm g{(const bf16_t*)(p.ws + WS_H), (const bf16_t*)(p.ws + WS_WINT), NT, DIN, 1024};
        pg8::StaticOrder S; S.init(NT, DIN, G, (int)blockIdx.x);
        pg8::EpiProj E{(bf16_t*)(p.ws + WS_A), (bf16_t*)(p.ws + WS_Q), (bf16_t*)(p.ws + WS_KP), (bf16_t*)(p.ws + WS_VP), (bf16_t*)(p.ws + WS_KS), (bf16_t*)(p.ws + WS_VS), p.out};
        const int nwg1 = (NT / 256) * (DIN / 256), rem1 = nwg1 % G, c1 = (int)blockIdx.x;
        const bool has_extra = rem1 != 0 && c1 < rem1;
        const bool grpA = ((c1 >> 3) & 1) == 0;
        auto cnt_even = [](int b) { return (b >> 4) * 8 + ((((b >> 3) & 1) == 0) ? (b & 7) : 8); };
        const int lo = rem1;
        const int nA = cnt_even(G) - cnt_even(lo), nB = (G - lo) - nA;
        const int rA = cnt_even(c1) - cnt_even(lo), rB = (c1 - lo) - rA;
        if (!has_extra && grpA && nA > 0) prep_late(p, lds, tid, lane, wave, rA, nA, nB > 0 ? 1 : 3);
        pg8::gemm_phase<pg8::EpiProj, pg8::StaticOrder, true, true>(lds, g, S, E);
        if (!has_extra && !grpA && nB > 0) prep_late(p, lds, tid, lane, wave, rB, nB, nA > 0 ? 2 : 3);
        GSYNC();
    }
    #ifndef P2MODE
#define P2MODE 0
#endif
    RPT(2) { PHASE_IDS(); att::phase2(p, lds, tid, lane, wave, rpt_, (((RPT_MASK) >> 2) & 1) && rpt_ == 0 ? P2MODE : 0); GSYNC(); }
    RPT(3) {
        PHASE_IDS();
        pg8::Gemm g{(const bf16_t*)(p.ws + WS_MIX), (const bf16_t*)(p.ws + WS_WOUTT), NP, 1024, 1024};
        pg8::StaticOrder S; S.init(NP, 1024, G, (int)blockIdx.x);
        pg8::EpiRes E{p.in[0], p.in[1], (bf16_t*)(p.ws + WS_XG), p.in[18], (float*)(p.ws + WS_SSQ)};
        pg8::gemm_phase<pg8::EpiRes, pg8::StaticOrder, true, true>(lds, g, S, E);
        {
            const float* xs = p.in[1]; bf16_t* go = (bf16_t*)(p.ws + WS_XG) + (size_t)NP * DM; const float* gff = p.in[18]; float* sso = (float*)(p.ws + WS_SSQ) + (size_t)NP * 16;
            mini_gemm((const bf16_t*)(p.ws + WS_MIX) + (size_t)NP * DM, (const bf16_t*)(p.ws + WS_WOUTT), 1024, lane, wave,
                      [=](int row, int cb, int fq, const pg8::f32x4 (&a)[4]) {
                          float sq = 0.f;
#pragma unroll
                          for (int n = 0; n < 4; ++n) {
                              const int col = cb * 64 + 16 * n + 4 * fq;
                              const pg8::f32x4 v = *(const pg8::f32x4*)(xs + (size_t)row * DM + col) + a[n];
                              *(u32x2*)(go + (size_t)row * DM + col) = pg8::pack4(v * *(const pg8::f32x4*)(gff + col));
                              sq += (v[0] * v[0] + v[1] * v[1]) + (v[2] * v[2] + v[3] * v[3]);
                          }
                          sq += __shfl_xor(sq, 16); sq += __shfl_xor(sq, 32);
                          if (fq == 0) sso[(size_t)row * 16 + cb] = sq;
                      });
        }
        GSYNC();
    }
    RPT(5) {
        PHASE_IDS();
        pg8::Gemm g{(const bf16_t*)(p.ws + WS_XG), (const bf16_t*)(p.ws + WS_WQT), NP, 2048, 1024};
        pg8::StaticOrder S; S.init(NP, 2048, G, (int)blockIdx.x);
        pg8::EpiBf16<0> E{(bf16_t*)(p.ws + WS_QP), 2048, nullptr, 0, 0, 1.f};
        pg8::gemm_phase<pg8::EpiBf16<0>, pg8::StaticOrder, true, true>(lds, g, S, E);
        {
            bf16_t* qo = (bf16_t*)(p.ws + WS_QP) + (size_t)NP * 2048;
            mini_gemm((const bf16_t*)(p.ws + WS_XG) + (size_t)NP * DM, (const bf16_t*)(p.ws + WS_WQT), 2048, lane, wave,
                      [=](int row, int cb, int fq, const pg8::f32x4 (&a)[4]) {
#pragma unroll
                          for (int n = 0; n < 4; ++n) *(u32x2*)(qo + (size_t)row * 2048 + cb * 64 + 16 * n + 4 * fq) = pg8::pack4(a[n]);
                      });
        }
        GSYNC();
    }
    RPT(6) { PHASE_IDS(); phase4b(p, lds, tid, lane, wave); GSYNC(); }
    RPT(7) { PHASE_IDS(); phase5a(p, lds, tid); GSYNC(); }
    RPT(8) { PHASE_IDS(); phase5u(p, lds, lane, wave); GSYNC(); }
    RPT(9) { PHASE_IDS(); phase5c(p, tid); GSYNC(); }
    { PHASE_IDS(); phase5v(p, lds, lane, wave); }
    GSYNC();
    { PHASE_IDS(); phase6(p, lane, wave); }
}

extern "C" void kernel_launch(void* const* d_in, const int* in_sizes, int n_in, void* d_out, int out_size, void* d_ws, size_t ws_size, hipStream_t stream) {
    static int grid = 0;
    if (grid == 0) {
        if (n_in != 24 || out_size != (int)OUT_TOTAL || ws_size < WS_END) { fprintf(stderr, "kernel_launch: unexpected shapes: n_in %d out %d ws %zu (need %zu)\n", n_in, out_size, ws_size, (size_t)WS_END); grid = -1; return; }
        int dev = 0, cus = 0, per_cu = 0;
        (void)hipGetDevice(&dev);
        (void)hipDeviceGetAttribute(&cus, hipDeviceAttributeMultiprocessorCount, dev);
        if (hipFuncSetAttribute((const void*)fwd_megakernel, hipFuncAttributeMaxDynamicSharedMemorySize, LDS_BYTES) != hipSuccess) { fprintf(stderr, "kernel_launch: hipFuncSetAttribute failed\n"); grid = -1; return; }
        if (hipOccupancyMaxActiveBlocksPerMultiprocessor(&per_cu, (const void*)fwd_megakernel, 512, LDS_BYTES) != hipSuccess || per_cu < 1) { fprintf(stderr, "kernel_launch: occupancy query gave %d\n", per_cu); per_cu = 1; }
        (void)hipGetLastError();
        grid = cus * 1;
        if (per_cu < 1) grid = -1;
    }
    if (grid < 0) return;
    (void)hipMemsetAsync((char*)d_ws + WS_CTL, 0, CTL_BYTES, stream);
    Params p{};
    for (int i = 0; i < 24; ++i) p.in[i] = (const float*)d_in[i];
    p.out = (float*)d_out; p.ws = (unsigned char*)d_ws;
    void* args[] = {&p};
    hipError_t e = hipLaunchCooperativeKernel((const void*)fwd_megakernel, dim3(grid), dim3(512), args, LDS_BYTES, stream);
    if (e != hipSuccess) fprintf(stderr, "cooperative launch failed: %s (grid %d)\n", hipGetErrorString(e), grid);
}
```
